# Optimizing an MI355X kernel written in HIP

```python
import jax, jax.numpy as jnp
from jax import lax
import numpy as np

D_MODEL = 1024
BATCH = 8
SEQ = 2048
DEPTH = 2

PLE_DIM = 256
HEAD_DIM = 64
SGU_HEADS = 4
SGU_WIDTH = SGU_HEADS * HEAD_DIM
CHUNK = 128
CONV_GROUPS = 4
CONV_WIDTH = CONV_GROUPS * HEAD_DIM
CONV_KERNEL = 31
MLA_HEADS = 8
MLA_NOPE = 64
MLA_ROPE = 32
MLA_QK = MLA_NOPE + MLA_ROPE
MLA_V = 64
MLA_WIDTH = MLA_HEADS * MLA_V
Q_RANK = 256
KV_RANK = 128
ROPE_THETA = 10000.0
Q_BLOCK = 128
MIX_WIDTH = SGU_WIDTH + CONV_WIDTH + MLA_WIDTH
IN_WIDTH = 2 * SGU_WIDTH + 2 * CONV_WIDTH + Q_RANK + KV_RANK + MLA_ROPE
IN_SPLITS = [2 * SGU_WIDTH, 2 * SGU_WIDTH + 2 * CONV_WIDTH,
             2 * SGU_WIDTH + 2 * CONV_WIDTH + Q_RANK,
             2 * SGU_WIDTH + 2 * CONV_WIDTH + Q_RANK + KV_RANK]
N_GROUPS = 4
EXPERTS_PER_GROUP = 8
N_EXPERTS = N_GROUPS * EXPERTS_PER_GROUP
D_EXPERT = 256
TOP_K = 2
EXPERT_BLOCK = 128
MAX_START = 4096
EPS = 1e-6

kernel_name = "hymba_sgu_conformer_mla_hmoe"


def rmsnorm(x, g):
    xf = x.astype(jnp.float32)
    y = xf * lax.rsqrt(jnp.mean(xf * xf, axis=-1, keepdims=True) + EPS)
    return (y * g.astype(jnp.float32)).astype(x.dtype)


def layernorm(x, g, b):
    xf = x.astype(jnp.float32)
    mu = jnp.mean(xf, axis=-1, keepdims=True)
    var = jnp.mean(jnp.square(xf - mu), axis=-1, keepdims=True)
    y = (xf - mu) * lax.rsqrt(var + EPS)
    return (y * g.astype(jnp.float32) + b.astype(jnp.float32)).astype(x.dtype)


def rope(x, cos, sin):
    xf = x.astype(jnp.float32)
    x1, x2 = jnp.split(xf, 2, axis=-1)
    return jnp.concatenate([x1 * cos - x2 * sin, x2 * cos + x1 * sin], axis=-1).astype(x.dtype)


def sgu_mixer(z, ln_g, ln_b, w_s, b_s):
    B, S, _ = z.shape
    z = jax.nn.gelu(z)
    u, v = jnp.split(z, 2, axis=-1)
    v = layernorm(v.reshape(B, S, SGU_HEADS, HEAD_DIM),
                  ln_g.reshape(SGU_HEADS, HEAD_DIM), ln_b.reshape(SGU_HEADS, HEAD_DIM))
    v = v.reshape(B, S // CHUNK, CHUNK, SGU_HEADS, HEAD_DIM)
    causal = jnp.tril(jnp.ones((CHUNK, CHUNK), w_s.dtype))
    s = jnp.einsum('hij,bnjhd->bnihd', w_s * causal, v)
    s = s + jnp.transpose(b_s)[None, None, :, :, None]
    return u * s.reshape(B, S, SGU_WIDTH)


def conv_mixer(z, conv_w, conv_b, ln_g, ln_b, pw_w, pw_b):
    B, S, _ = z.shape
    a, g = jnp.split(z, 2, axis=-1)
    y = a * jax.nn.sigmoid(g)
    y = lax.conv_general_dilated(
        y, conv_w[:, None, :].astype(y.dtype), window_strides=(1,),
        padding=[(CONV_KERNEL - 1, 0)], dimension_numbers=('NWC', 'WIO', 'NWC'),
        feature_group_count=CONV_WIDTH) + conv_b
    y = layernorm(y.reshape(B, S, CONV_GROUPS, HEAD_DIM),
                  ln_g.reshape(CONV_GROUPS, HEAD_DIM), ln_b.reshape(CONV_GROUPS, HEAD_DIM))
    y = jax.nn.silu(y.reshape(B, S, CONV_WIDTH))
    return y @ pw_w + pw_b


def causal_block_attention(q, k, v):
    B, S, H, _ = q.shape
    nb = S // Q_BLOCK
    qb = jnp.transpose(q.reshape(B, nb, Q_BLOCK, H, MLA_QK), (1, 0, 2, 3, 4))
    kpos = jnp.arange(S)
    scale = MLA_QK ** -0.5

    def block(args):
        qi, bi = args
        s = jnp.einsum('bqhd,bkhd->bhqk', qi, k, preferred_element_type=jnp.float32) * scale
        qpos = bi * Q_BLOCK + jnp.arange(Q_BLOCK)
        s = jnp.where(kpos[None, :] <= qpos[:, None], s, -1e30)
        pr = jax.nn.softmax(s, axis=-1).astype(v.dtype)
        return jnp.einsum('bhqk,bkhd->bqhd', pr, v)

    o = lax.map(block, (qb, jnp.arange(nb)))
    return jnp.transpose(o, (1, 0, 2, 3, 4)).reshape(B, S, H * MLA_V)


def mla_mixer(c_q, c_kv, k_pe, cos, sin, qa_g, w_uq, kva_g, w_ukv, qn_g, kn_g):
    B, S, _ = c_q.shape
    q = (rmsnorm(c_q, qa_g) @ w_uq).reshape(B, S, MLA_HEADS, MLA_QK)
    kv = (rmsnorm(c_kv, kva_g) @ w_ukv).reshape(B, S, MLA_HEADS, MLA_NOPE + MLA_V)
    q_nope = rmsnorm(q[..., :MLA_NOPE], qn_g[:MLA_NOPE])
    q_pe = rope(rmsnorm(q[..., MLA_NOPE:], qn_g[MLA_NOPE:]), cos, sin)
    k_nope = rmsnorm(kv[..., :MLA_NOPE], kn_g[:MLA_NOPE])
    v = kv[..., MLA_NOPE:]
    k_pe = rope(rmsnorm(k_pe, kn_g[MLA_NOPE:])[:, :, None, :], cos, sin)
    q = jnp.concatenate([q_nope, q_pe], axis=-1)
    k = jnp.concatenate([k_nope, jnp.broadcast_to(k_pe, (B, S, MLA_HEADS, MLA_ROPE))], axis=-1)
    return causal_block_attention(q, k, v)


def hier_moe(m, wg, bg, we, be, w_gate, w_up, w_down):
    B, S, D = m.shape
    t = m.reshape(-1, D)
    N = t.shape[0]
    glog = (t @ wg + bg).astype(jnp.float32)
    gprob = jax.nn.softmax(glog, axis=-1)
    g_idx = jnp.argmax(glog, axis=-1)
    g_w = jnp.take_along_axis(gprob, g_idx[:, None], axis=1)[:, 0]
    elog = (t @ we + be).astype(jnp.float32).reshape(N, N_GROUPS, EXPERTS_PER_GROUP)
    elog = jnp.take_along_axis(elog, g_idx[:, None, None], axis=1)[:, 0, :]
    eprob = jax.nn.softmax(elog, axis=-1)
    topv, topi = lax.top_k(eprob, TOP_K)
    topv = topv / jnp.sum(topv, axis=-1, keepdims=True)

    nk = N * TOP_K
    flat_e = (g_idx[:, None] * EXPERTS_PER_GROUP + topi).reshape(-1)
    flat_tok = jnp.repeat(jnp.arange(N, dtype=jnp.int32), TOP_K)
    flat_w = (g_w[:, None] * topv).reshape(-1)
    order = jnp.argsort(flat_e)
    e_s, tok_s, w_s = flat_e[order], flat_tok[order], flat_w[order]
    counts = jnp.bincount(flat_e, length=N_EXPERTS)
    start = jnp.cumsum(counts) - counts
    padded = (counts + EXPERT_BLOCK - 1) // EXPERT_BLOCK * EXPERT_BLOCK
    pend = jnp.cumsum(padded)
    pstart = pend - padded
    dest = pstart[e_s] + (jnp.arange(nk) - start[e_s])
    P = nk + N_EXPERTS * EXPERT_BLOCK
    nb = P // EXPERT_BLOCK
    buf_tok = jnp.zeros((P,), jnp.int32).at[dest].set(tok_s)
    buf_w = jnp.zeros((P,), t.dtype).at[dest].set(w_s.astype(t.dtype))
    blk_e = jnp.minimum(jnp.searchsorted(pend, jnp.arange(nb) * EXPERT_BLOCK, side='right'),
                        N_EXPERTS - 1)

    def expert_block(args):
        tok_b, w_b, e = args
        xb = t[tok_b]
        hb = jax.nn.silu(xb @ w_gate[e]) * (xb @ w_up[e])
        return (hb @ w_down[e]) * w_b[:, None]

    y = lax.map(expert_block, (buf_tok.reshape(nb, EXPERT_BLOCK),
                               buf_w.reshape(nb, EXPERT_BLOCK), blk_e))
    out = jnp.zeros((N, D), t.dtype).at[buf_tok].add(y.reshape(P, D))
    return out.reshape(B, S, D)


def setup_inputs(seed: int = 0) -> dict:
    key = jax.random.key(seed)
    ks = iter(jax.random.split(key, 48))
    L = DEPTH

    def nrm(shape, scale):
        return jax.random.normal(next(ks), shape, jnp.float32) * scale

    def gain(shape):
        return 1.0 + nrm(shape, 0.01)

    x = nrm((BATCH, SEQ, D_MODEL), 1.0)
    p = nrm((DEPTH, BATCH, SEQ, PLE_DIM), 1.0)
    positions = (jax.random.randint(next(ks), (BATCH, 1), 0, MAX_START, dtype=jnp.int32)
                 + jnp.arange(SEQ, dtype=jnp.int32)[None, :])
    return {
        "x": x,
        "p": p,
        "positions": positions,
        "mix_norm_g": gain((L, D_MODEL)),
        "w_in": nrm((L, D_MODEL, IN_WIDTH), D_MODEL ** -0.5),
        "sgu_ln_g": gain((L, SGU_WIDTH)),
        "sgu_ln_b": nrm((L, SGU_WIDTH), 0.01),
        "sgu_w": nrm((L, SGU_HEADS, CHUNK, CHUNK), CHUNK ** -0.5),
        "sgu_b": gain((L, SGU_HEADS, CHUNK)),
        "conv_w": nrm((L, CONV_KERNEL, CONV_WIDTH), CONV_KERNEL ** -0.5),
        "conv_b": nrm((L, CONV_WIDTH), 0.01),
        "conv_ln_g": gain((L, CONV_WIDTH)),
        "conv_ln_b": nrm((L, CONV_WIDTH), 0.01),
        "conv_pw_w": nrm((L, CONV_WIDTH, CONV_WIDTH), CONV_WIDTH ** -0.5),
        "conv_pw_b": nrm((L, CONV_WIDTH), 0.01),
        "q_a_norm_g": gain((L, Q_RANK)),
        "w_uq": nrm((L, Q_RANK, MLA_HEADS * MLA_QK), Q_RANK ** -0.5),
        "kv_a_norm_g": gain((L, KV_RANK)),
        "w_ukv": nrm((L, KV_RANK, MLA_HEADS * (MLA_NOPE + MLA_V)), KV_RANK ** -0.5),
        "q_norm_g": gain((L, MLA_QK)),
        "k_norm_g": gain((L, MLA_QK)),
        "branch_norm_g": gain((L, MIX_WIDTH)),
        "w_o": nrm((L, MIX_WIDTH, D_MODEL), MIX_WIDTH ** -0.5),
        "ffn_norm_g": gain((L, D_MODEL)),
        "router_group_w": nrm((L, D_MODEL, N_GROUPS), D_MODEL ** -0.5),
        "router_group_b": nrm((L, N_GROUPS), 0.01),
        "router_expert_w": nrm((L, D_MODEL, N_EXPERTS), D_MODEL ** -0.5),
        "router_expert_b": nrm((L, N_EXPERTS), 0.01),
        "moe_w_gate": nrm((L, N_EXPERTS, D_MODEL, D_EXPERT), D_MODEL ** -0.5),
        "moe_w_up": nrm((L, N_EXPERTS, D_MODEL, D_EXPERT), D_MODEL ** -0.5),
        "moe_w_down": nrm((L, N_EXPERTS, D_EXPERT, D_MODEL), D_EXPERT ** -0.5),
        "ple_norm_g": gain((L, D_MODEL)),
        "ple_gate_w": nrm((L, D_MODEL, D_MODEL), D_MODEL ** -0.5),
        "ple_proj_w": nrm((L, PLE_DIM, D_MODEL), PLE_DIM ** -0.5),
        "ple_post_norm_g": gain((L, D_MODEL)),
    }


def reference(x, p, positions, mix_norm_g, w_in, sgu_ln_g, sgu_ln_b, sgu_w, sgu_b,
              conv_w, conv_b, conv_ln_g, conv_ln_b, conv_pw_w, conv_pw_b,
              q_a_norm_g, w_uq, kv_a_norm_g, w_ukv, q_norm_g, k_norm_g,
              branch_norm_g, w_o, ffn_norm_g, router_group_w, router_group_b,
              router_expert_w, router_expert_b, moe_w_gate, moe_w_up, moe_w_down,
              ple_norm_g, ple_gate_w, ple_proj_w, ple_post_norm_g):
    inv_freq = ROPE_THETA ** (-jnp.arange(0, MLA_ROPE, 2, dtype=jnp.float32) / MLA_ROPE)
    ang = positions.astype(jnp.float32)[..., None] * inv_freq
    cos = jnp.cos(ang)[:, :, None, :]
    sin = jnp.sin(ang)[:, :, None, :]

    h = x
    for i in range(DEPTH):
        a = rmsnorm(h, mix_norm_g[i])
        z = a @ w_in[i]
        z_sgu, z_conv, c_q, c_kv, k_pe = jnp.split(z, IN_SPLITS, axis=-1)
        y_a = sgu_mixer(z_sgu, sgu_ln_g[i], sgu_ln_b[i], sgu_w[i], sgu_b[i])
        y_b = conv_mixer(z_conv, conv_w[i], conv_b[i], conv_ln_g[i], conv_ln_b[i],
                         conv_pw_w[i], conv_pw_b[i])
        y_c = mla_mixer(c_q, c_kv, k_pe, cos, sin, q_a_norm_g[i], w_uq[i],
                        kv_a_norm_g[i], w_ukv[i], q_norm_g[i], k_norm_g[i])
        bg = branch_norm_g[i]
        y = jnp.concatenate([
            rmsnorm(y_a, bg[:SGU_WIDTH]),
            rmsnorm(y_b, bg[SGU_WIDTH:SGU_WIDTH + CONV_WIDTH]),
            rmsnorm(y_c, bg[SGU_WIDTH + CONV_WIDTH:]),
        ], axis=-1)
        h = h + y @ w_o[i]

        m = rmsnorm(h, ffn_norm_g[i])
        h = h + hier_moe(m, router_group_w[i], router_group_b[i], router_expert_w[i],
                         router_expert_b[i], moe_w_gate[i], moe_w_up[i], moe_w_down[i])

        gate = jax.nn.sigmoid(rmsnorm(h, ple_norm_g[i]) @ ple_gate_w[i])
        e = rmsnorm(p[i] @ ple_proj_w[i], ple_post_norm_g[i])
        h = h + gate * e
    return h
```

```cpp
#include <hip/hip_runtime.h>
#include <hip/hip_bf16.h>
#include <stdint.h>
#include <cstdio>
namespace nv {

struct GemmP {
    const float* A; int lda; const float* B; int ldb; float* C; int ldc; int M, N, K;
    const float* bias;
    const int* seg_off; const int* seg_cnt; long strideB;
    const int* arow;
    int mode;
    const int* crow; const float* rw;
};

__global__ void __launch_bounds__(256) k_gemm(GemmP p) {
    __shared__ float As[16][68];
    __shared__ float Bs[16][68];
    int M = p.M; const float* B = p.B; int rowbase = 0;
    if (p.seg_cnt) { M = p.seg_cnt[blockIdx.z]; rowbase = p.seg_off[blockIdx.z]; B += (long)blockIdx.z * p.strideB; }
    const int m0 = blockIdx.y * 64, n0 = blockIdx.x * 64;
    if (m0 >= M) return;
    const int tid = threadIdx.x, ty = tid / 16, tx = tid % 16;
    const int ar = tid / 4, ak = (tid % 4) * 4;
    long arow_abs = -1;
    if (m0 + ar < M) { int r = rowbase + m0 + ar; arow_abs = p.arow ? p.arow[r] : r; }
    const int bk = tid / 16, bn = (tid % 16) * 4;
    float acc[4][4];
#pragma unroll
    for (int i = 0; i < 4; ++i)
#pragma unroll
        for (int j = 0; j < 4; ++j) acc[i][j] = 0.f;
    for (int k0 = 0; k0 < p.K; k0 += 16) {
        float4 av = make_float4(0.f, 0.f, 0.f, 0.f);
        if (arow_abs >= 0) av = *(const float4*)(p.A + arow_abs * p.lda + k0 + ak);
        float4 bv = make_float4(0.f, 0.f, 0.f, 0.f);
        if (n0 + bn < p.N) bv = *(const float4*)(B + (long)(k0 + bk) * p.ldb + n0 + bn);
        __syncthreads();
        As[ak + 0][ar] = av.x; As[ak + 1][ar] = av.y; As[ak + 2][ar] = av.z; As[ak + 3][ar] = av.w;
        *(float4*)&Bs[bk][bn] = bv;
        __syncthreads();
#pragma unroll
        for (int k = 0; k < 16; ++k) {
            float a[4], b[4];
#pragma unroll
            for (int i = 0; i < 4; ++i) a[i] = As[k][ty * 4 + i];
#pragma unroll
            for (int j = 0; j < 4; ++j) b[j] = Bs[k][tx * 4 + j];
#pragma unroll
            for (int i = 0; i < 4; ++i)
#pragma unroll
                for (int j = 0; j < 4; ++j) acc[i][j] = fmaf(a[i], b[j], acc[i][j]);
        }
    }
#pragma unroll
    for (int i = 0; i < 4; ++i) {
        const int m = m0 + ty * 4 + i;
        if (m >= M) continue;
        const int r = rowbase + m;
        long crow_abs = (p.mode == 2) ? p.crow[r] : r;
        float w = (p.mode == 2) ? p.rw[r] : 1.f;
#pragma unroll
        for (int j = 0; j < 4; ++j) {
            const int n = n0 + tx * 4 + j;
            if (n >= p.N) continue;
            float v = acc[i][j];
            if (p.bias) v += p.bias[n];
            float* c = p.C + crow_abs * p.ldc + n;
            if (p.mode == 0) *c = v;
            else if (p.mode == 1) *c += v;
            else atomicAdd(c, w * v);
        }
    }
}

__device__ __forceinline__ float wave_sum(float v) {
#pragma unroll
    for (int o = 32; o > 0; o >>= 1) v += __shfl_xor(v, o);
    return v;
}
__device__ __forceinline__ float wave_max(float v) {
#pragma unroll
    for (int o = 32; o > 0; o >>= 1) v = fmaxf(v, __shfl_xor(v, o));
    return v;
}

__global__ void k_rope_table(const int* pos, float* cs, int ntok) {
    int i = blockIdx.x * blockDim.x + threadIdx.x;
    if (i >= ntok * 16) return;
    int t = i / 16, j = i % 16;
    double inv = pow(10000.0, -(double)(2 * j) / 32.0);
    double ang = (double)pos[t] * inv;
    cs[t * 32 + j] = (float)cos(ang);
    cs[t * 32 + 16 + j] = (float)sin(ang);
}

__global__ void k_rmsnorm(const float* in, int ldin, const float* g, float* out, int ldout, int ncols, int nrows) {
    int row = blockIdx.x * 4 + threadIdx.x / 64, lane = threadIdx.x % 64;
    if (row >= nrows) return;
    const float* x = in + (long)row * ldin;
    float ss = 0.f;
    for (int c = lane; c < ncols; c += 64) { float v = x[c]; ss += v * v; }
    ss = wave_sum(ss);
    float r = rsqrtf(ss / (float)ncols + 1e-6f);
    float* o = out + (long)row * ldout;
    for (int c = lane; c < ncols; c += 64) o[c] = x[c] * r * g[c];
}

__device__ __forceinline__ float gelu_tanh(float x) {
    float u = 0.7978845608028654f * (x + 0.044715f * x * x * x);
    return 0.5f * x * (1.f + tanhf(u));
}
__device__ __forceinline__ float sigmoidf_(float x) { return 1.f / (1.f + expf(-x)); }

__global__ void k_sgu_prep(float* z, int ldz, const float* lng, const float* lnb, int ntok) {
    int w = blockIdx.x * 4 + threadIdx.x / 64, lane = threadIdx.x % 64;
    if (w >= ntok * 4) return;
    int t = w / 4, h = w % 4;
    float* zr = z + (long)t * ldz;
    zr[h * 64 + lane] = gelu_tanh(zr[h * 64 + lane]);
    float v = gelu_tanh(zr[256 + h * 64 + lane]);
    float mu = wave_sum(v) * (1.f / 64.f);
    float d = v - mu;
    float var = wave_sum(d * d) * (1.f / 64.f);
    zr[256 + h * 64 + lane] = d * rsqrtf(var + 1e-6f) * lng[h * 64 + lane] + lnb[h * 64 + lane];
}

__global__ void k_sgu_mix(const float* z, int ldz, const float* Ws, const float* bs, float* y, int ldy, int ntok) {
    int idx = blockIdx.x * blockDim.x + threadIdx.x;
    if (idx >= ntok * 256) return;
    int t = idx / 256, c = idx % 256, h = c / 64, i = t % 128, cb = t - i;
    const float* wr = Ws + ((long)h * 128 + i) * 128;
    float s = 0.f;
    for (int j = 0; j <= i; ++j) s = fmaf(wr[j], z[(long)(cb + j) * ldz + 256 + c], s);
    s += bs[h * 128 + i];
    y[(long)t * ldy + c] = z[(long)t * ldz + c] * s;
}

__global__ void k_glu(float* z, int ldz, int ntok) {
    int idx = blockIdx.x * blockDim.x + threadIdx.x;
    if (idx >= ntok * 256) return;
    int t = idx / 256, c = idx % 256;
    float* zr = z + (long)t * ldz;
    zr[512 + c] = zr[512 + c] * sigmoidf_(zr[768 + c]);
}

__global__ void k_conv(float* z, int ldz, const float* cw, const float* cb, const float* lng, const float* lnb, int ntok, int seq) {
    int w = blockIdx.x * 4 + threadIdx.x / 64, lane = threadIdx.x % 64;
    if (w >= ntok * 4) return;
    int t = w / 4, g = w % 4, c = g * 64 + lane, s = t % seq;
    float acc = cb[c];
    for (int k = 0; k < 31; ++k) {
        int sp = s - 30 + k;
        if (sp >= 0) acc = fmaf(cw[k * 256 + c], z[(long)(t - 30 + k) * ldz + 512 + c], acc);
    }
    float mu = wave_sum(acc) * (1.f / 64.f);
    float d = acc - mu;
    float var = wave_sum(d * d) * (1.f / 64.f);
    float v = d * rsqrtf(var + 1e-6f) * lng[c] + lnb[c];
    z[(long)t * ldz + 768 + c] = v * sigmoidf_(v);
}

__global__ void k_qk_post(float* q, float* kv, float* z, int ldz, const float* cs, const float* qn, const float* kn, int ntok) {
    int w = blockIdx.x * 4 + threadIdx.x / 64, lane = threadIdx.x % 64;
    if (w >= ntok * 8) return;
    int t = w / 8, h = w % 8;
    float* qr = q + (long)t * 768 + h * 96;
    float* kr = kv + (long)t * 1024 + h * 128;
    const float* c = cs + (long)t * 32;
    {
        float v = qr[lane];
        float ss = wave_sum(v * v);
        qr[lane] = v * rsqrtf(ss * (1.f / 64.f) + 1e-6f) * qn[lane];
    }
    {
        float v = kr[lane];
        float ss = wave_sum(v * v);
        kr[lane] = v * rsqrtf(ss * (1.f / 64.f) + 1e-6f) * kn[lane];
    }
    {
        float v = (lane < 32) ? qr[64 + lane] : 0.f;
        float ss = wave_sum(v * v);
        float xn = v * rsqrtf(ss * (1.f / 32.f) + 1e-6f) * ((lane < 32) ? qn[64 + lane] : 0.f);
        float other = __shfl_xor(xn, 16);
        if (lane < 32) {
            int j = lane & 15;
            float o = (lane < 16) ? (xn * c[j] - other * c[16 + j]) : (xn * c[j] + other * c[16 + j]);
            qr[64 + lane] = o;
        }
    }
    if (h == 0) {
        float* kp = z + (long)t * ldz + 1408;
        float v = (lane < 32) ? kp[lane] : 0.f;
        float ss = wave_sum(v * v);
        float xn = v * rsqrtf(ss * (1.f / 32.f) + 1e-6f) * ((lane < 32) ? kn[64 + lane] : 0.f);
        float other = __shfl_xor(xn, 16);
        if (lane < 32) {
            int j = lane & 15;
            float o = (lane < 16) ? (xn * c[j] - other * c[16 + j]) : (xn * c[j] + other * c[16 + j]);
            kp[lane] = o;
        }
    }
}

__global__ void __launch_bounds__(256) k_attn(const float* q, const float* kv, const float* z, int ldz, float* y, int ldy, int seq) {
    __shared__ float Ks[64][97];
    __shared__ float Qs[4][96];
    __shared__ float Ps[4][2048];
    const int tid = threadIdx.x, wv = tid / 64, lane = tid % 64;
    const int qb = blockIdx.x;
    const int h = blockIdx.y, b = blockIdx.z;
    const int q0 = qb * 4, qpos = q0 + wv;
    const long tokbase = (long)b * seq;
    for (int i = tid; i < 4 * 96; i += 256) { int qq = i / 96, d = i % 96; Qs[qq][d] = q[(tokbase + q0 + qq) * 768 + h * 96 + d]; }
    const int nkeys = q0 + 4;
    const float scale = 0.10206207261596575f;
    float mx = -1e30f;
    for (int k0 = 0; k0 < nkeys; k0 += 64) {
        __syncthreads();
        for (int i = tid; i < 64 * 96; i += 256) {
            int kk = i / 96, d = i % 96; long tok = tokbase + k0 + kk;
            float v = 0.f;
            if (k0 + kk < seq) v = (d < 64) ? kv[tok * 1024 + h * 128 + d] : z[tok * ldz + 1408 + (d - 64)];
            Ks[kk][d] = v;
        }
        __syncthreads();
        float s = 0.f;
#pragma unroll 8
        for (int d = 0; d < 96; ++d) s = fmaf(Qs[wv][d], Ks[lane][d], s);
        s *= scale;
        int kpos = k0 + lane;
        if (kpos > qpos) s = -1e30f;
        Ps[wv][kpos] = s;
        mx = fmaxf(mx, s);
    }
    mx = wave_max(mx);
    const int nk = ((qpos / 64) + 1) * 64;
    float sum = 0.f;
    __syncthreads();
    for (int k = lane; k < nk; k += 64) { float e = (k <= qpos) ? expf(Ps[wv][k] - mx) : 0.f; Ps[wv][k] = e; sum += e; }
    sum = wave_sum(sum);
    __syncthreads();
    float o = 0.f;
    for (int k = 0; k <= qpos; ++k) o = fmaf(Ps[wv][k], kv[(tokbase + k) * 1024 + h * 128 + 64 + lane], o);
    y[(tokbase + qpos) * ldy + 512 + h * 64 + lane] = o / sum;
}

__global__ void k_router(const float* m, const float* wg, const float* bg, const float* we, const float* be,
                         int* cnt, int* tok_e, int* tok_pos, float* tok_w, int ntok) {
    int t = blockIdx.x * 4 + threadIdx.x / 64, lane = threadIdx.x % 64;
    if (t >= ntok) return;
    const float* x = m + (long)t * 1024;
    float acc[36];
#pragma unroll
    for (int j = 0; j < 36; ++j) acc[j] = 0.f;
    for (int k = lane; k < 1024; k += 64) {
        float xv = x[k];
#pragma unroll
        for (int j = 0; j < 4; ++j) acc[j] = fmaf(xv, wg[k * 4 + j], acc[j]);
#pragma unroll
        for (int j = 0; j < 32; ++j) acc[4 + j] = fmaf(xv, we[k * 32 + j], acc[4 + j]);
    }
#pragma unroll
    for (int j = 0; j < 36; ++j) acc[j] = wave_sum(acc[j]);
    if (lane == 0) {
        int gi = 0; float gm = acc[0] + bg[0];
#pragma unroll
        for (int j = 1; j < 4; ++j) { float v = acc[j] + bg[j]; if (v > gm) { gm = v; gi = j; } }
        float gs = 0.f;
#pragma unroll
        for (int j = 0; j < 4; ++j) gs += expf(acc[j] + bg[j] - gm);
        float gw = 1.f / gs;
        float el[8];
#pragma unroll
        for (int j = 0; j < 8; ++j) {
            float v = 0.f;
#pragma unroll
            for (int g = 0; g < 4; ++g) if (g == gi) v = acc[4 + g * 8 + j] + be[g * 8 + j];
            el[j] = v;
        }
        int i0 = 0; float v0 = el[0];
#pragma unroll
        for (int j = 1; j < 8; ++j) if (el[j] > v0) { v0 = el[j]; i0 = j; }
        int i1 = -1; float v1 = -3.0e38f;
#pragma unroll
        for (int j = 0; j < 8; ++j) if (j != i0 && el[j] > v1) { v1 = el[j]; i1 = j; }
        float e1 = expf(v1 - v0);
        float w0 = 1.f / (1.f + e1), w1 = e1 / (1.f + e1);
        int ex0 = gi * 8 + i0, ex1 = gi * 8 + i1;
        int p0 = atomicAdd(&cnt[ex0], 1), p1 = atomicAdd(&cnt[ex1], 1);
        tok_e[t * 2] = ex0; tok_e[t * 2 + 1] = ex1;
        tok_pos[t * 2] = p0; tok_pos[t * 2 + 1] = p1;
        tok_w[t * 2] = gw * w0; tok_w[t * 2 + 1] = gw * w1;
    }
}

__global__ void k_moe_offsets(const int* cnt, int* off) {
    if (threadIdx.x == 0 && blockIdx.x == 0) { int s = 0; for (int e = 0; e < 32; ++e) { off[e] = s; s += cnt[e]; } }
}
__global__ void k_moe_fill(const int* off, const int* tok_e, const int* tok_pos, const float* tok_w, int* arow, float* rw, int ntok) {
    int i = blockIdx.x * blockDim.x + threadIdx.x;
    if (i >= ntok * 2) return;
    int r = off[tok_e[i]] + tok_pos[i];
    arow[r] = i / 2; rw[r] = tok_w[i];
}
__global__ void k_silu_mul(float* g, const float* u, long n) {
    long i = (long)blockIdx.x * blockDim.x + threadIdx.x;
    if (i >= n) return;
    float a = g[i];
    g[i] = a * sigmoidf_(a) * u[i];
}
__global__ void k_ple_final(float* h, const float* gate_raw, const float* e_raw, const float* g, int ntok) {
    int t = blockIdx.x * 4 + threadIdx.x / 64, lane = threadIdx.x % 64;
    if (t >= ntok) return;
    const float* er = e_raw + (long)t * 1024; const float* gr = gate_raw + (long)t * 1024; float* hr = h + (long)t * 1024;
    float ss = 0.f;
    for (int c = lane; c < 1024; c += 64) { float v = er[c]; ss += v * v; }
    ss = wave_sum(ss);
    float r = rsqrtf(ss * (1.f / 1024.f) + 1e-6f);
    for (int c = lane; c < 1024; c += 64) hr[c] += sigmoidf_(gr[c]) * (er[c] * r * g[c]);
}

}
namespace nv {

struct Inputs {
    const float *x, *p; const int* positions;
    const float *mix_norm_g, *w_in, *sgu_ln_g, *sgu_ln_b, *sgu_w, *sgu_b, *conv_w, *conv_b, *conv_ln_g, *conv_ln_b, *conv_pw_w, *conv_pw_b,
        *q_a_norm_g, *w_uq, *kv_a_norm_g, *w_ukv, *q_norm_g, *k_norm_g, *branch_norm_g, *w_o, *ffn_norm_g, *router_group_w, *router_group_b,
        *router_expert_w, *router_expert_b, *moe_w_gate, *moe_w_up, *moe_w_down, *ple_norm_g, *ple_gate_w, *ple_proj_w, *ple_post_norm_g;
};

static void gemm(hipStream_t s, const float* A, int lda, const float* B, int ldb, float* C, int ldc, int M, int N, int K,
                 const float* bias, int mode) {
    GemmP p{}; p.A = A; p.lda = lda; p.B = B; p.ldb = ldb; p.C = C; p.ldc = ldc; p.M = M; p.N = N; p.K = K; p.bias = bias; p.mode = mode;
    dim3 g((N + 63) / 64, (M + 63) / 64, 1);
    hipLaunchKernelGGL(k_gemm, g, dim3(256), 0, s, p);
}

static void forward(const Inputs& in, float* h, char* ws, hipStream_t s) {
    const int NT = 16384, SEQ = 2048;
    float* z = (float*)ws;
    float* nb = (float*)(ws + (size_t)NT * 1440 * 4);
    float* y = nb + (size_t)NT * 1024;
    float* q = y + (size_t)NT * 1024;
    float* cs = q + (size_t)NT * 768;
    int* cnt = (int*)(cs + (size_t)NT * 32);
    int* off = cnt + 64;
    int* tok_e = off + 64;
    int* tok_pos = tok_e + 2 * NT;
    float* tok_w = (float*)(tok_pos + 2 * NT);
    int* arow = (int*)(tok_w + 2 * NT);
    float* rw = (float*)(arow + 2 * NT);
    float* kv = nb;
    float* hbg = z; float* hbu = z + (size_t)2 * NT * 256;
    float* gate_raw = z; float* e_raw = y;

    hipMemcpyAsync(h, in.x, (size_t)NT * 1024 * 4, hipMemcpyDeviceToDevice, s);
    hipLaunchKernelGGL(k_rope_table, dim3(NT * 16 / 256), dim3(256), 0, s, in.positions, cs, NT);
    for (int L = 0; L < 2; ++L) {
        hipLaunchKernelGGL(k_rmsnorm, dim3(NT / 4), dim3(256), 0, s, h, 1024, in.mix_norm_g + L * 1024, nb, 1024, 1024, NT);
        gemm(s, nb, 1024, in.w_in + (size_t)L * 1024 * 1440, 1440, z, 1440, NT, 1440, 1024, nullptr, 0);
        hipLaunchKernelGGL(k_sgu_prep, dim3(NT), dim3(256), 0, s, z, 1440, in.sgu_ln_g + L * 256, in.sgu_ln_b + L * 256, NT);
        hipLaunchKernelGGL(k_sgu_mix, dim3(NT), dim3(256), 0, s, z, 1440, in.sgu_w + (size_t)L * 4 * 128 * 128, in.sgu_b + L * 512, y, 1024, NT);
        hipLaunchKernelGGL(k_glu, dim3(NT), dim3(256), 0, s, z, 1440, NT);
        hipLaunchKernelGGL(k_conv, dim3(NT), dim3(256), 0, s, z, 1440, in.conv_w + L * 31 * 256, in.conv_b + L * 256, in.conv_ln_g + L * 256,
                           in.conv_ln_b + L * 256, NT, SEQ);
        gemm(s, z + 768, 1440, in.conv_pw_w + (size_t)L * 256 * 256, 256, y + 256, 1024, NT, 256, 256, in.conv_pw_b + L * 256, 0);
        hipLaunchKernelGGL(k_rmsnorm, dim3(NT / 4), dim3(256), 0, s, z + 1024, 1440, in.q_a_norm_g + L * 256, z + 1024, 1440, 256, NT);
        hipLaunchKernelGGL(k_rmsnorm, dim3(NT / 4), dim3(256), 0, s, z + 1280, 1440, in.kv_a_norm_g + L * 128, z + 1280, 1440, 128, NT);
        gemm(s, z + 1024, 1440, in.w_uq + (size_t)L * 256 * 768, 768, q, 768, NT, 768, 256, nullptr, 0);
        gemm(s, z + 1280, 1440, in.w_ukv + (size_t)L * 128 * 1024, 1024, kv, 1024, NT, 1024, 128, nullptr, 0);
        hipLaunchKernelGGL(k_qk_post, dim3(NT * 8 / 4), dim3(256), 0, s, q, kv, z, 1440, cs, in.q_norm_g + L * 96, in.k_norm_g + L * 96, NT);
        hipLaunchKernelGGL(k_attn, dim3(SEQ / 4, 8, 8), dim3(256), 0, s, q, kv, z, 1440, y, 1024, SEQ);
        hipLaunchKernelGGL(k_rmsnorm, dim3(NT / 4), dim3(256), 0, s, y, 1024, in.branch_norm_g + L * 1024, y, 1024, 256, NT);
        hipLaunchKernelGGL(k_rmsnorm, dim3(NT / 4), dim3(256), 0, s, y + 256, 1024, in.branch_norm_g + L * 1024 + 256, y + 256, 1024, 256, NT);
        hipLaunchKernelGGL(k_rmsnorm, dim3(NT / 4), dim3(256), 0, s, y + 512, 1024, in.branch_norm_g + L * 1024 + 512, y + 512, 1024, 512, NT);
        gemm(s, y, 1024, in.w_o + (size_t)L * 1024 * 1024, 1024, h, 1024, NT, 1024, 1024, nullptr, 1);
        hipLaunchKernelGGL(k_rmsnorm, dim3(NT / 4), dim3(256), 0, s, h, 1024, in.ffn_norm_g + L * 1024, nb, 1024, 1024, NT);
        hipMemsetAsync(cnt, 0, 64 * 4, s);
        hipLaunchKernelGGL(k_router, dim3(NT / 4), dim3(256), 0, s, nb, in.router_group_w + L * 1024 * 4, in.router_group_b + L * 4,
                           in.router_expert_w + L * 1024 * 32, in.router_expert_b + L * 32, cnt, tok_e, tok_pos, tok_w, NT);
        hipLaunchKernelGGL(k_moe_offsets, dim3(1), dim3(64), 0, s, cnt, off);
        hipLaunchKernelGGL(k_moe_fill, dim3(2 * NT / 256), dim3(256), 0, s, off, tok_e, tok_pos, tok_w, arow, rw, NT);
        {
            GemmP p{}; p.A = nb; p.lda = 1024; p.B = in.moe_w_gate + (size_t)L * 32 * 1024 * 256; p.ldb = 256; p.C = hbg; p.ldc = 256;
            p.M = 0; p.N = 256; p.K = 1024; p.seg_off = off; p.seg_cnt = cnt; p.strideB = 1024L * 256; p.arow = arow; p.mode = 0;
            hipLaunchKernelGGL(k_gemm, dim3(4, NT / 64, 32), dim3(256), 0, s, p);
            p.B = in.moe_w_up + (size_t)L * 32 * 1024 * 256; p.C = hbu;
            hipLaunchKernelGGL(k_gemm, dim3(4, NT / 64, 32), dim3(256), 0, s, p);
            hipLaunchKernelGGL(k_silu_mul, dim3(2 * NT * 256 / 256), dim3(256), 0, s, hbg, hbu, (long)2 * NT * 256);
            GemmP d{}; d.A = hbg; d.lda = 256; d.B = in.moe_w_down + (size_t)L * 32 * 256 * 1024; d.ldb = 1024; d.C = h; d.ldc = 1024;
            d.M = 0; d.N = 1024; d.K = 256; d.seg_off = off; d.seg_cnt = cnt; d.strideB = 256L * 1024; d.arow = nullptr; d.mode = 2;
            d.crow = arow; d.rw = rw;
            hipLaunchKernelGGL(k_gemm, dim3(16, NT / 64, 32), dim3(256), 0, s, d);
        }
        hipLaunchKernelGGL(k_rmsnorm, dim3(NT / 4), dim3(256), 0, s, h, 1024, in.ple_norm_g + L * 1024, nb, 1024, 1024, NT);
        gemm(s, nb, 1024, in.ple_gate_w + (size_t)L * 1024 * 1024, 1024, gate_raw, 1024, NT, 1024, 1024, nullptr, 0);
        gemm(s, in.p + (size_t)L * NT * 256, 256, in.ple_proj_w + (size_t)L * 256 * 1024, 1024, e_raw, 1024, NT, 1024, 256, nullptr, 0);
        hipLaunchKernelGGL(k_ple_final, dim3(NT / 4), dim3(256), 0, s, h, gate_raw, e_raw, in.ple_post_norm_g + L * 1024, NT);
    }
}

}
extern "C" void kernel_launch(void* const* d_in, const int* in_sizes, int n_in, void* d_out, int out_size, void* d_ws, size_t ws_size,
                              hipStream_t stream) {
    nv::Inputs in{};
    in.x = (const float*)d_in[0]; in.p = (const float*)d_in[1]; in.positions = (const int*)d_in[2];
    const float** f = &in.mix_norm_g;
    for (int i = 0; i < 32; ++i) f[i] = (const float*)d_in[3 + i];
    nv::forward(in, (float*)d_out, (char*)d_ws, stream);
}
```

```cpp
#define HY2_MOE 1
#define HY2_PLE 1
#include <hip/hip_runtime.h>
#include <hip/hip_bf16.h>
#include <stdint.h>
#include <cstdio>
namespace nv {

struct Inputs {
    const float *x, *p; const int* positions;
    const float *mix_norm_g, *w_in, *sgu_ln_g, *sgu_ln_b, *sgu_w, *sgu_b, *conv_w, *conv_b, *conv_ln_g, *conv_ln_b, *conv_pw_w, *conv_pw_b,
        *q_a_norm_g, *w_uq, *kv_a_norm_g, *w_ukv, *q_norm_g, *k_norm_g, *branch_norm_g, *w_o, *ffn_norm_g, *router_group_w, *router_group_b,
        *router_expert_w, *router_expert_b, *moe_w_gate, *moe_w_up, *moe_w_down, *ple_norm_g, *ple_gate_w, *ple_proj_w, *ple_post_norm_g;
};

struct GemmP {
    const float* A; int lda; const float* B; int ldb; float* C; int ldc; int M, N, K;
    const float* bias;
    const int* seg_off; const int* seg_cnt; long strideB;
    const int* arow;
    int mode;
    const int* crow; const float* rw;
};

__global__ void __launch_bounds__(256) k_gemm(GemmP p) {
    __shared__ float As[16][68];
    __shared__ float Bs[16][68];
    int M = p.M; const float* B = p.B; int rowbase = 0;
    if (p.seg_cnt) { M = p.seg_cnt[blockIdx.z]; rowbase = p.seg_off[blockIdx.z]; B += (long)blockIdx.z * p.strideB; }
    const int m0 = blockIdx.y * 64, n0 = blockIdx.x * 64;
    if (m0 >= M) return;
    const int tid = threadIdx.x, ty = tid / 16, tx = tid % 16;
    const int ar = tid / 4, ak = (tid % 4) * 4;
    long arow_abs = -1;
    if (m0 + ar < M) { int r = rowbase + m0 + ar; arow_abs = p.arow ? p.arow[r] : r; }
    const int bk = tid / 16, bn = (tid % 16) * 4;
    float acc[4][4];
#pragma unroll
    for (int i = 0; i < 4; ++i)
#pragma unroll
        for (int j = 0; j < 4; ++j) acc[i][j] = 0.f;
    for (int k0 = 0; k0 < p.K; k0 += 16) {
        float4 av = make_float4(0.f, 0.f, 0.f, 0.f);
        if (arow_abs >= 0) av = *(const float4*)(p.A + arow_abs * p.lda + k0 + ak);
        float4 bv = make_float4(0.f, 0.f, 0.f, 0.f);
        if (n0 + bn < p.N) bv = *(const float4*)(B + (long)(k0 + bk) * p.ldb + n0 + bn);
        __syncthreads();
        As[ak + 0][ar] = av.x; As[ak + 1][ar] = av.y; As[ak + 2][ar] = av.z; As[ak + 3][ar] = av.w;
        *(float4*)&Bs[bk][bn] = bv;
        __syncthreads();
#pragma unroll
        for (int k = 0; k < 16; ++k) {
            float a[4], b[4];
#pragma unroll
            for (int i = 0; i < 4; ++i) a[i] = As[k][ty * 4 + i];
#pragma unroll
            for (int j = 0; j < 4; ++j) b[j] = Bs[k][tx * 4 + j];
#pragma unroll
            for (int i = 0; i < 4; ++i)
#pragma unroll
                for (int j = 0; j < 4; ++j) acc[i][j] = fmaf(a[i], b[j], acc[i][j]);
        }
    }
#pragma unroll
    for (int i = 0; i < 4; ++i) {
        const int m = m0 + ty * 4 + i;
        if (m >= M) continue;
        const int r = rowbase + m;
        long crow_abs = (p.mode == 2) ? p.crow[r] : r;
        float w = (p.mode == 2) ? p.rw[r] : 1.f;
#pragma unroll
        for (int j = 0; j < 4; ++j) {
            const int n = n0 + tx * 4 + j;
            if (n >= p.N) continue;
            float v = acc[i][j];
            if (p.bias) v += p.bias[n];
            float* c = p.C + crow_abs * p.ldc + n;
            if (p.mode == 0) *c = v;
            else if (p.mode == 1) *c += v;
            else atomicAdd(c, w * v);
        }
    }
}

__device__ __forceinline__ float wave_sum(float v) {
#pragma unroll
    for (int o = 32; o > 0; o >>= 1) v += __shfl_xor(v, o);
    return v;
}
__device__ __forceinline__ float wave_max(float v) {
#pragma unroll
    for (int o = 32; o > 0; o >>= 1) v = fmaxf(v, __shfl_xor(v, o));
    return v;
}

__global__ void k_rope_table(const int* pos, float* cs, int ntok) {
    int i = blockIdx.x * blockDim.x + threadIdx.x;
    if (i >= ntok * 16) return;
    int t = i / 16, j = i % 16;
    double inv = pow(10000.0, -(double)(2 * j) / 32.0);
    double ang = (double)pos[t] * inv;
    cs[t * 32 + j] = (float)cos(ang);
    cs[t * 32 + 16 + j] = (float)sin(ang);
}

__global__ void k_rmsnorm(const float* in, int ldin, const float* g, float* out, int ldout, int ncols, int nrows) {
    int row = blockIdx.x * 4 + threadIdx.x / 64, lane = threadIdx.x % 64;
    if (row >= nrows) return;
    const float* x = in + (long)row * ldin;
    float ss = 0.f;
    for (int c = lane; c < ncols; c += 64) { float v = x[c]; ss += v * v; }
    ss = wave_sum(ss);
    float r = rsqrtf(ss / (float)ncols + 1e-6f);
    float* o = out + (long)row * ldout;
    for (int c = lane; c < ncols; c += 64) o[c] = x[c] * r * g[c];
}

__device__ __forceinline__ float gelu_tanh(float x) {
    float u = 0.7978845608028654f * (x + 0.044715f * x * x * x);
    return 0.5f * x * (1.f + tanhf(u));
}
__device__ __forceinline__ float sigmoidf_(float x) { return 1.f / (1.f + expf(-x)); }

__global__ void k_sgu_prep(float* z, int ldz, const float* lng, const float* lnb, int ntok) {
    int w = blockIdx.x * 4 + threadIdx.x / 64, lane = threadIdx.x % 64;
    if (w >= ntok * 4) return;
    int t = w / 4, h = w % 4;
    float* zr = z + (long)t * ldz;
    zr[h * 64 + lane] = gelu_tanh(zr[h * 64 + lane]);
    float v = gelu_tanh(zr[256 + h * 64 + lane]);
    float mu = wave_sum(v) * (1.f / 64.f);
    float d = v - mu;
    float var = wave_sum(d * d) * (1.f / 64.f);
    zr[256 + h * 64 + lane] = d * rsqrtf(var + 1e-6f) * lng[h * 64 + lane] + lnb[h * 64 + lane];
}

__global__ void k_sgu_mix(const float* z, int ldz, const float* Ws, const float* bs, float* y, int ldy, int ntok) {
    int idx = blockIdx.x * blockDim.x + threadIdx.x;
    if (idx >= ntok * 256) return;
    int t = idx / 256, c = idx % 256, h = c / 64, i = t % 128, cb = t - i;
    const float* wr = Ws + ((long)h * 128 + i) * 128;
    float s = 0.f;
    for (int j = 0; j <= i; ++j) s = fmaf(wr[j], z[(long)(cb + j) * ldz + 256 + c], s);
    s += bs[h * 128 + i];
    y[(long)t * ldy + c] = z[(long)t * ldz + c] * s;
}

__global__ void k_glu(float* z, int ldz, int ntok) {
    int idx = blockIdx.x * blockDim.x + threadIdx.x;
    if (idx >= ntok * 256) return;
    int t = idx / 256, c = idx % 256;
    float* zr = z + (long)t * ldz;
    zr[512 + c] = zr[512 + c] * sigmoidf_(zr[768 + c]);
}

__global__ void k_conv(float* z, int ldz, const float* cw, const float* cb, const float* lng, const float* lnb, int ntok, int seq) {
    int w = blockIdx.x * 4 + threadIdx.x / 64, lane = threadIdx.x % 64;
    if (w >= ntok * 4) return;
    int t = w / 4, g = w % 4, c = g * 64 + lane, s = t % seq;
    float acc = cb[c];
    for (int k = 0; k < 31; ++k) {
        int sp = s - 30 + k;
        if (sp >= 0) acc = fmaf(cw[k * 256 + c], z[(long)(t - 30 + k) * ldz + 512 + c], acc);
    }
    float mu = wave_sum(acc) * (1.f / 64.f);
    float d = acc - mu;
    float var = wave_sum(d * d) * (1.f / 64.f);
    float v = d * rsqrtf(var + 1e-6f) * lng[c] + lnb[c];
    z[(long)t * ldz + 768 + c] = v * sigmoidf_(v);
}

__global__ void k_qk_post(float* q, float* kv, float* z, int ldz, const float* cs, const float* qn, const float* kn, int ntok, int do_kpe) {
    int w = blockIdx.x * 4 + threadIdx.x / 64, lane = threadIdx.x % 64;
    if (w >= ntok * 8) return;
    int t = w / 8, h = w % 8;
    float* qr = q + (long)t * 768 + h * 96;
    float* kr = kv + (long)t * 1024 + h * 128;
    const float* c = cs + (long)t * 32;
    {
        float v = qr[lane];
        float ss = wave_sum(v * v);
        qr[lane] = v * rsqrtf(ss * (1.f / 64.f) + 1e-6f) * qn[lane];
    }
    {
        float v = kr[lane];
        float ss = wave_sum(v * v);
        kr[lane] = v * rsqrtf(ss * (1.f / 64.f) + 1e-6f) * kn[lane];
    }
    {
        float v = (lane < 32) ? qr[64 + lane] : 0.f;
        float ss = wave_sum(v * v);
        float xn = v * rsqrtf(ss * (1.f / 32.f) + 1e-6f) * ((lane < 32) ? qn[64 + lane] : 0.f);
        float other = __shfl_xor(xn, 16);
        if (lane < 32) {
            int j = lane & 15;
            float o = (lane < 16) ? (xn * c[j] - other * c[16 + j]) : (xn * c[j] + other * c[16 + j]);
            qr[64 + lane] = o;
        }
    }
    if (h == 0 && do_kpe) {
        float* kp = z + (long)t * ldz + 1408;
        float v = (lane < 32) ? kp[lane] : 0.f;
        float ss = wave_sum(v * v);
        float xn = v * rsqrtf(ss * (1.f / 32.f) + 1e-6f) * ((lane < 32) ? kn[64 + lane] : 0.f);
        float other = __shfl_xor(xn, 16);
        if (lane < 32) {
            int j = lane & 15;
            float o = (lane < 16) ? (xn * c[j] - other * c[16 + j]) : (xn * c[j] + other * c[16 + j]);
            kp[lane] = o;
        }
    }
}

__global__ void __launch_bounds__(256) k_attn(const float* q, const float* kv, const float* z, int ldz, float* y, int ldy, int seq) {
    __shared__ float Ks[64][97];
    __shared__ float Qs[4][96];
    __shared__ float Ps[4][2048];
    const int tid = threadIdx.x, wv = tid / 64, lane = tid % 64;
    const int qb = blockIdx.x;
    const int h = blockIdx.y, b = blockIdx.z;
    const int q0 = qb * 4, qpos = q0 + wv;
    const long tokbase = (long)b * seq;
    for (int i = tid; i < 4 * 96; i += 256) { int qq = i / 96, d = i % 96; Qs[qq][d] = q[(tokbase + q0 + qq) * 768 + h * 96 + d]; }
    const int nkeys = q0 + 4;
    const float scale = 0.10206207261596575f;
    float mx = -1e30f;
    for (int k0 = 0; k0 < nkeys; k0 += 64) {
        __syncthreads();
        for (int i = tid; i < 64 * 96; i += 256) {
            int kk = i / 96, d = i % 96; long tok = tokbase + k0 + kk;
            float v = 0.f;
            if (k0 + kk < seq) v = (d < 64) ? kv[tok * 1024 + h * 128 + d] : z[tok * ldz + 1408 + (d - 64)];
            Ks[kk][d] = v;
        }
        __syncthreads();
        float s = 0.f;
#pragma unroll 8
        for (int d = 0; d < 96; ++d) s = fmaf(Qs[wv][d], Ks[lane][d], s);
        s *= scale;
        int kpos = k0 + lane;
        if (kpos > qpos) s = -1e30f;
        Ps[wv][kpos] = s;
        mx = fmaxf(mx, s);
    }
    mx = wave_max(mx);
    const int nk = ((qpos / 64) + 1) * 64;
    float sum = 0.f;
    __syncthreads();
    for (int k = lane; k < nk; k += 64) { float e = (k <= qpos) ? expf(Ps[wv][k] - mx) : 0.f; Ps[wv][k] = e; sum += e; }
    sum = wave_sum(sum);
    __syncthreads();
    float o = 0.f;
    for (int k = 0; k <= qpos; ++k) o = fmaf(Ps[wv][k], kv[(tokbase + k) * 1024 + h * 128 + 64 + lane], o);
    y[(tokbase + qpos) * ldy + 512 + h * 64 + lane] = o / sum;
}

__global__ void k_router(const float* m, const float* wg, const float* bg, const float* we, const float* be,
                         int* cnt, int* tok_e, int* tok_pos, float* tok_w, int ntok) {
    int t = blockIdx.x * 4 + threadIdx.x / 64, lane = threadIdx.x % 64;
    if (t >= ntok) return;
    const float* x = m + (long)t * 1024;
    float acc[36];
#pragma unroll
    for (int j = 0; j < 36; ++j) acc[j] = 0.f;
    for (int k = lane; k < 1024; k += 64) {
        float xv = x[k];
#pragma unroll
        for (int j = 0; j < 4; ++j) acc[j] = fmaf(xv, wg[k * 4 + j], acc[j]);
#pragma unroll
        for (int j = 0; j < 32; ++j) acc[4 + j] = fmaf(xv, we[k * 32 + j], acc[4 + j]);
    }
#pragma unroll
    for (int j = 0; j < 36; ++j) acc[j] = wave_sum(acc[j]);
    if (lane == 0) {
        int gi = 0; float gm = acc[0] + bg[0];
#pragma unroll
        for (int j = 1; j < 4; ++j) { float v = acc[j] + bg[j]; if (v > gm) { gm = v; gi = j; } }
        float gs = 0.f;
#pragma unroll
        for (int j = 0; j < 4; ++j) gs += expf(acc[j] + bg[j] - gm);
        float gw = 1.f / gs;
        float el[8];
#pragma unroll
        for (int j = 0; j < 8; ++j) {
            float v = 0.f;
#pragma unroll
            for (int g = 0; g < 4; ++g) if (g == gi) v = acc[4 + g * 8 + j] + be[g * 8 + j];
            el[j] = v;
        }
        int i0 = 0; float v0 = el[0];
#pragma unroll
        for (int j = 1; j < 8; ++j) if (el[j] > v0) { v0 = el[j]; i0 = j; }
        int i1 = -1; float v1 = -3.0e38f;
#pragma unroll
        for (int j = 0; j < 8; ++j) if (j != i0 && el[j] > v1) { v1 = el[j]; i1 = j; }
        float e1 = expf(v1 - v0);
        float w0 = 1.f / (1.f + e1), w1 = e1 / (1.f + e1);
        int ex0 = gi * 8 + i0, ex1 = gi * 8 + i1;
        int p0 = atomicAdd(&cnt[ex0], 1), p1 = atomicAdd(&cnt[ex1], 1);
        tok_e[t * 2] = ex0; tok_e[t * 2 + 1] = ex1;
        tok_pos[t * 2] = p0; tok_pos[t * 2 + 1] = p1;
        tok_w[t * 2] = gw * w0; tok_w[t * 2 + 1] = gw * w1;
    }
}

__global__ void k_moe_offsets(const int* cnt, int* off) {
    if (threadIdx.x == 0 && blockIdx.x == 0) { int s = 0; for (int e = 0; e < 32; ++e) { off[e] = s; s += cnt[e]; } }
}
__global__ void k_moe_fill(const int* off, const int* tok_e, const int* tok_pos, const float* tok_w, int* arow, float* rw, int ntok) {
    int i = blockIdx.x * blockDim.x + threadIdx.x;
    if (i >= ntok * 2) return;
    int r = off[tok_e[i]] + tok_pos[i];
    arow[r] = i / 2; rw[r] = tok_w[i];
}
__global__ void k_silu_mul(float* g, const float* u, long n) {
    long i = (long)blockIdx.x * blockDim.x + threadIdx.x;
    if (i >= n) return;
    float a = g[i];
    g[i] = a * sigmoidf_(a) * u[i];
}
__global__ void k_ple_final(float* h, const float* gate_raw, const float* e_raw, const float* g, int ntok) {
    int t = blockIdx.x * 4 + threadIdx.x / 64, lane = threadIdx.x % 64;
    if (t >= ntok) return;
    const float* er = e_raw + (long)t * 1024; const float* gr = gate_raw + (long)t * 1024; float* hr = h + (long)t * 1024;
    float ss = 0.f;
    for (int c = lane; c < 1024; c += 64) { float v = er[c]; ss += v * v; }
    ss = wave_sum(ss);
    float r = rsqrtf(ss * (1.f / 1024.f) + 1e-6f);
    for (int c = lane; c < 1024; c += 64) hr[c] += sigmoidf_(gr[c]) * (er[c] * r * g[c]);
}

}
namespace nv {

static void gemm(hipStream_t s, const float* A, int lda, const float* B, int ldb, float* C, int ldc, int M, int N, int K,
                 const float* bias, int mode) {
    GemmP p{}; p.A = A; p.lda = lda; p.B = B; p.ldb = ldb; p.C = C; p.ldc = ldc; p.M = M; p.N = N; p.K = K; p.bias = bias; p.mode = mode;
    dim3 g((N + 63) / 64, (M + 63) / 64, 1);
    hipLaunchKernelGGL(k_gemm, g, dim3(256), 0, s, p);
}

constexpr int NS = 2048;
struct Bufs {
    float *z, *nb, *y, *q, *cs; int *cnt, *off, *tok_e, *tok_pos; float* tok_w; int* arow; float* rw;
    float *kv, *hbg, *hbu, *gate_raw, *e_raw;
};
static size_t bufs_bytes() { return (size_t)NS * (1440 + 1024 + 1024 + 768 + 32) * 4 + 4096 + (size_t)NS * 2 * 4 * 5; }
static Bufs make_bufs(char* ws) {
    Bufs b{};
    b.z = (float*)ws; b.nb = b.z + (size_t)NS * 1440; b.y = b.nb + (size_t)NS * 1024; b.q = b.y + (size_t)NS * 1024; b.cs = b.q + (size_t)NS * 768;
    b.cnt = (int*)(b.cs + (size_t)NS * 32); b.off = b.cnt + 64; b.tok_e = b.off + 64; b.tok_pos = b.tok_e + 2 * NS; b.tok_w = (float*)(b.tok_pos + 2 * NS);
    b.arow = (int*)(b.tok_w + 2 * NS); b.rw = (float*)(b.arow + 2 * NS);
    b.kv = b.nb; b.hbg = b.z; b.hbu = b.z + (size_t)2 * NS * 256; b.gate_raw = b.z; b.e_raw = b.y;
    return b;
}

enum { F_Z = 1, F_SGU = 2, F_CONV = 4, F_ATTN = 8, F_QKV = 16 };

static void mixer_z(const Inputs& in, int L, float* h, int t0, const Bufs& b, hipStream_t s) {
    hipLaunchKernelGGL(k_rope_table, dim3(NS * 16 / 256), dim3(256), 0, s, in.positions + t0, b.cs, NS);
    hipLaunchKernelGGL(k_rmsnorm, dim3(NS / 4), dim3(256), 0, s, h + (size_t)t0 * 1024, 1024, in.mix_norm_g + L * 1024, b.nb, 1024, 1024, NS);
    gemm(s, b.nb, 1024, in.w_in + (size_t)L * 1024 * 1440, 1440, b.z, 1440, NS, 1440, 1024, nullptr, 0);
    hipLaunchKernelGGL(k_sgu_prep, dim3(NS), dim3(256), 0, s, b.z, 1440, in.sgu_ln_g + L * 256, in.sgu_ln_b + L * 256, NS);
    hipLaunchKernelGGL(k_glu, dim3(NS), dim3(256), 0, s, b.z, 1440, NS);
}
static void mixer_branches(const Inputs& in, int L, const Bufs& b, hipStream_t s, int flags) {
    if (!(flags & F_SGU))
        hipLaunchKernelGGL(k_sgu_mix, dim3(NS), dim3(256), 0, s, b.z, 1440, in.sgu_w + (size_t)L * 4 * 128 * 128, in.sgu_b + L * 512, b.y, 1024, NS);
    if (!(flags & F_CONV)) {
        hipLaunchKernelGGL(k_conv, dim3(NS), dim3(256), 0, s, b.z, 1440, in.conv_w + L * 31 * 256, in.conv_b + L * 256, in.conv_ln_g + L * 256,
                           in.conv_ln_b + L * 256, NS, 2048);
        gemm(s, b.z + 768, 1440, in.conv_pw_w + (size_t)L * 256 * 256, 256, b.y + 256, 1024, NS, 256, 256, in.conv_pw_b + L * 256, 0);
    }
    if (!(flags & F_ATTN) && (flags & F_QKV))
        hipLaunchKernelGGL(k_attn, dim3(2048 / 4, 8, NS / 2048), dim3(256), 0, s, b.q, b.kv, b.z, 1440, b.y, 1024, 2048);
    if (!(flags & F_ATTN) && !(flags & F_QKV)) {
        hipLaunchKernelGGL(k_rmsnorm, dim3(NS / 4), dim3(256), 0, s, b.z + 1024, 1440, in.q_a_norm_g + L * 256, b.z + 1024, 1440, 256, NS);
        hipLaunchKernelGGL(k_rmsnorm, dim3(NS / 4), dim3(256), 0, s, b.z + 1280, 1440, in.kv_a_norm_g + L * 128, b.z + 1280, 1440, 128, NS);
        gemm(s, b.z + 1024, 1440, in.w_uq + (size_t)L * 256 * 768, 768, b.q, 768, NS, 768, 256, nullptr, 0);
        gemm(s, b.z + 1280, 1440, in.w_ukv + (size_t)L * 128 * 1024, 1024, b.kv, 1024, NS, 1024, 128, nullptr, 0);
        hipLaunchKernelGGL(k_qk_post, dim3(NS * 8 / 4), dim3(256), 0, s, b.q, b.kv, b.z, 1440, b.cs, in.q_norm_g + L * 96, in.k_norm_g + L * 96, NS,
                           (flags & F_Z) ? 0 : 1);
        hipLaunchKernelGGL(k_attn, dim3(2048 / 4, 8, NS / 2048), dim3(256), 0, s, b.q, b.kv, b.z, 1440, b.y, 1024, 2048);
    }
}
static void mixer_out(const Inputs& in, int L, float* h, int t0, const Bufs& b, hipStream_t s) {
    hipLaunchKernelGGL(k_rmsnorm, dim3(NS / 4), dim3(256), 0, s, b.y, 1024, in.branch_norm_g + L * 1024, b.y, 1024, 256, NS);
    hipLaunchKernelGGL(k_rmsnorm, dim3(NS / 4), dim3(256), 0, s, b.y + 256, 1024, in.branch_norm_g + L * 1024 + 256, b.y + 256, 1024, 256, NS);
    hipLaunchKernelGGL(k_rmsnorm, dim3(NS / 4), dim3(256), 0, s, b.y + 512, 1024, in.branch_norm_g + L * 1024 + 512, b.y + 512, 1024, 512, NS);
    gemm(s, b.y, 1024, in.w_o + (size_t)L * 1024 * 1024, 1024, h + (size_t)t0 * 1024, 1024, NS, 1024, 1024, nullptr, 1);
}
static void moe(const Inputs& in, int L, float* h, int t0, const Bufs& b, hipStream_t s) {
    float* hh = h + (size_t)t0 * 1024;
    hipLaunchKernelGGL(k_rmsnorm, dim3(NS / 4), dim3(256), 0, s, hh, 1024, in.ffn_norm_g + L * 1024, b.nb, 1024, 1024, NS);
    hipMemsetAsync(b.cnt, 0, 64 * 4, s);
    hipLaunchKernelGGL(k_router, dim3(NS / 4), dim3(256), 0, s, b.nb, in.router_group_w + L * 1024 * 4, in.router_group_b + L * 4,
                       in.router_expert_w + L * 1024 * 32, in.router_expert_b + L * 32, b.cnt, b.tok_e, b.tok_pos, b.tok_w, NS);
    hipLaunchKernelGGL(k_moe_offsets, dim3(1), dim3(64), 0, s, b.cnt, b.off);
    hipLaunchKernelGGL(k_moe_fill, dim3(2 * NS / 256), dim3(256), 0, s, b.off, b.tok_e, b.tok_pos, b.tok_w, b.arow, b.rw, NS);
    GemmP p{}; p.A = b.nb; p.lda = 1024; p.B = in.moe_w_gate + (size_t)L * 32 * 1024 * 256; p.ldb = 256; p.C = b.hbg; p.ldc = 256;
    p.M = 0; p.N = 256; p.K = 1024; p.seg_off = b.off; p.seg_cnt = b.cnt; p.strideB = 1024L * 256; p.arow = b.arow; p.mode = 0;
    hipLaunchKernelGGL(k_gemm, dim3(4, NS / 64, 32), dim3(256), 0, s, p);
    p.B = in.moe_w_up + (size_t)L * 32 * 1024 * 256; p.C = b.hbu;
    hipLaunchKernelGGL(k_gemm, dim3(4, NS / 64, 32), dim3(256), 0, s, p);
    hipLaunchKernelGGL(k_silu_mul, dim3(2 * NS * 256 / 256), dim3(256), 0, s, b.hbg, b.hbu, (long)2 * NS * 256);
    GemmP d{}; d.A = b.hbg; d.lda = 256; d.B = in.moe_w_down + (size_t)L * 32 * 256 * 1024; d.ldb = 1024; d.C = hh; d.ldc = 1024;
    d.M = 0; d.N = 1024; d.K = 256; d.seg_off = b.off; d.seg_cnt = b.cnt; d.strideB = 256L * 1024; d.arow = nullptr; d.mode = 2;
    d.crow = b.arow; d.rw = b.rw;
    hipLaunchKernelGGL(k_gemm, dim3(16, NS / 64, 32), dim3(256), 0, s, d);
}
static void ple(const Inputs& in, int L, float* h, int t0, const Bufs& b, hipStream_t s) {
    float* hh = h + (size_t)t0 * 1024;
    hipLaunchKernelGGL(k_rmsnorm, dim3(NS / 4), dim3(256), 0, s, hh, 1024, in.ple_norm_g + L * 1024, b.nb, 1024, 1024, NS);
    gemm(s, b.nb, 1024, in.ple_gate_w + (size_t)L * 1024 * 1024, 1024, b.gate_raw, 1024, NS, 1024, 1024, nullptr, 0);
    gemm(s, in.p + ((size_t)L * 16384 + t0) * 256, 256, in.ple_proj_w + (size_t)L * 256 * 1024, 1024, b.e_raw, 1024, NS, 1024, 256, nullptr, 0);
    hipLaunchKernelGGL(k_ple_final, dim3(NS / 4), dim3(256), 0, s, hh, b.gate_raw, b.e_raw, in.ple_post_norm_g + L * 1024, NS);
}

}
namespace fx {

typedef unsigned short bf16_t;
typedef short bf16x8 __attribute__((ext_vector_type(8)));
typedef float f32x16 __attribute__((ext_vector_type(16)));
typedef float f32x4 __attribute__((ext_vector_type(4)));

constexpr int NT = 16384, SEQ = 2048, DM = 1024, NB = 8;
constexpr int ZN = 1536;
constexpr float EPS = 1e-6f;

typedef __bf16 bf16v2_t __attribute__((ext_vector_type(2)));
typedef float f32v2_t __attribute__((ext_vector_type(2)));
__device__ __forceinline__ unsigned pack2(float lo, float hi) {
    f32v2_t v; v.x = lo; v.y = hi;
    bf16v2_t b = __builtin_convertvector(v, bf16v2_t);
    return __builtin_bit_cast(unsigned, b);
}
__device__ __forceinline__ unsigned f2bf(float f) { return pack2(f, 0.f) & 0xffffu; }
__device__ __forceinline__ float bf2f(unsigned short b) { return __uint_as_float(((unsigned)b) << 16); }
__device__ __forceinline__ float bflo(unsigned u) { return __uint_as_float(u << 16); }
__device__ __forceinline__ float bfhi(unsigned u) { return __uint_as_float(u & 0xffff0000u); }
__device__ __forceinline__ float sigmoid_(float x) { return 1.f / (1.f + __expf(-x)); }
__device__ __forceinline__ float gelu_tanh_(float x) {
    float u = 0.7978845608028654f * (x + 0.044715f * x * x * x);
    return x * sigmoid_(2.f * u);
}
__device__ __forceinline__ int opaque_tid() { int t = threadIdx.x; asm volatile("" : "+v"(t)); return t; }
__device__ __forceinline__ float xor32(float v) { return v + __shfl_xor(v, 32); }

struct WS {
    bf16_t *W1t, *Wuqt, *Wukvt, *Wpwt, *Wot, *Wrt, *Wgut, *Wdt, *Wgt, *Wpt, *Wsm;
    bf16_t *hb;
    bf16_t *hb1;
    bf16_t *ub;
    bf16_t *vT;
    bf16_t *ygb;
    bf16_t *cqb;
    bf16_t *ckvb;
    bf16_t *kpeb;
    bf16_t *Qb;
    bf16_t *Knb;
    bf16_t *VTb;
    bf16_t *yb;
    float  *ssq;
    float  *cs;
    bf16_t *erb;
    float  *essq;
    bf16_t *hbuf;
    bf16_t *contrib;
    int    *cnt;
    int    *elist;
    float  *ewt;
    unsigned *bar;
};
constexpr size_t W1_SZ = (size_t)ZN * 1024, WUQ_SZ = 768 * 256, WUKV_SZ = 1024 * 128, WPW_SZ = 256 * 256, WO_SZ = 1024 * 1024, WR_SZ = 128 * 1024,
                 WGU_SZ = (size_t)32 * 512 * 1024, WD_SZ = (size_t)32 * 1024 * 256, WG_SZ = 1024 * 1024, WP_SZ = 1024 * 256, WSM_SZ = 4 * 128 * 128;

struct Params {
    nv::Inputs in;
    float* h;
    WS w;
    float* zf;
    float* yf;
};

static WS make_ws(char* base, size_t& used) {
    WS w{}; size_t o = 0;
    auto take = [&](size_t bytes) { char* p = base + o; o += (bytes + 255) & ~(size_t)255; return p; };
    w.W1t = (bf16_t*)take(2 * W1_SZ * 2);   w.Wuqt = (bf16_t*)take(2 * WUQ_SZ * 2); w.Wukvt = (bf16_t*)take(2 * WUKV_SZ * 2);
    w.Wpwt = (bf16_t*)take(2 * WPW_SZ * 2); w.Wot = (bf16_t*)take(2 * WO_SZ * 2);   w.Wrt = (bf16_t*)take(2 * WR_SZ * 2);
    w.Wgut = (bf16_t*)take(2 * WGU_SZ * 2); w.Wdt = (bf16_t*)take(2 * WD_SZ * 2);   w.Wgt = (bf16_t*)take(2 * WG_SZ * 2);
    w.Wpt = (bf16_t*)take(2 * WP_SZ * 2);   w.Wsm = (bf16_t*)take(2 * WSM_SZ * 2);
    w.hb = (bf16_t*)take((size_t)NT * 1024 * 2); w.hb1 = (bf16_t*)take((size_t)NT * 1024 * 2);
    w.ssq = (float*)take((size_t)NT * 16 * 4); w.cs = (float*)take((size_t)NT * 32 * 4);
    w.essq = (float*)take((size_t)NT * 8 * 4);
    w.cnt = (int*)take(2 * 64 * 4);
    w.elist = (int*)take((size_t)32 * NT * 4); w.ewt = (float*)take((size_t)32 * NT * 4);
    w.bar = (unsigned*)take(4096 * 4);
    const size_t region = o;
    w.ub = (bf16_t*)take((size_t)NT * 256 * 2); w.vT = (bf16_t*)take((size_t)NT * 256 * 2); w.ygb = (bf16_t*)take((size_t)NT * 256 * 2);
    w.cqb = (bf16_t*)take((size_t)NT * 256 * 2); w.ckvb = (bf16_t*)take((size_t)NT * 128 * 2); w.kpeb = (bf16_t*)take((size_t)NT * 32 * 2);
    w.Qb = (bf16_t*)take((size_t)NT * 768 * 2); w.Knb = (bf16_t*)take((size_t)NT * 512 * 2); w.VTb = (bf16_t*)take((size_t)NT * 512 * 2);
    w.yb = (bf16_t*)take((size_t)NT * 1024 * 2);
    const size_t region_end = o;
    o = region;
    w.contrib = (bf16_t*)take((size_t)NT * 2 * 1024 * 2);
    w.hbuf = (bf16_t*)take((size_t)(2 * NT + 128) * 256 * 2);
    w.erb = (bf16_t*)take((size_t)NT * 1024 * 2);
    if (o > region_end) { fprintf(stderr, "make_ws: overlay exceeds mixer region\n"); }
    o = region_end;
    used = o;
    return w;
}

__device__ const double ROPE_INV[16] = {1.0, 0.5623413251903491, 0.31622776601683794, 0.1778279410038923, 0.1, 0.05623413251903491, 0.03162277660168379, 0.01778279410038923, 0.01, 0.005623413251903491, 0.0031622776601683794, 0.0017782794100389228, 0.001, 0.0005623413251903491, 0.00031622776601683794, 0.00017782794100389227};
__device__ __forceinline__ void rope_cs(int pos, int j, float& c, float& s) {
    const double ang = (double)pos * ROPE_INV[j];
    const double n = rint(ang * 0.15915494309189535);
    double r = fma(-n, 6.283185307179586, ang); r = fma(-n, 2.4492935982947064e-16, r);
    const double r2 = r * r;
    double sc = 1.0, ss = 1.0;
    double tc = 1.0, ts = 1.0;
#pragma unroll
    for (int k = 1; k <= 14; ++k) {
        tc *= -r2 / (double)((2 * k - 1) * (2 * k)); sc += tc;
        ts *= -r2 / (double)((2 * k) * (2 * k + 1)); ss += ts;
    }
    c = (float)sc; s = (float)(ss * r);
}

enum { MAP_ID = 0, MAP_W1 = 1, MAP_UQ = 2, MAP_UKV = 3, MAP_GU = 4, MAP_ROUTER = 5 };
template <int MAP> __device__ __forceinline__ int srccol(int n) {
    if (MAP == MAP_W1) {
        if (n < 512) return n;
        if (n < 1024) { int m = n - 512; return (m & 1) ? (768 + (m >> 1)) : (512 + (m >> 1)); }
        if (n < 1440) return n;
        return -1;
    } else if (MAP == MAP_UQ) {
        if (n < 512) return (n >> 6) * 96 + (n & 63);
        int m = n - 512; return (m >> 5) * 96 + 64 + (m & 31);
    } else if (MAP == MAP_UKV) {
        if (n < 512) return (n >> 6) * 128 + (n & 63);
        int m = n - 512; return (m >> 6) * 128 + 64 + (m & 63);
    } else if (MAP == MAP_GU) {
        return (n & 1) ? (256 + (n >> 1)) : (n >> 1);
    }
    return n;
}
template <int MAP>
__device__ void prep_tile(const float* src, int ld, const float* src2, int split, const float* scale, bf16_t* dst, int K, int n0, int k0, int N, float* tile  , const int tid) {
    __syncthreads();
    for (int i = tid; i < 64 * 64; i += 256) {
        int kk = i >> 6, nn = i & 63;
        int n = n0 + nn; float v = 0.f;
        if (n < N) {
            int c = srccol<MAP>(n);
            if (c >= 0) {
                const float* s = src; int cc = c;
                if (src2 && c >= split) { s = src2; cc = c - split; }
                v = s[(size_t)(k0 + kk) * ld + cc];
                if (scale) v *= scale[k0 + kk];
            }
        }
        tile[kk * 65 + nn] = v;
    }
    __syncthreads();
    for (int i = tid; i < 64 * 32; i += 256) {
        int nn = i >> 5, k2 = (i & 31) * 2;
        if (n0 + nn < N) {
            unsigned pk = pack2(tile[k2 * 65 + nn], tile[(k2 + 1) * 65 + nn]);
            *(unsigned*)(dst + (size_t)(n0 + nn) * K + k0 + k2) = pk;
        }
    }
}

template <int MAP>
__device__ void prep_job(const float* src, int ld, size_t src_stride, const float* src2, int split, const float* scale, bf16_t* dst, size_t dst_stride,
                         int K, int N, int nbatch, float* tile, int& rot, const int tid) {
    const int tn = (N + 63) / 64, tk = K / 64, per = tn * tk, total = per * nbatch, G = gridDim.x;
    for (int t = ((int)blockIdx.x - rot + G) % G; t < total; t += G) {
        const int e = t / per, tt = t % per;
        prep_tile<MAP>(src + (size_t)e * src_stride, ld, src2 ? src2 + (size_t)e * src_stride : nullptr, split, scale, dst + (size_t)e * dst_stride, K,
                       (tt % tn) * 64, (tt / tn) * 64, N, tile, tid);
    }
    rot = (rot + total) % G;
}

__device__ void phase_prep(const Params& P, char* lds) {
    float* tile = (float*)lds;
    const nv::Inputs& in = P.in; const WS& w = P.w;
    const int G = gridDim.x, bid = blockIdx.x, tid = opaque_tid();
    int rot = 0;
    for (int L = 0; L < 2; ++L) {
        prep_job<MAP_W1>(in.w_in + (size_t)L * 1024 * 1440, 1440, 0, nullptr, 0, in.mix_norm_g + L * 1024, w.W1t + L * W1_SZ, 0, 1024, ZN, 1, tile, rot, tid);
        prep_job<MAP_UQ>(in.w_uq + (size_t)L * 256 * 768, 768, 0, nullptr, 0, in.q_a_norm_g + L * 256, w.Wuqt + L * WUQ_SZ, 0, 256, 768, 1, tile, rot, tid);
        prep_job<MAP_UKV>(in.w_ukv + (size_t)L * 128 * 1024, 1024, 0, nullptr, 0, in.kv_a_norm_g + L * 128, w.Wukvt + L * WUKV_SZ, 0, 128, 1024, 1, tile, rot, tid);
        prep_job<MAP_ID>(in.conv_pw_w + (size_t)L * 256 * 256, 256, 0, nullptr, 0, nullptr, w.Wpwt + L * WPW_SZ, 0, 256, 256, 1, tile, rot, tid);
        prep_job<MAP_ID>(in.w_o + (size_t)L * 1024 * 1024, 1024, 0, nullptr, 0, in.branch_norm_g + L * 1024, w.Wot + L * WO_SZ, 0, 1024, 1024, 1, tile, rot, tid);
        prep_job<MAP_ID>(in.ple_gate_w + (size_t)L * 1024 * 1024, 1024, 0, nullptr, 0, in.ple_norm_g + L * 1024, w.Wgt + L * WG_SZ, 0, 1024, 1024, 1, tile, rot, tid);
        prep_job<MAP_ID>(in.ple_proj_w + (size_t)L * 256 * 1024, 1024, 0, nullptr, 0, nullptr, w.Wpt + L * WP_SZ, 0, 256, 1024, 1, tile, rot, tid);
        prep_job<MAP_GU>(in.moe_w_gate + (size_t)L * 32 * 1024 * 256, 256, (size_t)1024 * 256, in.moe_w_up + (size_t)L * 32 * 1024 * 256, 256,
                         in.ffn_norm_g + L * 1024, w.Wgut + L * WGU_SZ, (size_t)512 * 1024, 1024, 512, 32, tile, rot, tid);
        prep_job<MAP_ID>(in.moe_w_down + (size_t)L * 32 * 256 * 1024, 1024, (size_t)256 * 1024, nullptr, 0, nullptr, w.Wdt + L * WD_SZ, (size_t)1024 * 256,
                         256, 1024, 32, tile, rot, tid);
        for (int i = bid * 256 + tid; i < 128 * 1024; i += G * 256) {
            int n = i >> 10, k = i & 1023; float v = 0.f;
            if (n < 4) v = in.router_group_w[(size_t)L * 1024 * 4 + k * 4 + n];
            else if (n < 36) v = in.router_expert_w[(size_t)L * 1024 * 32 + k * 32 + (n - 4)];
            v *= in.ffn_norm_g[L * 1024 + k];
            w.Wrt[L * WR_SZ + i] = (bf16_t)f2bf(v);
        }
        for (int i = bid * 256 + tid; i < 4 * 128 * 128; i += G * 256) {
            int jj = i & 127, ii = (i >> 7) & 127;
            float v = (jj <= ii) ? in.sgu_w[(size_t)L * WSM_SZ + i] : 0.f;
            w.Wsm[L * WSM_SZ + i] = (bf16_t)f2bf(v);
        }
    }
    for (int i = bid * 256 + tid; i < NT * 16; i += G * 256) {
        int t = i >> 4, j = i & 15;
        float c, sn; rope_cs(in.positions[t], j, c, sn);
        w.cs[t * 32 + j] = c; w.cs[t * 32 + 16 + j] = sn;
    }
    for (size_t i = (size_t)bid * 256 + tid; i < (size_t)NT * 1024 / 4; i += (size_t)G * 256) {
        float4 v = ((const float4*)in.x)[i];
        ((float4*)P.h)[i] = v;
        uint2 pk; pk.x = pack2(v.x, v.y); pk.y = pack2(v.z, v.w);
        ((uint2*)w.hb)[i] = pk;
    }
    for (int i = bid * 256 + tid; i < 128; i += G * 256) w.cnt[i] = 0;
}

__device__ __forceinline__ int lds_off(int row, int chunk) { return row * 128 + ((chunk ^ ((row >> 1) & 7)) << 4); }

template <typename AT> struct ARaw;
template <> struct ARaw<bf16_t> { uint4 v[4]; };
template <> struct ARaw<float> { float4 v[4][2]; };

__device__ __forceinline__ void a_load(ARaw<bf16_t>& r, const bf16_t* const (&rowp)[4], int koff) {
#pragma unroll
    for (int i = 0; i < 4; ++i) r.v[i] = *(const uint4*)(rowp[i] + koff);
}
__device__ __forceinline__ void a_load(ARaw<float>& r, const float* const (&rowp)[4], int koff) {
#pragma unroll
    for (int i = 0; i < 4; ++i) { r.v[i][0] = *(const float4*)(rowp[i] + koff); r.v[i][1] = *(const float4*)(rowp[i] + koff + 4); }
}
template <bool SUMSQ> __device__ __forceinline__ uint4 a_cvt(const uint4& v, float& ss) {
    if (SUMSQ) {
        float a;
        a = bflo(v.x); ss = fmaf(a, a, ss); a = bfhi(v.x); ss = fmaf(a, a, ss);
        a = bflo(v.y); ss = fmaf(a, a, ss); a = bfhi(v.y); ss = fmaf(a, a, ss);
        a = bflo(v.z); ss = fmaf(a, a, ss); a = bfhi(v.z); ss = fmaf(a, a, ss);
        a = bflo(v.w); ss = fmaf(a, a, ss); a = bfhi(v.w); ss = fmaf(a, a, ss);
    }
    return v;
}
template <bool SUMSQ> __device__ __forceinline__ void a_store(const ARaw<bf16_t>& r, char* ldsA, int tid, float (&ss)[4]) {
#pragma unroll
    for (int i = 0; i < 4; ++i) { uint4 v = a_cvt<SUMSQ>(r.v[i], ss[i]); *(uint4*)(ldsA + lds_off((tid >> 3) + 32 * i, tid & 7)) = v; }
}
template <bool SUMSQ> __device__ __forceinline__ void a_store(const ARaw<float>& r, char* ldsA, int tid, float (&ss)[4]) {
#pragma unroll
    for (int i = 0; i < 4; ++i) {
        const float4 a = r.v[i][0], b = r.v[i][1];
        if (SUMSQ) ss[i] += a.x * a.x + a.y * a.y + a.z * a.z + a.w * a.w + b.x * b.x + b.y * b.y + b.z * b.z + b.w * b.w;
        uint4 v; v.x = pack2(a.x, a.y); v.y = pack2(a.z, a.w); v.z = pack2(b.x, b.y); v.w = pack2(b.z, b.w);
        *(uint4*)(ldsA + lds_off((tid >> 3) + 32 * i, tid & 7)) = v;
    }
}

struct bf16x3_t {};
template <> struct ARaw<bf16x3_t> { uint4 a[4], b[4], c[4]; };
struct Rows3 { const bf16_t* p[2][4]; };
__device__ __forceinline__ void a_load(ARaw<bf16x3_t>& r, const Rows3& rows, int koff) {
#pragma unroll
    for (int i = 0; i < 4; ++i) { r.a[i] = *(const uint4*)(rows.p[0][i] + koff); r.b[i] = *(const uint4*)(rows.p[1][i] + koff); r.c[i] = *(const uint4*)(rows.p[1][i] + koff + 1024); }
}
__device__ __forceinline__ unsigned add3pk(unsigned a, unsigned b, unsigned c, float& ss) {
    const float lo = bflo(a) + bflo(b) + bflo(c), hi = bfhi(a) + bfhi(b) + bfhi(c);
    ss = fmaf(lo, lo, ss); ss = fmaf(hi, hi, ss);
    return pack2(lo, hi);
}
template <bool SUMSQ> __device__ __forceinline__ void a_store(const ARaw<bf16x3_t>& r, char* ldsA, int tid, float (&ss)[4]) {
#pragma unroll
    for (int i = 0; i < 4; ++i) {
        uint4 v;
        v.x = add3pk(r.a[i].x, r.b[i].x, r.c[i].x, ss[i]); v.y = add3pk(r.a[i].y, r.b[i].y, r.c[i].y, ss[i]);
        v.z = add3pk(r.a[i].z, r.b[i].z, r.c[i].z, ss[i]); v.w = add3pk(r.a[i].w, r.b[i].w, r.c[i].w, ss[i]);
        *(uint4*)(ldsA + lds_off((tid >> 3) + 32 * i, tid & 7)) = v;
    }
}

template <typename AT, bool SUMSQ, int SUNROLL = 4, typename AROWS>
__device__ __forceinline__ void gemm_mainloop(f32x16 (&acc)[2][2], const AROWS& arow, const bf16_t* const (&wrow)[4], int nkt, char* lds, float (&ss)[4], const int tid) {
    const int lane = tid & 63, wid = tid >> 6, wr = wid >> 1, wc = wid & 1;
    ARaw<AT> ra; ARaw<bf16_t> rb; float dummy[4] = {0.f, 0.f, 0.f, 0.f};
    a_load(ra, arow, 0); a_load(rb, wrow, 0);
    a_store<SUMSQ>(ra, lds, tid, ss); a_store<false>(rb, lds + 16384, tid, dummy);
    __syncthreads();
    const int fr = lane & 31, fh = lane >> 5;
#pragma unroll 1
    for (int kt = 0; kt < nkt; ++kt) {
        char* cur = lds + (kt & 1) * 32768;
        char* nxt = lds + ((kt + 1) & 1) * 32768;
        const bool more = (kt + 1 < nkt);
        if (more) { a_load(ra, arow, (kt + 1) * 64); a_load(rb, wrow, (kt + 1) * 64); }
#pragma unroll SUNROLL
        for (int s = 0; s < 4; ++s) {
            bf16x8 xa[2], wb[2];
#pragma unroll
            for (int i = 0; i < 2; ++i) xa[i] = *(const bf16x8*)(cur + lds_off(wr * 64 + i * 32 + fr, 2 * s + fh));
#pragma unroll
            for (int j = 0; j < 2; ++j) wb[j] = *(const bf16x8*)(cur + 16384 + lds_off(wc * 64 + j * 32 + fr, 2 * s + fh));
#pragma unroll
            for (int i = 0; i < 2; ++i)
#pragma unroll
                for (int j = 0; j < 2; ++j) acc[i][j] = __builtin_amdgcn_mfma_f32_32x32x16_bf16(wb[j], xa[i], acc[i][j], 0, 0, 0);
        }
        if (more) { a_store<SUMSQ>(ra, nxt, tid, ss); a_store<false>(rb, nxt + 16384, tid, dummy); }
        __syncthreads();
    }
}
__device__ __forceinline__ void acc_zero(f32x16 (&acc)[2][2]) {
#pragma unroll
    for (int i = 0; i < 2; ++i)
#pragma unroll
        for (int j = 0; j < 2; ++j)
#pragma unroll
            for (int r = 0; r < 16; ++r) acc[i][j][r] = 0.f;
}
__device__ __forceinline__ void publish_rowstat(float (&ss)[4], float* stat, float invK, bool as_rstd, const int tid) {
#pragma unroll
    for (int i = 0; i < 4; ++i) {
        float v = ss[i];
        v += __shfl_xor(v, 1); v += __shfl_xor(v, 2); v += __shfl_xor(v, 4);
        if ((tid & 7) == 0) stat[(tid >> 3) + 32 * i] = as_rstd ? rsqrtf(v * invK + EPS) : v;
    }
    __syncthreads();
}
__device__ __forceinline__ int nidx(int r, int fh) { return (r & 3) + 8 * (r >> 2) + 4 * fh; }
__device__ __forceinline__ void store4(bf16_t* p, float a, float b, float c, float d) {
    uint2 v; v.x = pack2(a, b); v.y = pack2(c, d); *(uint2*)p = v;
}

constexpr int TLD = 132;
constexpr int STAT_OFF = 128 * TLD * 4;
constexpr int LDS_GEMM_BYTES = STAT_OFF + 1024;
__device__ __forceinline__ void acc_to_lds(const f32x16 (&acc)[2][2], float* T, const int tid) {
    const int lane = tid & 63, wid = tid >> 6, wr = wid >> 1, wc = wid & 1, fr = lane & 31, fh = lane >> 5;
#pragma unroll
    for (int i = 0; i < 2; ++i)
#pragma unroll
        for (int j = 0; j < 2; ++j)
#pragma unroll
            for (int g = 0; g < 4; ++g) {
                float4 v; v.x = acc[i][j][4 * g]; v.y = acc[i][j][4 * g + 1]; v.z = acc[i][j][4 * g + 2]; v.w = acc[i][j][4 * g + 3];
                *(float4*)(T + (wr * 64 + i * 32 + fr) * TLD + wc * 64 + j * 32 + 8 * g + 4 * fh) = v;
            }
    __syncthreads();
}
__device__ __forceinline__ float grp_sum16(float v) { v += __shfl_xor(v, 1); v += __shfl_xor(v, 2); v += __shfl_xor(v, 4); v += __shfl_xor(v, 8); return v; }
__device__ __forceinline__ float grp_sum32(float v) { v = grp_sum16(v); v += __shfl_xor(v, 16); return v; }

}
namespace fx {

__device__ void phase_zgemm(const Params& P, int L, char* lds) {
    const WS& w = P.w; const nv::Inputs& in = P.in;
    const int tid0 = opaque_tid();
    float* T = (float*)lds; float* stat = (float*)(lds + STAT_OFF);
    const bf16_t* Wt = w.W1t + L * W1_SZ;
    const int nitems = 128 * 12;
    for (int item = blockIdx.x; item < nitems; item += gridDim.x) {
        int tid = tid0; asm volatile("" : "+v"(tid));
        const int lane = tid & 63, wid = tid >> 6;
        const int mt = item / 12, nt = item % 12, m0 = mt * 128, n0 = nt * 128;
        {
            const bf16_t* arow[4]; const bf16_t* wrow[4];
#pragma unroll
            for (int i = 0; i < 4; ++i) {
                arow[i] = w.hb + (size_t)(m0 + (tid >> 3) + 32 * i) * 1024 + (tid & 7) * 8;
                wrow[i] = Wt + (size_t)(n0 + (tid >> 3) + 32 * i) * 1024 + (tid & 7) * 8;
            }
            f32x16 acc[2][2]; acc_zero(acc);
            float ss[4] = {0.f, 0.f, 0.f, 0.f};
            gemm_mainloop<bf16_t, true>(acc, arow, wrow, 16, lds, ss, tid);
            publish_rowstat(ss, stat, 1.f / 1024.f, true, tid);
            acc_to_lds(acc, T, tid);
        }
        if (nt < 2) {
#pragma unroll 2
            for (int rr = 0; rr < 32; ++rr) {
                const int row = wid * 32 + rr; const float rs = stat[row];
                const float2 x = *(const float2*)(T + row * TLD + 2 * lane);
                *(unsigned*)(w.ub + (size_t)(m0 + row) * 256 + nt * 128 + 2 * lane) = pack2(gelu_tanh_(x.x * rs), gelu_tanh_(x.y * rs));
            }
        } else if (nt < 4) {
            const int hd = (nt - 2) * 2 + (lane >> 5);
            const float2 lg = *(const float2*)(in.sgu_ln_g + L * 256 + hd * 64 + 2 * (lane & 31));
            const float2 lb = *(const float2*)(in.sgu_ln_b + L * 256 + hd * 64 + 2 * (lane & 31));
#pragma unroll 2
            for (int rr = 0; rr < 32; ++rr) {
                const int row = wid * 32 + rr; const float rs = stat[row];
                float2 x = *(const float2*)(T + row * TLD + 2 * lane);
                x.x = gelu_tanh_(x.x * rs); x.y = gelu_tanh_(x.y * rs);
                const float mean = grp_sum32(x.x + x.y) * (1.f / 64.f);
                const float dx = x.x - mean, dy = x.y - mean;
                const float rv = rsqrtf(grp_sum32(dx * dx + dy * dy) * (1.f / 64.f) + EPS);
                float2 o; o.x = dx * rv * lg.x + lb.x; o.y = dy * rv * lg.y + lb.y;
                *(float2*)(T + row * TLD + 2 * lane) = o;
            }
            __syncthreads();
            {
                const int c = tid & 127, th = tid >> 7, hd2 = (nt - 2) * 2 + (c >> 6), d = c & 63;
                bf16_t* dst = w.vT + ((size_t)(mt * 4 + hd2) * 64 + d) * 128 + th * 64;
#pragma unroll 2
                for (int k8 = 0; k8 < 8; ++k8) {
                    float v[8];
#pragma unroll
                    for (int k = 0; k < 8; ++k) v[k] = T[(th * 64 + k8 * 8 + k) * TLD + c];
                    uint4 pk; pk.x = pack2(v[0], v[1]); pk.y = pack2(v[2], v[3]); pk.z = pack2(v[4], v[5]); pk.w = pack2(v[6], v[7]);
                    *(uint4*)(dst + k8 * 8) = pk;
                }
            }
        } else if (nt < 8) {
#pragma unroll 2
            for (int rr = 0; rr < 32; ++rr) {
                const int row = wid * 32 + rr; const float rs = stat[row];
                const float2 x = *(const float2*)(T + row * TLD + 2 * lane);
                w.ygb[(size_t)(m0 + row) * 256 + (nt - 4) * 64 + lane] = (bf16_t)f2bf(x.x * rs * sigmoid_(x.y * rs));
            }
        } else if (nt < 11) {
            bf16_t* base; int ld, cb;
            if (nt < 10) { base = w.cqb; ld = 256; cb = (nt - 8) * 128; } else { base = w.ckvb; ld = 128; cb = 0; }
#pragma unroll 2
            for (int rr = 0; rr < 32; ++rr) {
                const int row = wid * 32 + rr; const float rs = stat[row];
                const float2 x = *(const float2*)(T + row * TLD + 2 * lane);
                *(unsigned*)(base + (size_t)(m0 + row) * ld + cb + 2 * lane) = pack2(x.x * rs, x.y * rs);
            }
        } else {
            const float2 kg = *(const float2*)(in.k_norm_g + L * 96 + 64 + 2 * (lane & 15));
#pragma unroll 2
            for (int rr = 0; rr < 32; ++rr) {
                const int row = wid * 32 + rr; const float rs = stat[row]; const int tok = m0 + row;
                float2 x = *(const float2*)(T + row * TLD + 2 * (lane & 15));
                x.x *= rs; x.y *= rs;
                const float rn = rsqrtf(grp_sum16(x.x * x.x + x.y * x.y) * (1.f / 32.f) + EPS);
                x.x *= rn * kg.x; x.y *= rn * kg.y;
                const float ox = __shfl_xor(x.x, 8), oy = __shfl_xor(x.y, 8);
                const int jj = (2 * lane) & 15;
                const float2 c = *(const float2*)(w.cs + (size_t)tok * 32 + jj), sn = *(const float2*)(w.cs + (size_t)tok * 32 + 16 + jj);
                float2 o;
                if ((lane & 8) == 0) { o.x = x.x * c.x - ox * sn.x; o.y = x.y * c.y - oy * sn.y; }
                else { o.x = x.x * c.x + ox * sn.x; o.y = x.y * c.y + oy * sn.y; }
                if (lane < 16) *(unsigned*)(w.kpeb + (size_t)tok * 32 + 2 * lane) = pack2(o.x, o.y);
            }
        }
        __syncthreads();
    }
}

__global__ void k_shim_z(Params P, int t0) {
    const WS& w = P.w;
    size_t idx = (size_t)blockIdx.x * blockDim.x + threadIdx.x;
    if (idx >= (size_t)2048 * 1440) return;
    int t = t0 + (int)(idx / 1440), c = (int)(idx % 1440);
    float v = 0.f;
    if (c < 256) v = bf2f(w.ub[(size_t)t * 256 + c]);
    else if (c < 512) { int cc = c - 256; v = bf2f(w.vT[((size_t)((t >> 7) * 4 + (cc >> 6)) * 64 + (cc & 63)) * 128 + (t & 127)]); }
    else if (c < 768) v = bf2f(w.ygb[(size_t)t * 256 + c - 512]);
    else if (c < 1024) v = 0.f;
    else if (c < 1280) v = bf2f(w.cqb[(size_t)t * 256 + c - 1024]);
    else if (c < 1408) v = bf2f(w.ckvb[(size_t)t * 128 + c - 1280]);
    else v = bf2f(w.kpeb[(size_t)t * 32 + c - 1408]);
    P.zf[idx] = v;
}
__global__ void k_shim_hb(Params P) {
    size_t i = (size_t)blockIdx.x * blockDim.x + threadIdx.x;
    if (i >= (size_t)NT * 1024 / 4) return;
    float4 v = ((const float4*)P.h)[i];
    uint2 pk; pk.x = pack2(v.x, v.y); pk.y = pack2(v.z, v.w);
    ((uint2*)P.w.hb)[i] = pk;
}

}
namespace fx {

constexpr float QSCALE = 0.10206207261596575f * 1.4426950408889634f;

__device__ void qkv_item(const Params& P, int L, int item, char* lds, const int tid_in) {
    int tid = tid_in; asm volatile("" : "+v"(tid));
    const WS& w = P.w; const nv::Inputs& in = P.in;
    const int lane = tid & 63, wid = tid >> 6;
    float* T = (float*)lds; float* stat = (float*)(lds + STAT_OFF);
    const bool isq = item < 128 * 6;
    int mt, nt;
    if (isq) { mt = item / 6; nt = item % 6; } else { const int it = item - 128 * 6; mt = it / 8; nt = it % 8; }
    const int m0 = mt * 128, n0 = nt * 128;
    const int K = isq ? 256 : 128;
    {
        const bf16_t* A = isq ? w.cqb : w.ckvb;
        const bf16_t* Wt = isq ? (w.Wuqt + L * WUQ_SZ) : (w.Wukvt + L * WUKV_SZ);
        const bf16_t* arow[4]; const bf16_t* wrow[4];
#pragma unroll
        for (int i = 0; i < 4; ++i) {
            arow[i] = A + (size_t)(m0 + (tid >> 3) + 32 * i) * K + (tid & 7) * 8;
            wrow[i] = Wt + (size_t)(n0 + (tid >> 3) + 32 * i) * K + (tid & 7) * 8;
        }
        f32x16 acc[2][2]; acc_zero(acc);
        float ss[4] = {0.f, 0.f, 0.f, 0.f};
        gemm_mainloop<bf16_t, true>(acc, arow, wrow, K / 64, lds, ss, tid);
        publish_rowstat(ss, stat, 1.f / (float)K, true, tid);
        acc_to_lds(acc, T, tid);
    }
    const int b = m0 >> 11, s0 = m0 & 2047;
    if (isq && nt < 4) {
        const int hd = nt * 2 + (lane >> 5), d = 2 * (lane & 31);
        const float2 g = *(const float2*)(in.q_norm_g + L * 96 + d);
        bf16_t* dst = w.Qb + ((size_t)(b * 8 + hd) * 2048 + s0) * 96 + d;
#pragma unroll 2
        for (int rr = 0; rr < 32; ++rr) {
            const int row = wid * 32 + rr; const float rs = stat[row];
            float2 x = *(const float2*)(T + row * TLD + 2 * lane);
            x.x *= rs; x.y *= rs;
            const float rn = rsqrtf(grp_sum32(x.x * x.x + x.y * x.y) * (1.f / 64.f) + EPS) * QSCALE;
            *(unsigned*)(dst + (size_t)row * 96) = pack2(x.x * rn * g.x, x.y * rn * g.y);
        }
    } else if (isq) {
        const int hd = (nt - 4) * 4 + (lane >> 4), d = 2 * (lane & 15);
        const float2 g = *(const float2*)(in.q_norm_g + L * 96 + 64 + d);
        bf16_t* dst = w.Qb + ((size_t)(b * 8 + hd) * 2048 + s0) * 96 + 64 + d;
        const int jj = d & 15;
#pragma unroll 2
        for (int rr = 0; rr < 32; ++rr) {
            const int row = wid * 32 + rr; const float rs = stat[row]; const int tok = m0 + row;
            float2 x = *(const float2*)(T + row * TLD + 2 * lane);
            x.x *= rs; x.y *= rs;
            const float rn = rsqrtf(grp_sum16(x.x * x.x + x.y * x.y) * (1.f / 32.f) + EPS);
            x.x *= rn * g.x; x.y *= rn * g.y;
            const float ox = __shfl_xor(x.x, 8), oy = __shfl_xor(x.y, 8);
            const float2 c = *(const float2*)(w.cs + (size_t)tok * 32 + jj), sn = *(const float2*)(w.cs + (size_t)tok * 32 + 16 + jj);
            float2 o;
            if ((lane & 8) == 0) { o.x = x.x * c.x - ox * sn.x; o.y = x.y * c.y - oy * sn.y; }
            else { o.x = x.x * c.x + ox * sn.x; o.y = x.y * c.y + oy * sn.y; }
            *(unsigned*)(dst + (size_t)row * 96) = pack2(o.x * QSCALE, o.y * QSCALE);
        }
    } else if (nt < 4) {
        const int hd = nt * 2 + (lane >> 5), d = 2 * (lane & 31);
        const float2 g = *(const float2*)(in.k_norm_g + L * 96 + d);
        bf16_t* dst = w.Knb + ((size_t)(b * 8 + hd) * 2048 + s0) * 64 + d;
#pragma unroll 2
        for (int rr = 0; rr < 32; ++rr) {
            const int row = wid * 32 + rr; const float rs = stat[row];
            float2 x = *(const float2*)(T + row * TLD + 2 * lane);
            x.x *= rs; x.y *= rs;
            const float rn = rsqrtf(grp_sum32(x.x * x.x + x.y * x.y) * (1.f / 64.f) + EPS);
            *(unsigned*)(dst + (size_t)row * 64) = pack2(x.x * rn * g.x, x.y * rn * g.y);
        }
    } else {
        const int c = tid & 127, th = tid >> 7, hd = (nt - 4) * 2 + (c >> 6), d = c & 63;
        bf16_t* dst = w.VTb + ((size_t)(b * 8 + hd) * 64 + d) * 2048 + s0 + th * 64;
#pragma unroll 2
        for (int k8 = 0; k8 < 8; ++k8) {
            float v[8];
#pragma unroll
            for (int k = 0; k < 8; ++k) { const int row = th * 64 + k8 * 8 + k; v[k] = T[row * TLD + c] * stat[row]; }
            uint4 pk; pk.x = pack2(v[0], v[1]); pk.y = pack2(v[2], v[3]); pk.z = pack2(v[4], v[5]); pk.w = pack2(v[6], v[7]);
            *(uint4*)(dst + k8 * 8) = pk;
        }
    }
    __syncthreads();
}

__device__ void sgu_item(const Params& P, int L, int mt, char* lds, const int tid_in) {
    int tid = tid_in; asm volatile("" : "+v"(tid));
    const WS& w = P.w; const nv::Inputs& in = P.in;
    const int lane = tid & 63, hd = tid >> 6, fr = lane & 31, fh = lane >> 5;
    float* red = (float*)lds;
    const bf16_t* vt = w.vT + (size_t)(mt * 4 + hd) * 64 * 128;
    const bf16_t* ws = w.Wsm + L * WSM_SZ + (size_t)hd * 128 * 128;
    const float* bs = in.sgu_b + L * 512 + hd * 128;
    const int m0 = mt * 128;
#pragma unroll 1
    for (int it = 0; it < 4; ++it) {
        f32x16 a0, a1;
#pragma unroll
        for (int r = 0; r < 16; ++r) { a0[r] = 0.f; a1[r] = 0.f; }
        const int nks = 2 * (it + 1);
        const bf16_t* bp = ws + (size_t)(it * 32 + fr) * 128 + 8 * fh;
        const bf16_t* ap0 = vt + (size_t)fr * 128 + 8 * fh;
        const bf16_t* ap1 = vt + (size_t)(32 + fr) * 128 + 8 * fh;
#pragma unroll 2
        for (int s = 0; s < nks; ++s) {
            const bf16x8 bfrag = *(const bf16x8*)(bp + 16 * s);
            const bf16x8 af0 = *(const bf16x8*)(ap0 + 16 * s), af1 = *(const bf16x8*)(ap1 + 16 * s);
            a0 = __builtin_amdgcn_mfma_f32_32x32x16_bf16(af0, bfrag, a0, 0, 0, 0);
            a1 = __builtin_amdgcn_mfma_f32_32x32x16_bf16(af1, bfrag, a1, 0, 0, 0);
        }
        const int i = it * 32 + fr, tok = m0 + i;
        const float bias = bs[i];
        float ssq = 0.f;
#pragma unroll
        for (int dt = 0; dt < 2; ++dt)
#pragma unroll
            for (int g = 0; g < 4; ++g) {
                const int d = dt * 32 + 8 * g + 4 * fh;
                const uint2 uu = *(const uint2*)(w.ub + (size_t)tok * 256 + hd * 64 + d);
                float o[4];
#pragma unroll
                for (int q = 0; q < 4; ++q) {
                    const float sv = (dt == 0 ? a0[4 * g + q] : a1[4 * g + q]) + bias;
                    const float uv = (q == 0) ? bflo(uu.x) : (q == 1) ? bfhi(uu.x) : (q == 2) ? bflo(uu.y) : bfhi(uu.y);
                    o[q] = uv * sv; ssq += o[q] * o[q];
                }
                store4(w.yb + (size_t)tok * 1024 + hd * 64 + d, o[0], o[1], o[2], o[3]);
            }
        ssq = xor32(ssq);
        if (fh == 0) red[hd * 128 + i] = ssq;
    }
    __syncthreads();
    if (tid < 128) w.ssq[(size_t)(m0 + tid) * 16 + 0] = red[tid] + red[128 + tid] + red[256 + tid] + red[384 + tid];
    __syncthreads();
}

__device__ __forceinline__ int yl_off(int row, int chunk) { return row * 512 + ((chunk ^ (row & 7)) << 4); }
__device__ void conv_item(const Params& P, int L, int ct, char* lds, const int tid_in) {
    int tid = tid_in; asm volatile("" : "+v"(tid));
    const WS& w = P.w; const nv::Inputs& in = P.in;
    const int lane = tid & 63, wid = tid >> 6, fr = lane & 31, fh = lane >> 5;
    bf16_t* ygs = (bf16_t*)lds; char* yl = lds; float* red = (float*)(lds + 49152);
    const int t0 = ct * 64, s0 = t0 & 2047;
    for (int i = tid; i < 94 * 32; i += 256) {
        const int r = i >> 5, ch = i & 31;
        uint4 v = make_uint4(0u, 0u, 0u, 0u);
        if (s0 + r - 30 >= 0) v = *(const uint4*)(w.ygb + (size_t)(t0 + r - 30) * 256 + ch * 8);
        *(uint4*)(ygs + r * 256 + ch * 8) = v;
    }
    __syncthreads();
    {
        const int c = tid;
        float wk[31];
#pragma unroll
        for (int k = 0; k < 31; ++k) wk[k] = in.conv_w[(size_t)L * 31 * 256 + k * 256 + c];
        const float cb = in.conv_b[L * 256 + c], lg = in.conv_ln_g[L * 256 + c], lb = in.conv_ln_b[L * 256 + c];
#pragma unroll 1
        for (int t = 0; t < 64; ++t) {
            float a = cb;
#pragma unroll
            for (int k = 0; k < 31; ++k) a = fmaf(wk[k], bf2f(ygs[(t + k) * 256 + c]), a);
            float mean = a;
#pragma unroll
            for (int o = 32; o > 0; o >>= 1) mean += __shfl_xor(mean, o);
            mean *= (1.f / 64.f);
            const float dv = a - mean;
            float var = dv * dv;
#pragma unroll
            for (int o = 32; o > 0; o >>= 1) var += __shfl_xor(var, o);
            const float v = dv * rsqrtf(var * (1.f / 64.f) + EPS) * lg + lb;
            const float sv = v * sigmoid_(v);
            *(bf16_t*)(yl + yl_off(t, c >> 3) + (c & 7) * 2) = (bf16_t)f2bf(sv);
        }
    }
    __syncthreads();
    f32x16 acc[2][2];
#pragma unroll
    for (int jn = 0; jn < 2; ++jn)
#pragma unroll
        for (int it = 0; it < 2; ++it)
#pragma unroll
            for (int r = 0; r < 16; ++r) acc[jn][it][r] = 0.f;
    const bf16_t* wp = w.Wpwt + L * WPW_SZ + (size_t)(wid * 64 + fr) * 256 + 8 * fh;
#pragma unroll 2
    for (int s = 0; s < 16; ++s) {
        const bf16x8 w0 = *(const bf16x8*)(wp + 16 * s), w1 = *(const bf16x8*)(wp + 32 * 256 + 16 * s);
        const bf16x8 x0 = *(const bf16x8*)(yl + yl_off(fr, 2 * s + fh)), x1 = *(const bf16x8*)(yl + yl_off(32 + fr, 2 * s + fh));
        acc[0][0] = __builtin_amdgcn_mfma_f32_32x32x16_bf16(w0, x0, acc[0][0], 0, 0, 0);
        acc[0][1] = __builtin_amdgcn_mfma_f32_32x32x16_bf16(w0, x1, acc[0][1], 0, 0, 0);
        acc[1][0] = __builtin_amdgcn_mfma_f32_32x32x16_bf16(w1, x0, acc[1][0], 0, 0, 0);
        acc[1][1] = __builtin_amdgcn_mfma_f32_32x32x16_bf16(w1, x1, acc[1][1], 0, 0, 0);
    }
    const float* pb = in.conv_pw_b + L * 256;
#pragma unroll
    for (int it = 0; it < 2; ++it) {
        const int tok = t0 + it * 32 + fr;
        float ssq = 0.f;
#pragma unroll
        for (int jn = 0; jn < 2; ++jn)
#pragma unroll
            for (int g = 0; g < 4; ++g) {
                const int n = wid * 64 + jn * 32 + 8 * g + 4 * fh;
                const float4 b4 = *(const float4*)(pb + n);
                const float o0 = acc[jn][it][4 * g] + b4.x, o1 = acc[jn][it][4 * g + 1] + b4.y, o2 = acc[jn][it][4 * g + 2] + b4.z, o3 = acc[jn][it][4 * g + 3] + b4.w;
                ssq += o0 * o0 + o1 * o1 + o2 * o2 + o3 * o3;
                store4(w.yb + (size_t)tok * 1024 + 256 + n, o0, o1, o2, o3);
            }
        ssq = xor32(ssq);
        if (fh == 0) red[wid * 64 + it * 32 + fr] = ssq;
    }
    __syncthreads();
    if (tid < 64) w.ssq[(size_t)(t0 + tid) * 16 + 1] = red[tid] + red[64 + tid] + red[128 + tid] + red[192 + tid];
    __syncthreads();
}

__device__ void phase_mix(const Params& P, int L, char* lds) {
    const int tid = opaque_tid();
    const int NQKV = 128 * 6 + 128 * 8, NCONV = 256, NSGU = 128;
    for (int item = blockIdx.x; item < NQKV + NCONV + NSGU; item += gridDim.x) {
        if (item < NQKV) qkv_item(P, L, item, lds, tid);
        else if (item < NQKV + NCONV) conv_item(P, L, item - NQKV, lds, tid);
        else sgu_item(P, L, item - NQKV - NCONV, lds, tid);
    }
}

__global__ void k_shim_qkv(Params P, int t0, float* q, float* kv) {
    const WS& w = P.w;
    size_t idx = (size_t)blockIdx.x * blockDim.x + threadIdx.x;
    if (idx >= (size_t)2048 * 1792) return;
    const int tl = (int)(idx / 1792), c = (int)(idx % 1792), t = t0 + tl, b = t >> 11, s = t & 2047;
    if (c < 768) { const int h = c / 96, d = c % 96; q[(size_t)tl * 768 + c] = bf2f(w.Qb[((size_t)(b * 8 + h) * 2048 + s) * 96 + d]) * (1.f / QSCALE); }
    else {
        const int cc = c - 768, h = cc >> 7, d = cc & 127;
        kv[(size_t)tl * 1024 + cc] = (d < 64) ? bf2f(w.Knb[((size_t)(b * 8 + h) * 2048 + s) * 64 + d]) : bf2f(w.VTb[((size_t)(b * 8 + h) * 64 + (d - 64)) * 2048 + s]);
    }
}
__global__ void k_shim_y(Params P, int t0, int c0, int c1) {
    const int wdt = c1 - c0;
    size_t idx = (size_t)blockIdx.x * blockDim.x + threadIdx.x;
    if (idx >= (size_t)2048 * wdt) return;
    const int tl = (int)(idx / wdt), c = c0 + (int)(idx % wdt);
    P.yf[(size_t)tl * 1024 + c] = bf2f(P.w.yb[(size_t)(t0 + tl) * 1024 + c]);
}

}
namespace fx {

constexpr int KROW = 208, VROW = 136, ATT_STAGE = 64 * KROW + 64 * VROW;

struct KVRegs { uint4 k0, k1, k2, v0, v1; };
__device__ __forceinline__ uint4 k_ld(const bf16_t* Kn, const bf16_t* Kp, int k0, int c) {
    const int key = c / 12, ch = c % 12;
    const bf16_t* src = (ch < 8) ? (Kn + (size_t)(k0 + key) * 64 + ch * 8) : (Kp + (size_t)(k0 + key) * 32 + (ch - 8) * 8);
    return *(const uint4*)src;
}
__device__ __forceinline__ void kv_load(KVRegs& r, const bf16_t* Kn, const bf16_t* Kp, const bf16_t* Vt, int k0, const int tid) {
    r.k0 = k_ld(Kn, Kp, k0, tid); r.k1 = k_ld(Kn, Kp, k0, tid + 256); r.k2 = k_ld(Kn, Kp, k0, tid + 512);
    r.v0 = *(const uint4*)(Vt + (size_t)(tid >> 3) * 2048 + k0 + (tid & 7) * 8);
    r.v1 = *(const uint4*)(Vt + (size_t)(32 + (tid >> 3)) * 2048 + k0 + (tid & 7) * 8);
}
__device__ __forceinline__ void k_st(char* st, int c, const uint4& v) { const int key = c / 12, ch = c % 12; *(uint4*)(st + key * KROW + ch * 16) = v; }
__device__ __forceinline__ void v_st(char* st, int d, int ch, const uint4& v) {
    char* p = st + 64 * KROW + d * VROW + ch * 16;
    *(uint2*)p = make_uint2(v.x, v.y); *(uint2*)(p + 8) = make_uint2(v.z, v.w);
}
__device__ __forceinline__ void kv_store(const KVRegs& r, char* st, const int tid) {
    k_st(st, tid, r.k0); k_st(st, tid + 256, r.k1); k_st(st, tid + 512, r.k2);
    v_st(st, tid >> 3, tid & 7, r.v0); v_st(st, 32 + (tid >> 3), tid & 7, r.v1);
}

__device__ void attn_unit(const Params& P, int b, int h, int qt, char* lds, const int tid) {
    const WS& w = P.w;
    const int lane = tid & 63, wid = tid >> 6, fr = lane & 31, fh = lane >> 5;
    const bf16_t* Kn = w.Knb + (size_t)(b * 8 + h) * 2048 * 64;
    const bf16_t* Kp = w.kpeb + (size_t)b * 2048 * 32;
    const bf16_t* Vt = w.VTb + (size_t)(b * 8 + h) * 64 * 2048;
    const int q0 = qt * 128, qw0 = q0 + wid * 32, qpos = qw0 + fr;
    bf16x8 qf[6];
    {
        const bf16_t* qp = w.Qb + ((size_t)(b * 8 + h) * 2048 + qpos) * 96 + 8 * fh;
#pragma unroll
        for (int ks = 0; ks < 6; ++ks) qf[ks] = *(const bf16x8*)(qp + 16 * ks);
    }
    f32x16 o0, o1;
#pragma unroll
    for (int r = 0; r < 16; ++r) { o0[r] = 0.f; o1[r] = 0.f; }
    float m = -1e30f, l = 0.f;
    const int nkt = 2 * (qt + 1);
    KVRegs kr;
    kv_load(kr, Kn, Kp, Vt, 0, tid);
    kv_store(kr, lds, tid);
    __syncthreads();
#pragma unroll 1
    for (int kt = 0; kt < nkt; ++kt) {
        char* cur = lds + (kt & 1) * ATT_STAGE;
        char* nxt = lds + ((kt + 1) & 1) * ATT_STAGE;
        const bool more = kt + 1 < nkt;
        if (more) kv_load(kr, Kn, Kp, Vt, (kt + 1) * 64, tid);
        const int k0 = kt * 64;
        if (k0 <= qw0 + 31) {
            f32x16 s0, s1;
#pragma unroll
            for (int r = 0; r < 16; ++r) { s0[r] = 0.f; s1[r] = 0.f; }
            const char* kb = cur + fr * KROW + fh * 16;
#pragma unroll
            for (int ks = 0; ks < 6; ++ks) {
                const bf16x8 ka = *(const bf16x8*)(kb + ks * 32), kb2 = *(const bf16x8*)(kb + 32 * KROW + ks * 32);
                s0 = __builtin_amdgcn_mfma_f32_32x32x16_bf16(ka, qf[ks], s0, 0, 0, 0);
                s1 = __builtin_amdgcn_mfma_f32_32x32x16_bf16(kb2, qf[ks], s1, 0, 0, 0);
            }
            if (k0 + 63 > qw0) {
#pragma unroll
                for (int r = 0; r < 16; ++r) {
                    const int key = k0 + nidx(r, fh);
                    if (key > qpos) s0[r] = -1e30f;
                    if (key + 32 > qpos) s1[r] = -1e30f;
                }
            }
            float mx = s0[0];
#pragma unroll
            for (int r = 1; r < 16; ++r) mx = fmaxf(mx, s0[r]);
#pragma unroll
            for (int r = 0; r < 16; ++r) mx = fmaxf(mx, s1[r]);
            mx = fmaxf(mx, __shfl_xor(mx, 32));
            const float mn = fmaxf(m, mx);
            const float alpha = __builtin_amdgcn_exp2f(m - mn);
            m = mn;
            float ps = 0.f;
#pragma unroll
            for (int r = 0; r < 16; ++r) { s0[r] = __builtin_amdgcn_exp2f(s0[r] - mn); ps += s0[r]; }
#pragma unroll
            for (int r = 0; r < 16; ++r) { s1[r] = __builtin_amdgcn_exp2f(s1[r] - mn); ps += s1[r]; }
            ps += __shfl_xor(ps, 32);
            l = l * alpha + ps;
#pragma unroll
            for (int r = 0; r < 16; ++r) { o0[r] *= alpha; o1[r] *= alpha; }
            const char* vb = cur + 64 * KROW + fr * VROW + fh * 8;
#pragma unroll
            for (int ks = 0; ks < 4; ++ks) {
                bf16x8 pf;
                {
                    const int rb = 8 * (ks & 1);
                    unsigned u0, u1, u2, u3;
                    if (ks < 2) { u0 = pack2(s0[rb], s0[rb + 1]); u1 = pack2(s0[rb + 2], s0[rb + 3]); u2 = pack2(s0[rb + 4], s0[rb + 5]); u3 = pack2(s0[rb + 6], s0[rb + 7]); }
                    else { u0 = pack2(s1[rb], s1[rb + 1]); u1 = pack2(s1[rb + 2], s1[rb + 3]); u2 = pack2(s1[rb + 4], s1[rb + 5]); u3 = pack2(s1[rb + 6], s1[rb + 7]); }
                    uint4 uu = make_uint4(u0, u1, u2, u3);
                    pf = __builtin_bit_cast(bf16x8, uu);
                }
                const uint2 va0 = *(const uint2*)(vb + ks * 32), va1 = *(const uint2*)(vb + ks * 32 + 16);
                const uint2 vb0 = *(const uint2*)(vb + 32 * VROW + ks * 32), vb1 = *(const uint2*)(vb + 32 * VROW + ks * 32 + 16);
                const bf16x8 vfa = __builtin_bit_cast(bf16x8, make_uint4(va0.x, va0.y, va1.x, va1.y));
                const bf16x8 vfb = __builtin_bit_cast(bf16x8, make_uint4(vb0.x, vb0.y, vb1.x, vb1.y));
                o0 = __builtin_amdgcn_mfma_f32_32x32x16_bf16(vfa, pf, o0, 0, 0, 0);
                o1 = __builtin_amdgcn_mfma_f32_32x32x16_bf16(vfb, pf, o1, 0, 0, 0);
            }
        }
        if (more) kv_store(kr, nxt, tid);
        __syncthreads();
    }
    const float inv = 1.f / l;
    const int tok = b * 2048 + qpos;
    float ssq = 0.f;
#pragma unroll
    for (int dt = 0; dt < 2; ++dt)
#pragma unroll
        for (int g = 0; g < 4; ++g) {
            float o[4];
#pragma unroll
            for (int q = 0; q < 4; ++q) { o[q] = (dt == 0 ? o0[4 * g + q] : o1[4 * g + q]) * inv; ssq += o[q] * o[q]; }
            store4(w.yb + (size_t)tok * 1024 + 512 + h * 64 + dt * 32 + 8 * g + 4 * fh, o[0], o[1], o[2], o[3]);
        }
    ssq = xor32(ssq);
    if (fh == 0) w.ssq[(size_t)tok * 16 + 8 + h] = ssq;
}

__device__ void phase_attn(const Params& P, int L, char* lds) {
    const int tid0 = opaque_tid();
    for (int item = blockIdx.x; item < 8 * 8 * 8; item += gridDim.x) {
        int tid = tid0; asm volatile("" : "+v"(tid));
        const int p = item & 7, h = (item >> 3) & 7, b = item >> 6;
        attn_unit(P, b, h, 15 - p, lds, tid);
        attn_unit(P, b, h, p, lds, tid);
    }
}

}
namespace fx {

__device__ __forceinline__ void acc_scale(f32x16 (&acc)[2][2], const float* f, const int tid) {
    const int lane = tid & 63, wr = tid >> 7, fr = lane & 31;
#pragma unroll
    for (int i = 0; i < 2; ++i) {
        const float v = f[wr * 64 + i * 32 + fr];
#pragma unroll
        for (int j = 0; j < 2; ++j)
#pragma unroll
            for (int r = 0; r < 16; ++r) acc[i][j][r] *= v;
    }
}
__device__ void phase_oproj(const Params& P, int L, char* lds) {
    const WS& w = P.w;
    const int tid0 = opaque_tid();
    float* T = (float*)lds; float* stat = (float*)(lds + STAT_OFF);
    const bf16_t* Wt = w.Wot + L * WO_SZ;
    for (int item = blockIdx.x; item < 128 * 8; item += gridDim.x) {
        int tid = tid0; asm volatile("" : "+v"(tid));
        const int lane = tid & 63, wid = tid >> 6;
        const int mt = item >> 3, nt = item & 7, m0 = mt * 128, n0 = nt * 128;
        float rb_keep = 0.f;
        if (tid < 128) {
            const float* sq = w.ssq + (size_t)(m0 + tid) * 16;
            const float4 c0 = *(const float4*)(sq + 8), c1 = *(const float4*)(sq + 12);
            const float ra = rsqrtf(sq[0] * (1.f / 256.f) + EPS), rb = rsqrtf(sq[1] * (1.f / 256.f) + EPS);
            const float rc = rsqrtf((c0.x + c0.y + c0.z + c0.w + c1.x + c1.y + c1.z + c1.w) * (1.f / 512.f) + EPS);
            stat[tid] = rc / ra; stat[128 + tid] = ra / rb; rb_keep = rb;
        }
        {
            const bf16_t* arow[4]; const bf16_t* wrow[4];
#pragma unroll
            for (int i = 0; i < 4; ++i) {
                arow[i] = w.yb + (size_t)(m0 + (tid >> 3) + 32 * i) * 1024 + (tid & 7) * 8 + 512;
                wrow[i] = Wt + (size_t)(n0 + (tid >> 3) + 32 * i) * 1024 + (tid & 7) * 8 + 512;
            }
            f32x16 acc[2][2]; acc_zero(acc);
            float ss[4] = {0.f, 0.f, 0.f, 0.f};
            gemm_mainloop<bf16_t, false>(acc, arow, wrow, 8, lds, ss, tid);
            acc_scale(acc, stat, tid);
#pragma unroll
            for (int i = 0; i < 4; ++i) { arow[i] -= 512; wrow[i] -= 512; }
            gemm_mainloop<bf16_t, false>(acc, arow, wrow, 4, lds, ss, tid);
            acc_scale(acc, stat + 128, tid);
#pragma unroll
            for (int i = 0; i < 4; ++i) { arow[i] += 256; wrow[i] += 256; }
            gemm_mainloop<bf16_t, false>(acc, arow, wrow, 4, lds, ss, tid);
            __syncthreads();
            if (tid < 128) stat[tid] = rb_keep;
            acc_to_lds(acc, T, tid);
        }
#pragma unroll 2
        for (int rr = 0; rr < 32; ++rr) {
            const int row = wid * 32 + rr; const float rb = stat[row];
            const float2 x = *(const float2*)(T + row * TLD + 2 * lane);
            float2* hp = (float2*)(P.h + (size_t)(m0 + row) * 1024 + n0 + 2 * lane);
            float2 hv = *hp; hv.x += x.x * rb; hv.y += x.y * rb;
            *hp = hv;
            *(unsigned*)(w.hb1 + (size_t)(m0 + row) * 1024 + n0 + 2 * lane) = pack2(hv.x, hv.y);
        }
        __syncthreads();
    }
}

__device__ void router_item(const Params& P, int L, int mt, char* lds, const int tid_in) {
    int tid = tid_in; asm volatile("" : "+v"(tid));
    const WS& w = P.w; const nv::Inputs& in = P.in;
    float* T = (float*)lds; float* stat = (float*)(lds + STAT_OFF); int* hist = (int*)(lds + STAT_OFF + 512);
    const int m0 = mt * 128;
    {
        const bf16_t* arow[4]; const bf16_t* wrow[4];
#pragma unroll
        for (int i = 0; i < 4; ++i) {
            arow[i] = w.hb1 + (size_t)(m0 + (tid >> 3) + 32 * i) * 1024 + (tid & 7) * 8;
            wrow[i] = w.Wrt + L * WR_SZ + (size_t)((tid >> 3) + 32 * i) * 1024 + (tid & 7) * 8;
        }
        f32x16 acc[2][2]; acc_zero(acc);
        float ss[4] = {0.f, 0.f, 0.f, 0.f};
        gemm_mainloop<bf16_t, true>(acc, arow, wrow, 16, lds, ss, tid);
        publish_rowstat(ss, stat, 1.f / 1024.f, true, tid);
        if (tid < 32) hist[tid] = 0;
        acc_to_lds(acc, T, tid);
    }
    int e0 = 0, e1 = 0, r0 = 0, r1 = 0; float w0 = 0.f, w1 = 0.f;
    if (tid < 128) {
        const float rs = stat[tid];
        const float* lr = T + tid * TLD;
        const float* bg = in.router_group_b + L * 4; const float* be = in.router_expert_b + L * 32;
        int gi = 0; float gm = lr[0] * rs + bg[0];
#pragma unroll
        for (int j = 1; j < 4; ++j) { const float v = lr[j] * rs + bg[j]; if (v > gm) { gm = v; gi = j; } }
        float gs = 0.f;
#pragma unroll
        for (int j = 0; j < 4; ++j) gs += __expf(lr[j] * rs + bg[j] - gm);
        const float gw = 1.f / gs;
        int i0 = 0, i1 = -1; float v0 = -3.0e38f, v1 = -3.0e38f;
#pragma unroll
        for (int j = 0; j < 8; ++j) {
            const float v = lr[4 + gi * 8 + j] * rs + be[gi * 8 + j];
            if (v > v0) { v1 = v0; i1 = i0; v0 = v; i0 = j; } else if (v > v1) { v1 = v; i1 = j; }
        }
        const float ex = __expf(v1 - v0);
        w0 = gw / (1.f + ex); w1 = gw * ex / (1.f + ex);
        e0 = gi * 8 + i0; e1 = gi * 8 + i1;
        r0 = atomicAdd(&hist[e0], 1); r1 = atomicAdd(&hist[e1], 1);
    }
    __syncthreads();
    if (tid < 32) hist[32 + tid] = hist[tid] ? atomicAdd(&w.cnt[L * 64 + tid], hist[tid]) : 0;
    __syncthreads();
    if (tid < 128) {
        const int tok = m0 + tid;
        const int p0 = hist[32 + e0] + r0, p1 = hist[32 + e1] + r1;
        w.elist[(size_t)e0 * NT + p0] = tok * 2; w.ewt[(size_t)e0 * NT + p0] = w0;
        w.elist[(size_t)e1 * NT + p1] = tok * 2 + 1; w.ewt[(size_t)e1 * NT + p1] = w1;
    }
    __syncthreads();
}
__device__ void eraw_item(const Params& P, int L, int item, char* lds, const int tid_in) {
    int tid = tid_in; asm volatile("" : "+v"(tid));
    const WS& w = P.w; const nv::Inputs& in = P.in;
    const int lane = tid & 63, wid = tid >> 6;
    float* T = (float*)lds;
    const int mt = item >> 3, nt = item & 7, m0 = mt * 128, n0 = nt * 128;
    {
        const float* arow[4]; const bf16_t* wrow[4];
#pragma unroll
        for (int i = 0; i < 4; ++i) {
            arow[i] = in.p + ((size_t)L * NT + m0 + (tid >> 3) + 32 * i) * 256 + (tid & 7) * 8;
            wrow[i] = w.Wpt + L * WP_SZ + (size_t)(n0 + (tid >> 3) + 32 * i) * 256 + (tid & 7) * 8;
        }
        f32x16 acc[2][2]; acc_zero(acc);
        float ss[4] = {0.f, 0.f, 0.f, 0.f};
        gemm_mainloop<float, false>(acc, arow, wrow, 4, lds, ss, tid);
        acc_to_lds(acc, T, tid);
    }
#pragma unroll 2
    for (int rr = 0; rr < 32; ++rr) {
        const int row = wid * 32 + rr;
        const float2 x = *(const float2*)(T + row * TLD + 2 * lane);
        *(unsigned*)(w.erb + (size_t)(m0 + row) * 1024 + n0 + 2 * lane) = pack2(x.x, x.y);
        float sq = x.x * x.x + x.y * x.y;
        sq = grp_sum32(sq); sq += __shfl_xor(sq, 32);
        if (lane == 0) w.essq[(size_t)(m0 + row) * 8 + nt] = sq;
    }
    __syncthreads();
}
__device__ void phase_router(const Params& P, int L, char* lds) {
    const int tid = opaque_tid();
    for (int item = blockIdx.x; item < 128 + 1024; item += gridDim.x) {
        if (item < 128) router_item(P, L, item, lds, tid);
        else eraw_item(P, L, item - 128, lds, tid);
    }
}

constexpr int TT_OFF = STAT_OFF + 512;
__device__ __forceinline__ void moe_table(const Params& P, int L, char* lds, const int tid) {
    int* tt = (int*)(lds + TT_OFF);
    if (tid == 0) {
        int o = 0, t = 0;
        for (int e = 0; e < 32; ++e) { const int c = P.w.cnt[L * 64 + e]; tt[e] = o; tt[40 + e] = t; o += c; t += (c + 127) >> 7; }
        tt[32] = o; tt[72] = t;
    }
    __syncthreads();
}
__device__ __forceinline__ void moe_find(const int* tt, int tile, int& e, int& t) {
    int lo = 0;
#pragma unroll 1
    for (int k = 0; k < 32; ++k) if (tt[40 + k] <= tile) lo = k;
    e = lo; t = tile - tt[40 + lo];
}
__device__ void phase_moe_up(const Params& P, int L, char* lds) {
    const WS& w = P.w;
    const int tid0 = opaque_tid();
    float* T = (float*)lds; float* stat = (float*)(lds + STAT_OFF); const int* tt = (const int*)(lds + TT_OFF);
    moe_table(P, L, lds, tid0);
    const int ntiles = tt[72];
    for (int item = blockIdx.x; item < ntiles * 4; item += gridDim.x) {
        int tid = tid0; asm volatile("" : "+v"(tid));
        const int lane = tid & 63, wid = tid >> 6;
        const int tile = item >> 2, nt = item & 3;
        int e, t; moe_find(tt, tile, e, t);
        const int cnt = P.w.cnt[L * 64 + e], rbase = tt[e] + t * 128, nrows = min(128, cnt - t * 128);
        {
            const bf16_t* arow[4]; const bf16_t* wrow[4];
#pragma unroll
            for (int i = 0; i < 4; ++i) {
                const int r = (tid >> 3) + 32 * i;
                const int ent = w.elist[(size_t)e * NT + t * 128 + (r < nrows ? r : 0)];
                arow[i] = w.hb1 + (size_t)(ent >> 1) * 1024 + (tid & 7) * 8;
                wrow[i] = w.Wgut + L * WGU_SZ + ((size_t)e * 512 + nt * 128 + r) * 1024 + (tid & 7) * 8;
            }
            f32x16 acc[2][2]; acc_zero(acc);
            float ss[4] = {0.f, 0.f, 0.f, 0.f};
            gemm_mainloop<bf16_t, true>(acc, arow, wrow, 16, lds, ss, tid);
            publish_rowstat(ss, stat, 1.f / 1024.f, true, tid);
            acc_to_lds(acc, T, tid);
        }
#pragma unroll 2
        for (int rr = 0; rr < 32; ++rr) {
            const int row = wid * 32 + rr; const float rs = stat[row];
            const float2 x = *(const float2*)(T + row * TLD + 2 * lane);
            const float g = x.x * rs, u = x.y * rs;
            if (row < nrows) w.hbuf[(size_t)(rbase + row) * 256 + nt * 64 + lane] = (bf16_t)f2bf(g * sigmoid_(g) * u);
        }
        __syncthreads();
    }
}
__device__ void phase_moe_down(const Params& P, int L, char* lds) {
    const WS& w = P.w;
    const int tid0 = opaque_tid();
    float* T = (float*)lds; const int* tt = (const int*)(lds + TT_OFF);
    moe_table(P, L, lds, tid0);
    const int ntiles = tt[72];
    for (int item = blockIdx.x; item < ntiles * 8; item += gridDim.x) {
        int tid = tid0; asm volatile("" : "+v"(tid));
        const int lane = tid & 63, wid = tid >> 6;
        const int tile = item >> 3, nt = item & 7;
        int e, t; moe_find(tt, tile, e, t);
        const int cnt = P.w.cnt[L * 64 + e], rbase = tt[e] + t * 128, nrows = min(128, cnt - t * 128);
        {
            const bf16_t* arow[4]; const bf16_t* wrow[4];
#pragma unroll
            for (int i = 0; i < 4; ++i) {
                const int r = (tid >> 3) + 32 * i;
                arow[i] = w.hbuf + (size_t)(rbase + (r < nrows ? r : 0)) * 256 + (tid & 7) * 8;
                wrow[i] = w.Wdt + L * WD_SZ + ((size_t)e * 1024 + nt * 128 + r) * 256 + (tid & 7) * 8;
            }
            f32x16 acc[2][2]; acc_zero(acc);
            float ss[4] = {0.f, 0.f, 0.f, 0.f};
            gemm_mainloop<bf16_t, false>(acc, arow, wrow, 4, lds, ss, tid);
            acc_to_lds(acc, T, tid);
        }
#pragma unroll 2
        for (int rr = 0; rr < 32; ++rr) {
            const int row = wid * 32 + rr;
            if (row < nrows) {
                const int ent = w.elist[(size_t)e * NT + t * 128 + row]; const float wt = w.ewt[(size_t)e * NT + t * 128 + row];
                const float2 x = *(const float2*)(T + row * TLD + 2 * lane);
                *(unsigned*)(w.contrib + (size_t)ent * 1024 + nt * 128 + 2 * lane) = pack2(x.x * wt, x.y * wt);
            }
        }
        __syncthreads();
    }
}

__device__ void phase_ple(const Params& P, int L, char* lds) {
    const WS& w = P.w; const nv::Inputs& in = P.in;
    const int tid0 = opaque_tid();
    float* T = (float*)lds; float* stat = (float*)(lds + STAT_OFF);
    for (int item = blockIdx.x; item < 128 * 8; item += gridDim.x) {
        int tid = tid0; asm volatile("" : "+v"(tid));
        const int lane = tid & 63, wid = tid >> 6;
        const int mt = item >> 3, nt = item & 7, m0 = mt * 128, n0 = nt * 128;
        {
            Rows3 rows; const bf16_t* wrow[4];
#pragma unroll
            for (int i = 0; i < 4; ++i) {
                const size_t tok = m0 + (tid >> 3) + 32 * i;
                rows.p[0][i] = w.hb1 + tok * 1024 + (tid & 7) * 8;
                rows.p[1][i] = w.contrib + (tok * 2) * 1024 + (tid & 7) * 8;
                wrow[i] = w.Wgt + L * WG_SZ + (size_t)(n0 + (tid >> 3) + 32 * i) * 1024 + (tid & 7) * 8;
            }
            f32x16 acc[2][2]; acc_zero(acc);
            float ss[4] = {0.f, 0.f, 0.f, 0.f};
            gemm_mainloop<bf16x3_t, true, 1>(acc, rows, wrow, 16, lds, ss, tid);
            publish_rowstat(ss, stat, 1.f / 1024.f, true, tid);
            acc_to_lds(acc, T, tid);
        }
        const float2 pg = *(const float2*)(in.ple_post_norm_g + L * 1024 + n0 + 2 * lane);
#pragma unroll 2
        for (int rr = 0; rr < 32; ++rr) {
            const int row = wid * 32 + rr; const float rs = stat[row]; const size_t tok = m0 + row;
            const float4 q0 = *(const float4*)(w.essq + tok * 8), q1 = *(const float4*)(w.essq + tok * 8 + 4);
            const float re = rsqrtf((q0.x + q0.y + q0.z + q0.w + q1.x + q1.y + q1.z + q1.w) * (1.f / 1024.f) + EPS);
            const float2 x = *(const float2*)(T + row * TLD + 2 * lane);
            const size_t off = tok * 1024 + n0 + 2 * lane;
            const unsigned c0 = *(const unsigned*)(w.contrib + (tok * 2) * 1024 + n0 + 2 * lane), c1 = *(const unsigned*)(w.contrib + (tok * 2 + 1) * 1024 + n0 + 2 * lane);
            const unsigned er = *(const unsigned*)(w.erb + off);
            float2 hv = *(const float2*)(P.h + off);
            hv.x += bflo(c0) + bflo(c1) + sigmoid_(x.x * rs) * (bflo(er) * re * pg.x);
            hv.y += bfhi(c0) + bfhi(c1) + sigmoid_(x.y * rs) * (bfhi(er) * re * pg.y);
            *(float2*)(P.h + off) = hv;
            *(unsigned*)(w.hb + off) = pack2(hv.x, hv.y);
        }
        __syncthreads();
    }
}

}
namespace fx {
constexpr int LDS_BYTES = LDS_GEMM_BYTES;
__global__ void __launch_bounds__(256, 2) k_run(Params P, int ph_lo, int ph_hi) {
    extern __shared__ __attribute__((aligned(16))) char lds[];
    for (int ph = ph_lo; ph < ph_hi; ++ph) {
        if (ph == 0) phase_prep(P, lds);
        else {
            const int L = (ph - 1) >> 3, s = (ph - 1) & 7;
            switch (s) {
                case 0: phase_zgemm(P, L, lds); break;
                case 1: phase_mix(P, L, lds); break;
                case 2: phase_attn(P, L, lds); break;
                case 3: phase_oproj(P, L, lds); break;
                case 4: phase_router(P, L, lds); break;
                case 5: phase_moe_up(P, L, lds); break;
                case 6: phase_moe_down(P, L, lds); break;
                case 7: phase_ple(P, L, lds); break;
                default: break;
            }
        }
    }
}
}
#ifndef HY2_MOE
#define HY2_MOE 0
#endif
#ifndef HY2_PLE
#define HY2_PLE 0
#endif
namespace nv {
constexpr int NS2 = 512;
struct Bufs2 { float *nb, *zz, *yy; int *cnt, *off, *tok_e, *tok_pos; float* tok_w; int* arow; float* rw; };
static size_t bufs2_bytes() { return (size_t)NS2 * 3 * 1024 * 4 + 4096 + (size_t)NS2 * 2 * 4 * 5; }
static Bufs2 make_bufs2(char* ws) {
    Bufs2 b{}; b.nb = (float*)ws; b.zz = b.nb + (size_t)NS2 * 1024; b.yy = b.zz + (size_t)NS2 * 1024;
    b.cnt = (int*)(b.yy + (size_t)NS2 * 1024); b.off = b.cnt + 64; b.tok_e = b.off + 64; b.tok_pos = b.tok_e + 2 * NS2; b.tok_w = (float*)(b.tok_pos + 2 * NS2);
    b.arow = (int*)(b.tok_w + 2 * NS2); b.rw = (float*)(b.arow + 2 * NS2);
    return b;
}
static void moe2(const Inputs& in, int L, float* h, int t0, const Bufs2& b, hipStream_t s) {
    float* hh = h + (size_t)t0 * 1024; float* hbg = b.zz; float* hbu = b.zz + (size_t)2 * NS2 * 256;
    hipLaunchKernelGGL(k_rmsnorm, dim3(NS2 / 4), dim3(256), 0, s, hh, 1024, in.ffn_norm_g + L * 1024, b.nb, 1024, 1024, NS2);
    hipMemsetAsync(b.cnt, 0, 64 * 4, s);
    hipLaunchKernelGGL(k_router, dim3(NS2 / 4), dim3(256), 0, s, b.nb, in.router_group_w + L * 1024 * 4, in.router_group_b + L * 4,
                       in.router_expert_w + L * 1024 * 32, in.router_expert_b + L * 32, b.cnt, b.tok_e, b.tok_pos, b.tok_w, NS2);
    hipLaunchKernelGGL(k_moe_offsets, dim3(1), dim3(64), 0, s, b.cnt, b.off);
    hipLaunchKernelGGL(k_moe_fill, dim3(2 * NS2 / 256), dim3(256), 0, s, b.off, b.tok_e, b.tok_pos, b.tok_w, b.arow, b.rw, NS2);
    GemmP p{}; p.A = b.nb; p.lda = 1024; p.B = in.moe_w_gate + (size_t)L * 32 * 1024 * 256; p.ldb = 256; p.C = hbg; p.ldc = 256;
    p.M = 0; p.N = 256; p.K = 1024; p.seg_off = b.off; p.seg_cnt = b.cnt; p.strideB = 1024L * 256; p.arow = b.arow; p.mode = 0;
    hipLaunchKernelGGL(k_gemm, dim3(4, NS2 / 64, 32), dim3(256), 0, s, p);
    p.B = in.moe_w_up + (size_t)L * 32 * 1024 * 256; p.C = hbu;
    hipLaunchKernelGGL(k_gemm, dim3(4, NS2 / 64, 32), dim3(256), 0, s, p);
    hipLaunchKernelGGL(k_silu_mul, dim3(2 * NS2 * 256 / 256), dim3(256), 0, s, hbg, hbu, (long)2 * NS2 * 256);
    GemmP d{}; d.A = hbg; d.lda = 256; d.B = in.moe_w_down + (size_t)L * 32 * 256 * 1024; d.ldb = 1024; d.C = hh; d.ldc = 1024;
    d.M = 0; d.N = 1024; d.K = 256; d.seg_off = b.off; d.seg_cnt = b.cnt; d.strideB = 256L * 1024; d.arow = nullptr; d.mode = 2;
    d.crow = b.arow; d.rw = b.rw;
    hipLaunchKernelGGL(k_gemm, dim3(16, NS2 / 64, 32), dim3(256), 0, s, d);
}
static void ple2(const Inputs& in, int L, float* h, int t0, const Bufs2& b, hipStream_t s) {
    float* hh = h + (size_t)t0 * 1024;
    hipLaunchKernelGGL(k_rmsnorm, dim3(NS2 / 4), dim3(256), 0, s, hh, 1024, in.ple_norm_g + L * 1024, b.nb, 1024, 1024, NS2);
    gemm(s, b.nb, 1024, in.ple_gate_w + (size_t)L * 1024 * 1024, 1024, b.zz, 1024, NS2, 1024, 1024, nullptr, 0);
    gemm(s, in.p + ((size_t)L * 16384 + t0) * 256, 256, in.ple_proj_w + (size_t)L * 256 * 1024, 1024, b.yy, 1024, NS2, 1024, 256, nullptr, 0);
    hipLaunchKernelGGL(k_ple_final, dim3(NS2 / 4), dim3(256), 0, s, hh, b.zz, b.yy, in.ple_post_norm_g + L * 1024, NS2);
}
}
__global__ void k_shim_combine(fx::Params P) {
    size_t i = (size_t)blockIdx.x * blockDim.x + threadIdx.x;
    if (i >= (size_t)fx::NT * 512) return;
    const size_t tok = i / 512, c2 = i % 512;
    const unsigned a = *(const unsigned*)(P.w.contrib + (tok * 2) * 1024 + 2 * c2), b = *(const unsigned*)(P.w.contrib + (tok * 2 + 1) * 1024 + 2 * c2);
    float2* hp = (float2*)(P.h + tok * 1024 + 2 * c2); float2 hv = *hp;
    hv.x += fx::bflo(a) + fx::bflo(b); hv.y += fx::bfhi(a) + fx::bfhi(b); *hp = hv;
}
extern "C" void kernel_launch(void* const* d_in, const int* in_sizes, int n_in, void* d_out, int out_size, void* d_ws, size_t ws_size,
                              hipStream_t stream) {
    nv::Inputs in{};
    in.x = (const float*)d_in[0]; in.p = (const float*)d_in[1]; in.positions = (const int*)d_in[2];
    const float** f = &in.mix_norm_g;
    for (int i = 0; i < 32; ++i) f[i] = (const float*)d_in[3 + i];
    size_t used = 0;
    fx::WS w = fx::make_ws((char*)d_ws, used);
    static int grid = 0;
    if (grid == 0) {
        if (used + nv::bufs2_bytes() > ws_size) { fprintf(stderr, "workspace too small: need %zu + %zu, have %zu\n", used, nv::bufs2_bytes(), ws_size); grid = -1; return; }
        if (hipFuncSetAttribute((const void*)fx::k_run, hipFuncAttributeMaxDynamicSharedMemorySize, fx::LDS_BYTES) != hipSuccess) { fprintf(stderr, "hipFuncSetAttribute failed\n"); grid = -1; return; }
        int dev = 0, cus = 0, per_cu = 0;
        hipGetDevice(&dev); hipDeviceGetAttribute(&cus, hipDeviceAttributeMultiprocessorCount, dev);
        hipOccupancyMaxActiveBlocksPerMultiprocessor(&per_cu, (const void*)fx::k_run, 256, fx::LDS_BYTES);
        if (per_cu > 2) per_cu = 2;
        if (per_cu < 1) { fprintf(stderr, "occupancy query says %d blocks/CU\n", per_cu); grid = -1; return; }
        grid = cus * per_cu;
    }
    if (grid < 0) return;
    nv::Bufs2 b = nv::make_bufs2((char*)d_ws + used);
    fx::Params P{}; P.in = in; P.h = (float*)d_out; P.w = w;
    float* h = (float*)d_out;
    auto run = [&](int ph) { hipLaunchKernelGGL(fx::k_run, dim3(grid), dim3(256), fx::LDS_BYTES, stream, P, ph, ph + 1); };
    hipMemsetAsync(w.cnt, 0, 128 * 4, stream);
    run(0);
    for (int L = 0; L < 2; ++L) {
        for (int s = 0; s < 4; ++s) run(1 + 8 * L + s);
        if (HY2_MOE) {
            for (int s = 4; s < 7; ++s) run(1 + 8 * L + s);
            if (!HY2_PLE) hipLaunchKernelGGL(k_shim_combine, dim3(fx::NT * 512 / 256), dim3(256), 0, stream, P);
        } else {
            for (int sb = 0; sb < fx::NT / nv::NS2; ++sb) nv::moe2(in, L, h, sb * nv::NS2, b, stream);
        }
        if (HY2_PLE) run(1 + 8 * L + 7);
        else {
            for (int sb = 0; sb < fx::NT / nv::NS2; ++sb) nv::ple2(in, L, h, sb * nv::NS2, b, stream);
            if (L == 0) hipLaunchKernelGGL(fx::k_shim_hb, dim3(fx::NT * 1024 / 4 / 256), dim3(256), 0, stream, P);
        }
    }
}
```

```cpp
#include <hip/hip_runtime.h>
#include <hip/hip_bf16.h>
#include <stdint.h>
#include <cstdio>
namespace nv {
struct Inputs {
    const float *x, *p; const int* positions;
    const float *mix_norm_g, *w_in, *sgu_ln_g, *sgu_ln_b, *sgu_w, *sgu_b, *conv_w, *conv_b, *conv_ln_g, *conv_ln_b, *conv_pw_w, *conv_pw_b,
        *q_a_norm_g, *w_uq, *kv_a_norm_g, *w_ukv, *q_norm_g, *k_norm_g, *branch_norm_g, *w_o, *ffn_norm_g, *router_group_w, *router_group_b,
        *router_expert_w, *router_expert_b, *moe_w_gate, *moe_w_up, *moe_w_down, *ple_norm_g, *ple_gate_w, *ple_proj_w, *ple_post_norm_g;
};
}
namespace fx {

typedef unsigned short bf16_t;
typedef short bf16x8 __attribute__((ext_vector_type(8)));
typedef float f32x16 __attribute__((ext_vector_type(16)));
typedef float f32x4 __attribute__((ext_vector_type(4)));

constexpr int NT = 16384, SEQ = 2048, DM = 1024, NB = 8;
constexpr int ZN = 1536;
constexpr float EPS = 1e-6f;

typedef __bf16 bf16v2_t __attribute__((ext_vector_type(2)));
typedef float f32v2_t __attribute__((ext_vector_type(2)));
__device__ __forceinline__ unsigned pack2(float lo, float hi) {
    f32v2_t v; v.x = lo; v.y = hi;
    bf16v2_t b = __builtin_convertvector(v, bf16v2_t);
    return __builtin_bit_cast(unsigned, b);
}
__device__ __forceinline__ unsigned f2bf(float f) { return pack2(f, 0.f) & 0xffffu; }
__device__ __forceinline__ float bf2f(unsigned short b) { return __uint_as_float(((unsigned)b) << 16); }
__device__ __forceinline__ float bflo(unsigned u) { return __uint_as_float(u << 16); }
__device__ __forceinline__ float bfhi(unsigned u) { return __uint_as_float(u & 0xffff0000u); }
__device__ __forceinline__ float sigmoid_(float x) { return 1.f / (1.f + __expf(-x)); }
__device__ __forceinline__ float gelu_tanh_(float x) {
    float u = 0.7978845608028654f * (x + 0.044715f * x * x * x);
    return x * sigmoid_(2.f * u);
}
__device__ __forceinline__ int opaque_tid() { int t = threadIdx.x; asm volatile("" : "+v"(t)); return t; }
__device__ __forceinline__ float xor32(float v) { return v + __shfl_xor(v, 32); }

struct WS {
    bf16_t *W1t, *Wuqt, *Wukvt, *Wpwt, *Wot, *Wrt, *Wgut, *Wdt, *Wgt, *Wpt, *Wsm;
    bf16_t *hb;
    bf16_t *hb1;
    bf16_t *ub;
    bf16_t *vT;
    bf16_t *ygb;
    bf16_t *cqb;
    bf16_t *ckvb;
    bf16_t *kpeb;
    bf16_t *Qb;
    bf16_t *Knb;
    bf16_t *VTb;
    bf16_t *yb;
    float  *ssq;
    float  *cs;
    bf16_t *erb;
    float  *essq;
    bf16_t *hbuf;
    bf16_t *contrib;
    int    *cnt;
    int    *elist;
    float  *ewt;
    unsigned *bar;
};
constexpr size_t W1_SZ = (size_t)ZN * 1024, WUQ_SZ = 768 * 256, WUKV_SZ = 1024 * 128, WPW_SZ = 256 * 256, WO_SZ = 1024 * 1024, WR_SZ = 128 * 1024,
                 WGU_SZ = (size_t)32 * 512 * 1024, WD_SZ = (size_t)32 * 1024 * 256, WG_SZ = 1024 * 1024, WP_SZ = 1024 * 256, WSM_SZ = 4 * 128 * 128;

struct Params {
    nv::Inputs in;
    float* h;
    WS w;
    float* zf;
    float* yf;
};

static WS make_ws(char* base, size_t& used) {
    WS w{}; size_t o = 0;
    auto take = [&](size_t bytes) { char* p = base + o; o += (bytes + 255) & ~(size_t)255; return p; };
    w.W1t = (bf16_t*)take(2 * W1_SZ * 2);   w.Wuqt = (bf16_t*)take(2 * WUQ_SZ * 2); w.Wukvt = (bf16_t*)take(2 * WUKV_SZ * 2);
    w.Wpwt = (bf16_t*)take(2 * WPW_SZ * 2); w.Wot = (bf16_t*)take(2 * WO_SZ * 2);   w.Wrt = (bf16_t*)take(2 * WR_SZ * 2);
    w.Wgut = (bf16_t*)take(2 * WGU_SZ * 2); w.Wdt = (bf16_t*)take(2 * WD_SZ * 2);   w.Wgt = (bf16_t*)take(2 * WG_SZ * 2);
    w.Wpt = (bf16_t*)take(2 * WP_SZ * 2);   w.Wsm = (bf16_t*)take(2 * WSM_SZ * 2);
    w.hb = (bf16_t*)take((size_t)NT * 1024 * 2); w.hb1 = (bf16_t*)take((size_t)NT * 1024 * 2);
    w.ssq = (float*)take((size_t)NT * 16 * 4); w.cs = (float*)take((size_t)NT * 32 * 4);
    w.essq = (float*)take((size_t)NT * 8 * 4);
    w.cnt = (int*)take(2 * 64 * 4);
    w.elist = (int*)take((size_t)32 * NT * 4); w.ewt = (float*)take((size_t)32 * NT * 4);
    w.bar = (unsigned*)take(4096 * 4);
    const size_t region = o;
    w.ub = (bf16_t*)take((size_t)NT * 256 * 2); w.vT = (bf16_t*)take((size_t)NT * 256 * 2); w.ygb = (bf16_t*)take((size_t)NT * 256 * 2);
    w.cqb = (bf16_t*)take((size_t)NT * 256 * 2); w.ckvb = (bf16_t*)take((size_t)NT * 128 * 2); w.kpeb = (bf16_t*)take((size_t)NT * 32 * 2);
    w.Qb = (bf16_t*)take((size_t)NT * 768 * 2); w.Knb = (bf16_t*)take((size_t)NT * 512 * 2); w.VTb = (bf16_t*)take((size_t)NT * 512 * 2);
    w.yb = (bf16_t*)take((size_t)NT * 1024 * 2);
    const size_t region_end = o;
    o = region;
    w.contrib = (bf16_t*)take((size_t)NT * 2 * 1024 * 2);
    w.hbuf = (bf16_t*)take((size_t)(2 * NT + 128) * 256 * 2);
    w.erb = (bf16_t*)take((size_t)NT * 1024 * 2);
    if (o > region_end) { fprintf(stderr, "make_ws: overlay exceeds mixer region\n"); }
    o = region_end;
    used = o;
    return w;
}

__device__ const double ROPE_INV[16] = {1.0, 0.5623413251903491, 0.31622776601683794, 0.1778279410038923, 0.1, 0.05623413251903491, 0.03162277660168379, 0.01778279410038923, 0.01, 0.005623413251903491, 0.0031622776601683794, 0.0017782794100389228, 0.001, 0.0005623413251903491, 0.00031622776601683794, 0.00017782794100389227};
__device__ __forceinline__ void rope_cs(int pos, int j, float& c, float& s) {
    const double ang = (double)pos * ROPE_INV[j];
    const double n = rint(ang * 0.15915494309189535);
    double r = fma(-n, 6.283185307179586, ang); r = fma(-n, 2.4492935982947064e-16, r);
    const double r2 = r * r;
    double sc = 1.0, ss = 1.0;
    double tc = 1.0, ts = 1.0;
#pragma unroll
    for (int k = 1; k <= 14; ++k) {
        tc *= -r2 / (double)((2 * k - 1) * (2 * k)); sc += tc;
        ts *= -r2 / (double)((2 * k) * (2 * k + 1)); ss += ts;
    }
    c = (float)sc; s = (float)(ss * r);
}

enum { MAP_ID = 0, MAP_W1 = 1, MAP_UQ = 2, MAP_UKV = 3, MAP_GU = 4, MAP_ROUTER = 5 };
template <int MAP> __device__ __forceinline__ int srccol(int n) {
    if (MAP == MAP_W1) {
        if (n < 512) return n;
        if (n < 1024) { int m = n - 512; return (m & 1) ? (768 + (m >> 1)) : (512 + (m >> 1)); }
        if (n < 1440) return n;
        return -1;
    } else if (MAP == MAP_UQ) {
        if (n < 512) return (n >> 6) * 96 + (n & 63);
        int m = n - 512; return (m >> 5) * 96 + 64 + (m & 31);
    } else if (MAP == MAP_UKV) {
        if (n < 512) return (n >> 6) * 128 + (n & 63);
        int m = n - 512; return (m >> 6) * 128 + 64 + (m & 63);
    } else if (MAP == MAP_GU) {
        return (n & 1) ? (256 + (n >> 1)) : (n >> 1);
    }
    return n;
}
template <int MAP>
__device__ void prep_tile(const float* src, int ld, const float* src2, int split, const float* scale, bf16_t* dst, int K, int n0, int k0, int N, float* tile  , const int tid) {
    __syncthreads();
    for (int i = tid; i < 64 * 64; i += 256) {
        int kk = i >> 6, nn = i & 63;
        int n = n0 + nn; float v = 0.f;
        if (n < N) {
            int c = srccol<MAP>(n);
            if (c >= 0) {
                const float* s = src; int cc = c;
                if (src2 && c >= split) { s = src2; cc = c - split; }
                v = s[(size_t)(k0 + kk) * ld + cc];
                if (scale) v *= scale[k0 + kk];
            }
        }
        tile[kk * 65 + nn] = v;
    }
    __syncthreads();
    for (int i = tid; i < 64 * 32; i += 256) {
        int nn = i >> 5, k2 = (i & 31) * 2;
        if (n0 + nn < N) {
            unsigned pk = pack2(tile[k2 * 65 + nn], tile[(k2 + 1) * 65 + nn]);
            *(unsigned*)(dst + (size_t)(n0 + nn) * K + k0 + k2) = pk;
        }
    }
}

template <int MAP>
__device__ void prep_job(const float* src, int ld, size_t src_stride, const float* src2, int split, const float* scale, bf16_t* dst, size_t dst_stride,
                         int K, int N, int nbatch, float* tile, int& rot, const int tid) {
    const int tn = (N + 63) / 64, tk = K / 64, per = tn * tk, total = per * nbatch, G = gridDim.x;
    for (int t = ((int)blockIdx.x - rot + G) % G; t < total; t += G) {
        const int e = t / per, tt = t % per;
        prep_tile<MAP>(src + (size_t)e * src_stride, ld, src2 ? src2 + (size_t)e * src_stride : nullptr, split, scale, dst + (size_t)e * dst_stride, K,
                       (tt % tn) * 64, (tt / tn) * 64, N, tile, tid);
    }
    rot = (rot + total) % G;
}

__device__ void phase_prep(const Params& P, char* lds) {
    float* tile = (float*)lds;
    const nv::Inputs& in = P.in; const WS& w = P.w;
    const int G = gridDim.x, bid = blockIdx.x, tid = opaque_tid();
    int rot = 0;
    for (int L = 0; L < 2; ++L) {
        prep_job<MAP_W1>(in.w_in + (size_t)L * 1024 * 1440, 1440, 0, nullptr, 0, in.mix_norm_g + L * 1024, w.W1t + L * W1_SZ, 0, 1024, ZN, 1, tile, rot, tid);
        prep_job<MAP_UQ>(in.w_uq + (size_t)L * 256 * 768, 768, 0, nullptr, 0, in.q_a_norm_g + L * 256, w.Wuqt + L * WUQ_SZ, 0, 256, 768, 1, tile, rot, tid);
        prep_job<MAP_UKV>(in.w_ukv + (size_t)L * 128 * 1024, 1024, 0, nullptr, 0, in.kv_a_norm_g + L * 128, w.Wukvt + L * WUKV_SZ, 0, 128, 1024, 1, tile, rot, tid);
        prep_job<MAP_ID>(in.conv_pw_w + (size_t)L * 256 * 256, 256, 0, nullptr, 0, nullptr, w.Wpwt + L * WPW_SZ, 0, 256, 256, 1, tile, rot, tid);
        prep_job<MAP_ID>(in.w_o + (size_t)L * 1024 * 1024, 1024, 0, nullptr, 0, in.branch_norm_g + L * 1024, w.Wot + L * WO_SZ, 0, 1024, 1024, 1, tile, rot, tid);
        prep_job<MAP_ID>(in.ple_gate_w + (size_t)L * 1024 * 1024, 1024, 0, nullptr, 0, in.ple_norm_g + L * 1024, w.Wgt + L * WG_SZ, 0, 1024, 1024, 1, tile, rot, tid);
        prep_job<MAP_ID>(in.ple_proj_w + (size_t)L * 256 * 1024, 1024, 0, nullptr, 0, nullptr, w.Wpt + L * WP_SZ, 0, 256, 1024, 1, tile, rot, tid);
        prep_job<MAP_GU>(in.moe_w_gate + (size_t)L * 32 * 1024 * 256, 256, (size_t)1024 * 256, in.moe_w_up + (size_t)L * 32 * 1024 * 256, 256,
                         in.ffn_norm_g + L * 1024, w.Wgut + L * WGU_SZ, (size_t)512 * 1024, 1024, 512, 32, tile, rot, tid);
        prep_job<MAP_ID>(in.moe_w_down + (size_t)L * 32 * 256 * 1024, 1024, (size_t)256 * 1024, nullptr, 0, nullptr, w.Wdt + L * WD_SZ, (size_t)1024 * 256,
                         256, 1024, 32, tile, rot, tid);
        for (int i = bid * 256 + tid; i < 128 * 1024; i += G * 256) {
            int n = i >> 10, k = i & 1023; float v = 0.f;
            if (n < 4) v = in.router_group_w[(size_t)L * 1024 * 4 + k * 4 + n];
            else if (n < 36) v = in.router_expert_w[(size_t)L * 1024 * 32 + k * 32 + (n - 4)];
            v *= in.ffn_norm_g[L * 1024 + k];
            w.Wrt[L * WR_SZ + i] = (bf16_t)f2bf(v);
        }
        for (int i = bid * 256 + tid; i < 4 * 128 * 128; i += G * 256) {
            int jj = i & 127, ii = (i >> 7) & 127;
            float v = (jj <= ii) ? in.sgu_w[(size_t)L * WSM_SZ + i] : 0.f;
            w.Wsm[L * WSM_SZ + i] = (bf16_t)f2bf(v);
        }
    }
    for (int i = bid * 256 + tid; i < NT * 16; i += G * 256) {
        int t = i >> 4, j = i & 15;
        float c, sn; rope_cs(in.positions[t], j, c, sn);
        w.cs[t * 32 + j] = c; w.cs[t * 32 + 16 + j] = sn;
    }
    for (size_t i = (size_t)bid * 256 + tid; i < (size_t)NT * 1024 / 4; i += (size_t)G * 256) {
        float4 v = ((const float4*)in.x)[i];
        ((float4*)P.h)[i] = v;
        uint2 pk; pk.x = pack2(v.x, v.y); pk.y = pack2(v.z, v.w);
        ((uint2*)w.hb)[i] = pk;
    }
    for (int i = bid * 256 + tid; i < 128; i += G * 256) w.cnt[i] = 0;
}

__device__ __forceinline__ int lds_off(int row, int chunk) { return row * 128 + ((chunk ^ ((row >> 1) & 7)) << 4); }

template <typename AT> struct ARaw;
template <> struct ARaw<bf16_t> { uint4 v[4]; };
template <> struct ARaw<float> { float4 v[4][2]; };

__device__ __forceinline__ void a_load(ARaw<bf16_t>& r, const bf16_t* const (&rowp)[4], int koff) {
#pragma unroll
    for (int i = 0; i < 4; ++i) r.v[i] = *(const uint4*)(rowp[i] + koff);
}
__device__ __forceinline__ void a_load(ARaw<float>& r, const float* const (&rowp)[4], int koff) {
#pragma unroll
    for (int i = 0; i < 4; ++i) { r.v[i][0] = *(const float4*)(rowp[i] + koff); r.v[i][1] = *(const float4*)(rowp[i] + koff + 4); }
}
template <bool SUMSQ> __device__ __forceinline__ uint4 a_cvt(const uint4& v, float& ss) {
    if (SUMSQ) {
        float a;
        a = bflo(v.x); ss = fmaf(a, a, ss); a = bfhi(v.x); ss = fmaf(a, a, ss);
        a = bflo(v.y); ss = fmaf(a, a, ss); a = bfhi(v.y); ss = fmaf(a, a, ss);
        a = bflo(v.z); ss = fmaf(a, a, ss); a = bfhi(v.z); ss = fmaf(a, a, ss);
        a = bflo(v.w); ss = fmaf(a, a, ss); a = bfhi(v.w); ss = fmaf(a, a, ss);
    }
    return v;
}
template <bool SUMSQ> __device__ __forceinline__ void a_store(const ARaw<bf16_t>& r, char* ldsA, int tid, float (&ss)[4]) {
#pragma unroll
    for (int i = 0; i < 4; ++i) { uint4 v = a_cvt<SUMSQ>(r.v[i], ss[i]); *(uint4*)(ldsA + lds_off((tid >> 3) + 32 * i, tid & 7)) = v; }
}
template <bool SUMSQ> __device__ __forceinline__ void a_store(const ARaw<float>& r, char* ldsA, int tid, float (&ss)[4]) {
#pragma unroll
    for (int i = 0; i < 4; ++i) {
        const float4 a = r.v[i][0], b = r.v[i][1];
        if (SUMSQ) ss[i] += a.x * a.x + a.y * a.y + a.z * a.z + a.w * a.w + b.x * b.x + b.y * b.y + b.z * b.z + b.w * b.w;
        uint4 v; v.x = pack2(a.x, a.y); v.y = pack2(a.z, a.w); v.z = pack2(b.x, b.y); v.w = pack2(b.z, b.w);
        *(uint4*)(ldsA + lds_off((tid >> 3) + 32 * i, tid & 7)) = v;
    }
}

struct bf16x3_t {};
template <> struct ARaw<bf16x3_t> { uint4 a[4], b[4], c[4]; };
struct Rows3 { const bf16_t* p[2][4]; };
__device__ __forceinline__ void a_load(ARaw<bf16x3_t>& r, const Rows3& rows, int koff) {
#pragma unroll
    for (int i = 0; i < 4; ++i) { r.a[i] = *(const uint4*)(rows.p[0][i] + koff); r.b[i] = *(const uint4*)(rows.p[1][i] + koff); r.c[i] = *(const uint4*)(rows.p[1][i] + koff + 1024); }
}
__device__ __forceinline__ unsigned add3pk(unsigned a, unsigned b, unsigned c, float& ss) {
    const float lo = bflo(a) + bflo(b) + bflo(c), hi = bfhi(a) + bfhi(b) + bfhi(c);
    ss = fmaf(lo, lo, ss); ss = fmaf(hi, hi, ss);
    return pack2(lo, hi);
}
template <bool SUMSQ> __device__ __forceinline__ void a_store(const ARaw<bf16x3_t>& r, char* ldsA, int tid, float (&ss)[4]) {
#pragma unroll
    for (int i = 0; i < 4; ++i) {
        uint4 v;
        v.x = add3pk(r.a[i].x, r.b[i].x, r.c[i].x, ss[i]); v.y = add3pk(r.a[i].y, r.b[i].y, r.c[i].y, ss[i]);
        v.z = add3pk(r.a[i].z, r.b[i].z, r.c[i].z, ss[i]); v.w = add3pk(r.a[i].w, r.b[i].w, r.c[i].w, ss[i]);
        *(uint4*)(ldsA + lds_off((tid >> 3) + 32 * i, tid & 7)) = v;
    }
}

template <typename AT, bool SUMSQ, int SUNROLL = 4, typename AROWS>
__device__ __forceinline__ void gemm_mainloop(f32x16 (&acc)[2][2], const AROWS& arow, const bf16_t* const (&wrow)[4], int nkt, char* lds, float (&ss)[4], const int tid) {
    const int lane = tid & 63, wid = tid >> 6, wr = wid >> 1, wc = wid & 1;
    ARaw<AT> ra; ARaw<bf16_t> rb; float dummy[4] = {0.f, 0.f, 0.f, 0.f};
    a_load(ra, arow, 0); a_load(rb, wrow, 0);
    a_store<SUMSQ>(ra, lds, tid, ss); a_store<false>(rb, lds + 16384, tid, dummy);
    __syncthreads();
    const int fr = lane & 31, fh = lane >> 5;
#pragma unroll 1
    for (int kt = 0; kt < nkt; ++kt) {
        char* cur = lds + (kt & 1) * 32768;
        char* nxt = lds + ((kt + 1) & 1) * 32768;
        const bool more = (kt + 1 < nkt);
        if (more) { a_load(ra, arow, (kt + 1) * 64); a_load(rb, wrow, (kt + 1) * 64); }
#pragma unroll SUNROLL
        for (int s = 0; s < 4; ++s) {
            bf16x8 xa[2], wb[2];
#pragma unroll
            for (int i = 0; i < 2; ++i) xa[i] = *(const bf16x8*)(cur + lds_off(wr * 64 + i * 32 + fr, 2 * s + fh));
#pragma unroll
            for (int j = 0; j < 2; ++j) wb[j] = *(const bf16x8*)(cur + 16384 + lds_off(wc * 64 + j * 32 + fr, 2 * s + fh));
#pragma unroll
            for (int i = 0; i < 2; ++i)
#pragma unroll
                for (int j = 0; j < 2; ++j) acc[i][j] = __builtin_amdgcn_mfma_f32_32x32x16_bf16(wb[j], xa[i], acc[i][j], 0, 0, 0);
        }
        if (more) { a_store<SUMSQ>(ra, nxt, tid, ss); a_store<false>(rb, nxt + 16384, tid, dummy); }
        __syncthreads();
    }
}
__device__ __forceinline__ void acc_zero(f32x16 (&acc)[2][2]) {
#pragma unroll
    for (int i = 0; i < 2; ++i)
#pragma unroll
        for (int j = 0; j < 2; ++j)
#pragma unroll
            for (int r = 0; r < 16; ++r) acc[i][j][r] = 0.f;
}
__device__ __forceinline__ void publish_rowstat(float (&ss)[4], float* stat, float invK, bool as_rstd, const int tid) {
#pragma unroll
    for (int i = 0; i < 4; ++i) {
        float v = ss[i];
        v += __shfl_xor(v, 1); v += __shfl_xor(v, 2); v += __shfl_xor(v, 4);
        if ((tid & 7) == 0) stat[(tid >> 3) + 32 * i] = as_rstd ? rsqrtf(v * invK + EPS) : v;
    }
    __syncthreads();
}
__device__ __forceinline__ int nidx(int r, int fh) { return (r & 3) + 8 * (r >> 2) + 4 * fh; }
__device__ __forceinline__ void store4(bf16_t* p, float a, float b, float c, float d) {
    uint2 v; v.x = pack2(a, b); v.y = pack2(c, d); *(uint2*)p = v;
}

constexpr int TLD = 132;
constexpr int STAT_OFF = 128 * TLD * 4;
constexpr int LDS_GEMM_BYTES = STAT_OFF + 1024;
__device__ __forceinline__ void acc_to_lds(const f32x16 (&acc)[2][2], float* T, const int tid) {
    const int lane = tid & 63, wid = tid >> 6, wr = wid >> 1, wc = wid & 1, fr = lane & 31, fh = lane >> 5;
#pragma unroll
    for (int i = 0; i < 2; ++i)
#pragma unroll
        for (int j = 0; j < 2; ++j)
#pragma unroll
            for (int g = 0; g < 4; ++g) {
                float4 v; v.x = acc[i][j][4 * g]; v.y = acc[i][j][4 * g + 1]; v.z = acc[i][j][4 * g + 2]; v.w = acc[i][j][4 * g + 3];
                *(float4*)(T + (wr * 64 + i * 32 + fr) * TLD + wc * 64 + j * 32 + 8 * g + 4 * fh) = v;
            }
    __syncthreads();
}
__device__ __forceinline__ float grp_sum16(float v) { v += __shfl_xor(v, 1); v += __shfl_xor(v, 2); v += __shfl_xor(v, 4); v += __shfl_xor(v, 8); return v; }
__device__ __forceinline__ float grp_sum32(float v) { v = grp_sum16(v); v += __shfl_xor(v, 16); return v; }

}
namespace fx {

__device__ void phase_zgemm(const Params& P, int L, char* lds) {
    const WS& w = P.w; const nv::Inputs& in = P.in;
    const int tid0 = opaque_tid();
    float* T = (float*)lds; float* stat = (float*)(lds + STAT_OFF);
    const bf16_t* Wt = w.W1t + L * W1_SZ;
    const int nitems = 128 * 12;
    for (int item = blockIdx.x; item < nitems; item += gridDim.x) {
        int tid = tid0; asm volatile("" : "+v"(tid));
        const int lane = tid & 63, wid = tid >> 6;
        const int mt = item / 12, nt = item % 12, m0 = mt * 128, n0 = nt * 128;
        {
            const bf16_t* arow[4]; const bf16_t* wrow[4];
#pragma unroll
            for (int i = 0; i < 4; ++i) {
                arow[i] = w.hb + (size_t)(m0 + (tid >> 3) + 32 * i) * 1024 + (tid & 7) * 8;
                wrow[i] = Wt + (size_t)(n0 + (tid >> 3) + 32 * i) * 1024 + (tid & 7) * 8;
            }
            f32x16 acc[2][2]; acc_zero(acc);
            float ss[4] = {0.f, 0.f, 0.f, 0.f};
            gemm_mainloop<bf16_t, true>(acc, arow, wrow, 16, lds, ss, tid);
            publish_rowstat(ss, stat, 1.f / 1024.f, true, tid);
            acc_to_lds(acc, T, tid);
        }
        if (nt < 2) {
#pragma unroll 2
            for (int rr = 0; rr < 32; ++rr) {
                const int row = wid * 32 + rr; const float rs = stat[row];
                const float2 x = *(const float2*)(T + row * TLD + 2 * lane);
                *(unsigned*)(w.ub + (size_t)(m0 + row) * 256 + nt * 128 + 2 * lane) = pack2(gelu_tanh_(x.x * rs), gelu_tanh_(x.y * rs));
            }
        } else if (nt < 4) {
            const int hd = (nt - 2) * 2 + (lane >> 5);
            const float2 lg = *(const float2*)(in.sgu_ln_g + L * 256 + hd * 64 + 2 * (lane & 31));
            const float2 lb = *(const float2*)(in.sgu_ln_b + L * 256 + hd * 64 + 2 * (lane & 31));
#pragma unroll 2
            for (int rr = 0; rr < 32; ++rr) {
                const int row = wid * 32 + rr; const float rs = stat[row];
                float2 x = *(const float2*)(T + row * TLD + 2 * lane);
                x.x = gelu_tanh_(x.x * rs); x.y = gelu_tanh_(x.y * rs);
                const float mean = grp_sum32(x.x + x.y) * (1.f / 64.f);
                const float dx = x.x - mean, dy = x.y - mean;
                const float rv = rsqrtf(grp_sum32(dx * dx + dy * dy) * (1.f / 64.f) + EPS);
                float2 o; o.x = dx * rv * lg.x + lb.x; o.y = dy * rv * lg.y + lb.y;
                *(float2*)(T + row * TLD + 2 * lane) = o;
            }
            __syncthreads();
            {
                const int c = tid & 127, th = tid >> 7, hd2 = (nt - 2) * 2 + (c >> 6), d = c & 63;
                bf16_t* dst = w.vT + ((size_t)(mt * 4 + hd2) * 64 + d) * 128 + th * 64;
#pragma unroll 2
                for (int k8 = 0; k8 < 8; ++k8) {
                    float v[8];
#pragma unroll
                    for (int k = 0; k < 8; ++k) v[k] = T[(th * 64 + k8 * 8 + k) * TLD + c];
                    uint4 pk; pk.x = pack2(v[0], v[1]); pk.y = pack2(v[2], v[3]); pk.z = pack2(v[4], v[5]); pk.w = pack2(v[6], v[7]);
                    *(uint4*)(dst + k8 * 8) = pk;
                }
            }
        } else if (nt < 8) {
#pragma unroll 2
            for (int rr = 0; rr < 32; ++rr) {
                const int row = wid * 32 + rr; const float rs = stat[row];
                const float2 x = *(const float2*)(T + row * TLD + 2 * lane);
                w.ygb[(size_t)(m0 + row) * 256 + (nt - 4) * 64 + lane] = (bf16_t)f2bf(x.x * rs * sigmoid_(x.y * rs));
            }
        } else if (nt < 11) {
            bf16_t* base; int ld, cb;
            if (nt < 10) { base = w.cqb; ld = 256; cb = (nt - 8) * 128; } else { base = w.ckvb; ld = 128; cb = 0; }
#pragma unroll 2
            for (int rr = 0; rr < 32; ++rr) {
                const int row = wid * 32 + rr; const float rs = stat[row];
                const float2 x = *(const float2*)(T + row * TLD + 2 * lane);
                *(unsigned*)(base + (size_t)(m0 + row) * ld + cb + 2 * lane) = pack2(x.x * rs, x.y * rs);
            }
        } else {
            const float2 kg = *(const float2*)(in.k_norm_g + L * 96 + 64 + 2 * (lane & 15));
#pragma unroll 2
            for (int rr = 0; rr < 32; ++rr) {
                const int row = wid * 32 + rr; const float rs = stat[row]; const int tok = m0 + row;
                float2 x = *(const float2*)(T + row * TLD + 2 * (lane & 15));
                x.x *= rs; x.y *= rs;
                const float rn = rsqrtf(grp_sum16(x.x * x.x + x.y * x.y) * (1.f / 32.f) + EPS);
                x.x *= rn * kg.x; x.y *= rn * kg.y;
                const float ox = __shfl_xor(x.x, 8), oy = __shfl_xor(x.y, 8);
                const int jj = (2 * lane) & 15;
                const float2 c = *(const float2*)(w.cs + (size_t)tok * 32 + jj), sn = *(const float2*)(w.cs + (size_t)tok * 32 + 16 + jj);
                float2 o;
                if ((lane & 8) == 0) { o.x = x.x * c.x - ox * sn.x; o.y = x.y * c.y - oy * sn.y; }
                else { o.x = x.x * c.x + ox * sn.x; o.y = x.y * c.y + oy * sn.y; }
                if (lane < 16) *(unsigned*)(w.kpeb + (size_t)tok * 32 + 2 * lane) = pack2(o.x, o.y);
            }
        }
        __syncthreads();
    }
}

__global__ void k_shim_z(Params P, int t0) {
    const WS& w = P.w;
    size_t idx = (size_t)blockIdx.x * blockDim.x + threadIdx.x;
    if (idx >= (size_t)2048 * 1440) return;
    int t = t0 + (int)(idx / 1440), c = (int)(idx % 1440);
    float v = 0.f;
    if (c < 256) v = bf2f(w.ub[(size_t)t * 256 + c]);
    else if (c < 512) { int cc = c - 256; v = bf2f(w.vT[((size_t)((t >> 7) * 4 + (cc >> 6)) * 64 + (cc & 63)) * 128 + (t & 127)]); }
    else if (c < 768) v = bf2f(w.ygb[(size_t)t * 256 + c - 512]);
    else if (c < 1024) v = 0.f;
    else if (c < 1280) v = bf2f(w.cqb[(size_t)t * 256 + c - 1024]);
    else if (c < 1408) v = bf2f(w.ckvb[(size_t)t * 128 + c - 1280]);
    else v = bf2f(w.kpeb[(size_t)t * 32 + c - 1408]);
    P.zf[idx] = v;
}
__global__ void k_shim_hb(Params P) {
    size_t i = (size_t)blockIdx.x * blockDim.x + threadIdx.x;
    if (i >= (size_t)NT * 1024 / 4) return;
    float4 v = ((const float4*)P.h)[i];
    uint2 pk; pk.x = pack2(v.x, v.y); pk.y = pack2(v.z, v.w);
    ((uint2*)P.w.hb)[i] = pk;
}

}
namespace fx {

constexpr float QSCALE = 0.10206207261596575f * 1.4426950408889634f;

__device__ void qkv_item(const Params& P, int L, int item, char* lds, const int tid_in) {
    int tid = tid_in; asm volatile("" : "+v"(tid));
    const WS& w = P.w; const nv::Inputs& in = P.in;
    const int lane = tid & 63, wid = tid >> 6;
    float* T = (float*)lds; float* stat = (float*)(lds + STAT_OFF);
    const bool isq = item < 128 * 6;
    int mt, nt;
    if (isq) { mt = item / 6; nt = item % 6; } else { const int it = item - 128 * 6; mt = it / 8; nt = it % 8; }
    const int m0 = mt * 128, n0 = nt * 128;
    const int K = isq ? 256 : 128;
    {
        const bf16_t* A = isq ? w.cqb : w.ckvb;
        const bf16_t* Wt = isq ? (w.Wuqt + L * WUQ_SZ) : (w.Wukvt + L * WUKV_SZ);
        const bf16_t* arow[4]; const bf16_t* wrow[4];
#pragma unroll
        for (int i = 0; i < 4; ++i) {
            arow[i] = A + (size_t)(m0 + (tid >> 3) + 32 * i) * K + (tid & 7) * 8;
            wrow[i] = Wt + (size_t)(n0 + (tid >> 3) + 32 * i) * K + (tid & 7) * 8;
        }
        f32x16 acc[2][2]; acc_zero(acc);
        float ss[4] = {0.f, 0.f, 0.f, 0.f};
        gemm_mainloop<bf16_t, true>(acc, arow, wrow, K / 64, lds, ss, tid);
        publish_rowstat(ss, stat, 1.f / (float)K, true, tid);
        acc_to_lds(acc, T, tid);
    }
    const int b = m0 >> 11, s0 = m0 & 2047;
    if (isq && nt < 4) {
        const int hd = nt * 2 + (lane >> 5), d = 2 * (lane & 31);
        const float2 g = *(const float2*)(in.q_norm_g + L * 96 + d);
        bf16_t* dst = w.Qb + ((size_t)(b * 8 + hd) * 2048 + s0) * 96 + d;
#pragma unroll 2
        for (int rr = 0; rr < 32; ++rr) {
            const int row = wid * 32 + rr; const float rs = stat[row];
            float2 x = *(const float2*)(T + row * TLD + 2 * lane);
            x.x *= rs; x.y *= rs;
            const float rn = rsqrtf(grp_sum32(x.x * x.x + x.y * x.y) * (1.f / 64.f) + EPS) * QSCALE;
            *(unsigned*)(dst + (size_t)row * 96) = pack2(x.x * rn * g.x, x.y * rn * g.y);
        }
    } else if (isq) {
        const int hd = (nt - 4) * 4 + (lane >> 4), d = 2 * (lane & 15);
        const float2 g = *(const float2*)(in.q_norm_g + L * 96 + 64 + d);
        bf16_t* dst = w.Qb + ((size_t)(b * 8 + hd) * 2048 + s0) * 96 + 64 + d;
        const int jj = d & 15;
#pragma unroll 2
        for (int rr = 0; rr < 32; ++rr) {
            const int row = wid * 32 + rr; const float rs = stat[row]; const int tok = m0 + row;
            float2 x = *(const float2*)(T + row * TLD + 2 * lane);
            x.x *= rs; x.y *= rs;
            const float rn = rsqrtf(grp_sum16(x.x * x.x + x.y * x.y) * (1.f / 32.f) + EPS);
            x.x *= rn * g.x; x.y *= rn * g.y;
            const float ox = __shfl_xor(x.x, 8), oy = __shfl_xor(x.y, 8);
            const float2 c = *(const float2*)(w.cs + (size_t)tok * 32 + jj), sn = *(const float2*)(w.cs + (size_t)tok * 32 + 16 + jj);
            float2 o;
            if ((lane & 8) == 0) { o.x = x.x * c.x - ox * sn.x; o.y = x.y * c.y - oy * sn.y; }
            else { o.x = x.x * c.x + ox * sn.x; o.y = x.y * c.y + oy * sn.y; }
            *(unsigned*)(dst + (size_t)row * 96) = pack2(o.x * QSCALE, o.y * QSCALE);
        }
    } else if (nt < 4) {
        const int hd = nt * 2 + (lane >> 5), d = 2 * (lane & 31);
        const float2 g = *(const float2*)(in.k_norm_g + L * 96 + d);
        bf16_t* dst = w.Knb + ((size_t)(b * 8 + hd) * 2048 + s0) * 64 + d;
#pragma unroll 2
        for (int rr = 0; rr < 32; ++rr) {
            const int row = wid * 32 + rr; const float rs = stat[row];
            float2 x = *(const float2*)(T + row * TLD + 2 * lane);
            x.x *= rs; x.y *= rs;
            const float rn = rsqrtf(grp_sum32(x.x * x.x + x.y * x.y) * (1.f / 64.f) + EPS);
            *(unsigned*)(dst + (size_t)row * 64) = pack2(x.x * rn * g.x, x.y * rn * g.y);
        }
    } else {
        const int c = tid & 127, th = tid >> 7, hd = (nt - 4) * 2 + (c >> 6), d = c & 63;
        bf16_t* dst = w.VTb + ((size_t)(b * 8 + hd) * 64 + d) * 2048 + s0 + th * 64;
#pragma unroll 2
        for (int k8 = 0; k8 < 8; ++k8) {
            float v[8];
#pragma unroll
            for (int k = 0; k < 8; ++k) { const int row = th * 64 + k8 * 8 + k; v[k] = T[row * TLD + c] * stat[row]; }
            uint4 pk; pk.x = pack2(v[0], v[1]); pk.y = pack2(v[2], v[3]); pk.z = pack2(v[4], v[5]); pk.w = pack2(v[6], v[7]);
            *(uint4*)(dst + k8 * 8) = pk;
        }
    }
    __syncthreads();
}

__device__ void sgu_item(const Params& P, int L, int mt, char* lds, const int tid_in) {
    int tid = tid_in; asm volatile("" : "+v"(tid));
    const WS& w = P.w; const nv::Inputs& in = P.in;
    const int lane = tid & 63, hd = tid >> 6, fr = lane & 31, fh = lane >> 5;
    float* red = (float*)lds;
    const bf16_t* vt = w.vT + (size_t)(mt * 4 + hd) * 64 * 128;
    const bf16_t* ws = w.Wsm + L * WSM_SZ + (size_t)hd * 128 * 128;
    const float* bs = in.sgu_b + L * 512 + hd * 128;
    const int m0 = mt * 128;
#pragma unroll 1
    for (int it = 0; it < 4; ++it) {
        f32x16 a0, a1;
#pragma unroll
        for (int r = 0; r < 16; ++r) { a0[r] = 0.f; a1[r] = 0.f; }
        const int nks = 2 * (it + 1);
        const bf16_t* bp = ws + (size_t)(it * 32 + fr) * 128 + 8 * fh;
        const bf16_t* ap0 = vt + (size_t)fr * 128 + 8 * fh;
        const bf16_t* ap1 = vt + (size_t)(32 + fr) * 128 + 8 * fh;
#pragma unroll 2
        for (int s = 0; s < nks; ++s) {
            const bf16x8 bfrag = *(const bf16x8*)(bp + 16 * s);
            const bf16x8 af0 = *(const bf16x8*)(ap0 + 16 * s), af1 = *(const bf16x8*)(ap1 + 16 * s);
            a0 = __builtin_amdgcn_mfma_f32_32x32x16_bf16(af0, bfrag, a0, 0, 0, 0);
            a1 = __builtin_amdgcn_mfma_f32_32x32x16_bf16(af1, bfrag, a1, 0, 0, 0);
        }
        const int i = it * 32 + fr, tok = m0 + i;
        const float bias = bs[i];
        float ssq = 0.f;
#pragma unroll
        for (int dt = 0; dt < 2; ++dt)
#pragma unroll
            for (int g = 0; g < 4; ++g) {
                const int d = dt * 32 + 8 * g + 4 * fh;
                const uint2 uu = *(const uint2*)(w.ub + (size_t)tok * 256 + hd * 64 + d);
                float o[4];
#pragma unroll
                for (int q = 0; q < 4; ++q) {
                    const float sv = (dt == 0 ? a0[4 * g + q] : a1[4 * g + q]) + bias;
                    const float uv = (q == 0) ? bflo(uu.x) : (q == 1) ? bfhi(uu.x) : (q == 2) ? bflo(uu.y) : bfhi(uu.y);
                    o[q] = uv * sv; ssq += o[q] * o[q];
                }
                store4(w.yb + (size_t)tok * 1024 + hd * 64 + d, o[0], o[1], o[2], o[3]);
            }
        ssq = xor32(ssq);
        if (fh == 0) red[hd * 128 + i] = ssq;
    }
    __syncthreads();
    if (tid < 128) w.ssq[(size_t)(m0 + tid) * 16 + 0] = red[tid] + red[128 + tid] + red[256 + tid] + red[384 + tid];
    __syncthreads();
}

__device__ __forceinline__ int yl_off(int row, int chunk) { return row * 512 + ((chunk ^ (row & 7)) << 4); }
__device__ void conv_item(const Params& P, int L, int ct, char* lds, const int tid_in) {
    int tid = tid_in; asm volatile("" : "+v"(tid));
    const WS& w = P.w; const nv::Inputs& in = P.in;
    const int lane = tid & 63, wid = tid >> 6, fr = lane & 31, fh = lane >> 5;
    bf16_t* ygs = (bf16_t*)lds; char* yl = lds; float* red = (float*)(lds + 49152);
    const int t0 = ct * 64, s0 = t0 & 2047;
    for (int i = tid; i < 94 * 32; i += 256) {
        const int r = i >> 5, ch = i & 31;
        uint4 v = make_uint4(0u, 0u, 0u, 0u);
        if (s0 + r - 30 >= 0) v = *(const uint4*)(w.ygb + (size_t)(t0 + r - 30) * 256 + ch * 8);
        *(uint4*)(ygs + r * 256 + ch * 8) = v;
    }
    __syncthreads();
    {
        const int c = tid;
        float wk[31];
#pragma unroll
        for (int k = 0; k < 31; ++k) wk[k] = in.conv_w[(size_t)L * 31 * 256 + k * 256 + c];
        const float cb = in.conv_b[L * 256 + c], lg = in.conv_ln_g[L * 256 + c], lb = in.conv_ln_b[L * 256 + c];
#pragma unroll 1
        for (int t = 0; t < 64; ++t) {
            float a = cb;
#pragma unroll
            for (int k = 0; k < 31; ++k) a = fmaf(wk[k], bf2f(ygs[(t + k) * 256 + c]), a);
            float mean = a;
#pragma unroll
            for (int o = 32; o > 0; o >>= 1) mean += __shfl_xor(mean, o);
            mean *= (1.f / 64.f);
            const float dv = a - mean;
            float var = dv * dv;
#pragma unroll
            for (int o = 32; o > 0; o >>= 1) var += __shfl_xor(var, o);
            const float v = dv * rsqrtf(var * (1.f / 64.f) + EPS) * lg + lb;
            const float sv = v * sigmoid_(v);
            *(bf16_t*)(yl + yl_off(t, c >> 3) + (c & 7) * 2) = (bf16_t)f2bf(sv);
        }
    }
    __syncthreads();
    f32x16 acc[2][2];
#pragma unroll
    for (int jn = 0; jn < 2; ++jn)
#pragma unroll
        for (int it = 0; it < 2; ++it)
#pragma unroll
            for (int r = 0; r < 16; ++r) acc[jn][it][r] = 0.f;
    const bf16_t* wp = w.Wpwt + L * WPW_SZ + (size_t)(wid * 64 + fr) * 256 + 8 * fh;
#pragma unroll 2
    for (int s = 0; s < 16; ++s) {
        const bf16x8 w0 = *(const bf16x8*)(wp + 16 * s), w1 = *(const bf16x8*)(wp + 32 * 256 + 16 * s);
        const bf16x8 x0 = *(const bf16x8*)(yl + yl_off(fr, 2 * s + fh)), x1 = *(const bf16x8*)(yl + yl_off(32 + fr, 2 * s + fh));
        acc[0][0] = __builtin_amdgcn_mfma_f32_32x32x16_bf16(w0, x0, acc[0][0], 0, 0, 0);
        acc[0][1] = __builtin_amdgcn_mfma_f32_32x32x16_bf16(w0, x1, acc[0][1], 0, 0, 0);
        acc[1][0] = __builtin_amdgcn_mfma_f32_32x32x16_bf16(w1, x0, acc[1][0], 0, 0, 0);
        acc[1][1] = __builtin_amdgcn_mfma_f32_32x32x16_bf16(w1, x1, acc[1][1], 0, 0, 0);
    }
    const float* pb = in.conv_pw_b + L * 256;
#pragma unroll
    for (int it = 0; it < 2; ++it) {
        const int tok = t0 + it * 32 + fr;
        float ssq = 0.f;
#pragma unroll
        for (int jn = 0; jn < 2; ++jn)
#pragma unroll
            for (int g = 0; g < 4; ++g) {
                const int n = wid * 64 + jn * 32 + 8 * g + 4 * fh;
                const float4 b4 = *(const float4*)(pb + n);
                const float o0 = acc[jn][it][4 * g] + b4.x, o1 = acc[jn][it][4 * g + 1] + b4.y, o2 = acc[jn][it][4 * g + 2] + b4.z, o3 = acc[jn][it][4 * g + 3] + b4.w;
                ssq += o0 * o0 + o1 * o1 + o2 * o2 + o3 * o3;
                store4(w.yb + (size_t)tok * 1024 + 256 + n, o0, o1, o2, o3);
            }
        ssq = xor32(ssq);
        if (fh == 0) red[wid * 64 + it * 32 + fr] = ssq;
    }
    __syncthreads();
    if (tid < 64) w.ssq[(size_t)(t0 + tid) * 16 + 1] = red[tid] + red[64 + tid] + red[128 + tid] + red[192 + tid];
    __syncthreads();
}

__device__ void phase_mix(const Params& P, int L, char* lds) {
    const int tid = opaque_tid();
    const int NQKV = 128 * 6 + 128 * 8, NCONV = 256, NSGU = 128;
    for (int item = blockIdx.x; item < NQKV + NCONV + NSGU; item += gridDim.x) {
        if (item < NQKV) qkv_item(P, L, item, lds, tid);
        else if (item < NQKV + NCONV) conv_item(P, L, item - NQKV, lds, tid);
        else sgu_item(P, L, item - NQKV - NCONV, lds, tid);
    }
}

__global__ void k_shim_qkv(Params P, int t0, float* q, float* kv) {
    const WS& w = P.w;
    size_t idx = (size_t)blockIdx.x * blockDim.x + threadIdx.x;
    if (idx >= (size_t)2048 * 1792) return;
    const int tl = (int)(idx / 1792), c = (int)(idx % 1792), t = t0 + tl, b = t >> 11, s = t & 2047;
    if (c < 768) { const int h = c / 96, d = c % 96; q[(size_t)tl * 768 + c] = bf2f(w.Qb[((size_t)(b * 8 + h) * 2048 + s) * 96 + d]) * (1.f / QSCALE); }
    else {
        const int cc = c - 768, h = cc >> 7, d = cc & 127;
        kv[(size_t)tl * 1024 + cc] = (d < 64) ? bf2f(w.Knb[((size_t)(b * 8 + h) * 2048 + s) * 64 + d]) : bf2f(w.VTb[((size_t)(b * 8 + h) * 64 + (d - 64)) * 2048 + s]);
    }
}
__global__ void k_shim_y(Params P, int t0, int c0, int c1) {
    const int wdt = c1 - c0;
    size_t idx = (size_t)blockIdx.x * blockDim.x + threadIdx.x;
    if (idx >= (size_t)2048 * wdt) return;
    const int tl = (int)(idx / wdt), c = c0 + (int)(idx % wdt);
    P.yf[(size_t)tl * 1024 + c] = bf2f(P.w.yb[(size_t)(t0 + tl) * 1024 + c]);
}

}
namespace fx {

constexpr int KROW = 208, VROW = 136, ATT_STAGE = 64 * KROW + 64 * VROW;

struct KVRegs { uint4 k0, k1, k2, v0, v1; };
__device__ __forceinline__ uint4 k_ld(const bf16_t* Kn, const bf16_t* Kp, int k0, int c) {
    const int key = c / 12, ch = c % 12;
    const bf16_t* src = (ch < 8) ? (Kn + (size_t)(k0 + key) * 64 + ch * 8) : (Kp + (size_t)(k0 + key) * 32 + (ch - 8) * 8);
    return *(const uint4*)src;
}
__device__ __forceinline__ void kv_load(KVRegs& r, const bf16_t* Kn, const bf16_t* Kp, const bf16_t* Vt, int k0, const int tid) {
    r.k0 = k_ld(Kn, Kp, k0, tid); r.k1 = k_ld(Kn, Kp, k0, tid + 256); r.k2 = k_ld(Kn, Kp, k0, tid + 512);
    r.v0 = *(const uint4*)(Vt + (size_t)(tid >> 3) * 2048 + k0 + (tid & 7) * 8);
    r.v1 = *(const uint4*)(Vt + (size_t)(32 + (tid >> 3)) * 2048 + k0 + (tid & 7) * 8);
}
__device__ __forceinline__ void k_st(char* st, int c, const uint4& v) { const int key = c / 12, ch = c % 12; *(uint4*)(st + key * KROW + ch * 16) = v; }
__device__ __forceinline__ void v_st(char* st, int d, int ch, const uint4& v) {
    char* p = st + 64 * KROW + d * VROW + ch * 16;
    *(uint2*)p = make_uint2(v.x, v.y); *(uint2*)(p + 8) = make_uint2(v.z, v.w);
}
__device__ __forceinline__ void kv_store(const KVRegs& r, char* st, const int tid) {
    k_st(st, tid, r.k0); k_st(st, tid + 256, r.k1); k_st(st, tid + 512, r.k2);
    v_st(st, tid >> 3, tid & 7, r.v0); v_st(st, 32 + (tid >> 3), tid & 7, r.v1);
}

__device__ void attn_unit(const Params& P, int b, int h, int qt, char* lds, const int tid) {
    const WS& w = P.w;
    const int lane = tid & 63, wid = tid >> 6, fr = lane & 31, fh = lane >> 5;
    const bf16_t* Kn = w.Knb + (size_t)(b * 8 + h) * 2048 * 64;
    const bf16_t* Kp = w.kpeb + (size_t)b * 2048 * 32;
    const bf16_t* Vt = w.VTb + (size_t)(b * 8 + h) * 64 * 2048;
    const int q0 = qt * 128, qw0 = q0 + wid * 32, qpos = qw0 + fr;
    bf16x8 qf[6];
    {
        const bf16_t* qp = w.Qb + ((size_t)(b * 8 + h) * 2048 + qpos) * 96 + 8 * fh;
#pragma unroll
        for (int ks = 0; ks < 6; ++ks) qf[ks] = *(const bf16x8*)(qp + 16 * ks);
    }
    f32x16 o0, o1;
#pragma unroll
    for (int r = 0; r < 16; ++r) { o0[r] = 0.f; o1[r] = 0.f; }
    float m = -1e30f, l = 0.f;
    const int nkt = 2 * (qt + 1);
    KVRegs kr;
    kv_load(kr, Kn, Kp, Vt, 0, tid);
    kv_store(kr, lds, tid);
    __syncthreads();
#pragma unroll 1
    for (int kt = 0; kt < nkt; ++kt) {
        char* cur = lds + (kt & 1) * ATT_STAGE;
        char* nxt = lds + ((kt + 1) & 1) * ATT_STAGE;
        const bool more = kt + 1 < nkt;
        if (more) kv_load(kr, Kn, Kp, Vt, (kt + 1) * 64, tid);
        const int k0 = kt * 64;
        if (k0 <= qw0 + 31) {
            f32x16 s0, s1;
#pragma unroll
            for (int r = 0; r < 16; ++r) { s0[r] = 0.f; s1[r] = 0.f; }
            const char* kb = cur + fr * KROW + fh * 16;
#pragma unroll
            for (int ks = 0; ks < 6; ++ks) {
                const bf16x8 ka = *(const bf16x8*)(kb + ks * 32), kb2 = *(const bf16x8*)(kb + 32 * KROW + ks * 32);
                s0 = __builtin_amdgcn_mfma_f32_32x32x16_bf16(ka, qf[ks], s0, 0, 0, 0);
                s1 = __builtin_amdgcn_mfma_f32_32x32x16_bf16(kb2, qf[ks], s1, 0, 0, 0);
            }
            if (k0 + 63 > qw0) {
#pragma unroll
                for (int r = 0; r < 16; ++r) {
                    const int key = k0 + nidx(r, fh);
                    if (key > qpos) s0[r] = -1e30f;
                    if (key + 32 > qpos) s1[r] = -1e30f;
                }
            }
            float mx = s0[0];
#pragma unroll
            for (int r = 1; r < 16; ++r) mx = fmaxf(mx, s0[r]);
#pragma unroll
            for (int r = 0; r < 16; ++r) mx = fmaxf(mx, s1[r]);
            mx = fmaxf(mx, __shfl_xor(mx, 32));
            const float mn = fmaxf(m, mx);
            const float alpha = __builtin_amdgcn_exp2f(m - mn);
            m = mn;
            float ps = 0.f;
#pragma unroll
            for (int r = 0; r < 16; ++r) { s0[r] = __builtin_amdgcn_exp2f(s0[r] - mn); ps += s0[r]; }
#pragma unroll
            for (int r = 0; r < 16; ++r) { s1[r] = __builtin_amdgcn_exp2f(s1[r] - mn); ps += s1[r]; }
            ps += __shfl_xor(ps, 32);
            l = l * alpha + ps;
#pragma unroll
            for (int r = 0; r < 16; ++r) { o0[r] *= alpha; o1[r] *= alpha; }
            const char* vb = cur + 64 * KROW + fr * VROW + fh * 8;
#pragma unroll
            for (int ks = 0; ks < 4; ++ks) {
                bf16x8 pf;
                {
                    const int rb = 8 * (ks & 1);
                    unsigned u0, u1, u2, u3;
                    if (ks < 2) { u0 = pack2(s0[rb], s0[rb + 1]); u1 = pack2(s0[rb + 2], s0[rb + 3]); u2 = pack2(s0[rb + 4], s0[rb + 5]); u3 = pack2(s0[rb + 6], s0[rb + 7]); }
                    else { u0 = pack2(s1[rb], s1[rb + 1]); u1 = pack2(s1[rb + 2], s1[rb + 3]); u2 = pack2(s1[rb + 4], s1[rb + 5]); u3 = pack2(s1[rb + 6], s1[rb + 7]); }
                    uint4 uu = make_uint4(u0, u1, u2, u3);
                    pf = __builtin_bit_cast(bf16x8, uu);
                }
                const uint2 va0 = *(const uint2*)(vb + ks * 32), va1 = *(const uint2*)(vb + ks * 32 + 16);
                const uint2 vb0 = *(const uint2*)(vb + 32 * VROW + ks * 32), vb1 = *(const uint2*)(vb + 32 * VROW + ks * 32 + 16);
                const bf16x8 vfa = __builtin_bit_cast(bf16x8, make_uint4(va0.x, va0.y, va1.x, va1.y));
                const bf16x8 vfb = __builtin_bit_cast(bf16x8, make_uint4(vb0.x, vb0.y, vb1.x, vb1.y));
                o0 = __builtin_amdgcn_mfma_f32_32x32x16_bf16(vfa, pf, o0, 0, 0, 0);
                o1 = __builtin_amdgcn_mfma_f32_32x32x16_bf16(vfb, pf, o1, 0, 0, 0);
            }
        }
        if (more) kv_store(kr, nxt, tid);
        __syncthreads();
    }
    const float inv = 1.f / l;
    const int tok = b * 2048 + qpos;
    float ssq = 0.f;
#pragma unroll
    for (int dt = 0; dt < 2; ++dt)
#pragma unroll
        for (int g = 0; g < 4; ++g) {
            float o[4];
#pragma unroll
            for (int q = 0; q < 4; ++q) { o[q] = (dt == 0 ? o0[4 * g + q] : o1[4 * g + q]) * inv; ssq += o[q] * o[q]; }
            store4(w.yb + (size_t)tok * 1024 + 512 + h * 64 + dt * 32 + 8 * g + 4 * fh, o[0], o[1], o[2], o[3]);
        }
    ssq = xor32(ssq);
    if (fh == 0) w.ssq[(size_t)tok * 16 + 8 + h] = ssq;
}

__device__ void phase_attn(const Params& P, int L, char* lds) {
    const int tid0 = opaque_tid();
    for (int item = blockIdx.x; item < 8 * 8 * 8; item += gridDim.x) {
        int tid = tid0; asm volatile("" : "+v"(tid));
        const int p = item & 7, h = (item >> 3) & 7, b = item >> 6;
        attn_unit(P, b, h, 15 - p, lds, tid);
        attn_unit(P, b, h, p, lds, tid);
    }
}

}
namespace fx {

__device__ __forceinline__ void acc_scale(f32x16 (&acc)[2][2], const float* f, const int tid) {
    const int lane = tid & 63, wr = tid >> 7, fr = lane & 31;
#pragma unroll
    for (int i = 0; i < 2; ++i) {
        const float v = f[wr * 64 + i * 32 + fr];
#pragma unroll
        for (int j = 0; j < 2; ++j)
#pragma unroll
            for (int r = 0; r < 16; ++r) acc[i][j][r] *= v;
    }
}
__device__ void phase_oproj(const Params& P, int L, char* lds) {
    const WS& w = P.w;
    const int tid0 = opaque_tid();
    float* T = (float*)lds; float* stat = (float*)(lds + STAT_OFF);
    const bf16_t* Wt = w.Wot + L * WO_SZ;
    for (int item = blockIdx.x; item < 128 * 8; item += gridDim.x) {
        int tid = tid0; asm volatile("" : "+v"(tid));
        const int lane = tid & 63, wid = tid >> 6;
        const int mt = item >> 3, nt = item & 7, m0 = mt * 128, n0 = nt * 128;
        float rb_keep = 0.f;
        if (tid < 128) {
            const float* sq = w.ssq + (size_t)(m0 + tid) * 16;
            const float4 c0 = *(const float4*)(sq + 8), c1 = *(const float4*)(sq + 12);
            const float ra = rsqrtf(sq[0] * (1.f / 256.f) + EPS), rb = rsqrtf(sq[1] * (1.f / 256.f) + EPS);
            const float rc = rsqrtf((c0.x + c0.y + c0.z + c0.w + c1.x + c1.y + c1.z + c1.w) * (1.f / 512.f) + EPS);
            stat[tid] = rc / ra; stat[128 + tid] = ra / rb; rb_keep = rb;
        }
        {
            const bf16_t* arow[4]; const bf16_t* wrow[4];
#pragma unroll
            for (int i = 0; i < 4; ++i) {
                arow[i] = w.yb + (size_t)(m0 + (tid >> 3) + 32 * i) * 1024 + (tid & 7) * 8 + 512;
                wrow[i] = Wt + (size_t)(n0 + (tid >> 3) + 32 * i) * 1024 + (tid & 7) * 8 + 512;
            }
            f32x16 acc[2][2]; acc_zero(acc);
            float ss[4] = {0.f, 0.f, 0.f, 0.f};
            gemm_mainloop<bf16_t, false>(acc, arow, wrow, 8, lds, ss, tid);
            acc_scale(acc, stat, tid);
#pragma unroll
            for (int i = 0; i < 4; ++i) { arow[i] -= 512; wrow[i] -= 512; }
            gemm_mainloop<bf16_t, false>(acc, arow, wrow, 4, lds, ss, tid);
            acc_scale(acc, stat + 128, tid);
#pragma unroll
            for (int i = 0; i < 4; ++i) { arow[i] += 256; wrow[i] += 256; }
            gemm_mainloop<bf16_t, false>(acc, arow, wrow, 4, lds, ss, tid);
            __syncthreads();
            if (tid < 128) stat[tid] = rb_keep;
            acc_to_lds(acc, T, tid);
        }
#pragma unroll 2
        for (int rr = 0; rr < 32; ++rr) {
            const int row = wid * 32 + rr; const float rb = stat[row];
            const float2 x = *(const float2*)(T + row * TLD + 2 * lane);
            float2* hp = (float2*)(P.h + (size_t)(m0 + row) * 1024 + n0 + 2 * lane);
            float2 hv = *hp; hv.x += x.x * rb; hv.y += x.y * rb;
            *hp = hv;
            *(unsigned*)(w.hb1 + (size_t)(m0 + row) * 1024 + n0 + 2 * lane) = pack2(hv.x, hv.y);
        }
        __syncthreads();
    }
}

__device__ void router_item(const Params& P, int L, int mt, char* lds, const int tid_in) {
    int tid = tid_in; asm volatile("" : "+v"(tid));
    const WS& w = P.w; const nv::Inputs& in = P.in;
    float* T = (float*)lds; float* stat = (float*)(lds + STAT_OFF); int* hist = (int*)(lds + STAT_OFF + 512);
    const int m0 = mt * 128;
    {
        const bf16_t* arow[4]; const bf16_t* wrow[4];
#pragma unroll
        for (int i = 0; i < 4; ++i) {
            arow[i] = w.hb1 + (size_t)(m0 + (tid >> 3) + 32 * i) * 1024 + (tid & 7) * 8;
            wrow[i] = w.Wrt + L * WR_SZ + (size_t)((tid >> 3) + 32 * i) * 1024 + (tid & 7) * 8;
        }
        f32x16 acc[2][2]; acc_zero(acc);
        float ss[4] = {0.f, 0.f, 0.f, 0.f};
        gemm_mainloop<bf16_t, true>(acc, arow, wrow, 16, lds, ss, tid);
        publish_rowstat(ss, stat, 1.f / 1024.f, true, tid);
        if (tid < 32) hist[tid] = 0;
        acc_to_lds(acc, T, tid);
    }
    int e0 = 0, e1 = 0, r0 = 0, r1 = 0; float w0 = 0.f, w1 = 0.f;
    if (tid < 128) {
        const float rs = stat[tid];
        const float* lr = T + tid * TLD;
        const float* bg = in.router_group_b + L * 4; const float* be = in.router_expert_b + L * 32;
        int gi = 0; float gm = lr[0] * rs + bg[0];
#pragma unroll
        for (int j = 1; j < 4; ++j) { const float v = lr[j] * rs + bg[j]; if (v > gm) { gm = v; gi = j; } }
        float gs = 0.f;
#pragma unroll
        for (int j = 0; j < 4; ++j) gs += __expf(lr[j] * rs + bg[j] - gm);
        const float gw = 1.f / gs;
        int i0 = 0, i1 = -1; float v0 = -3.0e38f, v1 = -3.0e38f;
#pragma unroll
        for (int j = 0; j < 8; ++j) {
            const float v = lr[4 + gi * 8 + j] * rs + be[gi * 8 + j];
            if (v > v0) { v1 = v0; i1 = i0; v0 = v; i0 = j; } else if (v > v1) { v1 = v; i1 = j; }
        }
        const float ex = __expf(v1 - v0);
        w0 = gw / (1.f + ex); w1 = gw * ex / (1.f + ex);
        e0 = gi * 8 + i0; e1 = gi * 8 + i1;
        r0 = atomicAdd(&hist[e0], 1); r1 = atomicAdd(&hist[e1], 1);
    }
    __syncthreads();
    if (tid < 32) hist[32 + tid] = hist[tid] ? atomicAdd(&w.cnt[L * 64 + tid], hist[tid]) : 0;
    __syncthreads();
    if (tid < 128) {
        const int tok = m0 + tid;
        const int p0 = hist[32 + e0] + r0, p1 = hist[32 + e1] + r1;
        w.elist[(size_t)e0 * NT + p0] = tok * 2; w.ewt[(size_t)e0 * NT + p0] = w0;
        w.elist[(size_t)e1 * NT + p1] = tok * 2 + 1; w.ewt[(size_t)e1 * NT + p1] = w1;
    }
    __syncthreads();
}
__device__ void eraw_item(const Params& P, int L, int item, char* lds, const int tid_in) {
    int tid = tid_in; asm volatile("" : "+v"(tid));
    const WS& w = P.w; const nv::Inputs& in = P.in;
    const int lane = tid & 63, wid = tid >> 6;
    float* T = (float*)lds;
    const int mt = item >> 3, nt = item & 7, m0 = mt * 128, n0 = nt * 128;
    {
        const float* arow[4]; const bf16_t* wrow[4];
#pragma unroll
        for (int i = 0; i < 4; ++i) {
            arow[i] = in.p + ((size_t)L * NT + m0 + (tid >> 3) + 32 * i) * 256 + (tid & 7) * 8;
            wrow[i] = w.Wpt + L * WP_SZ + (size_t)(n0 + (tid >> 3) + 32 * i) * 256 + (tid & 7) * 8;
        }
        f32x16 acc[2][2]; acc_zero(acc);
        float ss[4] = {0.f, 0.f, 0.f, 0.f};
        gemm_mainloop<float, false>(acc, arow, wrow, 4, lds, ss, tid);
        acc_to_lds(acc, T, tid);
    }
#pragma unroll 2
    for (int rr = 0; rr < 32; ++rr) {
        const int row = wid * 32 + rr;
        const float2 x = *(const float2*)(T + row * TLD + 2 * lane);
        *(unsigned*)(w.erb + (size_t)(m0 + row) * 1024 + n0 + 2 * lane) = pack2(x.x, x.y);
        float sq = x.x * x.x + x.y * x.y;
        sq = grp_sum32(sq); sq += __shfl_xor(sq, 32);
        if (lane == 0) w.essq[(size_t)(m0 + row) * 8 + nt] = sq;
    }
    __syncthreads();
}
__device__ void phase_router(const Params& P, int L, char* lds) {
    const int tid = opaque_tid();
    for (int item = blockIdx.x; item < 128 + 1024; item += gridDim.x) {
        if (item < 128) router_item(P, L, item, lds, tid);
        else eraw_item(P, L, item - 128, lds, tid);
    }
}

constexpr int TT_OFF = STAT_OFF + 512;
__device__ __forceinline__ void moe_table(const Params& P, int L, char* lds, const int tid) {
    int* tt = (int*)(lds + TT_OFF);
    if (tid == 0) {
        int o = 0, t = 0;
        for (int e = 0; e < 32; ++e) { const int c = P.w.cnt[L * 64 + e]; tt[e] = o; tt[40 + e] = t; o += c; t += (c + 127) >> 7; }
        tt[32] = o; tt[72] = t;
    }
    __syncthreads();
}
__device__ __forceinline__ void moe_find(const int* tt, int tile, int& e, int& t) {
    int lo = 0;
#pragma unroll 1
    for (int k = 0; k < 32; ++k) if (tt[40 + k] <= tile) lo = k;
    e = lo; t = tile - tt[40 + lo];
}
__device__ void phase_moe_up(const Params& P, int L, char* lds) {
    const WS& w = P.w;
    const int tid0 = opaque_tid();
    float* T = (float*)lds; float* stat = (float*)(lds + STAT_OFF); const int* tt = (const int*)(lds + TT_OFF);
    moe_table(P, L, lds, tid0);
    const int ntiles = tt[72];
    for (int item = blockIdx.x; item < ntiles * 4; item += gridDim.x) {
        int tid = tid0; asm volatile("" : "+v"(tid));
        const int lane = tid & 63, wid = tid >> 6;
        const int tile = item >> 2, nt = item & 3;
        int e, t; moe_find(tt, tile, e, t);
        const int cnt = P.w.cnt[L * 64 + e], rbase = tt[e] + t * 128, nrows = min(128, cnt - t * 128);
        {
            const bf16_t* arow[4]; const bf16_t* wrow[4];
#pragma unroll
            for (int i = 0; i < 4; ++i) {
                const int r = (tid >> 3) + 32 * i;
                const int ent = w.elist[(size_t)e * NT + t * 128 + (r < nrows ? r : 0)];
                arow[i] = w.hb1 + (size_t)(ent >> 1) * 1024 + (tid & 7) * 8;
                wrow[i] = w.Wgut + L * WGU_SZ + ((size_t)e * 512 + nt * 128 + r) * 1024 + (tid & 7) * 8;
            }
            f32x16 acc[2][2]; acc_zero(acc);
            float ss[4] = {0.f, 0.f, 0.f, 0.f};
            gemm_mainloop<bf16_t, true>(acc, arow, wrow, 16, lds, ss, tid);
            publish_rowstat(ss, stat, 1.f / 1024.f, true, tid);
            acc_to_lds(acc, T, tid);
        }
#pragma unroll 2
        for (int rr = 0; rr < 32; ++rr) {
            const int row = wid * 32 + rr; const float rs = stat[row];
            const float2 x = *(const float2*)(T + row * TLD + 2 * lane);
            const float g = x.x * rs, u = x.y * rs;
            if (row < nrows) w.hbuf[(size_t)(rbase + row) * 256 + nt * 64 + lane] = (bf16_t)f2bf(g * sigmoid_(g) * u);
        }
        __syncthreads();
    }
}
__device__ void phase_moe_down(const Params& P, int L, char* lds) {
    const WS& w = P.w;
    const int tid0 = opaque_tid();
    float* T = (float*)lds; const int* tt = (const int*)(lds + TT_OFF);
    moe_table(P, L, lds, tid0);
    const int ntiles = tt[72];
    for (int item = blockIdx.x; item < ntiles * 8; item += gridDim.x) {
        int tid = tid0; asm volatile("" : "+v"(tid));
        const int lane = tid & 63, wid = tid >> 6;
        const int tile = item >> 3, nt = item & 7;
        int e, t; moe_find(tt, tile, e, t);
        const int cnt = P.w.cnt[L * 64 + e], rbase = tt[e] + t * 128, nrows = min(128, cnt - t * 128);
        {
            const bf16_t* arow[4]; const bf16_t* wrow[4];
#pragma unroll
            for (int i = 0; i < 4; ++i) {
                const int r = (tid >> 3) + 32 * i;
                arow[i] = w.hbuf + (size_t)(rbase + (r < nrows ? r : 0)) * 256 + (tid & 7) * 8;
                wrow[i] = w.Wdt + L * WD_SZ + ((size_t)e * 1024 + nt * 128 + r) * 256 + (tid & 7) * 8;
            }
            f32x16 acc[2][2]; acc_zero(acc);
            float ss[4] = {0.f, 0.f, 0.f, 0.f};
            gemm_mainloop<bf16_t, false>(acc, arow, wrow, 4, lds, ss, tid);
            acc_to_lds(acc, T, tid);
        }
#pragma unroll 2
        for (int rr = 0; rr < 32; ++rr) {
            const int row = wid * 32 + rr;
            if (row < nrows) {
                const int ent = w.elist[(size_t)e * NT + t * 128 + row]; const float wt = w.ewt[(size_t)e * NT + t * 128 + row];
                const float2 x = *(const float2*)(T + row * TLD + 2 * lane);
                *(unsigned*)(w.contrib + (size_t)ent * 1024 + nt * 128 + 2 * lane) = pack2(x.x * wt, x.y * wt);
            }
        }
        __syncthreads();
    }
}

__device__ void phase_ple(const Params& P, int L, char* lds) {
    const WS& w = P.w; const nv::Inputs& in = P.in;
    const int tid0 = opaque_tid();
    float* T = (float*)lds; float* stat = (float*)(lds + STAT_OFF);
    for (int item = blockIdx.x; item < 128 * 8; item += gridDim.x) {
        int tid = tid0; asm volatile("" : "+v"(tid));
        const int lane = tid & 63, wid = tid >> 6;
        const int mt = item >> 3, nt = item & 7, m0 = mt * 128, n0 = nt * 128;
        {
            Rows3 rows; const bf16_t* wrow[4];
#pragma unroll
            for (int i = 0; i < 4; ++i) {
                const size_t tok = m0 + (tid >> 3) + 32 * i;
                rows.p[0][i] = w.hb1 + tok * 1024 + (tid & 7) * 8;
                rows.p[1][i] = w.contrib + (tok * 2) * 1024 + (tid & 7) * 8;
                wrow[i] = w.Wgt + L * WG_SZ + (size_t)(n0 + (tid >> 3) + 32 * i) * 1024 + (tid & 7) * 8;
            }
            f32x16 acc[2][2]; acc_zero(acc);
            float ss[4] = {0.f, 0.f, 0.f, 0.f};
            gemm_mainloop<bf16x3_t, true, 1>(acc, rows, wrow, 16, lds, ss, tid);
            publish_rowstat(ss, stat, 1.f / 1024.f, true, tid);
            acc_to_lds(acc, T, tid);
        }
        const float2 pg = *(const float2*)(in.ple_post_norm_g + L * 1024 + n0 + 2 * lane);
#pragma unroll 2
        for (int rr = 0; rr < 32; ++rr) {
            const int row = wid * 32 + rr; const float rs = stat[row]; const size_t tok = m0 + row;
            const float4 q0 = *(const float4*)(w.essq + tok * 8), q1 = *(const float4*)(w.essq + tok * 8 + 4);
            const float re = rsqrtf((q0.x + q0.y + q0.z + q0.w + q1.x + q1.y + q1.z + q1.w) * (1.f / 1024.f) + EPS);
            const float2 x = *(const float2*)(T + row * TLD + 2 * lane);
            const size_t off = tok * 1024 + n0 + 2 * lane;
            const unsigned c0 = *(const unsigned*)(w.contrib + (tok * 2) * 1024 + n0 + 2 * lane), c1 = *(const unsigned*)(w.contrib + (tok * 2 + 1) * 1024 + n0 + 2 * lane);
            const unsigned er = *(const unsigned*)(w.erb + off);
            float2 hv = *(const float2*)(P.h + off);
            hv.x += bflo(c0) + bflo(c1) + sigmoid_(x.x * rs) * (bflo(er) * re * pg.x);
            hv.y += bfhi(c0) + bfhi(c1) + sigmoid_(x.y * rs) * (bfhi(er) * re * pg.y);
            *(float2*)(P.h + off) = hv;
            *(unsigned*)(w.hb + off) = pack2(hv.x, hv.y);
        }
        __syncthreads();
    }
}

}
namespace fx {
#define XB_TMO      128
#define XB_XCNT(j)  (256  + 64 * (j))
#define XB_XSUB(j)  (1280 + 64 * (j))
#define XB_XGEN(j)  (2304 + 64 * (j))
#define XB_TOP      3328
#define XB_TOPGEN   3392
#define XCD_BAR_WORDS 3456
#define XB_SPIN_CAP (1u << 18)
#define LAS __attribute__((address_space(3)))
__device__ __forceinline__ unsigned xb_ld(unsigned* p)              { return __hip_atomic_load(p, __ATOMIC_RELAXED, __HIP_MEMORY_SCOPE_AGENT); }
__device__ __forceinline__ unsigned xb_add(unsigned* p, unsigned v) { return __hip_atomic_fetch_add(p, v, __ATOMIC_RELAXED, __HIP_MEMORY_SCOPE_AGENT); }
__device__ __forceinline__ unsigned xb_xcc_id() { return (unsigned)__builtin_amdgcn_s_getreg((3 << 11) | 20) & 0xFu; }
#define XB_SPIN(cond, bar) do { unsigned _sp = 0; while (cond) { __builtin_amdgcn_s_sleep(1); \
    if ((++_sp & 255u) == 0u) { if (xb_ld(&(bar)[XB_TMO])) break; if (_sp > XB_SPIN_CAP) { atomicAdd(&(bar)[XB_TMO], 1u); break; } } } } while (0)
struct XcdBarrier { unsigned* bar; unsigned x; volatile LAS unsigned* st; };
__device__ __forceinline__ XcdBarrier xcd_barrier_post(unsigned* bar, volatile LAS unsigned* st) {
    XcdBarrier b; b.bar = bar; b.x = xb_xcc_id(); b.st = st;
    if (threadIdx.x == 0) (void)xb_add(&bar[XB_XCNT(b.x)], 1u);
    return b;
}
__device__ __forceinline__ void xcd_barrier_complete(unsigned* bar, unsigned x, unsigned& nloc, unsigned& nx) {
    const unsigned G = gridDim.x * gridDim.y * gridDim.z;
    unsigned sum, cnt, mine, sp = 0u;
    for (;;) {
        sum = 0u; cnt = 0u; mine = 0u;
#pragma unroll
        for (unsigned j = 0; j < 16; ++j) { const unsigned c = xb_ld(&bar[XB_XCNT(j)]); sum += c; cnt += (c > 0u) ? 1u : 0u; mine = (j == x) ? c : mine; }
        if (sum == G) break;
        __builtin_amdgcn_s_sleep(1);
        if ((++sp & 255u) == 0u) { if (xb_ld(&bar[XB_TMO])) break; if (sp > XB_SPIN_CAP) { atomicAdd(&bar[XB_TMO], 1u); break; } }
    }
    nloc = mine > 0u ? mine : 1u; nx = cnt > 0u ? cnt : 1u;
}
__device__ __forceinline__ void xcd_barrier(const XcdBarrier& b) {
    asm volatile("s_waitcnt vmcnt(0)" ::: "memory");
    __syncthreads();
    if (threadIdx.x == 0) {
        unsigned* bar = b.bar;
        __builtin_amdgcn_s_waitcnt(0);
        unsigned nloc = b.st[0], nx = b.st[1];
        if (nloc == 0u) { xcd_barrier_complete(bar, b.x, nloc, nx); b.st[0] = nloc; b.st[1] = nx; }
        const unsigned old = xb_add(&bar[XB_XSUB(b.x)], 1u);
        const unsigned gen = old / nloc;
        if (old + 1u == (gen + 1u) * nloc) {
            __builtin_amdgcn_fence(__ATOMIC_RELEASE, "agent");
            asm volatile("s_waitcnt vmcnt(0)" ::: "memory");
            const unsigned og = xb_add(&bar[XB_TOP], 1u);
            const unsigned tg = og / nx;
            if (og + 1u == (tg + 1u) * nx) xb_add(&bar[XB_TOPGEN], 1u);
            else XB_SPIN(xb_ld(&bar[XB_TOPGEN]) == tg, bar);
            __builtin_amdgcn_fence(__ATOMIC_ACQUIRE, "agent");
            xb_add(&bar[XB_XGEN(b.x)], 1u);
            asm volatile("s_waitcnt vmcnt(0)" ::: "memory");
        } else {
            XB_SPIN(xb_ld(&bar[XB_XGEN(b.x)]) == gen, bar);
            __builtin_amdgcn_fence(__ATOMIC_ACQUIRE, "agent");
            asm volatile("s_waitcnt vmcnt(0)" ::: "memory");
        }
    }
    __syncthreads();
}

constexpr int LDS_BYTES = LDS_GEMM_BYTES + 16;
constexpr int N_PHASES = 17;
__global__ void __launch_bounds__(256, 2) k_run(Params P, int ph_lo, int ph_hi) {
    extern __shared__ __attribute__((aligned(16))) char lds[];
    volatile LAS unsigned* st = (volatile LAS unsigned*)(lds + LDS_GEMM_BYTES);
    if (threadIdx.x == 0) { st[0] = 0u; st[1] = 0u; }
    __syncthreads();
    XcdBarrier xb = xcd_barrier_post(P.w.bar, st);
    for (int ph = ph_lo; ph < ph_hi; ++ph) {
        if (ph > ph_lo) xcd_barrier(xb);
        if (ph == 0) phase_prep(P, lds);
        else {
            const int L = (ph - 1) >> 3, s = (ph - 1) & 7;
            switch (s) {
                case 0: phase_zgemm(P, L, lds); break;
                case 1: phase_mix(P, L, lds); break;
                case 2: phase_attn(P, L, lds); break;
                case 3: phase_oproj(P, L, lds); break;
                case 4: phase_router(P, L, lds); break;
                case 5: phase_moe_up(P, L, lds); break;
                case 6: phase_moe_down(P, L, lds); break;
                case 7: phase_ple(P, L, lds); break;
            }
        }
    }
}
}
#ifndef MK_N_LAUNCHES
#define MK_N_LAUNCHES 1
#endif
extern "C" void kernel_launch(void* const* d_in, const int* in_sizes, int n_in, void* d_out, int out_size, void* d_ws, size_t ws_size,
                              hipStream_t stream) {
    nv::Inputs in{};
    in.x = (const float*)d_in[0]; in.p = (const float*)d_in[1]; in.positions = (const int*)d_in[2];
    const float** f = &in.mix_norm_g;
    for (int i = 0; i < 32; ++i) f[i] = (const float*)d_in[3 + i];
    size_t used = 0;
    fx::WS w = fx::make_ws((char*)d_ws, used);
    static int grid = 0;
    if (grid == 0) {
        if (n_in != 35 || out_size != fx::NT * 1024 || used > ws_size) { fprintf(stderr, "kernel_launch: unexpected shapes / workspace (need %zu, have %zu)\n", used, ws_size); grid = -1; return; }
        if (hipFuncSetAttribute((const void*)fx::k_run, hipFuncAttributeMaxDynamicSharedMemorySize, fx::LDS_BYTES) != hipSuccess) { fprintf(stderr, "hipFuncSetAttribute failed\n"); grid = -1; return; }
        int dev = 0, cus = 0, per_cu = 0;
        hipGetDevice(&dev); hipDeviceGetAttribute(&cus, hipDeviceAttributeMultiprocessorCount, dev);
        hipOccupancyMaxActiveBlocksPerMultiprocessor(&per_cu, (const void*)fx::k_run, 256, fx::LDS_BYTES);
        if (per_cu > 2) per_cu = 2;
        if (per_cu < 1) { fprintf(stderr, "occupancy query says %d blocks/CU\n", per_cu); grid = -1; return; }
        grid = cus * per_cu;
    }
    if (grid < 0) return;
    fx::Params P{}; P.in = in; P.h = (float*)d_out; P.w = w;
    hipMemsetAsync(w.cnt, 0, 128 * 4, stream);
    hipMemsetAsync(w.bar, 0, XCD_BAR_WORDS * 4, stream);
    if (MK_N_LAUNCHES == 1) hipLaunchKernelGGL(fx::k_run, dim3(grid), dim3(256), fx::LDS_BYTES, stream, P, 0, fx::N_PHASES);
    else for (int ph = 0; ph < fx::N_PHASES; ++ph) hipLaunchKernelGGL(fx::k_run, dim3(grid), dim3(256), fx::LDS_BYTES, stream, P, ph, ph + 1);
}
```

```cpp
#include <hip/hip_runtime.h>
#include <hip/hip_bf16.h>
#include <stdint.h>
#include <cstdio>
namespace nv {
struct Inputs {
    const float *x, *p; const int* positions;
    const float *mix_norm_g, *w_in, *sgu_ln_g, *sgu_ln_b, *sgu_w, *sgu_b, *conv_w, *conv_b, *conv_ln_g, *conv_ln_b, *conv_pw_w, *conv_pw_b,
        *q_a_norm_g, *w_uq, *kv_a_norm_g, *w_ukv, *q_norm_g, *k_norm_g, *branch_norm_g, *w_o, *ffn_norm_g, *router_group_w, *router_group_b,
        *router_expert_w, *router_expert_b, *moe_w_gate, *moe_w_up, *moe_w_down, *ple_norm_g, *ple_gate_w, *ple_proj_w, *ple_post_norm_g;
};
}
namespace fx {

typedef unsigned short bf16_t;
typedef short bf16x8 __attribute__((ext_vector_type(8)));
typedef float f32x16 __attribute__((ext_vector_type(16)));
typedef float f32x4 __attribute__((ext_vector_type(4)));

constexpr int NT = 16384, SEQ = 2048, DM = 1024, NB = 8;
constexpr int ZN = 1536;
constexpr float EPS = 1e-6f;

typedef __bf16 bf16v2_t __attribute__((ext_vector_type(2)));
typedef float f32v2_t __attribute__((ext_vector_type(2)));
__device__ __forceinline__ unsigned pack2(float lo, float hi) {
    f32v2_t v; v.x = lo; v.y = hi;
    bf16v2_t b = __builtin_convertvector(v, bf16v2_t);
    return __builtin_bit_cast(unsigned, b);
}
__device__ __forceinline__ unsigned f2bf(float f) { return pack2(f, 0.f) & 0xffffu; }
__device__ __forceinline__ float bf2f(unsigned short b) { return __uint_as_float(((unsigned)b) << 16); }
__device__ __forceinline__ float bflo(unsigned u) { return __uint_as_float(u << 16); }
__device__ __forceinline__ float bfhi(unsigned u) { return __uint_as_float(u & 0xffff0000u); }
__device__ __forceinline__ float sigmoid_(float x) { return 1.f / (1.f + __expf(-x)); }
__device__ __forceinline__ float gelu_tanh_(float x) {
    float u = 0.7978845608028654f * (x + 0.044715f * x * x * x);
    return x * sigmoid_(2.f * u);
}
__device__ __forceinline__ int opaque_tid() { int t = threadIdx.x; asm volatile("" : "+v"(t)); return t; }
__device__ __forceinline__ float xor32(float v) { return v + __shfl_xor(v, 32); }

struct WS {
    bf16_t *W1t, *Wuqt, *Wukvt, *Wpwt, *Wot, *Wrt, *Wgut, *Wdt, *Wgt, *Wpt, *Wsm;
    bf16_t *hb;
    bf16_t *hb1;
    bf16_t *ub;
    bf16_t *vT;
    bf16_t *ygb;
    bf16_t *cqb;
    bf16_t *ckvb;
    bf16_t *kpeb;
    bf16_t *Qb;
    bf16_t *Knb;
    bf16_t *VTb;
    bf16_t *yb;
    float  *ssq;
    float  *cs;
    bf16_t *erb;
    float  *essq;
    bf16_t *hbuf;
    bf16_t *contrib;
    int    *cnt;
    int    *elist;
    float  *ewt;
    unsigned *bar;
};
constexpr size_t W1_SZ = (size_t)ZN * 1024, WUQ_SZ = 768 * 256, WUKV_SZ = 1024 * 128, WPW_SZ = 256 * 256, WO_SZ = 1024 * 1024, WR_SZ = 128 * 1024,
                 WGU_SZ = (size_t)32 * 512 * 1024, WD_SZ = (size_t)32 * 1024 * 256, WG_SZ = 1024 * 1024, WP_SZ = 1024 * 256, WSM_SZ = 4 * 128 * 128;

struct Params {
    nv::Inputs in;
    float* h;
    WS w;
    float* zf;
    float* yf;
};

static WS make_ws(char* base, size_t& used) {
    WS w{}; size_t o = 0;
    auto take = [&](size_t bytes) { char* p = base + o; o += (bytes + 255) & ~(size_t)255; return p; };
    w.W1t = (bf16_t*)take(2 * W1_SZ * 2);   w.Wuqt = (bf16_t*)take(2 * WUQ_SZ * 2); w.Wukvt = (bf16_t*)take(2 * WUKV_SZ * 2);
    w.Wpwt = (bf16_t*)take(2 * WPW_SZ * 2); w.Wot = (bf16_t*)take(2 * WO_SZ * 2);   w.Wrt = (bf16_t*)take(2 * WR_SZ * 2);
    w.Wgut = (bf16_t*)take(2 * WGU_SZ * 2); w.Wdt = (bf16_t*)take(2 * WD_SZ * 2);   w.Wgt = (bf16_t*)take(2 * WG_SZ * 2);
    w.Wpt = (bf16_t*)take(2 * WP_SZ * 2);   w.Wsm = (bf16_t*)take(2 * WSM_SZ * 2);
    w.hb = (bf16_t*)take((size_t)NT * 1024 * 2); w.hb1 = (bf16_t*)take((size_t)NT * 1024 * 2);
    w.ssq = (float*)take((size_t)NT * 16 * 4); w.cs = (float*)take((size_t)NT * 32 * 4);
    w.essq = (float*)take((size_t)NT * 8 * 4);
    w.cnt = (int*)take(2 * 64 * 4);
    w.elist = (int*)take((size_t)32 * NT * 4); w.ewt = (float*)take((size_t)32 * NT * 4);
    w.bar = (unsigned*)take(4096 * 4);
    const size_t region = o;
    w.ub = (bf16_t*)take((size_t)NT * 256 * 2); w.vT = (bf16_t*)take((size_t)NT * 256 * 2); w.ygb = (bf16_t*)take((size_t)NT * 256 * 2);
    w.cqb = (bf16_t*)take((size_t)NT * 256 * 2); w.ckvb = (bf16_t*)take((size_t)NT * 128 * 2); w.kpeb = (bf16_t*)take((size_t)NT * 32 * 2);
    w.Qb = (bf16_t*)take((size_t)NT * 768 * 2); w.Knb = (bf16_t*)take((size_t)NT * 512 * 2); w.VTb = (bf16_t*)take((size_t)NT * 512 * 2);
    w.yb = (bf16_t*)take((size_t)NT * 1024 * 2);
    const size_t region_end = o;
    o = region;
    w.contrib = (bf16_t*)take((size_t)NT * 2 * 1024 * 2);
    w.hbuf = (bf16_t*)take((size_t)(2 * NT + 128) * 256 * 2);
    w.erb = (bf16_t*)take((size_t)NT * 1024 * 2);
    if (o > region_end) { fprintf(stderr, "make_ws: overlay exceeds mixer region\n"); }
    o = region_end;
    used = o;
    return w;
}

__device__ const double ROPE_INV[16] = {1.0, 0.5623413251903491, 0.31622776601683794, 0.1778279410038923, 0.1, 0.05623413251903491, 0.03162277660168379, 0.01778279410038923, 0.01, 0.005623413251903491, 0.0031622776601683794, 0.0017782794100389228, 0.001, 0.0005623413251903491, 0.00031622776601683794, 0.00017782794100389227};
__device__ __forceinline__ void rope_cs(int pos, int j, float& c, float& s) {
    const double ang = (double)pos * ROPE_INV[j];
    const double n = rint(ang * 0.15915494309189535);
    double r = fma(-n, 6.283185307179586, ang); r = fma(-n, 2.4492935982947064e-16, r);
    const double r2 = r * r;
    double sc = 1.0, ss = 1.0;
    double tc = 1.0, ts = 1.0;
#pragma unroll
    for (int k = 1; k <= 14; ++k) {
        tc *= -r2 / (double)((2 * k - 1) * (2 * k)); sc += tc;
        ts *= -r2 / (double)((2 * k) * (2 * k + 1)); ss += ts;
    }
    c = (float)sc; s = (float)(ss * r);
}

enum { MAP_ID = 0, MAP_W1 = 1, MAP_UQ = 2, MAP_UKV = 3, MAP_GATE = 4, MAP_UP = 5 };
template <int MAP> __device__ __forceinline__ int dstrow(int c) {
    if (MAP == MAP_W1) {
        if (c < 512) return c;
        if (c < 768) return 512 + 2 * (c - 512);
        if (c < 1024) return 513 + 2 * (c - 768);
        return c;
    } else if (MAP == MAP_UQ) {
        const int h = c / 96, d = c - h * 96; return d < 64 ? h * 64 + d : 512 + h * 32 + d - 64;
    } else if (MAP == MAP_UKV) {
        const int h = c >> 7, d = c & 127; return d < 64 ? h * 64 + d : 512 + h * 64 + d - 64;
    } else if (MAP == MAP_GATE) return 2 * c;
    else if (MAP == MAP_UP) return 2 * c + 1;
    return c;
}
template <int MAP>
__device__ __forceinline__ void prep_tile(const float* src, int ld, int Nsrc, const float* scale, bf16_t* dst, int K, int k0, int c0, float* tile  , const int tid) {
    __syncthreads();
#pragma unroll
    for (int i = 0; i < 4; ++i) {
        const int kk = (tid >> 4) + 16 * i, c4 = (tid & 15) * 4;
        float4 v = make_float4(0.f, 0.f, 0.f, 0.f);
        if (c0 + c4 < Nsrc) v = *(const float4*)(src + (size_t)(k0 + kk) * ld + c0 + c4);
        const float sc = scale ? scale[k0 + kk] : 1.f;
        float* t = tile + kk * 65 + c4;
        t[0] = v.x * sc; t[1] = v.y * sc; t[2] = v.z * sc; t[3] = v.w * sc;
    }
    __syncthreads();
#pragma unroll
    for (int i = 0; i < 2; ++i) {
        const int idx = tid + 256 * i, c = idx >> 3, kc = idx & 7;
        if (c0 + c < Nsrc) {
            const float* t = tile + (kc * 8) * 65 + c;
            uint4 pk;
            pk.x = pack2(t[0], t[65]); pk.y = pack2(t[130], t[195]); pk.z = pack2(t[260], t[325]); pk.w = pack2(t[390], t[455]);
            *(uint4*)(dst + (size_t)dstrow<MAP>(c0 + c) * K + k0 + kc * 8) = pk;
        }
    }
}
template <int MAP>
__device__ void prep_job(const float* src, int ld, int Nsrc, size_t src_stride, const float* scale, bf16_t* dst, size_t dst_stride, int K, int nbatch, float* tile, int& rot, const int tid) {
    const int tn = (Nsrc + 63) / 64, tk = K / 64, per = tn * tk, total = per * nbatch, G = gridDim.x;
    for (int t = ((int)blockIdx.x - rot + G) % G; t < total; t += G) {
        const int e = t / per, tt = t % per;
        prep_tile<MAP>(src + (size_t)e * src_stride, ld, Nsrc, scale, dst + (size_t)e * dst_stride, K, (tt / tn) * 64, (tt % tn) * 64, tile, tid);
    }
    rot = (rot + total) % G;
}

__device__ void phase_prep(const Params& P, char* lds) {
    float* tile = (float*)lds;
    const nv::Inputs& in = P.in; const WS& w = P.w;
    const int G = gridDim.x, bid = blockIdx.x, tid = opaque_tid();
    int rot = 0;
    for (int L = 0; L < 2; ++L) {
        prep_job<MAP_GATE>(in.moe_w_gate + (size_t)L * 32 * 1024 * 256, 256, 256, (size_t)1024 * 256, in.ffn_norm_g + L * 1024, w.Wgut + L * WGU_SZ, (size_t)512 * 1024, 1024, 32, tile, rot, tid);
        prep_job<MAP_UP>(in.moe_w_up + (size_t)L * 32 * 1024 * 256, 256, 256, (size_t)1024 * 256, in.ffn_norm_g + L * 1024, w.Wgut + L * WGU_SZ, (size_t)512 * 1024, 1024, 32, tile, rot, tid);
        prep_job<MAP_ID>(in.moe_w_down + (size_t)L * 32 * 256 * 1024, 1024, 1024, (size_t)256 * 1024, nullptr, w.Wdt + L * WD_SZ, (size_t)1024 * 256, 256, 32, tile, rot, tid);
        prep_job<MAP_W1>(in.w_in + (size_t)L * 1024 * 1440, 1440, 1440, 0, in.mix_norm_g + L * 1024, w.W1t + L * W1_SZ, 0, 1024, 1, tile, rot, tid);
        prep_job<MAP_UQ>(in.w_uq + (size_t)L * 256 * 768, 768, 768, 0, in.q_a_norm_g + L * 256, w.Wuqt + L * WUQ_SZ, 0, 256, 1, tile, rot, tid);
        prep_job<MAP_UKV>(in.w_ukv + (size_t)L * 128 * 1024, 1024, 1024, 0, in.kv_a_norm_g + L * 128, w.Wukvt + L * WUKV_SZ, 0, 128, 1, tile, rot, tid);
        prep_job<MAP_ID>(in.conv_pw_w + (size_t)L * 256 * 256, 256, 256, 0, nullptr, w.Wpwt + L * WPW_SZ, 0, 256, 1, tile, rot, tid);
        prep_job<MAP_ID>(in.w_o + (size_t)L * 1024 * 1024, 1024, 1024, 0, in.branch_norm_g + L * 1024, w.Wot + L * WO_SZ, 0, 1024, 1, tile, rot, tid);
        prep_job<MAP_ID>(in.ple_gate_w + (size_t)L * 1024 * 1024, 1024, 1024, 0, in.ple_norm_g + L * 1024, w.Wgt + L * WG_SZ, 0, 1024, 1, tile, rot, tid);
        prep_job<MAP_ID>(in.ple_proj_w + (size_t)L * 256 * 1024, 1024, 1024, 0, nullptr, w.Wpt + L * WP_SZ, 0, 256, 1, tile, rot, tid);
        for (int i = bid * 256 + tid; i < 96 * 1024 / 8; i += G * 256) *(uint4*)(w.W1t + L * W1_SZ + (size_t)1440 * 1024 + (size_t)i * 8) = make_uint4(0u, 0u, 0u, 0u);
        for (int i = bid * 256 + tid; i < 128 * 1024; i += G * 256) {
            int n = i >> 10, k = i & 1023; float v = 0.f;
            if (n < 4) v = in.router_group_w[(size_t)L * 1024 * 4 + k * 4 + n];
            else if (n < 36) v = in.router_expert_w[(size_t)L * 1024 * 32 + k * 32 + (n - 4)];
            v *= in.ffn_norm_g[L * 1024 + k];
            w.Wrt[L * WR_SZ + i] = (bf16_t)f2bf(v);
        }
        for (int i = bid * 256 + tid; i < 4 * 128 * 128; i += G * 256) {
            int jj = i & 127, ii = (i >> 7) & 127;
            float v = (jj <= ii) ? in.sgu_w[(size_t)L * WSM_SZ + i] : 0.f;
            w.Wsm[L * WSM_SZ + i] = (bf16_t)f2bf(v);
        }
    }
    for (int i = bid * 256 + tid; i < NT * 16; i += G * 256) {
        int t = i >> 4, j = i & 15;
        float c, sn; rope_cs(in.positions[t], j, c, sn);
        w.cs[t * 32 + j] = c; w.cs[t * 32 + 16 + j] = sn;
    }
    for (size_t i = (size_t)bid * 256 + tid; i < (size_t)NT * 1024 / 4; i += (size_t)G * 256) {
        float4 v = ((const float4*)in.x)[i];
        ((float4*)P.h)[i] = v;
        uint2 pk; pk.x = pack2(v.x, v.y); pk.y = pack2(v.z, v.w);
        ((uint2*)w.hb)[i] = pk;
    }
}

__device__ __forceinline__ int lds_off(int row, int chunk) { return row * 128 + ((chunk ^ ((row >> 1) & 7)) << 4); }

template <typename AT> struct ARaw;
template <> struct ARaw<bf16_t> { uint4 v[4]; };
template <> struct ARaw<float> { float4 v[4][2]; };

__device__ __forceinline__ void a_load(ARaw<bf16_t>& r, const bf16_t* const (&rowp)[4], int koff) {
#pragma unroll
    for (int i = 0; i < 4; ++i) r.v[i] = *(const uint4*)(rowp[i] + koff);
}
__device__ __forceinline__ void a_load(ARaw<float>& r, const float* const (&rowp)[4], int koff) {
#pragma unroll
    for (int i = 0; i < 4; ++i) { r.v[i][0] = *(const float4*)(rowp[i] + koff); r.v[i][1] = *(const float4*)(rowp[i] + koff + 4); }
}
template <bool SUMSQ> __device__ __forceinline__ uint4 a_cvt(const uint4& v, float& ss) {
    if (SUMSQ) {
        float a;
        a = bflo(v.x); ss = fmaf(a, a, ss); a = bfhi(v.x); ss = fmaf(a, a, ss);
        a = bflo(v.y); ss = fmaf(a, a, ss); a = bfhi(v.y); ss = fmaf(a, a, ss);
        a = bflo(v.z); ss = fmaf(a, a, ss); a = bfhi(v.z); ss = fmaf(a, a, ss);
        a = bflo(v.w); ss = fmaf(a, a, ss); a = bfhi(v.w); ss = fmaf(a, a, ss);
    }
    return v;
}
template <bool SUMSQ> __device__ __forceinline__ void a_store(const ARaw<bf16_t>& r, char* ldsA, int tid, float (&ss)[4]) {
#pragma unroll
    for (int i = 0; i < 4; ++i) { uint4 v = a_cvt<SUMSQ>(r.v[i], ss[i]); *(uint4*)(ldsA + lds_off((tid >> 3) + 32 * i, tid & 7)) = v; }
}
template <bool SUMSQ> __device__ __forceinline__ void a_store(const ARaw<float>& r, char* ldsA, int tid, float (&ss)[4]) {
#pragma unroll
    for (int i = 0; i < 4; ++i) {
        const float4 a = r.v[i][0], b = r.v[i][1];
        if (SUMSQ) ss[i] += a.x * a.x + a.y * a.y + a.z * a.z + a.w * a.w + b.x * b.x + b.y * b.y + b.z * b.z + b.w * b.w;
        uint4 v; v.x = pack2(a.x, a.y); v.y = pack2(a.z, a.w); v.z = pack2(b.x, b.y); v.w = pack2(b.z, b.w);
        *(uint4*)(ldsA + lds_off((tid >> 3) + 32 * i, tid & 7)) = v;
    }
}

struct bf16x3_t {};
template <> struct ARaw<bf16x3_t> { uint4 a[4], b[4], c[4]; };
struct Rows3 { const bf16_t* p[2][4]; };
__device__ __forceinline__ void a_load(ARaw<bf16x3_t>& r, const Rows3& rows, int koff) {
#pragma unroll
    for (int i = 0; i < 4; ++i) { r.a[i] = *(const uint4*)(rows.p[0][i] + koff); r.b[i] = *(const uint4*)(rows.p[1][i] + koff); r.c[i] = *(const uint4*)(rows.p[1][i] + koff + 1024); }
}
__device__ __forceinline__ unsigned add3pk(unsigned a, unsigned b, unsigned c, float& ss) {
    const float lo = bflo(a) + bflo(b) + bflo(c), hi = bfhi(a) + bfhi(b) + bfhi(c);
    ss = fmaf(lo, lo, ss); ss = fmaf(hi, hi, ss);
    return pack2(lo, hi);
}
template <bool SUMSQ> __device__ __forceinline__ void a_store(const ARaw<bf16x3_t>& r, char* ldsA, int tid, float (&ss)[4]) {
#pragma unroll
    for (int i = 0; i < 4; ++i) {
        uint4 v;
        v.x = add3pk(r.a[i].x, r.b[i].x, r.c[i].x, ss[i]); v.y = add3pk(r.a[i].y, r.b[i].y, r.c[i].y, ss[i]);
        v.z = add3pk(r.a[i].z, r.b[i].z, r.c[i].z, ss[i]); v.w = add3pk(r.a[i].w, r.b[i].w, r.c[i].w, ss[i]);
        *(uint4*)(ldsA + lds_off((tid >> 3) + 32 * i, tid & 7)) = v;
    }
}

template <typename AT, bool SUMSQ, int SUNROLL = 4, typename AROWS>
__device__ __forceinline__ void gemm_mainloop(f32x16 (&acc)[2][2], const AROWS& arow, const bf16_t* const (&wrow)[4], int nkt, char* lds, float (&ss)[4], const int tid) {
    const int lane = tid & 63, wid = tid >> 6, wr = wid >> 1, wc = wid & 1;
    ARaw<AT> ra; ARaw<bf16_t> rb; float dummy[4] = {0.f, 0.f, 0.f, 0.f};
    a_load(ra, arow, 0); a_load(rb, wrow, 0);
    a_store<SUMSQ>(ra, lds, tid, ss); a_store<false>(rb, lds + 16384, tid, dummy);
    __syncthreads();
    const int fr = lane & 31, fh = lane >> 5;
#pragma unroll 1
    for (int kt = 0; kt < nkt; ++kt) {
        char* cur = lds + (kt & 1) * 32768;
        char* nxt = lds + ((kt + 1) & 1) * 32768;
        const bool more = (kt + 1 < nkt);
        if (more) { a_load(ra, arow, (kt + 1) * 64); a_load(rb, wrow, (kt + 1) * 64); }
#pragma unroll SUNROLL
        for (int s = 0; s < 4; ++s) {
            bf16x8 xa[2], wb[2];
#pragma unroll
            for (int i = 0; i < 2; ++i) xa[i] = *(const bf16x8*)(cur + lds_off(wr * 64 + i * 32 + fr, 2 * s + fh));
#pragma unroll
            for (int j = 0; j < 2; ++j) wb[j] = *(const bf16x8*)(cur + 16384 + lds_off(wc * 64 + j * 32 + fr, 2 * s + fh));
#pragma unroll
            for (int i = 0; i < 2; ++i)
#pragma unroll
                for (int j = 0; j < 2; ++j) acc[i][j] = __builtin_amdgcn_mfma_f32_32x32x16_bf16(wb[j], xa[i], acc[i][j], 0, 0, 0);
        }
        if (more) { a_store<SUMSQ>(ra, nxt, tid, ss); a_store<false>(rb, nxt + 16384, tid, dummy); }
        __syncthreads();
    }
}
__device__ __forceinline__ void acc_zero(f32x16 (&acc)[2][2]) {
#pragma unroll
    for (int i = 0; i < 2; ++i)
#pragma unroll
        for (int j = 0; j < 2; ++j)
#pragma unroll
            for (int r = 0; r < 16; ++r) acc[i][j][r] = 0.f;
}
__device__ __forceinline__ void publish_rowstat(float (&ss)[4], float* stat, float invK, bool as_rstd, const int tid) {
#pragma unroll
    for (int i = 0; i < 4; ++i) {
        float v = ss[i];
        v += __shfl_xor(v, 1); v += __shfl_xor(v, 2); v += __shfl_xor(v, 4);
        if ((tid & 7) == 0) stat[(tid >> 3) + 32 * i] = as_rstd ? rsqrtf(v * invK + EPS) : v;
    }
    __syncthreads();
}
__device__ __forceinline__ int nidx(int r, int fh) { return (r & 3) + 8 * (r >> 2) + 4 * fh; }
__device__ __forceinline__ void store4(bf16_t* p, float a, float b, float c, float d) {
    uint2 v; v.x = pack2(a, b); v.y = pack2(c, d); *(uint2*)p = v;
}

__device__ __forceinline__ bool xcd_item(int it, int MT, int NTl, int& mt, int& nt) {
    const int x = blockIdx.x & 7, lb = blockIdx.x >> 3, nlb = gridDim.x >> 3;
    const int li = it * nlb + lb, per = (MT >> 3) * NTl;
    if (li >= per) return false;
    mt = (li / NTl) * 8 + x; nt = li % NTl; return true;
}

constexpr int TLD = 132;
constexpr int STAT_OFF = 128 * TLD * 4;
constexpr int LDS_GEMM_BYTES = STAT_OFF + 1024;
__device__ __forceinline__ void acc_to_lds(const f32x16 (&acc)[2][2], float* T, const int tid) {
    const int lane = tid & 63, wid = tid >> 6, wr = wid >> 1, wc = wid & 1, fr = lane & 31, fh = lane >> 5;
#pragma unroll
    for (int i = 0; i < 2; ++i)
#pragma unroll
        for (int j = 0; j < 2; ++j)
#pragma unroll
            for (int g = 0; g < 4; ++g) {
                float4 v; v.x = acc[i][j][4 * g]; v.y = acc[i][j][4 * g + 1]; v.z = acc[i][j][4 * g + 2]; v.w = acc[i][j][4 * g + 3];
                *(float4*)(T + (wr * 64 + i * 32 + fr) * TLD + wc * 64 + j * 32 + 8 * g + 4 * fh) = v;
            }
    __syncthreads();
}
__device__ __forceinline__ float grp_sum16(float v) { v += __shfl_xor(v, 1); v += __shfl_xor(v, 2); v += __shfl_xor(v, 4); v += __shfl_xor(v, 8); return v; }
__device__ __forceinline__ float grp_sum32(float v) { v = grp_sum16(v); v += __shfl_xor(v, 16); return v; }

}
namespace fx {

__device__ void phase_zgemm(const Params& P, int L, char* lds) {
    const WS& w = P.w; const nv::Inputs& in = P.in;
    const int tid0 = opaque_tid();
    float* T = (float*)lds; float* stat = (float*)(lds + STAT_OFF);
    const bf16_t* Wt = w.W1t + L * W1_SZ;
    int mt, nt;
    for (int it = 0; xcd_item(it, 128, 12, mt, nt); ++it) {
        int tid = tid0; asm volatile("" : "+v"(tid));
        const int lane = tid & 63, wid = tid >> 6;
        const int m0 = mt * 128, n0 = nt * 128;
        {
            const bf16_t* arow[4]; const bf16_t* wrow[4];
#pragma unroll
            for (int i = 0; i < 4; ++i) {
                arow[i] = w.hb + (size_t)(m0 + (tid >> 3) + 32 * i) * 1024 + (tid & 7) * 8;
                wrow[i] = Wt + (size_t)(n0 + (tid >> 3) + 32 * i) * 1024 + (tid & 7) * 8;
            }
            f32x16 acc[2][2]; acc_zero(acc);
            float ss[4] = {0.f, 0.f, 0.f, 0.f};
            gemm_mainloop<bf16_t, true>(acc, arow, wrow, 16, lds, ss, tid);
            publish_rowstat(ss, stat, 1.f / 1024.f, true, tid);
            acc_to_lds(acc, T, tid);
        }
        if (nt < 2) {
#pragma unroll 4
            for (int rr = 0; rr < 32; ++rr) {
                const int row = wid * 32 + rr; const float rs = stat[row];
                const float2 x = *(const float2*)(T + row * TLD + 2 * lane);
                *(unsigned*)(w.ub + (size_t)(m0 + row) * 256 + nt * 128 + 2 * lane) = pack2(gelu_tanh_(x.x * rs), gelu_tanh_(x.y * rs));
            }
        } else if (nt < 4) {
            const int hd = (nt - 2) * 2 + (lane >> 5);
            const float2 lg = *(const float2*)(in.sgu_ln_g + L * 256 + hd * 64 + 2 * (lane & 31));
            const float2 lb = *(const float2*)(in.sgu_ln_b + L * 256 + hd * 64 + 2 * (lane & 31));
#pragma unroll 4
            for (int rr = 0; rr < 32; ++rr) {
                const int row = wid * 32 + rr; const float rs = stat[row];
                float2 x = *(const float2*)(T + row * TLD + 2 * lane);
                x.x = gelu_tanh_(x.x * rs); x.y = gelu_tanh_(x.y * rs);
                const float mean = grp_sum32(x.x + x.y) * (1.f / 64.f);
                const float dx = x.x - mean, dy = x.y - mean;
                const float rv = rsqrtf(grp_sum32(dx * dx + dy * dy) * (1.f / 64.f) + EPS);
                float2 o; o.x = dx * rv * lg.x + lb.x; o.y = dy * rv * lg.y + lb.y;
                *(float2*)(T + row * TLD + 2 * lane) = o;
            }
            __syncthreads();
            {
                const int c = tid & 127, th = tid >> 7, hd2 = (nt - 2) * 2 + (c >> 6), d = c & 63;
                bf16_t* dst = w.vT + ((size_t)(mt * 4 + hd2) * 64 + d) * 128 + th * 64;
#pragma unroll 2
                for (int k8 = 0; k8 < 8; ++k8) {
                    float v[8];
#pragma unroll
                    for (int k = 0; k < 8; ++k) v[k] = T[(th * 64 + k8 * 8 + k) * TLD + c];
                    uint4 pk; pk.x = pack2(v[0], v[1]); pk.y = pack2(v[2], v[3]); pk.z = pack2(v[4], v[5]); pk.w = pack2(v[6], v[7]);
                    *(uint4*)(dst + k8 * 8) = pk;
                }
            }
        } else if (nt < 8) {
#pragma unroll 4
            for (int rr = 0; rr < 32; ++rr) {
                const int row = wid * 32 + rr; const float rs = stat[row];
                const float2 x = *(const float2*)(T + row * TLD + 2 * lane);
                w.ygb[(size_t)(m0 + row) * 256 + (nt - 4) * 64 + lane] = (bf16_t)f2bf(x.x * rs * sigmoid_(x.y * rs));
            }
        } else if (nt < 11) {
            bf16_t* base; int ld, cb;
            if (nt < 10) { base = w.cqb; ld = 256; cb = (nt - 8) * 128; } else { base = w.ckvb; ld = 128; cb = 0; }
#pragma unroll 4
            for (int rr = 0; rr < 32; ++rr) {
                const int row = wid * 32 + rr; const float rs = stat[row];
                const float2 x = *(const float2*)(T + row * TLD + 2 * lane);
                *(unsigned*)(base + (size_t)(m0 + row) * ld + cb + 2 * lane) = pack2(x.x * rs, x.y * rs);
            }
        } else {
            const float2 kg = *(const float2*)(in.k_norm_g + L * 96 + 64 + 2 * (lane & 15));
#pragma unroll 4
            for (int rr = 0; rr < 32; ++rr) {
                const int row = wid * 32 + rr; const float rs = stat[row]; const int tok = m0 + row;
                float2 x = *(const float2*)(T + row * TLD + 2 * (lane & 15));
                x.x *= rs; x.y *= rs;
                const float rn = rsqrtf(grp_sum16(x.x * x.x + x.y * x.y) * (1.f / 32.f) + EPS);
                x.x *= rn * kg.x; x.y *= rn * kg.y;
                const float ox = __shfl_xor(x.x, 8), oy = __shfl_xor(x.y, 8);
                const int jj = (2 * lane) & 15;
                const float2 c = *(const float2*)(w.cs + (size_t)tok * 32 + jj), sn = *(const float2*)(w.cs + (size_t)tok * 32 + 16 + jj);
                float2 o;
                if ((lane & 8) == 0) { o.x = x.x * c.x - ox * sn.x; o.y = x.y * c.y - oy * sn.y; }
                else { o.x = x.x * c.x + ox * sn.x; o.y = x.y * c.y + oy * sn.y; }
                if (lane < 16) *(unsigned*)(w.kpeb + (size_t)tok * 32 + 2 * lane) = pack2(o.x, o.y);
            }
        }
        __syncthreads();
    }
}

__global__ void k_shim_z(Params P, int t0) {
    const WS& w = P.w;
    size_t idx = (size_t)blockIdx.x * blockDim.x + threadIdx.x;
    if (idx >= (size_t)2048 * 1440) return;
    int t = t0 + (int)(idx / 1440), c = (int)(idx % 1440);
    float v = 0.f;
    if (c < 256) v = bf2f(w.ub[(size_t)t * 256 + c]);
    else if (c < 512) { int cc = c - 256; v = bf2f(w.vT[((size_t)((t >> 7) * 4 + (cc >> 6)) * 64 + (cc & 63)) * 128 + (t & 127)]); }
    else if (c < 768) v = bf2f(w.ygb[(size_t)t * 256 + c - 512]);
    else if (c < 1024) v = 0.f;
    else if (c < 1280) v = bf2f(w.cqb[(size_t)t * 256 + c - 1024]);
    else if (c < 1408) v = bf2f(w.ckvb[(size_t)t * 128 + c - 1280]);
    else v = bf2f(w.kpeb[(size_t)t * 32 + c - 1408]);
    P.zf[idx] = v;
}
__global__ void k_shim_hb(Params P) {
    size_t i = (size_t)blockIdx.x * blockDim.x + threadIdx.x;
    if (i >= (size_t)NT * 1024 / 4) return;
    float4 v = ((const float4*)P.h)[i];
    uint2 pk; pk.x = pack2(v.x, v.y); pk.y = pack2(v.z, v.w);
    ((uint2*)P.w.hb)[i] = pk;
}

}
namespace fx {

constexpr float QSCALE = 0.10206207261596575f * 1.4426950408889634f;

__device__ void qkv_item(const Params& P, int L, const bool isq, const int mt, const int nt, char* lds, const int tid_in) {
    int tid = tid_in; asm volatile("" : "+v"(tid));
    const WS& w = P.w; const nv::Inputs& in = P.in;
    const int lane = tid & 63, wid = tid >> 6;
    float* T = (float*)lds; float* stat = (float*)(lds + STAT_OFF);
    const int m0 = mt * 128, n0 = nt * 128;
    const int K = isq ? 256 : 128;
    {
        const bf16_t* A = isq ? w.cqb : w.ckvb;
        const bf16_t* Wt = isq ? (w.Wuqt + L * WUQ_SZ) : (w.Wukvt + L * WUKV_SZ);
        const bf16_t* arow[4]; const bf16_t* wrow[4];
#pragma unroll
        for (int i = 0; i < 4; ++i) {
            arow[i] = A + (size_t)(m0 + (tid >> 3) + 32 * i) * K + (tid & 7) * 8;
            wrow[i] = Wt + (size_t)(n0 + (tid >> 3) + 32 * i) * K + (tid & 7) * 8;
        }
        f32x16 acc[2][2]; acc_zero(acc);
        float ss[4] = {0.f, 0.f, 0.f, 0.f};
        gemm_mainloop<bf16_t, true>(acc, arow, wrow, K / 64, lds, ss, tid);
        publish_rowstat(ss, stat, 1.f / (float)K, true, tid);
        acc_to_lds(acc, T, tid);
    }
    const int b = m0 >> 11, s0 = m0 & 2047;
    if (isq && nt < 4) {
        const int hd = nt * 2 + (lane >> 5), d = 2 * (lane & 31);
        const float2 g = *(const float2*)(in.q_norm_g + L * 96 + d);
        bf16_t* dst = w.Qb + ((size_t)(b * 8 + hd) * 2048 + s0) * 96 + d;
#pragma unroll 4
        for (int rr = 0; rr < 32; ++rr) {
            const int row = wid * 32 + rr; const float rs = stat[row];
            float2 x = *(const float2*)(T + row * TLD + 2 * lane);
            x.x *= rs; x.y *= rs;
            const float rn = rsqrtf(grp_sum32(x.x * x.x + x.y * x.y) * (1.f / 64.f) + EPS) * QSCALE;
            *(unsigned*)(dst + (size_t)row * 96) = pack2(x.x * rn * g.x, x.y * rn * g.y);
        }
    } else if (isq) {
        const int hd = (nt - 4) * 4 + (lane >> 4), d = 2 * (lane & 15);
        const float2 g = *(const float2*)(in.q_norm_g + L * 96 + 64 + d);
        bf16_t* dst = w.Qb + ((size_t)(b * 8 + hd) * 2048 + s0) * 96 + 64 + d;
        const int jj = d & 15;
#pragma unroll 4
        for (int rr = 0; rr < 32; ++rr) {
            const int row = wid * 32 + rr; const float rs = stat[row]; const int tok = m0 + row;
            float2 x = *(const float2*)(T + row * TLD + 2 * lane);
            x.x *= rs; x.y *= rs;
            const float rn = rsqrtf(grp_sum16(x.x * x.x + x.y * x.y) * (1.f / 32.f) + EPS);
            x.x *= rn * g.x; x.y *= rn * g.y;
            const float ox = __shfl_xor(x.x, 8), oy = __shfl_xor(x.y, 8);
            const float2 c = *(const float2*)(w.cs + (size_t)tok * 32 + jj), sn = *(const float2*)(w.cs + (size_t)tok * 32 + 16 + jj);
            float2 o;
            if ((lane & 8) == 0) { o.x = x.x * c.x - ox * sn.x; o.y = x.y * c.y - oy * sn.y; }
            else { o.x = x.x * c.x + ox * sn.x; o.y = x.y * c.y + oy * sn.y; }
            *(unsigned*)(dst + (size_t)row * 96) = pack2(o.x * QSCALE, o.y * QSCALE);
        }
    } else if (nt < 4) {
        const int hd = nt * 2 + (lane >> 5), d = 2 * (lane & 31);
        const float2 g = *(const float2*)(in.k_norm_g + L * 96 + d);
        bf16_t* dst = w.Knb + ((size_t)(b * 8 + hd) * 2048 + s0) * 64 + d;
#pragma unroll 4
        for (int rr = 0; rr < 32; ++rr) {
            const int row = wid * 32 + rr; const float rs = stat[row];
            float2 x = *(const float2*)(T + row * TLD + 2 * lane);
            x.x *= rs; x.y *= rs;
            const float rn = rsqrtf(grp_sum32(x.x * x.x + x.y * x.y) * (1.f / 64.f) + EPS);
            *(unsigned*)(dst + (size_t)row * 64) = pack2(x.x * rn * g.x, x.y * rn * g.y);
        }
    } else {
        const int c = tid & 127, th = tid >> 7, hd = (nt - 4) * 2 + (c >> 6), d = c & 63;
        bf16_t* dst = w.VTb + ((size_t)(b * 8 + hd) * 64 + d) * 2048 + s0 + th * 64;
#pragma unroll 2
        for (int k8 = 0; k8 < 8; ++k8) {
            float v[8];
#pragma unroll
            for (int k = 0; k < 8; ++k) { const int row = th * 64 + k8 * 8 + k; v[k] = T[row * TLD + c] * stat[row]; }
            uint4 pk; pk.x = pack2(v[0], v[1]); pk.y = pack2(v[2], v[3]); pk.z = pack2(v[4], v[5]); pk.w = pack2(v[6], v[7]);
            *(uint4*)(dst + k8 * 8) = pk;
        }
    }
    __syncthreads();
}

__device__ void sgu_item(const Params& P, int L, int mt, char* lds, const int tid_in) {
    int tid = tid_in; asm volatile("" : "+v"(tid));
    const WS& w = P.w; const nv::Inputs& in = P.in;
    const int lane = tid & 63, hd = tid >> 6, fr = lane & 31, fh = lane >> 5;
    float* red = (float*)lds;
    const bf16_t* vt = w.vT + (size_t)(mt * 4 + hd) * 64 * 128;
    const bf16_t* ws = w.Wsm + L * WSM_SZ + (size_t)hd * 128 * 128;
    const float* bs = in.sgu_b + L * 512 + hd * 128;
    const int m0 = mt * 128;
#pragma unroll 1
    for (int it = 0; it < 4; ++it) {
        f32x16 a0, a1;
#pragma unroll
        for (int r = 0; r < 16; ++r) { a0[r] = 0.f; a1[r] = 0.f; }
        const int nks = 2 * (it + 1);
        const bf16_t* bp = ws + (size_t)(it * 32 + fr) * 128 + 8 * fh;
        const bf16_t* ap0 = vt + (size_t)fr * 128 + 8 * fh;
        const bf16_t* ap1 = vt + (size_t)(32 + fr) * 128 + 8 * fh;
#pragma unroll 2
        for (int s = 0; s < nks; ++s) {
            const bf16x8 bfrag = *(const bf16x8*)(bp + 16 * s);
            const bf16x8 af0 = *(const bf16x8*)(ap0 + 16 * s), af1 = *(const bf16x8*)(ap1 + 16 * s);
            a0 = __builtin_amdgcn_mfma_f32_32x32x16_bf16(af0, bfrag, a0, 0, 0, 0);
            a1 = __builtin_amdgcn_mfma_f32_32x32x16_bf16(af1, bfrag, a1, 0, 0, 0);
        }
        const int i = it * 32 + fr, tok = m0 + i;
        const float bias = bs[i];
        float ssq = 0.f;
#pragma unroll
        for (int dt = 0; dt < 2; ++dt)
#pragma unroll
            for (int g = 0; g < 4; ++g) {
                const int d = dt * 32 + 8 * g + 4 * fh;
                const uint2 uu = *(const uint2*)(w.ub + (size_t)tok * 256 + hd * 64 + d);
                float o[4];
#pragma unroll
                for (int q = 0; q < 4; ++q) {
                    const float sv = (dt == 0 ? a0[4 * g + q] : a1[4 * g + q]) + bias;
                    const float uv = (q == 0) ? bflo(uu.x) : (q == 1) ? bfhi(uu.x) : (q == 2) ? bflo(uu.y) : bfhi(uu.y);
                    o[q] = uv * sv; ssq += o[q] * o[q];
                }
                store4(w.yb + (size_t)tok * 1024 + hd * 64 + d, o[0], o[1], o[2], o[3]);
            }
        ssq = xor32(ssq);
        if (fh == 0) red[hd * 128 + i] = ssq;
    }
    __syncthreads();
    if (tid < 128) w.ssq[(size_t)(m0 + tid) * 16 + 0] = red[tid] + red[128 + tid] + red[256 + tid] + red[384 + tid];
    __syncthreads();
}

constexpr int CLD = 260, CONV_YL = 32 * CLD * 4, CONV_ST = CONV_YL + 32 * 512, CONV_RED = CONV_ST + 32 * 4 * 8;
__device__ __forceinline__ int yl_off(int row, int chunk) { return row * 512 + ((chunk ^ (row & 15)) << 4); }
__device__ void conv_item(const Params& P, int L, int ct, char* lds, const int tid_in) {
    int tid = tid_in; asm volatile("" : "+v"(tid));
    const WS& w = P.w; const nv::Inputs& in = P.in;
    const int lane = tid & 63, wid = tid >> 6, fr = lane & 31, fh = lane >> 5;
    float* C = (float*)lds; char* yl = lds + CONV_YL; float2* stats = (float2*)(lds + CONV_ST); float* red = (float*)(lds + CONV_RED);
    const int t0 = ct * 32, s0 = t0 & 2047;
    {
        const int c = tid;
        float x[62];
#pragma unroll
        for (int r = 0; r < 62; ++r) x[r] = (s0 + r - 30 >= 0) ? bf2f(w.ygb[(size_t)(t0 + r - 30) * 256 + c]) : 0.f;
        float wk[31];
#pragma unroll
        for (int k = 0; k < 31; ++k) wk[k] = in.conv_w[(size_t)L * 31 * 256 + k * 256 + c];
        const float cb = in.conv_b[L * 256 + c];
#pragma unroll
        for (int t = 0; t < 32; ++t) {
            float a = cb;
#pragma unroll
            for (int k = 0; k < 31; ++k) a = fmaf(wk[k], x[t + k], a);
            C[t * CLD + c] = a;
        }
    }
    __syncthreads();
    if (tid < 128) {
        const int t = tid >> 2, g = tid & 3;
        const float4* cp = (const float4*)(C + t * CLD + g * 64);
        float4 v[16]; float s = 0.f;
#pragma unroll
        for (int i = 0; i < 16; ++i) { v[i] = cp[i]; s += (v[i].x + v[i].y) + (v[i].z + v[i].w); }
        const float mean = s * (1.f / 64.f); float q = 0.f;
#pragma unroll
        for (int i = 0; i < 16; ++i) { const float a = v[i].x - mean, b2 = v[i].y - mean, c2 = v[i].z - mean, d2 = v[i].w - mean; q += (a * a + b2 * b2) + (c2 * c2 + d2 * d2); }
        stats[t * 4 + g] = make_float2(mean, rsqrtf(q * (1.f / 64.f) + EPS));
    }
    __syncthreads();
    {
        const int c = tid, g = c >> 6;
        const float lg = in.conv_ln_g[L * 256 + c], lb = in.conv_ln_b[L * 256 + c];
#pragma unroll 8
        for (int t = 0; t < 32; ++t) {
            const float2 st = stats[t * 4 + g];
            const float v = (C[t * CLD + c] - st.x) * st.y * lg + lb;
            *(bf16_t*)(yl + yl_off(t, c >> 3) + (c & 7) * 2) = (bf16_t)f2bf(v * sigmoid_(v));
        }
    }
    __syncthreads();
    f32x16 acc0, acc1;
#pragma unroll
    for (int r = 0; r < 16; ++r) { acc0[r] = 0.f; acc1[r] = 0.f; }
    const bf16_t* wp = w.Wpwt + L * WPW_SZ + (size_t)(wid * 64 + fr) * 256 + 8 * fh;
#pragma unroll 4
    for (int s = 0; s < 16; ++s) {
        const bf16x8 w0 = *(const bf16x8*)(wp + 16 * s), w1 = *(const bf16x8*)(wp + 32 * 256 + 16 * s);
        const bf16x8 x0 = *(const bf16x8*)(yl + yl_off(fr, 2 * s + fh));
        acc0 = __builtin_amdgcn_mfma_f32_32x32x16_bf16(w0, x0, acc0, 0, 0, 0);
        acc1 = __builtin_amdgcn_mfma_f32_32x32x16_bf16(w1, x0, acc1, 0, 0, 0);
    }
    const float* pb = in.conv_pw_b + L * 256;
    {
        const int tok = t0 + fr;
        float ssq = 0.f;
#pragma unroll
        for (int jn = 0; jn < 2; ++jn)
#pragma unroll
            for (int g = 0; g < 4; ++g) {
                const int n = wid * 64 + jn * 32 + 8 * g + 4 * fh;
                const float4 b4 = *(const float4*)(pb + n);
                const float o0 = (jn ? acc1[4 * g] : acc0[4 * g]) + b4.x, o1 = (jn ? acc1[4 * g + 1] : acc0[4 * g + 1]) + b4.y;
                const float o2 = (jn ? acc1[4 * g + 2] : acc0[4 * g + 2]) + b4.z, o3 = (jn ? acc1[4 * g + 3] : acc0[4 * g + 3]) + b4.w;
                ssq += o0 * o0 + o1 * o1 + o2 * o2 + o3 * o3;
                store4(w.yb + (size_t)tok * 1024 + 256 + n, o0, o1, o2, o3);
            }
        ssq = xor32(ssq);
        if (fh == 0) red[wid * 32 + fr] = ssq;
    }
    __syncthreads();
    if (tid < 32) w.ssq[(size_t)(t0 + tid) * 16 + 1] = red[tid] + red[32 + tid] + red[64 + tid] + red[96 + tid];
    __syncthreads();
}

__device__ void phase_mix(const Params& P, int L, char* lds) {
    const int tid = opaque_tid();
    int mt, nt;
    for (int it = 0; xcd_item(it, 128, 6, mt, nt); ++it) qkv_item(P, L, true, mt, nt, lds, tid);
    for (int it = 0; xcd_item(it, 128, 8, mt, nt); ++it) qkv_item(P, L, false, mt, nt, lds, tid);
    for (int ct = blockIdx.x; ct < 512; ct += gridDim.x) conv_item(P, L, ct, lds, tid);
    {
        const int x = blockIdx.x & 7, lb = blockIdx.x >> 3, nlb = gridDim.x >> 3;
        const int lo = nlb >= 48 ? 32 : 0;
        for (int j = lb - lo; j >= 0 && j < 16; j += nlb) sgu_item(P, L, j * 8 + x, lds, tid);
    }
}

__global__ void k_shim_qkv(Params P, int t0, float* q, float* kv) {
    const WS& w = P.w;
    size_t idx = (size_t)blockIdx.x * blockDim.x + threadIdx.x;
    if (idx >= (size_t)2048 * 1792) return;
    const int tl = (int)(idx / 1792), c = (int)(idx % 1792), t = t0 + tl, b = t >> 11, s = t & 2047;
    if (c < 768) { const int h = c / 96, d = c % 96; q[(size_t)tl * 768 + c] = bf2f(w.Qb[((size_t)(b * 8 + h) * 2048 + s) * 96 + d]) * (1.f / QSCALE); }
    else {
        const int cc = c - 768, h = cc >> 7, d = cc & 127;
        kv[(size_t)tl * 1024 + cc] = (d < 64) ? bf2f(w.Knb[((size_t)(b * 8 + h) * 2048 + s) * 64 + d]) : bf2f(w.VTb[((size_t)(b * 8 + h) * 64 + (d - 64)) * 2048 + s]);
    }
}
__global__ void k_shim_y(Params P, int t0, int c0, int c1) {
    const int wdt = c1 - c0;
    size_t idx = (size_t)blockIdx.x * blockDim.x + threadIdx.x;
    if (idx >= (size_t)2048 * wdt) return;
    const int tl = (int)(idx / wdt), c = c0 + (int)(idx % wdt);
    P.yf[(size_t)tl * 1024 + c] = bf2f(P.w.yb[(size_t)(t0 + tl) * 1024 + c]);
}

}
namespace fx {

constexpr int KROW = 208, VROW = 136, ATT_STAGE = 64 * KROW + 64 * VROW;

struct KVRegs { uint4 k0, k1, k2, v0, v1; };
__device__ __forceinline__ uint4 k_ld(const bf16_t* Kn, const bf16_t* Kp, int k0, int c) {
    const int key = c / 12, ch = c % 12;
    const bf16_t* src = (ch < 8) ? (Kn + (size_t)(k0 + key) * 64 + ch * 8) : (Kp + (size_t)(k0 + key) * 32 + (ch - 8) * 8);
    return *(const uint4*)src;
}
__device__ __forceinline__ void kv_load(KVRegs& r, const bf16_t* Kn, const bf16_t* Kp, const bf16_t* Vt, int k0, const int tid) {
    r.k0 = k_ld(Kn, Kp, k0, tid); r.k1 = k_ld(Kn, Kp, k0, tid + 256); r.k2 = k_ld(Kn, Kp, k0, tid + 512);
    r.v0 = *(const uint4*)(Vt + (size_t)(tid >> 3) * 2048 + k0 + (tid & 7) * 8);
    r.v1 = *(const uint4*)(Vt + (size_t)(32 + (tid >> 3)) * 2048 + k0 + (tid & 7) * 8);
}
__device__ __forceinline__ void k_st(char* st, int c, const uint4& v) { const int key = c / 12, ch = c % 12; *(uint4*)(st + key * KROW + ch * 16) = v; }
__device__ __forceinline__ void v_st(char* st, int d, int ch, const uint4& v) {
    char* p = st + 64 * KROW + d * VROW + ch * 16;
    *(uint2*)p = make_uint2(v.x, v.y); *(uint2*)(p + 8) = make_uint2(v.z, v.w);
}
__device__ __forceinline__ void kv_store(const KVRegs& r, char* st, const int tid) {
    k_st(st, tid, r.k0); k_st(st, tid + 256, r.k1); k_st(st, tid + 512, r.k2);
    v_st(st, tid >> 3, tid & 7, r.v0); v_st(st, 32 + (tid >> 3), tid & 7, r.v1);
}

__device__ void attn_unit(const Params& P, int b, int h, int qt, char* lds, const int tid) {
    const WS& w = P.w;
    const int lane = tid & 63, wid = tid >> 6, fr = lane & 31, fh = lane >> 5;
    const bf16_t* Kn = w.Knb + (size_t)(b * 8 + h) * 2048 * 64;
    const bf16_t* Kp = w.kpeb + (size_t)b * 2048 * 32;
    const bf16_t* Vt = w.VTb + (size_t)(b * 8 + h) * 64 * 2048;
    const int q0 = qt * 128, qw0 = q0 + wid * 32, qpos = qw0 + fr;
    bf16x8 qf[6];
    {
        const bf16_t* qp = w.Qb + ((size_t)(b * 8 + h) * 2048 + qpos) * 96 + 8 * fh;
#pragma unroll
        for (int ks = 0; ks < 6; ++ks) qf[ks] = *(const bf16x8*)(qp + 16 * ks);
    }
    f32x16 o0, o1;
#pragma unroll
    for (int r = 0; r < 16; ++r) { o0[r] = 0.f; o1[r] = 0.f; }
    float m = -1e30f, l = 0.f;
    const int nkt = 2 * (qt + 1);
    KVRegs kr;
    kv_load(kr, Kn, Kp, Vt, 0, tid);
    kv_store(kr, lds, tid);
    __syncthreads();
#pragma unroll 1
    for (int kt = 0; kt < nkt; ++kt) {
        char* cur = lds + (kt & 1) * ATT_STAGE;
        char* nxt = lds + ((kt + 1) & 1) * ATT_STAGE;
        const bool more = kt + 1 < nkt;
        if (more) kv_load(kr, Kn, Kp, Vt, (kt + 1) * 64, tid);
        const int k0 = kt * 64;
        if (k0 <= qw0 + 31) {
            f32x16 s0, s1;
#pragma unroll
            for (int r = 0; r < 16; ++r) { s0[r] = 0.f; s1[r] = 0.f; }
            const char* kb = cur + fr * KROW + fh * 16;
#pragma unroll
            for (int ks = 0; ks < 6; ++ks) {
                const bf16x8 ka = *(const bf16x8*)(kb + ks * 32), kb2 = *(const bf16x8*)(kb + 32 * KROW + ks * 32);
                s0 = __builtin_amdgcn_mfma_f32_32x32x16_bf16(ka, qf[ks], s0, 0, 0, 0);
                s1 = __builtin_amdgcn_mfma_f32_32x32x16_bf16(kb2, qf[ks], s1, 0, 0, 0);
            }
            if (k0 + 63 > qw0) {
#pragma unroll
                for (int r = 0; r < 16; ++r) {
                    const int key = k0 + nidx(r, fh);
                    if (key > qpos) s0[r] = -1e30f;
                    if (key + 32 > qpos) s1[r] = -1e30f;
                }
            }
            float mx = s0[0];
#pragma unroll
            for (int r = 1; r < 16; ++r) mx = fmaxf(mx, s0[r]);
#pragma unroll
            for (int r = 0; r < 16; ++r) mx = fmaxf(mx, s1[r]);
            mx = fmaxf(mx, __shfl_xor(mx, 32));
            const float mn = fmaxf(m, mx);
            const float alpha = __builtin_amdgcn_exp2f(m - mn);
            m = mn;
            float ps = 0.f;
#pragma unroll
            for (int r = 0; r < 16; ++r) { s0[r] = __builtin_amdgcn_exp2f(s0[r] - mn); ps += s0[r]; }
#pragma unroll
            for (int r = 0; r < 16; ++r) { s1[r] = __builtin_amdgcn_exp2f(s1[r] - mn); ps += s1[r]; }
            ps += __shfl_xor(ps, 32);
            l = l * alpha + ps;
#pragma unroll
            for (int r = 0; r < 16; ++r) { o0[r] *= alpha; o1[r] *= alpha; }
            const char* vb = cur + 64 * KROW + fr * VROW + fh * 8;
#pragma unroll
            for (int ks = 0; ks < 4; ++ks) {
                bf16x8 pf;
                {
                    const int rb = 8 * (ks & 1);
                    unsigned u0, u1, u2, u3;
                    if (ks < 2) { u0 = pack2(s0[rb], s0[rb + 1]); u1 = pack2(s0[rb + 2], s0[rb + 3]); u2 = pack2(s0[rb + 4], s0[rb + 5]); u3 = pack2(s0[rb + 6], s0[rb + 7]); }
                    else { u0 = pack2(s1[rb], s1[rb + 1]); u1 = pack2(s1[rb + 2], s1[rb + 3]); u2 = pack2(s1[rb + 4], s1[rb + 5]); u3 = pack2(s1[rb + 6], s1[rb + 7]); }
                    uint4 uu = make_uint4(u0, u1, u2, u3);
                    pf = __builtin_bit_cast(bf16x8, uu);
                }
                const uint2 va0 = *(const uint2*)(vb + ks * 32), va1 = *(const uint2*)(vb + ks * 32 + 16);
                const uint2 vb0 = *(const uint2*)(vb + 32 * VROW + ks * 32), vb1 = *(const uint2*)(vb + 32 * VROW + ks * 32 + 16);
                const bf16x8 vfa = __builtin_bit_cast(bf16x8, make_uint4(va0.x, va0.y, va1.x, va1.y));
                const bf16x8 vfb = __builtin_bit_cast(bf16x8, make_uint4(vb0.x, vb0.y, vb1.x, vb1.y));
                o0 = __builtin_amdgcn_mfma_f32_32x32x16_bf16(vfa, pf, o0, 0, 0, 0);
                o1 = __builtin_amdgcn_mfma_f32_32x32x16_bf16(vfb, pf, o1, 0, 0, 0);
            }
        }
        if (more) kv_store(kr, nxt, tid);
        __syncthreads();
    }
    const float inv = 1.f / l;
    const int tok = b * 2048 + qpos;
    float ssq = 0.f;
#pragma unroll
    for (int dt = 0; dt < 2; ++dt)
#pragma unroll
        for (int g = 0; g < 4; ++g) {
            float o[4];
#pragma unroll
            for (int q = 0; q < 4; ++q) { o[q] = (dt == 0 ? o0[4 * g + q] : o1[4 * g + q]) * inv; ssq += o[q] * o[q]; }
            store4(w.yb + (size_t)tok * 1024 + 512 + h * 64 + dt * 32 + 8 * g + 4 * fh, o[0], o[1], o[2], o[3]);
        }
    ssq = xor32(ssq);
    if (fh == 0) w.ssq[(size_t)tok * 16 + 8 + h] = ssq;
}

__device__ void phase_attn(const Params& P, int L, char* lds) {
    const int tid0 = opaque_tid();
    const int h = blockIdx.x & 7, nlb = gridDim.x >> 3;
    for (int li = blockIdx.x >> 3; li < 64; li += nlb) {
        int tid = tid0; asm volatile("" : "+v"(tid));
        const int p = li & 7, b = li >> 3;
        attn_unit(P, b, h, 15 - p, lds, tid);
        attn_unit(P, b, h, p, lds, tid);
    }
}

}
namespace fx {

__device__ __forceinline__ void acc_scale(f32x16 (&acc)[2][2], const float* f, const int tid) {
    const int lane = tid & 63, wr = tid >> 7, fr = lane & 31;
#pragma unroll
    for (int i = 0; i < 2; ++i) {
        const float v = f[wr * 64 + i * 32 + fr];
#pragma unroll
        for (int j = 0; j < 2; ++j)
#pragma unroll
            for (int r = 0; r < 16; ++r) acc[i][j][r] *= v;
    }
}
__device__ void phase_oproj(const Params& P, int L, char* lds, const bool dry = false) {
    const WS& w = P.w;
    const int tid0 = opaque_tid();
    float* T = (float*)lds; float* stat = (float*)(lds + STAT_OFF);
    const bf16_t* Wt = w.Wot + L * WO_SZ;
    int mt, nt;
    for (int it = 0; xcd_item(it, 128, 8, mt, nt); ++it) {
        int tid = tid0; asm volatile("" : "+v"(tid));
        const int lane = tid & 63, wid = tid >> 6;
        const int m0 = mt * 128, n0 = nt * 128;
        float rb_keep = 0.f;
        if (tid < 128) {
            const float* sq = w.ssq + (size_t)(m0 + tid) * 16;
            const float4 c0 = *(const float4*)(sq + 8), c1 = *(const float4*)(sq + 12);
            const float ra = rsqrtf(sq[0] * (1.f / 256.f) + EPS), rb = rsqrtf(sq[1] * (1.f / 256.f) + EPS);
            const float rc = rsqrtf((c0.x + c0.y + c0.z + c0.w + c1.x + c1.y + c1.z + c1.w) * (1.f / 512.f) + EPS);
            stat[tid] = rc / ra; stat[128 + tid] = ra / rb; rb_keep = rb;
        }
        {
            const bf16_t* arow[4]; const bf16_t* wrow[4];
#pragma unroll
            for (int i = 0; i < 4; ++i) {
                arow[i] = w.yb + (size_t)(m0 + (tid >> 3) + 32 * i) * 1024 + (tid & 7) * 8 + 512;
                wrow[i] = Wt + (size_t)(n0 + (tid >> 3) + 32 * i) * 1024 + (tid & 7) * 8 + 512;
            }
            f32x16 acc[2][2]; acc_zero(acc);
            float ss[4] = {0.f, 0.f, 0.f, 0.f};
            gemm_mainloop<bf16_t, false>(acc, arow, wrow, 8, lds, ss, tid);
            acc_scale(acc, stat, tid);
#pragma unroll
            for (int i = 0; i < 4; ++i) { arow[i] -= 512; wrow[i] -= 512; }
            gemm_mainloop<bf16_t, false>(acc, arow, wrow, 4, lds, ss, tid);
            acc_scale(acc, stat + 128, tid);
#pragma unroll
            for (int i = 0; i < 4; ++i) { arow[i] += 256; wrow[i] += 256; }
            gemm_mainloop<bf16_t, false>(acc, arow, wrow, 4, lds, ss, tid);
            __syncthreads();
            if (tid < 128) stat[tid] = rb_keep;
            acc_to_lds(acc, T, tid);
        }
#pragma unroll 4
        for (int rr = 0; rr < 32; ++rr) {
            const int row = wid * 32 + rr; const float rb = stat[row];
            const float2 x = *(const float2*)(T + row * TLD + 2 * lane);
            float2* hp = (float2*)(P.h + (size_t)(m0 + row) * 1024 + n0 + 2 * lane);
            float2 hv = *hp; hv.x += x.x * rb; hv.y += x.y * rb;
            if (!dry) *hp = hv;
            *(unsigned*)(w.hb1 + (size_t)(m0 + row) * 1024 + n0 + 2 * lane) = pack2(hv.x, hv.y);
        }
        __syncthreads();
    }
}

__device__ void router_item(const Params& P, int L, int mt, char* lds, const int tid_in, const bool dry) {
    int tid = tid_in; asm volatile("" : "+v"(tid));
    const WS& w = P.w; const nv::Inputs& in = P.in;
    float* T = (float*)lds; float* stat = (float*)(lds + STAT_OFF); int* hist = (int*)(lds + STAT_OFF + 512);
    const int m0 = mt * 128;
    {
        const bf16_t* arow[4]; const bf16_t* wrow[4];
#pragma unroll
        for (int i = 0; i < 4; ++i) {
            arow[i] = w.hb1 + (size_t)(m0 + (tid >> 3) + 32 * i) * 1024 + (tid & 7) * 8;
            wrow[i] = w.Wrt + L * WR_SZ + (size_t)((tid >> 3) + 32 * i) * 1024 + (tid & 7) * 8;
        }
        f32x16 acc[2][2]; acc_zero(acc);
        float ss[4] = {0.f, 0.f, 0.f, 0.f};
        gemm_mainloop<bf16_t, true>(acc, arow, wrow, 16, lds, ss, tid);
        publish_rowstat(ss, stat, 1.f / 1024.f, true, tid);
        if (tid < 32) hist[tid] = 0;
        acc_to_lds(acc, T, tid);
    }
    int e0 = 0, e1 = 0, r0 = 0, r1 = 0; float w0 = 0.f, w1 = 0.f;
    if (tid < 128) {
        const float rs = stat[tid];
        const float* lr = T + tid * TLD;
        const float* bg = in.router_group_b + L * 4; const float* be = in.router_expert_b + L * 32;
        int gi = 0; float gm = lr[0] * rs + bg[0];
#pragma unroll
        for (int j = 1; j < 4; ++j) { const float v = lr[j] * rs + bg[j]; if (v > gm) { gm = v; gi = j; } }
        float gs = 0.f;
#pragma unroll
        for (int j = 0; j < 4; ++j) gs += __expf(lr[j] * rs + bg[j] - gm);
        const float gw = 1.f / gs;
        int i0 = 0, i1 = -1; float v0 = -3.0e38f, v1 = -3.0e38f;
#pragma unroll
        for (int j = 0; j < 8; ++j) {
            const float v = lr[4 + gi * 8 + j] * rs + be[gi * 8 + j];
            if (v > v0) { v1 = v0; i1 = i0; v0 = v; i0 = j; } else if (v > v1) { v1 = v; i1 = j; }
        }
        const float ex = __expf(v1 - v0);
        w0 = gw / (1.f + ex); w1 = gw * ex / (1.f + ex);
        e0 = gi * 8 + i0; e1 = gi * 8 + i1;
        r0 = atomicAdd(&hist[e0], 1); r1 = atomicAdd(&hist[e1], 1);
    }
    __syncthreads();
    if (tid < 32) hist[32 + tid] = (hist[tid] && !dry) ? atomicAdd(&w.cnt[L * 64 + tid], hist[tid]) : 0;
    __syncthreads();
    if (tid < 128 && !dry) {
        const int tok = m0 + tid;
        const int p0 = hist[32 + e0] + r0, p1 = hist[32 + e1] + r1;
        w.elist[(size_t)e0 * NT + p0] = tok * 2; w.ewt[(size_t)e0 * NT + p0] = w0;
        w.elist[(size_t)e1 * NT + p1] = tok * 2 + 1; w.ewt[(size_t)e1 * NT + p1] = w1;
    }
    __syncthreads();
}
__device__ void eraw_item(const Params& P, int L, const int mt, const int nt, char* lds, const int tid_in) {
    int tid = tid_in; asm volatile("" : "+v"(tid));
    const WS& w = P.w; const nv::Inputs& in = P.in;
    const int lane = tid & 63, wid = tid >> 6;
    float* T = (float*)lds;
    const int m0 = mt * 128, n0 = nt * 128;
    {
        const float* arow[4]; const bf16_t* wrow[4];
#pragma unroll
        for (int i = 0; i < 4; ++i) {
            arow[i] = in.p + ((size_t)L * NT + m0 + (tid >> 3) + 32 * i) * 256 + (tid & 7) * 8;
            wrow[i] = w.Wpt + L * WP_SZ + (size_t)(n0 + (tid >> 3) + 32 * i) * 256 + (tid & 7) * 8;
        }
        f32x16 acc[2][2]; acc_zero(acc);
        float ss[4] = {0.f, 0.f, 0.f, 0.f};
        gemm_mainloop<float, false>(acc, arow, wrow, 4, lds, ss, tid);
        acc_to_lds(acc, T, tid);
    }
#pragma unroll 4
    for (int rr = 0; rr < 32; ++rr) {
        const int row = wid * 32 + rr;
        const float2 x = *(const float2*)(T + row * TLD + 2 * lane);
        *(unsigned*)(w.erb + (size_t)(m0 + row) * 1024 + n0 + 2 * lane) = pack2(x.x, x.y);
        float sq = x.x * x.x + x.y * x.y;
        sq = grp_sum32(sq); sq += __shfl_xor(sq, 32);
        if (lane == 0) w.essq[(size_t)(m0 + row) * 8 + nt] = sq;
    }
    __syncthreads();
}
__device__ void phase_router(const Params& P, int L, char* lds, const bool dry = false) {
    const int tid = opaque_tid();
    int mt, nt;
    {
        const int x = blockIdx.x & 7, lb = blockIdx.x >> 3, nlb = gridDim.x >> 3;
        const int lo = nlb >= 16 ? nlb - 16 : 0;
        for (int j = lb - lo; j >= 0 && j < 16; j += nlb) router_item(P, L, j * 8 + x, lds, tid, dry);
    }
    for (int it = 0; xcd_item(it, 128, 8, mt, nt); ++it) eraw_item(P, L, mt, nt, lds, tid);
}

constexpr int TT_OFF = STAT_OFF + 512;
__device__ __forceinline__ void moe_table(const Params& P, int L, char* lds, const int tid) {
    int* tt = (int*)(lds + TT_OFF);
    if (tid == 0) {
        const int x = blockIdx.x & 7;
        int o = 0, t = 0;
        for (int e = 0; e < 32; ++e) {
            const int c = P.w.cnt[L * 64 + e];
            tt[e] = o; o += c;
            if ((e & 7) == x) { tt[40 + (e >> 3)] = t; t += (c + 127) >> 7; }
        }
        tt[32] = o; tt[44] = t;
    }
    __syncthreads();
}
__device__ __forceinline__ void moe_find(const int* tt, int tile, int& e, int& t) {
    int k = 0;
    if (tile >= tt[41]) k = 1;
    if (tile >= tt[42]) k = 2;
    if (tile >= tt[43]) k = 3;
    e = (blockIdx.x & 7) + 8 * k; t = tile - tt[40 + k];
}
__device__ void phase_moe_up(const Params& P, int L, char* lds) {
    const WS& w = P.w;
    const int tid0 = opaque_tid();
    float* T = (float*)lds; float* stat = (float*)(lds + STAT_OFF); const int* tt = (const int*)(lds + TT_OFF);
    moe_table(P, L, lds, tid0);
    const int ntiles = tt[44];
    for (int item = blockIdx.x >> 3; item < ntiles * 4; item += (gridDim.x >> 3)) {
        int tid = tid0; asm volatile("" : "+v"(tid));
        const int lane = tid & 63, wid = tid >> 6;
        const int tile = item >> 2, nt = item & 3;
        int e, t; moe_find(tt, tile, e, t);
        const int cnt = P.w.cnt[L * 64 + e], rbase = tt[e] + t * 128, nrows = min(128, cnt - t * 128);
        {
            const bf16_t* arow[4]; const bf16_t* wrow[4];
#pragma unroll
            for (int i = 0; i < 4; ++i) {
                const int r = (tid >> 3) + 32 * i;
                const int ent = w.elist[(size_t)e * NT + t * 128 + (r < nrows ? r : 0)];
                arow[i] = w.hb1 + (size_t)(ent >> 1) * 1024 + (tid & 7) * 8;
                wrow[i] = w.Wgut + L * WGU_SZ + ((size_t)e * 512 + nt * 128 + r) * 1024 + (tid & 7) * 8;
            }
            f32x16 acc[2][2]; acc_zero(acc);
            float ss[4] = {0.f, 0.f, 0.f, 0.f};
            gemm_mainloop<bf16_t, true>(acc, arow, wrow, 16, lds, ss, tid);
            publish_rowstat(ss, stat, 1.f / 1024.f, true, tid);
            acc_to_lds(acc, T, tid);
        }
#pragma unroll 4
        for (int rr = 0; rr < 32; ++rr) {
            const int row = wid * 32 + rr; const float rs = stat[row];
            const float2 x = *(const float2*)(T + row * TLD + 2 * lane);
            const float g = x.x * rs, u = x.y * rs;
            if (row < nrows) w.hbuf[(size_t)(rbase + row) * 256 + nt * 64 + lane] = (bf16_t)f2bf(g * sigmoid_(g) * u);
        }
        __syncthreads();
    }
}
__device__ void phase_moe_down(const Params& P, int L, char* lds) {
    const WS& w = P.w;
    const int tid0 = opaque_tid();
    float* T = (float*)lds; const int* tt = (const int*)(lds + TT_OFF);
    moe_table(P, L, lds, tid0);
    const int ntiles = tt[44];
    for (int item = blockIdx.x >> 3; item < ntiles * 8; item += (gridDim.x >> 3)) {
        int tid = tid0; asm volatile("" : "+v"(tid));
        const int lane = tid & 63, wid = tid >> 6;
        const int tile = item >> 3, nt = item & 7;
        int e, t; moe_find(tt, tile, e, t);
        const int cnt = P.w.cnt[L * 64 + e], rbase = tt[e] + t * 128, nrows = min(128, cnt - t * 128);
        {
            const bf16_t* arow[4]; const bf16_t* wrow[4];
#pragma unroll
            for (int i = 0; i < 4; ++i) {
                const int r = (tid >> 3) + 32 * i;
                arow[i] = w.hbuf + (size_t)(rbase + (r < nrows ? r : 0)) * 256 + (tid & 7) * 8;
                wrow[i] = w.Wdt + L * WD_SZ + ((size_t)e * 1024 + nt * 128 + r) * 256 + (tid & 7) * 8;
            }
            f32x16 acc[2][2]; acc_zero(acc);
            float ss[4] = {0.f, 0.f, 0.f, 0.f};
            gemm_mainloop<bf16_t, false>(acc, arow, wrow, 4, lds, ss, tid);
            acc_to_lds(acc, T, tid);
        }
#pragma unroll 4
        for (int rr = 0; rr < 32; ++rr) {
            const int row = wid * 32 + rr;
            if (row < nrows) {
                const int ent = w.elist[(size_t)e * NT + t * 128 + row]; const float wt = w.ewt[(size_t)e * NT + t * 128 + row];
                const float2 x = *(const float2*)(T + row * TLD + 2 * lane);
                *(unsigned*)(w.contrib + (size_t)ent * 1024 + nt * 128 + 2 * lane) = pack2(x.x * wt, x.y * wt);
            }
        }
        __syncthreads();
    }
}

__device__ void phase_combine(const Params& P, int L, char* lds) {
    const WS& w = P.w;
    const int tid = opaque_tid();
    for (size_t i = (size_t)blockIdx.x * 256 + tid; i < (size_t)NT * 128; i += (size_t)gridDim.x * 256) {
        const size_t tok = i >> 7, c8 = (i & 127) * 8;
        const uint4 a = *(const uint4*)(w.contrib + (tok * 2) * 1024 + c8), b = *(const uint4*)(w.contrib + (tok * 2 + 1) * 1024 + c8);
        float4* hp = (float4*)(P.h + tok * 1024 + c8);
        float4 h0 = hp[0], h1 = hp[1];
        h0.x += bflo(a.x) + bflo(b.x); h0.y += bfhi(a.x) + bfhi(b.x); h0.z += bflo(a.y) + bflo(b.y); h0.w += bfhi(a.y) + bfhi(b.y);
        h1.x += bflo(a.z) + bflo(b.z); h1.y += bfhi(a.z) + bfhi(b.z); h1.z += bflo(a.w) + bflo(b.w); h1.w += bfhi(a.w) + bfhi(b.w);
        hp[0] = h0; hp[1] = h1;
        uint4 pk; pk.x = pack2(h0.x, h0.y); pk.y = pack2(h0.z, h0.w); pk.z = pack2(h1.x, h1.y); pk.w = pack2(h1.z, h1.w);
        *(uint4*)(w.hb1 + tok * 1024 + c8) = pk;
    }
}

__device__ void phase_ple(const Params& P, int L, char* lds, const bool dry = false) {
    const WS& w = P.w; const nv::Inputs& in = P.in;
    const int tid0 = opaque_tid();
    float* T = (float*)lds; float* stat = (float*)(lds + STAT_OFF);
    int mt, nt;
    for (int it = 0; xcd_item(it, 128, 8, mt, nt); ++it) {
        int tid = tid0; asm volatile("" : "+v"(tid));
        const int lane = tid & 63, wid = tid >> 6;
        const int m0 = mt * 128, n0 = nt * 128;
        {
            const bf16_t* arow[4]; const bf16_t* wrow[4];
#pragma unroll
            for (int i = 0; i < 4; ++i) {
                arow[i] = w.hb1 + (size_t)(m0 + (tid >> 3) + 32 * i) * 1024 + (tid & 7) * 8;
                wrow[i] = w.Wgt + L * WG_SZ + (size_t)(n0 + (tid >> 3) + 32 * i) * 1024 + (tid & 7) * 8;
            }
            f32x16 acc[2][2]; acc_zero(acc);
            float ss[4] = {0.f, 0.f, 0.f, 0.f};
            gemm_mainloop<bf16_t, true>(acc, arow, wrow, 16, lds, ss, tid);
            publish_rowstat(ss, stat, 1.f / 1024.f, true, tid);
            acc_to_lds(acc, T, tid);
        }
        const float2 pg = *(const float2*)(in.ple_post_norm_g + L * 1024 + n0 + 2 * lane);
#pragma unroll 4
        for (int rr = 0; rr < 32; ++rr) {
            const int row = wid * 32 + rr; const float rs = stat[row]; const size_t tok = m0 + row;
            const float4 q0 = *(const float4*)(w.essq + tok * 8), q1 = *(const float4*)(w.essq + tok * 8 + 4);
            const float re = rsqrtf((q0.x + q0.y + q0.z + q0.w + q1.x + q1.y + q1.z + q1.w) * (1.f / 1024.f) + EPS);
            const float2 x = *(const float2*)(T + row * TLD + 2 * lane);
            const size_t off = tok * 1024 + n0 + 2 * lane;
            const unsigned er = *(const unsigned*)(w.erb + off);
            float2 hv = *(const float2*)(P.h + off);
            hv.x += sigmoid_(x.x * rs) * (bflo(er) * re * pg.x);
            hv.y += sigmoid_(x.y * rs) * (bfhi(er) * re * pg.y);
            if (!dry) *(float2*)(P.h + off) = hv;
            *(unsigned*)(w.hb + off) = pack2(hv.x, hv.y);
        }
        __syncthreads();
    }
}

}
namespace fx {
#define XB_TMO      128
#define XB_XCNT(j)  (256  + 64 * (j))
#define XB_XSUB(j)  (1280 + 64 * (j))
#define XB_XGEN(j)  (2304 + 64 * (j))
#define XB_TOP      3328
#define XB_TOPGEN   3392
#define XCD_BAR_WORDS 3456
#define XB_SPIN_CAP (1u << 18)
#define LAS __attribute__((address_space(3)))
__device__ __forceinline__ unsigned xb_ld(unsigned* p)              { return __hip_atomic_load(p, __ATOMIC_RELAXED, __HIP_MEMORY_SCOPE_AGENT); }
__device__ __forceinline__ unsigned xb_add(unsigned* p, unsigned v) { return __hip_atomic_fetch_add(p, v, __ATOMIC_RELAXED, __HIP_MEMORY_SCOPE_AGENT); }
__device__ __forceinline__ unsigned xb_xcc_id() { return (unsigned)__builtin_amdgcn_s_getreg((3 << 11) | 20) & 0xFu; }
#define XB_SPIN(cond, bar) do { unsigned _sp = 0; while (cond) { __builtin_amdgcn_s_sleep(1); \
    if ((++_sp & 255u) == 0u) { if (xb_ld(&(bar)[XB_TMO])) break; if (_sp > XB_SPIN_CAP) { atomicAdd(&(bar)[XB_TMO], 1u); break; } } } } while (0)
struct XcdBarrier { unsigned* bar; unsigned x; volatile LAS unsigned* st; };
__device__ __forceinline__ XcdBarrier xcd_barrier_post(unsigned* bar, volatile LAS unsigned* st) {
    XcdBarrier b; b.bar = bar; b.x = xb_xcc_id(); b.st = st;
    if (threadIdx.x == 0) (void)xb_add(&bar[XB_XCNT(b.x)], 1u);
    return b;
}
__device__ __forceinline__ void xcd_barrier_complete(unsigned* bar, unsigned x, unsigned& nloc, unsigned& nx) {
    const unsigned G = gridDim.x * gridDim.y * gridDim.z;
    unsigned sum, cnt, mine, sp = 0u;
    for (;;) {
        sum = 0u; cnt = 0u; mine = 0u;
#pragma unroll
        for (unsigned j = 0; j < 16; ++j) { const unsigned c = xb_ld(&bar[XB_XCNT(j)]); sum += c; cnt += (c > 0u) ? 1u : 0u; mine = (j == x) ? c : mine; }
        if (sum == G) break;
        __builtin_amdgcn_s_sleep(1);
        if ((++sp & 255u) == 0u) { if (xb_ld(&bar[XB_TMO])) break; if (sp > XB_SPIN_CAP) { atomicAdd(&bar[XB_TMO], 1u); break; } }
    }
    nloc = mine > 0u ? mine : 1u; nx = cnt > 0u ? cnt : 1u;
}
__device__ __forceinline__ void xcd_barrier(const XcdBarrier& b) {
    asm volatile("s_waitcnt vmcnt(0)" ::: "memory");
    __syncthreads();
    if (threadIdx.x == 0) {
        unsigned* bar = b.bar;
        __builtin_amdgcn_s_waitcnt(0);
        unsigned nloc = b.st[0], nx = b.st[1];
        if (nloc == 0u) { xcd_barrier_complete(bar, b.x, nloc, nx); b.st[0] = nloc; b.st[1] = nx; }
        const unsigned old = xb_add(&bar[XB_XSUB(b.x)], 1u);
        const unsigned gen = old / nloc;
        if (old + 1u == (gen + 1u) * nloc) {
            __builtin_amdgcn_fence(__ATOMIC_RELEASE, "agent");
            asm volatile("s_waitcnt vmcnt(0)" ::: "memory");
            const unsigned og = xb_add(&bar[XB_TOP], 1u);
            const unsigned tg = og / nx;
            if (og + 1u == (tg + 1u) * nx) xb_add(&bar[XB_TOPGEN], 1u);
            else XB_SPIN(xb_ld(&bar[XB_TOPGEN]) == tg, bar);
            __builtin_amdgcn_fence(__ATOMIC_ACQUIRE, "agent");
            xb_add(&bar[XB_XGEN(b.x)], 1u);
            asm volatile("s_waitcnt vmcnt(0)" ::: "memory");
        } else {
            XB_SPIN(xb_ld(&bar[XB_XGEN(b.x)]) == gen, bar);
            __builtin_amdgcn_fence(__ATOMIC_ACQUIRE, "agent");
            asm volatile("s_waitcnt vmcnt(0)" ::: "memory");
        }
    }
    __syncthreads();
}

constexpr int LDS_BYTES = LDS_GEMM_BYTES + 16;
constexpr int N_PHASES = 19;
constexpr int PPL = 9;
__global__ void __launch_bounds__(256, 2) k_run(Params P, int ph_lo, int ph_hi) {
    extern __shared__ __attribute__((aligned(16))) char lds[];
    volatile LAS unsigned* st = (volatile LAS unsigned*)(lds + LDS_GEMM_BYTES);
    if (threadIdx.x == 0) { st[0] = 0u; st[1] = 0u; }
    __syncthreads();
    XcdBarrier xb = xcd_barrier_post(P.w.bar, st);
    for (int ph = ph_lo; ph < ph_hi; ++ph) {
        if (ph > ph_lo) xcd_barrier(xb);
#ifdef REP_PHASE
        if (REP_PHASE == 0 && ph == 0) { phase_prep(P, lds); xcd_barrier(xb); }
        if (ph > 0 && ((ph - 1) % PPL) == REP_PHASE - 1) {
            const int L = (ph - 1) / PPL;
            switch (REP_PHASE - 1) {
                case 0: phase_zgemm(P, L, lds); break;
                case 1: phase_mix(P, L, lds); break;
                case 2: phase_attn(P, L, lds); break;
                case 3: phase_oproj(P, L, lds, true); break;
                case 4: phase_router(P, L, lds, true); break;
                case 5: phase_moe_up(P, L, lds); break;
                case 6: phase_moe_down(P, L, lds); break;
                case 7: break;
                case 8: phase_ple(P, L, lds, true); break;
            }
            xcd_barrier(xb);
        }
#endif
        if (ph == 0) phase_prep(P, lds);
        else {
            const int L = (ph - 1) / PPL, s = (ph - 1) % PPL;
            switch (s) {
                case 0: phase_zgemm(P, L, lds); break;
                case 1: phase_mix(P, L, lds); break;
                case 2: phase_attn(P, L, lds); break;
                case 3: phase_oproj(P, L, lds); break;
                case 4: phase_router(P, L, lds); break;
                case 5: phase_moe_up(P, L, lds); break;
                case 6: phase_moe_down(P, L, lds); break;
                case 7: phase_combine(P, L, lds); break;
                case 8: phase_ple(P, L, lds); break;
            }
        }
    }
}
}
#ifndef MK_N_LAUNCHES
#define MK_N_LAUNCHES 1
#endif
extern "C" void kernel_launch(void* const* d_in, const int* in_sizes, int n_in, void* d_out, int out_size, void* d_ws, size_t ws_size,
                              hipStream_t stream) {
    nv::Inputs in{};
    in.x = (const float*)d_in[0]; in.p = (const float*)d_in[1]; in.positions = (const int*)d_in[2];
    const float** f = &in.mix_norm_g;
    for (int i = 0; i < 32; ++i) f[i] = (const float*)d_in[3 + i];
    size_t used = 0;
    fx::WS w = fx::make_ws((char*)d_ws, used);
    static int grid = 0;
    if (grid == 0) {
        if (n_in != 35 || out_size != fx::NT * 1024 || used > ws_size) { fprintf(stderr, "kernel_launch: unexpected shapes / workspace (need %zu, have %zu)\n", used, ws_size); grid = -1; return; }
        if (hipFuncSetAttribute((const void*)fx::k_run, hipFuncAttributeMaxDynamicSharedMemorySize, fx::LDS_BYTES) != hipSuccess) { fprintf(stderr, "hipFuncSetAttribute failed\n"); grid = -1; return; }
        int dev = 0, cus = 0, per_cu = 0;
        hipGetDevice(&dev); hipDeviceGetAttribute(&cus, hipDeviceAttributeMultiprocessorCount, dev);
        hipOccupancyMaxActiveBlocksPerMultiprocessor(&per_cu, (const void*)fx::k_run, 256, fx::LDS_BYTES);
        if (per_cu > 2) per_cu = 2;
        if (per_cu < 1) { fprintf(stderr, "occupancy query says %d blocks/CU\n", per_cu); grid = -1; return; }
        grid = cus * per_cu;
    }
    if (grid < 0) return;
    fx::Params P{}; P.in = in; P.h = (float*)d_out; P.w = w;
    hipMemsetAsync(w.cnt, 0, 128 * 4, stream);
    hipMemsetAsync(w.bar, 0, XCD_BAR_WORDS * 4, stream);
    if (MK_N_LAUNCHES == 1) hipLaunchKernelGGL(fx::k_run, dim3(grid), dim3(256), fx::LDS_BYTES, stream, P, 0, fx::N_PHASES);
    else for (int ph = 0; ph < fx::N_PHASES; ++ph) hipLaunchKernelGGL(fx::k_run, dim3(grid), dim3(256), fx::LDS_BYTES, stream, P, ph, ph + 1);
}
```

```cpp
#include <hip/hip_runtime.h>
#include <hip/hip_bf16.h>
#include <stdint.h>
#include <cstdio>
namespace nv {
struct Inputs {
    const float *x, *p; const int* positions;
    const float *mix_norm_g, *w_in, *sgu_ln_g, *sgu_ln_b, *sgu_w, *sgu_b, *conv_w, *conv_b, *conv_ln_g, *conv_ln_b, *conv_pw_w, *conv_pw_b,
        *q_a_norm_g, *w_uq, *kv_a_norm_g, *w_ukv, *q_norm_g, *k_norm_g, *branch_norm_g, *w_o, *ffn_norm_g, *router_group_w, *router_group_b,
        *router_expert_w, *router_expert_b, *moe_w_gate, *moe_w_up, *moe_w_down, *ple_norm_g, *ple_gate_w, *ple_proj_w, *ple_post_norm_g;
};
}
namespace fx {

typedef unsigned short bf16_t;
typedef short bf16x8 __attribute__((ext_vector_type(8)));
typedef float f32x16 __attribute__((ext_vector_type(16)));
typedef float f32x4 __attribute__((ext_vector_type(4)));

constexpr int NT = 16384, SEQ = 2048, DM = 1024, NB = 8;
constexpr int ZN = 1536;
constexpr float EPS = 1e-6f;

typedef __bf16 bf16v2_t __attribute__((ext_vector_type(2)));
typedef float f32v2_t __attribute__((ext_vector_type(2)));
__device__ __forceinline__ unsigned pack2(float lo, float hi) {
    f32v2_t v; v.x = lo; v.y = hi;
    bf16v2_t b = __builtin_convertvector(v, bf16v2_t);
    return __builtin_bit_cast(unsigned, b);
}
__device__ __forceinline__ unsigned f2bf(float f) { return pack2(f, 0.f) & 0xffffu; }
__device__ __forceinline__ float bf2f(unsigned short b) { return __uint_as_float(((unsigned)b) << 16); }
__device__ __forceinline__ float bflo(unsigned u) { return __uint_as_float(u << 16); }
__device__ __forceinline__ float bfhi(unsigned u) { return __uint_as_float(u & 0xffff0000u); }
__device__ __forceinline__ float sigmoid_(float x) { return __builtin_amdgcn_rcpf(1.f + __builtin_amdgcn_exp2f(-1.4426950408889634f * x)); }
__device__ __forceinline__ float rsq_(float x) { return __builtin_amdgcn_rsqf(x); }
__device__ __forceinline__ float gelu_tanh_(float x) {
    float u = 0.7978845608028654f * (x + 0.044715f * x * x * x);
    return x * sigmoid_(2.f * u);
}
__device__ __forceinline__ int opaque_tid() { int t = threadIdx.x; asm volatile("" : "+v"(t)); return t; }
template <int CTRL> __device__ __forceinline__ float dpp_mov(float v) {
    return __builtin_bit_cast(float, __builtin_amdgcn_update_dpp(0, __builtin_bit_cast(int, v), CTRL, 0xf, 0xf, false));
}
__device__ __forceinline__ void swap16(float& a, float& b) { asm volatile("s_nop 1\n\tv_permlane16_swap_b32 %0, %1" : "+v"(a), "+v"(b)); }
__device__ __forceinline__ void swap32(float& a, float& b) { asm volatile("s_nop 1\n\tv_permlane32_swap_b32 %0, %1" : "+v"(a), "+v"(b)); }
__device__ __forceinline__ float swap16_sum(float v) { float a = v, b = v; swap16(a, b); return a + b; }
__device__ __forceinline__ float swap32_sum(float v) { float a = v, b = v; swap32(a, b); return a + b; }
__device__ __forceinline__ float swap32_max(float v) { float a = v, b = v; swap32(a, b); return fmaxf(a, b); }
__device__ __forceinline__ float grp_sum16(float v) { v += dpp_mov<0xB1>(v); v += dpp_mov<0x4E>(v); v += dpp_mov<0x124>(v); v += dpp_mov<0x128>(v); return v; }
__device__ __forceinline__ float grp_sum32(float v) { return swap16_sum(grp_sum16(v)); }
__device__ __forceinline__ float wave_sum64(float v) { return swap32_sum(grp_sum32(v)); }
__device__ __forceinline__ float xor8(float v) { return dpp_mov<0x128>(v); }
__device__ __forceinline__ float xor32(float v) { return swap32_sum(v); }

struct WS {
    bf16_t *W1t, *Wuqt, *Wukvt, *Wpwt, *Wot, *Wrt, *Wgut, *Wdt, *Wgt, *Wpt, *Wsm;
    bf16_t *hb;
    bf16_t *hb1;
    bf16_t *ub;
    bf16_t *vT;
    bf16_t *ygb;
    bf16_t *cqb;
    bf16_t *ckvb;
    bf16_t *kpeb;
    bf16_t *Qb;
    bf16_t *Knb;
    bf16_t *VTb;
    bf16_t *yb;
    float  *ssq;
    float  *rssA;
    float  *rssB;
    float  *cqss;
    float  *cs;
    bf16_t *erb;
    float  *essq;
    bf16_t *hbuf;
    bf16_t *contrib;
    int    *cnt;
    int    *elist;
    float  *ewt;
    unsigned *bar;
};
constexpr size_t W1_SZ = (size_t)ZN * 1024, WUQ_SZ = 768 * 256, WUKV_SZ = 1024 * 128, WPW_SZ = 256 * 256, WO_SZ = 1024 * 1024, WR_SZ = 128 * 1024,
                 WGU_SZ = (size_t)32 * 512 * 1024, WD_SZ = (size_t)32 * 1024 * 256, WG_SZ = 1024 * 1024, WP_SZ = 1024 * 256, WSM_SZ = 4 * 128 * 128;

struct Params {
    nv::Inputs in;
    float* h;
    WS w;
    float* zf;
    float* yf;
};

static WS make_ws(char* base, size_t& used) {
    WS w{}; size_t o = 0;
    auto take = [&](size_t bytes) { char* p = base + o; o += (bytes + 255) & ~(size_t)255; return p; };
    w.W1t = (bf16_t*)take(2 * W1_SZ * 2);   w.Wuqt = (bf16_t*)take(2 * WUQ_SZ * 2); w.Wukvt = (bf16_t*)take(2 * WUKV_SZ * 2);
    w.Wpwt = (bf16_t*)take(2 * WPW_SZ * 2); w.Wot = (bf16_t*)take(2 * WO_SZ * 2);   w.Wrt = (bf16_t*)take(2 * WR_SZ * 2);
    w.Wgut = (bf16_t*)take(2 * WGU_SZ * 2); w.Wdt = (bf16_t*)take(2 * WD_SZ * 2);   w.Wgt = (bf16_t*)take(2 * WG_SZ * 2);
    w.Wpt = (bf16_t*)take(2 * WP_SZ * 2);   w.Wsm = (bf16_t*)take(2 * WSM_SZ * 2);
    w.hb = (bf16_t*)take((size_t)NT * 1024 * 2); w.hb1 = (bf16_t*)take((size_t)NT * 1024 * 2);
    w.ssq = (float*)take((size_t)NT * 16 * 4); w.cs = (float*)take((size_t)NT * 32 * 4);
    w.rssA = (float*)take((size_t)NT * 8 * 4); w.rssB = (float*)take((size_t)NT * 8 * 4); w.cqss = (float*)take((size_t)NT * 4 * 4);
    w.essq = (float*)take((size_t)NT * 8 * 4);
    w.cnt = (int*)take(2 * 64 * 4);
    w.elist = (int*)take((size_t)32 * NT * 4); w.ewt = (float*)take((size_t)32 * NT * 4);
    w.bar = (unsigned*)take(4096 * 4);
    const size_t region = o;
    w.ub = (bf16_t*)take((size_t)NT * 256 * 2); w.vT = (bf16_t*)take((size_t)NT * 256 * 2); w.ygb = (bf16_t*)take((size_t)NT * 256 * 2);
    w.cqb = (bf16_t*)take((size_t)NT * 256 * 2); w.ckvb = (bf16_t*)take((size_t)NT * 128 * 2); w.kpeb = (bf16_t*)take((size_t)NT * 32 * 2);
    w.Qb = (bf16_t*)take((size_t)NT * 768 * 2); w.Knb = (bf16_t*)take((size_t)NT * 512 * 2); w.VTb = (bf16_t*)take((size_t)NT * 512 * 2);
    w.yb = (bf16_t*)take((size_t)NT * 1024 * 2);
    const size_t region_end = o;
    o = region;
    w.contrib = (bf16_t*)take((size_t)NT * 2 * 1024 * 2);
    w.hbuf = (bf16_t*)take((size_t)(2 * NT + 128) * 256 * 2);
    w.erb = (bf16_t*)take((size_t)NT * 1024 * 2);
    if (o > region_end) { fprintf(stderr, "make_ws: overlay exceeds mixer region\n"); }
    o = region_end;
    used = o;
    return w;
}

__device__ const double ROPE_INV[16] = {1.0, 0.5623413251903491, 0.31622776601683794, 0.1778279410038923, 0.1, 0.05623413251903491, 0.03162277660168379, 0.01778279410038923, 0.01, 0.005623413251903491, 0.0031622776601683794, 0.0017782794100389228, 0.001, 0.0005623413251903491, 0.00031622776601683794, 0.00017782794100389227};
__device__ __forceinline__ void rope_cs(int pos, int j, float& c, float& s) {
    const double ang = (double)pos * ROPE_INV[j];
    const double n = rint(ang * 0.15915494309189535);
    double r = fma(-n, 6.283185307179586, ang); r = fma(-n, 2.4492935982947064e-16, r);
    const double r2 = r * r;
    double sc = 1.0, ss = 1.0;
    double tc = 1.0, ts = 1.0;
#pragma unroll
    for (int k = 1; k <= 14; ++k) {
        tc *= -r2 / (double)((2 * k - 1) * (2 * k)); sc += tc;
        ts *= -r2 / (double)((2 * k) * (2 * k + 1)); ss += ts;
    }
    c = (float)sc; s = (float)(ss * r);
}

enum { MAP_ID = 0, MAP_W1 = 1, MAP_UQ = 2, MAP_UKV = 3, MAP_GATE = 4, MAP_UP = 5 };
template <int MAP> __device__ __forceinline__ int dstrow(int c) {
    if (MAP == MAP_W1) {
        if (c < 512) return c;
        if (c < 768) return 512 + 2 * (c - 512);
        if (c < 1024) return 513 + 2 * (c - 768);
        return c;
    } else if (MAP == MAP_UQ) {
        const int h = c / 96, d = c - h * 96; return d < 64 ? h * 64 + d : 512 + h * 32 + d - 64;
    } else if (MAP == MAP_UKV) {
        const int h = c >> 7, d = c & 127; return d < 64 ? h * 64 + d : 512 + h * 64 + d - 64;
    } else if (MAP == MAP_GATE) return 2 * c;
    else if (MAP == MAP_UP) return 2 * c + 1;
    return c;
}
template <int MAP>
__device__ __forceinline__ void prep_tile(const float* src, int ld, int Nsrc, const float* scale, bf16_t* dst, int K, int k0, int c0, float* tile  , const int tid) {
    __syncthreads();
#pragma unroll
    for (int i = 0; i < 4; ++i) {
        const int kk = (tid >> 4) + 16 * i, c4 = (tid & 15) * 4;
        float4 v = make_float4(0.f, 0.f, 0.f, 0.f);
        if (c0 + c4 < Nsrc) v = *(const float4*)(src + (size_t)(k0 + kk) * ld + c0 + c4);
        const float sc = scale ? scale[k0 + kk] : 1.f;
        float* t = tile + kk * 65 + c4;
        t[0] = v.x * sc; t[1] = v.y * sc; t[2] = v.z * sc; t[3] = v.w * sc;
    }
    __syncthreads();
#pragma unroll
    for (int i = 0; i < 2; ++i) {
        const int idx = tid + 256 * i, c = idx >> 3, kc = idx & 7;
        if (c0 + c < Nsrc) {
            const float* t = tile + (kc * 8) * 65 + c;
            uint4 pk;
            pk.x = pack2(t[0], t[65]); pk.y = pack2(t[130], t[195]); pk.z = pack2(t[260], t[325]); pk.w = pack2(t[390], t[455]);
            *(uint4*)(dst + (size_t)dstrow<MAP>(c0 + c) * K + k0 + kc * 8) = pk;
        }
    }
}
template <int MAP>
__device__ void prep_job(const float* src, int ld, int Nsrc, size_t src_stride, const float* scale, bf16_t* dst, size_t dst_stride, int K, int nbatch, float* tile, int& rot, const int tid) {
    const int tn = (Nsrc + 63) / 64, tk = K / 64, per = tn * tk, total = per * nbatch, G = gridDim.x;
    for (int t = ((int)blockIdx.x - rot + G) % G; t < total; t += G) {
        const int e = t / per, tt = t % per;
        prep_tile<MAP>(src + (size_t)e * src_stride, ld, Nsrc, scale, dst + (size_t)e * dst_stride, K, (tt / tn) * 64, (tt % tn) * 64, tile, tid);
    }
    rot = (rot + total) % G;
}

__device__ void phase_prep(const Params& P, char* lds) {
    float* tile = (float*)lds;
    const nv::Inputs& in = P.in; const WS& w = P.w;
    const int G = gridDim.x, bid = blockIdx.x, tid = opaque_tid();
    int rot = 0;
    for (int L = 0; L < 2; ++L) {
        prep_job<MAP_GATE>(in.moe_w_gate + (size_t)L * 32 * 1024 * 256, 256, 256, (size_t)1024 * 256, in.ffn_norm_g + L * 1024, w.Wgut + L * WGU_SZ, (size_t)512 * 1024, 1024, 32, tile, rot, tid);
        prep_job<MAP_UP>(in.moe_w_up + (size_t)L * 32 * 1024 * 256, 256, 256, (size_t)1024 * 256, in.ffn_norm_g + L * 1024, w.Wgut + L * WGU_SZ, (size_t)512 * 1024, 1024, 32, tile, rot, tid);
        prep_job<MAP_ID>(in.moe_w_down + (size_t)L * 32 * 256 * 1024, 1024, 1024, (size_t)256 * 1024, nullptr, w.Wdt + L * WD_SZ, (size_t)1024 * 256, 256, 32, tile, rot, tid);
        prep_job<MAP_W1>(in.w_in + (size_t)L * 1024 * 1440, 1440, 1440, 0, in.mix_norm_g + L * 1024, w.W1t + L * W1_SZ, 0, 1024, 1, tile, rot, tid);
        prep_job<MAP_UQ>(in.w_uq + (size_t)L * 256 * 768, 768, 768, 0, in.q_a_norm_g + L * 256, w.Wuqt + L * WUQ_SZ, 0, 256, 1, tile, rot, tid);
        prep_job<MAP_UKV>(in.w_ukv + (size_t)L * 128 * 1024, 1024, 1024, 0, in.kv_a_norm_g + L * 128, w.Wukvt + L * WUKV_SZ, 0, 128, 1, tile, rot, tid);
        prep_job<MAP_ID>(in.conv_pw_w + (size_t)L * 256 * 256, 256, 256, 0, nullptr, w.Wpwt + L * WPW_SZ, 0, 256, 1, tile, rot, tid);
        prep_job<MAP_ID>(in.w_o + (size_t)L * 1024 * 1024, 1024, 1024, 0, in.branch_norm_g + L * 1024, w.Wot + L * WO_SZ, 0, 1024, 1, tile, rot, tid);
        prep_job<MAP_ID>(in.ple_gate_w + (size_t)L * 1024 * 1024, 1024, 1024, 0, in.ple_norm_g + L * 1024, w.Wgt + L * WG_SZ, 0, 1024, 1, tile, rot, tid);
        prep_job<MAP_ID>(in.ple_proj_w + (size_t)L * 256 * 1024, 1024, 1024, 0, nullptr, w.Wpt + L * WP_SZ, 0, 256, 1, tile, rot, tid);
        for (int i = bid * 256 + tid; i < 96 * 1024 / 8; i += G * 256) *(uint4*)(w.W1t + L * W1_SZ + (size_t)1440 * 1024 + (size_t)i * 8) = make_uint4(0u, 0u, 0u, 0u);
        for (int i = bid * 256 + tid; i < 128 * 1024; i += G * 256) {
            int n = i >> 10, k = i & 1023; float v = 0.f;
            if (n < 4) v = in.router_group_w[(size_t)L * 1024 * 4 + k * 4 + n];
            else if (n < 36) v = in.router_expert_w[(size_t)L * 1024 * 32 + k * 32 + (n - 4)];
            v *= in.ffn_norm_g[L * 1024 + k];
            w.Wrt[L * WR_SZ + i] = (bf16_t)f2bf(v);
        }
        for (int i = bid * 256 + tid; i < 4 * 128 * 128; i += G * 256) {
            int jj = i & 127, ii = (i >> 7) & 127;
            float v = (jj <= ii) ? in.sgu_w[(size_t)L * WSM_SZ + i] : 0.f;
            w.Wsm[L * WSM_SZ + i] = (bf16_t)f2bf(v);
        }
    }
    for (int i = bid * 256 + tid; i < NT * 16; i += G * 256) {
        int t = i >> 4, j = i & 15;
        float c, sn; rope_cs(in.positions[t], j, c, sn);
        w.cs[t * 32 + j] = c; w.cs[t * 32 + 16 + j] = sn;
    }
    for (int row = bid * 4 + (tid >> 6); row < NT; row += G * 4) {
        const int lane = tid & 63;
        float ss = 0.f;
#pragma unroll
        for (int j = 0; j < 4; ++j) {
            const size_t i = (size_t)row * 256 + j * 64 + lane;
            const float4 v = ((const float4*)in.x)[i];
            ((float4*)P.h)[i] = v;
            uint2 pk; pk.x = pack2(v.x, v.y); pk.y = pack2(v.z, v.w);
            ((uint2*)w.hb)[i] = pk;
            ss += v.x * v.x + v.y * v.y + v.z * v.z + v.w * v.w;
        }
        ss = wave_sum64(ss);
        if (lane < 8) w.rssA[(size_t)row * 8 + lane] = lane == 0 ? ss : 0.f;
    }
}

__device__ __forceinline__ int lds_off(int row, int chunk) { return row * 128 + ((chunk ^ ((row >> 1) & 7)) << 4); }

template <typename AT> struct ARaw;
template <> struct ARaw<bf16_t> { uint4 v[4]; };
template <> struct ARaw<float> { float4 v[4][2]; };

__device__ __forceinline__ void a_load(ARaw<bf16_t>& r, const bf16_t* const (&rowp)[4], int koff) {
#pragma unroll
    for (int i = 0; i < 4; ++i) r.v[i] = *(const uint4*)(rowp[i] + koff);
}
__device__ __forceinline__ void a_load(ARaw<float>& r, const float* const (&rowp)[4], int koff) {
#pragma unroll
    for (int i = 0; i < 4; ++i) { r.v[i][0] = *(const float4*)(rowp[i] + koff); r.v[i][1] = *(const float4*)(rowp[i] + koff + 4); }
}
template <bool SUMSQ> __device__ __forceinline__ uint4 a_cvt(const uint4& v, float& ss) {
    if (SUMSQ) {
        float a;
        a = bflo(v.x); ss = fmaf(a, a, ss); a = bfhi(v.x); ss = fmaf(a, a, ss);
        a = bflo(v.y); ss = fmaf(a, a, ss); a = bfhi(v.y); ss = fmaf(a, a, ss);
        a = bflo(v.z); ss = fmaf(a, a, ss); a = bfhi(v.z); ss = fmaf(a, a, ss);
        a = bflo(v.w); ss = fmaf(a, a, ss); a = bfhi(v.w); ss = fmaf(a, a, ss);
    }
    return v;
}
template <bool SUMSQ> __device__ __forceinline__ void a_store(const ARaw<bf16_t>& r, char* ldsA, int tid, float (&ss)[4]) {
#pragma unroll
    for (int i = 0; i < 4; ++i) { uint4 v = a_cvt<SUMSQ>(r.v[i], ss[i]); *(uint4*)(ldsA + lds_off((tid >> 3) + 32 * i, tid & 7)) = v; }
}
template <bool SUMSQ> __device__ __forceinline__ void a_store(const ARaw<float>& r, char* ldsA, int tid, float (&ss)[4]) {
#pragma unroll
    for (int i = 0; i < 4; ++i) {
        const float4 a = r.v[i][0], b = r.v[i][1];
        if (SUMSQ) ss[i] += a.x * a.x + a.y * a.y + a.z * a.z + a.w * a.w + b.x * b.x + b.y * b.y + b.z * b.z + b.w * b.w;
        uint4 v; v.x = pack2(a.x, a.y); v.y = pack2(a.z, a.w); v.z = pack2(b.x, b.y); v.w = pack2(b.z, b.w);
        *(uint4*)(ldsA + lds_off((tid >> 3) + 32 * i, tid & 7)) = v;
    }
}

struct bf16x3_t {};
template <> struct ARaw<bf16x3_t> { uint4 a[4], b[4], c[4]; };
struct Rows3 { const bf16_t* p[2][4]; };
__device__ __forceinline__ void a_load(ARaw<bf16x3_t>& r, const Rows3& rows, int koff) {
#pragma unroll
    for (int i = 0; i < 4; ++i) { r.a[i] = *(const uint4*)(rows.p[0][i] + koff); r.b[i] = *(const uint4*)(rows.p[1][i] + koff); r.c[i] = *(const uint4*)(rows.p[1][i] + koff + 1024); }
}
__device__ __forceinline__ unsigned add3pk(unsigned a, unsigned b, unsigned c, float& ss) {
    const float lo = bflo(a) + bflo(b) + bflo(c), hi = bfhi(a) + bfhi(b) + bfhi(c);
    ss = fmaf(lo, lo, ss); ss = fmaf(hi, hi, ss);
    return pack2(lo, hi);
}
template <bool SUMSQ> __device__ __forceinline__ void a_store(const ARaw<bf16x3_t>& r, char* ldsA, int tid, float (&ss)[4]) {
#pragma unroll
    for (int i = 0; i < 4; ++i) {
        uint4 v;
        v.x = add3pk(r.a[i].x, r.b[i].x, r.c[i].x, ss[i]); v.y = add3pk(r.a[i].y, r.b[i].y, r.c[i].y, ss[i]);
        v.z = add3pk(r.a[i].z, r.b[i].z, r.c[i].z, ss[i]); v.w = add3pk(r.a[i].w, r.b[i].w, r.c[i].w, ss[i]);
        *(uint4*)(ldsA + lds_off((tid >> 3) + 32 * i, tid & 7)) = v;
    }
}

template <typename AT, bool SUMSQ, int SUNROLL = 4, typename AROWS>
__device__ __forceinline__ void gemm_mainloop(f32x16 (&acc)[2][2], const AROWS& arow, const bf16_t* const (&wrow)[4], int nkt, char* lds, float (&ss)[4], const int tid) {
    const int lane = tid & 63, wid = tid >> 6, wr = wid >> 1, wc = wid & 1;
    ARaw<AT> ra; ARaw<bf16_t> rb; float dummy[4] = {0.f, 0.f, 0.f, 0.f};
    a_load(ra, arow, 0); a_load(rb, wrow, 0);
    a_store<SUMSQ>(ra, lds, tid, ss); a_store<false>(rb, lds + 16384, tid, dummy);
    __syncthreads();
    const int fr = lane & 31, fh = lane >> 5;
#pragma unroll 1
    for (int kt = 0; kt < nkt; ++kt) {
        char* cur = lds + (kt & 1) * 32768;
        char* nxt = lds + ((kt + 1) & 1) * 32768;
        const bool more = (kt + 1 < nkt);
        if (more) { a_load(ra, arow, (kt + 1) * 64); a_load(rb, wrow, (kt + 1) * 64); }
#pragma unroll SUNROLL
        for (int s = 0; s < 4; ++s) {
            bf16x8 xa[2], wb[2];
#pragma unroll
            for (int i = 0; i < 2; ++i) xa[i] = *(const bf16x8*)(cur + lds_off(wr * 64 + i * 32 + fr, 2 * s + fh));
#pragma unroll
            for (int j = 0; j < 2; ++j) wb[j] = *(const bf16x8*)(cur + 16384 + lds_off(wc * 64 + j * 32 + fr, 2 * s + fh));
#pragma unroll
            for (int i = 0; i < 2; ++i)
#pragma unroll
                for (int j = 0; j < 2; ++j) acc[i][j] = __builtin_amdgcn_mfma_f32_32x32x16_bf16(wb[j], xa[i], acc[i][j], 0, 0, 0);
        }
        if (more) { a_store<SUMSQ>(ra, nxt, tid, ss); a_store<false>(rb, nxt + 16384, tid, dummy); }
        __syncthreads();
    }
}
constexpr int GST = 16384;
__device__ __forceinline__ int gl_chunk(int tid) { return (tid & 3) ^ ((tid >> 4) & 3); }
__device__ __forceinline__ int gl_off(int row, int chunk) { return row * 64 + ((chunk ^ ((row >> 2) & 3)) << 4); }
typedef __attribute__((address_space(3))) unsigned lds_u32_t;
__device__ __forceinline__ void glds16(const bf16_t* g, char* l) {
    __builtin_amdgcn_global_load_lds((const unsigned*)g, (lds_u32_t*)l, 16, 0, 0);
}
#define RAW_BARRIER() do { asm volatile("s_waitcnt lgkmcnt(0)" ::: "memory"); __builtin_amdgcn_s_barrier(); } while (0)
__device__ __forceinline__ void gemm_mainloop_g(f32x16 (&acc)[2][2], const bf16_t* const (&arow)[2], const bf16_t* const (&wrow)[2], const int nkt, char* lds, const int tid) {
    const int lane = tid & 63, wid = tid >> 6, wr = wid >> 1, wc = wid & 1, fr = lane & 31, fh = lane >> 5;
    const int wbase = __builtin_amdgcn_readfirstlane(wid) * 1024;
    asm volatile("s_waitcnt vmcnt(0)" ::: "memory");
#pragma unroll 1
    for (int p = 0; p < 3; ++p) if (p < nkt) {
        char* st = lds + p * GST + wbase;
        glds16(arow[0] + p * 32, st); glds16(arow[1] + p * 32, st + 4096);
        glds16(wrow[0] + p * 32, st + 8192); glds16(wrow[1] + p * 32, st + 8192 + 4096);
    }
    const int ra0 = gl_off(wr * 64 + fr, fh), ra1 = gl_off(wr * 64 + 32 + fr, fh);
    const int rb0 = 8192 + gl_off(wc * 64 + fr, fh), rb1 = 8192 + gl_off(wc * 64 + 32 + fr, fh);
#pragma unroll 1
    for (int kt = 0; kt < nkt; ++kt) {
        if (kt + 2 < nkt) asm volatile("s_waitcnt vmcnt(8)" ::: "memory");
        else if (kt + 1 < nkt) asm volatile("s_waitcnt vmcnt(4)" ::: "memory");
        else asm volatile("s_waitcnt vmcnt(0)" ::: "memory");
        RAW_BARRIER();
        if (kt + 3 < nkt) {
            char* st = lds + ((kt + 3) & 3) * GST + wbase;
            const int ko = (kt + 3) * 32;
            glds16(arow[0] + ko, st); glds16(arow[1] + ko, st + 4096);
            glds16(wrow[0] + ko, st + 8192); glds16(wrow[1] + ko, st + 8192 + 4096);
        }
        const char* cur = lds + (kt & 3) * GST;
        bf16x8 xa[2][2], wb[2][2];
#pragma unroll
        for (int s2 = 0; s2 < 2; ++s2) {
            xa[s2][0] = *(const bf16x8*)(cur + (ra0 ^ (s2 << 5))); xa[s2][1] = *(const bf16x8*)(cur + (ra1 ^ (s2 << 5)));
            wb[s2][0] = *(const bf16x8*)(cur + (rb0 ^ (s2 << 5))); wb[s2][1] = *(const bf16x8*)(cur + (rb1 ^ (s2 << 5)));
        }
        __builtin_amdgcn_sched_barrier(0);
#pragma unroll
        for (int s2 = 0; s2 < 2; ++s2) {
            acc[0][0] = __builtin_amdgcn_mfma_f32_32x32x16_bf16(wb[s2][0], xa[s2][0], acc[0][0], 0, 0, 0);
            acc[0][1] = __builtin_amdgcn_mfma_f32_32x32x16_bf16(wb[s2][1], xa[s2][0], acc[0][1], 0, 0, 0);
            acc[1][0] = __builtin_amdgcn_mfma_f32_32x32x16_bf16(wb[s2][0], xa[s2][1], acc[1][0], 0, 0, 0);
            acc[1][1] = __builtin_amdgcn_mfma_f32_32x32x16_bf16(wb[s2][1], xa[s2][1], acc[1][1], 0, 0, 0);
        }
    }
    RAW_BARRIER();
}
__device__ __forceinline__ int g64_chunk(int tid) { return (tid & 7) ^ ((tid >> 4) & 7); }
__device__ __forceinline__ void gemm_mainloop_g64(f32x16 (&acc)[2][2], const bf16_t* const (&arow)[4], const bf16_t* const (&wrow)[4], const int nkt, char* lds, const int tid) {
    const int lane = tid & 63, wid = tid >> 6, wr = wid >> 1, wc = wid & 1, fr = lane & 31, fh = lane >> 5;
    const int wbase = __builtin_amdgcn_readfirstlane(wid) * 1024;
    asm volatile("s_waitcnt vmcnt(0)" ::: "memory");
    {
        char* st = lds + wbase;
#pragma unroll
        for (int i = 0; i < 4; ++i) { glds16(arow[i], st + i * 4096); glds16(wrow[i], st + 16384 + i * 4096); }
    }
#pragma unroll 1
    for (int kt = 0; kt < nkt; ++kt) {
        asm volatile("s_waitcnt vmcnt(0)" ::: "memory");
        RAW_BARRIER();
        if (kt + 1 < nkt) {
            char* st = lds + ((kt + 1) & 1) * 32768 + wbase;
            const int ko = (kt + 1) * 64;
#pragma unroll
            for (int i = 0; i < 4; ++i) { glds16(arow[i] + ko, st + i * 4096); glds16(wrow[i] + ko, st + 16384 + i * 4096); }
        }
        const char* cur = lds + (kt & 1) * 32768;
#pragma unroll
        for (int s = 0; s < 4; ++s) {
            bf16x8 xa[2], wb[2];
#pragma unroll
            for (int i = 0; i < 2; ++i) xa[i] = *(const bf16x8*)(cur + lds_off(wr * 64 + i * 32 + fr, 2 * s + fh));
#pragma unroll
            for (int j = 0; j < 2; ++j) wb[j] = *(const bf16x8*)(cur + 16384 + lds_off(wc * 64 + j * 32 + fr, 2 * s + fh));
#pragma unroll
            for (int i = 0; i < 2; ++i)
#pragma unroll
                for (int j = 0; j < 2; ++j) acc[i][j] = __builtin_amdgcn_mfma_f32_32x32x16_bf16(wb[j], xa[i], acc[i][j], 0, 0, 0);
        }
    }
    RAW_BARRIER();
}
__device__ __forceinline__ void acc_zero(f32x16 (&acc)[2][2]) {
#pragma unroll
    for (int i = 0; i < 2; ++i)
#pragma unroll
        for (int j = 0; j < 2; ++j)
#pragma unroll
            for (int r = 0; r < 16; ++r) acc[i][j][r] = 0.f;
}
__device__ __forceinline__ void publish_rowstat(float (&ss)[4], float* stat, float invK, bool as_rstd, const int tid) {
#pragma unroll
    for (int i = 0; i < 4; ++i) {
        float v = ss[i];
        v += __shfl_xor(v, 1); v += __shfl_xor(v, 2); v += __shfl_xor(v, 4);
        if ((tid & 7) == 0) stat[(tid >> 3) + 32 * i] = as_rstd ? rsqrtf(v * invK + EPS) : v;
    }
    __syncthreads();
}
__device__ __forceinline__ int nidx(int r, int fh) { return (r & 3) + 8 * (r >> 2) + 4 * fh; }
__device__ __forceinline__ void store4(bf16_t* p, float a, float b, float c, float d) {
    uint2 v; v.x = pack2(a, b); v.y = pack2(c, d); *(uint2*)p = v;
}

__device__ __forceinline__ bool xcd_item(int it, int MT, int NTl, int& mt, int& nt) {
    const int x = blockIdx.x & 7, lb = blockIdx.x >> 3, nlb = gridDim.x >> 3;
    const int li = it * nlb + lb, per = (MT >> 3) * NTl;
    if (li >= per) return false;
    mt = (li / NTl) * 8 + x; nt = li % NTl; return true;
}

constexpr int TLD = 132;
constexpr int STAT_OFF = 128 * TLD * 4;
constexpr int LDS_GEMM_BYTES = STAT_OFF + 2048;
__device__ __forceinline__ void acc_to_lds(const f32x16 (&acc)[2][2], float* T, const int tid) {
    const int lane = tid & 63, wid = tid >> 6, wr = wid >> 1, wc = wid & 1, fr = lane & 31, fh = lane >> 5;
#pragma unroll
    for (int i = 0; i < 2; ++i)
#pragma unroll
        for (int j = 0; j < 2; ++j)
#pragma unroll
            for (int g = 0; g < 4; ++g) {
                float4 v; v.x = acc[i][j][4 * g]; v.y = acc[i][j][4 * g + 1]; v.z = acc[i][j][4 * g + 2]; v.w = acc[i][j][4 * g + 3];
                *(float4*)(T + (wr * 64 + i * 32 + fr) * TLD + wc * 64 + j * 32 + 8 * g + 4 * fh) = v;
            }
    __syncthreads();
}
__device__ __forceinline__ float rstd8(const float* p, float invK) {
    const float4 a = *(const float4*)p, b = *(const float4*)(p + 4);
    return rsq_(((a.x + a.y) + (a.z + a.w) + (b.x + b.y) + (b.z + b.w)) * invK + EPS);
}

}
namespace fx {

__device__ void phase_zgemm(const Params& P, int L, char* lds, const bool same = false) {
    const WS& w = P.w; const nv::Inputs& in = P.in;
    const int tid0 = opaque_tid();
    float* T = (float*)lds; float* stat = (float*)(lds + STAT_OFF);
    const bf16_t* Wt = w.W1t + L * W1_SZ;
    int mt, nt;
    for (int it = 0; xcd_item(it, 128, 12, mt, nt); ++it) {
        int tid = tid0; asm volatile("" : "+v"(tid));
        const int lane = tid & 63, wid = tid >> 6;
        const int m0 = mt * 128, n0 = nt * 128;
        {
            const bf16_t* arow[4]; const bf16_t* wrow[4];
#pragma unroll
            for (int i = 0; i < 4; ++i) {
                arow[i] = w.hb + (size_t)(m0 + (tid >> 3) + 32 * i) * 1024 + g64_chunk(tid) * 8;
                wrow[i] = Wt + (size_t)(n0 + (tid >> 3) + 32 * i) * 1024 + g64_chunk(tid) * 8;
            }
            f32x16 acc[2][2]; acc_zero(acc);
            gemm_mainloop_g64(acc, arow, wrow, 16, lds, tid);
            if (tid < 128) stat[tid] = rstd8(w.rssA + (size_t)(m0 + tid) * 8, 1.f / 1024.f);
            acc_to_lds(acc, T, tid);
        }
        if (nt < 2) {
#pragma unroll 8
            for (int rr = 0; rr < 32; ++rr) {
                const int row = wid * 32 + rr; const float rs = stat[row];
                const float2 x = *(const float2*)(T + row * TLD + 2 * lane);
                *(unsigned*)(w.ub + (size_t)(m0 + row) * 256 + nt * 128 + 2 * lane) = pack2(gelu_tanh_(x.x * rs), gelu_tanh_(x.y * rs));
            }
        } else if (nt < 4) {
            const int hd = (nt - 2) * 2 + (lane >> 5);
            const float2 lg = *(const float2*)(in.sgu_ln_g + L * 256 + hd * 64 + 2 * (lane & 31));
            const float2 lb = *(const float2*)(in.sgu_ln_b + L * 256 + hd * 64 + 2 * (lane & 31));
#pragma unroll 8
            for (int rr = 0; rr < 32; ++rr) {
                const int row = wid * 32 + rr; const float rs = stat[row];
                float2 x = *(const float2*)(T + row * TLD + 2 * lane);
                x.x = gelu_tanh_(x.x * rs); x.y = gelu_tanh_(x.y * rs);
                const float mean = grp_sum32(x.x + x.y) * (1.f / 64.f);
                const float dx = x.x - mean, dy = x.y - mean;
                const float rv = rsq_(grp_sum32(dx * dx + dy * dy) * (1.f / 64.f) + EPS);
                float2 o; o.x = dx * rv * lg.x + lb.x; o.y = dy * rv * lg.y + lb.y;
                *(float2*)(T + row * TLD + 2 * lane) = o;
            }
            __syncthreads();
            {
                const int c = tid & 127, th = tid >> 7, hd2 = (nt - 2) * 2 + (c >> 6), d = c & 63;
                bf16_t* dst = w.vT + ((size_t)(mt * 4 + hd2) * 64 + d) * 128 + th * 64;
#pragma unroll 2
                for (int k8 = 0; k8 < 8; ++k8) {
                    float v[8];
#pragma unroll
                    for (int k = 0; k < 8; ++k) v[k] = T[(th * 64 + k8 * 8 + k) * TLD + c];
                    uint4 pk; pk.x = pack2(v[0], v[1]); pk.y = pack2(v[2], v[3]); pk.z = pack2(v[4], v[5]); pk.w = pack2(v[6], v[7]);
                    *(uint4*)(dst + k8 * 8) = pk;
                }
            }
        } else if (nt < 8) {
#pragma unroll 8
            for (int rr = 0; rr < 32; ++rr) {
                const int row = wid * 32 + rr; const float rs = stat[row];
                const float2 x = *(const float2*)(T + row * TLD + 2 * lane);
                w.ygb[(size_t)(m0 + row) * 256 + (nt - 4) * 64 + lane] = (bf16_t)f2bf(x.x * rs * sigmoid_(x.y * rs));
            }
        } else if (nt < 11) {
            bf16_t* base; int ld, cb;
            if (nt < 10) { base = w.cqb; ld = 256; cb = (nt - 8) * 128; } else { base = w.ckvb; ld = 128; cb = 0; }
#pragma unroll 8
            for (int rr = 0; rr < 32; ++rr) {
                const int row = wid * 32 + rr; const float rs = stat[row];
                float2 x = *(const float2*)(T + row * TLD + 2 * lane);
                x.x *= rs; x.y *= rs;
                *(unsigned*)(base + (size_t)(m0 + row) * ld + cb + 2 * lane) = pack2(x.x, x.y);
                float sq = grp_sum32(x.x * x.x + x.y * x.y); sq = swap32_sum(sq);
                if (lane == 0) w.cqss[(size_t)(m0 + row) * 4 + (nt - 8)] = sq;
            }
        } else {
            const float2 kg = *(const float2*)(in.k_norm_g + L * 96 + 64 + 2 * (lane & 15));
#pragma unroll 8
            for (int rr = 0; rr < 32; ++rr) {
                const int row = wid * 32 + rr; const float rs = stat[row]; const int tok = m0 + row;
                float2 x = *(const float2*)(T + row * TLD + 2 * (lane & 15));
                x.x *= rs; x.y *= rs;
                const float rn = rsq_(grp_sum16(x.x * x.x + x.y * x.y) * (1.f / 32.f) + EPS);
                x.x *= rn * kg.x; x.y *= rn * kg.y;
                const float ox = xor8(x.x), oy = xor8(x.y);
                const int jj = (2 * lane) & 15;
                const float2 c = *(const float2*)(w.cs + (size_t)tok * 32 + jj), sn = *(const float2*)(w.cs + (size_t)tok * 32 + 16 + jj);
                float2 o;
                if ((lane & 8) == 0) { o.x = x.x * c.x - ox * sn.x; o.y = x.y * c.y - oy * sn.y; }
                else { o.x = x.x * c.x + ox * sn.x; o.y = x.y * c.y + oy * sn.y; }
                if (lane < 16) *(unsigned*)(w.kpeb + (size_t)tok * 32 + 2 * lane) = pack2(o.x, o.y);
            }
        }
        __syncthreads();
    }
}

__global__ void k_shim_z(Params P, int t0) {
    const WS& w = P.w;
    size_t idx = (size_t)blockIdx.x * blockDim.x + threadIdx.x;
    if (idx >= (size_t)2048 * 1440) return;
    int t = t0 + (int)(idx / 1440), c = (int)(idx % 1440);
    float v = 0.f;
    if (c < 256) v = bf2f(w.ub[(size_t)t * 256 + c]);
    else if (c < 512) { int cc = c - 256; v = bf2f(w.vT[((size_t)((t >> 7) * 4 + (cc >> 6)) * 64 + (cc & 63)) * 128 + (t & 127)]); }
    else if (c < 768) v = bf2f(w.ygb[(size_t)t * 256 + c - 512]);
    else if (c < 1024) v = 0.f;
    else if (c < 1280) v = bf2f(w.cqb[(size_t)t * 256 + c - 1024]);
    else if (c < 1408) v = bf2f(w.ckvb[(size_t)t * 128 + c - 1280]);
    else v = bf2f(w.kpeb[(size_t)t * 32 + c - 1408]);
    P.zf[idx] = v;
}
__global__ void k_shim_hb(Params P) {
    size_t i = (size_t)blockIdx.x * blockDim.x + threadIdx.x;
    if (i >= (size_t)NT * 1024 / 4) return;
    float4 v = ((const float4*)P.h)[i];
    uint2 pk; pk.x = pack2(v.x, v.y); pk.y = pack2(v.z, v.w);
    ((uint2*)P.w.hb)[i] = pk;
}

}
namespace fx {

constexpr float QSCALE = 0.10206207261596575f * 1.4426950408889634f;

__device__ void qkv_item(const Params& P, int L, const bool isq, const int mt, const int nt, char* lds, const int tid_in) {
    int tid = tid_in; asm volatile("" : "+v"(tid));
    const WS& w = P.w; const nv::Inputs& in = P.in;
    const int lane = tid & 63, wid = tid >> 6;
    float* T = (float*)lds; float* stat = (float*)(lds + STAT_OFF);
    const int m0 = mt * 128, n0 = nt * 128;
    const int K = isq ? 256 : 128;
    {
        const bf16_t* A = isq ? w.cqb : w.ckvb;
        const bf16_t* Wt = isq ? (w.Wuqt + L * WUQ_SZ) : (w.Wukvt + L * WUKV_SZ);
        const bf16_t* arow[2]; const bf16_t* wrow[2];
#pragma unroll
        for (int i = 0; i < 2; ++i) {
            arow[i] = A + (size_t)(m0 + (tid >> 2) + 64 * i) * K + gl_chunk(tid) * 8;
            wrow[i] = Wt + (size_t)(n0 + (tid >> 2) + 64 * i) * K + gl_chunk(tid) * 8;
        }
        f32x16 acc[2][2]; acc_zero(acc);
        gemm_mainloop_g(acc, arow, wrow, K / 32, lds, tid);
        if (tid < 128) {
            const float4 c = *(const float4*)(w.cqss + (size_t)(m0 + tid) * 4);
            stat[tid] = isq ? rsq_((c.x + c.y) * (1.f / 256.f) + EPS) : rsq_(c.z * (1.f / 128.f) + EPS);
        }
        acc_to_lds(acc, T, tid);
    }
    const int b = m0 >> 11, s0 = m0 & 2047;
    if (isq && nt < 4) {
        const int hd = nt * 2 + (lane >> 5), d = 2 * (lane & 31);
        const float2 g = *(const float2*)(in.q_norm_g + L * 96 + d);
        bf16_t* dst = w.Qb + ((size_t)(b * 8 + hd) * 2048 + s0) * 96 + d;
#pragma unroll 8
        for (int rr = 0; rr < 32; ++rr) {
            const int row = wid * 32 + rr; const float rs = stat[row];
            float2 x = *(const float2*)(T + row * TLD + 2 * lane);
            x.x *= rs; x.y *= rs;
            const float rn = rsq_(grp_sum32(x.x * x.x + x.y * x.y) * (1.f / 64.f) + EPS) * QSCALE;
            *(unsigned*)(dst + (size_t)row * 96) = pack2(x.x * rn * g.x, x.y * rn * g.y);
        }
    } else if (isq) {
        const int hd = (nt - 4) * 4 + (lane >> 4), d = 2 * (lane & 15);
        const float2 g = *(const float2*)(in.q_norm_g + L * 96 + 64 + d);
        bf16_t* dst = w.Qb + ((size_t)(b * 8 + hd) * 2048 + s0) * 96 + 64 + d;
        const int jj = d & 15;
#pragma unroll 16
        for (int rr = 0; rr < 32; ++rr) {
            const int row = wid * 32 + rr; const float rs = stat[row]; const int tok = m0 + row;
            float2 x = *(const float2*)(T + row * TLD + 2 * lane);
            x.x *= rs; x.y *= rs;
            const float rn = rsq_(grp_sum16(x.x * x.x + x.y * x.y) * (1.f / 32.f) + EPS);
            x.x *= rn * g.x; x.y *= rn * g.y;
            const float ox = xor8(x.x), oy = xor8(x.y);
            const float2 c = *(const float2*)(w.cs + (size_t)tok * 32 + jj), sn = *(const float2*)(w.cs + (size_t)tok * 32 + 16 + jj);
            float2 o;
            if ((lane & 8) == 0) { o.x = x.x * c.x - ox * sn.x; o.y = x.y * c.y - oy * sn.y; }
            else { o.x = x.x * c.x + ox * sn.x; o.y = x.y * c.y + oy * sn.y; }
            *(unsigned*)(dst + (size_t)row * 96) = pack2(o.x * QSCALE, o.y * QSCALE);
        }
    } else if (nt < 4) {
        const int hd = nt * 2 + (lane >> 5), d = 2 * (lane & 31);
        const float2 g = *(const float2*)(in.k_norm_g + L * 96 + d);
        bf16_t* dst = w.Knb + ((size_t)(b * 8 + hd) * 2048 + s0) * 64 + d;
#pragma unroll 8
        for (int rr = 0; rr < 32; ++rr) {
            const int row = wid * 32 + rr; const float rs = stat[row];
            float2 x = *(const float2*)(T + row * TLD + 2 * lane);
            x.x *= rs; x.y *= rs;
            const float rn = rsq_(grp_sum32(x.x * x.x + x.y * x.y) * (1.f / 64.f) + EPS);
            *(unsigned*)(dst + (size_t)row * 64) = pack2(x.x * rn * g.x, x.y * rn * g.y);
        }
    } else {
        const int c = tid & 127, th = tid >> 7, hd = (nt - 4) * 2 + (c >> 6), d = c & 63;
        bf16_t* dst = w.VTb + ((size_t)(b * 8 + hd) * 64 + d) * 2048 + s0 + th * 64;
#pragma unroll 2
        for (int k8 = 0; k8 < 8; ++k8) {
            float v[8];
#pragma unroll
            for (int k = 0; k < 8; ++k) { const int row = th * 64 + k8 * 8 + k; v[k] = T[row * TLD + c] * stat[row]; }
            uint4 pk; pk.x = pack2(v[0], v[1]); pk.y = pack2(v[2], v[3]); pk.z = pack2(v[4], v[5]); pk.w = pack2(v[6], v[7]);
            *(uint4*)(dst + k8 * 8) = pk;
        }
    }
    __syncthreads();
}

__device__ void sgu_item(const Params& P, int L, int mt, char* lds, const int tid_in) {
    int tid = tid_in; asm volatile("" : "+v"(tid));
    const WS& w = P.w; const nv::Inputs& in = P.in;
    const int lane = tid & 63, hd = tid >> 6, fr = lane & 31, fh = lane >> 5;
    float* red = (float*)lds;
    const bf16_t* vt = w.vT + (size_t)(mt * 4 + hd) * 64 * 128;
    const bf16_t* ws = w.Wsm + L * WSM_SZ + (size_t)hd * 128 * 128;
    const float* bs = in.sgu_b + L * 512 + hd * 128;
    const int m0 = mt * 128;
#pragma unroll 1
    for (int it = 0; it < 4; ++it) {
        f32x16 a0, a1;
#pragma unroll
        for (int r = 0; r < 16; ++r) { a0[r] = 0.f; a1[r] = 0.f; }
        const int nks = 2 * (it + 1);
        const bf16_t* bp = ws + (size_t)(it * 32 + fr) * 128 + 8 * fh;
        const bf16_t* ap0 = vt + (size_t)fr * 128 + 8 * fh;
        const bf16_t* ap1 = vt + (size_t)(32 + fr) * 128 + 8 * fh;
#pragma unroll 2
        for (int s = 0; s < nks; ++s) {
            const bf16x8 bfrag = *(const bf16x8*)(bp + 16 * s);
            const bf16x8 af0 = *(const bf16x8*)(ap0 + 16 * s), af1 = *(const bf16x8*)(ap1 + 16 * s);
            a0 = __builtin_amdgcn_mfma_f32_32x32x16_bf16(af0, bfrag, a0, 0, 0, 0);
            a1 = __builtin_amdgcn_mfma_f32_32x32x16_bf16(af1, bfrag, a1, 0, 0, 0);
        }
        const int i = it * 32 + fr, tok = m0 + i;
        const float bias = bs[i];
        float ssq = 0.f;
#pragma unroll
        for (int dt = 0; dt < 2; ++dt)
#pragma unroll
            for (int g = 0; g < 4; ++g) {
                const int d = dt * 32 + 8 * g + 4 * fh;
                const uint2 uu = *(const uint2*)(w.ub + (size_t)tok * 256 + hd * 64 + d);
                float o[4];
#pragma unroll
                for (int q = 0; q < 4; ++q) {
                    const float sv = (dt == 0 ? a0[4 * g + q] : a1[4 * g + q]) + bias;
                    const float uv = (q == 0) ? bflo(uu.x) : (q == 1) ? bfhi(uu.x) : (q == 2) ? bflo(uu.y) : bfhi(uu.y);
                    o[q] = uv * sv; ssq += o[q] * o[q];
                }
                store4(w.yb + (size_t)tok * 1024 + hd * 64 + d, o[0], o[1], o[2], o[3]);
            }
        ssq = xor32(ssq);
        if (fh == 0) red[hd * 128 + i] = ssq;
    }
    __syncthreads();
    if (tid < 128) w.ssq[(size_t)(m0 + tid) * 16 + 0] = red[tid] + red[128 + tid] + red[256 + tid] + red[384 + tid];
    __syncthreads();
}

constexpr int CLD = 260, CONV_YL = 32 * CLD * 4, CONV_ST = CONV_YL + 32 * 512, CONV_RED = CONV_ST + 32 * 4 * 8;
__device__ __forceinline__ int yl_off(int row, int chunk) { return row * 512 + ((chunk ^ (row & 15)) << 4); }
__device__ void conv_item(const Params& P, int L, int ct, char* lds, const int tid_in) {
    int tid = tid_in; asm volatile("" : "+v"(tid));
    const WS& w = P.w; const nv::Inputs& in = P.in;
    const int lane = tid & 63, wid = tid >> 6, fr = lane & 31, fh = lane >> 5;
    float* C = (float*)lds; char* yl = lds + CONV_YL; float2* stats = (float2*)(lds + CONV_ST); float* red = (float*)(lds + CONV_RED);
    const int t0 = ct * 32, s0 = t0 & 2047;
    {
        const int c = tid;
        float x[62];
#pragma unroll
        for (int r = 0; r < 62; ++r) x[r] = (s0 + r - 30 >= 0) ? bf2f(w.ygb[(size_t)(t0 + r - 30) * 256 + c]) : 0.f;
        float wk[31];
#pragma unroll
        for (int k = 0; k < 31; ++k) wk[k] = in.conv_w[(size_t)L * 31 * 256 + k * 256 + c];
        const float cb = in.conv_b[L * 256 + c];
#pragma unroll
        for (int t = 0; t < 32; ++t) {
            float a = cb;
#pragma unroll
            for (int k = 0; k < 31; ++k) a = fmaf(wk[k], x[t + k], a);
            C[t * CLD + c] = a;
        }
    }
    __syncthreads();
    if (tid < 128) {
        const int t = tid >> 2, g = tid & 3;
        const float4* cp = (const float4*)(C + t * CLD + g * 64);
        float4 v[16]; float s = 0.f;
#pragma unroll
        for (int i = 0; i < 16; ++i) { v[i] = cp[i]; s += (v[i].x + v[i].y) + (v[i].z + v[i].w); }
        const float mean = s * (1.f / 64.f); float q = 0.f;
#pragma unroll
        for (int i = 0; i < 16; ++i) { const float a = v[i].x - mean, b2 = v[i].y - mean, c2 = v[i].z - mean, d2 = v[i].w - mean; q += (a * a + b2 * b2) + (c2 * c2 + d2 * d2); }
        stats[t * 4 + g] = make_float2(mean, rsq_(q * (1.f / 64.f) + EPS));
    }
    __syncthreads();
    {
        const int c = tid, g = c >> 6;
        const float lg = in.conv_ln_g[L * 256 + c], lb = in.conv_ln_b[L * 256 + c];
#pragma unroll 8
        for (int t = 0; t < 32; ++t) {
            const float2 st = stats[t * 4 + g];
            const float v = (C[t * CLD + c] - st.x) * st.y * lg + lb;
            *(bf16_t*)(yl + yl_off(t, c >> 3) + (c & 7) * 2) = (bf16_t)f2bf(v * sigmoid_(v));
        }
    }
    __syncthreads();
    f32x16 acc0, acc1;
#pragma unroll
    for (int r = 0; r < 16; ++r) { acc0[r] = 0.f; acc1[r] = 0.f; }
    const bf16_t* wp = w.Wpwt + L * WPW_SZ + (size_t)(wid * 64 + fr) * 256 + 8 * fh;
#pragma unroll 4
    for (int s = 0; s < 16; ++s) {
        const bf16x8 w0 = *(const bf16x8*)(wp + 16 * s), w1 = *(const bf16x8*)(wp + 32 * 256 + 16 * s);
        const bf16x8 x0 = *(const bf16x8*)(yl + yl_off(fr, 2 * s + fh));
        acc0 = __builtin_amdgcn_mfma_f32_32x32x16_bf16(w0, x0, acc0, 0, 0, 0);
        acc1 = __builtin_amdgcn_mfma_f32_32x32x16_bf16(w1, x0, acc1, 0, 0, 0);
    }
    const float* pb = in.conv_pw_b + L * 256;
    {
        const int tok = t0 + fr;
        float ssq = 0.f;
#pragma unroll
        for (int jn = 0; jn < 2; ++jn)
#pragma unroll
            for (int g = 0; g < 4; ++g) {
                const int n = wid * 64 + jn * 32 + 8 * g + 4 * fh;
                const float4 b4 = *(const float4*)(pb + n);
                const float o0 = (jn ? acc1[4 * g] : acc0[4 * g]) + b4.x, o1 = (jn ? acc1[4 * g + 1] : acc0[4 * g + 1]) + b4.y;
                const float o2 = (jn ? acc1[4 * g + 2] : acc0[4 * g + 2]) + b4.z, o3 = (jn ? acc1[4 * g + 3] : acc0[4 * g + 3]) + b4.w;
                ssq += o0 * o0 + o1 * o1 + o2 * o2 + o3 * o3;
                store4(w.yb + (size_t)tok * 1024 + 256 + n, o0, o1, o2, o3);
            }
        ssq = xor32(ssq);
        if (fh == 0) red[wid * 32 + fr] = ssq;
    }
    __syncthreads();
    if (tid < 32) w.ssq[(size_t)(t0 + tid) * 16 + 1] = red[tid] + red[32 + tid] + red[64 + tid] + red[96 + tid];
    __syncthreads();
}

__device__ void phase_mix(const Params& P, int L, char* lds) {
    const int tid = opaque_tid();
    int mt, nt;
    for (int it = 0; xcd_item(it, 128, 6, mt, nt); ++it) qkv_item(P, L, true, mt, nt, lds, tid);
    for (int it = 0; xcd_item(it, 128, 8, mt, nt); ++it) qkv_item(P, L, false, mt, nt, lds, tid);
    for (int ct = blockIdx.x; ct < 512; ct += gridDim.x) conv_item(P, L, ct, lds, tid);
    {
        const int x = blockIdx.x & 7, lb = blockIdx.x >> 3, nlb = gridDim.x >> 3;
        const int lo = nlb >= 48 ? 32 : 0;
        for (int j = lb - lo; j >= 0 && j < 16; j += nlb) sgu_item(P, L, j * 8 + x, lds, tid);
    }
}

__global__ void k_shim_qkv(Params P, int t0, float* q, float* kv) {
    const WS& w = P.w;
    size_t idx = (size_t)blockIdx.x * blockDim.x + threadIdx.x;
    if (idx >= (size_t)2048 * 1792) return;
    const int tl = (int)(idx / 1792), c = (int)(idx % 1792), t = t0 + tl, b = t >> 11, s = t & 2047;
    if (c < 768) { const int h = c / 96, d = c % 96; q[(size_t)tl * 768 + c] = bf2f(w.Qb[((size_t)(b * 8 + h) * 2048 + s) * 96 + d]) * (1.f / QSCALE); }
    else {
        const int cc = c - 768, h = cc >> 7, d = cc & 127;
        kv[(size_t)tl * 1024 + cc] = (d < 64) ? bf2f(w.Knb[((size_t)(b * 8 + h) * 2048 + s) * 64 + d]) : bf2f(w.VTb[((size_t)(b * 8 + h) * 64 + (d - 64)) * 2048 + s]);
    }
}
__global__ void k_shim_y(Params P, int t0, int c0, int c1) {
    const int wdt = c1 - c0;
    size_t idx = (size_t)blockIdx.x * blockDim.x + threadIdx.x;
    if (idx >= (size_t)2048 * wdt) return;
    const int tl = (int)(idx / wdt), c = c0 + (int)(idx % wdt);
    P.yf[(size_t)tl * 1024 + c] = bf2f(P.w.yb[(size_t)(t0 + tl) * 1024 + c]);
}

}
namespace fx {

constexpr int KROW = 208, VROW = 136, ATT_STAGE = 64 * KROW + 64 * VROW;

struct KVRegs { uint4 k0, k1, k2, v0, v1; };
__device__ __forceinline__ uint4 k_ld(const bf16_t* Kn, const bf16_t* Kp, int k0, int c) {
    const int key = c / 12, ch = c % 12;
    const bf16_t* src = (ch < 8) ? (Kn + (size_t)(k0 + key) * 64 + ch * 8) : (Kp + (size_t)(k0 + key) * 32 + (ch - 8) * 8);
    return *(const uint4*)src;
}
__device__ __forceinline__ void kv_load(KVRegs& r, const bf16_t* Kn, const bf16_t* Kp, const bf16_t* Vt, int k0, const int tid) {
    r.k0 = k_ld(Kn, Kp, k0, tid); r.k1 = k_ld(Kn, Kp, k0, tid + 256); r.k2 = k_ld(Kn, Kp, k0, tid + 512);
    r.v0 = *(const uint4*)(Vt + (size_t)(tid >> 3) * 2048 + k0 + (tid & 7) * 8);
    r.v1 = *(const uint4*)(Vt + (size_t)(32 + (tid >> 3)) * 2048 + k0 + (tid & 7) * 8);
}
__device__ __forceinline__ void k_st(char* st, int c, const uint4& v) { const int key = c / 12, ch = c % 12; *(uint4*)(st + key * KROW + ch * 16) = v; }
__device__ __forceinline__ void v_st(char* st, int d, int ch, const uint4& v) {
    char* p = st + 64 * KROW + d * VROW + ch * 16;
    *(uint2*)p = make_uint2(v.x, v.y); *(uint2*)(p + 8) = make_uint2(v.z, v.w);
}
__device__ __forceinline__ void kv_store(const KVRegs& r, char* st, const int tid) {
    k_st(st, tid, r.k0); k_st(st, tid + 256, r.k1); k_st(st, tid + 512, r.k2);
    v_st(st, tid >> 3, tid & 7, r.v0); v_st(st, 32 + (tid >> 3), tid & 7, r.v1);
}

__device__ void attn_unit(const Params& P, int b, int h, int qt, char* lds, const int tid) {
    const WS& w = P.w;
    const int lane = tid & 63, wid = tid >> 6, fr = lane & 31, fh = lane >> 5;
    const bf16_t* Kn = w.Knb + (size_t)(b * 8 + h) * 2048 * 64;
    const bf16_t* Kp = w.kpeb + (size_t)b * 2048 * 32;
    const bf16_t* Vt = w.VTb + (size_t)(b * 8 + h) * 64 * 2048;
    const int q0 = qt * 128, qw0 = q0 + wid * 32, qpos = qw0 + fr;
    bf16x8 qf[6];
    {
        const bf16_t* qp = w.Qb + ((size_t)(b * 8 + h) * 2048 + qpos) * 96 + 8 * fh;
#pragma unroll
        for (int ks = 0; ks < 6; ++ks) qf[ks] = *(const bf16x8*)(qp + 16 * ks);
    }
    f32x16 o0, o1;
#pragma unroll
    for (int r = 0; r < 16; ++r) { o0[r] = 0.f; o1[r] = 0.f; }
    float m = -1e30f, l = 0.f;
    const int nkt = 2 * (qt + 1);
    KVRegs kr;
    kv_load(kr, Kn, Kp, Vt, 0, tid);
    kv_store(kr, lds, tid);
    __syncthreads();
#pragma unroll 1
    for (int kt = 0; kt < nkt; ++kt) {
        char* cur = lds + (kt & 1) * ATT_STAGE;
        char* nxt = lds + ((kt + 1) & 1) * ATT_STAGE;
        const bool more = kt + 1 < nkt;
        if (more) kv_load(kr, Kn, Kp, Vt, (kt + 1) * 64, tid);
        const int k0 = kt * 64;
        if (k0 <= qw0 + 31) {
            f32x16 s0, s1;
#pragma unroll
            for (int r = 0; r < 16; ++r) { s0[r] = 0.f; s1[r] = 0.f; }
            const char* kb = cur + fr * KROW + fh * 16;
#pragma unroll
            for (int ks = 0; ks < 6; ++ks) {
                const bf16x8 ka = *(const bf16x8*)(kb + ks * 32), kb2 = *(const bf16x8*)(kb + 32 * KROW + ks * 32);
                s0 = __builtin_amdgcn_mfma_f32_32x32x16_bf16(ka, qf[ks], s0, 0, 0, 0);
                s1 = __builtin_amdgcn_mfma_f32_32x32x16_bf16(kb2, qf[ks], s1, 0, 0, 0);
            }
            if (k0 + 63 > qw0) {
#pragma unroll
                for (int r = 0; r < 16; ++r) {
                    const int key = k0 + nidx(r, fh);
                    if (key > qpos) s0[r] = -1e30f;
                    if (key + 32 > qpos) s1[r] = -1e30f;
                }
            }
            float mx = s0[0];
#pragma unroll
            for (int r = 1; r < 16; ++r) mx = fmaxf(mx, s0[r]);
#pragma unroll
            for (int r = 0; r < 16; ++r) mx = fmaxf(mx, s1[r]);
            mx = swap32_max(mx);
            const float mn = fmaxf(m, mx);
            const float alpha = __builtin_amdgcn_exp2f(m - mn);
            m = mn;
            float ps = 0.f;
#pragma unroll
            for (int r = 0; r < 16; ++r) { s0[r] = __builtin_amdgcn_exp2f(s0[r] - mn); ps += s0[r]; }
#pragma unroll
            for (int r = 0; r < 16; ++r) { s1[r] = __builtin_amdgcn_exp2f(s1[r] - mn); ps += s1[r]; }
            ps = swap32_sum(ps);
            l = l * alpha + ps;
#pragma unroll
            for (int r = 0; r < 16; ++r) { o0[r] *= alpha; o1[r] *= alpha; }
            const char* vb = cur + 64 * KROW + fr * VROW + fh * 8;
#pragma unroll
            for (int ks = 0; ks < 4; ++ks) {
                bf16x8 pf;
                {
                    const int rb = 8 * (ks & 1);
                    unsigned u0, u1, u2, u3;
                    if (ks < 2) { u0 = pack2(s0[rb], s0[rb + 1]); u1 = pack2(s0[rb + 2], s0[rb + 3]); u2 = pack2(s0[rb + 4], s0[rb + 5]); u3 = pack2(s0[rb + 6], s0[rb + 7]); }
                    else { u0 = pack2(s1[rb], s1[rb + 1]); u1 = pack2(s1[rb + 2], s1[rb + 3]); u2 = pack2(s1[rb + 4], s1[rb + 5]); u3 = pack2(s1[rb + 6], s1[rb + 7]); }
                    uint4 uu = make_uint4(u0, u1, u2, u3);
                    pf = __builtin_bit_cast(bf16x8, uu);
                }
                const uint2 va0 = *(const uint2*)(vb + ks * 32), va1 = *(const uint2*)(vb + ks * 32 + 16);
                const uint2 vb0 = *(const uint2*)(vb + 32 * VROW + ks * 32), vb1 = *(const uint2*)(vb + 32 * VROW + ks * 32 + 16);
                const bf16x8 vfa = __builtin_bit_cast(bf16x8, make_uint4(va0.x, va0.y, va1.x, va1.y));
                const bf16x8 vfb = __builtin_bit_cast(bf16x8, make_uint4(vb0.x, vb0.y, vb1.x, vb1.y));
                o0 = __builtin_amdgcn_mfma_f32_32x32x16_bf16(vfa, pf, o0, 0, 0, 0);
                o1 = __builtin_amdgcn_mfma_f32_32x32x16_bf16(vfb, pf, o1, 0, 0, 0);
            }
        }
        if (more) kv_store(kr, nxt, tid);
        __syncthreads();
    }
    const float inv = 1.f / l;
    const int tok = b * 2048 + qpos;
    float ssq = 0.f;
#pragma unroll
    for (int dt = 0; dt < 2; ++dt)
#pragma unroll
        for (int g = 0; g < 4; ++g) {
            float o[4];
#pragma unroll
            for (int q = 0; q < 4; ++q) { o[q] = (dt == 0 ? o0[4 * g + q] : o1[4 * g + q]) * inv; ssq += o[q] * o[q]; }
            store4(w.yb + (size_t)tok * 1024 + 512 + h * 64 + dt * 32 + 8 * g + 4 * fh, o[0], o[1], o[2], o[3]);
        }
    ssq = xor32(ssq);
    if (fh == 0) w.ssq[(size_t)tok * 16 + 8 + h] = ssq;
}

__device__ void phase_attn(const Params& P, int L, char* lds) {
    const int tid0 = opaque_tid();
    const int h = blockIdx.x & 7, nlb = gridDim.x >> 3;
    for (int li = blockIdx.x >> 3; li < 64; li += nlb) {
        int tid = tid0; asm volatile("" : "+v"(tid));
        const int p = li & 7, b = li >> 3;
        attn_unit(P, b, h, 15 - p, lds, tid);
        attn_unit(P, b, h, p, lds, tid);
    }
}

}
namespace fx {

__device__ __forceinline__ void acc_scale(f32x16 (&acc)[2][2], const float* f, const int tid) {
    const int lane = tid & 63, wr = tid >> 7, fr = lane & 31;
#pragma unroll
    for (int i = 0; i < 2; ++i) {
        const float v = f[wr * 64 + i * 32 + fr];
#pragma unroll
        for (int j = 0; j < 2; ++j)
#pragma unroll
            for (int r = 0; r < 16; ++r) acc[i][j][r] *= v;
    }
}
__device__ void phase_oproj(const Params& P, int L, char* lds, const bool dry = false) {
    const WS& w = P.w;
    const int tid0 = opaque_tid();
    float* T = (float*)lds; float* stat = (float*)(lds + STAT_OFF);
    const bf16_t* Wt = w.Wot + L * WO_SZ;
    int mt, nt;
    for (int it = 0; xcd_item(it, 128, 8, mt, nt); ++it) {
        int tid = tid0; asm volatile("" : "+v"(tid));
        const int lane = tid & 63, wid = tid >> 6;
        const int m0 = mt * 128, n0 = nt * 128;
        float rb_keep = 0.f;
        if (tid < 128) {
            const float* sq = w.ssq + (size_t)(m0 + tid) * 16;
            const float4 c0 = *(const float4*)(sq + 8), c1 = *(const float4*)(sq + 12);
            const float ra = rsq_(sq[0] * (1.f / 256.f) + EPS), rb = rsq_(sq[1] * (1.f / 256.f) + EPS);
            const float rc = rsq_((c0.x + c0.y + c0.z + c0.w + c1.x + c1.y + c1.z + c1.w) * (1.f / 512.f) + EPS);
            stat[tid] = rc / ra; stat[128 + tid] = ra / rb; rb_keep = rb;
        }
        {
            const bf16_t* arow[2]; const bf16_t* wrow[2];
#pragma unroll
            for (int i = 0; i < 2; ++i) {
                arow[i] = w.yb + (size_t)(m0 + (tid >> 2) + 64 * i) * 1024 + gl_chunk(tid) * 8 + 512;
                wrow[i] = Wt + (size_t)(n0 + (tid >> 2) + 64 * i) * 1024 + gl_chunk(tid) * 8 + 512;
            }
            f32x16 acc[2][2]; acc_zero(acc);
            gemm_mainloop_g(acc, arow, wrow, 16, lds, tid);
            acc_scale(acc, stat, tid);
#pragma unroll
            for (int i = 0; i < 2; ++i) { arow[i] -= 512; wrow[i] -= 512; }
            gemm_mainloop_g(acc, arow, wrow, 8, lds, tid);
            acc_scale(acc, stat + 128, tid);
#pragma unroll
            for (int i = 0; i < 2; ++i) { arow[i] += 256; wrow[i] += 256; }
            gemm_mainloop_g(acc, arow, wrow, 8, lds, tid);
            if (tid < 128) stat[tid] = rb_keep;
            acc_to_lds(acc, T, tid);
        }
#pragma unroll 16
        for (int rr = 0; rr < 32; ++rr) {
            const int row = wid * 32 + rr; const float rb = stat[row];
            const float2 x = *(const float2*)(T + row * TLD + 2 * lane);
            float2* hp = (float2*)(P.h + (size_t)(m0 + row) * 1024 + n0 + 2 * lane);
            float2 hv = *hp; hv.x += x.x * rb; hv.y += x.y * rb;
            if (!dry) *hp = hv;
            *(unsigned*)(w.hb1 + (size_t)(m0 + row) * 1024 + n0 + 2 * lane) = pack2(hv.x, hv.y);
            float sq = grp_sum32(hv.x * hv.x + hv.y * hv.y); sq = swap32_sum(sq);
            if (lane == 0) w.rssB[(size_t)(m0 + row) * 8 + nt] = sq;
        }
        __syncthreads();
    }
}

__device__ void router_item(const Params& P, int L, int mt, char* lds, const int tid_in, const bool dry) {
    int tid = tid_in; asm volatile("" : "+v"(tid));
    const WS& w = P.w; const nv::Inputs& in = P.in;
    float* T = (float*)lds; float* stat = (float*)(lds + STAT_OFF); int* hist = (int*)(lds + STAT_OFF + 1024);
    const int m0 = mt * 128;
    {
        const bf16_t* arow[2]; const bf16_t* wrow[2];
#pragma unroll
        for (int i = 0; i < 2; ++i) {
            arow[i] = w.hb1 + (size_t)(m0 + (tid >> 2) + 64 * i) * 1024 + gl_chunk(tid) * 8;
            wrow[i] = w.Wrt + L * WR_SZ + (size_t)((tid >> 2) + 64 * i) * 1024 + gl_chunk(tid) * 8;
        }
        f32x16 acc[2][2]; acc_zero(acc);
        gemm_mainloop_g(acc, arow, wrow, 32, lds, tid);
        if (tid < 128) stat[tid] = rstd8(w.rssB + (size_t)(m0 + tid) * 8, 1.f / 1024.f);
        if (tid < 32) hist[tid] = 0;
        acc_to_lds(acc, T, tid);
    }
    int e0 = 0, e1 = 0, r0 = 0, r1 = 0; float w0 = 0.f, w1 = 0.f;
    if (tid < 128) {
        const float rs = stat[tid];
        const float* lr = T + tid * TLD;
        const float* bg = in.router_group_b + L * 4; const float* be = in.router_expert_b + L * 32;
        int gi = 0; float gm = lr[0] * rs + bg[0];
#pragma unroll
        for (int j = 1; j < 4; ++j) { const float v = lr[j] * rs + bg[j]; if (v > gm) { gm = v; gi = j; } }
        float gs = 0.f;
#pragma unroll
        for (int j = 0; j < 4; ++j) gs += __builtin_amdgcn_exp2f(1.4426950408889634f * (lr[j] * rs + bg[j] - gm));
        const float gw = 1.f / gs;
        int i0 = 0, i1 = -1; float v0 = -3.0e38f, v1 = -3.0e38f;
#pragma unroll
        for (int j = 0; j < 8; ++j) {
            const float v = lr[4 + gi * 8 + j] * rs + be[gi * 8 + j];
            if (v > v0) { v1 = v0; i1 = i0; v0 = v; i0 = j; } else if (v > v1) { v1 = v; i1 = j; }
        }
        const float ex = __builtin_amdgcn_exp2f(1.4426950408889634f * (v1 - v0));
        w0 = gw / (1.f + ex); w1 = gw * ex / (1.f + ex);
        e0 = gi * 8 + i0; e1 = gi * 8 + i1;
        r0 = atomicAdd(&hist[e0], 1); r1 = atomicAdd(&hist[e1], 1);
    }
    __syncthreads();
    if (tid < 32) hist[32 + tid] = (hist[tid] && !dry) ? atomicAdd(&w.cnt[L * 64 + tid], hist[tid]) : 0;
    __syncthreads();
    if (tid < 128 && !dry) {
        const int tok = m0 + tid;
        const int p0 = hist[32 + e0] + r0, p1 = hist[32 + e1] + r1;
        w.elist[(size_t)e0 * NT + p0] = tok * 2; w.ewt[(size_t)e0 * NT + p0] = w0;
        w.elist[(size_t)e1 * NT + p1] = tok * 2 + 1; w.ewt[(size_t)e1 * NT + p1] = w1;
    }
    __syncthreads();
}
__device__ void eraw_item(const Params& P, int L, const int mt, const int nt, char* lds, const int tid_in) {
    int tid = tid_in; asm volatile("" : "+v"(tid));
    const WS& w = P.w; const nv::Inputs& in = P.in;
    const int lane = tid & 63, wid = tid >> 6;
    float* T = (float*)lds;
    const int m0 = mt * 128, n0 = nt * 128;
    {
        const float* arow[4]; const bf16_t* wrow[4];
#pragma unroll
        for (int i = 0; i < 4; ++i) {
            arow[i] = in.p + ((size_t)L * NT + m0 + (tid >> 3) + 32 * i) * 256 + (tid & 7) * 8;
            wrow[i] = w.Wpt + L * WP_SZ + (size_t)(n0 + (tid >> 3) + 32 * i) * 256 + (tid & 7) * 8;
        }
        f32x16 acc[2][2]; acc_zero(acc);
        float ss[4] = {0.f, 0.f, 0.f, 0.f};
        gemm_mainloop<float, false>(acc, arow, wrow, 4, lds, ss, tid);
        acc_to_lds(acc, T, tid);
    }
#pragma unroll 8
    for (int rr = 0; rr < 32; ++rr) {
        const int row = wid * 32 + rr;
        const float2 x = *(const float2*)(T + row * TLD + 2 * lane);
        *(unsigned*)(w.erb + (size_t)(m0 + row) * 1024 + n0 + 2 * lane) = pack2(x.x, x.y);
        float sq = x.x * x.x + x.y * x.y;
        sq = grp_sum32(sq); sq = swap32_sum(sq);
        if (lane == 0) w.essq[(size_t)(m0 + row) * 8 + nt] = sq;
    }
    __syncthreads();
}
__device__ void phase_router(const Params& P, int L, char* lds, const bool dry = false) {
    const int tid = opaque_tid();
    int mt, nt;
    {
        const int x = blockIdx.x & 7, lb = blockIdx.x >> 3, nlb = gridDim.x >> 3;
        const int lo = nlb >= 16 ? nlb - 16 : 0;
        for (int j = lb - lo; j >= 0 && j < 16; j += nlb) router_item(P, L, j * 8 + x, lds, tid, dry);
    }
    for (int it = 0; xcd_item(it, 128, 8, mt, nt); ++it) eraw_item(P, L, mt, nt, lds, tid);
}

constexpr int TT_OFF = STAT_OFF + 1024;
__device__ __forceinline__ void moe_table(const Params& P, int L, char* lds, const int tid) {
    int* tt = (int*)(lds + TT_OFF);
    if (tid == 0) {
        const int x = blockIdx.x & 7;
        int o = 0, t = 0;
        for (int e = 0; e < 32; ++e) {
            const int c = P.w.cnt[L * 64 + e];
            tt[e] = o; o += c;
            if ((e & 7) == x) { tt[40 + (e >> 3)] = t; t += (c + 127) >> 7; }
        }
        tt[32] = o; tt[44] = t;
    }
    __syncthreads();
}
__device__ __forceinline__ void moe_find(const int* tt, int tile, int& e, int& t) {
    int k = 0;
    if (tile >= tt[41]) k = 1;
    if (tile >= tt[42]) k = 2;
    if (tile >= tt[43]) k = 3;
    e = (blockIdx.x & 7) + 8 * k; t = tile - tt[40 + k];
}
__device__ void phase_moe_up(const Params& P, int L, char* lds) {
    const WS& w = P.w;
    const int tid0 = opaque_tid();
    float* T = (float*)lds; float* stat = (float*)(lds + STAT_OFF); const int* tt = (const int*)(lds + TT_OFF);
    moe_table(P, L, lds, tid0);
    const int ntiles = tt[44];
    for (int item = blockIdx.x >> 3; item < ntiles * 4; item += (gridDim.x >> 3)) {
        int tid = tid0; asm volatile("" : "+v"(tid));
        const int lane = tid & 63, wid = tid >> 6;
        const int tile = item >> 2, nt = item & 3;
        int e, t; moe_find(tt, tile, e, t);
        const int cnt = P.w.cnt[L * 64 + e], rbase = tt[e] + t * 128, nrows = min(128, cnt - t * 128);
        {
            const bf16_t* arow[2]; const bf16_t* wrow[2];
#pragma unroll
            for (int i = 0; i < 2; ++i) {
                const int r = (tid >> 2) + 64 * i;
                const int ent = w.elist[(size_t)e * NT + t * 128 + (r < nrows ? r : 0)];
                arow[i] = w.hb1 + (size_t)(ent >> 1) * 1024 + gl_chunk(tid) * 8;
                wrow[i] = w.Wgut + L * WGU_SZ + ((size_t)e * 512 + nt * 128 + r) * 1024 + gl_chunk(tid) * 8;
            }
            f32x16 acc[2][2]; acc_zero(acc);
            gemm_mainloop_g(acc, arow, wrow, 32, lds, tid);
            if (tid < 128) {
                const int ent = w.elist[(size_t)e * NT + t * 128 + (tid < nrows ? tid : 0)];
                stat[tid] = rstd8(w.rssB + (size_t)(ent >> 1) * 8, 1.f / 1024.f);
            }
            acc_to_lds(acc, T, tid);
        }
#pragma unroll 8
        for (int rr = 0; rr < 32; ++rr) {
            const int row = wid * 32 + rr; const float rs = stat[row];
            const float2 x = *(const float2*)(T + row * TLD + 2 * lane);
            const float g = x.x * rs, u = x.y * rs;
            if (row < nrows) w.hbuf[(size_t)(rbase + row) * 256 + nt * 64 + lane] = (bf16_t)f2bf(g * sigmoid_(g) * u);
        }
        __syncthreads();
    }
}
__device__ void phase_moe_down(const Params& P, int L, char* lds) {
    const WS& w = P.w;
    const int tid0 = opaque_tid();
    float* T = (float*)lds; float* stat = (float*)(lds + STAT_OFF); const int* tt = (const int*)(lds + TT_OFF);
    moe_table(P, L, lds, tid0);
    const int ntiles = tt[44];
    for (int item = blockIdx.x >> 3; item < ntiles * 8; item += (gridDim.x >> 3)) {
        int tid = tid0; asm volatile("" : "+v"(tid));
        const int lane = tid & 63, wid = tid >> 6;
        const int tile = item >> 3, nt = item & 7;
        int e, t; moe_find(tt, tile, e, t);
        const int cnt = P.w.cnt[L * 64 + e], rbase = tt[e] + t * 128, nrows = min(128, cnt - t * 128);
        {
            const bf16_t* arow[2]; const bf16_t* wrow[2];
#pragma unroll
            for (int i = 0; i < 2; ++i) {
                const int r = (tid >> 2) + 64 * i;
                arow[i] = w.hbuf + (size_t)(rbase + (r < nrows ? r : 0)) * 256 + gl_chunk(tid) * 8;
                wrow[i] = w.Wdt + L * WD_SZ + ((size_t)e * 1024 + nt * 128 + r) * 256 + gl_chunk(tid) * 8;
            }
            f32x16 acc[2][2]; acc_zero(acc);
            gemm_mainloop_g(acc, arow, wrow, 8, lds, tid);
            if (tid < 128) {
                const int rr2 = tid < nrows ? tid : 0;
                ((int*)stat)[tid] = w.elist[(size_t)e * NT + t * 128 + rr2]; stat[128 + tid] = w.ewt[(size_t)e * NT + t * 128 + rr2];
            }
            acc_to_lds(acc, T, tid);
        }
#pragma unroll 8
        for (int rr = 0; rr < 32; ++rr) {
            const int row = wid * 32 + rr;
            if (row < nrows) {
                const int ent = ((const int*)stat)[row]; const float wt = stat[128 + row];
                const float2 x = *(const float2*)(T + row * TLD + 2 * lane);
                *(unsigned*)(w.contrib + (size_t)ent * 1024 + nt * 128 + 2 * lane) = pack2(x.x * wt, x.y * wt);
            }
        }
        __syncthreads();
    }
}

__device__ void phase_combine(const Params& P, int L, char* lds) {
    const WS& w = P.w;
    const int tid = opaque_tid(), lane = tid & 63;
    for (size_t tok = (size_t)blockIdx.x * 4 + (tid >> 6); tok < NT; tok += (size_t)gridDim.x * 4) {
        float ss = 0.f;
#pragma unroll
        for (int j = 0; j < 2; ++j) {
            const size_t c8 = (size_t)(j * 64 + lane) * 8;
            const uint4 a = *(const uint4*)(w.contrib + (tok * 2) * 1024 + c8), b = *(const uint4*)(w.contrib + (tok * 2 + 1) * 1024 + c8);
            float4* hp = (float4*)(P.h + tok * 1024 + c8);
            float4 h0 = hp[0], h1 = hp[1];
            h0.x += bflo(a.x) + bflo(b.x); h0.y += bfhi(a.x) + bfhi(b.x); h0.z += bflo(a.y) + bflo(b.y); h0.w += bfhi(a.y) + bfhi(b.y);
            h1.x += bflo(a.z) + bflo(b.z); h1.y += bfhi(a.z) + bfhi(b.z); h1.z += bflo(a.w) + bflo(b.w); h1.w += bfhi(a.w) + bfhi(b.w);
            hp[0] = h0; hp[1] = h1;
            uint4 pk; pk.x = pack2(h0.x, h0.y); pk.y = pack2(h0.z, h0.w); pk.z = pack2(h1.x, h1.y); pk.w = pack2(h1.z, h1.w);
            *(uint4*)(w.hb1 + tok * 1024 + c8) = pk;
            ss += (h0.x * h0.x + h0.y * h0.y) + (h0.z * h0.z + h0.w * h0.w) + (h1.x * h1.x + h1.y * h1.y) + (h1.z * h1.z + h1.w * h1.w);
        }
        ss = wave_sum64(ss);
        if (lane < 8) w.rssB[tok * 8 + lane] = lane == 0 ? ss : 0.f;
    }
}

__device__ void phase_ple(const Params& P, int L, char* lds, const bool dry = false) {
    const WS& w = P.w; const nv::Inputs& in = P.in;
    const int tid0 = opaque_tid();
    float* T = (float*)lds; float* stat = (float*)(lds + STAT_OFF);
    int mt, nt;
    for (int it = 0; xcd_item(it, 128, 8, mt, nt); ++it) {
        int tid = tid0; asm volatile("" : "+v"(tid));
        const int lane = tid & 63, wid = tid >> 6;
        const int m0 = mt * 128, n0 = nt * 128;
        {
            const bf16_t* arow[2]; const bf16_t* wrow[2];
#pragma unroll
            for (int i = 0; i < 2; ++i) {
                arow[i] = w.hb1 + (size_t)(m0 + (tid >> 2) + 64 * i) * 1024 + gl_chunk(tid) * 8;
                wrow[i] = w.Wgt + L * WG_SZ + (size_t)(n0 + (tid >> 2) + 64 * i) * 1024 + gl_chunk(tid) * 8;
            }
            f32x16 acc[2][2]; acc_zero(acc);
            gemm_mainloop_g(acc, arow, wrow, 32, lds, tid);
            if (tid < 128) { stat[tid] = rstd8(w.rssB + (size_t)(m0 + tid) * 8, 1.f / 1024.f); stat[128 + tid] = rstd8(w.essq + (size_t)(m0 + tid) * 8, 1.f / 1024.f); }
            acc_to_lds(acc, T, tid);
        }
        const float2 pg = *(const float2*)(in.ple_post_norm_g + L * 1024 + n0 + 2 * lane);
#pragma unroll 16
        for (int rr = 0; rr < 32; ++rr) {
            const int row = wid * 32 + rr; const float rs = stat[row], re = stat[128 + row]; const size_t tok = m0 + row;
            const float2 x = *(const float2*)(T + row * TLD + 2 * lane);
            const size_t off = tok * 1024 + n0 + 2 * lane;
            const unsigned er = *(const unsigned*)(w.erb + off);
            float2 hv = *(const float2*)(P.h + off);
            hv.x += sigmoid_(x.x * rs) * (bflo(er) * re * pg.x);
            hv.y += sigmoid_(x.y * rs) * (bfhi(er) * re * pg.y);
            if (!dry) *(float2*)(P.h + off) = hv;
            *(unsigned*)(w.hb + off) = pack2(hv.x, hv.y);
            float sq = grp_sum32(hv.x * hv.x + hv.y * hv.y); sq = swap32_sum(sq);
            if (lane == 0) w.rssA[tok * 8 + nt] = sq;
        }
        __syncthreads();
    }
}

}
namespace fx {
#define XB_TMO      128
#define XB_XCNT(j)  (256  + 64 * (j))
#define XB_XSUB(j)  (1280 + 64 * (j))
#define XB_XGEN(j)  (2304 + 64 * (j))
#define XB_TOP      3328
#define XB_TOPGEN   3392
#define XCD_BAR_WORDS 3456
#define XB_SPIN_CAP (1u << 18)
#define LAS __attribute__((address_space(3)))
__device__ __forceinline__ unsigned xb_ld(unsigned* p)              { return __hip_atomic_load(p, __ATOMIC_RELAXED, __HIP_MEMORY_SCOPE_AGENT); }
__device__ __forceinline__ unsigned xb_add(unsigned* p, unsigned v) { return __hip_atomic_fetch_add(p, v, __ATOMIC_RELAXED, __HIP_MEMORY_SCOPE_AGENT); }
__device__ __forceinline__ unsigned xb_xcc_id() { return (unsigned)__builtin_amdgcn_s_getreg((3 << 11) | 20) & 0xFu; }
#define XB_SPIN(cond, bar) do { unsigned _sp = 0; while (cond) { __builtin_amdgcn_s_sleep(1); \
    if ((++_sp & 255u) == 0u) { if (xb_ld(&(bar)[XB_TMO])) break; if (_sp > XB_SPIN_CAP) { atomicAdd(&(bar)[XB_TMO], 1u); break; } } } } while (0)
struct XcdBarrier { unsigned* bar; unsigned x; volatile LAS unsigned* st; };
__device__ __forceinline__ XcdBarrier xcd_barrier_post(unsigned* bar, volatile LAS unsigned* st) {
    XcdBarrier b; b.bar = bar; b.x = xb_xcc_id(); b.st = st;
    if (threadIdx.x == 0) (void)xb_add(&bar[XB_XCNT(b.x)], 1u);
    return b;
}
__device__ __forceinline__ void xcd_barrier_complete(unsigned* bar, unsigned x, unsigned& nloc, unsigned& nx) {
    const unsigned G = gridDim.x * gridDim.y * gridDim.z;
    unsigned sum, cnt, mine, sp = 0u;
    for (;;) {
        sum = 0u; cnt = 0u; mine = 0u;
#pragma unroll
        for (unsigned j = 0; j < 16; ++j) { const unsigned c = xb_ld(&bar[XB_XCNT(j)]); sum += c; cnt += (c > 0u) ? 1u : 0u; mine = (j == x) ? c : mine; }
        if (sum == G) break;
        __builtin_amdgcn_s_sleep(1);
        if ((++sp & 255u) == 0u) { if (xb_ld(&bar[XB_TMO])) break; if (sp > XB_SPIN_CAP) { atomicAdd(&bar[XB_TMO], 1u); break; } }
    }
    nloc = mine > 0u ? mine : 1u; nx = cnt > 0u ? cnt : 1u;
}
__device__ __forceinline__ void xcd_barrier(const XcdBarrier& b) {
    asm volatile("s_waitcnt vmcnt(0)" ::: "memory");
    __syncthreads();
    if (threadIdx.x == 0) {
        unsigned* bar = b.bar;
        __builtin_amdgcn_s_waitcnt(0);
        unsigned nloc = b.st[0], nx = b.st[1];
        if (nloc == 0u) { xcd_barrier_complete(bar, b.x, nloc, nx); b.st[0] = nloc; b.st[1] = nx; }
        const unsigned old = xb_add(&bar[XB_XSUB(b.x)], 1u);
        const unsigned gen = old / nloc;
        if (old + 1u == (gen + 1u) * nloc) {
            __builtin_amdgcn_fence(__ATOMIC_RELEASE, "agent");
            asm volatile("s_waitcnt vmcnt(0)" ::: "memory");
            const unsigned og = xb_add(&bar[XB_TOP], 1u);
            const unsigned tg = og / nx;
            if (og + 1u == (tg + 1u) * nx) xb_add(&bar[XB_TOPGEN], 1u);
            else XB_SPIN(xb_ld(&bar[XB_TOPGEN]) == tg, bar);
            __builtin_amdgcn_fence(__ATOMIC_ACQUIRE, "agent");
            xb_add(&bar[XB_XGEN(b.x)], 1u);
            asm volatile("s_waitcnt vmcnt(0)" ::: "memory");
        } else {
            XB_SPIN(xb_ld(&bar[XB_XGEN(b.x)]) == gen, bar);
            __builtin_amdgcn_fence(__ATOMIC_ACQUIRE, "agent");
            asm volatile("s_waitcnt vmcnt(0)" ::: "memory");
        }
    }
    __syncthreads();
}

constexpr int LDS_BYTES = LDS_GEMM_BYTES + 16;
constexpr int N_PHASES = 19;
constexpr int PPL = 9;
__global__ void __launch_bounds__(256, 2) k_run(Params P, int ph_lo, int ph_hi) {
    extern __shared__ __attribute__((aligned(16))) char lds[];
    volatile LAS unsigned* st = (volatile LAS unsigned*)(lds + LDS_GEMM_BYTES);
    if (threadIdx.x == 0) { st[0] = 0u; st[1] = 0u; }
    __syncthreads();
    XcdBarrier xb = xcd_barrier_post(P.w.bar, st);
    for (int ph = ph_lo; ph < ph_hi; ++ph) {
        if (ph > ph_lo) xcd_barrier(xb);
#ifdef REP_PHASE
        if (REP_PHASE == 0 && ph == 0) { phase_prep(P, lds); xcd_barrier(xb); }
        if (ph > 0 && ((ph - 1) % PPL) == REP_PHASE - 1) {
            const int L = (ph - 1) / PPL;
            switch (REP_PHASE - 1) {
                case 0: phase_zgemm(P, L, lds, true); break;
                case 1: phase_mix(P, L, lds); break;
                case 2: phase_attn(P, L, lds); break;
                case 3: phase_oproj(P, L, lds, true); break;
                case 4: phase_router(P, L, lds, true); break;
                case 5: phase_moe_up(P, L, lds); break;
                case 6: phase_moe_down(P, L, lds); break;
                case 7: break;
                case 8: phase_ple(P, L, lds, true); break;
            }
            xcd_barrier(xb);
        }
#endif
        if (ph == 0) phase_prep(P, lds);
        else {
            const int L = (ph - 1) / PPL, s = (ph - 1) % PPL;
            switch (s) {
                case 0: phase_zgemm(P, L, lds); break;
                case 1: phase_mix(P, L, lds); break;
                case 2: phase_attn(P, L, lds); break;
                case 3: phase_oproj(P, L, lds); break;
                case 4: phase_router(P, L, lds); break;
                case 5: phase_moe_up(P, L, lds); break;
                case 6: phase_moe_down(P, L, lds); break;
                case 7: phase_combine(P, L, lds); break;
                case 8: phase_ple(P, L, lds); break;
            }
        }
    }
}
}
#ifndef MK_N_LAUNCHES
#define MK_N_LAUNCHES 1
#endif
extern "C" void kernel_launch(void* const* d_in, const int* in_sizes, int n_in, void* d_out, int out_size, void* d_ws, size_t ws_size,
                              hipStream_t stream) {
    nv::Inputs in{};
    in.x = (const float*)d_in[0]; in.p = (const float*)d_in[1]; in.positions = (const int*)d_in[2];
    const float** f = &in.mix_norm_g;
    for (int i = 0; i < 32; ++i) f[i] = (const float*)d_in[3 + i];
    size_t used = 0;
    fx::WS w = fx::make_ws((char*)d_ws, used);
    static int grid = 0;
    if (grid == 0) {
        if (n_in != 35 || out_size != fx::NT * 1024 || used > ws_size) { fprintf(stderr, "kernel_launch: unexpected shapes / workspace (need %zu, have %zu)\n", used, ws_size); grid = -1; return; }
        if (hipFuncSetAttribute((const void*)fx::k_run, hipFuncAttributeMaxDynamicSharedMemorySize, fx::LDS_BYTES) != hipSuccess) { fprintf(stderr, "hipFuncSetAttribute failed\n"); grid = -1; return; }
        int dev = 0, cus = 0, per_cu = 0;
        hipGetDevice(&dev); hipDeviceGetAttribute(&cus, hipDeviceAttributeMultiprocessorCount, dev);
        hipOccupancyMaxActiveBlocksPerMultiprocessor(&per_cu, (const void*)fx::k_run, 256, fx::LDS_BYTES);
        if (per_cu > 2) per_cu = 2;
        if (per_cu < 1) { fprintf(stderr, "occupancy query says %d blocks/CU\n", per_cu); grid = -1; return; }
        grid = cus * per_cu;
    }
    if (grid < 0) return;
    fx::Params P{}; P.in = in; P.h = (float*)d_out; P.w = w;
    hipMemsetAsync(w.cnt, 0, 128 * 4, stream);
    hipMemsetAsync(w.bar, 0, XCD_BAR_WORDS * 4, stream);
    if (MK_N_LAUNCHES == 1) hipLaunchKernelGGL(fx::k_run, dim3(grid), dim3(256), fx::LDS_BYTES, stream, P, 0, fx::N_PHASES);
    else for (int ph = 0; ph < fx::N_PHASES; ++ph) hipLaunchKernelGGL(fx::k_run, dim3(grid), dim3(256), fx::LDS_BYTES, stream, P, ph, ph + 1);
}
```

```cpp
#include <hip/hip_runtime.h>
#include <hip/hip_bf16.h>
#include <stdint.h>
#include <cstdio>
namespace nv {
struct Inputs {
    const float *x, *p; const int* positions;
    const float *mix_norm_g, *w_in, *sgu_ln_g, *sgu_ln_b, *sgu_w, *sgu_b, *conv_w, *conv_b, *conv_ln_g, *conv_ln_b, *conv_pw_w, *conv_pw_b,
        *q_a_norm_g, *w_uq, *kv_a_norm_g, *w_ukv, *q_norm_g, *k_norm_g, *branch_norm_g, *w_o, *ffn_norm_g, *router_group_w, *router_group_b,
        *router_expert_w, *router_expert_b, *moe_w_gate, *moe_w_up, *moe_w_down, *ple_norm_g, *ple_gate_w, *ple_proj_w, *ple_post_norm_g;
};
}
namespace fx {

typedef unsigned short bf16_t;
typedef short bf16x8 __attribute__((ext_vector_type(8)));
typedef float f32x16 __attribute__((ext_vector_type(16)));
typedef float f32x4 __attribute__((ext_vector_type(4)));

constexpr int NT = 16384, SEQ = 2048, DM = 1024, NB = 8;
constexpr int ZN = 1536;
constexpr float EPS = 1e-6f;

typedef __bf16 bf16v2_t __attribute__((ext_vector_type(2)));
typedef float f32v2_t __attribute__((ext_vector_type(2)));
__device__ __forceinline__ unsigned pack2(float lo, float hi) {
    f32v2_t v; v.x = lo; v.y = hi;
    bf16v2_t b = __builtin_convertvector(v, bf16v2_t);
    return __builtin_bit_cast(unsigned, b);
}
__device__ __forceinline__ unsigned f2bf(float f) { return pack2(f, 0.f) & 0xffffu; }
__device__ __forceinline__ float bf2f(unsigned short b) { return __uint_as_float(((unsigned)b) << 16); }
__device__ __forceinline__ float bflo(unsigned u) { return __uint_as_float(u << 16); }
__device__ __forceinline__ float bfhi(unsigned u) { return __uint_as_float(u & 0xffff0000u); }
__device__ __forceinline__ float sigmoid_(float x) { return __builtin_amdgcn_rcpf(1.f + __builtin_amdgcn_exp2f(-1.4426950408889634f * x)); }
__device__ __forceinline__ float rsq_(float x) { return __builtin_amdgcn_rsqf(x); }
__device__ __forceinline__ float gelu_tanh_(float x) {
    float u = 0.7978845608028654f * (x + 0.044715f * x * x * x);
    return x * sigmoid_(2.f * u);
}
__device__ __forceinline__ int opaque_tid() { int t = threadIdx.x; asm volatile("" : "+v"(t)); return t; }
template <int CTRL> __device__ __forceinline__ float dpp_mov(float v) {
    return __builtin_bit_cast(float, __builtin_amdgcn_update_dpp(0, __builtin_bit_cast(int, v), CTRL, 0xf, 0xf, false));
}
__device__ __forceinline__ void swap16(float& a, float& b) { asm volatile("s_nop 1\n\tv_permlane16_swap_b32 %0, %1" : "+v"(a), "+v"(b)); }
__device__ __forceinline__ void swap32(float& a, float& b) { asm volatile("s_nop 1\n\tv_permlane32_swap_b32 %0, %1" : "+v"(a), "+v"(b)); }
__device__ __forceinline__ float swap16_sum(float v) { float a = v, b = v; swap16(a, b); return a + b; }
__device__ __forceinline__ float swap32_sum(float v) { float a = v, b = v; swap32(a, b); return a + b; }
__device__ __forceinline__ float swap32_max(float v) { float a = v, b = v; swap32(a, b); return fmaxf(a, b); }
__device__ __forceinline__ float grp_sum16(float v) { v += dpp_mov<0xB1>(v); v += dpp_mov<0x4E>(v); v += dpp_mov<0x124>(v); v += dpp_mov<0x128>(v); return v; }
__device__ __forceinline__ float grp_sum32(float v) { return swap16_sum(grp_sum16(v)); }
__device__ __forceinline__ float wave_sum64(float v) { return swap32_sum(grp_sum32(v)); }
__device__ __forceinline__ float grp_sum4(float v) { v += dpp_mov<0xB1>(v); v += dpp_mov<0x4E>(v); return v; }
__device__ __forceinline__ float grp_sum8(float v) { v = grp_sum4(v); v += dpp_mov<0x141>(v); return v; }
__device__ __forceinline__ float quad_x2(float v) { return dpp_mov<0x4E>(v); }
__device__ __forceinline__ float xor8(float v) { return dpp_mov<0x128>(v); }
__device__ __forceinline__ float xor32(float v) { return swap32_sum(v); }

struct WS {
    bf16_t *W1t, *Wuqt, *Wukvt, *Wpwt, *Wot, *Wrt, *Wgut, *Wdt, *Wgt, *Wpt, *Wsm;
    bf16_t *hb;
    bf16_t *hb1;
    bf16_t *ub;
    bf16_t *vT;
    bf16_t *ygb;
    bf16_t *cqb;
    bf16_t *ckvb;
    bf16_t *kpeb;
    bf16_t *Qb;
    bf16_t *Knb;
    bf16_t *VTb;
    bf16_t *yb;
    float  *ssq;
    float  *rssA;
    float  *rssB;
    float  *cqss;
    float  *cs;
    bf16_t *erb;
    float  *essq;
    bf16_t *hbuf;
    bf16_t *contrib;
    int    *cnt;
    int    *elist;
    float  *ewt;
    unsigned *bar;
};
constexpr size_t W1_SZ = (size_t)ZN * 1024, WUQ_SZ = 768 * 256, WUKV_SZ = 1024 * 128, WPW_SZ = 256 * 256, WO_SZ = 1024 * 1024, WR_SZ = 128 * 1024,
                 WGU_SZ = (size_t)32 * 512 * 1024, WD_SZ = (size_t)32 * 1024 * 256, WG_SZ = 1024 * 1024, WP_SZ = 1024 * 256, WSM_SZ = 4 * 128 * 128;

struct Params {
    nv::Inputs in;
    float* h;
    WS w;
    float* zf;
    float* yf;
};

static WS make_ws(char* base, size_t& used) {
    WS w{}; size_t o = 0;
    auto take = [&](size_t bytes) { char* p = base + o; o += (bytes + 255) & ~(size_t)255; return p; };
    w.W1t = (bf16_t*)take(2 * W1_SZ * 2);   w.Wuqt = (bf16_t*)take(2 * WUQ_SZ * 2); w.Wukvt = (bf16_t*)take(2 * WUKV_SZ * 2);
    w.Wpwt = (bf16_t*)take(2 * WPW_SZ * 2); w.Wot = (bf16_t*)take(2 * WO_SZ * 2);   w.Wrt = (bf16_t*)take(2 * WR_SZ * 2);
    w.Wgut = (bf16_t*)take(2 * WGU_SZ * 2); w.Wdt = (bf16_t*)take(2 * WD_SZ * 2);   w.Wgt = (bf16_t*)take(2 * WG_SZ * 2);
    w.Wpt = (bf16_t*)take(2 * WP_SZ * 2);   w.Wsm = (bf16_t*)take(2 * WSM_SZ * 2);
    w.hb = (bf16_t*)take((size_t)NT * 1024 * 2); w.hb1 = (bf16_t*)take((size_t)NT * 1024 * 2);
    w.ssq = (float*)take((size_t)NT * 16 * 4); w.cs = (float*)take((size_t)NT * 32 * 4);
    w.rssA = (float*)take((size_t)NT * 8 * 4); w.rssB = (float*)take((size_t)NT * 8 * 4); w.cqss = (float*)take((size_t)NT * 4 * 4);
    w.essq = (float*)take((size_t)NT * 8 * 4);
    w.cnt = (int*)take(2 * 64 * 4);
    w.elist = (int*)take((size_t)32 * NT * 4); w.ewt = (float*)take((size_t)32 * NT * 4);
    w.bar = (unsigned*)take(4096 * 4);
    const size_t region = o;
    w.ub = (bf16_t*)take((size_t)NT * 256 * 2); w.vT = (bf16_t*)take((size_t)NT * 256 * 2); w.ygb = (bf16_t*)take((size_t)NT * 256 * 2);
    w.cqb = (bf16_t*)take((size_t)NT * 256 * 2); w.ckvb = (bf16_t*)take((size_t)NT * 128 * 2); w.kpeb = (bf16_t*)take((size_t)NT * 32 * 2);
    w.Qb = (bf16_t*)take((size_t)NT * 768 * 2); w.Knb = (bf16_t*)take((size_t)NT * 512 * 2); w.VTb = (bf16_t*)take((size_t)NT * 512 * 2);
    w.yb = (bf16_t*)take((size_t)NT * 1024 * 2);
    const size_t region_end = o;
    o = region;
    w.contrib = (bf16_t*)take((size_t)NT * 2 * 1024 * 2);
    w.hbuf = (bf16_t*)take((size_t)(2 * NT + 128) * 256 * 2);
    w.erb = (bf16_t*)take((size_t)NT * 1024 * 2);
    if (o > region_end) { fprintf(stderr, "make_ws: overlay exceeds mixer region\n"); }
    o = region_end;
    used = o;
    return w;
}

__device__ const double ROPE_INV[16] = {1.0, 0.5623413251903491, 0.31622776601683794, 0.1778279410038923, 0.1, 0.05623413251903491, 0.03162277660168379, 0.01778279410038923, 0.01, 0.005623413251903491, 0.0031622776601683794, 0.0017782794100389228, 0.001, 0.0005623413251903491, 0.00031622776601683794, 0.00017782794100389227};
__device__ __forceinline__ void rope_cs(int pos, int j, float& c, float& s) {
    const double ang = (double)pos * ROPE_INV[j];
    const double n = rint(ang * 0.15915494309189535);
    double r = fma(-n, 6.283185307179586, ang); r = fma(-n, 2.4492935982947064e-16, r);
    const double r2 = r * r;
    double sc = 1.0, ss = 1.0;
    double tc = 1.0, ts = 1.0;
#pragma unroll
    for (int k = 1; k <= 14; ++k) {
        tc *= -r2 / (double)((2 * k - 1) * (2 * k)); sc += tc;
        ts *= -r2 / (double)((2 * k) * (2 * k + 1)); ss += ts;
    }
    c = (float)sc; s = (float)(ss * r);
}

enum { MAP_ID = 0, MAP_W1 = 1, MAP_UQ = 2, MAP_UKV = 3, MAP_GATE = 4, MAP_UP = 5 };
template <int MAP> __device__ __forceinline__ int dstrow(int c) {
    if (MAP == MAP_W1) {
        if (c < 512) return c;
        if (c < 768) return 512 + 2 * (c - 512);
        if (c < 1024) return 513 + 2 * (c - 768);
        return c;
    } else if (MAP == MAP_UQ) {
        const int h = c / 96, d = c - h * 96; return d < 64 ? h * 64 + d : 512 + h * 32 + d - 64;
    } else if (MAP == MAP_UKV) {
        const int h = c >> 7, d = c & 127; return d < 64 ? h * 64 + d : 512 + h * 64 + d - 64;
    } else if (MAP == MAP_GATE) return 2 * c;
    else if (MAP == MAP_UP) return 2 * c + 1;
    return c;
}
template <int MAP>
__device__ __forceinline__ void prep_tile(const float* src, int ld, int Nsrc, const float* scale, bf16_t* dst, int K, int k0, int c0, float* tile  , const int tid) {
    __syncthreads();
#pragma unroll
    for (int i = 0; i < 4; ++i) {
        const int kk = (tid >> 4) + 16 * i, c4 = (tid & 15) * 4;
        float4 v = make_float4(0.f, 0.f, 0.f, 0.f);
        if (c0 + c4 < Nsrc) v = *(const float4*)(src + (size_t)(k0 + kk) * ld + c0 + c4);
        const float sc = scale ? scale[k0 + kk] : 1.f;
        float* t = tile + kk * 65 + c4;
        t[0] = v.x * sc; t[1] = v.y * sc; t[2] = v.z * sc; t[3] = v.w * sc;
    }
    __syncthreads();
#pragma unroll
    for (int i = 0; i < 2; ++i) {
        const int idx = tid + 256 * i, c = idx >> 3, kc = idx & 7;
        if (c0 + c < Nsrc) {
            const float* t = tile + (kc * 8) * 65 + c;
            uint4 pk;
            pk.x = pack2(t[0], t[65]); pk.y = pack2(t[130], t[195]); pk.z = pack2(t[260], t[325]); pk.w = pack2(t[390], t[455]);
            *(uint4*)(dst + (size_t)dstrow<MAP>(c0 + c) * K + k0 + kc * 8) = pk;
        }
    }
}
template <int MAP>
__device__ void prep_job(const float* src, int ld, int Nsrc, size_t src_stride, const float* scale, bf16_t* dst, size_t dst_stride, int K, int nbatch, float* tile, int& rot, const int tid) {
    const int tn = (Nsrc + 63) / 64, tk = K / 64, per = tn * tk, total = per * nbatch, G = gridDim.x;
    for (int t = ((int)blockIdx.x - rot + G) % G; t < total; t += G) {
        const int e = t / per, tt = t % per;
        prep_tile<MAP>(src + (size_t)e * src_stride, ld, Nsrc, scale, dst + (size_t)e * dst_stride, K, (tt / tn) * 64, (tt % tn) * 64, tile, tid);
    }
    rot = (rot + total) % G;
}

__device__ void phase_prep(const Params& P, char* lds) {
    float* tile = (float*)lds;
    const nv::Inputs& in = P.in; const WS& w = P.w;
    const int G = gridDim.x, bid = blockIdx.x, tid = opaque_tid();
    int rot = 0;
    for (int L = 0; L < 2; ++L) {
        prep_job<MAP_GATE>(in.moe_w_gate + (size_t)L * 32 * 1024 * 256, 256, 256, (size_t)1024 * 256, in.ffn_norm_g + L * 1024, w.Wgut + L * WGU_SZ, (size_t)512 * 1024, 1024, 32, tile, rot, tid);
        prep_job<MAP_UP>(in.moe_w_up + (size_t)L * 32 * 1024 * 256, 256, 256, (size_t)1024 * 256, in.ffn_norm_g + L * 1024, w.Wgut + L * WGU_SZ, (size_t)512 * 1024, 1024, 32, tile, rot, tid);
        prep_job<MAP_ID>(in.moe_w_down + (size_t)L * 32 * 256 * 1024, 1024, 1024, (size_t)256 * 1024, nullptr, w.Wdt + L * WD_SZ, (size_t)1024 * 256, 256, 32, tile, rot, tid);
        prep_job<MAP_W1>(in.w_in + (size_t)L * 1024 * 1440, 1440, 1440, 0, in.mix_norm_g + L * 1024, w.W1t + L * W1_SZ, 0, 1024, 1, tile, rot, tid);
        prep_job<MAP_UQ>(in.w_uq + (size_t)L * 256 * 768, 768, 768, 0, in.q_a_norm_g + L * 256, w.Wuqt + L * WUQ_SZ, 0, 256, 1, tile, rot, tid);
        prep_job<MAP_UKV>(in.w_ukv + (size_t)L * 128 * 1024, 1024, 1024, 0, in.kv_a_norm_g + L * 128, w.Wukvt + L * WUKV_SZ, 0, 128, 1, tile, rot, tid);
        prep_job<MAP_ID>(in.conv_pw_w + (size_t)L * 256 * 256, 256, 256, 0, nullptr, w.Wpwt + L * WPW_SZ, 0, 256, 1, tile, rot, tid);
        prep_job<MAP_ID>(in.w_o + (size_t)L * 1024 * 1024, 1024, 1024, 0, in.branch_norm_g + L * 1024, w.Wot + L * WO_SZ, 0, 1024, 1, tile, rot, tid);
        prep_job<MAP_ID>(in.ple_gate_w + (size_t)L * 1024 * 1024, 1024, 1024, 0, in.ple_norm_g + L * 1024, w.Wgt + L * WG_SZ, 0, 1024, 1, tile, rot, tid);
        prep_job<MAP_ID>(in.ple_proj_w + (size_t)L * 256 * 1024, 1024, 1024, 0, nullptr, w.Wpt + L * WP_SZ, 0, 256, 1, tile, rot, tid);
        for (int i = bid * 256 + tid; i < 96 * 1024 / 8; i += G * 256) *(uint4*)(w.W1t + L * W1_SZ + (size_t)1440 * 1024 + (size_t)i * 8) = make_uint4(0u, 0u, 0u, 0u);
        for (int i = bid * 256 + tid; i < 128 * 1024; i += G * 256) {
            int n = i >> 10, k = i & 1023; float v = 0.f;
            if (n < 4) v = in.router_group_w[(size_t)L * 1024 * 4 + k * 4 + n];
            else if (n < 36) v = in.router_expert_w[(size_t)L * 1024 * 32 + k * 32 + (n - 4)];
            v *= in.ffn_norm_g[L * 1024 + k];
            w.Wrt[L * WR_SZ + i] = (bf16_t)f2bf(v);
        }
        for (int i = bid * 256 + tid; i < 4 * 128 * 128; i += G * 256) {
            int jj = i & 127, ii = (i >> 7) & 127;
            float v = (jj <= ii) ? in.sgu_w[(size_t)L * WSM_SZ + i] : 0.f;
            w.Wsm[L * WSM_SZ + i] = (bf16_t)f2bf(v);
        }
    }
    for (int i = bid * 256 + tid; i < NT * 16; i += G * 256) {
        int t = i >> 4, j = i & 15;
        float c, sn; rope_cs(in.positions[t], j, c, sn);
        w.cs[t * 32 + j] = c; w.cs[t * 32 + 16 + j] = sn;
    }
    for (int row = bid * 4 + (tid >> 6); row < NT; row += G * 4) {
        const int lane = tid & 63;
        float ss = 0.f;
#pragma unroll
        for (int j = 0; j < 4; ++j) {
            const size_t i = (size_t)row * 256 + j * 64 + lane;
            const float4 v = ((const float4*)in.x)[i];
            ((float4*)P.h)[i] = v;
            uint2 pk; pk.x = pack2(v.x, v.y); pk.y = pack2(v.z, v.w);
            ((uint2*)w.hb)[i] = pk;
            ss += v.x * v.x + v.y * v.y + v.z * v.z + v.w * v.w;
        }
        ss = wave_sum64(ss);
        if (lane < 8) w.rssA[(size_t)row * 8 + lane] = lane == 0 ? ss : 0.f;
    }
}

__device__ __forceinline__ int lds_off(int row, int chunk) { return row * 128 + ((chunk ^ ((row >> 1) & 7)) << 4); }

template <typename AT> struct ARaw;
template <> struct ARaw<bf16_t> { uint4 v[4]; };
template <> struct ARaw<float> { float4 v[4][2]; };

__device__ __forceinline__ void a_load(ARaw<bf16_t>& r, const bf16_t* const (&rowp)[4], int koff) {
#pragma unroll
    for (int i = 0; i < 4; ++i) r.v[i] = *(const uint4*)(rowp[i] + koff);
}
__device__ __forceinline__ void a_load(ARaw<float>& r, const float* const (&rowp)[4], int koff) {
#pragma unroll
    for (int i = 0; i < 4; ++i) { r.v[i][0] = *(const float4*)(rowp[i] + koff); r.v[i][1] = *(const float4*)(rowp[i] + koff + 4); }
}
template <bool SUMSQ> __device__ __forceinline__ uint4 a_cvt(const uint4& v, float& ss) {
    if (SUMSQ) {
        float a;
        a = bflo(v.x); ss = fmaf(a, a, ss); a = bfhi(v.x); ss = fmaf(a, a, ss);
        a = bflo(v.y); ss = fmaf(a, a, ss); a = bfhi(v.y); ss = fmaf(a, a, ss);
        a = bflo(v.z); ss = fmaf(a, a, ss); a = bfhi(v.z); ss = fmaf(a, a, ss);
        a = bflo(v.w); ss = fmaf(a, a, ss); a = bfhi(v.w); ss = fmaf(a, a, ss);
    }
    return v;
}
template <bool SUMSQ> __device__ __forceinline__ void a_store(const ARaw<bf16_t>& r, char* ldsA, int tid, float (&ss)[4]) {
#pragma unroll
    for (int i = 0; i < 4; ++i) { uint4 v = a_cvt<SUMSQ>(r.v[i], ss[i]); *(uint4*)(ldsA + lds_off((tid >> 3) + 32 * i, tid & 7)) = v; }
}
template <bool SUMSQ> __device__ __forceinline__ void a_store(const ARaw<float>& r, char* ldsA, int tid, float (&ss)[4]) {
#pragma unroll
    for (int i = 0; i < 4; ++i) {
        const float4 a = r.v[i][0], b = r.v[i][1];
        if (SUMSQ) ss[i] += a.x * a.x + a.y * a.y + a.z * a.z + a.w * a.w + b.x * b.x + b.y * b.y + b.z * b.z + b.w * b.w;
        uint4 v; v.x = pack2(a.x, a.y); v.y = pack2(a.z, a.w); v.z = pack2(b.x, b.y); v.w = pack2(b.z, b.w);
        *(uint4*)(ldsA + lds_off((tid >> 3) + 32 * i, tid & 7)) = v;
    }
}

struct bf16x3_t {};
template <> struct ARaw<bf16x3_t> { uint4 a[4], b[4], c[4]; };
struct Rows3 { const bf16_t* p[2][4]; };
__device__ __forceinline__ void a_load(ARaw<bf16x3_t>& r, const Rows3& rows, int koff) {
#pragma unroll
    for (int i = 0; i < 4; ++i) { r.a[i] = *(const uint4*)(rows.p[0][i] + koff); r.b[i] = *(const uint4*)(rows.p[1][i] + koff); r.c[i] = *(const uint4*)(rows.p[1][i] + koff + 1024); }
}
__device__ __forceinline__ unsigned add3pk(unsigned a, unsigned b, unsigned c, float& ss) {
    const float lo = bflo(a) + bflo(b) + bflo(c), hi = bfhi(a) + bfhi(b) + bfhi(c);
    ss = fmaf(lo, lo, ss); ss = fmaf(hi, hi, ss);
    return pack2(lo, hi);
}
template <bool SUMSQ> __device__ __forceinline__ void a_store(const ARaw<bf16x3_t>& r, char* ldsA, int tid, float (&ss)[4]) {
#pragma unroll
    for (int i = 0; i < 4; ++i) {
        uint4 v;
        v.x = add3pk(r.a[i].x, r.b[i].x, r.c[i].x, ss[i]); v.y = add3pk(r.a[i].y, r.b[i].y, r.c[i].y, ss[i]);
        v.z = add3pk(r.a[i].z, r.b[i].z, r.c[i].z, ss[i]); v.w = add3pk(r.a[i].w, r.b[i].w, r.c[i].w, ss[i]);
        *(uint4*)(ldsA + lds_off((tid >> 3) + 32 * i, tid & 7)) = v;
    }
}

template <typename AT, bool SUMSQ, int SUNROLL = 4, typename AROWS>
__device__ __forceinline__ void gemm_mainloop(f32x16 (&acc)[2][2], const AROWS& arow, const bf16_t* const (&wrow)[4], int nkt, char* lds, float (&ss)[4], const int tid) {
    const int lane = tid & 63, wid = tid >> 6, wr = wid >> 1, wc = wid & 1;
    ARaw<AT> ra; ARaw<bf16_t> rb; float dummy[4] = {0.f, 0.f, 0.f, 0.f};
    a_load(ra, arow, 0); a_load(rb, wrow, 0);
    a_store<SUMSQ>(ra, lds, tid, ss); a_store<false>(rb, lds + 16384, tid, dummy);
    __syncthreads();
    const int fr = lane & 31, fh = lane >> 5;
#pragma unroll 1
    for (int kt = 0; kt < nkt; ++kt) {
        char* cur = lds + (kt & 1) * 32768;
        char* nxt = lds + ((kt + 1) & 1) * 32768;
        const bool more = (kt + 1 < nkt);
        if (more) { a_load(ra, arow, (kt + 1) * 64); a_load(rb, wrow, (kt + 1) * 64); }
#pragma unroll SUNROLL
        for (int s = 0; s < 4; ++s) {
            bf16x8 xa[2], wb[2];
#pragma unroll
            for (int i = 0; i < 2; ++i) xa[i] = *(const bf16x8*)(cur + lds_off(wr * 64 + i * 32 + fr, 2 * s + fh));
#pragma unroll
            for (int j = 0; j < 2; ++j) wb[j] = *(const bf16x8*)(cur + 16384 + lds_off(wc * 64 + j * 32 + fr, 2 * s + fh));
#pragma unroll
            for (int i = 0; i < 2; ++i)
#pragma unroll
                for (int j = 0; j < 2; ++j) acc[i][j] = __builtin_amdgcn_mfma_f32_32x32x16_bf16(wb[j], xa[i], acc[i][j], 0, 0, 0);
        }
        if (more) { a_store<SUMSQ>(ra, nxt, tid, ss); a_store<false>(rb, nxt + 16384, tid, dummy); }
        __syncthreads();
    }
}
constexpr int GST = 16384;
__device__ __forceinline__ int gl_chunk(int tid) { return (tid & 3) ^ ((tid >> 4) & 3); }
__device__ __forceinline__ int gl_off(int row, int chunk) { return row * 64 + ((chunk ^ ((row >> 2) & 3)) << 4); }
typedef __attribute__((address_space(3))) unsigned lds_u32_t;
__device__ __forceinline__ void glds16(const bf16_t* g, char* l) {
    __builtin_amdgcn_global_load_lds((const unsigned*)g, (lds_u32_t*)l, 16, 0, 0);
}
#define RAW_BARRIER() do { asm volatile("s_waitcnt lgkmcnt(0)" ::: "memory"); __builtin_amdgcn_s_barrier(); } while (0)
__device__ __forceinline__ void gemm_mainloop_g(f32x16 (&acc)[2][2], const bf16_t* const (&arow)[2], const bf16_t* const (&wrow)[2], const int nkt, char* lds, const int tid) {
    const int lane = tid & 63, wid = tid >> 6, wr = wid >> 1, wc = wid & 1, fr = lane & 31, fh = lane >> 5;
    const int wbase = __builtin_amdgcn_readfirstlane(wid) * 1024;
    asm volatile("s_waitcnt vmcnt(0)" ::: "memory");
#pragma unroll 1
    for (int p = 0; p < 3; ++p) if (p < nkt) {
        char* st = lds + p * GST + wbase;
        glds16(arow[0] + p * 32, st); glds16(arow[1] + p * 32, st + 4096);
        glds16(wrow[0] + p * 32, st + 8192); glds16(wrow[1] + p * 32, st + 8192 + 4096);
    }
    const int ra0 = gl_off(wr * 64 + fr, fh), ra1 = gl_off(wr * 64 + 32 + fr, fh);
    const int rb0 = 8192 + gl_off(wc * 64 + fr, fh), rb1 = 8192 + gl_off(wc * 64 + 32 + fr, fh);
#pragma unroll 1
    for (int kt = 0; kt < nkt; ++kt) {
        if (kt + 2 < nkt) asm volatile("s_waitcnt vmcnt(8)" ::: "memory");
        else if (kt + 1 < nkt) asm volatile("s_waitcnt vmcnt(4)" ::: "memory");
        else asm volatile("s_waitcnt vmcnt(0)" ::: "memory");
        RAW_BARRIER();
        if (kt + 3 < nkt) {
            char* st = lds + ((kt + 3) & 3) * GST + wbase;
            const int ko = (kt + 3) * 32;
            glds16(arow[0] + ko, st); glds16(arow[1] + ko, st + 4096);
            glds16(wrow[0] + ko, st + 8192); glds16(wrow[1] + ko, st + 8192 + 4096);
        }
        const char* cur = lds + (kt & 3) * GST;
        bf16x8 xa[2][2], wb[2][2];
#pragma unroll
        for (int s2 = 0; s2 < 2; ++s2) {
            xa[s2][0] = *(const bf16x8*)(cur + (ra0 ^ (s2 << 5))); xa[s2][1] = *(const bf16x8*)(cur + (ra1 ^ (s2 << 5)));
            wb[s2][0] = *(const bf16x8*)(cur + (rb0 ^ (s2 << 5))); wb[s2][1] = *(const bf16x8*)(cur + (rb1 ^ (s2 << 5)));
        }
        __builtin_amdgcn_sched_barrier(0);
#pragma unroll
        for (int s2 = 0; s2 < 2; ++s2) {
            acc[0][0] = __builtin_amdgcn_mfma_f32_32x32x16_bf16(wb[s2][0], xa[s2][0], acc[0][0], 0, 0, 0);
            acc[0][1] = __builtin_amdgcn_mfma_f32_32x32x16_bf16(wb[s2][1], xa[s2][0], acc[0][1], 0, 0, 0);
            acc[1][0] = __builtin_amdgcn_mfma_f32_32x32x16_bf16(wb[s2][0], xa[s2][1], acc[1][0], 0, 0, 0);
            acc[1][1] = __builtin_amdgcn_mfma_f32_32x32x16_bf16(wb[s2][1], xa[s2][1], acc[1][1], 0, 0, 0);
        }
    }
    RAW_BARRIER();
}
__device__ __forceinline__ int g64_chunk(int tid) { return (tid & 7) ^ ((tid >> 4) & 7); }
__device__ __forceinline__ void gemm_mainloop_g64(f32x16 (&acc)[2][2], const bf16_t* const (&arow)[4], const bf16_t* const (&wrow)[4], const int nkt, char* lds, const int tid) {
    const int lane = tid & 63, wid = tid >> 6, wr = wid >> 1, wc = wid & 1, fr = lane & 31, fh = lane >> 5;
    const int wbase = __builtin_amdgcn_readfirstlane(wid) * 1024;
    asm volatile("s_waitcnt vmcnt(0)" ::: "memory");
    {
        char* st = lds + wbase;
#pragma unroll
        for (int i = 0; i < 4; ++i) { glds16(arow[i], st + i * 4096); glds16(wrow[i], st + 16384 + i * 4096); }
    }
#pragma unroll 1
    for (int kt = 0; kt < nkt; ++kt) {
        asm volatile("s_waitcnt vmcnt(0)" ::: "memory");
        RAW_BARRIER();
        if (kt + 1 < nkt) {
            char* st = lds + ((kt + 1) & 1) * 32768 + wbase;
            const int ko = (kt + 1) * 64;
#pragma unroll
            for (int i = 0; i < 4; ++i) { glds16(arow[i] + ko, st + i * 4096); glds16(wrow[i] + ko, st + 16384 + i * 4096); }
        }
        const char* cur = lds + (kt & 1) * 32768;
#pragma unroll
        for (int s = 0; s < 4; ++s) {
            bf16x8 xa[2], wb[2];
#pragma unroll
            for (int i = 0; i < 2; ++i) xa[i] = *(const bf16x8*)(cur + lds_off(wr * 64 + i * 32 + fr, 2 * s + fh));
#pragma unroll
            for (int j = 0; j < 2; ++j) wb[j] = *(const bf16x8*)(cur + 16384 + lds_off(wc * 64 + j * 32 + fr, 2 * s + fh));
#pragma unroll
            for (int i = 0; i < 2; ++i)
#pragma unroll
                for (int j = 0; j < 2; ++j) acc[i][j] = __builtin_amdgcn_mfma_f32_32x32x16_bf16(wb[j], xa[i], acc[i][j], 0, 0, 0);
        }
    }
    RAW_BARRIER();
}
__device__ __forceinline__ void acc_zero(f32x16 (&acc)[2][2]) {
#pragma unroll
    for (int i = 0; i < 2; ++i)
#pragma unroll
        for (int j = 0; j < 2; ++j)
#pragma unroll
            for (int r = 0; r < 16; ++r) acc[i][j][r] = 0.f;
}
__device__ __forceinline__ void publish_rowstat(float (&ss)[4], float* stat, float invK, bool as_rstd, const int tid) {
#pragma unroll
    for (int i = 0; i < 4; ++i) {
        float v = ss[i];
        v += __shfl_xor(v, 1); v += __shfl_xor(v, 2); v += __shfl_xor(v, 4);
        if ((tid & 7) == 0) stat[(tid >> 3) + 32 * i] = as_rstd ? rsqrtf(v * invK + EPS) : v;
    }
    __syncthreads();
}
__device__ __forceinline__ int nidx(int r, int fh) { return (r & 3) + 8 * (r >> 2) + 4 * fh; }
__device__ __forceinline__ uint4 pack8(const float4& a, const float4& b) { uint4 pk; pk.x = pack2(a.x, a.y); pk.y = pack2(a.z, a.w); pk.z = pack2(b.x, b.y); pk.w = pack2(b.z, b.w); return pk; }
__device__ __forceinline__ float sq8(const float4& a, const float4& b) { return (a.x * a.x + a.y * a.y) + (a.z * a.z + a.w * a.w) + (b.x * b.x + b.y * b.y) + (b.z * b.z + b.w * b.w); }
__device__ __forceinline__ float4 mul4(const float4& a, float s) { return make_float4(a.x * s, a.y * s, a.z * s, a.w * s); }
__device__ __forceinline__ void store4(bf16_t* p, float a, float b, float c, float d) {
    uint2 v; v.x = pack2(a, b); v.y = pack2(c, d); *(uint2*)p = v;
}

__device__ __forceinline__ bool xcd_item(int it, int MT, int NTl, int& mt, int& nt) {
    const int x = blockIdx.x & 7, lb = blockIdx.x >> 3, nlb = gridDim.x >> 3;
    const int li = it * nlb + lb, per = (MT >> 3) * NTl;
    if (li >= per) return false;
    mt = (li / NTl) * 8 + x; nt = li % NTl; return true;
}

constexpr int TLD = 132;
constexpr int STAT_OFF = 128 * TLD * 4;
constexpr int LDS_GEMM_BYTES = STAT_OFF + 2048;
__device__ __forceinline__ void acc_to_lds(const f32x16 (&acc)[2][2], float* T, const int tid) {
    const int lane = tid & 63, wid = tid >> 6, wr = wid >> 1, wc = wid & 1, fr = lane & 31, fh = lane >> 5;
#pragma unroll
    for (int i = 0; i < 2; ++i)
#pragma unroll
        for (int j = 0; j < 2; ++j)
#pragma unroll
            for (int g = 0; g < 4; ++g) {
                float4 v; v.x = acc[i][j][4 * g]; v.y = acc[i][j][4 * g + 1]; v.z = acc[i][j][4 * g + 2]; v.w = acc[i][j][4 * g + 3];
                *(float4*)(T + (wr * 64 + i * 32 + fr) * TLD + wc * 64 + j * 32 + 8 * g + 4 * fh) = v;
            }
    __syncthreads();
}
__device__ __forceinline__ float rstd8(const float* p, float invK) {
    const float4 a = *(const float4*)p, b = *(const float4*)(p + 4);
    return rsq_(((a.x + a.y) + (a.z + a.w) + (b.x + b.y) + (b.z + b.w)) * invK + EPS);
}

}
namespace fx {

__device__ void phase_zgemm(const Params& P, int L, char* lds, const bool same = false) {
    const WS& w = P.w; const nv::Inputs& in = P.in;
    const int tid0 = opaque_tid();
    float* T = (float*)lds; float* stat = (float*)(lds + STAT_OFF);
    const bf16_t* Wt = w.W1t + L * W1_SZ;
    int mt, nt;
    for (int it = 0; xcd_item(it, 128, 12, mt, nt); ++it) {
        int tid = tid0; asm volatile("" : "+v"(tid));
        const int lane = tid & 63, wid = tid >> 6;
        const int m0 = mt * 128, n0 = nt * 128;
        {
            const bf16_t* arow[4]; const bf16_t* wrow[4];
#pragma unroll
            for (int i = 0; i < 4; ++i) {
                arow[i] = w.hb + (size_t)(m0 + (tid >> 3) + 32 * i) * 1024 + g64_chunk(tid) * 8;
                wrow[i] = Wt + (size_t)(n0 + (tid >> 3) + 32 * i) * 1024 + g64_chunk(tid) * 8;
            }
            f32x16 acc[2][2]; acc_zero(acc);
            float my_rs = 0.f;
            if (tid < 128) my_rs = rstd8(w.rssA + (size_t)(m0 + tid) * 8, 1.f / 1024.f);
            gemm_mainloop_g64(acc, arow, wrow, 16, lds, tid);
            if (tid < 128) stat[tid] = my_rs;
            acc_to_lds(acc, T, tid);
        }
        const int sub = lane >> 4, l16 = lane & 15, c8 = l16 * 8;
        if (nt < 2) {
#pragma unroll 8
            for (int rr = 0; rr < 8; ++rr) {
                const int row = wid * 32 + rr * 4 + sub; const float rs = stat[row];
                float4 x0 = *(const float4*)(T + row * TLD + c8), x1 = *(const float4*)(T + row * TLD + c8 + 4);
                x0.x = gelu_tanh_(x0.x * rs); x0.y = gelu_tanh_(x0.y * rs); x0.z = gelu_tanh_(x0.z * rs); x0.w = gelu_tanh_(x0.w * rs);
                x1.x = gelu_tanh_(x1.x * rs); x1.y = gelu_tanh_(x1.y * rs); x1.z = gelu_tanh_(x1.z * rs); x1.w = gelu_tanh_(x1.w * rs);
                *(uint4*)(w.ub + (size_t)(m0 + row) * 256 + nt * 128 + c8) = pack8(x0, x1);
            }
        } else if (nt < 4) {
            const int hd = (nt - 2) * 2 + (l16 >> 3), d0 = (l16 & 7) * 8;
            const float4 g0 = *(const float4*)(in.sgu_ln_g + L * 256 + hd * 64 + d0), g1 = *(const float4*)(in.sgu_ln_g + L * 256 + hd * 64 + d0 + 4);
            const float4 b0 = *(const float4*)(in.sgu_ln_b + L * 256 + hd * 64 + d0), b1 = *(const float4*)(in.sgu_ln_b + L * 256 + hd * 64 + d0 + 4);
#pragma unroll 4
            for (int rr = 0; rr < 8; ++rr) {
                const int row = wid * 32 + rr * 4 + sub; const float rs = stat[row];
                float4 x0 = *(const float4*)(T + row * TLD + c8), x1 = *(const float4*)(T + row * TLD + c8 + 4);
                x0.x = gelu_tanh_(x0.x * rs); x0.y = gelu_tanh_(x0.y * rs); x0.z = gelu_tanh_(x0.z * rs); x0.w = gelu_tanh_(x0.w * rs);
                x1.x = gelu_tanh_(x1.x * rs); x1.y = gelu_tanh_(x1.y * rs); x1.z = gelu_tanh_(x1.z * rs); x1.w = gelu_tanh_(x1.w * rs);
                const float mean = grp_sum8((x0.x + x0.y) + (x0.z + x0.w) + (x1.x + x1.y) + (x1.z + x1.w)) * (1.f / 64.f);
                x0.x -= mean; x0.y -= mean; x0.z -= mean; x0.w -= mean; x1.x -= mean; x1.y -= mean; x1.z -= mean; x1.w -= mean;
                const float rv = rsq_(grp_sum8(sq8(x0, x1)) * (1.f / 64.f) + EPS);
                x0.x = x0.x * rv * g0.x + b0.x; x0.y = x0.y * rv * g0.y + b0.y; x0.z = x0.z * rv * g0.z + b0.z; x0.w = x0.w * rv * g0.w + b0.w;
                x1.x = x1.x * rv * g1.x + b1.x; x1.y = x1.y * rv * g1.y + b1.y; x1.z = x1.z * rv * g1.z + b1.z; x1.w = x1.w * rv * g1.w + b1.w;
                *(float4*)(T + row * TLD + c8) = x0; *(float4*)(T + row * TLD + c8 + 4) = x1;
            }
            __syncthreads();
            {
                const int c = tid & 127, th = tid >> 7, hd2 = (nt - 2) * 2 + (c >> 6), d = c & 63;
                bf16_t* dst = w.vT + ((size_t)(mt * 4 + hd2) * 64 + d) * 128 + th * 64;
#pragma unroll 2
                for (int k8 = 0; k8 < 8; ++k8) {
                    float v[8];
#pragma unroll
                    for (int k = 0; k < 8; ++k) v[k] = T[(th * 64 + k8 * 8 + k) * TLD + c];
                    uint4 pk; pk.x = pack2(v[0], v[1]); pk.y = pack2(v[2], v[3]); pk.z = pack2(v[4], v[5]); pk.w = pack2(v[6], v[7]);
                    *(uint4*)(dst + k8 * 8) = pk;
                }
            }
        } else if (nt < 8) {
#pragma unroll 8
            for (int rr = 0; rr < 8; ++rr) {
                const int row = wid * 32 + rr * 4 + sub; const float rs = stat[row];
                const float4 x0 = *(const float4*)(T + row * TLD + c8), x1 = *(const float4*)(T + row * TLD + c8 + 4);
                store4(w.ygb + (size_t)(m0 + row) * 256 + (nt - 4) * 64 + l16 * 4, x0.x * rs * sigmoid_(x0.y * rs), x0.z * rs * sigmoid_(x0.w * rs),
                       x1.x * rs * sigmoid_(x1.y * rs), x1.z * rs * sigmoid_(x1.w * rs));
            }
        } else if (nt < 11) {
            bf16_t* base; int ld, cb;
            if (nt < 10) { base = w.cqb; ld = 256; cb = (nt - 8) * 128; } else { base = w.ckvb; ld = 128; cb = 0; }
#pragma unroll 8
            for (int rr = 0; rr < 8; ++rr) {
                const int row = wid * 32 + rr * 4 + sub; const float rs = stat[row];
                const float4 x0 = mul4(*(const float4*)(T + row * TLD + c8), rs), x1 = mul4(*(const float4*)(T + row * TLD + c8 + 4), rs);
                *(uint4*)(base + (size_t)(m0 + row) * ld + cb + c8) = pack8(x0, x1);
                const float sq = grp_sum16(sq8(x0, x1));
                if (l16 == 0) w.cqss[(size_t)(m0 + row) * 4 + (nt - 8)] = sq;
            }
        } else {
            const int lq = l16 & 3, dd = lq * 8, jj = (lq & 1) * 8;
            const float4 kg0 = *(const float4*)(in.k_norm_g + L * 96 + 64 + dd), kg1 = *(const float4*)(in.k_norm_g + L * 96 + 64 + dd + 4);
#pragma unroll 8
            for (int rr = 0; rr < 8; ++rr) {
                const int row = wid * 32 + rr * 4 + sub; const float rs = stat[row]; const int tok = m0 + row;
                float4 x0 = mul4(*(const float4*)(T + row * TLD + dd), rs), x1 = mul4(*(const float4*)(T + row * TLD + dd + 4), rs);
                const float rn = rsq_(grp_sum4(sq8(x0, x1)) * (1.f / 32.f) + EPS);
                x0.x *= rn * kg0.x; x0.y *= rn * kg0.y; x0.z *= rn * kg0.z; x0.w *= rn * kg0.w;
                x1.x *= rn * kg1.x; x1.y *= rn * kg1.y; x1.z *= rn * kg1.z; x1.w *= rn * kg1.w;
                const float4 o0 = make_float4(quad_x2(x0.x), quad_x2(x0.y), quad_x2(x0.z), quad_x2(x0.w)), o1 = make_float4(quad_x2(x1.x), quad_x2(x1.y), quad_x2(x1.z), quad_x2(x1.w));
                const float* csr = w.cs + (size_t)tok * 32 + jj;
                const float4 c0 = *(const float4*)csr, c1 = *(const float4*)(csr + 4), s0 = *(const float4*)(csr + 16), s1 = *(const float4*)(csr + 20);
                const float sg = (lq & 2) ? 1.f : -1.f;
                float4 r0, r1;
                r0.x = x0.x * c0.x + sg * o0.x * s0.x; r0.y = x0.y * c0.y + sg * o0.y * s0.y; r0.z = x0.z * c0.z + sg * o0.z * s0.z; r0.w = x0.w * c0.w + sg * o0.w * s0.w;
                r1.x = x1.x * c1.x + sg * o1.x * s1.x; r1.y = x1.y * c1.y + sg * o1.y * s1.y; r1.z = x1.z * c1.z + sg * o1.z * s1.z; r1.w = x1.w * c1.w + sg * o1.w * s1.w;
                if (l16 < 4) *(uint4*)(w.kpeb + (size_t)tok * 32 + dd) = pack8(r0, r1);
            }
        }
        __syncthreads();
    }
}

__global__ void k_shim_z(Params P, int t0) {
    const WS& w = P.w;
    size_t idx = (size_t)blockIdx.x * blockDim.x + threadIdx.x;
    if (idx >= (size_t)2048 * 1440) return;
    int t = t0 + (int)(idx / 1440), c = (int)(idx % 1440);
    float v = 0.f;
    if (c < 256) v = bf2f(w.ub[(size_t)t * 256 + c]);
    else if (c < 512) { int cc = c - 256; v = bf2f(w.vT[((size_t)((t >> 7) * 4 + (cc >> 6)) * 64 + (cc & 63)) * 128 + (t & 127)]); }
    else if (c < 768) v = bf2f(w.ygb[(size_t)t * 256 + c - 512]);
    else if (c < 1024) v = 0.f;
    else if (c < 1280) v = bf2f(w.cqb[(size_t)t * 256 + c - 1024]);
    else if (c < 1408) v = bf2f(w.ckvb[(size_t)t * 128 + c - 1280]);
    else v = bf2f(w.kpeb[(size_t)t * 32 + c - 1408]);
    P.zf[idx] = v;
}
__global__ void k_shim_hb(Params P) {
    size_t i = (size_t)blockIdx.x * blockDim.x + threadIdx.x;
    if (i >= (size_t)NT * 1024 / 4) return;
    float4 v = ((const float4*)P.h)[i];
    uint2 pk; pk.x = pack2(v.x, v.y); pk.y = pack2(v.z, v.w);
    ((uint2*)P.w.hb)[i] = pk;
}

}
namespace fx {

constexpr float QSCALE = 0.10206207261596575f * 1.4426950408889634f;

__device__ void qkv_item(const Params& P, int L, const bool isq, const int mt, const int nt, char* lds, const int tid_in) {
    int tid = tid_in; asm volatile("" : "+v"(tid));
    const WS& w = P.w; const nv::Inputs& in = P.in;
    const int lane = tid & 63, wid = tid >> 6;
    float* T = (float*)lds; float* stat = (float*)(lds + STAT_OFF);
    const int m0 = mt * 128, n0 = nt * 128;
    const int K = isq ? 256 : 128;
    {
        const bf16_t* A = isq ? w.cqb : w.ckvb;
        const bf16_t* Wt = isq ? (w.Wuqt + L * WUQ_SZ) : (w.Wukvt + L * WUKV_SZ);
        const bf16_t* arow[2]; const bf16_t* wrow[2];
#pragma unroll
        for (int i = 0; i < 2; ++i) {
            arow[i] = A + (size_t)(m0 + (tid >> 2) + 64 * i) * K + gl_chunk(tid) * 8;
            wrow[i] = Wt + (size_t)(n0 + (tid >> 2) + 64 * i) * K + gl_chunk(tid) * 8;
        }
        f32x16 acc[2][2]; acc_zero(acc);
        float my_rs = 0.f;
        if (tid < 128) {
            const float4 c = *(const float4*)(w.cqss + (size_t)(m0 + tid) * 4);
            my_rs = isq ? rsq_((c.x + c.y) * (1.f / 256.f) + EPS) : rsq_(c.z * (1.f / 128.f) + EPS);
        }
        gemm_mainloop_g(acc, arow, wrow, K / 32, lds, tid);
        if (tid < 128) stat[tid] = my_rs;
        acc_to_lds(acc, T, tid);
    }
    const int b = m0 >> 11, s0 = m0 & 2047;
    const int sub = lane >> 4, l16 = lane & 15, c8 = l16 * 8;
    if (isq && nt < 4) {
        const int hd = nt * 2 + (l16 >> 3), d = (l16 & 7) * 8;
        const float4 g0 = mul4(*(const float4*)(in.q_norm_g + L * 96 + d), QSCALE), g1 = mul4(*(const float4*)(in.q_norm_g + L * 96 + d + 4), QSCALE);
        bf16_t* dst = w.Qb + ((size_t)(b * 8 + hd) * 2048 + s0) * 96 + d;
#pragma unroll 8
        for (int rr = 0; rr < 8; ++rr) {
            const int row = wid * 32 + rr * 4 + sub; const float rs = stat[row];
            float4 x0 = mul4(*(const float4*)(T + row * TLD + c8), rs), x1 = mul4(*(const float4*)(T + row * TLD + c8 + 4), rs);
            const float rn = rsq_(grp_sum8(sq8(x0, x1)) * (1.f / 64.f) + EPS);
            x0.x *= rn * g0.x; x0.y *= rn * g0.y; x0.z *= rn * g0.z; x0.w *= rn * g0.w; x1.x *= rn * g1.x; x1.y *= rn * g1.y; x1.z *= rn * g1.z; x1.w *= rn * g1.w;
            *(uint4*)(dst + (size_t)row * 96) = pack8(x0, x1);
        }
    } else if (isq) {
        const int hd = (nt - 4) * 4 + (l16 >> 2), lq = l16 & 3, dd = lq * 8, jj = (lq & 1) * 8;
        const float4 g0 = *(const float4*)(in.q_norm_g + L * 96 + 64 + dd), g1 = *(const float4*)(in.q_norm_g + L * 96 + 64 + dd + 4);
        bf16_t* dst = w.Qb + ((size_t)(b * 8 + hd) * 2048 + s0) * 96 + 64 + dd;
        const float sg = (lq & 2) ? QSCALE : -QSCALE;
#pragma unroll 8
        for (int rr = 0; rr < 8; ++rr) {
            const int row = wid * 32 + rr * 4 + sub; const float rs = stat[row]; const int tok = m0 + row;
            float4 x0 = mul4(*(const float4*)(T + row * TLD + c8), rs), x1 = mul4(*(const float4*)(T + row * TLD + c8 + 4), rs);
            const float rn = rsq_(grp_sum4(sq8(x0, x1)) * (1.f / 32.f) + EPS);
            x0.x *= rn * g0.x; x0.y *= rn * g0.y; x0.z *= rn * g0.z; x0.w *= rn * g0.w; x1.x *= rn * g1.x; x1.y *= rn * g1.y; x1.z *= rn * g1.z; x1.w *= rn * g1.w;
            const float4 o0 = make_float4(quad_x2(x0.x), quad_x2(x0.y), quad_x2(x0.z), quad_x2(x0.w)), o1 = make_float4(quad_x2(x1.x), quad_x2(x1.y), quad_x2(x1.z), quad_x2(x1.w));
            const float* csr = w.cs + (size_t)tok * 32 + jj;
            const float4 c0 = mul4(*(const float4*)csr, QSCALE), c1 = mul4(*(const float4*)(csr + 4), QSCALE), s0v = *(const float4*)(csr + 16), s1v = *(const float4*)(csr + 20);
            float4 r0, r1;
            r0.x = x0.x * c0.x + sg * o0.x * s0v.x; r0.y = x0.y * c0.y + sg * o0.y * s0v.y; r0.z = x0.z * c0.z + sg * o0.z * s0v.z; r0.w = x0.w * c0.w + sg * o0.w * s0v.w;
            r1.x = x1.x * c1.x + sg * o1.x * s1v.x; r1.y = x1.y * c1.y + sg * o1.y * s1v.y; r1.z = x1.z * c1.z + sg * o1.z * s1v.z; r1.w = x1.w * c1.w + sg * o1.w * s1v.w;
            *(uint4*)(dst + (size_t)row * 96) = pack8(r0, r1);
        }
    } else if (nt < 4) {
        const int hd = nt * 2 + (l16 >> 3), d = (l16 & 7) * 8;
        const float4 g0 = *(const float4*)(in.k_norm_g + L * 96 + d), g1 = *(const float4*)(in.k_norm_g + L * 96 + d + 4);
        bf16_t* dst = w.Knb + ((size_t)(b * 8 + hd) * 2048 + s0) * 64 + d;
#pragma unroll 8
        for (int rr = 0; rr < 8; ++rr) {
            const int row = wid * 32 + rr * 4 + sub; const float rs = stat[row];
            float4 x0 = mul4(*(const float4*)(T + row * TLD + c8), rs), x1 = mul4(*(const float4*)(T + row * TLD + c8 + 4), rs);
            const float rn = rsq_(grp_sum8(sq8(x0, x1)) * (1.f / 64.f) + EPS);
            x0.x *= rn * g0.x; x0.y *= rn * g0.y; x0.z *= rn * g0.z; x0.w *= rn * g0.w; x1.x *= rn * g1.x; x1.y *= rn * g1.y; x1.z *= rn * g1.z; x1.w *= rn * g1.w;
            *(uint4*)(dst + (size_t)row * 64) = pack8(x0, x1);
        }
    } else {
        const int c = tid & 127, th = tid >> 7, hd = (nt - 4) * 2 + (c >> 6), d = c & 63;
        bf16_t* dst = w.VTb + ((size_t)(b * 8 + hd) * 64 + d) * 2048 + s0 + th * 64;
#pragma unroll 2
        for (int k8 = 0; k8 < 8; ++k8) {
            float v[8];
#pragma unroll
            for (int k = 0; k < 8; ++k) { const int row = th * 64 + k8 * 8 + k; v[k] = T[row * TLD + c] * stat[row]; }
            uint4 pk; pk.x = pack2(v[0], v[1]); pk.y = pack2(v[2], v[3]); pk.z = pack2(v[4], v[5]); pk.w = pack2(v[6], v[7]);
            *(uint4*)(dst + k8 * 8) = pk;
        }
    }
    __syncthreads();
}

__device__ void sgu_item(const Params& P, int L, int mt, char* lds, const int tid_in) {
    int tid = tid_in; asm volatile("" : "+v"(tid));
    const WS& w = P.w; const nv::Inputs& in = P.in;
    const int lane = tid & 63, hd = tid >> 6, fr = lane & 31, fh = lane >> 5;
    float* red = (float*)lds;
    const bf16_t* vt = w.vT + (size_t)(mt * 4 + hd) * 64 * 128;
    const bf16_t* ws = w.Wsm + L * WSM_SZ + (size_t)hd * 128 * 128;
    const float* bs = in.sgu_b + L * 512 + hd * 128;
    const int m0 = mt * 128;
#pragma unroll 1
    for (int it = 0; it < 4; ++it) {
        f32x16 a0, a1;
#pragma unroll
        for (int r = 0; r < 16; ++r) { a0[r] = 0.f; a1[r] = 0.f; }
        const int nks = 2 * (it + 1);
        const bf16_t* bp = ws + (size_t)(it * 32 + fr) * 128 + 8 * fh;
        const bf16_t* ap0 = vt + (size_t)fr * 128 + 8 * fh;
        const bf16_t* ap1 = vt + (size_t)(32 + fr) * 128 + 8 * fh;
#pragma unroll 2
        for (int s = 0; s < nks; ++s) {
            const bf16x8 bfrag = *(const bf16x8*)(bp + 16 * s);
            const bf16x8 af0 = *(const bf16x8*)(ap0 + 16 * s), af1 = *(const bf16x8*)(ap1 + 16 * s);
            a0 = __builtin_amdgcn_mfma_f32_32x32x16_bf16(af0, bfrag, a0, 0, 0, 0);
            a1 = __builtin_amdgcn_mfma_f32_32x32x16_bf16(af1, bfrag, a1, 0, 0, 0);
        }
        const int i = it * 32 + fr, tok = m0 + i;
        const float bias = bs[i];
        float ssq = 0.f;
#pragma unroll
        for (int dt = 0; dt < 2; ++dt)
#pragma unroll
            for (int g = 0; g < 4; ++g) {
                const int d = dt * 32 + 8 * g + 4 * fh;
                const uint2 uu = *(const uint2*)(w.ub + (size_t)tok * 256 + hd * 64 + d);
                float o[4];
#pragma unroll
                for (int q = 0; q < 4; ++q) {
                    const float sv = (dt == 0 ? a0[4 * g + q] : a1[4 * g + q]) + bias;
                    const float uv = (q == 0) ? bflo(uu.x) : (q == 1) ? bfhi(uu.x) : (q == 2) ? bflo(uu.y) : bfhi(uu.y);
                    o[q] = uv * sv; ssq += o[q] * o[q];
                }
                store4(w.yb + (size_t)tok * 1024 + hd * 64 + d, o[0], o[1], o[2], o[3]);
            }
        ssq = xor32(ssq);
        if (fh == 0) red[hd * 128 + i] = ssq;
    }
    __syncthreads();
    if (tid < 128) w.ssq[(size_t)(m0 + tid) * 16 + 0] = red[tid] + red[128 + tid] + red[256 + tid] + red[384 + tid];
    __syncthreads();
}

constexpr int CLD = 260, CONV_YL = 32 * CLD * 4, CONV_ST = CONV_YL + 32 * 512, CONV_RED = CONV_ST + 32 * 4 * 8;
__device__ __forceinline__ int yl_off(int row, int chunk) { return row * 512 + ((chunk ^ (row & 15)) << 4); }
__device__ void conv_item(const Params& P, int L, int ct, char* lds, const int tid_in) {
    int tid = tid_in; asm volatile("" : "+v"(tid));
    const WS& w = P.w; const nv::Inputs& in = P.in;
    const int lane = tid & 63, wid = tid >> 6, fr = lane & 31, fh = lane >> 5;
    float* C = (float*)lds; char* yl = lds + CONV_YL; float2* stats = (float2*)(lds + CONV_ST); float* red = (float*)(lds + CONV_RED);
    const int t0 = ct * 32, s0 = t0 & 2047;
    {
        const int c = tid;
        float x[62];
#pragma unroll
        for (int r = 0; r < 62; ++r) x[r] = (s0 + r - 30 >= 0) ? bf2f(w.ygb[(size_t)(t0 + r - 30) * 256 + c]) : 0.f;
        float wk[31];
#pragma unroll
        for (int k = 0; k < 31; ++k) wk[k] = in.conv_w[(size_t)L * 31 * 256 + k * 256 + c];
        const float cb = in.conv_b[L * 256 + c];
#pragma unroll
        for (int t = 0; t < 32; ++t) {
            float a = cb;
#pragma unroll
            for (int k = 0; k < 31; ++k) a = fmaf(wk[k], x[t + k], a);
            C[t * CLD + c] = a;
        }
    }
    __syncthreads();
    if (tid < 128) {
        const int t = tid >> 2, g = tid & 3;
        const float4* cp = (const float4*)(C + t * CLD + g * 64);
        float4 v[16]; float s = 0.f;
#pragma unroll
        for (int i = 0; i < 16; ++i) { v[i] = cp[i]; s += (v[i].x + v[i].y) + (v[i].z + v[i].w); }
        const float mean = s * (1.f / 64.f); float q = 0.f;
#pragma unroll
        for (int i = 0; i < 16; ++i) { const float a = v[i].x - mean, b2 = v[i].y - mean, c2 = v[i].z - mean, d2 = v[i].w - mean; q += (a * a + b2 * b2) + (c2 * c2 + d2 * d2); }
        stats[t * 4 + g] = make_float2(mean, rsq_(q * (1.f / 64.f) + EPS));
    }
    __syncthreads();
    {
        const int c = tid, g = c >> 6;
        const float lg = in.conv_ln_g[L * 256 + c], lb = in.conv_ln_b[L * 256 + c];
#pragma unroll 8
        for (int t = 0; t < 32; ++t) {
            const float2 st = stats[t * 4 + g];
            const float v = (C[t * CLD + c] - st.x) * st.y * lg + lb;
            *(bf16_t*)(yl + yl_off(t, c >> 3) + (c & 7) * 2) = (bf16_t)f2bf(v * sigmoid_(v));
        }
    }
    __syncthreads();
    f32x16 acc0, acc1;
#pragma unroll
    for (int r = 0; r < 16; ++r) { acc0[r] = 0.f; acc1[r] = 0.f; }
    const bf16_t* wp = w.Wpwt + L * WPW_SZ + (size_t)(wid * 64 + fr) * 256 + 8 * fh;
#pragma unroll 4
    for (int s = 0; s < 16; ++s) {
        const bf16x8 w0 = *(const bf16x8*)(wp + 16 * s), w1 = *(const bf16x8*)(wp + 32 * 256 + 16 * s);
        const bf16x8 x0 = *(const bf16x8*)(yl + yl_off(fr, 2 * s + fh));
        acc0 = __builtin_amdgcn_mfma_f32_32x32x16_bf16(w0, x0, acc0, 0, 0, 0);
        acc1 = __builtin_amdgcn_mfma_f32_32x32x16_bf16(w1, x0, acc1, 0, 0, 0);
    }
    const float* pb = in.conv_pw_b + L * 256;
    {
        const int tok = t0 + fr;
        float ssq = 0.f;
#pragma unroll
        for (int jn = 0; jn < 2; ++jn)
#pragma unroll
            for (int g = 0; g < 4; ++g) {
                const int n = wid * 64 + jn * 32 + 8 * g + 4 * fh;
                const float4 b4 = *(const float4*)(pb + n);
                const float o0 = (jn ? acc1[4 * g] : acc0[4 * g]) + b4.x, o1 = (jn ? acc1[4 * g + 1] : acc0[4 * g + 1]) + b4.y;
                const float o2 = (jn ? acc1[4 * g + 2] : acc0[4 * g + 2]) + b4.z, o3 = (jn ? acc1[4 * g + 3] : acc0[4 * g + 3]) + b4.w;
                ssq += o0 * o0 + o1 * o1 + o2 * o2 + o3 * o3;
                store4(w.yb + (size_t)tok * 1024 + 256 + n, o0, o1, o2, o3);
            }
        ssq = xor32(ssq);
        if (fh == 0) red[wid * 32 + fr] = ssq;
    }
    __syncthreads();
    if (tid < 32) w.ssq[(size_t)(t0 + tid) * 16 + 1] = red[tid] + red[32 + tid] + red[64 + tid] + red[96 + tid];
    __syncthreads();
}

__device__ void phase_mix(const Params& P, int L, char* lds) {
    const int tid = opaque_tid();
    int mt, nt;
    for (int it = 0; xcd_item(it, 128, 6, mt, nt); ++it) qkv_item(P, L, true, mt, nt, lds, tid);
    for (int it = 0; xcd_item(it, 128, 8, mt, nt); ++it) qkv_item(P, L, false, mt, nt, lds, tid);
    for (int ct = blockIdx.x; ct < 512; ct += gridDim.x) conv_item(P, L, ct, lds, tid);
    {
        const int x = blockIdx.x & 7, lb = blockIdx.x >> 3, nlb = gridDim.x >> 3;
        const int lo = nlb >= 48 ? 32 : 0;
        for (int j = lb - lo; j >= 0 && j < 16; j += nlb) sgu_item(P, L, j * 8 + x, lds, tid);
    }
}

__global__ void k_shim_qkv(Params P, int t0, float* q, float* kv) {
    const WS& w = P.w;
    size_t idx = (size_t)blockIdx.x * blockDim.x + threadIdx.x;
    if (idx >= (size_t)2048 * 1792) return;
    const int tl = (int)(idx / 1792), c = (int)(idx % 1792), t = t0 + tl, b = t >> 11, s = t & 2047;
    if (c < 768) { const int h = c / 96, d = c % 96; q[(size_t)tl * 768 + c] = bf2f(w.Qb[((size_t)(b * 8 + h) * 2048 + s) * 96 + d]) * (1.f / QSCALE); }
    else {
        const int cc = c - 768, h = cc >> 7, d = cc & 127;
        kv[(size_t)tl * 1024 + cc] = (d < 64) ? bf2f(w.Knb[((size_t)(b * 8 + h) * 2048 + s) * 64 + d]) : bf2f(w.VTb[((size_t)(b * 8 + h) * 64 + (d - 64)) * 2048 + s]);
    }
}
__global__ void k_shim_y(Params P, int t0, int c0, int c1) {
    const int wdt = c1 - c0;
    size_t idx = (size_t)blockIdx.x * blockDim.x + threadIdx.x;
    if (idx >= (size_t)2048 * wdt) return;
    const int tl = (int)(idx / wdt), c = c0 + (int)(idx % wdt);
    P.yf[(size_t)tl * 1024 + c] = bf2f(P.w.yb[(size_t)(t0 + tl) * 1024 + c]);
}

}
namespace fx {

constexpr int KROW = 208, VROW = 136, ATT_STAGE = 64 * KROW + 64 * VROW;

struct KVRegs { uint4 k0, k1, k2, v0, v1; };
__device__ __forceinline__ uint4 k_ld(const bf16_t* Kn, const bf16_t* Kp, int k0, int c) {
    const int key = c / 12, ch = c % 12;
    const bf16_t* src = (ch < 8) ? (Kn + (size_t)(k0 + key) * 64 + ch * 8) : (Kp + (size_t)(k0 + key) * 32 + (ch - 8) * 8);
    return *(const uint4*)src;
}
__device__ __forceinline__ void kv_load(KVRegs& r, const bf16_t* Kn, const bf16_t* Kp, const bf16_t* Vt, int k0, const int tid) {
    r.k0 = k_ld(Kn, Kp, k0, tid); r.k1 = k_ld(Kn, Kp, k0, tid + 256); r.k2 = k_ld(Kn, Kp, k0, tid + 512);
    r.v0 = *(const uint4*)(Vt + (size_t)(tid >> 3) * 2048 + k0 + (tid & 7) * 8);
    r.v1 = *(const uint4*)(Vt + (size_t)(32 + (tid >> 3)) * 2048 + k0 + (tid & 7) * 8);
}
__device__ __forceinline__ void k_st(char* st, int c, const uint4& v) { const int key = c / 12, ch = c % 12; *(uint4*)(st + key * KROW + ch * 16) = v; }
__device__ __forceinline__ void v_st(char* st, int d, int ch, const uint4& v) {
    char* p = st + 64 * KROW + d * VROW + ch * 16;
    *(uint2*)p = make_uint2(v.x, v.y); *(uint2*)(p + 8) = make_uint2(v.z, v.w);
}
__device__ __forceinline__ void kv_store(const KVRegs& r, char* st, const int tid) {
    k_st(st, tid, r.k0); k_st(st, tid + 256, r.k1); k_st(st, tid + 512, r.k2);
    v_st(st, tid >> 3, tid & 7, r.v0); v_st(st, 32 + (tid >> 3), tid & 7, r.v1);
}

__device__ void attn_unit(const Params& P, int b, int h, int qt, char* lds, const int tid) {
    const WS& w = P.w;
    const int lane = tid & 63, wid = tid >> 6, fr = lane & 31, fh = lane >> 5;
    const bf16_t* Kn = w.Knb + (size_t)(b * 8 + h) * 2048 * 64;
    const bf16_t* Kp = w.kpeb + (size_t)b * 2048 * 32;
    const bf16_t* Vt = w.VTb + (size_t)(b * 8 + h) * 64 * 2048;
    const int q0 = qt * 128, qw0 = q0 + wid * 32, qpos = qw0 + fr;
    bf16x8 qf[6];
    {
        const bf16_t* qp = w.Qb + ((size_t)(b * 8 + h) * 2048 + qpos) * 96 + 8 * fh;
#pragma unroll
        for (int ks = 0; ks < 6; ++ks) qf[ks] = *(const bf16x8*)(qp + 16 * ks);
    }
    f32x16 o0, o1;
#pragma unroll
    for (int r = 0; r < 16; ++r) { o0[r] = 0.f; o1[r] = 0.f; }
    float m = -1e30f, l = 0.f;
    const int nkt = 2 * (qt + 1);
    KVRegs kr;
    kv_load(kr, Kn, Kp, Vt, 0, tid);
    kv_store(kr, lds, tid);
    __syncthreads();
#pragma unroll 1
    for (int kt = 0; kt < nkt; ++kt) {
        char* cur = lds + (kt & 1) * ATT_STAGE;
        char* nxt = lds + ((kt + 1) & 1) * ATT_STAGE;
        const bool more = kt + 1 < nkt;
        if (more) kv_load(kr, Kn, Kp, Vt, (kt + 1) * 64, tid);
        const int k0 = kt * 64;
        if (k0 <= qw0 + 31) {
            f32x16 s0, s1;
#pragma unroll
            for (int r = 0; r < 16; ++r) { s0[r] = 0.f; s1[r] = 0.f; }
            const char* kb = cur + fr * KROW + fh * 16;
#pragma unroll
            for (int ks = 0; ks < 6; ++ks) {
                const bf16x8 ka = *(const bf16x8*)(kb + ks * 32), kb2 = *(const bf16x8*)(kb + 32 * KROW + ks * 32);
                s0 = __builtin_amdgcn_mfma_f32_32x32x16_bf16(ka, qf[ks], s0, 0, 0, 0);
                s1 = __builtin_amdgcn_mfma_f32_32x32x16_bf16(kb2, qf[ks], s1, 0, 0, 0);
            }
            if (k0 + 63 > qw0) {
#pragma unroll
                for (int r = 0; r < 16; ++r) {
                    const int key = k0 + nidx(r, fh);
                    if (key > qpos) s0[r] = -1e30f;
                    if (key + 32 > qpos) s1[r] = -1e30f;
                }
            }
            float mx = s0[0];
#pragma unroll
            for (int r = 1; r < 16; ++r) mx = fmaxf(mx, s0[r]);
#pragma unroll
            for (int r = 0; r < 16; ++r) mx = fmaxf(mx, s1[r]);
            mx = swap32_max(mx);
            const float mn = fmaxf(m, mx);
            const float alpha = __builtin_amdgcn_exp2f(m - mn);
            m = mn;
            float ps = 0.f;
#pragma unroll
            for (int r = 0; r < 16; ++r) { s0[r] = __builtin_amdgcn_exp2f(s0[r] - mn); ps += s0[r]; }
#pragma unroll
            for (int r = 0; r < 16; ++r) { s1[r] = __builtin_amdgcn_exp2f(s1[r] - mn); ps += s1[r]; }
            ps = swap32_sum(ps);
            l = l * alpha + ps;
#pragma unroll
            for (int r = 0; r < 16; ++r) { o0[r] *= alpha; o1[r] *= alpha; }
            const char* vb = cur + 64 * KROW + fr * VROW + fh * 8;
#pragma unroll
            for (int ks = 0; ks < 4; ++ks) {
                bf16x8 pf;
                {
                    const int rb = 8 * (ks & 1);
                    unsigned u0, u1, u2, u3;
                    if (ks < 2) { u0 = pack2(s0[rb], s0[rb + 1]); u1 = pack2(s0[rb + 2], s0[rb + 3]); u2 = pack2(s0[rb + 4], s0[rb + 5]); u3 = pack2(s0[rb + 6], s0[rb + 7]); }
                    else { u0 = pack2(s1[rb], s1[rb + 1]); u1 = pack2(s1[rb + 2], s1[rb + 3]); u2 = pack2(s1[rb + 4], s1[rb + 5]); u3 = pack2(s1[rb + 6], s1[rb + 7]); }
                    uint4 uu = make_uint4(u0, u1, u2, u3);
                    pf = __builtin_bit_cast(bf16x8, uu);
                }
                const uint2 va0 = *(const uint2*)(vb + ks * 32), va1 = *(const uint2*)(vb + ks * 32 + 16);
                const uint2 vb0 = *(const uint2*)(vb + 32 * VROW + ks * 32), vb1 = *(const uint2*)(vb + 32 * VROW + ks * 32 + 16);
                const bf16x8 vfa = __builtin_bit_cast(bf16x8, make_uint4(va0.x, va0.y, va1.x, va1.y));
                const bf16x8 vfb = __builtin_bit_cast(bf16x8, make_uint4(vb0.x, vb0.y, vb1.x, vb1.y));
                o0 = __builtin_amdgcn_mfma_f32_32x32x16_bf16(vfa, pf, o0, 0, 0, 0);
                o1 = __builtin_amdgcn_mfma_f32_32x32x16_bf16(vfb, pf, o1, 0, 0, 0);
            }
        }
        if (more) kv_store(kr, nxt, tid);
        __syncthreads();
    }
    const float inv = 1.f / l;
    const int tok = b * 2048 + qpos;
    float ssq = 0.f;
#pragma unroll
    for (int dt = 0; dt < 2; ++dt)
#pragma unroll
        for (int g = 0; g < 4; ++g) {
            float o[4];
#pragma unroll
            for (int q = 0; q < 4; ++q) { o[q] = (dt == 0 ? o0[4 * g + q] : o1[4 * g + q]) * inv; ssq += o[q] * o[q]; }
            store4(w.yb + (size_t)tok * 1024 + 512 + h * 64 + dt * 32 + 8 * g + 4 * fh, o[0], o[1], o[2], o[3]);
        }
    ssq = xor32(ssq);
    if (fh == 0) w.ssq[(size_t)tok * 16 + 8 + h] = ssq;
}

__device__ void phase_attn(const Params& P, int L, char* lds) {
    const int tid0 = opaque_tid();
    const int h = blockIdx.x & 7, nlb = gridDim.x >> 3;
    for (int li = blockIdx.x >> 3; li < 64; li += nlb) {
        int tid = tid0; asm volatile("" : "+v"(tid));
        const int p = li & 7, b = li >> 3;
        attn_unit(P, b, h, 15 - p, lds, tid);
        attn_unit(P, b, h, p, lds, tid);
    }
}

}
namespace fx {

__device__ __forceinline__ void acc_scale(f32x16 (&acc)[2][2], const float* f, const int tid) {
    const int lane = tid & 63, wr = tid >> 7, fr = lane & 31;
#pragma unroll
    for (int i = 0; i < 2; ++i) {
        const float v = f[wr * 64 + i * 32 + fr];
#pragma unroll
        for (int j = 0; j < 2; ++j)
#pragma unroll
            for (int r = 0; r < 16; ++r) acc[i][j][r] *= v;
    }
}
__device__ void phase_oproj(const Params& P, int L, char* lds, const bool dry = false) {
    const WS& w = P.w;
    const int tid0 = opaque_tid();
    float* T = (float*)lds; float* stat = (float*)(lds + STAT_OFF);
    const bf16_t* Wt = w.Wot + L * WO_SZ;
    int mt, nt;
    for (int it = 0; xcd_item(it, 128, 8, mt, nt); ++it) {
        int tid = tid0; asm volatile("" : "+v"(tid));
        const int lane = tid & 63, wid = tid >> 6;
        const int m0 = mt * 128, n0 = nt * 128;
        float rb_keep = 0.f;
        if (tid < 128) {
            const float* sq = w.ssq + (size_t)(m0 + tid) * 16;
            const float4 c0 = *(const float4*)(sq + 8), c1 = *(const float4*)(sq + 12);
            const float ra = rsq_(sq[0] * (1.f / 256.f) + EPS), rb = rsq_(sq[1] * (1.f / 256.f) + EPS);
            const float rc = rsq_((c0.x + c0.y + c0.z + c0.w + c1.x + c1.y + c1.z + c1.w) * (1.f / 512.f) + EPS);
            stat[tid] = rc / ra; stat[128 + tid] = ra / rb; rb_keep = rb;
        }
        {
            const bf16_t* arow[2]; const bf16_t* wrow[2];
#pragma unroll
            for (int i = 0; i < 2; ++i) {
                arow[i] = w.yb + (size_t)(m0 + (tid >> 2) + 64 * i) * 1024 + gl_chunk(tid) * 8 + 512;
                wrow[i] = Wt + (size_t)(n0 + (tid >> 2) + 64 * i) * 1024 + gl_chunk(tid) * 8 + 512;
            }
            f32x16 acc[2][2]; acc_zero(acc);
            gemm_mainloop_g(acc, arow, wrow, 16, lds, tid);
            acc_scale(acc, stat, tid);
#pragma unroll
            for (int i = 0; i < 2; ++i) { arow[i] -= 512; wrow[i] -= 512; }
            gemm_mainloop_g(acc, arow, wrow, 8, lds, tid);
            acc_scale(acc, stat + 128, tid);
#pragma unroll
            for (int i = 0; i < 2; ++i) { arow[i] += 256; wrow[i] += 256; }
            gemm_mainloop_g(acc, arow, wrow, 8, lds, tid);
            if (tid < 128) stat[tid] = rb_keep;
            acc_to_lds(acc, T, tid);
        }
        {
            const int sub = lane >> 4, c8 = (lane & 15) * 8;
#pragma unroll 8
            for (int rr = 0; rr < 8; ++rr) {
                const int row = wid * 32 + rr * 4 + sub; const float rb = stat[row];
                const float4 x0 = *(const float4*)(T + row * TLD + c8), x1 = *(const float4*)(T + row * TLD + c8 + 4);
                float4* hp = (float4*)(P.h + (size_t)(m0 + row) * 1024 + n0 + c8);
                float4 h0 = hp[0], h1 = hp[1];
                h0.x += x0.x * rb; h0.y += x0.y * rb; h0.z += x0.z * rb; h0.w += x0.w * rb;
                h1.x += x1.x * rb; h1.y += x1.y * rb; h1.z += x1.z * rb; h1.w += x1.w * rb;
                if (!dry) { hp[0] = h0; hp[1] = h1; }
                uint4 pk; pk.x = pack2(h0.x, h0.y); pk.y = pack2(h0.z, h0.w); pk.z = pack2(h1.x, h1.y); pk.w = pack2(h1.z, h1.w);
                *(uint4*)(w.hb1 + (size_t)(m0 + row) * 1024 + n0 + c8) = pk;
                float sq = (h0.x * h0.x + h0.y * h0.y) + (h0.z * h0.z + h0.w * h0.w) + (h1.x * h1.x + h1.y * h1.y) + (h1.z * h1.z + h1.w * h1.w);
                sq = grp_sum16(sq);
                if ((lane & 15) == 0) w.rssB[(size_t)(m0 + row) * 8 + nt] = sq;
            }
        }
        __syncthreads();
    }
}

__device__ void router_item(const Params& P, int L, int mt, char* lds, const int tid_in, const bool dry) {
    int tid = tid_in; asm volatile("" : "+v"(tid));
    const WS& w = P.w; const nv::Inputs& in = P.in;
    float* T = (float*)lds; float* stat = (float*)(lds + STAT_OFF); int* hist = (int*)(lds + STAT_OFF + 1024);
    const int m0 = mt * 128;
    {
        const bf16_t* arow[2]; const bf16_t* wrow[2];
#pragma unroll
        for (int i = 0; i < 2; ++i) {
            arow[i] = w.hb1 + (size_t)(m0 + (tid >> 2) + 64 * i) * 1024 + gl_chunk(tid) * 8;
            wrow[i] = w.Wrt + L * WR_SZ + (size_t)((tid >> 2) + 64 * i) * 1024 + gl_chunk(tid) * 8;
        }
        f32x16 acc[2][2]; acc_zero(acc);
        float my_rs = 0.f;
        if (tid < 128) my_rs = rstd8(w.rssB + (size_t)(m0 + tid) * 8, 1.f / 1024.f);
        gemm_mainloop_g(acc, arow, wrow, 32, lds, tid);
        if (tid < 128) stat[tid] = my_rs;
        if (tid < 32) hist[tid] = 0;
        acc_to_lds(acc, T, tid);
    }
    int e0 = 0, e1 = 0, r0 = 0, r1 = 0; float w0 = 0.f, w1 = 0.f;
    if (tid < 128) {
        const float rs = stat[tid];
        const float* lr = T + tid * TLD;
        const float* bg = in.router_group_b + L * 4; const float* be = in.router_expert_b + L * 32;
        int gi = 0; float gm = lr[0] * rs + bg[0];
#pragma unroll
        for (int j = 1; j < 4; ++j) { const float v = lr[j] * rs + bg[j]; if (v > gm) { gm = v; gi = j; } }
        float gs = 0.f;
#pragma unroll
        for (int j = 0; j < 4; ++j) gs += __builtin_amdgcn_exp2f(1.4426950408889634f * (lr[j] * rs + bg[j] - gm));
        const float gw = 1.f / gs;
        int i0 = 0, i1 = -1; float v0 = -3.0e38f, v1 = -3.0e38f;
#pragma unroll
        for (int j = 0; j < 8; ++j) {
            const float v = lr[4 + gi * 8 + j] * rs + be[gi * 8 + j];
            if (v > v0) { v1 = v0; i1 = i0; v0 = v; i0 = j; } else if (v > v1) { v1 = v; i1 = j; }
        }
        const float ex = __builtin_amdgcn_exp2f(1.4426950408889634f * (v1 - v0));
        w0 = gw / (1.f + ex); w1 = gw * ex / (1.f + ex);
        e0 = gi * 8 + i0; e1 = gi * 8 + i1;
        r0 = atomicAdd(&hist[e0], 1); r1 = atomicAdd(&hist[e1], 1);
    }
    __syncthreads();
    if (tid < 32) hist[32 + tid] = (hist[tid] && !dry) ? atomicAdd(&w.cnt[L * 64 + tid], hist[tid]) : 0;
    __syncthreads();
    if (tid < 128 && !dry) {
        const int tok = m0 + tid;
        const int p0 = hist[32 + e0] + r0, p1 = hist[32 + e1] + r1;
        w.elist[(size_t)e0 * NT + p0] = tok * 2; w.ewt[(size_t)e0 * NT + p0] = w0;
        w.elist[(size_t)e1 * NT + p1] = tok * 2 + 1; w.ewt[(size_t)e1 * NT + p1] = w1;
    }
    __syncthreads();
}
__device__ void eraw_item(const Params& P, int L, const int mt, const int nt, char* lds, const int tid_in) {
    int tid = tid_in; asm volatile("" : "+v"(tid));
    const WS& w = P.w; const nv::Inputs& in = P.in;
    const int lane = tid & 63, wid = tid >> 6;
    float* T = (float*)lds;
    const int m0 = mt * 128, n0 = nt * 128;
    {
        const float* arow[4]; const bf16_t* wrow[4];
#pragma unroll
        for (int i = 0; i < 4; ++i) {
            arow[i] = in.p + ((size_t)L * NT + m0 + (tid >> 3) + 32 * i) * 256 + (tid & 7) * 8;
            wrow[i] = w.Wpt + L * WP_SZ + (size_t)(n0 + (tid >> 3) + 32 * i) * 256 + (tid & 7) * 8;
        }
        f32x16 acc[2][2]; acc_zero(acc);
        float ss[4] = {0.f, 0.f, 0.f, 0.f};
        gemm_mainloop<float, false>(acc, arow, wrow, 4, lds, ss, tid);
        acc_to_lds(acc, T, tid);
    }
    {
        const int sub = lane >> 4, l16 = lane & 15, c8 = l16 * 8;
#pragma unroll 8
        for (int rr = 0; rr < 8; ++rr) {
            const int row = wid * 32 + rr * 4 + sub;
            const float4 x0 = *(const float4*)(T + row * TLD + c8), x1 = *(const float4*)(T + row * TLD + c8 + 4);
            *(uint4*)(w.erb + (size_t)(m0 + row) * 1024 + n0 + c8) = pack8(x0, x1);
            const float sq = grp_sum16(sq8(x0, x1));
            if (l16 == 0) w.essq[(size_t)(m0 + row) * 8 + nt] = sq;
        }
    }
    __syncthreads();
}
__device__ void phase_router(const Params& P, int L, char* lds, const bool dry = false) {
    const int tid = opaque_tid();
    int mt, nt;
    {
        const int x = blockIdx.x & 7, lb = blockIdx.x >> 3, nlb = gridDim.x >> 3;
        const int lo = nlb >= 16 ? nlb - 16 : 0;
        for (int j = lb - lo; j >= 0 && j < 16; j += nlb) router_item(P, L, j * 8 + x, lds, tid, dry);
    }
    for (int it = 0; xcd_item(it, 128, 8, mt, nt); ++it) eraw_item(P, L, mt, nt, lds, tid);
}

constexpr int TT_OFF = STAT_OFF + 1024;
__device__ __forceinline__ void moe_table(const Params& P, int L, char* lds, const int tid) {
    int* tt = (int*)(lds + TT_OFF);
    if (tid == 0) {
        const int x = blockIdx.x & 7;
        int o = 0, t = 0;
        for (int e = 0; e < 32; ++e) {
            const int c = P.w.cnt[L * 64 + e];
            tt[e] = o; o += c;
            if ((e & 7) == x) { tt[40 + (e >> 3)] = t; t += (c + 127) >> 7; }
        }
        tt[32] = o; tt[44] = t;
    }
    __syncthreads();
}
__device__ __forceinline__ void moe_find(const int* tt, int tile, int& e, int& t) {
    int k = 0;
    if (tile >= tt[41]) k = 1;
    if (tile >= tt[42]) k = 2;
    if (tile >= tt[43]) k = 3;
    e = (blockIdx.x & 7) + 8 * k; t = tile - tt[40 + k];
}
__device__ void phase_moe_up(const Params& P, int L, char* lds) {
    const WS& w = P.w;
    const int tid0 = opaque_tid();
    float* T = (float*)lds; float* stat = (float*)(lds + STAT_OFF); const int* tt = (const int*)(lds + TT_OFF);
    moe_table(P, L, lds, tid0);
    const int ntiles = tt[44];
    for (int item = blockIdx.x >> 3; item < ntiles * 4; item += (gridDim.x >> 3)) {
        int tid = tid0; asm volatile("" : "+v"(tid));
        const int lane = tid & 63, wid = tid >> 6;
        const int tile = item >> 2, nt = item & 3;
        int e, t; moe_find(tt, tile, e, t);
        const int cnt = P.w.cnt[L * 64 + e], rbase = tt[e] + t * 128, nrows = min(128, cnt - t * 128);
        {
            const bf16_t* arow[2]; const bf16_t* wrow[2];
#pragma unroll
            for (int i = 0; i < 2; ++i) {
                const int r = (tid >> 2) + 64 * i;
                const int ent = w.elist[(size_t)e * NT + t * 128 + (r < nrows ? r : 0)];
                arow[i] = w.hb1 + (size_t)(ent >> 1) * 1024 + gl_chunk(tid) * 8;
                wrow[i] = w.Wgut + L * WGU_SZ + ((size_t)e * 512 + nt * 128 + r) * 1024 + gl_chunk(tid) * 8;
            }
            f32x16 acc[2][2]; acc_zero(acc);
            float my_rs = 0.f;
            if (tid < 128) {
                const int ent = w.elist[(size_t)e * NT + t * 128 + (tid < nrows ? tid : 0)];
                my_rs = rstd8(w.rssB + (size_t)(ent >> 1) * 8, 1.f / 1024.f);
            }
            gemm_mainloop_g(acc, arow, wrow, 32, lds, tid);
            if (tid < 128) stat[tid] = my_rs;
            acc_to_lds(acc, T, tid);
        }
        {
            const int sub = lane >> 4, l16 = lane & 15, c8 = l16 * 8;
#pragma unroll 8
            for (int rr = 0; rr < 8; ++rr) {
                const int row = wid * 32 + rr * 4 + sub; const float rs = stat[row];
                const float4 x0 = mul4(*(const float4*)(T + row * TLD + c8), rs), x1 = mul4(*(const float4*)(T + row * TLD + c8 + 4), rs);
                if (row < nrows)
                    store4(w.hbuf + (size_t)(rbase + row) * 256 + nt * 64 + l16 * 4, x0.x * sigmoid_(x0.x) * x0.y, x0.z * sigmoid_(x0.z) * x0.w,
                           x1.x * sigmoid_(x1.x) * x1.y, x1.z * sigmoid_(x1.z) * x1.w);
            }
        }
        __syncthreads();
    }
}
__device__ void phase_moe_down(const Params& P, int L, char* lds) {
    const WS& w = P.w;
    const int tid0 = opaque_tid();
    float* T = (float*)lds; float* stat = (float*)(lds + STAT_OFF); const int* tt = (const int*)(lds + TT_OFF);
    moe_table(P, L, lds, tid0);
    const int ntiles = tt[44];
    for (int item = blockIdx.x >> 3; item < ntiles * 8; item += (gridDim.x >> 3)) {
        int tid = tid0; asm volatile("" : "+v"(tid));
        const int lane = tid & 63, wid = tid >> 6;
        const int tile = item >> 3, nt = item & 7;
        int e, t; moe_find(tt, tile, e, t);
        const int cnt = P.w.cnt[L * 64 + e], rbase = tt[e] + t * 128, nrows = min(128, cnt - t * 128);
        {
            const bf16_t* arow[2]; const bf16_t* wrow[2];
#pragma unroll
            for (int i = 0; i < 2; ++i) {
                const int r = (tid >> 2) + 64 * i;
                arow[i] = w.hbuf + (size_t)(rbase + (r < nrows ? r : 0)) * 256 + gl_chunk(tid) * 8;
                wrow[i] = w.Wdt + L * WD_SZ + ((size_t)e * 1024 + nt * 128 + r) * 256 + gl_chunk(tid) * 8;
            }
            f32x16 acc[2][2]; acc_zero(acc);
            int my_ent = 0; float my_wt = 0.f;
            if (tid < 128) { const int rr2 = tid < nrows ? tid : 0; my_ent = w.elist[(size_t)e * NT + t * 128 + rr2]; my_wt = w.ewt[(size_t)e * NT + t * 128 + rr2]; }
            gemm_mainloop_g(acc, arow, wrow, 8, lds, tid);
            if (tid < 128) { ((int*)stat)[tid] = my_ent; stat[128 + tid] = my_wt; }
            acc_to_lds(acc, T, tid);
        }
        {
            const int sub = lane >> 4, l16 = lane & 15, c8 = l16 * 8;
#pragma unroll 8
            for (int rr = 0; rr < 8; ++rr) {
                const int row = wid * 32 + rr * 4 + sub;
                const int ent = ((const int*)stat)[row]; const float wt = stat[128 + row];
                const float4 x0 = mul4(*(const float4*)(T + row * TLD + c8), wt), x1 = mul4(*(const float4*)(T + row * TLD + c8 + 4), wt);
                if (row < nrows) *(uint4*)(w.contrib + (size_t)ent * 1024 + nt * 128 + c8) = pack8(x0, x1);
            }
        }
        __syncthreads();
    }
}

__device__ void phase_combine(const Params& P, int L, char* lds, const bool dry = false) {
    const WS& w = P.w;
    const int tid = opaque_tid(), lane = tid & 63;
    for (size_t tok = (size_t)blockIdx.x * 4 + (tid >> 6); tok < NT; tok += (size_t)gridDim.x * 4) {
        float ss = 0.f;
#pragma unroll
        for (int j = 0; j < 2; ++j) {
            const size_t c8 = (size_t)(j * 64 + lane) * 8;
            const uint4 a = *(const uint4*)(w.contrib + (tok * 2) * 1024 + c8), b = *(const uint4*)(w.contrib + (tok * 2 + 1) * 1024 + c8);
            float4* hp = (float4*)(P.h + tok * 1024 + c8);
            float4 h0 = hp[0], h1 = hp[1];
            h0.x += bflo(a.x) + bflo(b.x); h0.y += bfhi(a.x) + bfhi(b.x); h0.z += bflo(a.y) + bflo(b.y); h0.w += bfhi(a.y) + bfhi(b.y);
            h1.x += bflo(a.z) + bflo(b.z); h1.y += bfhi(a.z) + bfhi(b.z); h1.z += bflo(a.w) + bflo(b.w); h1.w += bfhi(a.w) + bfhi(b.w);
            if (!dry) { hp[0] = h0; hp[1] = h1; }
            uint4 pk; pk.x = pack2(h0.x, h0.y); pk.y = pack2(h0.z, h0.w); pk.z = pack2(h1.x, h1.y); pk.w = pack2(h1.z, h1.w);
            *(uint4*)(w.hb1 + tok * 1024 + c8) = pk;
            ss += (h0.x * h0.x + h0.y * h0.y) + (h0.z * h0.z + h0.w * h0.w) + (h1.x * h1.x + h1.y * h1.y) + (h1.z * h1.z + h1.w * h1.w);
        }
        ss = wave_sum64(ss);
        if (lane < 8) w.rssB[tok * 8 + lane] = lane == 0 ? ss : 0.f;
    }
}

__device__ void phase_ple(const Params& P, int L, char* lds, const bool dry = false) {
    const WS& w = P.w; const nv::Inputs& in = P.in;
    const int tid0 = opaque_tid();
    float* T = (float*)lds; float* stat = (float*)(lds + STAT_OFF);
    int mt, nt;
    for (int it = 0; xcd_item(it, 128, 8, mt, nt); ++it) {
        int tid = tid0; asm volatile("" : "+v"(tid));
        const int lane = tid & 63, wid = tid >> 6;
        const int m0 = mt * 128, n0 = nt * 128;
        {
            const bf16_t* arow[2]; const bf16_t* wrow[2];
#pragma unroll
            for (int i = 0; i < 2; ++i) {
                arow[i] = w.hb1 + (size_t)(m0 + (tid >> 2) + 64 * i) * 1024 + gl_chunk(tid) * 8;
                wrow[i] = w.Wgt + L * WG_SZ + (size_t)(n0 + (tid >> 2) + 64 * i) * 1024 + gl_chunk(tid) * 8;
            }
            f32x16 acc[2][2]; acc_zero(acc);
            float my_rs = 0.f, my_re = 0.f;
            if (tid < 128) { my_rs = rstd8(w.rssB + (size_t)(m0 + tid) * 8, 1.f / 1024.f); my_re = rstd8(w.essq + (size_t)(m0 + tid) * 8, 1.f / 1024.f); }
            gemm_mainloop_g(acc, arow, wrow, 32, lds, tid);
            if (tid < 128) { stat[tid] = my_rs; stat[128 + tid] = my_re; }
            acc_to_lds(acc, T, tid);
        }
        {
            const int sub = lane >> 4, l16 = lane & 15, c8 = l16 * 8;
            const float4 pg0 = *(const float4*)(in.ple_post_norm_g + L * 1024 + n0 + c8), pg1 = *(const float4*)(in.ple_post_norm_g + L * 1024 + n0 + c8 + 4);
#pragma unroll 8
            for (int rr = 0; rr < 8; ++rr) {
                const int row = wid * 32 + rr * 4 + sub; const float rs = stat[row], re = stat[128 + row]; const size_t tok = m0 + row;
                const float4 x0 = mul4(*(const float4*)(T + row * TLD + c8), rs), x1 = mul4(*(const float4*)(T + row * TLD + c8 + 4), rs);
                const size_t off = tok * 1024 + n0 + c8;
                const uint4 er = *(const uint4*)(w.erb + off);
                float4* hp = (float4*)(P.h + off);
                float4 h0 = hp[0], h1 = hp[1];
                h0.x += sigmoid_(x0.x) * (bflo(er.x) * re * pg0.x); h0.y += sigmoid_(x0.y) * (bfhi(er.x) * re * pg0.y);
                h0.z += sigmoid_(x0.z) * (bflo(er.y) * re * pg0.z); h0.w += sigmoid_(x0.w) * (bfhi(er.y) * re * pg0.w);
                h1.x += sigmoid_(x1.x) * (bflo(er.z) * re * pg1.x); h1.y += sigmoid_(x1.y) * (bfhi(er.z) * re * pg1.y);
                h1.z += sigmoid_(x1.z) * (bflo(er.w) * re * pg1.z); h1.w += sigmoid_(x1.w) * (bfhi(er.w) * re * pg1.w);
                if (!dry) { hp[0] = h0; hp[1] = h1; }
                *(uint4*)(w.hb + off) = pack8(h0, h1);
                const float sq = grp_sum16(sq8(h0, h1));
                if (l16 == 0) w.rssA[tok * 8 + nt] = sq;
            }
        }
        __syncthreads();
    }
}

}
namespace fx {
#define XB_TMO      128
#define XB_XCNT(j)  (256  + 64 * (j))
#define XB_XSUB(j)  (1280 + 64 * (j))
#define XB_XGEN(j)  (2304 + 64 * (j))
#define XB_TOP      3328
#define XB_TOPGEN   3392
#define XCD_BAR_WORDS 3456
#define XB_SPIN_CAP (1u << 18)
#define LAS __attribute__((address_space(3)))
__device__ __forceinline__ unsigned xb_ld(unsigned* p)              { return __hip_atomic_load(p, __ATOMIC_RELAXED, __HIP_MEMORY_SCOPE_AGENT); }
__device__ __forceinline__ unsigned xb_add(unsigned* p, unsigned v) { return __hip_atomic_fetch_add(p, v, __ATOMIC_RELAXED, __HIP_MEMORY_SCOPE_AGENT); }
__device__ __forceinline__ unsigned xb_xcc_id() { return (unsigned)__builtin_amdgcn_s_getreg((3 << 11) | 20) & 0xFu; }
#define XB_SPIN(cond, bar) do { unsigned _sp = 0; while (cond) { __builtin_amdgcn_s_sleep(1); \
    if ((++_sp & 255u) == 0u) { if (xb_ld(&(bar)[XB_TMO])) break; if (_sp > XB_SPIN_CAP) { atomicAdd(&(bar)[XB_TMO], 1u); break; } } } } while (0)
struct XcdBarrier { unsigned* bar; unsigned x; volatile LAS unsigned* st; };
__device__ __forceinline__ XcdBarrier xcd_barrier_post(unsigned* bar, volatile LAS unsigned* st) {
    XcdBarrier b; b.bar = bar; b.x = xb_xcc_id(); b.st = st;
    if (threadIdx.x == 0) (void)xb_add(&bar[XB_XCNT(b.x)], 1u);
    return b;
}
__device__ __forceinline__ void xcd_barrier_complete(unsigned* bar, unsigned x, unsigned& nloc, unsigned& nx) {
    const unsigned G = gridDim.x * gridDim.y * gridDim.z;
    unsigned sum, cnt, mine, sp = 0u;
    for (;;) {
        sum = 0u; cnt = 0u; mine = 0u;
#pragma unroll
        for (unsigned j = 0; j < 16; ++j) { const unsigned c = xb_ld(&bar[XB_XCNT(j)]); sum += c; cnt += (c > 0u) ? 1u : 0u; mine = (j == x) ? c : mine; }
        if (sum == G) break;
        __builtin_amdgcn_s_sleep(1);
        if ((++sp & 255u) == 0u) { if (xb_ld(&bar[XB_TMO])) break; if (sp > XB_SPIN_CAP) { atomicAdd(&bar[XB_TMO], 1u); break; } }
    }
    nloc = mine > 0u ? mine : 1u; nx = cnt > 0u ? cnt : 1u;
}
__device__ __forceinline__ void xcd_barrier(const XcdBarrier& b) {
    asm volatile("s_waitcnt vmcnt(0)" ::: "memory");
    __syncthreads();
    if (threadIdx.x == 0) {
        unsigned* bar = b.bar;
        __builtin_amdgcn_s_waitcnt(0);
        unsigned nloc = b.st[0], nx = b.st[1];
        if (nloc == 0u) { xcd_barrier_complete(bar, b.x, nloc, nx); b.st[0] = nloc; b.st[1] = nx; }
        const unsigned old = xb_add(&bar[XB_XSUB(b.x)], 1u);
        const unsigned gen = old / nloc;
        if (old + 1u == (gen + 1u) * nloc) {
            __builtin_amdgcn_fence(__ATOMIC_RELEASE, "agent");
            asm volatile("s_waitcnt vmcnt(0)" ::: "memory");
            const unsigned og = xb_add(&bar[XB_TOP], 1u);
            const unsigned tg = og / nx;
            if (og + 1u == (tg + 1u) * nx) xb_add(&bar[XB_TOPGEN], 1u);
            else XB_SPIN(xb_ld(&bar[XB_TOPGEN]) == tg, bar);
            __builtin_amdgcn_fence(__ATOMIC_ACQUIRE, "agent");
            xb_add(&bar[XB_XGEN(b.x)], 1u);
            asm volatile("s_waitcnt vmcnt(0)" ::: "memory");
        } else {
            XB_SPIN(xb_ld(&bar[XB_XGEN(b.x)]) == gen, bar);
            __builtin_amdgcn_fence(__ATOMIC_ACQUIRE, "agent");
            asm volatile("s_waitcnt vmcnt(0)" ::: "memory");
        }
    }
    __syncthreads();
}

constexpr int LDS_BYTES = LDS_GEMM_BYTES + 16;
constexpr int N_PHASES = 19;
constexpr int PPL = 9;
__global__ void __launch_bounds__(256, 2) k_run(Params P, int ph_lo, int ph_hi) {
    extern __shared__ __attribute__((aligned(16))) char lds[];
    volatile LAS unsigned* st = (volatile LAS unsigned*)(lds + LDS_GEMM_BYTES);
    if (threadIdx.x == 0) { st[0] = 0u; st[1] = 0u; }
    __syncthreads();
    XcdBarrier xb = xcd_barrier_post(P.w.bar, st);
    for (int ph = ph_lo; ph < ph_hi; ++ph) {
        if (ph > ph_lo) xcd_barrier(xb);
#ifdef REP_PHASE
        if (REP_PHASE == 0 && ph == 0) { phase_prep(P, lds); xcd_barrier(xb); }
        if (ph > 0 && ((ph - 1) % PPL) == REP_PHASE - 1) {
            const int L = (ph - 1) / PPL;
            switch (REP_PHASE - 1) {
                case 0: phase_zgemm(P, L, lds); break;
                case 1: phase_mix(P, L, lds); break;
                case 2: phase_attn(P, L, lds); break;
                case 3: phase_oproj(P, L, lds, true); break;
                case 4: phase_router(P, L, lds, true); break;
                case 5: phase_moe_up(P, L, lds); break;
                case 6: phase_moe_down(P, L, lds); break;
                case 7: phase_combine(P, L, lds, true); break;
                case 8: phase_ple(P, L, lds, true); break;
            }
            xcd_barrier(xb);
        }
#endif
        if (ph == 0) phase_prep(P, lds);
        else {
            const int L = (ph - 1) / PPL, s = (ph - 1) % PPL;
            switch (s) {
                case 0: phase_zgemm(P, L, lds); break;
                case 1: phase_mix(P, L, lds); break;
                case 2: phase_attn(P, L, lds); break;
                case 3: phase_oproj(P, L, lds); break;
                case 4: phase_router(P, L, lds); break;
                case 5: phase_moe_up(P, L, lds); break;
                case 6: phase_moe_down(P, L, lds); break;
                case 7: phase_combine(P, L, lds); break;
                case 8: phase_ple(P, L, lds); break;
            }
        }
    }
}
}
#ifndef MK_N_LAUNCHES
#define MK_N_LAUNCHES 1
#endif
extern "C" void kernel_launch(void* const* d_in, const int* in_sizes, int n_in, void* d_out, int out_size, void* d_ws, size_t ws_size,
                              hipStream_t stream) {
    nv::Inputs in{};
    in.x = (const float*)d_in[0]; in.p = (const float*)d_in[1]; in.positions = (const int*)d_in[2];
    const float** f = &in.mix_norm_g;
    for (int i = 0; i < 32; ++i) f[i] = (const float*)d_in[3 + i];
    size_t used = 0;
    fx::WS w = fx::make_ws((char*)d_ws, used);
    static int grid = 0;
    if (grid == 0) {
        if (n_in != 35 || out_size != fx::NT * 1024 || used > ws_size) { fprintf(stderr, "kernel_launch: unexpected shapes / workspace (need %zu, have %zu)\n", used, ws_size); grid = -1; return; }
        if (hipFuncSetAttribute((const void*)fx::k_run, hipFuncAttributeMaxDynamicSharedMemorySize, fx::LDS_BYTES) != hipSuccess) { fprintf(stderr, "hipFuncSetAttribute failed\n"); grid = -1; return; }
        int dev = 0, cus = 0, per_cu = 0;
        hipGetDevice(&dev); hipDeviceGetAttribute(&cus, hipDeviceAttributeMultiprocessorCount, dev);
        hipOccupancyMaxActiveBlocksPerMultiprocessor(&per_cu, (const void*)fx::k_run, 256, fx::LDS_BYTES);
        if (per_cu > 2) per_cu = 2;
        if (per_cu < 1) { fprintf(stderr, "occupancy query says %d blocks/CU\n", per_cu); grid = -1; return; }
        grid = cus * per_cu;
    }
    if (grid < 0) return;
    fx::Params P{}; P.in = in; P.h = (float*)d_out; P.w = w;
    hipMemsetAsync(w.cnt, 0, 128 * 4, stream);
    hipMemsetAsync(w.bar, 0, XCD_BAR_WORDS * 4, stream);
    if (MK_N_LAUNCHES == 1) hipLaunchKernelGGL(fx::k_run, dim3(grid), dim3(256), fx::LDS_BYTES, stream, P, 0, fx::N_PHASES);
    else for (int ph = 0; ph < fx::N_PHASES; ++ph) hipLaunchKernelGGL(fx::k_run, dim3(grid), dim3(256), fx::LDS_BYTES, stream, P, ph, ph + 1);
}
```

```cpp
#include <hip/hip_runtime.h>
#include <hip/hip_bf16.h>
#include <stdint.h>
#include <cstdio>
namespace nv {
struct Inputs {
    const float *x, *p; const int* positions;
    const float *mix_norm_g, *w_in, *sgu_ln_g, *sgu_ln_b, *sgu_w, *sgu_b, *conv_w, *conv_b, *conv_ln_g, *conv_ln_b, *conv_pw_w, *conv_pw_b,
        *q_a_norm_g, *w_uq, *kv_a_norm_g, *w_ukv, *q_norm_g, *k_norm_g, *branch_norm_g, *w_o, *ffn_norm_g, *router_group_w, *router_group_b,
        *router_expert_w, *router_expert_b, *moe_w_gate, *moe_w_up, *moe_w_down, *ple_norm_g, *ple_gate_w, *ple_proj_w, *ple_post_norm_g;
};
}
namespace fx {

typedef unsigned short bf16_t;
typedef short bf16x8 __attribute__((ext_vector_type(8)));
typedef float f32x16 __attribute__((ext_vector_type(16)));
typedef float f32x4 __attribute__((ext_vector_type(4)));

constexpr int NT = 16384, SEQ = 2048, DM = 1024, NB = 8;
constexpr int ZN = 1536;
constexpr float EPS = 1e-6f;

typedef __bf16 bf16v2_t __attribute__((ext_vector_type(2)));
typedef float f32v2_t __attribute__((ext_vector_type(2)));
__device__ __forceinline__ unsigned pack2(float lo, float hi) {
    f32v2_t v; v.x = lo; v.y = hi;
    bf16v2_t b = __builtin_convertvector(v, bf16v2_t);
    return __builtin_bit_cast(unsigned, b);
}
__device__ __forceinline__ unsigned f2bf(float f) { return pack2(f, 0.f) & 0xffffu; }
__device__ __forceinline__ float bf2f(unsigned short b) { return __uint_as_float(((unsigned)b) << 16); }
__device__ __forceinline__ float bflo(unsigned u) { return __uint_as_float(u << 16); }
__device__ __forceinline__ float bfhi(unsigned u) { return __uint_as_float(u & 0xffff0000u); }
__device__ __forceinline__ float sigmoid_(float x) { return __builtin_amdgcn_rcpf(1.f + __builtin_amdgcn_exp2f(-1.4426950408889634f * x)); }
__device__ __forceinline__ float rsq_(float x) { return __builtin_amdgcn_rsqf(x); }
__device__ __forceinline__ float gelu_tanh_(float x) {
    float u = 0.7978845608028654f * (x + 0.044715f * x * x * x);
    return x * sigmoid_(2.f * u);
}
__device__ __forceinline__ int opaque_tid() { int t = threadIdx.x; asm volatile("" : "+v"(t)); return t; }
template <int CTRL> __device__ __forceinline__ float dpp_mov(float v) {
    return __builtin_bit_cast(float, __builtin_amdgcn_update_dpp(0, __builtin_bit_cast(int, v), CTRL, 0xf, 0xf, false));
}
__device__ __forceinline__ void swap16(float& a, float& b) { asm volatile("s_nop 1\n\tv_permlane16_swap_b32 %0, %1" : "+v"(a), "+v"(b)); }
__device__ __forceinline__ void swap32(float& a, float& b) { asm volatile("s_nop 1\n\tv_permlane32_swap_b32 %0, %1" : "+v"(a), "+v"(b)); }
__device__ __forceinline__ float swap16_sum(float v) { float a = v, b = v; swap16(a, b); return a + b; }
__device__ __forceinline__ float swap32_sum(float v) { float a = v, b = v; swap32(a, b); return a + b; }
__device__ __forceinline__ float swap32_max(float v) { float a = v, b = v; swap32(a, b); return fmaxf(a, b); }
__device__ __forceinline__ float grp_sum16(float v) { v += dpp_mov<0xB1>(v); v += dpp_mov<0x4E>(v); v += dpp_mov<0x124>(v); v += dpp_mov<0x128>(v); return v; }
__device__ __forceinline__ float grp_sum32(float v) { return swap16_sum(grp_sum16(v)); }
__device__ __forceinline__ float wave_sum64(float v) { return swap32_sum(grp_sum32(v)); }
__device__ __forceinline__ float grp_sum4(float v) { v += dpp_mov<0xB1>(v); v += dpp_mov<0x4E>(v); return v; }
__device__ __forceinline__ float grp_sum8(float v) { v = grp_sum4(v); v += dpp_mov<0x141>(v); return v; }
__device__ __forceinline__ float quad_x2(float v) { return dpp_mov<0x4E>(v); }
__device__ __forceinline__ float xor8(float v) { return dpp_mov<0x128>(v); }
__device__ __forceinline__ float xor32(float v) { return swap32_sum(v); }

struct WS {
    bf16_t *W1t, *Wuqt, *Wukvt, *Wpwt, *Wot, *Wrt, *Wgut, *Wdt, *Wgt, *Wpt, *Wsm;
    bf16_t *hb;
    bf16_t *hb1;
    bf16_t *ub;
    bf16_t *vT;
    bf16_t *ygb;
    bf16_t *cqb;
    bf16_t *ckvb;
    bf16_t *kpeb;
    bf16_t *Qb;
    bf16_t *Knb;
    bf16_t *VTb;
    bf16_t *yb;
    float  *ssq;
    float  *rssA;
    float  *rssB;
    float  *cqss;
    float  *cs;
    bf16_t *erb;
    float  *essq;
    bf16_t *hbuf;
    bf16_t *contrib;
    int    *cnt;
    int    *elist;
    float  *ewt;
    unsigned *bar;
};
constexpr size_t W1_SZ = (size_t)ZN * 1024, WUQ_SZ = 768 * 256, WUKV_SZ = 1024 * 128, WPW_SZ = 256 * 256, WO_SZ = 1024 * 1024, WR_SZ = 128 * 1024,
                 WGU_SZ = (size_t)32 * 512 * 1024, WD_SZ = (size_t)32 * 1024 * 256, WG_SZ = 1024 * 1024, WP_SZ = 1024 * 256, WSM_SZ = 4 * 128 * 128;

struct Params {
    nv::Inputs in;
    float* h;
    WS w;
    float* zf;
    float* yf;
};

static WS make_ws(char* base, size_t& used) {
    WS w{}; size_t o = 0;
    auto take = [&](size_t bytes) { char* p = base + o; o += (bytes + 255) & ~(size_t)255; return p; };
    w.W1t = (bf16_t*)take(2 * W1_SZ * 2);   w.Wuqt = (bf16_t*)take(2 * WUQ_SZ * 2); w.Wukvt = (bf16_t*)take(2 * WUKV_SZ * 2);
    w.Wpwt = (bf16_t*)take(2 * WPW_SZ * 2); w.Wot = (bf16_t*)take(2 * WO_SZ * 2);   w.Wrt = (bf16_t*)take(2 * WR_SZ * 2);
    w.Wgut = (bf16_t*)take(2 * WGU_SZ * 2); w.Wdt = (bf16_t*)take(2 * WD_SZ * 2);   w.Wgt = (bf16_t*)take(2 * WG_SZ * 2);
    w.Wpt = (bf16_t*)take(2 * WP_SZ * 2);   w.Wsm = (bf16_t*)take(2 * WSM_SZ * 2);
    w.hb = (bf16_t*)take((size_t)NT * 1024 * 2); w.hb1 = (bf16_t*)take((size_t)NT * 1024 * 2);
    w.ssq = (float*)take((size_t)NT * 16 * 4); w.cs = (float*)take((size_t)NT * 32 * 4);
    w.rssA = (float*)take((size_t)NT * 8 * 4); w.rssB = (float*)take((size_t)NT * 8 * 4); w.cqss = (float*)take((size_t)NT * 4 * 4);
    w.essq = (float*)take((size_t)NT * 8 * 4);
    w.cnt = (int*)take(2 * 64 * 4);
    w.elist = (int*)take((size_t)32 * NT * 4); w.ewt = (float*)take((size_t)32 * NT * 4);
    w.bar = (unsigned*)take(4096 * 4);
    const size_t region = o;
    w.ub = (bf16_t*)take((size_t)NT * 256 * 2); w.vT = (bf16_t*)take((size_t)NT * 256 * 2); w.ygb = (bf16_t*)take((size_t)NT * 256 * 2);
    w.cqb = (bf16_t*)take((size_t)NT * 256 * 2); w.ckvb = (bf16_t*)take((size_t)NT * 128 * 2); w.kpeb = (bf16_t*)take((size_t)NT * 32 * 2);
    w.Qb = (bf16_t*)take((size_t)NT * 768 * 2); w.Knb = (bf16_t*)take((size_t)NT * 512 * 2); w.VTb = (bf16_t*)take((size_t)NT * 512 * 2);
    w.yb = (bf16_t*)take((size_t)NT * 1024 * 2);
    const size_t region_end = o;
    o = region;
    w.contrib = (bf16_t*)take((size_t)NT * 2 * 1024 * 2);
    w.hbuf = (bf16_t*)take((size_t)(2 * NT + 128) * 256 * 2);
    w.erb = (bf16_t*)take((size_t)NT * 1024 * 2);
    if (o > region_end) { fprintf(stderr, "make_ws: overlay exceeds mixer region\n"); }
    o = region_end;
    used = o;
    return w;
}

__device__ const double ROPE_INV[16] = {1.0, 0.5623413251903491, 0.31622776601683794, 0.1778279410038923, 0.1, 0.05623413251903491, 0.03162277660168379, 0.01778279410038923, 0.01, 0.005623413251903491, 0.0031622776601683794, 0.0017782794100389228, 0.001, 0.0005623413251903491, 0.00031622776601683794, 0.00017782794100389227};
__device__ __forceinline__ void rope_cs(int pos, int j, float& c, float& s) {
    const double ang = (double)pos * ROPE_INV[j];
    const double n = rint(ang * 0.15915494309189535);
    double r = fma(-n, 6.283185307179586, ang); r = fma(-n, 2.4492935982947064e-16, r);
    const double r2 = r * r;
    double sc = 1.0, ss = 1.0;
    double tc = 1.0, ts = 1.0;
#pragma unroll
    for (int k = 1; k <= 14; ++k) {
        tc *= -r2 / (double)((2 * k - 1) * (2 * k)); sc += tc;
        ts *= -r2 / (double)((2 * k) * (2 * k + 1)); ss += ts;
    }
    c = (float)sc; s = (float)(ss * r);
}

enum { MAP_ID = 0, MAP_W1 = 1, MAP_UQ = 2, MAP_UKV = 3, MAP_GATE = 4, MAP_UP = 5 };
template <int MAP> __device__ __forceinline__ int dstrow(int c) {
    if (MAP == MAP_W1) {
        if (c < 512) return c;
        if (c < 768) return 512 + 2 * (c - 512);
        if (c < 1024) return 513 + 2 * (c - 768);
        return c;
    } else if (MAP == MAP_UQ) {
        const int h = c / 96, d = c - h * 96; return d < 64 ? h * 64 + d : 512 + h * 32 + d - 64;
    } else if (MAP == MAP_UKV) {
        const int h = c >> 7, d = c & 127; return d < 64 ? h * 64 + d : 512 + h * 64 + d - 64;
    } else if (MAP == MAP_GATE) return 2 * c;
    else if (MAP == MAP_UP) return 2 * c + 1;
    return c;
}
template <int MAP>
__device__ __forceinline__ void prep_tile(const float* src, int ld, int Nsrc, const float* scale, bf16_t* dst, int K, int k0, int c0, float* tile  , const int tid) {
    __syncthreads();
#pragma unroll
    for (int i = 0; i < 4; ++i) {
        const int kk = (tid >> 4) + 16 * i, c4 = (tid & 15) * 4;
        float4 v = make_float4(0.f, 0.f, 0.f, 0.f);
        if (c0 + c4 < Nsrc) v = *(const float4*)(src + (size_t)(k0 + kk) * ld + c0 + c4);
        const float sc = scale ? scale[k0 + kk] : 1.f;
        float* t = tile + kk * 65 + c4;
        t[0] = v.x * sc; t[1] = v.y * sc; t[2] = v.z * sc; t[3] = v.w * sc;
    }
    __syncthreads();
#pragma unroll
    for (int i = 0; i < 2; ++i) {
        const int idx = tid + 256 * i, c = idx >> 3, kc = idx & 7;
        if (c0 + c < Nsrc) {
            const float* t = tile + (kc * 8) * 65 + c;
            uint4 pk;
            pk.x = pack2(t[0], t[65]); pk.y = pack2(t[130], t[195]); pk.z = pack2(t[260], t[325]); pk.w = pack2(t[390], t[455]);
            *(uint4*)(dst + (size_t)dstrow<MAP>(c0 + c) * K + k0 + kc * 8) = pk;
        }
    }
}
template <int MAP>
__device__ void prep_job(const float* src, int ld, int Nsrc, size_t src_stride, const float* scale, bf16_t* dst, size_t dst_stride, int K, int nbatch, float* tile, int& rot, const int tid) {
    const int tn = (Nsrc + 63) / 64, tk = K / 64, per = tn * tk, total = per * nbatch, G = gridDim.x;
    for (int t = ((int)blockIdx.x - rot + G) % G; t < total; t += G) {
        const int e = t / per, tt = t % per;
        prep_tile<MAP>(src + (size_t)e * src_stride, ld, Nsrc, scale, dst + (size_t)e * dst_stride, K, (tt / tn) * 64, (tt % tn) * 64, tile, tid);
    }
    rot = (rot + total) % G;
}

__device__ void phase_prep(const Params& P, char* lds) {
    float* tile = (float*)lds;
    const nv::Inputs& in = P.in; const WS& w = P.w;
    const int G = gridDim.x, bid = blockIdx.x, tid = opaque_tid();
    int rot = 0;
    for (int L = 0; L < 2; ++L) {
        prep_job<MAP_GATE>(in.moe_w_gate + (size_t)L * 32 * 1024 * 256, 256, 256, (size_t)1024 * 256, in.ffn_norm_g + L * 1024, w.Wgut + L * WGU_SZ, (size_t)512 * 1024, 1024, 32, tile, rot, tid);
        prep_job<MAP_UP>(in.moe_w_up + (size_t)L * 32 * 1024 * 256, 256, 256, (size_t)1024 * 256, in.ffn_norm_g + L * 1024, w.Wgut + L * WGU_SZ, (size_t)512 * 1024, 1024, 32, tile, rot, tid);
        prep_job<MAP_ID>(in.moe_w_down + (size_t)L * 32 * 256 * 1024, 1024, 1024, (size_t)256 * 1024, nullptr, w.Wdt + L * WD_SZ, (size_t)1024 * 256, 256, 32, tile, rot, tid);
        prep_job<MAP_W1>(in.w_in + (size_t)L * 1024 * 1440, 1440, 1440, 0, in.mix_norm_g + L * 1024, w.W1t + L * W1_SZ, 0, 1024, 1, tile, rot, tid);
        prep_job<MAP_UQ>(in.w_uq + (size_t)L * 256 * 768, 768, 768, 0, in.q_a_norm_g + L * 256, w.Wuqt + L * WUQ_SZ, 0, 256, 1, tile, rot, tid);
        prep_job<MAP_UKV>(in.w_ukv + (size_t)L * 128 * 1024, 1024, 1024, 0, in.kv_a_norm_g + L * 128, w.Wukvt + L * WUKV_SZ, 0, 128, 1, tile, rot, tid);
        prep_job<MAP_ID>(in.conv_pw_w + (size_t)L * 256 * 256, 256, 256, 0, nullptr, w.Wpwt + L * WPW_SZ, 0, 256, 1, tile, rot, tid);
        prep_job<MAP_ID>(in.w_o + (size_t)L * 1024 * 1024, 1024, 1024, 0, in.branch_norm_g + L * 1024, w.Wot + L * WO_SZ, 0, 1024, 1, tile, rot, tid);
        prep_job<MAP_ID>(in.ple_gate_w + (size_t)L * 1024 * 1024, 1024, 1024, 0, in.ple_norm_g + L * 1024, w.Wgt + L * WG_SZ, 0, 1024, 1, tile, rot, tid);
        prep_job<MAP_ID>(in.ple_proj_w + (size_t)L * 256 * 1024, 1024, 1024, 0, nullptr, w.Wpt + L * WP_SZ, 0, 256, 1, tile, rot, tid);
        for (int i = bid * 256 + tid; i < 96 * 1024 / 8; i += G * 256) *(uint4*)(w.W1t + L * W1_SZ + (size_t)1440 * 1024 + (size_t)i * 8) = make_uint4(0u, 0u, 0u, 0u);
        for (int i = bid * 256 + tid; i < 128 * 1024; i += G * 256) {
            int n = i >> 10, k = i & 1023; float v = 0.f;
            if (n < 4) v = in.router_group_w[(size_t)L * 1024 * 4 + k * 4 + n];
            else if (n < 36) v = in.router_expert_w[(size_t)L * 1024 * 32 + k * 32 + (n - 4)];
            v *= in.ffn_norm_g[L * 1024 + k];
            w.Wrt[L * WR_SZ + i] = (bf16_t)f2bf(v);
        }
        for (int i = bid * 256 + tid; i < 4 * 128 * 128; i += G * 256) {
            int jj = i & 127, ii = (i >> 7) & 127;
            float v = (jj <= ii) ? in.sgu_w[(size_t)L * WSM_SZ + i] : 0.f;
            w.Wsm[L * WSM_SZ + i] = (bf16_t)f2bf(v);
        }
    }
    for (int i = bid * 256 + tid; i < NT * 16; i += G * 256) {
        int t = i >> 4, j = i & 15;
        float c, sn; rope_cs(in.positions[t], j, c, sn);
        w.cs[t * 32 + j] = c; w.cs[t * 32 + 16 + j] = sn;
    }
    for (int row = bid * 4 + (tid >> 6); row < NT; row += G * 4) {
        const int lane = tid & 63;
        float ss = 0.f;
#pragma unroll
        for (int j = 0; j < 4; ++j) {
            const size_t i = (size_t)row * 256 + j * 64 + lane;
            const float4 v = ((const float4*)in.x)[i];
            ((float4*)P.h)[i] = v;
            uint2 pk; pk.x = pack2(v.x, v.y); pk.y = pack2(v.z, v.w);
            ((uint2*)w.hb)[i] = pk;
            ss += v.x * v.x + v.y * v.y + v.z * v.z + v.w * v.w;
        }
        ss = wave_sum64(ss);
        if (lane < 8) w.rssA[(size_t)row * 8 + lane] = lane == 0 ? ss : 0.f;
    }
}

__device__ __forceinline__ int lds_off(int row, int chunk) { return row * 128 + ((chunk ^ ((row >> 1) & 7)) << 4); }

template <typename AT> struct ARaw;
template <> struct ARaw<bf16_t> { uint4 v[4]; };
template <> struct ARaw<float> { float4 v[4][2]; };

__device__ __forceinline__ void a_load(ARaw<bf16_t>& r, const bf16_t* const (&rowp)[4], int koff) {
#pragma unroll
    for (int i = 0; i < 4; ++i) r.v[i] = *(const uint4*)(rowp[i] + koff);
}
__device__ __forceinline__ void a_load(ARaw<float>& r, const float* const (&rowp)[4], int koff) {
#pragma unroll
    for (int i = 0; i < 4; ++i) { r.v[i][0] = *(const float4*)(rowp[i] + koff); r.v[i][1] = *(const float4*)(rowp[i] + koff + 4); }
}
template <bool SUMSQ> __device__ __forceinline__ uint4 a_cvt(const uint4& v, float& ss) {
    if (SUMSQ) {
        float a;
        a = bflo(v.x); ss = fmaf(a, a, ss); a = bfhi(v.x); ss = fmaf(a, a, ss);
        a = bflo(v.y); ss = fmaf(a, a, ss); a = bfhi(v.y); ss = fmaf(a, a, ss);
        a = bflo(v.z); ss = fmaf(a, a, ss); a = bfhi(v.z); ss = fmaf(a, a, ss);
        a = bflo(v.w); ss = fmaf(a, a, ss); a = bfhi(v.w); ss = fmaf(a, a, ss);
    }
    return v;
}
template <bool SUMSQ> __device__ __forceinline__ void a_store(const ARaw<bf16_t>& r, char* ldsA, int tid, float (&ss)[4]) {
#pragma unroll
    for (int i = 0; i < 4; ++i) { uint4 v = a_cvt<SUMSQ>(r.v[i], ss[i]); *(uint4*)(ldsA + lds_off((tid >> 3) + 32 * i, tid & 7)) = v; }
}
template <bool SUMSQ> __device__ __forceinline__ void a_store(const ARaw<float>& r, char* ldsA, int tid, float (&ss)[4]) {
#pragma unroll
    for (int i = 0; i < 4; ++i) {
        const float4 a = r.v[i][0], b = r.v[i][1];
        if (SUMSQ) ss[i] += a.x * a.x + a.y * a.y + a.z * a.z + a.w * a.w + b.x * b.x + b.y * b.y + b.z * b.z + b.w * b.w;
        uint4 v; v.x = pack2(a.x, a.y); v.y = pack2(a.z, a.w); v.z = pack2(b.x, b.y); v.w = pack2(b.z, b.w);
        *(uint4*)(ldsA + lds_off((tid >> 3) + 32 * i, tid & 7)) = v;
    }
}

struct bf16x3_t {};
template <> struct ARaw<bf16x3_t> { uint4 a[4], b[4], c[4]; };
struct Rows3 { const bf16_t* p[2][4]; };
__device__ __forceinline__ void a_load(ARaw<bf16x3_t>& r, const Rows3& rows, int koff) {
#pragma unroll
    for (int i = 0; i < 4; ++i) { r.a[i] = *(const uint4*)(rows.p[0][i] + koff); r.b[i] = *(const uint4*)(rows.p[1][i] + koff); r.c[i] = *(const uint4*)(rows.p[1][i] + koff + 1024); }
}
__device__ __forceinline__ unsigned add3pk(unsigned a, unsigned b, unsigned c, float& ss) {
    const float lo = bflo(a) + bflo(b) + bflo(c), hi = bfhi(a) + bfhi(b) + bfhi(c);
    ss = fmaf(lo, lo, ss); ss = fmaf(hi, hi, ss);
    return pack2(lo, hi);
}
template <bool SUMSQ> __device__ __forceinline__ void a_store(const ARaw<bf16x3_t>& r, char* ldsA, int tid, float (&ss)[4]) {
#pragma unroll
    for (int i = 0; i < 4; ++i) {
        uint4 v;
        v.x = add3pk(r.a[i].x, r.b[i].x, r.c[i].x, ss[i]); v.y = add3pk(r.a[i].y, r.b[i].y, r.c[i].y, ss[i]);
        v.z = add3pk(r.a[i].z, r.b[i].z, r.c[i].z, ss[i]); v.w = add3pk(r.a[i].w, r.b[i].w, r.c[i].w, ss[i]);
        *(uint4*)(ldsA + lds_off((tid >> 3) + 32 * i, tid & 7)) = v;
    }
}

template <typename AT, bool SUMSQ, int SUNROLL = 4, typename AROWS>
__device__ __forceinline__ void gemm_mainloop(f32x16 (&acc)[2][2], const AROWS& arow, const bf16_t* const (&wrow)[4], int nkt, char* lds, float (&ss)[4], const int tid) {
    const int lane = tid & 63, wid = tid >> 6, wr = wid >> 1, wc = wid & 1;
    ARaw<AT> ra; ARaw<bf16_t> rb; float dummy[4] = {0.f, 0.f, 0.f, 0.f};
    a_load(ra, arow, 0); a_load(rb, wrow, 0);
    a_store<SUMSQ>(ra, lds, tid, ss); a_store<false>(rb, lds + 16384, tid, dummy);
    __syncthreads();
    const int fr = lane & 31, fh = lane >> 5;
#pragma unroll 1
    for (int kt = 0; kt < nkt; ++kt) {
        char* cur = lds + (kt & 1) * 32768;
        char* nxt = lds + ((kt + 1) & 1) * 32768;
        const bool more = (kt + 1 < nkt);
        if (more) { a_load(ra, arow, (kt + 1) * 64); a_load(rb, wrow, (kt + 1) * 64); }
#pragma unroll SUNROLL
        for (int s = 0; s < 4; ++s) {
            bf16x8 xa[2], wb[2];
#pragma unroll
            for (int i = 0; i < 2; ++i) xa[i] = *(const bf16x8*)(cur + lds_off(wr * 64 + i * 32 + fr, 2 * s + fh));
#pragma unroll
            for (int j = 0; j < 2; ++j) wb[j] = *(const bf16x8*)(cur + 16384 + lds_off(wc * 64 + j * 32 + fr, 2 * s + fh));
#pragma unroll
            for (int i = 0; i < 2; ++i)
#pragma unroll
                for (int j = 0; j < 2; ++j) acc[i][j] = __builtin_amdgcn_mfma_f32_32x32x16_bf16(wb[j], xa[i], acc[i][j], 0, 0, 0);
        }
        if (more) { a_store<SUMSQ>(ra, nxt, tid, ss); a_store<false>(rb, nxt + 16384, tid, dummy); }
        __syncthreads();
    }
}
constexpr int GST = 16384;
__device__ __forceinline__ int gl_chunk(int tid) { return (tid & 3) ^ ((tid >> 4) & 3); }
__device__ __forceinline__ int gl_off(int row, int chunk) { return row * 64 + ((chunk ^ ((row >> 2) & 3)) << 4); }
typedef __attribute__((address_space(3))) unsigned lds_u32_t;
__device__ __forceinline__ void glds16(const bf16_t* g, char* l) {
    __builtin_amdgcn_global_load_lds((const unsigned*)g, (lds_u32_t*)l, 16, 0, 0);
}
#define RAW_BARRIER() do { asm volatile("s_waitcnt lgkmcnt(0)" ::: "memory"); __builtin_amdgcn_s_barrier(); } while (0)
__device__ __forceinline__ void gemm_mainloop_g(f32x16 (&acc)[2][2], const bf16_t* const (&arow)[2], const bf16_t* const (&wrow)[2], const int nkt, char* lds, const int tid) {
    const int lane = tid & 63, wid = tid >> 6, wr = wid >> 1, wc = wid & 1, fr = lane & 31, fh = lane >> 5;
    const int wbase = __builtin_amdgcn_readfirstlane(wid) * 1024;
    asm volatile("s_waitcnt vmcnt(0)" ::: "memory");
#pragma unroll 1
    for (int p = 0; p < 3; ++p) if (p < nkt) {
        char* st = lds + p * GST + wbase;
        glds16(arow[0] + p * 32, st); glds16(arow[1] + p * 32, st + 4096);
        glds16(wrow[0] + p * 32, st + 8192); glds16(wrow[1] + p * 32, st + 8192 + 4096);
    }
    const int ra0 = gl_off(wr * 64 + fr, fh), ra1 = gl_off(wr * 64 + 32 + fr, fh);
    const int rb0 = 8192 + gl_off(wc * 64 + fr, fh), rb1 = 8192 + gl_off(wc * 64 + 32 + fr, fh);
#pragma unroll 1
    for (int kt = 0; kt < nkt; ++kt) {
        if (kt + 2 < nkt) asm volatile("s_waitcnt vmcnt(8)" ::: "memory");
        else if (kt + 1 < nkt) asm volatile("s_waitcnt vmcnt(4)" ::: "memory");
        else asm volatile("s_waitcnt vmcnt(0)" ::: "memory");
        RAW_BARRIER();
        if (kt + 3 < nkt) {
            char* st = lds + ((kt + 3) & 3) * GST + wbase;
            const int ko = (kt + 3) * 32;
            glds16(arow[0] + ko, st); glds16(arow[1] + ko, st + 4096);
            glds16(wrow[0] + ko, st + 8192); glds16(wrow[1] + ko, st + 8192 + 4096);
        }
        const char* cur = lds + (kt & 3) * GST;
        bf16x8 xa[2][2], wb[2][2];
#pragma unroll
        for (int s2 = 0; s2 < 2; ++s2) {
            xa[s2][0] = *(const bf16x8*)(cur + (ra0 ^ (s2 << 5))); xa[s2][1] = *(const bf16x8*)(cur + (ra1 ^ (s2 << 5)));
            wb[s2][0] = *(const bf16x8*)(cur + (rb0 ^ (s2 << 5))); wb[s2][1] = *(const bf16x8*)(cur + (rb1 ^ (s2 << 5)));
        }
        __builtin_amdgcn_sched_barrier(0);
#pragma unroll
        for (int s2 = 0; s2 < 2; ++s2) {
            acc[0][0] = __builtin_amdgcn_mfma_f32_32x32x16_bf16(wb[s2][0], xa[s2][0], acc[0][0], 0, 0, 0);
            acc[0][1] = __builtin_amdgcn_mfma_f32_32x32x16_bf16(wb[s2][1], xa[s2][0], acc[0][1], 0, 0, 0);
            acc[1][0] = __builtin_amdgcn_mfma_f32_32x32x16_bf16(wb[s2][0], xa[s2][1], acc[1][0], 0, 0, 0);
            acc[1][1] = __builtin_amdgcn_mfma_f32_32x32x16_bf16(wb[s2][1], xa[s2][1], acc[1][1], 0, 0, 0);
        }
    }
    RAW_BARRIER();
}
__device__ __forceinline__ int g64_chunk(int tid) { return (tid & 7) ^ ((tid >> 4) & 7); }
__device__ __forceinline__ void gemm_mainloop_g64(f32x16 (&acc)[2][2], const bf16_t* const (&arow)[4], const bf16_t* const (&wrow)[4], const int nkt, char* lds, const int tid) {
    const int lane = tid & 63, wid = tid >> 6, wr = wid >> 1, wc = wid & 1, fr = lane & 31, fh = lane >> 5;
    const int wbase = __builtin_amdgcn_readfirstlane(wid) * 1024;
    asm volatile("s_waitcnt vmcnt(0)" ::: "memory");
    {
        char* st = lds + wbase;
#pragma unroll
        for (int i = 0; i < 4; ++i) { glds16(arow[i], st + i * 4096); glds16(wrow[i], st + 16384 + i * 4096); }
    }
#pragma unroll 1
    for (int kt = 0; kt < nkt; ++kt) {
        asm volatile("s_waitcnt vmcnt(0)" ::: "memory");
        RAW_BARRIER();
        if (kt + 1 < nkt) {
            char* st = lds + ((kt + 1) & 1) * 32768 + wbase;
            const int ko = (kt + 1) * 64;
#pragma unroll
            for (int i = 0; i < 4; ++i) { glds16(arow[i] + ko, st + i * 4096); glds16(wrow[i] + ko, st + 16384 + i * 4096); }
        }
        const char* cur = lds + (kt & 1) * 32768;
#pragma unroll
        for (int s = 0; s < 4; ++s) {
            bf16x8 xa[2], wb[2];
#pragma unroll
            for (int i = 0; i < 2; ++i) xa[i] = *(const bf16x8*)(cur + lds_off(wr * 64 + i * 32 + fr, 2 * s + fh));
#pragma unroll
            for (int j = 0; j < 2; ++j) wb[j] = *(const bf16x8*)(cur + 16384 + lds_off(wc * 64 + j * 32 + fr, 2 * s + fh));
#pragma unroll
            for (int i = 0; i < 2; ++i)
#pragma unroll
                for (int j = 0; j < 2; ++j) acc[i][j] = __builtin_amdgcn_mfma_f32_32x32x16_bf16(wb[j], xa[i], acc[i][j], 0, 0, 0);
        }
    }
    RAW_BARRIER();
}
__device__ __forceinline__ void acc_zero(f32x16 (&acc)[2][2]) {
#pragma unroll
    for (int i = 0; i < 2; ++i)
#pragma unroll
        for (int j = 0; j < 2; ++j)
#pragma unroll
            for (int r = 0; r < 16; ++r) acc[i][j][r] = 0.f;
}
__device__ __forceinline__ void publish_rowstat(float (&ss)[4], float* stat, float invK, bool as_rstd, const int tid) {
#pragma unroll
    for (int i = 0; i < 4; ++i) {
        float v = ss[i];
        v += __shfl_xor(v, 1); v += __shfl_xor(v, 2); v += __shfl_xor(v, 4);
        if ((tid & 7) == 0) stat[(tid >> 3) + 32 * i] = as_rstd ? rsqrtf(v * invK + EPS) : v;
    }
    __syncthreads();
}
__device__ __forceinline__ int nidx(int r, int fh) { return (r & 3) + 8 * (r >> 2) + 4 * fh; }
__device__ __forceinline__ uint4 pack8(const float4& a, const float4& b) { uint4 pk; pk.x = pack2(a.x, a.y); pk.y = pack2(a.z, a.w); pk.z = pack2(b.x, b.y); pk.w = pack2(b.z, b.w); return pk; }
__device__ __forceinline__ float sq8(const float4& a, const float4& b) { return (a.x * a.x + a.y * a.y) + (a.z * a.z + a.w * a.w) + (b.x * b.x + b.y * b.y) + (b.z * b.z + b.w * b.w); }
__device__ __forceinline__ float4 mul4(const float4& a, float s) { return make_float4(a.x * s, a.y * s, a.z * s, a.w * s); }
__device__ __forceinline__ void store4(bf16_t* p, float a, float b, float c, float d) {
    uint2 v; v.x = pack2(a, b); v.y = pack2(c, d); *(uint2*)p = v;
}

__device__ __forceinline__ bool xcd_item(int it, int MT, int NTl, int& mt, int& nt) {
    const int x = blockIdx.x & 7, lb = blockIdx.x >> 3, nlb = gridDim.x >> 3;
    const int li = it * nlb + lb, per = (MT >> 3) * NTl;
    if (li >= per) return false;
    mt = (li / NTl) * 8 + x; nt = li % NTl; return true;
}

constexpr int TLD = 132;
constexpr int STAT_OFF = 128 * TLD * 4;
constexpr int LDS_GEMM_BYTES = STAT_OFF + 2048;
__device__ __forceinline__ void acc_to_lds(const f32x16 (&acc)[2][2], float* T, const int tid) {
    const int lane = tid & 63, wid = tid >> 6, wr = wid >> 1, wc = wid & 1, fr = lane & 31, fh = lane >> 5;
#pragma unroll
    for (int i = 0; i < 2; ++i)
#pragma unroll
        for (int j = 0; j < 2; ++j)
#pragma unroll
            for (int g = 0; g < 4; ++g) {
                float4 v; v.x = acc[i][j][4 * g]; v.y = acc[i][j][4 * g + 1]; v.z = acc[i][j][4 * g + 2]; v.w = acc[i][j][4 * g + 3];
                *(float4*)(T + (wr * 64 + i * 32 + fr) * TLD + wc * 64 + j * 32 + 8 * g + 4 * fh) = v;
            }
    __syncthreads();
}
__device__ __forceinline__ float rstd8(const float* p, float invK) {
    const float4 a = *(const float4*)p, b = *(const float4*)(p + 4);
    return rsq_(((a.x + a.y) + (a.z + a.w) + (b.x + b.y) + (b.z + b.w)) * invK + EPS);
}

}
namespace fx {

__device__ void phase_zgemm(const Params& P, int L, char* lds, const bool same = false) {
    const WS& w = P.w; const nv::Inputs& in = P.in;
    const int tid0 = opaque_tid();
    float* T = (float*)lds; float* stat = (float*)(lds + STAT_OFF);
    const bf16_t* Wt = w.W1t + L * W1_SZ;
    int mt, nt;
    for (int it = 0; xcd_item(it, 128, 12, mt, nt); ++it) {
        int tid = tid0; asm volatile("" : "+v"(tid));
        const int lane = tid & 63, wid = tid >> 6;
        const int m0 = mt * 128, n0 = nt * 128;
        {
            const bf16_t* arow[4]; const bf16_t* wrow[4];
#pragma unroll
            for (int i = 0; i < 4; ++i) {
                arow[i] = w.hb + (size_t)(m0 + (tid >> 3) + 32 * i) * 1024 + g64_chunk(tid) * 8;
                wrow[i] = Wt + (size_t)(n0 + (tid >> 3) + 32 * i) * 1024 + g64_chunk(tid) * 8;
            }
            f32x16 acc[2][2]; acc_zero(acc);
            float my_rs = 0.f;
            if (tid < 128) my_rs = rstd8(w.rssA + (size_t)(m0 + tid) * 8, 1.f / 1024.f);
            gemm_mainloop_g64(acc, arow, wrow, 16, lds, tid);
            if (tid < 128) stat[tid] = my_rs;
            acc_to_lds(acc, T, tid);
        }
        const int sub = lane >> 4, l16 = lane & 15, c8 = l16 * 8;
        if (nt < 2) {
#pragma unroll 8
            for (int rr = 0; rr < 8; ++rr) {
                const int row = wid * 32 + rr * 4 + sub; const float rs = stat[row];
                float4 x0 = *(const float4*)(T + row * TLD + c8), x1 = *(const float4*)(T + row * TLD + c8 + 4);
                x0.x = gelu_tanh_(x0.x * rs); x0.y = gelu_tanh_(x0.y * rs); x0.z = gelu_tanh_(x0.z * rs); x0.w = gelu_tanh_(x0.w * rs);
                x1.x = gelu_tanh_(x1.x * rs); x1.y = gelu_tanh_(x1.y * rs); x1.z = gelu_tanh_(x1.z * rs); x1.w = gelu_tanh_(x1.w * rs);
                *(uint4*)(w.ub + (size_t)(m0 + row) * 256 + nt * 128 + c8) = pack8(x0, x1);
            }
        } else if (nt < 4) {
            const int hd = (nt - 2) * 2 + (l16 >> 3), d0 = (l16 & 7) * 8;
            const float4 g0 = *(const float4*)(in.sgu_ln_g + L * 256 + hd * 64 + d0), g1 = *(const float4*)(in.sgu_ln_g + L * 256 + hd * 64 + d0 + 4);
            const float4 b0 = *(const float4*)(in.sgu_ln_b + L * 256 + hd * 64 + d0), b1 = *(const float4*)(in.sgu_ln_b + L * 256 + hd * 64 + d0 + 4);
#pragma unroll 4
            for (int rr = 0; rr < 8; ++rr) {
                const int row = wid * 32 + rr * 4 + sub; const float rs = stat[row];
                float4 x0 = *(const float4*)(T + row * TLD + c8), x1 = *(const float4*)(T + row * TLD + c8 + 4);
                x0.x = gelu_tanh_(x0.x * rs); x0.y = gelu_tanh_(x0.y * rs); x0.z = gelu_tanh_(x0.z * rs); x0.w = gelu_tanh_(x0.w * rs);
                x1.x = gelu_tanh_(x1.x * rs); x1.y = gelu_tanh_(x1.y * rs); x1.z = gelu_tanh_(x1.z * rs); x1.w = gelu_tanh_(x1.w * rs);
                const float mean = grp_sum8((x0.x + x0.y) + (x0.z + x0.w) + (x1.x + x1.y) + (x1.z + x1.w)) * (1.f / 64.f);
                x0.x -= mean; x0.y -= mean; x0.z -= mean; x0.w -= mean; x1.x -= mean; x1.y -= mean; x1.z -= mean; x1.w -= mean;
                const float rv = rsq_(grp_sum8(sq8(x0, x1)) * (1.f / 64.f) + EPS);
                x0.x = x0.x * rv * g0.x + b0.x; x0.y = x0.y * rv * g0.y + b0.y; x0.z = x0.z * rv * g0.z + b0.z; x0.w = x0.w * rv * g0.w + b0.w;
                x1.x = x1.x * rv * g1.x + b1.x; x1.y = x1.y * rv * g1.y + b1.y; x1.z = x1.z * rv * g1.z + b1.z; x1.w = x1.w * rv * g1.w + b1.w;
                *(float4*)(T + row * TLD + c8) = x0; *(float4*)(T + row * TLD + c8 + 4) = x1;
            }
            __syncthreads();
            {
                const int c = tid & 127, th = tid >> 7, hd2 = (nt - 2) * 2 + (c >> 6), d = c & 63;
                bf16_t* dst = w.vT + ((size_t)(mt * 4 + hd2) * 64 + d) * 128 + th * 64;
#pragma unroll 2
                for (int k8 = 0; k8 < 8; ++k8) {
                    float v[8];
#pragma unroll
                    for (int k = 0; k < 8; ++k) v[k] = T[(th * 64 + k8 * 8 + k) * TLD + c];
                    uint4 pk; pk.x = pack2(v[0], v[1]); pk.y = pack2(v[2], v[3]); pk.z = pack2(v[4], v[5]); pk.w = pack2(v[6], v[7]);
                    *(uint4*)(dst + k8 * 8) = pk;
                }
            }
        } else if (nt < 8) {
#pragma unroll 8
            for (int rr = 0; rr < 8; ++rr) {
                const int row = wid * 32 + rr * 4 + sub; const float rs = stat[row];
                const float4 x0 = *(const float4*)(T + row * TLD + c8), x1 = *(const float4*)(T + row * TLD + c8 + 4);
                store4(w.ygb + (size_t)(m0 + row) * 256 + (nt - 4) * 64 + l16 * 4, x0.x * rs * sigmoid_(x0.y * rs), x0.z * rs * sigmoid_(x0.w * rs),
                       x1.x * rs * sigmoid_(x1.y * rs), x1.z * rs * sigmoid_(x1.w * rs));
            }
        } else if (nt < 11) {
            bf16_t* base; int ld, cb;
            if (nt < 10) { base = w.cqb; ld = 256; cb = (nt - 8) * 128; } else { base = w.ckvb; ld = 128; cb = 0; }
#pragma unroll 8
            for (int rr = 0; rr < 8; ++rr) {
                const int row = wid * 32 + rr * 4 + sub; const float rs = stat[row];
                const float4 x0 = mul4(*(const float4*)(T + row * TLD + c8), rs), x1 = mul4(*(const float4*)(T + row * TLD + c8 + 4), rs);
                *(uint4*)(base + (size_t)(m0 + row) * ld + cb + c8) = pack8(x0, x1);
                const float sq = grp_sum16(sq8(x0, x1));
                if (l16 == 0) w.cqss[(size_t)(m0 + row) * 4 + (nt - 8)] = sq;
            }
        } else {
            const int lq = l16 & 3, dd = lq * 8, jj = (lq & 1) * 8;
            const float4 kg0 = *(const float4*)(in.k_norm_g + L * 96 + 64 + dd), kg1 = *(const float4*)(in.k_norm_g + L * 96 + 64 + dd + 4);
#pragma unroll 8
            for (int rr = 0; rr < 8; ++rr) {
                const int row = wid * 32 + rr * 4 + sub; const float rs = stat[row]; const int tok = m0 + row;
                float4 x0 = mul4(*(const float4*)(T + row * TLD + dd), rs), x1 = mul4(*(const float4*)(T + row * TLD + dd + 4), rs);
                const float rn = rsq_(grp_sum4(sq8(x0, x1)) * (1.f / 32.f) + EPS);
                x0.x *= rn * kg0.x; x0.y *= rn * kg0.y; x0.z *= rn * kg0.z; x0.w *= rn * kg0.w;
                x1.x *= rn * kg1.x; x1.y *= rn * kg1.y; x1.z *= rn * kg1.z; x1.w *= rn * kg1.w;
                const float4 o0 = make_float4(quad_x2(x0.x), quad_x2(x0.y), quad_x2(x0.z), quad_x2(x0.w)), o1 = make_float4(quad_x2(x1.x), quad_x2(x1.y), quad_x2(x1.z), quad_x2(x1.w));
                const float* csr = w.cs + (size_t)tok * 32 + jj;
                const float4 c0 = *(const float4*)csr, c1 = *(const float4*)(csr + 4), s0 = *(const float4*)(csr + 16), s1 = *(const float4*)(csr + 20);
                const float sg = (lq & 2) ? 1.f : -1.f;
                float4 r0, r1;
                r0.x = x0.x * c0.x + sg * o0.x * s0.x; r0.y = x0.y * c0.y + sg * o0.y * s0.y; r0.z = x0.z * c0.z + sg * o0.z * s0.z; r0.w = x0.w * c0.w + sg * o0.w * s0.w;
                r1.x = x1.x * c1.x + sg * o1.x * s1.x; r1.y = x1.y * c1.y + sg * o1.y * s1.y; r1.z = x1.z * c1.z + sg * o1.z * s1.z; r1.w = x1.w * c1.w + sg * o1.w * s1.w;
                if (l16 < 4) *(uint4*)(w.kpeb + (size_t)tok * 32 + dd) = pack8(r0, r1);
            }
        }
        __syncthreads();
    }
}

__global__ void k_shim_z(Params P, int t0) {
    const WS& w = P.w;
    size_t idx = (size_t)blockIdx.x * blockDim.x + threadIdx.x;
    if (idx >= (size_t)2048 * 1440) return;
    int t = t0 + (int)(idx / 1440), c = (int)(idx % 1440);
    float v = 0.f;
    if (c < 256) v = bf2f(w.ub[(size_t)t * 256 + c]);
    else if (c < 512) { int cc = c - 256; v = bf2f(w.vT[((size_t)((t >> 7) * 4 + (cc >> 6)) * 64 + (cc & 63)) * 128 + (t & 127)]); }
    else if (c < 768) v = bf2f(w.ygb[(size_t)t * 256 + c - 512]);
    else if (c < 1024) v = 0.f;
    else if (c < 1280) v = bf2f(w.cqb[(size_t)t * 256 + c - 1024]);
    else if (c < 1408) v = bf2f(w.ckvb[(size_t)t * 128 + c - 1280]);
    else v = bf2f(w.kpeb[(size_t)t * 32 + c - 1408]);
    P.zf[idx] = v;
}
__global__ void k_shim_hb(Params P) {
    size_t i = (size_t)blockIdx.x * blockDim.x + threadIdx.x;
    if (i >= (size_t)NT * 1024 / 4) return;
    float4 v = ((const float4*)P.h)[i];
    uint2 pk; pk.x = pack2(v.x, v.y); pk.y = pack2(v.z, v.w);
    ((uint2*)P.w.hb)[i] = pk;
}

}
namespace fx {

constexpr float QSCALE = 0.10206207261596575f * 1.4426950408889634f;

__device__ void qkv_item(const Params& P, int L, const bool isq, const int mt, const int nt, char* lds, const int tid_in) {
    int tid = tid_in; asm volatile("" : "+v"(tid));
    const WS& w = P.w; const nv::Inputs& in = P.in;
    const int lane = tid & 63, wid = tid >> 6;
    float* T = (float*)lds; float* stat = (float*)(lds + STAT_OFF);
    const int m0 = mt * 128, n0 = nt * 128;
    const int K = isq ? 256 : 128;
    {
        const bf16_t* A = isq ? w.cqb : w.ckvb;
        const bf16_t* Wt = isq ? (w.Wuqt + L * WUQ_SZ) : (w.Wukvt + L * WUKV_SZ);
        const bf16_t* arow[2]; const bf16_t* wrow[2];
#pragma unroll
        for (int i = 0; i < 2; ++i) {
            arow[i] = A + (size_t)(m0 + (tid >> 2) + 64 * i) * K + gl_chunk(tid) * 8;
            wrow[i] = Wt + (size_t)(n0 + (tid >> 2) + 64 * i) * K + gl_chunk(tid) * 8;
        }
        f32x16 acc[2][2]; acc_zero(acc);
        float my_rs = 0.f;
        if (tid < 128) {
            const float4 c = *(const float4*)(w.cqss + (size_t)(m0 + tid) * 4);
            my_rs = isq ? rsq_((c.x + c.y) * (1.f / 256.f) + EPS) : rsq_(c.z * (1.f / 128.f) + EPS);
        }
        gemm_mainloop_g(acc, arow, wrow, K / 32, lds, tid);
        if (tid < 128) stat[tid] = my_rs;
        acc_to_lds(acc, T, tid);
    }
    const int b = m0 >> 11, s0 = m0 & 2047;
    const int sub = lane >> 4, l16 = lane & 15, c8 = l16 * 8;
    if (isq && nt < 4) {
        const int hd = nt * 2 + (l16 >> 3), d = (l16 & 7) * 8;
        const float4 g0 = mul4(*(const float4*)(in.q_norm_g + L * 96 + d), QSCALE), g1 = mul4(*(const float4*)(in.q_norm_g + L * 96 + d + 4), QSCALE);
        bf16_t* dst = w.Qb + ((size_t)(b * 8 + hd) * 2048 + s0) * 96 + d;
#pragma unroll 8
        for (int rr = 0; rr < 8; ++rr) {
            const int row = wid * 32 + rr * 4 + sub; const float rs = stat[row];
            float4 x0 = mul4(*(const float4*)(T + row * TLD + c8), rs), x1 = mul4(*(const float4*)(T + row * TLD + c8 + 4), rs);
            const float rn = rsq_(grp_sum8(sq8(x0, x1)) * (1.f / 64.f) + EPS);
            x0.x *= rn * g0.x; x0.y *= rn * g0.y; x0.z *= rn * g0.z; x0.w *= rn * g0.w; x1.x *= rn * g1.x; x1.y *= rn * g1.y; x1.z *= rn * g1.z; x1.w *= rn * g1.w;
            *(uint4*)(dst + (size_t)row * 96) = pack8(x0, x1);
        }
    } else if (isq) {
        const int hd = (nt - 4) * 4 + (l16 >> 2), lq = l16 & 3, dd = lq * 8, jj = (lq & 1) * 8;
        const float4 g0 = *(const float4*)(in.q_norm_g + L * 96 + 64 + dd), g1 = *(const float4*)(in.q_norm_g + L * 96 + 64 + dd + 4);
        bf16_t* dst = w.Qb + ((size_t)(b * 8 + hd) * 2048 + s0) * 96 + 64 + dd;
        const float sg = (lq & 2) ? QSCALE : -QSCALE;
#pragma unroll 8
        for (int rr = 0; rr < 8; ++rr) {
            const int row = wid * 32 + rr * 4 + sub; const float rs = stat[row]; const int tok = m0 + row;
            float4 x0 = mul4(*(const float4*)(T + row * TLD + c8), rs), x1 = mul4(*(const float4*)(T + row * TLD + c8 + 4), rs);
            const float rn = rsq_(grp_sum4(sq8(x0, x1)) * (1.f / 32.f) + EPS);
            x0.x *= rn * g0.x; x0.y *= rn * g0.y; x0.z *= rn * g0.z; x0.w *= rn * g0.w; x1.x *= rn * g1.x; x1.y *= rn * g1.y; x1.z *= rn * g1.z; x1.w *= rn * g1.w;
            const float4 o0 = make_float4(quad_x2(x0.x), quad_x2(x0.y), quad_x2(x0.z), quad_x2(x0.w)), o1 = make_float4(quad_x2(x1.x), quad_x2(x1.y), quad_x2(x1.z), quad_x2(x1.w));
            const float* csr = w.cs + (size_t)tok * 32 + jj;
            const float4 c0 = mul4(*(const float4*)csr, QSCALE), c1 = mul4(*(const float4*)(csr + 4), QSCALE), s0v = *(const float4*)(csr + 16), s1v = *(const float4*)(csr + 20);
            float4 r0, r1;
            r0.x = x0.x * c0.x + sg * o0.x * s0v.x; r0.y = x0.y * c0.y + sg * o0.y * s0v.y; r0.z = x0.z * c0.z + sg * o0.z * s0v.z; r0.w = x0.w * c0.w + sg * o0.w * s0v.w;
            r1.x = x1.x * c1.x + sg * o1.x * s1v.x; r1.y = x1.y * c1.y + sg * o1.y * s1v.y; r1.z = x1.z * c1.z + sg * o1.z * s1v.z; r1.w = x1.w * c1.w + sg * o1.w * s1v.w;
            *(uint4*)(dst + (size_t)row * 96) = pack8(r0, r1);
        }
    } else if (nt < 4) {
        const int hd = nt * 2 + (l16 >> 3), d = (l16 & 7) * 8;
        const float4 g0 = *(const float4*)(in.k_norm_g + L * 96 + d), g1 = *(const float4*)(in.k_norm_g + L * 96 + d + 4);
        bf16_t* dst = w.Knb + ((size_t)(b * 8 + hd) * 2048 + s0) * 64 + d;
#pragma unroll 8
        for (int rr = 0; rr < 8; ++rr) {
            const int row = wid * 32 + rr * 4 + sub; const float rs = stat[row];
            float4 x0 = mul4(*(const float4*)(T + row * TLD + c8), rs), x1 = mul4(*(const float4*)(T + row * TLD + c8 + 4), rs);
            const float rn = rsq_(grp_sum8(sq8(x0, x1)) * (1.f / 64.f) + EPS);
            x0.x *= rn * g0.x; x0.y *= rn * g0.y; x0.z *= rn * g0.z; x0.w *= rn * g0.w; x1.x *= rn * g1.x; x1.y *= rn * g1.y; x1.z *= rn * g1.z; x1.w *= rn * g1.w;
            *(uint4*)(dst + (size_t)row * 64) = pack8(x0, x1);
        }
    } else {
        const int c = tid & 127, th = tid >> 7, hd = (nt - 4) * 2 + (c >> 6), d = c & 63;
        bf16_t* dst = w.VTb + ((size_t)(b * 8 + hd) * 64 + d) * 2048 + s0 + th * 64;
#pragma unroll 2
        for (int k8 = 0; k8 < 8; ++k8) {
            float v[8];
#pragma unroll
            for (int k = 0; k < 8; ++k) { const int row = th * 64 + k8 * 8 + k; v[k] = T[row * TLD + c] * stat[row]; }
            uint4 pk; pk.x = pack2(v[0], v[1]); pk.y = pack2(v[2], v[3]); pk.z = pack2(v[4], v[5]); pk.w = pack2(v[6], v[7]);
            *(uint4*)(dst + k8 * 8) = pk;
        }
    }
    __syncthreads();
}

__device__ void sgu_item(const Params& P, int L, int mt, char* lds, const int tid_in) {
    int tid = tid_in; asm volatile("" : "+v"(tid));
    const WS& w = P.w; const nv::Inputs& in = P.in;
    const int lane = tid & 63, hd = tid >> 6, fr = lane & 31, fh = lane >> 5;
    float* red = (float*)lds;
    const bf16_t* vt = w.vT + (size_t)(mt * 4 + hd) * 64 * 128;
    const bf16_t* ws = w.Wsm + L * WSM_SZ + (size_t)hd * 128 * 128;
    const float* bs = in.sgu_b + L * 512 + hd * 128;
    const int m0 = mt * 128;
#pragma unroll 1
    for (int it = 0; it < 4; ++it) {
        f32x16 a0, a1;
#pragma unroll
        for (int r = 0; r < 16; ++r) { a0[r] = 0.f; a1[r] = 0.f; }
        const int nks = 2 * (it + 1);
        const bf16_t* bp = ws + (size_t)(it * 32 + fr) * 128 + 8 * fh;
        const bf16_t* ap0 = vt + (size_t)fr * 128 + 8 * fh;
        const bf16_t* ap1 = vt + (size_t)(32 + fr) * 128 + 8 * fh;
#pragma unroll 2
        for (int s = 0; s < nks; ++s) {
            const bf16x8 bfrag = *(const bf16x8*)(bp + 16 * s);
            const bf16x8 af0 = *(const bf16x8*)(ap0 + 16 * s), af1 = *(const bf16x8*)(ap1 + 16 * s);
            a0 = __builtin_amdgcn_mfma_f32_32x32x16_bf16(af0, bfrag, a0, 0, 0, 0);
            a1 = __builtin_amdgcn_mfma_f32_32x32x16_bf16(af1, bfrag, a1, 0, 0, 0);
        }
        const int i = it * 32 + fr, tok = m0 + i;
        const float bias = bs[i];
        float ssq = 0.f;
#pragma unroll
        for (int dt = 0; dt < 2; ++dt)
#pragma unroll
            for (int g = 0; g < 4; ++g) {
                const int d = dt * 32 + 8 * g + 4 * fh;
                const uint2 uu = *(const uint2*)(w.ub + (size_t)tok * 256 + hd * 64 + d);
                float o[4];
#pragma unroll
                for (int q = 0; q < 4; ++q) {
                    const float sv = (dt == 0 ? a0[4 * g + q] : a1[4 * g + q]) + bias;
                    const float uv = (q == 0) ? bflo(uu.x) : (q == 1) ? bfhi(uu.x) : (q == 2) ? bflo(uu.y) : bfhi(uu.y);
                    o[q] = uv * sv; ssq += o[q] * o[q];
                }
                store4(w.yb + (size_t)tok * 1024 + hd * 64 + d, o[0], o[1], o[2], o[3]);
            }
        ssq = xor32(ssq);
        if (fh == 0) red[hd * 128 + i] = ssq;
    }
    __syncthreads();
    if (tid < 128) w.ssq[(size_t)(m0 + tid) * 16 + 0] = red[tid] + red[128 + tid] + red[256 + tid] + red[384 + tid];
    __syncthreads();
}

constexpr int CLD = 260, CONV_YL = 32 * CLD * 4, CONV_ST = CONV_YL + 32 * 512, CONV_RED = CONV_ST + 32 * 4 * 8;
__device__ __forceinline__ int yl_off(int row, int chunk) { return row * 512 + ((chunk ^ (row & 15)) << 4); }
__device__ void conv_item(const Params& P, int L, int ct, char* lds, const int tid_in) {
    int tid = tid_in; asm volatile("" : "+v"(tid));
    const WS& w = P.w; const nv::Inputs& in = P.in;
    const int lane = tid & 63, wid = tid >> 6, fr = lane & 31, fh = lane >> 5;
    float* C = (float*)lds; char* yl = lds + CONV_YL; float2* stats = (float2*)(lds + CONV_ST); float* red = (float*)(lds + CONV_RED);
    const int t0 = ct * 32, s0 = t0 & 2047;
    {
        const int c = tid;
        float x[62];
#pragma unroll
        for (int r = 0; r < 62; ++r) x[r] = (s0 + r - 30 >= 0) ? bf2f(w.ygb[(size_t)(t0 + r - 30) * 256 + c]) : 0.f;
        float wk[31];
#pragma unroll
        for (int k = 0; k < 31; ++k) wk[k] = in.conv_w[(size_t)L * 31 * 256 + k * 256 + c];
        const float cb = in.conv_b[L * 256 + c];
#pragma unroll
        for (int t = 0; t < 32; ++t) {
            float a = cb;
#pragma unroll
            for (int k = 0; k < 31; ++k) a = fmaf(wk[k], x[t + k], a);
            C[t * CLD + c] = a;
        }
    }
    __syncthreads();
    if (tid < 128) {
        const int t = tid >> 2, g = tid & 3;
        const float4* cp = (const float4*)(C + t * CLD + g * 64);
        float4 v[16]; float s = 0.f;
#pragma unroll
        for (int i = 0; i < 16; ++i) { v[i] = cp[i]; s += (v[i].x + v[i].y) + (v[i].z + v[i].w); }
        const float mean = s * (1.f / 64.f); float q = 0.f;
#pragma unroll
        for (int i = 0; i < 16; ++i) { const float a = v[i].x - mean, b2 = v[i].y - mean, c2 = v[i].z - mean, d2 = v[i].w - mean; q += (a * a + b2 * b2) + (c2 * c2 + d2 * d2); }
        stats[t * 4 + g] = make_float2(mean, rsq_(q * (1.f / 64.f) + EPS));
    }
    __syncthreads();
    {
        const int c = tid, g = c >> 6;
        const float lg = in.conv_ln_g[L * 256 + c], lb = in.conv_ln_b[L * 256 + c];
#pragma unroll 8
        for (int t = 0; t < 32; ++t) {
            const float2 st = stats[t * 4 + g];
            const float v = (C[t * CLD + c] - st.x) * st.y * lg + lb;
            *(bf16_t*)(yl + yl_off(t, c >> 3) + (c & 7) * 2) = (bf16_t)f2bf(v * sigmoid_(v));
        }
    }
    __syncthreads();
    f32x16 acc0, acc1;
#pragma unroll
    for (int r = 0; r < 16; ++r) { acc0[r] = 0.f; acc1[r] = 0.f; }
    const bf16_t* wp = w.Wpwt + L * WPW_SZ + (size_t)(wid * 64 + fr) * 256 + 8 * fh;
#pragma unroll 4
    for (int s = 0; s < 16; ++s) {
        const bf16x8 w0 = *(const bf16x8*)(wp + 16 * s), w1 = *(const bf16x8*)(wp + 32 * 256 + 16 * s);
        const bf16x8 x0 = *(const bf16x8*)(yl + yl_off(fr, 2 * s + fh));
        acc0 = __builtin_amdgcn_mfma_f32_32x32x16_bf16(w0, x0, acc0, 0, 0, 0);
        acc1 = __builtin_amdgcn_mfma_f32_32x32x16_bf16(w1, x0, acc1, 0, 0, 0);
    }
    const float* pb = in.conv_pw_b + L * 256;
    {
        const int tok = t0 + fr;
        float ssq = 0.f;
#pragma unroll
        for (int jn = 0; jn < 2; ++jn)
#pragma unroll
            for (int g = 0; g < 4; ++g) {
                const int n = wid * 64 + jn * 32 + 8 * g + 4 * fh;
                const float4 b4 = *(const float4*)(pb + n);
                const float o0 = (jn ? acc1[4 * g] : acc0[4 * g]) + b4.x, o1 = (jn ? acc1[4 * g + 1] : acc0[4 * g + 1]) + b4.y;
                const float o2 = (jn ? acc1[4 * g + 2] : acc0[4 * g + 2]) + b4.z, o3 = (jn ? acc1[4 * g + 3] : acc0[4 * g + 3]) + b4.w;
                ssq += o0 * o0 + o1 * o1 + o2 * o2 + o3 * o3;
                store4(w.yb + (size_t)tok * 1024 + 256 + n, o0, o1, o2, o3);
            }
        ssq = xor32(ssq);
        if (fh == 0) red[wid * 32 + fr] = ssq;
    }
    __syncthreads();
    if (tid < 32) w.ssq[(size_t)(t0 + tid) * 16 + 1] = red[tid] + red[32 + tid] + red[64 + tid] + red[96 + tid];
    __syncthreads();
}

__device__ void phase_mix(const Params& P, int L, char* lds) {
    const int tid = opaque_tid();
    int mt, nt;
    for (int it = 0; xcd_item(it, 128, 6, mt, nt); ++it) qkv_item(P, L, true, mt, nt, lds, tid);
    for (int it = 0; xcd_item(it, 128, 8, mt, nt); ++it) qkv_item(P, L, false, mt, nt, lds, tid);
    for (int ct = blockIdx.x; ct < 512; ct += gridDim.x) conv_item(P, L, ct, lds, tid);
    {
        const int x = blockIdx.x & 7, lb = blockIdx.x >> 3, nlb = gridDim.x >> 3;
        const int lo = nlb >= 48 ? 32 : 0;
        for (int j = lb - lo; j >= 0 && j < 16; j += nlb) sgu_item(P, L, j * 8 + x, lds, tid);
    }
}

__global__ void k_shim_qkv(Params P, int t0, float* q, float* kv) {
    const WS& w = P.w;
    size_t idx = (size_t)blockIdx.x * blockDim.x + threadIdx.x;
    if (idx >= (size_t)2048 * 1792) return;
    const int tl = (int)(idx / 1792), c = (int)(idx % 1792), t = t0 + tl, b = t >> 11, s = t & 2047;
    if (c < 768) { const int h = c / 96, d = c % 96; q[(size_t)tl * 768 + c] = bf2f(w.Qb[((size_t)(b * 8 + h) * 2048 + s) * 96 + d]) * (1.f / QSCALE); }
    else {
        const int cc = c - 768, h = cc >> 7, d = cc & 127;
        kv[(size_t)tl * 1024 + cc] = (d < 64) ? bf2f(w.Knb[((size_t)(b * 8 + h) * 2048 + s) * 64 + d]) : bf2f(w.VTb[((size_t)(b * 8 + h) * 64 + (d - 64)) * 2048 + s]);
    }
}
__global__ void k_shim_y(Params P, int t0, int c0, int c1) {
    const int wdt = c1 - c0;
    size_t idx = (size_t)blockIdx.x * blockDim.x + threadIdx.x;
    if (idx >= (size_t)2048 * wdt) return;
    const int tl = (int)(idx / wdt), c = c0 + (int)(idx % wdt);
    P.yf[(size_t)tl * 1024 + c] = bf2f(P.w.yb[(size_t)(t0 + tl) * 1024 + c]);
}

}
namespace fx {

constexpr int KROW = 208, VROW = 136, ATT_STAGE = 64 * KROW + 64 * VROW;

struct KVRegs { uint4 k0, k1, k2, v0, v1; };
__device__ __forceinline__ uint4 k_ld(const bf16_t* Kn, const bf16_t* Kp, int k0, int c) {
    const int key = c / 12, ch = c % 12;
    const bf16_t* src = (ch < 8) ? (Kn + (size_t)(k0 + key) * 64 + ch * 8) : (Kp + (size_t)(k0 + key) * 32 + (ch - 8) * 8);
    return *(const uint4*)src;
}
__device__ __forceinline__ void kv_load(KVRegs& r, const bf16_t* Kn, const bf16_t* Kp, const bf16_t* Vt, int k0, const int tid) {
    r.k0 = k_ld(Kn, Kp, k0, tid); r.k1 = k_ld(Kn, Kp, k0, tid + 256); r.k2 = k_ld(Kn, Kp, k0, tid + 512);
    r.v0 = *(const uint4*)(Vt + (size_t)(tid >> 3) * 2048 + k0 + (tid & 7) * 8);
    r.v1 = *(const uint4*)(Vt + (size_t)(32 + (tid >> 3)) * 2048 + k0 + (tid & 7) * 8);
}
__device__ __forceinline__ void k_st(char* st, int c, const uint4& v) { const int key = c / 12, ch = c % 12; *(uint4*)(st + key * KROW + ch * 16) = v; }
__device__ __forceinline__ void v_st(char* st, int d, int ch, const uint4& v) {
    char* p = st + 64 * KROW + d * VROW + ch * 16;
    *(uint2*)p = make_uint2(v.x, v.y); *(uint2*)(p + 8) = make_uint2(v.z, v.w);
}
__device__ __forceinline__ void kv_store(const KVRegs& r, char* st, const int tid) {
    k_st(st, tid, r.k0); k_st(st, tid + 256, r.k1); k_st(st, tid + 512, r.k2);
    v_st(st, tid >> 3, tid & 7, r.v0); v_st(st, 32 + (tid >> 3), tid & 7, r.v1);
}

__device__ void attn_unit(const Params& P, int b, int h, int qt, char* lds, const int tid) {
    const WS& w = P.w;
    const int lane = tid & 63, wid = tid >> 6, fr = lane & 31, fh = lane >> 5;
    const bf16_t* Kn = w.Knb + (size_t)(b * 8 + h) * 2048 * 64;
    const bf16_t* Kp = w.kpeb + (size_t)b * 2048 * 32;
    const bf16_t* Vt = w.VTb + (size_t)(b * 8 + h) * 64 * 2048;
    const int q0 = qt * 128, qw0 = q0 + wid * 32, qpos = qw0 + fr;
    bf16x8 qf[6];
    {
        const bf16_t* qp = w.Qb + ((size_t)(b * 8 + h) * 2048 + qpos) * 96 + 8 * fh;
#pragma unroll
        for (int ks = 0; ks < 6; ++ks) qf[ks] = *(const bf16x8*)(qp + 16 * ks);
    }
    f32x16 o0, o1;
#pragma unroll
    for (int r = 0; r < 16; ++r) { o0[r] = 0.f; o1[r] = 0.f; }
    float m = -1e30f, l = 0.f;
    const int nkt = 2 * (qt + 1);
    KVRegs kr;
    kv_load(kr, Kn, Kp, Vt, 0, tid);
    kv_store(kr, lds, tid);
    __syncthreads();
#pragma unroll 1
    for (int kt = 0; kt < nkt; ++kt) {
        char* cur = lds + (kt & 1) * ATT_STAGE;
        char* nxt = lds + ((kt + 1) & 1) * ATT_STAGE;
        const bool more = kt + 1 < nkt;
        if (more) kv_load(kr, Kn, Kp, Vt, (kt + 1) * 64, tid);
        const int k0 = kt * 64;
        if (k0 <= qw0 + 31) {
            f32x16 s0, s1;
#pragma unroll
            for (int r = 0; r < 16; ++r) { s0[r] = 0.f; s1[r] = 0.f; }
            const char* kb = cur + fr * KROW + fh * 16;
#pragma unroll
            for (int ks = 0; ks < 6; ++ks) {
                const bf16x8 ka = *(const bf16x8*)(kb + ks * 32), kb2 = *(const bf16x8*)(kb + 32 * KROW + ks * 32);
                s0 = __builtin_amdgcn_mfma_f32_32x32x16_bf16(ka, qf[ks], s0, 0, 0, 0);
                s1 = __builtin_amdgcn_mfma_f32_32x32x16_bf16(kb2, qf[ks], s1, 0, 0, 0);
            }
            if (k0 + 63 > qw0) {
#pragma unroll
                for (int r = 0; r < 16; ++r) {
                    const int key = k0 + nidx(r, fh);
                    if (key > qpos) s0[r] = -1e30f;
                    if (key + 32 > qpos) s1[r] = -1e30f;
                }
            }
            float mx = s0[0];
#pragma unroll
            for (int r = 1; r < 16; ++r) mx = fmaxf(mx, s0[r]);
#pragma unroll
            for (int r = 0; r < 16; ++r) mx = fmaxf(mx, s1[r]);
            mx = swap32_max(mx);
            const float mn = fmaxf(m, mx);
            const float alpha = __builtin_amdgcn_exp2f(m - mn);
            m = mn;
            float ps = 0.f;
#pragma unroll
            for (int r = 0; r < 16; ++r) { s0[r] = __builtin_amdgcn_exp2f(s0[r] - mn); ps += s0[r]; }
#pragma unroll
            for (int r = 0; r < 16; ++r) { s1[r] = __builtin_amdgcn_exp2f(s1[r] - mn); ps += s1[r]; }
            ps = swap32_sum(ps);
            l = l * alpha + ps;
#pragma unroll
            for (int r = 0; r < 16; ++r) { o0[r] *= alpha; o1[r] *= alpha; }
            const char* vb = cur + 64 * KROW + fr * VROW + fh * 8;
#pragma unroll
            for (int ks = 0; ks < 4; ++ks) {
                bf16x8 pf;
                {
                    const int rb = 8 * (ks & 1);
                    unsigned u0, u1, u2, u3;
                    if (ks < 2) { u0 = pack2(s0[rb], s0[rb + 1]); u1 = pack2(s0[rb + 2], s0[rb + 3]); u2 = pack2(s0[rb + 4], s0[rb + 5]); u3 = pack2(s0[rb + 6], s0[rb + 7]); }
                    else { u0 = pack2(s1[rb], s1[rb + 1]); u1 = pack2(s1[rb + 2], s1[rb + 3]); u2 = pack2(s1[rb + 4], s1[rb + 5]); u3 = pack2(s1[rb + 6], s1[rb + 7]); }
                    uint4 uu = make_uint4(u0, u1, u2, u3);
                    pf = __builtin_bit_cast(bf16x8, uu);
                }
                const uint2 va0 = *(const uint2*)(vb + ks * 32), va1 = *(const uint2*)(vb + ks * 32 + 16);
                const uint2 vb0 = *(const uint2*)(vb + 32 * VROW + ks * 32), vb1 = *(const uint2*)(vb + 32 * VROW + ks * 32 + 16);
                const bf16x8 vfa = __builtin_bit_cast(bf16x8, make_uint4(va0.x, va0.y, va1.x, va1.y));
                const bf16x8 vfb = __builtin_bit_cast(bf16x8, make_uint4(vb0.x, vb0.y, vb1.x, vb1.y));
                o0 = __builtin_amdgcn_mfma_f32_32x32x16_bf16(vfa, pf, o0, 0, 0, 0);
                o1 = __builtin_amdgcn_mfma_f32_32x32x16_bf16(vfb, pf, o1, 0, 0, 0);
            }
        }
        if (more) kv_store(kr, nxt, tid);
        __syncthreads();
    }
    const float inv = 1.f / l;
    const int tok = b * 2048 + qpos;
    float ssq = 0.f;
#pragma unroll
    for (int dt = 0; dt < 2; ++dt)
#pragma unroll
        for (int g = 0; g < 4; ++g) {
            float o[4];
#pragma unroll
            for (int q = 0; q < 4; ++q) { o[q] = (dt == 0 ? o0[4 * g + q] : o1[4 * g + q]) * inv; ssq += o[q] * o[q]; }
            store4(w.yb + (size_t)tok * 1024 + 512 + h * 64 + dt * 32 + 8 * g + 4 * fh, o[0], o[1], o[2], o[3]);
        }
    ssq = xor32(ssq);
    if (fh == 0) w.ssq[(size_t)tok * 16 + 8 + h] = ssq;
}

__device__ void phase_attn(const Params& P, int L, char* lds) {
    const int tid0 = opaque_tid();
    const int h = blockIdx.x & 7, nlb = gridDim.x >> 3;
    for (int li = blockIdx.x >> 3; li < 64; li += nlb) {
        int tid = tid0; asm volatile("" : "+v"(tid));
        const int p = li & 7, b = li >> 3;
        attn_unit(P, b, h, 15 - p, lds, tid);
        attn_unit(P, b, h, p, lds, tid);
    }
}

}
namespace fx {

__device__ __forceinline__ void acc_scale(f32x16 (&acc)[2][2], const float* f, const int tid) {
    const int lane = tid & 63, wr = tid >> 7, fr = lane & 31;
#pragma unroll
    for (int i = 0; i < 2; ++i) {
        const float v = f[wr * 64 + i * 32 + fr];
#pragma unroll
        for (int j = 0; j < 2; ++j)
#pragma unroll
            for (int r = 0; r < 16; ++r) acc[i][j][r] *= v;
    }
}
__device__ void phase_oproj(const Params& P, int L, char* lds, const bool dry = false) {
    const WS& w = P.w;
    const int tid0 = opaque_tid();
    float* T = (float*)lds; float* stat = (float*)(lds + STAT_OFF);
    const bf16_t* Wt = w.Wot + L * WO_SZ;
    int mt, nt;
    for (int it = 0; xcd_item(it, 128, 8, mt, nt); ++it) {
        int tid = tid0; asm volatile("" : "+v"(tid));
        const int lane = tid & 63, wid = tid >> 6;
        const int m0 = mt * 128, n0 = nt * 128;
        float rb_keep = 0.f;
        if (tid < 128) {
            const float* sq = w.ssq + (size_t)(m0 + tid) * 16;
            const float4 c0 = *(const float4*)(sq + 8), c1 = *(const float4*)(sq + 12);
            const float ra = rsq_(sq[0] * (1.f / 256.f) + EPS), rb = rsq_(sq[1] * (1.f / 256.f) + EPS);
            const float rc = rsq_((c0.x + c0.y + c0.z + c0.w + c1.x + c1.y + c1.z + c1.w) * (1.f / 512.f) + EPS);
            stat[tid] = rc / ra; stat[128 + tid] = ra / rb; rb_keep = rb;
        }
        {
            const bf16_t* arow[2]; const bf16_t* wrow[2];
#pragma unroll
            for (int i = 0; i < 2; ++i) {
                arow[i] = w.yb + (size_t)(m0 + (tid >> 2) + 64 * i) * 1024 + gl_chunk(tid) * 8 + 512;
                wrow[i] = Wt + (size_t)(n0 + (tid >> 2) + 64 * i) * 1024 + gl_chunk(tid) * 8 + 512;
            }
            f32x16 acc[2][2]; acc_zero(acc);
            gemm_mainloop_g(acc, arow, wrow, 16, lds, tid);
            acc_scale(acc, stat, tid);
#pragma unroll
            for (int i = 0; i < 2; ++i) { arow[i] -= 512; wrow[i] -= 512; }
            gemm_mainloop_g(acc, arow, wrow, 8, lds, tid);
            acc_scale(acc, stat + 128, tid);
#pragma unroll
            for (int i = 0; i < 2; ++i) { arow[i] += 256; wrow[i] += 256; }
            gemm_mainloop_g(acc, arow, wrow, 8, lds, tid);
            if (tid < 128) stat[tid] = rb_keep;
            acc_to_lds(acc, T, tid);
        }
        {
            const int sub = lane >> 4, c8 = (lane & 15) * 8;
#pragma unroll 8
            for (int rr = 0; rr < 8; ++rr) {
                const int row = wid * 32 + rr * 4 + sub; const float rb = stat[row];
                const float4 x0 = *(const float4*)(T + row * TLD + c8), x1 = *(const float4*)(T + row * TLD + c8 + 4);
                float4* hp = (float4*)(P.h + (size_t)(m0 + row) * 1024 + n0 + c8);
                float4 h0 = hp[0], h1 = hp[1];
                h0.x += x0.x * rb; h0.y += x0.y * rb; h0.z += x0.z * rb; h0.w += x0.w * rb;
                h1.x += x1.x * rb; h1.y += x1.y * rb; h1.z += x1.z * rb; h1.w += x1.w * rb;
                if (!dry) { hp[0] = h0; hp[1] = h1; }
                uint4 pk; pk.x = pack2(h0.x, h0.y); pk.y = pack2(h0.z, h0.w); pk.z = pack2(h1.x, h1.y); pk.w = pack2(h1.z, h1.w);
                *(uint4*)(w.hb1 + (size_t)(m0 + row) * 1024 + n0 + c8) = pk;
                float sq = (h0.x * h0.x + h0.y * h0.y) + (h0.z * h0.z + h0.w * h0.w) + (h1.x * h1.x + h1.y * h1.y) + (h1.z * h1.z + h1.w * h1.w);
                sq = grp_sum16(sq);
                if ((lane & 15) == 0) w.rssB[(size_t)(m0 + row) * 8 + nt] = sq;
            }
        }
        __syncthreads();
    }
}

__device__ void router_item(const Params& P, int L, int mt, char* lds, const int tid_in, const bool dry) {
    int tid = tid_in; asm volatile("" : "+v"(tid));
    const WS& w = P.w; const nv::Inputs& in = P.in;
    float* T = (float*)lds; float* stat = (float*)(lds + STAT_OFF); int* hist = (int*)(lds + STAT_OFF + 1024);
    const int m0 = mt * 128;
    {
        const bf16_t* arow[2]; const bf16_t* wrow[2];
#pragma unroll
        for (int i = 0; i < 2; ++i) {
            arow[i] = w.hb1 + (size_t)(m0 + (tid >> 2) + 64 * i) * 1024 + gl_chunk(tid) * 8;
            wrow[i] = w.Wrt + L * WR_SZ + (size_t)((tid >> 2) + 64 * i) * 1024 + gl_chunk(tid) * 8;
        }
        f32x16 acc[2][2]; acc_zero(acc);
        float my_rs = 0.f;
        if (tid < 128) my_rs = rstd8(w.rssB + (size_t)(m0 + tid) * 8, 1.f / 1024.f);
        gemm_mainloop_g(acc, arow, wrow, 32, lds, tid);
        if (tid < 128) stat[tid] = my_rs;
        if (tid < 32) hist[tid] = 0;
        acc_to_lds(acc, T, tid);
    }
    int e0 = 0, e1 = 0, r0 = 0, r1 = 0; float w0 = 0.f, w1 = 0.f;
    if (tid < 128) {
        const float rs = stat[tid];
        const float* lr = T + tid * TLD;
        const float* bg = in.router_group_b + L * 4; const float* be = in.router_expert_b + L * 32;
        int gi = 0; float gm = lr[0] * rs + bg[0];
#pragma unroll
        for (int j = 1; j < 4; ++j) { const float v = lr[j] * rs + bg[j]; if (v > gm) { gm = v; gi = j; } }
        float gs = 0.f;
#pragma unroll
        for (int j = 0; j < 4; ++j) gs += __builtin_amdgcn_exp2f(1.4426950408889634f * (lr[j] * rs + bg[j] - gm));
        const float gw = 1.f / gs;
        int i0 = 0, i1 = -1; float v0 = -3.0e38f, v1 = -3.0e38f;
#pragma unroll
        for (int j = 0; j < 8; ++j) {
            const float v = lr[4 + gi * 8 + j] * rs + be[gi * 8 + j];
            if (v > v0) { v1 = v0; i1 = i0; v0 = v; i0 = j; } else if (v > v1) { v1 = v; i1 = j; }
        }
        const float ex = __builtin_amdgcn_exp2f(1.4426950408889634f * (v1 - v0));
        w0 = gw / (1.f + ex); w1 = gw * ex / (1.f + ex);
        e0 = gi * 8 + i0; e1 = gi * 8 + i1;
        r0 = atomicAdd(&hist[e0], 1); r1 = atomicAdd(&hist[e1], 1);
    }
    __syncthreads();
    if (tid < 32) hist[32 + tid] = (hist[tid] && !dry) ? atomicAdd(&w.cnt[L * 64 + tid], hist[tid]) : 0;
    __syncthreads();
    if (tid < 128 && !dry) {
        const int tok = m0 + tid;
        const int p0 = hist[32 + e0] + r0, p1 = hist[32 + e1] + r1;
        w.elist[(size_t)e0 * NT + p0] = tok * 2; w.ewt[(size_t)e0 * NT + p0] = w0;
        w.elist[(size_t)e1 * NT + p1] = tok * 2 + 1; w.ewt[(size_t)e1 * NT + p1] = w1;
    }
    __syncthreads();
}
__device__ void eraw_item(const Params& P, int L, const int mt, const int nt, char* lds, const int tid_in) {
    int tid = tid_in; asm volatile("" : "+v"(tid));
    const WS& w = P.w; const nv::Inputs& in = P.in;
    const int lane = tid & 63, wid = tid >> 6;
    float* T = (float*)lds;
    const int m0 = mt * 128, n0 = nt * 128;
    {
        const float* arow[4]; const bf16_t* wrow[4];
#pragma unroll
        for (int i = 0; i < 4; ++i) {
            arow[i] = in.p + ((size_t)L * NT + m0 + (tid >> 3) + 32 * i) * 256 + (tid & 7) * 8;
            wrow[i] = w.Wpt + L * WP_SZ + (size_t)(n0 + (tid >> 3) + 32 * i) * 256 + (tid & 7) * 8;
        }
        f32x16 acc[2][2]; acc_zero(acc);
        float ss[4] = {0.f, 0.f, 0.f, 0.f};
        gemm_mainloop<float, false>(acc, arow, wrow, 4, lds, ss, tid);
        acc_to_lds(acc, T, tid);
    }
    {
        const int sub = lane >> 4, l16 = lane & 15, c8 = l16 * 8;
#pragma unroll 8
        for (int rr = 0; rr < 8; ++rr) {
            const int row = wid * 32 + rr * 4 + sub;
            const float4 x0 = *(const float4*)(T + row * TLD + c8), x1 = *(const float4*)(T + row * TLD + c8 + 4);
            *(uint4*)(w.erb + (size_t)(m0 + row) * 1024 + n0 + c8) = pack8(x0, x1);
            const float sq = grp_sum16(sq8(x0, x1));
            if (l16 == 0) w.essq[(size_t)(m0 + row) * 8 + nt] = sq;
        }
    }
    __syncthreads();
}
__device__ void phase_router(const Params& P, int L, char* lds, const bool dry = false) {
    const int tid = opaque_tid();
    {
        const int x = blockIdx.x & 7, lb = blockIdx.x >> 3, nlb = gridDim.x >> 3;
        for (int j = lb; j < 16; j += nlb) router_item(P, L, j * 8 + x, lds, tid, dry);
    }
}

constexpr int TT_OFF = STAT_OFF + 1024;
__device__ __forceinline__ void moe_table(const Params& P, int L, char* lds, const int tid) {
    int* tt = (int*)(lds + TT_OFF);
    if (tid == 0) {
        const int x = blockIdx.x & 7;
        int o = 0, t = 0;
        for (int e = 0; e < 32; ++e) {
            const int c = P.w.cnt[L * 64 + e];
            tt[e] = o; o += c;
            if ((e & 7) == x) { tt[40 + (e >> 3)] = t; t += (c + 127) >> 7; }
        }
        tt[32] = o; tt[44] = t;
    }
    __syncthreads();
}
__device__ __forceinline__ void moe_find(const int* tt, int tile, int& e, int& t) {
    int k = 0;
    if (tile >= tt[41]) k = 1;
    if (tile >= tt[42]) k = 2;
    if (tile >= tt[43]) k = 3;
    e = (blockIdx.x & 7) + 8 * k; t = tile - tt[40 + k];
}
__device__ void phase_moe_up(const Params& P, int L, char* lds, const bool noeraw = false) {
    const WS& w = P.w;
    const int tid0 = opaque_tid();
    float* T = (float*)lds; float* stat = (float*)(lds + STAT_OFF); const int* tt = (const int*)(lds + TT_OFF);
    moe_table(P, L, lds, tid0);
    const int ntiles = tt[44];
    for (int item = blockIdx.x >> 3; item < ntiles * 4; item += (gridDim.x >> 3)) {
        int tid = tid0; asm volatile("" : "+v"(tid));
        const int lane = tid & 63, wid = tid >> 6;
        const int tile = item >> 2, nt = item & 3;
        int e, t; moe_find(tt, tile, e, t);
        const int cnt = P.w.cnt[L * 64 + e], rbase = tt[e] + t * 128, nrows = min(128, cnt - t * 128);
        {
            const bf16_t* arow[2]; const bf16_t* wrow[2];
#pragma unroll
            for (int i = 0; i < 2; ++i) {
                const int r = (tid >> 2) + 64 * i;
                const int ent = w.elist[(size_t)e * NT + t * 128 + (r < nrows ? r : 0)];
                arow[i] = w.hb1 + (size_t)(ent >> 1) * 1024 + gl_chunk(tid) * 8;
                wrow[i] = w.Wgut + L * WGU_SZ + ((size_t)e * 512 + nt * 128 + r) * 1024 + gl_chunk(tid) * 8;
            }
            f32x16 acc[2][2]; acc_zero(acc);
            float my_rs = 0.f;
            if (tid < 128) {
                const int ent = w.elist[(size_t)e * NT + t * 128 + (tid < nrows ? tid : 0)];
                my_rs = rstd8(w.rssB + (size_t)(ent >> 1) * 8, 1.f / 1024.f);
            }
            gemm_mainloop_g(acc, arow, wrow, 32, lds, tid);
            if (tid < 128) stat[tid] = my_rs;
            acc_to_lds(acc, T, tid);
        }
        {
            const int sub = lane >> 4, l16 = lane & 15, c8 = l16 * 8;
#pragma unroll 8
            for (int rr = 0; rr < 8; ++rr) {
                const int row = wid * 32 + rr * 4 + sub; const float rs = stat[row];
                const float4 x0 = mul4(*(const float4*)(T + row * TLD + c8), rs), x1 = mul4(*(const float4*)(T + row * TLD + c8 + 4), rs);
                if (row < nrows)
                    store4(w.hbuf + (size_t)(rbase + row) * 256 + nt * 64 + l16 * 4, x0.x * sigmoid_(x0.x) * x0.y, x0.z * sigmoid_(x0.z) * x0.w,
                           x1.x * sigmoid_(x1.x) * x1.y, x1.z * sigmoid_(x1.z) * x1.w);
            }
        }
        __syncthreads();
    }
    if (!noeraw) {
        int* qslot = (int*)(lds + TT_OFF + 256);
        for (;;) {
            if (tid0 == 0) *qslot = atomicAdd(&P.w.cnt[L * 64 + 32], 1);
            __syncthreads();
            const int item = *qslot;
            __syncthreads();
            if (item >= 1024) break;
            eraw_item(P, L, item >> 3, item & 7, lds, tid0);
        }
    }
}
__device__ void phase_moe_down(const Params& P, int L, char* lds) {
    const WS& w = P.w;
    const int tid0 = opaque_tid();
    float* T = (float*)lds; float* stat = (float*)(lds + STAT_OFF); const int* tt = (const int*)(lds + TT_OFF);
    moe_table(P, L, lds, tid0);
    const int ntiles = tt[44];
    for (int item = blockIdx.x >> 3; item < ntiles * 8; item += (gridDim.x >> 3)) {
        int tid = tid0; asm volatile("" : "+v"(tid));
        const int lane = tid & 63, wid = tid >> 6;
        const int tile = item >> 3, nt = item & 7;
        int e, t; moe_find(tt, tile, e, t);
        const int cnt = P.w.cnt[L * 64 + e], rbase = tt[e] + t * 128, nrows = min(128, cnt - t * 128);
        {
            const bf16_t* arow[2]; const bf16_t* wrow[2];
#pragma unroll
            for (int i = 0; i < 2; ++i) {
                const int r = (tid >> 2) + 64 * i;
                arow[i] = w.hbuf + (size_t)(rbase + (r < nrows ? r : 0)) * 256 + gl_chunk(tid) * 8;
                wrow[i] = w.Wdt + L * WD_SZ + ((size_t)e * 1024 + nt * 128 + r) * 256 + gl_chunk(tid) * 8;
            }
            f32x16 acc[2][2]; acc_zero(acc);
            int my_ent = 0; float my_wt = 0.f;
            if (tid < 128) { const int rr2 = tid < nrows ? tid : 0; my_ent = w.elist[(size_t)e * NT + t * 128 + rr2]; my_wt = w.ewt[(size_t)e * NT + t * 128 + rr2]; }
            gemm_mainloop_g(acc, arow, wrow, 8, lds, tid);
            if (tid < 128) { ((int*)stat)[tid] = my_ent; stat[128 + tid] = my_wt; }
            acc_to_lds(acc, T, tid);
        }
        {
            const int sub = lane >> 4, l16 = lane & 15, c8 = l16 * 8;
#pragma unroll 8
            for (int rr = 0; rr < 8; ++rr) {
                const int row = wid * 32 + rr * 4 + sub;
                const int ent = ((const int*)stat)[row]; const float wt = stat[128 + row];
                const float4 x0 = mul4(*(const float4*)(T + row * TLD + c8), wt), x1 = mul4(*(const float4*)(T + row * TLD + c8 + 4), wt);
                if (row < nrows) *(uint4*)(w.contrib + (size_t)ent * 1024 + nt * 128 + c8) = pack8(x0, x1);
            }
        }
        __syncthreads();
    }
}

__device__ void phase_combine(const Params& P, int L, char* lds, const bool dry = false) {
    const WS& w = P.w;
    const int tid = opaque_tid(), lane = tid & 63;
    for (size_t tok = (size_t)blockIdx.x * 4 + (tid >> 6); tok < NT; tok += (size_t)gridDim.x * 4) {
        float ss = 0.f;
#pragma unroll
        for (int j = 0; j < 2; ++j) {
            const size_t c8 = (size_t)(j * 64 + lane) * 8;
            const uint4 a = *(const uint4*)(w.contrib + (tok * 2) * 1024 + c8), b = *(const uint4*)(w.contrib + (tok * 2 + 1) * 1024 + c8);
            float4* hp = (float4*)(P.h + tok * 1024 + c8);
            float4 h0 = hp[0], h1 = hp[1];
            h0.x += bflo(a.x) + bflo(b.x); h0.y += bfhi(a.x) + bfhi(b.x); h0.z += bflo(a.y) + bflo(b.y); h0.w += bfhi(a.y) + bfhi(b.y);
            h1.x += bflo(a.z) + bflo(b.z); h1.y += bfhi(a.z) + bfhi(b.z); h1.z += bflo(a.w) + bflo(b.w); h1.w += bfhi(a.w) + bfhi(b.w);
            if (!dry) { hp[0] = h0; hp[1] = h1; }
            uint4 pk; pk.x = pack2(h0.x, h0.y); pk.y = pack2(h0.z, h0.w); pk.z = pack2(h1.x, h1.y); pk.w = pack2(h1.z, h1.w);
            *(uint4*)(w.hb1 + tok * 1024 + c8) = pk;
            ss += (h0.x * h0.x + h0.y * h0.y) + (h0.z * h0.z + h0.w * h0.w) + (h1.x * h1.x + h1.y * h1.y) + (h1.z * h1.z + h1.w * h1.w);
        }
        ss = wave_sum64(ss);
        if (lane < 8) w.rssB[tok * 8 + lane] = lane == 0 ? ss : 0.f;
    }
}

__device__ void phase_ple(const Params& P, int L, char* lds, const bool dry = false) {
    const WS& w = P.w; const nv::Inputs& in = P.in;
    const int tid0 = opaque_tid();
    float* T = (float*)lds; float* stat = (float*)(lds + STAT_OFF);
    int mt, nt;
    for (int it = 0; xcd_item(it, 128, 8, mt, nt); ++it) {
        int tid = tid0; asm volatile("" : "+v"(tid));
        const int lane = tid & 63, wid = tid >> 6;
        const int m0 = mt * 128, n0 = nt * 128;
        {
            const bf16_t* arow[2]; const bf16_t* wrow[2];
#pragma unroll
            for (int i = 0; i < 2; ++i) {
                arow[i] = w.hb1 + (size_t)(m0 + (tid >> 2) + 64 * i) * 1024 + gl_chunk(tid) * 8;
                wrow[i] = w.Wgt + L * WG_SZ + (size_t)(n0 + (tid >> 2) + 64 * i) * 1024 + gl_chunk(tid) * 8;
            }
            f32x16 acc[2][2]; acc_zero(acc);
            float my_rs = 0.f, my_re = 0.f;
            if (tid < 128) { my_rs = rstd8(w.rssB + (size_t)(m0 + tid) * 8, 1.f / 1024.f); my_re = rstd8(w.essq + (size_t)(m0 + tid) * 8, 1.f / 1024.f); }
            gemm_mainloop_g(acc, arow, wrow, 32, lds, tid);
            if (tid < 128) { stat[tid] = my_rs; stat[128 + tid] = my_re; }
            acc_to_lds(acc, T, tid);
        }
        {
            const int sub = lane >> 4, l16 = lane & 15, c8 = l16 * 8;
            const float4 pg0 = *(const float4*)(in.ple_post_norm_g + L * 1024 + n0 + c8), pg1 = *(const float4*)(in.ple_post_norm_g + L * 1024 + n0 + c8 + 4);
#pragma unroll 8
            for (int rr = 0; rr < 8; ++rr) {
                const int row = wid * 32 + rr * 4 + sub; const float rs = stat[row], re = stat[128 + row]; const size_t tok = m0 + row;
                const float4 x0 = mul4(*(const float4*)(T + row * TLD + c8), rs), x1 = mul4(*(const float4*)(T + row * TLD + c8 + 4), rs);
                const size_t off = tok * 1024 + n0 + c8;
                const uint4 er = *(const uint4*)(w.erb + off);
                float4* hp = (float4*)(P.h + off);
                float4 h0 = hp[0], h1 = hp[1];
                h0.x += sigmoid_(x0.x) * (bflo(er.x) * re * pg0.x); h0.y += sigmoid_(x0.y) * (bfhi(er.x) * re * pg0.y);
                h0.z += sigmoid_(x0.z) * (bflo(er.y) * re * pg0.z); h0.w += sigmoid_(x0.w) * (bfhi(er.y) * re * pg0.w);
                h1.x += sigmoid_(x1.x) * (bflo(er.z) * re * pg1.x); h1.y += sigmoid_(x1.y) * (bfhi(er.z) * re * pg1.y);
                h1.z += sigmoid_(x1.z) * (bflo(er.w) * re * pg1.z); h1.w += sigmoid_(x1.w) * (bfhi(er.w) * re * pg1.w);
                if (!dry) { hp[0] = h0; hp[1] = h1; }
                *(uint4*)(w.hb + off) = pack8(h0, h1);
                const float sq = grp_sum16(sq8(h0, h1));
                if (l16 == 0) w.rssA[tok * 8 + nt] = sq;
            }
        }
        __syncthreads();
    }
}

}
namespace fx {
#define XB_TMO      128
#define XB_XCNT(j)  (256  + 64 * (j))
#define XB_XSUB(j)  (1280 + 64 * (j))
#define XB_XGEN(j)  (2304 + 64 * (j))
#define XB_TOP      3328
#define XB_TOPGEN   3392
#define XCD_BAR_WORDS 3456
#define XB_SPIN_CAP (1u << 18)
#define LAS __attribute__((address_space(3)))
__device__ __forceinline__ unsigned xb_ld(unsigned* p)              { return __hip_atomic_load(p, __ATOMIC_RELAXED, __HIP_MEMORY_SCOPE_AGENT); }
__device__ __forceinline__ unsigned xb_add(unsigned* p, unsigned v) { return __hip_atomic_fetch_add(p, v, __ATOMIC_RELAXED, __HIP_MEMORY_SCOPE_AGENT); }
__device__ __forceinline__ unsigned xb_xcc_id() { return (unsigned)__builtin_amdgcn_s_getreg((3 << 11) | 20) & 0xFu; }
#define XB_SPIN(cond, bar) do { unsigned _sp = 0; while (cond) { __builtin_amdgcn_s_sleep(1); \
    if ((++_sp & 255u) == 0u) { if (xb_ld(&(bar)[XB_TMO])) break; if (_sp > XB_SPIN_CAP) { atomicAdd(&(bar)[XB_TMO], 1u); break; } } } } while (0)
struct XcdBarrier { unsigned* bar; unsigned x; volatile LAS unsigned* st; };
__device__ __forceinline__ XcdBarrier xcd_barrier_post(unsigned* bar, volatile LAS unsigned* st) {
    XcdBarrier b; b.bar = bar; b.x = xb_xcc_id(); b.st = st;
    if (threadIdx.x == 0) (void)xb_add(&bar[XB_XCNT(b.x)], 1u);
    return b;
}
__device__ __forceinline__ void xcd_barrier_complete(unsigned* bar, unsigned x, unsigned& nloc, unsigned& nx) {
    const unsigned G = gridDim.x * gridDim.y * gridDim.z;
    unsigned sum, cnt, mine, sp = 0u;
    for (;;) {
        sum = 0u; cnt = 0u; mine = 0u;
#pragma unroll
        for (unsigned j = 0; j < 16; ++j) { const unsigned c = xb_ld(&bar[XB_XCNT(j)]); sum += c; cnt += (c > 0u) ? 1u : 0u; mine = (j == x) ? c : mine; }
        if (sum == G) break;
        __builtin_amdgcn_s_sleep(1);
        if ((++sp & 255u) == 0u) { if (xb_ld(&bar[XB_TMO])) break; if (sp > XB_SPIN_CAP) { atomicAdd(&bar[XB_TMO], 1u); break; } }
    }
    nloc = mine > 0u ? mine : 1u; nx = cnt > 0u ? cnt : 1u;
}
__device__ __forceinline__ void xcd_barrier(const XcdBarrier& b) {
    asm volatile("s_waitcnt vmcnt(0)" ::: "memory");
    __syncthreads();
    if (threadIdx.x == 0) {
        unsigned* bar = b.bar;
        __builtin_amdgcn_s_waitcnt(0);
        unsigned nloc = b.st[0], nx = b.st[1];
        if (nloc == 0u) { xcd_barrier_complete(bar, b.x, nloc, nx); b.st[0] = nloc; b.st[1] = nx; }
        const unsigned old = xb_add(&bar[XB_XSUB(b.x)], 1u);
        const unsigned gen = old / nloc;
        if (old + 1u == (gen + 1u) * nloc) {
            __builtin_amdgcn_fence(__ATOMIC_RELEASE, "agent");
            asm volatile("s_waitcnt vmcnt(0)" ::: "memory");
            const unsigned og = xb_add(&bar[XB_TOP], 1u);
            const unsigned tg = og / nx;
            if (og + 1u == (tg + 1u) * nx) xb_add(&bar[XB_TOPGEN], 1u);
            else XB_SPIN(xb_ld(&bar[XB_TOPGEN]) == tg, bar);
            __builtin_amdgcn_fence(__ATOMIC_ACQUIRE, "agent");
            xb_add(&bar[XB_XGEN(b.x)], 1u);
            asm volatile("s_waitcnt vmcnt(0)" ::: "memory");
        } else {
            XB_SPIN(xb_ld(&bar[XB_XGEN(b.x)]) == gen, bar);
            __builtin_amdgcn_fence(__ATOMIC_ACQUIRE, "agent");
            asm volatile("s_waitcnt vmcnt(0)" ::: "memory");
        }
    }
    __syncthreads();
}

constexpr int LDS_BYTES = LDS_GEMM_BYTES + 16;
constexpr int N_PHASES = 19;
constexpr int PPL = 9;
__global__ void __launch_bounds__(256, 2) k_run(Params P, int ph_lo, int ph_hi) {
    extern __shared__ __attribute__((aligned(16))) char lds[];
    volatile LAS unsigned* st = (volatile LAS unsigned*)(lds + LDS_GEMM_BYTES);
    if (threadIdx.x == 0) { st[0] = 0u; st[1] = 0u; }
    __syncthreads();
    XcdBarrier xb = xcd_barrier_post(P.w.bar, st);
    for (int ph = ph_lo; ph < ph_hi; ++ph) {
        if (ph > ph_lo) xcd_barrier(xb);
#ifdef REP_PHASE
        if (REP_PHASE == 0 && ph == 0) { phase_prep(P, lds); xcd_barrier(xb); }
        if (ph > 0 && ((ph - 1) % PPL) == REP_PHASE - 1) {
            const int L = (ph - 1) / PPL;
            switch (REP_PHASE - 1) {
                case 0: phase_zgemm(P, L, lds); break;
                case 1: phase_mix(P, L, lds); break;
                case 2: phase_attn(P, L, lds); break;
                case 3: phase_oproj(P, L, lds, true); break;
                case 4: phase_router(P, L, lds, true); break;
                case 5: phase_moe_up(P, L, lds, true); break;
                case 6: phase_moe_down(P, L, lds); break;
                case 7: phase_combine(P, L, lds, true); break;
                case 8: phase_ple(P, L, lds, true); break;
            }
            xcd_barrier(xb);
        }
#endif
        if (ph == 0) phase_prep(P, lds);
        else {
            const int L = (ph - 1) / PPL, s = (ph - 1) % PPL;
            switch (s) {
                case 0: phase_zgemm(P, L, lds); break;
                case 1: phase_mix(P, L, lds); break;
                case 2: phase_attn(P, L, lds); break;
                case 3: phase_oproj(P, L, lds); break;
                case 4: phase_router(P, L, lds); break;
                case 5: phase_moe_up(P, L, lds); break;
                case 6: phase_moe_down(P, L, lds); break;
                case 7: phase_combine(P, L, lds); break;
                case 8: phase_ple(P, L, lds); break;
            }
        }
    }
}
}
#ifndef MK_N_LAUNCHES
#define MK_N_LAUNCHES 1
#endif
extern "C" void kernel_launch(void* const* d_in, const int* in_sizes, int n_in, void* d_out, int out_size, void* d_ws, size_t ws_size,
                              hipStream_t stream) {
    nv::Inputs in{};
    in.x = (const float*)d_in[0]; in.p = (const float*)d_in[1]; in.positions = (const int*)d_in[2];
    const float** f = &in.mix_norm_g;
    for (int i = 0; i < 32; ++i) f[i] = (const float*)d_in[3 + i];
    size_t used = 0;
    fx::WS w = fx::make_ws((char*)d_ws, used);
    static int grid = 0;
    if (grid == 0) {
        if (n_in != 35 || out_size != fx::NT * 1024 || used > ws_size) { fprintf(stderr, "kernel_launch: unexpected shapes / workspace (need %zu, have %zu)\n", used, ws_size); grid = -1; return; }
        if (hipFuncSetAttribute((const void*)fx::k_run, hipFuncAttributeMaxDynamicSharedMemorySize, fx::LDS_BYTES) != hipSuccess) { fprintf(stderr, "hipFuncSetAttribute failed\n"); grid = -1; return; }
        int dev = 0, cus = 0, per_cu = 0;
        hipGetDevice(&dev); hipDeviceGetAttribute(&cus, hipDeviceAttributeMultiprocessorCount, dev);
        hipOccupancyMaxActiveBlocksPerMultiprocessor(&per_cu, (const void*)fx::k_run, 256, fx::LDS_BYTES);
        if (per_cu > 2) per_cu = 2;
        if (per_cu < 1) { fprintf(stderr, "occupancy query says %d blocks/CU\n", per_cu); grid = -1; return; }
        grid = cus * per_cu;
    }
    if (grid < 0) return;
    fx::Params P{}; P.in = in; P.h = (float*)d_out; P.w = w;
    hipMemsetAsync(w.cnt, 0, 128 * 4, stream);
    hipMemsetAsync(w.bar, 0, XCD_BAR_WORDS * 4, stream);
    if (MK_N_LAUNCHES == 1) hipLaunchKernelGGL(fx::k_run, dim3(grid), dim3(256), fx::LDS_BYTES, stream, P, 0, fx::N_PHASES);
    else for (int ph = 0; ph < fx::N_PHASES; ++ph) hipLaunchKernelGGL(fx::k_run, dim3(grid), dim3(256), fx::LDS_BYTES, stream, P, ph, ph + 1);
}
```

```cpp
#include <hip/hip_runtime.h>
#include <hip/hip_bf16.h>
#include <stdint.h>
#include <cstdio>
namespace nv {
struct Inputs {
    const float *x, *p; const int* positions;
    const float *mix_norm_g, *w_in, *sgu_ln_g, *sgu_ln_b, *sgu_w, *sgu_b, *conv_w, *conv_b, *conv_ln_g, *conv_ln_b, *conv_pw_w, *conv_pw_b,
        *q_a_norm_g, *w_uq, *kv_a_norm_g, *w_ukv, *q_norm_g, *k_norm_g, *branch_norm_g, *w_o, *ffn_norm_g, *router_group_w, *router_group_b,
        *router_expert_w, *router_expert_b, *moe_w_gate, *moe_w_up, *moe_w_down, *ple_norm_g, *ple_gate_w, *ple_proj_w, *ple_post_norm_g;
};
}
namespace fx {

typedef unsigned short bf16_t;
typedef short bf16x8 __attribute__((ext_vector_type(8)));
typedef float f32x16 __attribute__((ext_vector_type(16)));
typedef float f32x4 __attribute__((ext_vector_type(4)));

constexpr int NT = 16384, SEQ = 2048, DM = 1024, NB = 8;
constexpr int ZN = 1536;
constexpr float EPS = 1e-6f;

typedef __bf16 bf16v2_t __attribute__((ext_vector_type(2)));
typedef float f32v2_t __attribute__((ext_vector_type(2)));
__device__ __forceinline__ unsigned pack2(float lo, float hi) {
    f32v2_t v; v.x = lo; v.y = hi;
    bf16v2_t b = __builtin_convertvector(v, bf16v2_t);
    return __builtin_bit_cast(unsigned, b);
}
__device__ __forceinline__ unsigned f2bf(float f) { return pack2(f, 0.f) & 0xffffu; }
__device__ __forceinline__ float bf2f(unsigned short b) { return __uint_as_float(((unsigned)b) << 16); }
__device__ __forceinline__ float bflo(unsigned u) { return __uint_as_float(u << 16); }
__device__ __forceinline__ float bfhi(unsigned u) { return __uint_as_float(u & 0xffff0000u); }
__device__ __forceinline__ float sigmoid_(float x) { return __builtin_amdgcn_rcpf(1.f + __builtin_amdgcn_exp2f(-1.4426950408889634f * x)); }
__device__ __forceinline__ float rsq_(float x) { return __builtin_amdgcn_rsqf(x); }
__device__ __forceinline__ float gelu_tanh_(float x) {
    float u = 0.7978845608028654f * (x + 0.044715f * x * x * x);
    return x * sigmoid_(2.f * u);
}
__device__ __forceinline__ int opaque_tid() { int t = threadIdx.x; asm volatile("" : "+v"(t)); return t; }
template <int CTRL> __device__ __forceinline__ float dpp_mov(float v) {
    return __builtin_bit_cast(float, __builtin_amdgcn_update_dpp(0, __builtin_bit_cast(int, v), CTRL, 0xf, 0xf, false));
}
__device__ __forceinline__ void swap16(float& a, float& b) { asm volatile("s_nop 1\n\tv_permlane16_swap_b32 %0, %1" : "+v"(a), "+v"(b)); }
__device__ __forceinline__ void swap32(float& a, float& b) { asm volatile("s_nop 1\n\tv_permlane32_swap_b32 %0, %1" : "+v"(a), "+v"(b)); }
__device__ __forceinline__ float swap16_sum(float v) { float a = v, b = v; swap16(a, b); return a + b; }
__device__ __forceinline__ float swap32_sum(float v) { float a = v, b = v; swap32(a, b); return a + b; }
__device__ __forceinline__ float swap32_max(float v) { float a = v, b = v; swap32(a, b); return fmaxf(a, b); }
__device__ __forceinline__ float grp_sum16(float v) { v += dpp_mov<0xB1>(v); v += dpp_mov<0x4E>(v); v += dpp_mov<0x124>(v); v += dpp_mov<0x128>(v); return v; }
__device__ __forceinline__ float grp_sum32(float v) { return swap16_sum(grp_sum16(v)); }
__device__ __forceinline__ float wave_sum64(float v) { return swap32_sum(grp_sum32(v)); }
__device__ __forceinline__ float grp_sum4(float v) { v += dpp_mov<0xB1>(v); v += dpp_mov<0x4E>(v); return v; }
__device__ __forceinline__ float grp_sum8(float v) { v = grp_sum4(v); v += dpp_mov<0x141>(v); return v; }
__device__ __forceinline__ float quad_x2(float v) { return dpp_mov<0x4E>(v); }
__device__ __forceinline__ float xor8(float v) { return dpp_mov<0x128>(v); }
__device__ __forceinline__ float xor32(float v) { return swap32_sum(v); }

struct WS {
    bf16_t *W1t, *Wuqt, *Wukvt, *Wpwt, *Wot, *Wrt, *Wgut, *Wdt, *Wgt, *Wpt, *Wsm;
    bf16_t *hb;
    bf16_t *hb1;
    bf16_t *ub;
    bf16_t *vT;
    bf16_t *ygb;
    bf16_t *cqb;
    bf16_t *ckvb;
    bf16_t *kpeb;
    bf16_t *Qb;
    bf16_t *Knb;
    bf16_t *VTb;
    bf16_t *yb;
    float  *ssq;
    float  *rssA;
    float  *rssB;
    float  *cqss;
    float  *cs;
    bf16_t *erb;
    float  *essq;
    bf16_t *hbuf;
    bf16_t *contrib;
    int    *cnt;
    int    *elist;
    float  *ewt;
    unsigned *bar;
};
constexpr size_t W1_SZ = (size_t)ZN * 1024, WUQ_SZ = 768 * 256, WUKV_SZ = 1024 * 128, WPW_SZ = 256 * 256, WO_SZ = 1024 * 1024, WR_SZ = 128 * 1024,
                 WGU_SZ = (size_t)32 * 512 * 1024, WD_SZ = (size_t)32 * 1024 * 256, WG_SZ = 1024 * 1024, WP_SZ = 1024 * 256, WSM_SZ = 4 * 128 * 128;

struct Params {
    nv::Inputs in;
    float* h;
    WS w;
    float* zf;
    float* yf;
};

static WS make_ws(char* base, size_t& used) {
    WS w{}; size_t o = 0;
    auto take = [&](size_t bytes) { char* p = base + o; o += (bytes + 255) & ~(size_t)255; return p; };
    w.W1t = (bf16_t*)take(2 * W1_SZ * 2);   w.Wuqt = (bf16_t*)take(2 * WUQ_SZ * 2); w.Wukvt = (bf16_t*)take(2 * WUKV_SZ * 2);
    w.Wpwt = (bf16_t*)take(2 * WPW_SZ * 2); w.Wot = (bf16_t*)take(2 * WO_SZ * 2);   w.Wrt = (bf16_t*)take(2 * WR_SZ * 2);
    w.Wgut = (bf16_t*)take(2 * WGU_SZ * 2); w.Wdt = (bf16_t*)take(2 * WD_SZ * 2);   w.Wgt = (bf16_t*)take(2 * WG_SZ * 2);
    w.Wpt = (bf16_t*)take(2 * WP_SZ * 2);   w.Wsm = (bf16_t*)take(2 * WSM_SZ * 2);
    w.hb = (bf16_t*)take((size_t)NT * 1024 * 2); w.hb1 = (bf16_t*)take((size_t)NT * 1024 * 2);
    w.ssq = (float*)take((size_t)NT * 16 * 4); w.cs = (float*)take((size_t)NT * 32 * 4);
    w.rssA = (float*)take((size_t)NT * 8 * 4); w.rssB = (float*)take((size_t)NT * 8 * 4); w.cqss = (float*)take((size_t)NT * 4 * 4);
    w.essq = (float*)take((size_t)NT * 8 * 4);
    w.cnt = (int*)take(2 * 64 * 4);
    w.elist = (int*)take((size_t)32 * NT * 4); w.ewt = (float*)take((size_t)32 * NT * 4);
    w.bar = (unsigned*)take(4096 * 4);
    const size_t region = o;
    w.ub = (bf16_t*)take((size_t)NT * 256 * 2); w.vT = (bf16_t*)take((size_t)NT * 256 * 2); w.ygb = (bf16_t*)take((size_t)NT * 256 * 2);
    w.cqb = (bf16_t*)take((size_t)NT * 256 * 2); w.ckvb = (bf16_t*)take((size_t)NT * 128 * 2); w.kpeb = (bf16_t*)take((size_t)NT * 32 * 2);
    w.Qb = (bf16_t*)take((size_t)NT * 768 * 2); w.Knb = (bf16_t*)take((size_t)NT * 512 * 2); w.VTb = (bf16_t*)take((size_t)NT * 512 * 2);
    w.yb = (bf16_t*)take((size_t)NT * 1024 * 2);
    const size_t region_end = o;
    o = region;
    w.contrib = (bf16_t*)take((size_t)NT * 2 * 1024 * 2);
    w.hbuf = (bf16_t*)take((size_t)(2 * NT + 128) * 256 * 2);
    w.erb = (bf16_t*)take((size_t)NT * 1024 * 2);
    if (o > region_end) { fprintf(stderr, "make_ws: overlay exceeds mixer region\n"); }
    o = region_end;
    used = o;
    return w;
}

__device__ const double ROPE_INV[16] = {1.0, 0.5623413251903491, 0.31622776601683794, 0.1778279410038923, 0.1, 0.05623413251903491, 0.03162277660168379, 0.01778279410038923, 0.01, 0.005623413251903491, 0.0031622776601683794, 0.0017782794100389228, 0.001, 0.0005623413251903491, 0.00031622776601683794, 0.00017782794100389227};
__device__ __forceinline__ void rope_cs(int pos, int j, float& c, float& s) {
    const double ang = (double)pos * ROPE_INV[j];
    const double n = rint(ang * 0.15915494309189535);
    double r = fma(-n, 6.283185307179586, ang); r = fma(-n, 2.4492935982947064e-16, r);
    const double r2 = r * r;
    double sc = 1.0, ss = 1.0;
    double tc = 1.0, ts = 1.0;
#pragma unroll
    for (int k = 1; k <= 14; ++k) {
        tc *= -r2 / (double)((2 * k - 1) * (2 * k)); sc += tc;
        ts *= -r2 / (double)((2 * k) * (2 * k + 1)); ss += ts;
    }
    c = (float)sc; s = (float)(ss * r);
}

enum { MAP_ID = 0, MAP_W1 = 1, MAP_UQ = 2, MAP_UKV = 3, MAP_GATE = 4, MAP_UP = 5 };
template <int MAP> __device__ __forceinline__ int dstrow(int c) {
    if (MAP == MAP_W1) {
        if (c < 512) return c;
        if (c < 768) return 512 + 2 * (c - 512);
        if (c < 1024) return 513 + 2 * (c - 768);
        return c;
    } else if (MAP == MAP_UQ) {
        const int h = c / 96, d = c - h * 96; return d < 64 ? h * 64 + d : 512 + h * 32 + d - 64;
    } else if (MAP == MAP_UKV) {
        const int h = c >> 7, d = c & 127; return d < 64 ? h * 64 + d : 512 + h * 64 + d - 64;
    } else if (MAP == MAP_GATE) return 2 * c;
    else if (MAP == MAP_UP) return 2 * c + 1;
    return c;
}
#define PREP_LOAD(V0, V1, V2, V3, SRC, K0, C0) do { \
    const int kk_ = tid >> 4, c4_ = (tid & 15) * 4; \
    const float* p_ = (C0) + c4_ < Nsrc ? (SRC) + (size_t)((K0) + kk_) * ld + (C0) + c4_ : (SRC) + (size_t)((K0) + kk_) * ld; \
    V0 = *(const float4*)p_; V1 = *(const float4*)(p_ + (size_t)16 * ld); V2 = *(const float4*)(p_ + (size_t)32 * ld); V3 = *(const float4*)(p_ + (size_t)48 * ld); } while (0)
__device__ __forceinline__ void prep_put(float* tile, int kk, int c4, const float4& v, float sc) {
    float* t = tile + kk * 65 + c4; t[0] = v.x * sc; t[1] = v.y * sc; t[2] = v.z * sc; t[3] = v.w * sc;
}
template <int MAP>
__device__ void prep_job(const float* src, int ld, int Nsrc, size_t src_stride, const float* scale, bf16_t* dst, size_t dst_stride, int K, int nbatch, float* tiles, int& rot, const int tid, const int bi, const int G) {
    const int tn = (Nsrc + 63) / 64, tk = K / 64, per = tn * tk, total = per * nbatch;
    int t = (bi - rot + G) % G, buf = 0;
    float4 a0 = make_float4(0.f, 0.f, 0.f, 0.f), a1 = a0, a2 = a0, a3 = a0, b0 = a0, b1 = a0, b2 = a0, b3 = a0;
    if (t < total) { const int e = t / per, tt = t % per; PREP_LOAD(a0, a1, a2, a3, src + (size_t)e * src_stride, (tt / tn) * 64, (tt % tn) * 64); }
    for (; t < total; t += G) {
        const int e = t / per, tt = t % per, k0 = (tt / tn) * 64, c0 = (tt % tn) * 64;
        const int t2 = t + G;
        if (t2 < total) { const int e2 = t2 / per, tt2 = t2 % per; PREP_LOAD(b0, b1, b2, b3, src + (size_t)e2 * src_stride, (tt2 / tn) * 64, (tt2 % tn) * 64); }
        float* tile = tiles + buf * (64 * 65);
        {
            const int kk = tid >> 4, c4 = (tid & 15) * 4;
            const float s0 = scale ? scale[k0 + kk] : 1.f, s1 = scale ? scale[k0 + kk + 16] : 1.f, s2 = scale ? scale[k0 + kk + 32] : 1.f, s3 = scale ? scale[k0 + kk + 48] : 1.f;
            prep_put(tile, kk, c4, a0, s0); prep_put(tile, kk + 16, c4, a1, s1); prep_put(tile, kk + 32, c4, a2, s2); prep_put(tile, kk + 48, c4, a3, s3);
        }
        __syncthreads();
        bf16_t* d = dst + (size_t)e * dst_stride;
#pragma unroll
        for (int i = 0; i < 2; ++i) {
            const int idx = tid + 256 * i, c = idx >> 3, kc = idx & 7;
            if (c0 + c < Nsrc) {
                const float* q = tile + (kc * 8) * 65 + c;
                uint4 pk;
                pk.x = pack2(q[0], q[65]); pk.y = pack2(q[130], q[195]); pk.z = pack2(q[260], q[325]); pk.w = pack2(q[390], q[455]);
                *(uint4*)(d + (size_t)dstrow<MAP>(c0 + c) * K + k0 + kc * 8) = pk;
            }
        }
        a0 = b0; a1 = b1; a2 = b2; a3 = b3; buf ^= 1;
    }
    __syncthreads();
    rot = (rot + total) % G;
}

__device__ void phase_prep(const Params& P, char* lds) {
    float* tile = (float*)lds;
    const nv::Inputs& in = P.in; const WS& w = P.w;
    const int G = gridDim.x, bid = blockIdx.x, tid = opaque_tid();
    int rot = 0;
    for (int L = 0; L < 2; ++L) {
        if (L == 0) {
        prep_job<MAP_GATE>(in.moe_w_gate + (size_t)L * 32 * 1024 * 256, 256, 256, (size_t)1024 * 256, in.ffn_norm_g + L * 1024, w.Wgut + L * WGU_SZ, (size_t)512 * 1024, 1024, 32, tile, rot, tid, bid, G);
        prep_job<MAP_UP>(in.moe_w_up + (size_t)L * 32 * 1024 * 256, 256, 256, (size_t)1024 * 256, in.ffn_norm_g + L * 1024, w.Wgut + L * WGU_SZ, (size_t)512 * 1024, 1024, 32, tile, rot, tid, bid, G);
        prep_job<MAP_ID>(in.moe_w_down + (size_t)L * 32 * 256 * 1024, 1024, 1024, (size_t)256 * 1024, nullptr, w.Wdt + L * WD_SZ, (size_t)1024 * 256, 256, 32, tile, rot, tid, bid, G);
        }
        prep_job<MAP_W1>(in.w_in + (size_t)L * 1024 * 1440, 1440, 1440, 0, in.mix_norm_g + L * 1024, w.W1t + L * W1_SZ, 0, 1024, 1, tile, rot, tid, bid, G);
        prep_job<MAP_UQ>(in.w_uq + (size_t)L * 256 * 768, 768, 768, 0, in.q_a_norm_g + L * 256, w.Wuqt + L * WUQ_SZ, 0, 256, 1, tile, rot, tid, bid, G);
        prep_job<MAP_UKV>(in.w_ukv + (size_t)L * 128 * 1024, 1024, 1024, 0, in.kv_a_norm_g + L * 128, w.Wukvt + L * WUKV_SZ, 0, 128, 1, tile, rot, tid, bid, G);
        prep_job<MAP_ID>(in.conv_pw_w + (size_t)L * 256 * 256, 256, 256, 0, nullptr, w.Wpwt + L * WPW_SZ, 0, 256, 1, tile, rot, tid, bid, G);
        prep_job<MAP_ID>(in.w_o + (size_t)L * 1024 * 1024, 1024, 1024, 0, in.branch_norm_g + L * 1024, w.Wot + L * WO_SZ, 0, 1024, 1, tile, rot, tid, bid, G);
        prep_job<MAP_ID>(in.ple_gate_w + (size_t)L * 1024 * 1024, 1024, 1024, 0, in.ple_norm_g + L * 1024, w.Wgt + L * WG_SZ, 0, 1024, 1, tile, rot, tid, bid, G);
        prep_job<MAP_ID>(in.ple_proj_w + (size_t)L * 256 * 1024, 1024, 1024, 0, nullptr, w.Wpt + L * WP_SZ, 0, 256, 1, tile, rot, tid, bid, G);
        for (int i = bid * 256 + tid; i < 96 * 1024 / 8; i += G * 256) *(uint4*)(w.W1t + L * W1_SZ + (size_t)1440 * 1024 + (size_t)i * 8) = make_uint4(0u, 0u, 0u, 0u);
        for (int i = bid * 256 + tid; i < 128 * 1024; i += G * 256) {
            int n = i >> 10, k = i & 1023; float v = 0.f;
            if (n < 4) v = in.router_group_w[(size_t)L * 1024 * 4 + k * 4 + n];
            else if (n < 36) v = in.router_expert_w[(size_t)L * 1024 * 32 + k * 32 + (n - 4)];
            v *= in.ffn_norm_g[L * 1024 + k];
            w.Wrt[L * WR_SZ + i] = (bf16_t)f2bf(v);
        }
        for (int i = bid * 256 + tid; i < 4 * 128 * 128; i += G * 256) {
            int jj = i & 127, ii = (i >> 7) & 127;
            float v = (jj <= ii) ? in.sgu_w[(size_t)L * WSM_SZ + i] : 0.f;
            w.Wsm[L * WSM_SZ + i] = (bf16_t)f2bf(v);
        }
    }
    for (int i = bid * 256 + tid; i < NT * 16; i += G * 256) {
        int t = i >> 4, j = i & 15;
        float c, sn; rope_cs(in.positions[t], j, c, sn);
        w.cs[t * 32 + j] = c; w.cs[t * 32 + 16 + j] = sn;
    }
    for (int row = bid * 4 + (tid >> 6); row < NT; row += G * 4) {
        const int lane = tid & 63;
        float ss = 0.f;
#pragma unroll
        for (int j = 0; j < 4; ++j) {
            const size_t i = (size_t)row * 256 + j * 64 + lane;
            const float4 v = ((const float4*)in.x)[i];
            uint2 pk; pk.x = pack2(v.x, v.y); pk.y = pack2(v.z, v.w);
            ((uint2*)w.hb)[i] = pk;
            ss += v.x * v.x + v.y * v.y + v.z * v.z + v.w * v.w;
        }
        ss = wave_sum64(ss);
        if (lane < 8) w.rssA[(size_t)row * 8 + lane] = lane == 0 ? ss : 0.f;
    }
}

__device__ void prep_moe_late(const Params& P, int part, char* lds, const int tid, const int bi, const int nb) {
    float* tile = (float*)lds;
    const nv::Inputs& in = P.in; const WS& w = P.w;
    int rot = 0; const int L = 1;
    const float* up = in.moe_w_up + (size_t)L * 32 * 1024 * 256;
    if (part == 0) {
        prep_job<MAP_GATE>(in.moe_w_gate + (size_t)L * 32 * 1024 * 256, 256, 256, (size_t)1024 * 256, in.ffn_norm_g + L * 1024, w.Wgut + L * WGU_SZ, (size_t)512 * 1024, 1024, 32, tile, rot, tid, bi, nb);
        prep_job<MAP_UP>(up, 256, 256, (size_t)1024 * 256, in.ffn_norm_g + L * 1024, w.Wgut + L * WGU_SZ, (size_t)512 * 1024, 1024, 16, tile, rot, tid, bi, nb);
    } else {
        prep_job<MAP_UP>(up + (size_t)16 * 1024 * 256, 256, 256, (size_t)1024 * 256, in.ffn_norm_g + L * 1024, w.Wgut + L * WGU_SZ + (size_t)16 * 512 * 1024, (size_t)512 * 1024, 1024, 16, tile, rot, tid, bi, nb);
        prep_job<MAP_ID>(in.moe_w_down + (size_t)L * 32 * 256 * 1024, 1024, 1024, (size_t)256 * 1024, nullptr, w.Wdt + L * WD_SZ, (size_t)1024 * 256, 256, 32, tile, rot, tid, bi, nb);
    }
    __syncthreads();
}

__device__ __forceinline__ int lds_off(int row, int chunk) { return row * 128 + ((chunk ^ ((row >> 1) & 7)) << 4); }

template <typename AT> struct ARaw;
template <> struct ARaw<bf16_t> { uint4 v[4]; };
template <> struct ARaw<float> { float4 v[4][2]; };

__device__ __forceinline__ void a_load(ARaw<bf16_t>& r, const bf16_t* const (&rowp)[4], int koff) {
#pragma unroll
    for (int i = 0; i < 4; ++i) r.v[i] = *(const uint4*)(rowp[i] + koff);
}
__device__ __forceinline__ void a_load(ARaw<float>& r, const float* const (&rowp)[4], int koff) {
#pragma unroll
    for (int i = 0; i < 4; ++i) { r.v[i][0] = *(const float4*)(rowp[i] + koff); r.v[i][1] = *(const float4*)(rowp[i] + koff + 4); }
}
template <bool SUMSQ> __device__ __forceinline__ uint4 a_cvt(const uint4& v, float& ss) {
    if (SUMSQ) {
        float a;
        a = bflo(v.x); ss = fmaf(a, a, ss); a = bfhi(v.x); ss = fmaf(a, a, ss);
        a = bflo(v.y); ss = fmaf(a, a, ss); a = bfhi(v.y); ss = fmaf(a, a, ss);
        a = bflo(v.z); ss = fmaf(a, a, ss); a = bfhi(v.z); ss = fmaf(a, a, ss);
        a = bflo(v.w); ss = fmaf(a, a, ss); a = bfhi(v.w); ss = fmaf(a, a, ss);
    }
    return v;
}
template <bool SUMSQ> __device__ __forceinline__ void a_store(const ARaw<bf16_t>& r, char* ldsA, int tid, float (&ss)[4]) {
#pragma unroll
    for (int i = 0; i < 4; ++i) { uint4 v = a_cvt<SUMSQ>(r.v[i], ss[i]); *(uint4*)(ldsA + lds_off((tid >> 3) + 32 * i, tid & 7)) = v; }
}
template <bool SUMSQ> __device__ __forceinline__ void a_store(const ARaw<float>& r, char* ldsA, int tid, float (&ss)[4]) {
#pragma unroll
    for (int i = 0; i < 4; ++i) {
        const float4 a = r.v[i][0], b = r.v[i][1];
        if (SUMSQ) ss[i] += a.x * a.x + a.y * a.y + a.z * a.z + a.w * a.w + b.x * b.x + b.y * b.y + b.z * b.z + b.w * b.w;
        uint4 v; v.x = pack2(a.x, a.y); v.y = pack2(a.z, a.w); v.z = pack2(b.x, b.y); v.w = pack2(b.z, b.w);
        *(uint4*)(ldsA + lds_off((tid >> 3) + 32 * i, tid & 7)) = v;
    }
}

struct bf16x3_t {};
template <> struct ARaw<bf16x3_t> { uint4 a[4], b[4], c[4]; };
struct Rows3 { const bf16_t* p[2][4]; };
__device__ __forceinline__ void a_load(ARaw<bf16x3_t>& r, const Rows3& rows, int koff) {
#pragma unroll
    for (int i = 0; i < 4; ++i) { r.a[i] = *(const uint4*)(rows.p[0][i] + koff); r.b[i] = *(const uint4*)(rows.p[1][i] + koff); r.c[i] = *(const uint4*)(rows.p[1][i] + koff + 1024); }
}
__device__ __forceinline__ unsigned add3pk(unsigned a, unsigned b, unsigned c, float& ss) {
    const float lo = bflo(a) + bflo(b) + bflo(c), hi = bfhi(a) + bfhi(b) + bfhi(c);
    ss = fmaf(lo, lo, ss); ss = fmaf(hi, hi, ss);
    return pack2(lo, hi);
}
template <bool SUMSQ> __device__ __forceinline__ void a_store(const ARaw<bf16x3_t>& r, char* ldsA, int tid, float (&ss)[4]) {
#pragma unroll
    for (int i = 0; i < 4; ++i) {
        uint4 v;
        v.x = add3pk(r.a[i].x, r.b[i].x, r.c[i].x, ss[i]); v.y = add3pk(r.a[i].y, r.b[i].y, r.c[i].y, ss[i]);
        v.z = add3pk(r.a[i].z, r.b[i].z, r.c[i].z, ss[i]); v.w = add3pk(r.a[i].w, r.b[i].w, r.c[i].w, ss[i]);
        *(uint4*)(ldsA + lds_off((tid >> 3) + 32 * i, tid & 7)) = v;
    }
}

template <typename AT, bool SUMSQ, int SUNROLL = 4, typename AROWS>
__device__ __forceinline__ void gemm_mainloop(f32x16 (&acc)[2][2], const AROWS& arow, const bf16_t* const (&wrow)[4], int nkt, char* lds, float (&ss)[4], const int tid) {
    const int lane = tid & 63, wid = tid >> 6, wr = wid >> 1, wc = wid & 1;
    ARaw<AT> ra; ARaw<bf16_t> rb; float dummy[4] = {0.f, 0.f, 0.f, 0.f};
    a_load(ra, arow, 0); a_load(rb, wrow, 0);
    a_store<SUMSQ>(ra, lds, tid, ss); a_store<false>(rb, lds + 16384, tid, dummy);
    __syncthreads();
    const int fr = lane & 31, fh = lane >> 5;
#pragma unroll 1
    for (int kt = 0; kt < nkt; ++kt) {
        char* cur = lds + (kt & 1) * 32768;
        char* nxt = lds + ((kt + 1) & 1) * 32768;
        const bool more = (kt + 1 < nkt);
        if (more) { a_load(ra, arow, (kt + 1) * 64); a_load(rb, wrow, (kt + 1) * 64); }
#pragma unroll SUNROLL
        for (int s = 0; s < 4; ++s) {
            bf16x8 xa[2], wb[2];
#pragma unroll
            for (int i = 0; i < 2; ++i) xa[i] = *(const bf16x8*)(cur + lds_off(wr * 64 + i * 32 + fr, 2 * s + fh));
#pragma unroll
            for (int j = 0; j < 2; ++j) wb[j] = *(const bf16x8*)(cur + 16384 + lds_off(wc * 64 + j * 32 + fr, 2 * s + fh));
#pragma unroll
            for (int i = 0; i < 2; ++i)
#pragma unroll
                for (int j = 0; j < 2; ++j) acc[i][j] = __builtin_amdgcn_mfma_f32_32x32x16_bf16(wb[j], xa[i], acc[i][j], 0, 0, 0);
        }
        if (more) { a_store<SUMSQ>(ra, nxt, tid, ss); a_store<false>(rb, nxt + 16384, tid, dummy); }
        __syncthreads();
    }
}
constexpr int GST = 16384;
__device__ __forceinline__ int gl_chunk(int tid) { return (tid & 3) ^ ((tid >> 4) & 3); }
__device__ __forceinline__ int gl_off(int row, int chunk) { return row * 64 + ((chunk ^ ((row >> 2) & 3)) << 4); }
typedef __attribute__((address_space(3))) unsigned lds_u32_t;
__device__ __forceinline__ void glds16(const bf16_t* g, char* l) {
    __builtin_amdgcn_global_load_lds((const unsigned*)g, (lds_u32_t*)l, 16, 0, 0);
}
#define RAW_BARRIER() do { asm volatile("s_waitcnt lgkmcnt(0)" ::: "memory"); __builtin_amdgcn_s_barrier(); } while (0)
__device__ __forceinline__ void gemm_mainloop_g(f32x16 (&acc)[2][2], const bf16_t* const (&arow)[2], const bf16_t* const (&wrow)[2], const int nkt, char* lds, const int tid) {
    const int lane = tid & 63, wid = tid >> 6, wr = wid >> 1, wc = wid & 1, fr = lane & 31, fh = lane >> 5;
    const int wbase = __builtin_amdgcn_readfirstlane(wid) * 1024;
    asm volatile("s_waitcnt vmcnt(0)" ::: "memory");
#pragma unroll 1
    for (int p = 0; p < 3; ++p) if (p < nkt) {
        char* st = lds + p * GST + wbase;
        glds16(arow[0] + p * 32, st); glds16(arow[1] + p * 32, st + 4096);
        glds16(wrow[0] + p * 32, st + 8192); glds16(wrow[1] + p * 32, st + 8192 + 4096);
    }
    const int ra0 = gl_off(wr * 64 + fr, fh), ra1 = gl_off(wr * 64 + 32 + fr, fh);
    const int rb0 = 8192 + gl_off(wc * 64 + fr, fh), rb1 = 8192 + gl_off(wc * 64 + 32 + fr, fh);
#pragma unroll 1
    for (int kt = 0; kt < nkt; ++kt) {
        if (kt + 2 < nkt) asm volatile("s_waitcnt vmcnt(8)" ::: "memory");
        else if (kt + 1 < nkt) asm volatile("s_waitcnt vmcnt(4)" ::: "memory");
        else asm volatile("s_waitcnt vmcnt(0)" ::: "memory");
        RAW_BARRIER();
        if (kt + 3 < nkt) {
            char* st = lds + ((kt + 3) & 3) * GST + wbase;
            const int ko = (kt + 3) * 32;
            glds16(arow[0] + ko, st); glds16(arow[1] + ko, st + 4096);
            glds16(wrow[0] + ko, st + 8192); glds16(wrow[1] + ko, st + 8192 + 4096);
        }
        const char* cur = lds + (kt & 3) * GST;
        bf16x8 xa[2][2], wb[2][2];
#pragma unroll
        for (int s2 = 0; s2 < 2; ++s2) {
            xa[s2][0] = *(const bf16x8*)(cur + (ra0 ^ (s2 << 5))); xa[s2][1] = *(const bf16x8*)(cur + (ra1 ^ (s2 << 5)));
            wb[s2][0] = *(const bf16x8*)(cur + (rb0 ^ (s2 << 5))); wb[s2][1] = *(const bf16x8*)(cur + (rb1 ^ (s2 << 5)));
        }
        __builtin_amdgcn_sched_barrier(0);
#pragma unroll
        for (int s2 = 0; s2 < 2; ++s2) {
            acc[0][0] = __builtin_amdgcn_mfma_f32_32x32x16_bf16(wb[s2][0], xa[s2][0], acc[0][0], 0, 0, 0);
            acc[0][1] = __builtin_amdgcn_mfma_f32_32x32x16_bf16(wb[s2][1], xa[s2][0], acc[0][1], 0, 0, 0);
            acc[1][0] = __builtin_amdgcn_mfma_f32_32x32x16_bf16(wb[s2][0], xa[s2][1], acc[1][0], 0, 0, 0);
            acc[1][1] = __builtin_amdgcn_mfma_f32_32x32x16_bf16(wb[s2][1], xa[s2][1], acc[1][1], 0, 0, 0);
        }
    }
    RAW_BARRIER();
}
__device__ __forceinline__ int g64_chunk(int tid) { return (tid & 7) ^ ((tid >> 4) & 7); }
__device__ __forceinline__ void gemm_mainloop_g64(f32x16 (&acc)[2][2], const bf16_t* const (&arow)[4], const bf16_t* const (&wrow)[4], const int nkt, char* lds, const int tid) {
    const int lane = tid & 63, wid = tid >> 6, wr = wid >> 1, wc = wid & 1, fr = lane & 31, fh = lane >> 5;
    const int wbase = __builtin_amdgcn_readfirstlane(wid) * 1024;
    asm volatile("s_waitcnt vmcnt(0)" ::: "memory");
    {
        char* st = lds + wbase;
#pragma unroll
        for (int i = 0; i < 4; ++i) { glds16(arow[i], st + i * 4096); glds16(wrow[i], st + 16384 + i * 4096); }
    }
#pragma unroll 1
    for (int kt = 0; kt < nkt; ++kt) {
        asm volatile("s_waitcnt vmcnt(0)" ::: "memory");
        RAW_BARRIER();
        if (kt + 1 < nkt) {
            char* st = lds + ((kt + 1) & 1) * 32768 + wbase;
            const int ko = (kt + 1) * 64;
#pragma unroll
            for (int i = 0; i < 4; ++i) { glds16(arow[i] + ko, st + i * 4096); glds16(wrow[i] + ko, st + 16384 + i * 4096); }
        }
        const char* cur = lds + (kt & 1) * 32768;
#pragma unroll
        for (int s = 0; s < 4; ++s) {
            bf16x8 xa[2], wb[2];
#pragma unroll
            for (int i = 0; i < 2; ++i) xa[i] = *(const bf16x8*)(cur + lds_off(wr * 64 + i * 32 + fr, 2 * s + fh));
#pragma unroll
            for (int j = 0; j < 2; ++j) wb[j] = *(const bf16x8*)(cur + 16384 + lds_off(wc * 64 + j * 32 + fr, 2 * s + fh));
#pragma unroll
            for (int i = 0; i < 2; ++i)
#pragma unroll
                for (int j = 0; j < 2; ++j) acc[i][j] = __builtin_amdgcn_mfma_f32_32x32x16_bf16(wb[j], xa[i], acc[i][j], 0, 0, 0);
        }
    }
    RAW_BARRIER();
}
__device__ __forceinline__ void acc_zero(f32x16 (&acc)[2][2]) {
#pragma unroll
    for (int i = 0; i < 2; ++i)
#pragma unroll
        for (int j = 0; j < 2; ++j)
#pragma unroll
            for (int r = 0; r < 16; ++r) acc[i][j][r] = 0.f;
}
__device__ __forceinline__ void publish_rowstat(float (&ss)[4], float* stat, float invK, bool as_rstd, const int tid) {
#pragma unroll
    for (int i = 0; i < 4; ++i) {
        float v = ss[i];
        v += __shfl_xor(v, 1); v += __shfl_xor(v, 2); v += __shfl_xor(v, 4);
        if ((tid & 7) == 0) stat[(tid >> 3) + 32 * i] = as_rstd ? rsqrtf(v * invK + EPS) : v;
    }
    __syncthreads();
}
__device__ __forceinline__ int nidx(int r, int fh) { return (r & 3) + 8 * (r >> 2) + 4 * fh; }
__device__ __forceinline__ uint4 pack8(const float4& a, const float4& b) { uint4 pk; pk.x = pack2(a.x, a.y); pk.y = pack2(a.z, a.w); pk.z = pack2(b.x, b.y); pk.w = pack2(b.z, b.w); return pk; }
__device__ __forceinline__ float sq8(const float4& a, const float4& b) { return (a.x * a.x + a.y * a.y) + (a.z * a.z + a.w * a.w) + (b.x * b.x + b.y * b.y) + (b.z * b.z + b.w * b.w); }
__device__ __forceinline__ float4 mul4(const float4& a, float s) { return make_float4(a.x * s, a.y * s, a.z * s, a.w * s); }
__device__ __forceinline__ void store4(bf16_t* p, float a, float b, float c, float d) {
    uint2 v; v.x = pack2(a, b); v.y = pack2(c, d); *(uint2*)p = v;
}

__device__ __forceinline__ bool xcd_item(int it, int MT, int NTl, int& mt, int& nt) {
    const int x = blockIdx.x & 7, lb = blockIdx.x >> 3, nlb = gridDim.x >> 3;
    const int li = it * nlb + lb, per = (MT >> 3) * NTl;
    if (li >= per) return false;
    mt = (li / NTl) * 8 + x; nt = li % NTl; return true;
}

constexpr int TLD = 132;
constexpr int STAT_OFF = 128 * TLD * 4;
constexpr int LDS_GEMM_BYTES = STAT_OFF + 2048;
__device__ __forceinline__ void acc_to_lds(const f32x16 (&acc)[2][2], float* T, const int tid) {
    const int lane = tid & 63, wid = tid >> 6, wr = wid >> 1, wc = wid & 1, fr = lane & 31, fh = lane >> 5;
#pragma unroll
    for (int i = 0; i < 2; ++i)
#pragma unroll
        for (int j = 0; j < 2; ++j)
#pragma unroll
            for (int g = 0; g < 4; ++g) {
                float4 v; v.x = acc[i][j][4 * g]; v.y = acc[i][j][4 * g + 1]; v.z = acc[i][j][4 * g + 2]; v.w = acc[i][j][4 * g + 3];
                *(float4*)(T + (wr * 64 + i * 32 + fr) * TLD + wc * 64 + j * 32 + 8 * g + 4 * fh) = v;
            }
    __syncthreads();
}
__device__ __forceinline__ float rstd8(const float* p, float invK) {
    const float4 a = *(const float4*)p, b = *(const float4*)(p + 4);
    return rsq_(((a.x + a.y) + (a.z + a.w) + (b.x + b.y) + (b.z + b.w)) * invK + EPS);
}

}
namespace fx {

__device__ void phase_zgemm(const Params& P, int L, char* lds, const bool same = false) {
    const WS& w = P.w; const nv::Inputs& in = P.in;
    const int tid0 = opaque_tid();
    float* T = (float*)lds; float* stat = (float*)(lds + STAT_OFF);
    const bf16_t* Wt = w.W1t + L * W1_SZ;
    int mt, nt;
    for (int it = 0; xcd_item(it, 128, 12, mt, nt); ++it) {
        int tid = tid0; asm volatile("" : "+v"(tid));
        const int lane = tid & 63, wid = tid >> 6;
        const int m0 = mt * 128, n0 = nt * 128;
        {
            const bf16_t* arow[4]; const bf16_t* wrow[4];
#pragma unroll
            for (int i = 0; i < 4; ++i) {
                arow[i] = w.hb + (size_t)(m0 + (tid >> 3) + 32 * i) * 1024 + g64_chunk(tid) * 8;
                wrow[i] = Wt + (size_t)(n0 + (tid >> 3) + 32 * i) * 1024 + g64_chunk(tid) * 8;
            }
            f32x16 acc[2][2]; acc_zero(acc);
            float my_rs = 0.f;
            if (tid < 128) my_rs = rstd8(w.rssA + (size_t)(m0 + tid) * 8, 1.f / 1024.f);
            gemm_mainloop_g64(acc, arow, wrow, 16, lds, tid);
            if (tid < 128) stat[tid] = my_rs;
            acc_to_lds(acc, T, tid);
        }
        const int sub = lane >> 4, l16 = lane & 15, c8 = l16 * 8;
        if (nt < 2) {
#pragma unroll 8
            for (int rr = 0; rr < 8; ++rr) {
                const int row = wid * 32 + rr * 4 + sub; const float rs = stat[row];
                float4 x0 = *(const float4*)(T + row * TLD + c8), x1 = *(const float4*)(T + row * TLD + c8 + 4);
                x0.x = gelu_tanh_(x0.x * rs); x0.y = gelu_tanh_(x0.y * rs); x0.z = gelu_tanh_(x0.z * rs); x0.w = gelu_tanh_(x0.w * rs);
                x1.x = gelu_tanh_(x1.x * rs); x1.y = gelu_tanh_(x1.y * rs); x1.z = gelu_tanh_(x1.z * rs); x1.w = gelu_tanh_(x1.w * rs);
                *(uint4*)(w.ub + (size_t)(m0 + row) * 256 + nt * 128 + c8) = pack8(x0, x1);
            }
        } else if (nt < 4) {
            const int hd = (nt - 2) * 2 + (l16 >> 3), d0 = (l16 & 7) * 8;
            const float4 g0 = *(const float4*)(in.sgu_ln_g + L * 256 + hd * 64 + d0), g1 = *(const float4*)(in.sgu_ln_g + L * 256 + hd * 64 + d0 + 4);
            const float4 b0 = *(const float4*)(in.sgu_ln_b + L * 256 + hd * 64 + d0), b1 = *(const float4*)(in.sgu_ln_b + L * 256 + hd * 64 + d0 + 4);
#pragma unroll 4
            for (int rr = 0; rr < 8; ++rr) {
                const int row = wid * 32 + rr * 4 + sub; const float rs = stat[row];
                float4 x0 = *(const float4*)(T + row * TLD + c8), x1 = *(const float4*)(T + row * TLD + c8 + 4);
                x0.x = gelu_tanh_(x0.x * rs); x0.y = gelu_tanh_(x0.y * rs); x0.z = gelu_tanh_(x0.z * rs); x0.w = gelu_tanh_(x0.w * rs);
                x1.x = gelu_tanh_(x1.x * rs); x1.y = gelu_tanh_(x1.y * rs); x1.z = gelu_tanh_(x1.z * rs); x1.w = gelu_tanh_(x1.w * rs);
                const float mean = grp_sum8((x0.x + x0.y) + (x0.z + x0.w) + (x1.x + x1.y) + (x1.z + x1.w)) * (1.f / 64.f);
                x0.x -= mean; x0.y -= mean; x0.z -= mean; x0.w -= mean; x1.x -= mean; x1.y -= mean; x1.z -= mean; x1.w -= mean;
                const float rv = rsq_(grp_sum8(sq8(x0, x1)) * (1.f / 64.f) + EPS);
                x0.x = x0.x * rv * g0.x + b0.x; x0.y = x0.y * rv * g0.y + b0.y; x0.z = x0.z * rv * g0.z + b0.z; x0.w = x0.w * rv * g0.w + b0.w;
                x1.x = x1.x * rv * g1.x + b1.x; x1.y = x1.y * rv * g1.y + b1.y; x1.z = x1.z * rv * g1.z + b1.z; x1.w = x1.w * rv * g1.w + b1.w;
                *(float4*)(T + row * TLD + c8) = x0; *(float4*)(T + row * TLD + c8 + 4) = x1;
            }
            __syncthreads();
            {
                const int c = tid & 127, th = tid >> 7, hd2 = (nt - 2) * 2 + (c >> 6), d = c & 63;
                bf16_t* dst = w.vT + ((size_t)(mt * 4 + hd2) * 64 + d) * 128 + th * 64;
#pragma unroll 2
                for (int k8 = 0; k8 < 8; ++k8) {
                    float v[8];
#pragma unroll
                    for (int k = 0; k < 8; ++k) v[k] = T[(th * 64 + k8 * 8 + k) * TLD + c];
                    uint4 pk; pk.x = pack2(v[0], v[1]); pk.y = pack2(v[2], v[3]); pk.z = pack2(v[4], v[5]); pk.w = pack2(v[6], v[7]);
                    *(uint4*)(dst + k8 * 8) = pk;
                }
            }
        } else if (nt < 8) {
#pragma unroll 8
            for (int rr = 0; rr < 8; ++rr) {
                const int row = wid * 32 + rr * 4 + sub; const float rs = stat[row];
                const float4 x0 = *(const float4*)(T + row * TLD + c8), x1 = *(const float4*)(T + row * TLD + c8 + 4);
                store4(w.ygb + (size_t)(m0 + row) * 256 + (nt - 4) * 64 + l16 * 4, x0.x * rs * sigmoid_(x0.y * rs), x0.z * rs * sigmoid_(x0.w * rs),
                       x1.x * rs * sigmoid_(x1.y * rs), x1.z * rs * sigmoid_(x1.w * rs));
            }
        } else if (nt < 11) {
            bf16_t* base; int ld, cb;
            if (nt < 10) { base = w.cqb; ld = 256; cb = (nt - 8) * 128; } else { base = w.ckvb; ld = 128; cb = 0; }
#pragma unroll 8
            for (int rr = 0; rr < 8; ++rr) {
                const int row = wid * 32 + rr * 4 + sub; const float rs = stat[row];
                const float4 x0 = mul4(*(const float4*)(T + row * TLD + c8), rs), x1 = mul4(*(const float4*)(T + row * TLD + c8 + 4), rs);
                *(uint4*)(base + (size_t)(m0 + row) * ld + cb + c8) = pack8(x0, x1);
                const float sq = grp_sum16(sq8(x0, x1));
                if (l16 == 0) w.cqss[(size_t)(m0 + row) * 4 + (nt - 8)] = sq;
            }
        } else {
            const int lq = l16 & 3, dd = lq * 8, jj = (lq & 1) * 8;
            const float4 kg0 = *(const float4*)(in.k_norm_g + L * 96 + 64 + dd), kg1 = *(const float4*)(in.k_norm_g + L * 96 + 64 + dd + 4);
#pragma unroll 8
            for (int rr = 0; rr < 8; ++rr) {
                const int row = wid * 32 + rr * 4 + sub; const float rs = stat[row]; const int tok = m0 + row;
                float4 x0 = mul4(*(const float4*)(T + row * TLD + dd), rs), x1 = mul4(*(const float4*)(T + row * TLD + dd + 4), rs);
                const float rn = rsq_(grp_sum4(sq8(x0, x1)) * (1.f / 32.f) + EPS);
                x0.x *= rn * kg0.x; x0.y *= rn * kg0.y; x0.z *= rn * kg0.z; x0.w *= rn * kg0.w;
                x1.x *= rn * kg1.x; x1.y *= rn * kg1.y; x1.z *= rn * kg1.z; x1.w *= rn * kg1.w;
                const float4 o0 = make_float4(quad_x2(x0.x), quad_x2(x0.y), quad_x2(x0.z), quad_x2(x0.w)), o1 = make_float4(quad_x2(x1.x), quad_x2(x1.y), quad_x2(x1.z), quad_x2(x1.w));
                const float* csr = w.cs + (size_t)tok * 32 + jj;
                const float4 c0 = *(const float4*)csr, c1 = *(const float4*)(csr + 4), s0 = *(const float4*)(csr + 16), s1 = *(const float4*)(csr + 20);
                const float sg = (lq & 2) ? 1.f : -1.f;
                float4 r0, r1;
                r0.x = x0.x * c0.x + sg * o0.x * s0.x; r0.y = x0.y * c0.y + sg * o0.y * s0.y; r0.z = x0.z * c0.z + sg * o0.z * s0.z; r0.w = x0.w * c0.w + sg * o0.w * s0.w;
                r1.x = x1.x * c1.x + sg * o1.x * s1.x; r1.y = x1.y * c1.y + sg * o1.y * s1.y; r1.z = x1.z * c1.z + sg * o1.z * s1.z; r1.w = x1.w * c1.w + sg * o1.w * s1.w;
                if (l16 < 4) *(uint4*)(w.kpeb + (size_t)tok * 32 + dd) = pack8(r0, r1);
            }
        }
        __syncthreads();
    }
}

__global__ void k_shim_z(Params P, int t0) {
    const WS& w = P.w;
    size_t idx = (size_t)blockIdx.x * blockDim.x + threadIdx.x;
    if (idx >= (size_t)2048 * 1440) return;
    int t = t0 + (int)(idx / 1440), c = (int)(idx % 1440);
    float v = 0.f;
    if (c < 256) v = bf2f(w.ub[(size_t)t * 256 + c]);
    else if (c < 512) { int cc = c - 256; v = bf2f(w.vT[((size_t)((t >> 7) * 4 + (cc >> 6)) * 64 + (cc & 63)) * 128 + (t & 127)]); }
    else if (c < 768) v = bf2f(w.ygb[(size_t)t * 256 + c - 512]);
    else if (c < 1024) v = 0.f;
    else if (c < 1280) v = bf2f(w.cqb[(size_t)t * 256 + c - 1024]);
    else if (c < 1408) v = bf2f(w.ckvb[(size_t)t * 128 + c - 1280]);
    else v = bf2f(w.kpeb[(size_t)t * 32 + c - 1408]);
    P.zf[idx] = v;
}
__global__ void k_shim_hb(Params P) {
    size_t i = (size_t)blockIdx.x * blockDim.x + threadIdx.x;
    if (i >= (size_t)NT * 1024 / 4) return;
    float4 v = ((const float4*)P.h)[i];
    uint2 pk; pk.x = pack2(v.x, v.y); pk.y = pack2(v.z, v.w);
    ((uint2*)P.w.hb)[i] = pk;
}

}
namespace fx {

constexpr float QSCALE = 0.10206207261596575f * 1.4426950408889634f;

__device__ void qkv_item(const Params& P, int L, const bool isq, const int mt, const int nt, char* lds, const int tid_in) {
    int tid = tid_in; asm volatile("" : "+v"(tid));
    const WS& w = P.w; const nv::Inputs& in = P.in;
    const int lane = tid & 63, wid = tid >> 6;
    float* T = (float*)lds; float* stat = (float*)(lds + STAT_OFF);
    const int m0 = mt * 128, n0 = nt * 128;
    const int K = isq ? 256 : 128;
    {
        const bf16_t* A = isq ? w.cqb : w.ckvb;
        const bf16_t* Wt = isq ? (w.Wuqt + L * WUQ_SZ) : (w.Wukvt + L * WUKV_SZ);
        const bf16_t* arow[2]; const bf16_t* wrow[2];
#pragma unroll
        for (int i = 0; i < 2; ++i) {
            arow[i] = A + (size_t)(m0 + (tid >> 2) + 64 * i) * K + gl_chunk(tid) * 8;
            wrow[i] = Wt + (size_t)(n0 + (tid >> 2) + 64 * i) * K + gl_chunk(tid) * 8;
        }
        f32x16 acc[2][2]; acc_zero(acc);
        float my_rs = 0.f;
        if (tid < 128) {
            const float4 c = *(const float4*)(w.cqss + (size_t)(m0 + tid) * 4);
            my_rs = isq ? rsq_((c.x + c.y) * (1.f / 256.f) + EPS) : rsq_(c.z * (1.f / 128.f) + EPS);
        }
        gemm_mainloop_g(acc, arow, wrow, K / 32, lds, tid);
        if (tid < 128) stat[tid] = my_rs;
        acc_to_lds(acc, T, tid);
    }
    const int b = m0 >> 11, s0 = m0 & 2047;
    const int sub = lane >> 4, l16 = lane & 15, c8 = l16 * 8;
    if (isq && nt < 4) {
        const int hd = nt * 2 + (l16 >> 3), d = (l16 & 7) * 8;
        const float4 g0 = mul4(*(const float4*)(in.q_norm_g + L * 96 + d), QSCALE), g1 = mul4(*(const float4*)(in.q_norm_g + L * 96 + d + 4), QSCALE);
        bf16_t* dst = w.Qb + ((size_t)(b * 8 + hd) * 2048 + s0) * 96 + d;
#pragma unroll 8
        for (int rr = 0; rr < 8; ++rr) {
            const int row = wid * 32 + rr * 4 + sub; const float rs = stat[row];
            float4 x0 = mul4(*(const float4*)(T + row * TLD + c8), rs), x1 = mul4(*(const float4*)(T + row * TLD + c8 + 4), rs);
            const float rn = rsq_(grp_sum8(sq8(x0, x1)) * (1.f / 64.f) + EPS);
            x0.x *= rn * g0.x; x0.y *= rn * g0.y; x0.z *= rn * g0.z; x0.w *= rn * g0.w; x1.x *= rn * g1.x; x1.y *= rn * g1.y; x1.z *= rn * g1.z; x1.w *= rn * g1.w;
            *(uint4*)(dst + (size_t)row * 96) = pack8(x0, x1);
        }
    } else if (isq) {
        const int hd = (nt - 4) * 4 + (l16 >> 2), lq = l16 & 3, dd = lq * 8, jj = (lq & 1) * 8;
        const float4 g0 = *(const float4*)(in.q_norm_g + L * 96 + 64 + dd), g1 = *(const float4*)(in.q_norm_g + L * 96 + 64 + dd + 4);
        bf16_t* dst = w.Qb + ((size_t)(b * 8 + hd) * 2048 + s0) * 96 + 64 + dd;
        const float sg = (lq & 2) ? QSCALE : -QSCALE;
#pragma unroll 8
        for (int rr = 0; rr < 8; ++rr) {
            const int row = wid * 32 + rr * 4 + sub; const float rs = stat[row]; const int tok = m0 + row;
            float4 x0 = mul4(*(const float4*)(T + row * TLD + c8), rs), x1 = mul4(*(const float4*)(T + row * TLD + c8 + 4), rs);
            const float rn = rsq_(grp_sum4(sq8(x0, x1)) * (1.f / 32.f) + EPS);
            x0.x *= rn * g0.x; x0.y *= rn * g0.y; x0.z *= rn * g0.z; x0.w *= rn * g0.w; x1.x *= rn * g1.x; x1.y *= rn * g1.y; x1.z *= rn * g1.z; x1.w *= rn * g1.w;
            const float4 o0 = make_float4(quad_x2(x0.x), quad_x2(x0.y), quad_x2(x0.z), quad_x2(x0.w)), o1 = make_float4(quad_x2(x1.x), quad_x2(x1.y), quad_x2(x1.z), quad_x2(x1.w));
            const float* csr = w.cs + (size_t)tok * 32 + jj;
            const float4 c0 = mul4(*(const float4*)csr, QSCALE), c1 = mul4(*(const float4*)(csr + 4), QSCALE), s0v = *(const float4*)(csr + 16), s1v = *(const float4*)(csr + 20);
            float4 r0, r1;
            r0.x = x0.x * c0.x + sg * o0.x * s0v.x; r0.y = x0.y * c0.y + sg * o0.y * s0v.y; r0.z = x0.z * c0.z + sg * o0.z * s0v.z; r0.w = x0.w * c0.w + sg * o0.w * s0v.w;
            r1.x = x1.x * c1.x + sg * o1.x * s1v.x; r1.y = x1.y * c1.y + sg * o1.y * s1v.y; r1.z = x1.z * c1.z + sg * o1.z * s1v.z; r1.w = x1.w * c1.w + sg * o1.w * s1v.w;
            *(uint4*)(dst + (size_t)row * 96) = pack8(r0, r1);
        }
    } else if (nt < 4) {
        const int hd = nt * 2 + (l16 >> 3), d = (l16 & 7) * 8;
        const float4 g0 = *(const float4*)(in.k_norm_g + L * 96 + d), g1 = *(const float4*)(in.k_norm_g + L * 96 + d + 4);
        bf16_t* dst = w.Knb + ((size_t)(b * 8 + hd) * 2048 + s0) * 64 + d;
#pragma unroll 8
        for (int rr = 0; rr < 8; ++rr) {
            const int row = wid * 32 + rr * 4 + sub; const float rs = stat[row];
            float4 x0 = mul4(*(const float4*)(T + row * TLD + c8), rs), x1 = mul4(*(const float4*)(T + row * TLD + c8 + 4), rs);
            const float rn = rsq_(grp_sum8(sq8(x0, x1)) * (1.f / 64.f) + EPS);
            x0.x *= rn * g0.x; x0.y *= rn * g0.y; x0.z *= rn * g0.z; x0.w *= rn * g0.w; x1.x *= rn * g1.x; x1.y *= rn * g1.y; x1.z *= rn * g1.z; x1.w *= rn * g1.w;
            *(uint4*)(dst + (size_t)row * 64) = pack8(x0, x1);
        }
    } else {
        const int c = tid & 127, th = tid >> 7, hd = (nt - 4) * 2 + (c >> 6), d = c & 63;
        bf16_t* dst = w.VTb + ((size_t)(b * 8 + hd) * 64 + d) * 2048 + s0 + th * 64;
#pragma unroll 2
        for (int k8 = 0; k8 < 8; ++k8) {
            float v[8];
#pragma unroll
            for (int k = 0; k < 8; ++k) { const int row = th * 64 + k8 * 8 + k; v[k] = T[row * TLD + c] * stat[row]; }
            uint4 pk; pk.x = pack2(v[0], v[1]); pk.y = pack2(v[2], v[3]); pk.z = pack2(v[4], v[5]); pk.w = pack2(v[6], v[7]);
            *(uint4*)(dst + k8 * 8) = pk;
        }
    }
    __syncthreads();
}

__device__ void sgu_item(const Params& P, int L, int mt, char* lds, const int tid_in) {
    int tid = tid_in; asm volatile("" : "+v"(tid));
    const WS& w = P.w; const nv::Inputs& in = P.in;
    const int lane = tid & 63, hd = tid >> 6, fr = lane & 31, fh = lane >> 5;
    float* red = (float*)lds;
    const bf16_t* vt = w.vT + (size_t)(mt * 4 + hd) * 64 * 128;
    const bf16_t* ws = w.Wsm + L * WSM_SZ + (size_t)hd * 128 * 128;
    const float* bs = in.sgu_b + L * 512 + hd * 128;
    const int m0 = mt * 128;
#pragma unroll 1
    for (int it = 0; it < 4; ++it) {
        f32x16 a0, a1;
#pragma unroll
        for (int r = 0; r < 16; ++r) { a0[r] = 0.f; a1[r] = 0.f; }
        const int nks = 2 * (it + 1);
        const bf16_t* bp = ws + (size_t)(it * 32 + fr) * 128 + 8 * fh;
        const bf16_t* ap0 = vt + (size_t)fr * 128 + 8 * fh;
        const bf16_t* ap1 = vt + (size_t)(32 + fr) * 128 + 8 * fh;
#pragma unroll 2
        for (int s = 0; s < nks; ++s) {
            const bf16x8 bfrag = *(const bf16x8*)(bp + 16 * s);
            const bf16x8 af0 = *(const bf16x8*)(ap0 + 16 * s), af1 = *(const bf16x8*)(ap1 + 16 * s);
            a0 = __builtin_amdgcn_mfma_f32_32x32x16_bf16(af0, bfrag, a0, 0, 0, 0);
            a1 = __builtin_amdgcn_mfma_f32_32x32x16_bf16(af1, bfrag, a1, 0, 0, 0);
        }
        const int i = it * 32 + fr, tok = m0 + i;
        const float bias = bs[i];
        float ssq = 0.f;
#pragma unroll
        for (int dt = 0; dt < 2; ++dt)
#pragma unroll
            for (int g = 0; g < 4; ++g) {
                const int d = dt * 32 + 8 * g + 4 * fh;
                const uint2 uu = *(const uint2*)(w.ub + (size_t)tok * 256 + hd * 64 + d);
                float o[4];
#pragma unroll
                for (int q = 0; q < 4; ++q) {
                    const float sv = (dt == 0 ? a0[4 * g + q] : a1[4 * g + q]) + bias;
                    const float uv = (q == 0) ? bflo(uu.x) : (q == 1) ? bfhi(uu.x) : (q == 2) ? bflo(uu.y) : bfhi(uu.y);
                    o[q] = uv * sv; ssq += o[q] * o[q];
                }
                store4(w.yb + (size_t)tok * 1024 + hd * 64 + d, o[0], o[1], o[2], o[3]);
            }
        ssq = xor32(ssq);
        if (fh == 0) red[hd * 128 + i] = ssq;
    }
    __syncthreads();
    if (tid < 128) w.ssq[(size_t)(m0 + tid) * 16 + 0] = red[tid] + red[128 + tid] + red[256 + tid] + red[384 + tid];
    __syncthreads();
}

constexpr int CLD = 260, CONV_YL = 32 * CLD * 4, CONV_ST = CONV_YL + 32 * 512, CONV_RED = CONV_ST + 32 * 4 * 8;
__device__ __forceinline__ int yl_off(int row, int chunk) { return row * 512 + ((chunk ^ (row & 15)) << 4); }
__device__ void conv_item(const Params& P, int L, int ct, char* lds, const int tid_in) {
    int tid = tid_in; asm volatile("" : "+v"(tid));
    const WS& w = P.w; const nv::Inputs& in = P.in;
    const int lane = tid & 63, wid = tid >> 6, fr = lane & 31, fh = lane >> 5;
    float* C = (float*)lds; char* yl = lds + CONV_YL; float2* stats = (float2*)(lds + CONV_ST); float* red = (float*)(lds + CONV_RED);
    const int t0 = ct * 32, s0 = t0 & 2047;
    {
        const int c = tid;
        float x[62];
#pragma unroll
        for (int r = 0; r < 62; ++r) x[r] = (s0 + r - 30 >= 0) ? bf2f(w.ygb[(size_t)(t0 + r - 30) * 256 + c]) : 0.f;
        float wk[31];
#pragma unroll
        for (int k = 0; k < 31; ++k) wk[k] = in.conv_w[(size_t)L * 31 * 256 + k * 256 + c];
        const float cb = in.conv_b[L * 256 + c];
#pragma unroll
        for (int t = 0; t < 32; ++t) {
            float a = cb;
#pragma unroll
            for (int k = 0; k < 31; ++k) a = fmaf(wk[k], x[t + k], a);
            C[t * CLD + c] = a;
        }
    }
    __syncthreads();
    if (tid < 128) {
        const int t = tid >> 2, g = tid & 3;
        const float4* cp = (const float4*)(C + t * CLD + g * 64);
        float4 v[16]; float s = 0.f;
#pragma unroll
        for (int i = 0; i < 16; ++i) { v[i] = cp[i]; s += (v[i].x + v[i].y) + (v[i].z + v[i].w); }
        const float mean = s * (1.f / 64.f); float q = 0.f;
#pragma unroll
        for (int i = 0; i < 16; ++i) { const float a = v[i].x - mean, b2 = v[i].y - mean, c2 = v[i].z - mean, d2 = v[i].w - mean; q += (a * a + b2 * b2) + (c2 * c2 + d2 * d2); }
        stats[t * 4 + g] = make_float2(mean, rsq_(q * (1.f / 64.f) + EPS));
    }
    __syncthreads();
    {
        const int c = tid, g = c >> 6;
        const float lg = in.conv_ln_g[L * 256 + c], lb = in.conv_ln_b[L * 256 + c];
#pragma unroll 8
        for (int t = 0; t < 32; ++t) {
            const float2 st = stats[t * 4 + g];
            const float v = (C[t * CLD + c] - st.x) * st.y * lg + lb;
            *(bf16_t*)(yl + yl_off(t, c >> 3) + (c & 7) * 2) = (bf16_t)f2bf(v * sigmoid_(v));
        }
    }
    __syncthreads();
    f32x16 acc0, acc1;
#pragma unroll
    for (int r = 0; r < 16; ++r) { acc0[r] = 0.f; acc1[r] = 0.f; }
    const bf16_t* wp = w.Wpwt + L * WPW_SZ + (size_t)(wid * 64 + fr) * 256 + 8 * fh;
#pragma unroll 4
    for (int s = 0; s < 16; ++s) {
        const bf16x8 w0 = *(const bf16x8*)(wp + 16 * s), w1 = *(const bf16x8*)(wp + 32 * 256 + 16 * s);
        const bf16x8 x0 = *(const bf16x8*)(yl + yl_off(fr, 2 * s + fh));
        acc0 = __builtin_amdgcn_mfma_f32_32x32x16_bf16(w0, x0, acc0, 0, 0, 0);
        acc1 = __builtin_amdgcn_mfma_f32_32x32x16_bf16(w1, x0, acc1, 0, 0, 0);
    }
    const float* pb = in.conv_pw_b + L * 256;
    {
        const int tok = t0 + fr;
        float ssq = 0.f;
#pragma unroll
        for (int jn = 0; jn < 2; ++jn)
#pragma unroll
            for (int g = 0; g < 4; ++g) {
                const int n = wid * 64 + jn * 32 + 8 * g + 4 * fh;
                const float4 b4 = *(const float4*)(pb + n);
                const float o0 = (jn ? acc1[4 * g] : acc0[4 * g]) + b4.x, o1 = (jn ? acc1[4 * g + 1] : acc0[4 * g + 1]) + b4.y;
                const float o2 = (jn ? acc1[4 * g + 2] : acc0[4 * g + 2]) + b4.z, o3 = (jn ? acc1[4 * g + 3] : acc0[4 * g + 3]) + b4.w;
                ssq += o0 * o0 + o1 * o1 + o2 * o2 + o3 * o3;
                store4(w.yb + (size_t)tok * 1024 + 256 + n, o0, o1, o2, o3);
            }
        ssq = xor32(ssq);
        if (fh == 0) red[wid * 32 + fr] = ssq;
    }
    __syncthreads();
    if (tid < 32) w.ssq[(size_t)(t0 + tid) * 16 + 1] = red[tid] + red[32 + tid] + red[64 + tid] + red[96 + tid];
    __syncthreads();
}

__device__ void phase_mix(const Params& P, int L, char* lds) {
    const int tid = opaque_tid();
    int mt, nt;
    for (int it = 0; xcd_item(it, 128, 6, mt, nt); ++it) qkv_item(P, L, true, mt, nt, lds, tid);
    for (int it = 0; xcd_item(it, 128, 8, mt, nt); ++it) qkv_item(P, L, false, mt, nt, lds, tid);
    for (int ct = blockIdx.x; ct < 512; ct += gridDim.x) conv_item(P, L, ct, lds, tid);
    {
        const int x = blockIdx.x & 7, lb = blockIdx.x >> 3, nlb = gridDim.x >> 3;
        const int lo = nlb >= 48 ? 32 : 0;
        for (int j = lb - lo; j >= 0 && j < 16; j += nlb) sgu_item(P, L, j * 8 + x, lds, tid);
    }
}

__global__ void k_shim_qkv(Params P, int t0, float* q, float* kv) {
    const WS& w = P.w;
    size_t idx = (size_t)blockIdx.x * blockDim.x + threadIdx.x;
    if (idx >= (size_t)2048 * 1792) return;
    const int tl = (int)(idx / 1792), c = (int)(idx % 1792), t = t0 + tl, b = t >> 11, s = t & 2047;
    if (c < 768) { const int h = c / 96, d = c % 96; q[(size_t)tl * 768 + c] = bf2f(w.Qb[((size_t)(b * 8 + h) * 2048 + s) * 96 + d]) * (1.f / QSCALE); }
    else {
        const int cc = c - 768, h = cc >> 7, d = cc & 127;
        kv[(size_t)tl * 1024 + cc] = (d < 64) ? bf2f(w.Knb[((size_t)(b * 8 + h) * 2048 + s) * 64 + d]) : bf2f(w.VTb[((size_t)(b * 8 + h) * 64 + (d - 64)) * 2048 + s]);
    }
}
__global__ void k_shim_y(Params P, int t0, int c0, int c1) {
    const int wdt = c1 - c0;
    size_t idx = (size_t)blockIdx.x * blockDim.x + threadIdx.x;
    if (idx >= (size_t)2048 * wdt) return;
    const int tl = (int)(idx / wdt), c = c0 + (int)(idx % wdt);
    P.yf[(size_t)tl * 1024 + c] = bf2f(P.w.yb[(size_t)(t0 + tl) * 1024 + c]);
}

}
namespace fx {

constexpr int KROW = 208, VROW = 136, ATT_STAGE = 64 * KROW + 64 * VROW;

struct KVRegs { uint4 k0, k1, k2, v0, v1; };
__device__ __forceinline__ uint4 k_ld(const bf16_t* Kn, const bf16_t* Kp, int k0, int c) {
    const int key = c / 12, ch = c % 12;
    const bf16_t* src = (ch < 8) ? (Kn + (size_t)(k0 + key) * 64 + ch * 8) : (Kp + (size_t)(k0 + key) * 32 + (ch - 8) * 8);
    return *(const uint4*)src;
}
__device__ __forceinline__ void kv_load(KVRegs& r, const bf16_t* Kn, const bf16_t* Kp, const bf16_t* Vt, int k0, const int tid) {
    r.k0 = k_ld(Kn, Kp, k0, tid); r.k1 = k_ld(Kn, Kp, k0, tid + 256); r.k2 = k_ld(Kn, Kp, k0, tid + 512);
    r.v0 = *(const uint4*)(Vt + (size_t)(tid >> 3) * 2048 + k0 + (tid & 7) * 8);
    r.v1 = *(const uint4*)(Vt + (size_t)(32 + (tid >> 3)) * 2048 + k0 + (tid & 7) * 8);
}
__device__ __forceinline__ void k_st(char* st, int c, const uint4& v) { const int key = c / 12, ch = c % 12; *(uint4*)(st + key * KROW + ch * 16) = v; }
__device__ __forceinline__ void v_st(char* st, int d, int ch, const uint4& v) {
    char* p = st + 64 * KROW + d * VROW + ch * 16;
    *(uint2*)p = make_uint2(v.x, v.y); *(uint2*)(p + 8) = make_uint2(v.z, v.w);
}
__device__ __forceinline__ void kv_store(const KVRegs& r, char* st, const int tid) {
    k_st(st, tid, r.k0); k_st(st, tid + 256, r.k1); k_st(st, tid + 512, r.k2);
    v_st(st, tid >> 3, tid & 7, r.v0); v_st(st, 32 + (tid >> 3), tid & 7, r.v1);
}

__device__ void attn_unit(const Params& P, int b, int h, int qt, char* lds, const int tid) {
    const WS& w = P.w;
    const int lane = tid & 63, wid = tid >> 6, fr = lane & 31, fh = lane >> 5;
    const bf16_t* Kn = w.Knb + (size_t)(b * 8 + h) * 2048 * 64;
    const bf16_t* Kp = w.kpeb + (size_t)b * 2048 * 32;
    const bf16_t* Vt = w.VTb + (size_t)(b * 8 + h) * 64 * 2048;
    const int q0 = qt * 128, qw0 = q0 + wid * 32, qpos = qw0 + fr;
    bf16x8 qf[6];
    {
        const bf16_t* qp = w.Qb + ((size_t)(b * 8 + h) * 2048 + qpos) * 96 + 8 * fh;
#pragma unroll
        for (int ks = 0; ks < 6; ++ks) qf[ks] = *(const bf16x8*)(qp + 16 * ks);
    }
    f32x16 o0, o1;
#pragma unroll
    for (int r = 0; r < 16; ++r) { o0[r] = 0.f; o1[r] = 0.f; }
    float m = -1e30f, l = 0.f;
    const int nkt = 2 * (qt + 1);
    KVRegs kr;
    kv_load(kr, Kn, Kp, Vt, 0, tid);
    kv_store(kr, lds, tid);
    __syncthreads();
#pragma unroll 1
    for (int kt = 0; kt < nkt; ++kt) {
        char* cur = lds + (kt & 1) * ATT_STAGE;
        char* nxt = lds + ((kt + 1) & 1) * ATT_STAGE;
        const bool more = kt + 1 < nkt;
        if (more) kv_load(kr, Kn, Kp, Vt, (kt + 1) * 64, tid);
        const int k0 = kt * 64;
        if (k0 <= qw0 + 31) {
            f32x16 s0, s1;
#pragma unroll
            for (int r = 0; r < 16; ++r) { s0[r] = 0.f; s1[r] = 0.f; }
            const char* kb = cur + fr * KROW + fh * 16;
#pragma unroll
            for (int ks = 0; ks < 6; ++ks) {
                const bf16x8 ka = *(const bf16x8*)(kb + ks * 32), kb2 = *(const bf16x8*)(kb + 32 * KROW + ks * 32);
                s0 = __builtin_amdgcn_mfma_f32_32x32x16_bf16(ka, qf[ks], s0, 0, 0, 0);
                s1 = __builtin_amdgcn_mfma_f32_32x32x16_bf16(kb2, qf[ks], s1, 0, 0, 0);
            }
            if (k0 + 63 > qw0) {
#pragma unroll
                for (int r = 0; r < 16; ++r) {
                    const int key = k0 + nidx(r, fh);
                    if (key > qpos) s0[r] = -1e30f;
                    if (key + 32 > qpos) s1[r] = -1e30f;
                }
            }
            float mx = s0[0];
#pragma unroll
            for (int r = 1; r < 16; ++r) mx = fmaxf(mx, s0[r]);
#pragma unroll
            for (int r = 0; r < 16; ++r) mx = fmaxf(mx, s1[r]);
            mx = swap32_max(mx);
            const float mn = fmaxf(m, mx);
            const float alpha = __builtin_amdgcn_exp2f(m - mn);
            m = mn;
            float ps = 0.f;
#pragma unroll
            for (int r = 0; r < 16; ++r) { s0[r] = __builtin_amdgcn_exp2f(s0[r] - mn); ps += s0[r]; }
#pragma unroll
            for (int r = 0; r < 16; ++r) { s1[r] = __builtin_amdgcn_exp2f(s1[r] - mn); ps += s1[r]; }
            ps = swap32_sum(ps);
            l = l * alpha + ps;
#pragma unroll
            for (int r = 0; r < 16; ++r) { o0[r] *= alpha; o1[r] *= alpha; }
            const char* vb = cur + 64 * KROW + fr * VROW + fh * 8;
#pragma unroll
            for (int ks = 0; ks < 4; ++ks) {
                bf16x8 pf;
                {
                    const int rb = 8 * (ks & 1);
                    unsigned u0, u1, u2, u3;
                    if (ks < 2) { u0 = pack2(s0[rb], s0[rb + 1]); u1 = pack2(s0[rb + 2], s0[rb + 3]); u2 = pack2(s0[rb + 4], s0[rb + 5]); u3 = pack2(s0[rb + 6], s0[rb + 7]); }
                    else { u0 = pack2(s1[rb], s1[rb + 1]); u1 = pack2(s1[rb + 2], s1[rb + 3]); u2 = pack2(s1[rb + 4], s1[rb + 5]); u3 = pack2(s1[rb + 6], s1[rb + 7]); }
                    uint4 uu = make_uint4(u0, u1, u2, u3);
                    pf = __builtin_bit_cast(bf16x8, uu);
                }
                const uint2 va0 = *(const uint2*)(vb + ks * 32), va1 = *(const uint2*)(vb + ks * 32 + 16);
                const uint2 vb0 = *(const uint2*)(vb + 32 * VROW + ks * 32), vb1 = *(const uint2*)(vb + 32 * VROW + ks * 32 + 16);
                const bf16x8 vfa = __builtin_bit_cast(bf16x8, make_uint4(va0.x, va0.y, va1.x, va1.y));
                const bf16x8 vfb = __builtin_bit_cast(bf16x8, make_uint4(vb0.x, vb0.y, vb1.x, vb1.y));
                o0 = __builtin_amdgcn_mfma_f32_32x32x16_bf16(vfa, pf, o0, 0, 0, 0);
                o1 = __builtin_amdgcn_mfma_f32_32x32x16_bf16(vfb, pf, o1, 0, 0, 0);
            }
        }
        if (more) kv_store(kr, nxt, tid);
        __syncthreads();
    }
    const float inv = 1.f / l;
    const int tok = b * 2048 + qpos;
    float ssq = 0.f;
#pragma unroll
    for (int dt = 0; dt < 2; ++dt)
#pragma unroll
        for (int g = 0; g < 4; ++g) {
            float o[4];
#pragma unroll
            for (int q = 0; q < 4; ++q) { o[q] = (dt == 0 ? o0[4 * g + q] : o1[4 * g + q]) * inv; ssq += o[q] * o[q]; }
            store4(w.yb + (size_t)tok * 1024 + 512 + h * 64 + dt * 32 + 8 * g + 4 * fh, o[0], o[1], o[2], o[3]);
        }
    ssq = xor32(ssq);
    if (fh == 0) w.ssq[(size_t)tok * 16 + 8 + h] = ssq;
}

__device__ void phase_attn(const Params& P, int L, char* lds) {
    const int tid0 = opaque_tid();
    const int h = blockIdx.x & 7, nlb = gridDim.x >> 3;
    for (int li = blockIdx.x >> 3; li < 64; li += nlb) {
        int tid = tid0; asm volatile("" : "+v"(tid));
        const int p = li & 7, b = li >> 3;
        attn_unit(P, b, h, 15 - p, lds, tid);
        attn_unit(P, b, h, p, lds, tid);
    }
}

}
namespace fx {

__device__ __forceinline__ void acc_scale(f32x16 (&acc)[2][2], const float* f, const int tid) {
    const int lane = tid & 63, wr = tid >> 7, fr = lane & 31;
#pragma unroll
    for (int i = 0; i < 2; ++i) {
        const float v = f[wr * 64 + i * 32 + fr];
#pragma unroll
        for (int j = 0; j < 2; ++j)
#pragma unroll
            for (int r = 0; r < 16; ++r) acc[i][j][r] *= v;
    }
}
__device__ void phase_oproj(const Params& P, int L, char* lds, const bool dry = false) {
    const WS& w = P.w;
    const int tid0 = opaque_tid();
    float* T = (float*)lds; float* stat = (float*)(lds + STAT_OFF);
    const bf16_t* Wt = w.Wot + L * WO_SZ;
    int mt, nt;
    for (int it = 0; xcd_item(it, 128, 8, mt, nt); ++it) {
        int tid = tid0; asm volatile("" : "+v"(tid));
        const int lane = tid & 63, wid = tid >> 6;
        const int m0 = mt * 128, n0 = nt * 128;
        float rb_keep = 0.f;
        if (tid < 128) {
            const float* sq = w.ssq + (size_t)(m0 + tid) * 16;
            const float4 c0 = *(const float4*)(sq + 8), c1 = *(const float4*)(sq + 12);
            const float ra = rsq_(sq[0] * (1.f / 256.f) + EPS), rb = rsq_(sq[1] * (1.f / 256.f) + EPS);
            const float rc = rsq_((c0.x + c0.y + c0.z + c0.w + c1.x + c1.y + c1.z + c1.w) * (1.f / 512.f) + EPS);
            stat[tid] = rc / ra; stat[128 + tid] = ra / rb; rb_keep = rb;
        }
        {
            const bf16_t* arow[2]; const bf16_t* wrow[2];
#pragma unroll
            for (int i = 0; i < 2; ++i) {
                arow[i] = w.yb + (size_t)(m0 + (tid >> 2) + 64 * i) * 1024 + gl_chunk(tid) * 8 + 512;
                wrow[i] = Wt + (size_t)(n0 + (tid >> 2) + 64 * i) * 1024 + gl_chunk(tid) * 8 + 512;
            }
            f32x16 acc[2][2]; acc_zero(acc);
            gemm_mainloop_g(acc, arow, wrow, 16, lds, tid);
            acc_scale(acc, stat, tid);
#pragma unroll
            for (int i = 0; i < 2; ++i) { arow[i] -= 512; wrow[i] -= 512; }
            gemm_mainloop_g(acc, arow, wrow, 8, lds, tid);
            acc_scale(acc, stat + 128, tid);
#pragma unroll
            for (int i = 0; i < 2; ++i) { arow[i] += 256; wrow[i] += 256; }
            gemm_mainloop_g(acc, arow, wrow, 8, lds, tid);
            if (tid < 128) stat[tid] = rb_keep;
            acc_to_lds(acc, T, tid);
        }
        {
            const int sub = lane >> 4, c8 = (lane & 15) * 8;
#pragma unroll 8
            for (int rr = 0; rr < 8; ++rr) {
                const int row = wid * 32 + rr * 4 + sub; const float rb = stat[row];
                const float4 x0 = *(const float4*)(T + row * TLD + c8), x1 = *(const float4*)(T + row * TLD + c8 + 4);
                float4* hp = (float4*)(P.h + (size_t)(m0 + row) * 1024 + n0 + c8);
                const float4* hin = (const float4*)((L == 0 ? P.in.x : P.h) + (size_t)(m0 + row) * 1024 + n0 + c8);
                float4 h0 = hin[0], h1 = hin[1];
                h0.x += x0.x * rb; h0.y += x0.y * rb; h0.z += x0.z * rb; h0.w += x0.w * rb;
                h1.x += x1.x * rb; h1.y += x1.y * rb; h1.z += x1.z * rb; h1.w += x1.w * rb;
                if (!dry) { hp[0] = h0; hp[1] = h1; }
                uint4 pk; pk.x = pack2(h0.x, h0.y); pk.y = pack2(h0.z, h0.w); pk.z = pack2(h1.x, h1.y); pk.w = pack2(h1.z, h1.w);
                *(uint4*)(w.hb1 + (size_t)(m0 + row) * 1024 + n0 + c8) = pk;
                float sq = (h0.x * h0.x + h0.y * h0.y) + (h0.z * h0.z + h0.w * h0.w) + (h1.x * h1.x + h1.y * h1.y) + (h1.z * h1.z + h1.w * h1.w);
                sq = grp_sum16(sq);
                if ((lane & 15) == 0) w.rssB[(size_t)(m0 + row) * 8 + nt] = sq;
            }
        }
        __syncthreads();
    }
}

__device__ void router_item(const Params& P, int L, int mt, char* lds, const int tid_in, const bool dry) {
    int tid = tid_in; asm volatile("" : "+v"(tid));
    const WS& w = P.w; const nv::Inputs& in = P.in;
    float* T = (float*)lds; float* stat = (float*)(lds + STAT_OFF); int* hist = (int*)(lds + STAT_OFF + 1024);
    const int m0 = mt * 128;
    {
        const bf16_t* arow[2]; const bf16_t* wrow[2];
#pragma unroll
        for (int i = 0; i < 2; ++i) {
            arow[i] = w.hb1 + (size_t)(m0 + (tid >> 2) + 64 * i) * 1024 + gl_chunk(tid) * 8;
            wrow[i] = w.Wrt + L * WR_SZ + (size_t)((tid >> 2) + 64 * i) * 1024 + gl_chunk(tid) * 8;
        }
        f32x16 acc[2][2]; acc_zero(acc);
        float my_rs = 0.f;
        if (tid < 128) my_rs = rstd8(w.rssB + (size_t)(m0 + tid) * 8, 1.f / 1024.f);
        gemm_mainloop_g(acc, arow, wrow, 32, lds, tid);
        if (tid < 128) stat[tid] = my_rs;
        if (tid < 32) hist[tid] = 0;
        acc_to_lds(acc, T, tid);
    }
    int e0 = 0, e1 = 0, r0 = 0, r1 = 0; float w0 = 0.f, w1 = 0.f;
    if (tid < 128) {
        const float rs = stat[tid];
        const float* lr = T + tid * TLD;
        const float* bg = in.router_group_b + L * 4; const float* be = in.router_expert_b + L * 32;
        int gi = 0; float gm = lr[0] * rs + bg[0];
#pragma unroll
        for (int j = 1; j < 4; ++j) { const float v = lr[j] * rs + bg[j]; if (v > gm) { gm = v; gi = j; } }
        float gs = 0.f;
#pragma unroll
        for (int j = 0; j < 4; ++j) gs += __builtin_amdgcn_exp2f(1.4426950408889634f * (lr[j] * rs + bg[j] - gm));
        const float gw = 1.f / gs;
        int i0 = 0, i1 = -1; float v0 = -3.0e38f, v1 = -3.0e38f;
#pragma unroll
        for (int j = 0; j < 8; ++j) {
            const float v = lr[4 + gi * 8 + j] * rs + be[gi * 8 + j];
            if (v > v0) { v1 = v0; i1 = i0; v0 = v; i0 = j; } else if (v > v1) { v1 = v; i1 = j; }
        }
        const float ex = __builtin_amdgcn_exp2f(1.4426950408889634f * (v1 - v0));
        w0 = gw / (1.f + ex); w1 = gw * ex / (1.f + ex);
        e0 = gi * 8 + i0; e1 = gi * 8 + i1;
        r0 = atomicAdd(&hist[e0], 1); r1 = atomicAdd(&hist[e1], 1);
    }
    __syncthreads();
    if (tid < 32) hist[32 + tid] = (hist[tid] && !dry) ? atomicAdd(&w.cnt[L * 64 + tid], hist[tid]) : 0;
    __syncthreads();
    if (tid < 128 && !dry) {
        const int tok = m0 + tid;
        const int p0 = hist[32 + e0] + r0, p1 = hist[32 + e1] + r1;
        w.elist[(size_t)e0 * NT + p0] = tok * 2; w.ewt[(size_t)e0 * NT + p0] = w0;
        w.elist[(size_t)e1 * NT + p1] = tok * 2 + 1; w.ewt[(size_t)e1 * NT + p1] = w1;
    }
    __syncthreads();
}
__device__ void eraw_item(const Params& P, int L, const int mt, const int nt, char* lds, const int tid_in) {
    int tid = tid_in; asm volatile("" : "+v"(tid));
    const WS& w = P.w; const nv::Inputs& in = P.in;
    const int lane = tid & 63, wid = tid >> 6;
    float* T = (float*)lds;
    const int m0 = mt * 128, n0 = nt * 128;
    {
        const float* arow[4]; const bf16_t* wrow[4];
#pragma unroll
        for (int i = 0; i < 4; ++i) {
            arow[i] = in.p + ((size_t)L * NT + m0 + (tid >> 3) + 32 * i) * 256 + (tid & 7) * 8;
            wrow[i] = w.Wpt + L * WP_SZ + (size_t)(n0 + (tid >> 3) + 32 * i) * 256 + (tid & 7) * 8;
        }
        f32x16 acc[2][2]; acc_zero(acc);
        float ss[4] = {0.f, 0.f, 0.f, 0.f};
        gemm_mainloop<float, false>(acc, arow, wrow, 4, lds, ss, tid);
        acc_to_lds(acc, T, tid);
    }
    {
        const int sub = lane >> 4, l16 = lane & 15, c8 = l16 * 8;
#pragma unroll 8
        for (int rr = 0; rr < 8; ++rr) {
            const int row = wid * 32 + rr * 4 + sub;
            const float4 x0 = *(const float4*)(T + row * TLD + c8), x1 = *(const float4*)(T + row * TLD + c8 + 4);
            *(uint4*)(w.erb + (size_t)(m0 + row) * 1024 + n0 + c8) = pack8(x0, x1);
            const float sq = grp_sum16(sq8(x0, x1));
            if (l16 == 0) w.essq[(size_t)(m0 + row) * 8 + nt] = sq;
        }
    }
    __syncthreads();
}
__device__ void phase_router(const Params& P, int L, char* lds, const bool dry = false) {
    const int tid = opaque_tid();
    {
        const int x = blockIdx.x & 7, lb = blockIdx.x >> 3, nlb = gridDim.x >> 3;
        if (lb < 16 || nlb <= 16) { for (int j = lb; j < 16; j += nlb) router_item(P, L, j * 8 + x, lds, tid, dry); }
        if (!dry) {
            if (nlb > 16) { if (lb >= 16) prep_moe_late(P, L, lds, tid, (lb - 16) * 8 + x, (nlb - 16) * 8); }
            else prep_moe_late(P, L, lds, tid, blockIdx.x, gridDim.x);
        }
    }
}

constexpr int TT_OFF = STAT_OFF + 1024;
__device__ __forceinline__ void moe_table(const Params& P, int L, char* lds, const int tid) {
    int* tt = (int*)(lds + TT_OFF);
    if (tid == 0) {
        const int x = blockIdx.x & 7;
        int o = 0, t = 0;
        for (int e = 0; e < 32; ++e) {
            const int c = P.w.cnt[L * 64 + e];
            tt[e] = o; o += c;
            if ((e & 7) == x) { tt[40 + (e >> 3)] = t; t += (c + 127) >> 7; }
        }
        tt[32] = o; tt[44] = t;
    }
    __syncthreads();
}
__device__ __forceinline__ void moe_find(const int* tt, int tile, int& e, int& t) {
    int k = 0;
    if (tile >= tt[41]) k = 1;
    if (tile >= tt[42]) k = 2;
    if (tile >= tt[43]) k = 3;
    e = (blockIdx.x & 7) + 8 * k; t = tile - tt[40 + k];
}
__device__ void phase_moe_up(const Params& P, int L, char* lds, const bool noeraw = false) {
    const WS& w = P.w;
    const int tid0 = opaque_tid();
    float* T = (float*)lds; float* stat = (float*)(lds + STAT_OFF); const int* tt = (const int*)(lds + TT_OFF);
    moe_table(P, L, lds, tid0);
    const int ntiles = tt[44];
    for (int item = blockIdx.x >> 3; item < ntiles * 4; item += (gridDim.x >> 3)) {
        int tid = tid0; asm volatile("" : "+v"(tid));
        const int lane = tid & 63, wid = tid >> 6;
        const int tile = item >> 2, nt = item & 3;
        int e, t; moe_find(tt, tile, e, t);
        const int cnt = P.w.cnt[L * 64 + e], rbase = tt[e] + t * 128, nrows = min(128, cnt - t * 128);
        {
            const bf16_t* arow[2]; const bf16_t* wrow[2];
#pragma unroll
            for (int i = 0; i < 2; ++i) {
                const int r = (tid >> 2) + 64 * i;
                const int ent = w.elist[(size_t)e * NT + t * 128 + (r < nrows ? r : 0)];
                arow[i] = w.hb1 + (size_t)(ent >> 1) * 1024 + gl_chunk(tid) * 8;
                wrow[i] = w.Wgut + L * WGU_SZ + ((size_t)e * 512 + nt * 128 + r) * 1024 + gl_chunk(tid) * 8;
            }
            f32x16 acc[2][2]; acc_zero(acc);
            float my_rs = 0.f;
            if (tid < 128) {
                const int ent = w.elist[(size_t)e * NT + t * 128 + (tid < nrows ? tid : 0)];
                my_rs = rstd8(w.rssB + (size_t)(ent >> 1) * 8, 1.f / 1024.f);
            }
            gemm_mainloop_g(acc, arow, wrow, 32, lds, tid);
            if (tid < 128) stat[tid] = my_rs;
            acc_to_lds(acc, T, tid);
        }
        {
            const int sub = lane >> 4, l16 = lane & 15, c8 = l16 * 8;
#pragma unroll 8
            for (int rr = 0; rr < 8; ++rr) {
                const int row = wid * 32 + rr * 4 + sub; const float rs = stat[row];
                const float4 x0 = mul4(*(const float4*)(T + row * TLD + c8), rs), x1 = mul4(*(const float4*)(T + row * TLD + c8 + 4), rs);
                if (row < nrows)
                    store4(w.hbuf + (size_t)(rbase + row) * 256 + nt * 64 + l16 * 4, x0.x * sigmoid_(x0.x) * x0.y, x0.z * sigmoid_(x0.z) * x0.w,
                           x1.x * sigmoid_(x1.x) * x1.y, x1.z * sigmoid_(x1.z) * x1.w);
            }
        }
        __syncthreads();
    }
    if (!noeraw) {
        int* qslot = (int*)(lds + TT_OFF + 256);
        for (;;) {
            if (tid0 == 0) *qslot = atomicAdd(&P.w.cnt[L * 64 + 32], 1);
            __syncthreads();
            const int item = *qslot;
            __syncthreads();
            if (item >= 1024) break;
            eraw_item(P, L, item >> 3, item & 7, lds, tid0);
        }
    }
}
__device__ void phase_moe_down(const Params& P, int L, char* lds) {
    const WS& w = P.w;
    const int tid0 = opaque_tid();
    float* T = (float*)lds; float* stat = (float*)(lds + STAT_OFF); const int* tt = (const int*)(lds + TT_OFF);
    moe_table(P, L, lds, tid0);
    const int ntiles = tt[44];
    for (int item = blockIdx.x >> 3; item < ntiles * 8; item += (gridDim.x >> 3)) {
        int tid = tid0; asm volatile("" : "+v"(tid));
        const int lane = tid & 63, wid = tid >> 6;
        const int tile = item >> 3, nt = item & 7;
        int e, t; moe_find(tt, tile, e, t);
        const int cnt = P.w.cnt[L * 64 + e], rbase = tt[e] + t * 128, nrows = min(128, cnt - t * 128);
        {
            const bf16_t* arow[2]; const bf16_t* wrow[2];
#pragma unroll
            for (int i = 0; i < 2; ++i) {
                const int r = (tid >> 2) + 64 * i;
                arow[i] = w.hbuf + (size_t)(rbase + (r < nrows ? r : 0)) * 256 + gl_chunk(tid) * 8;
                wrow[i] = w.Wdt + L * WD_SZ + ((size_t)e * 1024 + nt * 128 + r) * 256 + gl_chunk(tid) * 8;
            }
            f32x16 acc[2][2]; acc_zero(acc);
            int my_ent = 0; float my_wt = 0.f;
            if (tid < 128) { const int rr2 = tid < nrows ? tid : 0; my_ent = w.elist[(size_t)e * NT + t * 128 + rr2]; my_wt = w.ewt[(size_t)e * NT + t * 128 + rr2]; }
            gemm_mainloop_g(acc, arow, wrow, 8, lds, tid);
            if (tid < 128) { ((int*)stat)[tid] = my_ent; stat[128 + tid] = my_wt; }
            acc_to_lds(acc, T, tid);
        }
        {
            const int sub = lane >> 4, l16 = lane & 15, c8 = l16 * 8;
#pragma unroll 8
            for (int rr = 0; rr < 8; ++rr) {
                const int row = wid * 32 + rr * 4 + sub;
                const int ent = ((const int*)stat)[row]; const float wt = stat[128 + row];
                const float4 x0 = mul4(*(const float4*)(T + row * TLD + c8), wt), x1 = mul4(*(const float4*)(T + row * TLD + c8 + 4), wt);
                if (row < nrows) *(uint4*)(w.contrib + (size_t)ent * 1024 + nt * 128 + c8) = pack8(x0, x1);
            }
        }
        __syncthreads();
    }
}

__device__ void phase_combine(const Params& P, int L, char* lds, const bool dry = false) {
    const WS& w = P.w;
    const int tid = opaque_tid(), lane = tid & 63;
    for (size_t tok = (size_t)blockIdx.x * 4 + (tid >> 6); tok < NT; tok += (size_t)gridDim.x * 4) {
        float ss = 0.f;
#pragma unroll
        for (int j = 0; j < 2; ++j) {
            const size_t c8 = (size_t)(j * 64 + lane) * 8;
            const uint4 a = *(const uint4*)(w.contrib + (tok * 2) * 1024 + c8), b = *(const uint4*)(w.contrib + (tok * 2 + 1) * 1024 + c8);
            float4* hp = (float4*)(P.h + tok * 1024 + c8);
            float4 h0 = hp[0], h1 = hp[1];
            h0.x += bflo(a.x) + bflo(b.x); h0.y += bfhi(a.x) + bfhi(b.x); h0.z += bflo(a.y) + bflo(b.y); h0.w += bfhi(a.y) + bfhi(b.y);
            h1.x += bflo(a.z) + bflo(b.z); h1.y += bfhi(a.z) + bfhi(b.z); h1.z += bflo(a.w) + bflo(b.w); h1.w += bfhi(a.w) + bfhi(b.w);
            if (!dry) { hp[0] = h0; hp[1] = h1; }
            uint4 pk; pk.x = pack2(h0.x, h0.y); pk.y = pack2(h0.z, h0.w); pk.z = pack2(h1.x, h1.y); pk.w = pack2(h1.z, h1.w);
            *(uint4*)(w.hb1 + tok * 1024 + c8) = pk;
            ss += (h0.x * h0.x + h0.y * h0.y) + (h0.z * h0.z + h0.w * h0.w) + (h1.x * h1.x + h1.y * h1.y) + (h1.z * h1.z + h1.w * h1.w);
        }
        ss = wave_sum64(ss);
        if (lane < 8) w.rssB[tok * 8 + lane] = lane == 0 ? ss : 0.f;
    }
}

__device__ void phase_ple(const Params& P, int L, char* lds, const bool dry = false) {
    const WS& w = P.w; const nv::Inputs& in = P.in;
    const int tid0 = opaque_tid();
    float* T = (float*)lds; float* stat = (float*)(lds + STAT_OFF);
    int mt, nt;
    for (int it = 0; xcd_item(it, 128, 8, mt, nt); ++it) {
        int tid = tid0; asm volatile("" : "+v"(tid));
        const int lane = tid & 63, wid = tid >> 6;
        const int m0 = mt * 128, n0 = nt * 128;
        {
            const bf16_t* arow[2]; const bf16_t* wrow[2];
#pragma unroll
            for (int i = 0; i < 2; ++i) {
                arow[i] = w.hb1 + (size_t)(m0 + (tid >> 2) + 64 * i) * 1024 + gl_chunk(tid) * 8;
                wrow[i] = w.Wgt + L * WG_SZ + (size_t)(n0 + (tid >> 2) + 64 * i) * 1024 + gl_chunk(tid) * 8;
            }
            f32x16 acc[2][2]; acc_zero(acc);
            float my_rs = 0.f, my_re = 0.f;
            if (tid < 128) { my_rs = rstd8(w.rssB + (size_t)(m0 + tid) * 8, 1.f / 1024.f); my_re = rstd8(w.essq + (size_t)(m0 + tid) * 8, 1.f / 1024.f); }
            gemm_mainloop_g(acc, arow, wrow, 32, lds, tid);
            if (tid < 128) { stat[tid] = my_rs; stat[128 + tid] = my_re; }
            acc_to_lds(acc, T, tid);
        }
        {
            const int sub = lane >> 4, l16 = lane & 15, c8 = l16 * 8;
            const float4 pg0 = *(const float4*)(in.ple_post_norm_g + L * 1024 + n0 + c8), pg1 = *(const float4*)(in.ple_post_norm_g + L * 1024 + n0 + c8 + 4);
#pragma unroll 8
            for (int rr = 0; rr < 8; ++rr) {
                const int row = wid * 32 + rr * 4 + sub; const float rs = stat[row], re = stat[128 + row]; const size_t tok = m0 + row;
                const float4 x0 = mul4(*(const float4*)(T + row * TLD + c8), rs), x1 = mul4(*(const float4*)(T + row * TLD + c8 + 4), rs);
                const size_t off = tok * 1024 + n0 + c8;
                const uint4 er = *(const uint4*)(w.erb + off);
                float4* hp = (float4*)(P.h + off);
                float4 h0 = hp[0], h1 = hp[1];
                h0.x += sigmoid_(x0.x) * (bflo(er.x) * re * pg0.x); h0.y += sigmoid_(x0.y) * (bfhi(er.x) * re * pg0.y);
                h0.z += sigmoid_(x0.z) * (bflo(er.y) * re * pg0.z); h0.w += sigmoid_(x0.w) * (bfhi(er.y) * re * pg0.w);
                h1.x += sigmoid_(x1.x) * (bflo(er.z) * re * pg1.x); h1.y += sigmoid_(x1.y) * (bfhi(er.z) * re * pg1.y);
                h1.z += sigmoid_(x1.z) * (bflo(er.w) * re * pg1.z); h1.w += sigmoid_(x1.w) * (bfhi(er.w) * re * pg1.w);
                if (!dry) { hp[0] = h0; hp[1] = h1; }
                *(uint4*)(w.hb + off) = pack8(h0, h1);
                const float sq = grp_sum16(sq8(h0, h1));
                if (l16 == 0) w.rssA[tok * 8 + nt] = sq;
            }
        }
        __syncthreads();
    }
}

}
namespace fx {
#define XB_TMO      128
#define XB_XCNT(j)  (256  + 64 * (j))
#define XB_XSUB(j)  (1280 + 64 * (j))
#define XB_XGEN(j)  (2304 + 64 * (j))
#define XB_TOP      3328
#define XB_TOPGEN   3392
#define XCD_BAR_WORDS 3456
#define XB_SPIN_CAP (1u << 18)
#define LAS __attribute__((address_space(3)))
__device__ __forceinline__ unsigned xb_ld(unsigned* p)              { return __hip_atomic_load(p, __ATOMIC_RELAXED, __HIP_MEMORY_SCOPE_AGENT); }
__device__ __forceinline__ unsigned xb_add(unsigned* p, unsigned v) { return __hip_atomic_fetch_add(p, v, __ATOMIC_RELAXED, __HIP_MEMORY_SCOPE_AGENT); }
__device__ __forceinline__ unsigned xb_xcc_id() { return (unsigned)__builtin_amdgcn_s_getreg((3 << 11) | 20) & 0xFu; }
#define XB_SPIN(cond, bar) do { unsigned _sp = 0; while (cond) { __builtin_amdgcn_s_sleep(1); \
    if ((++_sp & 255u) == 0u) { if (xb_ld(&(bar)[XB_TMO])) break; if (_sp > XB_SPIN_CAP) { atomicAdd(&(bar)[XB_TMO], 1u); break; } } } } while (0)
struct XcdBarrier { unsigned* bar; unsigned x; volatile LAS unsigned* st; };
__device__ __forceinline__ XcdBarrier xcd_barrier_post(unsigned* bar, volatile LAS unsigned* st) {
    XcdBarrier b; b.bar = bar; b.x = xb_xcc_id(); b.st = st;
    if (threadIdx.x == 0) (void)xb_add(&bar[XB_XCNT(b.x)], 1u);
    return b;
}
__device__ __forceinline__ void xcd_barrier_complete(unsigned* bar, unsigned x, unsigned& nloc, unsigned& nx) {
    const unsigned G = gridDim.x * gridDim.y * gridDim.z;
    unsigned sum, cnt, mine, sp = 0u;
    for (;;) {
        sum = 0u; cnt = 0u; mine = 0u;
#pragma unroll
        for (unsigned j = 0; j < 16; ++j) { const unsigned c = xb_ld(&bar[XB_XCNT(j)]); sum += c; cnt += (c > 0u) ? 1u : 0u; mine = (j == x) ? c : mine; }
        if (sum == G) break;
        __builtin_amdgcn_s_sleep(1);
        if ((++sp & 255u) == 0u) { if (xb_ld(&bar[XB_TMO])) break; if (sp > XB_SPIN_CAP) { atomicAdd(&bar[XB_TMO], 1u); break; } }
    }
    nloc = mine > 0u ? mine : 1u; nx = cnt > 0u ? cnt : 1u;
}
__device__ __forceinline__ void xcd_barrier(const XcdBarrier& b) {
    asm volatile("s_waitcnt vmcnt(0)" ::: "memory");
    __syncthreads();
    if (threadIdx.x == 0) {
        unsigned* bar = b.bar;
        __builtin_amdgcn_s_waitcnt(0);
        unsigned nloc = b.st[0], nx = b.st[1];
        if (nloc == 0u) { xcd_barrier_complete(bar, b.x, nloc, nx); b.st[0] = nloc; b.st[1] = nx; }
        const unsigned old = xb_add(&bar[XB_XSUB(b.x)], 1u);
        const unsigned gen = old / nloc;
        if (old + 1u == (gen + 1u) * nloc) {
            __builtin_amdgcn_fence(__ATOMIC_RELEASE, "agent");
            asm volatile("s_waitcnt vmcnt(0)" ::: "memory");
            const unsigned og = xb_add(&bar[XB_TOP], 1u);
            const unsigned tg = og / nx;
            if (og + 1u == (tg + 1u) * nx) xb_add(&bar[XB_TOPGEN], 1u);
            else XB_SPIN(xb_ld(&bar[XB_TOPGEN]) == tg, bar);
            __builtin_amdgcn_fence(__ATOMIC_ACQUIRE, "agent");
            xb_add(&bar[XB_XGEN(b.x)], 1u);
            asm volatile("s_waitcnt vmcnt(0)" ::: "memory");
        } else {
            XB_SPIN(xb_ld(&bar[XB_XGEN(b.x)]) == gen, bar);
            __builtin_amdgcn_fence(__ATOMIC_ACQUIRE, "agent");
            asm volatile("s_waitcnt vmcnt(0)" ::: "memory");
        }
    }
    __syncthreads();
}

constexpr int LDS_BYTES = LDS_GEMM_BYTES + 16;
constexpr int N_PHASES = 19;
constexpr int PPL = 9;
__global__ void __launch_bounds__(256, 2) k_run(Params P, int ph_lo, int ph_hi) {
    extern __shared__ __attribute__((aligned(16))) char lds[];
    volatile LAS unsigned* st = (volatile LAS unsigned*)(lds + LDS_GEMM_BYTES);
    if (threadIdx.x == 0) { st[0] = 0u; st[1] = 0u; }
    __syncthreads();
    XcdBarrier xb = xcd_barrier_post(P.w.bar, st);
    for (int ph = ph_lo; ph < ph_hi; ++ph) {
        if (ph > ph_lo) xcd_barrier(xb);
        int reps = 1;
#ifdef REP_PHASE
        if (ph == 0 ? (REP_PHASE == 0) : (((ph - 1) % PPL) == REP_PHASE - 1)) reps = 2;
        asm volatile("" : "+s"(reps));
#endif
        for (int rep = 0; rep < reps; ++rep) {
            const bool dry = rep + 1 < reps;
            if (rep > 0) xcd_barrier(xb);
            if (ph == 0) phase_prep(P, lds);
            else {
                const int L = (ph - 1) / PPL, s = (ph - 1) % PPL;
                switch (s) {
                    case 0: phase_zgemm(P, L, lds); break;
                    case 1: phase_mix(P, L, lds); break;
                    case 2: phase_attn(P, L, lds); break;
                    case 3: phase_oproj(P, L, lds, dry); break;
                    case 4: phase_router(P, L, lds, dry); break;
                    case 5: phase_moe_up(P, L, lds, dry); break;
                    case 6: phase_moe_down(P, L, lds); break;
                    case 7: phase_combine(P, L, lds, dry); break;
                    case 8: phase_ple(P, L, lds, dry); break;
                }
            }
        }
    }
}
}
#ifndef MK_N_LAUNCHES
#define MK_N_LAUNCHES 1
#endif
extern "C" void kernel_launch(void* const* d_in, const int* in_sizes, int n_in, void* d_out, int out_size, void* d_ws, size_t ws_size,
                              hipStream_t stream) {
    nv::Inputs in{};
    in.x = (const float*)d_in[0]; in.p = (const float*)d_in[1]; in.positions = (const int*)d_in[2];
    const float** f = &in.mix_norm_g;
    for (int i = 0; i < 32; ++i) f[i] = (const float*)d_in[3 + i];
    size_t used = 0;
    fx::WS w = fx::make_ws((char*)d_ws, used);
    static int grid = 0;
    if (grid == 0) {
        if (n_in != 35 || out_size != fx::NT * 1024 || used > ws_size) { fprintf(stderr, "kernel_launch: unexpected shapes / workspace (need %zu, have %zu)\n", used, ws_size); grid = -1; return; }
        if (hipFuncSetAttribute((const void*)fx::k_run, hipFuncAttributeMaxDynamicSharedMemorySize, fx::LDS_BYTES) != hipSuccess) { fprintf(stderr, "hipFuncSetAttribute failed\n"); grid = -1; return; }
        int dev = 0, cus = 0, per_cu = 0;
        hipGetDevice(&dev); hipDeviceGetAttribute(&cus, hipDeviceAttributeMultiprocessorCount, dev);
        hipOccupancyMaxActiveBlocksPerMultiprocessor(&per_cu, (const void*)fx::k_run, 256, fx::LDS_BYTES);
        if (per_cu > 2) per_cu = 2;
        if (per_cu < 1) { fprintf(stderr, "occupancy query says %d blocks/CU\n", per_cu); grid = -1; return; }
        grid = cus * per_cu;
    }
    if (grid < 0) return;
    fx::Params P{}; P.in = in; P.h = (float*)d_out; P.w = w;
    hipMemsetAsync(w.cnt, 0, 128 * 4, stream);
    hipMemsetAsync(w.bar, 0, XCD_BAR_WORDS * 4, stream);
    if (MK_N_LAUNCHES == 1) hipLaunchKernelGGL(fx::k_run, dim3(grid), dim3(256), fx::LDS_BYTES, stream, P, 0, fx::N_PHASES);
    else for (int ph = 0; ph < fx::N_PHASES; ++ph) hipLaunchKernelGGL(fx::k_run, dim3(grid), dim3(256), fx::LDS_BYTES, stream, P, ph, ph + 1);
}
```

```cpp
#include <hip/hip_runtime.h>
#include <hip/hip_bf16.h>
#include <stdint.h>
#include <cstdio>
namespace nv {
struct Inputs {
    const float *x, *p; const int* positions;
    const float *mix_norm_g, *w_in, *sgu_ln_g, *sgu_ln_b, *sgu_w, *sgu_b, *conv_w, *conv_b, *conv_ln_g, *conv_ln_b, *conv_pw_w, *conv_pw_b,
        *q_a_norm_g, *w_uq, *kv_a_norm_g, *w_ukv, *q_norm_g, *k_norm_g, *branch_norm_g, *w_o, *ffn_norm_g, *router_group_w, *router_group_b,
        *router_expert_w, *router_expert_b, *moe_w_gate, *moe_w_up, *moe_w_down, *ple_norm_g, *ple_gate_w, *ple_proj_w, *ple_post_norm_g;
};
}
namespace fx {

typedef unsigned short bf16_t;
typedef short bf16x8 __attribute__((ext_vector_type(8)));
typedef float f32x16 __attribute__((ext_vector_type(16)));
typedef float f32x4 __attribute__((ext_vector_type(4)));

constexpr int NT = 16384, SEQ = 2048, DM = 1024, NB = 8;
constexpr int ZN = 1536;
constexpr float EPS = 1e-6f;

typedef __bf16 bf16v2_t __attribute__((ext_vector_type(2)));
typedef float f32v2_t __attribute__((ext_vector_type(2)));
__device__ __forceinline__ unsigned pack2(float lo, float hi) {
    f32v2_t v; v.x = lo; v.y = hi;
    bf16v2_t b = __builtin_convertvector(v, bf16v2_t);
    return __builtin_bit_cast(unsigned, b);
}
__device__ __forceinline__ unsigned f2bf(float f) { return pack2(f, 0.f) & 0xffffu; }
__device__ __forceinline__ float bf2f(unsigned short b) { return __uint_as_float(((unsigned)b) << 16); }
__device__ __forceinline__ float bflo(unsigned u) { return __uint_as_float(u << 16); }
__device__ __forceinline__ float bfhi(unsigned u) { return __uint_as_float(u & 0xffff0000u); }
__device__ __forceinline__ float sigmoid_(float x) { return __builtin_amdgcn_rcpf(1.f + __builtin_amdgcn_exp2f(-1.4426950408889634f * x)); }
__device__ __forceinline__ float rsq_(float x) { return __builtin_amdgcn_rsqf(x); }
__device__ __forceinline__ float gelu_tanh_(float x) {
    float u = 0.7978845608028654f * (x + 0.044715f * x * x * x);
    return x * sigmoid_(2.f * u);
}
__device__ __forceinline__ int opaque_tid() { int t = threadIdx.x; asm volatile("" : "+v"(t)); return t; }
template <int CTRL> __device__ __forceinline__ float dpp_mov(float v) {
    return __builtin_bit_cast(float, __builtin_amdgcn_update_dpp(0, __builtin_bit_cast(int, v), CTRL, 0xf, 0xf, false));
}
__device__ __forceinline__ void swap16(float& a, float& b) { asm volatile("s_nop 1\n\tv_permlane16_swap_b32 %0, %1" : "+v"(a), "+v"(b)); }
__device__ __forceinline__ void swap32(float& a, float& b) { asm volatile("s_nop 1\n\tv_permlane32_swap_b32 %0, %1" : "+v"(a), "+v"(b)); }
__device__ __forceinline__ float swap16_sum(float v) { float a = v, b = v; swap16(a, b); return a + b; }
__device__ __forceinline__ float swap32_sum(float v) { float a = v, b = v; swap32(a, b); return a + b; }
__device__ __forceinline__ float swap32_max(float v) { float a = v, b = v; swap32(a, b); return fmaxf(a, b); }
__device__ __forceinline__ float grp_sum16(float v) { v += dpp_mov<0xB1>(v); v += dpp_mov<0x4E>(v); v += dpp_mov<0x124>(v); v += dpp_mov<0x128>(v); return v; }
__device__ __forceinline__ float grp_sum32(float v) { return swap16_sum(grp_sum16(v)); }
__device__ __forceinline__ float wave_sum64(float v) { return swap32_sum(grp_sum32(v)); }
__device__ __forceinline__ float grp_sum4(float v) { v += dpp_mov<0xB1>(v); v += dpp_mov<0x4E>(v); return v; }
__device__ __forceinline__ float grp_sum8(float v) { v = grp_sum4(v); v += dpp_mov<0x141>(v); return v; }
__device__ __forceinline__ float quad_x2(float v) { return dpp_mov<0x4E>(v); }
__device__ __forceinline__ float xor8(float v) { return dpp_mov<0x128>(v); }
__device__ __forceinline__ float xor32(float v) { return swap32_sum(v); }

struct WS {
    bf16_t *W1t, *Wuqt, *Wukvt, *Wpwt, *Wot, *Wrt, *Wgut, *Wdt, *Wgt, *Wpt, *Wsm;
    bf16_t *hb;
    bf16_t *hb1;
    bf16_t *ub;
    bf16_t *vT;
    bf16_t *ygb;
    bf16_t *cqb;
    bf16_t *ckvb;
    bf16_t *kpeb;
    bf16_t *Qb;
    bf16_t *Knb;
    bf16_t *VTb;
    bf16_t *yb;
    float  *ssq;
    float  *rssA;
    float  *rssB;
    float  *cqss;
    float  *cs;
    bf16_t *erb;
    float  *essq;
    bf16_t *hbuf;
    bf16_t *contrib;
    int    *cnt;
    int    *elist;
    float  *ewt;
    unsigned *bar;
};
constexpr size_t W1_SZ = (size_t)ZN * 1024, WUQ_SZ = 768 * 256, WUKV_SZ = 1024 * 128, WPW_SZ = 256 * 256, WO_SZ = 1024 * 1024, WR_SZ = 128 * 1024,
                 WGU_SZ = (size_t)32 * 512 * 1024, WD_SZ = (size_t)32 * 1024 * 256, WG_SZ = 1024 * 1024, WP_SZ = 1024 * 256, WSM_SZ = 4 * 128 * 128;

struct Params {
    nv::Inputs in;
    float* h;
    WS w;
    float* zf;
    float* yf;
};

static WS make_ws(char* base, size_t& used) {
    WS w{}; size_t o = 0;
    auto take = [&](size_t bytes) { char* p = base + o; o += (bytes + 255) & ~(size_t)255; return p; };
    w.W1t = (bf16_t*)take(2 * W1_SZ * 2);   w.Wuqt = (bf16_t*)take(2 * WUQ_SZ * 2); w.Wukvt = (bf16_t*)take(2 * WUKV_SZ * 2);
    w.Wpwt = (bf16_t*)take(2 * WPW_SZ * 2); w.Wot = (bf16_t*)take(2 * WO_SZ * 2);   w.Wrt = (bf16_t*)take(2 * WR_SZ * 2);
    w.Wgut = (bf16_t*)take(2 * WGU_SZ * 2); w.Wdt = (bf16_t*)take(2 * WD_SZ * 2);   w.Wgt = (bf16_t*)take(2 * WG_SZ * 2);
    w.Wpt = (bf16_t*)take(2 * WP_SZ * 2);   w.Wsm = (bf16_t*)take(2 * WSM_SZ * 2);
    w.hb = (bf16_t*)take((size_t)NT * 1024 * 2); w.hb1 = (bf16_t*)take((size_t)NT * 1024 * 2);
    w.ssq = (float*)take((size_t)NT * 16 * 4); w.cs = (float*)take((size_t)NT * 32 * 4);
    w.rssA = (float*)take((size_t)NT * 8 * 4); w.rssB = (float*)take((size_t)NT * 8 * 4); w.cqss = (float*)take((size_t)NT * 4 * 4);
    w.essq = (float*)take((size_t)NT * 8 * 4);
    w.cnt = (int*)take(2 * 64 * 4);
    w.elist = (int*)take((size_t)32 * NT * 4); w.ewt = (float*)take((size_t)32 * NT * 4);
    w.bar = (unsigned*)take(4096 * 4);
    const size_t region = o;
    w.ub = (bf16_t*)take((size_t)NT * 256 * 2); w.vT = (bf16_t*)take((size_t)NT * 256 * 2); w.ygb = (bf16_t*)take((size_t)NT * 256 * 2);
    w.cqb = (bf16_t*)take((size_t)NT * 256 * 2); w.ckvb = (bf16_t*)take((size_t)NT * 128 * 2); w.kpeb = (bf16_t*)take((size_t)NT * 32 * 2);
    w.Qb = (bf16_t*)take((size_t)NT * 768 * 2); w.Knb = (bf16_t*)take((size_t)NT * 512 * 2); w.VTb = (bf16_t*)take((size_t)NT * 512 * 2);
    w.yb = (bf16_t*)take((size_t)NT * 1024 * 2);
    const size_t region_end = o;
    o = region;
    w.contrib = (bf16_t*)take((size_t)NT * 2 * 1024 * 2);
    w.hbuf = (bf16_t*)take((size_t)(2 * NT + 128) * 256 * 2);
    w.erb = (bf16_t*)take((size_t)NT * 1024 * 2);
    if (o > region_end) { fprintf(stderr, "make_ws: overlay exceeds mixer region\n"); }
    o = region_end;
    used = o;
    return w;
}

__device__ const double ROPE_INV[16] = {1.0, 0.5623413251903491, 0.31622776601683794, 0.1778279410038923, 0.1, 0.05623413251903491, 0.03162277660168379, 0.01778279410038923, 0.01, 0.005623413251903491, 0.0031622776601683794, 0.0017782794100389228, 0.001, 0.0005623413251903491, 0.00031622776601683794, 0.00017782794100389227};
__device__ __forceinline__ void rope_cs(int pos, int j, float& c, float& s) {
    const double ang = (double)pos * ROPE_INV[j];
    const double n = rint(ang * 0.15915494309189535);
    double r = fma(-n, 6.283185307179586, ang); r = fma(-n, 2.4492935982947064e-16, r);
    const double r2 = r * r;
    double sc = 1.0, ss = 1.0;
    double tc = 1.0, ts = 1.0;
#pragma unroll
    for (int k = 1; k <= 14; ++k) {
        tc *= -r2 / (double)((2 * k - 1) * (2 * k)); sc += tc;
        ts *= -r2 / (double)((2 * k) * (2 * k + 1)); ss += ts;
    }
    c = (float)sc; s = (float)(ss * r);
}

enum { MAP_ID = 0, MAP_W1 = 1, MAP_UQ = 2, MAP_UKV = 3, MAP_GATE = 4, MAP_UP = 5 };
template <int MAP> __device__ __forceinline__ int dstrow(int c) {
    if (MAP == MAP_W1) {
        if (c < 512) return c;
        if (c < 768) return 512 + 2 * (c - 512);
        if (c < 1024) return 513 + 2 * (c - 768);
        return c;
    } else if (MAP == MAP_UQ) {
        const int h = c / 96, d = c - h * 96; return d < 64 ? h * 64 + d : 512 + h * 32 + d - 64;
    } else if (MAP == MAP_UKV) {
        const int h = c >> 7, d = c & 127; return d < 64 ? h * 64 + d : 512 + h * 64 + d - 64;
    } else if (MAP == MAP_GATE) return 2 * c;
    else if (MAP == MAP_UP) return 2 * c + 1;
    return c;
}
#define PREP_LOAD(V0, V1, V2, V3, SRC, K0, C0) do { \
    const int kk_ = tid >> 4, c4_ = (tid & 15) * 4; \
    const float* p_ = (C0) + c4_ < Nsrc ? (SRC) + (size_t)((K0) + kk_) * ld + (C0) + c4_ : (SRC) + (size_t)((K0) + kk_) * ld; \
    V0 = *(const float4*)p_; V1 = *(const float4*)(p_ + (size_t)16 * ld); V2 = *(const float4*)(p_ + (size_t)32 * ld); V3 = *(const float4*)(p_ + (size_t)48 * ld); } while (0)
__device__ __forceinline__ void prep_put(float* tile, int kk, int c4, const float4& v, float sc) {
    float* t = tile + kk * 65 + c4; t[0] = v.x * sc; t[1] = v.y * sc; t[2] = v.z * sc; t[3] = v.w * sc;
}
template <int MAP>
__device__ void prep_job(const float* src, int ld, int Nsrc, size_t src_stride, const float* scale, bf16_t* dst, size_t dst_stride, int K, int nbatch, float* tiles, int& rot, const int tid, const int bi, const int G) {
    const int tn = (Nsrc + 63) / 64, tk = K / 64, per = tn * tk, total = per * nbatch;
    int t = (bi - rot + G) % G, buf = 0;
    float4 a0 = make_float4(0.f, 0.f, 0.f, 0.f), a1 = a0, a2 = a0, a3 = a0, b0 = a0, b1 = a0, b2 = a0, b3 = a0;
    if (t < total) { const int e = t / per, tt = t % per; PREP_LOAD(a0, a1, a2, a3, src + (size_t)e * src_stride, (tt / tn) * 64, (tt % tn) * 64); }
    for (; t < total; t += G) {
        const int e = t / per, tt = t % per, k0 = (tt / tn) * 64, c0 = (tt % tn) * 64;
        const int t2 = t + G;
        if (t2 < total) { const int e2 = t2 / per, tt2 = t2 % per; PREP_LOAD(b0, b1, b2, b3, src + (size_t)e2 * src_stride, (tt2 / tn) * 64, (tt2 % tn) * 64); }
        float* tile = tiles + buf * (64 * 65);
        {
            const int kk = tid >> 4, c4 = (tid & 15) * 4;
            const float s0 = scale ? scale[k0 + kk] : 1.f, s1 = scale ? scale[k0 + kk + 16] : 1.f, s2 = scale ? scale[k0 + kk + 32] : 1.f, s3 = scale ? scale[k0 + kk + 48] : 1.f;
            prep_put(tile, kk, c4, a0, s0); prep_put(tile, kk + 16, c4, a1, s1); prep_put(tile, kk + 32, c4, a2, s2); prep_put(tile, kk + 48, c4, a3, s3);
        }
        __syncthreads();
        bf16_t* d = dst + (size_t)e * dst_stride;
#pragma unroll
        for (int i = 0; i < 2; ++i) {
            const int idx = tid + 256 * i, c = idx >> 3, kc = idx & 7;
            if (c0 + c < Nsrc) {
                const float* q = tile + (kc * 8) * 65 + c;
                uint4 pk;
                pk.x = pack2(q[0], q[65]); pk.y = pack2(q[130], q[195]); pk.z = pack2(q[260], q[325]); pk.w = pack2(q[390], q[455]);
                *(uint4*)(d + (size_t)dstrow<MAP>(c0 + c) * K + k0 + kc * 8) = pk;
            }
        }
        a0 = b0; a1 = b1; a2 = b2; a3 = b3; buf ^= 1;
    }
    __syncthreads();
    rot = (rot + total) % G;
}

__device__ void phase_prep(const Params& P, char* lds) {
    float* tile = (float*)lds;
    const nv::Inputs& in = P.in; const WS& w = P.w;
    const int G = gridDim.x, bid = blockIdx.x, tid = opaque_tid();
    int rot = 0;
    for (int L = 0; L < 2; ++L) {
        if (L == 0) {
        prep_job<MAP_GATE>(in.moe_w_gate + (size_t)L * 32 * 1024 * 256, 256, 256, (size_t)1024 * 256, in.ffn_norm_g + L * 1024, w.Wgut + L * WGU_SZ, (size_t)512 * 1024, 1024, 32, tile, rot, tid, bid, G);
        prep_job<MAP_UP>(in.moe_w_up + (size_t)L * 32 * 1024 * 256, 256, 256, (size_t)1024 * 256, in.ffn_norm_g + L * 1024, w.Wgut + L * WGU_SZ, (size_t)512 * 1024, 1024, 32, tile, rot, tid, bid, G);
        prep_job<MAP_ID>(in.moe_w_down + (size_t)L * 32 * 256 * 1024, 1024, 1024, (size_t)256 * 1024, nullptr, w.Wdt + L * WD_SZ, (size_t)1024 * 256, 256, 32, tile, rot, tid, bid, G);
        }
        prep_job<MAP_W1>(in.w_in + (size_t)L * 1024 * 1440, 1440, 1440, 0, in.mix_norm_g + L * 1024, w.W1t + L * W1_SZ, 0, 1024, 1, tile, rot, tid, bid, G);
        prep_job<MAP_UQ>(in.w_uq + (size_t)L * 256 * 768, 768, 768, 0, in.q_a_norm_g + L * 256, w.Wuqt + L * WUQ_SZ, 0, 256, 1, tile, rot, tid, bid, G);
        prep_job<MAP_UKV>(in.w_ukv + (size_t)L * 128 * 1024, 1024, 1024, 0, in.kv_a_norm_g + L * 128, w.Wukvt + L * WUKV_SZ, 0, 128, 1, tile, rot, tid, bid, G);
        prep_job<MAP_ID>(in.conv_pw_w + (size_t)L * 256 * 256, 256, 256, 0, nullptr, w.Wpwt + L * WPW_SZ, 0, 256, 1, tile, rot, tid, bid, G);
        prep_job<MAP_ID>(in.w_o + (size_t)L * 1024 * 1024, 1024, 1024, 0, in.branch_norm_g + L * 1024, w.Wot + L * WO_SZ, 0, 1024, 1, tile, rot, tid, bid, G);
        prep_job<MAP_ID>(in.ple_gate_w + (size_t)L * 1024 * 1024, 1024, 1024, 0, in.ple_norm_g + L * 1024, w.Wgt + L * WG_SZ, 0, 1024, 1, tile, rot, tid, bid, G);
        prep_job<MAP_ID>(in.ple_proj_w + (size_t)L * 256 * 1024, 1024, 1024, 0, nullptr, w.Wpt + L * WP_SZ, 0, 256, 1, tile, rot, tid, bid, G);
        for (int i = bid * 256 + tid; i < 96 * 1024 / 8; i += G * 256) *(uint4*)(w.W1t + L * W1_SZ + (size_t)1440 * 1024 + (size_t)i * 8) = make_uint4(0u, 0u, 0u, 0u);
        for (int i = bid * 256 + tid; i < 128 * 1024; i += G * 256) {
            int n = i >> 10, k = i & 1023; float v = 0.f;
            if (n < 4) v = in.router_group_w[(size_t)L * 1024 * 4 + k * 4 + n];
            else if (n < 36) v = in.router_expert_w[(size_t)L * 1024 * 32 + k * 32 + (n - 4)];
            v *= in.ffn_norm_g[L * 1024 + k];
            w.Wrt[L * WR_SZ + i] = (bf16_t)f2bf(v);
        }
        for (int i = bid * 256 + tid; i < 4 * 128 * 128; i += G * 256) {
            int jj = i & 127, ii = (i >> 7) & 127;
            float v = (jj <= ii) ? in.sgu_w[(size_t)L * WSM_SZ + i] : 0.f;
            w.Wsm[L * WSM_SZ + i] = (bf16_t)f2bf(v);
        }
    }
    for (int i = bid * 256 + tid; i < NT * 16; i += G * 256) {
        int t = i >> 4, j = i & 15;
        float c, sn; rope_cs(in.positions[t], j, c, sn);
        w.cs[t * 32 + j] = c; w.cs[t * 32 + 16 + j] = sn;
    }
    for (int row = bid * 4 + (tid >> 6); row < NT; row += G * 4) {
        const int lane = tid & 63;
        float ss = 0.f;
#pragma unroll
        for (int j = 0; j < 4; ++j) {
            const size_t i = (size_t)row * 256 + j * 64 + lane;
            const float4 v = ((const float4*)in.x)[i];
            uint2 pk; pk.x = pack2(v.x, v.y); pk.y = pack2(v.z, v.w);
            ((uint2*)w.hb)[i] = pk;
            ss += v.x * v.x + v.y * v.y + v.z * v.z + v.w * v.w;
        }
        ss = wave_sum64(ss);
        if (lane < 8) w.rssA[(size_t)row * 8 + lane] = lane == 0 ? ss : 0.f;
    }
}

__device__ void prep_moe_late(const Params& P, int part, char* lds, const int tid, const int bi, const int nb) {
    float* tile = (float*)lds;
    const nv::Inputs& in = P.in; const WS& w = P.w;
    int rot = 0; const int L = 1;
    const float* up = in.moe_w_up + (size_t)L * 32 * 1024 * 256;
    if (part == 0) {
        prep_job<MAP_GATE>(in.moe_w_gate + (size_t)L * 32 * 1024 * 256, 256, 256, (size_t)1024 * 256, in.ffn_norm_g + L * 1024, w.Wgut + L * WGU_SZ, (size_t)512 * 1024, 1024, 32, tile, rot, tid, bi, nb);
        prep_job<MAP_UP>(up, 256, 256, (size_t)1024 * 256, in.ffn_norm_g + L * 1024, w.Wgut + L * WGU_SZ, (size_t)512 * 1024, 1024, 16, tile, rot, tid, bi, nb);
    } else {
        prep_job<MAP_UP>(up + (size_t)16 * 1024 * 256, 256, 256, (size_t)1024 * 256, in.ffn_norm_g + L * 1024, w.Wgut + L * WGU_SZ + (size_t)16 * 512 * 1024, (size_t)512 * 1024, 1024, 16, tile, rot, tid, bi, nb);
        prep_job<MAP_ID>(in.moe_w_down + (size_t)L * 32 * 256 * 1024, 1024, 1024, (size_t)256 * 1024, nullptr, w.Wdt + L * WD_SZ, (size_t)1024 * 256, 256, 32, tile, rot, tid, bi, nb);
    }
    __syncthreads();
}

__device__ __forceinline__ int lds_off(int row, int chunk) { return row * 128 + ((chunk ^ ((row >> 1) & 7)) << 4); }

template <typename AT> struct ARaw;
template <> struct ARaw<bf16_t> { uint4 v[4]; };
template <> struct ARaw<float> { float4 v[4][2]; };

__device__ __forceinline__ void a_load(ARaw<bf16_t>& r, const bf16_t* const (&rowp)[4], int koff) {
#pragma unroll
    for (int i = 0; i < 4; ++i) r.v[i] = *(const uint4*)(rowp[i] + koff);
}
__device__ __forceinline__ void a_load(ARaw<float>& r, const float* const (&rowp)[4], int koff) {
#pragma unroll
    for (int i = 0; i < 4; ++i) { r.v[i][0] = *(const float4*)(rowp[i] + koff); r.v[i][1] = *(const float4*)(rowp[i] + koff + 4); }
}
template <bool SUMSQ> __device__ __forceinline__ uint4 a_cvt(const uint4& v, float& ss) {
    if (SUMSQ) {
        float a;
        a = bflo(v.x); ss = fmaf(a, a, ss); a = bfhi(v.x); ss = fmaf(a, a, ss);
        a = bflo(v.y); ss = fmaf(a, a, ss); a = bfhi(v.y); ss = fmaf(a, a, ss);
        a = bflo(v.z); ss = fmaf(a, a, ss); a = bfhi(v.z); ss = fmaf(a, a, ss);
        a = bflo(v.w); ss = fmaf(a, a, ss); a = bfhi(v.w); ss = fmaf(a, a, ss);
    }
    return v;
}
template <bool SUMSQ> __device__ __forceinline__ void a_store(const ARaw<bf16_t>& r, char* ldsA, int tid, float (&ss)[4]) {
#pragma unroll
    for (int i = 0; i < 4; ++i) { uint4 v = a_cvt<SUMSQ>(r.v[i], ss[i]); *(uint4*)(ldsA + lds_off((tid >> 3) + 32 * i, tid & 7)) = v; }
}
template <bool SUMSQ> __device__ __forceinline__ void a_store(const ARaw<float>& r, char* ldsA, int tid, float (&ss)[4]) {
#pragma unroll
    for (int i = 0; i < 4; ++i) {
        const float4 a = r.v[i][0], b = r.v[i][1];
        if (SUMSQ) ss[i] += a.x * a.x + a.y * a.y + a.z * a.z + a.w * a.w + b.x * b.x + b.y * b.y + b.z * b.z + b.w * b.w;
        uint4 v; v.x = pack2(a.x, a.y); v.y = pack2(a.z, a.w); v.z = pack2(b.x, b.y); v.w = pack2(b.z, b.w);
        *(uint4*)(ldsA + lds_off((tid >> 3) + 32 * i, tid & 7)) = v;
    }
}

struct bf16x3_t {};
template <> struct ARaw<bf16x3_t> { uint4 a[4], b[4], c[4]; };
struct Rows3 { const bf16_t* p[2][4]; };
__device__ __forceinline__ void a_load(ARaw<bf16x3_t>& r, const Rows3& rows, int koff) {
#pragma unroll
    for (int i = 0; i < 4; ++i) { r.a[i] = *(const uint4*)(rows.p[0][i] + koff); r.b[i] = *(const uint4*)(rows.p[1][i] + koff); r.c[i] = *(const uint4*)(rows.p[1][i] + koff + 1024); }
}
__device__ __forceinline__ unsigned add3pk(unsigned a, unsigned b, unsigned c, float& ss) {
    const float lo = bflo(a) + bflo(b) + bflo(c), hi = bfhi(a) + bfhi(b) + bfhi(c);
    ss = fmaf(lo, lo, ss); ss = fmaf(hi, hi, ss);
    return pack2(lo, hi);
}
template <bool SUMSQ> __device__ __forceinline__ void a_store(const ARaw<bf16x3_t>& r, char* ldsA, int tid, float (&ss)[4]) {
#pragma unroll
    for (int i = 0; i < 4; ++i) {
        uint4 v;
        v.x = add3pk(r.a[i].x, r.b[i].x, r.c[i].x, ss[i]); v.y = add3pk(r.a[i].y, r.b[i].y, r.c[i].y, ss[i]);
        v.z = add3pk(r.a[i].z, r.b[i].z, r.c[i].z, ss[i]); v.w = add3pk(r.a[i].w, r.b[i].w, r.c[i].w, ss[i]);
        *(uint4*)(ldsA + lds_off((tid >> 3) + 32 * i, tid & 7)) = v;
    }
}

template <typename AT, bool SUMSQ, int SUNROLL = 4, typename AROWS>
__device__ __forceinline__ void gemm_mainloop(f32x16 (&acc)[2][2], const AROWS& arow, const bf16_t* const (&wrow)[4], int nkt, char* lds, float (&ss)[4], const int tid) {
    const int lane = tid & 63, wid = tid >> 6, wr = wid >> 1, wc = wid & 1;
    ARaw<AT> ra; ARaw<bf16_t> rb; float dummy[4] = {0.f, 0.f, 0.f, 0.f};
    a_load(ra, arow, 0); a_load(rb, wrow, 0);
    a_store<SUMSQ>(ra, lds, tid, ss); a_store<false>(rb, lds + 16384, tid, dummy);
    __syncthreads();
    const int fr = lane & 31, fh = lane >> 5;
#pragma unroll 1
    for (int kt = 0; kt < nkt; ++kt) {
        char* cur = lds + (kt & 1) * 32768;
        char* nxt = lds + ((kt + 1) & 1) * 32768;
        const bool more = (kt + 1 < nkt);
        if (more) { a_load(ra, arow, (kt + 1) * 64); a_load(rb, wrow, (kt + 1) * 64); }
#pragma unroll SUNROLL
        for (int s = 0; s < 4; ++s) {
            bf16x8 xa[2], wb[2];
#pragma unroll
            for (int i = 0; i < 2; ++i) xa[i] = *(const bf16x8*)(cur + lds_off(wr * 64 + i * 32 + fr, 2 * s + fh));
#pragma unroll
            for (int j = 0; j < 2; ++j) wb[j] = *(const bf16x8*)(cur + 16384 + lds_off(wc * 64 + j * 32 + fr, 2 * s + fh));
#pragma unroll
            for (int i = 0; i < 2; ++i)
#pragma unroll
                for (int j = 0; j < 2; ++j) acc[i][j] = __builtin_amdgcn_mfma_f32_32x32x16_bf16(wb[j], xa[i], acc[i][j], 0, 0, 0);
        }
        if (more) { a_store<SUMSQ>(ra, nxt, tid, ss); a_store<false>(rb, nxt + 16384, tid, dummy); }
        __syncthreads();
    }
}
constexpr int GST = 16384;
__device__ __forceinline__ int gl_chunk(int tid) { return (tid & 3) ^ ((tid >> 4) & 3); }
__device__ __forceinline__ int gl_off(int row, int chunk) { return row * 64 + ((chunk ^ ((row >> 2) & 3)) << 4); }
typedef __attribute__((address_space(3))) unsigned lds_u32_t;
__device__ __forceinline__ void glds16(const bf16_t* g, char* l) {
    __builtin_amdgcn_global_load_lds((const unsigned*)g, (lds_u32_t*)l, 16, 0, 0);
}
#define RAW_BARRIER() do { asm volatile("s_waitcnt lgkmcnt(0)" ::: "memory"); __builtin_amdgcn_s_barrier(); } while (0)
__device__ __forceinline__ void gemm_mainloop_g(f32x16 (&acc)[2][2], const bf16_t* const (&arow)[2], const bf16_t* const (&wrow)[2], const int nkt, char* lds, const int tid) {
    const int lane = tid & 63, wid = tid >> 6, wr = wid >> 1, wc = wid & 1, fr = lane & 31, fh = lane >> 5;
    const int wbase = __builtin_amdgcn_readfirstlane(wid) * 1024;
#pragma unroll 1
    for (int p = 0; p < 3; ++p) if (p < nkt) {
        char* st = lds + p * GST + wbase;
        glds16(arow[0] + p * 32, st); glds16(arow[1] + p * 32, st + 4096);
        glds16(wrow[0] + p * 32, st + 8192); glds16(wrow[1] + p * 32, st + 8192 + 4096);
    }
    const int ra0 = gl_off(wr * 64 + fr, fh), ra1 = gl_off(wr * 64 + 32 + fr, fh);
    const int rb0 = 8192 + gl_off(wc * 64 + fr, fh), rb1 = 8192 + gl_off(wc * 64 + 32 + fr, fh);
#pragma unroll 1
    for (int kt = 0; kt < nkt; ++kt) {
        if (kt + 2 < nkt) asm volatile("s_waitcnt vmcnt(8)" ::: "memory");
        else if (kt + 1 < nkt) asm volatile("s_waitcnt vmcnt(4)" ::: "memory");
        else asm volatile("s_waitcnt vmcnt(0)" ::: "memory");
        RAW_BARRIER();
        if (kt + 3 < nkt) {
            char* st = lds + ((kt + 3) & 3) * GST + wbase;
            const int ko = (kt + 3) * 32;
            glds16(arow[0] + ko, st); glds16(arow[1] + ko, st + 4096);
            glds16(wrow[0] + ko, st + 8192); glds16(wrow[1] + ko, st + 8192 + 4096);
        }
        const char* cur = lds + (kt & 3) * GST;
        bf16x8 xa[2][2], wb[2][2];
#pragma unroll
        for (int s2 = 0; s2 < 2; ++s2) {
            xa[s2][0] = *(const bf16x8*)(cur + (ra0 ^ (s2 << 5))); xa[s2][1] = *(const bf16x8*)(cur + (ra1 ^ (s2 << 5)));
            wb[s2][0] = *(const bf16x8*)(cur + (rb0 ^ (s2 << 5))); wb[s2][1] = *(const bf16x8*)(cur + (rb1 ^ (s2 << 5)));
        }
        __builtin_amdgcn_sched_barrier(0);
#pragma unroll
        for (int s2 = 0; s2 < 2; ++s2) {
            acc[0][0] = __builtin_amdgcn_mfma_f32_32x32x16_bf16(wb[s2][0], xa[s2][0], acc[0][0], 0, 0, 0);
            acc[0][1] = __builtin_amdgcn_mfma_f32_32x32x16_bf16(wb[s2][1], xa[s2][0], acc[0][1], 0, 0, 0);
            acc[1][0] = __builtin_amdgcn_mfma_f32_32x32x16_bf16(wb[s2][0], xa[s2][1], acc[1][0], 0, 0, 0);
            acc[1][1] = __builtin_amdgcn_mfma_f32_32x32x16_bf16(wb[s2][1], xa[s2][1], acc[1][1], 0, 0, 0);
        }
    }
    RAW_BARRIER();
}
__device__ __forceinline__ int g64_chunk(int tid) { return (tid & 7) ^ ((tid >> 4) & 7); }
__device__ __forceinline__ void gemm_mainloop_g64(f32x16 (&acc)[2][2], const bf16_t* const (&arow)[4], const bf16_t* const (&wrow)[4], const int nkt, char* lds, const int tid) {
    const int lane = tid & 63, wid = tid >> 6, wr = wid >> 1, wc = wid & 1, fr = lane & 31, fh = lane >> 5;
    const int wbase = __builtin_amdgcn_readfirstlane(wid) * 1024;
    {
        char* st = lds + wbase;
#pragma unroll
        for (int i = 0; i < 4; ++i) { glds16(arow[i], st + i * 4096); glds16(wrow[i], st + 16384 + i * 4096); }
    }
#pragma unroll 1
    for (int kt = 0; kt < nkt; ++kt) {
        asm volatile("s_waitcnt vmcnt(0)" ::: "memory");
        RAW_BARRIER();
        if (kt + 1 < nkt) {
            char* st = lds + ((kt + 1) & 1) * 32768 + wbase;
            const int ko = (kt + 1) * 64;
#pragma unroll
            for (int i = 0; i < 4; ++i) { glds16(arow[i] + ko, st + i * 4096); glds16(wrow[i] + ko, st + 16384 + i * 4096); }
        }
        const char* cur = lds + (kt & 1) * 32768;
#pragma unroll
        for (int s = 0; s < 4; ++s) {
            bf16x8 xa[2], wb[2];
#pragma unroll
            for (int i = 0; i < 2; ++i) xa[i] = *(const bf16x8*)(cur + lds_off(wr * 64 + i * 32 + fr, 2 * s + fh));
#pragma unroll
            for (int j = 0; j < 2; ++j) wb[j] = *(const bf16x8*)(cur + 16384 + lds_off(wc * 64 + j * 32 + fr, 2 * s + fh));
#pragma unroll
            for (int i = 0; i < 2; ++i)
#pragma unroll
                for (int j = 0; j < 2; ++j) acc[i][j] = __builtin_amdgcn_mfma_f32_32x32x16_bf16(wb[j], xa[i], acc[i][j], 0, 0, 0);
        }
    }
    RAW_BARRIER();
}
__device__ __forceinline__ void acc_zero(f32x16 (&acc)[2][2]) {
#pragma unroll
    for (int i = 0; i < 2; ++i)
#pragma unroll
        for (int j = 0; j < 2; ++j)
#pragma unroll
            for (int r = 0; r < 16; ++r) acc[i][j][r] = 0.f;
}
__device__ __forceinline__ void publish_rowstat(float (&ss)[4], float* stat, float invK, bool as_rstd, const int tid) {
#pragma unroll
    for (int i = 0; i < 4; ++i) {
        float v = ss[i];
        v += __shfl_xor(v, 1); v += __shfl_xor(v, 2); v += __shfl_xor(v, 4);
        if ((tid & 7) == 0) stat[(tid >> 3) + 32 * i] = as_rstd ? rsqrtf(v * invK + EPS) : v;
    }
    __syncthreads();
}
__device__ __forceinline__ int nidx(int r, int fh) { return (r & 3) + 8 * (r >> 2) + 4 * fh; }
__device__ __forceinline__ uint4 pack8(const float4& a, const float4& b) { uint4 pk; pk.x = pack2(a.x, a.y); pk.y = pack2(a.z, a.w); pk.z = pack2(b.x, b.y); pk.w = pack2(b.z, b.w); return pk; }
__device__ __forceinline__ float sq8(const float4& a, const float4& b) { return (a.x * a.x + a.y * a.y) + (a.z * a.z + a.w * a.w) + (b.x * b.x + b.y * b.y) + (b.z * b.z + b.w * b.w); }
__device__ __forceinline__ float4 mul4(const float4& a, float s) { return make_float4(a.x * s, a.y * s, a.z * s, a.w * s); }
__device__ __forceinline__ void store4(bf16_t* p, float a, float b, float c, float d) {
    uint2 v; v.x = pack2(a, b); v.y = pack2(c, d); *(uint2*)p = v;
}

__device__ __forceinline__ bool xcd_item(int it, int MT, int NTl, int& mt, int& nt) {
    const int x = blockIdx.x & 7, lb = blockIdx.x >> 3, nlb = gridDim.x >> 3;
    const int li = it * nlb + lb, per = (MT >> 3) * NTl;
    if (li >= per) return false;
    mt = (li / NTl) * 8 + x; nt = li % NTl; return true;
}

constexpr int TLD = 132;
constexpr int STAT_OFF = 128 * TLD * 4;
constexpr int LDS_GEMM_BYTES = STAT_OFF + 2048;
__device__ __forceinline__ void acc_to_lds(const f32x16 (&acc)[2][2], float* T, const int tid) {
    const int lane = tid & 63, wid = tid >> 6, wr = wid >> 1, wc = wid & 1, fr = lane & 31, fh = lane >> 5;
#pragma unroll
    for (int i = 0; i < 2; ++i)
#pragma unroll
        for (int j = 0; j < 2; ++j)
#pragma unroll
            for (int g = 0; g < 4; ++g) {
                float4 v; v.x = acc[i][j][4 * g]; v.y = acc[i][j][4 * g + 1]; v.z = acc[i][j][4 * g + 2]; v.w = acc[i][j][4 * g + 3];
                *(float4*)(T + (wr * 64 + i * 32 + fr) * TLD + wc * 64 + j * 32 + 8 * g + 4 * fh) = v;
            }
    __syncthreads();
}
__device__ __forceinline__ float rstd8(const float* p, float invK) {
    const float4 a = *(const float4*)p, b = *(const float4*)(p + 4);
    return rsq_(((a.x + a.y) + (a.z + a.w) + (b.x + b.y) + (b.z + b.w)) * invK + EPS);
}

}
namespace fx {

__device__ void phase_zgemm(const Params& P, int L, char* lds, const bool same = false) {
    const WS& w = P.w; const nv::Inputs& in = P.in;
    const int tid0 = opaque_tid();
    float* T = (float*)lds; float* stat = (float*)(lds + STAT_OFF);
    const bf16_t* Wt = w.W1t + L * W1_SZ;
    int mt, nt;
    for (int it = 0; xcd_item(it, 128, 12, mt, nt); ++it) {
        int tid = tid0; asm volatile("" : "+v"(tid));
        const int lane = tid & 63, wid = tid >> 6;
        const int m0 = mt * 128, n0 = nt * 128;
        {
            const bf16_t* arow[4]; const bf16_t* wrow[4];
#pragma unroll
            for (int i = 0; i < 4; ++i) {
                arow[i] = w.hb + (size_t)(m0 + (tid >> 3) + 32 * i) * 1024 + g64_chunk(tid) * 8;
                wrow[i] = Wt + (size_t)(n0 + (tid >> 3) + 32 * i) * 1024 + g64_chunk(tid) * 8;
            }
            f32x16 acc[2][2]; acc_zero(acc);
            float my_rs = 0.f;
            if (tid < 128) my_rs = rstd8(w.rssA + (size_t)(m0 + tid) * 8, 1.f / 1024.f);
            gemm_mainloop_g64(acc, arow, wrow, 16, lds, tid);
            if (tid < 128) stat[tid] = my_rs;
            acc_to_lds(acc, T, tid);
        }
        const int sub = lane >> 4, l16 = lane & 15, c8 = l16 * 8;
        if (nt < 2) {
#pragma unroll 8
            for (int rr = 0; rr < 8; ++rr) {
                const int row = wid * 32 + rr * 4 + sub; const float rs = stat[row];
                float4 x0 = *(const float4*)(T + row * TLD + c8), x1 = *(const float4*)(T + row * TLD + c8 + 4);
                x0.x = gelu_tanh_(x0.x * rs); x0.y = gelu_tanh_(x0.y * rs); x0.z = gelu_tanh_(x0.z * rs); x0.w = gelu_tanh_(x0.w * rs);
                x1.x = gelu_tanh_(x1.x * rs); x1.y = gelu_tanh_(x1.y * rs); x1.z = gelu_tanh_(x1.z * rs); x1.w = gelu_tanh_(x1.w * rs);
                *(uint4*)(w.ub + (size_t)(m0 + row) * 256 + nt * 128 + c8) = pack8(x0, x1);
            }
        } else if (nt < 4) {
            const int hd = (nt - 2) * 2 + (l16 >> 3), d0 = (l16 & 7) * 8;
            const float4 g0 = *(const float4*)(in.sgu_ln_g + L * 256 + hd * 64 + d0), g1 = *(const float4*)(in.sgu_ln_g + L * 256 + hd * 64 + d0 + 4);
            const float4 b0 = *(const float4*)(in.sgu_ln_b + L * 256 + hd * 64 + d0), b1 = *(const float4*)(in.sgu_ln_b + L * 256 + hd * 64 + d0 + 4);
#pragma unroll 4
            for (int rr = 0; rr < 8; ++rr) {
                const int row = wid * 32 + rr * 4 + sub; const float rs = stat[row];
                float4 x0 = *(const float4*)(T + row * TLD + c8), x1 = *(const float4*)(T + row * TLD + c8 + 4);
                x0.x = gelu_tanh_(x0.x * rs); x0.y = gelu_tanh_(x0.y * rs); x0.z = gelu_tanh_(x0.z * rs); x0.w = gelu_tanh_(x0.w * rs);
                x1.x = gelu_tanh_(x1.x * rs); x1.y = gelu_tanh_(x1.y * rs); x1.z = gelu_tanh_(x1.z * rs); x1.w = gelu_tanh_(x1.w * rs);
                const float mean = grp_sum8((x0.x + x0.y) + (x0.z + x0.w) + (x1.x + x1.y) + (x1.z + x1.w)) * (1.f / 64.f);
                x0.x -= mean; x0.y -= mean; x0.z -= mean; x0.w -= mean; x1.x -= mean; x1.y -= mean; x1.z -= mean; x1.w -= mean;
                const float rv = rsq_(grp_sum8(sq8(x0, x1)) * (1.f / 64.f) + EPS);
                x0.x = x0.x * rv * g0.x + b0.x; x0.y = x0.y * rv * g0.y + b0.y; x0.z = x0.z * rv * g0.z + b0.z; x0.w = x0.w * rv * g0.w + b0.w;
                x1.x = x1.x * rv * g1.x + b1.x; x1.y = x1.y * rv * g1.y + b1.y; x1.z = x1.z * rv * g1.z + b1.z; x1.w = x1.w * rv * g1.w + b1.w;
                *(float4*)(T + row * TLD + c8) = x0; *(float4*)(T + row * TLD + c8 + 4) = x1;
            }
            __syncthreads();
            {
                const int c = tid & 127, th = tid >> 7, hd2 = (nt - 2) * 2 + (c >> 6), d = c & 63;
                bf16_t* dst = w.vT + ((size_t)(mt * 4 + hd2) * 64 + d) * 128 + th * 64;
#pragma unroll 2
                for (int k8 = 0; k8 < 8; ++k8) {
                    float v[8];
#pragma unroll
                    for (int k = 0; k < 8; ++k) v[k] = T[(th * 64 + k8 * 8 + k) * TLD + c];
                    uint4 pk; pk.x = pack2(v[0], v[1]); pk.y = pack2(v[2], v[3]); pk.z = pack2(v[4], v[5]); pk.w = pack2(v[6], v[7]);
                    *(uint4*)(dst + k8 * 8) = pk;
                }
            }
        } else if (nt < 8) {
#pragma unroll 8
            for (int rr = 0; rr < 8; ++rr) {
                const int row = wid * 32 + rr * 4 + sub; const float rs = stat[row];
                const float4 x0 = *(const float4*)(T + row * TLD + c8), x1 = *(const float4*)(T + row * TLD + c8 + 4);
                store4(w.ygb + (size_t)(m0 + row) * 256 + (nt - 4) * 64 + l16 * 4, x0.x * rs * sigmoid_(x0.y * rs), x0.z * rs * sigmoid_(x0.w * rs),
                       x1.x * rs * sigmoid_(x1.y * rs), x1.z * rs * sigmoid_(x1.w * rs));
            }
        } else if (nt < 11) {
            bf16_t* base; int ld, cb;
            if (nt < 10) { base = w.cqb; ld = 256; cb = (nt - 8) * 128; } else { base = w.ckvb; ld = 128; cb = 0; }
#pragma unroll 8
            for (int rr = 0; rr < 8; ++rr) {
                const int row = wid * 32 + rr * 4 + sub; const float rs = stat[row];
                const float4 x0 = mul4(*(const float4*)(T + row * TLD + c8), rs), x1 = mul4(*(const float4*)(T + row * TLD + c8 + 4), rs);
                *(uint4*)(base + (size_t)(m0 + row) * ld + cb + c8) = pack8(x0, x1);
                const float sq = grp_sum16(sq8(x0, x1));
                if (l16 == 0) w.cqss[(size_t)(m0 + row) * 4 + (nt - 8)] = sq;
            }
        } else {
            const int lq = l16 & 3, dd = lq * 8, jj = (lq & 1) * 8;
            const float4 kg0 = *(const float4*)(in.k_norm_g + L * 96 + 64 + dd), kg1 = *(const float4*)(in.k_norm_g + L * 96 + 64 + dd + 4);
#pragma unroll 1
            for (int hb4 = 0; hb4 < 2; ++hb4) {
                float4 cc0[4], cc1[4], ss0[4], ss1[4];
#pragma unroll
                for (int r4 = 0; r4 < 4; ++r4) {
                    const float* csr = w.cs + (size_t)(m0 + wid * 32 + (hb4 * 4 + r4) * 4 + sub) * 32 + jj;
                    cc0[r4] = *(const float4*)csr; cc1[r4] = *(const float4*)(csr + 4); ss0[r4] = *(const float4*)(csr + 16); ss1[r4] = *(const float4*)(csr + 20);
                }
#pragma unroll
                for (int r4 = 0; r4 < 4; ++r4) {
                    const int row = wid * 32 + (hb4 * 4 + r4) * 4 + sub; const float rs = stat[row]; const int tok = m0 + row;
                    float4 x0 = mul4(*(const float4*)(T + row * TLD + dd), rs), x1 = mul4(*(const float4*)(T + row * TLD + dd + 4), rs);
                    const float rn = rsq_(grp_sum4(sq8(x0, x1)) * (1.f / 32.f) + EPS);
                    x0.x *= rn * kg0.x; x0.y *= rn * kg0.y; x0.z *= rn * kg0.z; x0.w *= rn * kg0.w;
                    x1.x *= rn * kg1.x; x1.y *= rn * kg1.y; x1.z *= rn * kg1.z; x1.w *= rn * kg1.w;
                    const float4 o0 = make_float4(quad_x2(x0.x), quad_x2(x0.y), quad_x2(x0.z), quad_x2(x0.w)), o1 = make_float4(quad_x2(x1.x), quad_x2(x1.y), quad_x2(x1.z), quad_x2(x1.w));
                    const float4 c0 = cc0[r4], c1 = cc1[r4], s0 = ss0[r4], s1 = ss1[r4];
                    const float sg = (lq & 2) ? 1.f : -1.f;
                    float4 r0, r1;
                    r0.x = x0.x * c0.x + sg * o0.x * s0.x; r0.y = x0.y * c0.y + sg * o0.y * s0.y; r0.z = x0.z * c0.z + sg * o0.z * s0.z; r0.w = x0.w * c0.w + sg * o0.w * s0.w;
                    r1.x = x1.x * c1.x + sg * o1.x * s1.x; r1.y = x1.y * c1.y + sg * o1.y * s1.y; r1.z = x1.z * c1.z + sg * o1.z * s1.z; r1.w = x1.w * c1.w + sg * o1.w * s1.w;
                    if (l16 < 4) *(uint4*)(w.kpeb + (size_t)tok * 32 + dd) = pack8(r0, r1);
                }
            }
        }
        __syncthreads();
    }
}

__global__ void k_shim_z(Params P, int t0) {
    const WS& w = P.w;
    size_t idx = (size_t)blockIdx.x * blockDim.x + threadIdx.x;
    if (idx >= (size_t)2048 * 1440) return;
    int t = t0 + (int)(idx / 1440), c = (int)(idx % 1440);
    float v = 0.f;
    if (c < 256) v = bf2f(w.ub[(size_t)t * 256 + c]);
    else if (c < 512) { int cc = c - 256; v = bf2f(w.vT[((size_t)((t >> 7) * 4 + (cc >> 6)) * 64 + (cc & 63)) * 128 + (t & 127)]); }
    else if (c < 768) v = bf2f(w.ygb[(size_t)t * 256 + c - 512]);
    else if (c < 1024) v = 0.f;
    else if (c < 1280) v = bf2f(w.cqb[(size_t)t * 256 + c - 1024]);
    else if (c < 1408) v = bf2f(w.ckvb[(size_t)t * 128 + c - 1280]);
    else v = bf2f(w.kpeb[(size_t)t * 32 + c - 1408]);
    P.zf[idx] = v;
}
__global__ void k_shim_hb(Params P) {
    size_t i = (size_t)blockIdx.x * blockDim.x + threadIdx.x;
    if (i >= (size_t)NT * 1024 / 4) return;
    float4 v = ((const float4*)P.h)[i];
    uint2 pk; pk.x = pack2(v.x, v.y); pk.y = pack2(v.z, v.w);
    ((uint2*)P.w.hb)[i] = pk;
}

}
namespace fx {

constexpr float QSCALE = 0.10206207261596575f * 1.4426950408889634f;

__device__ void qkv_item(const Params& P, int L, const bool isq, const int mt, const int nt, char* lds, const int tid_in) {
    int tid = tid_in; asm volatile("" : "+v"(tid));
    const WS& w = P.w; const nv::Inputs& in = P.in;
    const int lane = tid & 63, wid = tid >> 6;
    float* T = (float*)lds; float* stat = (float*)(lds + STAT_OFF);
    const int m0 = mt * 128, n0 = nt * 128;
    const int K = isq ? 256 : 128;
    {
        const bf16_t* A = isq ? w.cqb : w.ckvb;
        const bf16_t* Wt = isq ? (w.Wuqt + L * WUQ_SZ) : (w.Wukvt + L * WUKV_SZ);
        const bf16_t* arow[2]; const bf16_t* wrow[2];
#pragma unroll
        for (int i = 0; i < 2; ++i) {
            arow[i] = A + (size_t)(m0 + (tid >> 2) + 64 * i) * K + gl_chunk(tid) * 8;
            wrow[i] = Wt + (size_t)(n0 + (tid >> 2) + 64 * i) * K + gl_chunk(tid) * 8;
        }
        f32x16 acc[2][2]; acc_zero(acc);
        float my_rs = 0.f;
        if (tid < 128) {
            const float4 c = *(const float4*)(w.cqss + (size_t)(m0 + tid) * 4);
            my_rs = isq ? rsq_((c.x + c.y) * (1.f / 256.f) + EPS) : rsq_(c.z * (1.f / 128.f) + EPS);
        }
        gemm_mainloop_g(acc, arow, wrow, K / 32, lds, tid);
        if (tid < 128) stat[tid] = my_rs;
        acc_to_lds(acc, T, tid);
    }
    const int b = m0 >> 11, s0 = m0 & 2047;
    const int sub = lane >> 4, l16 = lane & 15, c8 = l16 * 8;
    if (isq && nt < 4) {
        const int hd = nt * 2 + (l16 >> 3), d = (l16 & 7) * 8;
        const float4 g0 = mul4(*(const float4*)(in.q_norm_g + L * 96 + d), QSCALE), g1 = mul4(*(const float4*)(in.q_norm_g + L * 96 + d + 4), QSCALE);
        bf16_t* dst = w.Qb + ((size_t)(b * 8 + hd) * 2048 + s0) * 96 + d;
#pragma unroll 8
        for (int rr = 0; rr < 8; ++rr) {
            const int row = wid * 32 + rr * 4 + sub; const float rs = stat[row];
            float4 x0 = mul4(*(const float4*)(T + row * TLD + c8), rs), x1 = mul4(*(const float4*)(T + row * TLD + c8 + 4), rs);
            const float rn = rsq_(grp_sum8(sq8(x0, x1)) * (1.f / 64.f) + EPS);
            x0.x *= rn * g0.x; x0.y *= rn * g0.y; x0.z *= rn * g0.z; x0.w *= rn * g0.w; x1.x *= rn * g1.x; x1.y *= rn * g1.y; x1.z *= rn * g1.z; x1.w *= rn * g1.w;
            *(uint4*)(dst + (size_t)row * 96) = pack8(x0, x1);
        }
    } else if (isq) {
        const int hd = (nt - 4) * 4 + (l16 >> 2), lq = l16 & 3, dd = lq * 8, jj = (lq & 1) * 8;
        const float4 g0 = *(const float4*)(in.q_norm_g + L * 96 + 64 + dd), g1 = *(const float4*)(in.q_norm_g + L * 96 + 64 + dd + 4);
        bf16_t* dst = w.Qb + ((size_t)(b * 8 + hd) * 2048 + s0) * 96 + 64 + dd;
        const float sg = (lq & 2) ? QSCALE : -QSCALE;
#pragma unroll 1
        for (int hb4 = 0; hb4 < 2; ++hb4) {
            float4 cc0[4], cc1[4], ss0[4], ss1[4];
#pragma unroll
            for (int r4 = 0; r4 < 4; ++r4) {
                const float* csr = w.cs + (size_t)(m0 + wid * 32 + (hb4 * 4 + r4) * 4 + sub) * 32 + jj;
                cc0[r4] = *(const float4*)csr; cc1[r4] = *(const float4*)(csr + 4); ss0[r4] = *(const float4*)(csr + 16); ss1[r4] = *(const float4*)(csr + 20);
            }
#pragma unroll
            for (int r4 = 0; r4 < 4; ++r4) {
                const int row = wid * 32 + (hb4 * 4 + r4) * 4 + sub; const float rs = stat[row];
                float4 x0 = mul4(*(const float4*)(T + row * TLD + c8), rs), x1 = mul4(*(const float4*)(T + row * TLD + c8 + 4), rs);
                const float rn = rsq_(grp_sum4(sq8(x0, x1)) * (1.f / 32.f) + EPS);
                x0.x *= rn * g0.x; x0.y *= rn * g0.y; x0.z *= rn * g0.z; x0.w *= rn * g0.w; x1.x *= rn * g1.x; x1.y *= rn * g1.y; x1.z *= rn * g1.z; x1.w *= rn * g1.w;
                const float4 o0 = make_float4(quad_x2(x0.x), quad_x2(x0.y), quad_x2(x0.z), quad_x2(x0.w)), o1 = make_float4(quad_x2(x1.x), quad_x2(x1.y), quad_x2(x1.z), quad_x2(x1.w));
                const float4 c0 = mul4(cc0[r4], QSCALE), c1 = mul4(cc1[r4], QSCALE), s0v = ss0[r4], s1v = ss1[r4];
                float4 r0, r1;
                r0.x = x0.x * c0.x + sg * o0.x * s0v.x; r0.y = x0.y * c0.y + sg * o0.y * s0v.y; r0.z = x0.z * c0.z + sg * o0.z * s0v.z; r0.w = x0.w * c0.w + sg * o0.w * s0v.w;
                r1.x = x1.x * c1.x + sg * o1.x * s1v.x; r1.y = x1.y * c1.y + sg * o1.y * s1v.y; r1.z = x1.z * c1.z + sg * o1.z * s1v.z; r1.w = x1.w * c1.w + sg * o1.w * s1v.w;
                *(uint4*)(dst + (size_t)row * 96) = pack8(r0, r1);
            }
        }
    } else if (nt < 4) {
        const int hd = nt * 2 + (l16 >> 3), d = (l16 & 7) * 8;
        const float4 g0 = *(const float4*)(in.k_norm_g + L * 96 + d), g1 = *(const float4*)(in.k_norm_g + L * 96 + d + 4);
        bf16_t* dst = w.Knb + ((size_t)(b * 8 + hd) * 2048 + s0) * 64 + d;
#pragma unroll 8
        for (int rr = 0; rr < 8; ++rr) {
            const int row = wid * 32 + rr * 4 + sub; const float rs = stat[row];
            float4 x0 = mul4(*(const float4*)(T + row * TLD + c8), rs), x1 = mul4(*(const float4*)(T + row * TLD + c8 + 4), rs);
            const float rn = rsq_(grp_sum8(sq8(x0, x1)) * (1.f / 64.f) + EPS);
            x0.x *= rn * g0.x; x0.y *= rn * g0.y; x0.z *= rn * g0.z; x0.w *= rn * g0.w; x1.x *= rn * g1.x; x1.y *= rn * g1.y; x1.z *= rn * g1.z; x1.w *= rn * g1.w;
            *(uint4*)(dst + (size_t)row * 64) = pack8(x0, x1);
        }
    } else {
        const int c = tid & 127, th = tid >> 7, hd = (nt - 4) * 2 + (c >> 6), d = c & 63;
        bf16_t* dst = w.VTb + ((size_t)(b * 8 + hd) * 64 + d) * 2048 + s0 + th * 64;
#pragma unroll 2
        for (int k8 = 0; k8 < 8; ++k8) {
            float v[8];
#pragma unroll
            for (int k = 0; k < 8; ++k) { const int row = th * 64 + k8 * 8 + k; v[k] = T[row * TLD + c] * stat[row]; }
            uint4 pk; pk.x = pack2(v[0], v[1]); pk.y = pack2(v[2], v[3]); pk.z = pack2(v[4], v[5]); pk.w = pack2(v[6], v[7]);
            *(uint4*)(dst + k8 * 8) = pk;
        }
    }
    __syncthreads();
}

__device__ void sgu_item(const Params& P, int L, int mt, char* lds, const int tid_in) {
    int tid = tid_in; asm volatile("" : "+v"(tid));
    const WS& w = P.w; const nv::Inputs& in = P.in;
    const int lane = tid & 63, hd = tid >> 6, fr = lane & 31, fh = lane >> 5;
    float* red = (float*)lds;
    const bf16_t* vt = w.vT + (size_t)(mt * 4 + hd) * 64 * 128;
    const bf16_t* ws = w.Wsm + L * WSM_SZ + (size_t)hd * 128 * 128;
    const float* bs = in.sgu_b + L * 512 + hd * 128;
    const int m0 = mt * 128;
    bf16x8 af0[8], af1[8];
    {
        const bf16_t* ap0 = vt + (size_t)fr * 128 + 8 * fh;
        const bf16_t* ap1 = vt + (size_t)(32 + fr) * 128 + 8 * fh;
#pragma unroll
        for (int s = 0; s < 8; ++s) { af0[s] = *(const bf16x8*)(ap0 + 16 * s); af1[s] = *(const bf16x8*)(ap1 + 16 * s); }
    }
#pragma unroll 1
    for (int it = 0; it < 4; ++it) {
        f32x16 a0, a1;
#pragma unroll
        for (int r = 0; r < 16; ++r) { a0[r] = 0.f; a1[r] = 0.f; }
        const bf16_t* bp = ws + (size_t)(it * 32 + fr) * 128 + 8 * fh;
        bf16x8 bfr[8];
#pragma unroll
        for (int s = 0; s < 8; ++s) bfr[s] = *(const bf16x8*)(bp + 16 * s);
#pragma unroll
        for (int s = 0; s < 8; ++s) {
            a0 = __builtin_amdgcn_mfma_f32_32x32x16_bf16(af0[s], bfr[s], a0, 0, 0, 0);
            a1 = __builtin_amdgcn_mfma_f32_32x32x16_bf16(af1[s], bfr[s], a1, 0, 0, 0);
        }
        const int i = it * 32 + fr, tok = m0 + i;
        const float bias = bs[i];
        uint2 uu[2][4];
#pragma unroll
        for (int dt = 0; dt < 2; ++dt)
#pragma unroll
            for (int g = 0; g < 4; ++g) uu[dt][g] = *(const uint2*)(w.ub + (size_t)tok * 256 + hd * 64 + dt * 32 + 8 * g + 4 * fh);
        float ssq = 0.f;
#pragma unroll
        for (int dt = 0; dt < 2; ++dt)
#pragma unroll
            for (int g = 0; g < 4; ++g) {
                const int d = dt * 32 + 8 * g + 4 * fh;
                float o[4];
#pragma unroll
                for (int q = 0; q < 4; ++q) {
                    const float sv = (dt == 0 ? a0[4 * g + q] : a1[4 * g + q]) + bias;
                    const float uv = (q == 0) ? bflo(uu[dt][g].x) : (q == 1) ? bfhi(uu[dt][g].x) : (q == 2) ? bflo(uu[dt][g].y) : bfhi(uu[dt][g].y);
                    o[q] = uv * sv; ssq += o[q] * o[q];
                }
                store4(w.yb + (size_t)tok * 1024 + hd * 64 + d, o[0], o[1], o[2], o[3]);
            }
        ssq = xor32(ssq);
        if (fh == 0) red[hd * 128 + i] = ssq;
    }
    __syncthreads();
    if (tid < 128) w.ssq[(size_t)(m0 + tid) * 16 + 0] = red[tid] + red[128 + tid] + red[256 + tid] + red[384 + tid];
    __syncthreads();
}

constexpr int CLD = 260, CONV_YL = 32 * CLD * 4, CONV_ST = CONV_YL + 32 * 512, CONV_RED = CONV_ST + 32 * 4 * 8;
__device__ __forceinline__ int yl_off(int row, int chunk) { return row * 512 + ((chunk ^ (row & 15)) << 4); }
__device__ void conv_item(const Params& P, int L, int ct, char* lds, const int tid_in) {
    int tid = tid_in; asm volatile("" : "+v"(tid));
    const WS& w = P.w; const nv::Inputs& in = P.in;
    const int lane = tid & 63, wid = tid >> 6, fr = lane & 31, fh = lane >> 5;
    float* C = (float*)lds; char* yl = lds + CONV_YL; float2* stats = (float2*)(lds + CONV_ST); float* red = (float*)(lds + CONV_RED);
    const int t0 = ct * 32, s0 = t0 & 2047;
    {
        const int c = tid;
        float x[62];
#pragma unroll
        for (int r = 0; r < 62; ++r) {
            const bool ok = s0 + r - 30 >= 0;
            const unsigned short raw = w.ygb[(size_t)(ok ? t0 + r - 30 : t0) * 256 + c];
            x[r] = bf2f(raw) * (ok ? 1.f : 0.f);
        }
        float wk[31];
#pragma unroll
        for (int k = 0; k < 31; ++k) wk[k] = in.conv_w[(size_t)L * 31 * 256 + k * 256 + c];
        const float cb = in.conv_b[L * 256 + c];
#pragma unroll
        for (int t = 0; t < 32; ++t) {
            float a = cb;
#pragma unroll
            for (int k = 0; k < 31; ++k) a = fmaf(wk[k], x[t + k], a);
            C[t * CLD + c] = a;
        }
    }
    __syncthreads();
    if (tid < 128) {
        const int t = tid >> 2, g = tid & 3;
        const float4* cp = (const float4*)(C + t * CLD + g * 64);
        float4 v[16]; float s = 0.f;
#pragma unroll
        for (int i = 0; i < 16; ++i) { v[i] = cp[i]; s += (v[i].x + v[i].y) + (v[i].z + v[i].w); }
        const float mean = s * (1.f / 64.f); float q = 0.f;
#pragma unroll
        for (int i = 0; i < 16; ++i) { const float a = v[i].x - mean, b2 = v[i].y - mean, c2 = v[i].z - mean, d2 = v[i].w - mean; q += (a * a + b2 * b2) + (c2 * c2 + d2 * d2); }
        stats[t * 4 + g] = make_float2(mean, rsq_(q * (1.f / 64.f) + EPS));
    }
    __syncthreads();
    {
        const int c = tid, g = c >> 6;
        const float lg = in.conv_ln_g[L * 256 + c], lb = in.conv_ln_b[L * 256 + c];
#pragma unroll 8
        for (int t = 0; t < 32; ++t) {
            const float2 st = stats[t * 4 + g];
            const float v = (C[t * CLD + c] - st.x) * st.y * lg + lb;
            *(bf16_t*)(yl + yl_off(t, c >> 3) + (c & 7) * 2) = (bf16_t)f2bf(v * sigmoid_(v));
        }
    }
    __syncthreads();
    f32x16 acc0, acc1;
#pragma unroll
    for (int r = 0; r < 16; ++r) { acc0[r] = 0.f; acc1[r] = 0.f; }
    const bf16_t* wp = w.Wpwt + L * WPW_SZ + (size_t)(wid * 64 + fr) * 256 + 8 * fh;
#pragma unroll 4
    for (int s = 0; s < 16; ++s) {
        const bf16x8 w0 = *(const bf16x8*)(wp + 16 * s), w1 = *(const bf16x8*)(wp + 32 * 256 + 16 * s);
        const bf16x8 x0 = *(const bf16x8*)(yl + yl_off(fr, 2 * s + fh));
        acc0 = __builtin_amdgcn_mfma_f32_32x32x16_bf16(w0, x0, acc0, 0, 0, 0);
        acc1 = __builtin_amdgcn_mfma_f32_32x32x16_bf16(w1, x0, acc1, 0, 0, 0);
    }
    const float* pb = in.conv_pw_b + L * 256;
    {
        const int tok = t0 + fr;
        float4 bia[2][4];
#pragma unroll
        for (int jn = 0; jn < 2; ++jn)
#pragma unroll
            for (int g = 0; g < 4; ++g) bia[jn][g] = *(const float4*)(pb + wid * 64 + jn * 32 + 8 * g + 4 * fh);
        float ssq = 0.f;
#pragma unroll
        for (int jn = 0; jn < 2; ++jn)
#pragma unroll
            for (int g = 0; g < 4; ++g) {
                const int n = wid * 64 + jn * 32 + 8 * g + 4 * fh;
                const float4 b4 = bia[jn][g];
                const float o0 = (jn ? acc1[4 * g] : acc0[4 * g]) + b4.x, o1 = (jn ? acc1[4 * g + 1] : acc0[4 * g + 1]) + b4.y;
                const float o2 = (jn ? acc1[4 * g + 2] : acc0[4 * g + 2]) + b4.z, o3 = (jn ? acc1[4 * g + 3] : acc0[4 * g + 3]) + b4.w;
                ssq += o0 * o0 + o1 * o1 + o2 * o2 + o3 * o3;
                store4(w.yb + (size_t)tok * 1024 + 256 + n, o0, o1, o2, o3);
            }
        ssq = xor32(ssq);
        if (fh == 0) red[wid * 32 + fr] = ssq;
    }
    __syncthreads();
    if (tid < 32) w.ssq[(size_t)(t0 + tid) * 16 + 1] = red[tid] + red[32 + tid] + red[64 + tid] + red[96 + tid];
    __syncthreads();
}

__device__ void phase_mix(const Params& P, int L, char* lds, const int rep = 0, const bool dryrun = false) {
    const int tid = opaque_tid();
    const int x = blockIdx.x & 7;
    int* qctr = P.w.cnt + L * 64 + 40 + x + 8 * rep;
    volatile int* slot = (volatile int*)(lds + LDS_GEMM_BYTES - 16);
    if (tid == 0) *slot = atomicAdd(qctr, 1);
    __syncthreads();
    int cur = *slot;
    __syncthreads();
    while (cur < 304) {
        int nxt = 0;
        if (tid == 0) nxt = atomicAdd(qctr, 1);
#ifdef MIX_MASK
        const int mask = dryrun ? MIX_MASK : 15;
#else
        const int mask = 15;
#endif
#ifdef MIX_TWICE
        if (cur < 16) { if (MIX_TWICE & 1) sgu_item(P, L, cur * 8 + x, lds, tid); }
        else if (cur < 80) { if (MIX_TWICE & 2) conv_item(P, L, (cur - 16) * 8 + x, lds, tid); }
        else if (cur < 176) { if (MIX_TWICE & 4) { const int li = cur - 80; qkv_item(P, L, true, (li / 6) * 8 + x, li % 6, lds, tid); } }
        else { if (MIX_TWICE & 8) { const int li = cur - 176; qkv_item(P, L, false, (li >> 3) * 8 + x, li & 7, lds, tid); } }
#endif
        if (cur < 16) { if (mask & 1) sgu_item(P, L, cur * 8 + x, lds, tid); }
        else if (cur < 80) { if (mask & 2) conv_item(P, L, (cur - 16) * 8 + x, lds, tid); }
        else if (cur < 176) { if (mask & 4) { const int li = cur - 80; qkv_item(P, L, true, (li / 6) * 8 + x, li % 6, lds, tid); } }
        else { if (mask & 8) { const int li = cur - 176; qkv_item(P, L, false, (li >> 3) * 8 + x, li & 7, lds, tid); } }
        if (tid == 0) *slot = nxt;
        __syncthreads();
        cur = *slot;
        __syncthreads();
    }
}

__global__ void k_shim_qkv(Params P, int t0, float* q, float* kv) {
    const WS& w = P.w;
    size_t idx = (size_t)blockIdx.x * blockDim.x + threadIdx.x;
    if (idx >= (size_t)2048 * 1792) return;
    const int tl = (int)(idx / 1792), c = (int)(idx % 1792), t = t0 + tl, b = t >> 11, s = t & 2047;
    if (c < 768) { const int h = c / 96, d = c % 96; q[(size_t)tl * 768 + c] = bf2f(w.Qb[((size_t)(b * 8 + h) * 2048 + s) * 96 + d]) * (1.f / QSCALE); }
    else {
        const int cc = c - 768, h = cc >> 7, d = cc & 127;
        kv[(size_t)tl * 1024 + cc] = (d < 64) ? bf2f(w.Knb[((size_t)(b * 8 + h) * 2048 + s) * 64 + d]) : bf2f(w.VTb[((size_t)(b * 8 + h) * 64 + (d - 64)) * 2048 + s]);
    }
}
__global__ void k_shim_y(Params P, int t0, int c0, int c1) {
    const int wdt = c1 - c0;
    size_t idx = (size_t)blockIdx.x * blockDim.x + threadIdx.x;
    if (idx >= (size_t)2048 * wdt) return;
    const int tl = (int)(idx / wdt), c = c0 + (int)(idx % wdt);
    P.yf[(size_t)tl * 1024 + c] = bf2f(P.w.yb[(size_t)(t0 + tl) * 1024 + c]);
}

}
namespace fx {

constexpr int KROW = 208, VROW = 136, ATT_STAGE = 64 * KROW + 64 * VROW;

struct KVRegs { uint4 k0, k1, k2, v0, v1; };
__device__ __forceinline__ uint4 k_ld(const bf16_t* Kn, const bf16_t* Kp, int k0, int c) {
    const int key = c / 12, ch = c % 12;
    const bf16_t* src = (ch < 8) ? (Kn + (size_t)(k0 + key) * 64 + ch * 8) : (Kp + (size_t)(k0 + key) * 32 + (ch - 8) * 8);
    return *(const uint4*)src;
}
__device__ __forceinline__ void kv_load(KVRegs& r, const bf16_t* Kn, const bf16_t* Kp, const bf16_t* Vt, int k0, const int tid) {
    r.k0 = k_ld(Kn, Kp, k0, tid); r.k1 = k_ld(Kn, Kp, k0, tid + 256); r.k2 = k_ld(Kn, Kp, k0, tid + 512);
    r.v0 = *(const uint4*)(Vt + (size_t)(tid >> 3) * 2048 + k0 + (tid & 7) * 8);
    r.v1 = *(const uint4*)(Vt + (size_t)(32 + (tid >> 3)) * 2048 + k0 + (tid & 7) * 8);
}
__device__ __forceinline__ void k_st(char* st, int c, const uint4& v) { const int key = c / 12, ch = c % 12; *(uint4*)(st + key * KROW + ch * 16) = v; }
__device__ __forceinline__ void v_st(char* st, int d, int ch, const uint4& v) {
    char* p = st + 64 * KROW + d * VROW + ch * 16;
    *(uint2*)p = make_uint2(v.x, v.y); *(uint2*)(p + 8) = make_uint2(v.z, v.w);
}
__device__ __forceinline__ void kv_store(const KVRegs& r, char* st, const int tid) {
    k_st(st, tid, r.k0); k_st(st, tid + 256, r.k1); k_st(st, tid + 512, r.k2);
    v_st(st, tid >> 3, tid & 7, r.v0); v_st(st, 32 + (tid >> 3), tid & 7, r.v1);
}

__device__ void attn_unit(const Params& P, int b, int h, int qt, char* lds, const int tid) {
    const WS& w = P.w;
    const int lane = tid & 63, wid = tid >> 6, fr = lane & 31, fh = lane >> 5;
    const bf16_t* Kn = w.Knb + (size_t)(b * 8 + h) * 2048 * 64;
    const bf16_t* Kp = w.kpeb + (size_t)b * 2048 * 32;
    const bf16_t* Vt = w.VTb + (size_t)(b * 8 + h) * 64 * 2048;
    const int q0 = qt * 128, qw0 = q0 + wid * 32, qpos = qw0 + fr;
    bf16x8 qf[6];
    {
        const bf16_t* qp = w.Qb + ((size_t)(b * 8 + h) * 2048 + qpos) * 96 + 8 * fh;
#pragma unroll
        for (int ks = 0; ks < 6; ++ks) qf[ks] = *(const bf16x8*)(qp + 16 * ks);
    }
    f32x16 o0, o1;
#pragma unroll
    for (int r = 0; r < 16; ++r) { o0[r] = 0.f; o1[r] = 0.f; }
    float m = -1e30f, l = 0.f;
    const int nkt = 2 * (qt + 1);
    KVRegs kr;
    kv_load(kr, Kn, Kp, Vt, 0, tid);
    kv_store(kr, lds, tid);
    __syncthreads();
#pragma unroll 1
    for (int kt = 0; kt < nkt; ++kt) {
        char* cur = lds + (kt & 1) * ATT_STAGE;
        char* nxt = lds + ((kt + 1) & 1) * ATT_STAGE;
        const bool more = kt + 1 < nkt;
        if (more) kv_load(kr, Kn, Kp, Vt, (kt + 1) * 64, tid);
        const int k0 = kt * 64;
        if (k0 <= qw0 + 31) {
            f32x16 s0, s1;
#pragma unroll
            for (int r = 0; r < 16; ++r) { s0[r] = 0.f; s1[r] = 0.f; }
            const char* kb = cur + fr * KROW + fh * 16;
#pragma unroll
            for (int ks = 0; ks < 6; ++ks) {
                const bf16x8 ka = *(const bf16x8*)(kb + ks * 32), kb2 = *(const bf16x8*)(kb + 32 * KROW + ks * 32);
                s0 = __builtin_amdgcn_mfma_f32_32x32x16_bf16(ka, qf[ks], s0, 0, 0, 0);
                s1 = __builtin_amdgcn_mfma_f32_32x32x16_bf16(kb2, qf[ks], s1, 0, 0, 0);
            }
            if (k0 + 63 > qw0) {
#pragma unroll
                for (int r = 0; r < 16; ++r) {
                    const int key = k0 + nidx(r, fh);
                    if (key > qpos) s0[r] = -1e30f;
                    if (key + 32 > qpos) s1[r] = -1e30f;
                }
            }
            float mx = s0[0];
#pragma unroll
            for (int r = 1; r < 16; ++r) mx = fmaxf(mx, s0[r]);
#pragma unroll
            for (int r = 0; r < 16; ++r) mx = fmaxf(mx, s1[r]);
            mx = swap32_max(mx);
            const float mn = fmaxf(m, mx);
            const float alpha = __builtin_amdgcn_exp2f(m - mn);
            m = mn;
            float ps = 0.f;
#pragma unroll
            for (int r = 0; r < 16; ++r) { s0[r] = __builtin_amdgcn_exp2f(s0[r] - mn); ps += s0[r]; }
#pragma unroll
            for (int r = 0; r < 16; ++r) { s1[r] = __builtin_amdgcn_exp2f(s1[r] - mn); ps += s1[r]; }
            ps = swap32_sum(ps);
            l = l * alpha + ps;
#pragma unroll
            for (int r = 0; r < 16; ++r) { o0[r] *= alpha; o1[r] *= alpha; }
            const char* vb = cur + 64 * KROW + fr * VROW + fh * 8;
#pragma unroll
            for (int ks = 0; ks < 4; ++ks) {
                bf16x8 pf;
                {
                    const int rb = 8 * (ks & 1);
                    unsigned u0, u1, u2, u3;
                    if (ks < 2) { u0 = pack2(s0[rb], s0[rb + 1]); u1 = pack2(s0[rb + 2], s0[rb + 3]); u2 = pack2(s0[rb + 4], s0[rb + 5]); u3 = pack2(s0[rb + 6], s0[rb + 7]); }
                    else { u0 = pack2(s1[rb], s1[rb + 1]); u1 = pack2(s1[rb + 2], s1[rb + 3]); u2 = pack2(s1[rb + 4], s1[rb + 5]); u3 = pack2(s1[rb + 6], s1[rb + 7]); }
                    uint4 uu = make_uint4(u0, u1, u2, u3);
                    pf = __builtin_bit_cast(bf16x8, uu);
                }
                const uint2 va0 = *(const uint2*)(vb + ks * 32), va1 = *(const uint2*)(vb + ks * 32 + 16);
                const uint2 vb0 = *(const uint2*)(vb + 32 * VROW + ks * 32), vb1 = *(const uint2*)(vb + 32 * VROW + ks * 32 + 16);
                const bf16x8 vfa = __builtin_bit_cast(bf16x8, make_uint4(va0.x, va0.y, va1.x, va1.y));
                const bf16x8 vfb = __builtin_bit_cast(bf16x8, make_uint4(vb0.x, vb0.y, vb1.x, vb1.y));
                o0 = __builtin_amdgcn_mfma_f32_32x32x16_bf16(vfa, pf, o0, 0, 0, 0);
                o1 = __builtin_amdgcn_mfma_f32_32x32x16_bf16(vfb, pf, o1, 0, 0, 0);
            }
        }
        if (more) kv_store(kr, nxt, tid);
        __syncthreads();
    }
    const float inv = 1.f / l;
    const int tok = b * 2048 + qpos;
    float ssq = 0.f;
#pragma unroll
    for (int dt = 0; dt < 2; ++dt)
#pragma unroll
        for (int g = 0; g < 4; ++g) {
            float o[4];
#pragma unroll
            for (int q = 0; q < 4; ++q) { o[q] = (dt == 0 ? o0[4 * g + q] : o1[4 * g + q]) * inv; ssq += o[q] * o[q]; }
            store4(w.yb + (size_t)tok * 1024 + 512 + h * 64 + dt * 32 + 8 * g + 4 * fh, o[0], o[1], o[2], o[3]);
        }
    ssq = xor32(ssq);
    if (fh == 0) w.ssq[(size_t)tok * 16 + 8 + h] = ssq;
}

__device__ void phase_attn(const Params& P, int L, char* lds) {
    const int tid0 = opaque_tid();
    const int h = blockIdx.x & 7, nlb = gridDim.x >> 3;
    for (int li = blockIdx.x >> 3; li < 64; li += nlb) {
        int tid = tid0; asm volatile("" : "+v"(tid));
        const int p = li & 7, b = li >> 3;
        attn_unit(P, b, h, 15 - p, lds, tid);
        attn_unit(P, b, h, p, lds, tid);
    }
}

}
namespace fx {

__device__ __forceinline__ void acc_scale(f32x16 (&acc)[2][2], const float* f, const int tid) {
    const int lane = tid & 63, wr = tid >> 7, fr = lane & 31;
#pragma unroll
    for (int i = 0; i < 2; ++i) {
        const float v = f[wr * 64 + i * 32 + fr];
#pragma unroll
        for (int j = 0; j < 2; ++j)
#pragma unroll
            for (int r = 0; r < 16; ++r) acc[i][j][r] *= v;
    }
}
__device__ void phase_oproj(const Params& P, int L, char* lds, const bool dry = false) {
    const WS& w = P.w;
    const int tid0 = opaque_tid();
    float* T = (float*)lds; float* stat = (float*)(lds + STAT_OFF);
    const bf16_t* Wt = w.Wot + L * WO_SZ;
    int mt, nt;
    for (int it = 0; xcd_item(it, 128, 8, mt, nt); ++it) {
        int tid = tid0; asm volatile("" : "+v"(tid));
        const int lane = tid & 63, wid = tid >> 6;
        const int m0 = mt * 128, n0 = nt * 128;
        float rb_keep = 0.f;
        if (tid < 128) {
            const float* sq = w.ssq + (size_t)(m0 + tid) * 16;
            const float4 c0 = *(const float4*)(sq + 8), c1 = *(const float4*)(sq + 12);
            const float ra = rsq_(sq[0] * (1.f / 256.f) + EPS), rb = rsq_(sq[1] * (1.f / 256.f) + EPS);
            const float rc = rsq_((c0.x + c0.y + c0.z + c0.w + c1.x + c1.y + c1.z + c1.w) * (1.f / 512.f) + EPS);
            stat[tid] = rc / ra; stat[128 + tid] = ra / rb; rb_keep = rb;
        }
        {
            const bf16_t* arow[2]; const bf16_t* wrow[2];
#pragma unroll
            for (int i = 0; i < 2; ++i) {
                arow[i] = w.yb + (size_t)(m0 + (tid >> 2) + 64 * i) * 1024 + gl_chunk(tid) * 8 + 512;
                wrow[i] = Wt + (size_t)(n0 + (tid >> 2) + 64 * i) * 1024 + gl_chunk(tid) * 8 + 512;
            }
            f32x16 acc[2][2]; acc_zero(acc);
            gemm_mainloop_g(acc, arow, wrow, 16, lds, tid);
            acc_scale(acc, stat, tid);
#pragma unroll
            for (int i = 0; i < 2; ++i) { arow[i] -= 512; wrow[i] -= 512; }
            gemm_mainloop_g(acc, arow, wrow, 8, lds, tid);
            acc_scale(acc, stat + 128, tid);
#pragma unroll
            for (int i = 0; i < 2; ++i) { arow[i] += 256; wrow[i] += 256; }
            gemm_mainloop_g(acc, arow, wrow, 8, lds, tid);
            if (tid < 128) stat[tid] = rb_keep;
            acc_to_lds(acc, T, tid);
        }
        {
            const int sub = lane >> 4, c8 = (lane & 15) * 8;
            float4 hv0[8], hv1[8];
            if (L == 0) {
#pragma unroll
                for (int rr = 0; rr < 8; ++rr) {
                    const float4* hin = (const float4*)(P.in.x + (size_t)(m0 + wid * 32 + rr * 4 + sub) * 1024 + n0 + c8);
                    hv0[rr] = hin[0]; hv1[rr] = hin[1];
                }
            } else {
#pragma unroll
                for (int rr = 0; rr < 8; ++rr) {
                    const uint4 hh = *(const uint4*)(w.hb + (size_t)(m0 + wid * 32 + rr * 4 + sub) * 1024 + n0 + c8);
                    hv0[rr] = make_float4(bflo(hh.x), bfhi(hh.x), bflo(hh.y), bfhi(hh.y)); hv1[rr] = make_float4(bflo(hh.z), bfhi(hh.z), bflo(hh.w), bfhi(hh.w));
                }
            }
#pragma unroll
            for (int rr = 0; rr < 8; ++rr) {
                const int row = wid * 32 + rr * 4 + sub; const float rb = stat[row];
                const float4 x0 = *(const float4*)(T + row * TLD + c8), x1 = *(const float4*)(T + row * TLD + c8 + 4);
                float4 h0 = hv0[rr], h1 = hv1[rr];
                h0.x += x0.x * rb; h0.y += x0.y * rb; h0.z += x0.z * rb; h0.w += x0.w * rb;
                h1.x += x1.x * rb; h1.y += x1.y * rb; h1.z += x1.z * rb; h1.w += x1.w * rb;
                *(uint4*)(w.hb1 + (size_t)(m0 + row) * 1024 + n0 + c8) = pack8(h0, h1);
                const float sq = grp_sum16(sq8(h0, h1));
                if ((lane & 15) == 0) w.rssB[(size_t)(m0 + row) * 8 + nt] = sq;
            }
        }
        __syncthreads();
    }
}

__device__ void router_item(const Params& P, int L, int mt, char* lds, const int tid_in, const bool dry) {
    int tid = tid_in; asm volatile("" : "+v"(tid));
    const WS& w = P.w; const nv::Inputs& in = P.in;
    float* T = (float*)lds; float* stat = (float*)(lds + STAT_OFF); int* hist = (int*)(lds + STAT_OFF + 1024);
    const int m0 = mt * 128;
    {
        const bf16_t* arow[2]; const bf16_t* wrow[2];
#pragma unroll
        for (int i = 0; i < 2; ++i) {
            arow[i] = w.hb1 + (size_t)(m0 + (tid >> 2) + 64 * i) * 1024 + gl_chunk(tid) * 8;
            wrow[i] = w.Wrt + L * WR_SZ + (size_t)((tid >> 2) + 64 * i) * 1024 + gl_chunk(tid) * 8;
        }
        f32x16 acc[2][2]; acc_zero(acc);
        float my_rs = 0.f;
        if (tid < 128) my_rs = rstd8(w.rssB + (size_t)(m0 + tid) * 8, 1.f / 1024.f);
        gemm_mainloop_g(acc, arow, wrow, 32, lds, tid);
        if (tid < 128) stat[tid] = my_rs;
        if (tid < 32) hist[tid] = 0;
        acc_to_lds(acc, T, tid);
    }
    int e0 = 0, e1 = 0, r0 = 0, r1 = 0; float w0 = 0.f, w1 = 0.f;
    if (tid < 128) {
        const float rs = stat[tid];
        const float* lr = T + tid * TLD;
        const float* bg = in.router_group_b + L * 4; const float* be = in.router_expert_b + L * 32;
        int gi = 0; float gm = lr[0] * rs + bg[0];
#pragma unroll
        for (int j = 1; j < 4; ++j) { const float v = lr[j] * rs + bg[j]; if (v > gm) { gm = v; gi = j; } }
        float gs = 0.f;
#pragma unroll
        for (int j = 0; j < 4; ++j) gs += __builtin_amdgcn_exp2f(1.4426950408889634f * (lr[j] * rs + bg[j] - gm));
        const float gw = 1.f / gs;
        int i0 = 0, i1 = -1; float v0 = -3.0e38f, v1 = -3.0e38f;
#pragma unroll
        for (int j = 0; j < 8; ++j) {
            const float v = lr[4 + gi * 8 + j] * rs + be[gi * 8 + j];
            if (v > v0) { v1 = v0; i1 = i0; v0 = v; i0 = j; } else if (v > v1) { v1 = v; i1 = j; }
        }
        const float ex = __builtin_amdgcn_exp2f(1.4426950408889634f * (v1 - v0));
        w0 = gw / (1.f + ex); w1 = gw * ex / (1.f + ex);
        e0 = gi * 8 + i0; e1 = gi * 8 + i1;
        r0 = atomicAdd(&hist[e0], 1); r1 = atomicAdd(&hist[e1], 1);
    }
    __syncthreads();
    if (tid < 32) hist[32 + tid] = (hist[tid] && !dry) ? atomicAdd(&w.cnt[L * 64 + tid], hist[tid]) : 0;
    __syncthreads();
    if (tid < 128 && !dry) {
        const int tok = m0 + tid;
        const int p0 = hist[32 + e0] + r0, p1 = hist[32 + e1] + r1;
        w.elist[(size_t)e0 * NT + p0] = tok * 2; w.ewt[(size_t)e0 * NT + p0] = w0;
        w.elist[(size_t)e1 * NT + p1] = tok * 2 + 1; w.ewt[(size_t)e1 * NT + p1] = w1;
    }
    __syncthreads();
}
__device__ void eraw_item(const Params& P, int L, const int mt, const int nt, char* lds, const int tid_in) {
    int tid = tid_in; asm volatile("" : "+v"(tid));
    const WS& w = P.w; const nv::Inputs& in = P.in;
    const int lane = tid & 63, wid = tid >> 6;
    float* T = (float*)lds;
    const int m0 = mt * 128, n0 = nt * 128;
    {
        const float* arow[4]; const bf16_t* wrow[4];
#pragma unroll
        for (int i = 0; i < 4; ++i) {
            arow[i] = in.p + ((size_t)L * NT + m0 + (tid >> 3) + 32 * i) * 256 + (tid & 7) * 8;
            wrow[i] = w.Wpt + L * WP_SZ + (size_t)(n0 + (tid >> 3) + 32 * i) * 256 + (tid & 7) * 8;
        }
        f32x16 acc[2][2]; acc_zero(acc);
        float ss[4] = {0.f, 0.f, 0.f, 0.f};
        gemm_mainloop<float, false>(acc, arow, wrow, 4, lds, ss, tid);
        acc_to_lds(acc, T, tid);
    }
    {
        const int sub = lane >> 4, l16 = lane & 15, c8 = l16 * 8;
#pragma unroll 8
        for (int rr = 0; rr < 8; ++rr) {
            const int row = wid * 32 + rr * 4 + sub;
            const float4 x0 = *(const float4*)(T + row * TLD + c8), x1 = *(const float4*)(T + row * TLD + c8 + 4);
            *(uint4*)(w.erb + (size_t)(m0 + row) * 1024 + n0 + c8) = pack8(x0, x1);
            const float sq = grp_sum16(sq8(x0, x1));
            if (l16 == 0) w.essq[(size_t)(m0 + row) * 8 + nt] = sq;
        }
    }
    __syncthreads();
}
__device__ void phase_router(const Params& P, int L, char* lds, const bool dry = false) {
    const int tid = opaque_tid();
    {
        const int x = blockIdx.x & 7, lb = blockIdx.x >> 3, nlb = gridDim.x >> 3;
        if (lb < 16 || nlb <= 16) { for (int j = lb; j < 16; j += nlb) router_item(P, L, j * 8 + x, lds, tid, dry); }
        if (!dry) {
            if (nlb > 16) { if (lb >= 16) prep_moe_late(P, L, lds, tid, (lb - 16) * 8 + x, (nlb - 16) * 8); }
            else prep_moe_late(P, L, lds, tid, blockIdx.x, gridDim.x);
        }
    }
}

constexpr int TT_OFF = STAT_OFF + 1024;
__device__ __forceinline__ void moe_table(const Params& P, int L, char* lds, const int tid) {
    int* tt = (int*)(lds + TT_OFF);
    if (tid == 0) {
        const int x = blockIdx.x & 7;
        int o = 0, t = 0;
        for (int e = 0; e < 32; ++e) {
            const int c = P.w.cnt[L * 64 + e];
            tt[e] = o; o += c;
            if ((e & 7) == x) { tt[40 + (e >> 3)] = t; t += (c + 127) >> 7; }
        }
        tt[32] = o; tt[44] = t;
    }
    __syncthreads();
}
__device__ __forceinline__ void moe_find(const int* tt, int tile, int& e, int& t) {
    int k = 0;
    if (tile >= tt[41]) k = 1;
    if (tile >= tt[42]) k = 2;
    if (tile >= tt[43]) k = 3;
    e = (blockIdx.x & 7) + 8 * k; t = tile - tt[40 + k];
}
__device__ void phase_moe_up(const Params& P, int L, char* lds, const bool noeraw = false) {
    const WS& w = P.w;
    const int tid0 = opaque_tid();
    float* T = (float*)lds; float* stat = (float*)(lds + STAT_OFF); const int* tt = (const int*)(lds + TT_OFF);
    moe_table(P, L, lds, tid0);
    const int ntiles = tt[44];
    for (int item = blockIdx.x >> 3; item < ntiles * 4; item += (gridDim.x >> 3)) {
        int tid = tid0; asm volatile("" : "+v"(tid));
        const int lane = tid & 63, wid = tid >> 6;
        const int tile = item >> 2, nt = item & 3;
        int e, t; moe_find(tt, tile, e, t);
        const int cnt = P.w.cnt[L * 64 + e], rbase = tt[e] + t * 128, nrows = min(128, cnt - t * 128);
        {
            const bf16_t* arow[2]; const bf16_t* wrow[2];
#pragma unroll
            for (int i = 0; i < 2; ++i) {
                const int r = (tid >> 2) + 64 * i;
                const int ent = w.elist[(size_t)e * NT + t * 128 + (r < nrows ? r : 0)];
                arow[i] = w.hb1 + (size_t)(ent >> 1) * 1024 + gl_chunk(tid) * 8;
                wrow[i] = w.Wgut + L * WGU_SZ + ((size_t)e * 512 + nt * 128 + r) * 1024 + gl_chunk(tid) * 8;
            }
            f32x16 acc[2][2]; acc_zero(acc);
            float my_rs = 0.f;
            if (tid < 128) {
                const int ent = w.elist[(size_t)e * NT + t * 128 + (tid < nrows ? tid : 0)];
                my_rs = rstd8(w.rssB + (size_t)(ent >> 1) * 8, 1.f / 1024.f);
            }
            gemm_mainloop_g(acc, arow, wrow, 32, lds, tid);
            if (tid < 128) stat[tid] = my_rs;
            acc_to_lds(acc, T, tid);
        }
        {
            const int sub = lane >> 4, l16 = lane & 15, c8 = l16 * 8;
#pragma unroll 8
            for (int rr = 0; rr < 8; ++rr) {
                const int row = wid * 32 + rr * 4 + sub; const float rs = stat[row];
                const float4 x0 = mul4(*(const float4*)(T + row * TLD + c8), rs), x1 = mul4(*(const float4*)(T + row * TLD + c8 + 4), rs);
                if (row < nrows)
                    store4(w.hbuf + (size_t)(rbase + row) * 256 + nt * 64 + l16 * 4, x0.x * sigmoid_(x0.x) * x0.y, x0.z * sigmoid_(x0.z) * x0.w,
                           x1.x * sigmoid_(x1.x) * x1.y, x1.z * sigmoid_(x1.z) * x1.w);
            }
        }
        __syncthreads();
    }
    if (!noeraw) {
        int* qslot = (int*)(lds + TT_OFF + 256);
        for (;;) {
            if (tid0 == 0) *qslot = atomicAdd(&P.w.cnt[L * 64 + 32], 1);
            __syncthreads();
            const int item = *qslot;
            __syncthreads();
            if (item >= 1024) break;
            eraw_item(P, L, item >> 3, item & 7, lds, tid0);
        }
    }
}
__device__ void phase_moe_down(const Params& P, int L, char* lds) {
    const WS& w = P.w;
    const int tid0 = opaque_tid();
    float* T = (float*)lds; float* stat = (float*)(lds + STAT_OFF); const int* tt = (const int*)(lds + TT_OFF);
    moe_table(P, L, lds, tid0);
    const int ntiles = tt[44];
    for (int item = blockIdx.x >> 3; item < ntiles * 8; item += (gridDim.x >> 3)) {
        int tid = tid0; asm volatile("" : "+v"(tid));
        const int lane = tid & 63, wid = tid >> 6;
        const int tile = item >> 3, nt = item & 7;
        int e, t; moe_find(tt, tile, e, t);
        const int cnt = P.w.cnt[L * 64 + e], rbase = tt[e] + t * 128, nrows = min(128, cnt - t * 128);
        {
            const bf16_t* arow[2]; const bf16_t* wrow[2];
#pragma unroll
            for (int i = 0; i < 2; ++i) {
                const int r = (tid >> 2) + 64 * i;
                arow[i] = w.hbuf + (size_t)(rbase + (r < nrows ? r : 0)) * 256 + gl_chunk(tid) * 8;
                wrow[i] = w.Wdt + L * WD_SZ + ((size_t)e * 1024 + nt * 128 + r) * 256 + gl_chunk(tid) * 8;
            }
            f32x16 acc[2][2]; acc_zero(acc);
            int my_ent = 0; float my_wt = 0.f;
            if (tid < 128) { const int rr2 = tid < nrows ? tid : 0; my_ent = w.elist[(size_t)e * NT + t * 128 + rr2]; my_wt = w.ewt[(size_t)e * NT + t * 128 + rr2]; }
            gemm_mainloop_g(acc, arow, wrow, 8, lds, tid);
            if (tid < 128) { ((int*)stat)[tid] = my_ent; stat[128 + tid] = my_wt; }
            acc_to_lds(acc, T, tid);
        }
        {
            const int sub = lane >> 4, l16 = lane & 15, c8 = l16 * 8;
#pragma unroll 8
            for (int rr = 0; rr < 8; ++rr) {
                const int row = wid * 32 + rr * 4 + sub;
                const int ent = ((const int*)stat)[row]; const float wt = stat[128 + row];
                const float4 x0 = mul4(*(const float4*)(T + row * TLD + c8), wt), x1 = mul4(*(const float4*)(T + row * TLD + c8 + 4), wt);
                if (row < nrows) *(uint4*)(w.contrib + (size_t)ent * 1024 + nt * 128 + c8) = pack8(x0, x1);
            }
        }
        __syncthreads();
    }
}

__device__ void phase_combine(const Params& P, int L, char* lds, const bool dry = false) {
    const WS& w = P.w;
    const int tid = opaque_tid(), lane = tid & 63;
    for (size_t tok = (size_t)blockIdx.x * 4 + (tid >> 6); tok < NT; tok += (size_t)gridDim.x * 4) {
        float ss = 0.f;
        uint4 ca[2], cb[2], hh[2];
#pragma unroll
        for (int j = 0; j < 2; ++j) {
            const size_t c8 = (size_t)(j * 64 + lane) * 8;
            ca[j] = *(const uint4*)(w.contrib + (tok * 2) * 1024 + c8); cb[j] = *(const uint4*)(w.contrib + (tok * 2 + 1) * 1024 + c8);
            hh[j] = *(const uint4*)(w.hb1 + tok * 1024 + c8);
        }
#pragma unroll
        for (int j = 0; j < 2; ++j) {
            const size_t c8 = (size_t)(j * 64 + lane) * 8;
            const uint4 a = ca[j], b = cb[j], h = hh[j];
            float4 h0, h1;
            h0.x = bflo(h.x) + bflo(a.x) + bflo(b.x); h0.y = bfhi(h.x) + bfhi(a.x) + bfhi(b.x); h0.z = bflo(h.y) + bflo(a.y) + bflo(b.y); h0.w = bfhi(h.y) + bfhi(a.y) + bfhi(b.y);
            h1.x = bflo(h.z) + bflo(a.z) + bflo(b.z); h1.y = bfhi(h.z) + bfhi(a.z) + bfhi(b.z); h1.z = bflo(h.w) + bflo(a.w) + bflo(b.w); h1.w = bfhi(h.w) + bfhi(a.w) + bfhi(b.w);
            if (!dry) *(uint4*)(w.hb1 + tok * 1024 + c8) = pack8(h0, h1);
            ss += sq8(h0, h1);
        }
        ss = wave_sum64(ss);
        if (lane < 8) w.rssB[tok * 8 + lane] = lane == 0 ? ss : 0.f;
    }
}

__device__ void phase_ple(const Params& P, int L, char* lds, const bool dry = false) {
    const WS& w = P.w; const nv::Inputs& in = P.in;
    const int tid0 = opaque_tid();
    float* T = (float*)lds; float* stat = (float*)(lds + STAT_OFF);
    int mt, nt;
    for (int it = 0; xcd_item(it, 128, 8, mt, nt); ++it) {
        int tid = tid0; asm volatile("" : "+v"(tid));
        const int lane = tid & 63, wid = tid >> 6;
        const int m0 = mt * 128, n0 = nt * 128;
        {
            const bf16_t* arow[2]; const bf16_t* wrow[2];
#pragma unroll
            for (int i = 0; i < 2; ++i) {
                arow[i] = w.hb1 + (size_t)(m0 + (tid >> 2) + 64 * i) * 1024 + gl_chunk(tid) * 8;
                wrow[i] = w.Wgt + L * WG_SZ + (size_t)(n0 + (tid >> 2) + 64 * i) * 1024 + gl_chunk(tid) * 8;
            }
            f32x16 acc[2][2]; acc_zero(acc);
            float my_rs = 0.f, my_re = 0.f;
            if (tid < 128) { my_rs = rstd8(w.rssB + (size_t)(m0 + tid) * 8, 1.f / 1024.f); my_re = rstd8(w.essq + (size_t)(m0 + tid) * 8, 1.f / 1024.f); }
            gemm_mainloop_g(acc, arow, wrow, 32, lds, tid);
            if (tid < 128) { stat[tid] = my_rs; stat[128 + tid] = my_re; }
            acc_to_lds(acc, T, tid);
        }
        {
            const int sub = lane >> 4, l16 = lane & 15, c8 = l16 * 8;
            const float4 pg0 = *(const float4*)(in.ple_post_norm_g + L * 1024 + n0 + c8), pg1 = *(const float4*)(in.ple_post_norm_g + L * 1024 + n0 + c8 + 4);
            uint4 hhv[8], erv[8];
#pragma unroll
            for (int rr = 0; rr < 8; ++rr) {
                const size_t off = (size_t)(m0 + wid * 32 + rr * 4 + sub) * 1024 + n0 + c8;
                hhv[rr] = *(const uint4*)(w.hb1 + off); erv[rr] = *(const uint4*)(w.erb + off);
            }
#pragma unroll
            for (int rr = 0; rr < 8; ++rr) {
                const int row = wid * 32 + rr * 4 + sub; const float rs = stat[row], re = stat[128 + row]; const size_t tok = m0 + row;
                const float4 x0 = mul4(*(const float4*)(T + row * TLD + c8), rs), x1 = mul4(*(const float4*)(T + row * TLD + c8 + 4), rs);
                const size_t off = tok * 1024 + n0 + c8;
                const uint4 er = erv[rr], hh = hhv[rr];
                float4 h0, h1;
                h0.x = bflo(hh.x) + sigmoid_(x0.x) * (bflo(er.x) * re * pg0.x); h0.y = bfhi(hh.x) + sigmoid_(x0.y) * (bfhi(er.x) * re * pg0.y);
                h0.z = bflo(hh.y) + sigmoid_(x0.z) * (bflo(er.y) * re * pg0.z); h0.w = bfhi(hh.y) + sigmoid_(x0.w) * (bfhi(er.y) * re * pg0.w);
                h1.x = bflo(hh.z) + sigmoid_(x1.x) * (bflo(er.z) * re * pg1.x); h1.y = bfhi(hh.z) + sigmoid_(x1.y) * (bfhi(er.z) * re * pg1.y);
                h1.z = bflo(hh.w) + sigmoid_(x1.z) * (bflo(er.w) * re * pg1.z); h1.w = bfhi(hh.w) + sigmoid_(x1.w) * (bfhi(er.w) * re * pg1.w);
                if (L == 1) { float4* op = (float4*)(P.h + off); op[0] = h0; op[1] = h1; }
                else {
                    *(uint4*)(w.hb + off) = pack8(h0, h1);
                    const float sq = grp_sum16(sq8(h0, h1));
                    if (l16 == 0) w.rssA[tok * 8 + nt] = sq;
                }
            }
        }
        __syncthreads();
    }
}

}
namespace fx {
#define XB_TMO      128
#define XB_XCNT(j)  (256  + 64 * (j))
#define XB_XSUB(j)  (1280 + 64 * (j))
#define XB_XGEN(j)  (2304 + 64 * (j))
#define XB_TOP      3328
#define XB_TOPGEN   3392
#define XCD_BAR_WORDS 3456
#define XB_SPIN_CAP (1u << 18)
#define LAS __attribute__((address_space(3)))
__device__ __forceinline__ unsigned xb_ld(unsigned* p)              { return __hip_atomic_load(p, __ATOMIC_RELAXED, __HIP_MEMORY_SCOPE_AGENT); }
__device__ __forceinline__ unsigned xb_add(unsigned* p, unsigned v) { return __hip_atomic_fetch_add(p, v, __ATOMIC_RELAXED, __HIP_MEMORY_SCOPE_AGENT); }
__device__ __forceinline__ unsigned xb_xcc_id() { return (unsigned)__builtin_amdgcn_s_getreg((3 << 11) | 20) & 0xFu; }
#define XB_SPIN(cond, bar) do { unsigned _sp = 0; while (cond) { __builtin_amdgcn_s_sleep(1); \
    if ((++_sp & 255u) == 0u) { if (xb_ld(&(bar)[XB_TMO])) break; if (_sp > XB_SPIN_CAP) { atomicAdd(&(bar)[XB_TMO], 1u); break; } } } } while (0)
struct XcdBarrier { unsigned* bar; unsigned x; volatile LAS unsigned* st; };
__device__ __forceinline__ XcdBarrier xcd_barrier_post(unsigned* bar, volatile LAS unsigned* st) {
    XcdBarrier b; b.bar = bar; b.x = xb_xcc_id(); b.st = st;
    if (threadIdx.x == 0) (void)xb_add(&bar[XB_XCNT(b.x)], 1u);
    return b;
}
__device__ __forceinline__ void xcd_barrier_complete(unsigned* bar, unsigned x, unsigned& nloc, unsigned& nx) {
    const unsigned G = gridDim.x * gridDim.y * gridDim.z;
    unsigned sum, cnt, mine, sp = 0u;
    for (;;) {
        sum = 0u; cnt = 0u; mine = 0u;
#pragma unroll
        for (unsigned j = 0; j < 16; ++j) { const unsigned c = xb_ld(&bar[XB_XCNT(j)]); sum += c; cnt += (c > 0u) ? 1u : 0u; mine = (j == x) ? c : mine; }
        if (sum == G) break;
        __builtin_amdgcn_s_sleep(1);
        if ((++sp & 255u) == 0u) { if (xb_ld(&bar[XB_TMO])) break; if (sp > XB_SPIN_CAP) { atomicAdd(&bar[XB_TMO], 1u); break; } }
    }
    nloc = mine > 0u ? mine : 1u; nx = cnt > 0u ? cnt : 1u;
}
__device__ __forceinline__ void xcd_barrier(const XcdBarrier& b) {
    asm volatile("s_waitcnt vmcnt(0)" ::: "memory");
    __syncthreads();
    if (threadIdx.x == 0) {
        unsigned* bar = b.bar;
        __builtin_amdgcn_s_waitcnt(0);
        unsigned nloc = b.st[0], nx = b.st[1];
        if (nloc == 0u) { xcd_barrier_complete(bar, b.x, nloc, nx); b.st[0] = nloc; b.st[1] = nx; }
        const unsigned old = xb_add(&bar[XB_XSUB(b.x)], 1u);
        const unsigned gen = old / nloc;
        if (old + 1u == (gen + 1u) * nloc) {
            __builtin_amdgcn_fence(__ATOMIC_RELEASE, "agent");
            asm volatile("s_waitcnt vmcnt(0)" ::: "memory");
            const unsigned og = xb_add(&bar[XB_TOP], 1u);
            const unsigned tg = og / nx;
            if (og + 1u == (tg + 1u) * nx) xb_add(&bar[XB_TOPGEN], 1u);
            else XB_SPIN(xb_ld(&bar[XB_TOPGEN]) == tg, bar);
            __builtin_amdgcn_fence(__ATOMIC_ACQUIRE, "agent");
            xb_add(&bar[XB_XGEN(b.x)], 1u);
            asm volatile("s_waitcnt vmcnt(0)" ::: "memory");
        } else {
            XB_SPIN(xb_ld(&bar[XB_XGEN(b.x)]) == gen, bar);
            __builtin_amdgcn_fence(__ATOMIC_ACQUIRE, "agent");
            asm volatile("s_waitcnt vmcnt(0)" ::: "memory");
        }
    }
    __syncthreads();
}

constexpr int LDS_BYTES = LDS_GEMM_BYTES + 16;
constexpr int N_PHASES = 19;
constexpr int PPL = 9;
__global__ void __launch_bounds__(256, 2) k_run(Params P, int ph_lo, int ph_hi) {
    extern __shared__ __attribute__((aligned(16))) char lds[];
    volatile LAS unsigned* st = (volatile LAS unsigned*)(lds + LDS_GEMM_BYTES);
    if (threadIdx.x == 0) { st[0] = 0u; st[1] = 0u; }
    __syncthreads();
    XcdBarrier xb = xcd_barrier_post(P.w.bar, st);
    for (int ph = ph_lo; ph < ph_hi; ++ph) {
        if (ph > ph_lo) xcd_barrier(xb);
        int reps = 1;
#ifdef REP_PHASE
        if (ph == 0 ? (REP_PHASE == 0) : (((ph - 1) % PPL) == REP_PHASE - 1)) reps = 2;
        asm volatile("" : "+s"(reps));
#endif
        for (int rep = 0; rep < reps; ++rep) {
            const bool dry = rep + 1 < reps;
            if (rep > 0) xcd_barrier(xb);
            if (ph == 0) phase_prep(P, lds);
            else {
                const int L = (ph - 1) / PPL, s = (ph - 1) % PPL;
                switch (s) {
                    case 0: phase_zgemm(P, L, lds); break;
                    case 1: phase_mix(P, L, lds, rep, dry); break;
                    case 2: phase_attn(P, L, lds); break;
                    case 3: phase_oproj(P, L, lds, dry); break;
                    case 4: phase_router(P, L, lds, dry); break;
                    case 5: phase_moe_up(P, L, lds, dry); break;
                    case 6: phase_moe_down(P, L, lds); break;
                    case 7: phase_combine(P, L, lds, dry); break;
                    case 8: phase_ple(P, L, lds, dry); break;
                }
            }
        }
    }
}
}
#ifndef MK_N_LAUNCHES
#define MK_N_LAUNCHES 1
#endif
extern "C" void kernel_launch(void* const* d_in, const int* in_sizes, int n_in, void* d_out, int out_size, void* d_ws, size_t ws_size,
                              hipStream_t stream) {
    nv::Inputs in{};
    in.x = (const float*)d_in[0]; in.p = (const float*)d_in[1]; in.positions = (const int*)d_in[2];
    const float** f = &in.mix_norm_g;
    for (int i = 0; i < 32; ++i) f[i] = (const float*)d_in[3 + i];
    size_t used = 0;
    fx::WS w = fx::make_ws((char*)d_ws, used);
    static int grid = 0;
    if (grid == 0) {
        if (n_in != 35 || out_size != fx::NT * 1024 || used > ws_size) { fprintf(stderr, "kernel_launch: unexpected shapes / workspace (need %zu, have %zu)\n", used, ws_size); grid = -1; return; }
        if (hipFuncSetAttribute((const void*)fx::k_run, hipFuncAttributeMaxDynamicSharedMemorySize, fx::LDS_BYTES) != hipSuccess) { fprintf(stderr, "hipFuncSetAttribute failed\n"); grid = -1; return; }
        int dev = 0, cus = 0, per_cu = 0;
        hipGetDevice(&dev); hipDeviceGetAttribute(&cus, hipDeviceAttributeMultiprocessorCount, dev);
        hipOccupancyMaxActiveBlocksPerMultiprocessor(&per_cu, (const void*)fx::k_run, 256, fx::LDS_BYTES);
        if (per_cu > 2) per_cu = 2;
        if (per_cu < 1) { fprintf(stderr, "occupancy query says %d blocks/CU\n", per_cu); grid = -1; return; }
        grid = cus * per_cu;
    }
    if (grid < 0) return;
    fx::Params P{}; P.in = in; P.h = (float*)d_out; P.w = w;
    hipMemsetAsync(w.cnt, 0, 128 * 4, stream);
    hipMemsetAsync(w.bar, 0, XCD_BAR_WORDS * 4, stream);
    if (MK_N_LAUNCHES == 1) hipLaunchKernelGGL(fx::k_run, dim3(grid), dim3(256), fx::LDS_BYTES, stream, P, 0, fx::N_PHASES);
    else for (int ph = 0; ph < fx::N_PHASES; ++ph) hipLaunchKernelGGL(fx::k_run, dim3(grid), dim3(256), fx::LDS_BYTES, stream, P, ph, ph + 1);
}
```

```cpp
#include <hip/hip_runtime.h>
#include <hip/hip_bf16.h>
#include <stdint.h>
#include <cstdio>
namespace nv {
struct Inputs {
    const float *x, *p; const int* positions;
    const float *mix_norm_g, *w_in, *sgu_ln_g, *sgu_ln_b, *sgu_w, *sgu_b, *conv_w, *conv_b, *conv_ln_g, *conv_ln_b, *conv_pw_w, *conv_pw_b,
        *q_a_norm_g, *w_uq, *kv_a_norm_g, *w_ukv, *q_norm_g, *k_norm_g, *branch_norm_g, *w_o, *ffn_norm_g, *router_group_w, *router_group_b,
        *router_expert_w, *router_expert_b, *moe_w_gate, *moe_w_up, *moe_w_down, *ple_norm_g, *ple_gate_w, *ple_proj_w, *ple_post_norm_g;
};
}
namespace fx {

typedef unsigned short bf16_t;
typedef short bf16x8 __attribute__((ext_vector_type(8)));
typedef float f32x16 __attribute__((ext_vector_type(16)));
typedef float f32x4 __attribute__((ext_vector_type(4)));

constexpr int NT = 16384, SEQ = 2048, DM = 1024, NB = 8;
constexpr int ZN = 1536;
constexpr float EPS = 1e-6f;

typedef __bf16 bf16v2_t __attribute__((ext_vector_type(2)));
typedef float f32v2_t __attribute__((ext_vector_type(2)));
__device__ __forceinline__ unsigned pack2(float lo, float hi) {
    f32v2_t v; v.x = lo; v.y = hi;
    bf16v2_t b = __builtin_convertvector(v, bf16v2_t);
    return __builtin_bit_cast(unsigned, b);
}
__device__ __forceinline__ unsigned f2bf(float f) { return pack2(f, 0.f) & 0xffffu; }
__device__ __forceinline__ float bf2f(unsigned short b) { return __uint_as_float(((unsigned)b) << 16); }
__device__ __forceinline__ float bflo(unsigned u) { return __uint_as_float(u << 16); }
__device__ __forceinline__ float bfhi(unsigned u) { return __uint_as_float(u & 0xffff0000u); }
__device__ __forceinline__ float sigmoid_(float x) { return __builtin_amdgcn_rcpf(1.f + __builtin_amdgcn_exp2f(-1.4426950408889634f * x)); }
__device__ __forceinline__ float rsq_(float x) { return __builtin_amdgcn_rsqf(x); }
__device__ __forceinline__ float gelu_tanh_(float x) {
    float u = 0.7978845608028654f * (x + 0.044715f * x * x * x);
    return x * sigmoid_(2.f * u);
}
__device__ __forceinline__ int opaque_tid() { int t = threadIdx.x; asm volatile("" : "+v"(t)); return t; }
template <int CTRL> __device__ __forceinline__ float dpp_mov(float v) {
    return __builtin_bit_cast(float, __builtin_amdgcn_update_dpp(0, __builtin_bit_cast(int, v), CTRL, 0xf, 0xf, false));
}
__device__ __forceinline__ void swap16(float& a, float& b) { asm volatile("s_nop 1\n\tv_permlane16_swap_b32 %0, %1" : "+v"(a), "+v"(b)); }
__device__ __forceinline__ void swap32(float& a, float& b) { asm volatile("s_nop 1\n\tv_permlane32_swap_b32 %0, %1" : "+v"(a), "+v"(b)); }
__device__ __forceinline__ float swap16_sum(float v) { float a = v, b = v; swap16(a, b); return a + b; }
__device__ __forceinline__ float swap32_sum(float v) { float a = v, b = v; swap32(a, b); return a + b; }
__device__ __forceinline__ float swap32_max(float v) { float a = v, b = v; swap32(a, b); return fmaxf(a, b); }
__device__ __forceinline__ float grp_sum16(float v) { v += dpp_mov<0xB1>(v); v += dpp_mov<0x4E>(v); v += dpp_mov<0x124>(v); v += dpp_mov<0x128>(v); return v; }
__device__ __forceinline__ float grp_sum32(float v) { return swap16_sum(grp_sum16(v)); }
__device__ __forceinline__ float wave_sum64(float v) { return swap32_sum(grp_sum32(v)); }
__device__ __forceinline__ float grp_sum4(float v) { v += dpp_mov<0xB1>(v); v += dpp_mov<0x4E>(v); return v; }
__device__ __forceinline__ float grp_sum8(float v) { v = grp_sum4(v); v += dpp_mov<0x141>(v); return v; }
__device__ __forceinline__ float quad_x2(float v) { return dpp_mov<0x4E>(v); }
__device__ __forceinline__ float xor8(float v) { return dpp_mov<0x128>(v); }
__device__ __forceinline__ float xor32(float v) { return swap32_sum(v); }

struct WS {
    bf16_t *W1t, *Wuqt, *Wukvt, *Wpwt, *Wot, *Wrt, *Wgut, *Wdt, *Wgt, *Wpt, *Wsm;
    bf16_t *hb;
    bf16_t *hb1;
    bf16_t *ub;
    bf16_t *vT;
    bf16_t *ygb;
    bf16_t *cqb;
    bf16_t *ckvb;
    bf16_t *kpeb;
    bf16_t *Qb;
    bf16_t *Knb;
    bf16_t *VTb;
    bf16_t *yb;
    float  *ssq;
    float  *rssA;
    float  *rssB;
    float  *cqss;
    float  *cs;
    bf16_t *erb;
    float  *essq;
    bf16_t *hbuf;
    int    *cnt;
    int    *elist;
    float  *ewt;
    unsigned *bar;
};
constexpr size_t W1_SZ = (size_t)ZN * 1024, WUQ_SZ = 768 * 256, WUKV_SZ = 1024 * 128, WPW_SZ = 256 * 256, WO_SZ = 1024 * 1024, WR_SZ = 128 * 1024,
                 WGU_SZ = (size_t)32 * 512 * 1024, WD_SZ = (size_t)32 * 1024 * 256, WG_SZ = 1024 * 1024, WP_SZ = 1024 * 256, WSM_SZ = 4 * 128 * 128;

struct Params {
    nv::Inputs in;
    float* h;
    WS w;
    float* zf;
    float* yf;
};

static WS make_ws(char* base, size_t& used) {
    WS w{}; size_t o = 0;
    auto take = [&](size_t bytes) { char* p = base + o; o += (bytes + 255) & ~(size_t)255; return p; };
    w.W1t = (bf16_t*)take(2 * W1_SZ * 2);   w.Wuqt = (bf16_t*)take(2 * WUQ_SZ * 2); w.Wukvt = (bf16_t*)take(2 * WUKV_SZ * 2);
    w.Wpwt = (bf16_t*)take(2 * WPW_SZ * 2); w.Wot = (bf16_t*)take(2 * WO_SZ * 2);   w.Wrt = (bf16_t*)take(2 * WR_SZ * 2);
    w.Wgut = (bf16_t*)take(2 * WGU_SZ * 2); w.Wdt = (bf16_t*)take(2 * WD_SZ * 2);   w.Wgt = (bf16_t*)take(2 * WG_SZ * 2);
    w.Wpt = (bf16_t*)take(2 * WP_SZ * 2);   w.Wsm = (bf16_t*)take(2 * WSM_SZ * 2);
    w.hb = (bf16_t*)take((size_t)NT * 1024 * 2); w.hb1 = (bf16_t*)take((size_t)NT * 1024 * 2);
    w.ssq = (float*)take((size_t)NT * 16 * 4); w.cs = (float*)take((size_t)NT * 32 * 4);
    w.rssA = (float*)take((size_t)NT * 8 * 4); w.rssB = (float*)take((size_t)NT * 8 * 4); w.cqss = (float*)take((size_t)NT * 4 * 4);
    w.essq = (float*)take((size_t)NT * 8 * 4);
    w.cnt = (int*)take(2 * 256 * 4);
    w.elist = (int*)take((size_t)64 * NT * 4); w.ewt = (float*)take((size_t)64 * NT * 4);
    w.bar = (unsigned*)take(4096 * 4);
    const size_t region = o;
    w.ub = (bf16_t*)take((size_t)NT * 256 * 2); w.vT = (bf16_t*)take((size_t)NT * 256 * 2); w.ygb = (bf16_t*)take((size_t)NT * 256 * 2);
    w.cqb = (bf16_t*)take((size_t)NT * 256 * 2); w.ckvb = (bf16_t*)take((size_t)NT * 128 * 2); w.kpeb = (bf16_t*)take((size_t)NT * 32 * 2);
    w.Qb = (bf16_t*)take((size_t)NT * 768 * 2); w.Knb = (bf16_t*)take((size_t)NT * 512 * 2); w.VTb = (bf16_t*)take((size_t)NT * 512 * 2);
    w.yb = (bf16_t*)take((size_t)NT * 1024 * 2);
    const size_t region_end = o;
    o = region;
    w.hbuf = (bf16_t*)take((size_t)(2 * NT + 128) * 256 * 2);
    w.erb = (bf16_t*)take((size_t)NT * 1024 * 2);
    if (o > region_end) { fprintf(stderr, "make_ws: overlay exceeds mixer region\n"); }
    o = region_end;
    used = o;
    return w;
}

__device__ const double ROPE_INV[16] = {1.0, 0.5623413251903491, 0.31622776601683794, 0.1778279410038923, 0.1, 0.05623413251903491, 0.03162277660168379, 0.01778279410038923, 0.01, 0.005623413251903491, 0.0031622776601683794, 0.0017782794100389228, 0.001, 0.0005623413251903491, 0.00031622776601683794, 0.00017782794100389227};
__device__ __forceinline__ void rope_cs(int pos, int j, float& c, float& s) {
    const double ang = (double)pos * ROPE_INV[j];
    const double n = rint(ang * 0.15915494309189535);
    double r = fma(-n, 6.283185307179586, ang); r = fma(-n, 2.4492935982947064e-16, r);
    const double r2 = r * r;
    double sc = 1.0, ss = 1.0;
    double tc = 1.0, ts = 1.0;
#pragma unroll
    for (int k = 1; k <= 14; ++k) {
        tc *= -r2 / (double)((2 * k - 1) * (2 * k)); sc += tc;
        ts *= -r2 / (double)((2 * k) * (2 * k + 1)); ss += ts;
    }
    c = (float)sc; s = (float)(ss * r);
}

enum { MAP_ID = 0, MAP_W1 = 1, MAP_UQ = 2, MAP_UKV = 3, MAP_GATE = 4, MAP_UP = 5 };
template <int MAP> __device__ __forceinline__ int dstrow(int c) {
    if (MAP == MAP_W1) {
        if (c < 512) return c;
        if (c < 768) return 512 + 2 * (c - 512);
        if (c < 1024) return 513 + 2 * (c - 768);
        return c;
    } else if (MAP == MAP_UQ) {
        const int h = c / 96, d = c - h * 96; return d < 64 ? h * 64 + d : 512 + h * 32 + d - 64;
    } else if (MAP == MAP_UKV) {
        const int h = c >> 7, d = c & 127; return d < 64 ? h * 64 + d : 512 + h * 64 + d - 64;
    } else if (MAP == MAP_GATE) return 2 * c;
    else if (MAP == MAP_UP) return 2 * c + 1;
    return c;
}
#define PREP_LOAD(V0, V1, V2, V3, SRC, K0, C0) do { \
    const int kk_ = tid >> 4, c4_ = (tid & 15) * 4; \
    const float* p_ = (C0) + c4_ < Nsrc ? (SRC) + (size_t)((K0) + kk_) * ld + (C0) + c4_ : (SRC) + (size_t)((K0) + kk_) * ld; \
    V0 = *(const float4*)p_; V1 = *(const float4*)(p_ + (size_t)16 * ld); V2 = *(const float4*)(p_ + (size_t)32 * ld); V3 = *(const float4*)(p_ + (size_t)48 * ld); } while (0)
__device__ __forceinline__ void prep_put(float* tile, int kk, int c4, const float4& v, float sc) {
    float* t = tile + kk * 65 + c4; t[0] = v.x * sc; t[1] = v.y * sc; t[2] = v.z * sc; t[3] = v.w * sc;
}
template <int MAP>
__device__ void prep_job(const float* src, int ld, int Nsrc, size_t src_stride, const float* scale, bf16_t* dst, size_t dst_stride, int K, int nbatch, float* tiles, int& rot, const int tid, const int bi, const int G) {
    const int tn = (Nsrc + 63) / 64, tk = K / 64, per = tn * tk, total = per * nbatch;
    int t = (bi - rot + G) % G, buf = 0;
    float4 a0 = make_float4(0.f, 0.f, 0.f, 0.f), a1 = a0, a2 = a0, a3 = a0, b0 = a0, b1 = a0, b2 = a0, b3 = a0;
    if (t < total) { const int e = t / per, tt = t % per; PREP_LOAD(a0, a1, a2, a3, src + (size_t)e * src_stride, (tt / tn) * 64, (tt % tn) * 64); }
    for (; t < total; t += G) {
        const int e = t / per, tt = t % per, k0 = (tt / tn) * 64, c0 = (tt % tn) * 64;
        const int t2 = t + G;
        if (t2 < total) { const int e2 = t2 / per, tt2 = t2 % per; PREP_LOAD(b0, b1, b2, b3, src + (size_t)e2 * src_stride, (tt2 / tn) * 64, (tt2 % tn) * 64); }
        float* tile = tiles + buf * (64 * 65);
        {
            const int kk = tid >> 4, c4 = (tid & 15) * 4;
            const float s0 = scale ? scale[k0 + kk] : 1.f, s1 = scale ? scale[k0 + kk + 16] : 1.f, s2 = scale ? scale[k0 + kk + 32] : 1.f, s3 = scale ? scale[k0 + kk + 48] : 1.f;
            prep_put(tile, kk, c4, a0, s0); prep_put(tile, kk + 16, c4, a1, s1); prep_put(tile, kk + 32, c4, a2, s2); prep_put(tile, kk + 48, c4, a3, s3);
        }
        __syncthreads();
        bf16_t* d = dst + (size_t)e * dst_stride;
#pragma unroll
        for (int i = 0; i < 2; ++i) {
            const int idx = tid + 256 * i, c = idx >> 3, kc = idx & 7;
            if (c0 + c < Nsrc) {
                const float* q = tile + (kc * 8) * 65 + c;
                uint4 pk;
                pk.x = pack2(q[0], q[65]); pk.y = pack2(q[130], q[195]); pk.z = pack2(q[260], q[325]); pk.w = pack2(q[390], q[455]);
                *(uint4*)(d + (size_t)dstrow<MAP>(c0 + c) * K + k0 + kc * 8) = pk;
            }
        }
        a0 = b0; a1 = b1; a2 = b2; a3 = b3; buf ^= 1;
    }
    __syncthreads();
    rot = (rot + total) % G;
}

__device__ void phase_prep(const Params& P, char* lds) {
    float* tile = (float*)lds;
    const nv::Inputs& in = P.in; const WS& w = P.w;
    const int G = gridDim.x, bid = blockIdx.x, tid = opaque_tid();
    int rot = 0;
    for (int L = 0; L < 2; ++L) {
        if (L == 0) {
        prep_job<MAP_GATE>(in.moe_w_gate + (size_t)L * 32 * 1024 * 256, 256, 256, (size_t)1024 * 256, in.ffn_norm_g + L * 1024, w.Wgut + L * WGU_SZ, (size_t)512 * 1024, 1024, 32, tile, rot, tid, bid, G);
        prep_job<MAP_UP>(in.moe_w_up + (size_t)L * 32 * 1024 * 256, 256, 256, (size_t)1024 * 256, in.ffn_norm_g + L * 1024, w.Wgut + L * WGU_SZ, (size_t)512 * 1024, 1024, 32, tile, rot, tid, bid, G);
        prep_job<MAP_ID>(in.moe_w_down + (size_t)L * 32 * 256 * 1024, 1024, 1024, (size_t)256 * 1024, nullptr, w.Wdt + L * WD_SZ, (size_t)1024 * 256, 256, 32, tile, rot, tid, bid, G);
        }
        prep_job<MAP_W1>(in.w_in + (size_t)L * 1024 * 1440, 1440, 1440, 0, in.mix_norm_g + L * 1024, w.W1t + L * W1_SZ, 0, 1024, 1, tile, rot, tid, bid, G);
        prep_job<MAP_UQ>(in.w_uq + (size_t)L * 256 * 768, 768, 768, 0, in.q_a_norm_g + L * 256, w.Wuqt + L * WUQ_SZ, 0, 256, 1, tile, rot, tid, bid, G);
        prep_job<MAP_UKV>(in.w_ukv + (size_t)L * 128 * 1024, 1024, 1024, 0, in.kv_a_norm_g + L * 128, w.Wukvt + L * WUKV_SZ, 0, 128, 1, tile, rot, tid, bid, G);
        prep_job<MAP_ID>(in.conv_pw_w + (size_t)L * 256 * 256, 256, 256, 0, nullptr, w.Wpwt + L * WPW_SZ, 0, 256, 1, tile, rot, tid, bid, G);
        prep_job<MAP_ID>(in.w_o + (size_t)L * 1024 * 1024, 1024, 1024, 0, in.branch_norm_g + L * 1024, w.Wot + L * WO_SZ, 0, 1024, 1, tile, rot, tid, bid, G);
        prep_job<MAP_ID>(in.ple_gate_w + (size_t)L * 1024 * 1024, 1024, 1024, 0, in.ple_norm_g + L * 1024, w.Wgt + L * WG_SZ, 0, 1024, 1, tile, rot, tid, bid, G);
        prep_job<MAP_ID>(in.ple_proj_w + (size_t)L * 256 * 1024, 1024, 1024, 0, nullptr, w.Wpt + L * WP_SZ, 0, 256, 1, tile, rot, tid, bid, G);
        for (int i = bid * 256 + tid; i < 96 * 1024 / 8; i += G * 256) *(uint4*)(w.W1t + L * W1_SZ + (size_t)1440 * 1024 + (size_t)i * 8) = make_uint4(0u, 0u, 0u, 0u);
        for (int i = bid * 256 + tid; i < 128 * 1024; i += G * 256) {
            int n = i >> 10, k = i & 1023; float v = 0.f;
            if (n < 4) v = in.router_group_w[(size_t)L * 1024 * 4 + k * 4 + n];
            else if (n < 36) v = in.router_expert_w[(size_t)L * 1024 * 32 + k * 32 + (n - 4)];
            v *= in.ffn_norm_g[L * 1024 + k];
            w.Wrt[L * WR_SZ + i] = (bf16_t)f2bf(v);
        }
        for (int i = bid * 256 + tid; i < 4 * 128 * 128; i += G * 256) {
            int jj = i & 127, ii = (i >> 7) & 127;
            float v = (jj <= ii) ? in.sgu_w[(size_t)L * WSM_SZ + i] : 0.f;
            w.Wsm[L * WSM_SZ + i] = (bf16_t)f2bf(v);
        }
    }
    for (int i = bid * 256 + tid; i < NT * 16; i += G * 256) {
        int t = i >> 4, j = i & 15;
        float c, sn; rope_cs(in.positions[t], j, c, sn);
        w.cs[t * 32 + j] = c; w.cs[t * 32 + 16 + j] = sn;
    }
    for (int row = bid * 4 + (tid >> 6); row < NT; row += G * 4) {
        const int lane = tid & 63;
        float ss = 0.f;
#pragma unroll
        for (int j = 0; j < 4; ++j) {
            const size_t i = (size_t)row * 256 + j * 64 + lane;
            const float4 v = ((const float4*)in.x)[i];
            uint2 pk; pk.x = pack2(v.x, v.y); pk.y = pack2(v.z, v.w);
            ((uint2*)w.hb)[i] = pk;
            ss += v.x * v.x + v.y * v.y + v.z * v.z + v.w * v.w;
        }
        ss = wave_sum64(ss);
        if (lane < 8) w.rssA[(size_t)row * 8 + lane] = lane == 0 ? ss : 0.f;
    }
}

__device__ void prep_moe_late(const Params& P, int part, char* lds, const int tid, const int bi, const int nb) {
    float* tile = (float*)lds;
    const nv::Inputs& in = P.in; const WS& w = P.w;
    int rot = 0; const int L = 1;
    const float* up = in.moe_w_up + (size_t)L * 32 * 1024 * 256;
    if (part == 0) {
        prep_job<MAP_GATE>(in.moe_w_gate + (size_t)L * 32 * 1024 * 256, 256, 256, (size_t)1024 * 256, in.ffn_norm_g + L * 1024, w.Wgut + L * WGU_SZ, (size_t)512 * 1024, 1024, 32, tile, rot, tid, bi, nb);
        prep_job<MAP_UP>(up, 256, 256, (size_t)1024 * 256, in.ffn_norm_g + L * 1024, w.Wgut + L * WGU_SZ, (size_t)512 * 1024, 1024, 16, tile, rot, tid, bi, nb);
    } else {
        prep_job<MAP_UP>(up + (size_t)16 * 1024 * 256, 256, 256, (size_t)1024 * 256, in.ffn_norm_g + L * 1024, w.Wgut + L * WGU_SZ + (size_t)16 * 512 * 1024, (size_t)512 * 1024, 1024, 16, tile, rot, tid, bi, nb);
        prep_job<MAP_ID>(in.moe_w_down + (size_t)L * 32 * 256 * 1024, 1024, 1024, (size_t)256 * 1024, nullptr, w.Wdt + L * WD_SZ, (size_t)1024 * 256, 256, 32, tile, rot, tid, bi, nb);
    }
    __syncthreads();
}

__device__ __forceinline__ int lds_off(int row, int chunk) { return row * 128 + ((chunk ^ ((row >> 1) & 7)) << 4); }

template <typename AT> struct ARaw;
template <> struct ARaw<bf16_t> { uint4 v[4]; };
template <> struct ARaw<float> { float4 v[4][2]; };

__device__ __forceinline__ void a_load(ARaw<bf16_t>& r, const bf16_t* const (&rowp)[4], int koff) {
#pragma unroll
    for (int i = 0; i < 4; ++i) r.v[i] = *(const uint4*)(rowp[i] + koff);
}
__device__ __forceinline__ void a_load(ARaw<float>& r, const float* const (&rowp)[4], int koff) {
#pragma unroll
    for (int i = 0; i < 4; ++i) { r.v[i][0] = *(const float4*)(rowp[i] + koff); r.v[i][1] = *(const float4*)(rowp[i] + koff + 4); }
}
template <bool SUMSQ> __device__ __forceinline__ uint4 a_cvt(const uint4& v, float& ss) {
    if (SUMSQ) {
        float a;
        a = bflo(v.x); ss = fmaf(a, a, ss); a = bfhi(v.x); ss = fmaf(a, a, ss);
        a = bflo(v.y); ss = fmaf(a, a, ss); a = bfhi(v.y); ss = fmaf(a, a, ss);
        a = bflo(v.z); ss = fmaf(a, a, ss); a = bfhi(v.z); ss = fmaf(a, a, ss);
        a = bflo(v.w); ss = fmaf(a, a, ss); a = bfhi(v.w); ss = fmaf(a, a, ss);
    }
    return v;
}
template <bool SUMSQ> __device__ __forceinline__ void a_store(const ARaw<bf16_t>& r, char* ldsA, int tid, float (&ss)[4]) {
#pragma unroll
    for (int i = 0; i < 4; ++i) { uint4 v = a_cvt<SUMSQ>(r.v[i], ss[i]); *(uint4*)(ldsA + lds_off((tid >> 3) + 32 * i, tid & 7)) = v; }
}
template <bool SUMSQ> __device__ __forceinline__ void a_store(const ARaw<float>& r, char* ldsA, int tid, float (&ss)[4]) {
#pragma unroll
    for (int i = 0; i < 4; ++i) {
        const float4 a = r.v[i][0], b = r.v[i][1];
        if (SUMSQ) ss[i] += a.x * a.x + a.y * a.y + a.z * a.z + a.w * a.w + b.x * b.x + b.y * b.y + b.z * b.z + b.w * b.w;
        uint4 v; v.x = pack2(a.x, a.y); v.y = pack2(a.z, a.w); v.z = pack2(b.x, b.y); v.w = pack2(b.z, b.w);
        *(uint4*)(ldsA + lds_off((tid >> 3) + 32 * i, tid & 7)) = v;
    }
}

struct bf16x3_t {};
template <> struct ARaw<bf16x3_t> { uint4 a[4], b[4], c[4]; };
struct Rows3 { const bf16_t* p[2][4]; };
__device__ __forceinline__ void a_load(ARaw<bf16x3_t>& r, const Rows3& rows, int koff) {
#pragma unroll
    for (int i = 0; i < 4; ++i) { r.a[i] = *(const uint4*)(rows.p[0][i] + koff); r.b[i] = *(const uint4*)(rows.p[1][i] + koff); r.c[i] = *(const uint4*)(rows.p[1][i] + koff + 1024); }
}
__device__ __forceinline__ unsigned add3pk(unsigned a, unsigned b, unsigned c, float& ss) {
    const float lo = bflo(a) + bflo(b) + bflo(c), hi = bfhi(a) + bfhi(b) + bfhi(c);
    ss = fmaf(lo, lo, ss); ss = fmaf(hi, hi, ss);
    return pack2(lo, hi);
}
template <bool SUMSQ> __device__ __forceinline__ void a_store(const ARaw<bf16x3_t>& r, char* ldsA, int tid, float (&ss)[4]) {
#pragma unroll
    for (int i = 0; i < 4; ++i) {
        uint4 v;
        v.x = add3pk(r.a[i].x, r.b[i].x, r.c[i].x, ss[i]); v.y = add3pk(r.a[i].y, r.b[i].y, r.c[i].y, ss[i]);
        v.z = add3pk(r.a[i].z, r.b[i].z, r.c[i].z, ss[i]); v.w = add3pk(r.a[i].w, r.b[i].w, r.c[i].w, ss[i]);
        *(uint4*)(ldsA + lds_off((tid >> 3) + 32 * i, tid & 7)) = v;
    }
}

template <typename AT, bool SUMSQ, int SUNROLL = 4, typename AROWS>
__device__ __forceinline__ void gemm_mainloop(f32x16 (&acc)[2][2], const AROWS& arow, const bf16_t* const (&wrow)[4], int nkt, char* lds, float (&ss)[4], const int tid) {
    const int lane = tid & 63, wid = tid >> 6, wr = wid >> 1, wc = wid & 1;
    ARaw<AT> ra; ARaw<bf16_t> rb; float dummy[4] = {0.f, 0.f, 0.f, 0.f};
    a_load(ra, arow, 0); a_load(rb, wrow, 0);
    a_store<SUMSQ>(ra, lds, tid, ss); a_store<false>(rb, lds + 16384, tid, dummy);
    __syncthreads();
    const int fr = lane & 31, fh = lane >> 5;
#pragma unroll 1
    for (int kt = 0; kt < nkt; ++kt) {
        char* cur = lds + (kt & 1) * 32768;
        char* nxt = lds + ((kt + 1) & 1) * 32768;
        const bool more = (kt + 1 < nkt);
        if (more) { a_load(ra, arow, (kt + 1) * 64); a_load(rb, wrow, (kt + 1) * 64); }
#pragma unroll SUNROLL
        for (int s = 0; s < 4; ++s) {
            bf16x8 xa[2], wb[2];
#pragma unroll
            for (int i = 0; i < 2; ++i) xa[i] = *(const bf16x8*)(cur + lds_off(wr * 64 + i * 32 + fr, 2 * s + fh));
#pragma unroll
            for (int j = 0; j < 2; ++j) wb[j] = *(const bf16x8*)(cur + 16384 + lds_off(wc * 64 + j * 32 + fr, 2 * s + fh));
#pragma unroll
            for (int i = 0; i < 2; ++i)
#pragma unroll
                for (int j = 0; j < 2; ++j) acc[i][j] = __builtin_amdgcn_mfma_f32_32x32x16_bf16(wb[j], xa[i], acc[i][j], 0, 0, 0);
        }
        if (more) { a_store<SUMSQ>(ra, nxt, tid, ss); a_store<false>(rb, nxt + 16384, tid, dummy); }
        __syncthreads();
    }
}
constexpr int GST = 16384;
__device__ __forceinline__ int gl_chunk(int tid) { return (tid & 3) ^ ((tid >> 4) & 3); }
__device__ __forceinline__ int gl_off(int row, int chunk) { return row * 64 + ((chunk ^ ((row >> 2) & 3)) << 4); }
typedef __attribute__((address_space(3))) unsigned lds_u32_t;
__device__ __forceinline__ void glds16(const bf16_t* g, char* l) {
    __builtin_amdgcn_global_load_lds((const unsigned*)g, (lds_u32_t*)l, 16, 0, 0);
}
#define RAW_BARRIER() do { asm volatile("s_waitcnt lgkmcnt(0)" ::: "memory"); __builtin_amdgcn_s_barrier(); } while (0)
template <bool SEG = false>
__device__ __forceinline__ void gemm_mainloop_g(f32x16 (&acc)[2][2], const bf16_t* const (&arow)[2], const bf16_t* const (&wrow)[2], const int nkt, char* lds, const int tid,
                                                const int rot = 0, const int kt1 = -1, const float* f1 = nullptr, const int kt2 = -1, const float* f2 = nullptr) {
    const int lane = tid & 63, wid = tid >> 6, wr = wid >> 1, wc = wid & 1, fr = lane & 31, fh = lane >> 5;
    const int wbase = __builtin_amdgcn_readfirstlane(wid) * 1024;
#pragma unroll 1
    for (int p = 0; p < 3; ++p) if (p < nkt) {
        char* st = lds + p * GST + wbase;
        const int ko = SEG ? ((p + rot) & (nkt - 1)) * 32 : p * 32;
        glds16(arow[0] + ko, st); glds16(arow[1] + ko, st + 4096);
        glds16(wrow[0] + ko, st + 8192); glds16(wrow[1] + ko, st + 8192 + 4096);
    }
    const int ra0 = gl_off(wr * 64 + fr, fh), ra1 = gl_off(wr * 64 + 32 + fr, fh);
    const int rb0 = 8192 + gl_off(wc * 64 + fr, fh), rb1 = 8192 + gl_off(wc * 64 + 32 + fr, fh);
#pragma unroll 1
    for (int kt = 0; kt < nkt; ++kt) {
        if (kt + 2 < nkt) asm volatile("s_waitcnt vmcnt(8)" ::: "memory");
        else if (kt + 1 < nkt) asm volatile("s_waitcnt vmcnt(4)" ::: "memory");
        else asm volatile("s_waitcnt vmcnt(0)" ::: "memory");
        RAW_BARRIER();
        if (kt + 3 < nkt) {
            char* st = lds + ((kt + 3) & 3) * GST + wbase;
            const int ko = SEG ? ((kt + 3 + rot) & (nkt - 1)) * 32 : (kt + 3) * 32;
            glds16(arow[0] + ko, st); glds16(arow[1] + ko, st + 4096);
            glds16(wrow[0] + ko, st + 8192); glds16(wrow[1] + ko, st + 8192 + 4096);
        }
        const char* cur = lds + (kt & 3) * GST;
        if (SEG && (kt == kt1 || kt == kt2)) {
            const float* f = kt == kt1 ? f1 : f2;
#pragma unroll
            for (int i = 0; i < 2; ++i) {
                const float v = f[wr * 64 + i * 32 + fr];
#pragma unroll
                for (int j = 0; j < 2; ++j)
#pragma unroll
                    for (int r = 0; r < 16; ++r) acc[i][j][r] *= v;
            }
        }
        bf16x8 xa[2][2], wb[2][2];
#pragma unroll
        for (int s2 = 0; s2 < 2; ++s2) {
            xa[s2][0] = *(const bf16x8*)(cur + (ra0 ^ (s2 << 5))); xa[s2][1] = *(const bf16x8*)(cur + (ra1 ^ (s2 << 5)));
            wb[s2][0] = *(const bf16x8*)(cur + (rb0 ^ (s2 << 5))); wb[s2][1] = *(const bf16x8*)(cur + (rb1 ^ (s2 << 5)));
        }
        __builtin_amdgcn_sched_barrier(0);
#pragma unroll
        for (int s2 = 0; s2 < 2; ++s2) {
            acc[0][0] = __builtin_amdgcn_mfma_f32_32x32x16_bf16(wb[s2][0], xa[s2][0], acc[0][0], 0, 0, 0);
            acc[0][1] = __builtin_amdgcn_mfma_f32_32x32x16_bf16(wb[s2][1], xa[s2][0], acc[0][1], 0, 0, 0);
            acc[1][0] = __builtin_amdgcn_mfma_f32_32x32x16_bf16(wb[s2][0], xa[s2][1], acc[1][0], 0, 0, 0);
            acc[1][1] = __builtin_amdgcn_mfma_f32_32x32x16_bf16(wb[s2][1], xa[s2][1], acc[1][1], 0, 0, 0);
        }
    }
    RAW_BARRIER();
}
__device__ __forceinline__ int g64_chunk(int tid) { return (tid & 7) ^ ((tid >> 4) & 7); }
__device__ __forceinline__ void gemm_mainloop_g64(f32x16 (&acc)[2][2], const bf16_t* const (&arow)[4], const bf16_t* const (&wrow)[4], const int nkt, char* lds, const int tid) {
    const int lane = tid & 63, wid = tid >> 6, wr = wid >> 1, wc = wid & 1, fr = lane & 31, fh = lane >> 5;
    const int wbase = __builtin_amdgcn_readfirstlane(wid) * 1024;
    {
        char* st = lds + wbase;
#pragma unroll
        for (int i = 0; i < 4; ++i) { glds16(arow[i], st + i * 4096); glds16(wrow[i], st + 16384 + i * 4096); }
    }
#pragma unroll 1
    for (int kt = 0; kt < nkt; ++kt) {
        asm volatile("s_waitcnt vmcnt(0)" ::: "memory");
        RAW_BARRIER();
        if (kt + 1 < nkt) {
            char* st = lds + ((kt + 1) & 1) * 32768 + wbase;
            const int ko = (kt + 1) * 64;
#pragma unroll
            for (int i = 0; i < 4; ++i) { glds16(arow[i] + ko, st + i * 4096); glds16(wrow[i] + ko, st + 16384 + i * 4096); }
        }
        const char* cur = lds + (kt & 1) * 32768;
#pragma unroll
        for (int s = 0; s < 4; ++s) {
            bf16x8 xa[2], wb[2];
#pragma unroll
            for (int i = 0; i < 2; ++i) xa[i] = *(const bf16x8*)(cur + lds_off(wr * 64 + i * 32 + fr, 2 * s + fh));
#pragma unroll
            for (int j = 0; j < 2; ++j) wb[j] = *(const bf16x8*)(cur + 16384 + lds_off(wc * 64 + j * 32 + fr, 2 * s + fh));
#pragma unroll
            for (int i = 0; i < 2; ++i)
#pragma unroll
                for (int j = 0; j < 2; ++j) acc[i][j] = __builtin_amdgcn_mfma_f32_32x32x16_bf16(wb[j], xa[i], acc[i][j], 0, 0, 0);
        }
    }
    RAW_BARRIER();
}
__device__ __forceinline__ void acc_zero(f32x16 (&acc)[2][2]) {
#pragma unroll
    for (int i = 0; i < 2; ++i)
#pragma unroll
        for (int j = 0; j < 2; ++j)
#pragma unroll
            for (int r = 0; r < 16; ++r) acc[i][j][r] = 0.f;
}
__device__ __forceinline__ void publish_rowstat(float (&ss)[4], float* stat, float invK, bool as_rstd, const int tid) {
#pragma unroll
    for (int i = 0; i < 4; ++i) {
        float v = ss[i];
        v += __shfl_xor(v, 1); v += __shfl_xor(v, 2); v += __shfl_xor(v, 4);
        if ((tid & 7) == 0) stat[(tid >> 3) + 32 * i] = as_rstd ? rsqrtf(v * invK + EPS) : v;
    }
    __syncthreads();
}
__device__ __forceinline__ int nidx(int r, int fh) { return (r & 3) + 8 * (r >> 2) + 4 * fh; }
__device__ __forceinline__ uint4 pack8(const float4& a, const float4& b) { uint4 pk; pk.x = pack2(a.x, a.y); pk.y = pack2(a.z, a.w); pk.z = pack2(b.x, b.y); pk.w = pack2(b.z, b.w); return pk; }
__device__ __forceinline__ float sq8(const float4& a, const float4& b) { return (a.x * a.x + a.y * a.y) + (a.z * a.z + a.w * a.w) + (b.x * b.x + b.y * b.y) + (b.z * b.z + b.w * b.w); }
__device__ __forceinline__ float4 mul4(const float4& a, float s) { return make_float4(a.x * s, a.y * s, a.z * s, a.w * s); }
__device__ __forceinline__ void store4(bf16_t* p, float a, float b, float c, float d) {
    uint2 v; v.x = pack2(a, b); v.y = pack2(c, d); *(uint2*)p = v;
}

__device__ __forceinline__ bool xcd_item(int it, int MT, int NTl, int& mt, int& nt) {
    const int x = blockIdx.x & 7, lb = blockIdx.x >> 3, nlb = gridDim.x >> 3;
    const int li = it * nlb + lb, per = (MT >> 3) * NTl;
    if (li >= per) return false;
    mt = (li / NTl) * 8 + x; nt = li % NTl; return true;
}

constexpr int TLD = 132;
constexpr int STAT_OFF = 128 * TLD * 4;
constexpr int LDS_GEMM_BYTES = STAT_OFF + 2048;
__device__ __forceinline__ void acc_to_lds(const f32x16 (&acc)[2][2], float* T, const int tid) {
    const int lane = tid & 63, wid = tid >> 6, wr = wid >> 1, wc = wid & 1, fr = lane & 31, fh = lane >> 5;
#pragma unroll
    for (int i = 0; i < 2; ++i)
#pragma unroll
        for (int j = 0; j < 2; ++j)
#pragma unroll
            for (int g = 0; g < 4; ++g) {
                float4 v; v.x = acc[i][j][4 * g]; v.y = acc[i][j][4 * g + 1]; v.z = acc[i][j][4 * g + 2]; v.w = acc[i][j][4 * g + 3];
                *(float4*)(T + (wr * 64 + i * 32 + fr) * TLD + wc * 64 + j * 32 + 8 * g + 4 * fh) = v;
            }
    __syncthreads();
}
__device__ __forceinline__ float rstd8(const float* p, float invK) {
    const float4 a = *(const float4*)p, b = *(const float4*)(p + 4);
    return rsq_(((a.x + a.y) + (a.z + a.w) + (b.x + b.y) + (b.z + b.w)) * invK + EPS);
}

}
namespace fx {

__device__ void phase_zgemm(const Params& P, int L, char* lds, const bool same = false) {
    const WS& w = P.w; const nv::Inputs& in = P.in;
    const int tid0 = opaque_tid();
    float* T = (float*)lds; float* stat = (float*)(lds + STAT_OFF);
    const bf16_t* Wt = w.W1t + L * W1_SZ;
    int mt, nt;
    for (int it = 0; xcd_item(it, 128, 12, mt, nt); ++it) {
        int tid = tid0; asm volatile("" : "+v"(tid));
        const int lane = tid & 63, wid = tid >> 6;
        const int m0 = mt * 128, n0 = nt * 128;
        {
            const bf16_t* arow[4]; const bf16_t* wrow[4];
#pragma unroll
            for (int i = 0; i < 4; ++i) {
                arow[i] = w.hb + (size_t)(m0 + (tid >> 3) + 32 * i) * 1024 + g64_chunk(tid) * 8;
                wrow[i] = Wt + (size_t)(n0 + (tid >> 3) + 32 * i) * 1024 + g64_chunk(tid) * 8;
            }
            f32x16 acc[2][2]; acc_zero(acc);
            float my_rs = 0.f;
            if (tid < 128) my_rs = rstd8(w.rssA + (size_t)(m0 + tid) * 8, 1.f / 1024.f);
            gemm_mainloop_g64(acc, arow, wrow, 16, lds, tid);
            if (tid < 128) stat[tid] = my_rs;
            acc_to_lds(acc, T, tid);
        }
        const int sub = lane >> 4, l16 = lane & 15, c8 = l16 * 8;
        if (nt < 2) {
#pragma unroll 8
            for (int rr = 0; rr < 8; ++rr) {
                const int row = wid * 32 + rr * 4 + sub; const float rs = stat[row];
                float4 x0 = *(const float4*)(T + row * TLD + c8), x1 = *(const float4*)(T + row * TLD + c8 + 4);
                x0.x = gelu_tanh_(x0.x * rs); x0.y = gelu_tanh_(x0.y * rs); x0.z = gelu_tanh_(x0.z * rs); x0.w = gelu_tanh_(x0.w * rs);
                x1.x = gelu_tanh_(x1.x * rs); x1.y = gelu_tanh_(x1.y * rs); x1.z = gelu_tanh_(x1.z * rs); x1.w = gelu_tanh_(x1.w * rs);
                *(uint4*)(w.ub + (size_t)(m0 + row) * 256 + nt * 128 + c8) = pack8(x0, x1);
            }
        } else if (nt < 4) {
            const int hd = (nt - 2) * 2 + (l16 >> 3), d0 = (l16 & 7) * 8;
            const float4 g0 = *(const float4*)(in.sgu_ln_g + L * 256 + hd * 64 + d0), g1 = *(const float4*)(in.sgu_ln_g + L * 256 + hd * 64 + d0 + 4);
            const float4 b0 = *(const float4*)(in.sgu_ln_b + L * 256 + hd * 64 + d0), b1 = *(const float4*)(in.sgu_ln_b + L * 256 + hd * 64 + d0 + 4);
#pragma unroll 4
            for (int rr = 0; rr < 8; ++rr) {
                const int row = wid * 32 + rr * 4 + sub; const float rs = stat[row];
                float4 x0 = *(const float4*)(T + row * TLD + c8), x1 = *(const float4*)(T + row * TLD + c8 + 4);
                x0.x = gelu_tanh_(x0.x * rs); x0.y = gelu_tanh_(x0.y * rs); x0.z = gelu_tanh_(x0.z * rs); x0.w = gelu_tanh_(x0.w * rs);
                x1.x = gelu_tanh_(x1.x * rs); x1.y = gelu_tanh_(x1.y * rs); x1.z = gelu_tanh_(x1.z * rs); x1.w = gelu_tanh_(x1.w * rs);
                const float mean = grp_sum8((x0.x + x0.y) + (x0.z + x0.w) + (x1.x + x1.y) + (x1.z + x1.w)) * (1.f / 64.f);
                x0.x -= mean; x0.y -= mean; x0.z -= mean; x0.w -= mean; x1.x -= mean; x1.y -= mean; x1.z -= mean; x1.w -= mean;
                const float rv = rsq_(grp_sum8(sq8(x0, x1)) * (1.f / 64.f) + EPS);
                x0.x = x0.x * rv * g0.x + b0.x; x0.y = x0.y * rv * g0.y + b0.y; x0.z = x0.z * rv * g0.z + b0.z; x0.w = x0.w * rv * g0.w + b0.w;
                x1.x = x1.x * rv * g1.x + b1.x; x1.y = x1.y * rv * g1.y + b1.y; x1.z = x1.z * rv * g1.z + b1.z; x1.w = x1.w * rv * g1.w + b1.w;
                *(float4*)(T + row * TLD + c8) = x0; *(float4*)(T + row * TLD + c8 + 4) = x1;
            }
            __syncthreads();
            {
                const int c = tid & 127, th = tid >> 7, hd2 = (nt - 2) * 2 + (c >> 6), d = c & 63;
                bf16_t* dst = w.vT + ((size_t)(mt * 4 + hd2) * 64 + d) * 128 + th * 64;
#pragma unroll 2
                for (int k8 = 0; k8 < 8; ++k8) {
                    float v[8];
#pragma unroll
                    for (int k = 0; k < 8; ++k) v[k] = T[(th * 64 + k8 * 8 + k) * TLD + c];
                    uint4 pk; pk.x = pack2(v[0], v[1]); pk.y = pack2(v[2], v[3]); pk.z = pack2(v[4], v[5]); pk.w = pack2(v[6], v[7]);
                    *(uint4*)(dst + k8 * 8) = pk;
                }
            }
        } else if (nt < 8) {
#pragma unroll 8
            for (int rr = 0; rr < 8; ++rr) {
                const int row = wid * 32 + rr * 4 + sub; const float rs = stat[row];
                const float4 x0 = *(const float4*)(T + row * TLD + c8), x1 = *(const float4*)(T + row * TLD + c8 + 4);
                store4(w.ygb + (size_t)(m0 + row) * 256 + (nt - 4) * 64 + l16 * 4, x0.x * rs * sigmoid_(x0.y * rs), x0.z * rs * sigmoid_(x0.w * rs),
                       x1.x * rs * sigmoid_(x1.y * rs), x1.z * rs * sigmoid_(x1.w * rs));
            }
        } else if (nt < 11) {
            bf16_t* base; int ld, cb;
            if (nt < 10) { base = w.cqb; ld = 256; cb = (nt - 8) * 128; } else { base = w.ckvb; ld = 128; cb = 0; }
#pragma unroll 8
            for (int rr = 0; rr < 8; ++rr) {
                const int row = wid * 32 + rr * 4 + sub; const float rs = stat[row];
                const float4 x0 = mul4(*(const float4*)(T + row * TLD + c8), rs), x1 = mul4(*(const float4*)(T + row * TLD + c8 + 4), rs);
                *(uint4*)(base + (size_t)(m0 + row) * ld + cb + c8) = pack8(x0, x1);
                const float sq = grp_sum16(sq8(x0, x1));
                if (l16 == 0) w.cqss[(size_t)(m0 + row) * 4 + (nt - 8)] = sq;
            }
        } else {
            const int lq = l16 & 3, dd = lq * 8, jj = (lq & 1) * 8;
            const float4 kg0 = *(const float4*)(in.k_norm_g + L * 96 + 64 + dd), kg1 = *(const float4*)(in.k_norm_g + L * 96 + 64 + dd + 4);
#pragma unroll 1
            for (int hb4 = 0; hb4 < 2; ++hb4) {
                float4 cc0[4], cc1[4], ss0[4], ss1[4];
#pragma unroll
                for (int r4 = 0; r4 < 4; ++r4) {
                    const float* csr = w.cs + (size_t)(m0 + wid * 32 + (hb4 * 4 + r4) * 4 + sub) * 32 + jj;
                    cc0[r4] = *(const float4*)csr; cc1[r4] = *(const float4*)(csr + 4); ss0[r4] = *(const float4*)(csr + 16); ss1[r4] = *(const float4*)(csr + 20);
                }
#pragma unroll
                for (int r4 = 0; r4 < 4; ++r4) {
                    const int row = wid * 32 + (hb4 * 4 + r4) * 4 + sub; const float rs = stat[row]; const int tok = m0 + row;
                    float4 x0 = mul4(*(const float4*)(T + row * TLD + dd), rs), x1 = mul4(*(const float4*)(T + row * TLD + dd + 4), rs);
                    const float rn = rsq_(grp_sum4(sq8(x0, x1)) * (1.f / 32.f) + EPS);
                    x0.x *= rn * kg0.x; x0.y *= rn * kg0.y; x0.z *= rn * kg0.z; x0.w *= rn * kg0.w;
                    x1.x *= rn * kg1.x; x1.y *= rn * kg1.y; x1.z *= rn * kg1.z; x1.w *= rn * kg1.w;
                    const float4 o0 = make_float4(quad_x2(x0.x), quad_x2(x0.y), quad_x2(x0.z), quad_x2(x0.w)), o1 = make_float4(quad_x2(x1.x), quad_x2(x1.y), quad_x2(x1.z), quad_x2(x1.w));
                    const float4 c0 = cc0[r4], c1 = cc1[r4], s0 = ss0[r4], s1 = ss1[r4];
                    const float sg = (lq & 2) ? 1.f : -1.f;
                    float4 r0, r1;
                    r0.x = x0.x * c0.x + sg * o0.x * s0.x; r0.y = x0.y * c0.y + sg * o0.y * s0.y; r0.z = x0.z * c0.z + sg * o0.z * s0.z; r0.w = x0.w * c0.w + sg * o0.w * s0.w;
                    r1.x = x1.x * c1.x + sg * o1.x * s1.x; r1.y = x1.y * c1.y + sg * o1.y * s1.y; r1.z = x1.z * c1.z + sg * o1.z * s1.z; r1.w = x1.w * c1.w + sg * o1.w * s1.w;
                    if (l16 < 4) *(uint4*)(w.kpeb + (size_t)tok * 32 + dd) = pack8(r0, r1);
                }
            }
        }
        __syncthreads();
    }
}

__global__ void k_shim_z(Params P, int t0) {
    const WS& w = P.w;
    size_t idx = (size_t)blockIdx.x * blockDim.x + threadIdx.x;
    if (idx >= (size_t)2048 * 1440) return;
    int t = t0 + (int)(idx / 1440), c = (int)(idx % 1440);
    float v = 0.f;
    if (c < 256) v = bf2f(w.ub[(size_t)t * 256 + c]);
    else if (c < 512) { int cc = c - 256; v = bf2f(w.vT[((size_t)((t >> 7) * 4 + (cc >> 6)) * 64 + (cc & 63)) * 128 + (t & 127)]); }
    else if (c < 768) v = bf2f(w.ygb[(size_t)t * 256 + c - 512]);
    else if (c < 1024) v = 0.f;
    else if (c < 1280) v = bf2f(w.cqb[(size_t)t * 256 + c - 1024]);
    else if (c < 1408) v = bf2f(w.ckvb[(size_t)t * 128 + c - 1280]);
    else v = bf2f(w.kpeb[(size_t)t * 32 + c - 1408]);
    P.zf[idx] = v;
}
__global__ void k_shim_hb(Params P) {
    size_t i = (size_t)blockIdx.x * blockDim.x + threadIdx.x;
    if (i >= (size_t)NT * 1024 / 4) return;
    float4 v = ((const float4*)P.h)[i];
    uint2 pk; pk.x = pack2(v.x, v.y); pk.y = pack2(v.z, v.w);
    ((uint2*)P.w.hb)[i] = pk;
}

}
namespace fx {

constexpr float QSCALE = 0.10206207261596575f * 1.4426950408889634f;

__device__ void qkv_item(const Params& P, int L, const bool isq, const int mt, const int nt, char* lds, const int tid_in) {
    int tid = tid_in; asm volatile("" : "+v"(tid));
    const WS& w = P.w; const nv::Inputs& in = P.in;
    const int lane = tid & 63, wid = tid >> 6;
    float* T = (float*)lds; float* stat = (float*)(lds + STAT_OFF);
    const int m0 = mt * 128, n0 = nt * 128;
    const int K = isq ? 256 : 128;
    {
        const bf16_t* A = isq ? w.cqb : w.ckvb;
        const bf16_t* Wt = isq ? (w.Wuqt + L * WUQ_SZ) : (w.Wukvt + L * WUKV_SZ);
        const bf16_t* arow[2]; const bf16_t* wrow[2];
#pragma unroll
        for (int i = 0; i < 2; ++i) {
            arow[i] = A + (size_t)(m0 + (tid >> 2) + 64 * i) * K + gl_chunk(tid) * 8;
            wrow[i] = Wt + (size_t)(n0 + (tid >> 2) + 64 * i) * K + gl_chunk(tid) * 8;
        }
        f32x16 acc[2][2]; acc_zero(acc);
        float my_rs = 0.f;
        if (tid < 128) {
            const float4 c = *(const float4*)(w.cqss + (size_t)(m0 + tid) * 4);
            my_rs = isq ? rsq_((c.x + c.y) * (1.f / 256.f) + EPS) : rsq_(c.z * (1.f / 128.f) + EPS);
        }
        gemm_mainloop_g(acc, arow, wrow, K / 32, lds, tid);
        if (tid < 128) stat[tid] = my_rs;
        acc_to_lds(acc, T, tid);
    }
    const int b = m0 >> 11, s0 = m0 & 2047;
    const int sub = lane >> 4, l16 = lane & 15, c8 = l16 * 8;
    if (isq && nt < 4) {
        const int hd = nt * 2 + (l16 >> 3), d = (l16 & 7) * 8;
        const float4 g0 = mul4(*(const float4*)(in.q_norm_g + L * 96 + d), QSCALE), g1 = mul4(*(const float4*)(in.q_norm_g + L * 96 + d + 4), QSCALE);
        bf16_t* dst = w.Qb + ((size_t)(b * 8 + hd) * 2048 + s0) * 96 + d;
#pragma unroll 8
        for (int rr = 0; rr < 8; ++rr) {
            const int row = wid * 32 + rr * 4 + sub; const float rs = stat[row];
            float4 x0 = mul4(*(const float4*)(T + row * TLD + c8), rs), x1 = mul4(*(const float4*)(T + row * TLD + c8 + 4), rs);
            const float rn = rsq_(grp_sum8(sq8(x0, x1)) * (1.f / 64.f) + EPS);
            x0.x *= rn * g0.x; x0.y *= rn * g0.y; x0.z *= rn * g0.z; x0.w *= rn * g0.w; x1.x *= rn * g1.x; x1.y *= rn * g1.y; x1.z *= rn * g1.z; x1.w *= rn * g1.w;
            *(uint4*)(dst + (size_t)row * 96) = pack8(x0, x1);
        }
    } else if (isq) {
        const int hd = (nt - 4) * 4 + (l16 >> 2), lq = l16 & 3, dd = lq * 8, jj = (lq & 1) * 8;
        const float4 g0 = *(const float4*)(in.q_norm_g + L * 96 + 64 + dd), g1 = *(const float4*)(in.q_norm_g + L * 96 + 64 + dd + 4);
        bf16_t* dst = w.Qb + ((size_t)(b * 8 + hd) * 2048 + s0) * 96 + 64 + dd;
        const float sg = (lq & 2) ? QSCALE : -QSCALE;
#pragma unroll 1
        for (int hb4 = 0; hb4 < 2; ++hb4) {
            float4 cc0[4], cc1[4], ss0[4], ss1[4];
#pragma unroll
            for (int r4 = 0; r4 < 4; ++r4) {
                const float* csr = w.cs + (size_t)(m0 + wid * 32 + (hb4 * 4 + r4) * 4 + sub) * 32 + jj;
                cc0[r4] = *(const float4*)csr; cc1[r4] = *(const float4*)(csr + 4); ss0[r4] = *(const float4*)(csr + 16); ss1[r4] = *(const float4*)(csr + 20);
            }
#pragma unroll
            for (int r4 = 0; r4 < 4; ++r4) {
                const int row = wid * 32 + (hb4 * 4 + r4) * 4 + sub; const float rs = stat[row];
                float4 x0 = mul4(*(const float4*)(T + row * TLD + c8), rs), x1 = mul4(*(const float4*)(T + row * TLD + c8 + 4), rs);
                const float rn = rsq_(grp_sum4(sq8(x0, x1)) * (1.f / 32.f) + EPS);
                x0.x *= rn * g0.x; x0.y *= rn * g0.y; x0.z *= rn * g0.z; x0.w *= rn * g0.w; x1.x *= rn * g1.x; x1.y *= rn * g1.y; x1.z *= rn * g1.z; x1.w *= rn * g1.w;
                const float4 o0 = make_float4(quad_x2(x0.x), quad_x2(x0.y), quad_x2(x0.z), quad_x2(x0.w)), o1 = make_float4(quad_x2(x1.x), quad_x2(x1.y), quad_x2(x1.z), quad_x2(x1.w));
                const float4 c0 = mul4(cc0[r4], QSCALE), c1 = mul4(cc1[r4], QSCALE), s0v = ss0[r4], s1v = ss1[r4];
                float4 r0, r1;
                r0.x = x0.x * c0.x + sg * o0.x * s0v.x; r0.y = x0.y * c0.y + sg * o0.y * s0v.y; r0.z = x0.z * c0.z + sg * o0.z * s0v.z; r0.w = x0.w * c0.w + sg * o0.w * s0v.w;
                r1.x = x1.x * c1.x + sg * o1.x * s1v.x; r1.y = x1.y * c1.y + sg * o1.y * s1v.y; r1.z = x1.z * c1.z + sg * o1.z * s1v.z; r1.w = x1.w * c1.w + sg * o1.w * s1v.w;
                *(uint4*)(dst + (size_t)row * 96) = pack8(r0, r1);
            }
        }
    } else if (nt < 4) {
        const int hd = nt * 2 + (l16 >> 3), d = (l16 & 7) * 8;
        const float4 g0 = *(const float4*)(in.k_norm_g + L * 96 + d), g1 = *(const float4*)(in.k_norm_g + L * 96 + d + 4);
        bf16_t* dst = w.Knb + ((size_t)(b * 8 + hd) * 2048 + s0) * 64 + d;
#pragma unroll 8
        for (int rr = 0; rr < 8; ++rr) {
            const int row = wid * 32 + rr * 4 + sub; const float rs = stat[row];
            float4 x0 = mul4(*(const float4*)(T + row * TLD + c8), rs), x1 = mul4(*(const float4*)(T + row * TLD + c8 + 4), rs);
            const float rn = rsq_(grp_sum8(sq8(x0, x1)) * (1.f / 64.f) + EPS);
            x0.x *= rn * g0.x; x0.y *= rn * g0.y; x0.z *= rn * g0.z; x0.w *= rn * g0.w; x1.x *= rn * g1.x; x1.y *= rn * g1.y; x1.z *= rn * g1.z; x1.w *= rn * g1.w;
            *(uint4*)(dst + (size_t)row * 64) = pack8(x0, x1);
        }
    } else {
        const int c = tid & 127, th = tid >> 7, hd = (nt - 4) * 2 + (c >> 6), d = c & 63;
        bf16_t* dst = w.VTb + ((size_t)(b * 8 + hd) * 64 + d) * 2048 + s0 + th * 64;
#pragma unroll 2
        for (int k8 = 0; k8 < 8; ++k8) {
            float v[8];
#pragma unroll
            for (int k = 0; k < 8; ++k) { const int row = th * 64 + k8 * 8 + k; v[k] = T[row * TLD + c] * stat[row]; }
            uint4 pk; pk.x = pack2(v[0], v[1]); pk.y = pack2(v[2], v[3]); pk.z = pack2(v[4], v[5]); pk.w = pack2(v[6], v[7]);
            *(uint4*)(dst + k8 * 8) = pk;
        }
    }
    __syncthreads();
}

__device__ void sgu_item(const Params& P, int L, int mt, char* lds, const int tid_in) {
    int tid = tid_in; asm volatile("" : "+v"(tid));
    const WS& w = P.w; const nv::Inputs& in = P.in;
    const int lane = tid & 63, hd = tid >> 6, fr = lane & 31, fh = lane >> 5;
    float* red = (float*)lds;
    const bf16_t* vt = w.vT + (size_t)(mt * 4 + hd) * 64 * 128;
    const bf16_t* ws = w.Wsm + L * WSM_SZ + (size_t)hd * 128 * 128;
    const float* bs = in.sgu_b + L * 512 + hd * 128;
    const int m0 = mt * 128;
    bf16x8 af0[8], af1[8];
    {
        const bf16_t* ap0 = vt + (size_t)fr * 128 + 8 * fh;
        const bf16_t* ap1 = vt + (size_t)(32 + fr) * 128 + 8 * fh;
#pragma unroll
        for (int s = 0; s < 8; ++s) { af0[s] = *(const bf16x8*)(ap0 + 16 * s); af1[s] = *(const bf16x8*)(ap1 + 16 * s); }
    }
#pragma unroll 1
    for (int it = 0; it < 4; ++it) {
        f32x16 a0, a1;
#pragma unroll
        for (int r = 0; r < 16; ++r) { a0[r] = 0.f; a1[r] = 0.f; }
        const bf16_t* bp = ws + (size_t)(it * 32 + fr) * 128 + 8 * fh;
        bf16x8 bfr[8];
#pragma unroll
        for (int s = 0; s < 8; ++s) bfr[s] = *(const bf16x8*)(bp + 16 * s);
#pragma unroll
        for (int s = 0; s < 8; ++s) {
            a0 = __builtin_amdgcn_mfma_f32_32x32x16_bf16(af0[s], bfr[s], a0, 0, 0, 0);
            a1 = __builtin_amdgcn_mfma_f32_32x32x16_bf16(af1[s], bfr[s], a1, 0, 0, 0);
        }
        const int i = it * 32 + fr, tok = m0 + i;
        const float bias = bs[i];
        uint2 uu[2][4];
#pragma unroll
        for (int dt = 0; dt < 2; ++dt)
#pragma unroll
            for (int g = 0; g < 4; ++g) uu[dt][g] = *(const uint2*)(w.ub + (size_t)tok * 256 + hd * 64 + dt * 32 + 8 * g + 4 * fh);
        float ssq = 0.f;
#pragma unroll
        for (int dt = 0; dt < 2; ++dt)
#pragma unroll
            for (int g = 0; g < 4; ++g) {
                const int d = dt * 32 + 8 * g + 4 * fh;
                float o[4];
#pragma unroll
                for (int q = 0; q < 4; ++q) {
                    const float sv = (dt == 0 ? a0[4 * g + q] : a1[4 * g + q]) + bias;
                    const float uv = (q == 0) ? bflo(uu[dt][g].x) : (q == 1) ? bfhi(uu[dt][g].x) : (q == 2) ? bflo(uu[dt][g].y) : bfhi(uu[dt][g].y);
                    o[q] = uv * sv; ssq += o[q] * o[q];
                }
                store4(w.yb + (size_t)tok * 1024 + hd * 64 + d, o[0], o[1], o[2], o[3]);
            }
        ssq = xor32(ssq);
        if (fh == 0) red[hd * 128 + i] = ssq;
    }
    __syncthreads();
    if (tid < 128) w.ssq[(size_t)(m0 + tid) * 16 + 0] = red[tid] + red[128 + tid] + red[256 + tid] + red[384 + tid];
    __syncthreads();
}

constexpr int CLD = 260, CONV_YL = 32 * CLD * 4, CONV_ST = CONV_YL + 32 * 512, CONV_RED = CONV_ST + 32 * 4 * 8;
__device__ __forceinline__ int yl_off(int row, int chunk) { return row * 512 + ((chunk ^ (row & 15)) << 4); }
__device__ void conv_item(const Params& P, int L, int ct, char* lds, const int tid_in) {
    int tid = tid_in; asm volatile("" : "+v"(tid));
    const WS& w = P.w; const nv::Inputs& in = P.in;
    const int lane = tid & 63, wid = tid >> 6, fr = lane & 31, fh = lane >> 5;
    float* C = (float*)lds; char* yl = lds + CONV_YL; float2* stats = (float2*)(lds + CONV_ST); float* red = (float*)(lds + CONV_RED);
    const int t0 = ct * 32, s0 = t0 & 2047;
    {
        const int c = tid;
        float x[62];
#pragma unroll
        for (int r = 0; r < 62; ++r) {
            const bool ok = s0 + r - 30 >= 0;
            const unsigned short raw = w.ygb[(size_t)(ok ? t0 + r - 30 : t0) * 256 + c];
            x[r] = bf2f(raw) * (ok ? 1.f : 0.f);
        }
        float wk[31];
#pragma unroll
        for (int k = 0; k < 31; ++k) wk[k] = in.conv_w[(size_t)L * 31 * 256 + k * 256 + c];
        const float cb = in.conv_b[L * 256 + c];
#pragma unroll
        for (int t = 0; t < 32; ++t) {
            float a = cb;
#pragma unroll
            for (int k = 0; k < 31; ++k) a = fmaf(wk[k], x[t + k], a);
            C[t * CLD + c] = a;
        }
    }
    __syncthreads();
    if (tid < 128) {
        const int t = tid >> 2, g = tid & 3;
        const float4* cp = (const float4*)(C + t * CLD + g * 64);
        float4 v[16]; float s = 0.f;
#pragma unroll
        for (int i = 0; i < 16; ++i) { v[i] = cp[i]; s += (v[i].x + v[i].y) + (v[i].z + v[i].w); }
        const float mean = s * (1.f / 64.f); float q = 0.f;
#pragma unroll
        for (int i = 0; i < 16; ++i) { const float a = v[i].x - mean, b2 = v[i].y - mean, c2 = v[i].z - mean, d2 = v[i].w - mean; q += (a * a + b2 * b2) + (c2 * c2 + d2 * d2); }
        stats[t * 4 + g] = make_float2(mean, rsq_(q * (1.f / 64.f) + EPS));
    }
    __syncthreads();
    {
        const int c = tid, g = c >> 6;
        const float lg = in.conv_ln_g[L * 256 + c], lb = in.conv_ln_b[L * 256 + c];
#pragma unroll 8
        for (int t = 0; t < 32; ++t) {
            const float2 st = stats[t * 4 + g];
            const float v = (C[t * CLD + c] - st.x) * st.y * lg + lb;
            *(bf16_t*)(yl + yl_off(t, c >> 3) + (c & 7) * 2) = (bf16_t)f2bf(v * sigmoid_(v));
        }
    }
    __syncthreads();
    f32x16 acc0, acc1;
#pragma unroll
    for (int r = 0; r < 16; ++r) { acc0[r] = 0.f; acc1[r] = 0.f; }
    const bf16_t* wp = w.Wpwt + L * WPW_SZ + (size_t)(wid * 64 + fr) * 256 + 8 * fh;
#pragma unroll 1
    for (int sb = 0; sb < 2; ++sb) {
        bf16x8 w0[8], w1[8];
#pragma unroll
        for (int s = 0; s < 8; ++s) { w0[s] = *(const bf16x8*)(wp + 16 * (sb * 8 + s)); w1[s] = *(const bf16x8*)(wp + 32 * 256 + 16 * (sb * 8 + s)); }
#pragma unroll
        for (int s = 0; s < 8; ++s) {
            const bf16x8 x0 = *(const bf16x8*)(yl + yl_off(fr, 2 * (sb * 8 + s) + fh));
            acc0 = __builtin_amdgcn_mfma_f32_32x32x16_bf16(w0[s], x0, acc0, 0, 0, 0);
            acc1 = __builtin_amdgcn_mfma_f32_32x32x16_bf16(w1[s], x0, acc1, 0, 0, 0);
        }
    }
    const float* pb = in.conv_pw_b + L * 256;
    {
        const int tok = t0 + fr;
        float4 bia[2][4];
#pragma unroll
        for (int jn = 0; jn < 2; ++jn)
#pragma unroll
            for (int g = 0; g < 4; ++g) bia[jn][g] = *(const float4*)(pb + wid * 64 + jn * 32 + 8 * g + 4 * fh);
        float ssq = 0.f;
#pragma unroll
        for (int jn = 0; jn < 2; ++jn)
#pragma unroll
            for (int g = 0; g < 4; ++g) {
                const int n = wid * 64 + jn * 32 + 8 * g + 4 * fh;
                const float4 b4 = bia[jn][g];
                const float o0 = (jn ? acc1[4 * g] : acc0[4 * g]) + b4.x, o1 = (jn ? acc1[4 * g + 1] : acc0[4 * g + 1]) + b4.y;
                const float o2 = (jn ? acc1[4 * g + 2] : acc0[4 * g + 2]) + b4.z, o3 = (jn ? acc1[4 * g + 3] : acc0[4 * g + 3]) + b4.w;
                ssq += o0 * o0 + o1 * o1 + o2 * o2 + o3 * o3;
                store4(w.yb + (size_t)tok * 1024 + 256 + n, o0, o1, o2, o3);
            }
        ssq = xor32(ssq);
        if (fh == 0) red[wid * 32 + fr] = ssq;
    }
    __syncthreads();
    if (tid < 32) w.ssq[(size_t)(t0 + tid) * 16 + 1] = red[tid] + red[32 + tid] + red[64 + tid] + red[96 + tid];
    __syncthreads();
}

__device__ void phase_mix(const Params& P, int L, char* lds, const int rep = 0, const bool dryrun = false) {
    const int tid = opaque_tid();
    const int x = blockIdx.x & 7;
    int* qctr = P.w.cnt + L * 256 + 72 + x + 8 * rep;
    volatile int* slot = (volatile int*)(lds + LDS_GEMM_BYTES - 16);
    if (tid == 0) *slot = atomicAdd(qctr, 1);
    __syncthreads();
    int cur = *slot;
    __syncthreads();
    while (cur < 304) {
        int nxt = 0;
        if (tid == 0) nxt = atomicAdd(qctr, 1);
#ifdef MIX_MASK
        const int mask = dryrun ? MIX_MASK : 15;
#else
        const int mask = 15;
#endif
#ifdef MIX_TWICE
        if (cur < 16) { if (MIX_TWICE & 1) sgu_item(P, L, cur * 8 + x, lds, tid); }
        else if (cur < 80) { if (MIX_TWICE & 2) conv_item(P, L, (cur - 16) * 8 + x, lds, tid); }
        else if (cur < 176) { if (MIX_TWICE & 4) { const int li = cur - 80; qkv_item(P, L, true, (li / 6) * 8 + x, li % 6, lds, tid); } }
        else { if (MIX_TWICE & 8) { const int li = cur - 176; qkv_item(P, L, false, (li >> 3) * 8 + x, li & 7, lds, tid); } }
#endif
        if (cur < 16) { if (mask & 1) sgu_item(P, L, cur * 8 + x, lds, tid); }
        else if (cur < 80) { if (mask & 2) conv_item(P, L, (cur - 16) * 8 + x, lds, tid); }
        else if (cur < 176) { if (mask & 4) { const int li = cur - 80; qkv_item(P, L, true, (li / 6) * 8 + x, li % 6, lds, tid); } }
        else { if (mask & 8) { const int li = cur - 176; qkv_item(P, L, false, (li >> 3) * 8 + x, li & 7, lds, tid); } }
        if (tid == 0) *slot = nxt;
        __syncthreads();
        cur = *slot;
        __syncthreads();
    }
}

__global__ void k_shim_qkv(Params P, int t0, float* q, float* kv) {
    const WS& w = P.w;
    size_t idx = (size_t)blockIdx.x * blockDim.x + threadIdx.x;
    if (idx >= (size_t)2048 * 1792) return;
    const int tl = (int)(idx / 1792), c = (int)(idx % 1792), t = t0 + tl, b = t >> 11, s = t & 2047;
    if (c < 768) { const int h = c / 96, d = c % 96; q[(size_t)tl * 768 + c] = bf2f(w.Qb[((size_t)(b * 8 + h) * 2048 + s) * 96 + d]) * (1.f / QSCALE); }
    else {
        const int cc = c - 768, h = cc >> 7, d = cc & 127;
        kv[(size_t)tl * 1024 + cc] = (d < 64) ? bf2f(w.Knb[((size_t)(b * 8 + h) * 2048 + s) * 64 + d]) : bf2f(w.VTb[((size_t)(b * 8 + h) * 64 + (d - 64)) * 2048 + s]);
    }
}
__global__ void k_shim_y(Params P, int t0, int c0, int c1) {
    const int wdt = c1 - c0;
    size_t idx = (size_t)blockIdx.x * blockDim.x + threadIdx.x;
    if (idx >= (size_t)2048 * wdt) return;
    const int tl = (int)(idx / wdt), c = c0 + (int)(idx % wdt);
    P.yf[(size_t)tl * 1024 + c] = bf2f(P.w.yb[(size_t)(t0 + tl) * 1024 + c]);
}

}
namespace fx {

constexpr int AKN = 0, AKP = 8192, AVT = 12288, ATT_STAGE = 20480;
__device__ __forceinline__ void att_issue(const bf16_t* Kn, const bf16_t* Kp, const bf16_t* Vt, int k0, char* st, const int tid, const int wbase) {
    {
        const int row = tid >> 3, ch = (tid & 7) ^ ((tid >> 4) & 7);
        glds16(Kn + (size_t)(k0 + row) * 64 + ch * 8, st + AKN + wbase);
        glds16(Kn + (size_t)(k0 + row + 32) * 64 + ch * 8, st + AKN + 4096 + wbase);
    }
    {
        const int row = tid >> 2, ch = (tid & 3) ^ ((tid >> 4) & 3);
        glds16(Kp + (size_t)(k0 + row) * 32 + ch * 8, st + AKP + wbase);
    }
    {
        const int d = tid >> 3, ch = (tid & 7) ^ ((tid >> 4) & 7);
        glds16(Vt + (size_t)d * 2048 + k0 + ch * 8, st + AVT + wbase);
        glds16(Vt + (size_t)(d + 32) * 2048 + k0 + ch * 8, st + AVT + 4096 + wbase);
    }
}

__device__ void attn_unit(const Params& P, int b, int h, int qt, char* lds, const int tid) {
    const WS& w = P.w;
    const int lane = tid & 63, wid = tid >> 6, fr = lane & 31, fh = lane >> 5;
    const int wbase = __builtin_amdgcn_readfirstlane(wid) * 1024;
    const bf16_t* Kn = w.Knb + (size_t)(b * 8 + h) * 2048 * 64;
    const bf16_t* Kp = w.kpeb + (size_t)b * 2048 * 32;
    const bf16_t* Vt = w.VTb + (size_t)(b * 8 + h) * 64 * 2048;
    const int q0 = qt * 128, qw0 = q0 + wid * 32, qpos = qw0 + fr;
    bf16x8 qf[6];
    {
        const bf16_t* qp = w.Qb + ((size_t)(b * 8 + h) * 2048 + qpos) * 96 + 8 * fh;
#pragma unroll
        for (int ks = 0; ks < 6; ++ks) qf[ks] = *(const bf16x8*)(qp + 16 * ks);
    }
    f32x16 o0, o1;
#pragma unroll
    for (int r = 0; r < 16; ++r) { o0[r] = 0.f; o1[r] = 0.f; }
    float m = -1e30f, l = 0.f;
    const int nkt = 2 * (qt + 1);
    asm volatile("s_waitcnt vmcnt(0)" ::: "memory");
    att_issue(Kn, Kp, Vt, 0, lds, tid, wbase);
    if (nkt > 1) att_issue(Kn, Kp, Vt, 64, lds + ATT_STAGE, tid, wbase);
    const int kn0 = AKN + fr * 128, kn1 = AKN + (32 + fr) * 128, swn = (fr >> 1) & 7;
    const int kp0 = AKP + fr * 64, kp1 = AKP + (32 + fr) * 64, swp = (fr >> 2) & 3;
    const int vt0 = AVT + fr * 128 + 8 * fh, vt1 = AVT + (32 + fr) * 128 + 8 * fh, swv = (fr >> 1) & 7;
#pragma unroll 1
    for (int kt = 0; kt < nkt; ++kt) {
        if (kt + 1 < nkt) asm volatile("s_waitcnt vmcnt(5)" ::: "memory"); else asm volatile("s_waitcnt vmcnt(0)" ::: "memory");
        RAW_BARRIER();
        if (kt + 2 < nkt) att_issue(Kn, Kp, Vt, (kt + 2) * 64, lds + ((kt + 2) % 3) * ATT_STAGE, tid, wbase);
        const char* cur = lds + (kt % 3) * ATT_STAGE;
        const int k0 = kt * 64;
        if (k0 <= qw0 + 31) {
            f32x16 s0, s1;
#pragma unroll
            for (int r = 0; r < 16; ++r) { s0[r] = 0.f; s1[r] = 0.f; }
            {
                bf16x8 ka[6], kc[6];
#pragma unroll
                for (int ks = 0; ks < 4; ++ks) {
                    const int off = ((2 * ks + fh) ^ swn) << 4;
                    ka[ks] = *(const bf16x8*)(cur + kn0 + off); kc[ks] = *(const bf16x8*)(cur + kn1 + off);
                }
#pragma unroll
                for (int ks = 4; ks < 6; ++ks) {
                    const int off = ((2 * (ks - 4) + fh) ^ swp) << 4;
                    ka[ks] = *(const bf16x8*)(cur + kp0 + off); kc[ks] = *(const bf16x8*)(cur + kp1 + off);
                }
                __builtin_amdgcn_sched_barrier(0);
#pragma unroll
                for (int ks = 0; ks < 6; ++ks) {
                    s0 = __builtin_amdgcn_mfma_f32_32x32x16_bf16(ka[ks], qf[ks], s0, 0, 0, 0);
                    s1 = __builtin_amdgcn_mfma_f32_32x32x16_bf16(kc[ks], qf[ks], s1, 0, 0, 0);
                }
            }
            uint2 va0[4], va1[4], vb0[4], vb1[4];
#pragma unroll
            for (int ks = 0; ks < 4; ++ks) {
                const int c0 = ((2 * ks) ^ swv) << 4, c1 = ((2 * ks + 1) ^ swv) << 4;
                va0[ks] = *(const uint2*)(cur + vt0 + c0); va1[ks] = *(const uint2*)(cur + vt0 + c1);
                vb0[ks] = *(const uint2*)(cur + vt1 + c0); vb1[ks] = *(const uint2*)(cur + vt1 + c1);
            }
            __builtin_amdgcn_sched_barrier(0);
            if (k0 + 63 > qw0) {
#pragma unroll
                for (int r = 0; r < 16; ++r) {
                    const int key = k0 + nidx(r, fh);
                    if (key > qpos) s0[r] = -1e30f;
                    if (key + 32 > qpos) s1[r] = -1e30f;
                }
            }
            float mx = s0[0];
#pragma unroll
            for (int r = 1; r < 16; ++r) mx = fmaxf(mx, s0[r]);
#pragma unroll
            for (int r = 0; r < 16; ++r) mx = fmaxf(mx, s1[r]);
            mx = swap32_max(mx);
            const float mn = fmaxf(m, mx);
            const float alpha = __builtin_amdgcn_exp2f(m - mn);
            m = mn;
            float ps = 0.f;
#pragma unroll
            for (int r = 0; r < 16; ++r) { s0[r] = __builtin_amdgcn_exp2f(s0[r] - mn); ps += s0[r]; }
#pragma unroll
            for (int r = 0; r < 16; ++r) { s1[r] = __builtin_amdgcn_exp2f(s1[r] - mn); ps += s1[r]; }
            ps = swap32_sum(ps);
            l = l * alpha + ps;
#pragma unroll
            for (int r = 0; r < 16; ++r) { o0[r] *= alpha; o1[r] *= alpha; }
#pragma unroll
            for (int ks = 0; ks < 4; ++ks) {
                bf16x8 pf;
                {
                    const int rb = 8 * (ks & 1);
                    unsigned u0, u1, u2, u3;
                    if (ks < 2) { u0 = pack2(s0[rb], s0[rb + 1]); u1 = pack2(s0[rb + 2], s0[rb + 3]); u2 = pack2(s0[rb + 4], s0[rb + 5]); u3 = pack2(s0[rb + 6], s0[rb + 7]); }
                    else { u0 = pack2(s1[rb], s1[rb + 1]); u1 = pack2(s1[rb + 2], s1[rb + 3]); u2 = pack2(s1[rb + 4], s1[rb + 5]); u3 = pack2(s1[rb + 6], s1[rb + 7]); }
                    uint4 uu = make_uint4(u0, u1, u2, u3);
                    pf = __builtin_bit_cast(bf16x8, uu);
                }
                const bf16x8 vfa = __builtin_bit_cast(bf16x8, make_uint4(va0[ks].x, va0[ks].y, va1[ks].x, va1[ks].y));
                const bf16x8 vfb = __builtin_bit_cast(bf16x8, make_uint4(vb0[ks].x, vb0[ks].y, vb1[ks].x, vb1[ks].y));
                o0 = __builtin_amdgcn_mfma_f32_32x32x16_bf16(vfa, pf, o0, 0, 0, 0);
                o1 = __builtin_amdgcn_mfma_f32_32x32x16_bf16(vfb, pf, o1, 0, 0, 0);
            }
        }
    }
    RAW_BARRIER();
    const float inv = 1.f / l;
    const int tok = b * 2048 + qpos;
    float ssq = 0.f;
#pragma unroll
    for (int dt = 0; dt < 2; ++dt)
#pragma unroll
        for (int g = 0; g < 4; ++g) {
            float o[4];
#pragma unroll
            for (int q = 0; q < 4; ++q) { o[q] = (dt == 0 ? o0[4 * g + q] : o1[4 * g + q]) * inv; ssq += o[q] * o[q]; }
            store4(w.yb + (size_t)tok * 1024 + 512 + h * 64 + dt * 32 + 8 * g + 4 * fh, o[0], o[1], o[2], o[3]);
        }
    ssq = xor32(ssq);
    if (fh == 0) w.ssq[(size_t)tok * 16 + 8 + h] = ssq;
}

__device__ void phase_attn(const Params& P, int L, char* lds) {
    const int tid0 = opaque_tid();
    const int h = blockIdx.x & 7, nlb = gridDim.x >> 3;
    for (int li = blockIdx.x >> 3; li < 64; li += nlb) {
        int tid = tid0; asm volatile("" : "+v"(tid));
        const int p = li & 7, b = li >> 3;
        attn_unit(P, b, h, 15 - p, lds, tid);
        attn_unit(P, b, h, p, lds, tid);
    }
}

}
namespace fx {

__device__ __forceinline__ void acc_scale(f32x16 (&acc)[2][2], const float* f, const int tid) {
    const int lane = tid & 63, wr = tid >> 7, fr = lane & 31;
#pragma unroll
    for (int i = 0; i < 2; ++i) {
        const float v = f[wr * 64 + i * 32 + fr];
#pragma unroll
        for (int j = 0; j < 2; ++j)
#pragma unroll
            for (int r = 0; r < 16; ++r) acc[i][j][r] *= v;
    }
}
__device__ void phase_oproj(const Params& P, int L, char* lds, const bool dry = false) {
    const WS& w = P.w;
    const int tid0 = opaque_tid();
    float* T = (float*)lds; float* stat = (float*)(lds + STAT_OFF);
    const bf16_t* Wt = w.Wot + L * WO_SZ;
    int mt, nt;
    for (int it = 0; xcd_item(it, 128, 8, mt, nt); ++it) {
        int tid = tid0; asm volatile("" : "+v"(tid));
        const int lane = tid & 63, wid = tid >> 6;
        const int m0 = mt * 128, n0 = nt * 128;
        float rb_keep = 0.f;
        if (tid < 128) {
            const float* sq = w.ssq + (size_t)(m0 + tid) * 16;
            const float4 c0 = *(const float4*)(sq + 8), c1 = *(const float4*)(sq + 12);
            const float ra = rsq_(sq[0] * (1.f / 256.f) + EPS), rb = rsq_(sq[1] * (1.f / 256.f) + EPS);
            const float rc = rsq_((c0.x + c0.y + c0.z + c0.w + c1.x + c1.y + c1.z + c1.w) * (1.f / 512.f) + EPS);
            stat[tid] = rc / ra; stat[128 + tid] = ra / rb; rb_keep = rb;
        }
        {
            const bf16_t* arow[2]; const bf16_t* wrow[2];
#pragma unroll
            for (int i = 0; i < 2; ++i) {
                arow[i] = w.yb + (size_t)(m0 + (tid >> 2) + 64 * i) * 1024 + gl_chunk(tid) * 8;
                wrow[i] = Wt + (size_t)(n0 + (tid >> 2) + 64 * i) * 1024 + gl_chunk(tid) * 8;
            }
            f32x16 acc[2][2]; acc_zero(acc);
            gemm_mainloop_g<true>(acc, arow, wrow, 32, lds, tid, 16, 16, stat, 24, stat + 128);
            if (tid < 128) stat[tid] = rb_keep;
            acc_to_lds(acc, T, tid);
        }
        {
            const int sub = lane >> 4, c8 = (lane & 15) * 8;
            float4 hv0[8], hv1[8];
            if (L == 0) {
#pragma unroll
                for (int rr = 0; rr < 8; ++rr) {
                    const float4* hin = (const float4*)(P.in.x + (size_t)(m0 + wid * 32 + rr * 4 + sub) * 1024 + n0 + c8);
                    hv0[rr] = hin[0]; hv1[rr] = hin[1];
                }
            } else {
#pragma unroll
                for (int rr = 0; rr < 8; ++rr) {
                    const uint4 hh = *(const uint4*)(w.hb + (size_t)(m0 + wid * 32 + rr * 4 + sub) * 1024 + n0 + c8);
                    hv0[rr] = make_float4(bflo(hh.x), bfhi(hh.x), bflo(hh.y), bfhi(hh.y)); hv1[rr] = make_float4(bflo(hh.z), bfhi(hh.z), bflo(hh.w), bfhi(hh.w));
                }
            }
#pragma unroll
            for (int rr = 0; rr < 8; ++rr) {
                const int row = wid * 32 + rr * 4 + sub; const float rb = stat[row];
                const float4 x0 = *(const float4*)(T + row * TLD + c8), x1 = *(const float4*)(T + row * TLD + c8 + 4);
                float4 h0 = hv0[rr], h1 = hv1[rr];
                h0.x += x0.x * rb; h0.y += x0.y * rb; h0.z += x0.z * rb; h0.w += x0.w * rb;
                h1.x += x1.x * rb; h1.y += x1.y * rb; h1.z += x1.z * rb; h1.w += x1.w * rb;
                *(uint4*)(w.hb1 + (size_t)(m0 + row) * 1024 + n0 + c8) = pack8(h0, h1);
                const float sq = grp_sum16(sq8(h0, h1));
                if ((lane & 15) == 0) w.rssB[(size_t)(m0 + row) * 8 + nt] = sq;
            }
        }
        __syncthreads();
    }
}

__device__ void router_item(const Params& P, int L, int mt, char* lds, const int tid_in, const bool dry) {
    int tid = tid_in; asm volatile("" : "+v"(tid));
    const WS& w = P.w; const nv::Inputs& in = P.in;
    float* T = (float*)lds; float* stat = (float*)(lds + STAT_OFF); int* hist = (int*)(lds + STAT_OFF + 1024);
    const int m0 = mt * 128;
    {
        const bf16_t* arow[2]; const bf16_t* wrow[2];
#pragma unroll
        for (int i = 0; i < 2; ++i) {
            arow[i] = w.hb1 + (size_t)(m0 + (tid >> 2) + 64 * i) * 1024 + gl_chunk(tid) * 8;
            wrow[i] = w.Wrt + L * WR_SZ + (size_t)((tid >> 2) + 64 * i) * 1024 + gl_chunk(tid) * 8;
        }
        f32x16 acc[2][2]; acc_zero(acc);
        float my_rs = 0.f;
        if (tid < 128) my_rs = rstd8(w.rssB + (size_t)(m0 + tid) * 8, 1.f / 1024.f);
        gemm_mainloop_g(acc, arow, wrow, 32, lds, tid);
        if (tid < 128) stat[tid] = my_rs;
        if (tid < 64) hist[tid] = 0;
        acc_to_lds(acc, T, tid);
    }
    int e0 = 0, e1 = 0, r0 = 0, r1 = 0; float w0 = 0.f, w1 = 0.f;
    if (tid < 128) {
        const float rs = stat[tid];
        const float* lr = T + tid * TLD;
        const float* bg = in.router_group_b + L * 4; const float* be = in.router_expert_b + L * 32;
        int gi = 0; float gm = lr[0] * rs + bg[0];
#pragma unroll
        for (int j = 1; j < 4; ++j) { const float v = lr[j] * rs + bg[j]; if (v > gm) { gm = v; gi = j; } }
        float gs = 0.f;
#pragma unroll
        for (int j = 0; j < 4; ++j) gs += __builtin_amdgcn_exp2f(1.4426950408889634f * (lr[j] * rs + bg[j] - gm));
        const float gw = 1.f / gs;
        int i0 = 0, i1 = -1; float v0 = -3.0e38f, v1 = -3.0e38f;
#pragma unroll
        for (int j = 0; j < 8; ++j) {
            const float v = lr[4 + gi * 8 + j] * rs + be[gi * 8 + j];
            if (v > v0) { v1 = v0; i1 = i0; v0 = v; i0 = j; } else if (v > v1) { v1 = v; i1 = j; }
        }
        const float ex = __builtin_amdgcn_exp2f(1.4426950408889634f * (v1 - v0));
        w0 = gw / (1.f + ex); w1 = gw * ex / (1.f + ex);
        e0 = gi * 8 + i0; e1 = gi * 8 + i1;
        e0 = e0 * 2; e1 = e1 * 2 + 1;
        r0 = atomicAdd(&hist[e0], 1); r1 = atomicAdd(&hist[e1], 1);
    }
    __syncthreads();
    if (tid < 64) hist[64 + tid] = (hist[tid] && !dry) ? atomicAdd(&w.cnt[L * 256 + tid], hist[tid]) : 0;
    __syncthreads();
    if (tid < 128 && !dry) {
        const int tok = m0 + tid;
        const int p0 = hist[64 + e0] + r0, p1 = hist[64 + e1] + r1;
        w.elist[(size_t)e0 * NT + p0] = tok; w.ewt[(size_t)e0 * NT + p0] = w0;
        w.elist[(size_t)e1 * NT + p1] = tok; w.ewt[(size_t)e1 * NT + p1] = w1;
    }
    __syncthreads();
}
__device__ void eraw_item(const Params& P, int L, const int mt, const int nt, char* lds, const int tid_in) {
    int tid = tid_in; asm volatile("" : "+v"(tid));
    const WS& w = P.w; const nv::Inputs& in = P.in;
    const int lane = tid & 63, wid = tid >> 6;
    float* T = (float*)lds;
    const int m0 = mt * 128, n0 = nt * 128;
    {
        const float* arow[4]; const bf16_t* wrow[4];
#pragma unroll
        for (int i = 0; i < 4; ++i) {
            arow[i] = in.p + ((size_t)L * NT + m0 + (tid >> 3) + 32 * i) * 256 + (tid & 7) * 8;
            wrow[i] = w.Wpt + L * WP_SZ + (size_t)(n0 + (tid >> 3) + 32 * i) * 256 + (tid & 7) * 8;
        }
        f32x16 acc[2][2]; acc_zero(acc);
        float ss[4] = {0.f, 0.f, 0.f, 0.f};
        gemm_mainloop<float, false>(acc, arow, wrow, 4, lds, ss, tid);
        acc_to_lds(acc, T, tid);
    }
    {
        const int sub = lane >> 4, l16 = lane & 15, c8 = l16 * 8;
#pragma unroll 8
        for (int rr = 0; rr < 8; ++rr) {
            const int row = wid * 32 + rr * 4 + sub;
            const float4 x0 = *(const float4*)(T + row * TLD + c8), x1 = *(const float4*)(T + row * TLD + c8 + 4);
            *(uint4*)(w.erb + (size_t)(m0 + row) * 1024 + n0 + c8) = pack8(x0, x1);
            const float sq = grp_sum16(sq8(x0, x1));
            if (l16 == 0) w.essq[(size_t)(m0 + row) * 8 + nt] = sq;
        }
    }
    __syncthreads();
}
__device__ void phase_router(const Params& P, int L, char* lds, const bool dry = false) {
    const int tid = opaque_tid();
    {
        const int x = blockIdx.x & 7, lb = blockIdx.x >> 3, nlb = gridDim.x >> 3;
        if (lb < 16 || nlb <= 16) { for (int j = lb; j < 16; j += nlb) router_item(P, L, j * 8 + x, lds, tid, dry); }
        if (!dry) {
            if (nlb > 16) { if (lb >= 16) prep_moe_late(P, L, lds, tid, (lb - 16) * 8 + x, (nlb - 16) * 8); }
            else prep_moe_late(P, L, lds, tid, blockIdx.x, gridDim.x);
        }
    }
}

constexpr int TT_OFF = STAT_OFF + 1024;
__device__ __forceinline__ void moe_table(const Params& P, int L, char* lds, const int tid) {
    int* tt = (int*)(lds + TT_OFF);
    if (tid == 0) {
        const int x = blockIdx.x & 7;
        int o = 0;
        for (int li = 0; li < 64; ++li) { tt[li] = o; o += P.w.cnt[L * 256 + li]; }
        tt[64] = o;
        int t = 0, t0 = 0, t1 = 0;
        for (int k = 0; k < 8; ++k) {
            const int li = ((k >> 1) * 8 + x) * 2 + (k & 1), nt_ = (P.w.cnt[L * 256 + li] + 127) >> 7;
            tt[72 + k] = t; t += nt_;
            if (k & 1) { tt[92 + (k >> 1)] = t1; t1 += nt_; } else { tt[84 + (k >> 1)] = t0; t0 += nt_; }
        }
        tt[80] = t; tt[88] = t0; tt[96] = t1;
    }
    __syncthreads();
}
__device__ __forceinline__ void moe_find(const int* tt, int tile, int& li, int& t) {
    int k = 0;
#pragma unroll
    for (int j = 1; j < 8; ++j) if (tile >= tt[72 + j]) k = j;
    li = ((k >> 1) * 8 + (blockIdx.x & 7)) * 2 + (k & 1); t = tile - tt[72 + k];
}
__device__ __forceinline__ void moe_find_slot(const int* tt, int slot, int tile, int& li, int& t) {
    const int* tp = tt + (slot ? 92 : 84);
    int k = 0;
#pragma unroll
    for (int j = 1; j < 4; ++j) if (tile >= tp[j]) k = j;
    li = (k * 8 + (blockIdx.x & 7)) * 2 + slot; t = tile - tp[k];
}
__device__ void phase_moe_up(const Params& P, int L, char* lds, const bool noeraw = false) {
    const WS& w = P.w;
    const int tid0 = opaque_tid();
    float* T = (float*)lds; float* stat = (float*)(lds + STAT_OFF); const int* tt = (const int*)(lds + TT_OFF);
    moe_table(P, L, lds, tid0);
    const int ntiles = tt[80];
    for (int item = blockIdx.x >> 3; item < ntiles * 4; item += (gridDim.x >> 3)) {
        int tid = tid0; asm volatile("" : "+v"(tid));
        const int lane = tid & 63, wid = tid >> 6;
        const int tile = item >> 2, nt = item & 3;
        int li, t; moe_find(tt, tile, li, t);
        const int e = li >> 1;
        const int cnt = P.w.cnt[L * 256 + li], rbase = tt[li] + t * 128, nrows = min(128, cnt - t * 128);
        {
            const bf16_t* arow[2]; const bf16_t* wrow[2];
#pragma unroll
            for (int i = 0; i < 2; ++i) {
                const int r = (tid >> 2) + 64 * i;
                const int tok = w.elist[(size_t)li * NT + t * 128 + (r < nrows ? r : 0)];
                arow[i] = w.hb1 + (size_t)tok * 1024 + gl_chunk(tid) * 8;
                wrow[i] = w.Wgut + L * WGU_SZ + ((size_t)e * 512 + nt * 128 + r) * 1024 + gl_chunk(tid) * 8;
            }
            f32x16 acc[2][2]; acc_zero(acc);
            float my_rs = 0.f;
            if (tid < 128) {
                const int tok = w.elist[(size_t)li * NT + t * 128 + (tid < nrows ? tid : 0)];
                my_rs = rstd8(w.rssB + (size_t)tok * 8, 1.f / 1024.f);
            }
            gemm_mainloop_g(acc, arow, wrow, 32, lds, tid);
            if (tid < 128) stat[tid] = my_rs;
            acc_to_lds(acc, T, tid);
        }
        {
            const int sub = lane >> 4, l16 = lane & 15, c8 = l16 * 8;
#pragma unroll 8
            for (int rr = 0; rr < 8; ++rr) {
                const int row = wid * 32 + rr * 4 + sub; const float rs = stat[row];
                const float4 x0 = mul4(*(const float4*)(T + row * TLD + c8), rs), x1 = mul4(*(const float4*)(T + row * TLD + c8 + 4), rs);
                if (row < nrows)
                    store4(w.hbuf + (size_t)(rbase + row) * 256 + nt * 64 + l16 * 4, x0.x * sigmoid_(x0.x) * x0.y, x0.z * sigmoid_(x0.z) * x0.w,
                           x1.x * sigmoid_(x1.x) * x1.y, x1.z * sigmoid_(x1.z) * x1.w);
            }
        }
        __syncthreads();
    }
    if (!noeraw) {
        int* qslot = (int*)(lds + TT_OFF + 256);
        for (;;) {
            if (tid0 == 0) *qslot = atomicAdd(&P.w.cnt[L * 256 + 64], 1);
            __syncthreads();
            const int item = *qslot;
            __syncthreads();
            if (item >= 1024) break;
            eraw_item(P, L, item >> 3, item & 7, lds, tid0);
        }
    }
}
__device__ void phase_moe_down(const Params& P, int L, char* lds, const int slot, const bool dry = false) {
    const WS& w = P.w;
    const int tid0 = opaque_tid();
    float* T = (float*)lds; float* stat = (float*)(lds + STAT_OFF); const int* tt = (const int*)(lds + TT_OFF);
    moe_table(P, L, lds, tid0);
    const int ntiles = tt[slot ? 96 : 88];
    for (int item = blockIdx.x >> 3; item < ntiles * 8; item += (gridDim.x >> 3)) {
        int tid = tid0; asm volatile("" : "+v"(tid));
        const int lane = tid & 63, wid = tid >> 6;
        const int tile = item >> 3, nt = item & 7;
        int li, t; moe_find_slot(tt, slot, tile, li, t);
        const int e = li >> 1;
        const int cnt = P.w.cnt[L * 256 + li], rbase = tt[li] + t * 128, nrows = min(128, cnt - t * 128);
        {
            const bf16_t* arow[2]; const bf16_t* wrow[2];
#pragma unroll
            for (int i = 0; i < 2; ++i) {
                const int r = (tid >> 2) + 64 * i;
                arow[i] = w.hbuf + (size_t)(rbase + (r < nrows ? r : 0)) * 256 + gl_chunk(tid) * 8;
                wrow[i] = w.Wdt + L * WD_SZ + ((size_t)e * 1024 + nt * 128 + r) * 256 + gl_chunk(tid) * 8;
            }
            f32x16 acc[2][2]; acc_zero(acc);
            int my_tok = 0; float my_wt = 0.f;
            if (tid < 128) { const int rr2 = tid < nrows ? tid : 0; my_tok = w.elist[(size_t)li * NT + t * 128 + rr2]; my_wt = w.ewt[(size_t)li * NT + t * 128 + rr2]; }
            gemm_mainloop_g(acc, arow, wrow, 8, lds, tid);
            if (tid < 128) { ((int*)stat)[tid] = my_tok; stat[128 + tid] = my_wt; }
            acc_to_lds(acc, T, tid);
        }
        {
            const int sub = lane >> 4, l16 = lane & 15, c8 = l16 * 8;
            uint4 hh[8];
#pragma unroll
            for (int rr = 0; rr < 8; ++rr) hh[rr] = *(const uint4*)(w.hb1 + (size_t)((const int*)stat)[wid * 32 + rr * 4 + sub] * 1024 + nt * 128 + c8);
#pragma unroll
            for (int rr = 0; rr < 8; ++rr) {
                const int row = wid * 32 + rr * 4 + sub;
                const int tok = ((const int*)stat)[row]; const float wt = stat[128 + row];
                const float4 x0 = *(const float4*)(T + row * TLD + c8), x1 = *(const float4*)(T + row * TLD + c8 + 4);
                const uint4 h = hh[rr];
                float4 h0, h1;
                h0.x = bflo(h.x) + wt * x0.x; h0.y = bfhi(h.x) + wt * x0.y; h0.z = bflo(h.y) + wt * x0.z; h0.w = bfhi(h.y) + wt * x0.w;
                h1.x = bflo(h.z) + wt * x1.x; h1.y = bfhi(h.z) + wt * x1.y; h1.z = bflo(h.w) + wt * x1.z; h1.w = bfhi(h.w) + wt * x1.w;
                const float sq = grp_sum16(sq8(h0, h1));
                if (row < nrows && !dry) {
                    *(uint4*)(w.hb1 + (size_t)tok * 1024 + nt * 128 + c8) = pack8(h0, h1);
                    if (slot && l16 == 0) w.rssB[(size_t)tok * 8 + nt] = sq;
                }
            }
        }
        __syncthreads();
    }
}

__device__ void phase_ple(const Params& P, int L, char* lds, const bool dry = false) {
    const WS& w = P.w; const nv::Inputs& in = P.in;
    const int tid0 = opaque_tid();
    float* T = (float*)lds; float* stat = (float*)(lds + STAT_OFF);
    int mt, nt;
    for (int it = 0; xcd_item(it, 128, 8, mt, nt); ++it) {
        int tid = tid0; asm volatile("" : "+v"(tid));
        const int lane = tid & 63, wid = tid >> 6;
        const int m0 = mt * 128, n0 = nt * 128;
        {
            const bf16_t* arow[2]; const bf16_t* wrow[2];
#pragma unroll
            for (int i = 0; i < 2; ++i) {
                arow[i] = w.hb1 + (size_t)(m0 + (tid >> 2) + 64 * i) * 1024 + gl_chunk(tid) * 8;
                wrow[i] = w.Wgt + L * WG_SZ + (size_t)(n0 + (tid >> 2) + 64 * i) * 1024 + gl_chunk(tid) * 8;
            }
            f32x16 acc[2][2]; acc_zero(acc);
            float my_rs = 0.f, my_re = 0.f;
            if (tid < 128) { my_rs = rstd8(w.rssB + (size_t)(m0 + tid) * 8, 1.f / 1024.f); my_re = rstd8(w.essq + (size_t)(m0 + tid) * 8, 1.f / 1024.f); }
            gemm_mainloop_g(acc, arow, wrow, 32, lds, tid);
            if (tid < 128) { stat[tid] = my_rs; stat[128 + tid] = my_re; }
            acc_to_lds(acc, T, tid);
        }
        {
            const int sub = lane >> 4, l16 = lane & 15, c8 = l16 * 8;
            const float4 pg0 = *(const float4*)(in.ple_post_norm_g + L * 1024 + n0 + c8), pg1 = *(const float4*)(in.ple_post_norm_g + L * 1024 + n0 + c8 + 4);
            uint4 hhv[8], erv[8];
#pragma unroll
            for (int rr = 0; rr < 8; ++rr) {
                const size_t off = (size_t)(m0 + wid * 32 + rr * 4 + sub) * 1024 + n0 + c8;
                hhv[rr] = *(const uint4*)(w.hb1 + off); erv[rr] = *(const uint4*)(w.erb + off);
            }
#pragma unroll
            for (int rr = 0; rr < 8; ++rr) {
                const int row = wid * 32 + rr * 4 + sub; const float rs = stat[row], re = stat[128 + row]; const size_t tok = m0 + row;
                const float4 x0 = mul4(*(const float4*)(T + row * TLD + c8), rs), x1 = mul4(*(const float4*)(T + row * TLD + c8 + 4), rs);
                const size_t off = tok * 1024 + n0 + c8;
                const uint4 er = erv[rr], hh = hhv[rr];
                float4 h0, h1;
                h0.x = bflo(hh.x) + sigmoid_(x0.x) * (bflo(er.x) * re * pg0.x); h0.y = bfhi(hh.x) + sigmoid_(x0.y) * (bfhi(er.x) * re * pg0.y);
                h0.z = bflo(hh.y) + sigmoid_(x0.z) * (bflo(er.y) * re * pg0.z); h0.w = bfhi(hh.y) + sigmoid_(x0.w) * (bfhi(er.y) * re * pg0.w);
                h1.x = bflo(hh.z) + sigmoid_(x1.x) * (bflo(er.z) * re * pg1.x); h1.y = bfhi(hh.z) + sigmoid_(x1.y) * (bfhi(er.z) * re * pg1.y);
                h1.z = bflo(hh.w) + sigmoid_(x1.z) * (bflo(er.w) * re * pg1.z); h1.w = bfhi(hh.w) + sigmoid_(x1.w) * (bfhi(er.w) * re * pg1.w);
                if (L == 1) { float4* op = (float4*)(P.h + off); op[0] = h0; op[1] = h1; }
                else {
                    *(uint4*)(w.hb + off) = pack8(h0, h1);
                    const float sq = grp_sum16(sq8(h0, h1));
                    if (l16 == 0) w.rssA[tok * 8 + nt] = sq;
                }
            }
        }
        __syncthreads();
    }
}

}
namespace fx {
#define XB_TMO      128
#define XB_XCNT(j)  (256  + 64 * (j))
#define XB_XSUB(j)  (1280 + 64 * (j))
#define XB_XGEN(j)  (2304 + 64 * (j))
#define XB_TOP      3328
#define XB_TOPGEN   3392
#define XCD_BAR_WORDS 3456
#define XB_SPIN_CAP (1u << 18)
#define LAS __attribute__((address_space(3)))
__device__ __forceinline__ unsigned xb_ld(unsigned* p)              { return __hip_atomic_load(p, __ATOMIC_RELAXED, __HIP_MEMORY_SCOPE_AGENT); }
__device__ __forceinline__ unsigned xb_add(unsigned* p, unsigned v) { return __hip_atomic_fetch_add(p, v, __ATOMIC_RELAXED, __HIP_MEMORY_SCOPE_AGENT); }
__device__ __forceinline__ unsigned xb_xcc_id() { return (unsigned)__builtin_amdgcn_s_getreg((3 << 11) | 20) & 0xFu; }
#define XB_SPIN(cond, bar) do { unsigned _sp = 0; while (cond) { __builtin_amdgcn_s_sleep(1); \
    if ((++_sp & 255u) == 0u) { if (xb_ld(&(bar)[XB_TMO])) break; if (_sp > XB_SPIN_CAP) { atomicAdd(&(bar)[XB_TMO], 1u); break; } } } } while (0)
struct XcdBarrier { unsigned* bar; unsigned x; volatile LAS unsigned* st; };
__device__ __forceinline__ XcdBarrier xcd_barrier_post(unsigned* bar, volatile LAS unsigned* st) {
    XcdBarrier b; b.bar = bar; b.x = xb_xcc_id(); b.st = st;
    if (threadIdx.x == 0) (void)xb_add(&bar[XB_XCNT(b.x)], 1u);
    return b;
}
__device__ __forceinline__ void xcd_barrier_complete(unsigned* bar, unsigned x, unsigned& nloc, unsigned& nx) {
    const unsigned G = gridDim.x * gridDim.y * gridDim.z;
    unsigned sum, cnt, mine, sp = 0u;
    for (;;) {
        sum = 0u; cnt = 0u; mine = 0u;
#pragma unroll
        for (unsigned j = 0; j < 16; ++j) { const unsigned c = xb_ld(&bar[XB_XCNT(j)]); sum += c; cnt += (c > 0u) ? 1u : 0u; mine = (j == x) ? c : mine; }
        if (sum == G) break;
        __builtin_amdgcn_s_sleep(1);
        if ((++sp & 255u) == 0u) { if (xb_ld(&bar[XB_TMO])) break; if (sp > XB_SPIN_CAP) { atomicAdd(&bar[XB_TMO], 1u); break; } }
    }
    nloc = mine > 0u ? mine : 1u; nx = cnt > 0u ? cnt : 1u;
}
__device__ __forceinline__ void xcd_barrier(const XcdBarrier& b) {
    asm volatile("s_waitcnt vmcnt(0)" ::: "memory");
    __syncthreads();
    if (threadIdx.x == 0) {
        unsigned* bar = b.bar;
        __builtin_amdgcn_s_waitcnt(0);
        unsigned nloc = b.st[0], nx = b.st[1];
        if (nloc == 0u) { xcd_barrier_complete(bar, b.x, nloc, nx); b.st[0] = nloc; b.st[1] = nx; }
        const unsigned old = xb_add(&bar[XB_XSUB(b.x)], 1u);
        const unsigned gen = old / nloc;
        if (old + 1u == (gen + 1u) * nloc) {
            __builtin_amdgcn_fence(__ATOMIC_RELEASE, "agent");
            asm volatile("s_waitcnt vmcnt(0)" ::: "memory");
            const unsigned og = xb_add(&bar[XB_TOP], 1u);
            const unsigned tg = og / nx;
            if (og + 1u == (tg + 1u) * nx) xb_add(&bar[XB_TOPGEN], 1u);
            else XB_SPIN(xb_ld(&bar[XB_TOPGEN]) == tg, bar);
            __builtin_amdgcn_fence(__ATOMIC_ACQUIRE, "agent");
            xb_add(&bar[XB_XGEN(b.x)], 1u);
            asm volatile("s_waitcnt vmcnt(0)" ::: "memory");
        } else {
            XB_SPIN(xb_ld(&bar[XB_XGEN(b.x)]) == gen, bar);
            __builtin_amdgcn_fence(__ATOMIC_ACQUIRE, "agent");
            asm volatile("s_waitcnt vmcnt(0)" ::: "memory");
        }
    }
    __syncthreads();
}

constexpr int LDS_BYTES = LDS_GEMM_BYTES + 16;
constexpr int N_PHASES = 19;
constexpr int PPL = 9;
__global__ void __launch_bounds__(256, 2) k_run(Params P, int ph_lo, int ph_hi) {
    extern __shared__ __attribute__((aligned(16))) char lds[];
    volatile LAS unsigned* st = (volatile LAS unsigned*)(lds + LDS_GEMM_BYTES);
    if (threadIdx.x == 0) { st[0] = 0u; st[1] = 0u; }
    __syncthreads();
    XcdBarrier xb = xcd_barrier_post(P.w.bar, st);
    for (int ph = ph_lo; ph < ph_hi; ++ph) {
        if (ph > ph_lo) xcd_barrier(xb);
        int reps = 1;
#ifdef REP_PHASE
        if (ph == 0 ? (REP_PHASE == 0) : (((ph - 1) % PPL) == REP_PHASE - 1)) reps = 2;
        asm volatile("" : "+s"(reps));
#endif
        for (int rep = 0; rep < reps; ++rep) {
            const bool dry = rep + 1 < reps;
            if (rep > 0) xcd_barrier(xb);
            if (ph == 0) phase_prep(P, lds);
            else {
                const int L = (ph - 1) / PPL, s = (ph - 1) % PPL;
                switch (s) {
                    case 0: phase_zgemm(P, L, lds); break;
                    case 1: phase_mix(P, L, lds, rep, dry); break;
                    case 2: phase_attn(P, L, lds); break;
                    case 3: phase_oproj(P, L, lds, dry); break;
                    case 4: phase_router(P, L, lds, dry); break;
                    case 5: phase_moe_up(P, L, lds, dry); break;
                    case 6: phase_moe_down(P, L, lds, 0, dry); break;
                    case 7: phase_moe_down(P, L, lds, 1, dry); break;
                    case 8: phase_ple(P, L, lds, dry); break;
                }
            }
        }
    }
}
}
#ifndef MK_N_LAUNCHES
#define MK_N_LAUNCHES 1
#endif
extern "C" void kernel_launch(void* const* d_in, const int* in_sizes, int n_in, void* d_out, int out_size, void* d_ws, size_t ws_size,
                              hipStream_t stream) {
    nv::Inputs in{};
    in.x = (const float*)d_in[0]; in.p = (const float*)d_in[1]; in.positions = (const int*)d_in[2];
    const float** f = &in.mix_norm_g;
    for (int i = 0; i < 32; ++i) f[i] = (const float*)d_in[3 + i];
    size_t used = 0;
    fx::WS w = fx::make_ws((char*)d_ws, used);
    static int grid = 0;
    if (grid == 0) {
        if (n_in != 35 || out_size != fx::NT * 1024 || used > ws_size) { fprintf(stderr, "kernel_launch: unexpected shapes / workspace (need %zu, have %zu)\n", used, ws_size); grid = -1; return; }
        if (hipFuncSetAttribute((const void*)fx::k_run, hipFuncAttributeMaxDynamicSharedMemorySize, fx::LDS_BYTES) != hipSuccess) { fprintf(stderr, "hipFuncSetAttribute failed\n"); grid = -1; return; }
        int dev = 0, cus = 0, per_cu = 0;
        hipGetDevice(&dev); hipDeviceGetAttribute(&cus, hipDeviceAttributeMultiprocessorCount, dev);
        hipOccupancyMaxActiveBlocksPerMultiprocessor(&per_cu, (const void*)fx::k_run, 256, fx::LDS_BYTES);
        if (per_cu > 2) per_cu = 2;
        if (per_cu < 1) { fprintf(stderr, "occupancy query says %d blocks/CU\n", per_cu); grid = -1; return; }
        grid = cus * per_cu;
    }
    if (grid < 0) return;
    fx::Params P{}; P.in = in; P.h = (float*)d_out; P.w = w;
    hipMemsetAsync(w.cnt, 0, 2 * 256 * 4, stream);
    hipMemsetAsync(w.bar, 0, XCD_BAR_WORDS * 4, stream);
    if (MK_N_LAUNCHES == 1) hipLaunchKernelGGL(fx::k_run, dim3(grid), dim3(256), fx::LDS_BYTES, stream, P, 0, fx::N_PHASES);
    else for (int ph = 0; ph < fx::N_PHASES; ++ph) hipLaunchKernelGGL(fx::k_run, dim3(grid), dim3(256), fx::LDS_BYTES, stream, P, ph, ph + 1);
}
```

```cpp
#include <hip/hip_runtime.h>
#include <hip/hip_bf16.h>
#include <stdint.h>
#include <cstdio>
namespace nv {
struct Inputs {
    const float *x, *p; const int* positions;
    const float *mix_norm_g, *w_in, *sgu_ln_g, *sgu_ln_b, *sgu_w, *sgu_b, *conv_w, *conv_b, *conv_ln_g, *conv_ln_b, *conv_pw_w, *conv_pw_b,
        *q_a_norm_g, *w_uq, *kv_a_norm_g, *w_ukv, *q_norm_g, *k_norm_g, *branch_norm_g, *w_o, *ffn_norm_g, *router_group_w, *router_group_b,
        *router_expert_w, *router_expert_b, *moe_w_gate, *moe_w_up, *moe_w_down, *ple_norm_g, *ple_gate_w, *ple_proj_w, *ple_post_norm_g;
};
}
namespace fx {

typedef unsigned short bf16_t;
typedef short bf16x8 __attribute__((ext_vector_type(8)));
typedef float f32x16 __attribute__((ext_vector_type(16)));
typedef float f32x4 __attribute__((ext_vector_type(4)));

constexpr int NT = 16384, SEQ = 2048, DM = 1024, NB = 8;
constexpr int ZN = 1536;
constexpr float EPS = 1e-6f;

typedef __bf16 bf16v2_t __attribute__((ext_vector_type(2)));
typedef float f32v2_t __attribute__((ext_vector_type(2)));
__device__ __forceinline__ unsigned pack2(float lo, float hi) {
    f32v2_t v; v.x = lo; v.y = hi;
    bf16v2_t b = __builtin_convertvector(v, bf16v2_t);
    return __builtin_bit_cast(unsigned, b);
}
__device__ __forceinline__ unsigned f2bf(float f) { return pack2(f, 0.f) & 0xffffu; }
__device__ __forceinline__ float bf2f(unsigned short b) { return __uint_as_float(((unsigned)b) << 16); }
__device__ __forceinline__ float bflo(unsigned u) { return __uint_as_float(u << 16); }
__device__ __forceinline__ float bfhi(unsigned u) { return __uint_as_float(u & 0xffff0000u); }
__device__ __forceinline__ float sigmoid_(float x) { return __builtin_amdgcn_rcpf(1.f + __builtin_amdgcn_exp2f(-1.4426950408889634f * x)); }
__device__ __forceinline__ float rsq_(float x) { return __builtin_amdgcn_rsqf(x); }
__device__ __forceinline__ float gelu_tanh_(float x) {
    float u = 0.7978845608028654f * (x + 0.044715f * x * x * x);
    return x * sigmoid_(2.f * u);
}
__device__ __forceinline__ int opaque_tid() { int t = threadIdx.x; asm volatile("" : "+v"(t)); return t; }
template <int CTRL> __device__ __forceinline__ float dpp_mov(float v) {
    return __builtin_bit_cast(float, __builtin_amdgcn_update_dpp(0, __builtin_bit_cast(int, v), CTRL, 0xf, 0xf, false));
}
__device__ __forceinline__ void swap16(float& a, float& b) { asm volatile("s_nop 1\n\tv_permlane16_swap_b32 %0, %1" : "+v"(a), "+v"(b)); }
__device__ __forceinline__ void swap32(float& a, float& b) { asm volatile("s_nop 1\n\tv_permlane32_swap_b32 %0, %1" : "+v"(a), "+v"(b)); }
__device__ __forceinline__ float swap16_sum(float v) { float a = v, b = v; swap16(a, b); return a + b; }
__device__ __forceinline__ float swap32_sum(float v) { float a = v, b = v; swap32(a, b); return a + b; }
__device__ __forceinline__ float swap32_max(float v) { float a = v, b = v; swap32(a, b); return fmaxf(a, b); }
__device__ __forceinline__ float grp_sum16(float v) { v += dpp_mov<0xB1>(v); v += dpp_mov<0x4E>(v); v += dpp_mov<0x124>(v); v += dpp_mov<0x128>(v); return v; }
__device__ __forceinline__ float grp_sum32(float v) { return swap16_sum(grp_sum16(v)); }
__device__ __forceinline__ float wave_sum64(float v) { return swap32_sum(grp_sum32(v)); }
__device__ __forceinline__ float grp_sum4(float v) { v += dpp_mov<0xB1>(v); v += dpp_mov<0x4E>(v); return v; }
__device__ __forceinline__ float grp_sum8(float v) { v = grp_sum4(v); v += dpp_mov<0x141>(v); return v; }
__device__ __forceinline__ float quad_x2(float v) { return dpp_mov<0x4E>(v); }
__device__ __forceinline__ float xor8(float v) { return dpp_mov<0x128>(v); }
__device__ __forceinline__ float xor32(float v) { return swap32_sum(v); }

struct WS {
    bf16_t *W1t, *Wuqt, *Wukvt, *Wpwt, *Wot, *Wrt, *Wgut, *Wdt, *Wgt, *Wpt, *Wsm;
    bf16_t *hb;
    bf16_t *hb1;
    bf16_t *ub;
    bf16_t *vT;
    bf16_t *ygb;
    bf16_t *cqb;
    bf16_t *ckvb;
    bf16_t *kpeb;
    bf16_t *Qb;
    bf16_t *Knb;
    bf16_t *VTb;
    bf16_t *yb;
    float  *ssq;
    float  *rssA;
    float  *rssB;
    float  *cqss;
    float  *cs;
    bf16_t *erb;
    float  *essq;
    bf16_t *hbuf;
    int    *cnt;
    int    *elist;
    float  *ewt;
    unsigned *bar;
};
constexpr size_t W1_SZ = (size_t)ZN * 1024, WUQ_SZ = 768 * 256, WUKV_SZ = 1024 * 128, WPW_SZ = 256 * 256, WO_SZ = 1024 * 1024, WR_SZ = 128 * 1024,
                 WGU_SZ = (size_t)32 * 512 * 1024, WD_SZ = (size_t)32 * 1024 * 256, WG_SZ = 1024 * 1024, WP_SZ = 1024 * 256, WSM_SZ = 4 * 128 * 128;

struct Params {
    nv::Inputs in;
    float* h;
    WS w;
};

static WS make_ws(char* base, size_t& used) {
    WS w{}; size_t o = 0;
    auto take = [&](size_t bytes) { char* p = base + o; o += (bytes + 255) & ~(size_t)255; return p; };
    w.W1t = (bf16_t*)take(2 * W1_SZ * 2);   w.Wuqt = (bf16_t*)take(2 * WUQ_SZ * 2); w.Wukvt = (bf16_t*)take(2 * WUKV_SZ * 2);
    w.Wpwt = (bf16_t*)take(2 * WPW_SZ * 2); w.Wot = (bf16_t*)take(2 * WO_SZ * 2);   w.Wrt = (bf16_t*)take(2 * WR_SZ * 2);
    w.Wgut = (bf16_t*)take(2 * WGU_SZ * 2); w.Wdt = (bf16_t*)take(2 * WD_SZ * 2);   w.Wgt = (bf16_t*)take(2 * WG_SZ * 2);
    w.Wpt = (bf16_t*)take(2 * WP_SZ * 2);   w.Wsm = (bf16_t*)take(2 * WSM_SZ * 2);
    w.hb = (bf16_t*)take((size_t)NT * 1024 * 2); w.hb1 = (bf16_t*)take((size_t)NT * 1024 * 2);
    w.ssq = (float*)take((size_t)NT * 16 * 4); w.cs = (float*)take((size_t)NT * 32 * 4);
    w.rssA = (float*)take((size_t)NT * 8 * 4); w.rssB = (float*)take((size_t)NT * 8 * 4); w.cqss = (float*)take((size_t)NT * 4 * 4);
    w.essq = (float*)take((size_t)NT * 8 * 4);
    w.cnt = (int*)take(2 * 256 * 4);
    w.elist = (int*)take((size_t)64 * NT * 4); w.ewt = (float*)take((size_t)64 * NT * 4);
    w.bar = (unsigned*)take(4096 * 4);
    const size_t region = o;
    w.ub = (bf16_t*)take((size_t)NT * 256 * 2); w.vT = (bf16_t*)take((size_t)NT * 256 * 2); w.ygb = (bf16_t*)take((size_t)NT * 256 * 2);
    w.cqb = (bf16_t*)take((size_t)NT * 256 * 2); w.ckvb = (bf16_t*)take((size_t)NT * 128 * 2); w.kpeb = (bf16_t*)take((size_t)NT * 32 * 2);
    w.Qb = (bf16_t*)take((size_t)NT * 768 * 2); w.Knb = (bf16_t*)take((size_t)NT * 512 * 2); w.VTb = (bf16_t*)take((size_t)NT * 512 * 2);
    w.yb = (bf16_t*)take((size_t)NT * 1024 * 2);
    const size_t region_end = o;
    o = region;
    w.hbuf = (bf16_t*)take((size_t)(2 * NT + 128) * 256 * 2);
    w.erb = (bf16_t*)take((size_t)NT * 1024 * 2);
    if (o > region_end) { fprintf(stderr, "make_ws: overlay exceeds mixer region\n"); }
    o = region_end;
    used = o;
    return w;
}

__device__ const double ROPE_INV[16] = {1.0, 0.5623413251903491, 0.31622776601683794, 0.1778279410038923, 0.1, 0.05623413251903491, 0.03162277660168379, 0.01778279410038923, 0.01, 0.005623413251903491, 0.0031622776601683794, 0.0017782794100389228, 0.001, 0.0005623413251903491, 0.00031622776601683794, 0.00017782794100389227};
__device__ __forceinline__ void rope_cs(int pos, int j, float& c, float& s) {
    const double ang = (double)pos * ROPE_INV[j];
    const double n = rint(ang * 0.15915494309189535);
    double r = fma(-n, 6.283185307179586, ang); r = fma(-n, 2.4492935982947064e-16, r);
    const double r2 = r * r;
    double sc = 1.0, ss = 1.0;
    double tc = 1.0, ts = 1.0;
#pragma unroll
    for (int k = 1; k <= 14; ++k) {
        tc *= -r2 / (double)((2 * k - 1) * (2 * k)); sc += tc;
        ts *= -r2 / (double)((2 * k) * (2 * k + 1)); ss += ts;
    }
    c = (float)sc; s = (float)(ss * r);
}

enum { MAP_ID = 0, MAP_W1 = 1, MAP_UQ = 2, MAP_UKV = 3, MAP_GATE = 4, MAP_UP = 5 };
template <int MAP> __device__ __forceinline__ int dstrow(int c) {
    if (MAP == MAP_W1) {
        if (c < 512) return c;
        if (c < 768) return 512 + 2 * (c - 512);
        if (c < 1024) return 513 + 2 * (c - 768);
        return c;
    } else if (MAP == MAP_UQ) {
        const int h = c / 96, d = c - h * 96; return d < 64 ? h * 64 + d : 512 + h * 32 + d - 64;
    } else if (MAP == MAP_UKV) {
        const int h = c >> 7, d = c & 127; return d < 64 ? h * 64 + d : 512 + h * 64 + d - 64;
    } else if (MAP == MAP_GATE) return 2 * c;
    else if (MAP == MAP_UP) return 2 * c + 1;
    return c;
}
#define PREP_LOAD(V0, V1, V2, V3, SRC, K0, C0) do { \
    const int kk_ = tid >> 4, c4_ = (tid & 15) * 4; \
    const float* p_ = (C0) + c4_ < Nsrc ? (SRC) + (size_t)((K0) + kk_) * ld + (C0) + c4_ : (SRC) + (size_t)((K0) + kk_) * ld; \
    V0 = *(const float4*)p_; V1 = *(const float4*)(p_ + (size_t)16 * ld); V2 = *(const float4*)(p_ + (size_t)32 * ld); V3 = *(const float4*)(p_ + (size_t)48 * ld); } while (0)
__device__ __forceinline__ void prep_put(float* tile, int kk, int c4, const float4& v, float sc) {
    float* t = tile + kk * 65 + c4; t[0] = v.x * sc; t[1] = v.y * sc; t[2] = v.z * sc; t[3] = v.w * sc;
}
template <int MAP>
__device__ void prep_job(const float* src, int ld, int Nsrc, size_t src_stride, const float* scale, bf16_t* dst, size_t dst_stride, int K, int nbatch, float* tiles, int& rot, const int tid, const int bi, const int G) {
    const int tn = (Nsrc + 63) / 64, tk = K / 64, per = tn * tk, total = per * nbatch;
    int t = (bi - rot + G) % G, buf = 0;
    float4 a0 = make_float4(0.f, 0.f, 0.f, 0.f), a1 = a0, a2 = a0, a3 = a0, b0 = a0, b1 = a0, b2 = a0, b3 = a0;
    if (t < total) { const int e = t / per, tt = t % per; PREP_LOAD(a0, a1, a2, a3, src + (size_t)e * src_stride, (tt / tn) * 64, (tt % tn) * 64); }
    for (; t < total; t += G) {
        const int e = t / per, tt = t % per, k0 = (tt / tn) * 64, c0 = (tt % tn) * 64;
        const int t2 = t + G;
        if (t2 < total) { const int e2 = t2 / per, tt2 = t2 % per; PREP_LOAD(b0, b1, b2, b3, src + (size_t)e2 * src_stride, (tt2 / tn) * 64, (tt2 % tn) * 64); }
        float* tile = tiles + buf * (64 * 65);
        {
            const int kk = tid >> 4, c4 = (tid & 15) * 4;
            const float s0 = scale ? scale[k0 + kk] : 1.f, s1 = scale ? scale[k0 + kk + 16] : 1.f, s2 = scale ? scale[k0 + kk + 32] : 1.f, s3 = scale ? scale[k0 + kk + 48] : 1.f;
            prep_put(tile, kk, c4, a0, s0); prep_put(tile, kk + 16, c4, a1, s1); prep_put(tile, kk + 32, c4, a2, s2); prep_put(tile, kk + 48, c4, a3, s3);
        }
        __syncthreads();
        bf16_t* d = dst + (size_t)e * dst_stride;
#pragma unroll
        for (int i = 0; i < 2; ++i) {
            const int idx = tid + 256 * i, c = idx >> 3, kc = idx & 7;
            if (c0 + c < Nsrc) {
                const float* q = tile + (kc * 8) * 65 + c;
                uint4 pk;
                pk.x = pack2(q[0], q[65]); pk.y = pack2(q[130], q[195]); pk.z = pack2(q[260], q[325]); pk.w = pack2(q[390], q[455]);
                *(uint4*)(d + (size_t)dstrow<MAP>(c0 + c) * K + k0 + kc * 8) = pk;
            }
        }
        a0 = b0; a1 = b1; a2 = b2; a3 = b3; buf ^= 1;
    }
    __syncthreads();
    rot = (rot + total) % G;
}

__device__ void phase_prep(const Params& P, char* lds) {
    float* tile = (float*)lds;
    const nv::Inputs& in = P.in; const WS& w = P.w;
    const int G = gridDim.x, bid = blockIdx.x, tid = opaque_tid();
    int rot = 0;
    for (int L = 0; L < 2; ++L) {
        if (L == 0) {
        prep_job<MAP_GATE>(in.moe_w_gate + (size_t)L * 32 * 1024 * 256, 256, 256, (size_t)1024 * 256, in.ffn_norm_g + L * 1024, w.Wgut + L * WGU_SZ, (size_t)512 * 1024, 1024, 32, tile, rot, tid, bid, G);
        prep_job<MAP_UP>(in.moe_w_up + (size_t)L * 32 * 1024 * 256, 256, 256, (size_t)1024 * 256, in.ffn_norm_g + L * 1024, w.Wgut + L * WGU_SZ, (size_t)512 * 1024, 1024, 32, tile, rot, tid, bid, G);
        prep_job<MAP_ID>(in.moe_w_down + (size_t)L * 32 * 256 * 1024, 1024, 1024, (size_t)256 * 1024, nullptr, w.Wdt + L * WD_SZ, (size_t)1024 * 256, 256, 32, tile, rot, tid, bid, G);
        }
        prep_job<MAP_W1>(in.w_in + (size_t)L * 1024 * 1440, 1440, 1440, 0, in.mix_norm_g + L * 1024, w.W1t + L * W1_SZ, 0, 1024, 1, tile, rot, tid, bid, G);
        prep_job<MAP_UQ>(in.w_uq + (size_t)L * 256 * 768, 768, 768, 0, in.q_a_norm_g + L * 256, w.Wuqt + L * WUQ_SZ, 0, 256, 1, tile, rot, tid, bid, G);
        prep_job<MAP_UKV>(in.w_ukv + (size_t)L * 128 * 1024, 1024, 1024, 0, in.kv_a_norm_g + L * 128, w.Wukvt + L * WUKV_SZ, 0, 128, 1, tile, rot, tid, bid, G);
        prep_job<MAP_ID>(in.conv_pw_w + (size_t)L * 256 * 256, 256, 256, 0, nullptr, w.Wpwt + L * WPW_SZ, 0, 256, 1, tile, rot, tid, bid, G);
        prep_job<MAP_ID>(in.w_o + (size_t)L * 1024 * 1024, 1024, 1024, 0, in.branch_norm_g + L * 1024, w.Wot + L * WO_SZ, 0, 1024, 1, tile, rot, tid, bid, G);
        prep_job<MAP_ID>(in.ple_gate_w + (size_t)L * 1024 * 1024, 1024, 1024, 0, in.ple_norm_g + L * 1024, w.Wgt + L * WG_SZ, 0, 1024, 1, tile, rot, tid, bid, G);
        prep_job<MAP_ID>(in.ple_proj_w + (size_t)L * 256 * 1024, 1024, 1024, 0, nullptr, w.Wpt + L * WP_SZ, 0, 256, 1, tile, rot, tid, bid, G);
        for (int i = bid * 256 + tid; i < 96 * 1024 / 8; i += G * 256) *(uint4*)(w.W1t + L * W1_SZ + (size_t)1440 * 1024 + (size_t)i * 8) = make_uint4(0u, 0u, 0u, 0u);
        for (int i = bid * 256 + tid; i < 128 * 1024; i += G * 256) {
            int n = i >> 10, k = i & 1023; float v = 0.f;
            if (n < 4) v = in.router_group_w[(size_t)L * 1024 * 4 + k * 4 + n];
            else if (n < 36) v = in.router_expert_w[(size_t)L * 1024 * 32 + k * 32 + (n - 4)];
            v *= in.ffn_norm_g[L * 1024 + k];
            w.Wrt[L * WR_SZ + i] = (bf16_t)f2bf(v);
        }
        for (int i = bid * 256 + tid; i < 4 * 128 * 128; i += G * 256) {
            int jj = i & 127, ii = (i >> 7) & 127;
            float v = (jj <= ii) ? in.sgu_w[(size_t)L * WSM_SZ + i] : 0.f;
            w.Wsm[L * WSM_SZ + i] = (bf16_t)f2bf(v);
        }
    }
    for (int i = bid * 256 + tid; i < NT * 16; i += G * 256) {
        int t = i >> 4, j = i & 15;
        float c, sn; rope_cs(in.positions[t], j, c, sn);
        w.cs[t * 32 + j] = c; w.cs[t * 32 + 16 + j] = sn;
    }
    for (int row = bid * 4 + (tid >> 6); row < NT; row += G * 4) {
        const int lane = tid & 63;
        float ss = 0.f;
#pragma unroll
        for (int j = 0; j < 4; ++j) {
            const size_t i = (size_t)row * 256 + j * 64 + lane;
            const float4 v = ((const float4*)in.x)[i];
            uint2 pk; pk.x = pack2(v.x, v.y); pk.y = pack2(v.z, v.w);
            ((uint2*)w.hb)[i] = pk;
            ss += v.x * v.x + v.y * v.y + v.z * v.z + v.w * v.w;
        }
        ss = wave_sum64(ss);
        if (lane < 8) w.rssA[(size_t)row * 8 + lane] = lane == 0 ? ss : 0.f;
    }
}

__device__ void prep_moe_late(const Params& P, int part, char* lds, const int tid, const int bi, const int nb) {
    float* tile = (float*)lds;
    const nv::Inputs& in = P.in; const WS& w = P.w;
    int rot = 0; const int L = 1;
    const float* up = in.moe_w_up + (size_t)L * 32 * 1024 * 256;
    if (part == 0) {
        prep_job<MAP_GATE>(in.moe_w_gate + (size_t)L * 32 * 1024 * 256, 256, 256, (size_t)1024 * 256, in.ffn_norm_g + L * 1024, w.Wgut + L * WGU_SZ, (size_t)512 * 1024, 1024, 32, tile, rot, tid, bi, nb);
        prep_job<MAP_UP>(up, 256, 256, (size_t)1024 * 256, in.ffn_norm_g + L * 1024, w.Wgut + L * WGU_SZ, (size_t)512 * 1024, 1024, 16, tile, rot, tid, bi, nb);
    } else {
        prep_job<MAP_UP>(up + (size_t)16 * 1024 * 256, 256, 256, (size_t)1024 * 256, in.ffn_norm_g + L * 1024, w.Wgut + L * WGU_SZ + (size_t)16 * 512 * 1024, (size_t)512 * 1024, 1024, 16, tile, rot, tid, bi, nb);
        prep_job<MAP_ID>(in.moe_w_down + (size_t)L * 32 * 256 * 1024, 1024, 1024, (size_t)256 * 1024, nullptr, w.Wdt + L * WD_SZ, (size_t)1024 * 256, 256, 32, tile, rot, tid, bi, nb);
    }
    __syncthreads();
}

__device__ __forceinline__ int lds_off(int row, int chunk) { return row * 128 + ((chunk ^ ((row >> 1) & 7)) << 4); }

template <typename AT> struct ARaw;
template <> struct ARaw<bf16_t> { uint4 v[4]; };
template <> struct ARaw<float> { float4 v[4][2]; };

__device__ __forceinline__ void a_load(ARaw<bf16_t>& r, const bf16_t* const (&rowp)[4], int koff) {
#pragma unroll
    for (int i = 0; i < 4; ++i) r.v[i] = *(const uint4*)(rowp[i] + koff);
}
__device__ __forceinline__ void a_load(ARaw<float>& r, const float* const (&rowp)[4], int koff) {
#pragma unroll
    for (int i = 0; i < 4; ++i) { r.v[i][0] = *(const float4*)(rowp[i] + koff); r.v[i][1] = *(const float4*)(rowp[i] + koff + 4); }
}
template <bool SUMSQ> __device__ __forceinline__ uint4 a_cvt(const uint4& v, float& ss) {
    if (SUMSQ) {
        float a;
        a = bflo(v.x); ss = fmaf(a, a, ss); a = bfhi(v.x); ss = fmaf(a, a, ss);
        a = bflo(v.y); ss = fmaf(a, a, ss); a = bfhi(v.y); ss = fmaf(a, a, ss);
        a = bflo(v.z); ss = fmaf(a, a, ss); a = bfhi(v.z); ss = fmaf(a, a, ss);
        a = bflo(v.w); ss = fmaf(a, a, ss); a = bfhi(v.w); ss = fmaf(a, a, ss);
    }
    return v;
}
template <bool SUMSQ> __device__ __forceinline__ void a_store(const ARaw<bf16_t>& r, char* ldsA, int tid, float (&ss)[4]) {
#pragma unroll
    for (int i = 0; i < 4; ++i) { uint4 v = a_cvt<SUMSQ>(r.v[i], ss[i]); *(uint4*)(ldsA + lds_off((tid >> 3) + 32 * i, tid & 7)) = v; }
}
template <bool SUMSQ> __device__ __forceinline__ void a_store(const ARaw<float>& r, char* ldsA, int tid, float (&ss)[4]) {
#pragma unroll
    for (int i = 0; i < 4; ++i) {
        const float4 a = r.v[i][0], b = r.v[i][1];
        if (SUMSQ) ss[i] += a.x * a.x + a.y * a.y + a.z * a.z + a.w * a.w + b.x * b.x + b.y * b.y + b.z * b.z + b.w * b.w;
        uint4 v; v.x = pack2(a.x, a.y); v.y = pack2(a.z, a.w); v.z = pack2(b.x, b.y); v.w = pack2(b.z, b.w);
        *(uint4*)(ldsA + lds_off((tid >> 3) + 32 * i, tid & 7)) = v;
    }
}

struct bf16x3_t {};
template <> struct ARaw<bf16x3_t> { uint4 a[4], b[4], c[4]; };
struct Rows3 { const bf16_t* p[2][4]; };
__device__ __forceinline__ void a_load(ARaw<bf16x3_t>& r, const Rows3& rows, int koff) {
#pragma unroll
    for (int i = 0; i < 4; ++i) { r.a[i] = *(const uint4*)(rows.p[0][i] + koff); r.b[i] = *(const uint4*)(rows.p[1][i] + koff); r.c[i] = *(const uint4*)(rows.p[1][i] + koff + 1024); }
}
__device__ __forceinline__ unsigned add3pk(unsigned a, unsigned b, unsigned c, float& ss) {
    const float lo = bflo(a) + bflo(b) + bflo(c), hi = bfhi(a) + bfhi(b) + bfhi(c);
    ss = fmaf(lo, lo, ss); ss = fmaf(hi, hi, ss);
    return pack2(lo, hi);
}
template <bool SUMSQ> __device__ __forceinline__ void a_store(const ARaw<bf16x3_t>& r, char* ldsA, int tid, float (&ss)[4]) {
#pragma unroll
    for (int i = 0; i < 4; ++i) {
        uint4 v;
        v.x = add3pk(r.a[i].x, r.b[i].x, r.c[i].x, ss[i]); v.y = add3pk(r.a[i].y, r.b[i].y, r.c[i].y, ss[i]);
        v.z = add3pk(r.a[i].z, r.b[i].z, r.c[i].z, ss[i]); v.w = add3pk(r.a[i].w, r.b[i].w, r.c[i].w, ss[i]);
        *(uint4*)(ldsA + lds_off((tid >> 3) + 32 * i, tid & 7)) = v;
    }
}

template <typename AT, bool SUMSQ, int SUNROLL = 4, typename AROWS>
__device__ __forceinline__ void gemm_mainloop(f32x16 (&acc)[2][2], const AROWS& arow, const bf16_t* const (&wrow)[4], int nkt, char* lds, float (&ss)[4], const int tid) {
    const int lane = tid & 63, wid = tid >> 6, wr = wid >> 1, wc = wid & 1;
    ARaw<AT> ra; ARaw<bf16_t> rb; float dummy[4] = {0.f, 0.f, 0.f, 0.f};
    a_load(ra, arow, 0); a_load(rb, wrow, 0);
    a_store<SUMSQ>(ra, lds, tid, ss); a_store<false>(rb, lds + 16384, tid, dummy);
    __syncthreads();
    const int fr = lane & 31, fh = lane >> 5;
#pragma unroll 1
    for (int kt = 0; kt < nkt; ++kt) {
        char* cur = lds + (kt & 1) * 32768;
        char* nxt = lds + ((kt + 1) & 1) * 32768;
        const bool more = (kt + 1 < nkt);
        if (more) { a_load(ra, arow, (kt + 1) * 64); a_load(rb, wrow, (kt + 1) * 64); }
#pragma unroll SUNROLL
        for (int s = 0; s < 4; ++s) {
            bf16x8 xa[2], wb[2];
#pragma unroll
            for (int i = 0; i < 2; ++i) xa[i] = *(const bf16x8*)(cur + lds_off(wr * 64 + i * 32 + fr, 2 * s + fh));
#pragma unroll
            for (int j = 0; j < 2; ++j) wb[j] = *(const bf16x8*)(cur + 16384 + lds_off(wc * 64 + j * 32 + fr, 2 * s + fh));
#pragma unroll
            for (int i = 0; i < 2; ++i)
#pragma unroll
                for (int j = 0; j < 2; ++j) acc[i][j] = __builtin_amdgcn_mfma_f32_32x32x16_bf16(wb[j], xa[i], acc[i][j], 0, 0, 0);
        }
        if (more) { a_store<SUMSQ>(ra, nxt, tid, ss); a_store<false>(rb, nxt + 16384, tid, dummy); }
        __syncthreads();
    }
}
constexpr int GST = 16384;
__device__ __forceinline__ int gl_chunk(int tid) { return (tid & 3) ^ ((tid >> 4) & 3); }
__device__ __forceinline__ int gl_off(int row, int chunk) { return row * 64 + ((chunk ^ ((row >> 2) & 3)) << 4); }
typedef __attribute__((address_space(3))) unsigned lds_u32_t;
__device__ __forceinline__ void glds16(const bf16_t* g, char* l) {
    __builtin_amdgcn_global_load_lds((const unsigned*)g, (lds_u32_t*)l, 16, 0, 0);
}
#define RAW_BARRIER() do { asm volatile("s_waitcnt lgkmcnt(0)" ::: "memory"); __builtin_amdgcn_s_barrier(); } while (0)
template <bool SEG = false>
__device__ __forceinline__ void gemm_mainloop_g(f32x16 (&acc)[2][2], const bf16_t* const (&arow)[2], const bf16_t* const (&wrow)[2], const int nkt, char* lds, const int tid,
                                                const int rot = 0, const int kt1 = -1, const float* f1 = nullptr, const int kt2 = -1, const float* f2 = nullptr) {
    const int lane = tid & 63, wid = tid >> 6, wr = wid >> 1, wc = wid & 1, fr = lane & 31, fh = lane >> 5;
    const int wbase = __builtin_amdgcn_readfirstlane(wid) * 1024;
#pragma unroll 1
    for (int p = 0; p < 3; ++p) if (p < nkt) {
        char* st = lds + p * GST + wbase;
        const int ko = SEG ? ((p + rot) & (nkt - 1)) * 32 : p * 32;
        glds16(arow[0] + ko, st); glds16(arow[1] + ko, st + 4096);
        glds16(wrow[0] + ko, st + 8192); glds16(wrow[1] + ko, st + 8192 + 4096);
    }
    const int ra0 = gl_off(wr * 64 + fr, fh), ra1 = gl_off(wr * 64 + 32 + fr, fh);
    const int rb0 = 8192 + gl_off(wc * 64 + fr, fh), rb1 = 8192 + gl_off(wc * 64 + 32 + fr, fh);
#pragma unroll 1
    for (int kt = 0; kt < nkt; ++kt) {
        if (kt + 2 < nkt) asm volatile("s_waitcnt vmcnt(8)" ::: "memory");
        else if (kt + 1 < nkt) asm volatile("s_waitcnt vmcnt(4)" ::: "memory");
        else asm volatile("s_waitcnt vmcnt(0)" ::: "memory");
        RAW_BARRIER();
        if (kt + 3 < nkt) {
            char* st = lds + ((kt + 3) & 3) * GST + wbase;
            const int ko = SEG ? ((kt + 3 + rot) & (nkt - 1)) * 32 : (kt + 3) * 32;
            glds16(arow[0] + ko, st); glds16(arow[1] + ko, st + 4096);
            glds16(wrow[0] + ko, st + 8192); glds16(wrow[1] + ko, st + 8192 + 4096);
        }
        const char* cur = lds + (kt & 3) * GST;
        if (SEG && (kt == kt1 || kt == kt2)) {
            const float* f = kt == kt1 ? f1 : f2;
#pragma unroll
            for (int i = 0; i < 2; ++i) {
                const float v = f[wr * 64 + i * 32 + fr];
#pragma unroll
                for (int j = 0; j < 2; ++j)
#pragma unroll
                    for (int r = 0; r < 16; ++r) acc[i][j][r] *= v;
            }
        }
        bf16x8 xa[2][2], wb[2][2];
#pragma unroll
        for (int s2 = 0; s2 < 2; ++s2) {
            xa[s2][0] = *(const bf16x8*)(cur + (ra0 ^ (s2 << 5))); xa[s2][1] = *(const bf16x8*)(cur + (ra1 ^ (s2 << 5)));
            wb[s2][0] = *(const bf16x8*)(cur + (rb0 ^ (s2 << 5))); wb[s2][1] = *(const bf16x8*)(cur + (rb1 ^ (s2 << 5)));
        }
        __builtin_amdgcn_sched_barrier(0);
#pragma unroll
        for (int s2 = 0; s2 < 2; ++s2) {
            acc[0][0] = __builtin_amdgcn_mfma_f32_32x32x16_bf16(wb[s2][0], xa[s2][0], acc[0][0], 0, 0, 0);
            acc[0][1] = __builtin_amdgcn_mfma_f32_32x32x16_bf16(wb[s2][1], xa[s2][0], acc[0][1], 0, 0, 0);
            acc[1][0] = __builtin_amdgcn_mfma_f32_32x32x16_bf16(wb[s2][0], xa[s2][1], acc[1][0], 0, 0, 0);
            acc[1][1] = __builtin_amdgcn_mfma_f32_32x32x16_bf16(wb[s2][1], xa[s2][1], acc[1][1], 0, 0, 0);
        }
    }
    RAW_BARRIER();
}
__device__ __forceinline__ int g64_chunk(int tid) { return (tid & 7) ^ ((tid >> 4) & 7); }
__device__ __forceinline__ void gemm_mainloop_g64(f32x16 (&acc)[2][2], const bf16_t* const (&arow)[4], const bf16_t* const (&wrow)[4], const int nkt, char* lds, const int tid) {
    const int lane = tid & 63, wid = tid >> 6, wr = wid >> 1, wc = wid & 1, fr = lane & 31, fh = lane >> 5;
    const int wbase = __builtin_amdgcn_readfirstlane(wid) * 1024;
    {
        char* st = lds + wbase;
#pragma unroll
        for (int i = 0; i < 4; ++i) { glds16(arow[i], st + i * 4096); glds16(wrow[i], st + 16384 + i * 4096); }
    }
#pragma unroll 1
    for (int kt = 0; kt < nkt; ++kt) {
        asm volatile("s_waitcnt vmcnt(0)" ::: "memory");
        RAW_BARRIER();
        if (kt + 1 < nkt) {
            char* st = lds + ((kt + 1) & 1) * 32768 + wbase;
            const int ko = (kt + 1) * 64;
#pragma unroll
            for (int i = 0; i < 4; ++i) { glds16(arow[i] + ko, st + i * 4096); glds16(wrow[i] + ko, st + 16384 + i * 4096); }
        }
        const char* cur = lds + (kt & 1) * 32768;
#pragma unroll
        for (int s = 0; s < 4; ++s) {
            bf16x8 xa[2], wb[2];
#pragma unroll
            for (int i = 0; i < 2; ++i) xa[i] = *(const bf16x8*)(cur + lds_off(wr * 64 + i * 32 + fr, 2 * s + fh));
#pragma unroll
            for (int j = 0; j < 2; ++j) wb[j] = *(const bf16x8*)(cur + 16384 + lds_off(wc * 64 + j * 32 + fr, 2 * s + fh));
#pragma unroll
            for (int i = 0; i < 2; ++i)
#pragma unroll
                for (int j = 0; j < 2; ++j) acc[i][j] = __builtin_amdgcn_mfma_f32_32x32x16_bf16(wb[j], xa[i], acc[i][j], 0, 0, 0);
        }
    }
    RAW_BARRIER();
}
__device__ __forceinline__ void acc_zero(f32x16 (&acc)[2][2]) {
#pragma unroll
    for (int i = 0; i < 2; ++i)
#pragma unroll
        for (int j = 0; j < 2; ++j)
#pragma unroll
            for (int r = 0; r < 16; ++r) acc[i][j][r] = 0.f;
}
__device__ __forceinline__ void publish_rowstat(float (&ss)[4], float* stat, float invK, bool as_rstd, const int tid) {
#pragma unroll
    for (int i = 0; i < 4; ++i) {
        float v = ss[i];
        v += __shfl_xor(v, 1); v += __shfl_xor(v, 2); v += __shfl_xor(v, 4);
        if ((tid & 7) == 0) stat[(tid >> 3) + 32 * i] = as_rstd ? rsqrtf(v * invK + EPS) : v;
    }
    __syncthreads();
}
__device__ __forceinline__ int nidx(int r, int fh) { return (r & 3) + 8 * (r >> 2) + 4 * fh; }
__device__ __forceinline__ uint4 pack8(const float4& a, const float4& b) { uint4 pk; pk.x = pack2(a.x, a.y); pk.y = pack2(a.z, a.w); pk.z = pack2(b.x, b.y); pk.w = pack2(b.z, b.w); return pk; }
__device__ __forceinline__ float sq8(const float4& a, const float4& b) { return (a.x * a.x + a.y * a.y) + (a.z * a.z + a.w * a.w) + (b.x * b.x + b.y * b.y) + (b.z * b.z + b.w * b.w); }
__device__ __forceinline__ float4 mul4(const float4& a, float s) { return make_float4(a.x * s, a.y * s, a.z * s, a.w * s); }
__device__ __forceinline__ void store4(bf16_t* p, float a, float b, float c, float d) {
    uint2 v; v.x = pack2(a, b); v.y = pack2(c, d); *(uint2*)p = v;
}

__device__ __forceinline__ bool xcd_item(int it, int MT, int NTl, int& mt, int& nt) {
    const int x = blockIdx.x & 7, lb = blockIdx.x >> 3, nlb = gridDim.x >> 3;
    const int li = it * nlb + lb, per = (MT >> 3) * NTl;
    if (li >= per) return false;
    mt = (li / NTl) * 8 + x; nt = li % NTl; return true;
}

constexpr int TLD = 132;
constexpr int STAT_OFF = 128 * TLD * 4;
constexpr int LDS_GEMM_BYTES = STAT_OFF + 2048;
__device__ __forceinline__ void acc_to_lds(const f32x16 (&acc)[2][2], float* T, const int tid) {
    const int lane = tid & 63, wid = tid >> 6, wr = wid >> 1, wc = wid & 1, fr = lane & 31, fh = lane >> 5;
#pragma unroll
    for (int i = 0; i < 2; ++i)
#pragma unroll
        for (int j = 0; j < 2; ++j)
#pragma unroll
            for (int g = 0; g < 4; ++g) {
                float4 v; v.x = acc[i][j][4 * g]; v.y = acc[i][j][4 * g + 1]; v.z = acc[i][j][4 * g + 2]; v.w = acc[i][j][4 * g + 3];
                *(float4*)(T + (wr * 64 + i * 32 + fr) * TLD + wc * 64 + j * 32 + 8 * g + 4 * fh) = v;
            }
    __syncthreads();
}
__device__ __forceinline__ float rstd8(const float* p, float invK) {
    const float4 a = *(const float4*)p, b = *(const float4*)(p + 4);
    return rsq_(((a.x + a.y) + (a.z + a.w) + (b.x + b.y) + (b.z + b.w)) * invK + EPS);
}

}
namespace fx {

__device__ void phase_zgemm(const Params& P, int L, char* lds, const bool same = false) {
    const WS& w = P.w; const nv::Inputs& in = P.in;
    const int tid0 = opaque_tid();
    float* T = (float*)lds; float* stat = (float*)(lds + STAT_OFF);
    const bf16_t* Wt = w.W1t + L * W1_SZ;
    int mt, nt;
    for (int it = 0; xcd_item(it, 128, 12, mt, nt); ++it) {
        int tid = tid0; asm volatile("" : "+v"(tid));
        const int lane = tid & 63, wid = tid >> 6;
        const int m0 = mt * 128, n0 = nt * 128;
        {
            const bf16_t* arow[4]; const bf16_t* wrow[4];
#pragma unroll
            for (int i = 0; i < 4; ++i) {
                arow[i] = w.hb + (size_t)(m0 + (tid >> 3) + 32 * i) * 1024 + g64_chunk(tid) * 8;
                wrow[i] = Wt + (size_t)(n0 + (tid >> 3) + 32 * i) * 1024 + g64_chunk(tid) * 8;
            }
            f32x16 acc[2][2]; acc_zero(acc);
            float my_rs = 0.f;
            if (tid < 128) my_rs = rstd8(w.rssA + (size_t)(m0 + tid) * 8, 1.f / 1024.f);
            gemm_mainloop_g64(acc, arow, wrow, 16, lds, tid);
            if (tid < 128) stat[tid] = my_rs;
            acc_to_lds(acc, T, tid);
        }
        const int sub = lane >> 4, l16 = lane & 15, c8 = l16 * 8;
        if (nt < 2) {
#pragma unroll 8
            for (int rr = 0; rr < 8; ++rr) {
                const int row = wid * 32 + rr * 4 + sub; const float rs = stat[row];
                float4 x0 = *(const float4*)(T + row * TLD + c8), x1 = *(const float4*)(T + row * TLD + c8 + 4);
                x0.x = gelu_tanh_(x0.x * rs); x0.y = gelu_tanh_(x0.y * rs); x0.z = gelu_tanh_(x0.z * rs); x0.w = gelu_tanh_(x0.w * rs);
                x1.x = gelu_tanh_(x1.x * rs); x1.y = gelu_tanh_(x1.y * rs); x1.z = gelu_tanh_(x1.z * rs); x1.w = gelu_tanh_(x1.w * rs);
                *(uint4*)(w.ub + (size_t)(m0 + row) * 256 + nt * 128 + c8) = pack8(x0, x1);
            }
        } else if (nt < 4) {
            const int hd = (nt - 2) * 2 + (l16 >> 3), d0 = (l16 & 7) * 8;
            const float4 g0 = *(const float4*)(in.sgu_ln_g + L * 256 + hd * 64 + d0), g1 = *(const float4*)(in.sgu_ln_g + L * 256 + hd * 64 + d0 + 4);
            const float4 b0 = *(const float4*)(in.sgu_ln_b + L * 256 + hd * 64 + d0), b1 = *(const float4*)(in.sgu_ln_b + L * 256 + hd * 64 + d0 + 4);
#pragma unroll 4
            for (int rr = 0; rr < 8; ++rr) {
                const int row = wid * 32 + rr * 4 + sub; const float rs = stat[row];
                float4 x0 = *(const float4*)(T + row * TLD + c8), x1 = *(const float4*)(T + row * TLD + c8 + 4);
                x0.x = gelu_tanh_(x0.x * rs); x0.y = gelu_tanh_(x0.y * rs); x0.z = gelu_tanh_(x0.z * rs); x0.w = gelu_tanh_(x0.w * rs);
                x1.x = gelu_tanh_(x1.x * rs); x1.y = gelu_tanh_(x1.y * rs); x1.z = gelu_tanh_(x1.z * rs); x1.w = gelu_tanh_(x1.w * rs);
                const float mean = grp_sum8((x0.x + x0.y) + (x0.z + x0.w) + (x1.x + x1.y) + (x1.z + x1.w)) * (1.f / 64.f);
                x0.x -= mean; x0.y -= mean; x0.z -= mean; x0.w -= mean; x1.x -= mean; x1.y -= mean; x1.z -= mean; x1.w -= mean;
                const float rv = rsq_(grp_sum8(sq8(x0, x1)) * (1.f / 64.f) + EPS);
                x0.x = x0.x * rv * g0.x + b0.x; x0.y = x0.y * rv * g0.y + b0.y; x0.z = x0.z * rv * g0.z + b0.z; x0.w = x0.w * rv * g0.w + b0.w;
                x1.x = x1.x * rv * g1.x + b1.x; x1.y = x1.y * rv * g1.y + b1.y; x1.z = x1.z * rv * g1.z + b1.z; x1.w = x1.w * rv * g1.w + b1.w;
                *(float4*)(T + row * TLD + c8) = x0; *(float4*)(T + row * TLD + c8 + 4) = x1;
            }
            __syncthreads();
            {
                const int c = tid & 127, th = tid >> 7, hd2 = (nt - 2) * 2 + (c >> 6), d = c & 63;
                bf16_t* dst = w.vT + ((size_t)(mt * 4 + hd2) * 64 + d) * 128 + th * 64;
#pragma unroll 2
                for (int k8 = 0; k8 < 8; ++k8) {
                    float v[8];
#pragma unroll
                    for (int k = 0; k < 8; ++k) v[k] = T[(th * 64 + k8 * 8 + k) * TLD + c];
                    uint4 pk; pk.x = pack2(v[0], v[1]); pk.y = pack2(v[2], v[3]); pk.z = pack2(v[4], v[5]); pk.w = pack2(v[6], v[7]);
                    *(uint4*)(dst + k8 * 8) = pk;
                }
            }
        } else if (nt < 8) {
#pragma unroll 8
            for (int rr = 0; rr < 8; ++rr) {
                const int row = wid * 32 + rr * 4 + sub; const float rs = stat[row];
                const float4 x0 = *(const float4*)(T + row * TLD + c8), x1 = *(const float4*)(T + row * TLD + c8 + 4);
                store4(w.ygb + (size_t)(m0 + row) * 256 + (nt - 4) * 64 + l16 * 4, x0.x * rs * sigmoid_(x0.y * rs), x0.z * rs * sigmoid_(x0.w * rs),
                       x1.x * rs * sigmoid_(x1.y * rs), x1.z * rs * sigmoid_(x1.w * rs));
            }
        } else if (nt < 11) {
            bf16_t* base; int ld, cb;
            if (nt < 10) { base = w.cqb; ld = 256; cb = (nt - 8) * 128; } else { base = w.ckvb; ld = 128; cb = 0; }
#pragma unroll 8
            for (int rr = 0; rr < 8; ++rr) {
                const int row = wid * 32 + rr * 4 + sub; const float rs = stat[row];
                const float4 x0 = mul4(*(const float4*)(T + row * TLD + c8), rs), x1 = mul4(*(const float4*)(T + row * TLD + c8 + 4), rs);
                *(uint4*)(base + (size_t)(m0 + row) * ld + cb + c8) = pack8(x0, x1);
                const float sq = grp_sum16(sq8(x0, x1));
                if (l16 == 0) w.cqss[(size_t)(m0 + row) * 4 + (nt - 8)] = sq;
            }
        } else {
            const int lq = l16 & 3, dd = lq * 8, jj = (lq & 1) * 8;
            const float4 kg0 = *(const float4*)(in.k_norm_g + L * 96 + 64 + dd), kg1 = *(const float4*)(in.k_norm_g + L * 96 + 64 + dd + 4);
#pragma unroll 1
            for (int hb4 = 0; hb4 < 2; ++hb4) {
                float4 cc0[4], cc1[4], ss0[4], ss1[4];
#pragma unroll
                for (int r4 = 0; r4 < 4; ++r4) {
                    const float* csr = w.cs + (size_t)(m0 + wid * 32 + (hb4 * 4 + r4) * 4 + sub) * 32 + jj;
                    cc0[r4] = *(const float4*)csr; cc1[r4] = *(const float4*)(csr + 4); ss0[r4] = *(const float4*)(csr + 16); ss1[r4] = *(const float4*)(csr + 20);
                }
#pragma unroll
                for (int r4 = 0; r4 < 4; ++r4) {
                    const int row = wid * 32 + (hb4 * 4 + r4) * 4 + sub; const float rs = stat[row]; const int tok = m0 + row;
                    float4 x0 = mul4(*(const float4*)(T + row * TLD + dd), rs), x1 = mul4(*(const float4*)(T + row * TLD + dd + 4), rs);
                    const float rn = rsq_(grp_sum4(sq8(x0, x1)) * (1.f / 32.f) + EPS);
                    x0.x *= rn * kg0.x; x0.y *= rn * kg0.y; x0.z *= rn * kg0.z; x0.w *= rn * kg0.w;
                    x1.x *= rn * kg1.x; x1.y *= rn * kg1.y; x1.z *= rn * kg1.z; x1.w *= rn * kg1.w;
                    const float4 o0 = make_float4(quad_x2(x0.x), quad_x2(x0.y), quad_x2(x0.z), quad_x2(x0.w)), o1 = make_float4(quad_x2(x1.x), quad_x2(x1.y), quad_x2(x1.z), quad_x2(x1.w));
                    const float4 c0 = cc0[r4], c1 = cc1[r4], s0 = ss0[r4], s1 = ss1[r4];
                    const float sg = (lq & 2) ? 1.f : -1.f;
                    float4 r0, r1;
                    r0.x = x0.x * c0.x + sg * o0.x * s0.x; r0.y = x0.y * c0.y + sg * o0.y * s0.y; r0.z = x0.z * c0.z + sg * o0.z * s0.z; r0.w = x0.w * c0.w + sg * o0.w * s0.w;
                    r1.x = x1.x * c1.x + sg * o1.x * s1.x; r1.y = x1.y * c1.y + sg * o1.y * s1.y; r1.z = x1.z * c1.z + sg * o1.z * s1.z; r1.w = x1.w * c1.w + sg * o1.w * s1.w;
                    if (l16 < 4) *(uint4*)(w.kpeb + (size_t)tok * 32 + dd) = pack8(r0, r1);
                }
            }
        }
        __syncthreads();
    }
}

}
namespace fx {

constexpr float QSCALE = 0.10206207261596575f * 1.4426950408889634f;

__device__ void qkv_item(const Params& P, int L, const bool isq, const int mt, const int nt, char* lds, const int tid_in) {
    int tid = tid_in; asm volatile("" : "+v"(tid));
    const WS& w = P.w; const nv::Inputs& in = P.in;
    const int lane = tid & 63, wid = tid >> 6;
    float* T = (float*)lds; float* stat = (float*)(lds + STAT_OFF);
    const int m0 = mt * 128, n0 = nt * 128;
    const int K = isq ? 256 : 128;
    {
        const bf16_t* A = isq ? w.cqb : w.ckvb;
        const bf16_t* Wt = isq ? (w.Wuqt + L * WUQ_SZ) : (w.Wukvt + L * WUKV_SZ);
        const bf16_t* arow[2]; const bf16_t* wrow[2];
#pragma unroll
        for (int i = 0; i < 2; ++i) {
            arow[i] = A + (size_t)(m0 + (tid >> 2) + 64 * i) * K + gl_chunk(tid) * 8;
            wrow[i] = Wt + (size_t)(n0 + (tid >> 2) + 64 * i) * K + gl_chunk(tid) * 8;
        }
        f32x16 acc[2][2]; acc_zero(acc);
        float my_rs = 0.f;
        if (tid < 128) {
            const float4 c = *(const float4*)(w.cqss + (size_t)(m0 + tid) * 4);
            my_rs = isq ? rsq_((c.x + c.y) * (1.f / 256.f) + EPS) : rsq_(c.z * (1.f / 128.f) + EPS);
        }
        gemm_mainloop_g(acc, arow, wrow, K / 32, lds, tid);
        if (tid < 128) stat[tid] = my_rs;
        acc_to_lds(acc, T, tid);
    }
    const int b = m0 >> 11, s0 = m0 & 2047;
    const int sub = lane >> 4, l16 = lane & 15, c8 = l16 * 8;
    if (isq && nt < 4) {
        const int hd = nt * 2 + (l16 >> 3), d = (l16 & 7) * 8;
        const float4 g0 = mul4(*(const float4*)(in.q_norm_g + L * 96 + d), QSCALE), g1 = mul4(*(const float4*)(in.q_norm_g + L * 96 + d + 4), QSCALE);
        bf16_t* dst = w.Qb + ((size_t)(b * 8 + hd) * 2048 + s0) * 96 + d;
#pragma unroll 8
        for (int rr = 0; rr < 8; ++rr) {
            const int row = wid * 32 + rr * 4 + sub; const float rs = stat[row];
            float4 x0 = mul4(*(const float4*)(T + row * TLD + c8), rs), x1 = mul4(*(const float4*)(T + row * TLD + c8 + 4), rs);
            const float rn = rsq_(grp_sum8(sq8(x0, x1)) * (1.f / 64.f) + EPS);
            x0.x *= rn * g0.x; x0.y *= rn * g0.y; x0.z *= rn * g0.z; x0.w *= rn * g0.w; x1.x *= rn * g1.x; x1.y *= rn * g1.y; x1.z *= rn * g1.z; x1.w *= rn * g1.w;
            *(uint4*)(dst + (size_t)row * 96) = pack8(x0, x1);
        }
    } else if (isq) {
        const int hd = (nt - 4) * 4 + (l16 >> 2), lq = l16 & 3, dd = lq * 8, jj = (lq & 1) * 8;
        const float4 g0 = *(const float4*)(in.q_norm_g + L * 96 + 64 + dd), g1 = *(const float4*)(in.q_norm_g + L * 96 + 64 + dd + 4);
        bf16_t* dst = w.Qb + ((size_t)(b * 8 + hd) * 2048 + s0) * 96 + 64 + dd;
        const float sg = (lq & 2) ? QSCALE : -QSCALE;
#pragma unroll 1
        for (int hb4 = 0; hb4 < 2; ++hb4) {
            float4 cc0[4], cc1[4], ss0[4], ss1[4];
#pragma unroll
            for (int r4 = 0; r4 < 4; ++r4) {
                const float* csr = w.cs + (size_t)(m0 + wid * 32 + (hb4 * 4 + r4) * 4 + sub) * 32 + jj;
                cc0[r4] = *(const float4*)csr; cc1[r4] = *(const float4*)(csr + 4); ss0[r4] = *(const float4*)(csr + 16); ss1[r4] = *(const float4*)(csr + 20);
            }
#pragma unroll
            for (int r4 = 0; r4 < 4; ++r4) {
                const int row = wid * 32 + (hb4 * 4 + r4) * 4 + sub; const float rs = stat[row];
                float4 x0 = mul4(*(const float4*)(T + row * TLD + c8), rs), x1 = mul4(*(const float4*)(T + row * TLD + c8 + 4), rs);
                const float rn = rsq_(grp_sum4(sq8(x0, x1)) * (1.f / 32.f) + EPS);
                x0.x *= rn * g0.x; x0.y *= rn * g0.y; x0.z *= rn * g0.z; x0.w *= rn * g0.w; x1.x *= rn * g1.x; x1.y *= rn * g1.y; x1.z *= rn * g1.z; x1.w *= rn * g1.w;
                const float4 o0 = make_float4(quad_x2(x0.x), quad_x2(x0.y), quad_x2(x0.z), quad_x2(x0.w)), o1 = make_float4(quad_x2(x1.x), quad_x2(x1.y), quad_x2(x1.z), quad_x2(x1.w));
                const float4 c0 = mul4(cc0[r4], QSCALE), c1 = mul4(cc1[r4], QSCALE), s0v = ss0[r4], s1v = ss1[r4];
                float4 r0, r1;
                r0.x = x0.x * c0.x + sg * o0.x * s0v.x; r0.y = x0.y * c0.y + sg * o0.y * s0v.y; r0.z = x0.z * c0.z + sg * o0.z * s0v.z; r0.w = x0.w * c0.w + sg * o0.w * s0v.w;
                r1.x = x1.x * c1.x + sg * o1.x * s1v.x; r1.y = x1.y * c1.y + sg * o1.y * s1v.y; r1.z = x1.z * c1.z + sg * o1.z * s1v.z; r1.w = x1.w * c1.w + sg * o1.w * s1v.w;
                *(uint4*)(dst + (size_t)row * 96) = pack8(r0, r1);
            }
        }
    } else if (nt < 4) {
        const int hd = nt * 2 + (l16 >> 3), d = (l16 & 7) * 8;
        const float4 g0 = *(const float4*)(in.k_norm_g + L * 96 + d), g1 = *(const float4*)(in.k_norm_g + L * 96 + d + 4);
        bf16_t* dst = w.Knb + ((size_t)(b * 8 + hd) * 2048 + s0) * 64 + d;
#pragma unroll 8
        for (int rr = 0; rr < 8; ++rr) {
            const int row = wid * 32 + rr * 4 + sub; const float rs = stat[row];
            float4 x0 = mul4(*(const float4*)(T + row * TLD + c8), rs), x1 = mul4(*(const float4*)(T + row * TLD + c8 + 4), rs);
            const float rn = rsq_(grp_sum8(sq8(x0, x1)) * (1.f / 64.f) + EPS);
            x0.x *= rn * g0.x; x0.y *= rn * g0.y; x0.z *= rn * g0.z; x0.w *= rn * g0.w; x1.x *= rn * g1.x; x1.y *= rn * g1.y; x1.z *= rn * g1.z; x1.w *= rn * g1.w;
            *(uint4*)(dst + (size_t)row * 64) = pack8(x0, x1);
        }
    } else {
        const int c = tid & 127, th = tid >> 7, hd = (nt - 4) * 2 + (c >> 6), d = c & 63;
        bf16_t* dst = w.VTb + ((size_t)(b * 8 + hd) * 64 + d) * 2048 + s0 + th * 64;
#pragma unroll 2
        for (int k8 = 0; k8 < 8; ++k8) {
            float v[8];
#pragma unroll
            for (int k = 0; k < 8; ++k) { const int row = th * 64 + k8 * 8 + k; v[k] = T[row * TLD + c] * stat[row]; }
            uint4 pk; pk.x = pack2(v[0], v[1]); pk.y = pack2(v[2], v[3]); pk.z = pack2(v[4], v[5]); pk.w = pack2(v[6], v[7]);
            *(uint4*)(dst + k8 * 8) = pk;
        }
    }
    __syncthreads();
}

__device__ void sgu_item(const Params& P, int L, int mt, char* lds, const int tid_in) {
    int tid = tid_in; asm volatile("" : "+v"(tid));
    const WS& w = P.w; const nv::Inputs& in = P.in;
    const int lane = tid & 63, hd = tid >> 6, fr = lane & 31, fh = lane >> 5;
    float* red = (float*)lds;
    const bf16_t* vt = w.vT + (size_t)(mt * 4 + hd) * 64 * 128;
    const bf16_t* ws = w.Wsm + L * WSM_SZ + (size_t)hd * 128 * 128;
    const float* bs = in.sgu_b + L * 512 + hd * 128;
    const int m0 = mt * 128;
    bf16x8 af0[8], af1[8];
    {
        const bf16_t* ap0 = vt + (size_t)fr * 128 + 8 * fh;
        const bf16_t* ap1 = vt + (size_t)(32 + fr) * 128 + 8 * fh;
#pragma unroll
        for (int s = 0; s < 8; ++s) { af0[s] = *(const bf16x8*)(ap0 + 16 * s); af1[s] = *(const bf16x8*)(ap1 + 16 * s); }
    }
#pragma unroll 1
    for (int it = 0; it < 4; ++it) {
        f32x16 a0, a1;
#pragma unroll
        for (int r = 0; r < 16; ++r) { a0[r] = 0.f; a1[r] = 0.f; }
        const bf16_t* bp = ws + (size_t)(it * 32 + fr) * 128 + 8 * fh;
        bf16x8 bfr[8];
#pragma unroll
        for (int s = 0; s < 8; ++s) bfr[s] = *(const bf16x8*)(bp + 16 * s);
#pragma unroll
        for (int s = 0; s < 8; ++s) {
            a0 = __builtin_amdgcn_mfma_f32_32x32x16_bf16(af0[s], bfr[s], a0, 0, 0, 0);
            a1 = __builtin_amdgcn_mfma_f32_32x32x16_bf16(af1[s], bfr[s], a1, 0, 0, 0);
        }
        const int i = it * 32 + fr, tok = m0 + i;
        const float bias = bs[i];
        uint2 uu[2][4];
#pragma unroll
        for (int dt = 0; dt < 2; ++dt)
#pragma unroll
            for (int g = 0; g < 4; ++g) uu[dt][g] = *(const uint2*)(w.ub + (size_t)tok * 256 + hd * 64 + dt * 32 + 8 * g + 4 * fh);
        float ssq = 0.f;
#pragma unroll
        for (int dt = 0; dt < 2; ++dt)
#pragma unroll
            for (int g = 0; g < 4; ++g) {
                const int d = dt * 32 + 8 * g + 4 * fh;
                float o[4];
#pragma unroll
                for (int q = 0; q < 4; ++q) {
                    const float sv = (dt == 0 ? a0[4 * g + q] : a1[4 * g + q]) + bias;
                    const float uv = (q == 0) ? bflo(uu[dt][g].x) : (q == 1) ? bfhi(uu[dt][g].x) : (q == 2) ? bflo(uu[dt][g].y) : bfhi(uu[dt][g].y);
                    o[q] = uv * sv; ssq += o[q] * o[q];
                }
                store4(w.yb + (size_t)tok * 1024 + hd * 64 + d, o[0], o[1], o[2], o[3]);
            }
        ssq = xor32(ssq);
        if (fh == 0) red[hd * 128 + i] = ssq;
    }
    __syncthreads();
    if (tid < 128) w.ssq[(size_t)(m0 + tid) * 16 + 0] = red[tid] + red[128 + tid] + red[256 + tid] + red[384 + tid];
    __syncthreads();
}

constexpr int CLD = 260, CONV_YL = 32 * CLD * 4, CONV_ST = CONV_YL + 32 * 512, CONV_RED = CONV_ST + 32 * 4 * 8;
__device__ __forceinline__ int yl_off(int row, int chunk) { return row * 512 + ((chunk ^ (row & 15)) << 4); }
__device__ void conv_item(const Params& P, int L, int ct, char* lds, const int tid_in) {
    int tid = tid_in; asm volatile("" : "+v"(tid));
    const WS& w = P.w; const nv::Inputs& in = P.in;
    const int lane = tid & 63, wid = tid >> 6, fr = lane & 31, fh = lane >> 5;
    float* C = (float*)lds; char* yl = lds + CONV_YL; float2* stats = (float2*)(lds + CONV_ST); float* red = (float*)(lds + CONV_RED);
    const int t0 = ct * 32, s0 = t0 & 2047;
    {
        const int c = tid;
        float x[62];
#pragma unroll
        for (int r = 0; r < 62; ++r) {
            const bool ok = s0 + r - 30 >= 0;
            const unsigned short raw = w.ygb[(size_t)(ok ? t0 + r - 30 : t0) * 256 + c];
            x[r] = bf2f(raw) * (ok ? 1.f : 0.f);
        }
        float wk[31];
#pragma unroll
        for (int k = 0; k < 31; ++k) wk[k] = in.conv_w[(size_t)L * 31 * 256 + k * 256 + c];
        const float cb = in.conv_b[L * 256 + c];
#pragma unroll
        for (int t = 0; t < 32; ++t) {
            float a = cb;
#pragma unroll
            for (int k = 0; k < 31; ++k) a = fmaf(wk[k], x[t + k], a);
            C[t * CLD + c] = a;
        }
    }
    __syncthreads();
    if (tid < 128) {
        const int t = tid >> 2, g = tid & 3;
        const float4* cp = (const float4*)(C + t * CLD + g * 64);
        float4 v[16]; float s = 0.f;
#pragma unroll
        for (int i = 0; i < 16; ++i) { v[i] = cp[i]; s += (v[i].x + v[i].y) + (v[i].z + v[i].w); }
        const float mean = s * (1.f / 64.f); float q = 0.f;
#pragma unroll
        for (int i = 0; i < 16; ++i) { const float a = v[i].x - mean, b2 = v[i].y - mean, c2 = v[i].z - mean, d2 = v[i].w - mean; q += (a * a + b2 * b2) + (c2 * c2 + d2 * d2); }
        stats[t * 4 + g] = make_float2(mean, rsq_(q * (1.f / 64.f) + EPS));
    }
    __syncthreads();
    {
        const int c = tid, g = c >> 6;
        const float lg = in.conv_ln_g[L * 256 + c], lb = in.conv_ln_b[L * 256 + c];
#pragma unroll 8
        for (int t = 0; t < 32; ++t) {
            const float2 st = stats[t * 4 + g];
            const float v = (C[t * CLD + c] - st.x) * st.y * lg + lb;
            *(bf16_t*)(yl + yl_off(t, c >> 3) + (c & 7) * 2) = (bf16_t)f2bf(v * sigmoid_(v));
        }
    }
    __syncthreads();
    f32x16 acc0, acc1;
#pragma unroll
    for (int r = 0; r < 16; ++r) { acc0[r] = 0.f; acc1[r] = 0.f; }
    const bf16_t* wp = w.Wpwt + L * WPW_SZ + (size_t)(wid * 64 + fr) * 256 + 8 * fh;
#pragma unroll 1
    for (int sb = 0; sb < 2; ++sb) {
        bf16x8 w0[8], w1[8];
#pragma unroll
        for (int s = 0; s < 8; ++s) { w0[s] = *(const bf16x8*)(wp + 16 * (sb * 8 + s)); w1[s] = *(const bf16x8*)(wp + 32 * 256 + 16 * (sb * 8 + s)); }
#pragma unroll
        for (int s = 0; s < 8; ++s) {
            const bf16x8 x0 = *(const bf16x8*)(yl + yl_off(fr, 2 * (sb * 8 + s) + fh));
            acc0 = __builtin_amdgcn_mfma_f32_32x32x16_bf16(w0[s], x0, acc0, 0, 0, 0);
            acc1 = __builtin_amdgcn_mfma_f32_32x32x16_bf16(w1[s], x0, acc1, 0, 0, 0);
        }
    }
    const float* pb = in.conv_pw_b + L * 256;
    {
        const int tok = t0 + fr;
        float4 bia[2][4];
#pragma unroll
        for (int jn = 0; jn < 2; ++jn)
#pragma unroll
            for (int g = 0; g < 4; ++g) bia[jn][g] = *(const float4*)(pb + wid * 64 + jn * 32 + 8 * g + 4 * fh);
        float ssq = 0.f;
#pragma unroll
        for (int jn = 0; jn < 2; ++jn)
#pragma unroll
            for (int g = 0; g < 4; ++g) {
                const int n = wid * 64 + jn * 32 + 8 * g + 4 * fh;
                const float4 b4 = bia[jn][g];
                const float o0 = (jn ? acc1[4 * g] : acc0[4 * g]) + b4.x, o1 = (jn ? acc1[4 * g + 1] : acc0[4 * g + 1]) + b4.y;
                const float o2 = (jn ? acc1[4 * g + 2] : acc0[4 * g + 2]) + b4.z, o3 = (jn ? acc1[4 * g + 3] : acc0[4 * g + 3]) + b4.w;
                ssq += o0 * o0 + o1 * o1 + o2 * o2 + o3 * o3;
                store4(w.yb + (size_t)tok * 1024 + 256 + n, o0, o1, o2, o3);
            }
        ssq = xor32(ssq);
        if (fh == 0) red[wid * 32 + fr] = ssq;
    }
    __syncthreads();
    if (tid < 32) w.ssq[(size_t)(t0 + tid) * 16 + 1] = red[tid] + red[32 + tid] + red[64 + tid] + red[96 + tid];
    __syncthreads();
}

__device__ void phase_mix(const Params& P, int L, char* lds, const int rep = 0, const bool dryrun = false) {
    const int tid = opaque_tid();
    const int x = blockIdx.x & 7;
    int* qctr = P.w.cnt + L * 256 + 72 + x + 8 * rep;
    volatile int* slot = (volatile int*)(lds + LDS_GEMM_BYTES - 16);
    if (tid == 0) *slot = atomicAdd(qctr, 1);
    __syncthreads();
    int cur = *slot;
    __syncthreads();
    while (cur < 304) {
        int nxt = 0;
        if (tid == 0) nxt = atomicAdd(qctr, 1);
#ifdef MIX_MASK
        const int mask = dryrun ? MIX_MASK : 15;
#else
        const int mask = 15;
#endif
#ifdef MIX_TWICE
        if (cur < 16) { if (MIX_TWICE & 1) sgu_item(P, L, cur * 8 + x, lds, tid); }
        else if (cur < 80) { if (MIX_TWICE & 2) conv_item(P, L, (cur - 16) * 8 + x, lds, tid); }
        else if (cur < 176) { if (MIX_TWICE & 4) { const int li = cur - 80; qkv_item(P, L, true, (li / 6) * 8 + x, li % 6, lds, tid); } }
        else { if (MIX_TWICE & 8) { const int li = cur - 176; qkv_item(P, L, false, (li >> 3) * 8 + x, li & 7, lds, tid); } }
#endif
        if (cur < 16) { if (mask & 1) sgu_item(P, L, cur * 8 + x, lds, tid); }
        else if (cur < 80) { if (mask & 2) conv_item(P, L, (cur - 16) * 8 + x, lds, tid); }
        else if (cur < 176) { if (mask & 4) { const int li = cur - 80; qkv_item(P, L, true, (li / 6) * 8 + x, li % 6, lds, tid); } }
        else { if (mask & 8) { const int li = cur - 176; qkv_item(P, L, false, (li >> 3) * 8 + x, li & 7, lds, tid); } }
        if (tid == 0) *slot = nxt;
        __syncthreads();
        cur = *slot;
        __syncthreads();
    }
}

}
namespace fx {

constexpr int AKN = 0, AKP = 8192, AVT = 12288, ATT_STAGE = 20480;
__device__ __forceinline__ void att_issue(const bf16_t* Kn, const bf16_t* Kp, const bf16_t* Vt, int k0, char* st, const int tid, const int wbase) {
    {
        const int row = tid >> 3, ch = (tid & 7) ^ ((tid >> 4) & 7);
        glds16(Kn + (size_t)(k0 + row) * 64 + ch * 8, st + AKN + wbase);
        glds16(Kn + (size_t)(k0 + row + 32) * 64 + ch * 8, st + AKN + 4096 + wbase);
    }
    {
        const int row = tid >> 2, ch = (tid & 3) ^ ((tid >> 4) & 3);
        glds16(Kp + (size_t)(k0 + row) * 32 + ch * 8, st + AKP + wbase);
    }
    {
        const int d = tid >> 3, ch = (tid & 7) ^ ((tid >> 4) & 7);
        glds16(Vt + (size_t)d * 2048 + k0 + ch * 8, st + AVT + wbase);
        glds16(Vt + (size_t)(d + 32) * 2048 + k0 + ch * 8, st + AVT + 4096 + wbase);
    }
}

__device__ void attn_unit(const Params& P, int b, int h, int qt, char* lds, const int tid) {
    const WS& w = P.w;
    const int lane = tid & 63, wid = tid >> 6, fr = lane & 31, fh = lane >> 5;
    const int wbase = __builtin_amdgcn_readfirstlane(wid) * 1024;
    const bf16_t* Kn = w.Knb + (size_t)(b * 8 + h) * 2048 * 64;
    const bf16_t* Kp = w.kpeb + (size_t)b * 2048 * 32;
    const bf16_t* Vt = w.VTb + (size_t)(b * 8 + h) * 64 * 2048;
    const int q0 = qt * 128, qw0 = q0 + wid * 32, qpos = qw0 + fr;
    bf16x8 qf[6];
    {
        const bf16_t* qp = w.Qb + ((size_t)(b * 8 + h) * 2048 + qpos) * 96 + 8 * fh;
#pragma unroll
        for (int ks = 0; ks < 6; ++ks) qf[ks] = *(const bf16x8*)(qp + 16 * ks);
    }
    f32x16 o0, o1;
#pragma unroll
    for (int r = 0; r < 16; ++r) { o0[r] = 0.f; o1[r] = 0.f; }
    float m = -1e30f, l = 0.f;
    const int nkt = 2 * (qt + 1);
    asm volatile("s_waitcnt vmcnt(0)" ::: "memory");
    att_issue(Kn, Kp, Vt, 0, lds, tid, wbase);
    if (nkt > 1) att_issue(Kn, Kp, Vt, 64, lds + ATT_STAGE, tid, wbase);
    const int kn0 = AKN + fr * 128, kn1 = AKN + (32 + fr) * 128, swn = (fr >> 1) & 7;
    const int kp0 = AKP + fr * 64, kp1 = AKP + (32 + fr) * 64, swp = (fr >> 2) & 3;
    const int vt0 = AVT + fr * 128 + 8 * fh, vt1 = AVT + (32 + fr) * 128 + 8 * fh, swv = (fr >> 1) & 7;
#pragma unroll 1
    for (int kt = 0; kt < nkt; ++kt) {
        if (kt + 1 < nkt) asm volatile("s_waitcnt vmcnt(5)" ::: "memory"); else asm volatile("s_waitcnt vmcnt(0)" ::: "memory");
        RAW_BARRIER();
        if (kt + 2 < nkt) att_issue(Kn, Kp, Vt, (kt + 2) * 64, lds + ((kt + 2) % 3) * ATT_STAGE, tid, wbase);
        const char* cur = lds + (kt % 3) * ATT_STAGE;
        const int k0 = kt * 64;
        if (k0 <= qw0 + 31) {
            f32x16 s0, s1;
#pragma unroll
            for (int r = 0; r < 16; ++r) { s0[r] = 0.f; s1[r] = 0.f; }
            {
                bf16x8 ka[6], kc[6];
#pragma unroll
                for (int ks = 0; ks < 4; ++ks) {
                    const int off = ((2 * ks + fh) ^ swn) << 4;
                    ka[ks] = *(const bf16x8*)(cur + kn0 + off); kc[ks] = *(const bf16x8*)(cur + kn1 + off);
                }
#pragma unroll
                for (int ks = 4; ks < 6; ++ks) {
                    const int off = ((2 * (ks - 4) + fh) ^ swp) << 4;
                    ka[ks] = *(const bf16x8*)(cur + kp0 + off); kc[ks] = *(const bf16x8*)(cur + kp1 + off);
                }
                __builtin_amdgcn_sched_barrier(0);
#pragma unroll
                for (int ks = 0; ks < 6; ++ks) {
                    s0 = __builtin_amdgcn_mfma_f32_32x32x16_bf16(ka[ks], qf[ks], s0, 0, 0, 0);
                    s1 = __builtin_amdgcn_mfma_f32_32x32x16_bf16(kc[ks], qf[ks], s1, 0, 0, 0);
                }
            }
            uint2 va0[4], va1[4], vb0[4], vb1[4];
#pragma unroll
            for (int ks = 0; ks < 4; ++ks) {
                const int c0 = ((2 * ks) ^ swv) << 4, c1 = ((2 * ks + 1) ^ swv) << 4;
                va0[ks] = *(const uint2*)(cur + vt0 + c0); va1[ks] = *(const uint2*)(cur + vt0 + c1);
                vb0[ks] = *(const uint2*)(cur + vt1 + c0); vb1[ks] = *(const uint2*)(cur + vt1 + c1);
            }
            __builtin_amdgcn_sched_barrier(0);
            if (k0 + 63 > qw0) {
#pragma unroll
                for (int r = 0; r < 16; ++r) {
                    const int key = k0 + nidx(r, fh);
                    if (key > qpos) s0[r] = -1e30f;
                    if (key + 32 > qpos) s1[r] = -1e30f;
                }
            }
            float mx = s0[0];
#pragma unroll
            for (int r = 1; r < 16; ++r) mx = fmaxf(mx, s0[r]);
#pragma unroll
            for (int r = 0; r < 16; ++r) mx = fmaxf(mx, s1[r]);
            mx = swap32_max(mx);
            const float mn = fmaxf(m, mx);
            const float alpha = __builtin_amdgcn_exp2f(m - mn);
            m = mn;
            float ps = 0.f;
#pragma unroll
            for (int r = 0; r < 16; ++r) { s0[r] = __builtin_amdgcn_exp2f(s0[r] - mn); ps += s0[r]; }
#pragma unroll
            for (int r = 0; r < 16; ++r) { s1[r] = __builtin_amdgcn_exp2f(s1[r] - mn); ps += s1[r]; }
            ps = swap32_sum(ps);
            l = l * alpha + ps;
#pragma unroll
            for (int r = 0; r < 16; ++r) { o0[r] *= alpha; o1[r] *= alpha; }
#pragma unroll
            for (int ks = 0; ks < 4; ++ks) {
                bf16x8 pf;
                {
                    const int rb = 8 * (ks & 1);
                    unsigned u0, u1, u2, u3;
                    if (ks < 2) { u0 = pack2(s0[rb], s0[rb + 1]); u1 = pack2(s0[rb + 2], s0[rb + 3]); u2 = pack2(s0[rb + 4], s0[rb + 5]); u3 = pack2(s0[rb + 6], s0[rb + 7]); }
                    else { u0 = pack2(s1[rb], s1[rb + 1]); u1 = pack2(s1[rb + 2], s1[rb + 3]); u2 = pack2(s1[rb + 4], s1[rb + 5]); u3 = pack2(s1[rb + 6], s1[rb + 7]); }
                    uint4 uu = make_uint4(u0, u1, u2, u3);
                    pf = __builtin_bit_cast(bf16x8, uu);
                }
                const bf16x8 vfa = __builtin_bit_cast(bf16x8, make_uint4(va0[ks].x, va0[ks].y, va1[ks].x, va1[ks].y));
                const bf16x8 vfb = __builtin_bit_cast(bf16x8, make_uint4(vb0[ks].x, vb0[ks].y, vb1[ks].x, vb1[ks].y));
                o0 = __builtin_amdgcn_mfma_f32_32x32x16_bf16(vfa, pf, o0, 0, 0, 0);
                o1 = __builtin_amdgcn_mfma_f32_32x32x16_bf16(vfb, pf, o1, 0, 0, 0);
            }
        }
    }
    RAW_BARRIER();
    const float inv = 1.f / l;
    const int tok = b * 2048 + qpos;
    float ssq = 0.f;
#pragma unroll
    for (int dt = 0; dt < 2; ++dt)
#pragma unroll
        for (int g = 0; g < 4; ++g) {
            float o[4];
#pragma unroll
            for (int q = 0; q < 4; ++q) { o[q] = (dt == 0 ? o0[4 * g + q] : o1[4 * g + q]) * inv; ssq += o[q] * o[q]; }
            store4(w.yb + (size_t)tok * 1024 + 512 + h * 64 + dt * 32 + 8 * g + 4 * fh, o[0], o[1], o[2], o[3]);
        }
    ssq = xor32(ssq);
    if (fh == 0) w.ssq[(size_t)tok * 16 + 8 + h] = ssq;
}

__device__ void phase_attn(const Params& P, int L, char* lds) {
    const int tid0 = opaque_tid();
    const int h = blockIdx.x & 7, nlb = gridDim.x >> 3;
    for (int li = blockIdx.x >> 3; li < 64; li += nlb) {
        int tid = tid0; asm volatile("" : "+v"(tid));
        const int p = li & 7, b = li >> 3;
        attn_unit(P, b, h, 15 - p, lds, tid);
        attn_unit(P, b, h, p, lds, tid);
    }
}

}
namespace fx {

__device__ __forceinline__ void acc_scale(f32x16 (&acc)[2][2], const float* f, const int tid) {
    const int lane = tid & 63, wr = tid >> 7, fr = lane & 31;
#pragma unroll
    for (int i = 0; i < 2; ++i) {
        const float v = f[wr * 64 + i * 32 + fr];
#pragma unroll
        for (int j = 0; j < 2; ++j)
#pragma unroll
            for (int r = 0; r < 16; ++r) acc[i][j][r] *= v;
    }
}
__device__ void phase_oproj(const Params& P, int L, char* lds, const bool dry = false) {
    const WS& w = P.w;
    const int tid0 = opaque_tid();
    float* T = (float*)lds; float* stat = (float*)(lds + STAT_OFF);
    const bf16_t* Wt = w.Wot + L * WO_SZ;
    int mt, nt;
    for (int it = 0; xcd_item(it, 128, 8, mt, nt); ++it) {
        int tid = tid0; asm volatile("" : "+v"(tid));
        const int lane = tid & 63, wid = tid >> 6;
        const int m0 = mt * 128, n0 = nt * 128;
        float rb_keep = 0.f;
        if (tid < 128) {
            const float* sq = w.ssq + (size_t)(m0 + tid) * 16;
            const float4 c0 = *(const float4*)(sq + 8), c1 = *(const float4*)(sq + 12);
            const float ra = rsq_(sq[0] * (1.f / 256.f) + EPS), rb = rsq_(sq[1] * (1.f / 256.f) + EPS);
            const float rc = rsq_((c0.x + c0.y + c0.z + c0.w + c1.x + c1.y + c1.z + c1.w) * (1.f / 512.f) + EPS);
            stat[tid] = rc / ra; stat[128 + tid] = ra / rb; rb_keep = rb;
        }
        {
            const bf16_t* arow[2]; const bf16_t* wrow[2];
#pragma unroll
            for (int i = 0; i < 2; ++i) {
                arow[i] = w.yb + (size_t)(m0 + (tid >> 2) + 64 * i) * 1024 + gl_chunk(tid) * 8;
                wrow[i] = Wt + (size_t)(n0 + (tid >> 2) + 64 * i) * 1024 + gl_chunk(tid) * 8;
            }
            f32x16 acc[2][2]; acc_zero(acc);
            gemm_mainloop_g<true>(acc, arow, wrow, 32, lds, tid, 16, 16, stat, 24, stat + 128);
            if (tid < 128) stat[tid] = rb_keep;
            acc_to_lds(acc, T, tid);
        }
        {
            const int sub = lane >> 4, c8 = (lane & 15) * 8;
            float4 hv0[8], hv1[8];
            if (L == 0) {
#pragma unroll
                for (int rr = 0; rr < 8; ++rr) {
                    const float4* hin = (const float4*)(P.in.x + (size_t)(m0 + wid * 32 + rr * 4 + sub) * 1024 + n0 + c8);
                    hv0[rr] = hin[0]; hv1[rr] = hin[1];
                }
            } else {
#pragma unroll
                for (int rr = 0; rr < 8; ++rr) {
                    const uint4 hh = *(const uint4*)(w.hb + (size_t)(m0 + wid * 32 + rr * 4 + sub) * 1024 + n0 + c8);
                    hv0[rr] = make_float4(bflo(hh.x), bfhi(hh.x), bflo(hh.y), bfhi(hh.y)); hv1[rr] = make_float4(bflo(hh.z), bfhi(hh.z), bflo(hh.w), bfhi(hh.w));
                }
            }
#pragma unroll
            for (int rr = 0; rr < 8; ++rr) {
                const int row = wid * 32 + rr * 4 + sub; const float rb = stat[row];
                const float4 x0 = *(const float4*)(T + row * TLD + c8), x1 = *(const float4*)(T + row * TLD + c8 + 4);
                float4 h0 = hv0[rr], h1 = hv1[rr];
                h0.x += x0.x * rb; h0.y += x0.y * rb; h0.z += x0.z * rb; h0.w += x0.w * rb;
                h1.x += x1.x * rb; h1.y += x1.y * rb; h1.z += x1.z * rb; h1.w += x1.w * rb;
                *(uint4*)(w.hb1 + (size_t)(m0 + row) * 1024 + n0 + c8) = pack8(h0, h1);
                const float sq = grp_sum16(sq8(h0, h1));
                if ((lane & 15) == 0) w.rssB[(size_t)(m0 + row) * 8 + nt] = sq;
            }
        }
        __syncthreads();
    }
}

__device__ void router_item(const Params& P, int L, int mt, char* lds, const int tid_in, const bool dry) {
    int tid = tid_in; asm volatile("" : "+v"(tid));
    const WS& w = P.w; const nv::Inputs& in = P.in;
    float* T = (float*)lds; float* stat = (float*)(lds + STAT_OFF); int* hist = (int*)(lds + STAT_OFF + 1024);
    const int m0 = mt * 128;
    {
        const bf16_t* arow[2]; const bf16_t* wrow[2];
#pragma unroll
        for (int i = 0; i < 2; ++i) {
            arow[i] = w.hb1 + (size_t)(m0 + (tid >> 2) + 64 * i) * 1024 + gl_chunk(tid) * 8;
            wrow[i] = w.Wrt + L * WR_SZ + (size_t)((tid >> 2) + 64 * i) * 1024 + gl_chunk(tid) * 8;
        }
        f32x16 acc[2][2]; acc_zero(acc);
        float my_rs = 0.f;
        if (tid < 128) my_rs = rstd8(w.rssB + (size_t)(m0 + tid) * 8, 1.f / 1024.f);
        gemm_mainloop_g(acc, arow, wrow, 32, lds, tid);
        if (tid < 128) stat[tid] = my_rs;
        if (tid < 64) hist[tid] = 0;
        acc_to_lds(acc, T, tid);
    }
    int e0 = 0, e1 = 0, r0 = 0, r1 = 0; float w0 = 0.f, w1 = 0.f;
    if (tid < 128) {
        const float rs = stat[tid];
        const float* lr = T + tid * TLD;
        const float* bg = in.router_group_b + L * 4; const float* be = in.router_expert_b + L * 32;
        int gi = 0; float gm = lr[0] * rs + bg[0];
#pragma unroll
        for (int j = 1; j < 4; ++j) { const float v = lr[j] * rs + bg[j]; if (v > gm) { gm = v; gi = j; } }
        float gs = 0.f;
#pragma unroll
        for (int j = 0; j < 4; ++j) gs += __builtin_amdgcn_exp2f(1.4426950408889634f * (lr[j] * rs + bg[j] - gm));
        const float gw = 1.f / gs;
        int i0 = 0, i1 = -1; float v0 = -3.0e38f, v1 = -3.0e38f;
#pragma unroll
        for (int j = 0; j < 8; ++j) {
            const float v = lr[4 + gi * 8 + j] * rs + be[gi * 8 + j];
            if (v > v0) { v1 = v0; i1 = i0; v0 = v; i0 = j; } else if (v > v1) { v1 = v; i1 = j; }
        }
        const float ex = __builtin_amdgcn_exp2f(1.4426950408889634f * (v1 - v0));
        w0 = gw / (1.f + ex); w1 = gw * ex / (1.f + ex);
        e0 = gi * 8 + i0; e1 = gi * 8 + i1;
        e0 = e0 * 2; e1 = e1 * 2 + 1;
        r0 = atomicAdd(&hist[e0], 1); r1 = atomicAdd(&hist[e1], 1);
    }
    __syncthreads();
    if (tid < 64) hist[64 + tid] = (hist[tid] && !dry) ? atomicAdd(&w.cnt[L * 256 + tid], hist[tid]) : 0;
    __syncthreads();
    if (tid < 128 && !dry) {
        const int tok = m0 + tid;
        const int p0 = hist[64 + e0] + r0, p1 = hist[64 + e1] + r1;
        w.elist[(size_t)e0 * NT + p0] = tok; w.ewt[(size_t)e0 * NT + p0] = w0;
        w.elist[(size_t)e1 * NT + p1] = tok; w.ewt[(size_t)e1 * NT + p1] = w1;
    }
    __syncthreads();
}
__device__ void eraw_item(const Params& P, int L, const int mt, const int nt, char* lds, const int tid_in) {
    int tid = tid_in; asm volatile("" : "+v"(tid));
    const WS& w = P.w; const nv::Inputs& in = P.in;
    const int lane = tid & 63, wid = tid >> 6;
    float* T = (float*)lds;
    const int m0 = mt * 128, n0 = nt * 128;
    {
        const float* arow[4]; const bf16_t* wrow[4];
#pragma unroll
        for (int i = 0; i < 4; ++i) {
            arow[i] = in.p + ((size_t)L * NT + m0 + (tid >> 3) + 32 * i) * 256 + (tid & 7) * 8;
            wrow[i] = w.Wpt + L * WP_SZ + (size_t)(n0 + (tid >> 3) + 32 * i) * 256 + (tid & 7) * 8;
        }
        f32x16 acc[2][2]; acc_zero(acc);
        float ss[4] = {0.f, 0.f, 0.f, 0.f};
        gemm_mainloop<float, false>(acc, arow, wrow, 4, lds, ss, tid);
        acc_to_lds(acc, T, tid);
    }
    {
        const int sub = lane >> 4, l16 = lane & 15, c8 = l16 * 8;
#pragma unroll 8
        for (int rr = 0; rr < 8; ++rr) {
            const int row = wid * 32 + rr * 4 + sub;
            const float4 x0 = *(const float4*)(T + row * TLD + c8), x1 = *(const float4*)(T + row * TLD + c8 + 4);
            *(uint4*)(w.erb + (size_t)(m0 + row) * 1024 + n0 + c8) = pack8(x0, x1);
            const float sq = grp_sum16(sq8(x0, x1));
            if (l16 == 0) w.essq[(size_t)(m0 + row) * 8 + nt] = sq;
        }
    }
    __syncthreads();
}
__device__ void phase_router(const Params& P, int L, char* lds, const bool dry = false) {
    const int tid = opaque_tid();
    {
        const int x = blockIdx.x & 7, lb = blockIdx.x >> 3, nlb = gridDim.x >> 3;
        if (lb < 16 || nlb <= 16) { for (int j = lb; j < 16; j += nlb) router_item(P, L, j * 8 + x, lds, tid, dry); }
        if (!dry) {
            if (nlb > 16) { if (lb >= 16) prep_moe_late(P, L, lds, tid, (lb - 16) * 8 + x, (nlb - 16) * 8); }
            else prep_moe_late(P, L, lds, tid, blockIdx.x, gridDim.x);
        }
    }
}

constexpr int TT_OFF = STAT_OFF + 1024;
__device__ __forceinline__ void moe_table(const Params& P, int L, char* lds, const int tid) {
    int* tt = (int*)(lds + TT_OFF);
    if (tid == 0) {
        const int x = blockIdx.x & 7;
        int o = 0;
        for (int li = 0; li < 64; ++li) { tt[li] = o; o += P.w.cnt[L * 256 + li]; }
        tt[64] = o;
        int t = 0, t0 = 0, t1 = 0;
        for (int k = 0; k < 8; ++k) {
            const int li = ((k >> 1) * 8 + x) * 2 + (k & 1), nt_ = (P.w.cnt[L * 256 + li] + 127) >> 7;
            tt[72 + k] = t; t += nt_;
            if (k & 1) { tt[92 + (k >> 1)] = t1; t1 += nt_; } else { tt[84 + (k >> 1)] = t0; t0 += nt_; }
        }
        tt[80] = t; tt[88] = t0; tt[96] = t1;
        int tu = 0;
        for (int k = 0; k < 4; ++k) { const int e = k * 8 + x; tt[100 + k] = tu; tu += (P.w.cnt[L * 256 + 2 * e] + P.w.cnt[L * 256 + 2 * e + 1] + 127) >> 7; }
        tt[104] = tu;
    }
    __syncthreads();
}
__device__ __forceinline__ void moe_find(const int* tt, int tile, int& li, int& t) {
    int k = 0;
#pragma unroll
    for (int j = 1; j < 8; ++j) if (tile >= tt[72 + j]) k = j;
    li = ((k >> 1) * 8 + (blockIdx.x & 7)) * 2 + (k & 1); t = tile - tt[72 + k];
}
__device__ __forceinline__ void moe_find_slot(const int* tt, int slot, int tile, int& li, int& t) {
    const int* tp = tt + (slot ? 92 : 84);
    int k = 0;
#pragma unroll
    for (int j = 1; j < 4; ++j) if (tile >= tp[j]) k = j;
    li = (k * 8 + (blockIdx.x & 7)) * 2 + slot; t = tile - tp[k];
}
__device__ void phase_moe_up(const Params& P, int L, char* lds, const bool noeraw = false) {
    const WS& w = P.w;
    const int tid0 = opaque_tid();
    float* T = (float*)lds; float* stat = (float*)(lds + STAT_OFF); const int* tt = (const int*)(lds + TT_OFF);
    moe_table(P, L, lds, tid0);
    const int ntiles = tt[104];
    for (int item = blockIdx.x >> 3; item < ntiles * 4; item += (gridDim.x >> 3)) {
        int tid = tid0; asm volatile("" : "+v"(tid));
        const int lane = tid & 63, wid = tid >> 6;
        const int tile = item >> 2, nt = item & 3;
        int k = 0;
#pragma unroll
        for (int j = 1; j < 4; ++j) if (tile >= tt[100 + j]) k = j;
        const int e = k * 8 + (blockIdx.x & 7), t = tile - tt[100 + k];
        const int cnt0 = P.w.cnt[L * 256 + 2 * e], cnt = cnt0 + P.w.cnt[L * 256 + 2 * e + 1];
        const int rbase = tt[2 * e] + t * 128, nrows = min(128, cnt - t * 128);
        {
            const bf16_t* arow[2]; const bf16_t* wrow[2];
#pragma unroll
            for (int i = 0; i < 2; ++i) {
                const int r = (tid >> 2) + 64 * i;
                const int rr3 = t * 128 + (r < nrows ? r : 0);
                const int tok = rr3 < cnt0 ? w.elist[(size_t)(2 * e) * NT + rr3] : w.elist[(size_t)(2 * e + 1) * NT + rr3 - cnt0];
                arow[i] = w.hb1 + (size_t)tok * 1024 + gl_chunk(tid) * 8;
                wrow[i] = w.Wgut + L * WGU_SZ + ((size_t)e * 512 + nt * 128 + r) * 1024 + gl_chunk(tid) * 8;
            }
            f32x16 acc[2][2]; acc_zero(acc);
            float my_rs = 0.f;
            if (tid < 128) {
                const int rr3 = t * 128 + (tid < nrows ? tid : 0);
                const int tok = rr3 < cnt0 ? w.elist[(size_t)(2 * e) * NT + rr3] : w.elist[(size_t)(2 * e + 1) * NT + rr3 - cnt0];
                my_rs = rstd8(w.rssB + (size_t)tok * 8, 1.f / 1024.f);
            }
            gemm_mainloop_g(acc, arow, wrow, 32, lds, tid);
            if (tid < 128) stat[tid] = my_rs;
            acc_to_lds(acc, T, tid);
        }
        {
            const int sub = lane >> 4, l16 = lane & 15, c8 = l16 * 8;
#pragma unroll 8
            for (int rr = 0; rr < 8; ++rr) {
                const int row = wid * 32 + rr * 4 + sub; const float rs = stat[row];
                const float4 x0 = mul4(*(const float4*)(T + row * TLD + c8), rs), x1 = mul4(*(const float4*)(T + row * TLD + c8 + 4), rs);
                if (row < nrows)
                    store4(w.hbuf + (size_t)(rbase + row) * 256 + nt * 64 + l16 * 4, x0.x * sigmoid_(x0.x) * x0.y, x0.z * sigmoid_(x0.z) * x0.w,
                           x1.x * sigmoid_(x1.x) * x1.y, x1.z * sigmoid_(x1.z) * x1.w);
            }
        }
        __syncthreads();
    }
    if (!noeraw) {
        int* qslot = (int*)(lds + TT_OFF + 256);
        for (;;) {
            if (tid0 == 0) *qslot = atomicAdd(&P.w.cnt[L * 256 + 64], 1);
            __syncthreads();
            const int item = *qslot;
            __syncthreads();
            if (item >= 1024) break;
            eraw_item(P, L, item >> 3, item & 7, lds, tid0);
        }
    }
}
__device__ void phase_moe_down(const Params& P, int L, char* lds, const int slot, const bool dry = false) {
    const WS& w = P.w;
    const int tid0 = opaque_tid();
    float* T = (float*)lds; float* stat = (float*)(lds + STAT_OFF); const int* tt = (const int*)(lds + TT_OFF);
    moe_table(P, L, lds, tid0);
    const int ntiles = tt[slot ? 96 : 88];
    for (int item = blockIdx.x >> 3; item < ntiles * 8; item += (gridDim.x >> 3)) {
        int tid = tid0; asm volatile("" : "+v"(tid));
        const int lane = tid & 63, wid = tid >> 6;
        const int tile = item >> 3, nt = item & 7;
        int li, t; moe_find_slot(tt, slot, tile, li, t);
        const int e = li >> 1;
        const int cnt = P.w.cnt[L * 256 + li], rbase = tt[li] + t * 128, nrows = min(128, cnt - t * 128);
        {
            const bf16_t* arow[2]; const bf16_t* wrow[2];
#pragma unroll
            for (int i = 0; i < 2; ++i) {
                const int r = (tid >> 2) + 64 * i;
                arow[i] = w.hbuf + (size_t)(rbase + (r < nrows ? r : 0)) * 256 + gl_chunk(tid) * 8;
                wrow[i] = w.Wdt + L * WD_SZ + ((size_t)e * 1024 + nt * 128 + r) * 256 + gl_chunk(tid) * 8;
            }
            f32x16 acc[2][2]; acc_zero(acc);
            int my_tok = 0; float my_wt = 0.f;
            if (tid < 128) { const int rr2 = tid < nrows ? tid : 0; my_tok = w.elist[(size_t)li * NT + t * 128 + rr2]; my_wt = w.ewt[(size_t)li * NT + t * 128 + rr2]; }
            gemm_mainloop_g(acc, arow, wrow, 8, lds, tid);
            if (tid < 128) { ((int*)stat)[tid] = my_tok; stat[128 + tid] = my_wt; }
            acc_to_lds(acc, T, tid);
        }
        {
            const int sub = lane >> 4, l16 = lane & 15, c8 = l16 * 8;
            uint4 hh[8];
#pragma unroll
            for (int rr = 0; rr < 8; ++rr) hh[rr] = *(const uint4*)(w.hb1 + (size_t)((const int*)stat)[wid * 32 + rr * 4 + sub] * 1024 + nt * 128 + c8);
#pragma unroll
            for (int rr = 0; rr < 8; ++rr) {
                const int row = wid * 32 + rr * 4 + sub;
                const int tok = ((const int*)stat)[row]; const float wt = stat[128 + row];
                const float4 x0 = *(const float4*)(T + row * TLD + c8), x1 = *(const float4*)(T + row * TLD + c8 + 4);
                const uint4 h = hh[rr];
                float4 h0, h1;
                h0.x = bflo(h.x) + wt * x0.x; h0.y = bfhi(h.x) + wt * x0.y; h0.z = bflo(h.y) + wt * x0.z; h0.w = bfhi(h.y) + wt * x0.w;
                h1.x = bflo(h.z) + wt * x1.x; h1.y = bfhi(h.z) + wt * x1.y; h1.z = bflo(h.w) + wt * x1.z; h1.w = bfhi(h.w) + wt * x1.w;
                const float sq = grp_sum16(sq8(h0, h1));
                if (row < nrows && !dry) {
                    *(uint4*)(w.hb1 + (size_t)tok * 1024 + nt * 128 + c8) = pack8(h0, h1);
                    if (slot && l16 == 0) w.rssB[(size_t)tok * 8 + nt] = sq;
                }
            }
        }
        __syncthreads();
    }
}

__device__ void phase_ple(const Params& P, int L, char* lds, const bool dry = false) {
    const WS& w = P.w; const nv::Inputs& in = P.in;
    const int tid0 = opaque_tid();
    float* T = (float*)lds; float* stat = (float*)(lds + STAT_OFF);
    int mt, nt;
    for (int it = 0; xcd_item(it, 128, 8, mt, nt); ++it) {
        int tid = tid0; asm volatile("" : "+v"(tid));
        const int lane = tid & 63, wid = tid >> 6;
        const int m0 = mt * 128, n0 = nt * 128;
        {
            const bf16_t* arow[2]; const bf16_t* wrow[2];
#pragma unroll
            for (int i = 0; i < 2; ++i) {
                arow[i] = w.hb1 + (size_t)(m0 + (tid >> 2) + 64 * i) * 1024 + gl_chunk(tid) * 8;
                wrow[i] = w.Wgt + L * WG_SZ + (size_t)(n0 + (tid >> 2) + 64 * i) * 1024 + gl_chunk(tid) * 8;
            }
            f32x16 acc[2][2]; acc_zero(acc);
            float my_rs = 0.f, my_re = 0.f;
            if (tid < 128) { my_rs = rstd8(w.rssB + (size_t)(m0 + tid) * 8, 1.f / 1024.f); my_re = rstd8(w.essq + (size_t)(m0 + tid) * 8, 1.f / 1024.f); }
            gemm_mainloop_g(acc, arow, wrow, 32, lds, tid);
            if (tid < 128) { stat[tid] = my_rs; stat[128 + tid] = my_re; }
            acc_to_lds(acc, T, tid);
        }
        {
            const int sub = lane >> 4, l16 = lane & 15, c8 = l16 * 8;
            const float4 pg0 = *(const float4*)(in.ple_post_norm_g + L * 1024 + n0 + c8), pg1 = *(const float4*)(in.ple_post_norm_g + L * 1024 + n0 + c8 + 4);
            uint4 hhv[8], erv[8];
#pragma unroll
            for (int rr = 0; rr < 8; ++rr) {
                const size_t off = (size_t)(m0 + wid * 32 + rr * 4 + sub) * 1024 + n0 + c8;
                hhv[rr] = *(const uint4*)(w.hb1 + off); erv[rr] = *(const uint4*)(w.erb + off);
            }
#pragma unroll
            for (int rr = 0; rr < 8; ++rr) {
                const int row = wid * 32 + rr * 4 + sub; const float rs = stat[row], re = stat[128 + row]; const size_t tok = m0 + row;
                const float4 x0 = mul4(*(const float4*)(T + row * TLD + c8), rs), x1 = mul4(*(const float4*)(T + row * TLD + c8 + 4), rs);
                const size_t off = tok * 1024 + n0 + c8;
                const uint4 er = erv[rr], hh = hhv[rr];
                float4 h0, h1;
                h0.x = bflo(hh.x) + sigmoid_(x0.x) * (bflo(er.x) * re * pg0.x); h0.y = bfhi(hh.x) + sigmoid_(x0.y) * (bfhi(er.x) * re * pg0.y);
                h0.z = bflo(hh.y) + sigmoid_(x0.z) * (bflo(er.y) * re * pg0.z); h0.w = bfhi(hh.y) + sigmoid_(x0.w) * (bfhi(er.y) * re * pg0.w);
                h1.x = bflo(hh.z) + sigmoid_(x1.x) * (bflo(er.z) * re * pg1.x); h1.y = bfhi(hh.z) + sigmoid_(x1.y) * (bfhi(er.z) * re * pg1.y);
                h1.z = bflo(hh.w) + sigmoid_(x1.z) * (bflo(er.w) * re * pg1.z); h1.w = bfhi(hh.w) + sigmoid_(x1.w) * (bfhi(er.w) * re * pg1.w);
                if (L == 1) { float4* op = (float4*)(P.h + off); op[0] = h0; op[1] = h1; }
                else {
                    *(uint4*)(w.hb + off) = pack8(h0, h1);
                    const float sq = grp_sum16(sq8(h0, h1));
                    if (l16 == 0) w.rssA[tok * 8 + nt] = sq;
                }
            }
        }
        __syncthreads();
    }
}

}
namespace fx {
#define XB_TMO      128
#define XB_XCNT(j)  (256  + 64 * (j))
#define XB_XSUB(j)  (1280 + 64 * (j))
#define XB_XGEN(j)  (2304 + 64 * (j))
#define XB_TOP      3328
#define XB_TOPGEN   3392
#define XCD_BAR_WORDS 3456
#define XB_SPIN_CAP (1u << 18)
#define LAS __attribute__((address_space(3)))
__device__ __forceinline__ unsigned xb_ld(unsigned* p)              { return __hip_atomic_load(p, __ATOMIC_RELAXED, __HIP_MEMORY_SCOPE_AGENT); }
__device__ __forceinline__ unsigned xb_add(unsigned* p, unsigned v) { return __hip_atomic_fetch_add(p, v, __ATOMIC_RELAXED, __HIP_MEMORY_SCOPE_AGENT); }
__device__ __forceinline__ unsigned xb_xcc_id() { return (unsigned)__builtin_amdgcn_s_getreg((3 << 11) | 20) & 0xFu; }
#define XB_SPIN(cond, bar) do { unsigned _sp = 0; while (cond) { __builtin_amdgcn_s_sleep(1); \
    if ((++_sp & 255u) == 0u) { if (xb_ld(&(bar)[XB_TMO])) break; if (_sp > XB_SPIN_CAP) { atomicAdd(&(bar)[XB_TMO], 1u); break; } } } } while (0)
struct XcdBarrier { unsigned* bar; unsigned x; volatile LAS unsigned* st; };
__device__ __forceinline__ XcdBarrier xcd_barrier_post(unsigned* bar, volatile LAS unsigned* st) {
    XcdBarrier b; b.bar = bar; b.x = xb_xcc_id(); b.st = st;
    if (threadIdx.x == 0) (void)xb_add(&bar[XB_XCNT(b.x)], 1u);
    return b;
}
__device__ __forceinline__ void xcd_barrier_complete(unsigned* bar, unsigned x, unsigned& nloc, unsigned& nx) {
    const unsigned G = gridDim.x * gridDim.y * gridDim.z;
    unsigned sum, cnt, mine, sp = 0u;
    for (;;) {
        sum = 0u; cnt = 0u; mine = 0u;
#pragma unroll
        for (unsigned j = 0; j < 16; ++j) { const unsigned c = xb_ld(&bar[XB_XCNT(j)]); sum += c; cnt += (c > 0u) ? 1u : 0u; mine = (j == x) ? c : mine; }
        if (sum == G) break;
        __builtin_amdgcn_s_sleep(1);
        if ((++sp & 255u) == 0u) { if (xb_ld(&bar[XB_TMO])) break; if (sp > XB_SPIN_CAP) { atomicAdd(&bar[XB_TMO], 1u); break; } }
    }
    nloc = mine > 0u ? mine : 1u; nx = cnt > 0u ? cnt : 1u;
}
__device__ __forceinline__ void xcd_barrier(const XcdBarrier& b) {
    asm volatile("s_waitcnt vmcnt(0)" ::: "memory");
    __syncthreads();
    if (threadIdx.x == 0) {
        unsigned* bar = b.bar;
        __builtin_amdgcn_s_waitcnt(0);
        unsigned nloc = b.st[0], nx = b.st[1];
        if (nloc == 0u) { xcd_barrier_complete(bar, b.x, nloc, nx); b.st[0] = nloc; b.st[1] = nx; }
        const unsigned old = xb_add(&bar[XB_XSUB(b.x)], 1u);
        const unsigned gen = old / nloc;
        if (old + 1u == (gen + 1u) * nloc) {
            __builtin_amdgcn_fence(__ATOMIC_RELEASE, "agent");
            asm volatile("s_waitcnt vmcnt(0)" ::: "memory");
            const unsigned og = xb_add(&bar[XB_TOP], 1u);
            const unsigned tg = og / nx;
            if (og + 1u == (tg + 1u) * nx) xb_add(&bar[XB_TOPGEN], 1u);
            else XB_SPIN(xb_ld(&bar[XB_TOPGEN]) == tg, bar);
            __builtin_amdgcn_fence(__ATOMIC_ACQUIRE, "agent");
            xb_add(&bar[XB_XGEN(b.x)], 1u);
            asm volatile("s_waitcnt vmcnt(0)" ::: "memory");
        } else {
            XB_SPIN(xb_ld(&bar[XB_XGEN(b.x)]) == gen, bar);
            __builtin_amdgcn_fence(__ATOMIC_ACQUIRE, "agent");
            asm volatile("s_waitcnt vmcnt(0)" ::: "memory");
        }
    }
    __syncthreads();
}

constexpr int LDS_BYTES = LDS_GEMM_BYTES + 16;
constexpr int N_PHASES = 19;
constexpr int PPL = 9;
__global__ void __launch_bounds__(256, 2) k_run(Params P, int ph_lo, int ph_hi) {
    extern __shared__ __attribute__((aligned(16))) char lds[];
    volatile LAS unsigned* st = (volatile LAS unsigned*)(lds + LDS_GEMM_BYTES);
    if (threadIdx.x == 0) { st[0] = 0u; st[1] = 0u; }
    __syncthreads();
    XcdBarrier xb = xcd_barrier_post(P.w.bar, st);
#ifdef EXTRA_BARRIERS
    for (int i = 0; i < EXTRA_BARRIERS; ++i) xcd_barrier(xb);
#endif
    for (int ph = ph_lo; ph < ph_hi; ++ph) {
        if (ph > ph_lo) xcd_barrier(xb);
        int reps = 1;
#ifdef REP_PHASE
        if (ph == 0 ? (REP_PHASE == 0) : (((ph - 1) % PPL) == REP_PHASE - 1)) reps = 2;
        asm volatile("" : "+s"(reps));
#endif
        for (int rep = 0; rep < reps; ++rep) {
            const bool dry = rep + 1 < reps;
            if (rep > 0) xcd_barrier(xb);
            if (ph == 0) phase_prep(P, lds);
            else {
                const int L = (ph - 1) / PPL, s = (ph - 1) % PPL;
                switch (s) {
                    case 0: phase_zgemm(P, L, lds); break;
                    case 1: phase_mix(P, L, lds, rep, dry); break;
                    case 2: phase_attn(P, L, lds); break;
                    case 3: phase_oproj(P, L, lds, dry); break;
                    case 4: phase_router(P, L, lds, dry); break;
                    case 5: phase_moe_up(P, L, lds, dry); break;
                    case 6: phase_moe_down(P, L, lds, 0, dry); break;
                    case 7: phase_moe_down(P, L, lds, 1, dry); break;
                    case 8: phase_ple(P, L, lds, dry); break;
                }
            }
        }
    }
}
}
#ifndef MK_N_LAUNCHES
#define MK_N_LAUNCHES 1
#endif
extern "C" void kernel_launch(void* const* d_in, const int* in_sizes, int n_in, void* d_out, int out_size, void* d_ws, size_t ws_size,
                              hipStream_t stream) {
    nv::Inputs in{};
    in.x = (const float*)d_in[0]; in.p = (const float*)d_in[1]; in.positions = (const int*)d_in[2];
    const float** f = &in.mix_norm_g;
    for (int i = 0; i < 32; ++i) f[i] = (const float*)d_in[3 + i];
    size_t used = 0;
    fx::WS w = fx::make_ws((char*)d_ws, used);
    static int grid = 0;
    if (grid == 0) {
        if (n_in != 35 || out_size != fx::NT * 1024 || used > ws_size) { fprintf(stderr, "kernel_launch: unexpected shapes / workspace (need %zu, have %zu)\n", used, ws_size); grid = -1; return; }
        if (hipFuncSetAttribute((const void*)fx::k_run, hipFuncAttributeMaxDynamicSharedMemorySize, fx::LDS_BYTES) != hipSuccess) { fprintf(stderr, "hipFuncSetAttribute failed\n"); grid = -1; return; }
        int dev = 0, cus = 0, per_cu = 0;
        hipGetDevice(&dev); hipDeviceGetAttribute(&cus, hipDeviceAttributeMultiprocessorCount, dev);
        hipOccupancyMaxActiveBlocksPerMultiprocessor(&per_cu, (const void*)fx::k_run, 256, fx::LDS_BYTES);
        if (per_cu > 2) per_cu = 2;
        if (per_cu < 1) { fprintf(stderr, "occupancy query says %d blocks/CU\n", per_cu); grid = -1; return; }
        grid = cus * per_cu;
    }
    if (grid < 0) return;
    fx::Params P{}; P.in = in; P.h = (float*)d_out; P.w = w;
    hipMemsetAsync(w.cnt, 0, 2 * 256 * 4, stream);
    hipMemsetAsync(w.bar, 0, XCD_BAR_WORDS * 4, stream);
    if (MK_N_LAUNCHES == 1) hipLaunchKernelGGL(fx::k_run, dim3(grid), dim3(256), fx::LDS_BYTES, stream, P, 0, fx::N_PHASES);
    else for (int ph = 0; ph < fx::N_PHASES; ++ph) hipLaunchKernelGGL(fx::k_run, dim3(grid), dim3(256), fx::LDS_BYTES, stream, P, ph, ph + 1);
}
```

```cpp
#include <hip/hip_runtime.h>
#include <hip/hip_bf16.h>
#include <stdint.h>
#include <cstdio>
namespace nv {
struct Inputs {
    const float *x, *p; const int* positions;
    const float *mix_norm_g, *w_in, *sgu_ln_g, *sgu_ln_b, *sgu_w, *sgu_b, *conv_w, *conv_b, *conv_ln_g, *conv_ln_b, *conv_pw_w, *conv_pw_b,
        *q_a_norm_g, *w_uq, *kv_a_norm_g, *w_ukv, *q_norm_g, *k_norm_g, *branch_norm_g, *w_o, *ffn_norm_g, *router_group_w, *router_group_b,
        *router_expert_w, *router_expert_b, *moe_w_gate, *moe_w_up, *moe_w_down, *ple_norm_g, *ple_gate_w, *ple_proj_w, *ple_post_norm_g;
};
}
namespace fx {

typedef unsigned short bf16_t;
typedef short bf16x8 __attribute__((ext_vector_type(8)));
typedef float f32x16 __attribute__((ext_vector_type(16)));
typedef float f32x4 __attribute__((ext_vector_type(4)));

constexpr int NT = 16384, SEQ = 2048, DM = 1024, NB = 8;
constexpr int ZN = 1536;
constexpr float EPS = 1e-6f;

typedef __bf16 bf16v2_t __attribute__((ext_vector_type(2)));
typedef float f32v2_t __attribute__((ext_vector_type(2)));
__device__ __forceinline__ unsigned pack2(float lo, float hi) {
    f32v2_t v; v.x = lo; v.y = hi;
    bf16v2_t b = __builtin_convertvector(v, bf16v2_t);
    return __builtin_bit_cast(unsigned, b);
}
__device__ __forceinline__ unsigned f2bf(float f) { return pack2(f, 0.f) & 0xffffu; }
__device__ __forceinline__ float bf2f(unsigned short b) { return __uint_as_float(((unsigned)b) << 16); }
__device__ __forceinline__ float bflo(unsigned u) { return __uint_as_float(u << 16); }
__device__ __forceinline__ float bfhi(unsigned u) { return __uint_as_float(u & 0xffff0000u); }
__device__ __forceinline__ float sigmoid_(float x) { return __builtin_amdgcn_rcpf(1.f + __builtin_amdgcn_exp2f(-1.4426950408889634f * x)); }
__device__ __forceinline__ float rsq_(float x) { return __builtin_amdgcn_rsqf(x); }
__device__ __forceinline__ float gelu_tanh_(float x) {
    float u = 0.7978845608028654f * (x + 0.044715f * x * x * x);
    return x * sigmoid_(2.f * u);
}
__device__ __forceinline__ int opaque_tid() { int t = threadIdx.x; asm volatile("" : "+v"(t)); return t; }
template <int CTRL> __device__ __forceinline__ float dpp_mov(float v) {
    return __builtin_bit_cast(float, __builtin_amdgcn_update_dpp(0, __builtin_bit_cast(int, v), CTRL, 0xf, 0xf, false));
}
__device__ __forceinline__ void swap16(float& a, float& b) { asm volatile("s_nop 1\n\tv_permlane16_swap_b32 %0, %1" : "+v"(a), "+v"(b)); }
__device__ __forceinline__ void swap32(float& a, float& b) { asm volatile("s_nop 1\n\tv_permlane32_swap_b32 %0, %1" : "+v"(a), "+v"(b)); }
__device__ __forceinline__ float swap16_sum(float v) { float a = v, b = v; swap16(a, b); return a + b; }
__device__ __forceinline__ float swap32_sum(float v) { float a = v, b = v; swap32(a, b); return a + b; }
__device__ __forceinline__ float swap32_max(float v) { float a = v, b = v; swap32(a, b); return fmaxf(a, b); }
__device__ __forceinline__ float grp_sum16(float v) { v += dpp_mov<0xB1>(v); v += dpp_mov<0x4E>(v); v += dpp_mov<0x124>(v); v += dpp_mov<0x128>(v); return v; }
__device__ __forceinline__ float grp_sum32(float v) { return swap16_sum(grp_sum16(v)); }
__device__ __forceinline__ float wave_sum64(float v) { return swap32_sum(grp_sum32(v)); }
__device__ __forceinline__ float grp_sum4(float v) { v += dpp_mov<0xB1>(v); v += dpp_mov<0x4E>(v); return v; }
__device__ __forceinline__ float grp_sum8(float v) { v = grp_sum4(v); v += dpp_mov<0x141>(v); return v; }
__device__ __forceinline__ float quad_x2(float v) { return dpp_mov<0x4E>(v); }
__device__ __forceinline__ float xor8(float v) { return dpp_mov<0x128>(v); }
__device__ __forceinline__ float xor32(float v) { return swap32_sum(v); }

struct WS {
    bf16_t *W1t, *Wuqt, *Wukvt, *Wpwt, *Wot, *Wrt, *Wgut, *Wdt, *Wgt, *Wpt, *Wsm;
    bf16_t *hb;
    bf16_t *hb1;
    bf16_t *ub;
    bf16_t *vT;
    bf16_t *ygb;
    bf16_t *cqb;
    bf16_t *ckvb;
    bf16_t *kpeb;
    bf16_t *Qb;
    bf16_t *Knb;
    bf16_t *VTb;
    bf16_t *yb;
    float  *ssq;
    float  *rssA;
    float  *rssB;
    float  *cqss;
    float  *cs;
    bf16_t *erb;
    float  *essq;
    bf16_t *hbuf;
    int    *cnt;
    int    *elist;
    float  *ewt;
    unsigned *bar;
};
constexpr size_t W1_SZ = (size_t)ZN * 1024, WUQ_SZ = 768 * 256, WUKV_SZ = 1024 * 128, WPW_SZ = 256 * 256, WO_SZ = 1024 * 1024, WR_SZ = 128 * 1024,
                 WGU_SZ = (size_t)32 * 512 * 1024, WD_SZ = (size_t)32 * 1024 * 256, WG_SZ = 1024 * 1024, WP_SZ = 1024 * 256, WSM_SZ = 4 * 128 * 128;

struct Params {
    nv::Inputs in;
    float* h;
    WS w;
};

static WS make_ws(char* base, size_t& used) {
    WS w{}; size_t o = 0;
    auto take = [&](size_t bytes) { char* p = base + o; o += (bytes + 255) & ~(size_t)255; return p; };
    w.W1t = (bf16_t*)take(2 * W1_SZ * 2);   w.Wuqt = (bf16_t*)take(2 * WUQ_SZ * 2); w.Wukvt = (bf16_t*)take(2 * WUKV_SZ * 2);
    w.Wpwt = (bf16_t*)take(2 * WPW_SZ * 2); w.Wot = (bf16_t*)take(2 * WO_SZ * 2);   w.Wrt = (bf16_t*)take(2 * WR_SZ * 2);
    w.Wgut = (bf16_t*)take(2 * WGU_SZ * 2); w.Wdt = (bf16_t*)take(2 * WD_SZ * 2);   w.Wgt = (bf16_t*)take(2 * WG_SZ * 2);
    w.Wpt = (bf16_t*)take(2 * WP_SZ * 2);   w.Wsm = (bf16_t*)take(2 * WSM_SZ * 2);
    w.hb = (bf16_t*)take((size_t)NT * 1024 * 2); w.hb1 = (bf16_t*)take((size_t)NT * 1024 * 2);
    w.ssq = (float*)take((size_t)NT * 16 * 4); w.cs = (float*)take((size_t)NT * 32 * 4);
    w.rssA = (float*)take((size_t)NT * 8 * 4); w.rssB = (float*)take((size_t)NT * 8 * 4); w.cqss = (float*)take((size_t)NT * 4 * 4);
    w.essq = (float*)take((size_t)NT * 8 * 4);
    w.cnt = (int*)take(2 * 256 * 4);
    w.elist = (int*)take((size_t)64 * NT * 4); w.ewt = (float*)take((size_t)64 * NT * 4);
    w.bar = (unsigned*)take(4096 * 4);
    const size_t region = o;
    w.ub = (bf16_t*)take((size_t)NT * 256 * 2); w.vT = (bf16_t*)take((size_t)NT * 256 * 2); w.ygb = (bf16_t*)take((size_t)NT * 256 * 2);
    w.cqb = (bf16_t*)take((size_t)NT * 256 * 2); w.ckvb = (bf16_t*)take((size_t)NT * 128 * 2); w.kpeb = (bf16_t*)take((size_t)NT * 32 * 2);
    w.Qb = (bf16_t*)take((size_t)NT * 768 * 2); w.Knb = (bf16_t*)take((size_t)NT * 512 * 2); w.VTb = (bf16_t*)take((size_t)NT * 512 * 2);
    w.yb = (bf16_t*)take((size_t)NT * 1024 * 2);
    const size_t region_end = o;
    o = region;
    w.hbuf = (bf16_t*)take((size_t)(2 * NT + 128) * 256 * 2);
    w.erb = (bf16_t*)take((size_t)NT * 1024 * 2);
    if (o > region_end) { fprintf(stderr, "make_ws: overlay exceeds mixer region\n"); }
    o = region_end;
    used = o;
    return w;
}

__device__ const double ROPE_INV[16] = {1.0, 0.5623413251903491, 0.31622776601683794, 0.1778279410038923, 0.1, 0.05623413251903491, 0.03162277660168379, 0.01778279410038923, 0.01, 0.005623413251903491, 0.0031622776601683794, 0.0017782794100389228, 0.001, 0.0005623413251903491, 0.00031622776601683794, 0.00017782794100389227};
__device__ __forceinline__ void rope_cs(int pos, int j, float& c, float& s) {
    const double ang = (double)pos * ROPE_INV[j];
    const double n = rint(ang * 0.15915494309189535);
    double r = fma(-n, 6.283185307179586, ang); r = fma(-n, 2.4492935982947064e-16, r);
    const double r2 = r * r;
    double sc = 1.0, ss = 1.0;
    double tc = 1.0, ts = 1.0;
#pragma unroll
    for (int k = 1; k <= 14; ++k) {
        tc *= -r2 / (double)((2 * k - 1) * (2 * k)); sc += tc;
        ts *= -r2 / (double)((2 * k) * (2 * k + 1)); ss += ts;
    }
    c = (float)sc; s = (float)(ss * r);
}

enum { MAP_ID = 0, MAP_W1 = 1, MAP_UQ = 2, MAP_UKV = 3, MAP_GATE = 4, MAP_UP = 5 };
template <int MAP> __device__ __forceinline__ int dstrow(int c) {
    if (MAP == MAP_W1) {
        if (c < 512) return c;
        if (c < 768) return 512 + 2 * (c - 512);
        if (c < 1024) return 513 + 2 * (c - 768);
        return c;
    } else if (MAP == MAP_UQ) {
        const int h = c / 96, d = c - h * 96; return d < 64 ? h * 64 + d : 512 + h * 32 + d - 64;
    } else if (MAP == MAP_UKV) {
        const int h = c >> 7, d = c & 127; return d < 64 ? h * 64 + d : 512 + h * 64 + d - 64;
    } else if (MAP == MAP_GATE) return 2 * c;
    else if (MAP == MAP_UP) return 2 * c + 1;
    return c;
}
#define PREP_LOAD(V0, V1, V2, V3, SRC, K0, C0) do { \
    const int kk_ = tid >> 4, c4_ = (tid & 15) * 4; \
    const float* p_ = (C0) + c4_ < Nsrc ? (SRC) + (size_t)((K0) + kk_) * ld + (C0) + c4_ : (SRC) + (size_t)((K0) + kk_) * ld; \
    V0 = *(const float4*)p_; V1 = *(const float4*)(p_ + (size_t)16 * ld); V2 = *(const float4*)(p_ + (size_t)32 * ld); V3 = *(const float4*)(p_ + (size_t)48 * ld); } while (0)
__device__ __forceinline__ void prep_put(float* tile, int kk, int c4, const float4& v, float sc) {
    float* t = tile + kk * 65 + c4; t[0] = v.x * sc; t[1] = v.y * sc; t[2] = v.z * sc; t[3] = v.w * sc;
}
template <int MAP>
__device__ void prep_job(const float* src, int ld, int Nsrc, size_t src_stride, const float* scale, bf16_t* dst, size_t dst_stride, int K, int nbatch, float* tiles, int& rot, const int tid, const int bi, const int G) {
    const int tn = (Nsrc + 63) / 64, tk = K / 64, per = tn * tk, total = per * nbatch;
    int t = (bi - rot + G) % G, buf = 0;
    float4 a0 = make_float4(0.f, 0.f, 0.f, 0.f), a1 = a0, a2 = a0, a3 = a0, b0 = a0, b1 = a0, b2 = a0, b3 = a0;
    if (t < total) { const int e = t / per, tt = t % per; PREP_LOAD(a0, a1, a2, a3, src + (size_t)e * src_stride, (tt / tn) * 64, (tt % tn) * 64); }
    for (; t < total; t += G) {
        const int e = t / per, tt = t % per, k0 = (tt / tn) * 64, c0 = (tt % tn) * 64;
        const int t2 = t + G;
        if (t2 < total) { const int e2 = t2 / per, tt2 = t2 % per; PREP_LOAD(b0, b1, b2, b3, src + (size_t)e2 * src_stride, (tt2 / tn) * 64, (tt2 % tn) * 64); }
        float* tile = tiles + buf * (64 * 65);
        {
            const int kk = tid >> 4, c4 = (tid & 15) * 4;
            const float s0 = scale ? scale[k0 + kk] : 1.f, s1 = scale ? scale[k0 + kk + 16] : 1.f, s2 = scale ? scale[k0 + kk + 32] : 1.f, s3 = scale ? scale[k0 + kk + 48] : 1.f;
            prep_put(tile, kk, c4, a0, s0); prep_put(tile, kk + 16, c4, a1, s1); prep_put(tile, kk + 32, c4, a2, s2); prep_put(tile, kk + 48, c4, a3, s3);
        }
        __syncthreads();
        bf16_t* d = dst + (size_t)e * dst_stride;
#pragma unroll
        for (int i = 0; i < 2; ++i) {
            const int idx = tid + 256 * i, c = idx >> 3, kc = idx & 7;
            if (c0 + c < Nsrc) {
                const float* q = tile + (kc * 8) * 65 + c;
                uint4 pk;
                pk.x = pack2(q[0], q[65]); pk.y = pack2(q[130], q[195]); pk.z = pack2(q[260], q[325]); pk.w = pack2(q[390], q[455]);
                *(uint4*)(d + (size_t)dstrow<MAP>(c0 + c) * K + k0 + kc * 8) = pk;
            }
        }
        a0 = b0; a1 = b1; a2 = b2; a3 = b3; buf ^= 1;
    }
    __syncthreads();
    rot = (rot + total) % G;
}

__device__ void phase_prep(const Params& P, char* lds) {
    float* tile = (float*)lds;
    const nv::Inputs& in = P.in; const WS& w = P.w;
    const int G = gridDim.x, bid = blockIdx.x, tid = opaque_tid();
    int rot = 0;
    for (int L = 0; L < 2; ++L) {
        if (L == 0) {
        prep_job<MAP_GATE>(in.moe_w_gate + (size_t)L * 32 * 1024 * 256, 256, 256, (size_t)1024 * 256, in.ffn_norm_g + L * 1024, w.Wgut + L * WGU_SZ, (size_t)512 * 1024, 1024, 32, tile, rot, tid, bid, G);
        prep_job<MAP_UP>(in.moe_w_up + (size_t)L * 32 * 1024 * 256, 256, 256, (size_t)1024 * 256, in.ffn_norm_g + L * 1024, w.Wgut + L * WGU_SZ, (size_t)512 * 1024, 1024, 32, tile, rot, tid, bid, G);
        prep_job<MAP_ID>(in.moe_w_down + (size_t)L * 32 * 256 * 1024, 1024, 1024, (size_t)256 * 1024, nullptr, w.Wdt + L * WD_SZ, (size_t)1024 * 256, 256, 32, tile, rot, tid, bid, G);
        }
        prep_job<MAP_W1>(in.w_in + (size_t)L * 1024 * 1440, 1440, 1440, 0, in.mix_norm_g + L * 1024, w.W1t + L * W1_SZ, 0, 1024, 1, tile, rot, tid, bid, G);
        prep_job<MAP_UQ>(in.w_uq + (size_t)L * 256 * 768, 768, 768, 0, in.q_a_norm_g + L * 256, w.Wuqt + L * WUQ_SZ, 0, 256, 1, tile, rot, tid, bid, G);
        prep_job<MAP_UKV>(in.w_ukv + (size_t)L * 128 * 1024, 1024, 1024, 0, in.kv_a_norm_g + L * 128, w.Wukvt + L * WUKV_SZ, 0, 128, 1, tile, rot, tid, bid, G);
        prep_job<MAP_ID>(in.conv_pw_w + (size_t)L * 256 * 256, 256, 256, 0, nullptr, w.Wpwt + L * WPW_SZ, 0, 256, 1, tile, rot, tid, bid, G);
        prep_job<MAP_ID>(in.w_o + (size_t)L * 1024 * 1024, 1024, 1024, 0, in.branch_norm_g + L * 1024, w.Wot + L * WO_SZ, 0, 1024, 1, tile, rot, tid, bid, G);
        prep_job<MAP_ID>(in.ple_gate_w + (size_t)L * 1024 * 1024, 1024, 1024, 0, in.ple_norm_g + L * 1024, w.Wgt + L * WG_SZ, 0, 1024, 1, tile, rot, tid, bid, G);
        prep_job<MAP_ID>(in.ple_proj_w + (size_t)L * 256 * 1024, 1024, 1024, 0, nullptr, w.Wpt + L * WP_SZ, 0, 256, 1, tile, rot, tid, bid, G);
        for (int i = bid * 256 + tid; i < 96 * 1024 / 8; i += G * 256) *(uint4*)(w.W1t + L * W1_SZ + (size_t)1440 * 1024 + (size_t)i * 8) = make_uint4(0u, 0u, 0u, 0u);
        for (int i = bid * 256 + tid; i < 128 * 1024; i += G * 256) {
            int n = i >> 10, k = i & 1023; float v = 0.f;
            if (n < 4) v = in.router_group_w[(size_t)L * 1024 * 4 + k * 4 + n];
            else if (n < 36) v = in.router_expert_w[(size_t)L * 1024 * 32 + k * 32 + (n - 4)];
            v *= in.ffn_norm_g[L * 1024 + k];
            w.Wrt[L * WR_SZ + i] = (bf16_t)f2bf(v);
        }
        for (int i = bid * 256 + tid; i < 4 * 128 * 128; i += G * 256) {
            int jj = i & 127, ii = (i >> 7) & 127;
            float v = (jj <= ii) ? in.sgu_w[(size_t)L * WSM_SZ + i] : 0.f;
            w.Wsm[L * WSM_SZ + i] = (bf16_t)f2bf(v);
        }
    }
    for (int i = bid * 256 + tid; i < NT * 16; i += G * 256) {
        int t = i >> 4, j = i & 15;
        float c, sn; rope_cs(in.positions[t], j, c, sn);
        w.cs[t * 32 + j] = c; w.cs[t * 32 + 16 + j] = sn;
    }
    for (int row = bid * 4 + (tid >> 6); row < NT; row += G * 4) {
        const int lane = tid & 63;
        float ss = 0.f;
#pragma unroll
        for (int j = 0; j < 4; ++j) {
            const size_t i = (size_t)row * 256 + j * 64 + lane;
            const float4 v = ((const float4*)in.x)[i];
            uint2 pk; pk.x = pack2(v.x, v.y); pk.y = pack2(v.z, v.w);
            ((uint2*)w.hb)[i] = pk;
            ss += v.x * v.x + v.y * v.y + v.z * v.z + v.w * v.w;
        }
        ss = wave_sum64(ss);
        if (lane < 8) w.rssA[(size_t)row * 8 + lane] = lane == 0 ? ss : 0.f;
    }
}

__device__ void prep_moe_late(const Params& P, int part, char* lds, const int tid, const int bi, const int nb) {
    float* tile = (float*)lds;
    const nv::Inputs& in = P.in; const WS& w = P.w;
    int rot = 0; const int L = 1;
    const float* up = in.moe_w_up + (size_t)L * 32 * 1024 * 256;
    if (part == 0) {
        prep_job<MAP_GATE>(in.moe_w_gate + (size_t)L * 32 * 1024 * 256, 256, 256, (size_t)1024 * 256, in.ffn_norm_g + L * 1024, w.Wgut + L * WGU_SZ, (size_t)512 * 1024, 1024, 32, tile, rot, tid, bi, nb);
        prep_job<MAP_UP>(up, 256, 256, (size_t)1024 * 256, in.ffn_norm_g + L * 1024, w.Wgut + L * WGU_SZ, (size_t)512 * 1024, 1024, 16, tile, rot, tid, bi, nb);
    } else {
        prep_job<MAP_UP>(up + (size_t)16 * 1024 * 256, 256, 256, (size_t)1024 * 256, in.ffn_norm_g + L * 1024, w.Wgut + L * WGU_SZ + (size_t)16 * 512 * 1024, (size_t)512 * 1024, 1024, 16, tile, rot, tid, bi, nb);
        prep_job<MAP_ID>(in.moe_w_down + (size_t)L * 32 * 256 * 1024, 1024, 1024, (size_t)256 * 1024, nullptr, w.Wdt + L * WD_SZ, (size_t)1024 * 256, 256, 32, tile, rot, tid, bi, nb);
    }
    __syncthreads();
}

__device__ __forceinline__ int lds_off(int row, int chunk) { return row * 128 + ((chunk ^ ((row >> 1) & 7)) << 4); }

template <typename AT> struct ARaw;
template <> struct ARaw<bf16_t> { uint4 v[4]; };
template <> struct ARaw<float> { float4 v[4][2]; };

__device__ __forceinline__ void a_load(ARaw<bf16_t>& r, const bf16_t* const (&rowp)[4], int koff) {
#pragma unroll
    for (int i = 0; i < 4; ++i) r.v[i] = *(const uint4*)(rowp[i] + koff);
}
__device__ __forceinline__ void a_load(ARaw<float>& r, const float* const (&rowp)[4], int koff) {
#pragma unroll
    for (int i = 0; i < 4; ++i) { r.v[i][0] = *(const float4*)(rowp[i] + koff); r.v[i][1] = *(const float4*)(rowp[i] + koff + 4); }
}
template <bool SUMSQ> __device__ __forceinline__ uint4 a_cvt(const uint4& v, float& ss) {
    if (SUMSQ) {
        float a;
        a = bflo(v.x); ss = fmaf(a, a, ss); a = bfhi(v.x); ss = fmaf(a, a, ss);
        a = bflo(v.y); ss = fmaf(a, a, ss); a = bfhi(v.y); ss = fmaf(a, a, ss);
        a = bflo(v.z); ss = fmaf(a, a, ss); a = bfhi(v.z); ss = fmaf(a, a, ss);
        a = bflo(v.w); ss = fmaf(a, a, ss); a = bfhi(v.w); ss = fmaf(a, a, ss);
    }
    return v;
}
template <bool SUMSQ> __device__ __forceinline__ void a_store(const ARaw<bf16_t>& r, char* ldsA, int tid, float (&ss)[4]) {
#pragma unroll
    for (int i = 0; i < 4; ++i) { uint4 v = a_cvt<SUMSQ>(r.v[i], ss[i]); *(uint4*)(ldsA + lds_off((tid >> 3) + 32 * i, tid & 7)) = v; }
}
template <bool SUMSQ> __device__ __forceinline__ void a_store(const ARaw<float>& r, char* ldsA, int tid, float (&ss)[4]) {
#pragma unroll
    for (int i = 0; i < 4; ++i) {
        const float4 a = r.v[i][0], b = r.v[i][1];
        if (SUMSQ) ss[i] += a.x * a.x + a.y * a.y + a.z * a.z + a.w * a.w + b.x * b.x + b.y * b.y + b.z * b.z + b.w * b.w;
        uint4 v; v.x = pack2(a.x, a.y); v.y = pack2(a.z, a.w); v.z = pack2(b.x, b.y); v.w = pack2(b.z, b.w);
        *(uint4*)(ldsA + lds_off((tid >> 3) + 32 * i, tid & 7)) = v;
    }
}

struct bf16x3_t {};
template <> struct ARaw<bf16x3_t> { uint4 a[4], b[4], c[4]; };
struct Rows3 { const bf16_t* p[2][4]; };
__device__ __forceinline__ void a_load(ARaw<bf16x3_t>& r, const Rows3& rows, int koff) {
#pragma unroll
    for (int i = 0; i < 4; ++i) { r.a[i] = *(const uint4*)(rows.p[0][i] + koff); r.b[i] = *(const uint4*)(rows.p[1][i] + koff); r.c[i] = *(const uint4*)(rows.p[1][i] + koff + 1024); }
}
__device__ __forceinline__ unsigned add3pk(unsigned a, unsigned b, unsigned c, float& ss) {
    const float lo = bflo(a) + bflo(b) + bflo(c), hi = bfhi(a) + bfhi(b) + bfhi(c);
    ss = fmaf(lo, lo, ss); ss = fmaf(hi, hi, ss);
    return pack2(lo, hi);
}
template <bool SUMSQ> __device__ __forceinline__ void a_store(const ARaw<bf16x3_t>& r, char* ldsA, int tid, float (&ss)[4]) {
#pragma unroll
    for (int i = 0; i < 4; ++i) {
        uint4 v;
        v.x = add3pk(r.a[i].x, r.b[i].x, r.c[i].x, ss[i]); v.y = add3pk(r.a[i].y, r.b[i].y, r.c[i].y, ss[i]);
        v.z = add3pk(r.a[i].z, r.b[i].z, r.c[i].z, ss[i]); v.w = add3pk(r.a[i].w, r.b[i].w, r.c[i].w, ss[i]);
        *(uint4*)(ldsA + lds_off((tid >> 3) + 32 * i, tid & 7)) = v;
    }
}

template <typename AT, bool SUMSQ, int SUNROLL = 4, typename AROWS>
__device__ __forceinline__ void gemm_mainloop(f32x16 (&acc)[2][2], const AROWS& arow, const bf16_t* const (&wrow)[4], int nkt, char* lds, float (&ss)[4], const int tid) {
    const int lane = tid & 63, wid = tid >> 6, wr = wid >> 1, wc = wid & 1;
    ARaw<AT> ra; ARaw<bf16_t> rb; float dummy[4] = {0.f, 0.f, 0.f, 0.f};
    a_load(ra, arow, 0); a_load(rb, wrow, 0);
    a_store<SUMSQ>(ra, lds, tid, ss); a_store<false>(rb, lds + 16384, tid, dummy);
    __syncthreads();
    const int fr = lane & 31, fh = lane >> 5;
#pragma unroll 1
    for (int kt = 0; kt < nkt; ++kt) {
        char* cur = lds + (kt & 1) * 32768;
        char* nxt = lds + ((kt + 1) & 1) * 32768;
        const bool more = (kt + 1 < nkt);
        if (more) { a_load(ra, arow, (kt + 1) * 64); a_load(rb, wrow, (kt + 1) * 64); }
#pragma unroll SUNROLL
        for (int s = 0; s < 4; ++s) {
            bf16x8 xa[2], wb[2];
#pragma unroll
            for (int i = 0; i < 2; ++i) xa[i] = *(const bf16x8*)(cur + lds_off(wr * 64 + i * 32 + fr, 2 * s + fh));
#pragma unroll
            for (int j = 0; j < 2; ++j) wb[j] = *(const bf16x8*)(cur + 16384 + lds_off(wc * 64 + j * 32 + fr, 2 * s + fh));
#pragma unroll
            for (int i = 0; i < 2; ++i)
#pragma unroll
                for (int j = 0; j < 2; ++j) acc[i][j] = __builtin_amdgcn_mfma_f32_32x32x16_bf16(wb[j], xa[i], acc[i][j], 0, 0, 0);
        }
        if (more) { a_store<SUMSQ>(ra, nxt, tid, ss); a_store<false>(rb, nxt + 16384, tid, dummy); }
        __syncthreads();
    }
}
constexpr int GST = 16384;
__device__ __forceinline__ int gl_chunk(int tid) { return (tid & 3) ^ ((tid >> 4) & 3); }
__device__ __forceinline__ int gl_off(int row, int chunk) { return row * 64 + ((chunk ^ ((row >> 2) & 3)) << 4); }
typedef __attribute__((address_space(3))) unsigned lds_u32_t;
__device__ __forceinline__ void glds16(const bf16_t* g, char* l) {
    __builtin_amdgcn_global_load_lds((const unsigned*)g, (lds_u32_t*)l, 16, 0, 0);
}
#define RAW_BARRIER() do { asm volatile("s_waitcnt lgkmcnt(0)" ::: "memory"); __builtin_amdgcn_s_barrier(); } while (0)
template <bool SEG = false>
__device__ __forceinline__ void gemm_mainloop_g(f32x16 (&acc)[2][2], const bf16_t* const (&arow)[2], const bf16_t* const (&wrow)[2], const int nkt, char* lds, const int tid,
                                                const int rot = 0, const int kt1 = -1, const float* f1 = nullptr, const int kt2 = -1, const float* f2 = nullptr) {
    const int lane = tid & 63, wid = tid >> 6, wr = wid >> 1, wc = wid & 1, fr = lane & 31, fh = lane >> 5;
    const int wbase = __builtin_amdgcn_readfirstlane(wid) * 1024;
#pragma unroll 1
    for (int p = 0; p < 3; ++p) if (p < nkt) {
        char* st = lds + p * GST + wbase;
        const int ko = SEG ? ((p + rot) & (nkt - 1)) * 32 : p * 32;
        glds16(arow[0] + ko, st); glds16(arow[1] + ko, st + 4096);
        glds16(wrow[0] + ko, st + 8192); glds16(wrow[1] + ko, st + 8192 + 4096);
    }
    const int ra0 = gl_off(wr * 64 + fr, fh), ra1 = gl_off(wr * 64 + 32 + fr, fh);
    const int rb0 = 8192 + gl_off(wc * 64 + fr, fh), rb1 = 8192 + gl_off(wc * 64 + 32 + fr, fh);
#pragma unroll 1
    for (int kt = 0; kt < nkt; ++kt) {
        if (kt + 2 < nkt) asm volatile("s_waitcnt vmcnt(8)" ::: "memory");
        else if (kt + 1 < nkt) asm volatile("s_waitcnt vmcnt(4)" ::: "memory");
        else asm volatile("s_waitcnt vmcnt(0)" ::: "memory");
        RAW_BARRIER();
        if (kt + 3 < nkt) {
            char* st = lds + ((kt + 3) & 3) * GST + wbase;
            const int ko = SEG ? ((kt + 3 + rot) & (nkt - 1)) * 32 : (kt + 3) * 32;
            glds16(arow[0] + ko, st); glds16(arow[1] + ko, st + 4096);
            glds16(wrow[0] + ko, st + 8192); glds16(wrow[1] + ko, st + 8192 + 4096);
        }
        const char* cur = lds + (kt & 3) * GST;
        if (SEG && (kt == kt1 || kt == kt2)) {
            const float* f = kt == kt1 ? f1 : f2;
#pragma unroll
            for (int i = 0; i < 2; ++i) {
                const float v = f[wr * 64 + i * 32 + fr];
#pragma unroll
                for (int j = 0; j < 2; ++j)
#pragma unroll
                    for (int r = 0; r < 16; ++r) acc[i][j][r] *= v;
            }
        }
        bf16x8 xa[2][2], wb[2][2];
#pragma unroll
        for (int s2 = 0; s2 < 2; ++s2) {
            xa[s2][0] = *(const bf16x8*)(cur + (ra0 ^ (s2 << 5))); xa[s2][1] = *(const bf16x8*)(cur + (ra1 ^ (s2 << 5)));
            wb[s2][0] = *(const bf16x8*)(cur + (rb0 ^ (s2 << 5))); wb[s2][1] = *(const bf16x8*)(cur + (rb1 ^ (s2 << 5)));
        }
        __builtin_amdgcn_sched_barrier(0);
#pragma unroll
        for (int s2 = 0; s2 < 2; ++s2) {
            acc[0][0] = __builtin_amdgcn_mfma_f32_32x32x16_bf16(wb[s2][0], xa[s2][0], acc[0][0], 0, 0, 0);
            acc[0][1] = __builtin_amdgcn_mfma_f32_32x32x16_bf16(wb[s2][1], xa[s2][0], acc[0][1], 0, 0, 0);
            acc[1][0] = __builtin_amdgcn_mfma_f32_32x32x16_bf16(wb[s2][0], xa[s2][1], acc[1][0], 0, 0, 0);
            acc[1][1] = __builtin_amdgcn_mfma_f32_32x32x16_bf16(wb[s2][1], xa[s2][1], acc[1][1], 0, 0, 0);
        }
    }
    RAW_BARRIER();
}
__device__ __forceinline__ int g64_chunk(int tid) { return (tid & 7) ^ ((tid >> 4) & 7); }
__device__ __forceinline__ void gemm_mainloop_g64(f32x16 (&acc)[2][2], const bf16_t* const (&arow)[4], const bf16_t* const (&wrow)[4], const int nkt, char* lds, const int tid) {
    const int lane = tid & 63, wid = tid >> 6, wr = wid >> 1, wc = wid & 1, fr = lane & 31, fh = lane >> 5;
    const int wbase = __builtin_amdgcn_readfirstlane(wid) * 1024;
    {
        char* st = lds + wbase;
#pragma unroll
        for (int i = 0; i < 4; ++i) { glds16(arow[i], st + i * 4096); glds16(wrow[i], st + 16384 + i * 4096); }
    }
#pragma unroll 1
    for (int kt = 0; kt < nkt; ++kt) {
        asm volatile("s_waitcnt vmcnt(0)" ::: "memory");
        RAW_BARRIER();
        if (kt + 1 < nkt) {
            char* st = lds + ((kt + 1) & 1) * 32768 + wbase;
            const int ko = (kt + 1) * 64;
#pragma unroll
            for (int i = 0; i < 4; ++i) { glds16(arow[i] + ko, st + i * 4096); glds16(wrow[i] + ko, st + 16384 + i * 4096); }
        }
        const char* cur = lds + (kt & 1) * 32768;
#pragma unroll
        for (int s = 0; s < 4; ++s) {
            bf16x8 xa[2], wb[2];
#pragma unroll
            for (int i = 0; i < 2; ++i) xa[i] = *(const bf16x8*)(cur + lds_off(wr * 64 + i * 32 + fr, 2 * s + fh));
#pragma unroll
            for (int j = 0; j < 2; ++j) wb[j] = *(const bf16x8*)(cur + 16384 + lds_off(wc * 64 + j * 32 + fr, 2 * s + fh));
#pragma unroll
            for (int i = 0; i < 2; ++i)
#pragma unroll
                for (int j = 0; j < 2; ++j) acc[i][j] = __builtin_amdgcn_mfma_f32_32x32x16_bf16(wb[j], xa[i], acc[i][j], 0, 0, 0);
        }
    }
    RAW_BARRIER();
}
__device__ __forceinline__ void acc_zero(f32x16 (&acc)[2][2]) {
#pragma unroll
    for (int i = 0; i < 2; ++i)
#pragma unroll
        for (int j = 0; j < 2; ++j)
#pragma unroll
            for (int r = 0; r < 16; ++r) acc[i][j][r] = 0.f;
}
__device__ __forceinline__ void publish_rowstat(float (&ss)[4], float* stat, float invK, bool as_rstd, const int tid) {
#pragma unroll
    for (int i = 0; i < 4; ++i) {
        float v = ss[i];
        v += __shfl_xor(v, 1); v += __shfl_xor(v, 2); v += __shfl_xor(v, 4);
        if ((tid & 7) == 0) stat[(tid >> 3) + 32 * i] = as_rstd ? rsqrtf(v * invK + EPS) : v;
    }
    __syncthreads();
}
__device__ __forceinline__ int nidx(int r, int fh) { return (r & 3) + 8 * (r >> 2) + 4 * fh; }
__device__ __forceinline__ uint4 pack8(const float4& a, const float4& b) { uint4 pk; pk.x = pack2(a.x, a.y); pk.y = pack2(a.z, a.w); pk.z = pack2(b.x, b.y); pk.w = pack2(b.z, b.w); return pk; }
__device__ __forceinline__ float sq8(const float4& a, const float4& b) { return (a.x * a.x + a.y * a.y) + (a.z * a.z + a.w * a.w) + (b.x * b.x + b.y * b.y) + (b.z * b.z + b.w * b.w); }
__device__ __forceinline__ float4 mul4(const float4& a, float s) { return make_float4(a.x * s, a.y * s, a.z * s, a.w * s); }
__device__ __forceinline__ void store4(bf16_t* p, float a, float b, float c, float d) {
    uint2 v; v.x = pack2(a, b); v.y = pack2(c, d); *(uint2*)p = v;
}

__device__ __forceinline__ bool xcd_item(int it, int MT, int NTl, int& mt, int& nt) {
    const int x = blockIdx.x & 7, lb = blockIdx.x >> 3, nlb = gridDim.x >> 3;
    const int li = it * nlb + lb, per = (MT >> 3) * NTl;
    if (li >= per) return false;
    mt = (li / NTl) * 8 + x; nt = li % NTl; return true;
}

constexpr int TLD = 132;
constexpr int STAT_OFF = 128 * TLD * 4;
constexpr int LDS_GEMM_BYTES = STAT_OFF + 2048;
__device__ __forceinline__ void acc_to_lds(const f32x16 (&acc)[2][2], float* T, const int tid) {
    const int lane = tid & 63, wid = tid >> 6, wr = wid >> 1, wc = wid & 1, fr = lane & 31, fh = lane >> 5;
#pragma unroll
    for (int i = 0; i < 2; ++i)
#pragma unroll
        for (int j = 0; j < 2; ++j)
#pragma unroll
            for (int g = 0; g < 4; ++g) {
                float4 v; v.x = acc[i][j][4 * g]; v.y = acc[i][j][4 * g + 1]; v.z = acc[i][j][4 * g + 2]; v.w = acc[i][j][4 * g + 3];
                *(float4*)(T + (wr * 64 + i * 32 + fr) * TLD + wc * 64 + j * 32 + 8 * g + 4 * fh) = v;
            }
    __syncthreads();
}
__device__ __forceinline__ float rstd8(const float* p, float invK) {
    const float4 a = *(const float4*)p, b = *(const float4*)(p + 4);
    return rsq_(((a.x + a.y) + (a.z + a.w) + (b.x + b.y) + (b.z + b.w)) * invK + EPS);
}

}
namespace fx {

__device__ void phase_zgemm(const Params& P, int L, char* lds, const bool same = false) {
    const WS& w = P.w; const nv::Inputs& in = P.in;
    const int tid0 = opaque_tid();
    float* T = (float*)lds; float* stat = (float*)(lds + STAT_OFF);
    const bf16_t* Wt = w.W1t + L * W1_SZ;
    int mt, nt;
    for (int it = 0; xcd_item(it, 128, 12, mt, nt); ++it) {
        int tid = tid0; asm volatile("" : "+v"(tid));
        const int lane = tid & 63, wid = tid >> 6;
        const int m0 = mt * 128, n0 = nt * 128;
        {
            const bf16_t* arow[4]; const bf16_t* wrow[4];
#pragma unroll
            for (int i = 0; i < 4; ++i) {
                arow[i] = w.hb + (size_t)(m0 + (tid >> 3) + 32 * i) * 1024 + g64_chunk(tid) * 8;
                wrow[i] = Wt + (size_t)(n0 + (tid >> 3) + 32 * i) * 1024 + g64_chunk(tid) * 8;
            }
            f32x16 acc[2][2]; acc_zero(acc);
            float my_rs = 0.f;
            if (tid < 128) my_rs = rstd8(w.rssA + (size_t)(m0 + tid) * 8, 1.f / 1024.f);
            gemm_mainloop_g64(acc, arow, wrow, 16, lds, tid);
            if (tid < 128) stat[tid] = my_rs;
            acc_to_lds(acc, T, tid);
        }
        const int sub = lane >> 4, l16 = lane & 15, c8 = l16 * 8;
        if (nt < 2) {
#pragma unroll 8
            for (int rr = 0; rr < 8; ++rr) {
                const int row = wid * 32 + rr * 4 + sub; const float rs = stat[row];
                float4 x0 = *(const float4*)(T + row * TLD + c8), x1 = *(const float4*)(T + row * TLD + c8 + 4);
                x0.x = gelu_tanh_(x0.x * rs); x0.y = gelu_tanh_(x0.y * rs); x0.z = gelu_tanh_(x0.z * rs); x0.w = gelu_tanh_(x0.w * rs);
                x1.x = gelu_tanh_(x1.x * rs); x1.y = gelu_tanh_(x1.y * rs); x1.z = gelu_tanh_(x1.z * rs); x1.w = gelu_tanh_(x1.w * rs);
                *(uint4*)(w.ub + (size_t)(m0 + row) * 256 + nt * 128 + c8) = pack8(x0, x1);
            }
        } else if (nt < 4) {
            const int hd = (nt - 2) * 2 + (l16 >> 3), d0 = (l16 & 7) * 8;
            const float4 g0 = *(const float4*)(in.sgu_ln_g + L * 256 + hd * 64 + d0), g1 = *(const float4*)(in.sgu_ln_g + L * 256 + hd * 64 + d0 + 4);
            const float4 b0 = *(const float4*)(in.sgu_ln_b + L * 256 + hd * 64 + d0), b1 = *(const float4*)(in.sgu_ln_b + L * 256 + hd * 64 + d0 + 4);
#pragma unroll 4
            for (int rr = 0; rr < 8; ++rr) {
                const int row = wid * 32 + rr * 4 + sub; const float rs = stat[row];
                float4 x0 = *(const float4*)(T + row * TLD + c8), x1 = *(const float4*)(T + row * TLD + c8 + 4);
                x0.x = gelu_tanh_(x0.x * rs); x0.y = gelu_tanh_(x0.y * rs); x0.z = gelu_tanh_(x0.z * rs); x0.w = gelu_tanh_(x0.w * rs);
                x1.x = gelu_tanh_(x1.x * rs); x1.y = gelu_tanh_(x1.y * rs); x1.z = gelu_tanh_(x1.z * rs); x1.w = gelu_tanh_(x1.w * rs);
                const float mean = grp_sum8((x0.x + x0.y) + (x0.z + x0.w) + (x1.x + x1.y) + (x1.z + x1.w)) * (1.f / 64.f);
                x0.x -= mean; x0.y -= mean; x0.z -= mean; x0.w -= mean; x1.x -= mean; x1.y -= mean; x1.z -= mean; x1.w -= mean;
                const float rv = rsq_(grp_sum8(sq8(x0, x1)) * (1.f / 64.f) + EPS);
                x0.x = x0.x * rv * g0.x + b0.x; x0.y = x0.y * rv * g0.y + b0.y; x0.z = x0.z * rv * g0.z + b0.z; x0.w = x0.w * rv * g0.w + b0.w;
                x1.x = x1.x * rv * g1.x + b1.x; x1.y = x1.y * rv * g1.y + b1.y; x1.z = x1.z * rv * g1.z + b1.z; x1.w = x1.w * rv * g1.w + b1.w;
                *(float4*)(T + row * TLD + c8) = x0; *(float4*)(T + row * TLD + c8 + 4) = x1;
            }
            __syncthreads();
            {
                const int c = tid & 127, th = tid >> 7, hd2 = (nt - 2) * 2 + (c >> 6), d = c & 63;
                bf16_t* dst = w.vT + ((size_t)(mt * 4 + hd2) * 64 + d) * 128 + th * 64;
#pragma unroll 2
                for (int k8 = 0; k8 < 8; ++k8) {
                    float v[8];
#pragma unroll
                    for (int k = 0; k < 8; ++k) v[k] = T[(th * 64 + k8 * 8 + k) * TLD + c];
                    uint4 pk; pk.x = pack2(v[0], v[1]); pk.y = pack2(v[2], v[3]); pk.z = pack2(v[4], v[5]); pk.w = pack2(v[6], v[7]);
                    *(uint4*)(dst + k8 * 8) = pk;
                }
            }
        } else if (nt < 8) {
#pragma unroll 8
            for (int rr = 0; rr < 8; ++rr) {
                const int row = wid * 32 + rr * 4 + sub; const float rs = stat[row];
                const float4 x0 = *(const float4*)(T + row * TLD + c8), x1 = *(const float4*)(T + row * TLD + c8 + 4);
                store4(w.ygb + (size_t)(m0 + row) * 256 + (nt - 4) * 64 + l16 * 4, x0.x * rs * sigmoid_(x0.y * rs), x0.z * rs * sigmoid_(x0.w * rs),
                       x1.x * rs * sigmoid_(x1.y * rs), x1.z * rs * sigmoid_(x1.w * rs));
            }
        } else if (nt < 11) {
            bf16_t* base; int ld, cb;
            if (nt < 10) { base = w.cqb; ld = 256; cb = (nt - 8) * 128; } else { base = w.ckvb; ld = 128; cb = 0; }
#pragma unroll 8
            for (int rr = 0; rr < 8; ++rr) {
                const int row = wid * 32 + rr * 4 + sub; const float rs = stat[row];
                const float4 x0 = mul4(*(const float4*)(T + row * TLD + c8), rs), x1 = mul4(*(const float4*)(T + row * TLD + c8 + 4), rs);
                *(uint4*)(base + (size_t)(m0 + row) * ld + cb + c8) = pack8(x0, x1);
                const float sq = grp_sum16(sq8(x0, x1));
                if (l16 == 0) w.cqss[(size_t)(m0 + row) * 4 + (nt - 8)] = sq;
            }
        } else {
            const int lq = l16 & 3, dd = lq * 8, jj = (lq & 1) * 8;
            const float4 kg0 = *(const float4*)(in.k_norm_g + L * 96 + 64 + dd), kg1 = *(const float4*)(in.k_norm_g + L * 96 + 64 + dd + 4);
#pragma unroll 1
            for (int hb4 = 0; hb4 < 2; ++hb4) {
                float4 cc0[4], cc1[4], ss0[4], ss1[4];
#pragma unroll
                for (int r4 = 0; r4 < 4; ++r4) {
                    const float* csr = w.cs + (size_t)(m0 + wid * 32 + (hb4 * 4 + r4) * 4 + sub) * 32 + jj;
                    cc0[r4] = *(const float4*)csr; cc1[r4] = *(const float4*)(csr + 4); ss0[r4] = *(const float4*)(csr + 16); ss1[r4] = *(const float4*)(csr + 20);
                }
#pragma unroll
                for (int r4 = 0; r4 < 4; ++r4) {
                    const int row = wid * 32 + (hb4 * 4 + r4) * 4 + sub; const float rs = stat[row]; const int tok = m0 + row;
                    float4 x0 = mul4(*(const float4*)(T + row * TLD + dd), rs), x1 = mul4(*(const float4*)(T + row * TLD + dd + 4), rs);
                    const float rn = rsq_(grp_sum4(sq8(x0, x1)) * (1.f / 32.f) + EPS);
                    x0.x *= rn * kg0.x; x0.y *= rn * kg0.y; x0.z *= rn * kg0.z; x0.w *= rn * kg0.w;
                    x1.x *= rn * kg1.x; x1.y *= rn * kg1.y; x1.z *= rn * kg1.z; x1.w *= rn * kg1.w;
                    const float4 o0 = make_float4(quad_x2(x0.x), quad_x2(x0.y), quad_x2(x0.z), quad_x2(x0.w)), o1 = make_float4(quad_x2(x1.x), quad_x2(x1.y), quad_x2(x1.z), quad_x2(x1.w));
                    const float4 c0 = cc0[r4], c1 = cc1[r4], s0 = ss0[r4], s1 = ss1[r4];
                    const float sg = (lq & 2) ? 1.f : -1.f;
                    float4 r0, r1;
                    r0.x = x0.x * c0.x + sg * o0.x * s0.x; r0.y = x0.y * c0.y + sg * o0.y * s0.y; r0.z = x0.z * c0.z + sg * o0.z * s0.z; r0.w = x0.w * c0.w + sg * o0.w * s0.w;
                    r1.x = x1.x * c1.x + sg * o1.x * s1.x; r1.y = x1.y * c1.y + sg * o1.y * s1.y; r1.z = x1.z * c1.z + sg * o1.z * s1.z; r1.w = x1.w * c1.w + sg * o1.w * s1.w;
                    if (l16 < 4) *(uint4*)(w.kpeb + (size_t)tok * 32 + dd) = pack8(r0, r1);
                }
            }
        }
        __syncthreads();
    }
}

}
namespace fx {

constexpr float QSCALE = 0.10206207261596575f * 1.4426950408889634f;

__device__ void qkv_item(const Params& P, int L, const bool isq, const int mt, const int nt, char* lds, const int tid_in) {
    int tid = tid_in; asm volatile("" : "+v"(tid));
    const WS& w = P.w; const nv::Inputs& in = P.in;
    const int lane = tid & 63, wid = tid >> 6;
    float* T = (float*)lds; float* stat = (float*)(lds + STAT_OFF);
    const int m0 = mt * 128, n0 = nt * 128;
    const int K = isq ? 256 : 128;
    {
        const bf16_t* A = isq ? w.cqb : w.ckvb;
        const bf16_t* Wt = isq ? (w.Wuqt + L * WUQ_SZ) : (w.Wukvt + L * WUKV_SZ);
        const bf16_t* arow[2]; const bf16_t* wrow[2];
#pragma unroll
        for (int i = 0; i < 2; ++i) {
            arow[i] = A + (size_t)(m0 + (tid >> 2) + 64 * i) * K + gl_chunk(tid) * 8;
            wrow[i] = Wt + (size_t)(n0 + (tid >> 2) + 64 * i) * K + gl_chunk(tid) * 8;
        }
        f32x16 acc[2][2]; acc_zero(acc);
        float my_rs = 0.f;
        if (tid < 128) {
            const float4 c = *(const float4*)(w.cqss + (size_t)(m0 + tid) * 4);
            my_rs = isq ? rsq_((c.x + c.y) * (1.f / 256.f) + EPS) : rsq_(c.z * (1.f / 128.f) + EPS);
        }
        gemm_mainloop_g(acc, arow, wrow, K / 32, lds, tid);
        if (tid < 128) stat[tid] = my_rs;
        acc_to_lds(acc, T, tid);
    }
    const int b = m0 >> 11, s0 = m0 & 2047;
    const int sub = lane >> 4, l16 = lane & 15, c8 = l16 * 8;
    if (isq && nt < 4) {
        const int hd = nt * 2 + (l16 >> 3), d = (l16 & 7) * 8;
        const float4 g0 = mul4(*(const float4*)(in.q_norm_g + L * 96 + d), QSCALE), g1 = mul4(*(const float4*)(in.q_norm_g + L * 96 + d + 4), QSCALE);
        bf16_t* dst = w.Qb + ((size_t)(b * 8 + hd) * 2048 + s0) * 96 + d;
#pragma unroll 8
        for (int rr = 0; rr < 8; ++rr) {
            const int row = wid * 32 + rr * 4 + sub; const float rs = stat[row];
            float4 x0 = mul4(*(const float4*)(T + row * TLD + c8), rs), x1 = mul4(*(const float4*)(T + row * TLD + c8 + 4), rs);
            const float rn = rsq_(grp_sum8(sq8(x0, x1)) * (1.f / 64.f) + EPS);
            x0.x *= rn * g0.x; x0.y *= rn * g0.y; x0.z *= rn * g0.z; x0.w *= rn * g0.w; x1.x *= rn * g1.x; x1.y *= rn * g1.y; x1.z *= rn * g1.z; x1.w *= rn * g1.w;
            *(uint4*)(dst + (size_t)row * 96) = pack8(x0, x1);
        }
    } else if (isq) {
        const int hd = (nt - 4) * 4 + (l16 >> 2), lq = l16 & 3, dd = lq * 8, jj = (lq & 1) * 8;
        const float4 g0 = *(const float4*)(in.q_norm_g + L * 96 + 64 + dd), g1 = *(const float4*)(in.q_norm_g + L * 96 + 64 + dd + 4);
        bf16_t* dst = w.Qb + ((size_t)(b * 8 + hd) * 2048 + s0) * 96 + 64 + dd;
        const float sg = (lq & 2) ? QSCALE : -QSCALE;
#pragma unroll 1
        for (int hb4 = 0; hb4 < 2; ++hb4) {
            float4 cc0[4], cc1[4], ss0[4], ss1[4];
#pragma unroll
            for (int r4 = 0; r4 < 4; ++r4) {
                const float* csr = w.cs + (size_t)(m0 + wid * 32 + (hb4 * 4 + r4) * 4 + sub) * 32 + jj;
                cc0[r4] = *(const float4*)csr; cc1[r4] = *(const float4*)(csr + 4); ss0[r4] = *(const float4*)(csr + 16); ss1[r4] = *(const float4*)(csr + 20);
            }
#pragma unroll
            for (int r4 = 0; r4 < 4; ++r4) {
                const int row = wid * 32 + (hb4 * 4 + r4) * 4 + sub; const float rs = stat[row];
                float4 x0 = mul4(*(const float4*)(T + row * TLD + c8), rs), x1 = mul4(*(const float4*)(T + row * TLD + c8 + 4), rs);
                const float rn = rsq_(grp_sum4(sq8(x0, x1)) * (1.f / 32.f) + EPS);
                x0.x *= rn * g0.x; x0.y *= rn * g0.y; x0.z *= rn * g0.z; x0.w *= rn * g0.w; x1.x *= rn * g1.x; x1.y *= rn * g1.y; x1.z *= rn * g1.z; x1.w *= rn * g1.w;
                const float4 o0 = make_float4(quad_x2(x0.x), quad_x2(x0.y), quad_x2(x0.z), quad_x2(x0.w)), o1 = make_float4(quad_x2(x1.x), quad_x2(x1.y), quad_x2(x1.z), quad_x2(x1.w));
                const float4 c0 = mul4(cc0[r4], QSCALE), c1 = mul4(cc1[r4], QSCALE), s0v = ss0[r4], s1v = ss1[r4];
                float4 r0, r1;
                r0.x = x0.x * c0.x + sg * o0.x * s0v.x; r0.y = x0.y * c0.y + sg * o0.y * s0v.y; r0.z = x0.z * c0.z + sg * o0.z * s0v.z; r0.w = x0.w * c0.w + sg * o0.w * s0v.w;
                r1.x = x1.x * c1.x + sg * o1.x * s1v.x; r1.y = x1.y * c1.y + sg * o1.y * s1v.y; r1.z = x1.z * c1.z + sg * o1.z * s1v.z; r1.w = x1.w * c1.w + sg * o1.w * s1v.w;
                *(uint4*)(dst + (size_t)row * 96) = pack8(r0, r1);
            }
        }
    } else if (nt < 4) {
        const int hd = nt * 2 + (l16 >> 3), d = (l16 & 7) * 8;
        const float4 g0 = *(const float4*)(in.k_norm_g + L * 96 + d), g1 = *(const float4*)(in.k_norm_g + L * 96 + d + 4);
        bf16_t* dst = w.Knb + ((size_t)(b * 8 + hd) * 2048 + s0) * 64 + d;
#pragma unroll 8
        for (int rr = 0; rr < 8; ++rr) {
            const int row = wid * 32 + rr * 4 + sub; const float rs = stat[row];
            float4 x0 = mul4(*(const float4*)(T + row * TLD + c8), rs), x1 = mul4(*(const float4*)(T + row * TLD + c8 + 4), rs);
            const float rn = rsq_(grp_sum8(sq8(x0, x1)) * (1.f / 64.f) + EPS);
            x0.x *= rn * g0.x; x0.y *= rn * g0.y; x0.z *= rn * g0.z; x0.w *= rn * g0.w; x1.x *= rn * g1.x; x1.y *= rn * g1.y; x1.z *= rn * g1.z; x1.w *= rn * g1.w;
            *(uint4*)(dst + (size_t)row * 64) = pack8(x0, x1);
        }
    } else {
        const int c = tid & 127, th = tid >> 7, hd = (nt - 4) * 2 + (c >> 6), d = c & 63;
        bf16_t* dst = w.VTb + ((size_t)(b * 8 + hd) * 64 + d) * 2048 + s0 + th * 64;
#pragma unroll 2
        for (int k8 = 0; k8 < 8; ++k8) {
            float v[8];
#pragma unroll
            for (int k = 0; k < 8; ++k) { const int row = th * 64 + k8 * 8 + k; v[k] = T[row * TLD + c] * stat[row]; }
            uint4 pk; pk.x = pack2(v[0], v[1]); pk.y = pack2(v[2], v[3]); pk.z = pack2(v[4], v[5]); pk.w = pack2(v[6], v[7]);
            *(uint4*)(dst + k8 * 8) = pk;
        }
    }
    __syncthreads();
}

__device__ void sgu_item(const Params& P, int L, int mt, char* lds, const int tid_in) {
    int tid = tid_in; asm volatile("" : "+v"(tid));
    const WS& w = P.w; const nv::Inputs& in = P.in;
    const int lane = tid & 63, hd = tid >> 6, fr = lane & 31, fh = lane >> 5;
    float* red = (float*)lds;
    const bf16_t* vt = w.vT + (size_t)(mt * 4 + hd) * 64 * 128;
    const bf16_t* ws = w.Wsm + L * WSM_SZ + (size_t)hd * 128 * 128;
    const float* bs = in.sgu_b + L * 512 + hd * 128;
    const int m0 = mt * 128;
    bf16x8 af0[8], af1[8];
    {
        const bf16_t* ap0 = vt + (size_t)fr * 128 + 8 * fh;
        const bf16_t* ap1 = vt + (size_t)(32 + fr) * 128 + 8 * fh;
#pragma unroll
        for (int s = 0; s < 8; ++s) { af0[s] = *(const bf16x8*)(ap0 + 16 * s); af1[s] = *(const bf16x8*)(ap1 + 16 * s); }
    }
#pragma unroll 1
    for (int it = 0; it < 4; ++it) {
        f32x16 a0, a1;
#pragma unroll
        for (int r = 0; r < 16; ++r) { a0[r] = 0.f; a1[r] = 0.f; }
        const bf16_t* bp = ws + (size_t)(it * 32 + fr) * 128 + 8 * fh;
        bf16x8 bfr[8];
#pragma unroll
        for (int s = 0; s < 8; ++s) bfr[s] = *(const bf16x8*)(bp + 16 * s);
#pragma unroll
        for (int s = 0; s < 8; ++s) {
            a0 = __builtin_amdgcn_mfma_f32_32x32x16_bf16(af0[s], bfr[s], a0, 0, 0, 0);
            a1 = __builtin_amdgcn_mfma_f32_32x32x16_bf16(af1[s], bfr[s], a1, 0, 0, 0);
        }
        const int i = it * 32 + fr, tok = m0 + i;
        const float bias = bs[i];
        uint2 uu[2][4];
#pragma unroll
        for (int dt = 0; dt < 2; ++dt)
#pragma unroll
            for (int g = 0; g < 4; ++g) uu[dt][g] = *(const uint2*)(w.ub + (size_t)tok * 256 + hd * 64 + dt * 32 + 8 * g + 4 * fh);
        float ssq = 0.f;
#pragma unroll
        for (int dt = 0; dt < 2; ++dt)
#pragma unroll
            for (int g = 0; g < 4; ++g) {
                const int d = dt * 32 + 8 * g + 4 * fh;
                float o[4];
#pragma unroll
                for (int q = 0; q < 4; ++q) {
                    const float sv = (dt == 0 ? a0[4 * g + q] : a1[4 * g + q]) + bias;
                    const float uv = (q == 0) ? bflo(uu[dt][g].x) : (q == 1) ? bfhi(uu[dt][g].x) : (q == 2) ? bflo(uu[dt][g].y) : bfhi(uu[dt][g].y);
                    o[q] = uv * sv; ssq += o[q] * o[q];
                }
                store4(w.yb + (size_t)tok * 1024 + hd * 64 + d, o[0], o[1], o[2], o[3]);
            }
        ssq = xor32(ssq);
        if (fh == 0) red[hd * 128 + i] = ssq;
    }
    __syncthreads();
    if (tid < 128) w.ssq[(size_t)(m0 + tid) * 16 + 0] = red[tid] + red[128 + tid] + red[256 + tid] + red[384 + tid];
    __syncthreads();
}

constexpr int CLD = 260, CONV_YL = 32 * CLD * 4, CONV_ST = CONV_YL + 32 * 512, CONV_RED = CONV_ST + 32 * 4 * 8;
__device__ __forceinline__ int yl_off(int row, int chunk) { return row * 512 + ((chunk ^ (row & 15)) << 4); }
__device__ void conv_item(const Params& P, int L, int ct, char* lds, const int tid_in) {
    int tid = tid_in; asm volatile("" : "+v"(tid));
    const WS& w = P.w; const nv::Inputs& in = P.in;
    const int lane = tid & 63, wid = tid >> 6, fr = lane & 31, fh = lane >> 5;
    float* C = (float*)lds; char* yl = lds + CONV_YL; float2* stats = (float2*)(lds + CONV_ST); float* red = (float*)(lds + CONV_RED);
    const int t0 = ct * 32, s0 = t0 & 2047;
    {
        const int c = tid;
        float x[62];
#pragma unroll
        for (int r = 0; r < 62; ++r) {
            const bool ok = s0 + r - 30 >= 0;
            const unsigned short raw = w.ygb[(size_t)(ok ? t0 + r - 30 : t0) * 256 + c];
            x[r] = bf2f(raw) * (ok ? 1.f : 0.f);
        }
        float wk[31];
#pragma unroll
        for (int k = 0; k < 31; ++k) wk[k] = in.conv_w[(size_t)L * 31 * 256 + k * 256 + c];
        const float cb = in.conv_b[L * 256 + c];
#pragma unroll
        for (int t = 0; t < 32; ++t) {
            float a = cb;
#pragma unroll
            for (int k = 0; k < 31; ++k) a = fmaf(wk[k], x[t + k], a);
            C[t * CLD + c] = a;
        }
    }
    __syncthreads();
    if (tid < 128) {
        const int t = tid >> 2, g = tid & 3;
        const float4* cp = (const float4*)(C + t * CLD + g * 64);
        float4 v[16]; float s = 0.f;
#pragma unroll
        for (int i = 0; i < 16; ++i) { v[i] = cp[i]; s += (v[i].x + v[i].y) + (v[i].z + v[i].w); }
        const float mean = s * (1.f / 64.f); float q = 0.f;
#pragma unroll
        for (int i = 0; i < 16; ++i) { const float a = v[i].x - mean, b2 = v[i].y - mean, c2 = v[i].z - mean, d2 = v[i].w - mean; q += (a * a + b2 * b2) + (c2 * c2 + d2 * d2); }
        stats[t * 4 + g] = make_float2(mean, rsq_(q * (1.f / 64.f) + EPS));
    }
    __syncthreads();
    {
        const int c = tid, g = c >> 6;
        const float lg = in.conv_ln_g[L * 256 + c], lb = in.conv_ln_b[L * 256 + c];
#pragma unroll 8
        for (int t = 0; t < 32; ++t) {
            const float2 st = stats[t * 4 + g];
            const float v = (C[t * CLD + c] - st.x) * st.y * lg + lb;
            *(bf16_t*)(yl + yl_off(t, c >> 3) + (c & 7) * 2) = (bf16_t)f2bf(v * sigmoid_(v));
        }
    }
    __syncthreads();
    f32x16 acc0, acc1;
#pragma unroll
    for (int r = 0; r < 16; ++r) { acc0[r] = 0.f; acc1[r] = 0.f; }
    const bf16_t* wp = w.Wpwt + L * WPW_SZ + (size_t)(wid * 64 + fr) * 256 + 8 * fh;
#pragma unroll 1
    for (int sb = 0; sb < 2; ++sb) {
        bf16x8 w0[8], w1[8];
#pragma unroll
        for (int s = 0; s < 8; ++s) { w0[s] = *(const bf16x8*)(wp + 16 * (sb * 8 + s)); w1[s] = *(const bf16x8*)(wp + 32 * 256 + 16 * (sb * 8 + s)); }
#pragma unroll
        for (int s = 0; s < 8; ++s) {
            const bf16x8 x0 = *(const bf16x8*)(yl + yl_off(fr, 2 * (sb * 8 + s) + fh));
            acc0 = __builtin_amdgcn_mfma_f32_32x32x16_bf16(w0[s], x0, acc0, 0, 0, 0);
            acc1 = __builtin_amdgcn_mfma_f32_32x32x16_bf16(w1[s], x0, acc1, 0, 0, 0);
        }
    }
    const float* pb = in.conv_pw_b + L * 256;
    {
        const int tok = t0 + fr;
        float4 bia[2][4];
#pragma unroll
        for (int jn = 0; jn < 2; ++jn)
#pragma unroll
            for (int g = 0; g < 4; ++g) bia[jn][g] = *(const float4*)(pb + wid * 64 + jn * 32 + 8 * g + 4 * fh);
        float ssq = 0.f;
#pragma unroll
        for (int jn = 0; jn < 2; ++jn)
#pragma unroll
            for (int g = 0; g < 4; ++g) {
                const int n = wid * 64 + jn * 32 + 8 * g + 4 * fh;
                const float4 b4 = bia[jn][g];
                const float o0 = (jn ? acc1[4 * g] : acc0[4 * g]) + b4.x, o1 = (jn ? acc1[4 * g + 1] : acc0[4 * g + 1]) + b4.y;
                const float o2 = (jn ? acc1[4 * g + 2] : acc0[4 * g + 2]) + b4.z, o3 = (jn ? acc1[4 * g + 3] : acc0[4 * g + 3]) + b4.w;
                ssq += o0 * o0 + o1 * o1 + o2 * o2 + o3 * o3;
                store4(w.yb + (size_t)tok * 1024 + 256 + n, o0, o1, o2, o3);
            }
        ssq = xor32(ssq);
        if (fh == 0) red[wid * 32 + fr] = ssq;
    }
    __syncthreads();
    if (tid < 32) w.ssq[(size_t)(t0 + tid) * 16 + 1] = red[tid] + red[32 + tid] + red[64 + tid] + red[96 + tid];
    __syncthreads();
}

__device__ void phase_mix(const Params& P, int L, char* lds, const int rep = 0, const bool dryrun = false) {
    const int tid = opaque_tid();
    const int x = blockIdx.x & 7;
    int* qctr = P.w.cnt + L * 256 + 72 + x + 8 * rep;
    volatile int* slot = (volatile int*)(lds + LDS_GEMM_BYTES - 16);
    if (tid == 0) *slot = atomicAdd(qctr, 1);
    __syncthreads();
    int cur = *slot;
    __syncthreads();
    while (cur < 304) {
        int nxt = 0;
        if (tid == 0) nxt = atomicAdd(qctr, 1);
#ifdef MIX_MASK
        const int mask = dryrun ? MIX_MASK : 15;
#else
        const int mask = 15;
#endif
#ifdef MIX_TWICE
        if (cur < 16) { if (MIX_TWICE & 1) sgu_item(P, L, cur * 8 + x, lds, tid); }
        else if (cur < 80) { if (MIX_TWICE & 2) conv_item(P, L, (cur - 16) * 8 + x, lds, tid); }
        else if (cur < 176) { if (MIX_TWICE & 4) { const int li = cur - 80; qkv_item(P, L, true, (li / 6) * 8 + x, li % 6, lds, tid); } }
        else { if (MIX_TWICE & 8) { const int li = cur - 176; qkv_item(P, L, false, (li >> 3) * 8 + x, li & 7, lds, tid); } }
#endif
        if (cur < 16) { if (mask & 1) sgu_item(P, L, cur * 8 + x, lds, tid); }
        else if (cur < 80) { if (mask & 2) conv_item(P, L, (cur - 16) * 8 + x, lds, tid); }
        else if (cur < 176) { if (mask & 4) { const int li = cur - 80; qkv_item(P, L, true, (li / 6) * 8 + x, li % 6, lds, tid); } }
        else { if (mask & 8) { const int li = cur - 176; qkv_item(P, L, false, (li >> 3) * 8 + x, li & 7, lds, tid); } }
        if (tid == 0) *slot = nxt;
        __syncthreads();
        cur = *slot;
        __syncthreads();
    }
}

}
namespace fx {

constexpr int AKN = 0, AKP = 8192, AVT = 12288, ATT_STAGE = 20480;
__device__ __forceinline__ void att_issue(const bf16_t* Kn, const bf16_t* Kp, const bf16_t* Vt, int k0, char* st, const int tid, const int wbase) {
    {
        const int row = tid >> 3, ch = (tid & 7) ^ ((tid >> 4) & 7);
        glds16(Kn + (size_t)(k0 + row) * 64 + ch * 8, st + AKN + wbase);
        glds16(Kn + (size_t)(k0 + row + 32) * 64 + ch * 8, st + AKN + 4096 + wbase);
    }
    {
        const int row = tid >> 2, ch = (tid & 3) ^ ((tid >> 4) & 3);
        glds16(Kp + (size_t)(k0 + row) * 32 + ch * 8, st + AKP + wbase);
    }
    {
        const int d = tid >> 3, ch = (tid & 7) ^ ((tid >> 4) & 7);
        glds16(Vt + (size_t)d * 2048 + k0 + ch * 8, st + AVT + wbase);
        glds16(Vt + (size_t)(d + 32) * 2048 + k0 + ch * 8, st + AVT + 4096 + wbase);
    }
}

__device__ void attn_unit(const Params& P, int b, int h, int qt, char* lds, const int tid) {
    const WS& w = P.w;
    const int lane = tid & 63, wid = tid >> 6, fr = lane & 31, fh = lane >> 5;
    const int wbase = __builtin_amdgcn_readfirstlane(wid) * 1024;
    const bf16_t* Kn = w.Knb + (size_t)(b * 8 + h) * 2048 * 64;
    const bf16_t* Kp = w.kpeb + (size_t)b * 2048 * 32;
    const bf16_t* Vt = w.VTb + (size_t)(b * 8 + h) * 64 * 2048;
    const int q0 = qt * 128, qw0 = q0 + wid * 32, qpos = qw0 + fr;
    bf16x8 qf[6];
    {
        const bf16_t* qp = w.Qb + ((size_t)(b * 8 + h) * 2048 + qpos) * 96 + 8 * fh;
#pragma unroll
        for (int ks = 0; ks < 6; ++ks) qf[ks] = *(const bf16x8*)(qp + 16 * ks);
    }
    f32x16 o0, o1;
#pragma unroll
    for (int r = 0; r < 16; ++r) { o0[r] = 0.f; o1[r] = 0.f; }
    float m = -1e30f, l = 0.f;
    const int nkt = 2 * (qt + 1);
    asm volatile("s_waitcnt vmcnt(0)" ::: "memory");
    att_issue(Kn, Kp, Vt, 0, lds, tid, wbase);
    if (nkt > 1) att_issue(Kn, Kp, Vt, 64, lds + ATT_STAGE, tid, wbase);
    const int kn0 = AKN + fr * 128, kn1 = AKN + (32 + fr) * 128, swn = (fr >> 1) & 7;
    const int kp0 = AKP + fr * 64, kp1 = AKP + (32 + fr) * 64, swp = (fr >> 2) & 3;
    const int vt0 = AVT + fr * 128 + 8 * fh, vt1 = AVT + (32 + fr) * 128 + 8 * fh, swv = (fr >> 1) & 7;
#pragma unroll 1
    for (int kt = 0; kt < nkt; ++kt) {
        if (kt + 1 < nkt) asm volatile("s_waitcnt vmcnt(5)" ::: "memory"); else asm volatile("s_waitcnt vmcnt(0)" ::: "memory");
        RAW_BARRIER();
        if (kt + 2 < nkt) att_issue(Kn, Kp, Vt, (kt + 2) * 64, lds + ((kt + 2) % 3) * ATT_STAGE, tid, wbase);
        const char* cur = lds + (kt % 3) * ATT_STAGE;
        const int k0 = kt * 64;
        if (k0 <= qw0 + 31) {
            f32x16 s0, s1;
#pragma unroll
            for (int r = 0; r < 16; ++r) { s0[r] = 0.f; s1[r] = 0.f; }
            {
                bf16x8 ka[6], kc[6];
#pragma unroll
                for (int ks = 0; ks < 4; ++ks) {
                    const int off = ((2 * ks + fh) ^ swn) << 4;
                    ka[ks] = *(const bf16x8*)(cur + kn0 + off); kc[ks] = *(const bf16x8*)(cur + kn1 + off);
                }
#pragma unroll
                for (int ks = 4; ks < 6; ++ks) {
                    const int off = ((2 * (ks - 4) + fh) ^ swp) << 4;
                    ka[ks] = *(const bf16x8*)(cur + kp0 + off); kc[ks] = *(const bf16x8*)(cur + kp1 + off);
                }
                __builtin_amdgcn_sched_barrier(0);
#pragma unroll
                for (int ks = 0; ks < 6; ++ks) {
                    s0 = __builtin_amdgcn_mfma_f32_32x32x16_bf16(ka[ks], qf[ks], s0, 0, 0, 0);
                    s1 = __builtin_amdgcn_mfma_f32_32x32x16_bf16(kc[ks], qf[ks], s1, 0, 0, 0);
                }
            }
            uint2 va0[4], va1[4], vb0[4], vb1[4];
#pragma unroll
            for (int ks = 0; ks < 4; ++ks) {
                const int c0 = ((2 * ks) ^ swv) << 4, c1 = ((2 * ks + 1) ^ swv) << 4;
                va0[ks] = *(const uint2*)(cur + vt0 + c0); va1[ks] = *(const uint2*)(cur + vt0 + c1);
                vb0[ks] = *(const uint2*)(cur + vt1 + c0); vb1[ks] = *(const uint2*)(cur + vt1 + c1);
            }
            __builtin_amdgcn_sched_barrier(0);
            if (k0 + 63 > qw0) {
#pragma unroll
                for (int r = 0; r < 16; ++r) {
                    const int key = k0 + nidx(r, fh);
                    if (key > qpos) s0[r] = -1e30f;
                    if (key + 32 > qpos) s1[r] = -1e30f;
                }
            }
            float mx = s0[0];
#pragma unroll
            for (int r = 1; r < 16; ++r) mx = fmaxf(mx, s0[r]);
#pragma unroll
            for (int r = 0; r < 16; ++r) mx = fmaxf(mx, s1[r]);
            mx = swap32_max(mx);
            const float mn = fmaxf(m, mx);
            const float alpha = __builtin_amdgcn_exp2f(m - mn);
            m = mn;
            float ps = 0.f;
#pragma unroll
            for (int r = 0; r < 16; ++r) { s0[r] = __builtin_amdgcn_exp2f(s0[r] - mn); ps += s0[r]; }
#pragma unroll
            for (int r = 0; r < 16; ++r) { s1[r] = __builtin_amdgcn_exp2f(s1[r] - mn); ps += s1[r]; }
            ps = swap32_sum(ps);
            l = l * alpha + ps;
#pragma unroll
            for (int r = 0; r < 16; ++r) { o0[r] *= alpha; o1[r] *= alpha; }
#pragma unroll
            for (int ks = 0; ks < 4; ++ks) {
                bf16x8 pf;
                {
                    const int rb = 8 * (ks & 1);
                    unsigned u0, u1, u2, u3;
                    if (ks < 2) { u0 = pack2(s0[rb], s0[rb + 1]); u1 = pack2(s0[rb + 2], s0[rb + 3]); u2 = pack2(s0[rb + 4], s0[rb + 5]); u3 = pack2(s0[rb + 6], s0[rb + 7]); }
                    else { u0 = pack2(s1[rb], s1[rb + 1]); u1 = pack2(s1[rb + 2], s1[rb + 3]); u2 = pack2(s1[rb + 4], s1[rb + 5]); u3 = pack2(s1[rb + 6], s1[rb + 7]); }
                    uint4 uu = make_uint4(u0, u1, u2, u3);
                    pf = __builtin_bit_cast(bf16x8, uu);
                }
                const bf16x8 vfa = __builtin_bit_cast(bf16x8, make_uint4(va0[ks].x, va0[ks].y, va1[ks].x, va1[ks].y));
                const bf16x8 vfb = __builtin_bit_cast(bf16x8, make_uint4(vb0[ks].x, vb0[ks].y, vb1[ks].x, vb1[ks].y));
                o0 = __builtin_amdgcn_mfma_f32_32x32x16_bf16(vfa, pf, o0, 0, 0, 0);
                o1 = __builtin_amdgcn_mfma_f32_32x32x16_bf16(vfb, pf, o1, 0, 0, 0);
            }
        }
    }
    RAW_BARRIER();
    const float inv = 1.f / l;
    const int tok = b * 2048 + qpos;
    float ssq = 0.f;
#pragma unroll
    for (int dt = 0; dt < 2; ++dt)
#pragma unroll
        for (int g = 0; g < 4; ++g) {
            float o[4];
#pragma unroll
            for (int q = 0; q < 4; ++q) { o[q] = (dt == 0 ? o0[4 * g + q] : o1[4 * g + q]) * inv; ssq += o[q] * o[q]; }
            store4(w.yb + (size_t)tok * 1024 + 512 + h * 64 + dt * 32 + 8 * g + 4 * fh, o[0], o[1], o[2], o[3]);
        }
    ssq = xor32(ssq);
    if (fh == 0) w.ssq[(size_t)tok * 16 + 8 + h] = ssq;
}

__device__ void phase_attn(const Params& P, int L, char* lds) {
    const int tid0 = opaque_tid();
    const int h = blockIdx.x & 7, nlb = gridDim.x >> 3;
    for (int li = blockIdx.x >> 3; li < 64; li += nlb) {
        int tid = tid0; asm volatile("" : "+v"(tid));
        const int p = li & 7, b = li >> 3;
        attn_unit(P, b, h, 15 - p, lds, tid);
        attn_unit(P, b, h, p, lds, tid);
    }
}

}
namespace fx {

__device__ __forceinline__ void acc_scale(f32x16 (&acc)[2][2], const float* f, const int tid) {
    const int lane = tid & 63, wr = tid >> 7, fr = lane & 31;
#pragma unroll
    for (int i = 0; i < 2; ++i) {
        const float v = f[wr * 64 + i * 32 + fr];
#pragma unroll
        for (int j = 0; j < 2; ++j)
#pragma unroll
            for (int r = 0; r < 16; ++r) acc[i][j][r] *= v;
    }
}
__device__ void phase_oproj(const Params& P, int L, char* lds, const bool dry = false) {
    const WS& w = P.w;
    const int tid0 = opaque_tid();
    float* T = (float*)lds; float* stat = (float*)(lds + STAT_OFF);
    const bf16_t* Wt = w.Wot + L * WO_SZ;
    int mt, nt;
    for (int it = 0; xcd_item(it, 128, 8, mt, nt); ++it) {
        int tid = tid0; asm volatile("" : "+v"(tid));
        const int lane = tid & 63, wid = tid >> 6;
        const int m0 = mt * 128, n0 = nt * 128;
        float rb_keep = 0.f;
        if (tid < 128) {
            const float* sq = w.ssq + (size_t)(m0 + tid) * 16;
            const float4 c0 = *(const float4*)(sq + 8), c1 = *(const float4*)(sq + 12);
            const float ra = rsq_(sq[0] * (1.f / 256.f) + EPS), rb = rsq_(sq[1] * (1.f / 256.f) + EPS);
            const float rc = rsq_((c0.x + c0.y + c0.z + c0.w + c1.x + c1.y + c1.z + c1.w) * (1.f / 512.f) + EPS);
            stat[tid] = rc / ra; stat[128 + tid] = ra / rb; rb_keep = rb;
        }
        {
            const bf16_t* arow[2]; const bf16_t* wrow[2];
#pragma unroll
            for (int i = 0; i < 2; ++i) {
                arow[i] = w.yb + (size_t)(m0 + (tid >> 2) + 64 * i) * 1024 + gl_chunk(tid) * 8;
                wrow[i] = Wt + (size_t)(n0 + (tid >> 2) + 64 * i) * 1024 + gl_chunk(tid) * 8;
            }
            f32x16 acc[2][2]; acc_zero(acc);
            gemm_mainloop_g<true>(acc, arow, wrow, 32, lds, tid, 16, 16, stat, 24, stat + 128);
            if (tid < 128) stat[tid] = rb_keep;
            acc_to_lds(acc, T, tid);
        }
        {
            const int sub = lane >> 4, c8 = (lane & 15) * 8;
            float4 hv0[8], hv1[8];
            if (L == 0) {
#pragma unroll
                for (int rr = 0; rr < 8; ++rr) {
                    const float4* hin = (const float4*)(P.in.x + (size_t)(m0 + wid * 32 + rr * 4 + sub) * 1024 + n0 + c8);
                    hv0[rr] = hin[0]; hv1[rr] = hin[1];
                }
            } else {
#pragma unroll
                for (int rr = 0; rr < 8; ++rr) {
                    const uint4 hh = *(const uint4*)(w.hb + (size_t)(m0 + wid * 32 + rr * 4 + sub) * 1024 + n0 + c8);
                    hv0[rr] = make_float4(bflo(hh.x), bfhi(hh.x), bflo(hh.y), bfhi(hh.y)); hv1[rr] = make_float4(bflo(hh.z), bfhi(hh.z), bflo(hh.w), bfhi(hh.w));
                }
            }
#pragma unroll
            for (int rr = 0; rr < 8; ++rr) {
                const int row = wid * 32 + rr * 4 + sub; const float rb = stat[row];
                const float4 x0 = *(const float4*)(T + row * TLD + c8), x1 = *(const float4*)(T + row * TLD + c8 + 4);
                float4 h0 = hv0[rr], h1 = hv1[rr];
                h0.x += x0.x * rb; h0.y += x0.y * rb; h0.z += x0.z * rb; h0.w += x0.w * rb;
                h1.x += x1.x * rb; h1.y += x1.y * rb; h1.z += x1.z * rb; h1.w += x1.w * rb;
                *(uint4*)(w.hb1 + (size_t)(m0 + row) * 1024 + n0 + c8) = pack8(h0, h1);
                const float sq = grp_sum16(sq8(h0, h1));
                if ((lane & 15) == 0) w.rssB[(size_t)(m0 + row) * 8 + nt] = sq;
            }
        }
        __syncthreads();
    }
}

__device__ void router_item(const Params& P, int L, int mt, char* lds, const int tid_in, const bool dry) {
    int tid = tid_in; asm volatile("" : "+v"(tid));
    const WS& w = P.w; const nv::Inputs& in = P.in;
    float* T = (float*)lds; float* stat = (float*)(lds + STAT_OFF); int* hist = (int*)(lds + STAT_OFF + 1024);
    const int m0 = mt * 128;
    {
        const bf16_t* arow[4]; const bf16_t* wrow[4];
#pragma unroll
        for (int i = 0; i < 4; ++i) {
            arow[i] = w.hb1 + (size_t)(m0 + (tid >> 3) + 32 * i) * 1024 + g64_chunk(tid) * 8;
            wrow[i] = w.Wrt + L * WR_SZ + (size_t)((tid >> 3) + 32 * i) * 1024 + g64_chunk(tid) * 8;
        }
        f32x16 acc[2][2]; acc_zero(acc);
        float my_rs = 0.f;
        if (tid < 128) my_rs = rstd8(w.rssB + (size_t)(m0 + tid) * 8, 1.f / 1024.f);
        gemm_mainloop_g64(acc, arow, wrow, 16, lds, tid);
        if (tid < 128) stat[tid] = my_rs;
        if (tid < 64) hist[tid] = 0;
        acc_to_lds(acc, T, tid);
    }
    int e0 = 0, e1 = 0, r0 = 0, r1 = 0; float w0 = 0.f, w1 = 0.f;
    if (tid < 128) {
        const float rs = stat[tid];
        const float* lr = T + tid * TLD;
        const float* bg = in.router_group_b + L * 4; const float* be = in.router_expert_b + L * 32;
        int gi = 0; float gm = lr[0] * rs + bg[0];
#pragma unroll
        for (int j = 1; j < 4; ++j) { const float v = lr[j] * rs + bg[j]; if (v > gm) { gm = v; gi = j; } }
        float gs = 0.f;
#pragma unroll
        for (int j = 0; j < 4; ++j) gs += __builtin_amdgcn_exp2f(1.4426950408889634f * (lr[j] * rs + bg[j] - gm));
        const float gw = 1.f / gs;
        int i0 = 0, i1 = -1; float v0 = -3.0e38f, v1 = -3.0e38f;
#pragma unroll
        for (int j = 0; j < 8; ++j) {
            const float v = lr[4 + gi * 8 + j] * rs + be[gi * 8 + j];
            if (v > v0) { v1 = v0; i1 = i0; v0 = v; i0 = j; } else if (v > v1) { v1 = v; i1 = j; }
        }
        const float ex = __builtin_amdgcn_exp2f(1.4426950408889634f * (v1 - v0));
        w0 = gw / (1.f + ex); w1 = gw * ex / (1.f + ex);
        e0 = gi * 8 + i0; e1 = gi * 8 + i1;
        e0 = e0 * 2; e1 = e1 * 2 + 1;
        r0 = atomicAdd(&hist[e0], 1); r1 = atomicAdd(&hist[e1], 1);
    }
    __syncthreads();
    if (tid < 64) hist[64 + tid] = (hist[tid] && !dry) ? atomicAdd(&w.cnt[L * 256 + tid], hist[tid]) : 0;
    __syncthreads();
    if (tid < 128 && !dry) {
        const int tok = m0 + tid;
        const int p0 = hist[64 + e0] + r0, p1 = hist[64 + e1] + r1;
        w.elist[(size_t)e0 * NT + p0] = tok; w.ewt[(size_t)e0 * NT + p0] = w0;
        w.elist[(size_t)e1 * NT + p1] = tok; w.ewt[(size_t)e1 * NT + p1] = w1;
    }
    __syncthreads();
}
__device__ void eraw_item(const Params& P, int L, const int mt, const int nt, char* lds, const int tid_in) {
    int tid = tid_in; asm volatile("" : "+v"(tid));
    const WS& w = P.w; const nv::Inputs& in = P.in;
    const int lane = tid & 63, wid = tid >> 6;
    float* T = (float*)lds;
    const int m0 = mt * 128, n0 = nt * 128;
    {
        const float* arow[4]; const bf16_t* wrow[4];
#pragma unroll
        for (int i = 0; i < 4; ++i) {
            arow[i] = in.p + ((size_t)L * NT + m0 + (tid >> 3) + 32 * i) * 256 + (tid & 7) * 8;
            wrow[i] = w.Wpt + L * WP_SZ + (size_t)(n0 + (tid >> 3) + 32 * i) * 256 + (tid & 7) * 8;
        }
        f32x16 acc[2][2]; acc_zero(acc);
        float ss[4] = {0.f, 0.f, 0.f, 0.f};
        gemm_mainloop<float, false>(acc, arow, wrow, 4, lds, ss, tid);
        acc_to_lds(acc, T, tid);
    }
    {
        const int sub = lane >> 4, l16 = lane & 15, c8 = l16 * 8;
#pragma unroll 8
        for (int rr = 0; rr < 8; ++rr) {
            const int row = wid * 32 + rr * 4 + sub;
            const float4 x0 = *(const float4*)(T + row * TLD + c8), x1 = *(const float4*)(T + row * TLD + c8 + 4);
            *(uint4*)(w.erb + (size_t)(m0 + row) * 1024 + n0 + c8) = pack8(x0, x1);
            const float sq = grp_sum16(sq8(x0, x1));
            if (l16 == 0) w.essq[(size_t)(m0 + row) * 8 + nt] = sq;
        }
    }
    __syncthreads();
}
__device__ void phase_router(const Params& P, int L, char* lds, const bool dry = false) {
    const int tid = opaque_tid();
    {
        const int x = blockIdx.x & 7, lb = blockIdx.x >> 3, nlb = gridDim.x >> 3;
        if (lb < 16 || nlb <= 16) { for (int j = lb; j < 16; j += nlb) router_item(P, L, j * 8 + x, lds, tid, dry); }
        if (!dry) {
            if (nlb > 16) { if (lb >= 16) prep_moe_late(P, L, lds, tid, (lb - 16) * 8 + x, (nlb - 16) * 8); }
            else prep_moe_late(P, L, lds, tid, blockIdx.x, gridDim.x);
        }
    }
}

constexpr int TT_OFF = STAT_OFF + 1024;
__device__ __forceinline__ void moe_table(const Params& P, int L, char* lds, const int tid) {
    int* tt = (int*)(lds + TT_OFF);
    if (tid == 0) {
        const int x = blockIdx.x & 7;
        int o = 0;
        for (int li = 0; li < 64; ++li) { tt[li] = o; o += P.w.cnt[L * 256 + li]; }
        tt[64] = o;
        int t = 0, t0 = 0, t1 = 0;
        for (int k = 0; k < 8; ++k) {
            const int li = ((k >> 1) * 8 + x) * 2 + (k & 1), nt_ = (P.w.cnt[L * 256 + li] + 127) >> 7;
            tt[72 + k] = t; t += nt_;
            if (k & 1) { tt[92 + (k >> 1)] = t1; t1 += nt_; } else { tt[84 + (k >> 1)] = t0; t0 += nt_; }
        }
        tt[80] = t; tt[88] = t0; tt[96] = t1;
        int tu = 0;
        for (int k = 0; k < 4; ++k) { const int e = k * 8 + x; tt[100 + k] = tu; tu += (P.w.cnt[L * 256 + 2 * e] + P.w.cnt[L * 256 + 2 * e + 1] + 127) >> 7; }
        tt[104] = tu;
    }
    __syncthreads();
}
__device__ __forceinline__ void moe_find(const int* tt, int tile, int& li, int& t) {
    int k = 0;
#pragma unroll
    for (int j = 1; j < 8; ++j) if (tile >= tt[72 + j]) k = j;
    li = ((k >> 1) * 8 + (blockIdx.x & 7)) * 2 + (k & 1); t = tile - tt[72 + k];
}
__device__ __forceinline__ void moe_find_slot(const int* tt, int slot, int tile, int& li, int& t) {
    const int* tp = tt + (slot ? 92 : 84);
    int k = 0;
#pragma unroll
    for (int j = 1; j < 4; ++j) if (tile >= tp[j]) k = j;
    li = (k * 8 + (blockIdx.x & 7)) * 2 + slot; t = tile - tp[k];
}
__device__ void phase_moe_up(const Params& P, int L, char* lds, const bool noeraw = false) {
    const WS& w = P.w;
    const int tid0 = opaque_tid();
    float* T = (float*)lds; float* stat = (float*)(lds + STAT_OFF); const int* tt = (const int*)(lds + TT_OFF);
    moe_table(P, L, lds, tid0);
    const int ntiles = tt[104];
    for (int item = blockIdx.x >> 3; item < ntiles * 4; item += (gridDim.x >> 3)) {
        int tid = tid0; asm volatile("" : "+v"(tid));
        const int lane = tid & 63, wid = tid >> 6;
        const int tile = item >> 2, nt = item & 3;
        int k = 0;
#pragma unroll
        for (int j = 1; j < 4; ++j) if (tile >= tt[100 + j]) k = j;
        const int e = k * 8 + (blockIdx.x & 7), t = tile - tt[100 + k];
        const int cnt0 = P.w.cnt[L * 256 + 2 * e], cnt = cnt0 + P.w.cnt[L * 256 + 2 * e + 1];
        const int rbase = tt[2 * e] + t * 128, nrows = min(128, cnt - t * 128);
        {
            const bf16_t* arow[4]; const bf16_t* wrow[4];
#pragma unroll
            for (int i = 0; i < 4; ++i) {
                const int r = (tid >> 3) + 32 * i;
                const int rr3 = t * 128 + (r < nrows ? r : 0);
                const int tok = rr3 < cnt0 ? w.elist[(size_t)(2 * e) * NT + rr3] : w.elist[(size_t)(2 * e + 1) * NT + rr3 - cnt0];
                arow[i] = w.hb1 + (size_t)tok * 1024 + g64_chunk(tid) * 8;
                wrow[i] = w.Wgut + L * WGU_SZ + ((size_t)e * 512 + nt * 128 + r) * 1024 + g64_chunk(tid) * 8;
            }
            f32x16 acc[2][2]; acc_zero(acc);
            float my_rs = 0.f;
            if (tid < 128) {
                const int rr3 = t * 128 + (tid < nrows ? tid : 0);
                const int tok = rr3 < cnt0 ? w.elist[(size_t)(2 * e) * NT + rr3] : w.elist[(size_t)(2 * e + 1) * NT + rr3 - cnt0];
                my_rs = rstd8(w.rssB + (size_t)tok * 8, 1.f / 1024.f);
            }
            gemm_mainloop_g64(acc, arow, wrow, 16, lds, tid);
            if (tid < 128) stat[tid] = my_rs;
            acc_to_lds(acc, T, tid);
        }
        {
            const int sub = lane >> 4, l16 = lane & 15, c8 = l16 * 8;
#pragma unroll 8
            for (int rr = 0; rr < 8; ++rr) {
                const int row = wid * 32 + rr * 4 + sub; const float rs = stat[row];
                const float4 x0 = mul4(*(const float4*)(T + row * TLD + c8), rs), x1 = mul4(*(const float4*)(T + row * TLD + c8 + 4), rs);
                if (row < nrows)
                    store4(w.hbuf + (size_t)(rbase + row) * 256 + nt * 64 + l16 * 4, x0.x * sigmoid_(x0.x) * x0.y, x0.z * sigmoid_(x0.z) * x0.w,
                           x1.x * sigmoid_(x1.x) * x1.y, x1.z * sigmoid_(x1.z) * x1.w);
            }
        }
        __syncthreads();
    }
    if (!noeraw) {
        int* qslot = (int*)(lds + TT_OFF + 256);
        for (;;) {
            if (tid0 == 0) *qslot = atomicAdd(&P.w.cnt[L * 256 + 64], 1);
            __syncthreads();
            const int item = *qslot;
            __syncthreads();
            if (item >= 1024) break;
            eraw_item(P, L, item >> 3, item & 7, lds, tid0);
        }
    }
}
__device__ void phase_moe_down(const Params& P, int L, char* lds, const int slot, const bool dry = false) {
    const WS& w = P.w;
    const int tid0 = opaque_tid();
    float* T = (float*)lds; float* stat = (float*)(lds + STAT_OFF); const int* tt = (const int*)(lds + TT_OFF);
    moe_table(P, L, lds, tid0);
    const int ntiles = tt[slot ? 96 : 88];
    for (int item = blockIdx.x >> 3; item < ntiles * 8; item += (gridDim.x >> 3)) {
        int tid = tid0; asm volatile("" : "+v"(tid));
        const int lane = tid & 63, wid = tid >> 6;
        const int tile = item >> 3, nt = item & 7;
        int li, t; moe_find_slot(tt, slot, tile, li, t);
        const int e = li >> 1;
        const int cnt = P.w.cnt[L * 256 + li], rbase = tt[li] + t * 128, nrows = min(128, cnt - t * 128);
        {
            const bf16_t* arow[2]; const bf16_t* wrow[2];
#pragma unroll
            for (int i = 0; i < 2; ++i) {
                const int r = (tid >> 2) + 64 * i;
                arow[i] = w.hbuf + (size_t)(rbase + (r < nrows ? r : 0)) * 256 + gl_chunk(tid) * 8;
                wrow[i] = w.Wdt + L * WD_SZ + ((size_t)e * 1024 + nt * 128 + r) * 256 + gl_chunk(tid) * 8;
            }
            f32x16 acc[2][2]; acc_zero(acc);
            int my_tok = 0; float my_wt = 0.f;
            if (tid < 128) { const int rr2 = tid < nrows ? tid : 0; my_tok = w.elist[(size_t)li * NT + t * 128 + rr2]; my_wt = w.ewt[(size_t)li * NT + t * 128 + rr2]; }
            gemm_mainloop_g(acc, arow, wrow, 8, lds, tid);
            if (tid < 128) { ((int*)stat)[tid] = my_tok; stat[128 + tid] = my_wt; }
            acc_to_lds(acc, T, tid);
        }
        {
            const int sub = lane >> 4, l16 = lane & 15, c8 = l16 * 8;
            uint4 hh[8];
#pragma unroll
            for (int rr = 0; rr < 8; ++rr) hh[rr] = *(const uint4*)(w.hb1 + (size_t)((const int*)stat)[wid * 32 + rr * 4 + sub] * 1024 + nt * 128 + c8);
#pragma unroll
            for (int rr = 0; rr < 8; ++rr) {
                const int row = wid * 32 + rr * 4 + sub;
                const int tok = ((const int*)stat)[row]; const float wt = stat[128 + row];
                const float4 x0 = *(const float4*)(T + row * TLD + c8), x1 = *(const float4*)(T + row * TLD + c8 + 4);
                const uint4 h = hh[rr];
                float4 h0, h1;
                h0.x = bflo(h.x) + wt * x0.x; h0.y = bfhi(h.x) + wt * x0.y; h0.z = bflo(h.y) + wt * x0.z; h0.w = bfhi(h.y) + wt * x0.w;
                h1.x = bflo(h.z) + wt * x1.x; h1.y = bfhi(h.z) + wt * x1.y; h1.z = bflo(h.w) + wt * x1.z; h1.w = bfhi(h.w) + wt * x1.w;
                const float sq = grp_sum16(sq8(h0, h1));
                if (row < nrows && !dry) {
                    *(uint4*)(w.hb1 + (size_t)tok * 1024 + nt * 128 + c8) = pack8(h0, h1);
                    if (slot && l16 == 0) w.rssB[(size_t)tok * 8 + nt] = sq;
                }
            }
        }
        __syncthreads();
    }
}

__device__ void phase_ple(const Params& P, int L, char* lds, const bool dry = false) {
    const WS& w = P.w; const nv::Inputs& in = P.in;
    const int tid0 = opaque_tid();
    float* T = (float*)lds; float* stat = (float*)(lds + STAT_OFF);
    int mt, nt;
    for (int it = 0; xcd_item(it, 128, 8, mt, nt); ++it) {
        int tid = tid0; asm volatile("" : "+v"(tid));
        const int lane = tid & 63, wid = tid >> 6;
        const int m0 = mt * 128, n0 = nt * 128;
        {
            const bf16_t* arow[4]; const bf16_t* wrow[4];
#pragma unroll
            for (int i = 0; i < 4; ++i) {
                arow[i] = w.hb1 + (size_t)(m0 + (tid >> 3) + 32 * i) * 1024 + g64_chunk(tid) * 8;
                wrow[i] = w.Wgt + L * WG_SZ + (size_t)(n0 + (tid >> 3) + 32 * i) * 1024 + g64_chunk(tid) * 8;
            }
            f32x16 acc[2][2]; acc_zero(acc);
            float my_rs = 0.f, my_re = 0.f;
            if (tid < 128) { my_rs = rstd8(w.rssB + (size_t)(m0 + tid) * 8, 1.f / 1024.f); my_re = rstd8(w.essq + (size_t)(m0 + tid) * 8, 1.f / 1024.f); }
            gemm_mainloop_g64(acc, arow, wrow, 16, lds, tid);
            if (tid < 128) { stat[tid] = my_rs; stat[128 + tid] = my_re; }
            acc_to_lds(acc, T, tid);
        }
        {
            const int sub = lane >> 4, l16 = lane & 15, c8 = l16 * 8;
            const float4 pg0 = *(const float4*)(in.ple_post_norm_g + L * 1024 + n0 + c8), pg1 = *(const float4*)(in.ple_post_norm_g + L * 1024 + n0 + c8 + 4);
            uint4 hhv[8], erv[8];
#pragma unroll
            for (int rr = 0; rr < 8; ++rr) {
                const size_t off = (size_t)(m0 + wid * 32 + rr * 4 + sub) * 1024 + n0 + c8;
                hhv[rr] = *(const uint4*)(w.hb1 + off); erv[rr] = *(const uint4*)(w.erb + off);
            }
#pragma unroll
            for (int rr = 0; rr < 8; ++rr) {
                const int row = wid * 32 + rr * 4 + sub; const float rs = stat[row], re = stat[128 + row]; const size_t tok = m0 + row;
                const float4 x0 = mul4(*(const float4*)(T + row * TLD + c8), rs), x1 = mul4(*(const float4*)(T + row * TLD + c8 + 4), rs);
                const size_t off = tok * 1024 + n0 + c8;
                const uint4 er = erv[rr], hh = hhv[rr];
                float4 h0, h1;
                h0.x = bflo(hh.x) + sigmoid_(x0.x) * (bflo(er.x) * re * pg0.x); h0.y = bfhi(hh.x) + sigmoid_(x0.y) * (bfhi(er.x) * re * pg0.y);
                h0.z = bflo(hh.y) + sigmoid_(x0.z) * (bflo(er.y) * re * pg0.z); h0.w = bfhi(hh.y) + sigmoid_(x0.w) * (bfhi(er.y) * re * pg0.w);
                h1.x = bflo(hh.z) + sigmoid_(x1.x) * (bflo(er.z) * re * pg1.x); h1.y = bfhi(hh.z) + sigmoid_(x1.y) * (bfhi(er.z) * re * pg1.y);
                h1.z = bflo(hh.w) + sigmoid_(x1.z) * (bflo(er.w) * re * pg1.z); h1.w = bfhi(hh.w) + sigmoid_(x1.w) * (bfhi(er.w) * re * pg1.w);
                if (L == 1) { float4* op = (float4*)(P.h + off); op[0] = h0; op[1] = h1; }
                else {
                    *(uint4*)(w.hb + off) = pack8(h0, h1);
                    const float sq = grp_sum16(sq8(h0, h1));
                    if (l16 == 0) w.rssA[tok * 8 + nt] = sq;
                }
            }
        }
        __syncthreads();
    }
}

}
namespace fx {
#define XB_TMO      128
#define XB_XCNT(j)  (256  + 64 * (j))
#define XB_XSUB(j)  (1280 + 64 * (j))
#define XB_XGEN(j)  (2304 + 64 * (j))
#define XB_TOP      3328
#define XB_TOPGEN   3392
#define XCD_BAR_WORDS 3456
#define XB_SPIN_CAP (1u << 18)
#define LAS __attribute__((address_space(3)))
__device__ __forceinline__ unsigned xb_ld(unsigned* p)              { return __hip_atomic_load(p, __ATOMIC_RELAXED, __HIP_MEMORY_SCOPE_AGENT); }
__device__ __forceinline__ unsigned xb_add(unsigned* p, unsigned v) { return __hip_atomic_fetch_add(p, v, __ATOMIC_RELAXED, __HIP_MEMORY_SCOPE_AGENT); }
__device__ __forceinline__ unsigned xb_xcc_id() { return (unsigned)__builtin_amdgcn_s_getreg((3 << 11) | 20) & 0xFu; }
#define XB_SPIN(cond, bar) do { unsigned _sp = 0; while (cond) { __builtin_amdgcn_s_sleep(1); \
    if ((++_sp & 255u) == 0u) { if (xb_ld(&(bar)[XB_TMO])) break; if (_sp > XB_SPIN_CAP) { atomicAdd(&(bar)[XB_TMO], 1u); break; } } } } while (0)
struct XcdBarrier { unsigned* bar; unsigned x; volatile LAS unsigned* st; };
__device__ __forceinline__ XcdBarrier xcd_barrier_post(unsigned* bar, volatile LAS unsigned* st) {
    XcdBarrier b; b.bar = bar; b.x = xb_xcc_id(); b.st = st;
    if (threadIdx.x == 0) (void)xb_add(&bar[XB_XCNT(b.x)], 1u);
    return b;
}
__device__ __forceinline__ void xcd_barrier_complete(unsigned* bar, unsigned x, unsigned& nloc, unsigned& nx) {
    const unsigned G = gridDim.x * gridDim.y * gridDim.z;
    unsigned sum, cnt, mine, sp = 0u;
    for (;;) {
        sum = 0u; cnt = 0u; mine = 0u;
#pragma unroll
        for (unsigned j = 0; j < 16; ++j) { const unsigned c = xb_ld(&bar[XB_XCNT(j)]); sum += c; cnt += (c > 0u) ? 1u : 0u; mine = (j == x) ? c : mine; }
        if (sum == G) break;
        __builtin_amdgcn_s_sleep(1);
        if ((++sp & 255u) == 0u) { if (xb_ld(&bar[XB_TMO])) break; if (sp > XB_SPIN_CAP) { atomicAdd(&bar[XB_TMO], 1u); break; } }
    }
    nloc = mine > 0u ? mine : 1u; nx = cnt > 0u ? cnt : 1u;
}
__device__ __forceinline__ void xcd_barrier(const XcdBarrier& b) {
    asm volatile("s_waitcnt vmcnt(0)" ::: "memory");
    __syncthreads();
    if (threadIdx.x == 0) {
        unsigned* bar = b.bar;
        __builtin_amdgcn_s_waitcnt(0);
        unsigned nloc = b.st[0], nx = b.st[1];
        if (nloc == 0u) { xcd_barrier_complete(bar, b.x, nloc, nx); b.st[0] = nloc; b.st[1] = nx; }
        const unsigned old = xb_add(&bar[XB_XSUB(b.x)], 1u);
        const unsigned gen = old / nloc;
        if (old + 1u == (gen + 1u) * nloc) {
            __builtin_amdgcn_fence(__ATOMIC_RELEASE, "agent");
            asm volatile("s_waitcnt vmcnt(0)" ::: "memory");
            const unsigned og = xb_add(&bar[XB_TOP], 1u);
            const unsigned tg = og / nx;
            if (og + 1u == (tg + 1u) * nx) xb_add(&bar[XB_TOPGEN], 1u);
            else XB_SPIN(xb_ld(&bar[XB_TOPGEN]) == tg, bar);
            __builtin_amdgcn_fence(__ATOMIC_ACQUIRE, "agent");
            xb_add(&bar[XB_XGEN(b.x)], 1u);
            asm volatile("s_waitcnt vmcnt(0)" ::: "memory");
        } else {
            XB_SPIN(xb_ld(&bar[XB_XGEN(b.x)]) == gen, bar);
            __builtin_amdgcn_fence(__ATOMIC_ACQUIRE, "agent");
            asm volatile("s_waitcnt vmcnt(0)" ::: "memory");
        }
    }
    __syncthreads();
}

constexpr int LDS_BYTES = LDS_GEMM_BYTES + 16;
constexpr int N_PHASES = 19;
constexpr int PPL = 9;
__global__ void __launch_bounds__(256, 2) k_run(Params P, int ph_lo, int ph_hi) {
    extern __shared__ __attribute__((aligned(16))) char lds[];
    volatile LAS unsigned* st = (volatile LAS unsigned*)(lds + LDS_GEMM_BYTES);
    if (threadIdx.x == 0) { st[0] = 0u; st[1] = 0u; }
    __syncthreads();
    XcdBarrier xb = xcd_barrier_post(P.w.bar, st);
#ifdef EXTRA_BARRIERS
    for (int i = 0; i < EXTRA_BARRIERS; ++i) xcd_barrier(xb);
#endif
    for (int ph = ph_lo; ph < ph_hi; ++ph) {
        if (ph > ph_lo) xcd_barrier(xb);
        int reps = 1;
#ifdef REP_PHASE
        if (ph == 0 ? (REP_PHASE == 0) : (((ph - 1) % PPL) == REP_PHASE - 1)) reps = 2;
        asm volatile("" : "+s"(reps));
#endif
        for (int rep = 0; rep < reps; ++rep) {
            const bool dry = rep + 1 < reps;
            if (rep > 0) xcd_barrier(xb);
            if (ph == 0) phase_prep(P, lds);
            else {
                const int L = (ph - 1) / PPL, s = (ph - 1) % PPL;
                switch (s) {
                    case 0: phase_zgemm(P, L, lds); break;
                    case 1: phase_mix(P, L, lds, rep, dry); break;
                    case 2: phase_attn(P, L, lds); break;
                    case 3: phase_oproj(P, L, lds, dry); break;
                    case 4: phase_router(P, L, lds, dry); break;
                    case 5: phase_moe_up(P, L, lds, dry); break;
                    case 6: phase_moe_down(P, L, lds, 0, dry); break;
                    case 7: phase_moe_down(P, L, lds, 1, dry); break;
                    case 8: phase_ple(P, L, lds, dry); break;
                }
            }
        }
    }
}
}
#ifndef MK_N_LAUNCHES
#define MK_N_LAUNCHES 1
#endif
extern "C" void kernel_launch(void* const* d_in, const int* in_sizes, int n_in, void* d_out, int out_size, void* d_ws, size_t ws_size,
                              hipStream_t stream) {
    nv::Inputs in{};
    in.x = (const float*)d_in[0]; in.p = (const float*)d_in[1]; in.positions = (const int*)d_in[2];
    const float** f = &in.mix_norm_g;
    for (int i = 0; i < 32; ++i) f[i] = (const float*)d_in[3 + i];
    size_t used = 0;
    fx::WS w = fx::make_ws((char*)d_ws, used);
    static int grid = 0;
    if (grid == 0) {
        if (n_in != 35 || out_size != fx::NT * 1024 || used > ws_size) { fprintf(stderr, "kernel_launch: unexpected shapes / workspace (need %zu, have %zu)\n", used, ws_size); grid = -1; return; }
        if (hipFuncSetAttribute((const void*)fx::k_run, hipFuncAttributeMaxDynamicSharedMemorySize, fx::LDS_BYTES) != hipSuccess) { fprintf(stderr, "hipFuncSetAttribute failed\n"); grid = -1; return; }
        int dev = 0, cus = 0, per_cu = 0;
        hipGetDevice(&dev); hipDeviceGetAttribute(&cus, hipDeviceAttributeMultiprocessorCount, dev);
        hipOccupancyMaxActiveBlocksPerMultiprocessor(&per_cu, (const void*)fx::k_run, 256, fx::LDS_BYTES);
        if (per_cu > 2) per_cu = 2;
        if (per_cu < 1) { fprintf(stderr, "occupancy query says %d blocks/CU\n", per_cu); grid = -1; return; }
        grid = cus * per_cu;
    }
    if (grid < 0) return;
    fx::Params P{}; P.in = in; P.h = (float*)d_out; P.w = w;
    hipMemsetAsync(w.cnt, 0, 2 * 256 * 4, stream);
    hipMemsetAsync(w.bar, 0, XCD_BAR_WORDS * 4, stream);
    if (MK_N_LAUNCHES == 1) hipLaunchKernelGGL(fx::k_run, dim3(grid), dim3(256), fx::LDS_BYTES, stream, P, 0, fx::N_PHASES);
    else for (int ph = 0; ph < fx::N_PHASES; ++ph) hipLaunchKernelGGL(fx::k_run, dim3(grid), dim3(256), fx::LDS_BYTES, stream, P, ph, ph + 1);
}
```

```cpp
#include <hip/hip_runtime.h>
#include <hip/hip_bf16.h>
#include <stdint.h>
#include <cstdio>
namespace nv {
struct Inputs {
    const float *x, *p; const int* positions;
    const float *mix_norm_g, *w_in, *sgu_ln_g, *sgu_ln_b, *sgu_w, *sgu_b, *conv_w, *conv_b, *conv_ln_g, *conv_ln_b, *conv_pw_w, *conv_pw_b,
        *q_a_norm_g, *w_uq, *kv_a_norm_g, *w_ukv, *q_norm_g, *k_norm_g, *branch_norm_g, *w_o, *ffn_norm_g, *router_group_w, *router_group_b,
        *router_expert_w, *router_expert_b, *moe_w_gate, *moe_w_up, *moe_w_down, *ple_norm_g, *ple_gate_w, *ple_proj_w, *ple_post_norm_g;
};
}
namespace fx {

typedef unsigned short bf16_t;
typedef short bf16x8 __attribute__((ext_vector_type(8)));
typedef float f32x16 __attribute__((ext_vector_type(16)));
typedef float f32x4 __attribute__((ext_vector_type(4)));

constexpr int NT = 16384, SEQ = 2048, DM = 1024, NB = 8;
constexpr int ZN = 1536;
constexpr float EPS = 1e-6f;

typedef __bf16 bf16v2_t __attribute__((ext_vector_type(2)));
typedef float f32v2_t __attribute__((ext_vector_type(2)));
__device__ __forceinline__ unsigned pack2(float lo, float hi) {
    f32v2_t v; v.x = lo; v.y = hi;
    bf16v2_t b = __builtin_convertvector(v, bf16v2_t);
    return __builtin_bit_cast(unsigned, b);
}
__device__ __forceinline__ unsigned f2bf(float f) { return pack2(f, 0.f) & 0xffffu; }
__device__ __forceinline__ float bf2f(unsigned short b) { return __uint_as_float(((unsigned)b) << 16); }
__device__ __forceinline__ float bflo(unsigned u) { return __uint_as_float(u << 16); }
__device__ __forceinline__ float bfhi(unsigned u) { return __uint_as_float(u & 0xffff0000u); }
__device__ __forceinline__ float sigmoid_(float x) { return __builtin_amdgcn_rcpf(1.f + __builtin_amdgcn_exp2f(-1.4426950408889634f * x)); }
__device__ __forceinline__ float rsq_(float x) { return __builtin_amdgcn_rsqf(x); }
__device__ __forceinline__ float gelu_tanh_(float x) {
    float u = 0.7978845608028654f * (x + 0.044715f * x * x * x);
    return x * sigmoid_(2.f * u);
}
__device__ __forceinline__ int opaque_tid() { int t = threadIdx.x; asm volatile("" : "+v"(t)); return t; }
template <int CTRL> __device__ __forceinline__ float dpp_mov(float v) {
    return __builtin_bit_cast(float, __builtin_amdgcn_update_dpp(0, __builtin_bit_cast(int, v), CTRL, 0xf, 0xf, false));
}
__device__ __forceinline__ void swap16(float& a, float& b) { asm volatile("s_nop 1\n\tv_permlane16_swap_b32 %0, %1" : "+v"(a), "+v"(b)); }
__device__ __forceinline__ void swap32(float& a, float& b) { asm volatile("s_nop 1\n\tv_permlane32_swap_b32 %0, %1" : "+v"(a), "+v"(b)); }
__device__ __forceinline__ float swap16_sum(float v) { float a = v, b = v; swap16(a, b); return a + b; }
__device__ __forceinline__ float swap32_sum(float v) { float a = v, b = v; swap32(a, b); return a + b; }
__device__ __forceinline__ float swap32_max(float v) { float a = v, b = v; swap32(a, b); return fmaxf(a, b); }
__device__ __forceinline__ float grp_sum16(float v) { v += dpp_mov<0xB1>(v); v += dpp_mov<0x4E>(v); v += dpp_mov<0x124>(v); v += dpp_mov<0x128>(v); return v; }
__device__ __forceinline__ float grp_sum32(float v) { return swap16_sum(grp_sum16(v)); }
__device__ __forceinline__ float wave_sum64(float v) { return swap32_sum(grp_sum32(v)); }
__device__ __forceinline__ float grp_sum4(float v) { v += dpp_mov<0xB1>(v); v += dpp_mov<0x4E>(v); return v; }
__device__ __forceinline__ float grp_sum8(float v) { v = grp_sum4(v); v += dpp_mov<0x141>(v); return v; }
__device__ __forceinline__ float quad_x2(float v) { return dpp_mov<0x4E>(v); }
__device__ __forceinline__ float xor8(float v) { return dpp_mov<0x128>(v); }
__device__ __forceinline__ float xor32(float v) { return swap32_sum(v); }

struct WS {
    bf16_t *W1t, *Wuqt, *Wukvt, *Wpwt, *Wot, *Wrt, *Wgut, *Wdt, *Wgt, *Wpt, *Wsm;
    bf16_t *hb;
    bf16_t *hb1;
    bf16_t *ub;
    bf16_t *vT;
    bf16_t *ygb;
    bf16_t *cqb;
    bf16_t *ckvb;
    bf16_t *kpeb;
    bf16_t *Qb;
    bf16_t *Knb;
    bf16_t *VTb;
    bf16_t *yb;
    float  *ssq;
    float  *rssA;
    float  *rssB;
    float  *cqss;
    float  *cs;
    bf16_t *erb;
    float  *essq;
    bf16_t *hbuf;
    int    *cnt;
    int    *elist;
    float  *ewt;
    unsigned *bar;
};
constexpr size_t W1_SZ = (size_t)ZN * 1024, WUQ_SZ = 768 * 256, WUKV_SZ = 1024 * 128, WPW_SZ = 256 * 256, WO_SZ = 1024 * 1024, WR_SZ = 128 * 1024,
                 WGU_SZ = (size_t)32 * 512 * 1024, WD_SZ = (size_t)32 * 1024 * 256, WG_SZ = 1024 * 1024, WP_SZ = 1024 * 256, WSM_SZ = 4 * 128 * 128;

struct Params {
    nv::Inputs in;
    float* h;
    WS w;
};

static WS make_ws(char* base, size_t& used) {
    WS w{}; size_t o = 0;
    auto take = [&](size_t bytes) { char* p = base + o; o += (bytes + 255) & ~(size_t)255; return p; };
    w.W1t = (bf16_t*)take(2 * W1_SZ * 2);   w.Wuqt = (bf16_t*)take(2 * WUQ_SZ * 2); w.Wukvt = (bf16_t*)take(2 * WUKV_SZ * 2);
    w.Wpwt = (bf16_t*)take(2 * WPW_SZ * 2); w.Wot = (bf16_t*)take(2 * WO_SZ * 2);   w.Wrt = (bf16_t*)take(2 * WR_SZ * 2);
    w.Wgut = (bf16_t*)take(2 * WGU_SZ * 2); w.Wdt = (bf16_t*)take(2 * WD_SZ * 2);   w.Wgt = (bf16_t*)take(2 * WG_SZ * 2);
    w.Wpt = (bf16_t*)take(2 * WP_SZ * 2);   w.Wsm = (bf16_t*)take(2 * WSM_SZ * 2);
    w.hb = (bf16_t*)take((size_t)NT * 1024 * 2); w.hb1 = (bf16_t*)take((size_t)NT * 1024 * 2);
    w.ssq = (float*)take((size_t)NT * 16 * 4); w.cs = (float*)take((size_t)NT * 32 * 4);
    w.rssA = (float*)take((size_t)NT * 8 * 4); w.rssB = (float*)take((size_t)NT * 8 * 4); w.cqss = (float*)take((size_t)NT * 4 * 4);
    w.essq = (float*)take((size_t)NT * 8 * 4);
    w.cnt = (int*)take(2 * 256 * 4);
    w.elist = (int*)take((size_t)64 * NT * 4); w.ewt = (float*)take((size_t)64 * NT * 4);
    w.bar = (unsigned*)take(4096 * 4);
    const size_t region = o;
    w.ub = (bf16_t*)take((size_t)NT * 256 * 2); w.vT = (bf16_t*)take((size_t)NT * 256 * 2); w.ygb = (bf16_t*)take((size_t)NT * 256 * 2);
    w.cqb = (bf16_t*)take((size_t)NT * 256 * 2); w.ckvb = (bf16_t*)take((size_t)NT * 128 * 2); w.kpeb = (bf16_t*)take((size_t)NT * 32 * 2);
    w.Qb = (bf16_t*)take((size_t)NT * 768 * 2); w.Knb = (bf16_t*)take((size_t)NT * 512 * 2); w.VTb = (bf16_t*)take((size_t)NT * 512 * 2);
    w.yb = (bf16_t*)take((size_t)NT * 1024 * 2);
    const size_t region_end = o;
    o = region;
    w.hbuf = (bf16_t*)take((size_t)(2 * NT + 128) * 256 * 2);
    w.erb = (bf16_t*)take((size_t)NT * 1024 * 2);
    if (o > region_end) { fprintf(stderr, "make_ws: overlay exceeds mixer region\n"); }
    o = region_end;
    used = o;
    return w;
}

__device__ const double ROPE_INV[16] = {1.0, 0.5623413251903491, 0.31622776601683794, 0.1778279410038923, 0.1, 0.05623413251903491, 0.03162277660168379, 0.01778279410038923, 0.01, 0.005623413251903491, 0.0031622776601683794, 0.0017782794100389228, 0.001, 0.0005623413251903491, 0.00031622776601683794, 0.00017782794100389227};
__device__ __forceinline__ void rope_cs(int pos, int j, float& c, float& s) {
    const double ang = (double)pos * ROPE_INV[j];
    const double n = rint(ang * 0.15915494309189535);
    double r = fma(-n, 6.283185307179586, ang); r = fma(-n, 2.4492935982947064e-16, r);
    const double r2 = r * r;
    double sc = 1.0, ss = 1.0;
    double tc = 1.0, ts = 1.0;
#pragma unroll
    for (int k = 1; k <= 14; ++k) {
        tc *= -r2 / (double)((2 * k - 1) * (2 * k)); sc += tc;
        ts *= -r2 / (double)((2 * k) * (2 * k + 1)); ss += ts;
    }
    c = (float)sc; s = (float)(ss * r);
}

enum { MAP_ID = 0, MAP_W1 = 1, MAP_UQ = 2, MAP_UKV = 3, MAP_GATE = 4, MAP_UP = 5 };
template <int MAP> __device__ __forceinline__ int dstrow(int c) {
    if (MAP == MAP_W1) {
        if (c < 512) return c;
        if (c < 768) return 512 + 2 * (c - 512);
        if (c < 1024) return 513 + 2 * (c - 768);
        return c;
    } else if (MAP == MAP_UQ) {
        const int h = c / 96, d = c - h * 96; return d < 64 ? h * 64 + d : 512 + h * 32 + d - 64;
    } else if (MAP == MAP_UKV) {
        const int h = c >> 7, d = c & 127; return d < 64 ? h * 64 + d : 512 + h * 64 + d - 64;
    } else if (MAP == MAP_GATE) return 2 * c;
    else if (MAP == MAP_UP) return 2 * c + 1;
    return c;
}
#define PREP_LOAD(V0, V1, V2, V3, SRC, K0, C0) do { \
    const int kk_ = tid >> 4, c4_ = (tid & 15) * 4; \
    const float* p_ = (C0) + c4_ < Nsrc ? (SRC) + (size_t)((K0) + kk_) * ld + (C0) + c4_ : (SRC) + (size_t)((K0) + kk_) * ld; \
    V0 = *(const float4*)p_; V1 = *(const float4*)(p_ + (size_t)16 * ld); V2 = *(const float4*)(p_ + (size_t)32 * ld); V3 = *(const float4*)(p_ + (size_t)48 * ld); } while (0)
__device__ __forceinline__ void prep_put(float* tile, int kk, int c4, const float4& v, float sc) {
    float* t = tile + kk * 65 + c4; t[0] = v.x * sc; t[1] = v.y * sc; t[2] = v.z * sc; t[3] = v.w * sc;
}
template <int MAP>
__device__ void prep_job(const float* src, int ld, int Nsrc, size_t src_stride, const float* scale, bf16_t* dst, size_t dst_stride, int K, int nbatch, float* tiles, int& rot, const int tid, const int bi, const int G) {
    const int tn = (Nsrc + 63) / 64, tk = K / 64, per = tn * tk, total = per * nbatch;
    int t = (bi - rot + G) % G, buf = 0;
    float4 a0 = make_float4(0.f, 0.f, 0.f, 0.f), a1 = a0, a2 = a0, a3 = a0, b0 = a0, b1 = a0, b2 = a0, b3 = a0;
    if (t < total) { const int e = t / per, tt = t % per; PREP_LOAD(a0, a1, a2, a3, src + (size_t)e * src_stride, (tt / tn) * 64, (tt % tn) * 64); }
    for (; t < total; t += G) {
        const int e = t / per, tt = t % per, k0 = (tt / tn) * 64, c0 = (tt % tn) * 64;
        const int t2 = t + G;
        if (t2 < total) { const int e2 = t2 / per, tt2 = t2 % per; PREP_LOAD(b0, b1, b2, b3, src + (size_t)e2 * src_stride, (tt2 / tn) * 64, (tt2 % tn) * 64); }
        float* tile = tiles + buf * (64 * 65);
        {
            const int kk = tid >> 4, c4 = (tid & 15) * 4;
            const float s0 = scale ? scale[k0 + kk] : 1.f, s1 = scale ? scale[k0 + kk + 16] : 1.f, s2 = scale ? scale[k0 + kk + 32] : 1.f, s3 = scale ? scale[k0 + kk + 48] : 1.f;
            prep_put(tile, kk, c4, a0, s0); prep_put(tile, kk + 16, c4, a1, s1); prep_put(tile, kk + 32, c4, a2, s2); prep_put(tile, kk + 48, c4, a3, s3);
        }
        __syncthreads();
        bf16_t* d = dst + (size_t)e * dst_stride;
#pragma unroll
        for (int i = 0; i < 2; ++i) {
            const int idx = tid + 256 * i, c = idx >> 3, kc = idx & 7;
            if (c0 + c < Nsrc) {
                const float* q = tile + (kc * 8) * 65 + c;
                uint4 pk;
                pk.x = pack2(q[0], q[65]); pk.y = pack2(q[130], q[195]); pk.z = pack2(q[260], q[325]); pk.w = pack2(q[390], q[455]);
                *(uint4*)(d + (size_t)dstrow<MAP>(c0 + c) * K + k0 + kc * 8) = pk;
            }
        }
        a0 = b0; a1 = b1; a2 = b2; a3 = b3; buf ^= 1;
    }
    __syncthreads();
    rot = (rot + total) % G;
}

__device__ void phase_prep(const Params& P, char* lds) {
    float* tile = (float*)lds;
    const nv::Inputs& in = P.in; const WS& w = P.w;
    const int G = gridDim.x, bid = blockIdx.x, tid = opaque_tid();
    int rot = 0;
    for (int L = 0; L < 2; ++L) {
        if (L == 0) {
        prep_job<MAP_GATE>(in.moe_w_gate + (size_t)L * 32 * 1024 * 256, 256, 256, (size_t)1024 * 256, in.ffn_norm_g + L * 1024, w.Wgut + L * WGU_SZ, (size_t)512 * 1024, 1024, 32, tile, rot, tid, bid, G);
        prep_job<MAP_UP>(in.moe_w_up + (size_t)L * 32 * 1024 * 256, 256, 256, (size_t)1024 * 256, in.ffn_norm_g + L * 1024, w.Wgut + L * WGU_SZ, (size_t)512 * 1024, 1024, 32, tile, rot, tid, bid, G);
        prep_job<MAP_ID>(in.moe_w_down + (size_t)L * 32 * 256 * 1024, 1024, 1024, (size_t)256 * 1024, nullptr, w.Wdt + L * WD_SZ, (size_t)1024 * 256, 256, 32, tile, rot, tid, bid, G);
        }
        prep_job<MAP_W1>(in.w_in + (size_t)L * 1024 * 1440, 1440, 1440, 0, in.mix_norm_g + L * 1024, w.W1t + L * W1_SZ, 0, 1024, 1, tile, rot, tid, bid, G);
        prep_job<MAP_UQ>(in.w_uq + (size_t)L * 256 * 768, 768, 768, 0, in.q_a_norm_g + L * 256, w.Wuqt + L * WUQ_SZ, 0, 256, 1, tile, rot, tid, bid, G);
        prep_job<MAP_UKV>(in.w_ukv + (size_t)L * 128 * 1024, 1024, 1024, 0, in.kv_a_norm_g + L * 128, w.Wukvt + L * WUKV_SZ, 0, 128, 1, tile, rot, tid, bid, G);
        prep_job<MAP_ID>(in.conv_pw_w + (size_t)L * 256 * 256, 256, 256, 0, nullptr, w.Wpwt + L * WPW_SZ, 0, 256, 1, tile, rot, tid, bid, G);
        prep_job<MAP_ID>(in.w_o + (size_t)L * 1024 * 1024, 1024, 1024, 0, in.branch_norm_g + L * 1024, w.Wot + L * WO_SZ, 0, 1024, 1, tile, rot, tid, bid, G);
        prep_job<MAP_ID>(in.ple_gate_w + (size_t)L * 1024 * 1024, 1024, 1024, 0, in.ple_norm_g + L * 1024, w.Wgt + L * WG_SZ, 0, 1024, 1, tile, rot, tid, bid, G);
        prep_job<MAP_ID>(in.ple_proj_w + (size_t)L * 256 * 1024, 1024, 1024, 0, nullptr, w.Wpt + L * WP_SZ, 0, 256, 1, tile, rot, tid, bid, G);
        for (int i = bid * 256 + tid; i < 96 * 1024 / 8; i += G * 256) *(uint4*)(w.W1t + L * W1_SZ + (size_t)1440 * 1024 + (size_t)i * 8) = make_uint4(0u, 0u, 0u, 0u);
        for (int i = bid * 256 + tid; i < 128 * 1024; i += G * 256) {
            int n = i >> 10, k = i & 1023; float v = 0.f;
            if (n < 4) v = in.router_group_w[(size_t)L * 1024 * 4 + k * 4 + n];
            else if (n < 36) v = in.router_expert_w[(size_t)L * 1024 * 32 + k * 32 + (n - 4)];
            v *= in.ffn_norm_g[L * 1024 + k];
            w.Wrt[L * WR_SZ + i] = (bf16_t)f2bf(v);
        }
        for (int i = bid * 256 + tid; i < 4 * 128 * 128; i += G * 256) {
            int jj = i & 127, ii = (i >> 7) & 127;
            float v = (jj <= ii) ? in.sgu_w[(size_t)L * WSM_SZ + i] : 0.f;
            w.Wsm[L * WSM_SZ + i] = (bf16_t)f2bf(v);
        }
    }
    for (int i = bid * 256 + tid; i < NT * 16; i += G * 256) {
        int t = i >> 4, j = i & 15;
        float c, sn; rope_cs(in.positions[t], j, c, sn);
        w.cs[t * 32 + j] = c; w.cs[t * 32 + 16 + j] = sn;
    }
    for (int row = bid * 4 + (tid >> 6); row < NT; row += G * 4) {
        const int lane = tid & 63;
        float ss = 0.f;
#pragma unroll
        for (int j = 0; j < 4; ++j) {
            const size_t i = (size_t)row * 256 + j * 64 + lane;
            const float4 v = ((const float4*)in.x)[i];
            uint2 pk; pk.x = pack2(v.x, v.y); pk.y = pack2(v.z, v.w);
            ((uint2*)w.hb)[i] = pk;
            ss += v.x * v.x + v.y * v.y + v.z * v.z + v.w * v.w;
        }
        ss = wave_sum64(ss);
        if (lane < 8) w.rssA[(size_t)row * 8 + lane] = lane == 0 ? ss : 0.f;
    }
}

__device__ void prep_moe_late(const Params& P, int part, char* lds, const int tid, const int bi, const int nb) {
    float* tile = (float*)lds;
    const nv::Inputs& in = P.in; const WS& w = P.w;
    int rot = 0; const int L = 1;
    const float* up = in.moe_w_up + (size_t)L * 32 * 1024 * 256;
    if (part == 0) {
        prep_job<MAP_GATE>(in.moe_w_gate + (size_t)L * 32 * 1024 * 256, 256, 256, (size_t)1024 * 256, in.ffn_norm_g + L * 1024, w.Wgut + L * WGU_SZ, (size_t)512 * 1024, 1024, 32, tile, rot, tid, bi, nb);
        prep_job<MAP_UP>(up, 256, 256, (size_t)1024 * 256, in.ffn_norm_g + L * 1024, w.Wgut + L * WGU_SZ, (size_t)512 * 1024, 1024, 16, tile, rot, tid, bi, nb);
    } else {
        prep_job<MAP_UP>(up + (size_t)16 * 1024 * 256, 256, 256, (size_t)1024 * 256, in.ffn_norm_g + L * 1024, w.Wgut + L * WGU_SZ + (size_t)16 * 512 * 1024, (size_t)512 * 1024, 1024, 16, tile, rot, tid, bi, nb);
        prep_job<MAP_ID>(in.moe_w_down + (size_t)L * 32 * 256 * 1024, 1024, 1024, (size_t)256 * 1024, nullptr, w.Wdt + L * WD_SZ, (size_t)1024 * 256, 256, 32, tile, rot, tid, bi, nb);
    }
    __syncthreads();
}

__device__ __forceinline__ int lds_off(int row, int chunk) { return row * 128 + ((chunk ^ ((row >> 1) & 7)) << 4); }

template <typename AT> struct ARaw;
template <> struct ARaw<bf16_t> { uint4 v[4]; };
template <> struct ARaw<float> { float4 v[4][2]; };

__device__ __forceinline__ void a_load(ARaw<bf16_t>& r, const bf16_t* const (&rowp)[4], int koff) {
#pragma unroll
    for (int i = 0; i < 4; ++i) r.v[i] = *(const uint4*)(rowp[i] + koff);
}
__device__ __forceinline__ void a_load(ARaw<float>& r, const float* const (&rowp)[4], int koff) {
#pragma unroll
    for (int i = 0; i < 4; ++i) { r.v[i][0] = *(const float4*)(rowp[i] + koff); r.v[i][1] = *(const float4*)(rowp[i] + koff + 4); }
}
template <bool SUMSQ> __device__ __forceinline__ uint4 a_cvt(const uint4& v, float& ss) {
    if (SUMSQ) {
        float a;
        a = bflo(v.x); ss = fmaf(a, a, ss); a = bfhi(v.x); ss = fmaf(a, a, ss);
        a = bflo(v.y); ss = fmaf(a, a, ss); a = bfhi(v.y); ss = fmaf(a, a, ss);
        a = bflo(v.z); ss = fmaf(a, a, ss); a = bfhi(v.z); ss = fmaf(a, a, ss);
        a = bflo(v.w); ss = fmaf(a, a, ss); a = bfhi(v.w); ss = fmaf(a, a, ss);
    }
    return v;
}
template <bool SUMSQ> __device__ __forceinline__ void a_store(const ARaw<bf16_t>& r, char* ldsA, int tid, float (&ss)[4]) {
#pragma unroll
    for (int i = 0; i < 4; ++i) { uint4 v = a_cvt<SUMSQ>(r.v[i], ss[i]); *(uint4*)(ldsA + lds_off((tid >> 3) + 32 * i, tid & 7)) = v; }
}
template <bool SUMSQ> __device__ __forceinline__ void a_store(const ARaw<float>& r, char* ldsA, int tid, float (&ss)[4]) {
#pragma unroll
    for (int i = 0; i < 4; ++i) {
        const float4 a = r.v[i][0], b = r.v[i][1];
        if (SUMSQ) ss[i] += a.x * a.x + a.y * a.y + a.z * a.z + a.w * a.w + b.x * b.x + b.y * b.y + b.z * b.z + b.w * b.w;
        uint4 v; v.x = pack2(a.x, a.y); v.y = pack2(a.z, a.w); v.z = pack2(b.x, b.y); v.w = pack2(b.z, b.w);
        *(uint4*)(ldsA + lds_off((tid >> 3) + 32 * i, tid & 7)) = v;
    }
}

struct bf16x3_t {};
template <> struct ARaw<bf16x3_t> { uint4 a[4], b[4], c[4]; };
struct Rows3 { const bf16_t* p[2][4]; };
__device__ __forceinline__ void a_load(ARaw<bf16x3_t>& r, const Rows3& rows, int koff) {
#pragma unroll
    for (int i = 0; i < 4; ++i) { r.a[i] = *(const uint4*)(rows.p[0][i] + koff); r.b[i] = *(const uint4*)(rows.p[1][i] + koff); r.c[i] = *(const uint4*)(rows.p[1][i] + koff + 1024); }
}
__device__ __forceinline__ unsigned add3pk(unsigned a, unsigned b, unsigned c, float& ss) {
    const float lo = bflo(a) + bflo(b) + bflo(c), hi = bfhi(a) + bfhi(b) + bfhi(c);
    ss = fmaf(lo, lo, ss); ss = fmaf(hi, hi, ss);
    return pack2(lo, hi);
}
template <bool SUMSQ> __device__ __forceinline__ void a_store(const ARaw<bf16x3_t>& r, char* ldsA, int tid, float (&ss)[4]) {
#pragma unroll
    for (int i = 0; i < 4; ++i) {
        uint4 v;
        v.x = add3pk(r.a[i].x, r.b[i].x, r.c[i].x, ss[i]); v.y = add3pk(r.a[i].y, r.b[i].y, r.c[i].y, ss[i]);
        v.z = add3pk(r.a[i].z, r.b[i].z, r.c[i].z, ss[i]); v.w = add3pk(r.a[i].w, r.b[i].w, r.c[i].w, ss[i]);
        *(uint4*)(ldsA + lds_off((tid >> 3) + 32 * i, tid & 7)) = v;
    }
}

template <typename AT, bool SUMSQ, int SUNROLL = 4, typename AROWS>
__device__ __forceinline__ void gemm_mainloop(f32x16 (&acc)[2][2], const AROWS& arow, const bf16_t* const (&wrow)[4], int nkt, char* lds, float (&ss)[4], const int tid) {
    const int lane = tid & 63, wid = tid >> 6, wr = wid >> 1, wc = wid & 1;
    ARaw<AT> ra; ARaw<bf16_t> rb; float dummy[4] = {0.f, 0.f, 0.f, 0.f};
    a_load(ra, arow, 0); a_load(rb, wrow, 0);
    a_store<SUMSQ>(ra, lds, tid, ss); a_store<false>(rb, lds + 16384, tid, dummy);
    __syncthreads();
    const int fr = lane & 31, fh = lane >> 5;
#pragma unroll 1
    for (int kt = 0; kt < nkt; ++kt) {
        char* cur = lds + (kt & 1) * 32768;
        char* nxt = lds + ((kt + 1) & 1) * 32768;
        const bool more = (kt + 1 < nkt);
        if (more) { a_load(ra, arow, (kt + 1) * 64); a_load(rb, wrow, (kt + 1) * 64); }
#pragma unroll SUNROLL
        for (int s = 0; s < 4; ++s) {
            bf16x8 xa[2], wb[2];
#pragma unroll
            for (int i = 0; i < 2; ++i) xa[i] = *(const bf16x8*)(cur + lds_off(wr * 64 + i * 32 + fr, 2 * s + fh));
#pragma unroll
            for (int j = 0; j < 2; ++j) wb[j] = *(const bf16x8*)(cur + 16384 + lds_off(wc * 64 + j * 32 + fr, 2 * s + fh));
#pragma unroll
            for (int i = 0; i < 2; ++i)
#pragma unroll
                for (int j = 0; j < 2; ++j) acc[i][j] = __builtin_amdgcn_mfma_f32_32x32x16_bf16(wb[j], xa[i], acc[i][j], 0, 0, 0);
        }
        if (more) { a_store<SUMSQ>(ra, nxt, tid, ss); a_store<false>(rb, nxt + 16384, tid, dummy); }
        __syncthreads();
    }
}
constexpr int GST = 16384;
__device__ __forceinline__ int gl_chunk(int tid) { return (tid & 3) ^ ((tid >> 4) & 3); }
__device__ __forceinline__ int gl_off(int row, int chunk) { return row * 64 + ((chunk ^ ((row >> 2) & 3)) << 4); }
typedef __attribute__((address_space(3))) unsigned lds_u32_t;
__device__ __forceinline__ void glds16(const bf16_t* g, char* l) {
    __builtin_amdgcn_global_load_lds((const unsigned*)g, (lds_u32_t*)l, 16, 0, 0);
}
#define RAW_BARRIER() do { asm volatile("s_waitcnt lgkmcnt(0)" ::: "memory"); __builtin_amdgcn_s_barrier(); } while (0)
template <bool SEG = false>
__device__ __forceinline__ void gemm_mainloop_g(f32x16 (&acc)[2][2], const bf16_t* const (&arow)[2], const bf16_t* const (&wrow)[2], const int nkt, char* lds, const int tid,
                                                const int rot = 0, const int kt1 = -1, const float* f1 = nullptr, const int kt2 = -1, const float* f2 = nullptr) {
    const int lane = tid & 63, wid = tid >> 6, wr = wid >> 1, wc = wid & 1, fr = lane & 31, fh = lane >> 5;
    const int wbase = __builtin_amdgcn_readfirstlane(wid) * 1024;
#pragma unroll 1
    for (int p = 0; p < 3; ++p) if (p < nkt) {
        char* st = lds + p * GST + wbase;
        const int ko = SEG ? ((p + rot) & (nkt - 1)) * 32 : p * 32;
        glds16(arow[0] + ko, st); glds16(arow[1] + ko, st + 4096);
        glds16(wrow[0] + ko, st + 8192); glds16(wrow[1] + ko, st + 8192 + 4096);
    }
    const int ra0 = gl_off(wr * 64 + fr, fh), ra1 = gl_off(wr * 64 + 32 + fr, fh);
    const int rb0 = 8192 + gl_off(wc * 64 + fr, fh), rb1 = 8192 + gl_off(wc * 64 + 32 + fr, fh);
#pragma unroll 1
    for (int kt = 0; kt < nkt; ++kt) {
        if (kt + 2 < nkt) asm volatile("s_waitcnt vmcnt(8)" ::: "memory");
        else if (kt + 1 < nkt) asm volatile("s_waitcnt vmcnt(4)" ::: "memory");
        else asm volatile("s_waitcnt vmcnt(0)" ::: "memory");
        RAW_BARRIER();
        if (kt + 3 < nkt) {
            char* st = lds + ((kt + 3) & 3) * GST + wbase;
            const int ko = SEG ? ((kt + 3 + rot) & (nkt - 1)) * 32 : (kt + 3) * 32;
            glds16(arow[0] + ko, st); glds16(arow[1] + ko, st + 4096);
            glds16(wrow[0] + ko, st + 8192); glds16(wrow[1] + ko, st + 8192 + 4096);
        }
        const char* cur = lds + (kt & 3) * GST;
        if (SEG && (kt == kt1 || kt == kt2)) {
            const float* f = kt == kt1 ? f1 : f2;
#pragma unroll
            for (int i = 0; i < 2; ++i) {
                const float v = f[wr * 64 + i * 32 + fr];
#pragma unroll
                for (int j = 0; j < 2; ++j)
#pragma unroll
                    for (int r = 0; r < 16; ++r) acc[i][j][r] *= v;
            }
        }
        bf16x8 xa[2][2], wb[2][2];
#pragma unroll
        for (int s2 = 0; s2 < 2; ++s2) {
            xa[s2][0] = *(const bf16x8*)(cur + (ra0 ^ (s2 << 5))); xa[s2][1] = *(const bf16x8*)(cur + (ra1 ^ (s2 << 5)));
            wb[s2][0] = *(const bf16x8*)(cur + (rb0 ^ (s2 << 5))); wb[s2][1] = *(const bf16x8*)(cur + (rb1 ^ (s2 << 5)));
        }
        __builtin_amdgcn_sched_barrier(0);
#pragma unroll
        for (int s2 = 0; s2 < 2; ++s2) {
            acc[0][0] = __builtin_amdgcn_mfma_f32_32x32x16_bf16(wb[s2][0], xa[s2][0], acc[0][0], 0, 0, 0);
            acc[0][1] = __builtin_amdgcn_mfma_f32_32x32x16_bf16(wb[s2][1], xa[s2][0], acc[0][1], 0, 0, 0);
            acc[1][0] = __builtin_amdgcn_mfma_f32_32x32x16_bf16(wb[s2][0], xa[s2][1], acc[1][0], 0, 0, 0);
            acc[1][1] = __builtin_amdgcn_mfma_f32_32x32x16_bf16(wb[s2][1], xa[s2][1], acc[1][1], 0, 0, 0);
        }
    }
    RAW_BARRIER();
}
__device__ __forceinline__ int g64_chunk(int tid) { return (tid & 7) ^ ((tid >> 4) & 7); }
template <bool SEG = false>
__device__ __forceinline__ void gemm_mainloop_g64(f32x16 (&acc)[2][2], const bf16_t* const (&arow)[4], const bf16_t* const (&wrow)[4], const int nkt, char* lds, const int tid,
                                                  const int rot = 0, const int kt1 = -1, const float* f1 = nullptr, const int kt2 = -1, const float* f2 = nullptr) {
    const int lane = tid & 63, wid = tid >> 6, wr = wid >> 1, wc = wid & 1, fr = lane & 31, fh = lane >> 5;
    const int wbase = __builtin_amdgcn_readfirstlane(wid) * 1024;
    {
        char* st = lds + wbase;
        const int ko0 = SEG ? (rot & (nkt - 1)) * 64 : 0;
#pragma unroll
        for (int i = 0; i < 4; ++i) { glds16(arow[i] + ko0, st + i * 4096); glds16(wrow[i] + ko0, st + 16384 + i * 4096); }
    }
#pragma unroll 1
    for (int kt = 0; kt < nkt; ++kt) {
        asm volatile("s_waitcnt vmcnt(0)" ::: "memory");
        RAW_BARRIER();
        if (kt + 1 < nkt) {
            char* st = lds + ((kt + 1) & 1) * 32768 + wbase;
            const int ko = SEG ? ((kt + 1 + rot) & (nkt - 1)) * 64 : (kt + 1) * 64;
#pragma unroll
            for (int i = 0; i < 4; ++i) { glds16(arow[i] + ko, st + i * 4096); glds16(wrow[i] + ko, st + 16384 + i * 4096); }
        }
        const char* cur = lds + (kt & 1) * 32768;
        if (SEG && (kt == kt1 || kt == kt2)) {
            const float* f = kt == kt1 ? f1 : f2;
#pragma unroll
            for (int i = 0; i < 2; ++i) {
                const float v = f[wr * 64 + i * 32 + fr];
#pragma unroll
                for (int j = 0; j < 2; ++j)
#pragma unroll
                    for (int r = 0; r < 16; ++r) acc[i][j][r] *= v;
            }
        }
#pragma unroll
        for (int s = 0; s < 4; ++s) {
            bf16x8 xa[2], wb[2];
#pragma unroll
            for (int i = 0; i < 2; ++i) xa[i] = *(const bf16x8*)(cur + lds_off(wr * 64 + i * 32 + fr, 2 * s + fh));
#pragma unroll
            for (int j = 0; j < 2; ++j) wb[j] = *(const bf16x8*)(cur + 16384 + lds_off(wc * 64 + j * 32 + fr, 2 * s + fh));
#pragma unroll
            for (int i = 0; i < 2; ++i)
#pragma unroll
                for (int j = 0; j < 2; ++j) acc[i][j] = __builtin_amdgcn_mfma_f32_32x32x16_bf16(wb[j], xa[i], acc[i][j], 0, 0, 0);
        }
    }
    RAW_BARRIER();
}
__device__ __forceinline__ void acc_zero(f32x16 (&acc)[2][2]) {
#pragma unroll
    for (int i = 0; i < 2; ++i)
#pragma unroll
        for (int j = 0; j < 2; ++j)
#pragma unroll
            for (int r = 0; r < 16; ++r) acc[i][j][r] = 0.f;
}
__device__ __forceinline__ void publish_rowstat(float (&ss)[4], float* stat, float invK, bool as_rstd, const int tid) {
#pragma unroll
    for (int i = 0; i < 4; ++i) {
        float v = ss[i];
        v += __shfl_xor(v, 1); v += __shfl_xor(v, 2); v += __shfl_xor(v, 4);
        if ((tid & 7) == 0) stat[(tid >> 3) + 32 * i] = as_rstd ? rsqrtf(v * invK + EPS) : v;
    }
    __syncthreads();
}
__device__ __forceinline__ int nidx(int r, int fh) { return (r & 3) + 8 * (r >> 2) + 4 * fh; }
__device__ __forceinline__ uint4 pack8(const float4& a, const float4& b) { uint4 pk; pk.x = pack2(a.x, a.y); pk.y = pack2(a.z, a.w); pk.z = pack2(b.x, b.y); pk.w = pack2(b.z, b.w); return pk; }
__device__ __forceinline__ float sq8(const float4& a, const float4& b) { return (a.x * a.x + a.y * a.y) + (a.z * a.z + a.w * a.w) + (b.x * b.x + b.y * b.y) + (b.z * b.z + b.w * b.w); }
__device__ __forceinline__ float4 mul4(const float4& a, float s) { return make_float4(a.x * s, a.y * s, a.z * s, a.w * s); }
__device__ __forceinline__ void store4(bf16_t* p, float a, float b, float c, float d) {
    uint2 v; v.x = pack2(a, b); v.y = pack2(c, d); *(uint2*)p = v;
}

__device__ __forceinline__ bool xcd_item(int it, int MT, int NTl, int& mt, int& nt) {
    const int x = blockIdx.x & 7, lb = blockIdx.x >> 3, nlb = gridDim.x >> 3;
    const int li = it * nlb + lb, per = (MT >> 3) * NTl;
    if (li >= per) return false;
    mt = (li / NTl) * 8 + x; nt = li % NTl; return true;
}

constexpr int TLD = 132;
constexpr int STAT_OFF = 128 * TLD * 4;
constexpr int LDS_GEMM_BYTES = STAT_OFF + 2048;
__device__ __forceinline__ void acc_to_lds(const f32x16 (&acc)[2][2], float* T, const int tid) {
    const int lane = tid & 63, wid = tid >> 6, wr = wid >> 1, wc = wid & 1, fr = lane & 31, fh = lane >> 5;
#pragma unroll
    for (int i = 0; i < 2; ++i)
#pragma unroll
        for (int j = 0; j < 2; ++j)
#pragma unroll
            for (int g = 0; g < 4; ++g) {
                float4 v; v.x = acc[i][j][4 * g]; v.y = acc[i][j][4 * g + 1]; v.z = acc[i][j][4 * g + 2]; v.w = acc[i][j][4 * g + 3];
                *(float4*)(T + (wr * 64 + i * 32 + fr) * TLD + wc * 64 + j * 32 + 8 * g + 4 * fh) = v;
            }
    __syncthreads();
}
__device__ __forceinline__ float rstd8(const float* p, float invK) {
    const float4 a = *(const float4*)p, b = *(const float4*)(p + 4);
    return rsq_(((a.x + a.y) + (a.z + a.w) + (b.x + b.y) + (b.z + b.w)) * invK + EPS);
}

}
namespace fx {

__device__ void phase_zgemm(const Params& P, int L, char* lds, const bool same = false) {
    const WS& w = P.w; const nv::Inputs& in = P.in;
    const int tid0 = opaque_tid();
    float* T = (float*)lds; float* stat = (float*)(lds + STAT_OFF);
    const bf16_t* Wt = w.W1t + L * W1_SZ;
    int mt, nt;
    for (int it = 0; xcd_item(it, 128, 12, mt, nt); ++it) {
        int tid = tid0; asm volatile("" : "+v"(tid));
        const int lane = tid & 63, wid = tid >> 6;
        const int m0 = mt * 128, n0 = nt * 128;
        {
            const bf16_t* arow[4]; const bf16_t* wrow[4];
#pragma unroll
            for (int i = 0; i < 4; ++i) {
                arow[i] = w.hb + (size_t)(m0 + (tid >> 3) + 32 * i) * 1024 + g64_chunk(tid) * 8;
                wrow[i] = Wt + (size_t)(n0 + (tid >> 3) + 32 * i) * 1024 + g64_chunk(tid) * 8;
            }
            f32x16 acc[2][2]; acc_zero(acc);
            float my_rs = 0.f;
            if (tid < 128) my_rs = rstd8(w.rssA + (size_t)(m0 + tid) * 8, 1.f / 1024.f);
            gemm_mainloop_g64(acc, arow, wrow, 16, lds, tid);
            if (tid < 128) stat[tid] = my_rs;
            acc_to_lds(acc, T, tid);
        }
        const int sub = lane >> 4, l16 = lane & 15, c8 = l16 * 8;
        if (nt < 2) {
#pragma unroll 8
            for (int rr = 0; rr < 8; ++rr) {
                const int row = wid * 32 + rr * 4 + sub; const float rs = stat[row];
                float4 x0 = *(const float4*)(T + row * TLD + c8), x1 = *(const float4*)(T + row * TLD + c8 + 4);
                x0.x = gelu_tanh_(x0.x * rs); x0.y = gelu_tanh_(x0.y * rs); x0.z = gelu_tanh_(x0.z * rs); x0.w = gelu_tanh_(x0.w * rs);
                x1.x = gelu_tanh_(x1.x * rs); x1.y = gelu_tanh_(x1.y * rs); x1.z = gelu_tanh_(x1.z * rs); x1.w = gelu_tanh_(x1.w * rs);
                *(uint4*)(w.ub + (size_t)(m0 + row) * 256 + nt * 128 + c8) = pack8(x0, x1);
            }
        } else if (nt < 4) {
            const int hd = (nt - 2) * 2 + (l16 >> 3), d0 = (l16 & 7) * 8;
            const float4 g0 = *(const float4*)(in.sgu_ln_g + L * 256 + hd * 64 + d0), g1 = *(const float4*)(in.sgu_ln_g + L * 256 + hd * 64 + d0 + 4);
            const float4 b0 = *(const float4*)(in.sgu_ln_b + L * 256 + hd * 64 + d0), b1 = *(const float4*)(in.sgu_ln_b + L * 256 + hd * 64 + d0 + 4);
#pragma unroll 4
            for (int rr = 0; rr < 8; ++rr) {
                const int row = wid * 32 + rr * 4 + sub; const float rs = stat[row];
                float4 x0 = *(const float4*)(T + row * TLD + c8), x1 = *(const float4*)(T + row * TLD + c8 + 4);
                x0.x = gelu_tanh_(x0.x * rs); x0.y = gelu_tanh_(x0.y * rs); x0.z = gelu_tanh_(x0.z * rs); x0.w = gelu_tanh_(x0.w * rs);
                x1.x = gelu_tanh_(x1.x * rs); x1.y = gelu_tanh_(x1.y * rs); x1.z = gelu_tanh_(x1.z * rs); x1.w = gelu_tanh_(x1.w * rs);
                const float mean = grp_sum8((x0.x + x0.y) + (x0.z + x0.w) + (x1.x + x1.y) + (x1.z + x1.w)) * (1.f / 64.f);
                x0.x -= mean; x0.y -= mean; x0.z -= mean; x0.w -= mean; x1.x -= mean; x1.y -= mean; x1.z -= mean; x1.w -= mean;
                const float rv = rsq_(grp_sum8(sq8(x0, x1)) * (1.f / 64.f) + EPS);
                x0.x = x0.x * rv * g0.x + b0.x; x0.y = x0.y * rv * g0.y + b0.y; x0.z = x0.z * rv * g0.z + b0.z; x0.w = x0.w * rv * g0.w + b0.w;
                x1.x = x1.x * rv * g1.x + b1.x; x1.y = x1.y * rv * g1.y + b1.y; x1.z = x1.z * rv * g1.z + b1.z; x1.w = x1.w * rv * g1.w + b1.w;
                *(float4*)(T + row * TLD + c8) = x0; *(float4*)(T + row * TLD + c8 + 4) = x1;
            }
            __syncthreads();
            {
                const int c = tid & 127, th = tid >> 7, hd2 = (nt - 2) * 2 + (c >> 6), d = c & 63;
                bf16_t* dst = w.vT + ((size_t)(mt * 4 + hd2) * 64 + d) * 128 + th * 64;
#pragma unroll 2
                for (int k8 = 0; k8 < 8; ++k8) {
                    float v[8];
#pragma unroll
                    for (int k = 0; k < 8; ++k) v[k] = T[(th * 64 + k8 * 8 + k) * TLD + c];
                    uint4 pk; pk.x = pack2(v[0], v[1]); pk.y = pack2(v[2], v[3]); pk.z = pack2(v[4], v[5]); pk.w = pack2(v[6], v[7]);
                    *(uint4*)(dst + k8 * 8) = pk;
                }
            }
        } else if (nt < 8) {
#pragma unroll 8
            for (int rr = 0; rr < 8; ++rr) {
                const int row = wid * 32 + rr * 4 + sub; const float rs = stat[row];
                const float4 x0 = *(const float4*)(T + row * TLD + c8), x1 = *(const float4*)(T + row * TLD + c8 + 4);
                store4(w.ygb + (size_t)(m0 + row) * 256 + (nt - 4) * 64 + l16 * 4, x0.x * rs * sigmoid_(x0.y * rs), x0.z * rs * sigmoid_(x0.w * rs),
                       x1.x * rs * sigmoid_(x1.y * rs), x1.z * rs * sigmoid_(x1.w * rs));
            }
        } else if (nt < 11) {
            bf16_t* base; int ld, cb;
            if (nt < 10) { base = w.cqb; ld = 256; cb = (nt - 8) * 128; } else { base = w.ckvb; ld = 128; cb = 0; }
#pragma unroll 8
            for (int rr = 0; rr < 8; ++rr) {
                const int row = wid * 32 + rr * 4 + sub; const float rs = stat[row];
                const float4 x0 = mul4(*(const float4*)(T + row * TLD + c8), rs), x1 = mul4(*(const float4*)(T + row * TLD + c8 + 4), rs);
                *(uint4*)(base + (size_t)(m0 + row) * ld + cb + c8) = pack8(x0, x1);
                const float sq = grp_sum16(sq8(x0, x1));
                if (l16 == 0) w.cqss[(size_t)(m0 + row) * 4 + (nt - 8)] = sq;
            }
        } else {
            const int lq = l16 & 3, dd = lq * 8, jj = (lq & 1) * 8;
            const float4 kg0 = *(const float4*)(in.k_norm_g + L * 96 + 64 + dd), kg1 = *(const float4*)(in.k_norm_g + L * 96 + 64 + dd + 4);
#pragma unroll 1
            for (int hb4 = 0; hb4 < 2; ++hb4) {
                float4 cc0[4], cc1[4], ss0[4], ss1[4];
#pragma unroll
                for (int r4 = 0; r4 < 4; ++r4) {
                    const float* csr = w.cs + (size_t)(m0 + wid * 32 + (hb4 * 4 + r4) * 4 + sub) * 32 + jj;
                    cc0[r4] = *(const float4*)csr; cc1[r4] = *(const float4*)(csr + 4); ss0[r4] = *(const float4*)(csr + 16); ss1[r4] = *(const float4*)(csr + 20);
                }
#pragma unroll
                for (int r4 = 0; r4 < 4; ++r4) {
                    const int row = wid * 32 + (hb4 * 4 + r4) * 4 + sub; const float rs = stat[row]; const int tok = m0 + row;
                    float4 x0 = mul4(*(const float4*)(T + row * TLD + dd), rs), x1 = mul4(*(const float4*)(T + row * TLD + dd + 4), rs);
                    const float rn = rsq_(grp_sum4(sq8(x0, x1)) * (1.f / 32.f) + EPS);
                    x0.x *= rn * kg0.x; x0.y *= rn * kg0.y; x0.z *= rn * kg0.z; x0.w *= rn * kg0.w;
                    x1.x *= rn * kg1.x; x1.y *= rn * kg1.y; x1.z *= rn * kg1.z; x1.w *= rn * kg1.w;
                    const float4 o0 = make_float4(quad_x2(x0.x), quad_x2(x0.y), quad_x2(x0.z), quad_x2(x0.w)), o1 = make_float4(quad_x2(x1.x), quad_x2(x1.y), quad_x2(x1.z), quad_x2(x1.w));
                    const float4 c0 = cc0[r4], c1 = cc1[r4], s0 = ss0[r4], s1 = ss1[r4];
                    const float sg = (lq & 2) ? 1.f : -1.f;
                    float4 r0, r1;
                    r0.x = x0.x * c0.x + sg * o0.x * s0.x; r0.y = x0.y * c0.y + sg * o0.y * s0.y; r0.z = x0.z * c0.z + sg * o0.z * s0.z; r0.w = x0.w * c0.w + sg * o0.w * s0.w;
                    r1.x = x1.x * c1.x + sg * o1.x * s1.x; r1.y = x1.y * c1.y + sg * o1.y * s1.y; r1.z = x1.z * c1.z + sg * o1.z * s1.z; r1.w = x1.w * c1.w + sg * o1.w * s1.w;
                    if (l16 < 4) *(uint4*)(w.kpeb + (size_t)tok * 32 + dd) = pack8(r0, r1);
                }
            }
        }
        __syncthreads();
    }
}

}
namespace fx {

constexpr float QSCALE = 0.10206207261596575f * 1.4426950408889634f;

__device__ void qkv_item(const Params& P, int L, const bool isq, const int mt, const int nt, char* lds, const int tid_in) {
    int tid = tid_in; asm volatile("" : "+v"(tid));
    const WS& w = P.w; const nv::Inputs& in = P.in;
    const int lane = tid & 63, wid = tid >> 6;
    float* T = (float*)lds; float* stat = (float*)(lds + STAT_OFF);
    const int m0 = mt * 128, n0 = nt * 128;
    const int K = isq ? 256 : 128;
    {
        const bf16_t* A = isq ? w.cqb : w.ckvb;
        const bf16_t* Wt = isq ? (w.Wuqt + L * WUQ_SZ) : (w.Wukvt + L * WUKV_SZ);
        const bf16_t* arow[4]; const bf16_t* wrow[4];
#pragma unroll
        for (int i = 0; i < 4; ++i) {
            arow[i] = A + (size_t)(m0 + (tid >> 3) + 32 * i) * K + g64_chunk(tid) * 8;
            wrow[i] = Wt + (size_t)(n0 + (tid >> 3) + 32 * i) * K + g64_chunk(tid) * 8;
        }
        f32x16 acc[2][2]; acc_zero(acc);
        float my_rs = 0.f;
        if (tid < 128) {
            const float4 c = *(const float4*)(w.cqss + (size_t)(m0 + tid) * 4);
            my_rs = isq ? rsq_((c.x + c.y) * (1.f / 256.f) + EPS) : rsq_(c.z * (1.f / 128.f) + EPS);
        }
        gemm_mainloop_g64(acc, arow, wrow, K / 64, lds, tid);
        if (tid < 128) stat[tid] = my_rs;
        acc_to_lds(acc, T, tid);
    }
    const int b = m0 >> 11, s0 = m0 & 2047;
    const int sub = lane >> 4, l16 = lane & 15, c8 = l16 * 8;
    if (isq && nt < 4) {
        const int hd = nt * 2 + (l16 >> 3), d = (l16 & 7) * 8;
        const float4 g0 = mul4(*(const float4*)(in.q_norm_g + L * 96 + d), QSCALE), g1 = mul4(*(const float4*)(in.q_norm_g + L * 96 + d + 4), QSCALE);
        bf16_t* dst = w.Qb + ((size_t)(b * 8 + hd) * 2048 + s0) * 96 + d;
#pragma unroll 8
        for (int rr = 0; rr < 8; ++rr) {
            const int row = wid * 32 + rr * 4 + sub; const float rs = stat[row];
            float4 x0 = mul4(*(const float4*)(T + row * TLD + c8), rs), x1 = mul4(*(const float4*)(T + row * TLD + c8 + 4), rs);
            const float rn = rsq_(grp_sum8(sq8(x0, x1)) * (1.f / 64.f) + EPS);
            x0.x *= rn * g0.x; x0.y *= rn * g0.y; x0.z *= rn * g0.z; x0.w *= rn * g0.w; x1.x *= rn * g1.x; x1.y *= rn * g1.y; x1.z *= rn * g1.z; x1.w *= rn * g1.w;
            *(uint4*)(dst + (size_t)row * 96) = pack8(x0, x1);
        }
    } else if (isq) {
        const int hd = (nt - 4) * 4 + (l16 >> 2), lq = l16 & 3, dd = lq * 8, jj = (lq & 1) * 8;
        const float4 g0 = *(const float4*)(in.q_norm_g + L * 96 + 64 + dd), g1 = *(const float4*)(in.q_norm_g + L * 96 + 64 + dd + 4);
        bf16_t* dst = w.Qb + ((size_t)(b * 8 + hd) * 2048 + s0) * 96 + 64 + dd;
        const float sg = (lq & 2) ? QSCALE : -QSCALE;
#pragma unroll 1
        for (int hb4 = 0; hb4 < 2; ++hb4) {
            float4 cc0[4], cc1[4], ss0[4], ss1[4];
#pragma unroll
            for (int r4 = 0; r4 < 4; ++r4) {
                const float* csr = w.cs + (size_t)(m0 + wid * 32 + (hb4 * 4 + r4) * 4 + sub) * 32 + jj;
                cc0[r4] = *(const float4*)csr; cc1[r4] = *(const float4*)(csr + 4); ss0[r4] = *(const float4*)(csr + 16); ss1[r4] = *(const float4*)(csr + 20);
            }
#pragma unroll
            for (int r4 = 0; r4 < 4; ++r4) {
                const int row = wid * 32 + (hb4 * 4 + r4) * 4 + sub; const float rs = stat[row];
                float4 x0 = mul4(*(const float4*)(T + row * TLD + c8), rs), x1 = mul4(*(const float4*)(T + row * TLD + c8 + 4), rs);
                const float rn = rsq_(grp_sum4(sq8(x0, x1)) * (1.f / 32.f) + EPS);
                x0.x *= rn * g0.x; x0.y *= rn * g0.y; x0.z *= rn * g0.z; x0.w *= rn * g0.w; x1.x *= rn * g1.x; x1.y *= rn * g1.y; x1.z *= rn * g1.z; x1.w *= rn * g1.w;
                const float4 o0 = make_float4(quad_x2(x0.x), quad_x2(x0.y), quad_x2(x0.z), quad_x2(x0.w)), o1 = make_float4(quad_x2(x1.x), quad_x2(x1.y), quad_x2(x1.z), quad_x2(x1.w));
                const float4 c0 = mul4(cc0[r4], QSCALE), c1 = mul4(cc1[r4], QSCALE), s0v = ss0[r4], s1v = ss1[r4];
                float4 r0, r1;
                r0.x = x0.x * c0.x + sg * o0.x * s0v.x; r0.y = x0.y * c0.y + sg * o0.y * s0v.y; r0.z = x0.z * c0.z + sg * o0.z * s0v.z; r0.w = x0.w * c0.w + sg * o0.w * s0v.w;
                r1.x = x1.x * c1.x + sg * o1.x * s1v.x; r1.y = x1.y * c1.y + sg * o1.y * s1v.y; r1.z = x1.z * c1.z + sg * o1.z * s1v.z; r1.w = x1.w * c1.w + sg * o1.w * s1v.w;
                *(uint4*)(dst + (size_t)row * 96) = pack8(r0, r1);
            }
        }
    } else if (nt < 4) {
        const int hd = nt * 2 + (l16 >> 3), d = (l16 & 7) * 8;
        const float4 g0 = *(const float4*)(in.k_norm_g + L * 96 + d), g1 = *(const float4*)(in.k_norm_g + L * 96 + d + 4);
        bf16_t* dst = w.Knb + ((size_t)(b * 8 + hd) * 2048 + s0) * 64 + d;
#pragma unroll 8
        for (int rr = 0; rr < 8; ++rr) {
            const int row = wid * 32 + rr * 4 + sub; const float rs = stat[row];
            float4 x0 = mul4(*(const float4*)(T + row * TLD + c8), rs), x1 = mul4(*(const float4*)(T + row * TLD + c8 + 4), rs);
            const float rn = rsq_(grp_sum8(sq8(x0, x1)) * (1.f / 64.f) + EPS);
            x0.x *= rn * g0.x; x0.y *= rn * g0.y; x0.z *= rn * g0.z; x0.w *= rn * g0.w; x1.x *= rn * g1.x; x1.y *= rn * g1.y; x1.z *= rn * g1.z; x1.w *= rn * g1.w;
            *(uint4*)(dst + (size_t)row * 64) = pack8(x0, x1);
        }
    } else {
        const int c = tid & 127, th = tid >> 7, hd = (nt - 4) * 2 + (c >> 6), d = c & 63;
        bf16_t* dst = w.VTb + ((size_t)(b * 8 + hd) * 64 + d) * 2048 + s0 + th * 64;
#pragma unroll 2
        for (int k8 = 0; k8 < 8; ++k8) {
            float v[8];
#pragma unroll
            for (int k = 0; k < 8; ++k) { const int row = th * 64 + k8 * 8 + k; v[k] = T[row * TLD + c] * stat[row]; }
            uint4 pk; pk.x = pack2(v[0], v[1]); pk.y = pack2(v[2], v[3]); pk.z = pack2(v[4], v[5]); pk.w = pack2(v[6], v[7]);
            *(uint4*)(dst + k8 * 8) = pk;
        }
    }
    __syncthreads();
}

__device__ void sgu_item(const Params& P, int L, int mt, char* lds, const int tid_in) {
    int tid = tid_in; asm volatile("" : "+v"(tid));
    const WS& w = P.w; const nv::Inputs& in = P.in;
    const int lane = tid & 63, hd = tid >> 6, fr = lane & 31, fh = lane >> 5;
    float* red = (float*)lds;
    const bf16_t* vt = w.vT + (size_t)(mt * 4 + hd) * 64 * 128;
    const bf16_t* ws = w.Wsm + L * WSM_SZ + (size_t)hd * 128 * 128;
    const float* bs = in.sgu_b + L * 512 + hd * 128;
    const int m0 = mt * 128;
    bf16x8 af0[8], af1[8];
    {
        const bf16_t* ap0 = vt + (size_t)fr * 128 + 8 * fh;
        const bf16_t* ap1 = vt + (size_t)(32 + fr) * 128 + 8 * fh;
#pragma unroll
        for (int s = 0; s < 8; ++s) { af0[s] = *(const bf16x8*)(ap0 + 16 * s); af1[s] = *(const bf16x8*)(ap1 + 16 * s); }
    }
#pragma unroll 1
    for (int it = 0; it < 4; ++it) {
        f32x16 a0, a1;
#pragma unroll
        for (int r = 0; r < 16; ++r) { a0[r] = 0.f; a1[r] = 0.f; }
        const bf16_t* bp = ws + (size_t)(it * 32 + fr) * 128 + 8 * fh;
        bf16x8 bfr[8];
#pragma unroll
        for (int s = 0; s < 8; ++s) bfr[s] = *(const bf16x8*)(bp + 16 * s);
#pragma unroll
        for (int s = 0; s < 8; ++s) {
            a0 = __builtin_amdgcn_mfma_f32_32x32x16_bf16(af0[s], bfr[s], a0, 0, 0, 0);
            a1 = __builtin_amdgcn_mfma_f32_32x32x16_bf16(af1[s], bfr[s], a1, 0, 0, 0);
        }
        const int i = it * 32 + fr, tok = m0 + i;
        const float bias = bs[i];
        uint2 uu[2][4];
#pragma unroll
        for (int dt = 0; dt < 2; ++dt)
#pragma unroll
            for (int g = 0; g < 4; ++g) uu[dt][g] = *(const uint2*)(w.ub + (size_t)tok * 256 + hd * 64 + dt * 32 + 8 * g + 4 * fh);
        float ssq = 0.f;
#pragma unroll
        for (int dt = 0; dt < 2; ++dt)
#pragma unroll
            for (int g = 0; g < 4; ++g) {
                const int d = dt * 32 + 8 * g + 4 * fh;
                float o[4];
#pragma unroll
                for (int q = 0; q < 4; ++q) {
                    const float sv = (dt == 0 ? a0[4 * g + q] : a1[4 * g + q]) + bias;
                    const float uv = (q == 0) ? bflo(uu[dt][g].x) : (q == 1) ? bfhi(uu[dt][g].x) : (q == 2) ? bflo(uu[dt][g].y) : bfhi(uu[dt][g].y);
                    o[q] = uv * sv; ssq += o[q] * o[q];
                }
                store4(w.yb + (size_t)tok * 1024 + hd * 64 + d, o[0], o[1], o[2], o[3]);
            }
        ssq = xor32(ssq);
        if (fh == 0) red[hd * 128 + i] = ssq;
    }
    __syncthreads();
    if (tid < 128) w.ssq[(size_t)(m0 + tid) * 16 + 0] = red[tid] + red[128 + tid] + red[256 + tid] + red[384 + tid];
    __syncthreads();
}

constexpr int CLD = 260, CONV_YL = 32 * CLD * 4, CONV_ST = CONV_YL + 32 * 512, CONV_RED = CONV_ST + 32 * 4 * 8;
__device__ __forceinline__ int yl_off(int row, int chunk) { return row * 512 + ((chunk ^ (row & 15)) << 4); }
__device__ void conv_item(const Params& P, int L, int ct, char* lds, const int tid_in) {
    int tid = tid_in; asm volatile("" : "+v"(tid));
    const WS& w = P.w; const nv::Inputs& in = P.in;
    const int lane = tid & 63, wid = tid >> 6, fr = lane & 31, fh = lane >> 5;
    float* C = (float*)lds; char* yl = lds + CONV_YL; float2* stats = (float2*)(lds + CONV_ST); float* red = (float*)(lds + CONV_RED);
    const int t0 = ct * 32, s0 = t0 & 2047;
    {
        const int c = tid;
        float x[62];
#pragma unroll
        for (int r = 0; r < 62; ++r) {
            const bool ok = s0 + r - 30 >= 0;
            const unsigned short raw = w.ygb[(size_t)(ok ? t0 + r - 30 : t0) * 256 + c];
            x[r] = bf2f(raw) * (ok ? 1.f : 0.f);
        }
        float wk[31];
#pragma unroll
        for (int k = 0; k < 31; ++k) wk[k] = in.conv_w[(size_t)L * 31 * 256 + k * 256 + c];
        const float cb = in.conv_b[L * 256 + c];
#pragma unroll
        for (int t = 0; t < 32; ++t) {
            float a = cb;
#pragma unroll
            for (int k = 0; k < 31; ++k) a = fmaf(wk[k], x[t + k], a);
            C[t * CLD + c] = a;
        }
    }
    __syncthreads();
    if (tid < 128) {
        const int t = tid >> 2, g = tid & 3;
        const float4* cp = (const float4*)(C + t * CLD + g * 64);
        float4 v[16]; float s = 0.f;
#pragma unroll
        for (int i = 0; i < 16; ++i) { v[i] = cp[i]; s += (v[i].x + v[i].y) + (v[i].z + v[i].w); }
        const float mean = s * (1.f / 64.f); float q = 0.f;
#pragma unroll
        for (int i = 0; i < 16; ++i) { const float a = v[i].x - mean, b2 = v[i].y - mean, c2 = v[i].z - mean, d2 = v[i].w - mean; q += (a * a + b2 * b2) + (c2 * c2 + d2 * d2); }
        stats[t * 4 + g] = make_float2(mean, rsq_(q * (1.f / 64.f) + EPS));
    }
    __syncthreads();
    {
        const int c = tid, g = c >> 6;
        const float lg = in.conv_ln_g[L * 256 + c], lb = in.conv_ln_b[L * 256 + c];
#pragma unroll 8
        for (int t = 0; t < 32; ++t) {
            const float2 st = stats[t * 4 + g];
            const float v = (C[t * CLD + c] - st.x) * st.y * lg + lb;
            *(bf16_t*)(yl + yl_off(t, c >> 3) + (c & 7) * 2) = (bf16_t)f2bf(v * sigmoid_(v));
        }
    }
    __syncthreads();
    f32x16 acc0, acc1;
#pragma unroll
    for (int r = 0; r < 16; ++r) { acc0[r] = 0.f; acc1[r] = 0.f; }
    const bf16_t* wp = w.Wpwt + L * WPW_SZ + (size_t)(wid * 64 + fr) * 256 + 8 * fh;
#pragma unroll 1
    for (int sb = 0; sb < 2; ++sb) {
        bf16x8 w0[8], w1[8];
#pragma unroll
        for (int s = 0; s < 8; ++s) { w0[s] = *(const bf16x8*)(wp + 16 * (sb * 8 + s)); w1[s] = *(const bf16x8*)(wp + 32 * 256 + 16 * (sb * 8 + s)); }
#pragma unroll
        for (int s = 0; s < 8; ++s) {
            const bf16x8 x0 = *(const bf16x8*)(yl + yl_off(fr, 2 * (sb * 8 + s) + fh));
            acc0 = __builtin_amdgcn_mfma_f32_32x32x16_bf16(w0[s], x0, acc0, 0, 0, 0);
            acc1 = __builtin_amdgcn_mfma_f32_32x32x16_bf16(w1[s], x0, acc1, 0, 0, 0);
        }
    }
    const float* pb = in.conv_pw_b + L * 256;
    {
        const int tok = t0 + fr;
        float4 bia[2][4];
#pragma unroll
        for (int jn = 0; jn < 2; ++jn)
#pragma unroll
            for (int g = 0; g < 4; ++g) bia[jn][g] = *(const float4*)(pb + wid * 64 + jn * 32 + 8 * g + 4 * fh);
        float ssq = 0.f;
#pragma unroll
        for (int jn = 0; jn < 2; ++jn)
#pragma unroll
            for (int g = 0; g < 4; ++g) {
                const int n = wid * 64 + jn * 32 + 8 * g + 4 * fh;
                const float4 b4 = bia[jn][g];
                const float o0 = (jn ? acc1[4 * g] : acc0[4 * g]) + b4.x, o1 = (jn ? acc1[4 * g + 1] : acc0[4 * g + 1]) + b4.y;
                const float o2 = (jn ? acc1[4 * g + 2] : acc0[4 * g + 2]) + b4.z, o3 = (jn ? acc1[4 * g + 3] : acc0[4 * g + 3]) + b4.w;
                ssq += o0 * o0 + o1 * o1 + o2 * o2 + o3 * o3;
                store4(w.yb + (size_t)tok * 1024 + 256 + n, o0, o1, o2, o3);
            }
        ssq = xor32(ssq);
        if (fh == 0) red[wid * 32 + fr] = ssq;
    }
    __syncthreads();
    if (tid < 32) w.ssq[(size_t)(t0 + tid) * 16 + 1] = red[tid] + red[32 + tid] + red[64 + tid] + red[96 + tid];
    __syncthreads();
}

__device__ void phase_mix(const Params& P, int L, char* lds, const int rep = 0, const bool dryrun = false) {
    const int tid = opaque_tid();
    const int x = blockIdx.x & 7;
    int* qctr = P.w.cnt + L * 256 + 72 + x + 8 * rep;
    volatile int* slot = (volatile int*)(lds + LDS_GEMM_BYTES - 16);
    if (tid == 0) *slot = atomicAdd(qctr, 1);
    __syncthreads();
    int cur = *slot;
    __syncthreads();
    while (cur < 304) {
        int nxt = 0;
        if (tid == 0) nxt = atomicAdd(qctr, 1);
#ifdef MIX_MASK
        const int mask = dryrun ? MIX_MASK : 15;
#else
        const int mask = 15;
#endif
#ifdef MIX_TWICE
        if (cur < 16) { if (MIX_TWICE & 1) sgu_item(P, L, cur * 8 + x, lds, tid); }
        else if (cur < 80) { if (MIX_TWICE & 2) conv_item(P, L, (cur - 16) * 8 + x, lds, tid); }
        else if (cur < 176) { if (MIX_TWICE & 4) { const int li = cur - 80; qkv_item(P, L, true, (li / 6) * 8 + x, li % 6, lds, tid); } }
        else { if (MIX_TWICE & 8) { const int li = cur - 176; qkv_item(P, L, false, (li >> 3) * 8 + x, li & 7, lds, tid); } }
#endif
        if (cur < 16) { if (mask & 1) sgu_item(P, L, cur * 8 + x, lds, tid); }
        else if (cur < 80) { if (mask & 2) conv_item(P, L, (cur - 16) * 8 + x, lds, tid); }
        else if (cur < 176) { if (mask & 4) { const int li = cur - 80; qkv_item(P, L, true, (li / 6) * 8 + x, li % 6, lds, tid); } }
        else { if (mask & 8) { const int li = cur - 176; qkv_item(P, L, false, (li >> 3) * 8 + x, li & 7, lds, tid); } }
        if (tid == 0) *slot = nxt;
        __syncthreads();
        cur = *slot;
        __syncthreads();
    }
}

}
namespace fx {

constexpr int AKN = 0, AKP = 8192, AVT = 12288, ATT_STAGE = 20480;
__device__ __forceinline__ void att_issue(const bf16_t* Kn, const bf16_t* Kp, const bf16_t* Vt, int k0, char* st, const int tid, const int wbase) {
    {
        const int row = tid >> 3, ch = (tid & 7) ^ ((tid >> 4) & 7);
        glds16(Kn + (size_t)(k0 + row) * 64 + ch * 8, st + AKN + wbase);
        glds16(Kn + (size_t)(k0 + row + 32) * 64 + ch * 8, st + AKN + 4096 + wbase);
    }
    {
        const int row = tid >> 2, ch = (tid & 3) ^ ((tid >> 4) & 3);
        glds16(Kp + (size_t)(k0 + row) * 32 + ch * 8, st + AKP + wbase);
    }
    {
        const int d = tid >> 3, ch = (tid & 7) ^ ((tid >> 4) & 7);
        glds16(Vt + (size_t)d * 2048 + k0 + ch * 8, st + AVT + wbase);
        glds16(Vt + (size_t)(d + 32) * 2048 + k0 + ch * 8, st + AVT + 4096 + wbase);
    }
}

__device__ void attn_unit(const Params& P, int b, int h, int qt, char* lds, const int tid) {
    const WS& w = P.w;
    const int lane = tid & 63, wid = tid >> 6, fr = lane & 31, fh = lane >> 5;
    const int wbase = __builtin_amdgcn_readfirstlane(wid) * 1024;
    const bf16_t* Kn = w.Knb + (size_t)(b * 8 + h) * 2048 * 64;
    const bf16_t* Kp = w.kpeb + (size_t)b * 2048 * 32;
    const bf16_t* Vt = w.VTb + (size_t)(b * 8 + h) * 64 * 2048;
    const int q0 = qt * 128, qw0 = q0 + wid * 32, qpos = qw0 + fr;
    bf16x8 qf[6];
    {
        const bf16_t* qp = w.Qb + ((size_t)(b * 8 + h) * 2048 + qpos) * 96 + 8 * fh;
#pragma unroll
        for (int ks = 0; ks < 6; ++ks) qf[ks] = *(const bf16x8*)(qp + 16 * ks);
    }
    f32x16 o0, o1;
#pragma unroll
    for (int r = 0; r < 16; ++r) { o0[r] = 0.f; o1[r] = 0.f; }
    float m = -1e30f, l = 0.f;
    const int nkt = 2 * (qt + 1);
    asm volatile("s_waitcnt vmcnt(0)" ::: "memory");
    att_issue(Kn, Kp, Vt, 0, lds, tid, wbase);
    if (nkt > 1) att_issue(Kn, Kp, Vt, 64, lds + ATT_STAGE, tid, wbase);
    const int kn0 = AKN + fr * 128, kn1 = AKN + (32 + fr) * 128, swn = (fr >> 1) & 7;
    const int kp0 = AKP + fr * 64, kp1 = AKP + (32 + fr) * 64, swp = (fr >> 2) & 3;
    const int vt0 = AVT + fr * 128 + 8 * fh, vt1 = AVT + (32 + fr) * 128 + 8 * fh, swv = (fr >> 1) & 7;
#pragma unroll 1
    for (int kt = 0; kt < nkt; ++kt) {
        if (kt + 1 < nkt) asm volatile("s_waitcnt vmcnt(5)" ::: "memory"); else asm volatile("s_waitcnt vmcnt(0)" ::: "memory");
        RAW_BARRIER();
        if (kt + 2 < nkt) att_issue(Kn, Kp, Vt, (kt + 2) * 64, lds + ((kt + 2) % 3) * ATT_STAGE, tid, wbase);
        const char* cur = lds + (kt % 3) * ATT_STAGE;
        const int k0 = kt * 64;
        if (k0 <= qw0 + 31) {
            f32x16 s0, s1;
#pragma unroll
            for (int r = 0; r < 16; ++r) { s0[r] = 0.f; s1[r] = 0.f; }
            {
                bf16x8 ka[6], kc[6];
#pragma unroll
                for (int ks = 0; ks < 4; ++ks) {
                    const int off = ((2 * ks + fh) ^ swn) << 4;
                    ka[ks] = *(const bf16x8*)(cur + kn0 + off); kc[ks] = *(const bf16x8*)(cur + kn1 + off);
                }
#pragma unroll
                for (int ks = 4; ks < 6; ++ks) {
                    const int off = ((2 * (ks - 4) + fh) ^ swp) << 4;
                    ka[ks] = *(const bf16x8*)(cur + kp0 + off); kc[ks] = *(const bf16x8*)(cur + kp1 + off);
                }
                __builtin_amdgcn_sched_barrier(0);
#pragma unroll
                for (int ks = 0; ks < 6; ++ks) {
                    s0 = __builtin_amdgcn_mfma_f32_32x32x16_bf16(ka[ks], qf[ks], s0, 0, 0, 0);
                    s1 = __builtin_amdgcn_mfma_f32_32x32x16_bf16(kc[ks], qf[ks], s1, 0, 0, 0);
                }
            }
            uint2 va0[4], va1[4], vb0[4], vb1[4];
#pragma unroll
            for (int ks = 0; ks < 4; ++ks) {
                const int c0 = ((2 * ks) ^ swv) << 4, c1 = ((2 * ks + 1) ^ swv) << 4;
                va0[ks] = *(const uint2*)(cur + vt0 + c0); va1[ks] = *(const uint2*)(cur + vt0 + c1);
                vb0[ks] = *(const uint2*)(cur + vt1 + c0); vb1[ks] = *(const uint2*)(cur + vt1 + c1);
            }
            __builtin_amdgcn_sched_barrier(0);
            if (k0 + 63 > qw0) {
#pragma unroll
                for (int r = 0; r < 16; ++r) {
                    const int key = k0 + nidx(r, fh);
                    if (key > qpos) s0[r] = -1e30f;
                    if (key + 32 > qpos) s1[r] = -1e30f;
                }
            }
            float mx = s0[0];
#pragma unroll
            for (int r = 1; r < 16; ++r) mx = fmaxf(mx, s0[r]);
#pragma unroll
            for (int r = 0; r < 16; ++r) mx = fmaxf(mx, s1[r]);
            mx = swap32_max(mx);
            const float mn = fmaxf(m, mx);
            const float alpha = __builtin_amdgcn_exp2f(m - mn);
            m = mn;
            float ps = 0.f;
#pragma unroll
            for (int r = 0; r < 16; ++r) { s0[r] = __builtin_amdgcn_exp2f(s0[r] - mn); ps += s0[r]; }
#pragma unroll
            for (int r = 0; r < 16; ++r) { s1[r] = __builtin_amdgcn_exp2f(s1[r] - mn); ps += s1[r]; }
            ps = swap32_sum(ps);
            l = l * alpha + ps;
#pragma unroll
            for (int r = 0; r < 16; ++r) { o0[r] *= alpha; o1[r] *= alpha; }
#pragma unroll
            for (int ks = 0; ks < 4; ++ks) {
                bf16x8 pf;
                {
                    const int rb = 8 * (ks & 1);
                    unsigned u0, u1, u2, u3;
                    if (ks < 2) { u0 = pack2(s0[rb], s0[rb + 1]); u1 = pack2(s0[rb + 2], s0[rb + 3]); u2 = pack2(s0[rb + 4], s0[rb + 5]); u3 = pack2(s0[rb + 6], s0[rb + 7]); }
                    else { u0 = pack2(s1[rb], s1[rb + 1]); u1 = pack2(s1[rb + 2], s1[rb + 3]); u2 = pack2(s1[rb + 4], s1[rb + 5]); u3 = pack2(s1[rb + 6], s1[rb + 7]); }
                    uint4 uu = make_uint4(u0, u1, u2, u3);
                    pf = __builtin_bit_cast(bf16x8, uu);
                }
                const bf16x8 vfa = __builtin_bit_cast(bf16x8, make_uint4(va0[ks].x, va0[ks].y, va1[ks].x, va1[ks].y));
                const bf16x8 vfb = __builtin_bit_cast(bf16x8, make_uint4(vb0[ks].x, vb0[ks].y, vb1[ks].x, vb1[ks].y));
                o0 = __builtin_amdgcn_mfma_f32_32x32x16_bf16(vfa, pf, o0, 0, 0, 0);
                o1 = __builtin_amdgcn_mfma_f32_32x32x16_bf16(vfb, pf, o1, 0, 0, 0);
            }
        }
    }
    RAW_BARRIER();
    const float inv = 1.f / l;
    const int tok = b * 2048 + qpos;
    float ssq = 0.f;
#pragma unroll
    for (int dt = 0; dt < 2; ++dt)
#pragma unroll
        for (int g = 0; g < 4; ++g) {
            float o[4];
#pragma unroll
            for (int q = 0; q < 4; ++q) { o[q] = (dt == 0 ? o0[4 * g + q] : o1[4 * g + q]) * inv; ssq += o[q] * o[q]; }
            store4(w.yb + (size_t)tok * 1024 + 512 + h * 64 + dt * 32 + 8 * g + 4 * fh, o[0], o[1], o[2], o[3]);
        }
    ssq = xor32(ssq);
    if (fh == 0) w.ssq[(size_t)tok * 16 + 8 + h] = ssq;
}

__device__ void phase_attn(const Params& P, int L, char* lds) {
    const int tid0 = opaque_tid();
    const int h = blockIdx.x & 7, nlb = gridDim.x >> 3;
    for (int li = blockIdx.x >> 3; li < 64; li += nlb) {
        int tid = tid0; asm volatile("" : "+v"(tid));
        const int p = li & 7, b = li >> 3;
        attn_unit(P, b, h, 15 - p, lds, tid);
        attn_unit(P, b, h, p, lds, tid);
    }
}

}
namespace fx {

__device__ __forceinline__ void acc_scale(f32x16 (&acc)[2][2], const float* f, const int tid) {
    const int lane = tid & 63, wr = tid >> 7, fr = lane & 31;
#pragma unroll
    for (int i = 0; i < 2; ++i) {
        const float v = f[wr * 64 + i * 32 + fr];
#pragma unroll
        for (int j = 0; j < 2; ++j)
#pragma unroll
            for (int r = 0; r < 16; ++r) acc[i][j][r] *= v;
    }
}
__device__ void phase_oproj(const Params& P, int L, char* lds, const bool dry = false) {
    const WS& w = P.w;
    const int tid0 = opaque_tid();
    float* T = (float*)lds; float* stat = (float*)(lds + STAT_OFF);
    const bf16_t* Wt = w.Wot + L * WO_SZ;
    int mt, nt;
    for (int it = 0; xcd_item(it, 128, 8, mt, nt); ++it) {
        int tid = tid0; asm volatile("" : "+v"(tid));
        const int lane = tid & 63, wid = tid >> 6;
        const int m0 = mt * 128, n0 = nt * 128;
        float rb_keep = 0.f;
        if (tid < 128) {
            const float* sq = w.ssq + (size_t)(m0 + tid) * 16;
            const float4 c0 = *(const float4*)(sq + 8), c1 = *(const float4*)(sq + 12);
            const float ra = rsq_(sq[0] * (1.f / 256.f) + EPS), rb = rsq_(sq[1] * (1.f / 256.f) + EPS);
            const float rc = rsq_((c0.x + c0.y + c0.z + c0.w + c1.x + c1.y + c1.z + c1.w) * (1.f / 512.f) + EPS);
            stat[tid] = rc / ra; stat[128 + tid] = ra / rb; rb_keep = rb;
        }
        {
            const bf16_t* arow[4]; const bf16_t* wrow[4];
#pragma unroll
            for (int i = 0; i < 4; ++i) {
                arow[i] = w.yb + (size_t)(m0 + (tid >> 3) + 32 * i) * 1024 + g64_chunk(tid) * 8;
                wrow[i] = Wt + (size_t)(n0 + (tid >> 3) + 32 * i) * 1024 + g64_chunk(tid) * 8;
            }
            f32x16 acc[2][2]; acc_zero(acc);
            gemm_mainloop_g64<true>(acc, arow, wrow, 16, lds, tid, 8, 8, stat, 12, stat + 128);
            if (tid < 128) stat[tid] = rb_keep;
            acc_to_lds(acc, T, tid);
        }
        {
            const int sub = lane >> 4, c8 = (lane & 15) * 8;
            float4 hv0[8], hv1[8];
            if (L == 0) {
#pragma unroll
                for (int rr = 0; rr < 8; ++rr) {
                    const float4* hin = (const float4*)(P.in.x + (size_t)(m0 + wid * 32 + rr * 4 + sub) * 1024 + n0 + c8);
                    hv0[rr] = hin[0]; hv1[rr] = hin[1];
                }
            } else {
#pragma unroll
                for (int rr = 0; rr < 8; ++rr) {
                    const uint4 hh = *(const uint4*)(w.hb + (size_t)(m0 + wid * 32 + rr * 4 + sub) * 1024 + n0 + c8);
                    hv0[rr] = make_float4(bflo(hh.x), bfhi(hh.x), bflo(hh.y), bfhi(hh.y)); hv1[rr] = make_float4(bflo(hh.z), bfhi(hh.z), bflo(hh.w), bfhi(hh.w));
                }
            }
#pragma unroll
            for (int rr = 0; rr < 8; ++rr) {
                const int row = wid * 32 + rr * 4 + sub; const float rb = stat[row];
                const float4 x0 = *(const float4*)(T + row * TLD + c8), x1 = *(const float4*)(T + row * TLD + c8 + 4);
                float4 h0 = hv0[rr], h1 = hv1[rr];
                h0.x += x0.x * rb; h0.y += x0.y * rb; h0.z += x0.z * rb; h0.w += x0.w * rb;
                h1.x += x1.x * rb; h1.y += x1.y * rb; h1.z += x1.z * rb; h1.w += x1.w * rb;
                *(uint4*)(w.hb1 + (size_t)(m0 + row) * 1024 + n0 + c8) = pack8(h0, h1);
                const float sq = grp_sum16(sq8(h0, h1));
                if ((lane & 15) == 0) w.rssB[(size_t)(m0 + row) * 8 + nt] = sq;
            }
        }
        __syncthreads();
    }
}

__device__ void router_item(const Params& P, int L, int mt, char* lds, const int tid_in, const bool dry) {
    int tid = tid_in; asm volatile("" : "+v"(tid));
    const WS& w = P.w; const nv::Inputs& in = P.in;
    float* T = (float*)lds; float* stat = (float*)(lds + STAT_OFF); int* hist = (int*)(lds + STAT_OFF + 1024);
    const int m0 = mt * 128;
    {
        const bf16_t* arow[4]; const bf16_t* wrow[4];
#pragma unroll
        for (int i = 0; i < 4; ++i) {
            arow[i] = w.hb1 + (size_t)(m0 + (tid >> 3) + 32 * i) * 1024 + g64_chunk(tid) * 8;
            wrow[i] = w.Wrt + L * WR_SZ + (size_t)((tid >> 3) + 32 * i) * 1024 + g64_chunk(tid) * 8;
        }
        f32x16 acc[2][2]; acc_zero(acc);
        float my_rs = 0.f;
        if (tid < 128) my_rs = rstd8(w.rssB + (size_t)(m0 + tid) * 8, 1.f / 1024.f);
        gemm_mainloop_g64(acc, arow, wrow, 16, lds, tid);
        if (tid < 128) stat[tid] = my_rs;
        if (tid < 64) hist[tid] = 0;
        acc_to_lds(acc, T, tid);
    }
    int e0 = 0, e1 = 0, r0 = 0, r1 = 0; float w0 = 0.f, w1 = 0.f;
    if (tid < 128) {
        const float rs = stat[tid];
        const float* lr = T + tid * TLD;
        const float* bg = in.router_group_b + L * 4; const float* be = in.router_expert_b + L * 32;
        int gi = 0; float gm = lr[0] * rs + bg[0];
#pragma unroll
        for (int j = 1; j < 4; ++j) { const float v = lr[j] * rs + bg[j]; if (v > gm) { gm = v; gi = j; } }
        float gs = 0.f;
#pragma unroll
        for (int j = 0; j < 4; ++j) gs += __builtin_amdgcn_exp2f(1.4426950408889634f * (lr[j] * rs + bg[j] - gm));
        const float gw = 1.f / gs;
        int i0 = 0, i1 = -1; float v0 = -3.0e38f, v1 = -3.0e38f;
#pragma unroll
        for (int j = 0; j < 8; ++j) {
            const float v = lr[4 + gi * 8 + j] * rs + be[gi * 8 + j];
            if (v > v0) { v1 = v0; i1 = i0; v0 = v; i0 = j; } else if (v > v1) { v1 = v; i1 = j; }
        }
        const float ex = __builtin_amdgcn_exp2f(1.4426950408889634f * (v1 - v0));
        w0 = gw / (1.f + ex); w1 = gw * ex / (1.f + ex);
        e0 = gi * 8 + i0; e1 = gi * 8 + i1;
        e0 = e0 * 2; e1 = e1 * 2 + 1;
        r0 = atomicAdd(&hist[e0], 1); r1 = atomicAdd(&hist[e1], 1);
    }
    __syncthreads();
    if (tid < 64) hist[64 + tid] = (hist[tid] && !dry) ? atomicAdd(&w.cnt[L * 256 + tid], hist[tid]) : 0;
    __syncthreads();
    if (tid < 128 && !dry) {
        const int tok = m0 + tid;
        const int p0 = hist[64 + e0] + r0, p1 = hist[64 + e1] + r1;
        w.elist[(size_t)e0 * NT + p0] = tok; w.ewt[(size_t)e0 * NT + p0] = w0;
        w.elist[(size_t)e1 * NT + p1] = tok; w.ewt[(size_t)e1 * NT + p1] = w1;
    }
    __syncthreads();
}
__device__ void eraw_item(const Params& P, int L, const int mt, const int nt, char* lds, const int tid_in) {
    int tid = tid_in; asm volatile("" : "+v"(tid));
    const WS& w = P.w; const nv::Inputs& in = P.in;
    const int lane = tid & 63, wid = tid >> 6;
    float* T = (float*)lds;
    const int m0 = mt * 128, n0 = nt * 128;
    {
        const float* arow[4]; const bf16_t* wrow[4];
#pragma unroll
        for (int i = 0; i < 4; ++i) {
            arow[i] = in.p + ((size_t)L * NT + m0 + (tid >> 3) + 32 * i) * 256 + (tid & 7) * 8;
            wrow[i] = w.Wpt + L * WP_SZ + (size_t)(n0 + (tid >> 3) + 32 * i) * 256 + (tid & 7) * 8;
        }
        f32x16 acc[2][2]; acc_zero(acc);
        float ss[4] = {0.f, 0.f, 0.f, 0.f};
        gemm_mainloop<float, false>(acc, arow, wrow, 4, lds, ss, tid);
        acc_to_lds(acc, T, tid);
    }
    {
        const int sub = lane >> 4, l16 = lane & 15, c8 = l16 * 8;
#pragma unroll 8
        for (int rr = 0; rr < 8; ++rr) {
            const int row = wid * 32 + rr * 4 + sub;
            const float4 x0 = *(const float4*)(T + row * TLD + c8), x1 = *(const float4*)(T + row * TLD + c8 + 4);
            *(uint4*)(w.erb + (size_t)(m0 + row) * 1024 + n0 + c8) = pack8(x0, x1);
            const float sq = grp_sum16(sq8(x0, x1));
            if (l16 == 0) w.essq[(size_t)(m0 + row) * 8 + nt] = sq;
        }
    }
    __syncthreads();
}
__device__ void phase_router(const Params& P, int L, char* lds, const bool dry = false) {
    const int tid = opaque_tid();
    {
        const int x = blockIdx.x & 7, lb = blockIdx.x >> 3, nlb = gridDim.x >> 3;
        if (lb < 16 || nlb <= 16) { for (int j = lb; j < 16; j += nlb) router_item(P, L, j * 8 + x, lds, tid, dry); }
        if (!dry) {
            if (nlb > 16) { if (lb >= 16) prep_moe_late(P, L, lds, tid, (lb - 16) * 8 + x, (nlb - 16) * 8); }
            else prep_moe_late(P, L, lds, tid, blockIdx.x, gridDim.x);
        }
    }
}

constexpr int TT_OFF = STAT_OFF + 1024;
__device__ __forceinline__ void moe_table(const Params& P, int L, char* lds, const int tid) {
    int* tt = (int*)(lds + TT_OFF);
    if (tid == 0) {
        const int x = blockIdx.x & 7;
        int o = 0;
        for (int li = 0; li < 64; ++li) { tt[li] = o; o += P.w.cnt[L * 256 + li]; }
        tt[64] = o;
        int t = 0, t0 = 0, t1 = 0;
        for (int k = 0; k < 8; ++k) {
            const int li = ((k >> 1) * 8 + x) * 2 + (k & 1), nt_ = (P.w.cnt[L * 256 + li] + 127) >> 7;
            tt[72 + k] = t; t += nt_;
            if (k & 1) { tt[92 + (k >> 1)] = t1; t1 += nt_; } else { tt[84 + (k >> 1)] = t0; t0 += nt_; }
        }
        tt[80] = t; tt[88] = t0; tt[96] = t1;
        int tu = 0;
        for (int k = 0; k < 4; ++k) { const int e = k * 8 + x; tt[100 + k] = tu; tu += (P.w.cnt[L * 256 + 2 * e] + P.w.cnt[L * 256 + 2 * e + 1] + 127) >> 7; }
        tt[104] = tu;
    }
    __syncthreads();
}
__device__ __forceinline__ void moe_find(const int* tt, int tile, int& li, int& t) {
    int k = 0;
#pragma unroll
    for (int j = 1; j < 8; ++j) if (tile >= tt[72 + j]) k = j;
    li = ((k >> 1) * 8 + (blockIdx.x & 7)) * 2 + (k & 1); t = tile - tt[72 + k];
}
__device__ __forceinline__ void moe_find_slot(const int* tt, int slot, int tile, int& li, int& t) {
    const int* tp = tt + (slot ? 92 : 84);
    int k = 0;
#pragma unroll
    for (int j = 1; j < 4; ++j) if (tile >= tp[j]) k = j;
    li = (k * 8 + (blockIdx.x & 7)) * 2 + slot; t = tile - tp[k];
}
__device__ void phase_moe_up(const Params& P, int L, char* lds, const bool noeraw = false) {
    const WS& w = P.w;
    const int tid0 = opaque_tid();
    float* T = (float*)lds; float* stat = (float*)(lds + STAT_OFF); const int* tt = (const int*)(lds + TT_OFF);
    moe_table(P, L, lds, tid0);
    const int ntiles = tt[104];
    for (int item = blockIdx.x >> 3; item < ntiles * 4; item += (gridDim.x >> 3)) {
        int tid = tid0; asm volatile("" : "+v"(tid));
        const int lane = tid & 63, wid = tid >> 6;
        const int tile = item >> 2, nt = item & 3;
        int k = 0;
#pragma unroll
        for (int j = 1; j < 4; ++j) if (tile >= tt[100 + j]) k = j;
        const int e = k * 8 + (blockIdx.x & 7), t = tile - tt[100 + k];
        const int cnt0 = P.w.cnt[L * 256 + 2 * e], cnt = cnt0 + P.w.cnt[L * 256 + 2 * e + 1];
        const int rbase = tt[2 * e] + t * 128, nrows = min(128, cnt - t * 128);
        {
            const bf16_t* arow[4]; const bf16_t* wrow[4];
#pragma unroll
            for (int i = 0; i < 4; ++i) {
                const int r = (tid >> 3) + 32 * i;
                const int rr3 = t * 128 + (r < nrows ? r : 0);
                const int tok = rr3 < cnt0 ? w.elist[(size_t)(2 * e) * NT + rr3] : w.elist[(size_t)(2 * e + 1) * NT + rr3 - cnt0];
                arow[i] = w.hb1 + (size_t)tok * 1024 + g64_chunk(tid) * 8;
                wrow[i] = w.Wgut + L * WGU_SZ + ((size_t)e * 512 + nt * 128 + r) * 1024 + g64_chunk(tid) * 8;
            }
            f32x16 acc[2][2]; acc_zero(acc);
            float my_rs = 0.f;
            if (tid < 128) {
                const int rr3 = t * 128 + (tid < nrows ? tid : 0);
                const int tok = rr3 < cnt0 ? w.elist[(size_t)(2 * e) * NT + rr3] : w.elist[(size_t)(2 * e + 1) * NT + rr3 - cnt0];
                my_rs = rstd8(w.rssB + (size_t)tok * 8, 1.f / 1024.f);
            }
            gemm_mainloop_g64(acc, arow, wrow, 16, lds, tid);
            if (tid < 128) stat[tid] = my_rs;
            acc_to_lds(acc, T, tid);
        }
        {
            const int sub = lane >> 4, l16 = lane & 15, c8 = l16 * 8;
#pragma unroll 8
            for (int rr = 0; rr < 8; ++rr) {
                const int row = wid * 32 + rr * 4 + sub; const float rs = stat[row];
                const float4 x0 = mul4(*(const float4*)(T + row * TLD + c8), rs), x1 = mul4(*(const float4*)(T + row * TLD + c8 + 4), rs);
                if (row < nrows)
                    store4(w.hbuf + (size_t)(rbase + row) * 256 + nt * 64 + l16 * 4, x0.x * sigmoid_(x0.x) * x0.y, x0.z * sigmoid_(x0.z) * x0.w,
                           x1.x * sigmoid_(x1.x) * x1.y, x1.z * sigmoid_(x1.z) * x1.w);
            }
        }
        __syncthreads();
    }
    if (!noeraw) {
        int* qslot = (int*)(lds + TT_OFF + 256);
        for (;;) {
            if (tid0 == 0) *qslot = atomicAdd(&P.w.cnt[L * 256 + 64], 1);
            __syncthreads();
            const int item = *qslot;
            __syncthreads();
            if (item >= 1024) break;
            eraw_item(P, L, item >> 3, item & 7, lds, tid0);
        }
    }
}
__device__ void phase_moe_down(const Params& P, int L, char* lds, const int slot, const bool dry = false) {
    const WS& w = P.w;
    const int tid0 = opaque_tid();
    float* T = (float*)lds; float* stat = (float*)(lds + STAT_OFF); const int* tt = (const int*)(lds + TT_OFF);
    moe_table(P, L, lds, tid0);
    const int ntiles = tt[slot ? 96 : 88];
    for (int item = blockIdx.x >> 3; item < ntiles * 8; item += (gridDim.x >> 3)) {
        int tid = tid0; asm volatile("" : "+v"(tid));
        const int lane = tid & 63, wid = tid >> 6;
        const int tile = item >> 3, nt = item & 7;
        int li, t; moe_find_slot(tt, slot, tile, li, t);
        const int e = li >> 1;
        const int cnt = P.w.cnt[L * 256 + li], rbase = tt[li] + t * 128, nrows = min(128, cnt - t * 128);
        {
            const bf16_t* arow[4]; const bf16_t* wrow[4];
#pragma unroll
            for (int i = 0; i < 4; ++i) {
                const int r = (tid >> 3) + 32 * i;
                arow[i] = w.hbuf + (size_t)(rbase + (r < nrows ? r : 0)) * 256 + g64_chunk(tid) * 8;
                wrow[i] = w.Wdt + L * WD_SZ + ((size_t)e * 1024 + nt * 128 + r) * 256 + g64_chunk(tid) * 8;
            }
            f32x16 acc[2][2]; acc_zero(acc);
            int my_tok = 0; float my_wt = 0.f;
            if (tid < 128) { const int rr2 = tid < nrows ? tid : 0; my_tok = w.elist[(size_t)li * NT + t * 128 + rr2]; my_wt = w.ewt[(size_t)li * NT + t * 128 + rr2]; }
            gemm_mainloop_g64(acc, arow, wrow, 4, lds, tid);
            if (tid < 128) { ((int*)stat)[tid] = my_tok; stat[128 + tid] = my_wt; }
            acc_to_lds(acc, T, tid);
        }
        {
            const int sub = lane >> 4, l16 = lane & 15, c8 = l16 * 8;
            uint4 hh[8];
#pragma unroll
            for (int rr = 0; rr < 8; ++rr) hh[rr] = *(const uint4*)(w.hb1 + (size_t)((const int*)stat)[wid * 32 + rr * 4 + sub] * 1024 + nt * 128 + c8);
#pragma unroll
            for (int rr = 0; rr < 8; ++rr) {
                const int row = wid * 32 + rr * 4 + sub;
                const int tok = ((const int*)stat)[row]; const float wt = stat[128 + row];
                const float4 x0 = *(const float4*)(T + row * TLD + c8), x1 = *(const float4*)(T + row * TLD + c8 + 4);
                const uint4 h = hh[rr];
                float4 h0, h1;
                h0.x = bflo(h.x) + wt * x0.x; h0.y = bfhi(h.x) + wt * x0.y; h0.z = bflo(h.y) + wt * x0.z; h0.w = bfhi(h.y) + wt * x0.w;
                h1.x = bflo(h.z) + wt * x1.x; h1.y = bfhi(h.z) + wt * x1.y; h1.z = bflo(h.w) + wt * x1.z; h1.w = bfhi(h.w) + wt * x1.w;
                const float sq = grp_sum16(sq8(h0, h1));
                if (row < nrows && !dry) {
                    *(uint4*)(w.hb1 + (size_t)tok * 1024 + nt * 128 + c8) = pack8(h0, h1);
                    if (slot && l16 == 0) w.rssB[(size_t)tok * 8 + nt] = sq;
                }
            }
        }
        __syncthreads();
    }
}

__device__ void phase_ple(const Params& P, int L, char* lds, const bool dry = false) {
    const WS& w = P.w; const nv::Inputs& in = P.in;
    const int tid0 = opaque_tid();
    float* T = (float*)lds; float* stat = (float*)(lds + STAT_OFF);
    int mt, nt;
    for (int it = 0; xcd_item(it, 128, 8, mt, nt); ++it) {
        int tid = tid0; asm volatile("" : "+v"(tid));
        const int lane = tid & 63, wid = tid >> 6;
        const int m0 = mt * 128, n0 = nt * 128;
        {
            const bf16_t* arow[4]; const bf16_t* wrow[4];
#pragma unroll
            for (int i = 0; i < 4; ++i) {
                arow[i] = w.hb1 + (size_t)(m0 + (tid >> 3) + 32 * i) * 1024 + g64_chunk(tid) * 8;
                wrow[i] = w.Wgt + L * WG_SZ + (size_t)(n0 + (tid >> 3) + 32 * i) * 1024 + g64_chunk(tid) * 8;
            }
            f32x16 acc[2][2]; acc_zero(acc);
            float my_rs = 0.f, my_re = 0.f;
            if (tid < 128) { my_rs = rstd8(w.rssB + (size_t)(m0 + tid) * 8, 1.f / 1024.f); my_re = rstd8(w.essq + (size_t)(m0 + tid) * 8, 1.f / 1024.f); }
            gemm_mainloop_g64(acc, arow, wrow, 16, lds, tid);
            if (tid < 128) { stat[tid] = my_rs; stat[128 + tid] = my_re; }
            acc_to_lds(acc, T, tid);
        }
        {
            const int sub = lane >> 4, l16 = lane & 15, c8 = l16 * 8;
            const float4 pg0 = *(const float4*)(in.ple_post_norm_g + L * 1024 + n0 + c8), pg1 = *(const float4*)(in.ple_post_norm_g + L * 1024 + n0 + c8 + 4);
            uint4 hhv[8], erv[8];
#pragma unroll
            for (int rr = 0; rr < 8; ++rr) {
                const size_t off = (size_t)(m0 + wid * 32 + rr * 4 + sub) * 1024 + n0 + c8;
                hhv[rr] = *(const uint4*)(w.hb1 + off); erv[rr] = *(const uint4*)(w.erb + off);
            }
#pragma unroll
            for (int rr = 0; rr < 8; ++rr) {
                const int row = wid * 32 + rr * 4 + sub; const float rs = stat[row], re = stat[128 + row]; const size_t tok = m0 + row;
                const float4 x0 = mul4(*(const float4*)(T + row * TLD + c8), rs), x1 = mul4(*(const float4*)(T + row * TLD + c8 + 4), rs);
                const size_t off = tok * 1024 + n0 + c8;
                const uint4 er = erv[rr], hh = hhv[rr];
                float4 h0, h1;
                h0.x = bflo(hh.x) + sigmoid_(x0.x) * (bflo(er.x) * re * pg0.x); h0.y = bfhi(hh.x) + sigmoid_(x0.y) * (bfhi(er.x) * re * pg0.y);
                h0.z = bflo(hh.y) + sigmoid_(x0.z) * (bflo(er.y) * re * pg0.z); h0.w = bfhi(hh.y) + sigmoid_(x0.w) * (bfhi(er.y) * re * pg0.w);
                h1.x = bflo(hh.z) + sigmoid_(x1.x) * (bflo(er.z) * re * pg1.x); h1.y = bfhi(hh.z) + sigmoid_(x1.y) * (bfhi(er.z) * re * pg1.y);
                h1.z = bflo(hh.w) + sigmoid_(x1.z) * (bflo(er.w) * re * pg1.z); h1.w = bfhi(hh.w) + sigmoid_(x1.w) * (bfhi(er.w) * re * pg1.w);
                if (L == 1) { float4* op = (float4*)(P.h + off); op[0] = h0; op[1] = h1; }
                else {
                    *(uint4*)(w.hb + off) = pack8(h0, h1);
                    const float sq = grp_sum16(sq8(h0, h1));
                    if (l16 == 0) w.rssA[tok * 8 + nt] = sq;
                }
            }
        }
        __syncthreads();
    }
}

}
namespace fx {
#define XB_TMO      128
#define XB_XCNT(j)  (256  + 64 * (j))
#define XB_XSUB(j)  (1280 + 64 * (j))
#define XB_XGEN(j)  (2304 + 64 * (j))
#define XB_TOP      3328
#define XB_TOPGEN   3392
#define XCD_BAR_WORDS 3456
#define XB_SPIN_CAP (1u << 18)
#define LAS __attribute__((address_space(3)))
__device__ __forceinline__ unsigned xb_ld(unsigned* p)              { return __hip_atomic_load(p, __ATOMIC_RELAXED, __HIP_MEMORY_SCOPE_AGENT); }
__device__ __forceinline__ unsigned xb_add(unsigned* p, unsigned v) { return __hip_atomic_fetch_add(p, v, __ATOMIC_RELAXED, __HIP_MEMORY_SCOPE_AGENT); }
__device__ __forceinline__ unsigned xb_xcc_id() { return (unsigned)__builtin_amdgcn_s_getreg((3 << 11) | 20) & 0xFu; }
#define XB_SPIN(cond, bar) do { unsigned _sp = 0; while (cond) { __builtin_amdgcn_s_sleep(1); \
    if ((++_sp & 255u) == 0u) { if (xb_ld(&(bar)[XB_TMO])) break; if (_sp > XB_SPIN_CAP) { atomicAdd(&(bar)[XB_TMO], 1u); break; } } } } while (0)
struct XcdBarrier { unsigned* bar; unsigned x; volatile LAS unsigned* st; };
__device__ __forceinline__ XcdBarrier xcd_barrier_post(unsigned* bar, volatile LAS unsigned* st) {
    XcdBarrier b; b.bar = bar; b.x = xb_xcc_id(); b.st = st;
    if (threadIdx.x == 0) (void)xb_add(&bar[XB_XCNT(b.x)], 1u);
    return b;
}
__device__ __forceinline__ void xcd_barrier_complete(unsigned* bar, unsigned x, unsigned& nloc, unsigned& nx) {
    const unsigned G = gridDim.x * gridDim.y * gridDim.z;
    unsigned sum, cnt, mine, sp = 0u;
    for (;;) {
        sum = 0u; cnt = 0u; mine = 0u;
#pragma unroll
        for (unsigned j = 0; j < 16; ++j) { const unsigned c = xb_ld(&bar[XB_XCNT(j)]); sum += c; cnt += (c > 0u) ? 1u : 0u; mine = (j == x) ? c : mine; }
        if (sum == G) break;
        __builtin_amdgcn_s_sleep(1);
        if ((++sp & 255u) == 0u) { if (xb_ld(&bar[XB_TMO])) break; if (sp > XB_SPIN_CAP) { atomicAdd(&bar[XB_TMO], 1u); break; } }
    }
    nloc = mine > 0u ? mine : 1u; nx = cnt > 0u ? cnt : 1u;
}
__device__ __forceinline__ void xcd_barrier(const XcdBarrier& b) {
    asm volatile("s_waitcnt vmcnt(0)" ::: "memory");
    __syncthreads();
    if (threadIdx.x == 0) {
        unsigned* bar = b.bar;
        __builtin_amdgcn_s_waitcnt(0);
        unsigned nloc = b.st[0], nx = b.st[1];
        if (nloc == 0u) { xcd_barrier_complete(bar, b.x, nloc, nx); b.st[0] = nloc; b.st[1] = nx; }
        const unsigned old = xb_add(&bar[XB_XSUB(b.x)], 1u);
        const unsigned gen = old / nloc;
        if (old + 1u == (gen + 1u) * nloc) {
            __builtin_amdgcn_fence(__ATOMIC_RELEASE, "agent");
            asm volatile("s_waitcnt vmcnt(0)" ::: "memory");
            const unsigned og = xb_add(&bar[XB_TOP], 1u);
            const unsigned tg = og / nx;
            if (og + 1u == (tg + 1u) * nx) xb_add(&bar[XB_TOPGEN], 1u);
            else XB_SPIN(xb_ld(&bar[XB_TOPGEN]) == tg, bar);
            __builtin_amdgcn_fence(__ATOMIC_ACQUIRE, "agent");
            xb_add(&bar[XB_XGEN(b.x)], 1u);
            asm volatile("s_waitcnt vmcnt(0)" ::: "memory");
        } else {
            XB_SPIN(xb_ld(&bar[XB_XGEN(b.x)]) == gen, bar);
            __builtin_amdgcn_fence(__ATOMIC_ACQUIRE, "agent");
            asm volatile("s_waitcnt vmcnt(0)" ::: "memory");
        }
    }
    __syncthreads();
}

constexpr int LDS_BYTES = LDS_GEMM_BYTES + 16;
constexpr int N_PHASES = 19;
constexpr int PPL = 9;
__global__ void __launch_bounds__(256, 2) k_run(Params P, int ph_lo, int ph_hi) {
    extern __shared__ __attribute__((aligned(16))) char lds[];
    volatile LAS unsigned* st = (volatile LAS unsigned*)(lds + LDS_GEMM_BYTES);
    if (threadIdx.x == 0) { st[0] = 0u; st[1] = 0u; }
    __syncthreads();
    XcdBarrier xb = xcd_barrier_post(P.w.bar, st);
#ifdef EXTRA_BARRIERS
    for (int i = 0; i < EXTRA_BARRIERS; ++i) xcd_barrier(xb);
#endif
    for (int ph = ph_lo; ph < ph_hi; ++ph) {
        if (ph > ph_lo) xcd_barrier(xb);
        int reps = 1;
#ifdef REP_PHASE
        if (ph == 0 ? (REP_PHASE == 0) : (((ph - 1) % PPL) == REP_PHASE - 1)) reps = 2;
        asm volatile("" : "+s"(reps));
#endif
        for (int rep = 0; rep < reps; ++rep) {
            const bool dry = rep + 1 < reps;
            if (rep > 0) xcd_barrier(xb);
            if (ph == 0) phase_prep(P, lds);
            else {
                const int L = (ph - 1) / PPL, s = (ph - 1) % PPL;
                switch (s) {
                    case 0: phase_zgemm(P, L, lds); break;
                    case 1: phase_mix(P, L, lds, rep, dry); break;
                    case 2: phase_attn(P, L, lds); break;
                    case 3: phase_oproj(P, L, lds, dry); break;
                    case 4: phase_router(P, L, lds, dry); break;
                    case 5: phase_moe_up(P, L, lds, dry); break;
                    case 6: phase_moe_down(P, L, lds, 0, dry); break;
                    case 7: phase_moe_down(P, L, lds, 1, dry); break;
                    case 8: phase_ple(P, L, lds, dry); break;
                }
            }
        }
    }
}
}
#ifndef MK_N_LAUNCHES
#define MK_N_LAUNCHES 1
#endif
extern "C" void kernel_launch(void* const* d_in, const int* in_sizes, int n_in, void* d_out, int out_size, void* d_ws, size_t ws_size,
                              hipStream_t stream) {
    nv::Inputs in{};
    in.x = (const float*)d_in[0]; in.p = (const float*)d_in[1]; in.positions = (const int*)d_in[2];
    const float** f = &in.mix_norm_g;
    for (int i = 0; i < 32; ++i) f[i] = (const float*)d_in[3 + i];
    size_t used = 0;
    fx::WS w = fx::make_ws((char*)d_ws, used);
    static int grid = 0;
    if (grid == 0) {
        if (n_in != 35 || out_size != fx::NT * 1024 || used > ws_size) { fprintf(stderr, "kernel_launch: unexpected shapes / workspace (need %zu, have %zu)\n", used, ws_size); grid = -1; return; }
        if (hipFuncSetAttribute((const void*)fx::k_run, hipFuncAttributeMaxDynamicSharedMemorySize, fx::LDS_BYTES) != hipSuccess) { fprintf(stderr, "hipFuncSetAttribute failed\n"); grid = -1; return; }
        int dev = 0, cus = 0, per_cu = 0;
        hipGetDevice(&dev); hipDeviceGetAttribute(&cus, hipDeviceAttributeMultiprocessorCount, dev);
        hipOccupancyMaxActiveBlocksPerMultiprocessor(&per_cu, (const void*)fx::k_run, 256, fx::LDS_BYTES);
        if (per_cu > 2) per_cu = 2;
        if (per_cu < 1) { fprintf(stderr, "occupancy query says %d blocks/CU\n", per_cu); grid = -1; return; }
        grid = cus * per_cu;
    }
    if (grid < 0) return;
    fx::Params P{}; P.in = in; P.h = (float*)d_out; P.w = w;
    hipMemsetAsync(w.cnt, 0, 2 * 256 * 4, stream);
    hipMemsetAsync(w.bar, 0, XCD_BAR_WORDS * 4, stream);
    if (MK_N_LAUNCHES == 1) hipLaunchKernelGGL(fx::k_run, dim3(grid), dim3(256), fx::LDS_BYTES, stream, P, 0, fx::N_PHASES);
    else for (int ph = 0; ph < fx::N_PHASES; ++ph) hipLaunchKernelGGL(fx::k_run, dim3(grid), dim3(256), fx::LDS_BYTES, stream, P, ph, ph + 1);
}
```

```cpp
#include <hip/hip_runtime.h>
#include <hip/hip_bf16.h>
#include <stdint.h>
#include <cstdio>
namespace nv {
struct Inputs {
    const float *x, *p; const int* positions;
    const float *mix_norm_g, *w_in, *sgu_ln_g, *sgu_ln_b, *sgu_w, *sgu_b, *conv_w, *conv_b, *conv_ln_g, *conv_ln_b, *conv_pw_w, *conv_pw_b,
        *q_a_norm_g, *w_uq, *kv_a_norm_g, *w_ukv, *q_norm_g, *k_norm_g, *branch_norm_g, *w_o, *ffn_norm_g, *router_group_w, *router_group_b,
        *router_expert_w, *router_expert_b, *moe_w_gate, *moe_w_up, *moe_w_down, *ple_norm_g, *ple_gate_w, *ple_proj_w, *ple_post_norm_g;
};
}
namespace fx {

typedef unsigned short bf16_t;
typedef short bf16x8 __attribute__((ext_vector_type(8)));
typedef float f32x16 __attribute__((ext_vector_type(16)));
typedef float f32x4 __attribute__((ext_vector_type(4)));

constexpr int NT = 16384, SEQ = 2048, DM = 1024, NB = 8;
constexpr int ZN = 1536;
constexpr float EPS = 1e-6f;

typedef __bf16 bf16v2_t __attribute__((ext_vector_type(2)));
typedef float f32v2_t __attribute__((ext_vector_type(2)));
__device__ __forceinline__ unsigned pack2(float lo, float hi) {
    f32v2_t v; v.x = lo; v.y = hi;
    bf16v2_t b = __builtin_convertvector(v, bf16v2_t);
    return __builtin_bit_cast(unsigned, b);
}
__device__ __forceinline__ unsigned f2bf(float f) { return pack2(f, 0.f) & 0xffffu; }
__device__ __forceinline__ float bf2f(unsigned short b) { return __uint_as_float(((unsigned)b) << 16); }
__device__ __forceinline__ float bflo(unsigned u) { return __uint_as_float(u << 16); }
__device__ __forceinline__ float bfhi(unsigned u) { return __uint_as_float(u & 0xffff0000u); }
__device__ __forceinline__ float sigmoid_(float x) { return __builtin_amdgcn_rcpf(1.f + __builtin_amdgcn_exp2f(-1.4426950408889634f * x)); }
__device__ __forceinline__ float rsq_(float x) { return __builtin_amdgcn_rsqf(x); }
__device__ __forceinline__ float gelu_tanh_(float x) {
    float u = 0.7978845608028654f * (x + 0.044715f * x * x * x);
    return x * sigmoid_(2.f * u);
}
__device__ __forceinline__ int opaque_tid() { int t = threadIdx.x; asm volatile("" : "+v"(t)); return t; }
template <int CTRL> __device__ __forceinline__ float dpp_mov(float v) {
    return __builtin_bit_cast(float, __builtin_amdgcn_update_dpp(0, __builtin_bit_cast(int, v), CTRL, 0xf, 0xf, false));
}
__device__ __forceinline__ void swap16(float& a, float& b) { asm volatile("s_nop 1\n\tv_permlane16_swap_b32 %0, %1" : "+v"(a), "+v"(b)); }
__device__ __forceinline__ void swap32(float& a, float& b) { asm volatile("s_nop 1\n\tv_permlane32_swap_b32 %0, %1" : "+v"(a), "+v"(b)); }
__device__ __forceinline__ float swap16_sum(float v) { float a = v, b = v; swap16(a, b); return a + b; }
__device__ __forceinline__ float swap32_sum(float v) { float a = v, b = v; swap32(a, b); return a + b; }
__device__ __forceinline__ float swap32_max(float v) { float a = v, b = v; swap32(a, b); return fmaxf(a, b); }
__device__ __forceinline__ float grp_sum16(float v) { v += dpp_mov<0xB1>(v); v += dpp_mov<0x4E>(v); v += dpp_mov<0x124>(v); v += dpp_mov<0x128>(v); return v; }
__device__ __forceinline__ float grp_sum32(float v) { return swap16_sum(grp_sum16(v)); }
__device__ __forceinline__ float wave_sum64(float v) { return swap32_sum(grp_sum32(v)); }
__device__ __forceinline__ float grp_sum4(float v) { v += dpp_mov<0xB1>(v); v += dpp_mov<0x4E>(v); return v; }
__device__ __forceinline__ float grp_sum8(float v) { v = grp_sum4(v); v += dpp_mov<0x141>(v); return v; }
__device__ __forceinline__ float quad_x2(float v) { return dpp_mov<0x4E>(v); }
__device__ __forceinline__ float xor8(float v) { return dpp_mov<0x128>(v); }
__device__ __forceinline__ float xor32(float v) { return swap32_sum(v); }

struct WS {
    bf16_t *W1t, *Wuqt, *Wukvt, *Wpwt, *Wot, *Wrt, *Wgut, *Wdt, *Wgt, *Wpt, *Wsm;
    bf16_t *hb;
    bf16_t *hb1;
    bf16_t *ub;
    bf16_t *vT;
    bf16_t *ygb;
    bf16_t *cqb;
    bf16_t *ckvb;
    bf16_t *kpeb;
    bf16_t *Qb;
    bf16_t *Knb;
    bf16_t *VTb;
    bf16_t *yb;
    float  *ssq;
    float  *rssA;
    float  *rssB;
    float  *cqss;
    float  *cs;
    bf16_t *erb;
    float  *essq;
    bf16_t *hbuf;
    int    *cnt;
    int    *elist;
    float  *ewt;
    unsigned *bar;
};
constexpr size_t W1_SZ = (size_t)ZN * 1024, WUQ_SZ = 768 * 256, WUKV_SZ = 1024 * 128, WPW_SZ = 256 * 256, WO_SZ = 1024 * 1024, WR_SZ = 128 * 1024,
                 WGU_SZ = (size_t)32 * 512 * 1024, WD_SZ = (size_t)32 * 1024 * 256, WG_SZ = 1024 * 1024, WP_SZ = 1024 * 256, WSM_SZ = 4 * 128 * 128;

struct Params {
    nv::Inputs in;
    float* h;
    WS w;
};

static WS make_ws(char* base, size_t& used) {
    WS w{}; size_t o = 0;
    auto take = [&](size_t bytes) { char* p = base + o; o += (bytes + 255) & ~(size_t)255; return p; };
    w.W1t = (bf16_t*)take(2 * W1_SZ * 2);   w.Wuqt = (bf16_t*)take(2 * WUQ_SZ * 2); w.Wukvt = (bf16_t*)take(2 * WUKV_SZ * 2);
    w.Wpwt = (bf16_t*)take(2 * WPW_SZ * 2); w.Wot = (bf16_t*)take(2 * WO_SZ * 2);   w.Wrt = (bf16_t*)take(2 * WR_SZ * 2);
    w.Wgut = (bf16_t*)take(2 * WGU_SZ * 2); w.Wdt = (bf16_t*)take(2 * WD_SZ * 2);   w.Wgt = (bf16_t*)take(2 * WG_SZ * 2);
    w.Wpt = (bf16_t*)take(2 * WP_SZ * 2);   w.Wsm = (bf16_t*)take(2 * WSM_SZ * 2);
    w.hb = (bf16_t*)take((size_t)NT * 1024 * 2); w.hb1 = (bf16_t*)take((size_t)NT * 1024 * 2);
    w.ssq = (float*)take((size_t)NT * 16 * 4); w.cs = (float*)take((size_t)NT * 32 * 4);
    w.rssA = (float*)take((size_t)NT * 8 * 4); w.rssB = (float*)take((size_t)NT * 8 * 4); w.cqss = (float*)take((size_t)NT * 4 * 4);
    w.essq = (float*)take((size_t)NT * 8 * 4);
    w.cnt = (int*)take(2 * 256 * 4);
    w.elist = (int*)take((size_t)64 * NT * 4); w.ewt = (float*)take((size_t)64 * NT * 4);
    w.bar = (unsigned*)take(4096 * 4);
    const size_t region = o;
    w.ub = (bf16_t*)take((size_t)NT * 256 * 2); w.vT = (bf16_t*)take((size_t)NT * 256 * 2); w.ygb = (bf16_t*)take((size_t)NT * 256 * 2);
    w.cqb = (bf16_t*)take((size_t)NT * 256 * 2); w.ckvb = (bf16_t*)take((size_t)NT * 128 * 2); w.kpeb = (bf16_t*)take((size_t)NT * 32 * 2);
    w.Qb = (bf16_t*)take((size_t)NT * 768 * 2); w.Knb = (bf16_t*)take((size_t)NT * 512 * 2); w.VTb = (bf16_t*)take((size_t)NT * 512 * 2);
    w.yb = (bf16_t*)take((size_t)NT * 1024 * 2);
    const size_t region_end = o;
    o = region;
    w.hbuf = (bf16_t*)take((size_t)(2 * NT + 128) * 256 * 2);
    w.erb = (bf16_t*)take((size_t)NT * 1024 * 2);
    if (o > region_end) { fprintf(stderr, "make_ws: overlay exceeds mixer region\n"); }
    o = region_end;
    used = o;
    return w;
}

__device__ const double ROPE_INV[16] = {1.0, 0.5623413251903491, 0.31622776601683794, 0.1778279410038923, 0.1, 0.05623413251903491, 0.03162277660168379, 0.01778279410038923, 0.01, 0.005623413251903491, 0.0031622776601683794, 0.0017782794100389228, 0.001, 0.0005623413251903491, 0.00031622776601683794, 0.00017782794100389227};
__device__ __forceinline__ void rope_cs(int pos, int j, float& c, float& s) {
    const double ang = (double)pos * ROPE_INV[j];
    const double n = rint(ang * 0.15915494309189535);
    double r = fma(-n, 6.283185307179586, ang); r = fma(-n, 2.4492935982947064e-16, r);
    const double r2 = r * r;
    double sc = 1.0, ss = 1.0;
    double tc = 1.0, ts = 1.0;
#pragma unroll
    for (int k = 1; k <= 14; ++k) {
        tc *= -r2 / (double)((2 * k - 1) * (2 * k)); sc += tc;
        ts *= -r2 / (double)((2 * k) * (2 * k + 1)); ss += ts;
    }
    c = (float)sc; s = (float)(ss * r);
}

enum { MAP_ID = 0, MAP_W1 = 1, MAP_UQ = 2, MAP_UKV = 3, MAP_GATE = 4, MAP_UP = 5 };
template <int MAP> __device__ __forceinline__ int dstrow(int c) {
    if (MAP == MAP_W1) {
        if (c < 512) return c;
        if (c < 768) return 512 + 2 * (c - 512);
        if (c < 1024) return 513 + 2 * (c - 768);
        return c;
    } else if (MAP == MAP_UQ) {
        const int h = c / 96, d = c - h * 96; return d < 64 ? h * 64 + d : 512 + h * 32 + d - 64;
    } else if (MAP == MAP_UKV) {
        const int h = c >> 7, d = c & 127; return d < 64 ? h * 64 + d : 512 + h * 64 + d - 64;
    } else if (MAP == MAP_GATE) return 2 * c;
    else if (MAP == MAP_UP) return 2 * c + 1;
    return c;
}
#define PREP_LOAD(V0, V1, V2, V3, SRC, K0, C0) do { \
    const int kk_ = tid >> 4, c4_ = (tid & 15) * 4; \
    const float* p_ = (C0) + c4_ < Nsrc ? (SRC) + (size_t)((K0) + kk_) * ld + (C0) + c4_ : (SRC) + (size_t)((K0) + kk_) * ld; \
    V0 = *(const float4*)p_; V1 = *(const float4*)(p_ + (size_t)16 * ld); V2 = *(const float4*)(p_ + (size_t)32 * ld); V3 = *(const float4*)(p_ + (size_t)48 * ld); } while (0)
__device__ __forceinline__ void prep_put(float* tile, int kk, int c4, const float4& v, float sc) {
    float* t = tile + kk * 65 + c4; t[0] = v.x * sc; t[1] = v.y * sc; t[2] = v.z * sc; t[3] = v.w * sc;
}
template <int MAP>
__device__ void prep_job(const float* src, int ld, int Nsrc, size_t src_stride, const float* scale, bf16_t* dst, size_t dst_stride, int K, int nbatch, float* tiles, int& rot, const int tid, const int bi, const int G) {
    const int tn = (Nsrc + 63) / 64, tk = K / 64, per = tn * tk, total = per * nbatch;
    int t = (bi - rot + G) % G, buf = 0;
    float4 a0 = make_float4(0.f, 0.f, 0.f, 0.f), a1 = a0, a2 = a0, a3 = a0, b0 = a0, b1 = a0, b2 = a0, b3 = a0;
    if (t < total) { const int e = t / per, tt = t % per; PREP_LOAD(a0, a1, a2, a3, src + (size_t)e * src_stride, (tt / tn) * 64, (tt % tn) * 64); }
    for (; t < total; t += G) {
        const int e = t / per, tt = t % per, k0 = (tt / tn) * 64, c0 = (tt % tn) * 64;
        const int t2 = t + G;
        if (t2 < total) { const int e2 = t2 / per, tt2 = t2 % per; PREP_LOAD(b0, b1, b2, b3, src + (size_t)e2 * src_stride, (tt2 / tn) * 64, (tt2 % tn) * 64); }
        float* tile = tiles + buf * (64 * 65);
        {
            const int kk = tid >> 4, c4 = (tid & 15) * 4;
            const float s0 = scale ? scale[k0 + kk] : 1.f, s1 = scale ? scale[k0 + kk + 16] : 1.f, s2 = scale ? scale[k0 + kk + 32] : 1.f, s3 = scale ? scale[k0 + kk + 48] : 1.f;
            prep_put(tile, kk, c4, a0, s0); prep_put(tile, kk + 16, c4, a1, s1); prep_put(tile, kk + 32, c4, a2, s2); prep_put(tile, kk + 48, c4, a3, s3);
        }
        __syncthreads();
        bf16_t* d = dst + (size_t)e * dst_stride;
#pragma unroll
        for (int i = 0; i < 2; ++i) {
            const int idx = tid + 256 * i, c = idx >> 3, kc = idx & 7;
            if (c0 + c < Nsrc) {
                const float* q = tile + (kc * 8) * 65 + c;
                uint4 pk;
                pk.x = pack2(q[0], q[65]); pk.y = pack2(q[130], q[195]); pk.z = pack2(q[260], q[325]); pk.w = pack2(q[390], q[455]);
                *(uint4*)(d + (size_t)dstrow<MAP>(c0 + c) * K + k0 + kc * 8) = pk;
            }
        }
        a0 = b0; a1 = b1; a2 = b2; a3 = b3; buf ^= 1;
    }
    __syncthreads();
    rot = (rot + total) % G;
}

__device__ void phase_prep(const Params& P, char* lds) {
    float* tile = (float*)lds;
    const nv::Inputs& in = P.in; const WS& w = P.w;
    const int G = gridDim.x, bid = blockIdx.x, tid = opaque_tid();
    int rot = 0;
    for (int L = 0; L < 2; ++L) {
        if (L == 0) {
        prep_job<MAP_GATE>(in.moe_w_gate + (size_t)L * 32 * 1024 * 256, 256, 256, (size_t)1024 * 256, in.ffn_norm_g + L * 1024, w.Wgut + L * WGU_SZ, (size_t)512 * 1024, 1024, 32, tile, rot, tid, bid, G);
        prep_job<MAP_UP>(in.moe_w_up + (size_t)L * 32 * 1024 * 256, 256, 256, (size_t)1024 * 256, in.ffn_norm_g + L * 1024, w.Wgut + L * WGU_SZ, (size_t)512 * 1024, 1024, 32, tile, rot, tid, bid, G);
        prep_job<MAP_ID>(in.moe_w_down + (size_t)L * 32 * 256 * 1024, 1024, 1024, (size_t)256 * 1024, nullptr, w.Wdt + L * WD_SZ, (size_t)1024 * 256, 256, 32, tile, rot, tid, bid, G);
        }
        prep_job<MAP_W1>(in.w_in + (size_t)L * 1024 * 1440, 1440, 1440, 0, in.mix_norm_g + L * 1024, w.W1t + L * W1_SZ, 0, 1024, 1, tile, rot, tid, bid, G);
        prep_job<MAP_UQ>(in.w_uq + (size_t)L * 256 * 768, 768, 768, 0, in.q_a_norm_g + L * 256, w.Wuqt + L * WUQ_SZ, 0, 256, 1, tile, rot, tid, bid, G);
        prep_job<MAP_UKV>(in.w_ukv + (size_t)L * 128 * 1024, 1024, 1024, 0, in.kv_a_norm_g + L * 128, w.Wukvt + L * WUKV_SZ, 0, 128, 1, tile, rot, tid, bid, G);
        prep_job<MAP_ID>(in.conv_pw_w + (size_t)L * 256 * 256, 256, 256, 0, nullptr, w.Wpwt + L * WPW_SZ, 0, 256, 1, tile, rot, tid, bid, G);
        prep_job<MAP_ID>(in.w_o + (size_t)L * 1024 * 1024, 1024, 1024, 0, in.branch_norm_g + L * 1024, w.Wot + L * WO_SZ, 0, 1024, 1, tile, rot, tid, bid, G);
        prep_job<MAP_ID>(in.ple_gate_w + (size_t)L * 1024 * 1024, 1024, 1024, 0, in.ple_norm_g + L * 1024, w.Wgt + L * WG_SZ, 0, 1024, 1, tile, rot, tid, bid, G);
        prep_job<MAP_ID>(in.ple_proj_w + (size_t)L * 256 * 1024, 1024, 1024, 0, nullptr, w.Wpt + L * WP_SZ, 0, 256, 1, tile, rot, tid, bid, G);
        for (int i = bid * 256 + tid; i < 96 * 1024 / 8; i += G * 256) *(uint4*)(w.W1t + L * W1_SZ + (size_t)1440 * 1024 + (size_t)i * 8) = make_uint4(0u, 0u, 0u, 0u);
        for (int i = bid * 256 + tid; i < 128 * 1024; i += G * 256) {
            int n = i >> 10, k = i & 1023; float v = 0.f;
            if (n < 4) v = in.router_group_w[(size_t)L * 1024 * 4 + k * 4 + n];
            else if (n < 36) v = in.router_expert_w[(size_t)L * 1024 * 32 + k * 32 + (n - 4)];
            v *= in.ffn_norm_g[L * 1024 + k];
            w.Wrt[L * WR_SZ + i] = (bf16_t)f2bf(v);
        }
        for (int i = bid * 256 + tid; i < 4 * 128 * 128; i += G * 256) {
            int jj = i & 127, ii = (i >> 7) & 127;
            float v = (jj <= ii) ? in.sgu_w[(size_t)L * WSM_SZ + i] : 0.f;
            w.Wsm[L * WSM_SZ + i] = (bf16_t)f2bf(v);
        }
    }
    for (int i = bid * 256 + tid; i < NT * 16; i += G * 256) {
        int t = i >> 4, j = i & 15;
        float c, sn; rope_cs(in.positions[t], j, c, sn);
        w.cs[t * 32 + j] = c; w.cs[t * 32 + 16 + j] = sn;
    }
    for (int row = bid * 4 + (tid >> 6); row < NT; row += G * 4) {
        const int lane = tid & 63;
        float ss = 0.f;
#pragma unroll
        for (int j = 0; j < 4; ++j) {
            const size_t i = (size_t)row * 256 + j * 64 + lane;
            const float4 v = ((const float4*)in.x)[i];
            uint2 pk; pk.x = pack2(v.x, v.y); pk.y = pack2(v.z, v.w);
            ((uint2*)w.hb)[i] = pk;
            ss += v.x * v.x + v.y * v.y + v.z * v.z + v.w * v.w;
        }
        ss = wave_sum64(ss);
        if (lane < 8) w.rssA[(size_t)row * 8 + lane] = lane == 0 ? ss : 0.f;
    }
}

__device__ void prep_moe_late(const Params& P, int part, char* lds, const int tid, const int bi, const int nb) {
    float* tile = (float*)lds;
    const nv::Inputs& in = P.in; const WS& w = P.w;
    int rot = 0; const int L = 1;
    const float* up = in.moe_w_up + (size_t)L * 32 * 1024 * 256;
    if (part == 0) {
        prep_job<MAP_GATE>(in.moe_w_gate + (size_t)L * 32 * 1024 * 256, 256, 256, (size_t)1024 * 256, in.ffn_norm_g + L * 1024, w.Wgut + L * WGU_SZ, (size_t)512 * 1024, 1024, 32, tile, rot, tid, bi, nb);
        prep_job<MAP_UP>(up, 256, 256, (size_t)1024 * 256, in.ffn_norm_g + L * 1024, w.Wgut + L * WGU_SZ, (size_t)512 * 1024, 1024, 16, tile, rot, tid, bi, nb);
    } else {
        prep_job<MAP_UP>(up + (size_t)16 * 1024 * 256, 256, 256, (size_t)1024 * 256, in.ffn_norm_g + L * 1024, w.Wgut + L * WGU_SZ + (size_t)16 * 512 * 1024, (size_t)512 * 1024, 1024, 16, tile, rot, tid, bi, nb);
        prep_job<MAP_ID>(in.moe_w_down + (size_t)L * 32 * 256 * 1024, 1024, 1024, (size_t)256 * 1024, nullptr, w.Wdt + L * WD_SZ, (size_t)1024 * 256, 256, 32, tile, rot, tid, bi, nb);
    }
    __syncthreads();
}

__device__ __forceinline__ int lds_off(int row, int chunk) { return row * 128 + ((chunk ^ ((row >> 1) & 7)) << 4); }

template <typename AT> struct ARaw;
template <> struct ARaw<bf16_t> { uint4 v[4]; };
template <> struct ARaw<float> { float4 v[4][2]; };

__device__ __forceinline__ void a_load(ARaw<bf16_t>& r, const bf16_t* const (&rowp)[4], int koff) {
#pragma unroll
    for (int i = 0; i < 4; ++i) r.v[i] = *(const uint4*)(rowp[i] + koff);
}
__device__ __forceinline__ void a_load(ARaw<float>& r, const float* const (&rowp)[4], int koff) {
#pragma unroll
    for (int i = 0; i < 4; ++i) { r.v[i][0] = *(const float4*)(rowp[i] + koff); r.v[i][1] = *(const float4*)(rowp[i] + koff + 4); }
}
template <bool SUMSQ> __device__ __forceinline__ uint4 a_cvt(const uint4& v, float& ss) {
    if (SUMSQ) {
        float a;
        a = bflo(v.x); ss = fmaf(a, a, ss); a = bfhi(v.x); ss = fmaf(a, a, ss);
        a = bflo(v.y); ss = fmaf(a, a, ss); a = bfhi(v.y); ss = fmaf(a, a, ss);
        a = bflo(v.z); ss = fmaf(a, a, ss); a = bfhi(v.z); ss = fmaf(a, a, ss);
        a = bflo(v.w); ss = fmaf(a, a, ss); a = bfhi(v.w); ss = fmaf(a, a, ss);
    }
    return v;
}
template <bool SUMSQ> __device__ __forceinline__ void a_store(const ARaw<bf16_t>& r, char* ldsA, int tid, float (&ss)[4]) {
#pragma unroll
    for (int i = 0; i < 4; ++i) { uint4 v = a_cvt<SUMSQ>(r.v[i], ss[i]); *(uint4*)(ldsA + lds_off((tid >> 3) + 32 * i, tid & 7)) = v; }
}
template <bool SUMSQ> __device__ __forceinline__ void a_store(const ARaw<float>& r, char* ldsA, int tid, float (&ss)[4]) {
#pragma unroll
    for (int i = 0; i < 4; ++i) {
        const float4 a = r.v[i][0], b = r.v[i][1];
        if (SUMSQ) ss[i] += a.x * a.x + a.y * a.y + a.z * a.z + a.w * a.w + b.x * b.x + b.y * b.y + b.z * b.z + b.w * b.w;
        uint4 v; v.x = pack2(a.x, a.y); v.y = pack2(a.z, a.w); v.z = pack2(b.x, b.y); v.w = pack2(b.z, b.w);
        *(uint4*)(ldsA + lds_off((tid >> 3) + 32 * i, tid & 7)) = v;
    }
}

struct bf16x3_t {};
template <> struct ARaw<bf16x3_t> { uint4 a[4], b[4], c[4]; };
struct Rows3 { const bf16_t* p[2][4]; };
__device__ __forceinline__ void a_load(ARaw<bf16x3_t>& r, const Rows3& rows, int koff) {
#pragma unroll
    for (int i = 0; i < 4; ++i) { r.a[i] = *(const uint4*)(rows.p[0][i] + koff); r.b[i] = *(const uint4*)(rows.p[1][i] + koff); r.c[i] = *(const uint4*)(rows.p[1][i] + koff + 1024); }
}
__device__ __forceinline__ unsigned add3pk(unsigned a, unsigned b, unsigned c, float& ss) {
    const float lo = bflo(a) + bflo(b) + bflo(c), hi = bfhi(a) + bfhi(b) + bfhi(c);
    ss = fmaf(lo, lo, ss); ss = fmaf(hi, hi, ss);
    return pack2(lo, hi);
}
template <bool SUMSQ> __device__ __forceinline__ void a_store(const ARaw<bf16x3_t>& r, char* ldsA, int tid, float (&ss)[4]) {
#pragma unroll
    for (int i = 0; i < 4; ++i) {
        uint4 v;
        v.x = add3pk(r.a[i].x, r.b[i].x, r.c[i].x, ss[i]); v.y = add3pk(r.a[i].y, r.b[i].y, r.c[i].y, ss[i]);
        v.z = add3pk(r.a[i].z, r.b[i].z, r.c[i].z, ss[i]); v.w = add3pk(r.a[i].w, r.b[i].w, r.c[i].w, ss[i]);
        *(uint4*)(ldsA + lds_off((tid >> 3) + 32 * i, tid & 7)) = v;
    }
}

template <typename AT, bool SUMSQ, int SUNROLL = 4, typename AROWS>
__device__ __forceinline__ void gemm_mainloop(f32x16 (&acc)[2][2], const AROWS& arow, const bf16_t* const (&wrow)[4], int nkt, char* lds, float (&ss)[4], const int tid) {
    const int lane = tid & 63, wid = tid >> 6, wr = wid >> 1, wc = wid & 1;
    ARaw<AT> ra; ARaw<bf16_t> rb; float dummy[4] = {0.f, 0.f, 0.f, 0.f};
    a_load(ra, arow, 0); a_load(rb, wrow, 0);
    a_store<SUMSQ>(ra, lds, tid, ss); a_store<false>(rb, lds + 16384, tid, dummy);
    __syncthreads();
    const int fr = lane & 31, fh = lane >> 5;
#pragma unroll 1
    for (int kt = 0; kt < nkt; ++kt) {
        char* cur = lds + (kt & 1) * 32768;
        char* nxt = lds + ((kt + 1) & 1) * 32768;
        const bool more = (kt + 1 < nkt);
        if (more) { a_load(ra, arow, (kt + 1) * 64); a_load(rb, wrow, (kt + 1) * 64); }
#pragma unroll SUNROLL
        for (int s = 0; s < 4; ++s) {
            bf16x8 xa[2], wb[2];
#pragma unroll
            for (int i = 0; i < 2; ++i) xa[i] = *(const bf16x8*)(cur + lds_off(wr * 64 + i * 32 + fr, 2 * s + fh));
#pragma unroll
            for (int j = 0; j < 2; ++j) wb[j] = *(const bf16x8*)(cur + 16384 + lds_off(wc * 64 + j * 32 + fr, 2 * s + fh));
#pragma unroll
            for (int i = 0; i < 2; ++i)
#pragma unroll
                for (int j = 0; j < 2; ++j) acc[i][j] = __builtin_amdgcn_mfma_f32_32x32x16_bf16(wb[j], xa[i], acc[i][j], 0, 0, 0);
        }
        if (more) { a_store<SUMSQ>(ra, nxt, tid, ss); a_store<false>(rb, nxt + 16384, tid, dummy); }
        __syncthreads();
    }
}
constexpr int GST = 16384;
__device__ __forceinline__ int gl_chunk(int tid) { return (tid & 3) ^ ((tid >> 4) & 3); }
__device__ __forceinline__ int gl_off(int row, int chunk) { return row * 64 + ((chunk ^ ((row >> 2) & 3)) << 4); }
typedef __attribute__((address_space(3))) unsigned lds_u32_t;
__device__ __forceinline__ void glds16(const bf16_t* g, char* l) {
    __builtin_amdgcn_global_load_lds((const unsigned*)g, (lds_u32_t*)l, 16, 0, 0);
}
#define RAW_BARRIER() do { asm volatile("s_waitcnt lgkmcnt(0)" ::: "memory"); __builtin_amdgcn_s_barrier(); } while (0)
template <bool SEG = false>
__device__ __forceinline__ void gemm_mainloop_g(f32x16 (&acc)[2][2], const bf16_t* const (&arow)[2], const bf16_t* const (&wrow)[2], const int nkt, char* lds, const int tid,
                                                const int rot = 0, const int kt1 = -1, const float* f1 = nullptr, const int kt2 = -1, const float* f2 = nullptr) {
    const int lane = tid & 63, wid = tid >> 6, wr = wid >> 1, wc = wid & 1, fr = lane & 31, fh = lane >> 5;
    const int wbase = __builtin_amdgcn_readfirstlane(wid) * 1024;
#pragma unroll 1
    for (int p = 0; p < 3; ++p) if (p < nkt) {
        char* st = lds + p * GST + wbase;
        const int ko = SEG ? ((p + rot) & (nkt - 1)) * 32 : p * 32;
        glds16(arow[0] + ko, st); glds16(arow[1] + ko, st + 4096);
        glds16(wrow[0] + ko, st + 8192); glds16(wrow[1] + ko, st + 8192 + 4096);
    }
    const int ra0 = gl_off(wr * 64 + fr, fh), ra1 = gl_off(wr * 64 + 32 + fr, fh);
    const int rb0 = 8192 + gl_off(wc * 64 + fr, fh), rb1 = 8192 + gl_off(wc * 64 + 32 + fr, fh);
#pragma unroll 1
    for (int kt = 0; kt < nkt; ++kt) {
        if (kt + 2 < nkt) asm volatile("s_waitcnt vmcnt(8)" ::: "memory");
        else if (kt + 1 < nkt) asm volatile("s_waitcnt vmcnt(4)" ::: "memory");
        else asm volatile("s_waitcnt vmcnt(0)" ::: "memory");
        RAW_BARRIER();
        if (kt + 3 < nkt) {
            char* st = lds + ((kt + 3) & 3) * GST + wbase;
            const int ko = SEG ? ((kt + 3 + rot) & (nkt - 1)) * 32 : (kt + 3) * 32;
            glds16(arow[0] + ko, st); glds16(arow[1] + ko, st + 4096);
            glds16(wrow[0] + ko, st + 8192); glds16(wrow[1] + ko, st + 8192 + 4096);
        }
        const char* cur = lds + (kt & 3) * GST;
        if (SEG && (kt == kt1 || kt == kt2)) {
            const float* f = kt == kt1 ? f1 : f2;
#pragma unroll
            for (int i = 0; i < 2; ++i) {
                const float v = f[wr * 64 + i * 32 + fr];
#pragma unroll
                for (int j = 0; j < 2; ++j)
#pragma unroll
                    for (int r = 0; r < 16; ++r) acc[i][j][r] *= v;
            }
        }
        bf16x8 xa[2][2], wb[2][2];
#pragma unroll
        for (int s2 = 0; s2 < 2; ++s2) {
            xa[s2][0] = *(const bf16x8*)(cur + (ra0 ^ (s2 << 5))); xa[s2][1] = *(const bf16x8*)(cur + (ra1 ^ (s2 << 5)));
            wb[s2][0] = *(const bf16x8*)(cur + (rb0 ^ (s2 << 5))); wb[s2][1] = *(const bf16x8*)(cur + (rb1 ^ (s2 << 5)));
        }
        __builtin_amdgcn_sched_barrier(0);
#pragma unroll
        for (int s2 = 0; s2 < 2; ++s2) {
            acc[0][0] = __builtin_amdgcn_mfma_f32_32x32x16_bf16(wb[s2][0], xa[s2][0], acc[0][0], 0, 0, 0);
            acc[0][1] = __builtin_amdgcn_mfma_f32_32x32x16_bf16(wb[s2][1], xa[s2][0], acc[0][1], 0, 0, 0);
            acc[1][0] = __builtin_amdgcn_mfma_f32_32x32x16_bf16(wb[s2][0], xa[s2][1], acc[1][0], 0, 0, 0);
            acc[1][1] = __builtin_amdgcn_mfma_f32_32x32x16_bf16(wb[s2][1], xa[s2][1], acc[1][1], 0, 0, 0);
        }
    }
    RAW_BARRIER();
}
__device__ __forceinline__ int g64_chunk(int tid) { return (tid & 7) ^ ((tid >> 4) & 7); }
template <bool SEG = false>
__device__ __forceinline__ void gemm_mainloop_g64(f32x16 (&acc)[2][2], const bf16_t* const (&arow)[4], const bf16_t* const (&wrow)[4], const int nkt, char* lds, const int tid,
                                                  const int rot = 0, const int kt1 = -1, const float* f1 = nullptr, const int kt2 = -1, const float* f2 = nullptr) {
    const int lane = tid & 63, wid = tid >> 6, wr = wid >> 1, wc = wid & 1, fr = lane & 31, fh = lane >> 5;
    const int wbase = __builtin_amdgcn_readfirstlane(wid) * 1024;
    {
        char* st = lds + wbase;
        const int ko0 = SEG ? (rot & (nkt - 1)) * 64 : 0;
#pragma unroll
        for (int i = 0; i < 4; ++i) { glds16(arow[i] + ko0, st + i * 4096); glds16(wrow[i] + ko0, st + 16384 + i * 4096); }
    }
#pragma unroll 1
    for (int kt = 0; kt < nkt; ++kt) {
        asm volatile("s_waitcnt vmcnt(0)" ::: "memory");
        RAW_BARRIER();
        if (kt + 1 < nkt) {
            char* st = lds + ((kt + 1) & 1) * 32768 + wbase;
            const int ko = SEG ? ((kt + 1 + rot) & (nkt - 1)) * 64 : (kt + 1) * 64;
#pragma unroll
            for (int i = 0; i < 4; ++i) { glds16(arow[i] + ko, st + i * 4096); glds16(wrow[i] + ko, st + 16384 + i * 4096); }
        }
        const char* cur = lds + (kt & 1) * 32768;
        if (SEG && (kt == kt1 || kt == kt2)) {
            const float* f = kt == kt1 ? f1 : f2;
#pragma unroll
            for (int i = 0; i < 2; ++i) {
                const float v = f[wr * 64 + i * 32 + fr];
#pragma unroll
                for (int j = 0; j < 2; ++j)
#pragma unroll
                    for (int r = 0; r < 16; ++r) acc[i][j][r] *= v;
            }
        }
#pragma unroll
        for (int s = 0; s < 4; ++s) {
            bf16x8 xa[2], wb[2];
#pragma unroll
            for (int i = 0; i < 2; ++i) xa[i] = *(const bf16x8*)(cur + lds_off(wr * 64 + i * 32 + fr, 2 * s + fh));
#pragma unroll
            for (int j = 0; j < 2; ++j) wb[j] = *(const bf16x8*)(cur + 16384 + lds_off(wc * 64 + j * 32 + fr, 2 * s + fh));
#pragma unroll
            for (int i = 0; i < 2; ++i)
#pragma unroll
                for (int j = 0; j < 2; ++j) acc[i][j] = __builtin_amdgcn_mfma_f32_32x32x16_bf16(wb[j], xa[i], acc[i][j], 0, 0, 0);
        }
    }
    RAW_BARRIER();
}
__device__ __forceinline__ void acc_zero(f32x16 (&acc)[2][2]) {
#pragma unroll
    for (int i = 0; i < 2; ++i)
#pragma unroll
        for (int j = 0; j < 2; ++j)
#pragma unroll
            for (int r = 0; r < 16; ++r) acc[i][j][r] = 0.f;
}
__device__ __forceinline__ void publish_rowstat(float (&ss)[4], float* stat, float invK, bool as_rstd, const int tid) {
#pragma unroll
    for (int i = 0; i < 4; ++i) {
        float v = ss[i];
        v += __shfl_xor(v, 1); v += __shfl_xor(v, 2); v += __shfl_xor(v, 4);
        if ((tid & 7) == 0) stat[(tid >> 3) + 32 * i] = as_rstd ? rsqrtf(v * invK + EPS) : v;
    }
    __syncthreads();
}
__device__ __forceinline__ int nidx(int r, int fh) { return (r & 3) + 8 * (r >> 2) + 4 * fh; }
__device__ __forceinline__ uint4 pack8(const float4& a, const float4& b) { uint4 pk; pk.x = pack2(a.x, a.y); pk.y = pack2(a.z, a.w); pk.z = pack2(b.x, b.y); pk.w = pack2(b.z, b.w); return pk; }
__device__ __forceinline__ float sq8(const float4& a, const float4& b) { return (a.x * a.x + a.y * a.y) + (a.z * a.z + a.w * a.w) + (b.x * b.x + b.y * b.y) + (b.z * b.z + b.w * b.w); }
__device__ __forceinline__ float4 mul4(const float4& a, float s) { return make_float4(a.x * s, a.y * s, a.z * s, a.w * s); }
__device__ __forceinline__ void store4(bf16_t* p, float a, float b, float c, float d) {
    uint2 v; v.x = pack2(a, b); v.y = pack2(c, d); *(uint2*)p = v;
}

__device__ __forceinline__ bool xcd_item(int it, int MT, int NTl, int& mt, int& nt) {
    const int x = blockIdx.x & 7, lb = blockIdx.x >> 3, nlb = gridDim.x >> 3;
    const int li = it * nlb + lb, per = (MT >> 3) * NTl;
    if (li >= per) return false;
    mt = (li / NTl) * 8 + x; nt = li % NTl; return true;
}

constexpr int TLD = 132;
constexpr int STAT_OFF = 128 * TLD * 4;
constexpr int LDS_GEMM_BYTES = STAT_OFF + 2048;
__device__ __forceinline__ void acc_to_lds(const f32x16 (&acc)[2][2], float* T, const int tid) {
    const int lane = tid & 63, wid = tid >> 6, wr = wid >> 1, wc = wid & 1, fr = lane & 31, fh = lane >> 5;
#pragma unroll
    for (int i = 0; i < 2; ++i)
#pragma unroll
        for (int j = 0; j < 2; ++j)
#pragma unroll
            for (int g = 0; g < 4; ++g) {
                float4 v; v.x = acc[i][j][4 * g]; v.y = acc[i][j][4 * g + 1]; v.z = acc[i][j][4 * g + 2]; v.w = acc[i][j][4 * g + 3];
                *(float4*)(T + (wr * 64 + i * 32 + fr) * TLD + wc * 64 + j * 32 + 8 * g + 4 * fh) = v;
            }
    __syncthreads();
}
__device__ __forceinline__ float rstd8(const float* p, float invK) {
    const float4 a = *(const float4*)p, b = *(const float4*)(p + 4);
    return rsq_(((a.x + a.y) + (a.z + a.w) + (b.x + b.y) + (b.z + b.w)) * invK + EPS);
}

}
namespace fx {

__device__ void phase_zgemm(const Params& P, int L, char* lds, const bool same = false) {
    const WS& w = P.w; const nv::Inputs& in = P.in;
    const int tid0 = opaque_tid();
    float* T = (float*)lds; float* stat = (float*)(lds + STAT_OFF);
    const bf16_t* Wt = w.W1t + L * W1_SZ;
    int mt, nt;
    for (int it = 0; xcd_item(it, 128, 12, mt, nt); ++it) {
        int tid = tid0; asm volatile("" : "+v"(tid));
        const int lane = tid & 63, wid = tid >> 6;
        const int m0 = mt * 128, n0 = nt * 128;
        {
            const bf16_t* arow[4]; const bf16_t* wrow[4];
#pragma unroll
            for (int i = 0; i < 4; ++i) {
                arow[i] = w.hb + (size_t)(m0 + (tid >> 3) + 32 * i) * 1024 + g64_chunk(tid) * 8;
                wrow[i] = Wt + (size_t)(n0 + (tid >> 3) + 32 * i) * 1024 + g64_chunk(tid) * 8;
            }
            f32x16 acc[2][2]; acc_zero(acc);
            float my_rs = 0.f;
            if (tid < 128) my_rs = rstd8(w.rssA + (size_t)(m0 + tid) * 8, 1.f / 1024.f);
            gemm_mainloop_g64(acc, arow, wrow, 16, lds, tid);
            if (tid < 128) stat[tid] = my_rs;
            acc_to_lds(acc, T, tid);
        }
        const int sub = lane >> 4, l16 = lane & 15, c8 = l16 * 8;
        if (nt < 2) {
#pragma unroll 8
            for (int rr = 0; rr < 8; ++rr) {
                const int row = wid * 32 + rr * 4 + sub; const float rs = stat[row];
                float4 x0 = *(const float4*)(T + row * TLD + c8), x1 = *(const float4*)(T + row * TLD + c8 + 4);
                x0.x = gelu_tanh_(x0.x * rs); x0.y = gelu_tanh_(x0.y * rs); x0.z = gelu_tanh_(x0.z * rs); x0.w = gelu_tanh_(x0.w * rs);
                x1.x = gelu_tanh_(x1.x * rs); x1.y = gelu_tanh_(x1.y * rs); x1.z = gelu_tanh_(x1.z * rs); x1.w = gelu_tanh_(x1.w * rs);
                *(uint4*)(w.ub + (size_t)(m0 + row) * 256 + nt * 128 + c8) = pack8(x0, x1);
            }
        } else if (nt < 4) {
            const int hd = (nt - 2) * 2 + (l16 >> 3), d0 = (l16 & 7) * 8;
            const float4 g0 = *(const float4*)(in.sgu_ln_g + L * 256 + hd * 64 + d0), g1 = *(const float4*)(in.sgu_ln_g + L * 256 + hd * 64 + d0 + 4);
            const float4 b0 = *(const float4*)(in.sgu_ln_b + L * 256 + hd * 64 + d0), b1 = *(const float4*)(in.sgu_ln_b + L * 256 + hd * 64 + d0 + 4);
#pragma unroll 4
            for (int rr = 0; rr < 8; ++rr) {
                const int row = wid * 32 + rr * 4 + sub; const float rs = stat[row];
                float4 x0 = *(const float4*)(T + row * TLD + c8), x1 = *(const float4*)(T + row * TLD + c8 + 4);
                x0.x = gelu_tanh_(x0.x * rs); x0.y = gelu_tanh_(x0.y * rs); x0.z = gelu_tanh_(x0.z * rs); x0.w = gelu_tanh_(x0.w * rs);
                x1.x = gelu_tanh_(x1.x * rs); x1.y = gelu_tanh_(x1.y * rs); x1.z = gelu_tanh_(x1.z * rs); x1.w = gelu_tanh_(x1.w * rs);
                const float mean = grp_sum8((x0.x + x0.y) + (x0.z + x0.w) + (x1.x + x1.y) + (x1.z + x1.w)) * (1.f / 64.f);
                x0.x -= mean; x0.y -= mean; x0.z -= mean; x0.w -= mean; x1.x -= mean; x1.y -= mean; x1.z -= mean; x1.w -= mean;
                const float rv = rsq_(grp_sum8(sq8(x0, x1)) * (1.f / 64.f) + EPS);
                x0.x = x0.x * rv * g0.x + b0.x; x0.y = x0.y * rv * g0.y + b0.y; x0.z = x0.z * rv * g0.z + b0.z; x0.w = x0.w * rv * g0.w + b0.w;
                x1.x = x1.x * rv * g1.x + b1.x; x1.y = x1.y * rv * g1.y + b1.y; x1.z = x1.z * rv * g1.z + b1.z; x1.w = x1.w * rv * g1.w + b1.w;
                *(float4*)(T + row * TLD + c8) = x0; *(float4*)(T + row * TLD + c8 + 4) = x1;
            }
            __syncthreads();
            {
                const int c = tid & 127, th = tid >> 7, hd2 = (nt - 2) * 2 + (c >> 6), d = c & 63;
                bf16_t* dst = w.vT + ((size_t)(mt * 4 + hd2) * 64 + d) * 128 + th * 64;
#pragma unroll 2
                for (int k8 = 0; k8 < 8; ++k8) {
                    float v[8];
#pragma unroll
                    for (int k = 0; k < 8; ++k) v[k] = T[(th * 64 + k8 * 8 + k) * TLD + c];
                    uint4 pk; pk.x = pack2(v[0], v[1]); pk.y = pack2(v[2], v[3]); pk.z = pack2(v[4], v[5]); pk.w = pack2(v[6], v[7]);
                    *(uint4*)(dst + k8 * 8) = pk;
                }
            }
        } else if (nt < 8) {
#pragma unroll 8
            for (int rr = 0; rr < 8; ++rr) {
                const int row = wid * 32 + rr * 4 + sub; const float rs = stat[row];
                const float4 x0 = *(const float4*)(T + row * TLD + c8), x1 = *(const float4*)(T + row * TLD + c8 + 4);
                store4(w.ygb + (size_t)(m0 + row) * 256 + (nt - 4) * 64 + l16 * 4, x0.x * rs * sigmoid_(x0.y * rs), x0.z * rs * sigmoid_(x0.w * rs),
                       x1.x * rs * sigmoid_(x1.y * rs), x1.z * rs * sigmoid_(x1.w * rs));
            }
        } else if (nt < 11) {
            bf16_t* base; int ld, cb;
            if (nt < 10) { base = w.cqb; ld = 256; cb = (nt - 8) * 128; } else { base = w.ckvb; ld = 128; cb = 0; }
#pragma unroll 8
            for (int rr = 0; rr < 8; ++rr) {
                const int row = wid * 32 + rr * 4 + sub; const float rs = stat[row];
                const float4 x0 = mul4(*(const float4*)(T + row * TLD + c8), rs), x1 = mul4(*(const float4*)(T + row * TLD + c8 + 4), rs);
                *(uint4*)(base + (size_t)(m0 + row) * ld + cb + c8) = pack8(x0, x1);
                const float sq = grp_sum16(sq8(x0, x1));
                if (l16 == 0) w.cqss[(size_t)(m0 + row) * 4 + (nt - 8)] = sq;
            }
        } else {
            const int lq = l16 & 3, dd = lq * 8, jj = (lq & 1) * 8;
            const float4 kg0 = *(const float4*)(in.k_norm_g + L * 96 + 64 + dd), kg1 = *(const float4*)(in.k_norm_g + L * 96 + 64 + dd + 4);
#pragma unroll 1
            for (int hb4 = 0; hb4 < 2; ++hb4) {
                float4 cc0[4], cc1[4], ss0[4], ss1[4];
#pragma unroll
                for (int r4 = 0; r4 < 4; ++r4) {
                    const float* csr = w.cs + (size_t)(m0 + wid * 32 + (hb4 * 4 + r4) * 4 + sub) * 32 + jj;
                    cc0[r4] = *(const float4*)csr; cc1[r4] = *(const float4*)(csr + 4); ss0[r4] = *(const float4*)(csr + 16); ss1[r4] = *(const float4*)(csr + 20);
                }
#pragma unroll
                for (int r4 = 0; r4 < 4; ++r4) {
                    const int row = wid * 32 + (hb4 * 4 + r4) * 4 + sub; const float rs = stat[row]; const int tok = m0 + row;
                    float4 x0 = mul4(*(const float4*)(T + row * TLD + dd), rs), x1 = mul4(*(const float4*)(T + row * TLD + dd + 4), rs);
                    const float rn = rsq_(grp_sum4(sq8(x0, x1)) * (1.f / 32.f) + EPS);
                    x0.x *= rn * kg0.x; x0.y *= rn * kg0.y; x0.z *= rn * kg0.z; x0.w *= rn * kg0.w;
                    x1.x *= rn * kg1.x; x1.y *= rn * kg1.y; x1.z *= rn * kg1.z; x1.w *= rn * kg1.w;
                    const float4 o0 = make_float4(quad_x2(x0.x), quad_x2(x0.y), quad_x2(x0.z), quad_x2(x0.w)), o1 = make_float4(quad_x2(x1.x), quad_x2(x1.y), quad_x2(x1.z), quad_x2(x1.w));
                    const float4 c0 = cc0[r4], c1 = cc1[r4], s0 = ss0[r4], s1 = ss1[r4];
                    const float sg = (lq & 2) ? 1.f : -1.f;
                    float4 r0, r1;
                    r0.x = x0.x * c0.x + sg * o0.x * s0.x; r0.y = x0.y * c0.y + sg * o0.y * s0.y; r0.z = x0.z * c0.z + sg * o0.z * s0.z; r0.w = x0.w * c0.w + sg * o0.w * s0.w;
                    r1.x = x1.x * c1.x + sg * o1.x * s1.x; r1.y = x1.y * c1.y + sg * o1.y * s1.y; r1.z = x1.z * c1.z + sg * o1.z * s1.z; r1.w = x1.w * c1.w + sg * o1.w * s1.w;
                    if (l16 < 4) *(uint4*)(w.kpeb + (size_t)tok * 32 + dd) = pack8(r0, r1);
                }
            }
        }
        __syncthreads();
    }
}

}
namespace fx {

constexpr float QSCALE = 0.10206207261596575f * 1.4426950408889634f;

__device__ void qkv_item(const Params& P, int L, const bool isq, const int mt, const int nt, char* lds, const int tid_in) {
    int tid = tid_in; asm volatile("" : "+v"(tid));
    const WS& w = P.w; const nv::Inputs& in = P.in;
    const int lane = tid & 63, wid = tid >> 6;
    float* T = (float*)lds; float* stat = (float*)(lds + STAT_OFF);
    const int m0 = mt * 128, n0 = nt * 128;
    const int K = isq ? 256 : 128;
    {
        const bf16_t* A = isq ? w.cqb : w.ckvb;
        const bf16_t* Wt = isq ? (w.Wuqt + L * WUQ_SZ) : (w.Wukvt + L * WUKV_SZ);
        const bf16_t* arow[4]; const bf16_t* wrow[4];
#pragma unroll
        for (int i = 0; i < 4; ++i) {
            arow[i] = A + (size_t)(m0 + (tid >> 3) + 32 * i) * K + g64_chunk(tid) * 8;
            wrow[i] = Wt + (size_t)(n0 + (tid >> 3) + 32 * i) * K + g64_chunk(tid) * 8;
        }
        f32x16 acc[2][2]; acc_zero(acc);
        float my_rs = 0.f;
        if (tid < 128) {
            const float4 c = *(const float4*)(w.cqss + (size_t)(m0 + tid) * 4);
            my_rs = isq ? rsq_((c.x + c.y) * (1.f / 256.f) + EPS) : rsq_(c.z * (1.f / 128.f) + EPS);
        }
        gemm_mainloop_g64(acc, arow, wrow, K / 64, lds, tid);
        if (tid < 128) stat[tid] = my_rs;
        acc_to_lds(acc, T, tid);
    }
    const int b = m0 >> 11, s0 = m0 & 2047;
    const int sub = lane >> 4, l16 = lane & 15, c8 = l16 * 8;
    if (isq && nt < 4) {
        const int hd = nt * 2 + (l16 >> 3), d = (l16 & 7) * 8;
        const float4 g0 = mul4(*(const float4*)(in.q_norm_g + L * 96 + d), QSCALE), g1 = mul4(*(const float4*)(in.q_norm_g + L * 96 + d + 4), QSCALE);
        bf16_t* dst = w.Qb + ((size_t)(b * 8 + hd) * 2048 + s0) * 96 + d;
#pragma unroll 8
        for (int rr = 0; rr < 8; ++rr) {
            const int row = wid * 32 + rr * 4 + sub; const float rs = stat[row];
            float4 x0 = mul4(*(const float4*)(T + row * TLD + c8), rs), x1 = mul4(*(const float4*)(T + row * TLD + c8 + 4), rs);
            const float rn = rsq_(grp_sum8(sq8(x0, x1)) * (1.f / 64.f) + EPS);
            x0.x *= rn * g0.x; x0.y *= rn * g0.y; x0.z *= rn * g0.z; x0.w *= rn * g0.w; x1.x *= rn * g1.x; x1.y *= rn * g1.y; x1.z *= rn * g1.z; x1.w *= rn * g1.w;
            *(uint4*)(dst + (size_t)row * 96) = pack8(x0, x1);
        }
    } else if (isq) {
        const int hd = (nt - 4) * 4 + (l16 >> 2), lq = l16 & 3, dd = lq * 8, jj = (lq & 1) * 8;
        const float4 g0 = *(const float4*)(in.q_norm_g + L * 96 + 64 + dd), g1 = *(const float4*)(in.q_norm_g + L * 96 + 64 + dd + 4);
        bf16_t* dst = w.Qb + ((size_t)(b * 8 + hd) * 2048 + s0) * 96 + 64 + dd;
        const float sg = (lq & 2) ? QSCALE : -QSCALE;
#pragma unroll 1
        for (int hb4 = 0; hb4 < 2; ++hb4) {
            float4 cc0[4], cc1[4], ss0[4], ss1[4];
#pragma unroll
            for (int r4 = 0; r4 < 4; ++r4) {
                const float* csr = w.cs + (size_t)(m0 + wid * 32 + (hb4 * 4 + r4) * 4 + sub) * 32 + jj;
                cc0[r4] = *(const float4*)csr; cc1[r4] = *(const float4*)(csr + 4); ss0[r4] = *(const float4*)(csr + 16); ss1[r4] = *(const float4*)(csr + 20);
            }
#pragma unroll
            for (int r4 = 0; r4 < 4; ++r4) {
                const int row = wid * 32 + (hb4 * 4 + r4) * 4 + sub; const float rs = stat[row];
                float4 x0 = mul4(*(const float4*)(T + row * TLD + c8), rs), x1 = mul4(*(const float4*)(T + row * TLD + c8 + 4), rs);
                const float rn = rsq_(grp_sum4(sq8(x0, x1)) * (1.f / 32.f) + EPS);
                x0.x *= rn * g0.x; x0.y *= rn * g0.y; x0.z *= rn * g0.z; x0.w *= rn * g0.w; x1.x *= rn * g1.x; x1.y *= rn * g1.y; x1.z *= rn * g1.z; x1.w *= rn * g1.w;
                const float4 o0 = make_float4(quad_x2(x0.x), quad_x2(x0.y), quad_x2(x0.z), quad_x2(x0.w)), o1 = make_float4(quad_x2(x1.x), quad_x2(x1.y), quad_x2(x1.z), quad_x2(x1.w));
                const float4 c0 = mul4(cc0[r4], QSCALE), c1 = mul4(cc1[r4], QSCALE), s0v = ss0[r4], s1v = ss1[r4];
                float4 r0, r1;
                r0.x = x0.x * c0.x + sg * o0.x * s0v.x; r0.y = x0.y * c0.y + sg * o0.y * s0v.y; r0.z = x0.z * c0.z + sg * o0.z * s0v.z; r0.w = x0.w * c0.w + sg * o0.w * s0v.w;
                r1.x = x1.x * c1.x + sg * o1.x * s1v.x; r1.y = x1.y * c1.y + sg * o1.y * s1v.y; r1.z = x1.z * c1.z + sg * o1.z * s1v.z; r1.w = x1.w * c1.w + sg * o1.w * s1v.w;
                *(uint4*)(dst + (size_t)row * 96) = pack8(r0, r1);
            }
        }
    } else if (nt < 4) {
        const int hd = nt * 2 + (l16 >> 3), d = (l16 & 7) * 8;
        const float4 g0 = *(const float4*)(in.k_norm_g + L * 96 + d), g1 = *(const float4*)(in.k_norm_g + L * 96 + d + 4);
        bf16_t* dst = w.Knb + ((size_t)(b * 8 + hd) * 2048 + s0) * 64 + d;
#pragma unroll 8
        for (int rr = 0; rr < 8; ++rr) {
            const int row = wid * 32 + rr * 4 + sub; const float rs = stat[row];
            float4 x0 = mul4(*(const float4*)(T + row * TLD + c8), rs), x1 = mul4(*(const float4*)(T + row * TLD + c8 + 4), rs);
            const float rn = rsq_(grp_sum8(sq8(x0, x1)) * (1.f / 64.f) + EPS);
            x0.x *= rn * g0.x; x0.y *= rn * g0.y; x0.z *= rn * g0.z; x0.w *= rn * g0.w; x1.x *= rn * g1.x; x1.y *= rn * g1.y; x1.z *= rn * g1.z; x1.w *= rn * g1.w;
            *(uint4*)(dst + (size_t)row * 64) = pack8(x0, x1);
        }
    } else {
        const int c = tid & 127, th = tid >> 7, hd = (nt - 4) * 2 + (c >> 6), d = c & 63;
        bf16_t* dst = w.VTb + ((size_t)(b * 8 + hd) * 64 + d) * 2048 + s0 + th * 64;
#pragma unroll 2
        for (int k8 = 0; k8 < 8; ++k8) {
            float v[8];
#pragma unroll
            for (int k = 0; k < 8; ++k) { const int row = th * 64 + k8 * 8 + k; v[k] = T[row * TLD + c] * stat[row]; }
            uint4 pk; pk.x = pack2(v[0], v[1]); pk.y = pack2(v[2], v[3]); pk.z = pack2(v[4], v[5]); pk.w = pack2(v[6], v[7]);
            *(uint4*)(dst + k8 * 8) = pk;
        }
    }
    __syncthreads();
}

__device__ void sgu_item(const Params& P, int L, int mt, char* lds, const int tid_in) {
    int tid = tid_in; asm volatile("" : "+v"(tid));
    const WS& w = P.w; const nv::Inputs& in = P.in;
    const int lane = tid & 63, hd = tid >> 6, fr = lane & 31, fh = lane >> 5;
    float* red = (float*)lds;
    const bf16_t* vt = w.vT + (size_t)(mt * 4 + hd) * 64 * 128;
    const bf16_t* ws = w.Wsm + L * WSM_SZ + (size_t)hd * 128 * 128;
    const float* bs = in.sgu_b + L * 512 + hd * 128;
    const int m0 = mt * 128;
    bf16x8 af0[8], af1[8];
    {
        const bf16_t* ap0 = vt + (size_t)fr * 128 + 8 * fh;
        const bf16_t* ap1 = vt + (size_t)(32 + fr) * 128 + 8 * fh;
#pragma unroll
        for (int s = 0; s < 8; ++s) { af0[s] = *(const bf16x8*)(ap0 + 16 * s); af1[s] = *(const bf16x8*)(ap1 + 16 * s); }
    }
#pragma unroll 1
    for (int it = 0; it < 4; ++it) {
        f32x16 a0, a1;
#pragma unroll
        for (int r = 0; r < 16; ++r) { a0[r] = 0.f; a1[r] = 0.f; }
        const bf16_t* bp = ws + (size_t)(it * 32 + fr) * 128 + 8 * fh;
        bf16x8 bfr[8];
#pragma unroll
        for (int s = 0; s < 8; ++s) bfr[s] = *(const bf16x8*)(bp + 16 * s);
#pragma unroll
        for (int s = 0; s < 8; ++s) {
            a0 = __builtin_amdgcn_mfma_f32_32x32x16_bf16(af0[s], bfr[s], a0, 0, 0, 0);
            a1 = __builtin_amdgcn_mfma_f32_32x32x16_bf16(af1[s], bfr[s], a1, 0, 0, 0);
        }
        const int i = it * 32 + fr, tok = m0 + i;
        const float bias = bs[i];
        uint2 uu[2][4];
#pragma unroll
        for (int dt = 0; dt < 2; ++dt)
#pragma unroll
            for (int g = 0; g < 4; ++g) uu[dt][g] = *(const uint2*)(w.ub + (size_t)tok * 256 + hd * 64 + dt * 32 + 8 * g + 4 * fh);
        float ssq = 0.f;
#pragma unroll
        for (int dt = 0; dt < 2; ++dt)
#pragma unroll
            for (int g = 0; g < 4; ++g) {
                const int d = dt * 32 + 8 * g + 4 * fh;
                float o[4];
#pragma unroll
                for (int q = 0; q < 4; ++q) {
                    const float sv = (dt == 0 ? a0[4 * g + q] : a1[4 * g + q]) + bias;
                    const float uv = (q == 0) ? bflo(uu[dt][g].x) : (q == 1) ? bfhi(uu[dt][g].x) : (q == 2) ? bflo(uu[dt][g].y) : bfhi(uu[dt][g].y);
                    o[q] = uv * sv; ssq += o[q] * o[q];
                }
                store4(w.yb + (size_t)tok * 1024 + hd * 64 + d, o[0], o[1], o[2], o[3]);
            }
        ssq = xor32(ssq);
        if (fh == 0) red[hd * 128 + i] = ssq;
    }
    __syncthreads();
    if (tid < 128) w.ssq[(size_t)(m0 + tid) * 16 + 0] = red[tid] + red[128 + tid] + red[256 + tid] + red[384 + tid];
    __syncthreads();
}

constexpr int CLD = 260, CONV_YL = 32 * CLD * 4, CONV_ST = CONV_YL + 32 * 512, CONV_RED = CONV_ST + 32 * 4 * 8;
__device__ __forceinline__ int yl_off(int row, int chunk) { return row * 512 + ((chunk ^ (row & 15)) << 4); }
__device__ void conv_item(const Params& P, int L, int ct, char* lds, const int tid_in) {
    int tid = tid_in; asm volatile("" : "+v"(tid));
    const WS& w = P.w; const nv::Inputs& in = P.in;
    const int lane = tid & 63, wid = tid >> 6, fr = lane & 31, fh = lane >> 5;
    float* C = (float*)lds; char* yl = lds + CONV_YL; float2* stats = (float2*)(lds + CONV_ST); float* red = (float*)(lds + CONV_RED);
    const int t0 = ct * 32, s0 = t0 & 2047;
    {
        const int c = tid;
        float x[62];
#pragma unroll
        for (int r = 0; r < 62; ++r) {
            const bool ok = s0 + r - 30 >= 0;
            const unsigned short raw = w.ygb[(size_t)(ok ? t0 + r - 30 : t0) * 256 + c];
            x[r] = bf2f(raw) * (ok ? 1.f : 0.f);
        }
        float wk[31];
#pragma unroll
        for (int k = 0; k < 31; ++k) wk[k] = in.conv_w[(size_t)L * 31 * 256 + k * 256 + c];
        const float cb = in.conv_b[L * 256 + c];
#pragma unroll
        for (int t = 0; t < 32; ++t) {
            float a = cb;
#pragma unroll
            for (int k = 0; k < 31; ++k) a = fmaf(wk[k], x[t + k], a);
            C[t * CLD + c] = a;
        }
    }
    __syncthreads();
    if (tid < 128) {
        const int t = tid >> 2, g = tid & 3;
        const float4* cp = (const float4*)(C + t * CLD + g * 64);
        float4 v[16]; float s = 0.f;
#pragma unroll
        for (int i = 0; i < 16; ++i) { v[i] = cp[i]; s += (v[i].x + v[i].y) + (v[i].z + v[i].w); }
        const float mean = s * (1.f / 64.f); float q = 0.f;
#pragma unroll
        for (int i = 0; i < 16; ++i) { const float a = v[i].x - mean, b2 = v[i].y - mean, c2 = v[i].z - mean, d2 = v[i].w - mean; q += (a * a + b2 * b2) + (c2 * c2 + d2 * d2); }
        stats[t * 4 + g] = make_float2(mean, rsq_(q * (1.f / 64.f) + EPS));
    }
    __syncthreads();
    {
        const int c = tid, g = c >> 6;
        const float lg = in.conv_ln_g[L * 256 + c], lb = in.conv_ln_b[L * 256 + c];
#pragma unroll 8
        for (int t = 0; t < 32; ++t) {
            const float2 st = stats[t * 4 + g];
            const float v = (C[t * CLD + c] - st.x) * st.y * lg + lb;
            *(bf16_t*)(yl + yl_off(t, c >> 3) + (c & 7) * 2) = (bf16_t)f2bf(v * sigmoid_(v));
        }
    }
    __syncthreads();
    f32x16 acc0, acc1;
#pragma unroll
    for (int r = 0; r < 16; ++r) { acc0[r] = 0.f; acc1[r] = 0.f; }
    const bf16_t* wp = w.Wpwt + L * WPW_SZ + (size_t)(wid * 64 + fr) * 256 + 8 * fh;
#pragma unroll 1
    for (int sb = 0; sb < 2; ++sb) {
        bf16x8 w0[8], w1[8];
#pragma unroll
        for (int s = 0; s < 8; ++s) { w0[s] = *(const bf16x8*)(wp + 16 * (sb * 8 + s)); w1[s] = *(const bf16x8*)(wp + 32 * 256 + 16 * (sb * 8 + s)); }
#pragma unroll
        for (int s = 0; s < 8; ++s) {
            const bf16x8 x0 = *(const bf16x8*)(yl + yl_off(fr, 2 * (sb * 8 + s) + fh));
            acc0 = __builtin_amdgcn_mfma_f32_32x32x16_bf16(w0[s], x0, acc0, 0, 0, 0);
            acc1 = __builtin_amdgcn_mfma_f32_32x32x16_bf16(w1[s], x0, acc1, 0, 0, 0);
        }
    }
    const float* pb = in.conv_pw_b + L * 256;
    {
        const int tok = t0 + fr;
        float4 bia[2][4];
#pragma unroll
        for (int jn = 0; jn < 2; ++jn)
#pragma unroll
            for (int g = 0; g < 4; ++g) bia[jn][g] = *(const float4*)(pb + wid * 64 + jn * 32 + 8 * g + 4 * fh);
        float ssq = 0.f;
#pragma unroll
        for (int jn = 0; jn < 2; ++jn)
#pragma unroll
            for (int g = 0; g < 4; ++g) {
                const int n = wid * 64 + jn * 32 + 8 * g + 4 * fh;
                const float4 b4 = bia[jn][g];
                const float o0 = (jn ? acc1[4 * g] : acc0[4 * g]) + b4.x, o1 = (jn ? acc1[4 * g + 1] : acc0[4 * g + 1]) + b4.y;
                const float o2 = (jn ? acc1[4 * g + 2] : acc0[4 * g + 2]) + b4.z, o3 = (jn ? acc1[4 * g + 3] : acc0[4 * g + 3]) + b4.w;
                ssq += o0 * o0 + o1 * o1 + o2 * o2 + o3 * o3;
                store4(w.yb + (size_t)tok * 1024 + 256 + n, o0, o1, o2, o3);
            }
        ssq = xor32(ssq);
        if (fh == 0) red[wid * 32 + fr] = ssq;
    }
    __syncthreads();
    if (tid < 32) w.ssq[(size_t)(t0 + tid) * 16 + 1] = red[tid] + red[32 + tid] + red[64 + tid] + red[96 + tid];
    __syncthreads();
}

__device__ void phase_mix(const Params& P, int L, char* lds, const int rep = 0, const bool dryrun = false) {
    const int tid = opaque_tid();
    const int x = blockIdx.x & 7;
    int* qctr = P.w.cnt + L * 256 + 72 + x + 8 * rep;
    volatile int* slot = (volatile int*)(lds + LDS_GEMM_BYTES - 16);
    if (tid == 0) *slot = atomicAdd(qctr, 1);
    __syncthreads();
    int cur = *slot;
    __syncthreads();
    while (cur < 304) {
        int nxt = 0;
        if (tid == 0) nxt = atomicAdd(qctr, 1);
#ifdef MIX_MASK
        const int mask = dryrun ? MIX_MASK : 15;
#else
        const int mask = 15;
#endif
#ifdef MIX_TWICE
        if (cur < 16) { if (MIX_TWICE & 1) sgu_item(P, L, cur * 8 + x, lds, tid); }
        else if (cur < 80) { if (MIX_TWICE & 2) conv_item(P, L, (cur - 16) * 8 + x, lds, tid); }
        else if (cur < 176) { if (MIX_TWICE & 4) { const int li = cur - 80; qkv_item(P, L, true, (li / 6) * 8 + x, li % 6, lds, tid); } }
        else { if (MIX_TWICE & 8) { const int li = cur - 176; qkv_item(P, L, false, (li >> 3) * 8 + x, li & 7, lds, tid); } }
#endif
        if (cur < 16) { if (mask & 1) sgu_item(P, L, cur * 8 + x, lds, tid); }
        else if (cur < 80) { if (mask & 2) conv_item(P, L, (cur - 16) * 8 + x, lds, tid); }
        else if (cur < 176) { if (mask & 4) { const int li = cur - 80; qkv_item(P, L, true, (li / 6) * 8 + x, li % 6, lds, tid); } }
        else { if (mask & 8) { const int li = cur - 176; qkv_item(P, L, false, (li >> 3) * 8 + x, li & 7, lds, tid); } }
        if (tid == 0) *slot = nxt;
        __syncthreads();
        cur = *slot;
        __syncthreads();
    }
}

}
namespace fx {

constexpr int AKN = 0, AKP = 8192, AVT = 12288, ATT_STAGE = 20480;
__device__ __forceinline__ void att_issue(const bf16_t* Kn, const bf16_t* Kp, const bf16_t* Vt, int k0, char* st, const int tid, const int wbase) {
    {
        const int row = tid >> 3, ch = (tid & 7) ^ ((tid >> 4) & 7);
        glds16(Kn + (size_t)(k0 + row) * 64 + ch * 8, st + AKN + wbase);
        glds16(Kn + (size_t)(k0 + row + 32) * 64 + ch * 8, st + AKN + 4096 + wbase);
    }
    {
        const int row = tid >> 2, ch = (tid & 3) ^ ((tid >> 4) & 3);
        glds16(Kp + (size_t)(k0 + row) * 32 + ch * 8, st + AKP + wbase);
    }
    {
        const int d = tid >> 3, ch = (tid & 7) ^ ((tid >> 4) & 7);
        glds16(Vt + (size_t)d * 2048 + k0 + ch * 8, st + AVT + wbase);
        glds16(Vt + (size_t)(d + 32) * 2048 + k0 + ch * 8, st + AVT + 4096 + wbase);
    }
}

__device__ void attn_unit(const Params& P, int b, int h, int qt, char* lds, const int tid) {
    const WS& w = P.w;
    const int lane = tid & 63, wid = tid >> 6, fr = lane & 31, fh = lane >> 5;
    const int wbase = __builtin_amdgcn_readfirstlane(wid) * 1024;
    const bf16_t* Kn = w.Knb + (size_t)(b * 8 + h) * 2048 * 64;
    const bf16_t* Kp = w.kpeb + (size_t)b * 2048 * 32;
    const bf16_t* Vt = w.VTb + (size_t)(b * 8 + h) * 64 * 2048;
    const int q0 = qt * 128, qw0 = q0 + wid * 32, qpos = qw0 + fr;
    bf16x8 qf[6];
    {
        const bf16_t* qp = w.Qb + ((size_t)(b * 8 + h) * 2048 + qpos) * 96 + 8 * fh;
#pragma unroll
        for (int ks = 0; ks < 6; ++ks) qf[ks] = *(const bf16x8*)(qp + 16 * ks);
    }
    f32x16 o0, o1;
#pragma unroll
    for (int r = 0; r < 16; ++r) { o0[r] = 0.f; o1[r] = 0.f; }
    float m = -1e30f, l = 0.f;
    const int nkt = 2 * (qt + 1);
    asm volatile("s_waitcnt vmcnt(0)" ::: "memory");
    att_issue(Kn, Kp, Vt, 0, lds, tid, wbase);
    if (nkt > 1) att_issue(Kn, Kp, Vt, 64, lds + ATT_STAGE, tid, wbase);
    const int kn0 = AKN + fr * 128, kn1 = AKN + (32 + fr) * 128, swn = (fr >> 1) & 7;
    const int kp0 = AKP + fr * 64, kp1 = AKP + (32 + fr) * 64, swp = (fr >> 2) & 3;
    const int vt0 = AVT + fr * 128 + 8 * fh, vt1 = AVT + (32 + fr) * 128 + 8 * fh, swv = (fr >> 1) & 7;
#pragma unroll 1
    for (int kt = 0; kt < nkt; ++kt) {
        if (kt + 1 < nkt) asm volatile("s_waitcnt vmcnt(5)" ::: "memory"); else asm volatile("s_waitcnt vmcnt(0)" ::: "memory");
        RAW_BARRIER();
        if (kt + 2 < nkt) att_issue(Kn, Kp, Vt, (kt + 2) * 64, lds + ((kt + 2) % 3) * ATT_STAGE, tid, wbase);
        const char* cur = lds + (kt % 3) * ATT_STAGE;
        const int k0 = kt * 64;
        if (k0 <= qw0 + 31) {
            f32x16 s0, s1;
#pragma unroll
            for (int r = 0; r < 16; ++r) { s0[r] = 0.f; s1[r] = 0.f; }
            {
                bf16x8 ka[6], kc[6];
#pragma unroll
                for (int ks = 0; ks < 4; ++ks) {
                    const int off = ((2 * ks + fh) ^ swn) << 4;
                    ka[ks] = *(const bf16x8*)(cur + kn0 + off); kc[ks] = *(const bf16x8*)(cur + kn1 + off);
                }
#pragma unroll
                for (int ks = 4; ks < 6; ++ks) {
                    const int off = ((2 * (ks - 4) + fh) ^ swp) << 4;
                    ka[ks] = *(const bf16x8*)(cur + kp0 + off); kc[ks] = *(const bf16x8*)(cur + kp1 + off);
                }
                __builtin_amdgcn_sched_barrier(0);
#pragma unroll
                for (int ks = 0; ks < 6; ++ks) {
                    s0 = __builtin_amdgcn_mfma_f32_32x32x16_bf16(ka[ks], qf[ks], s0, 0, 0, 0);
                    s1 = __builtin_amdgcn_mfma_f32_32x32x16_bf16(kc[ks], qf[ks], s1, 0, 0, 0);
                }
            }
            uint2 va0[4], va1[4], vb0[4], vb1[4];
#pragma unroll
            for (int ks = 0; ks < 4; ++ks) {
                const int c0 = ((2 * ks) ^ swv) << 4, c1 = ((2 * ks + 1) ^ swv) << 4;
                va0[ks] = *(const uint2*)(cur + vt0 + c0); va1[ks] = *(const uint2*)(cur + vt0 + c1);
                vb0[ks] = *(const uint2*)(cur + vt1 + c0); vb1[ks] = *(const uint2*)(cur + vt1 + c1);
            }
            __builtin_amdgcn_sched_barrier(0);
            if (k0 + 63 > qw0) {
#pragma unroll
                for (int r = 0; r < 16; ++r) {
                    const int key = k0 + nidx(r, fh);
                    if (key > qpos) s0[r] = -1e30f;
                    if (key + 32 > qpos) s1[r] = -1e30f;
                }
            }
            float mx = s0[0];
#pragma unroll
            for (int r = 1; r < 16; ++r) mx = fmaxf(mx, s0[r]);
#pragma unroll
            for (int r = 0; r < 16; ++r) mx = fmaxf(mx, s1[r]);
            mx = swap32_max(mx);
            const float mn = fmaxf(m, mx);
            const float alpha = __builtin_amdgcn_exp2f(m - mn);
            m = mn;
            float ps = 0.f;
#pragma unroll
            for (int r = 0; r < 16; ++r) { s0[r] = __builtin_amdgcn_exp2f(s0[r] - mn); ps += s0[r]; }
#pragma unroll
            for (int r = 0; r < 16; ++r) { s1[r] = __builtin_amdgcn_exp2f(s1[r] - mn); ps += s1[r]; }
            ps = swap32_sum(ps);
            l = l * alpha + ps;
#pragma unroll
            for (int r = 0; r < 16; ++r) { o0[r] *= alpha; o1[r] *= alpha; }
#pragma unroll
            for (int ks = 0; ks < 4; ++ks) {
                bf16x8 pf;
                {
                    const int rb = 8 * (ks & 1);
                    unsigned u0, u1, u2, u3;
                    if (ks < 2) { u0 = pack2(s0[rb], s0[rb + 1]); u1 = pack2(s0[rb + 2], s0[rb + 3]); u2 = pack2(s0[rb + 4], s0[rb + 5]); u3 = pack2(s0[rb + 6], s0[rb + 7]); }
                    else { u0 = pack2(s1[rb], s1[rb + 1]); u1 = pack2(s1[rb + 2], s1[rb + 3]); u2 = pack2(s1[rb + 4], s1[rb + 5]); u3 = pack2(s1[rb + 6], s1[rb + 7]); }
                    uint4 uu = make_uint4(u0, u1, u2, u3);
                    pf = __builtin_bit_cast(bf16x8, uu);
                }
                const bf16x8 vfa = __builtin_bit_cast(bf16x8, make_uint4(va0[ks].x, va0[ks].y, va1[ks].x, va1[ks].y));
                const bf16x8 vfb = __builtin_bit_cast(bf16x8, make_uint4(vb0[ks].x, vb0[ks].y, vb1[ks].x, vb1[ks].y));
                o0 = __builtin_amdgcn_mfma_f32_32x32x16_bf16(vfa, pf, o0, 0, 0, 0);
                o1 = __builtin_amdgcn_mfma_f32_32x32x16_bf16(vfb, pf, o1, 0, 0, 0);
            }
        }
    }
    RAW_BARRIER();
    const float inv = 1.f / l;
    const int tok = b * 2048 + qpos;
    float ssq = 0.f;
#pragma unroll
    for (int dt = 0; dt < 2; ++dt)
#pragma unroll
        for (int g = 0; g < 4; ++g) {
            float o[4];
#pragma unroll
            for (int q = 0; q < 4; ++q) { o[q] = (dt == 0 ? o0[4 * g + q] : o1[4 * g + q]) * inv; ssq += o[q] * o[q]; }
            store4(w.yb + (size_t)tok * 1024 + 512 + h * 64 + dt * 32 + 8 * g + 4 * fh, o[0], o[1], o[2], o[3]);
        }
    ssq = xor32(ssq);
    if (fh == 0) w.ssq[(size_t)tok * 16 + 8 + h] = ssq;
}

__device__ void phase_attn(const Params& P, int L, char* lds) {
    const int tid0 = opaque_tid();
    const int h = blockIdx.x & 7, nlb = gridDim.x >> 3;
    for (int li = blockIdx.x >> 3; li < 64; li += nlb) {
        int tid = tid0; asm volatile("" : "+v"(tid));
        const int p = li & 7, b = li >> 3;
        attn_unit(P, b, h, 15 - p, lds, tid);
        attn_unit(P, b, h, p, lds, tid);
    }
}

}
namespace fx {

__device__ __forceinline__ void acc_scale(f32x16 (&acc)[2][2], const float* f, const int tid) {
    const int lane = tid & 63, wr = tid >> 7, fr = lane & 31;
#pragma unroll
    for (int i = 0; i < 2; ++i) {
        const float v = f[wr * 64 + i * 32 + fr];
#pragma unroll
        for (int j = 0; j < 2; ++j)
#pragma unroll
            for (int r = 0; r < 16; ++r) acc[i][j][r] *= v;
    }
}
__device__ void phase_oproj(const Params& P, int L, char* lds, const bool dry = false) {
    const WS& w = P.w;
    const int tid0 = opaque_tid();
    float* T = (float*)lds; float* stat = (float*)(lds + STAT_OFF);
    const bf16_t* Wt = w.Wot + L * WO_SZ;
    int mt, nt;
    for (int it = 0; xcd_item(it, 128, 8, mt, nt); ++it) {
        int tid = tid0; asm volatile("" : "+v"(tid));
        const int lane = tid & 63, wid = tid >> 6;
        const int m0 = mt * 128, n0 = nt * 128;
        float rb_keep = 0.f;
        if (tid < 128) {
            const float* sq = w.ssq + (size_t)(m0 + tid) * 16;
            const float4 c0 = *(const float4*)(sq + 8), c1 = *(const float4*)(sq + 12);
            const float ra = rsq_(sq[0] * (1.f / 256.f) + EPS), rb = rsq_(sq[1] * (1.f / 256.f) + EPS);
            const float rc = rsq_((c0.x + c0.y + c0.z + c0.w + c1.x + c1.y + c1.z + c1.w) * (1.f / 512.f) + EPS);
            stat[tid] = rc / ra; stat[128 + tid] = ra / rb; rb_keep = rb;
        }
        {
            const bf16_t* arow[4]; const bf16_t* wrow[4];
#pragma unroll
            for (int i = 0; i < 4; ++i) {
                arow[i] = w.yb + (size_t)(m0 + (tid >> 3) + 32 * i) * 1024 + g64_chunk(tid) * 8;
                wrow[i] = Wt + (size_t)(n0 + (tid >> 3) + 32 * i) * 1024 + g64_chunk(tid) * 8;
            }
            f32x16 acc[2][2]; acc_zero(acc);
            gemm_mainloop_g64<true>(acc, arow, wrow, 16, lds, tid, 8, 8, stat, 12, stat + 128);
            if (tid < 128) stat[tid] = rb_keep;
            acc_to_lds(acc, T, tid);
        }
        {
            const int sub = lane >> 4, c8 = (lane & 15) * 8;
            float4 hv0[8], hv1[8];
            if (L == 0) {
#pragma unroll
                for (int rr = 0; rr < 8; ++rr) {
                    const float4* hin = (const float4*)(P.in.x + (size_t)(m0 + wid * 32 + rr * 4 + sub) * 1024 + n0 + c8);
                    hv0[rr] = hin[0]; hv1[rr] = hin[1];
                }
            } else {
#pragma unroll
                for (int rr = 0; rr < 8; ++rr) {
                    const uint4 hh = *(const uint4*)(w.hb + (size_t)(m0 + wid * 32 + rr * 4 + sub) * 1024 + n0 + c8);
                    hv0[rr] = make_float4(bflo(hh.x), bfhi(hh.x), bflo(hh.y), bfhi(hh.y)); hv1[rr] = make_float4(bflo(hh.z), bfhi(hh.z), bflo(hh.w), bfhi(hh.w));
                }
            }
#pragma unroll
            for (int rr = 0; rr < 8; ++rr) {
                const int row = wid * 32 + rr * 4 + sub; const float rb = stat[row];
                const float4 x0 = *(const float4*)(T + row * TLD + c8), x1 = *(const float4*)(T + row * TLD + c8 + 4);
                float4 h0 = hv0[rr], h1 = hv1[rr];
                h0.x += x0.x * rb; h0.y += x0.y * rb; h0.z += x0.z * rb; h0.w += x0.w * rb;
                h1.x += x1.x * rb; h1.y += x1.y * rb; h1.z += x1.z * rb; h1.w += x1.w * rb;
                *(uint4*)(w.hb1 + (size_t)(m0 + row) * 1024 + n0 + c8) = pack8(h0, h1);
                const float sq = grp_sum16(sq8(h0, h1));
                if ((lane & 15) == 0) w.rssB[(size_t)(m0 + row) * 8 + nt] = sq;
            }
        }
        __syncthreads();
    }
}

__device__ void router_item(const Params& P, int L, int mt, char* lds, const int tid_in, const bool dry) {
    int tid = tid_in; asm volatile("" : "+v"(tid));
    const WS& w = P.w; const nv::Inputs& in = P.in;
    float* T = (float*)lds; float* stat = (float*)(lds + STAT_OFF); int* hist = (int*)(lds + STAT_OFF + 1024);
    const int m0 = mt * 128;
    {
        const bf16_t* arow[4]; const bf16_t* wrow[4];
#pragma unroll
        for (int i = 0; i < 4; ++i) {
            arow[i] = w.hb1 + (size_t)(m0 + (tid >> 3) + 32 * i) * 1024 + g64_chunk(tid) * 8;
            wrow[i] = w.Wrt + L * WR_SZ + (size_t)((tid >> 3) + 32 * i) * 1024 + g64_chunk(tid) * 8;
        }
        f32x16 acc[2][2]; acc_zero(acc);
        float my_rs = 0.f;
        if (tid < 128) my_rs = rstd8(w.rssB + (size_t)(m0 + tid) * 8, 1.f / 1024.f);
        gemm_mainloop_g64(acc, arow, wrow, 16, lds, tid);
        if (tid < 128) stat[tid] = my_rs;
        if (tid < 64) hist[tid] = 0;
        acc_to_lds(acc, T, tid);
    }
    int e0 = 0, e1 = 0, r0 = 0, r1 = 0; float w0 = 0.f, w1 = 0.f;
    if (tid < 128) {
        const float rs = stat[tid];
        const float* lr = T + tid * TLD;
        const float* bg = in.router_group_b + L * 4; const float* be = in.router_expert_b + L * 32;
        int gi = 0; float gm = lr[0] * rs + bg[0];
#pragma unroll
        for (int j = 1; j < 4; ++j) { const float v = lr[j] * rs + bg[j]; if (v > gm) { gm = v; gi = j; } }
        float gs = 0.f;
#pragma unroll
        for (int j = 0; j < 4; ++j) gs += __builtin_amdgcn_exp2f(1.4426950408889634f * (lr[j] * rs + bg[j] - gm));
        const float gw = 1.f / gs;
        int i0 = 0, i1 = -1; float v0 = -3.0e38f, v1 = -3.0e38f;
#pragma unroll
        for (int j = 0; j < 8; ++j) {
            const float v = lr[4 + gi * 8 + j] * rs + be[gi * 8 + j];
            if (v > v0) { v1 = v0; i1 = i0; v0 = v; i0 = j; } else if (v > v1) { v1 = v; i1 = j; }
        }
        const float ex = __builtin_amdgcn_exp2f(1.4426950408889634f * (v1 - v0));
        w0 = gw / (1.f + ex); w1 = gw * ex / (1.f + ex);
        e0 = gi * 8 + i0; e1 = gi * 8 + i1;
        e0 = e0 * 2; e1 = e1 * 2 + 1;
        r0 = atomicAdd(&hist[e0], 1); r1 = atomicAdd(&hist[e1], 1);
    }
    __syncthreads();
    if (tid < 64) hist[64 + tid] = (hist[tid] && !dry) ? atomicAdd(&w.cnt[L * 256 + tid], hist[tid]) : 0;
    __syncthreads();
    if (tid < 128 && !dry) {
        const int tok = m0 + tid;
        const int p0 = hist[64 + e0] + r0, p1 = hist[64 + e1] + r1;
        w.elist[(size_t)e0 * NT + p0] = tok; w.ewt[(size_t)e0 * NT + p0] = w0;
        w.elist[(size_t)e1 * NT + p1] = tok; w.ewt[(size_t)e1 * NT + p1] = w1;
    }
    __syncthreads();
}
__device__ void eraw_item(const Params& P, int L, const int mt, const int nt, char* lds, const int tid_in) {
    int tid = tid_in; asm volatile("" : "+v"(tid));
    const WS& w = P.w; const nv::Inputs& in = P.in;
    const int lane = tid & 63, wid = tid >> 6;
    float* T = (float*)lds;
    const int m0 = mt * 128, n0 = nt * 128;
    {
        const float* arow[4]; const bf16_t* wrow[4];
#pragma unroll
        for (int i = 0; i < 4; ++i) {
            arow[i] = in.p + ((size_t)L * NT + m0 + (tid >> 3) + 32 * i) * 256 + (tid & 7) * 8;
            wrow[i] = w.Wpt + L * WP_SZ + (size_t)(n0 + (tid >> 3) + 32 * i) * 256 + (tid & 7) * 8;
        }
        f32x16 acc[2][2]; acc_zero(acc);
        float ss[4] = {0.f, 0.f, 0.f, 0.f};
        gemm_mainloop<float, false>(acc, arow, wrow, 4, lds, ss, tid);
        acc_to_lds(acc, T, tid);
    }
    {
        const int sub = lane >> 4, l16 = lane & 15, c8 = l16 * 8;
#pragma unroll 8
        for (int rr = 0; rr < 8; ++rr) {
            const int row = wid * 32 + rr * 4 + sub;
            const float4 x0 = *(const float4*)(T + row * TLD + c8), x1 = *(const float4*)(T + row * TLD + c8 + 4);
            *(uint4*)(w.erb + (size_t)(m0 + row) * 1024 + n0 + c8) = pack8(x0, x1);
            const float sq = grp_sum16(sq8(x0, x1));
            if (l16 == 0) w.essq[(size_t)(m0 + row) * 8 + nt] = sq;
        }
    }
    __syncthreads();
}
__device__ void phase_router(const Params& P, int L, char* lds, const bool dry = false) {
    const int tid = opaque_tid();
    {
        const int x = blockIdx.x & 7, lb = blockIdx.x >> 3, nlb = gridDim.x >> 3;
        if (lb < 16 || nlb <= 16) { for (int j = lb; j < 16; j += nlb) router_item(P, L, j * 8 + x, lds, tid, dry); }
        if (!dry) {
            if (nlb > 16) { if (lb >= 16) prep_moe_late(P, L, lds, tid, (lb - 16) * 8 + x, (nlb - 16) * 8); }
            else prep_moe_late(P, L, lds, tid, blockIdx.x, gridDim.x);
        }
    }
}

constexpr int TT_OFF = STAT_OFF + 1024;
__device__ __forceinline__ void moe_table(const Params& P, int L, char* lds, const int tid) {
    int* tt = (int*)(lds + TT_OFF);
    if (tid == 0) {
        const int x = blockIdx.x & 7;
        int o = 0;
        for (int li = 0; li < 64; ++li) { tt[li] = o; o += P.w.cnt[L * 256 + li]; }
        tt[64] = o;
        int t = 0, t0 = 0, t1 = 0;
        for (int k = 0; k < 8; ++k) {
            const int li = ((k >> 1) * 8 + x) * 2 + (k & 1), nt_ = (P.w.cnt[L * 256 + li] + 127) >> 7;
            tt[72 + k] = t; t += nt_;
            if (k & 1) { tt[92 + (k >> 1)] = t1; t1 += nt_; } else { tt[84 + (k >> 1)] = t0; t0 += nt_; }
        }
        tt[80] = t; tt[88] = t0; tt[96] = t1;
        int tu = 0;
        for (int k = 0; k < 4; ++k) { const int e = k * 8 + x; tt[100 + k] = tu; tu += (P.w.cnt[L * 256 + 2 * e] + P.w.cnt[L * 256 + 2 * e + 1] + 127) >> 7; }
        tt[104] = tu;
    }
    __syncthreads();
}
__device__ __forceinline__ void moe_find(const int* tt, int tile, int& li, int& t) {
    int k = 0;
#pragma unroll
    for (int j = 1; j < 8; ++j) if (tile >= tt[72 + j]) k = j;
    li = ((k >> 1) * 8 + (blockIdx.x & 7)) * 2 + (k & 1); t = tile - tt[72 + k];
}
__device__ __forceinline__ void moe_find_slot(const int* tt, int slot, int tile, int& li, int& t) {
    const int* tp = tt + (slot ? 92 : 84);
    int k = 0;
#pragma unroll
    for (int j = 1; j < 4; ++j) if (tile >= tp[j]) k = j;
    li = (k * 8 + (blockIdx.x & 7)) * 2 + slot; t = tile - tp[k];
}
__device__ void phase_moe_up(const Params& P, int L, char* lds, const bool noeraw = false) {
    const WS& w = P.w;
    const int tid0 = opaque_tid();
    float* T = (float*)lds; float* stat = (float*)(lds + STAT_OFF); const int* tt = (const int*)(lds + TT_OFF);
    moe_table(P, L, lds, tid0);
    const int ntiles = tt[104];
    for (int item = blockIdx.x >> 3; item < ntiles * 4; item += (gridDim.x >> 3)) {
        int tid = tid0; asm volatile("" : "+v"(tid));
        const int lane = tid & 63, wid = tid >> 6;
        const int tile = item >> 2, nt = item & 3;
        int k = 0;
#pragma unroll
        for (int j = 1; j < 4; ++j) if (tile >= tt[100 + j]) k = j;
        const int e = k * 8 + (blockIdx.x & 7), t = tile - tt[100 + k];
        const int cnt0 = P.w.cnt[L * 256 + 2 * e], cnt = cnt0 + P.w.cnt[L * 256 + 2 * e + 1];
        const int rbase = tt[2 * e] + t * 128, nrows = min(128, cnt - t * 128);
        {
            const bf16_t* arow[4]; const bf16_t* wrow[4];
#pragma unroll
            for (int i = 0; i < 4; ++i) {
                const int r = (tid >> 3) + 32 * i;
                const int rr3 = t * 128 + (r < nrows ? r : 0);
                const int tok = rr3 < cnt0 ? w.elist[(size_t)(2 * e) * NT + rr3] : w.elist[(size_t)(2 * e + 1) * NT + rr3 - cnt0];
                arow[i] = w.hb1 + (size_t)tok * 1024 + g64_chunk(tid) * 8;
                wrow[i] = w.Wgut + L * WGU_SZ + ((size_t)e * 512 + nt * 128 + r) * 1024 + g64_chunk(tid) * 8;
            }
            f32x16 acc[2][2]; acc_zero(acc);
            float my_rs = 0.f;
            if (tid < 128) {
                const int rr3 = t * 128 + (tid < nrows ? tid : 0);
                const int tok = rr3 < cnt0 ? w.elist[(size_t)(2 * e) * NT + rr3] : w.elist[(size_t)(2 * e + 1) * NT + rr3 - cnt0];
                my_rs = rstd8(w.rssB + (size_t)tok * 8, 1.f / 1024.f);
            }
            gemm_mainloop_g64(acc, arow, wrow, 16, lds, tid);
            if (tid < 128) stat[tid] = my_rs;
            acc_to_lds(acc, T, tid);
        }
        {
            const int sub = lane >> 4, l16 = lane & 15, c8 = l16 * 8;
#pragma unroll 8
            for (int rr = 0; rr < 8; ++rr) {
                const int row = wid * 32 + rr * 4 + sub; const float rs = stat[row];
                const float4 x0 = mul4(*(const float4*)(T + row * TLD + c8), rs), x1 = mul4(*(const float4*)(T + row * TLD + c8 + 4), rs);
                if (row < nrows)
                    store4(w.hbuf + (size_t)(rbase + row) * 256 + nt * 64 + l16 * 4, x0.x * sigmoid_(x0.x) * x0.y, x0.z * sigmoid_(x0.z) * x0.w,
                           x1.x * sigmoid_(x1.x) * x1.y, x1.z * sigmoid_(x1.z) * x1.w);
            }
        }
        __syncthreads();
    }
    if (!noeraw) {
        int* qslot = (int*)(lds + TT_OFF + 512);
        for (;;) {
            if (tid0 == 0) *qslot = atomicAdd(&P.w.cnt[L * 256 + 64], 1);
            __syncthreads();
            const int item = *qslot;
            __syncthreads();
            if (item >= 1024) break;
            eraw_item(P, L, item >> 3, item & 7, lds, tid0);
        }
    }
}
__device__ void phase_moe_down(const Params& P, int L, char* lds, const int slot, const bool dry = false) {
    const WS& w = P.w;
    const int tid0 = opaque_tid();
    float* T = (float*)lds; float* stat = (float*)(lds + STAT_OFF); const int* tt = (const int*)(lds + TT_OFF);
    moe_table(P, L, lds, tid0);
    const int ntiles = tt[slot ? 96 : 88];
    for (int item = blockIdx.x >> 3; item < ntiles * 8; item += (gridDim.x >> 3)) {
        int tid = tid0; asm volatile("" : "+v"(tid));
        const int lane = tid & 63, wid = tid >> 6;
        const int tile = item >> 3, nt = item & 7;
        int li, t; moe_find_slot(tt, slot, tile, li, t);
        const int e = li >> 1;
        const int cnt = P.w.cnt[L * 256 + li], rbase = tt[li] + t * 128, nrows = min(128, cnt - t * 128);
        {
            const bf16_t* arow[4]; const bf16_t* wrow[4];
#pragma unroll
            for (int i = 0; i < 4; ++i) {
                const int r = (tid >> 3) + 32 * i;
                arow[i] = w.hbuf + (size_t)(rbase + (r < nrows ? r : 0)) * 256 + g64_chunk(tid) * 8;
                wrow[i] = w.Wdt + L * WD_SZ + ((size_t)e * 1024 + nt * 128 + r) * 256 + g64_chunk(tid) * 8;
            }
            f32x16 acc[2][2]; acc_zero(acc);
            int my_tok = 0; float my_wt = 0.f;
            if (tid < 128) { const int rr2 = tid < nrows ? tid : 0; my_tok = w.elist[(size_t)li * NT + t * 128 + rr2]; my_wt = w.ewt[(size_t)li * NT + t * 128 + rr2]; }
            gemm_mainloop_g64(acc, arow, wrow, 4, lds, tid);
            if (tid < 128) { ((int*)stat)[tid] = my_tok; stat[128 + tid] = my_wt; }
            acc_to_lds(acc, T, tid);
        }
        {
            const int sub = lane >> 4, l16 = lane & 15, c8 = l16 * 8;
            uint4 hh[8];
#pragma unroll
            for (int rr = 0; rr < 8; ++rr) hh[rr] = *(const uint4*)(w.hb1 + (size_t)((const int*)stat)[wid * 32 + rr * 4 + sub] * 1024 + nt * 128 + c8);
#pragma unroll
            for (int rr = 0; rr < 8; ++rr) {
                const int row = wid * 32 + rr * 4 + sub;
                const int tok = ((const int*)stat)[row]; const float wt = stat[128 + row];
                const float4 x0 = *(const float4*)(T + row * TLD + c8), x1 = *(const float4*)(T + row * TLD + c8 + 4);
                const uint4 h = hh[rr];
                float4 h0, h1;
                h0.x = bflo(h.x) + wt * x0.x; h0.y = bfhi(h.x) + wt * x0.y; h0.z = bflo(h.y) + wt * x0.z; h0.w = bfhi(h.y) + wt * x0.w;
                h1.x = bflo(h.z) + wt * x1.x; h1.y = bfhi(h.z) + wt * x1.y; h1.z = bflo(h.w) + wt * x1.z; h1.w = bfhi(h.w) + wt * x1.w;
                const float sq = grp_sum16(sq8(h0, h1));
                if (row < nrows && !dry) {
                    *(uint4*)(w.hb1 + (size_t)tok * 1024 + nt * 128 + c8) = pack8(h0, h1);
                    if (slot && l16 == 0) w.rssB[(size_t)tok * 8 + nt] = sq;
                }
            }
        }
        __syncthreads();
    }
}

__device__ void phase_ple(const Params& P, int L, char* lds, const bool dry = false) {
    const WS& w = P.w; const nv::Inputs& in = P.in;
    const int tid0 = opaque_tid();
    float* T = (float*)lds; float* stat = (float*)(lds + STAT_OFF);
    int mt, nt;
    for (int it = 0; xcd_item(it, 128, 8, mt, nt); ++it) {
        int tid = tid0; asm volatile("" : "+v"(tid));
        const int lane = tid & 63, wid = tid >> 6;
        const int m0 = mt * 128, n0 = nt * 128;
        {
            const bf16_t* arow[4]; const bf16_t* wrow[4];
#pragma unroll
            for (int i = 0; i < 4; ++i) {
                arow[i] = w.hb1 + (size_t)(m0 + (tid >> 3) + 32 * i) * 1024 + g64_chunk(tid) * 8;
                wrow[i] = w.Wgt + L * WG_SZ + (size_t)(n0 + (tid >> 3) + 32 * i) * 1024 + g64_chunk(tid) * 8;
            }
            f32x16 acc[2][2]; acc_zero(acc);
            float my_rs = 0.f, my_re = 0.f;
            if (tid < 128) { my_rs = rstd8(w.rssB + (size_t)(m0 + tid) * 8, 1.f / 1024.f); my_re = rstd8(w.essq + (size_t)(m0 + tid) * 8, 1.f / 1024.f); }
            gemm_mainloop_g64(acc, arow, wrow, 16, lds, tid);
            if (tid < 128) { stat[tid] = my_rs; stat[128 + tid] = my_re; }
            acc_to_lds(acc, T, tid);
        }
        {
            const int sub = lane >> 4, l16 = lane & 15, c8 = l16 * 8;
            const float4 pg0 = *(const float4*)(in.ple_post_norm_g + L * 1024 + n0 + c8), pg1 = *(const float4*)(in.ple_post_norm_g + L * 1024 + n0 + c8 + 4);
            uint4 hhv[8], erv[8];
#pragma unroll
            for (int rr = 0; rr < 8; ++rr) {
                const size_t off = (size_t)(m0 + wid * 32 + rr * 4 + sub) * 1024 + n0 + c8;
                hhv[rr] = *(const uint4*)(w.hb1 + off); erv[rr] = *(const uint4*)(w.erb + off);
            }
#pragma unroll
            for (int rr = 0; rr < 8; ++rr) {
                const int row = wid * 32 + rr * 4 + sub; const float rs = stat[row], re = stat[128 + row]; const size_t tok = m0 + row;
                const float4 x0 = mul4(*(const float4*)(T + row * TLD + c8), rs), x1 = mul4(*(const float4*)(T + row * TLD + c8 + 4), rs);
                const size_t off = tok * 1024 + n0 + c8;
                const uint4 er = erv[rr], hh = hhv[rr];
                float4 h0, h1;
                h0.x = bflo(hh.x) + sigmoid_(x0.x) * (bflo(er.x) * re * pg0.x); h0.y = bfhi(hh.x) + sigmoid_(x0.y) * (bfhi(er.x) * re * pg0.y);
                h0.z = bflo(hh.y) + sigmoid_(x0.z) * (bflo(er.y) * re * pg0.z); h0.w = bfhi(hh.y) + sigmoid_(x0.w) * (bfhi(er.y) * re * pg0.w);
                h1.x = bflo(hh.z) + sigmoid_(x1.x) * (bflo(er.z) * re * pg1.x); h1.y = bfhi(hh.z) + sigmoid_(x1.y) * (bfhi(er.z) * re * pg1.y);
                h1.z = bflo(hh.w) + sigmoid_(x1.z) * (bflo(er.w) * re * pg1.z); h1.w = bfhi(hh.w) + sigmoid_(x1.w) * (bfhi(er.w) * re * pg1.w);
                if (L == 1) { float4* op = (float4*)(P.h + off); op[0] = h0; op[1] = h1; }
                else {
                    *(uint4*)(w.hb + off) = pack8(h0, h1);
                    const float sq = grp_sum16(sq8(h0, h1));
                    if (l16 == 0) w.rssA[tok * 8 + nt] = sq;
                }
            }
        }
        __syncthreads();
    }
}

}
namespace fx {
#define XB_TMO      128
#define XB_XCNT(j)  (256  + 64 * (j))
#define XB_XSUB(j)  (1280 + 64 * (j))
#define XB_XGEN(j)  (2304 + 64 * (j))
#define XB_TOP      3328
#define XB_TOPGEN   3392
#define XCD_BAR_WORDS 3456
#define XB_SPIN_CAP (1u << 18)
#define LAS __attribute__((address_space(3)))
__device__ __forceinline__ unsigned xb_ld(unsigned* p)              { return __hip_atomic_load(p, __ATOMIC_RELAXED, __HIP_MEMORY_SCOPE_AGENT); }
__device__ __forceinline__ unsigned xb_add(unsigned* p, unsigned v) { return __hip_atomic_fetch_add(p, v, __ATOMIC_RELAXED, __HIP_MEMORY_SCOPE_AGENT); }
__device__ __forceinline__ unsigned xb_xcc_id() { return (unsigned)__builtin_amdgcn_s_getreg((3 << 11) | 20) & 0xFu; }
#define XB_SPIN(cond, bar) do { unsigned _sp = 0; while (cond) { __builtin_amdgcn_s_sleep(1); \
    if ((++_sp & 255u) == 0u) { if (xb_ld(&(bar)[XB_TMO])) break; if (_sp > XB_SPIN_CAP) { atomicAdd(&(bar)[XB_TMO], 1u); break; } } } } while (0)
struct XcdBarrier { unsigned* bar; unsigned x; volatile LAS unsigned* st; };
__device__ __forceinline__ XcdBarrier xcd_barrier_post(unsigned* bar, volatile LAS unsigned* st) {
    XcdBarrier b; b.bar = bar; b.x = xb_xcc_id(); b.st = st;
    if (threadIdx.x == 0) (void)xb_add(&bar[XB_XCNT(b.x)], 1u);
    return b;
}
__device__ __forceinline__ void xcd_barrier_complete(unsigned* bar, unsigned x, unsigned& nloc, unsigned& nx) {
    const unsigned G = gridDim.x * gridDim.y * gridDim.z;
    unsigned sum, cnt, mine, sp = 0u;
    for (;;) {
        sum = 0u; cnt = 0u; mine = 0u;
#pragma unroll
        for (unsigned j = 0; j < 16; ++j) { const unsigned c = xb_ld(&bar[XB_XCNT(j)]); sum += c; cnt += (c > 0u) ? 1u : 0u; mine = (j == x) ? c : mine; }
        if (sum == G) break;
        __builtin_amdgcn_s_sleep(1);
        if ((++sp & 255u) == 0u) { if (xb_ld(&bar[XB_TMO])) break; if (sp > XB_SPIN_CAP) { atomicAdd(&bar[XB_TMO], 1u); break; } }
    }
    nloc = mine > 0u ? mine : 1u; nx = cnt > 0u ? cnt : 1u;
}
__device__ __forceinline__ void xcd_barrier(const XcdBarrier& b) {
    asm volatile("s_waitcnt vmcnt(0)" ::: "memory");
    __syncthreads();
    if (threadIdx.x == 0) {
        unsigned* bar = b.bar;
        __builtin_amdgcn_s_waitcnt(0);
        unsigned nloc = b.st[0], nx = b.st[1];
        if (nloc == 0u) { xcd_barrier_complete(bar, b.x, nloc, nx); b.st[0] = nloc; b.st[1] = nx; }
        const unsigned old = xb_add(&bar[XB_XSUB(b.x)], 1u);
        const unsigned gen = old / nloc;
        if (old + 1u == (gen + 1u) * nloc) {
            __builtin_amdgcn_fence(__ATOMIC_RELEASE, "agent");
            asm volatile("s_waitcnt vmcnt(0)" ::: "memory");
            const unsigned og = xb_add(&bar[XB_TOP], 1u);
            const unsigned tg = og / nx;
            if (og + 1u == (tg + 1u) * nx) xb_add(&bar[XB_TOPGEN], 1u);
            else XB_SPIN(xb_ld(&bar[XB_TOPGEN]) == tg, bar);
            __builtin_amdgcn_fence(__ATOMIC_ACQUIRE, "agent");
            xb_add(&bar[XB_XGEN(b.x)], 1u);
            asm volatile("s_waitcnt vmcnt(0)" ::: "memory");
        } else {
            XB_SPIN(xb_ld(&bar[XB_XGEN(b.x)]) == gen, bar);
            __builtin_amdgcn_fence(__ATOMIC_ACQUIRE, "agent");
            asm volatile("s_waitcnt vmcnt(0)" ::: "memory");
        }
    }
    __syncthreads();
}

constexpr int LDS_BYTES = LDS_GEMM_BYTES + 16;
constexpr int N_PHASES = 19;
constexpr int PPL = 9;
__global__ void __launch_bounds__(256, 2) k_run(Params P, int ph_lo, int ph_hi) {
    extern __shared__ __attribute__((aligned(16))) char lds[];
    volatile LAS unsigned* st = (volatile LAS unsigned*)(lds + LDS_GEMM_BYTES);
    if (threadIdx.x == 0) { st[0] = 0u; st[1] = 0u; }
    __syncthreads();
    XcdBarrier xb = xcd_barrier_post(P.w.bar, st);
#ifdef EXTRA_BARRIERS
    for (int i = 0; i < EXTRA_BARRIERS; ++i) xcd_barrier(xb);
#endif
    for (int ph = ph_lo; ph < ph_hi; ++ph) {
        if (ph > ph_lo) xcd_barrier(xb);
        int reps = 1;
#ifdef REP_PHASE
        if (ph == 0 ? (REP_PHASE == 0) : (((ph - 1) % PPL) == REP_PHASE - 1)) reps = 2;
        asm volatile("" : "+s"(reps));
#endif
        for (int rep = 0; rep < reps; ++rep) {
            const bool dry = rep + 1 < reps;
            if (rep > 0) xcd_barrier(xb);
            if (ph == 0) phase_prep(P, lds);
            else {
                const int L = (ph - 1) / PPL, s = (ph - 1) % PPL;
                switch (s) {
                    case 0: phase_zgemm(P, L, lds); break;
                    case 1: phase_mix(P, L, lds, rep, dry); break;
                    case 2: phase_attn(P, L, lds); break;
                    case 3: phase_oproj(P, L, lds, dry); break;
                    case 4: phase_router(P, L, lds, dry); break;
                    case 5: phase_moe_up(P, L, lds, dry); break;
                    case 6: phase_moe_down(P, L, lds, 0, dry); break;
                    case 7: phase_moe_down(P, L, lds, 1, dry); break;
                    case 8: phase_ple(P, L, lds, dry); break;
                }
            }
        }
    }
}
}
#ifndef MK_N_LAUNCHES
#define MK_N_LAUNCHES 1
#endif
extern "C" void kernel_launch(void* const* d_in, const int* in_sizes, int n_in, void* d_out, int out_size, void* d_ws, size_t ws_size,
                              hipStream_t stream) {
    nv::Inputs in{};
    in.x = (const float*)d_in[0]; in.p = (const float*)d_in[1]; in.positions = (const int*)d_in[2];
    const float** f = &in.mix_norm_g;
    for (int i = 0; i < 32; ++i) f[i] = (const float*)d_in[3 + i];
    size_t used = 0;
    fx::WS w = fx::make_ws((char*)d_ws, used);
    static int grid = 0;
    if (grid == 0) {
        if (n_in != 35 || out_size != fx::NT * 1024 || used > ws_size) { fprintf(stderr, "kernel_launch: unexpected shapes / workspace (need %zu, have %zu)\n", used, ws_size); grid = -1; return; }
        if (hipFuncSetAttribute((const void*)fx::k_run, hipFuncAttributeMaxDynamicSharedMemorySize, fx::LDS_BYTES) != hipSuccess) { fprintf(stderr, "hipFuncSetAttribute failed\n"); grid = -1; return; }
        int dev = 0, cus = 0, per_cu = 0;
        hipGetDevice(&dev); hipDeviceGetAttribute(&cus, hipDeviceAttributeMultiprocessorCount, dev);
        hipOccupancyMaxActiveBlocksPerMultiprocessor(&per_cu, (const void*)fx::k_run, 256, fx::LDS_BYTES);
        if (per_cu > 2) per_cu = 2;
        if (per_cu < 1) { fprintf(stderr, "occupancy query says %d blocks/CU\n", per_cu); grid = -1; return; }
        grid = cus * per_cu;
    }
    if (grid < 0) return;
    fx::Params P{}; P.in = in; P.h = (float*)d_out; P.w = w;
    hipMemsetAsync(w.cnt, 0, 2 * 256 * 4, stream);
    hipMemsetAsync(w.bar, 0, XCD_BAR_WORDS * 4, stream);
    if (MK_N_LAUNCHES == 1) hipLaunchKernelGGL(fx::k_run, dim3(grid), dim3(256), fx::LDS_BYTES, stream, P, 0, fx::N_PHASES);
    else for (int ph = 0; ph < fx::N_PHASES; ++ph) hipLaunchKernelGGL(fx::k_run, dim3(grid), dim3(256), fx::LDS_BYTES, stream, P, ph, ph + 1);
}
```

```cpp
#include <hip/hip_runtime.h>
#include <hip/hip_bf16.h>
#include <stdint.h>
#include <cstdio>
namespace nv {
struct Inputs {
    const float *x, *p; const int* positions;
    const float *mix_norm_g, *w_in, *sgu_ln_g, *sgu_ln_b, *sgu_w, *sgu_b, *conv_w, *conv_b, *conv_ln_g, *conv_ln_b, *conv_pw_w, *conv_pw_b,
        *q_a_norm_g, *w_uq, *kv_a_norm_g, *w_ukv, *q_norm_g, *k_norm_g, *branch_norm_g, *w_o, *ffn_norm_g, *router_group_w, *router_group_b,
        *router_expert_w, *router_expert_b, *moe_w_gate, *moe_w_up, *moe_w_down, *ple_norm_g, *ple_gate_w, *ple_proj_w, *ple_post_norm_g;
};
}
namespace fx {

typedef unsigned short bf16_t;
typedef short bf16x8 __attribute__((ext_vector_type(8)));
typedef float f32x16 __attribute__((ext_vector_type(16)));
typedef float f32x4 __attribute__((ext_vector_type(4)));

constexpr int NT = 16384, SEQ = 2048, DM = 1024, NB = 8;
constexpr int ZN = 1536;
constexpr float EPS = 1e-6f;

typedef __bf16 bf16v2_t __attribute__((ext_vector_type(2)));
typedef float f32v2_t __attribute__((ext_vector_type(2)));
__device__ __forceinline__ unsigned pack2(float lo, float hi) {
    f32v2_t v; v.x = lo; v.y = hi;
    bf16v2_t b = __builtin_convertvector(v, bf16v2_t);
    return __builtin_bit_cast(unsigned, b);
}
__device__ __forceinline__ unsigned f2bf(float f) { return pack2(f, 0.f) & 0xffffu; }
__device__ __forceinline__ float bf2f(unsigned short b) { return __uint_as_float(((unsigned)b) << 16); }
__device__ __forceinline__ float bflo(unsigned u) { return __uint_as_float(u << 16); }
__device__ __forceinline__ float bfhi(unsigned u) { return __uint_as_float(u & 0xffff0000u); }
__device__ __forceinline__ float sigmoid_(float x) { return __builtin_amdgcn_rcpf(1.f + __builtin_amdgcn_exp2f(-1.4426950408889634f * x)); }
__device__ __forceinline__ float rsq_(float x) { return __builtin_amdgcn_rsqf(x); }
__device__ __forceinline__ float gelu_tanh_(float x) {
    float u = 0.7978845608028654f * (x + 0.044715f * x * x * x);
    return x * sigmoid_(2.f * u);
}
__device__ __forceinline__ int opaque_tid() { int t = threadIdx.x; asm volatile("" : "+v"(t)); return t; }
template <int CTRL> __device__ __forceinline__ float dpp_mov(float v) {
    return __builtin_bit_cast(float, __builtin_amdgcn_update_dpp(0, __builtin_bit_cast(int, v), CTRL, 0xf, 0xf, false));
}
__device__ __forceinline__ void swap16(float& a, float& b) { asm volatile("s_nop 1\n\tv_permlane16_swap_b32 %0, %1" : "+v"(a), "+v"(b)); }
__device__ __forceinline__ void swap32(float& a, float& b) { asm volatile("s_nop 1\n\tv_permlane32_swap_b32 %0, %1" : "+v"(a), "+v"(b)); }
__device__ __forceinline__ float swap16_sum(float v) { float a = v, b = v; swap16(a, b); return a + b; }
__device__ __forceinline__ float swap32_sum(float v) { float a = v, b = v; swap32(a, b); return a + b; }
__device__ __forceinline__ float swap32_max(float v) { float a = v, b = v; swap32(a, b); return fmaxf(a, b); }
__device__ __forceinline__ float grp_sum16(float v) { v += dpp_mov<0xB1>(v); v += dpp_mov<0x4E>(v); v += dpp_mov<0x124>(v); v += dpp_mov<0x128>(v); return v; }
__device__ __forceinline__ float grp_sum32(float v) { return swap16_sum(grp_sum16(v)); }
__device__ __forceinline__ float wave_sum64(float v) { return swap32_sum(grp_sum32(v)); }
__device__ __forceinline__ float grp_sum4(float v) { v += dpp_mov<0xB1>(v); v += dpp_mov<0x4E>(v); return v; }
__device__ __forceinline__ float grp_sum8(float v) { v = grp_sum4(v); v += dpp_mov<0x141>(v); return v; }
__device__ __forceinline__ float quad_x2(float v) { return dpp_mov<0x4E>(v); }
__device__ __forceinline__ float xor8(float v) { return dpp_mov<0x128>(v); }
__device__ __forceinline__ float xor32(float v) { return swap32_sum(v); }

struct WS {
    bf16_t *W1t, *Wuqt, *Wukvt, *Wpwt, *Wot, *Wrt, *Wgut, *Wdt, *Wgt, *Wpt, *Wsm;
    bf16_t *hb;
    bf16_t *hb1;
    bf16_t *ub;
    bf16_t *vT;
    bf16_t *ygb;
    bf16_t *cqb;
    bf16_t *ckvb;
    bf16_t *kpeb;
    bf16_t *Qb;
    bf16_t *Knb;
    bf16_t *VTb;
    bf16_t *yb;
    float  *ssq;
    float  *rssA;
    float  *rssB;
    float  *cqss;
    float  *cs;
    bf16_t *erb;
    float  *essq;
    bf16_t *hbuf;
    int    *cnt;
    int    *elist;
    float  *ewt;
    unsigned *bar;
};
constexpr size_t W1_SZ = (size_t)ZN * 1024, WUQ_SZ = 768 * 256, WUKV_SZ = 1024 * 128, WPW_SZ = 256 * 256, WO_SZ = 1024 * 1024, WR_SZ = 128 * 1024,
                 WGU_SZ = (size_t)32 * 512 * 1024, WD_SZ = (size_t)32 * 1024 * 256, WG_SZ = 1024 * 1024, WP_SZ = 1024 * 256, WSM_SZ = 4 * 128 * 128;

struct Params {
    nv::Inputs in;
    float* h;
    WS w;
};

static WS make_ws(char* base, size_t& used) {
    WS w{}; size_t o = 0;
    auto take = [&](size_t bytes) { char* p = base + o; o += (bytes + 255) & ~(size_t)255; return p; };
    w.W1t = (bf16_t*)take(2 * W1_SZ * 2);   w.Wuqt = (bf16_t*)take(2 * WUQ_SZ * 2); w.Wukvt = (bf16_t*)take(2 * WUKV_SZ * 2);
    w.Wpwt = (bf16_t*)take(2 * WPW_SZ * 2); w.Wot = (bf16_t*)take(2 * WO_SZ * 2);   w.Wrt = (bf16_t*)take(2 * WR_SZ * 2);
    w.Wgut = (bf16_t*)take(2 * WGU_SZ * 2); w.Wdt = (bf16_t*)take(2 * WD_SZ * 2);   w.Wgt = (bf16_t*)take(2 * WG_SZ * 2);
    w.Wpt = (bf16_t*)take(2 * WP_SZ * 2);   w.Wsm = (bf16_t*)take(2 * WSM_SZ * 2);
    w.hb = (bf16_t*)take((size_t)NT * 1024 * 2); w.hb1 = (bf16_t*)take((size_t)NT * 1024 * 2);
    w.ssq = (float*)take((size_t)NT * 16 * 4); w.cs = (float*)take((size_t)NT * 32 * 4);
    w.rssA = (float*)take((size_t)NT * 8 * 4); w.rssB = (float*)take((size_t)NT * 8 * 4); w.cqss = (float*)take((size_t)NT * 4 * 4);
    w.essq = (float*)take((size_t)NT * 8 * 4);
    w.cnt = (int*)take(2 * 256 * 4);
    w.elist = (int*)take((size_t)64 * NT * 4); w.ewt = (float*)take((size_t)64 * NT * 4);
    w.bar = (unsigned*)take(4096 * 4);
    const size_t region = o;
    w.ub = (bf16_t*)take((size_t)NT * 256 * 2); w.vT = (bf16_t*)take((size_t)NT * 256 * 2); w.ygb = (bf16_t*)take((size_t)NT * 256 * 2);
    w.cqb = (bf16_t*)take((size_t)NT * 256 * 2); w.ckvb = (bf16_t*)take((size_t)NT * 128 * 2); w.kpeb = (bf16_t*)take((size_t)NT * 32 * 2);
    w.Qb = (bf16_t*)take((size_t)NT * 768 * 2); w.Knb = (bf16_t*)take((size_t)NT * 512 * 2); w.VTb = (bf16_t*)take((size_t)NT * 512 * 2);
    w.yb = (bf16_t*)take((size_t)NT * 1024 * 2);
    const size_t region_end = o;
    o = region;
    w.hbuf = (bf16_t*)take((size_t)(2 * NT + 128) * 256 * 2);
    w.erb = (bf16_t*)take((size_t)NT * 1024 * 2);
    if (o > region_end) { fprintf(stderr, "make_ws: overlay exceeds mixer region\n"); }
    o = region_end;
    used = o;
    return w;
}

__device__ const double ROPE_INV[16] = {1.0, 0.5623413251903491, 0.31622776601683794, 0.1778279410038923, 0.1, 0.05623413251903491, 0.03162277660168379, 0.01778279410038923, 0.01, 0.005623413251903491, 0.0031622776601683794, 0.0017782794100389228, 0.001, 0.0005623413251903491, 0.00031622776601683794, 0.00017782794100389227};
__device__ __forceinline__ void rope_cs(int pos, int j, float& c, float& s) {
    const double ang = (double)pos * ROPE_INV[j];
    const double n = rint(ang * 0.15915494309189535);
    double r = fma(-n, 6.283185307179586, ang); r = fma(-n, 2.4492935982947064e-16, r);
    const double r2 = r * r;
    double sc = 1.0, ss = 1.0;
    double tc = 1.0, ts = 1.0;
#pragma unroll
    for (int k = 1; k <= 14; ++k) {
        tc *= -r2 / (double)((2 * k - 1) * (2 * k)); sc += tc;
        ts *= -r2 / (double)((2 * k) * (2 * k + 1)); ss += ts;
    }
    c = (float)sc; s = (float)(ss * r);
}

enum { MAP_ID = 0, MAP_W1 = 1, MAP_UQ = 2, MAP_UKV = 3, MAP_GATE = 4, MAP_UP = 5 };
template <int MAP> __device__ __forceinline__ int dstrow(int c) {
    if (MAP == MAP_W1) {
        if (c < 512) return c;
        if (c < 768) return 512 + 2 * (c - 512);
        if (c < 1024) return 513 + 2 * (c - 768);
        return c;
    } else if (MAP == MAP_UQ) {
        const int h = c / 96, d = c - h * 96; return d < 64 ? h * 64 + d : 512 + h * 32 + d - 64;
    } else if (MAP == MAP_UKV) {
        const int h = c >> 7, d = c & 127; return d < 64 ? h * 64 + d : 512 + h * 64 + d - 64;
    } else if (MAP == MAP_GATE) return 2 * c;
    else if (MAP == MAP_UP) return 2 * c + 1;
    return c;
}
#define PREP_LOAD(V0, V1, V2, V3, SRC, K0, C0) do { \
    const int kk_ = tid >> 4, c4_ = (tid & 15) * 4; \
    const float* p_ = (C0) + c4_ < Nsrc ? (SRC) + (size_t)((K0) + kk_) * ld + (C0) + c4_ : (SRC) + (size_t)((K0) + kk_) * ld; \
    { const f32x4* q_ = (const f32x4*)p_; const f32x4 t0_ = __builtin_nontemporal_load(q_), t1_ = __builtin_nontemporal_load(q_ + (size_t)4 * ld), t2_ = __builtin_nontemporal_load(q_ + (size_t)8 * ld), t3_ = __builtin_nontemporal_load(q_ + (size_t)12 * ld); \
      V0 = make_float4(t0_[0], t0_[1], t0_[2], t0_[3]); V1 = make_float4(t1_[0], t1_[1], t1_[2], t1_[3]); V2 = make_float4(t2_[0], t2_[1], t2_[2], t2_[3]); V3 = make_float4(t3_[0], t3_[1], t3_[2], t3_[3]); } } while (0)
__device__ __forceinline__ void prep_put(float* tile, int kk, int c4, const float4& v, float sc) {
    float* t = tile + kk * 65 + c4; t[0] = v.x * sc; t[1] = v.y * sc; t[2] = v.z * sc; t[3] = v.w * sc;
}
template <int MAP>
__device__ void prep_job(const float* src, int ld, int Nsrc, size_t src_stride, const float* scale, bf16_t* dst, size_t dst_stride, int K, int nbatch, float* tiles, int& rot, const int tid, const int bi, const int G) {
    const int tn = (Nsrc + 63) / 64, tk = K / 64, per = tn * tk, total = per * nbatch;
    int t = (bi - rot + G) % G, buf = 0;
    float4 a0 = make_float4(0.f, 0.f, 0.f, 0.f), a1 = a0, a2 = a0, a3 = a0, b0 = a0, b1 = a0, b2 = a0, b3 = a0;
    if (t < total) { const int e = t / per, tt = t % per; PREP_LOAD(a0, a1, a2, a3, src + (size_t)e * src_stride, (tt / tn) * 64, (tt % tn) * 64); }
    for (; t < total; t += G) {
        const int e = t / per, tt = t % per, k0 = (tt / tn) * 64, c0 = (tt % tn) * 64;
        const int t2 = t + G;
        if (t2 < total) { const int e2 = t2 / per, tt2 = t2 % per; PREP_LOAD(b0, b1, b2, b3, src + (size_t)e2 * src_stride, (tt2 / tn) * 64, (tt2 % tn) * 64); }
        float* tile = tiles + buf * (64 * 65);
        {
            const int kk = tid >> 4, c4 = (tid & 15) * 4;
            const float s0 = scale ? scale[k0 + kk] : 1.f, s1 = scale ? scale[k0 + kk + 16] : 1.f, s2 = scale ? scale[k0 + kk + 32] : 1.f, s3 = scale ? scale[k0 + kk + 48] : 1.f;
            prep_put(tile, kk, c4, a0, s0); prep_put(tile, kk + 16, c4, a1, s1); prep_put(tile, kk + 32, c4, a2, s2); prep_put(tile, kk + 48, c4, a3, s3);
        }
        __syncthreads();
        bf16_t* d = dst + (size_t)e * dst_stride;
#pragma unroll
        for (int i = 0; i < 2; ++i) {
            const int idx = tid + 256 * i, c = idx >> 3, kc = idx & 7;
            if (c0 + c < Nsrc) {
                const float* q = tile + (kc * 8) * 65 + c;
                uint4 pk;
                pk.x = pack2(q[0], q[65]); pk.y = pack2(q[130], q[195]); pk.z = pack2(q[260], q[325]); pk.w = pack2(q[390], q[455]);
                *(uint4*)(d + (size_t)dstrow<MAP>(c0 + c) * K + k0 + kc * 8) = pk;
            }
        }
        a0 = b0; a1 = b1; a2 = b2; a3 = b3; buf ^= 1;
    }
    __syncthreads();
    rot = (rot + total) % G;
}

__device__ void phase_prep(const Params& P, char* lds) {
    float* tile = (float*)lds;
    const nv::Inputs& in = P.in; const WS& w = P.w;
    const int G = gridDim.x, bid = blockIdx.x, tid = opaque_tid();
    int rot = 0;
    for (int L = 0; L < 2; ++L) {
        if (L == 0) {
        prep_job<MAP_GATE>(in.moe_w_gate + (size_t)L * 32 * 1024 * 256, 256, 256, (size_t)1024 * 256, in.ffn_norm_g + L * 1024, w.Wgut + L * WGU_SZ, (size_t)512 * 1024, 1024, 32, tile, rot, tid, bid, G);
        prep_job<MAP_UP>(in.moe_w_up + (size_t)L * 32 * 1024 * 256, 256, 256, (size_t)1024 * 256, in.ffn_norm_g + L * 1024, w.Wgut + L * WGU_SZ, (size_t)512 * 1024, 1024, 32, tile, rot, tid, bid, G);
        prep_job<MAP_ID>(in.moe_w_down + (size_t)L * 32 * 256 * 1024, 1024, 1024, (size_t)256 * 1024, nullptr, w.Wdt + L * WD_SZ, (size_t)1024 * 256, 256, 32, tile, rot, tid, bid, G);
        }
        prep_job<MAP_W1>(in.w_in + (size_t)L * 1024 * 1440, 1440, 1440, 0, in.mix_norm_g + L * 1024, w.W1t + L * W1_SZ, 0, 1024, 1, tile, rot, tid, bid, G);
        prep_job<MAP_UQ>(in.w_uq + (size_t)L * 256 * 768, 768, 768, 0, in.q_a_norm_g + L * 256, w.Wuqt + L * WUQ_SZ, 0, 256, 1, tile, rot, tid, bid, G);
        prep_job<MAP_UKV>(in.w_ukv + (size_t)L * 128 * 1024, 1024, 1024, 0, in.kv_a_norm_g + L * 128, w.Wukvt + L * WUKV_SZ, 0, 128, 1, tile, rot, tid, bid, G);
        prep_job<MAP_ID>(in.conv_pw_w + (size_t)L * 256 * 256, 256, 256, 0, nullptr, w.Wpwt + L * WPW_SZ, 0, 256, 1, tile, rot, tid, bid, G);
        prep_job<MAP_ID>(in.w_o + (size_t)L * 1024 * 1024, 1024, 1024, 0, in.branch_norm_g + L * 1024, w.Wot + L * WO_SZ, 0, 1024, 1, tile, rot, tid, bid, G);
        prep_job<MAP_ID>(in.ple_gate_w + (size_t)L * 1024 * 1024, 1024, 1024, 0, in.ple_norm_g + L * 1024, w.Wgt + L * WG_SZ, 0, 1024, 1, tile, rot, tid, bid, G);
        prep_job<MAP_ID>(in.ple_proj_w + (size_t)L * 256 * 1024, 1024, 1024, 0, nullptr, w.Wpt + L * WP_SZ, 0, 256, 1, tile, rot, tid, bid, G);
        for (int i = bid * 256 + tid; i < 96 * 1024 / 8; i += G * 256) *(uint4*)(w.W1t + L * W1_SZ + (size_t)1440 * 1024 + (size_t)i * 8) = make_uint4(0u, 0u, 0u, 0u);
        for (int i = bid * 256 + tid; i < 128 * 1024; i += G * 256) {
            int n = i >> 10, k = i & 1023; float v = 0.f;
            if (n < 4) v = in.router_group_w[(size_t)L * 1024 * 4 + k * 4 + n];
            else if (n < 36) v = in.router_expert_w[(size_t)L * 1024 * 32 + k * 32 + (n - 4)];
            v *= in.ffn_norm_g[L * 1024 + k];
            w.Wrt[L * WR_SZ + i] = (bf16_t)f2bf(v);
        }
        for (int i = bid * 256 + tid; i < 4 * 128 * 128; i += G * 256) {
            int jj = i & 127, ii = (i >> 7) & 127;
            float v = (jj <= ii) ? in.sgu_w[(size_t)L * WSM_SZ + i] : 0.f;
            w.Wsm[L * WSM_SZ + i] = (bf16_t)f2bf(v);
        }
    }
    for (int i = bid * 256 + tid; i < NT * 16; i += G * 256) {
        int t = i >> 4, j = i & 15;
        float c, sn; rope_cs(in.positions[t], j, c, sn);
        w.cs[t * 32 + j] = c; w.cs[t * 32 + 16 + j] = sn;
    }
    for (int row = bid * 4 + (tid >> 6); row < NT; row += G * 4) {
        const int lane = tid & 63;
        float ss = 0.f;
#pragma unroll
        for (int j = 0; j < 4; ++j) {
            const size_t i = (size_t)row * 256 + j * 64 + lane;
            const float4 v = ((const float4*)in.x)[i];
            uint2 pk; pk.x = pack2(v.x, v.y); pk.y = pack2(v.z, v.w);
            ((uint2*)w.hb)[i] = pk;
            ss += v.x * v.x + v.y * v.y + v.z * v.z + v.w * v.w;
        }
        ss = wave_sum64(ss);
        if (lane < 8) w.rssA[(size_t)row * 8 + lane] = lane == 0 ? ss : 0.f;
    }
}

__device__ void prep_moe_late(const Params& P, int part, char* lds, const int tid, const int bi, const int nb) {
    float* tile = (float*)lds;
    const nv::Inputs& in = P.in; const WS& w = P.w;
    int rot = 0; const int L = 1;
    const float* up = in.moe_w_up + (size_t)L * 32 * 1024 * 256;
    if (part == 0) {
        prep_job<MAP_GATE>(in.moe_w_gate + (size_t)L * 32 * 1024 * 256, 256, 256, (size_t)1024 * 256, in.ffn_norm_g + L * 1024, w.Wgut + L * WGU_SZ, (size_t)512 * 1024, 1024, 32, tile, rot, tid, bi, nb);
        prep_job<MAP_UP>(up, 256, 256, (size_t)1024 * 256, in.ffn_norm_g + L * 1024, w.Wgut + L * WGU_SZ, (size_t)512 * 1024, 1024, 16, tile, rot, tid, bi, nb);
    } else {
        prep_job<MAP_UP>(up + (size_t)16 * 1024 * 256, 256, 256, (size_t)1024 * 256, in.ffn_norm_g + L * 1024, w.Wgut + L * WGU_SZ + (size_t)16 * 512 * 1024, (size_t)512 * 1024, 1024, 16, tile, rot, tid, bi, nb);
        prep_job<MAP_ID>(in.moe_w_down + (size_t)L * 32 * 256 * 1024, 1024, 1024, (size_t)256 * 1024, nullptr, w.Wdt + L * WD_SZ, (size_t)1024 * 256, 256, 32, tile, rot, tid, bi, nb);
    }
    __syncthreads();
}

__device__ __forceinline__ int lds_off(int row, int chunk) { return row * 128 + ((chunk ^ ((row >> 1) & 7)) << 4); }

template <typename AT> struct ARaw;
template <> struct ARaw<bf16_t> { uint4 v[4]; };
template <> struct ARaw<float> { float4 v[4][2]; };

__device__ __forceinline__ void a_load(ARaw<bf16_t>& r, const bf16_t* const (&rowp)[4], int koff) {
#pragma unroll
    for (int i = 0; i < 4; ++i) r.v[i] = *(const uint4*)(rowp[i] + koff);
}
__device__ __forceinline__ void a_load(ARaw<float>& r, const float* const (&rowp)[4], int koff) {
#pragma unroll
    for (int i = 0; i < 4; ++i) { r.v[i][0] = *(const float4*)(rowp[i] + koff); r.v[i][1] = *(const float4*)(rowp[i] + koff + 4); }
}
template <bool SUMSQ> __device__ __forceinline__ uint4 a_cvt(const uint4& v, float& ss) {
    if (SUMSQ) {
        float a;
        a = bflo(v.x); ss = fmaf(a, a, ss); a = bfhi(v.x); ss = fmaf(a, a, ss);
        a = bflo(v.y); ss = fmaf(a, a, ss); a = bfhi(v.y); ss = fmaf(a, a, ss);
        a = bflo(v.z); ss = fmaf(a, a, ss); a = bfhi(v.z); ss = fmaf(a, a, ss);
        a = bflo(v.w); ss = fmaf(a, a, ss); a = bfhi(v.w); ss = fmaf(a, a, ss);
    }
    return v;
}
template <bool SUMSQ> __device__ __forceinline__ void a_store(const ARaw<bf16_t>& r, char* ldsA, int tid, float (&ss)[4]) {
#pragma unroll
    for (int i = 0; i < 4; ++i) { uint4 v = a_cvt<SUMSQ>(r.v[i], ss[i]); *(uint4*)(ldsA + lds_off((tid >> 3) + 32 * i, tid & 7)) = v; }
}
template <bool SUMSQ> __device__ __forceinline__ void a_store(const ARaw<float>& r, char* ldsA, int tid, float (&ss)[4]) {
#pragma unroll
    for (int i = 0; i < 4; ++i) {
        const float4 a = r.v[i][0], b = r.v[i][1];
        if (SUMSQ) ss[i] += a.x * a.x + a.y * a.y + a.z * a.z + a.w * a.w + b.x * b.x + b.y * b.y + b.z * b.z + b.w * b.w;
        uint4 v; v.x = pack2(a.x, a.y); v.y = pack2(a.z, a.w); v.z = pack2(b.x, b.y); v.w = pack2(b.z, b.w);
        *(uint4*)(ldsA + lds_off((tid >> 3) + 32 * i, tid & 7)) = v;
    }
}

struct bf16x3_t {};
template <> struct ARaw<bf16x3_t> { uint4 a[4], b[4], c[4]; };
struct Rows3 { const bf16_t* p[2][4]; };
__device__ __forceinline__ void a_load(ARaw<bf16x3_t>& r, const Rows3& rows, int koff) {
#pragma unroll
    for (int i = 0; i < 4; ++i) { r.a[i] = *(const uint4*)(rows.p[0][i] + koff); r.b[i] = *(const uint4*)(rows.p[1][i] + koff); r.c[i] = *(const uint4*)(rows.p[1][i] + koff + 1024); }
}
__device__ __forceinline__ unsigned add3pk(unsigned a, unsigned b, unsigned c, float& ss) {
    const float lo = bflo(a) + bflo(b) + bflo(c), hi = bfhi(a) + bfhi(b) + bfhi(c);
    ss = fmaf(lo, lo, ss); ss = fmaf(hi, hi, ss);
    return pack2(lo, hi);
}
template <bool SUMSQ> __device__ __forceinline__ void a_store(const ARaw<bf16x3_t>& r, char* ldsA, int tid, float (&ss)[4]) {
#pragma unroll
    for (int i = 0; i < 4; ++i) {
        uint4 v;
        v.x = add3pk(r.a[i].x, r.b[i].x, r.c[i].x, ss[i]); v.y = add3pk(r.a[i].y, r.b[i].y, r.c[i].y, ss[i]);
        v.z = add3pk(r.a[i].z, r.b[i].z, r.c[i].z, ss[i]); v.w = add3pk(r.a[i].w, r.b[i].w, r.c[i].w, ss[i]);
        *(uint4*)(ldsA + lds_off((tid >> 3) + 32 * i, tid & 7)) = v;
    }
}

template <typename AT, bool SUMSQ, int SUNROLL = 4, typename AROWS>
__device__ __forceinline__ void gemm_mainloop(f32x16 (&acc)[2][2], const AROWS& arow, const bf16_t* const (&wrow)[4], int nkt, char* lds, float (&ss)[4], const int tid) {
    const int lane = tid & 63, wid = tid >> 6, wr = wid >> 1, wc = wid & 1;
    ARaw<AT> ra; ARaw<bf16_t> rb; float dummy[4] = {0.f, 0.f, 0.f, 0.f};
    a_load(ra, arow, 0); a_load(rb, wrow, 0);
    a_store<SUMSQ>(ra, lds, tid, ss); a_store<false>(rb, lds + 16384, tid, dummy);
    __syncthreads();
    const int fr = lane & 31, fh = lane >> 5;
#pragma unroll 1
    for (int kt = 0; kt < nkt; ++kt) {
        char* cur = lds + (kt & 1) * 32768;
        char* nxt = lds + ((kt + 1) & 1) * 32768;
        const bool more = (kt + 1 < nkt);
        if (more) { a_load(ra, arow, (kt + 1) * 64); a_load(rb, wrow, (kt + 1) * 64); }
#pragma unroll SUNROLL
        for (int s = 0; s < 4; ++s) {
            bf16x8 xa[2], wb[2];
#pragma unroll
            for (int i = 0; i < 2; ++i) xa[i] = *(const bf16x8*)(cur + lds_off(wr * 64 + i * 32 + fr, 2 * s + fh));
#pragma unroll
            for (int j = 0; j < 2; ++j) wb[j] = *(const bf16x8*)(cur + 16384 + lds_off(wc * 64 + j * 32 + fr, 2 * s + fh));
#pragma unroll
            for (int i = 0; i < 2; ++i)
#pragma unroll
                for (int j = 0; j < 2; ++j) acc[i][j] = __builtin_amdgcn_mfma_f32_32x32x16_bf16(wb[j], xa[i], acc[i][j], 0, 0, 0);
        }
        if (more) { a_store<SUMSQ>(ra, nxt, tid, ss); a_store<false>(rb, nxt + 16384, tid, dummy); }
        __syncthreads();
    }
}
constexpr int GST = 16384;
__device__ __forceinline__ int gl_chunk(int tid) { return (tid & 3) ^ ((tid >> 4) & 3); }
__device__ __forceinline__ int gl_off(int row, int chunk) { return row * 64 + ((chunk ^ ((row >> 2) & 3)) << 4); }
typedef __attribute__((address_space(3))) unsigned lds_u32_t;
__device__ __forceinline__ void glds16(const bf16_t* g, char* l) {
    __builtin_amdgcn_global_load_lds((const unsigned*)g, (lds_u32_t*)l, 16, 0, 0);
}
#define RAW_BARRIER() do { asm volatile("s_waitcnt lgkmcnt(0)" ::: "memory"); __builtin_amdgcn_s_barrier(); } while (0)
template <bool SEG = false>
__device__ __forceinline__ void gemm_mainloop_g(f32x16 (&acc)[2][2], const bf16_t* const (&arow)[2], const bf16_t* const (&wrow)[2], const int nkt, char* lds, const int tid,
                                                const int rot = 0, const int kt1 = -1, const float* f1 = nullptr, const int kt2 = -1, const float* f2 = nullptr) {
    const int lane = tid & 63, wid = tid >> 6, wr = wid >> 1, wc = wid & 1, fr = lane & 31, fh = lane >> 5;
    const int wbase = __builtin_amdgcn_readfirstlane(wid) * 1024;
#pragma unroll 1
    for (int p = 0; p < 3; ++p) if (p < nkt) {
        char* st = lds + p * GST + wbase;
        const int ko = SEG ? ((p + rot) & (nkt - 1)) * 32 : p * 32;
        glds16(arow[0] + ko, st); glds16(arow[1] + ko, st + 4096);
        glds16(wrow[0] + ko, st + 8192); glds16(wrow[1] + ko, st + 8192 + 4096);
    }
    const int ra0 = gl_off(wr * 64 + fr, fh), ra1 = gl_off(wr * 64 + 32 + fr, fh);
    const int rb0 = 8192 + gl_off(wc * 64 + fr, fh), rb1 = 8192 + gl_off(wc * 64 + 32 + fr, fh);
#pragma unroll 1
    for (int kt = 0; kt < nkt; ++kt) {
        if (kt + 2 < nkt) asm volatile("s_waitcnt vmcnt(8)" ::: "memory");
        else if (kt + 1 < nkt) asm volatile("s_waitcnt vmcnt(4)" ::: "memory");
        else asm volatile("s_waitcnt vmcnt(0)" ::: "memory");
        RAW_BARRIER();
        if (kt + 3 < nkt) {
            char* st = lds + ((kt + 3) & 3) * GST + wbase;
            const int ko = SEG ? ((kt + 3 + rot) & (nkt - 1)) * 32 : (kt + 3) * 32;
            glds16(arow[0] + ko, st); glds16(arow[1] + ko, st + 4096);
            glds16(wrow[0] + ko, st + 8192); glds16(wrow[1] + ko, st + 8192 + 4096);
        }
        const char* cur = lds + (kt & 3) * GST;
        if (SEG && (kt == kt1 || kt == kt2)) {
            const float* f = kt == kt1 ? f1 : f2;
#pragma unroll
            for (int i = 0; i < 2; ++i) {
                const float v = f[wr * 64 + i * 32 + fr];
#pragma unroll
                for (int j = 0; j < 2; ++j)
#pragma unroll
                    for (int r = 0; r < 16; ++r) acc[i][j][r] *= v;
            }
        }
        bf16x8 xa[2][2], wb[2][2];
#pragma unroll
        for (int s2 = 0; s2 < 2; ++s2) {
            xa[s2][0] = *(const bf16x8*)(cur + (ra0 ^ (s2 << 5))); xa[s2][1] = *(const bf16x8*)(cur + (ra1 ^ (s2 << 5)));
            wb[s2][0] = *(const bf16x8*)(cur + (rb0 ^ (s2 << 5))); wb[s2][1] = *(const bf16x8*)(cur + (rb1 ^ (s2 << 5)));
        }
        __builtin_amdgcn_sched_barrier(0);
#pragma unroll
        for (int s2 = 0; s2 < 2; ++s2) {
            acc[0][0] = __builtin_amdgcn_mfma_f32_32x32x16_bf16(wb[s2][0], xa[s2][0], acc[0][0], 0, 0, 0);
            acc[0][1] = __builtin_amdgcn_mfma_f32_32x32x16_bf16(wb[s2][1], xa[s2][0], acc[0][1], 0, 0, 0);
            acc[1][0] = __builtin_amdgcn_mfma_f32_32x32x16_bf16(wb[s2][0], xa[s2][1], acc[1][0], 0, 0, 0);
            acc[1][1] = __builtin_amdgcn_mfma_f32_32x32x16_bf16(wb[s2][1], xa[s2][1], acc[1][1], 0, 0, 0);
        }
    }
    RAW_BARRIER();
}
__device__ __forceinline__ int g64_chunk(int tid) { return (tid & 7) ^ ((tid >> 4) & 7); }
template <bool SEG = false>
__device__ __forceinline__ void gemm_mainloop_g64(f32x16 (&acc)[2][2], const bf16_t* const (&arow)[4], const bf16_t* const (&wrow)[4], const int nkt, char* lds, const int tid,
                                                  const int rot = 0, const int kt1 = -1, const float* f1 = nullptr, const int kt2 = -1, const float* f2 = nullptr) {
    const int lane = tid & 63, wid = tid >> 6, wr = wid >> 1, wc = wid & 1, fr = lane & 31, fh = lane >> 5;
    const int wbase = __builtin_amdgcn_readfirstlane(wid) * 1024;
    {
        char* st = lds + wbase;
        const int ko0 = SEG ? (rot & (nkt - 1)) * 64 : 0;
#pragma unroll
        for (int i = 0; i < 4; ++i) { glds16(arow[i] + ko0, st + i * 4096); glds16(wrow[i] + ko0, st + 16384 + i * 4096); }
    }
#pragma unroll 1
    for (int kt = 0; kt < nkt; ++kt) {
        asm volatile("s_waitcnt vmcnt(0)" ::: "memory");
        RAW_BARRIER();
        if (kt + 1 < nkt) {
            char* st = lds + ((kt + 1) & 1) * 32768 + wbase;
            const int ko = SEG ? ((kt + 1 + rot) & (nkt - 1)) * 64 : (kt + 1) * 64;
#pragma unroll
            for (int i = 0; i < 4; ++i) { glds16(arow[i] + ko, st + i * 4096); glds16(wrow[i] + ko, st + 16384 + i * 4096); }
        }
        const char* cur = lds + (kt & 1) * 32768;
        if (SEG && (kt == kt1 || kt == kt2)) {
            const float* f = kt == kt1 ? f1 : f2;
#pragma unroll
            for (int i = 0; i < 2; ++i) {
                const float v = f[wr * 64 + i * 32 + fr];
#pragma unroll
                for (int j = 0; j < 2; ++j)
#pragma unroll
                    for (int r = 0; r < 16; ++r) acc[i][j][r] *= v;
            }
        }
#pragma unroll
        for (int s = 0; s < 4; ++s) {
            bf16x8 xa[2], wb[2];
#pragma unroll
            for (int i = 0; i < 2; ++i) xa[i] = *(const bf16x8*)(cur + lds_off(wr * 64 + i * 32 + fr, 2 * s + fh));
#pragma unroll
            for (int j = 0; j < 2; ++j) wb[j] = *(const bf16x8*)(cur + 16384 + lds_off(wc * 64 + j * 32 + fr, 2 * s + fh));
#pragma unroll
            for (int i = 0; i < 2; ++i)
#pragma unroll
                for (int j = 0; j < 2; ++j) acc[i][j] = __builtin_amdgcn_mfma_f32_32x32x16_bf16(wb[j], xa[i], acc[i][j], 0, 0, 0);
        }
    }
    RAW_BARRIER();
}
__device__ __forceinline__ void acc_zero(f32x16 (&acc)[2][2]) {
#pragma unroll
    for (int i = 0; i < 2; ++i)
#pragma unroll
        for (int j = 0; j < 2; ++j)
#pragma unroll
            for (int r = 0; r < 16; ++r) acc[i][j][r] = 0.f;
}
__device__ __forceinline__ void publish_rowstat(float (&ss)[4], float* stat, float invK, bool as_rstd, const int tid) {
#pragma unroll
    for (int i = 0; i < 4; ++i) {
        float v = ss[i];
        v += __shfl_xor(v, 1); v += __shfl_xor(v, 2); v += __shfl_xor(v, 4);
        if ((tid & 7) == 0) stat[(tid >> 3) + 32 * i] = as_rstd ? rsqrtf(v * invK + EPS) : v;
    }
    __syncthreads();
}
__device__ __forceinline__ int nidx(int r, int fh) { return (r & 3) + 8 * (r >> 2) + 4 * fh; }
__device__ __forceinline__ uint4 pack8(const float4& a, const float4& b) { uint4 pk; pk.x = pack2(a.x, a.y); pk.y = pack2(a.z, a.w); pk.z = pack2(b.x, b.y); pk.w = pack2(b.z, b.w); return pk; }
__device__ __forceinline__ float sq8(const float4& a, const float4& b) { return (a.x * a.x + a.y * a.y) + (a.z * a.z + a.w * a.w) + (b.x * b.x + b.y * b.y) + (b.z * b.z + b.w * b.w); }
__device__ __forceinline__ float4 mul4(const float4& a, float s) { return make_float4(a.x * s, a.y * s, a.z * s, a.w * s); }
__device__ __forceinline__ void store4(bf16_t* p, float a, float b, float c, float d) {
    uint2 v; v.x = pack2(a, b); v.y = pack2(c, d); *(uint2*)p = v;
}

__device__ __forceinline__ bool xcd_item(int it, int MT, int NTl, int& mt, int& nt) {
    const int x = blockIdx.x & 7, lb = blockIdx.x >> 3, nlb = gridDim.x >> 3;
    const int li = it * nlb + lb, per = (MT >> 3) * NTl;
    if (li >= per) return false;
    mt = (li / NTl) * 8 + x; nt = li % NTl; return true;
}

constexpr int TLD = 132;
constexpr int STAT_OFF = 128 * TLD * 4;
constexpr int LDS_GEMM_BYTES = STAT_OFF + 2048;
__device__ __forceinline__ void acc_to_lds(const f32x16 (&acc)[2][2], float* T, const int tid) {
    const int lane = tid & 63, wid = tid >> 6, wr = wid >> 1, wc = wid & 1, fr = lane & 31, fh = lane >> 5;
#pragma unroll
    for (int i = 0; i < 2; ++i)
#pragma unroll
        for (int j = 0; j < 2; ++j)
#pragma unroll
            for (int g = 0; g < 4; ++g) {
                float4 v; v.x = acc[i][j][4 * g]; v.y = acc[i][j][4 * g + 1]; v.z = acc[i][j][4 * g + 2]; v.w = acc[i][j][4 * g + 3];
                *(float4*)(T + (wr * 64 + i * 32 + fr) * TLD + wc * 64 + j * 32 + 8 * g + 4 * fh) = v;
            }
    __syncthreads();
}
__device__ __forceinline__ float rstd8(const float* p, float invK) {
    const float4 a = *(const float4*)p, b = *(const float4*)(p + 4);
    return rsq_(((a.x + a.y) + (a.z + a.w) + (b.x + b.y) + (b.z + b.w)) * invK + EPS);
}

}
namespace fx {

__device__ void phase_zgemm(const Params& P, int L, char* lds, const bool same = false) {
    const WS& w = P.w; const nv::Inputs& in = P.in;
    const int tid0 = opaque_tid();
    float* T = (float*)lds; float* stat = (float*)(lds + STAT_OFF);
    const bf16_t* Wt = w.W1t + L * W1_SZ;
    int mt, nt;
    for (int it = 0; xcd_item(it, 128, 12, mt, nt); ++it) {
        int tid = tid0; asm volatile("" : "+v"(tid));
        const int lane = tid & 63, wid = tid >> 6;
        const int m0 = mt * 128, n0 = nt * 128;
        {
            const bf16_t* arow[4]; const bf16_t* wrow[4];
#pragma unroll
            for (int i = 0; i < 4; ++i) {
                arow[i] = w.hb + (size_t)(m0 + (tid >> 3) + 32 * i) * 1024 + g64_chunk(tid) * 8;
                wrow[i] = Wt + (size_t)(n0 + (tid >> 3) + 32 * i) * 1024 + g64_chunk(tid) * 8;
            }
            f32x16 acc[2][2]; acc_zero(acc);
            float my_rs = 0.f;
            if (tid < 128) my_rs = rstd8(w.rssA + (size_t)(m0 + tid) * 8, 1.f / 1024.f);
            gemm_mainloop_g64(acc, arow, wrow, 16, lds, tid);
            if (tid < 128) stat[tid] = my_rs;
            acc_to_lds(acc, T, tid);
        }
        const int sub = lane >> 4, l16 = lane & 15, c8 = l16 * 8;
        if (nt < 2) {
#pragma unroll 8
            for (int rr = 0; rr < 8; ++rr) {
                const int row = wid * 32 + rr * 4 + sub; const float rs = stat[row];
                float4 x0 = *(const float4*)(T + row * TLD + c8), x1 = *(const float4*)(T + row * TLD + c8 + 4);
                x0.x = gelu_tanh_(x0.x * rs); x0.y = gelu_tanh_(x0.y * rs); x0.z = gelu_tanh_(x0.z * rs); x0.w = gelu_tanh_(x0.w * rs);
                x1.x = gelu_tanh_(x1.x * rs); x1.y = gelu_tanh_(x1.y * rs); x1.z = gelu_tanh_(x1.z * rs); x1.w = gelu_tanh_(x1.w * rs);
                *(uint4*)(w.ub + (size_t)(m0 + row) * 256 + nt * 128 + c8) = pack8(x0, x1);
            }
        } else if (nt < 4) {
            const int hd = (nt - 2) * 2 + (l16 >> 3), d0 = (l16 & 7) * 8;
            const float4 g0 = *(const float4*)(in.sgu_ln_g + L * 256 + hd * 64 + d0), g1 = *(const float4*)(in.sgu_ln_g + L * 256 + hd * 64 + d0 + 4);
            const float4 b0 = *(const float4*)(in.sgu_ln_b + L * 256 + hd * 64 + d0), b1 = *(const float4*)(in.sgu_ln_b + L * 256 + hd * 64 + d0 + 4);
#pragma unroll 4
            for (int rr = 0; rr < 8; ++rr) {
                const int row = wid * 32 + rr * 4 + sub; const float rs = stat[row];
                float4 x0 = *(const float4*)(T + row * TLD + c8), x1 = *(const float4*)(T + row * TLD + c8 + 4);
                x0.x = gelu_tanh_(x0.x * rs); x0.y = gelu_tanh_(x0.y * rs); x0.z = gelu_tanh_(x0.z * rs); x0.w = gelu_tanh_(x0.w * rs);
                x1.x = gelu_tanh_(x1.x * rs); x1.y = gelu_tanh_(x1.y * rs); x1.z = gelu_tanh_(x1.z * rs); x1.w = gelu_tanh_(x1.w * rs);
                const float mean = grp_sum8((x0.x + x0.y) + (x0.z + x0.w) + (x1.x + x1.y) + (x1.z + x1.w)) * (1.f / 64.f);
                x0.x -= mean; x0.y -= mean; x0.z -= mean; x0.w -= mean; x1.x -= mean; x1.y -= mean; x1.z -= mean; x1.w -= mean;
                const float rv = rsq_(grp_sum8(sq8(x0, x1)) * (1.f / 64.f) + EPS);
                x0.x = x0.x * rv * g0.x + b0.x; x0.y = x0.y * rv * g0.y + b0.y; x0.z = x0.z * rv * g0.z + b0.z; x0.w = x0.w * rv * g0.w + b0.w;
                x1.x = x1.x * rv * g1.x + b1.x; x1.y = x1.y * rv * g1.y + b1.y; x1.z = x1.z * rv * g1.z + b1.z; x1.w = x1.w * rv * g1.w + b1.w;
                *(float4*)(T + row * TLD + c8) = x0; *(float4*)(T + row * TLD + c8 + 4) = x1;
            }
            __syncthreads();
            {
                const int c = tid & 127, th = tid >> 7, hd2 = (nt - 2) * 2 + (c >> 6), d = c & 63;
                bf16_t* dst = w.vT + ((size_t)(mt * 4 + hd2) * 64 + d) * 128 + th * 64;
#pragma unroll 2
                for (int k8 = 0; k8 < 8; ++k8) {
                    float v[8];
#pragma unroll
                    for (int k = 0; k < 8; ++k) v[k] = T[(th * 64 + k8 * 8 + k) * TLD + c];
                    uint4 pk; pk.x = pack2(v[0], v[1]); pk.y = pack2(v[2], v[3]); pk.z = pack2(v[4], v[5]); pk.w = pack2(v[6], v[7]);
                    *(uint4*)(dst + k8 * 8) = pk;
                }
            }
        } else if (nt < 8) {
#pragma unroll 8
            for (int rr = 0; rr < 8; ++rr) {
                const int row = wid * 32 + rr * 4 + sub; const float rs = stat[row];
                const float4 x0 = *(const float4*)(T + row * TLD + c8), x1 = *(const float4*)(T + row * TLD + c8 + 4);
                store4(w.ygb + (size_t)(m0 + row) * 256 + (nt - 4) * 64 + l16 * 4, x0.x * rs * sigmoid_(x0.y * rs), x0.z * rs * sigmoid_(x0.w * rs),
                       x1.x * rs * sigmoid_(x1.y * rs), x1.z * rs * sigmoid_(x1.w * rs));
            }
        } else if (nt < 11) {
            bf16_t* base; int ld, cb;
            if (nt < 10) { base = w.cqb; ld = 256; cb = (nt - 8) * 128; } else { base = w.ckvb; ld = 128; cb = 0; }
#pragma unroll 8
            for (int rr = 0; rr < 8; ++rr) {
                const int row = wid * 32 + rr * 4 + sub; const float rs = stat[row];
                const float4 x0 = mul4(*(const float4*)(T + row * TLD + c8), rs), x1 = mul4(*(const float4*)(T + row * TLD + c8 + 4), rs);
                *(uint4*)(base + (size_t)(m0 + row) * ld + cb + c8) = pack8(x0, x1);
                const float sq = grp_sum16(sq8(x0, x1));
                if (l16 == 0) w.cqss[(size_t)(m0 + row) * 4 + (nt - 8)] = sq;
            }
        } else {
            const int lq = l16 & 3, dd = lq * 8, jj = (lq & 1) * 8;
            const float4 kg0 = *(const float4*)(in.k_norm_g + L * 96 + 64 + dd), kg1 = *(const float4*)(in.k_norm_g + L * 96 + 64 + dd + 4);
#pragma unroll 1
            for (int hb4 = 0; hb4 < 2; ++hb4) {
                float4 cc0[4], cc1[4], ss0[4], ss1[4];
#pragma unroll
                for (int r4 = 0; r4 < 4; ++r4) {
                    const float* csr = w.cs + (size_t)(m0 + wid * 32 + (hb4 * 4 + r4) * 4 + sub) * 32 + jj;
                    cc0[r4] = *(const float4*)csr; cc1[r4] = *(const float4*)(csr + 4); ss0[r4] = *(const float4*)(csr + 16); ss1[r4] = *(const float4*)(csr + 20);
                }
#pragma unroll
                for (int r4 = 0; r4 < 4; ++r4) {
                    const int row = wid * 32 + (hb4 * 4 + r4) * 4 + sub; const float rs = stat[row]; const int tok = m0 + row;
                    float4 x0 = mul4(*(const float4*)(T + row * TLD + dd), rs), x1 = mul4(*(const float4*)(T + row * TLD + dd + 4), rs);
                    const float rn = rsq_(grp_sum4(sq8(x0, x1)) * (1.f / 32.f) + EPS);
                    x0.x *= rn * kg0.x; x0.y *= rn * kg0.y; x0.z *= rn * kg0.z; x0.w *= rn * kg0.w;
                    x1.x *= rn * kg1.x; x1.y *= rn * kg1.y; x1.z *= rn * kg1.z; x1.w *= rn * kg1.w;
                    const float4 o0 = make_float4(quad_x2(x0.x), quad_x2(x0.y), quad_x2(x0.z), quad_x2(x0.w)), o1 = make_float4(quad_x2(x1.x), quad_x2(x1.y), quad_x2(x1.z), quad_x2(x1.w));
                    const float4 c0 = cc0[r4], c1 = cc1[r4], s0 = ss0[r4], s1 = ss1[r4];
                    const float sg = (lq & 2) ? 1.f : -1.f;
                    float4 r0, r1;
                    r0.x = x0.x * c0.x + sg * o0.x * s0.x; r0.y = x0.y * c0.y + sg * o0.y * s0.y; r0.z = x0.z * c0.z + sg * o0.z * s0.z; r0.w = x0.w * c0.w + sg * o0.w * s0.w;
                    r1.x = x1.x * c1.x + sg * o1.x * s1.x; r1.y = x1.y * c1.y + sg * o1.y * s1.y; r1.z = x1.z * c1.z + sg * o1.z * s1.z; r1.w = x1.w * c1.w + sg * o1.w * s1.w;
                    if (l16 < 4) *(uint4*)(w.kpeb + (size_t)tok * 32 + dd) = pack8(r0, r1);
                }
            }
        }
        __syncthreads();
    }
}

}
namespace fx {

constexpr float QSCALE = 0.10206207261596575f * 1.4426950408889634f;

__device__ void qkv_item(const Params& P, int L, const bool isq, const int mt, const int nt, char* lds, const int tid_in) {
    int tid = tid_in; asm volatile("" : "+v"(tid));
    const WS& w = P.w; const nv::Inputs& in = P.in;
    const int lane = tid & 63, wid = tid >> 6;
    float* T = (float*)lds; float* stat = (float*)(lds + STAT_OFF);
    const int m0 = mt * 128, n0 = nt * 128;
    const int K = isq ? 256 : 128;
    {
        const bf16_t* A = isq ? w.cqb : w.ckvb;
        const bf16_t* Wt = isq ? (w.Wuqt + L * WUQ_SZ) : (w.Wukvt + L * WUKV_SZ);
        const bf16_t* arow[4]; const bf16_t* wrow[4];
#pragma unroll
        for (int i = 0; i < 4; ++i) {
            arow[i] = A + (size_t)(m0 + (tid >> 3) + 32 * i) * K + g64_chunk(tid) * 8;
            wrow[i] = Wt + (size_t)(n0 + (tid >> 3) + 32 * i) * K + g64_chunk(tid) * 8;
        }
        f32x16 acc[2][2]; acc_zero(acc);
        float my_rs = 0.f;
        if (tid < 128) {
            const float4 c = *(const float4*)(w.cqss + (size_t)(m0 + tid) * 4);
            my_rs = isq ? rsq_((c.x + c.y) * (1.f / 256.f) + EPS) : rsq_(c.z * (1.f / 128.f) + EPS);
        }
        gemm_mainloop_g64(acc, arow, wrow, K / 64, lds, tid);
        if (tid < 128) stat[tid] = my_rs;
        acc_to_lds(acc, T, tid);
    }
    const int b = m0 >> 11, s0 = m0 & 2047;
    const int sub = lane >> 4, l16 = lane & 15, c8 = l16 * 8;
    if (isq && nt < 4) {
        const int hd = nt * 2 + (l16 >> 3), d = (l16 & 7) * 8;
        const float4 g0 = mul4(*(const float4*)(in.q_norm_g + L * 96 + d), QSCALE), g1 = mul4(*(const float4*)(in.q_norm_g + L * 96 + d + 4), QSCALE);
        bf16_t* dst = w.Qb + ((size_t)(b * 8 + hd) * 2048 + s0) * 96 + d;
#pragma unroll 8
        for (int rr = 0; rr < 8; ++rr) {
            const int row = wid * 32 + rr * 4 + sub; const float rs = stat[row];
            float4 x0 = mul4(*(const float4*)(T + row * TLD + c8), rs), x1 = mul4(*(const float4*)(T + row * TLD + c8 + 4), rs);
            const float rn = rsq_(grp_sum8(sq8(x0, x1)) * (1.f / 64.f) + EPS);
            x0.x *= rn * g0.x; x0.y *= rn * g0.y; x0.z *= rn * g0.z; x0.w *= rn * g0.w; x1.x *= rn * g1.x; x1.y *= rn * g1.y; x1.z *= rn * g1.z; x1.w *= rn * g1.w;
            *(uint4*)(dst + (size_t)row * 96) = pack8(x0, x1);
        }
    } else if (isq) {
        const int hd = (nt - 4) * 4 + (l16 >> 2), lq = l16 & 3, dd = lq * 8, jj = (lq & 1) * 8;
        const float4 g0 = *(const float4*)(in.q_norm_g + L * 96 + 64 + dd), g1 = *(const float4*)(in.q_norm_g + L * 96 + 64 + dd + 4);
        bf16_t* dst = w.Qb + ((size_t)(b * 8 + hd) * 2048 + s0) * 96 + 64 + dd;
        const float sg = (lq & 2) ? QSCALE : -QSCALE;
#pragma unroll 1
        for (int hb4 = 0; hb4 < 2; ++hb4) {
            float4 cc0[4], cc1[4], ss0[4], ss1[4];
#pragma unroll
            for (int r4 = 0; r4 < 4; ++r4) {
                const float* csr = w.cs + (size_t)(m0 + wid * 32 + (hb4 * 4 + r4) * 4 + sub) * 32 + jj;
                cc0[r4] = *(const float4*)csr; cc1[r4] = *(const float4*)(csr + 4); ss0[r4] = *(const float4*)(csr + 16); ss1[r4] = *(const float4*)(csr + 20);
            }
#pragma unroll
            for (int r4 = 0; r4 < 4; ++r4) {
                const int row = wid * 32 + (hb4 * 4 + r4) * 4 + sub; const float rs = stat[row];
                float4 x0 = mul4(*(const float4*)(T + row * TLD + c8), rs), x1 = mul4(*(const float4*)(T + row * TLD + c8 + 4), rs);
                const float rn = rsq_(grp_sum4(sq8(x0, x1)) * (1.f / 32.f) + EPS);
                x0.x *= rn * g0.x; x0.y *= rn * g0.y; x0.z *= rn * g0.z; x0.w *= rn * g0.w; x1.x *= rn * g1.x; x1.y *= rn * g1.y; x1.z *= rn * g1.z; x1.w *= rn * g1.w;
                const float4 o0 = make_float4(quad_x2(x0.x), quad_x2(x0.y), quad_x2(x0.z), quad_x2(x0.w)), o1 = make_float4(quad_x2(x1.x), quad_x2(x1.y), quad_x2(x1.z), quad_x2(x1.w));
                const float4 c0 = mul4(cc0[r4], QSCALE), c1 = mul4(cc1[r4], QSCALE), s0v = ss0[r4], s1v = ss1[r4];
                float4 r0, r1;
                r0.x = x0.x * c0.x + sg * o0.x * s0v.x; r0.y = x0.y * c0.y + sg * o0.y * s0v.y; r0.z = x0.z * c0.z + sg * o0.z * s0v.z; r0.w = x0.w * c0.w + sg * o0.w * s0v.w;
                r1.x = x1.x * c1.x + sg * o1.x * s1v.x; r1.y = x1.y * c1.y + sg * o1.y * s1v.y; r1.z = x1.z * c1.z + sg * o1.z * s1v.z; r1.w = x1.w * c1.w + sg * o1.w * s1v.w;
                *(uint4*)(dst + (size_t)row * 96) = pack8(r0, r1);
            }
        }
    } else if (nt < 4) {
        const int hd = nt * 2 + (l16 >> 3), d = (l16 & 7) * 8;
        const float4 g0 = *(const float4*)(in.k_norm_g + L * 96 + d), g1 = *(const float4*)(in.k_norm_g + L * 96 + d + 4);
        bf16_t* dst = w.Knb + ((size_t)(b * 8 + hd) * 2048 + s0) * 64 + d;
#pragma unroll 8
        for (int rr = 0; rr < 8; ++rr) {
            const int row = wid * 32 + rr * 4 + sub; const float rs = stat[row];
            float4 x0 = mul4(*(const float4*)(T + row * TLD + c8), rs), x1 = mul4(*(const float4*)(T + row * TLD + c8 + 4), rs);
            const float rn = rsq_(grp_sum8(sq8(x0, x1)) * (1.f / 64.f) + EPS);
            x0.x *= rn * g0.x; x0.y *= rn * g0.y; x0.z *= rn * g0.z; x0.w *= rn * g0.w; x1.x *= rn * g1.x; x1.y *= rn * g1.y; x1.z *= rn * g1.z; x1.w *= rn * g1.w;
            *(uint4*)(dst + (size_t)row * 64) = pack8(x0, x1);
        }
    } else {
        const int c = tid & 127, th = tid >> 7, hd = (nt - 4) * 2 + (c >> 6), d = c & 63;
        bf16_t* dst = w.VTb + ((size_t)(b * 8 + hd) * 64 + d) * 2048 + s0 + th * 64;
#pragma unroll 2
        for (int k8 = 0; k8 < 8; ++k8) {
            float v[8];
#pragma unroll
            for (int k = 0; k < 8; ++k) { const int row = th * 64 + k8 * 8 + k; v[k] = T[row * TLD + c] * stat[row]; }
            uint4 pk; pk.x = pack2(v[0], v[1]); pk.y = pack2(v[2], v[3]); pk.z = pack2(v[4], v[5]); pk.w = pack2(v[6], v[7]);
            *(uint4*)(dst + k8 * 8) = pk;
        }
    }
    __syncthreads();
}

__device__ void sgu_item(const Params& P, int L, int mt, char* lds, const int tid_in) {
    int tid = tid_in; asm volatile("" : "+v"(tid));
    const WS& w = P.w; const nv::Inputs& in = P.in;
    const int lane = tid & 63, hd = tid >> 6, fr = lane & 31, fh = lane >> 5;
    float* red = (float*)lds;
    const bf16_t* vt = w.vT + (size_t)(mt * 4 + hd) * 64 * 128;
    const bf16_t* ws = w.Wsm + L * WSM_SZ + (size_t)hd * 128 * 128;
    const float* bs = in.sgu_b + L * 512 + hd * 128;
    const int m0 = mt * 128;
    bf16x8 af0[8], af1[8];
    {
        const bf16_t* ap0 = vt + (size_t)fr * 128 + 8 * fh;
        const bf16_t* ap1 = vt + (size_t)(32 + fr) * 128 + 8 * fh;
#pragma unroll
        for (int s = 0; s < 8; ++s) { af0[s] = *(const bf16x8*)(ap0 + 16 * s); af1[s] = *(const bf16x8*)(ap1 + 16 * s); }
    }
#pragma unroll 1
    for (int it = 0; it < 4; ++it) {
        f32x16 a0, a1;
#pragma unroll
        for (int r = 0; r < 16; ++r) { a0[r] = 0.f; a1[r] = 0.f; }
        const bf16_t* bp = ws + (size_t)(it * 32 + fr) * 128 + 8 * fh;
        bf16x8 bfr[8];
#pragma unroll
        for (int s = 0; s < 8; ++s) bfr[s] = *(const bf16x8*)(bp + 16 * s);
#pragma unroll
        for (int s = 0; s < 8; ++s) {
            a0 = __builtin_amdgcn_mfma_f32_32x32x16_bf16(af0[s], bfr[s], a0, 0, 0, 0);
            a1 = __builtin_amdgcn_mfma_f32_32x32x16_bf16(af1[s], bfr[s], a1, 0, 0, 0);
        }
        const int i = it * 32 + fr, tok = m0 + i;
        const float bias = bs[i];
        uint2 uu[2][4];
#pragma unroll
        for (int dt = 0; dt < 2; ++dt)
#pragma unroll
            for (int g = 0; g < 4; ++g) uu[dt][g] = *(const uint2*)(w.ub + (size_t)tok * 256 + hd * 64 + dt * 32 + 8 * g + 4 * fh);
        float ssq = 0.f;
#pragma unroll
        for (int dt = 0; dt < 2; ++dt)
#pragma unroll
            for (int g = 0; g < 4; ++g) {
                const int d = dt * 32 + 8 * g + 4 * fh;
                float o[4];
#pragma unroll
                for (int q = 0; q < 4; ++q) {
                    const float sv = (dt == 0 ? a0[4 * g + q] : a1[4 * g + q]) + bias;
                    const float uv = (q == 0) ? bflo(uu[dt][g].x) : (q == 1) ? bfhi(uu[dt][g].x) : (q == 2) ? bflo(uu[dt][g].y) : bfhi(uu[dt][g].y);
                    o[q] = uv * sv; ssq += o[q] * o[q];
                }
                store4(w.yb + (size_t)tok * 1024 + hd * 64 + d, o[0], o[1], o[2], o[3]);
            }
        ssq = xor32(ssq);
        if (fh == 0) red[hd * 128 + i] = ssq;
    }
    __syncthreads();
    if (tid < 128) w.ssq[(size_t)(m0 + tid) * 16 + 0] = red[tid] + red[128 + tid] + red[256 + tid] + red[384 + tid];
    __syncthreads();
}

constexpr int CLD = 260, CONV_YL = 32 * CLD * 4, CONV_ST = CONV_YL + 32 * 512, CONV_RED = CONV_ST + 32 * 4 * 8;
__device__ __forceinline__ int yl_off(int row, int chunk) { return row * 512 + ((chunk ^ (row & 15)) << 4); }
__device__ void conv_item(const Params& P, int L, int ct, char* lds, const int tid_in) {
    int tid = tid_in; asm volatile("" : "+v"(tid));
    const WS& w = P.w; const nv::Inputs& in = P.in;
    const int lane = tid & 63, wid = tid >> 6, fr = lane & 31, fh = lane >> 5;
    float* C = (float*)lds; char* yl = lds + CONV_YL; float2* stats = (float2*)(lds + CONV_ST); float* red = (float*)(lds + CONV_RED);
    const int t0 = ct * 32, s0 = t0 & 2047;
    {
        const int c = tid;
        float x[62];
#pragma unroll
        for (int r = 0; r < 62; ++r) {
            const bool ok = s0 + r - 30 >= 0;
            const unsigned short raw = w.ygb[(size_t)(ok ? t0 + r - 30 : t0) * 256 + c];
            x[r] = bf2f(raw) * (ok ? 1.f : 0.f);
        }
        float wk[31];
#pragma unroll
        for (int k = 0; k < 31; ++k) wk[k] = in.conv_w[(size_t)L * 31 * 256 + k * 256 + c];
        const float cb = in.conv_b[L * 256 + c];
#pragma unroll
        for (int t = 0; t < 32; ++t) {
            float a = cb;
#pragma unroll
            for (int k = 0; k < 31; ++k) a = fmaf(wk[k], x[t + k], a);
            C[t * CLD + c] = a;
        }
    }
    __syncthreads();
    if (tid < 128) {
        const int t = tid >> 2, g = tid & 3;
        const float4* cp = (const float4*)(C + t * CLD + g * 64);
        float4 v[16]; float s = 0.f;
#pragma unroll
        for (int i = 0; i < 16; ++i) { v[i] = cp[i]; s += (v[i].x + v[i].y) + (v[i].z + v[i].w); }
        const float mean = s * (1.f / 64.f); float q = 0.f;
#pragma unroll
        for (int i = 0; i < 16; ++i) { const float a = v[i].x - mean, b2 = v[i].y - mean, c2 = v[i].z - mean, d2 = v[i].w - mean; q += (a * a + b2 * b2) + (c2 * c2 + d2 * d2); }
        stats[t * 4 + g] = make_float2(mean, rsq_(q * (1.f / 64.f) + EPS));
    }
    __syncthreads();
    {
        const int c = tid, g = c >> 6;
        const float lg = in.conv_ln_g[L * 256 + c], lb = in.conv_ln_b[L * 256 + c];
#pragma unroll 8
        for (int t = 0; t < 32; ++t) {
            const float2 st = stats[t * 4 + g];
            const float v = (C[t * CLD + c] - st.x) * st.y * lg + lb;
            *(bf16_t*)(yl + yl_off(t, c >> 3) + (c & 7) * 2) = (bf16_t)f2bf(v * sigmoid_(v));
        }
    }
    __syncthreads();
    f32x16 acc0, acc1;
#pragma unroll
    for (int r = 0; r < 16; ++r) { acc0[r] = 0.f; acc1[r] = 0.f; }
    const bf16_t* wp = w.Wpwt + L * WPW_SZ + (size_t)(wid * 64 + fr) * 256 + 8 * fh;
#pragma unroll 1
    for (int sb = 0; sb < 2; ++sb) {
        bf16x8 w0[8], w1[8];
#pragma unroll
        for (int s = 0; s < 8; ++s) { w0[s] = *(const bf16x8*)(wp + 16 * (sb * 8 + s)); w1[s] = *(const bf16x8*)(wp + 32 * 256 + 16 * (sb * 8 + s)); }
#pragma unroll
        for (int s = 0; s < 8; ++s) {
            const bf16x8 x0 = *(const bf16x8*)(yl + yl_off(fr, 2 * (sb * 8 + s) + fh));
            acc0 = __builtin_amdgcn_mfma_f32_32x32x16_bf16(w0[s], x0, acc0, 0, 0, 0);
            acc1 = __builtin_amdgcn_mfma_f32_32x32x16_bf16(w1[s], x0, acc1, 0, 0, 0);
        }
    }
    const float* pb = in.conv_pw_b + L * 256;
    {
        const int tok = t0 + fr;
        float4 bia[2][4];
#pragma unroll
        for (int jn = 0; jn < 2; ++jn)
#pragma unroll
            for (int g = 0; g < 4; ++g) bia[jn][g] = *(const float4*)(pb + wid * 64 + jn * 32 + 8 * g + 4 * fh);
        float ssq = 0.f;
#pragma unroll
        for (int jn = 0; jn < 2; ++jn)
#pragma unroll
            for (int g = 0; g < 4; ++g) {
                const int n = wid * 64 + jn * 32 + 8 * g + 4 * fh;
                const float4 b4 = bia[jn][g];
                const float o0 = (jn ? acc1[4 * g] : acc0[4 * g]) + b4.x, o1 = (jn ? acc1[4 * g + 1] : acc0[4 * g + 1]) + b4.y;
                const float o2 = (jn ? acc1[4 * g + 2] : acc0[4 * g + 2]) + b4.z, o3 = (jn ? acc1[4 * g + 3] : acc0[4 * g + 3]) + b4.w;
                ssq += o0 * o0 + o1 * o1 + o2 * o2 + o3 * o3;
                store4(w.yb + (size_t)tok * 1024 + 256 + n, o0, o1, o2, o3);
            }
        ssq = xor32(ssq);
        if (fh == 0) red[wid * 32 + fr] = ssq;
    }
    __syncthreads();
    if (tid < 32) w.ssq[(size_t)(t0 + tid) * 16 + 1] = red[tid] + red[32 + tid] + red[64 + tid] + red[96 + tid];
    __syncthreads();
}

__device__ void phase_mix(const Params& P, int L, char* lds, const int rep = 0, const bool dryrun = false) {
    const int tid = opaque_tid();
    const int x = blockIdx.x & 7;
    int* qctr = P.w.cnt + L * 256 + 72 + x + 8 * rep;
    volatile int* slot = (volatile int*)(lds + LDS_GEMM_BYTES - 16);
    if (tid == 0) *slot = atomicAdd(qctr, 1);
    __syncthreads();
    int cur = *slot;
    __syncthreads();
    while (cur < 304) {
        int nxt = 0;
        if (tid == 0) nxt = atomicAdd(qctr, 1);
#ifdef MIX_MASK
        const int mask = dryrun ? MIX_MASK : 15;
#else
        const int mask = 15;
#endif
#ifdef MIX_TWICE
        if (cur < 16) { if (MIX_TWICE & 1) sgu_item(P, L, cur * 8 + x, lds, tid); }
        else if (cur < 80) { if (MIX_TWICE & 2) conv_item(P, L, (cur - 16) * 8 + x, lds, tid); }
        else if (cur < 176) { if (MIX_TWICE & 4) { const int li = cur - 80; qkv_item(P, L, true, (li / 6) * 8 + x, li % 6, lds, tid); } }
        else { if (MIX_TWICE & 8) { const int li = cur - 176; qkv_item(P, L, false, (li >> 3) * 8 + x, li & 7, lds, tid); } }
#endif
        if (cur < 16) { if (mask & 1) sgu_item(P, L, cur * 8 + x, lds, tid); }
        else if (cur < 80) { if (mask & 2) conv_item(P, L, (cur - 16) * 8 + x, lds, tid); }
        else if (cur < 176) { if (mask & 4) { const int li = cur - 80; qkv_item(P, L, true, (li / 6) * 8 + x, li % 6, lds, tid); } }
        else { if (mask & 8) { const int li = cur - 176; qkv_item(P, L, false, (li >> 3) * 8 + x, li & 7, lds, tid); } }
        if (tid == 0) *slot = nxt;
        __syncthreads();
        cur = *slot;
        __syncthreads();
    }
}

}
namespace fx {

constexpr int AKN = 0, AKP = 8192, AVT = 12288, ATT_STAGE = 20480;
__device__ __forceinline__ void att_issue(const bf16_t* Kn, const bf16_t* Kp, const bf16_t* Vt, int k0, char* st, const int tid, const int wbase) {
    {
        const int row = tid >> 3, ch = (tid & 7) ^ ((tid >> 4) & 7);
        glds16(Kn + (size_t)(k0 + row) * 64 + ch * 8, st + AKN + wbase);
        glds16(Kn + (size_t)(k0 + row + 32) * 64 + ch * 8, st + AKN + 4096 + wbase);
    }
    {
        const int row = tid >> 2, ch = (tid & 3) ^ ((tid >> 4) & 3);
        glds16(Kp + (size_t)(k0 + row) * 32 + ch * 8, st + AKP + wbase);
    }
    {
        const int d = tid >> 3, ch = (tid & 7) ^ ((tid >> 4) & 7);
        glds16(Vt + (size_t)d * 2048 + k0 + ch * 8, st + AVT + wbase);
        glds16(Vt + (size_t)(d + 32) * 2048 + k0 + ch * 8, st + AVT + 4096 + wbase);
    }
}

__device__ void attn_unit(const Params& P, int b, int h, int qt, char* lds, const int tid) {
    const WS& w = P.w;
    const int lane = tid & 63, wid = tid >> 6, fr = lane & 31, fh = lane >> 5;
    const int wbase = __builtin_amdgcn_readfirstlane(wid) * 1024;
    const bf16_t* Kn = w.Knb + (size_t)(b * 8 + h) * 2048 * 64;
    const bf16_t* Kp = w.kpeb + (size_t)b * 2048 * 32;
    const bf16_t* Vt = w.VTb + (size_t)(b * 8 + h) * 64 * 2048;
    const int q0 = qt * 128, qw0 = q0 + wid * 32, qpos = qw0 + fr;
    bf16x8 qf[6];
    {
        const bf16_t* qp = w.Qb + ((size_t)(b * 8 + h) * 2048 + qpos) * 96 + 8 * fh;
#pragma unroll
        for (int ks = 0; ks < 6; ++ks) qf[ks] = *(const bf16x8*)(qp + 16 * ks);
    }
    f32x16 o0, o1;
#pragma unroll
    for (int r = 0; r < 16; ++r) { o0[r] = 0.f; o1[r] = 0.f; }
    float m = -1e30f, l = 0.f;
    const int nkt = 2 * (qt + 1);
    asm volatile("s_waitcnt vmcnt(0)" ::: "memory");
    att_issue(Kn, Kp, Vt, 0, lds, tid, wbase);
    if (nkt > 1) att_issue(Kn, Kp, Vt, 64, lds + ATT_STAGE, tid, wbase);
    const int kn0 = AKN + fr * 128, kn1 = AKN + (32 + fr) * 128, swn = (fr >> 1) & 7;
    const int kp0 = AKP + fr * 64, kp1 = AKP + (32 + fr) * 64, swp = (fr >> 2) & 3;
    const int vt0 = AVT + fr * 128 + 8 * fh, vt1 = AVT + (32 + fr) * 128 + 8 * fh, swv = (fr >> 1) & 7;
#pragma unroll 1
    for (int kt = 0; kt < nkt; ++kt) {
        if (kt + 1 < nkt) asm volatile("s_waitcnt vmcnt(5)" ::: "memory"); else asm volatile("s_waitcnt vmcnt(0)" ::: "memory");
        RAW_BARRIER();
        if (kt + 2 < nkt) att_issue(Kn, Kp, Vt, (kt + 2) * 64, lds + ((kt + 2) % 3) * ATT_STAGE, tid, wbase);
        const char* cur = lds + (kt % 3) * ATT_STAGE;
        const int k0 = kt * 64;
        if (k0 <= qw0 + 31) {
            f32x16 s0, s1;
#pragma unroll
            for (int r = 0; r < 16; ++r) { s0[r] = 0.f; s1[r] = 0.f; }
            {
                bf16x8 ka[6], kc[6];
#pragma unroll
                for (int ks = 0; ks < 4; ++ks) {
                    const int off = ((2 * ks + fh) ^ swn) << 4;
                    ka[ks] = *(const bf16x8*)(cur + kn0 + off); kc[ks] = *(const bf16x8*)(cur + kn1 + off);
                }
#pragma unroll
                for (int ks = 4; ks < 6; ++ks) {
                    const int off = ((2 * (ks - 4) + fh) ^ swp) << 4;
                    ka[ks] = *(const bf16x8*)(cur + kp0 + off); kc[ks] = *(const bf16x8*)(cur + kp1 + off);
                }
                __builtin_amdgcn_sched_barrier(0);
#pragma unroll
                for (int ks = 0; ks < 6; ++ks) {
                    s0 = __builtin_amdgcn_mfma_f32_32x32x16_bf16(ka[ks], qf[ks], s0, 0, 0, 0);
                    s1 = __builtin_amdgcn_mfma_f32_32x32x16_bf16(kc[ks], qf[ks], s1, 0, 0, 0);
                }
            }
            uint2 va0[4], va1[4], vb0[4], vb1[4];
#pragma unroll
            for (int ks = 0; ks < 4; ++ks) {
                const int c0 = ((2 * ks) ^ swv) << 4, c1 = ((2 * ks + 1) ^ swv) << 4;
                va0[ks] = *(const uint2*)(cur + vt0 + c0); va1[ks] = *(const uint2*)(cur + vt0 + c1);
                vb0[ks] = *(const uint2*)(cur + vt1 + c0); vb1[ks] = *(const uint2*)(cur + vt1 + c1);
            }
            __builtin_amdgcn_sched_barrier(0);
            if (k0 + 63 > qw0) {
#pragma unroll
                for (int r = 0; r < 16; ++r) {
                    const int key = k0 + nidx(r, fh);
                    if (key > qpos) s0[r] = -1e30f;
                    if (key + 32 > qpos) s1[r] = -1e30f;
                }
            }
            float mx = s0[0];
#pragma unroll
            for (int r = 1; r < 16; ++r) mx = fmaxf(mx, s0[r]);
#pragma unroll
            for (int r = 0; r < 16; ++r) mx = fmaxf(mx, s1[r]);
            mx = swap32_max(mx);
            const float mn = fmaxf(m, mx);
            const float alpha = __builtin_amdgcn_exp2f(m - mn);
            m = mn;
            float ps = 0.f;
#pragma unroll
            for (int r = 0; r < 16; ++r) { s0[r] = __builtin_amdgcn_exp2f(s0[r] - mn); ps += s0[r]; }
#pragma unroll
            for (int r = 0; r < 16; ++r) { s1[r] = __builtin_amdgcn_exp2f(s1[r] - mn); ps += s1[r]; }
            ps = swap32_sum(ps);
            l = l * alpha + ps;
#pragma unroll
            for (int r = 0; r < 16; ++r) { o0[r] *= alpha; o1[r] *= alpha; }
#pragma unroll
            for (int ks = 0; ks < 4; ++ks) {
                bf16x8 pf;
                {
                    const int rb = 8 * (ks & 1);
                    unsigned u0, u1, u2, u3;
                    if (ks < 2) { u0 = pack2(s0[rb], s0[rb + 1]); u1 = pack2(s0[rb + 2], s0[rb + 3]); u2 = pack2(s0[rb + 4], s0[rb + 5]); u3 = pack2(s0[rb + 6], s0[rb + 7]); }
                    else { u0 = pack2(s1[rb], s1[rb + 1]); u1 = pack2(s1[rb + 2], s1[rb + 3]); u2 = pack2(s1[rb + 4], s1[rb + 5]); u3 = pack2(s1[rb + 6], s1[rb + 7]); }
                    uint4 uu = make_uint4(u0, u1, u2, u3);
                    pf = __builtin_bit_cast(bf16x8, uu);
                }
                const bf16x8 vfa = __builtin_bit_cast(bf16x8, make_uint4(va0[ks].x, va0[ks].y, va1[ks].x, va1[ks].y));
                const bf16x8 vfb = __builtin_bit_cast(bf16x8, make_uint4(vb0[ks].x, vb0[ks].y, vb1[ks].x, vb1[ks].y));
                o0 = __builtin_amdgcn_mfma_f32_32x32x16_bf16(vfa, pf, o0, 0, 0, 0);
                o1 = __builtin_amdgcn_mfma_f32_32x32x16_bf16(vfb, pf, o1, 0, 0, 0);
            }
        }
    }
    RAW_BARRIER();
    const float inv = 1.f / l;
    const int tok = b * 2048 + qpos;
    float ssq = 0.f;
#pragma unroll
    for (int dt = 0; dt < 2; ++dt)
#pragma unroll
        for (int g = 0; g < 4; ++g) {
            float o[4];
#pragma unroll
            for (int q = 0; q < 4; ++q) { o[q] = (dt == 0 ? o0[4 * g + q] : o1[4 * g + q]) * inv; ssq += o[q] * o[q]; }
            store4(w.yb + (size_t)tok * 1024 + 512 + h * 64 + dt * 32 + 8 * g + 4 * fh, o[0], o[1], o[2], o[3]);
        }
    ssq = xor32(ssq);
    if (fh == 0) w.ssq[(size_t)tok * 16 + 8 + h] = ssq;
}

__device__ void phase_attn(const Params& P, int L, char* lds) {
    const int tid0 = opaque_tid();
    const int h = blockIdx.x & 7, nlb = gridDim.x >> 3;
    for (int li = blockIdx.x >> 3; li < 64; li += nlb) {
        int tid = tid0; asm volatile("" : "+v"(tid));
        const int p = li & 7, b = li >> 3;
        attn_unit(P, b, h, 15 - p, lds, tid);
        attn_unit(P, b, h, p, lds, tid);
    }
}

}
namespace fx {

__device__ __forceinline__ void acc_scale(f32x16 (&acc)[2][2], const float* f, const int tid) {
    const int lane = tid & 63, wr = tid >> 7, fr = lane & 31;
#pragma unroll
    for (int i = 0; i < 2; ++i) {
        const float v = f[wr * 64 + i * 32 + fr];
#pragma unroll
        for (int j = 0; j < 2; ++j)
#pragma unroll
            for (int r = 0; r < 16; ++r) acc[i][j][r] *= v;
    }
}
__device__ void phase_oproj(const Params& P, int L, char* lds, const bool dry = false) {
    const WS& w = P.w;
    const int tid0 = opaque_tid();
    float* T = (float*)lds; float* stat = (float*)(lds + STAT_OFF);
    const bf16_t* Wt = w.Wot + L * WO_SZ;
    int mt, nt;
    for (int it = 0; xcd_item(it, 128, 8, mt, nt); ++it) {
        int tid = tid0; asm volatile("" : "+v"(tid));
        const int lane = tid & 63, wid = tid >> 6;
        const int m0 = mt * 128, n0 = nt * 128;
        float rb_keep = 0.f;
        if (tid < 128) {
            const float* sq = w.ssq + (size_t)(m0 + tid) * 16;
            const float4 c0 = *(const float4*)(sq + 8), c1 = *(const float4*)(sq + 12);
            const float ra = rsq_(sq[0] * (1.f / 256.f) + EPS), rb = rsq_(sq[1] * (1.f / 256.f) + EPS);
            const float rc = rsq_((c0.x + c0.y + c0.z + c0.w + c1.x + c1.y + c1.z + c1.w) * (1.f / 512.f) + EPS);
            stat[tid] = rc / ra; stat[128 + tid] = ra / rb; rb_keep = rb;
        }
        {
            const bf16_t* arow[4]; const bf16_t* wrow[4];
#pragma unroll
            for (int i = 0; i < 4; ++i) {
                arow[i] = w.yb + (size_t)(m0 + (tid >> 3) + 32 * i) * 1024 + g64_chunk(tid) * 8;
                wrow[i] = Wt + (size_t)(n0 + (tid >> 3) + 32 * i) * 1024 + g64_chunk(tid) * 8;
            }
            f32x16 acc[2][2]; acc_zero(acc);
            gemm_mainloop_g64<true>(acc, arow, wrow, 16, lds, tid, 8, 8, stat, 12, stat + 128);
            if (tid < 128) stat[tid] = rb_keep;
            acc_to_lds(acc, T, tid);
        }
        {
            const int sub = lane >> 4, c8 = (lane & 15) * 8;
            float4 hv0[8], hv1[8];
            if (L == 0) {
#pragma unroll
                for (int rr = 0; rr < 8; ++rr) {
                    const float4* hin = (const float4*)(P.in.x + (size_t)(m0 + wid * 32 + rr * 4 + sub) * 1024 + n0 + c8);
                    hv0[rr] = hin[0]; hv1[rr] = hin[1];
                }
            } else {
#pragma unroll
                for (int rr = 0; rr < 8; ++rr) {
                    const uint4 hh = *(const uint4*)(w.hb + (size_t)(m0 + wid * 32 + rr * 4 + sub) * 1024 + n0 + c8);
                    hv0[rr] = make_float4(bflo(hh.x), bfhi(hh.x), bflo(hh.y), bfhi(hh.y)); hv1[rr] = make_float4(bflo(hh.z), bfhi(hh.z), bflo(hh.w), bfhi(hh.w));
                }
            }
#pragma unroll
            for (int rr = 0; rr < 8; ++rr) {
                const int row = wid * 32 + rr * 4 + sub; const float rb = stat[row];
                const float4 x0 = *(const float4*)(T + row * TLD + c8), x1 = *(const float4*)(T + row * TLD + c8 + 4);
                float4 h0 = hv0[rr], h1 = hv1[rr];
                h0.x += x0.x * rb; h0.y += x0.y * rb; h0.z += x0.z * rb; h0.w += x0.w * rb;
                h1.x += x1.x * rb; h1.y += x1.y * rb; h1.z += x1.z * rb; h1.w += x1.w * rb;
                *(uint4*)(w.hb1 + (size_t)(m0 + row) * 1024 + n0 + c8) = pack8(h0, h1);
                const float sq = grp_sum16(sq8(h0, h1));
                if ((lane & 15) == 0) w.rssB[(size_t)(m0 + row) * 8 + nt] = sq;
            }
        }
        __syncthreads();
    }
}

__device__ void router_item(const Params& P, int L, int mt, char* lds, const int tid_in, const bool dry) {
    int tid = tid_in; asm volatile("" : "+v"(tid));
    const WS& w = P.w; const nv::Inputs& in = P.in;
    float* T = (float*)lds; float* stat = (float*)(lds + STAT_OFF); int* hist = (int*)(lds + STAT_OFF + 1024);
    const int m0 = mt * 128;
    {
        const bf16_t* arow[4]; const bf16_t* wrow[4];
#pragma unroll
        for (int i = 0; i < 4; ++i) {
            arow[i] = w.hb1 + (size_t)(m0 + (tid >> 3) + 32 * i) * 1024 + g64_chunk(tid) * 8;
            wrow[i] = w.Wrt + L * WR_SZ + (size_t)((tid >> 3) + 32 * i) * 1024 + g64_chunk(tid) * 8;
        }
        f32x16 acc[2][2]; acc_zero(acc);
        float my_rs = 0.f;
        if (tid < 128) my_rs = rstd8(w.rssB + (size_t)(m0 + tid) * 8, 1.f / 1024.f);
        gemm_mainloop_g64(acc, arow, wrow, 16, lds, tid);
        if (tid < 128) stat[tid] = my_rs;
        if (tid < 64) hist[tid] = 0;
        acc_to_lds(acc, T, tid);
    }
    int e0 = 0, e1 = 0, r0 = 0, r1 = 0; float w0 = 0.f, w1 = 0.f;
    if (tid < 128) {
        const float rs = stat[tid];
        const float* lr = T + tid * TLD;
        const float* bg = in.router_group_b + L * 4; const float* be = in.router_expert_b + L * 32;
        int gi = 0; float gm = lr[0] * rs + bg[0];
#pragma unroll
        for (int j = 1; j < 4; ++j) { const float v = lr[j] * rs + bg[j]; if (v > gm) { gm = v; gi = j; } }
        float gs = 0.f;
#pragma unroll
        for (int j = 0; j < 4; ++j) gs += __builtin_amdgcn_exp2f(1.4426950408889634f * (lr[j] * rs + bg[j] - gm));
        const float gw = 1.f / gs;
        int i0 = 0, i1 = -1; float v0 = -3.0e38f, v1 = -3.0e38f;
#pragma unroll
        for (int j = 0; j < 8; ++j) {
            const float v = lr[4 + gi * 8 + j] * rs + be[gi * 8 + j];
            if (v > v0) { v1 = v0; i1 = i0; v0 = v; i0 = j; } else if (v > v1) { v1 = v; i1 = j; }
        }
        const float ex = __builtin_amdgcn_exp2f(1.4426950408889634f * (v1 - v0));
        w0 = gw / (1.f + ex); w1 = gw * ex / (1.f + ex);
        e0 = gi * 8 + i0; e1 = gi * 8 + i1;
        e0 = e0 * 2; e1 = e1 * 2 + 1;
        r0 = atomicAdd(&hist[e0], 1); r1 = atomicAdd(&hist[e1], 1);
    }
    __syncthreads();
    if (tid < 64) hist[64 + tid] = (hist[tid] && !dry) ? atomicAdd(&w.cnt[L * 256 + tid], hist[tid]) : 0;
    __syncthreads();
    if (tid < 128 && !dry) {
        const int tok = m0 + tid;
        const int p0 = hist[64 + e0] + r0, p1 = hist[64 + e1] + r1;
        w.elist[(size_t)e0 * NT + p0] = tok; w.ewt[(size_t)e0 * NT + p0] = w0;
        w.elist[(size_t)e1 * NT + p1] = tok; w.ewt[(size_t)e1 * NT + p1] = w1;
    }
    __syncthreads();
}
__device__ void eraw_item(const Params& P, int L, const int mt, const int nt, char* lds, const int tid_in) {
    int tid = tid_in; asm volatile("" : "+v"(tid));
    const WS& w = P.w; const nv::Inputs& in = P.in;
    const int lane = tid & 63, wid = tid >> 6;
    float* T = (float*)lds;
    const int m0 = mt * 128, n0 = nt * 128;
    {
        const float* arow[4]; const bf16_t* wrow[4];
#pragma unroll
        for (int i = 0; i < 4; ++i) {
            arow[i] = in.p + ((size_t)L * NT + m0 + (tid >> 3) + 32 * i) * 256 + (tid & 7) * 8;
            wrow[i] = w.Wpt + L * WP_SZ + (size_t)(n0 + (tid >> 3) + 32 * i) * 256 + (tid & 7) * 8;
        }
        f32x16 acc[2][2]; acc_zero(acc);
        float ss[4] = {0.f, 0.f, 0.f, 0.f};
        gemm_mainloop<float, false>(acc, arow, wrow, 4, lds, ss, tid);
        acc_to_lds(acc, T, tid);
    }
    {
        const int sub = lane >> 4, l16 = lane & 15, c8 = l16 * 8;
#pragma unroll 8
        for (int rr = 0; rr < 8; ++rr) {
            const int row = wid * 32 + rr * 4 + sub;
            const float4 x0 = *(const float4*)(T + row * TLD + c8), x1 = *(const float4*)(T + row * TLD + c8 + 4);
            *(uint4*)(w.erb + (size_t)(m0 + row) * 1024 + n0 + c8) = pack8(x0, x1);
            const float sq = grp_sum16(sq8(x0, x1));
            if (l16 == 0) w.essq[(size_t)(m0 + row) * 8 + nt] = sq;
        }
    }
    __syncthreads();
}
__device__ void phase_router(const Params& P, int L, char* lds, const bool dry = false) {
    const int tid = opaque_tid();
    {
        const int x = blockIdx.x & 7, lb = blockIdx.x >> 3, nlb = gridDim.x >> 3;
        if (lb < 16 || nlb <= 16) { for (int j = lb; j < 16; j += nlb) router_item(P, L, j * 8 + x, lds, tid, dry); }
        if (!dry) {
            if (nlb > 16) { if (lb >= 16) prep_moe_late(P, L, lds, tid, (lb - 16) * 8 + x, (nlb - 16) * 8); }
            else prep_moe_late(P, L, lds, tid, blockIdx.x, gridDim.x);
        }
    }
}

constexpr int TT_OFF = STAT_OFF + 1024;
__device__ __forceinline__ void moe_table(const Params& P, int L, char* lds, const int tid) {
    int* tt = (int*)(lds + TT_OFF);
    if (tid == 0) {
        const int x = blockIdx.x & 7;
        int o = 0;
        for (int li = 0; li < 64; ++li) { tt[li] = o; o += P.w.cnt[L * 256 + li]; }
        tt[64] = o;
        int t = 0, t0 = 0, t1 = 0;
        for (int k = 0; k < 8; ++k) {
            const int li = ((k >> 1) * 8 + x) * 2 + (k & 1), nt_ = (P.w.cnt[L * 256 + li] + 127) >> 7;
            tt[72 + k] = t; t += nt_;
            if (k & 1) { tt[92 + (k >> 1)] = t1; t1 += nt_; } else { tt[84 + (k >> 1)] = t0; t0 += nt_; }
        }
        tt[80] = t; tt[88] = t0; tt[96] = t1;
        int tu = 0;
        for (int k = 0; k < 4; ++k) { const int e = k * 8 + x; tt[100 + k] = tu; tu += (P.w.cnt[L * 256 + 2 * e] + P.w.cnt[L * 256 + 2 * e + 1] + 127) >> 7; }
        tt[104] = tu;
    }
    __syncthreads();
}
__device__ __forceinline__ void moe_find(const int* tt, int tile, int& li, int& t) {
    int k = 0;
#pragma unroll
    for (int j = 1; j < 8; ++j) if (tile >= tt[72 + j]) k = j;
    li = ((k >> 1) * 8 + (blockIdx.x & 7)) * 2 + (k & 1); t = tile - tt[72 + k];
}
__device__ __forceinline__ void moe_find_slot(const int* tt, int slot, int tile, int& li, int& t) {
    const int* tp = tt + (slot ? 92 : 84);
    int k = 0;
#pragma unroll
    for (int j = 1; j < 4; ++j) if (tile >= tp[j]) k = j;
    li = (k * 8 + (blockIdx.x & 7)) * 2 + slot; t = tile - tp[k];
}
__device__ void phase_moe_up(const Params& P, int L, char* lds, const bool noeraw = false) {
    const WS& w = P.w;
    const int tid0 = opaque_tid();
    float* T = (float*)lds; float* stat = (float*)(lds + STAT_OFF); const int* tt = (const int*)(lds + TT_OFF);
    moe_table(P, L, lds, tid0);
    const int ntiles = tt[104];
    for (int item = blockIdx.x >> 3; item < ntiles * 4; item += (gridDim.x >> 3)) {
        int tid = tid0; asm volatile("" : "+v"(tid));
        const int lane = tid & 63, wid = tid >> 6;
        const int tile = item >> 2, nt = item & 3;
        int k = 0;
#pragma unroll
        for (int j = 1; j < 4; ++j) if (tile >= tt[100 + j]) k = j;
        const int e = k * 8 + (blockIdx.x & 7), t = tile - tt[100 + k];
        const int cnt0 = P.w.cnt[L * 256 + 2 * e], cnt = cnt0 + P.w.cnt[L * 256 + 2 * e + 1];
        const int rbase = tt[2 * e] + t * 128, nrows = min(128, cnt - t * 128);
        {
            const bf16_t* arow[4]; const bf16_t* wrow[4];
#pragma unroll
            for (int i = 0; i < 4; ++i) {
                const int r = (tid >> 3) + 32 * i;
                const int rr3 = t * 128 + (r < nrows ? r : 0);
                const int tok = rr3 < cnt0 ? w.elist[(size_t)(2 * e) * NT + rr3] : w.elist[(size_t)(2 * e + 1) * NT + rr3 - cnt0];
                arow[i] = w.hb1 + (size_t)tok * 1024 + g64_chunk(tid) * 8;
                wrow[i] = w.Wgut + L * WGU_SZ + ((size_t)e * 512 + nt * 128 + r) * 1024 + g64_chunk(tid) * 8;
            }
            f32x16 acc[2][2]; acc_zero(acc);
            float my_rs = 0.f;
            if (tid < 128) {
                const int rr3 = t * 128 + (tid < nrows ? tid : 0);
                const int tok = rr3 < cnt0 ? w.elist[(size_t)(2 * e) * NT + rr3] : w.elist[(size_t)(2 * e + 1) * NT + rr3 - cnt0];
                my_rs = rstd8(w.rssB + (size_t)tok * 8, 1.f / 1024.f);
            }
            gemm_mainloop_g64(acc, arow, wrow, 16, lds, tid);
            if (tid < 128) stat[tid] = my_rs;
            acc_to_lds(acc, T, tid);
        }
        {
            const int sub = lane >> 4, l16 = lane & 15, c8 = l16 * 8;
#pragma unroll 8
            for (int rr = 0; rr < 8; ++rr) {
                const int row = wid * 32 + rr * 4 + sub; const float rs = stat[row];
                const float4 x0 = mul4(*(const float4*)(T + row * TLD + c8), rs), x1 = mul4(*(const float4*)(T + row * TLD + c8 + 4), rs);
                if (row < nrows)
                    store4(w.hbuf + (size_t)(rbase + row) * 256 + nt * 64 + l16 * 4, x0.x * sigmoid_(x0.x) * x0.y, x0.z * sigmoid_(x0.z) * x0.w,
                           x1.x * sigmoid_(x1.x) * x1.y, x1.z * sigmoid_(x1.z) * x1.w);
            }
        }
        __syncthreads();
    }
    if (!noeraw) {
        int* qslot = (int*)(lds + TT_OFF + 512);
        for (;;) {
            if (tid0 == 0) *qslot = atomicAdd(&P.w.cnt[L * 256 + 64], 1);
            __syncthreads();
            const int item = *qslot;
            __syncthreads();
            if (item >= 1024) break;
            eraw_item(P, L, item >> 3, item & 7, lds, tid0);
        }
    }
}
__device__ void phase_moe_down(const Params& P, int L, char* lds, const int slot, const bool dry = false) {
    const WS& w = P.w;
    const int tid0 = opaque_tid();
    float* T = (float*)lds; float* stat = (float*)(lds + STAT_OFF); const int* tt = (const int*)(lds + TT_OFF);
    moe_table(P, L, lds, tid0);
    const int ntiles = tt[slot ? 96 : 88];
    for (int item = blockIdx.x >> 3; item < ntiles * 8; item += (gridDim.x >> 3)) {
        int tid = tid0; asm volatile("" : "+v"(tid));
        const int lane = tid & 63, wid = tid >> 6;
        const int tile = item >> 3, nt = item & 7;
        int li, t; moe_find_slot(tt, slot, tile, li, t);
        const int e = li >> 1;
        const int cnt = P.w.cnt[L * 256 + li], rbase = tt[li] + t * 128, nrows = min(128, cnt - t * 128);
        {
            const bf16_t* arow[4]; const bf16_t* wrow[4];
#pragma unroll
            for (int i = 0; i < 4; ++i) {
                const int r = (tid >> 3) + 32 * i;
                arow[i] = w.hbuf + (size_t)(rbase + (r < nrows ? r : 0)) * 256 + g64_chunk(tid) * 8;
                wrow[i] = w.Wdt + L * WD_SZ + ((size_t)e * 1024 + nt * 128 + r) * 256 + g64_chunk(tid) * 8;
            }
            f32x16 acc[2][2]; acc_zero(acc);
            int my_tok = 0; float my_wt = 0.f;
            if (tid < 128) { const int rr2 = tid < nrows ? tid : 0; my_tok = w.elist[(size_t)li * NT + t * 128 + rr2]; my_wt = w.ewt[(size_t)li * NT + t * 128 + rr2]; }
            gemm_mainloop_g64(acc, arow, wrow, 4, lds, tid);
            if (tid < 128) { ((int*)stat)[tid] = my_tok; stat[128 + tid] = my_wt; }
            acc_to_lds(acc, T, tid);
        }
        {
            const int sub = lane >> 4, l16 = lane & 15, c8 = l16 * 8;
            uint4 hh[8];
#pragma unroll
            for (int rr = 0; rr < 8; ++rr) hh[rr] = *(const uint4*)(w.hb1 + (size_t)((const int*)stat)[wid * 32 + rr * 4 + sub] * 1024 + nt * 128 + c8);
#pragma unroll
            for (int rr = 0; rr < 8; ++rr) {
                const int row = wid * 32 + rr * 4 + sub;
                const int tok = ((const int*)stat)[row]; const float wt = stat[128 + row];
                const float4 x0 = *(const float4*)(T + row * TLD + c8), x1 = *(const float4*)(T + row * TLD + c8 + 4);
                const uint4 h = hh[rr];
                float4 h0, h1;
                h0.x = bflo(h.x) + wt * x0.x; h0.y = bfhi(h.x) + wt * x0.y; h0.z = bflo(h.y) + wt * x0.z; h0.w = bfhi(h.y) + wt * x0.w;
                h1.x = bflo(h.z) + wt * x1.x; h1.y = bfhi(h.z) + wt * x1.y; h1.z = bflo(h.w) + wt * x1.z; h1.w = bfhi(h.w) + wt * x1.w;
                const float sq = grp_sum16(sq8(h0, h1));
                if (row < nrows && !dry) {
                    *(uint4*)(w.hb1 + (size_t)tok * 1024 + nt * 128 + c8) = pack8(h0, h1);
                    if (slot && l16 == 0) w.rssB[(size_t)tok * 8 + nt] = sq;
                }
            }
        }
        __syncthreads();
    }
}

__device__ void phase_ple(const Params& P, int L, char* lds, const bool dry = false) {
    const WS& w = P.w; const nv::Inputs& in = P.in;
    const int tid0 = opaque_tid();
    float* T = (float*)lds; float* stat = (float*)(lds + STAT_OFF);
    int mt, nt;
    for (int it = 0; xcd_item(it, 128, 8, mt, nt); ++it) {
        int tid = tid0; asm volatile("" : "+v"(tid));
        const int lane = tid & 63, wid = tid >> 6;
        const int m0 = mt * 128, n0 = nt * 128;
        {
            const bf16_t* arow[4]; const bf16_t* wrow[4];
#pragma unroll
            for (int i = 0; i < 4; ++i) {
                arow[i] = w.hb1 + (size_t)(m0 + (tid >> 3) + 32 * i) * 1024 + g64_chunk(tid) * 8;
                wrow[i] = w.Wgt + L * WG_SZ + (size_t)(n0 + (tid >> 3) + 32 * i) * 1024 + g64_chunk(tid) * 8;
            }
            f32x16 acc[2][2]; acc_zero(acc);
            float my_rs = 0.f, my_re = 0.f;
            if (tid < 128) { my_rs = rstd8(w.rssB + (size_t)(m0 + tid) * 8, 1.f / 1024.f); my_re = rstd8(w.essq + (size_t)(m0 + tid) * 8, 1.f / 1024.f); }
            gemm_mainloop_g64(acc, arow, wrow, 16, lds, tid);
            if (tid < 128) { stat[tid] = my_rs; stat[128 + tid] = my_re; }
            acc_to_lds(acc, T, tid);
        }
        {
            const int sub = lane >> 4, l16 = lane & 15, c8 = l16 * 8;
            const float4 pg0 = *(const float4*)(in.ple_post_norm_g + L * 1024 + n0 + c8), pg1 = *(const float4*)(in.ple_post_norm_g + L * 1024 + n0 + c8 + 4);
            uint4 hhv[8], erv[8];
#pragma unroll
            for (int rr = 0; rr < 8; ++rr) {
                const size_t off = (size_t)(m0 + wid * 32 + rr * 4 + sub) * 1024 + n0 + c8;
                hhv[rr] = *(const uint4*)(w.hb1 + off); erv[rr] = *(const uint4*)(w.erb + off);
            }
#pragma unroll
            for (int rr = 0; rr < 8; ++rr) {
                const int row = wid * 32 + rr * 4 + sub; const float rs = stat[row], re = stat[128 + row]; const size_t tok = m0 + row;
                const float4 x0 = mul4(*(const float4*)(T + row * TLD + c8), rs), x1 = mul4(*(const float4*)(T + row * TLD + c8 + 4), rs);
                const size_t off = tok * 1024 + n0 + c8;
                const uint4 er = erv[rr], hh = hhv[rr];
                float4 h0, h1;
                h0.x = bflo(hh.x) + sigmoid_(x0.x) * (bflo(er.x) * re * pg0.x); h0.y = bfhi(hh.x) + sigmoid_(x0.y) * (bfhi(er.x) * re * pg0.y);
                h0.z = bflo(hh.y) + sigmoid_(x0.z) * (bflo(er.y) * re * pg0.z); h0.w = bfhi(hh.y) + sigmoid_(x0.w) * (bfhi(er.y) * re * pg0.w);
                h1.x = bflo(hh.z) + sigmoid_(x1.x) * (bflo(er.z) * re * pg1.x); h1.y = bfhi(hh.z) + sigmoid_(x1.y) * (bfhi(er.z) * re * pg1.y);
                h1.z = bflo(hh.w) + sigmoid_(x1.z) * (bflo(er.w) * re * pg1.z); h1.w = bfhi(hh.w) + sigmoid_(x1.w) * (bfhi(er.w) * re * pg1.w);
                if (L == 1) { float4* op = (float4*)(P.h + off); op[0] = h0; op[1] = h1; }
                else {
                    *(uint4*)(w.hb + off) = pack8(h0, h1);
                    const float sq = grp_sum16(sq8(h0, h1));
                    if (l16 == 0) w.rssA[tok * 8 + nt] = sq;
                }
            }
        }
        __syncthreads();
    }
}

}
namespace fx {
#define XB_TMO      128
#define XB_XCNT(j)  (256  + 64 * (j))
#define XB_XSUB(j)  (1280 + 64 * (j))
#define XB_XGEN(j)  (2304 + 64 * (j))
#define XB_TOP      3328
#define XB_TOPGEN   3392
#define XCD_BAR_WORDS 3456
#define XB_SPIN_CAP (1u << 18)
#define LAS __attribute__((address_space(3)))
__device__ __forceinline__ unsigned xb_ld(unsigned* p)              { return __hip_atomic_load(p, __ATOMIC_RELAXED, __HIP_MEMORY_SCOPE_AGENT); }
__device__ __forceinline__ unsigned xb_add(unsigned* p, unsigned v) { return __hip_atomic_fetch_add(p, v, __ATOMIC_RELAXED, __HIP_MEMORY_SCOPE_AGENT); }
__device__ __forceinline__ unsigned xb_xcc_id() { return (unsigned)__builtin_amdgcn_s_getreg((3 << 11) | 20) & 0xFu; }
#define XB_SPIN(cond, bar) do { unsigned _sp = 0; while (cond) { __builtin_amdgcn_s_sleep(1); \
    if ((++_sp & 255u) == 0u) { if (xb_ld(&(bar)[XB_TMO])) break; if (_sp > XB_SPIN_CAP) { atomicAdd(&(bar)[XB_TMO], 1u); break; } } } } while (0)
struct XcdBarrier { unsigned* bar; unsigned x; volatile LAS unsigned* st; };
__device__ __forceinline__ XcdBarrier xcd_barrier_post(unsigned* bar, volatile LAS unsigned* st) {
    XcdBarrier b; b.bar = bar; b.x = xb_xcc_id(); b.st = st;
    if (threadIdx.x == 0) (void)xb_add(&bar[XB_XCNT(b.x)], 1u);
    return b;
}
__device__ __forceinline__ void xcd_barrier_complete(unsigned* bar, unsigned x, unsigned& nloc, unsigned& nx) {
    const unsigned G = gridDim.x * gridDim.y * gridDim.z;
    unsigned sum, cnt, mine, sp = 0u;
    for (;;) {
        sum = 0u; cnt = 0u; mine = 0u;
#pragma unroll
        for (unsigned j = 0; j < 16; ++j) { const unsigned c = xb_ld(&bar[XB_XCNT(j)]); sum += c; cnt += (c > 0u) ? 1u : 0u; mine = (j == x) ? c : mine; }
        if (sum == G) break;
        __builtin_amdgcn_s_sleep(1);
        if ((++sp & 255u) == 0u) { if (xb_ld(&bar[XB_TMO])) break; if (sp > XB_SPIN_CAP) { atomicAdd(&bar[XB_TMO], 1u); break; } }
    }
    nloc = mine > 0u ? mine : 1u; nx = cnt > 0u ? cnt : 1u;
}
__device__ __forceinline__ void xcd_barrier(const XcdBarrier& b) {
    asm volatile("s_waitcnt vmcnt(0)" ::: "memory");
    __syncthreads();
    if (threadIdx.x == 0) {
        unsigned* bar = b.bar;
        __builtin_amdgcn_s_waitcnt(0);
        unsigned nloc = b.st[0], nx = b.st[1];
        if (nloc == 0u) { xcd_barrier_complete(bar, b.x, nloc, nx); b.st[0] = nloc; b.st[1] = nx; }
        const unsigned old = xb_add(&bar[XB_XSUB(b.x)], 1u);
        const unsigned gen = old / nloc;
        if (old + 1u == (gen + 1u) * nloc) {
            __builtin_amdgcn_fence(__ATOMIC_RELEASE, "agent");
            asm volatile("s_waitcnt vmcnt(0)" ::: "memory");
            const unsigned og = xb_add(&bar[XB_TOP], 1u);
            const unsigned tg = og / nx;
            if (og + 1u == (tg + 1u) * nx) xb_add(&bar[XB_TOPGEN], 1u);
            else XB_SPIN(xb_ld(&bar[XB_TOPGEN]) == tg, bar);
            __builtin_amdgcn_fence(__ATOMIC_ACQUIRE, "agent");
            xb_add(&bar[XB_XGEN(b.x)], 1u);
            asm volatile("s_waitcnt vmcnt(0)" ::: "memory");
        } else {
            XB_SPIN(xb_ld(&bar[XB_XGEN(b.x)]) == gen, bar);
            __builtin_amdgcn_fence(__ATOMIC_ACQUIRE, "agent");
            asm volatile("s_waitcnt vmcnt(0)" ::: "memory");
        }
    }
    __syncthreads();
}

constexpr int LDS_BYTES = LDS_GEMM_BYTES + 16;
constexpr int N_PHASES = 19;
constexpr int PPL = 9;
__global__ void __launch_bounds__(256, 2) k_run(Params P, int ph_lo, int ph_hi) {
    extern __shared__ __attribute__((aligned(16))) char lds[];
    volatile LAS unsigned* st = (volatile LAS unsigned*)(lds + LDS_GEMM_BYTES);
    if (threadIdx.x == 0) { st[0] = 0u; st[1] = 0u; }
    __syncthreads();
    XcdBarrier xb = xcd_barrier_post(P.w.bar, st);
#ifdef EXTRA_BARRIERS
    for (int i = 0; i < EXTRA_BARRIERS; ++i) xcd_barrier(xb);
#endif
    for (int ph = ph_lo; ph < ph_hi; ++ph) {
        if (ph > ph_lo) xcd_barrier(xb);
        int reps = 1;
#ifdef REP_PHASE
        if (ph == 0 ? (REP_PHASE == 0) : (((ph - 1) % PPL) == REP_PHASE - 1)) reps = 2;
        asm volatile("" : "+s"(reps));
#endif
        for (int rep = 0; rep < reps; ++rep) {
            const bool dry = rep + 1 < reps;
            if (rep > 0) xcd_barrier(xb);
            if (ph == 0) phase_prep(P, lds);
            else {
                const int L = (ph - 1) / PPL, s = (ph - 1) % PPL;
                switch (s) {
                    case 0: phase_zgemm(P, L, lds); break;
                    case 1: phase_mix(P, L, lds, rep, dry); break;
                    case 2: phase_attn(P, L, lds); break;
                    case 3: phase_oproj(P, L, lds, dry); break;
                    case 4: phase_router(P, L, lds, dry); break;
                    case 5: phase_moe_up(P, L, lds, dry); break;
                    case 6: phase_moe_down(P, L, lds, 0, dry); break;
                    case 7: phase_moe_down(P, L, lds, 1, dry); break;
                    case 8: phase_ple(P, L, lds, dry); break;
                }
            }
        }
    }
}
}
#ifndef MK_N_LAUNCHES
#define MK_N_LAUNCHES 1
#endif
extern "C" void kernel_launch(void* const* d_in, const int* in_sizes, int n_in, void* d_out, int out_size, void* d_ws, size_t ws_size,
                              hipStream_t stream) {
    nv::Inputs in{};
    in.x = (const float*)d_in[0]; in.p = (const float*)d_in[1]; in.positions = (const int*)d_in[2];
    const float** f = &in.mix_norm_g;
    for (int i = 0; i < 32; ++i) f[i] = (const float*)d_in[3 + i];
    size_t used = 0;
    fx::WS w = fx::make_ws((char*)d_ws, used);
    static int grid = 0;
    if (grid == 0) {
        if (n_in != 35 || out_size != fx::NT * 1024 || used > ws_size) { fprintf(stderr, "kernel_launch: unexpected shapes / workspace (need %zu, have %zu)\n", used, ws_size); grid = -1; return; }
        if (hipFuncSetAttribute((const void*)fx::k_run, hipFuncAttributeMaxDynamicSharedMemorySize, fx::LDS_BYTES) != hipSuccess) { fprintf(stderr, "hipFuncSetAttribute failed\n"); grid = -1; return; }
        int dev = 0, cus = 0, per_cu = 0;
        hipGetDevice(&dev); hipDeviceGetAttribute(&cus, hipDeviceAttributeMultiprocessorCount, dev);
        hipOccupancyMaxActiveBlocksPerMultiprocessor(&per_cu, (const void*)fx::k_run, 256, fx::LDS_BYTES);
        if (per_cu > 2) per_cu = 2;
        if (per_cu < 1) { fprintf(stderr, "occupancy query says %d blocks/CU\n", per_cu); grid = -1; return; }
        grid = cus * per_cu;
    }
    if (grid < 0) return;
    fx::Params P{}; P.in = in; P.h = (float*)d_out; P.w = w;
    hipMemsetAsync(w.cnt, 0, 2 * 256 * 4, stream);
    hipMemsetAsync(w.bar, 0, XCD_BAR_WORDS * 4, stream);
    if (MK_N_LAUNCHES == 1) hipLaunchKernelGGL(fx::k_run, dim3(grid), dim3(256), fx::LDS_BYTES, stream, P, 0, fx::N_PHASES);
    else for (int ph = 0; ph < fx::N_PHASES; ++ph) hipLaunchKernelGGL(fx::k_run, dim3(grid), dim3(256), fx::LDS_BYTES, stream, P, ph, ph + 1);
}
```

```cpp
#include <hip/hip_runtime.h>
#include <hip/hip_bf16.h>
#include <stdint.h>
#include <type_traits>
#include <cstdio>
namespace nv {
struct Inputs {
    const float *x, *p; const int* positions;
    const float *mix_norm_g, *w_in, *sgu_ln_g, *sgu_ln_b, *sgu_w, *sgu_b, *conv_w, *conv_b, *conv_ln_g, *conv_ln_b, *conv_pw_w, *conv_pw_b,
        *q_a_norm_g, *w_uq, *kv_a_norm_g, *w_ukv, *q_norm_g, *k_norm_g, *branch_norm_g, *w_o, *ffn_norm_g, *router_group_w, *router_group_b,
        *router_expert_w, *router_expert_b, *moe_w_gate, *moe_w_up, *moe_w_down, *ple_norm_g, *ple_gate_w, *ple_proj_w, *ple_post_norm_g;
};
}
namespace fx {

typedef unsigned short bf16_t;
typedef short bf16x8 __attribute__((ext_vector_type(8)));
typedef float f32x16 __attribute__((ext_vector_type(16)));
typedef float f32x4 __attribute__((ext_vector_type(4)));

constexpr int NT = 16384, SEQ = 2048, DM = 1024, NB = 8;
constexpr int ZN = 1536;
constexpr float EPS = 1e-6f;

typedef __bf16 bf16v2_t __attribute__((ext_vector_type(2)));
typedef float f32v2_t __attribute__((ext_vector_type(2)));
__device__ __forceinline__ unsigned pack2(float lo, float hi) {
    f32v2_t v; v.x = lo; v.y = hi;
    bf16v2_t b = __builtin_convertvector(v, bf16v2_t);
    return __builtin_bit_cast(unsigned, b);
}
__device__ __forceinline__ unsigned f2bf(float f) { return pack2(f, 0.f) & 0xffffu; }
__device__ __forceinline__ float bf2f(unsigned short b) { return __uint_as_float(((unsigned)b) << 16); }
__device__ __forceinline__ float bflo(unsigned u) { return __uint_as_float(u << 16); }
__device__ __forceinline__ float bfhi(unsigned u) { return __uint_as_float(u & 0xffff0000u); }
__device__ __forceinline__ float sigmoid_(float x) { return __builtin_amdgcn_rcpf(1.f + __builtin_amdgcn_exp2f(-1.4426950408889634f * x)); }
__device__ __forceinline__ float rsq_(float x) { return __builtin_amdgcn_rsqf(x); }
__device__ __forceinline__ float gelu_tanh_(float x) {
    float u = 0.7978845608028654f * (x + 0.044715f * x * x * x);
    return x * sigmoid_(2.f * u);
}
__device__ __forceinline__ int opaque_tid() { int t = threadIdx.x; asm volatile("" : "+v"(t)); return t; }
template <int CTRL> __device__ __forceinline__ float dpp_mov(float v) {
    return __builtin_bit_cast(float, __builtin_amdgcn_update_dpp(0, __builtin_bit_cast(int, v), CTRL, 0xf, 0xf, false));
}
__device__ __forceinline__ void swap16(float& a, float& b) { asm volatile("s_nop 1\n\tv_permlane16_swap_b32 %0, %1" : "+v"(a), "+v"(b)); }
__device__ __forceinline__ void swap32(float& a, float& b) { asm volatile("s_nop 1\n\tv_permlane32_swap_b32 %0, %1" : "+v"(a), "+v"(b)); }
__device__ __forceinline__ float swap16_sum(float v) { float a = v, b = v; swap16(a, b); return a + b; }
__device__ __forceinline__ float swap32_sum(float v) { float a = v, b = v; swap32(a, b); return a + b; }
__device__ __forceinline__ float swap32_max(float v) { float a = v, b = v; swap32(a, b); return fmaxf(a, b); }
__device__ __forceinline__ float grp_sum16(float v) { v += dpp_mov<0xB1>(v); v += dpp_mov<0x4E>(v); v += dpp_mov<0x124>(v); v += dpp_mov<0x128>(v); return v; }
__device__ __forceinline__ float grp_sum32(float v) { return swap16_sum(grp_sum16(v)); }
__device__ __forceinline__ float wave_sum64(float v) { return swap32_sum(grp_sum32(v)); }
__device__ __forceinline__ float grp_sum4(float v) { v += dpp_mov<0xB1>(v); v += dpp_mov<0x4E>(v); return v; }
__device__ __forceinline__ float grp_sum8(float v) { v = grp_sum4(v); v += dpp_mov<0x141>(v); return v; }
__device__ __forceinline__ float quad_x2(float v) { return dpp_mov<0x4E>(v); }
__device__ __forceinline__ float xor8(float v) { return dpp_mov<0x128>(v); }
__device__ __forceinline__ float xor32(float v) { return swap32_sum(v); }

constexpr int UPC_TILES = 512, UPC_WORDS = 2 * 8 * UPC_TILES, FAST_FLAG = 120;
struct WS {
    bf16_t *W1t, *Wuqt, *Wukvt, *Wpwt, *Wot, *Wrt, *Wgut, *Wdt, *Wgt, *Wpt, *Wsm;
    bf16_t *hb;
    bf16_t *hb1;
    bf16_t *ub;
    bf16_t *vT;
    bf16_t *ygb;
    bf16_t *cqb;
    bf16_t *ckvb;
    bf16_t *kpeb;
    bf16_t *Qb;
    bf16_t *Knb;
    bf16_t *VTb;
    bf16_t *yb;
    float  *ssq;
    float  *rssA;
    float  *rssB;
    float  *cqss;
    float  *cs;
    bf16_t *erb;
    float  *essq;
    bf16_t *hbuf;
    int    *cnt;
    int    *elist;
    float  *ewt;
    unsigned *bar;
    unsigned *upc;
};
constexpr size_t W1_SZ = (size_t)ZN * 1024, WUQ_SZ = 768 * 256, WUKV_SZ = 1024 * 128, WPW_SZ = 256 * 256, WO_SZ = 1024 * 1024, WR_SZ = 128 * 1024,
                 WGU_SZ = (size_t)32 * 512 * 1024, WD_SZ = (size_t)32 * 1024 * 256, WG_SZ = 1024 * 1024, WP_SZ = 1024 * 256, WSM_SZ = 4 * 128 * 128;

struct Params {
    nv::Inputs in;
    float* h;
    WS w;
};

static WS make_ws(char* base, size_t& used) {
    WS w{}; size_t o = 0;
    auto take = [&](size_t bytes) { char* p = base + o; o += (bytes + 255) & ~(size_t)255; return p; };
    w.W1t = (bf16_t*)take(2 * W1_SZ * 2);   w.Wuqt = (bf16_t*)take(2 * WUQ_SZ * 2); w.Wukvt = (bf16_t*)take(2 * WUKV_SZ * 2);
    w.Wpwt = (bf16_t*)take(2 * WPW_SZ * 2); w.Wot = (bf16_t*)take(2 * WO_SZ * 2);   w.Wrt = (bf16_t*)take(2 * WR_SZ * 2);
    w.Wgut = (bf16_t*)take(2 * WGU_SZ * 2); w.Wdt = (bf16_t*)take(2 * WD_SZ * 2);   w.Wgt = (bf16_t*)take(2 * WG_SZ * 2);
    w.Wpt = (bf16_t*)take(2 * WP_SZ * 2);   w.Wsm = (bf16_t*)take(2 * WSM_SZ * 2);
    w.hb = (bf16_t*)take((size_t)NT * 1024 * 2); w.hb1 = (bf16_t*)take((size_t)NT * 1024 * 2);
    w.ssq = (float*)take((size_t)NT * 16 * 4); w.cs = (float*)take((size_t)NT * 32 * 4);
    w.rssA = (float*)take((size_t)NT * 8 * 4); w.rssB = (float*)take((size_t)NT * 8 * 4); w.cqss = (float*)take((size_t)NT * 4 * 4);
    w.essq = (float*)take((size_t)NT * 8 * 4);
    w.cnt = (int*)take(2 * 256 * 4);
    w.bar = (unsigned*)take(4096 * 4);
    w.upc = (unsigned*)take(UPC_WORDS * 4);
    w.elist = (int*)take((size_t)64 * NT * 4); w.ewt = (float*)take((size_t)64 * NT * 4);
    const size_t region = o;
    w.ub = (bf16_t*)take((size_t)NT * 256 * 2); w.vT = (bf16_t*)take((size_t)NT * 256 * 2); w.ygb = (bf16_t*)take((size_t)NT * 256 * 2);
    w.cqb = (bf16_t*)take((size_t)NT * 256 * 2); w.ckvb = (bf16_t*)take((size_t)NT * 128 * 2); w.kpeb = (bf16_t*)take((size_t)NT * 32 * 2);
    w.Qb = (bf16_t*)take((size_t)NT * 768 * 2); w.Knb = (bf16_t*)take((size_t)NT * 512 * 2); w.VTb = (bf16_t*)take((size_t)NT * 512 * 2);
    w.yb = (bf16_t*)take((size_t)NT * 1024 * 2);
    const size_t region_end = o;
    o = region;
    w.hbuf = (bf16_t*)take((size_t)(2 * NT + 128) * 256 * 2);
    w.erb = (bf16_t*)take((size_t)NT * 1024 * 2);
    if (o > region_end) { fprintf(stderr, "make_ws: overlay exceeds mixer region\n"); }
    o = region_end;
    used = o;
    return w;
}

__device__ const double ROPE_INV[16] = {1.0, 0.5623413251903491, 0.31622776601683794, 0.1778279410038923, 0.1, 0.05623413251903491, 0.03162277660168379, 0.01778279410038923, 0.01, 0.005623413251903491, 0.0031622776601683794, 0.0017782794100389228, 0.001, 0.0005623413251903491, 0.00031622776601683794, 0.00017782794100389227};
__device__ __forceinline__ void rope_cs(int pos, int j, float& c, float& s) {
    const double ang = (double)pos * ROPE_INV[j];
    const double n = rint(ang * 0.15915494309189535);
    double r = fma(-n, 6.283185307179586, ang); r = fma(-n, 2.4492935982947064e-16, r);
    const double r2 = r * r;
    double sc = 1.0, ss = 1.0;
    double tc = 1.0, ts = 1.0;
#pragma unroll
    for (int k = 1; k <= 14; ++k) {
        tc *= -r2 / (double)((2 * k - 1) * (2 * k)); sc += tc;
        ts *= -r2 / (double)((2 * k) * (2 * k + 1)); ss += ts;
    }
    c = (float)sc; s = (float)(ss * r);
}

enum { MAP_ID = 0, MAP_W1 = 1, MAP_UQ = 2, MAP_UKV = 3, MAP_GATE = 4, MAP_UP = 5 };
template <int MAP> __device__ __forceinline__ int dstrow(int c) {
    if (MAP == MAP_W1) {
        if (c < 512) return c;
        if (c < 768) return 512 + 2 * (c - 512);
        if (c < 1024) return 513 + 2 * (c - 768);
        return c;
    } else if (MAP == MAP_UQ) {
        const int h = c / 96, d = c - h * 96; return d < 64 ? h * 64 + d : 512 + h * 32 + d - 64;
    } else if (MAP == MAP_UKV) {
        const int h = c >> 7, d = c & 127; return d < 64 ? h * 64 + d : 512 + h * 64 + d - 64;
    } else if (MAP == MAP_GATE) return 2 * c;
    else if (MAP == MAP_UP) return 2 * c + 1;
    return c;
}
#define PREP_LOAD(V0, V1, V2, V3, SRC, K0, C0) do { \
    const int kk_ = tid >> 4, c4_ = (tid & 15) * 4; \
    const float* p_ = (C0) + c4_ < Nsrc ? (SRC) + (size_t)((K0) + kk_) * ld + (C0) + c4_ : (SRC) + (size_t)((K0) + kk_) * ld; \
    { const f32x4* q_ = (const f32x4*)p_; const f32x4 t0_ = __builtin_nontemporal_load(q_), t1_ = __builtin_nontemporal_load(q_ + (size_t)4 * ld), t2_ = __builtin_nontemporal_load(q_ + (size_t)8 * ld), t3_ = __builtin_nontemporal_load(q_ + (size_t)12 * ld); \
      V0 = make_float4(t0_[0], t0_[1], t0_[2], t0_[3]); V1 = make_float4(t1_[0], t1_[1], t1_[2], t1_[3]); V2 = make_float4(t2_[0], t2_[1], t2_[2], t2_[3]); V3 = make_float4(t3_[0], t3_[1], t3_[2], t3_[3]); } } while (0)
__device__ __forceinline__ void prep_put(float* tile, int kk, int c4, const float4& v, float sc) {
    float* t = tile + kk * 65 + c4; t[0] = v.x * sc; t[1] = v.y * sc; t[2] = v.z * sc; t[3] = v.w * sc;
}
template <int MAP>
__device__ __forceinline__ void prep_job(const float* src, int ld, int Nsrc, size_t src_stride, const float* scale, bf16_t* dst, size_t dst_stride, int K, int nbatch, float* tiles, int& rot, const int tid, const int bi, const int G) {
    const int tn = (Nsrc + 63) / 64, tk = K / 64, per = tn * tk, total = per * nbatch;
    int t = (bi - rot + G) % G, buf = 0;
    float4 a0 = make_float4(0.f, 0.f, 0.f, 0.f), a1 = a0, a2 = a0, a3 = a0, b0 = a0, b1 = a0, b2 = a0, b3 = a0;
    if (t < total) { const int e = t / per, tt = t % per; PREP_LOAD(a0, a1, a2, a3, src + (size_t)e * src_stride, (tt / tn) * 64, (tt % tn) * 64); }
    for (; t < total; t += G) {
        const int e = t / per, tt = t % per, k0 = (tt / tn) * 64, c0 = (tt % tn) * 64;
        const int t2 = t + G;
        if (t2 < total) { const int e2 = t2 / per, tt2 = t2 % per; PREP_LOAD(b0, b1, b2, b3, src + (size_t)e2 * src_stride, (tt2 / tn) * 64, (tt2 % tn) * 64); }
        float* tile = tiles + buf * (64 * 65);
        {
            const int kk = tid >> 4, c4 = (tid & 15) * 4;
            const float s0 = scale ? scale[k0 + kk] : 1.f, s1 = scale ? scale[k0 + kk + 16] : 1.f, s2 = scale ? scale[k0 + kk + 32] : 1.f, s3 = scale ? scale[k0 + kk + 48] : 1.f;
            prep_put(tile, kk, c4, a0, s0); prep_put(tile, kk + 16, c4, a1, s1); prep_put(tile, kk + 32, c4, a2, s2); prep_put(tile, kk + 48, c4, a3, s3);
        }
        __syncthreads();
        bf16_t* d = dst + (size_t)e * dst_stride;
#pragma unroll
        for (int i = 0; i < 2; ++i) {
            const int idx = tid + 256 * i, c = idx >> 3, kc = idx & 7;
            if (c0 + c < Nsrc) {
                const float* q = tile + (kc * 8) * 65 + c;
                uint4 pk;
                pk.x = pack2(q[0], q[65]); pk.y = pack2(q[130], q[195]); pk.z = pack2(q[260], q[325]); pk.w = pack2(q[390], q[455]);
                *(uint4*)(d + (size_t)dstrow<MAP>(c0 + c) * K + k0 + kc * 8) = pk;
            }
        }
        a0 = b0; a1 = b1; a2 = b2; a3 = b3; buf ^= 1;
    }
    __syncthreads();
    rot = (rot + total) % G;
}

__device__ __forceinline__ void phase_prep(const Params& P, char* lds) {
    float* tile = (float*)lds;
    const nv::Inputs& in = P.in; const WS& w = P.w;
    const int G = gridDim.x, bid = blockIdx.x, tid = opaque_tid();
    int rot = 0;
    for (int L = 0; L < 2; ++L) {
        prep_job<MAP_W1>(in.w_in + (size_t)L * 1024 * 1440, 1440, 1440, 0, in.mix_norm_g + L * 1024, w.W1t + L * W1_SZ, 0, 1024, 1, tile, rot, tid, bid, G);
        prep_job<MAP_UQ>(in.w_uq + (size_t)L * 256 * 768, 768, 768, 0, in.q_a_norm_g + L * 256, w.Wuqt + L * WUQ_SZ, 0, 256, 1, tile, rot, tid, bid, G);
        prep_job<MAP_UKV>(in.w_ukv + (size_t)L * 128 * 1024, 1024, 1024, 0, in.kv_a_norm_g + L * 128, w.Wukvt + L * WUKV_SZ, 0, 128, 1, tile, rot, tid, bid, G);
        prep_job<MAP_ID>(in.conv_pw_w + (size_t)L * 256 * 256, 256, 256, 0, nullptr, w.Wpwt + L * WPW_SZ, 0, 256, 1, tile, rot, tid, bid, G);
        prep_job<MAP_ID>(in.w_o + (size_t)L * 1024 * 1024, 1024, 1024, 0, in.branch_norm_g + L * 1024, w.Wot + L * WO_SZ, 0, 1024, 1, tile, rot, tid, bid, G);
        prep_job<MAP_ID>(in.ple_gate_w + (size_t)L * 1024 * 1024, 1024, 1024, 0, in.ple_norm_g + L * 1024, w.Wgt + L * WG_SZ, 0, 1024, 1, tile, rot, tid, bid, G);
        prep_job<MAP_ID>(in.ple_proj_w + (size_t)L * 256 * 1024, 1024, 1024, 0, nullptr, w.Wpt + L * WP_SZ, 0, 256, 1, tile, rot, tid, bid, G);
        for (int i = bid * 256 + tid; i < 96 * 1024 / 8; i += G * 256) *(uint4*)(w.W1t + L * W1_SZ + (size_t)1440 * 1024 + (size_t)i * 8) = make_uint4(0u, 0u, 0u, 0u);
        for (int i = bid * 256 + tid; i < 128 * 1024; i += G * 256) {
            int n = i >> 10, k = i & 1023; float v = 0.f;
            if (n < 4) v = in.router_group_w[(size_t)L * 1024 * 4 + k * 4 + n];
            else if (n < 36) v = in.router_expert_w[(size_t)L * 1024 * 32 + k * 32 + (n - 4)];
            v *= in.ffn_norm_g[L * 1024 + k];
            w.Wrt[L * WR_SZ + i] = (bf16_t)f2bf(v);
        }
        for (int i = bid * 256 + tid; i < 4 * 128 * 128; i += G * 256) {
            int jj = i & 127, ii = (i >> 7) & 127;
            float v = (jj <= ii) ? in.sgu_w[(size_t)L * WSM_SZ + i] : 0.f;
            w.Wsm[L * WSM_SZ + i] = (bf16_t)f2bf(v);
        }
    }
    for (int i = bid * 256 + tid; i < NT * 16; i += G * 256) {
        int t = i >> 4, j = i & 15;
        float c, sn; rope_cs(in.positions[t], j, c, sn);
        w.cs[t * 32 + j] = c; w.cs[t * 32 + 16 + j] = sn;
    }
    for (int row = bid * 4 + (tid >> 6); row < NT; row += G * 4) {
        const int lane = tid & 63;
        float ss = 0.f;
#pragma unroll
        for (int j = 0; j < 4; ++j) {
            const size_t i = (size_t)row * 256 + j * 64 + lane;
            const float4 v = ((const float4*)in.x)[i];
            uint2 pk; pk.x = pack2(v.x, v.y); pk.y = pack2(v.z, v.w);
            ((uint2*)w.hb)[i] = pk;
            ss += v.x * v.x + v.y * v.y + v.z * v.z + v.w * v.w;
        }
        ss = wave_sum64(ss);
        if (lane < 8) w.rssA[(size_t)row * 8 + lane] = lane == 0 ? ss : 0.f;
    }
}

constexpr int DOWNQ = 88;
constexpr int ERAW_Q = 104;
constexpr int PREP_THIRD = 683, PREP_NCH = 3 * PREP_THIRD, PREP_Q = 100;
template <int MAP>
__device__ __forceinline__ void prep_burst3(const float* src, int ld, int Nsrc, size_t src_stride, const float* scale, bf16_t* dst, size_t dst_stride, int K, int nbatch, float* tiles, const int tid, const int bi, const int G) {
    const int tn = (Nsrc + 63) / 64, tk = K / 64, per = tn * tk, total = per * nbatch;
    float4 a0 = make_float4(0.f, 0.f, 0.f, 0.f), a1 = a0, a2 = a0, a3 = a0, b0 = a0, b1 = a0, b2 = a0, b3 = a0, c0_ = a0, c1_ = a0, c2_ = a0, c3_ = a0;
    const int t0 = bi, t1 = bi + G, t2 = bi + 2 * G;
    if (t0 < total) { const int e = t0 / per, tt = t0 % per; PREP_LOAD(a0, a1, a2, a3, src + (size_t)e * src_stride, (tt / tn) * 64, (tt % tn) * 64); }
    if (t1 < total) { const int e = t1 / per, tt = t1 % per; PREP_LOAD(b0, b1, b2, b3, src + (size_t)e * src_stride, (tt / tn) * 64, (tt % tn) * 64); }
    if (t2 < total) { const int e = t2 / per, tt = t2 % per; PREP_LOAD(c0_, c1_, c2_, c3_, src + (size_t)e * src_stride, (tt / tn) * 64, (tt % tn) * 64); }
#pragma unroll
    for (int q = 0; q < 3; ++q) {
        const int t = bi + q * G;
        if (t < total) {
            const int e = t / per, tt = t % per, k0 = (tt / tn) * 64, c0 = (tt % tn) * 64;
            float* tile = tiles + (q & 1) * (64 * 65);
            {
                const int kk = tid >> 4, c4 = (tid & 15) * 4;
                const float s0 = scale ? scale[k0 + kk] : 1.f, s1 = scale ? scale[k0 + kk + 16] : 1.f, s2 = scale ? scale[k0 + kk + 32] : 1.f, s3 = scale ? scale[k0 + kk + 48] : 1.f;
                const float4 v0 = q == 0 ? a0 : q == 1 ? b0 : c0_, v1 = q == 0 ? a1 : q == 1 ? b1 : c1_, v2 = q == 0 ? a2 : q == 1 ? b2 : c2_, v3 = q == 0 ? a3 : q == 1 ? b3 : c3_;
                prep_put(tile, kk, c4, v0, s0); prep_put(tile, kk + 16, c4, v1, s1); prep_put(tile, kk + 32, c4, v2, s2); prep_put(tile, kk + 48, c4, v3, s3);
            }
            __syncthreads();
            bf16_t* d = dst + (size_t)e * dst_stride;
#pragma unroll
            for (int i = 0; i < 2; ++i) {
                const int idx = tid + 256 * i, cc = idx >> 3, kc = idx & 7;
                if (c0 + cc < Nsrc) {
                    const float* qq = tile + (kc * 8) * 65 + cc;
                    uint4 pk;
                    pk.x = pack2(qq[0], qq[65]); pk.y = pack2(qq[130], qq[195]); pk.z = pack2(qq[260], qq[325]); pk.w = pack2(qq[390], qq[455]);
                    *(uint4*)(d + (size_t)dstrow<MAP>(c0 + cc) * K + k0 + kc * 8) = pk;
                }
            }
        }
    }
    __syncthreads();
}
__device__ __forceinline__ void prep_chunk(const Params& P, const int c, char* lds, const int tid) {
    float* tile = (float*)lds;
    const nv::Inputs& in = P.in; const WS& w = P.w;
    if (c < PREP_THIRD) prep_burst3<MAP_GATE>(in.moe_w_gate, 256, 256, (size_t)1024 * 256, in.ffn_norm_g, w.Wgut, (size_t)512 * 1024, 1024, 32, tile, tid, c, PREP_THIRD);
    else if (c < 2 * PREP_THIRD) prep_burst3<MAP_UP>(in.moe_w_up, 256, 256, (size_t)1024 * 256, in.ffn_norm_g, w.Wgut, (size_t)512 * 1024, 1024, 32, tile, tid, c - PREP_THIRD, PREP_THIRD);
    else prep_burst3<MAP_ID>(in.moe_w_down, 1024, 1024, (size_t)256 * 1024, nullptr, w.Wdt, (size_t)1024 * 256, 256, 32, tile, tid, c - 2 * PREP_THIRD, PREP_THIRD);
}
__device__ __forceinline__ void prep_chunk_drain(const Params& P, char* lds, const int tid) {
    volatile int* slot = (volatile int*)(lds + 40960);
    for (;;) {
        if (tid == 0) *slot = atomicAdd(&P.w.cnt[PREP_Q], 1);
        __syncthreads();
        const int cc = *slot;
        __syncthreads();
        if (cc >= PREP_NCH) break;
        prep_chunk(P, cc, lds, tid);
    }
}

__device__ __forceinline__ void prep_moe_late(const Params& P, int part, char* lds, const int tid, const int bi, const int nb) {
    float* tile = (float*)lds;
    const nv::Inputs& in = P.in; const WS& w = P.w;
    int rot = 0; const int L = 1;
    const float* up = in.moe_w_up + (size_t)L * 32 * 1024 * 256;
    if (part == 0) {
        prep_job<MAP_GATE>(in.moe_w_gate + (size_t)L * 32 * 1024 * 256, 256, 256, (size_t)1024 * 256, in.ffn_norm_g + L * 1024, w.Wgut + L * WGU_SZ, (size_t)512 * 1024, 1024, 32, tile, rot, tid, bi, nb);
        prep_job<MAP_UP>(up, 256, 256, (size_t)1024 * 256, in.ffn_norm_g + L * 1024, w.Wgut + L * WGU_SZ, (size_t)512 * 1024, 1024, 16, tile, rot, tid, bi, nb);
    } else {
        prep_job<MAP_UP>(up + (size_t)16 * 1024 * 256, 256, 256, (size_t)1024 * 256, in.ffn_norm_g + L * 1024, w.Wgut + L * WGU_SZ + (size_t)16 * 512 * 1024, (size_t)512 * 1024, 1024, 16, tile, rot, tid, bi, nb);
        prep_job<MAP_ID>(in.moe_w_down + (size_t)L * 32 * 256 * 1024, 1024, 1024, (size_t)256 * 1024, nullptr, w.Wdt + L * WD_SZ, (size_t)1024 * 256, 256, 32, tile, rot, tid, bi, nb);
    }
    __syncthreads();
}

__device__ __forceinline__ int lds_off(int row, int chunk) { return row * 128 + ((chunk ^ ((row >> 1) & 7)) << 4); }

template <typename AT> struct ARaw;
template <> struct ARaw<bf16_t> { uint4 v[4]; };
template <> struct ARaw<float> { float4 v[4][2]; };

__device__ __forceinline__ void a_load(ARaw<bf16_t>& r, const bf16_t* const (&rowp)[4], int koff) {
#pragma unroll
    for (int i = 0; i < 4; ++i) r.v[i] = *(const uint4*)(rowp[i] + koff);
}
__device__ __forceinline__ void a_load(ARaw<float>& r, const float* const (&rowp)[4], int koff) {
#pragma unroll
    for (int i = 0; i < 4; ++i) { r.v[i][0] = *(const float4*)(rowp[i] + koff); r.v[i][1] = *(const float4*)(rowp[i] + koff + 4); }
}
template <bool SUMSQ> __device__ __forceinline__ uint4 a_cvt(const uint4& v, float& ss) {
    if (SUMSQ) {
        float a;
        a = bflo(v.x); ss = fmaf(a, a, ss); a = bfhi(v.x); ss = fmaf(a, a, ss);
        a = bflo(v.y); ss = fmaf(a, a, ss); a = bfhi(v.y); ss = fmaf(a, a, ss);
        a = bflo(v.z); ss = fmaf(a, a, ss); a = bfhi(v.z); ss = fmaf(a, a, ss);
        a = bflo(v.w); ss = fmaf(a, a, ss); a = bfhi(v.w); ss = fmaf(a, a, ss);
    }
    return v;
}
template <bool SUMSQ> __device__ __forceinline__ void a_store(const ARaw<bf16_t>& r, char* ldsA, int tid, float (&ss)[4]) {
#pragma unroll
    for (int i = 0; i < 4; ++i) { uint4 v = a_cvt<SUMSQ>(r.v[i], ss[i]); *(uint4*)(ldsA + lds_off((tid >> 3) + 32 * i, tid & 7)) = v; }
}
template <bool SUMSQ> __device__ __forceinline__ void a_store(const ARaw<float>& r, char* ldsA, int tid, float (&ss)[4]) {
#pragma unroll
    for (int i = 0; i < 4; ++i) {
        const float4 a = r.v[i][0], b = r.v[i][1];
        if (SUMSQ) ss[i] += a.x * a.x + a.y * a.y + a.z * a.z + a.w * a.w + b.x * b.x + b.y * b.y + b.z * b.z + b.w * b.w;
        uint4 v; v.x = pack2(a.x, a.y); v.y = pack2(a.z, a.w); v.z = pack2(b.x, b.y); v.w = pack2(b.z, b.w);
        *(uint4*)(ldsA + lds_off((tid >> 3) + 32 * i, tid & 7)) = v;
    }
}

struct bf16x3_t {};
template <> struct ARaw<bf16x3_t> { uint4 a[4], b[4], c[4]; };
struct Rows3 { const bf16_t* p[2][4]; };
__device__ __forceinline__ void a_load(ARaw<bf16x3_t>& r, const Rows3& rows, int koff) {
#pragma unroll
    for (int i = 0; i < 4; ++i) { r.a[i] = *(const uint4*)(rows.p[0][i] + koff); r.b[i] = *(const uint4*)(rows.p[1][i] + koff); r.c[i] = *(const uint4*)(rows.p[1][i] + koff + 1024); }
}
__device__ __forceinline__ unsigned add3pk(unsigned a, unsigned b, unsigned c, float& ss) {
    const float lo = bflo(a) + bflo(b) + bflo(c), hi = bfhi(a) + bfhi(b) + bfhi(c);
    ss = fmaf(lo, lo, ss); ss = fmaf(hi, hi, ss);
    return pack2(lo, hi);
}
template <bool SUMSQ> __device__ __forceinline__ void a_store(const ARaw<bf16x3_t>& r, char* ldsA, int tid, float (&ss)[4]) {
#pragma unroll
    for (int i = 0; i < 4; ++i) {
        uint4 v;
        v.x = add3pk(r.a[i].x, r.b[i].x, r.c[i].x, ss[i]); v.y = add3pk(r.a[i].y, r.b[i].y, r.c[i].y, ss[i]);
        v.z = add3pk(r.a[i].z, r.b[i].z, r.c[i].z, ss[i]); v.w = add3pk(r.a[i].w, r.b[i].w, r.c[i].w, ss[i]);
        *(uint4*)(ldsA + lds_off((tid >> 3) + 32 * i, tid & 7)) = v;
    }
}

template <typename AT, bool SUMSQ, int SUNROLL = 4, typename AROWS>
__device__ __forceinline__ void gemm_mainloop(f32x16 (&acc)[2][2], const AROWS& arow, const bf16_t* const (&wrow)[4], int nkt, char* lds, float (&ss)[4], const int tid) {
    const int lane = tid & 63, wid = tid >> 6, wr = wid >> 1, wc = wid & 1;
    ARaw<AT> ra; ARaw<bf16_t> rb; float dummy[4] = {0.f, 0.f, 0.f, 0.f};
    a_load(ra, arow, 0); a_load(rb, wrow, 0);
    a_store<SUMSQ>(ra, lds, tid, ss); a_store<false>(rb, lds + 16384, tid, dummy);
    __syncthreads();
    const int fr = lane & 31, fh = lane >> 5;
#pragma unroll 1
    for (int kt = 0; kt < nkt; ++kt) {
        char* cur = lds + (kt & 1) * 32768;
        char* nxt = lds + ((kt + 1) & 1) * 32768;
        const bool more = (kt + 1 < nkt);
        if (more) { a_load(ra, arow, (kt + 1) * 64); a_load(rb, wrow, (kt + 1) * 64); }
#pragma unroll SUNROLL
        for (int s = 0; s < 4; ++s) {
            bf16x8 xa[2], wb[2];
#pragma unroll
            for (int i = 0; i < 2; ++i) xa[i] = *(const bf16x8*)(cur + lds_off(wr * 64 + i * 32 + fr, 2 * s + fh));
#pragma unroll
            for (int j = 0; j < 2; ++j) wb[j] = *(const bf16x8*)(cur + 16384 + lds_off(wc * 64 + j * 32 + fr, 2 * s + fh));
#pragma unroll
            for (int i = 0; i < 2; ++i)
#pragma unroll
                for (int j = 0; j < 2; ++j) acc[i][j] = __builtin_amdgcn_mfma_f32_32x32x16_bf16(wb[j], xa[i], acc[i][j], 0, 0, 0);
        }
        if (more) { a_store<SUMSQ>(ra, nxt, tid, ss); a_store<false>(rb, nxt + 16384, tid, dummy); }
        __syncthreads();
    }
}
constexpr int GST = 16384;
__device__ __forceinline__ int gl_chunk(int tid) { return (tid & 3) ^ ((tid >> 4) & 3); }
__device__ __forceinline__ int gl_off(int row, int chunk) { return row * 64 + ((chunk ^ ((row >> 2) & 3)) << 4); }
typedef __attribute__((address_space(3))) unsigned lds_u32_t;
__device__ __forceinline__ void glds16(const bf16_t* g, char* l) {
    __builtin_amdgcn_global_load_lds((const unsigned*)g, (lds_u32_t*)l, 16, 0, 0);
}
typedef unsigned u32x4 __attribute__((ext_vector_type(4)));
typedef float f32x2 __attribute__((ext_vector_type(2)));
__device__ __forceinline__ unsigned lds_addr(const char* p) { return (unsigned)(size_t)(const __attribute__((address_space(3))) char*)p; }
__device__ __forceinline__ void bglds16(const __amdgpu_buffer_rsrc_t r, const unsigned voff, const int soff, char* l) {
    __builtin_amdgcn_raw_ptr_buffer_load_lds(r, (lds_u32_t*)l, 16, (int)voff, soff, 0, 0);
}
#define RAW_BARRIER() do { asm volatile("s_waitcnt lgkmcnt(0)" ::: "memory"); __builtin_amdgcn_s_barrier(); } while (0)
template <bool SEG = false>
__device__ __forceinline__ void gemm_mainloop_g(f32x16 (&acc)[2][2], const bf16_t* const (&arow)[2], const bf16_t* const (&wrow)[2], const int nkt, char* lds, const int tid,
                                                const int rot = 0, const int kt1 = -1, const float* f1 = nullptr, const int kt2 = -1, const float* f2 = nullptr) {
    const int lane = tid & 63, wid = tid >> 6, wr = wid >> 1, wc = wid & 1, fr = lane & 31, fh = lane >> 5;
    const int wbase = __builtin_amdgcn_readfirstlane(wid) * 1024;
#pragma unroll 1
    for (int p = 0; p < 3; ++p) if (p < nkt) {
        char* st = lds + p * GST + wbase;
        const int ko = SEG ? ((p + rot) & (nkt - 1)) * 32 : p * 32;
        glds16(arow[0] + ko, st); glds16(arow[1] + ko, st + 4096);
        glds16(wrow[0] + ko, st + 8192); glds16(wrow[1] + ko, st + 8192 + 4096);
    }
    const int ra0 = gl_off(wr * 64 + fr, fh), ra1 = gl_off(wr * 64 + 32 + fr, fh);
    const int rb0 = 8192 + gl_off(wc * 64 + fr, fh), rb1 = 8192 + gl_off(wc * 64 + 32 + fr, fh);
#pragma unroll 1
    for (int kt = 0; kt < nkt; ++kt) {
        if (kt + 2 < nkt) asm volatile("s_waitcnt vmcnt(8)" ::: "memory");
        else if (kt + 1 < nkt) asm volatile("s_waitcnt vmcnt(4)" ::: "memory");
        else asm volatile("s_waitcnt vmcnt(0)" ::: "memory");
        RAW_BARRIER();
        if (kt + 3 < nkt) {
            char* st = lds + ((kt + 3) & 3) * GST + wbase;
            const int ko = SEG ? ((kt + 3 + rot) & (nkt - 1)) * 32 : (kt + 3) * 32;
            glds16(arow[0] + ko, st); glds16(arow[1] + ko, st + 4096);
            glds16(wrow[0] + ko, st + 8192); glds16(wrow[1] + ko, st + 8192 + 4096);
        }
        const char* cur = lds + (kt & 3) * GST;
        if (SEG && (kt == kt1 || kt == kt2)) {
            const float* f = kt == kt1 ? f1 : f2;
#pragma unroll
            for (int i = 0; i < 2; ++i) {
                const float v = f[wr * 64 + i * 32 + fr];
#pragma unroll
                for (int j = 0; j < 2; ++j)
#pragma unroll
                    for (int r = 0; r < 16; ++r) acc[i][j][r] *= v;
            }
        }
        bf16x8 xa[2][2], wb[2][2];
#pragma unroll
        for (int s2 = 0; s2 < 2; ++s2) {
            xa[s2][0] = *(const bf16x8*)(cur + (ra0 ^ (s2 << 5))); xa[s2][1] = *(const bf16x8*)(cur + (ra1 ^ (s2 << 5)));
            wb[s2][0] = *(const bf16x8*)(cur + (rb0 ^ (s2 << 5))); wb[s2][1] = *(const bf16x8*)(cur + (rb1 ^ (s2 << 5)));
        }
        __builtin_amdgcn_sched_barrier(0);
#pragma unroll
        for (int s2 = 0; s2 < 2; ++s2) {
            acc[0][0] = __builtin_amdgcn_mfma_f32_32x32x16_bf16(wb[s2][0], xa[s2][0], acc[0][0], 0, 0, 0);
            acc[0][1] = __builtin_amdgcn_mfma_f32_32x32x16_bf16(wb[s2][1], xa[s2][0], acc[0][1], 0, 0, 0);
            acc[1][0] = __builtin_amdgcn_mfma_f32_32x32x16_bf16(wb[s2][0], xa[s2][1], acc[1][0], 0, 0, 0);
            acc[1][1] = __builtin_amdgcn_mfma_f32_32x32x16_bf16(wb[s2][1], xa[s2][1], acc[1][1], 0, 0, 0);
        }
    }
    RAW_BARRIER();
}
__device__ __forceinline__ int g64_chunk(int tid) { return (tid & 7) ^ ((tid >> 4) & 7); }
#define G64_RD(buf, st_, s_)                                                                                                                      \
    do {                                                                                                                                          \
        xa[buf][0] = *(const bf16x8*)((st_) + lds_off(wr * 64 + fr, 2 * (s_) + fh));                                                             \
        wb[buf][0] = *(const bf16x8*)((st_) + 16384 + lds_off(wc * 64 + fr, 2 * (s_) + fh));                                                     \
        wb[buf][1] = *(const bf16x8*)((st_) + 16384 + lds_off(wc * 64 + 32 + fr, 2 * (s_) + fh));                                                \
        xa[buf][1] = *(const bf16x8*)((st_) + lds_off(wr * 64 + 32 + fr, 2 * (s_) + fh));                                                        \
    } while (0)
#define G64_MM(buf, i_, j_) acc[i_][j_] = __builtin_amdgcn_mfma_f32_32x32x16_bf16(wb[buf][j_], xa[buf][i_], acc[i_][j_], 0, 0, 0)
template <bool SEG = false, int ABL = 0>
__device__ __forceinline__ void gemm_mainloop_g64(f32x16 (&acc)[2][2], const bf16_t* const (&arow)[4], const bf16_t* const (&wrow)[4], const int nkt, char* lds, const int tid,
                                                  const int rot = 0, const int kt1 = -1, const float* f1 = nullptr, const int kt2 = -1, const float* f2 = nullptr) {
    const int lane = tid & 63, wid = tid >> 6, wr = wid >> 1, wc = wid & 1, fr = lane & 31, fh = lane >> 5;
    const int wbase = __builtin_amdgcn_readfirstlane(wid) * 1024;
    bf16x8 xa[2][2], wb[2][2];
    {
        char* st = lds + wbase;
        const int ko0 = SEG ? (rot & (nkt - 1)) * 64 : 0;
#pragma unroll
        for (int i = 0; i < 4; ++i) if (ABL != 3) { glds16(arow[i] + ko0, st + i * 4096); glds16(wrow[i] + ko0, st + 16384 + i * 4096); }
        if (nkt > 1) {
            char* st1 = lds + 32768 + wbase;
            const int ko = SEG ? ((1 + rot) & (nkt - 1)) * 64 : 64;
#pragma unroll
            for (int i = 0; i < 4; ++i) if (ABL != 3) { glds16(arow[i] + ko, st1 + i * 4096); glds16(wrow[i] + ko, st1 + 16384 + i * 4096); }
            asm volatile("s_waitcnt vmcnt(8)" ::: "memory");
        } else asm volatile("s_waitcnt vmcnt(0)" ::: "memory");
        RAW_BARRIER();
        G64_RD(0, lds, 0);
    }
#pragma unroll 1
    for (int kt = 0; kt < nkt; ++kt) {
        const char* cur = lds + (kt & 1) * 32768;
        if (SEG && (kt == kt1 || kt == kt2)) {
            const float* f = kt == kt1 ? f1 : f2;
#pragma unroll
            for (int i = 0; i < 2; ++i) {
                const float v = f[wr * 64 + i * 32 + fr];
#pragma unroll
                for (int j = 0; j < 2; ++j)
#pragma unroll
                    for (int r = 0; r < 16; ++r) acc[i][j][r] *= v;
            }
        }
        G64_MM(0, 0, 0); G64_RD(1, cur, 1); G64_MM(0, 0, 1); G64_MM(0, 1, 0); G64_MM(0, 1, 1);
        __builtin_amdgcn_sched_group_barrier(0x008, 1, 0); __builtin_amdgcn_sched_group_barrier(0x100, 4, 0); __builtin_amdgcn_sched_group_barrier(0x008, 3, 0);
        G64_MM(1, 0, 0); G64_RD(0, cur, 2); G64_MM(1, 0, 1); G64_MM(1, 1, 0); G64_MM(1, 1, 1);
        __builtin_amdgcn_sched_group_barrier(0x008, 1, 0); __builtin_amdgcn_sched_group_barrier(0x100, 4, 0); __builtin_amdgcn_sched_group_barrier(0x008, 3, 0);
        G64_MM(0, 0, 0); G64_RD(1, cur, 3); G64_MM(0, 0, 1); G64_MM(0, 1, 0); G64_MM(0, 1, 1);
        __builtin_amdgcn_sched_group_barrier(0x008, 1, 0); __builtin_amdgcn_sched_group_barrier(0x100, 4, 0); __builtin_amdgcn_sched_group_barrier(0x008, 3, 0);
        if (kt + 1 < nkt) {
            asm volatile("s_waitcnt vmcnt(0)" ::: "memory");
            RAW_BARRIER();
            if (kt + 2 < nkt) {
                char* st = lds + (kt & 1) * 32768 + wbase;
                const int ko = SEG ? ((kt + 2 + rot) & (nkt - 1)) * 64 : (kt + 2) * 64;
#pragma unroll
                for (int i = 0; i < 4; ++i) if (ABL != 3) { glds16(arow[i] + ko, st + i * 4096); glds16(wrow[i] + ko, st + 16384 + i * 4096); }
            }
            const char* nxt = lds + ((kt + 1) & 1) * 32768;
            G64_RD(0, nxt, 0);
        }
        G64_MM(1, 0, 0); G64_MM(1, 0, 1); G64_MM(1, 1, 0); G64_MM(1, 1, 1);
    }
    RAW_BARRIER();
}
struct NoHook { __device__ __forceinline__ void operator()() const {} };
template <bool SEG = false, int ABL = 0, class HOOK = NoHook>
__device__ __forceinline__ void gemm_mainloop_b64(const bf16_t* a_base, const bf16_t* w_base, f32x16 (&acc)[2][2], const bf16_t* const (&arow)[4], const bf16_t* const (&wrow)[4], const int nkt, char* lds, const int tid,
                                                  const int rot = 0, const int kt1 = -1, const float* f1 = nullptr, const int kt2 = -1, const float* f2 = nullptr, HOOK hook = HOOK()) {
    const int lane = tid & 63, wid = tid >> 6, wr = wid >> 1, wc = wid & 1, fr = lane & 31, fh = lane >> 5;
    const int wbase = __builtin_amdgcn_readfirstlane(wid) * 1024;
    const __amdgpu_buffer_rsrc_t ra = __builtin_amdgcn_make_buffer_rsrc((void*)a_base, (short)0, 0x7fffffff, 0x00020000), rw = __builtin_amdgcn_make_buffer_rsrc((void*)w_base, (short)0, 0x7fffffff, 0x00020000);
    unsigned va[4], vw[4];
#pragma unroll
    for (int i = 0; i < 4; ++i) { va[i] = (unsigned)((const char*)arow[i] - (const char*)a_base); vw[i] = (unsigned)((const char*)wrow[i] - (const char*)w_base); }
    bf16x8 xa[2][2], wb[2][2];
    const char* pa[4]; const char* pb[4];
#pragma unroll
    for (int s = 0; s < 4; ++s) { pa[s] = lds + lds_off(wr * 64 + fr, 2 * s + fh); pb[s] = lds + 16384 + lds_off(wc * 64 + fr, 2 * s + fh); }
#define B64_RD(buf, SO_, s_)                                                                                              \
    do {                                                                                                                  \
        xa[buf][0] = *(const bf16x8*)(pa[s_] + (SO_));        wb[buf][0] = *(const bf16x8*)(pb[s_] + (SO_));              \
        wb[buf][1] = *(const bf16x8*)(pb[s_] + (SO_) + 4096); xa[buf][1] = *(const bf16x8*)(pa[s_] + (SO_) + 4096);       \
    } while (0)
    {
        char* st = lds + wbase;
        const int ko0 = SEG ? (rot & (nkt - 1)) * 64 : 0;
#pragma unroll
        for (int i = 0; i < 4; ++i) if (ABL != 3) { bglds16(ra, va[i], ko0 * 2, st + i * 4096); bglds16(rw, vw[i], ko0 * 2, st + 16384 + i * 4096); }
        if (nkt > 1) {
            char* st1 = lds + 32768 + wbase;
            const int ko = SEG ? ((1 + rot) & (nkt - 1)) * 64 : 64;
#pragma unroll
            for (int i = 0; i < 4; ++i) if (ABL != 3) { bglds16(ra, va[i], ko * 2, st1 + i * 4096); bglds16(rw, vw[i], ko * 2, st1 + 16384 + i * 4096); }
            asm volatile("s_waitcnt vmcnt(8)" ::: "memory");
        } else asm volatile("s_waitcnt vmcnt(0)" ::: "memory");
        RAW_BARRIER();
        B64_RD(0, 0, 0);
    }
    auto body = [&](const int kt, auto so_c, auto nso_c) __attribute__((always_inline)) {
        constexpr int SO = decltype(so_c)::value, NSO = decltype(nso_c)::value;
        if (SEG && (kt == kt1 || kt == kt2)) {
            const float* f = kt == kt1 ? f1 : f2;
#pragma unroll
            for (int i = 0; i < 2; ++i) {
                const float v = f[wr * 64 + i * 32 + fr];
#pragma unroll
                for (int j = 0; j < 2; ++j)
#pragma unroll
                    for (int r = 0; r < 16; ++r) acc[i][j][r] *= v;
            }
        }
        G64_MM(0, 0, 0); B64_RD(1, SO, 1); G64_MM(0, 0, 1); G64_MM(0, 1, 0); G64_MM(0, 1, 1);
        __builtin_amdgcn_sched_group_barrier(0x008, 2, 0); __builtin_amdgcn_sched_group_barrier(0x100, 4, 0); __builtin_amdgcn_sched_group_barrier(0x008, 2, 0);
        G64_MM(1, 0, 0); B64_RD(0, SO, 2); G64_MM(1, 0, 1); G64_MM(1, 1, 0); G64_MM(1, 1, 1);
        __builtin_amdgcn_sched_group_barrier(0x008, 2, 0); __builtin_amdgcn_sched_group_barrier(0x100, 4, 0); __builtin_amdgcn_sched_group_barrier(0x008, 2, 0);
        G64_MM(0, 0, 0); B64_RD(1, SO, 3); G64_MM(0, 0, 1); G64_MM(0, 1, 0); G64_MM(0, 1, 1);
        __builtin_amdgcn_sched_group_barrier(0x008, 2, 0); __builtin_amdgcn_sched_group_barrier(0x100, 4, 0); __builtin_amdgcn_sched_group_barrier(0x008, 2, 0);
        if (kt + 1 < nkt) {
            asm volatile("s_waitcnt vmcnt(0)" ::: "memory");
            RAW_BARRIER();
            if (kt + 2 == nkt) hook();
            if (kt + 2 < nkt) {
                char* st = lds + SO + wbase;
                const int ko = SEG ? ((kt + 2 + rot) & (nkt - 1)) * 64 : (kt + 2) * 64;
#pragma unroll
                for (int i = 0; i < 4; ++i) if (ABL != 3) { bglds16(ra, va[i], ko * 2, st + i * 4096); bglds16(rw, vw[i], ko * 2, st + 16384 + i * 4096); }
            }
            B64_RD(0, NSO, 0);
        }
        G64_MM(1, 0, 0); G64_MM(1, 0, 1); G64_MM(1, 1, 0); G64_MM(1, 1, 1);
    };
#pragma unroll 1
    for (int kt = 0; kt < nkt; kt += 2) {
        body(kt, std::integral_constant<int, 0>{}, std::integral_constant<int, 32768>{});
        if (kt + 1 < nkt) body(kt + 1, std::integral_constant<int, 32768>{}, std::integral_constant<int, 0>{});
    }
#undef B64_RD
    RAW_BARRIER();
}
__device__ __forceinline__ void acc_zero(f32x16 (&acc)[2][2]) {
#pragma unroll
    for (int i = 0; i < 2; ++i)
#pragma unroll
        for (int j = 0; j < 2; ++j)
#pragma unroll
            for (int r = 0; r < 16; ++r) acc[i][j][r] = 0.f;
}
__device__ __forceinline__ void publish_rowstat(float (&ss)[4], float* stat, float invK, bool as_rstd, const int tid) {
#pragma unroll
    for (int i = 0; i < 4; ++i) {
        float v = ss[i];
        v += __shfl_xor(v, 1); v += __shfl_xor(v, 2); v += __shfl_xor(v, 4);
        if ((tid & 7) == 0) stat[(tid >> 3) + 32 * i] = as_rstd ? rsqrtf(v * invK + EPS) : v;
    }
    __syncthreads();
}
__device__ __forceinline__ int nidx(int r, int fh) { return (r & 3) + 8 * (r >> 2) + 4 * fh; }
__device__ __forceinline__ uint4 pack8(const float4& a, const float4& b) { uint4 pk; pk.x = pack2(a.x, a.y); pk.y = pack2(a.z, a.w); pk.z = pack2(b.x, b.y); pk.w = pack2(b.z, b.w); return pk; }
__device__ __forceinline__ float sq8(const float4& a, const float4& b) { return (a.x * a.x + a.y * a.y) + (a.z * a.z + a.w * a.w) + (b.x * b.x + b.y * b.y) + (b.z * b.z + b.w * b.w); }
__device__ __forceinline__ float4 mul4(const float4& a, float s) { return make_float4(a.x * s, a.y * s, a.z * s, a.w * s); }
__device__ __forceinline__ void store4(bf16_t* p, float a, float b, float c, float d) {
    uint2 v; v.x = pack2(a, b); v.y = pack2(c, d); *(uint2*)p = v;
}

__device__ __forceinline__ bool xcd_item(int it, int MT, int NTl, int& mt, int& nt) {
    const int x = blockIdx.x & 7, lb = blockIdx.x >> 3, nlb = gridDim.x >> 3;
    const int li = it * nlb + lb, per = (MT >> 3) * NTl;
    if (li >= per) return false;
    mt = (li / NTl) * 8 + x; nt = li % NTl; return true;
}

constexpr int TLD = 132;
constexpr int STAT_OFF = 128 * TLD * 4;
constexpr int LDS_GEMM_BYTES = STAT_OFF + 2048;
__device__ __forceinline__ void acc_to_lds(const f32x16 (&acc)[2][2], float* T, const int tid) {
    const int lane = tid & 63, wid = tid >> 6, wr = wid >> 1, wc = wid & 1, fr = lane & 31, fh = lane >> 5;
#pragma unroll
    for (int i = 0; i < 2; ++i)
#pragma unroll
        for (int j = 0; j < 2; ++j)
#pragma unroll
            for (int g = 0; g < 4; ++g) {
                float4 v; v.x = acc[i][j][4 * g]; v.y = acc[i][j][4 * g + 1]; v.z = acc[i][j][4 * g + 2]; v.w = acc[i][j][4 * g + 3];
                *(float4*)(T + (wr * 64 + i * 32 + fr) * TLD + wc * 64 + j * 32 + 8 * g + 4 * fh) = v;
            }
    __syncthreads();
}
__device__ __forceinline__ float rstd8(const float* p, float invK) {
    const float4 a = *(const float4*)p, b = *(const float4*)(p + 4);
    return rsq_(((a.x + a.y) + (a.z + a.w) + (b.x + b.y) + (b.z + b.w)) * invK + EPS);
}

}
namespace fx {

__device__ __forceinline__ void phase_zgemm(const Params& P, int L, char* lds, const bool same = false) {
    const WS& w = P.w; const nv::Inputs& in = P.in;
    const int tid0 = opaque_tid();
    float* T = (float*)lds; float* stat = (float*)(lds + STAT_OFF);
    const bf16_t* Wt = w.W1t + L * W1_SZ;
    int mt, nt;
    for (int it = 0; xcd_item(it, 128, 12, mt, nt); ++it) {
        int tid = tid0; asm volatile("" : "+v"(tid));
        const int lane = tid & 63, wid = tid >> 6;
        const int m0 = mt * 128, n0 = nt * 128;
        {
            const bf16_t* arow[4]; const bf16_t* wrow[4];
#pragma unroll
            for (int i = 0; i < 4; ++i) {
                arow[i] = w.hb + (size_t)(m0 + (tid >> 3) + 32 * i) * 1024 + g64_chunk(tid) * 8;
                wrow[i] = Wt + (size_t)(n0 + (tid >> 3) + 32 * i) * 1024 + g64_chunk(tid) * 8;
            }
            f32x16 acc[2][2]; acc_zero(acc);
            float my_rs = 0.f;
            if (tid < 128) my_rs = rstd8(w.rssA + (size_t)(m0 + tid) * 8, 1.f / 1024.f);
#ifdef ZPROBE
            if (same) {
                gemm_mainloop_g64<false, ZPROBE>(acc, arow, wrow, 16, lds, tid);
                float sacc = 0.f;
#pragma unroll
                for (int i = 0; i < 2; ++i)
#pragma unroll
                    for (int j = 0; j < 2; ++j)
#pragma unroll
                        for (int r = 0; r < 16; ++r) sacc += acc[i][j][r];
                ((float*)w.hbuf)[blockIdx.x * 256 + tid] = sacc;
                __syncthreads();
                continue;
            }
#endif
            gemm_mainloop_b64(w.hb, Wt, acc, arow, wrow, 16, lds, tid);
            if (tid < 128) stat[tid] = my_rs;
            acc_to_lds(acc, T, tid);
        }
        const int sub = lane >> 4, l16 = lane & 15, c8 = l16 * 8;
        if (nt < 2) {
#pragma unroll 8
            for (int rr = 0; rr < 8; ++rr) {
                const int row = wid * 32 + rr * 4 + sub; const float rs = stat[row];
                float4 x0 = *(const float4*)(T + row * TLD + c8), x1 = *(const float4*)(T + row * TLD + c8 + 4);
                x0.x = gelu_tanh_(x0.x * rs); x0.y = gelu_tanh_(x0.y * rs); x0.z = gelu_tanh_(x0.z * rs); x0.w = gelu_tanh_(x0.w * rs);
                x1.x = gelu_tanh_(x1.x * rs); x1.y = gelu_tanh_(x1.y * rs); x1.z = gelu_tanh_(x1.z * rs); x1.w = gelu_tanh_(x1.w * rs);
                *(uint4*)(w.ub + (size_t)(m0 + row) * 256 + nt * 128 + c8) = pack8(x0, x1);
            }
        } else if (nt < 4) {
            const int hd = (nt - 2) * 2 + (l16 >> 3), d0 = (l16 & 7) * 8;
            const float4 g0 = *(const float4*)(in.sgu_ln_g + L * 256 + hd * 64 + d0), g1 = *(const float4*)(in.sgu_ln_g + L * 256 + hd * 64 + d0 + 4);
            const float4 b0 = *(const float4*)(in.sgu_ln_b + L * 256 + hd * 64 + d0), b1 = *(const float4*)(in.sgu_ln_b + L * 256 + hd * 64 + d0 + 4);
#pragma unroll 4
            for (int rr = 0; rr < 8; ++rr) {
                const int row = wid * 32 + rr * 4 + sub; const float rs = stat[row];
                float4 x0 = *(const float4*)(T + row * TLD + c8), x1 = *(const float4*)(T + row * TLD + c8 + 4);
                x0.x = gelu_tanh_(x0.x * rs); x0.y = gelu_tanh_(x0.y * rs); x0.z = gelu_tanh_(x0.z * rs); x0.w = gelu_tanh_(x0.w * rs);
                x1.x = gelu_tanh_(x1.x * rs); x1.y = gelu_tanh_(x1.y * rs); x1.z = gelu_tanh_(x1.z * rs); x1.w = gelu_tanh_(x1.w * rs);
                const float mean = grp_sum8((x0.x + x0.y) + (x0.z + x0.w) + (x1.x + x1.y) + (x1.z + x1.w)) * (1.f / 64.f);
                x0.x -= mean; x0.y -= mean; x0.z -= mean; x0.w -= mean; x1.x -= mean; x1.y -= mean; x1.z -= mean; x1.w -= mean;
                const float rv = rsq_(grp_sum8(sq8(x0, x1)) * (1.f / 64.f) + EPS);
                x0.x = x0.x * rv * g0.x + b0.x; x0.y = x0.y * rv * g0.y + b0.y; x0.z = x0.z * rv * g0.z + b0.z; x0.w = x0.w * rv * g0.w + b0.w;
                x1.x = x1.x * rv * g1.x + b1.x; x1.y = x1.y * rv * g1.y + b1.y; x1.z = x1.z * rv * g1.z + b1.z; x1.w = x1.w * rv * g1.w + b1.w;
                *(float4*)(T + row * TLD + c8) = x0; *(float4*)(T + row * TLD + c8 + 4) = x1;
            }
            __syncthreads();
            {
                const int c = tid & 127, th = tid >> 7, hd2 = (nt - 2) * 2 + (c >> 6), d = c & 63;
                bf16_t* dst = w.vT + ((size_t)(mt * 4 + hd2) * 64 + d) * 128 + th * 64;
#pragma unroll 2
                for (int k8 = 0; k8 < 8; ++k8) {
                    float v[8];
#pragma unroll
                    for (int k = 0; k < 8; ++k) v[k] = T[(th * 64 + k8 * 8 + k) * TLD + c];
                    uint4 pk; pk.x = pack2(v[0], v[1]); pk.y = pack2(v[2], v[3]); pk.z = pack2(v[4], v[5]); pk.w = pack2(v[6], v[7]);
                    *(uint4*)(dst + k8 * 8) = pk;
                }
            }
        } else if (nt < 8) {
#pragma unroll 8
            for (int rr = 0; rr < 8; ++rr) {
                const int row = wid * 32 + rr * 4 + sub; const float rs = stat[row];
                const float4 x0 = *(const float4*)(T + row * TLD + c8), x1 = *(const float4*)(T + row * TLD + c8 + 4);
                store4(w.ygb + (size_t)(m0 + row) * 256 + (nt - 4) * 64 + l16 * 4, x0.x * rs * sigmoid_(x0.y * rs), x0.z * rs * sigmoid_(x0.w * rs),
                       x1.x * rs * sigmoid_(x1.y * rs), x1.z * rs * sigmoid_(x1.w * rs));
            }
        } else if (nt < 11) {
            bf16_t* base; int ld, cb;
            if (nt < 10) { base = w.cqb; ld = 256; cb = (nt - 8) * 128; } else { base = w.ckvb; ld = 128; cb = 0; }
#pragma unroll 8
            for (int rr = 0; rr < 8; ++rr) {
                const int row = wid * 32 + rr * 4 + sub; const float rs = stat[row];
                const float4 x0 = mul4(*(const float4*)(T + row * TLD + c8), rs), x1 = mul4(*(const float4*)(T + row * TLD + c8 + 4), rs);
                *(uint4*)(base + (size_t)(m0 + row) * ld + cb + c8) = pack8(x0, x1);
                const float sq = grp_sum16(sq8(x0, x1));
                if (l16 == 0) w.cqss[(size_t)(m0 + row) * 4 + (nt - 8)] = sq;
            }
        } else {
            const int lq = l16 & 3, dd = lq * 8, jj = (lq & 1) * 8;
            const float4 kg0 = *(const float4*)(in.k_norm_g + L * 96 + 64 + dd), kg1 = *(const float4*)(in.k_norm_g + L * 96 + 64 + dd + 4);
#pragma unroll 1
            for (int hb4 = 0; hb4 < 2; ++hb4) {
                float4 cc0[4], cc1[4], ss0[4], ss1[4];
#pragma unroll
                for (int r4 = 0; r4 < 4; ++r4) {
                    const float* csr = w.cs + (size_t)(m0 + wid * 32 + (hb4 * 4 + r4) * 4 + sub) * 32 + jj;
                    cc0[r4] = *(const float4*)csr; cc1[r4] = *(const float4*)(csr + 4); ss0[r4] = *(const float4*)(csr + 16); ss1[r4] = *(const float4*)(csr + 20);
                }
#pragma unroll
                for (int r4 = 0; r4 < 4; ++r4) {
                    const int row = wid * 32 + (hb4 * 4 + r4) * 4 + sub; const float rs = stat[row]; const int tok = m0 + row;
                    float4 x0 = mul4(*(const float4*)(T + row * TLD + dd), rs), x1 = mul4(*(const float4*)(T + row * TLD + dd + 4), rs);
                    const float rn = rsq_(grp_sum4(sq8(x0, x1)) * (1.f / 32.f) + EPS);
                    x0.x *= rn * kg0.x; x0.y *= rn * kg0.y; x0.z *= rn * kg0.z; x0.w *= rn * kg0.w;
                    x1.x *= rn * kg1.x; x1.y *= rn * kg1.y; x1.z *= rn * kg1.z; x1.w *= rn * kg1.w;
                    const float4 o0 = make_float4(quad_x2(x0.x), quad_x2(x0.y), quad_x2(x0.z), quad_x2(x0.w)), o1 = make_float4(quad_x2(x1.x), quad_x2(x1.y), quad_x2(x1.z), quad_x2(x1.w));
                    const float4 c0 = cc0[r4], c1 = cc1[r4], s0 = ss0[r4], s1 = ss1[r4];
                    const float sg = (lq & 2) ? 1.f : -1.f;
                    float4 r0, r1;
                    r0.x = x0.x * c0.x + sg * o0.x * s0.x; r0.y = x0.y * c0.y + sg * o0.y * s0.y; r0.z = x0.z * c0.z + sg * o0.z * s0.z; r0.w = x0.w * c0.w + sg * o0.w * s0.w;
                    r1.x = x1.x * c1.x + sg * o1.x * s1.x; r1.y = x1.y * c1.y + sg * o1.y * s1.y; r1.z = x1.z * c1.z + sg * o1.z * s1.z; r1.w = x1.w * c1.w + sg * o1.w * s1.w;
                    if (l16 < 4) *(uint4*)(w.kpeb + (size_t)tok * 32 + dd) = pack8(r0, r1);
                }
            }
        }
        __syncthreads();
    }
}

}
namespace fx {

constexpr float QSCALE = 0.10206207261596575f * 1.4426950408889634f;

__device__ __forceinline__ void qkv_item(const Params& P, int L, const bool isq, const int mt, const int nt, char* lds, const int tid_in) {
    int tid = tid_in; asm volatile("" : "+v"(tid));
    const WS& w = P.w; const nv::Inputs& in = P.in;
    const int lane = tid & 63, wid = tid >> 6;
    float* T = (float*)lds; float* stat = (float*)(lds + STAT_OFF);
    const int m0 = mt * 128, n0 = nt * 128;
    const int K = isq ? 256 : 128;
    {
        const bf16_t* A = isq ? w.cqb : w.ckvb;
        const bf16_t* Wt = isq ? (w.Wuqt + L * WUQ_SZ) : (w.Wukvt + L * WUKV_SZ);
        const bf16_t* arow[4]; const bf16_t* wrow[4];
#pragma unroll
        for (int i = 0; i < 4; ++i) {
            arow[i] = A + (size_t)(m0 + (tid >> 3) + 32 * i) * K + g64_chunk(tid) * 8;
            wrow[i] = Wt + (size_t)(n0 + (tid >> 3) + 32 * i) * K + g64_chunk(tid) * 8;
        }
        f32x16 acc[2][2]; acc_zero(acc);
        float my_rs = 0.f;
        if (tid < 128) {
            const float4 c = *(const float4*)(w.cqss + (size_t)(m0 + tid) * 4);
            my_rs = isq ? rsq_((c.x + c.y) * (1.f / 256.f) + EPS) : rsq_(c.z * (1.f / 128.f) + EPS);
        }
        gemm_mainloop_b64(A, Wt, acc, arow, wrow, K / 64, lds, tid);
        if (tid < 128) stat[tid] = my_rs;
        acc_to_lds(acc, T, tid);
    }
    const int b = m0 >> 11, s0 = m0 & 2047;
    const int sub = lane >> 4, l16 = lane & 15, c8 = l16 * 8;
    if (isq && nt < 4) {
        const int hd = nt * 2 + (l16 >> 3), d = (l16 & 7) * 8;
        const float4 g0 = mul4(*(const float4*)(in.q_norm_g + L * 96 + d), QSCALE), g1 = mul4(*(const float4*)(in.q_norm_g + L * 96 + d + 4), QSCALE);
        bf16_t* dst = w.Qb + ((size_t)(b * 8 + hd) * 2048 + s0) * 96 + d;
#pragma unroll 8
        for (int rr = 0; rr < 8; ++rr) {
            const int row = wid * 32 + rr * 4 + sub; const float rs = stat[row];
            float4 x0 = mul4(*(const float4*)(T + row * TLD + c8), rs), x1 = mul4(*(const float4*)(T + row * TLD + c8 + 4), rs);
            const float rn = rsq_(grp_sum8(sq8(x0, x1)) * (1.f / 64.f) + EPS);
            x0.x *= rn * g0.x; x0.y *= rn * g0.y; x0.z *= rn * g0.z; x0.w *= rn * g0.w; x1.x *= rn * g1.x; x1.y *= rn * g1.y; x1.z *= rn * g1.z; x1.w *= rn * g1.w;
            *(uint4*)(dst + (size_t)row * 96) = pack8(x0, x1);
        }
    } else if (isq) {
        const int hd = (nt - 4) * 4 + (l16 >> 2), lq = l16 & 3, dd = lq * 8, jj = (lq & 1) * 8;
        const float4 g0 = *(const float4*)(in.q_norm_g + L * 96 + 64 + dd), g1 = *(const float4*)(in.q_norm_g + L * 96 + 64 + dd + 4);
        bf16_t* dst = w.Qb + ((size_t)(b * 8 + hd) * 2048 + s0) * 96 + 64 + dd;
        const float sg = (lq & 2) ? QSCALE : -QSCALE;
#pragma unroll 1
        for (int hb4 = 0; hb4 < 2; ++hb4) {
            float4 cc0[4], cc1[4], ss0[4], ss1[4];
#pragma unroll
            for (int r4 = 0; r4 < 4; ++r4) {
                const float* csr = w.cs + (size_t)(m0 + wid * 32 + (hb4 * 4 + r4) * 4 + sub) * 32 + jj;
                cc0[r4] = *(const float4*)csr; cc1[r4] = *(const float4*)(csr + 4); ss0[r4] = *(const float4*)(csr + 16); ss1[r4] = *(const float4*)(csr + 20);
            }
#pragma unroll
            for (int r4 = 0; r4 < 4; ++r4) {
                const int row = wid * 32 + (hb4 * 4 + r4) * 4 + sub; const float rs = stat[row];
                float4 x0 = mul4(*(const float4*)(T + row * TLD + c8), rs), x1 = mul4(*(const float4*)(T + row * TLD + c8 + 4), rs);
                const float rn = rsq_(grp_sum4(sq8(x0, x1)) * (1.f / 32.f) + EPS);
                x0.x *= rn * g0.x; x0.y *= rn * g0.y; x0.z *= rn * g0.z; x0.w *= rn * g0.w; x1.x *= rn * g1.x; x1.y *= rn * g1.y; x1.z *= rn * g1.z; x1.w *= rn * g1.w;
                const float4 o0 = make_float4(quad_x2(x0.x), quad_x2(x0.y), quad_x2(x0.z), quad_x2(x0.w)), o1 = make_float4(quad_x2(x1.x), quad_x2(x1.y), quad_x2(x1.z), quad_x2(x1.w));
                const float4 c0 = mul4(cc0[r4], QSCALE), c1 = mul4(cc1[r4], QSCALE), s0v = ss0[r4], s1v = ss1[r4];
                float4 r0, r1;
                r0.x = x0.x * c0.x + sg * o0.x * s0v.x; r0.y = x0.y * c0.y + sg * o0.y * s0v.y; r0.z = x0.z * c0.z + sg * o0.z * s0v.z; r0.w = x0.w * c0.w + sg * o0.w * s0v.w;
                r1.x = x1.x * c1.x + sg * o1.x * s1v.x; r1.y = x1.y * c1.y + sg * o1.y * s1v.y; r1.z = x1.z * c1.z + sg * o1.z * s1v.z; r1.w = x1.w * c1.w + sg * o1.w * s1v.w;
                *(uint4*)(dst + (size_t)row * 96) = pack8(r0, r1);
            }
        }
    } else if (nt < 4) {
        const int hd = nt * 2 + (l16 >> 3), d = (l16 & 7) * 8;
        const float4 g0 = *(const float4*)(in.k_norm_g + L * 96 + d), g1 = *(const float4*)(in.k_norm_g + L * 96 + d + 4);
        bf16_t* dst = w.Knb + ((size_t)(b * 8 + hd) * 2048 + s0) * 64 + d;
#pragma unroll 8
        for (int rr = 0; rr < 8; ++rr) {
            const int row = wid * 32 + rr * 4 + sub; const float rs = stat[row];
            float4 x0 = mul4(*(const float4*)(T + row * TLD + c8), rs), x1 = mul4(*(const float4*)(T + row * TLD + c8 + 4), rs);
            const float rn = rsq_(grp_sum8(sq8(x0, x1)) * (1.f / 64.f) + EPS);
            x0.x *= rn * g0.x; x0.y *= rn * g0.y; x0.z *= rn * g0.z; x0.w *= rn * g0.w; x1.x *= rn * g1.x; x1.y *= rn * g1.y; x1.z *= rn * g1.z; x1.w *= rn * g1.w;
            *(uint4*)(dst + (size_t)row * 64) = pack8(x0, x1);
        }
    } else {
        const int c = tid & 127, th = tid >> 7, hd = (nt - 4) * 2 + (c >> 6), d = c & 63;
        bf16_t* dst = w.VTb + ((size_t)(b * 8 + hd) * 64 + d) * 2048 + s0 + th * 64;
#pragma unroll 2
        for (int k8 = 0; k8 < 8; ++k8) {
            float v[8];
#pragma unroll
            for (int k = 0; k < 8; ++k) {
                const int row = th * 64 + (k8 >> 1) * 16 + 4 * (k8 & 1) + (k < 4 ? k : 4 + k); v[k] = T[row * TLD + c] * stat[row];
            }
            uint4 pk; pk.x = pack2(v[0], v[1]); pk.y = pack2(v[2], v[3]); pk.z = pack2(v[4], v[5]); pk.w = pack2(v[6], v[7]);
            *(uint4*)(dst + k8 * 8) = pk;
        }
    }
    __syncthreads();
}

__device__ __forceinline__ void sgu_item(const Params& P, int L, int mt, char* lds, const int tid_in) {
    int tid = tid_in; asm volatile("" : "+v"(tid));
    const WS& w = P.w; const nv::Inputs& in = P.in;
    const int lane = tid & 63, hd = tid >> 6, fr = lane & 31, fh = lane >> 5;
    float* red = (float*)lds;
    const bf16_t* vt = w.vT + (size_t)(mt * 4 + hd) * 64 * 128;
    const bf16_t* ws = w.Wsm + L * WSM_SZ + (size_t)hd * 128 * 128;
    const float* bs = in.sgu_b + L * 512 + hd * 128;
    const int m0 = mt * 128;
    bf16x8 af0[8], af1[8];
    {
        const bf16_t* ap0 = vt + (size_t)fr * 128 + 8 * fh;
        const bf16_t* ap1 = vt + (size_t)(32 + fr) * 128 + 8 * fh;
#pragma unroll
        for (int s = 0; s < 8; ++s) { af0[s] = *(const bf16x8*)(ap0 + 16 * s); af1[s] = *(const bf16x8*)(ap1 + 16 * s); }
    }
#pragma unroll 1
    for (int it = 0; it < 4; ++it) {
        f32x16 a0, a1;
#pragma unroll
        for (int r = 0; r < 16; ++r) { a0[r] = 0.f; a1[r] = 0.f; }
        const bf16_t* bp = ws + (size_t)(it * 32 + fr) * 128 + 8 * fh;
        bf16x8 bfr[8];
#pragma unroll
        for (int s = 0; s < 8; ++s) bfr[s] = *(const bf16x8*)(bp + 16 * s);
#pragma unroll
        for (int s = 0; s < 8; ++s) {
            a0 = __builtin_amdgcn_mfma_f32_32x32x16_bf16(af0[s], bfr[s], a0, 0, 0, 0);
            a1 = __builtin_amdgcn_mfma_f32_32x32x16_bf16(af1[s], bfr[s], a1, 0, 0, 0);
        }
        const int i = it * 32 + fr, tok = m0 + i;
        const float bias = bs[i];
        uint2 uu[2][4];
#pragma unroll
        for (int dt = 0; dt < 2; ++dt)
#pragma unroll
            for (int g = 0; g < 4; ++g) uu[dt][g] = *(const uint2*)(w.ub + (size_t)tok * 256 + hd * 64 + dt * 32 + 8 * g + 4 * fh);
        float ssq = 0.f;
#pragma unroll
        for (int dt = 0; dt < 2; ++dt)
#pragma unroll
            for (int g = 0; g < 4; ++g) {
                const int d = dt * 32 + 8 * g + 4 * fh;
                float o[4];
#pragma unroll
                for (int q = 0; q < 4; ++q) {
                    const float sv = (dt == 0 ? a0[4 * g + q] : a1[4 * g + q]) + bias;
                    const float uv = (q == 0) ? bflo(uu[dt][g].x) : (q == 1) ? bfhi(uu[dt][g].x) : (q == 2) ? bflo(uu[dt][g].y) : bfhi(uu[dt][g].y);
                    o[q] = uv * sv; ssq += o[q] * o[q];
                }
                store4(w.yb + (size_t)tok * 1024 + hd * 64 + d, o[0], o[1], o[2], o[3]);
            }
        ssq = xor32(ssq);
        if (fh == 0) red[hd * 128 + i] = ssq;
    }
    __syncthreads();
    if (tid < 128) w.ssq[(size_t)(m0 + tid) * 16 + 0] = red[tid] + red[128 + tid] + red[256 + tid] + red[384 + tid];
    __syncthreads();
}

constexpr int CLD = 260, CONV_YL = 32 * CLD * 4, CONV_ST = CONV_YL + 32 * 512, CONV_RED = CONV_ST + 32 * 4 * 8;
__device__ __forceinline__ int yl_off(int row, int chunk) { return row * 512 + ((chunk ^ (row & 15)) << 4); }
__device__ __forceinline__ void conv_item(const Params& P, int L, int ct, char* lds, const int tid_in) {
    int tid = tid_in; asm volatile("" : "+v"(tid));
    const WS& w = P.w; const nv::Inputs& in = P.in;
    const int lane = tid & 63, wid = tid >> 6, fr = lane & 31, fh = lane >> 5;
    float* C = (float*)lds; char* yl = lds + CONV_YL; float2* stats = (float2*)(lds + CONV_ST); float* red = (float*)(lds + CONV_RED);
    const int t0 = ct * 32, s0 = t0 & 2047;
    {
        const int c = tid;
        float x[62];
#pragma unroll
        for (int r = 0; r < 62; ++r) {
            const bool ok = s0 + r - 30 >= 0;
            const unsigned short raw = w.ygb[(size_t)(ok ? t0 + r - 30 : t0) * 256 + c];
            x[r] = bf2f(raw) * (ok ? 1.f : 0.f);
        }
        float wk[31];
#pragma unroll
        for (int k = 0; k < 31; ++k) wk[k] = in.conv_w[(size_t)L * 31 * 256 + k * 256 + c];
        const float cb = in.conv_b[L * 256 + c];
#pragma unroll
        for (int t = 0; t < 32; ++t) {
            float a = cb;
#pragma unroll
            for (int k = 0; k < 31; ++k) a = fmaf(wk[k], x[t + k], a);
            C[t * CLD + c] = a;
        }
    }
    __syncthreads();
    if (tid < 128) {
        const int t = tid >> 2, g = tid & 3;
        const float4* cp = (const float4*)(C + t * CLD + g * 64);
        float4 v[16]; float s = 0.f;
#pragma unroll
        for (int i = 0; i < 16; ++i) { v[i] = cp[i]; s += (v[i].x + v[i].y) + (v[i].z + v[i].w); }
        const float mean = s * (1.f / 64.f); float q = 0.f;
#pragma unroll
        for (int i = 0; i < 16; ++i) { const float a = v[i].x - mean, b2 = v[i].y - mean, c2 = v[i].z - mean, d2 = v[i].w - mean; q += (a * a + b2 * b2) + (c2 * c2 + d2 * d2); }
        stats[t * 4 + g] = make_float2(mean, rsq_(q * (1.f / 64.f) + EPS));
    }
    __syncthreads();
    {
        const int c = tid, g = c >> 6;
        const float lg = in.conv_ln_g[L * 256 + c], lb = in.conv_ln_b[L * 256 + c];
#pragma unroll 8
        for (int t = 0; t < 32; ++t) {
            const float2 st = stats[t * 4 + g];
            const float v = (C[t * CLD + c] - st.x) * st.y * lg + lb;
            *(bf16_t*)(yl + yl_off(t, c >> 3) + (c & 7) * 2) = (bf16_t)f2bf(v * sigmoid_(v));
        }
    }
    __syncthreads();
    f32x16 acc0, acc1;
#pragma unroll
    for (int r = 0; r < 16; ++r) { acc0[r] = 0.f; acc1[r] = 0.f; }
    const bf16_t* wp = w.Wpwt + L * WPW_SZ + (size_t)(wid * 64 + fr) * 256 + 8 * fh;
#pragma unroll 1
    for (int sb = 0; sb < 2; ++sb) {
        bf16x8 w0[8], w1[8];
#pragma unroll
        for (int s = 0; s < 8; ++s) { w0[s] = *(const bf16x8*)(wp + 16 * (sb * 8 + s)); w1[s] = *(const bf16x8*)(wp + 32 * 256 + 16 * (sb * 8 + s)); }
#pragma unroll
        for (int s = 0; s < 8; ++s) {
            const bf16x8 x0 = *(const bf16x8*)(yl + yl_off(fr, 2 * (sb * 8 + s) + fh));
            acc0 = __builtin_amdgcn_mfma_f32_32x32x16_bf16(w0[s], x0, acc0, 0, 0, 0);
            acc1 = __builtin_amdgcn_mfma_f32_32x32x16_bf16(w1[s], x0, acc1, 0, 0, 0);
        }
    }
    const float* pb = in.conv_pw_b + L * 256;
    {
        const int tok = t0 + fr;
        float4 bia[2][4];
#pragma unroll
        for (int jn = 0; jn < 2; ++jn)
#pragma unroll
            for (int g = 0; g < 4; ++g) bia[jn][g] = *(const float4*)(pb + wid * 64 + jn * 32 + 8 * g + 4 * fh);
        float ssq = 0.f;
#pragma unroll
        for (int jn = 0; jn < 2; ++jn)
#pragma unroll
            for (int g = 0; g < 4; ++g) {
                const int n = wid * 64 + jn * 32 + 8 * g + 4 * fh;
                const float4 b4 = bia[jn][g];
                const float o0 = (jn ? acc1[4 * g] : acc0[4 * g]) + b4.x, o1 = (jn ? acc1[4 * g + 1] : acc0[4 * g + 1]) + b4.y;
                const float o2 = (jn ? acc1[4 * g + 2] : acc0[4 * g + 2]) + b4.z, o3 = (jn ? acc1[4 * g + 3] : acc0[4 * g + 3]) + b4.w;
                ssq += o0 * o0 + o1 * o1 + o2 * o2 + o3 * o3;
                store4(w.yb + (size_t)tok * 1024 + 256 + n, o0, o1, o2, o3);
            }
        ssq = xor32(ssq);
        if (fh == 0) red[wid * 32 + fr] = ssq;
    }
    __syncthreads();
    if (tid < 32) w.ssq[(size_t)(t0 + tid) * 16 + 1] = red[tid] + red[32 + tid] + red[64 + tid] + red[96 + tid];
    __syncthreads();
}

__device__ __forceinline__ void phase_mix(const Params& P, int L, char* lds, const int rep = 0, const bool dryrun = false) {
    const int tid = opaque_tid();
    const int x = blockIdx.x & 7;
    int* qctr = P.w.cnt + L * 256 + 72 + x + 8 * rep;
    volatile int* slot = (volatile int*)(lds + LDS_GEMM_BYTES - 16);
    if (tid == 0) *slot = atomicAdd(qctr, 1);
    __syncthreads();
    int cur = *slot;
    __syncthreads();
    while (cur < 304) {
        int nxt = 0;
        if (tid == 0) nxt = atomicAdd(qctr, 1);
#ifdef MIX_MASK
        const int mask = dryrun ? MIX_MASK : 15;
#else
        const int mask = 15;
#endif
#ifdef MIX_TWICE
        if (cur < 16) { if (MIX_TWICE & 1) sgu_item(P, L, cur * 8 + x, lds, tid); }
        else if (cur < 80) { if (MIX_TWICE & 2) conv_item(P, L, (cur - 16) * 8 + x, lds, tid); }
        else if (cur < 176) { if (MIX_TWICE & 4) { const int li = cur - 80; qkv_item(P, L, true, (li / 6) * 8 + x, li % 6, lds, tid); } }
        else { if (MIX_TWICE & 8) { const int li = cur - 176; qkv_item(P, L, false, (li >> 3) * 8 + x, li & 7, lds, tid); } }
#endif
        if (cur < 16) { if (mask & 1) sgu_item(P, L, cur * 8 + x, lds, tid); }
        else if (cur < 80) { if (mask & 2) conv_item(P, L, (cur - 16) * 8 + x, lds, tid); }
        else if (cur < 176) { if (mask & 4) { const int li = cur - 80; qkv_item(P, L, true, (li / 6) * 8 + x, li % 6, lds, tid); } }
        else { if (mask & 8) { const int li = cur - 176; qkv_item(P, L, false, (li >> 3) * 8 + x, li & 7, lds, tid); } }
        if (tid == 0) *slot = nxt;
        __syncthreads();
        cur = *slot;
        __syncthreads();
    }
}

}
namespace fx {

constexpr int AKN = 0, AKP = 8192, AVT = 12288, ATT_STAGE = 20480;
__device__ __forceinline__ void att_issue(const bf16_t* Kn, const bf16_t* Kp, const bf16_t* Vt, int k0, char* st, const int tid, const int wbase) {
    {
        const int row = tid >> 3, ch = (tid & 7) ^ ((tid >> 4) & 7);
        glds16(Kn + (size_t)(k0 + row) * 64 + ch * 8, st + AKN + wbase);
        glds16(Kn + (size_t)(k0 + row + 32) * 64 + ch * 8, st + AKN + 4096 + wbase);
    }
    {
        const int row = tid >> 2, ch = (tid & 3) ^ ((tid >> 4) & 3);
        glds16(Kp + (size_t)(k0 + row) * 32 + ch * 8, st + AKP + wbase);
    }
    {
        const int d = tid >> 3, ch = (tid & 7) ^ ((tid >> 4) & 7);
        glds16(Vt + (size_t)d * 2048 + k0 + ch * 8, st + AVT + wbase);
        glds16(Vt + (size_t)(d + 32) * 2048 + k0 + ch * 8, st + AVT + 4096 + wbase);
    }
}

__device__ __forceinline__ void att_issue_b(const __amdgpu_buffer_rsrc_t rkn, const __amdgpu_buffer_rsrc_t rkp, const __amdgpu_buffer_rsrc_t rvt,
                                            const unsigned okn, const unsigned okp, const unsigned ovt, const int k0, char* st, const int wbase) {
    bglds16(rkn, okn, k0 * 128, st + AKN + wbase);
    bglds16(rkn, okn + 32 * 128, k0 * 128, st + AKN + 4096 + wbase);
    bglds16(rkp, okp, k0 * 64, st + AKP + wbase);
    bglds16(rvt, ovt, k0 * 2, st + AVT + wbase);
    bglds16(rvt, ovt + 32 * 4096, k0 * 2, st + AVT + 4096 + wbase);
}

template <bool NOMAX>
__device__ __forceinline__ void attn_unit(const Params& P, int b, int h, int qt, char* lds, const int tid) {
    const WS& w = P.w;
    const int lane = tid & 63, wid = __builtin_amdgcn_readfirstlane(tid >> 6), fr = lane & 31, fh = lane >> 5;
    const int wbase = wid * 1024;
    const bf16_t* Kn = w.Knb + (size_t)(b * 8 + h) * 2048 * 64;
    const bf16_t* Kp = w.kpeb + (size_t)b * 2048 * 32;
    const bf16_t* Vt = w.VTb + (size_t)(b * 8 + h) * 64 * 2048;
    const int q0 = qt * 128, qw0 = q0 + wid * 32, qpos = qw0 + fr;
    bf16x8 qf[6];
    {
        const bf16_t* qp = w.Qb + ((size_t)(b * 8 + h) * 2048 + qpos) * 96 + 8 * fh;
#pragma unroll
        for (int ks = 0; ks < 6; ++ks) qf[ks] = *(const bf16x8*)(qp + 16 * ks);
    }
    f32x16 o0, o1;
#pragma unroll
    for (int r = 0; r < 16; ++r) { o0[r] = 0.f; o1[r] = 0.f; }
    float m = -1e30f, l = 0.f;
    const int nkt = 2 * (qt + 1);
    const __amdgpu_buffer_rsrc_t rkn = __builtin_amdgcn_make_buffer_rsrc((void*)Kn, (short)0, 0x7fffffff, 0x00020000), rkp = __builtin_amdgcn_make_buffer_rsrc((void*)Kp, (short)0, 0x7fffffff, 0x00020000),
                                 rvt = __builtin_amdgcn_make_buffer_rsrc((void*)Vt, (short)0, 0x7fffffff, 0x00020000);
    const unsigned okn = (unsigned)((tid >> 3) * 128 + (((tid & 7) ^ ((tid >> 4) & 7)) << 4));
    const unsigned okp = (unsigned)((tid >> 2) * 64 + (((tid & 3) ^ ((tid >> 4) & 3)) << 4));
    const unsigned ovt = (unsigned)((tid >> 3) * 4096 + (((tid & 7) ^ ((tid >> 4) & 7)) << 4));
    att_issue_b(rkn, rkp, rvt, okn, okp, ovt, 0, lds, wbase);
    if (nkt > 1) att_issue_b(rkn, rkp, rvt, okn, okp, ovt, 64, lds + ATT_STAGE, wbase);
    const char* pkn[4]; const char* pkp[2]; unsigned pvt[4];
    {
        const int swn = (fr >> 1) & 7, swp = (fr >> 2) & 3, swv = (fr >> 1) & 7;
#pragma unroll
        for (int ks = 0; ks < 4; ++ks) { pkn[ks] = lds + AKN + fr * 128 + (((2 * ks + fh) ^ swn) << 4); pvt[ks] = lds_addr(lds) + AVT + fr * 128 + (((2 * ks + fh) ^ swv) << 4); }
#pragma unroll
        for (int ks = 0; ks < 2; ++ks) pkp[ks] = lds + AKP + fr * 64 + (((2 * ks + fh) ^ swp) << 4);
    }
    auto body = [&](const int kt, auto st_c) __attribute__((always_inline)) {
        constexpr int ST = decltype(st_c)::value, SO = ST * ATT_STAGE, PSO = ((ST + 2) % 3) * ATT_STAGE;
        if (kt + 1 < nkt) asm volatile("s_waitcnt vmcnt(5)" ::: "memory"); else asm volatile("s_waitcnt vmcnt(0)" ::: "memory");
        RAW_BARRIER();
        if (kt + 2 < nkt) att_issue_b(rkn, rkp, rvt, okn, okp, ovt, (kt + 2) * 64, lds + PSO, wbase);
        const int k0 = kt * 64;
        if (k0 <= qw0 + 31) {
            f32x16 s0, s1;
#pragma unroll
            for (int r = 0; r < 16; ++r) { s0[r] = 0.f; s1[r] = 0.f; }
            {
                bf16x8 ka[6], kc[6];
#pragma unroll
                for (int ks = 0; ks < 4; ++ks) { ka[ks] = *(const bf16x8*)(pkn[ks] + SO); kc[ks] = *(const bf16x8*)(pkn[ks] + SO + 4096); }
#pragma unroll
                for (int ks = 4; ks < 6; ++ks) { ka[ks] = *(const bf16x8*)(pkp[ks - 4] + SO); kc[ks] = *(const bf16x8*)(pkp[ks - 4] + SO + 2048); }
                __builtin_amdgcn_sched_barrier(0);
#pragma unroll
                for (int ks = 0; ks < 6; ++ks) {
                    s0 = __builtin_amdgcn_mfma_f32_32x32x16_bf16(ka[ks], qf[ks], s0, 0, 0, 0);
                    s1 = __builtin_amdgcn_mfma_f32_32x32x16_bf16(kc[ks], qf[ks], s1, 0, 0, 0);
                }
            }
            u32x4 vv0[4], vv1[4];
#pragma unroll
            for (int ks = 0; ks < 4; ++ks) {
                asm volatile("ds_read_b128 %0, %1 offset:%2" : "=v"(vv0[ks]) : "v"(pvt[ks]), "n"(SO));
                asm volatile("ds_read_b128 %0, %1 offset:%2" : "=v"(vv1[ks]) : "v"(pvt[ks]), "n"(SO + 4096));
            }
            __builtin_amdgcn_sched_barrier(0);
            if (k0 + 63 > qw0) {
#pragma unroll
                for (int r = 0; r < 16; ++r) {
                    const int key = k0 + nidx(r, fh);
                    if (key > qpos) s0[r] = -1e30f;
                    if (key + 32 > qpos) s1[r] = -1e30f;
                }
            }
            if (NOMAX) {
                float ps = 0.f;
#pragma unroll
                for (int r = 0; r < 16; ++r) { s0[r] = __builtin_amdgcn_exp2f(s0[r]); ps += s0[r]; }
#pragma unroll
                for (int r = 0; r < 16; ++r) { s1[r] = __builtin_amdgcn_exp2f(s1[r]); ps += s1[r]; }
                l += ps;
            } else {
                float mx = s0[0];
#pragma unroll
                for (int r = 1; r < 16; ++r) mx = fmaxf(mx, s0[r]);
#pragma unroll
                for (int r = 0; r < 16; ++r) mx = fmaxf(mx, s1[r]);
                mx = swap32_max(mx);
                const float mn = fmaxf(m, mx);
                const float alpha = __builtin_amdgcn_exp2f(m - mn);
                m = mn;
                float ps = 0.f;
#pragma unroll
                for (int r = 0; r < 16; ++r) { s0[r] = __builtin_amdgcn_exp2f(s0[r] - mn); ps += s0[r]; }
#pragma unroll
                for (int r = 0; r < 16; ++r) { s1[r] = __builtin_amdgcn_exp2f(s1[r] - mn); ps += s1[r]; }
                ps = swap32_sum(ps);
                l = l * alpha + ps;
#pragma unroll
                for (int r = 0; r < 16; ++r) { o0[r] *= alpha; o1[r] *= alpha; }
            }
            asm volatile("s_waitcnt lgkmcnt(0)" : "+v"(vv0[0]), "+v"(vv0[1]), "+v"(vv0[2]), "+v"(vv0[3]), "+v"(vv1[0]), "+v"(vv1[1]), "+v"(vv1[2]), "+v"(vv1[3]));
#pragma unroll
            for (int ks = 0; ks < 4; ++ks) {
                bf16x8 pf;
                {
                    const int rb = 8 * (ks & 1);
                    unsigned u0, u1, u2, u3;
                    if (ks < 2) { u0 = pack2(s0[rb], s0[rb + 1]); u1 = pack2(s0[rb + 2], s0[rb + 3]); u2 = pack2(s0[rb + 4], s0[rb + 5]); u3 = pack2(s0[rb + 6], s0[rb + 7]); }
                    else { u0 = pack2(s1[rb], s1[rb + 1]); u1 = pack2(s1[rb + 2], s1[rb + 3]); u2 = pack2(s1[rb + 4], s1[rb + 5]); u3 = pack2(s1[rb + 6], s1[rb + 7]); }
                    uint4 uu = make_uint4(u0, u1, u2, u3);
                    pf = __builtin_bit_cast(bf16x8, uu);
                }
                const bf16x8 vfa = __builtin_bit_cast(bf16x8, vv0[ks]), vfb = __builtin_bit_cast(bf16x8, vv1[ks]);
                o0 = __builtin_amdgcn_mfma_f32_32x32x16_bf16(vfa, pf, o0, 0, 0, 0);
                o1 = __builtin_amdgcn_mfma_f32_32x32x16_bf16(vfb, pf, o1, 0, 0, 0);
            }
        }
    };
#pragma unroll 1
    for (int kt = 0; kt < nkt; kt += 3) {
        body(kt, std::integral_constant<int, 0>{});
        if (kt + 1 < nkt) body(kt + 1, std::integral_constant<int, 1>{});
        if (kt + 2 < nkt) body(kt + 2, std::integral_constant<int, 2>{});
    }
    RAW_BARRIER();
    if (NOMAX) l = swap32_sum(l);
    const float inv = 1.f / l;
    const int tok = b * 2048 + qpos;
    float ssq = 0.f;
#pragma unroll
    for (int dt = 0; dt < 2; ++dt)
#pragma unroll
        for (int g = 0; g < 4; ++g) {
            float o[4];
#pragma unroll
            for (int q = 0; q < 4; ++q) { o[q] = (dt == 0 ? o0[4 * g + q] : o1[4 * g + q]) * inv; ssq += o[q] * o[q]; }
            store4(w.yb + (size_t)tok * 1024 + 512 + h * 64 + dt * 32 + 8 * g + 4 * fh, o[0], o[1], o[2], o[3]);
        }
    ssq = xor32(ssq);
    if (fh == 0) w.ssq[(size_t)tok * 16 + 8 + h] = ssq;
}

__device__ __forceinline__ void phase_attn(const Params& P, int L, char* lds) {
    const int tid0 = opaque_tid();
    const int h = blockIdx.x & 7, nlb = gridDim.x >> 3;
    bool nomax;
    {
        const float* gq = P.in.q_norm_g + L * 96; const float* gk = P.in.k_norm_g + L * 96;
        float qn = 0.f, kn = 0.f, qp = 0.f, kp = 0.f;
        for (int d = 0; d < 64; ++d) { qn = fmaxf(qn, fabsf(gq[d])); kn = fmaxf(kn, fabsf(gk[d])); }
        for (int d = 64; d < 96; ++d) { qp = fmaxf(qp, fabsf(gq[d])); kp = fmaxf(kp, fabsf(gk[d])); }
        const float bound = (64.f * qn * kn + 32.f * qp * kp) * QSCALE;
        nomax = bound <= 100.f;
    }
    if (nomax) {
        for (int li = blockIdx.x >> 3; li < 64; li += nlb) {
            const int p = li & 7, b = li >> 3;
#pragma unroll 1
            for (int u = 0; u < 2; ++u) {
                int tid = tid0; asm volatile("" : "+v"(tid));
                attn_unit<true>(P, b, h, u == 0 ? 15 - p : p, lds, tid);
            }
        }
    } else {
        for (int li = blockIdx.x >> 3; li < 64; li += nlb) {
            const int p = li & 7, b = li >> 3;
#pragma unroll 1
            for (int u = 0; u < 2; ++u) {
                int tid = tid0; asm volatile("" : "+v"(tid));
                attn_unit<false>(P, b, h, u == 0 ? 15 - p : p, lds, tid);
            }
        }
    }
}

}
namespace fx {

__device__ __forceinline__ void acc_scale(f32x16 (&acc)[2][2], const float* f, const int tid) {
    const int lane = tid & 63, wr = tid >> 7, fr = lane & 31;
#pragma unroll
    for (int i = 0; i < 2; ++i) {
        const float v = f[wr * 64 + i * 32 + fr];
#pragma unroll
        for (int j = 0; j < 2; ++j)
#pragma unroll
            for (int r = 0; r < 16; ++r) acc[i][j][r] *= v;
    }
}
__device__ __forceinline__ void phase_oproj(const Params& P, int L, char* lds, const bool dry = false) {
    const WS& w = P.w;
    const int tid0 = opaque_tid();
    float* T = (float*)lds; float* stat = (float*)(lds + STAT_OFF);
    const bf16_t* Wt = w.Wot + L * WO_SZ;
    int mt, nt;
    for (int it = 0; xcd_item(it, 128, 8, mt, nt); ++it) {
        int tid = tid0; asm volatile("" : "+v"(tid));
        const int lane = tid & 63, wid = tid >> 6;
        const int m0 = mt * 128, n0 = nt * 128;
        float rb_keep = 0.f;
        uint4 hq[8];
        if (tid < 128) {
            const float* sq = w.ssq + (size_t)(m0 + tid) * 16;
            const float4 c0 = *(const float4*)(sq + 8), c1 = *(const float4*)(sq + 12);
            const float ra = rsq_(sq[0] * (1.f / 256.f) + EPS), rb = rsq_(sq[1] * (1.f / 256.f) + EPS);
            const float rc = rsq_((c0.x + c0.y + c0.z + c0.w + c1.x + c1.y + c1.z + c1.w) * (1.f / 512.f) + EPS);
            stat[tid] = rc / ra; stat[128 + tid] = ra / rb; rb_keep = rb;
        }
        {
            const bf16_t* arow[4]; const bf16_t* wrow[4];
#pragma unroll
            for (int i = 0; i < 4; ++i) {
                arow[i] = w.yb + (size_t)(m0 + (tid >> 3) + 32 * i) * 1024 + g64_chunk(tid) * 8;
                wrow[i] = Wt + (size_t)(n0 + (tid >> 3) + 32 * i) * 1024 + g64_chunk(tid) * 8;
            }
            f32x16 acc[2][2]; acc_zero(acc);
            auto hook = [&]() __attribute__((always_inline)) {
#pragma unroll
                for (int rr = 0; rr < 8; ++rr) hq[rr] = *(const uint4*)(w.hb + (size_t)(m0 + wid * 32 + rr * 4 + (lane >> 4)) * 1024 + n0 + (lane & 15) * 8);
            };
            gemm_mainloop_b64<true, 0>(w.yb, Wt, acc, arow, wrow, 16, lds, tid, 8, 8, stat, 12, stat + 128, hook);
            if (tid < 128) stat[tid] = rb_keep;
            acc_to_lds(acc, T, tid);
        }
        {
            const int sub = lane >> 4, c8 = (lane & 15) * 8;
#pragma unroll
            for (int rr = 0; rr < 8; ++rr) {
                const int row = wid * 32 + rr * 4 + sub; const float rb = stat[row];
                const float4 x0 = *(const float4*)(T + row * TLD + c8), x1 = *(const float4*)(T + row * TLD + c8 + 4);
                const uint4 hh = hq[rr];
                float4 h0 = make_float4(bflo(hh.x), bfhi(hh.x), bflo(hh.y), bfhi(hh.y)), h1 = make_float4(bflo(hh.z), bfhi(hh.z), bflo(hh.w), bfhi(hh.w));
                h0.x += x0.x * rb; h0.y += x0.y * rb; h0.z += x0.z * rb; h0.w += x0.w * rb;
                h1.x += x1.x * rb; h1.y += x1.y * rb; h1.z += x1.z * rb; h1.w += x1.w * rb;
                *(uint4*)(w.hb1 + (size_t)(m0 + row) * 1024 + n0 + c8) = pack8(h0, h1);
                const float sq = grp_sum16(sq8(h0, h1));
                if ((lane & 15) == 0) w.rssB[(size_t)(m0 + row) * 8 + nt] = sq;
            }
        }
        __syncthreads();
    }
}

__device__ __forceinline__ void router_item(const Params& P, int L, int mt, char* lds, const int tid_in, const bool dry) {
    int tid = tid_in; asm volatile("" : "+v"(tid));
    const WS& w = P.w; const nv::Inputs& in = P.in;
    float* T = (float*)lds; float* stat = (float*)(lds + STAT_OFF); int* hist = (int*)(lds + STAT_OFF + 1024);
    const int m0 = mt * 128;
    {
        const bf16_t* arow[4]; const bf16_t* wrow[4];
#pragma unroll
        for (int i = 0; i < 4; ++i) {
            arow[i] = w.hb1 + (size_t)(m0 + (tid >> 3) + 32 * i) * 1024 + g64_chunk(tid) * 8;
            wrow[i] = w.Wrt + L * WR_SZ + (size_t)((tid >> 3) + 32 * i) * 1024 + g64_chunk(tid) * 8;
        }
        f32x16 acc[2][2]; acc_zero(acc);
        float my_rs = 0.f;
        if (tid < 128) my_rs = rstd8(w.rssB + (size_t)(m0 + tid) * 8, 1.f / 1024.f);
        gemm_mainloop_b64(w.hb1, w.Wrt, acc, arow, wrow, 16, lds, tid);
        if (tid < 128) stat[tid] = my_rs;
        if (tid < 64) hist[tid] = 0;
        acc_to_lds(acc, T, tid);
    }
    int e0 = 0, e1 = 0, r0 = 0, r1 = 0; float w0 = 0.f, w1 = 0.f;
    if (tid < 128) {
        const float rs = stat[tid];
        const float* lr = T + tid * TLD;
        const float* bg = in.router_group_b + L * 4; const float* be = in.router_expert_b + L * 32;
        int gi = 0; float gm = lr[0] * rs + bg[0];
#pragma unroll
        for (int j = 1; j < 4; ++j) { const float v = lr[j] * rs + bg[j]; if (v > gm) { gm = v; gi = j; } }
        float gs = 0.f;
#pragma unroll
        for (int j = 0; j < 4; ++j) gs += __builtin_amdgcn_exp2f(1.4426950408889634f * (lr[j] * rs + bg[j] - gm));
        const float gw = 1.f / gs;
        int i0 = 0, i1 = -1; float v0 = -3.0e38f, v1 = -3.0e38f;
#pragma unroll
        for (int j = 0; j < 8; ++j) {
            const float v = lr[4 + gi * 8 + j] * rs + be[gi * 8 + j];
            if (v > v0) { v1 = v0; i1 = i0; v0 = v; i0 = j; } else if (v > v1) { v1 = v; i1 = j; }
        }
        const float ex = __builtin_amdgcn_exp2f(1.4426950408889634f * (v1 - v0));
        w0 = gw / (1.f + ex); w1 = gw * ex / (1.f + ex);
        e0 = gi * 8 + i0; e1 = gi * 8 + i1;
        e0 = e0 * 2; e1 = e1 * 2 + 1;
        r0 = atomicAdd(&hist[e0], 1); r1 = atomicAdd(&hist[e1], 1);
    }
    __syncthreads();
    if (tid < 64) hist[64 + tid] = (hist[tid] && !dry) ? atomicAdd(&w.cnt[L * 256 + tid], hist[tid]) : 0;
    __syncthreads();
    if (tid < 128 && !dry) {
        const int tok = m0 + tid;
        const int p0 = hist[64 + e0] + r0, p1 = hist[64 + e1] + r1;
        w.elist[(size_t)e0 * NT + p0] = tok; w.ewt[(size_t)e0 * NT + p0] = w0;
        w.elist[(size_t)e1 * NT + p1] = tok; w.ewt[(size_t)e1 * NT + p1] = w1;
    }
    __syncthreads();
}
__device__ __forceinline__ void eraw_item(const Params& P, int L, const int mt, const int nt, char* lds, const int tid_in) {
    int tid = tid_in; asm volatile("" : "+v"(tid));
    const WS& w = P.w; const nv::Inputs& in = P.in;
    const int lane = tid & 63, wid = tid >> 6;
    float* T = (float*)lds;
    const int m0 = mt * 128, n0 = nt * 128;
    {
        const float* arow[4]; const bf16_t* wrow[4];
#pragma unroll
        for (int i = 0; i < 4; ++i) {
            arow[i] = in.p + ((size_t)L * NT + m0 + (tid >> 3) + 32 * i) * 256 + (tid & 7) * 8;
            wrow[i] = w.Wpt + L * WP_SZ + (size_t)(n0 + (tid >> 3) + 32 * i) * 256 + (tid & 7) * 8;
        }
        f32x16 acc[2][2]; acc_zero(acc);
        float ss[4] = {0.f, 0.f, 0.f, 0.f};
        gemm_mainloop<float, false>(acc, arow, wrow, 4, lds, ss, tid);
        acc_to_lds(acc, T, tid);
    }
    {
        const int sub = lane >> 4, l16 = lane & 15, c8 = l16 * 8;
#pragma unroll 8
        for (int rr = 0; rr < 8; ++rr) {
            const int row = wid * 32 + rr * 4 + sub;
            const float4 x0 = *(const float4*)(T + row * TLD + c8), x1 = *(const float4*)(T + row * TLD + c8 + 4);
            *(uint4*)(w.erb + (size_t)(m0 + row) * 1024 + n0 + c8) = pack8(x0, x1);
            const float sq = grp_sum16(sq8(x0, x1));
            if (l16 == 0) w.essq[(size_t)(m0 + row) * 8 + nt] = sq;
        }
    }
    __syncthreads();
}
__device__ __forceinline__ void phase_router(const Params& P, int L, char* lds, const bool dry = false) {
    const int tid = opaque_tid();
    {
        const int x = blockIdx.x & 7, lb = blockIdx.x >> 3, nlb = gridDim.x >> 3;
        if (lb < 16 || nlb <= 16) { for (int j = lb; j < 16; j += nlb) router_item(P, L, j * 8 + x, lds, tid, dry); }
        if (!dry) {
            if (L == 0 && (lb >= 16 || nlb <= 16)) prep_chunk_drain(P, lds, tid);
            if (nlb > 16) { if (lb >= 16) prep_moe_late(P, L, lds, tid, (lb - 16) * 8 + x, (nlb - 16) * 8); }
            else prep_moe_late(P, L, lds, tid, blockIdx.x, gridDim.x);
        }
    }
}

constexpr int TT_OFF = STAT_OFF + 1024;
__device__ __forceinline__ void moe_table(const Params& P, int L, char* lds, const int tid) {
    int* tt = (int*)(lds + TT_OFF);
    if (tid == 0) {
        const int x = blockIdx.x & 7;
        int o = 0;
        for (int li = 0; li < 64; ++li) { tt[li] = o; o += P.w.cnt[L * 256 + li]; }
        tt[64] = o;
        int t = 0, t0 = 0, t1 = 0;
        for (int k = 0; k < 8; ++k) {
            const int li = ((k >> 1) * 8 + x) * 2 + (k & 1), nt_ = (P.w.cnt[L * 256 + li] + 127) >> 7;
            tt[72 + k] = t; t += nt_;
            if (k & 1) { tt[92 + (k >> 1)] = t1; t1 += nt_; } else { tt[84 + (k >> 1)] = t0; t0 += nt_; }
        }
        tt[80] = t; tt[88] = t0; tt[96] = t1;
        int tu = 0;
        for (int k = 0; k < 4; ++k) { const int e = k * 8 + x; tt[100 + k] = tu; tu += (P.w.cnt[L * 256 + 2 * e] + P.w.cnt[L * 256 + 2 * e + 1] + 127) >> 7; }
        tt[104] = tu;
    }
    __syncthreads();
}
__device__ __forceinline__ void moe_find(const int* tt, int tile, int& li, int& t) {
    int k = 0;
#pragma unroll
    for (int j = 1; j < 8; ++j) if (tile >= tt[72 + j]) k = j;
    li = ((k >> 1) * 8 + (blockIdx.x & 7)) * 2 + (k & 1); t = tile - tt[72 + k];
}
__device__ __forceinline__ void moe_find_slot(const int* tt, int slot, int tile, int& li, int& t) {
    const int* tp = tt + (slot ? 92 : 84);
    int k = 0;
#pragma unroll
    for (int j = 1; j < 4; ++j) if (tile >= tp[j]) k = j;
    li = (k * 8 + (blockIdx.x & 7)) * 2 + slot; t = tile - tp[k];
}
__device__ __forceinline__ void phase_moe_up(const Params& P, int L, char* lds, const bool noeraw = false, const bool fast = false) {
    const WS& w = P.w;
    const int tid0 = opaque_tid();
    float* T = (float*)lds; float* stat = (float*)(lds + STAT_OFF); const int* tt = (const int*)(lds + TT_OFF);
    moe_table(P, L, lds, tid0);
    const int ntiles = tt[104];
    for (int item = blockIdx.x >> 3; item < ntiles * 4; item += (gridDim.x >> 3)) {
        int tid = tid0; asm volatile("" : "+v"(tid));
        const int lane = tid & 63, wid = tid >> 6;
        const int tile = item >> 2, nt = item & 3;
        int k = 0;
#pragma unroll
        for (int j = 1; j < 4; ++j) if (tile >= tt[100 + j]) k = j;
        const int e = k * 8 + (blockIdx.x & 7), t = tile - tt[100 + k];
        const int cnt0 = P.w.cnt[L * 256 + 2 * e], cnt = cnt0 + P.w.cnt[L * 256 + 2 * e + 1];
        const int rbase = tt[2 * e] + t * 128, nrows = min(128, cnt - t * 128);
        {
            const bf16_t* arow[4]; const bf16_t* wrow[4];
#pragma unroll
            for (int i = 0; i < 4; ++i) {
                const int r = (tid >> 3) + 32 * i;
                const int rr3 = t * 128 + (r < nrows ? r : 0);
                const int tok = rr3 < cnt0 ? w.elist[(size_t)(2 * e) * NT + rr3] : w.elist[(size_t)(2 * e + 1) * NT + rr3 - cnt0];
                arow[i] = w.hb1 + (size_t)tok * 1024 + g64_chunk(tid) * 8;
                wrow[i] = w.Wgut + L * WGU_SZ + ((size_t)e * 512 + nt * 128 + r) * 1024 + g64_chunk(tid) * 8;
            }
            f32x16 acc[2][2]; acc_zero(acc);
            float my_rs = 0.f;
            if (tid < 128) {
                const int rr3 = t * 128 + (tid < nrows ? tid : 0);
                const int tok = rr3 < cnt0 ? w.elist[(size_t)(2 * e) * NT + rr3] : w.elist[(size_t)(2 * e + 1) * NT + rr3 - cnt0];
                my_rs = rstd8(w.rssB + (size_t)tok * 8, 1.f / 1024.f);
            }
            gemm_mainloop_b64(w.hb1, w.Wgut, acc, arow, wrow, 16, lds, tid);
            if (tid < 128) stat[tid] = my_rs;
            acc_to_lds(acc, T, tid);
        }
        {
            const int sub = lane >> 4, l16 = lane & 15, c8 = l16 * 8;
#pragma unroll 8
            for (int rr = 0; rr < 8; ++rr) {
                const int row = wid * 32 + rr * 4 + sub; const float rs = stat[row];
                const float4 x0 = mul4(*(const float4*)(T + row * TLD + c8), rs), x1 = mul4(*(const float4*)(T + row * TLD + c8 + 4), rs);
                if (row < nrows)
                    store4(w.hbuf + (size_t)(rbase + row) * 256 + nt * 64 + l16 * 4, x0.x * sigmoid_(x0.x) * x0.y, x0.z * sigmoid_(x0.z) * x0.w,
                           x1.x * sigmoid_(x1.x) * x1.y, x1.z * sigmoid_(x1.z) * x1.w);
            }
        }
        if (fast) asm volatile("s_waitcnt vmcnt(0)" ::: "memory");
        __syncthreads();
        if (fast && tid0 == 0) __hip_atomic_fetch_add(&w.upc[(size_t)(L * 8 + (blockIdx.x & 7)) * UPC_TILES + tile], 1u, __ATOMIC_RELAXED, __HIP_MEMORY_SCOPE_AGENT);
    }
    if (!noeraw) {
        int* qslot = (int*)(lds + TT_OFF + 512);
        for (;;) {
            if (tid0 == 0) *qslot = atomicAdd(&P.w.cnt[L * 256 + ERAW_Q + (blockIdx.x & 7)], 1);
            __syncthreads();
            const int item = *qslot;
            __syncthreads();
            if (item >= 128) break;
            eraw_item(P, L, (item >> 3) * 8 + (blockIdx.x & 7), item & 7, lds, tid0);
        }
    }
}
__device__ __forceinline__ void phase_moe_down(const Params& P, int L, char* lds, const int slot, const bool dry = false, const bool fast = false) {
    const WS& w = P.w;
    const int tid0 = opaque_tid();
    float* T = (float*)lds; float* stat = (float*)(lds + STAT_OFF); const int* tt = (const int*)(lds + TT_OFF);
    moe_table(P, L, lds, tid0);
    const bf16_t* rsrc = slot ? w.hb : w.hb1; bf16_t* rdst = slot ? w.hb1 : w.hb;
    const int ntiles = tt[slot ? 96 : 88];
    const bool dyn = fast && slot == 0;
    const int nlb_ = gridDim.x >> 3;
    int* dq = &P.w.cnt[L * 256 + DOWNQ + (blockIdx.x & 7)];
    volatile int* dqs = (volatile int*)(lds + TT_OFF + 512);
    int item = blockIdx.x >> 3;
    if (dyn) { if (tid0 == 0) *dqs = atomicAdd(dq, 1); __syncthreads(); item = *dqs; __syncthreads(); }
    for (; item < ntiles * 8;) {
        int nxt_item = item + nlb_;
        if (dyn && tid0 == 0) nxt_item = atomicAdd(dq, 1);
        int tid = tid0; asm volatile("" : "+v"(tid));
        const int lane = tid & 63, wid = tid >> 6;
        const int tile = item >> 3, nt = item & 7;
        int li, t; moe_find_slot(tt, slot, tile, li, t);
        const int e = li >> 1;
        const int cnt = P.w.cnt[L * 256 + li], rbase = tt[li] + t * 128, nrows = min(128, cnt - t * 128);
        if (fast && slot == 0) {
            if (tid == 0) {
                const unsigned* c = &w.upc[(size_t)(L * 8 + (blockIdx.x & 7)) * UPC_TILES + tt[100 + (e >> 3)] + t];
                unsigned sp = 0u;
                while (__hip_atomic_load(c, __ATOMIC_RELAXED, __HIP_MEMORY_SCOPE_AGENT) < 4u) { __builtin_amdgcn_s_sleep(1); if (++sp > (1u << 20)) break; }
            }
            asm volatile("s_waitcnt vmcnt(0)" ::: "memory");
            __syncthreads();
        }
        uint4 hh[8];
        {
            const bf16_t* arow[4]; const bf16_t* wrow[4];
#pragma unroll
            for (int i = 0; i < 4; ++i) {
                const int r = (tid >> 3) + 32 * i;
                arow[i] = w.hbuf + (size_t)(rbase + (r < nrows ? r : 0)) * 256 + g64_chunk(tid) * 8;
                wrow[i] = w.Wdt + L * WD_SZ + ((size_t)e * 1024 + nt * 128 + r) * 256 + g64_chunk(tid) * 8;
            }
            f32x16 acc[2][2]; acc_zero(acc);
            int my_tok = 0; float my_wt = 0.f;
            if (tid < 128) { const int rr2 = tid < nrows ? tid : 0; my_tok = w.elist[(size_t)li * NT + t * 128 + rr2]; my_wt = w.ewt[(size_t)li * NT + t * 128 + rr2]; }
            int tk[8];
#pragma unroll
            for (int rr = 0; rr < 8; ++rr) { const int r8 = wid * 32 + rr * 4 + (lane >> 4); tk[rr] = w.elist[(size_t)li * NT + t * 128 + (r8 < nrows ? r8 : 0)]; }
            auto hook = [&]() __attribute__((always_inline)) {
#pragma unroll
                for (int rr = 0; rr < 8; ++rr) hh[rr] = *(const uint4*)(rsrc + (size_t)tk[rr] * 1024 + nt * 128 + (lane & 15) * 8);
            };
            gemm_mainloop_b64<false, 0>(w.hbuf, w.Wdt, acc, arow, wrow, 4, lds, tid, 0, -1, nullptr, -1, nullptr, hook);
            if (tid < 128) { ((int*)stat)[tid] = my_tok; stat[128 + tid] = my_wt; }
            acc_to_lds(acc, T, tid);
        }
        {
            const int sub = lane >> 4, l16 = lane & 15, c8 = l16 * 8;
#pragma unroll
            for (int rr = 0; rr < 8; ++rr) {
                const int row = wid * 32 + rr * 4 + sub;
                const int tok = ((const int*)stat)[row]; const float wt = stat[128 + row];
                const float4 x0 = *(const float4*)(T + row * TLD + c8), x1 = *(const float4*)(T + row * TLD + c8 + 4);
                const uint4 h = hh[rr];
                float4 h0, h1;
                h0.x = bflo(h.x) + wt * x0.x; h0.y = bfhi(h.x) + wt * x0.y; h0.z = bflo(h.y) + wt * x0.z; h0.w = bfhi(h.y) + wt * x0.w;
                h1.x = bflo(h.z) + wt * x1.x; h1.y = bfhi(h.z) + wt * x1.y; h1.z = bflo(h.w) + wt * x1.z; h1.w = bfhi(h.w) + wt * x1.w;
                const float sq = grp_sum16(sq8(h0, h1));
                if (row < nrows && !dry) {
                    *(uint4*)(rdst + (size_t)tok * 1024 + nt * 128 + c8) = pack8(h0, h1);
                    if (slot && l16 == 0) w.rssB[(size_t)tok * 8 + nt] = sq;
                }
            }
        }
        __syncthreads();
        if (dyn) { if (tid0 == 0) *dqs = nxt_item; __syncthreads(); item = *dqs; __syncthreads(); } else item = nxt_item;
    }
}

__device__ __forceinline__ void phase_ple(const Params& P, int L, char* lds, const bool dry = false) {
    const WS& w = P.w; const nv::Inputs& in = P.in;
    const int tid0 = opaque_tid();
    float* T = (float*)lds; float* stat = (float*)(lds + STAT_OFF);
    int mt, nt;
    for (int it = 0; xcd_item(it, 128, 8, mt, nt); ++it) {
        int tid = tid0; asm volatile("" : "+v"(tid));
        const int lane = tid & 63, wid = tid >> 6;
        const int m0 = mt * 128, n0 = nt * 128;
        uint4 hhv[8], erv[8];
        {
            const bf16_t* arow[4]; const bf16_t* wrow[4];
#pragma unroll
            for (int i = 0; i < 4; ++i) {
                arow[i] = w.hb1 + (size_t)(m0 + (tid >> 3) + 32 * i) * 1024 + g64_chunk(tid) * 8;
                wrow[i] = w.Wgt + L * WG_SZ + (size_t)(n0 + (tid >> 3) + 32 * i) * 1024 + g64_chunk(tid) * 8;
            }
            f32x16 acc[2][2]; acc_zero(acc);
            float my_rs = 0.f, my_re = 0.f;
            if (tid < 128) { my_rs = rstd8(w.rssB + (size_t)(m0 + tid) * 8, 1.f / 1024.f); my_re = rstd8(w.essq + (size_t)(m0 + tid) * 8, 1.f / 1024.f); }
            auto hook = [&]() __attribute__((always_inline)) {
#pragma unroll
                for (int rr = 0; rr < 8; ++rr) {
                    const size_t off = (size_t)(m0 + wid * 32 + rr * 4 + (lane >> 4)) * 1024 + n0 + (lane & 15) * 8;
                    hhv[rr] = *(const uint4*)(w.hb1 + off); erv[rr] = *(const uint4*)(w.erb + off);
                }
            };
            gemm_mainloop_b64<false, 0>(w.hb1, w.Wgt, acc, arow, wrow, 16, lds, tid, 0, -1, nullptr, -1, nullptr, hook);
            if (tid < 128) { stat[tid] = my_rs; stat[128 + tid] = my_re; }
            acc_to_lds(acc, T, tid);
        }
        {
            const int sub = lane >> 4, l16 = lane & 15, c8 = l16 * 8;
            const float4 pg0 = *(const float4*)(in.ple_post_norm_g + L * 1024 + n0 + c8), pg1 = *(const float4*)(in.ple_post_norm_g + L * 1024 + n0 + c8 + 4);
#pragma unroll
            for (int rr = 0; rr < 8; ++rr) {
                const int row = wid * 32 + rr * 4 + sub; const float rs = stat[row], re = stat[128 + row]; const size_t tok = m0 + row;
                const float4 x0 = mul4(*(const float4*)(T + row * TLD + c8), rs), x1 = mul4(*(const float4*)(T + row * TLD + c8 + 4), rs);
                const size_t off = tok * 1024 + n0 + c8;
                const uint4 er = erv[rr], hh = hhv[rr];
                float4 h0, h1;
                h0.x = bflo(hh.x) + sigmoid_(x0.x) * (bflo(er.x) * re * pg0.x); h0.y = bfhi(hh.x) + sigmoid_(x0.y) * (bfhi(er.x) * re * pg0.y);
                h0.z = bflo(hh.y) + sigmoid_(x0.z) * (bflo(er.y) * re * pg0.z); h0.w = bfhi(hh.y) + sigmoid_(x0.w) * (bfhi(er.y) * re * pg0.w);
                h1.x = bflo(hh.z) + sigmoid_(x1.x) * (bflo(er.z) * re * pg1.x); h1.y = bfhi(hh.z) + sigmoid_(x1.y) * (bfhi(er.z) * re * pg1.y);
                h1.z = bflo(hh.w) + sigmoid_(x1.z) * (bflo(er.w) * re * pg1.z); h1.w = bfhi(hh.w) + sigmoid_(x1.w) * (bfhi(er.w) * re * pg1.w);
                if (L == 1) { float4* op = (float4*)(P.h + off); op[0] = h0; op[1] = h1; }
                else {
                    *(uint4*)(w.hb + off) = pack8(h0, h1);
                    const float sq = grp_sum16(sq8(h0, h1));
                    if (l16 == 0) w.rssA[tok * 8 + nt] = sq;
                }
            }
        }
        __syncthreads();
    }
}

}
namespace fx {
#define XB_TMO      128
#define XB_XCNT(j)  (256  + 64 * (j))
#define XB_XSUB(j)  (1280 + 64 * (j))
#define XB_XGEN(j)  (2304 + 64 * (j))
#define XB_TOP      3328
#define XCD_BAR_WORDS 3456
#define XB_SPIN_CAP (1u << 18)
#define LAS __attribute__((address_space(3)))
__device__ __forceinline__ unsigned xb_ld(unsigned* p)              { return __hip_atomic_load(p, __ATOMIC_RELAXED, __HIP_MEMORY_SCOPE_AGENT); }
__device__ __forceinline__ unsigned xb_add(unsigned* p, unsigned v) { return __hip_atomic_fetch_add(p, v, __ATOMIC_RELAXED, __HIP_MEMORY_SCOPE_AGENT); }
__device__ __forceinline__ unsigned xb_xcc_id() { return (unsigned)__builtin_amdgcn_s_getreg((3 << 11) | 20) & 0xFu; }
#define XB_SPIN(cond, bar) do { unsigned _sp = 0; while (cond) { __builtin_amdgcn_s_sleep(1); \
    if ((++_sp & 255u) == 0u) { if (xb_ld(&(bar)[XB_TMO])) break; if (_sp > XB_SPIN_CAP) { atomicAdd(&(bar)[XB_TMO], 1u); break; } } } } while (0)
struct XcdBarrier { unsigned* bar; unsigned x; volatile LAS unsigned* st; };
__device__ __forceinline__ XcdBarrier xcd_barrier_post(unsigned* bar, volatile LAS unsigned* st) {
    XcdBarrier b; b.bar = bar; b.x = xb_xcc_id(); b.st = st;
    if (threadIdx.x == 0) (void)xb_add(&bar[XB_XCNT(b.x)], 1u);
    return b;
}
__device__ __forceinline__ void xcd_barrier_complete(unsigned* bar, unsigned x, unsigned& nloc, unsigned& nx) {
    const unsigned G = gridDim.x * gridDim.y * gridDim.z;
    unsigned sum, cnt, mine, sp = 0u;
    for (;;) {
        sum = 0u; cnt = 0u; mine = 0u;
#pragma unroll
        for (unsigned j = 0; j < 16; ++j) { const unsigned c = xb_ld(&bar[XB_XCNT(j)]); sum += c; cnt += (c > 0u) ? 1u : 0u; mine = (j == x) ? c : mine; }
        if (sum == G) break;
        __builtin_amdgcn_s_sleep(1);
        if ((++sp & 255u) == 0u) { if (xb_ld(&bar[XB_TMO])) break; if (sp > XB_SPIN_CAP) { atomicAdd(&bar[XB_TMO], 1u); break; } }
    }
    nloc = mine > 0u ? mine : 1u; nx = cnt > 0u ? cnt : 1u;
}
__device__ __forceinline__ void xcd_barrier(const XcdBarrier& b) {
    asm volatile("s_waitcnt vmcnt(0)" ::: "memory");
    __syncthreads();
    if (threadIdx.x == 0) {
        unsigned* bar = b.bar;
        __builtin_amdgcn_s_waitcnt(0);
        unsigned nloc = b.st[0], nx = b.st[1];
        if (nloc == 0u) { xcd_barrier_complete(bar, b.x, nloc, nx); b.st[0] = nloc; b.st[1] = nx; }
        const unsigned old = xb_add(&bar[XB_XSUB(b.x)], 1u);
        const unsigned gen = old / nloc;
        if (old + 1u == (gen + 1u) * nloc) {
            __builtin_amdgcn_fence(__ATOMIC_RELEASE, "agent");
            asm volatile("s_waitcnt vmcnt(0)" ::: "memory");
            (void)xb_add(&bar[XB_TOP], 1u);
            __builtin_amdgcn_fence(__ATOMIC_ACQUIRE, "agent");
            asm volatile("s_waitcnt vmcnt(0)" ::: "memory");
            xb_add(&bar[XB_XGEN(b.x)], 1u);
            XB_SPIN(xb_ld(&bar[XB_TOP]) < (gen + 1u) * nx, bar);
            asm volatile("buffer_inv sc0\n\ts_waitcnt vmcnt(0)" ::: "memory");
        } else {
            XB_SPIN(xb_ld(&bar[XB_XGEN(b.x)]) == gen, bar);
            XB_SPIN(xb_ld(&bar[XB_TOP]) < (gen + 1u) * nx, bar);
            asm volatile("buffer_inv sc0\n\ts_waitcnt vmcnt(0)" ::: "memory");
        }
    }
    __syncthreads();
}

__device__ __forceinline__ void xcd_barrier_shadow(const XcdBarrier& b, const Params& P, const int kind, const int L, char* lds) {
    asm volatile("s_waitcnt vmcnt(0)" ::: "memory");
    __syncthreads();
    if (threadIdx.x == 0) {
        unsigned* bar = b.bar;
        __builtin_amdgcn_s_waitcnt(0);
        unsigned nloc = b.st[0], nx = b.st[1];
        if (nloc == 0u) { xcd_barrier_complete(bar, b.x, nloc, nx); b.st[0] = nloc; b.st[1] = nx; }
        const unsigned old = xb_add(&bar[XB_XSUB(b.x)], 1u);
        const unsigned gen = old / nloc;
        unsigned leader = 0u;
        if (old + 1u == (gen + 1u) * nloc) {
            leader = 1u;
            __builtin_amdgcn_fence(__ATOMIC_RELEASE, "agent");
            asm volatile("s_waitcnt vmcnt(0)" ::: "memory");
            (void)xb_add(&bar[XB_TOP], 1u);
            __builtin_amdgcn_fence(__ATOMIC_ACQUIRE, "agent");
            asm volatile("s_waitcnt vmcnt(0)" ::: "memory");
            xb_add(&bar[XB_XGEN(b.x)], 1u);
            XB_SPIN(xb_ld(&bar[XB_TOP]) < (gen + 1u) * nx, bar);
            asm volatile("buffer_inv sc0\n\ts_waitcnt vmcnt(0)" ::: "memory");
        }
        b.st[2] = leader; b.st[3] = gen;
        if (!leader) {
            const int item = atomicAdd(&P.w.cnt[kind == 1 ? L * 256 + ERAW_Q + (blockIdx.x & 7) : PREP_Q], 1);
            b.st[2] = item < (kind == 1 ? 128 : PREP_NCH) ? (unsigned)(item + 2) : 0u;
        }
    }
    __syncthreads();
    const unsigned code = b.st[2];
    if (code >= 2u) {
        if (kind == 1) eraw_item(P, L, ((int)(code - 2u) >> 3) * 8 + (blockIdx.x & 7), (int)(code - 2u) & 7, lds, opaque_tid());
        else prep_chunk(P, (int)(code - 2u), lds, opaque_tid());
    }
    if (code != 1u) {
        if (threadIdx.x == 0) {
            unsigned* bar = b.bar;
            const unsigned gen = b.st[3], nx = b.st[1];
            XB_SPIN(xb_ld(&bar[XB_XGEN(b.x)]) == gen, bar);
            XB_SPIN(xb_ld(&bar[XB_TOP]) < (gen + 1u) * nx, bar);
            asm volatile("buffer_inv sc0\n\ts_waitcnt vmcnt(0)" ::: "memory");
        }
    }
    __syncthreads();
}

constexpr int LDS_BYTES = LDS_GEMM_BYTES + 16;
constexpr int N_PHASES = 19;
constexpr int PPL = 9;
__global__ void __launch_bounds__(256, 2) k_run(Params Pin, int ph_lo, int ph_hi) {
    extern __shared__ __attribute__((aligned(16))) char lds[];
    typedef const __attribute__((address_space(4))) Params* KParams;
    KParams kp = (KParams)__builtin_amdgcn_kernarg_segment_ptr();
    (void)Pin;
#define P (*(const Params*)kp)
    volatile LAS unsigned* st = (volatile LAS unsigned*)(lds + LDS_GEMM_BYTES);
    if (threadIdx.x == 0) { st[0] = 0u; st[1] = 0u; }
    __syncthreads();
    XcdBarrier xb = xcd_barrier_post(P.w.bar, st);
#ifdef EXTRA_BARRIERS
    for (int i = 0; i < EXTRA_BARRIERS; ++i) xcd_barrier(xb);
#endif
    if (threadIdx.x == 0 && xb.x != (blockIdx.x & 7u)) atomicAdd(&P.w.cnt[FAST_FLAG], 1);
    int fast = 0;
    for (int ph = ph_lo; ph < ph_hi; ++ph) {
        asm volatile("" : "+s"(kp));
        if (ph > ph_lo && fast && (ph - 1) % PPL == 6) {
        } else
        if (ph > ph_lo) {
#ifndef NO_SHADOW
            const int s_in = (ph - 1) % PPL;
            if (s_in == 4 || s_in == 5) xcd_barrier_shadow(xb, P, 1, (ph - 1) / PPL, lds);
            else if (ph <= 4) xcd_barrier_shadow(xb, P, 2, 0, lds);
            else
#endif
            xcd_barrier(xb);
        }
        if (ph == 1 && ph_lo == 0 && ph_hi == N_PHASES)
            fast = __builtin_amdgcn_readfirstlane((int)(xb_ld((unsigned*)&P.w.cnt[FAST_FLAG]) == 0u));
        int reps = 1;
#ifdef REP_PHASE
        if (ph == 0 ? (REP_PHASE == 0) : (((ph - 1) % PPL) == REP_PHASE - 1)) reps = 2;
        asm volatile("" : "+s"(reps));
#endif
        for (int rep = 0; rep < reps; ++rep) {
            const bool dry = rep + 1 < reps;
            if (rep > 0) xcd_barrier(xb);
            if (ph == 0) phase_prep(P, lds);
            else {
                const int L = (ph - 1) / PPL, s = (ph - 1) % PPL;
                switch (s) {
                    case 0: phase_zgemm(P, L, lds, dry); break;
                    case 1: phase_mix(P, L, lds, rep, dry); break;
                    case 2: phase_attn(P, L, lds); break;
                    case 3: phase_oproj(P, L, lds, dry); break;
                    case 4: phase_router(P, L, lds, dry); break;
                    case 5: phase_moe_up(P, L, lds, dry, fast != 0); break;
                    case 6: phase_moe_down(P, L, lds, 0, dry, fast != 0); break;
                    case 7: phase_moe_down(P, L, lds, 1, dry); break;
                    case 8: phase_ple(P, L, lds, dry); break;
                }
            }
        }
    }
}
#undef P
}
#ifndef MK_N_LAUNCHES
#define MK_N_LAUNCHES 1
#endif
extern "C" void kernel_launch(void* const* d_in, const int* in_sizes, int n_in, void* d_out, int out_size, void* d_ws, size_t ws_size,
                              hipStream_t stream) {
    nv::Inputs in{};
    in.x = (const float*)d_in[0]; in.p = (const float*)d_in[1]; in.positions = (const int*)d_in[2];
    const float** f = &in.mix_norm_g;
    for (int i = 0; i < 32; ++i) f[i] = (const float*)d_in[3 + i];
    size_t used = 0;
    fx::WS w = fx::make_ws((char*)d_ws, used);
    static int grid = 0;
    if (grid == 0) {
        if (n_in != 35 || out_size != fx::NT * 1024 || used > ws_size) { fprintf(stderr, "kernel_launch: unexpected shapes / workspace (need %zu, have %zu)\n", used, ws_size); grid = -1; return; }
        if (hipFuncSetAttribute((const void*)fx::k_run, hipFuncAttributeMaxDynamicSharedMemorySize, fx::LDS_BYTES) != hipSuccess) { fprintf(stderr, "hipFuncSetAttribute failed\n"); grid = -1; return; }
        int dev = 0, cus = 0, per_cu = 0;
        hipGetDevice(&dev); hipDeviceGetAttribute(&cus, hipDeviceAttributeMultiprocessorCount, dev);
        hipOccupancyMaxActiveBlocksPerMultiprocessor(&per_cu, (const void*)fx::k_run, 256, fx::LDS_BYTES);
        if (per_cu > 2) per_cu = 2;
        if (per_cu < 1) { fprintf(stderr, "occupancy query says %d blocks/CU\n", per_cu); grid = -1; return; }
        grid = cus * per_cu;
    }
    if (grid < 0) return;
    fx::Params P{}; P.in = in; P.h = (float*)d_out; P.w = w;
    hipMemsetAsync(w.cnt, 0, (size_t)((char*)w.upc - (char*)w.cnt) + (size_t)fx::UPC_WORDS * 4, stream);
    if (MK_N_LAUNCHES == 1) hipLaunchKernelGGL(fx::k_run, dim3(grid), dim3(256), fx::LDS_BYTES, stream, P, 0, fx::N_PHASES);
    else for (int ph = 0; ph < fx::N_PHASES; ++ph) hipLaunchKernelGGL(fx::k_run, dim3(grid), dim3(256), fx::LDS_BYTES, stream, P, ph, ph + 1);
}
```
